# Optimizing an MI355X kernel written in HIP

```python
import jax, jax.numpy as jnp
from jax import lax
import numpy as np

D_MODEL = 1024
BATCH = 8
SEQ = 8192
DEPTH = 2

N_EVEN = (DEPTH + 1) // 2
N_ODD = DEPTH // 2
NORM_EPS = 1e-6
NEG_INF = -1e30

GMLP_GROUPS = 4
GMLP_GROUP_DIM = 128
GMLP_WIDTH = GMLP_GROUPS * GMLP_GROUP_DIM
GMLP_CHUNK = 128
HGRN_HEADS = 4
HGRN_KEY_DIM = 128
HGRN_VAL_DIM = 128
HGRN_KEY_WIDTH = HGRN_HEADS * HGRN_KEY_DIM
HGRN_WIDTH = HGRN_HEADS * HGRN_VAL_DIM
HGRN_CHUNK = 64
EVEN_IN_WIDTH = 2 * GMLP_WIDTH + 2 * HGRN_KEY_WIDTH + 2 * HGRN_WIDTH
EVEN_SPLITS = (GMLP_WIDTH, 2 * GMLP_WIDTH, 2 * GMLP_WIDTH + HGRN_KEY_WIDTH,
               2 * GMLP_WIDTH + 2 * HGRN_KEY_WIDTH, 2 * GMLP_WIDTH + 2 * HGRN_KEY_WIDTH + HGRN_WIDTH)
EVEN_MIX_WIDTH = GMLP_WIDTH + HGRN_WIDTH
ATTN_HEADS = 16
ATTN_HEAD_DIM = 64
ATTN_WIDTH = ATTN_HEADS * ATTN_HEAD_DIM
ROT_DIM = ATTN_HEAD_DIM // 4
ROPE_THETA = 500000.0
DILATED_GROUPS = ((128, 1), (512, 4), (2048, 16))
ATTN_Q_BLOCK = 128
PEER_N_KEYS = 128
PEER_N_EXPERTS = PEER_N_KEYS * PEER_N_KEYS
PEER_HEADS = 8
PEER_KEY_DIM = 256
PEER_KEY_HALF = PEER_KEY_DIM // 2
PEER_TOPK = 16
PEER_TOKEN_BLOCK = 128

kernel_name = 'hybrid_gmlp_hgrn2_dilated_peer_block'


def rms_norm(x, g):
    x32 = x.astype(jnp.float32)
    y = x32 * lax.rsqrt(jnp.mean(x32 * x32, axis=-1, keepdims=True) + NORM_EPS)
    return (y * g.astype(jnp.float32)).astype(x.dtype)


def gmlp_spatial_gating(u_raw, v_raw, ln_g, ln_b, w_s, b_s):
    B, S, _ = u_raw.shape
    n_chunks = S // GMLP_CHUNK
    shp = (B, n_chunks, GMLP_CHUNK, GMLP_GROUPS, GMLP_GROUP_DIM)
    u = jax.nn.gelu(u_raw.astype(jnp.float32), approximate=False).reshape(shp)
    v = jax.nn.gelu(v_raw.astype(jnp.float32), approximate=False).reshape(shp)
    mu = jnp.mean(v, axis=-1, keepdims=True)
    var = jnp.mean(jnp.square(v - mu), axis=-1, keepdims=True)
    v = (v - mu) * lax.rsqrt(var + NORM_EPS) * ln_g.astype(jnp.float32).reshape(GMLP_GROUPS, GMLP_GROUP_DIM) \
        + ln_b.astype(jnp.float32).reshape(GMLP_GROUPS, GMLP_GROUP_DIM)
    causal = jnp.tril(jnp.ones((GMLP_CHUNK, GMLP_CHUNK), dtype=bool))
    w = jnp.where(causal[None], w_s.astype(jnp.float32), 0.0)
    s = jnp.einsum('gts,bnsgc->bntgc', w, v) + b_s.astype(jnp.float32).T[:, :, None]
    return (u * s).reshape(B, S, GMLP_WIDTH)


def hgrn2_chunk_scan(q, k, v, log_f):
    B, S, H, K = q.shape
    V = v.shape[-1]
    n = S // HGRN_CHUNK
    def to_chunks(t):
        return t.reshape(B, n, HGRN_CHUNK, H, t.shape[-1]).transpose(1, 0, 3, 2, 4)
    causal = jnp.tril(jnp.ones((HGRN_CHUNK, HGRN_CHUNK), dtype=bool))[:, :, None]
    def step(state, inp):
        qi, ki, vi, gi = inp
        b = jnp.cumsum(gi, axis=2)
        diff = b[:, :, :, None, :] - b[:, :, None, :, :]
        decay = jnp.exp(jnp.where(causal, diff, -jnp.inf))
        attn = jnp.einsum('bhtk,bhtsk,bhsk->bhts', qi, decay, ki)
        o = jnp.einsum('bhts,bhsv->bhtv', attn, vi) + jnp.einsum('bhtk,bhkv->bhtv', qi * jnp.exp(b), state)
        b_last = b[:, :, -1:, :]
        new_state = jnp.exp(b_last[:, :, 0, :])[..., None] * state \
            + jnp.einsum('bhsk,bhsv->bhkv', ki * jnp.exp(b_last - b), vi)
        return new_state, o
    state0 = jnp.zeros((B, H, K, V), jnp.float32)
    _, o = lax.scan(step, state0, (to_chunks(q), to_chunks(k), to_chunks(v), to_chunks(log_f)))
    return o.transpose(1, 0, 3, 2, 4).reshape(B, S, H, V)


def hgrn2_mixer(q_raw, f_raw, i_raw, g_raw, lower_bound, norm_g):
    B, S, _ = q_raw.shape
    H, K, V = HGRN_HEADS, HGRN_KEY_DIM, HGRN_VAL_DIM
    q = jax.nn.silu(q_raw.astype(jnp.float32)).reshape(B, S, H, K) * (K ** -0.5)
    lb = lower_bound.astype(jnp.float32).reshape(H, K)
    f = lb + (1.0 - lb) * jax.nn.sigmoid(f_raw.astype(jnp.float32).reshape(B, S, H, K))
    k = 1.0 - f
    v = i_raw.astype(jnp.float32).reshape(B, S, H, V)
    o = hgrn2_chunk_scan(q, k, v, jnp.log(f))
    o = o * lax.rsqrt(jnp.mean(o * o, axis=-1, keepdims=True) + NORM_EPS) * norm_g.astype(jnp.float32).reshape(H, V)
    o = o * jax.nn.silu(g_raw.astype(jnp.float32).reshape(B, S, H, V))
    return o.reshape(B, S, H * V)


def even_mixer(h, w_in, w_out, ln_g, ln_b, w_s, b_s, lower_bound, hgrn_norm_g):
    p = h @ w_in
    a_u, a_v, b_q, b_f, b_i, b_g = jnp.split(p, EVEN_SPLITS, axis=-1)
    ya = gmlp_spatial_gating(a_u, a_v, ln_g, ln_b, w_s, b_s)
    yb = hgrn2_mixer(b_q, b_f, b_i, b_g, lower_bound, hgrn_norm_g)
    return jnp.concatenate([ya, yb], axis=-1).astype(h.dtype) @ w_out


def partial_rotary(x, positions):
    half = ROT_DIM // 2
    inv_freq = 1.0 / (ROPE_THETA ** (jnp.arange(half, dtype=jnp.float32) * (2.0 / ROT_DIM)))
    ang = positions.astype(jnp.float32)[..., None] * inv_freq
    cos = jnp.cos(ang)[:, :, None, :]
    sin = jnp.sin(ang)[:, :, None, :]
    x1 = x[..., :half]
    x2 = x[..., half:ROT_DIM]
    return jnp.concatenate([x1 * cos - x2 * sin, x2 * cos + x1 * sin, x[..., ROT_DIM:]], axis=-1)


def dilated_window_attention(q, k, v, window, dilation):
    S, H, E = q.shape
    L = S // dilation
    n_back = window // dilation
    Qb = ATTN_Q_BLOCK
    nb = -(-L // Qb)
    Lp = nb * Qb
    def by_residue(t):
        return t.reshape(L, dilation, H, E).transpose(1, 0, 2, 3)
    qb = jnp.pad(by_residue(q), ((0, 0), (0, Lp - L), (0, 0), (0, 0))).reshape(dilation, nb, Qb, H, E)
    def key_blocks(t):
        tp = jnp.pad(by_residue(t), ((0, 0), (Qb, Lp - L), (0, 0), (0, 0))).reshape(dilation, nb + 1, Qb, H, E)
        return jnp.concatenate([tp[:, :-1], tp[:, 1:]], axis=2)
    kb = key_blocks(k)
    vb = key_blocks(v)
    qi = jnp.arange(Qb)[:, None]
    kj = jnp.arange(2 * Qb)[None, :]
    dist = qi + Qb - kj
    band = (dist >= 0) & (dist <= n_back)
    not_first = jnp.arange(nb)[:, None, None] > 0
    mask = band[None] & (not_first | (kj[None] >= Qb))
    s = jnp.einsum('rnqhe,rnkhe->rnhqk', qb, kb) * (ATTN_HEAD_DIM ** -0.5)
    s = jnp.where(mask[None, :, None], s, NEG_INF)
    m = jnp.max(s, axis=-1, keepdims=True)
    p = jnp.exp(s - m)
    den = jnp.sum(p, axis=-1)
    o = jnp.einsum('rnhqk,rnkhe->rnqhe', p, vb) / jnp.swapaxes(den, 2, 3)[..., None]
    lse = jnp.swapaxes(m[..., 0] + jnp.log(den), 2, 3)
    def back(t):
        t = t.reshape(dilation, Lp, *t.shape[3:])[:, :L]
        return jnp.swapaxes(t, 0, 1).reshape(S, *t.shape[2:])
    return back(o), back(lse)


def dilated_mixture_one_seq(qkv):
    q, k, v = qkv
    outs, lses = [], []
    for window, dilation in DILATED_GROUPS:
        o, l = dilated_window_attention(q, k, v, window, dilation)
        outs.append(o)
        lses.append(l)
    alpha = jax.nn.softmax(jnp.stack(lses), axis=0)
    return jnp.einsum('gsh,gshe->she', alpha, jnp.stack(outs))


def odd_mixer(h, positions, w_qkv, w_out):
    B, S, _ = h.shape
    qkv = (h @ w_qkv).astype(jnp.float32).reshape(B, S, 3, ATTN_HEADS, ATTN_HEAD_DIM)
    q = partial_rotary(qkv[:, :, 0], positions)
    k = partial_rotary(qkv[:, :, 1], positions)
    v = qkv[:, :, 2]
    o = lax.map(dilated_mixture_one_seq, (q, k, v))
    return o.reshape(B, S, ATTN_WIDTH).astype(h.dtype) @ w_out


def peer_block(xb, w_query, sub_keys, down, up):
    TB = xb.shape[0]
    q = (xb @ w_query).astype(jnp.float32).reshape(TB, PEER_HEADS, 2, PEER_KEY_HALF)
    sk = sub_keys.astype(jnp.float32)
    s1 = jnp.einsum('thc,nc->thn', q[:, :, 0], sk[0])
    s2 = jnp.einsum('thc,nc->thn', q[:, :, 1], sk[1])
    v1, i1 = lax.top_k(s1, PEER_TOPK)
    v2, i2 = lax.top_k(s2, PEER_TOPK)
    cand_s = (v1[..., :, None] + v2[..., None, :]).reshape(TB, PEER_HEADS, PEER_TOPK * PEER_TOPK)
    cand_i = (i1[..., :, None] * PEER_N_KEYS + i2[..., None, :]).reshape(TB, PEER_HEADS, PEER_TOPK * PEER_TOPK)
    top_s, top_p = lax.top_k(cand_s, PEER_TOPK)
    idx = jnp.take_along_axis(cand_i, top_p, axis=-1).reshape(TB, PEER_HEADS * PEER_TOPK)
    g = jax.nn.softmax(top_s, axis=-1).reshape(TB, PEER_HEADS * PEER_TOPK)
    u = jnp.take(down, idx, axis=0)
    a = jax.nn.gelu(jnp.einsum('td,tkd->tk', xb, u).astype(jnp.float32), approximate=False)
    w = jnp.take(up, idx, axis=0)
    return jnp.einsum('tk,tkd->td', (g * a).astype(xb.dtype), w)


def peer_ffn(h, w_query, sub_keys, down, up):
    B, S, D = h.shape
    nblk = (B * S) // PEER_TOKEN_BLOCK
    xb = h.reshape(nblk, PEER_TOKEN_BLOCK, D)
    out = lax.map(lambda t: peer_block(t, w_query, sub_keys, down, up), xb)
    return out.reshape(B, S, D).astype(h.dtype)


def setup_inputs(seed: int = 0) -> dict:
    key = jax.random.key(seed)
    ks = jax.random.split(key, 24)
    f32 = jnp.float32
    D = D_MODEL
    def nrm(k, shape, scale):
        return jax.random.normal(k, shape, f32) * scale
    x = nrm(ks[0], (BATCH, SEQ, D), 1.0)
    c = nrm(ks[1], (BATCH, D), 1.0)
    offsets = jax.random.randint(ks[2], (BATCH, 1), 0, 4096, dtype=jnp.int32)
    positions = offsets + jnp.arange(SEQ, dtype=jnp.int32)[None, :]
    return {
        'x': x,
        'c': c,
        'positions': positions,
        'ada_w': nrm(ks[3], (DEPTH, D, 6 * D), 0.5 * D ** -0.5),
        'ada_b': nrm(ks[4], (DEPTH, 6 * D), 0.01),
        'norm_mix_g': 1.0 + nrm(ks[5], (DEPTH, D), 0.02),
        'norm_ffn_g': 1.0 + nrm(ks[6], (DEPTH, D), 0.02),
        'final_norm_g': 1.0 + nrm(ks[7], (D,), 0.02),
        'even_w_in': nrm(ks[8], (N_EVEN, D, EVEN_IN_WIDTH), D ** -0.5),
        'even_w_out': nrm(ks[9], (N_EVEN, EVEN_MIX_WIDTH, D), EVEN_MIX_WIDTH ** -0.5),
        'gmlp_ln_g': 1.0 + nrm(ks[10], (N_EVEN, GMLP_WIDTH), 0.02),
        'gmlp_ln_b': nrm(ks[11], (N_EVEN, GMLP_WIDTH), 0.02),
        'gmlp_w_s': nrm(ks[12], (N_EVEN, GMLP_GROUPS, GMLP_CHUNK, GMLP_CHUNK), GMLP_CHUNK ** -0.5),
        'gmlp_b_s': 1.0 + nrm(ks[13], (N_EVEN, GMLP_GROUPS, GMLP_CHUNK), 0.02),
        'hgrn_lb_logits': nrm(ks[14], (N_EVEN + 1, HGRN_KEY_WIDTH), 0.1),
        'hgrn_norm_g': 1.0 + nrm(ks[15], (N_EVEN, HGRN_WIDTH), 0.02),
        'odd_w_qkv': nrm(ks[16], (N_ODD, D, 3 * ATTN_WIDTH), D ** -0.5),
        'odd_w_out': nrm(ks[17], (N_ODD, ATTN_WIDTH, D), ATTN_WIDTH ** -0.5),
        'peer_w_query': nrm(ks[18], (DEPTH, D, PEER_HEADS * PEER_KEY_DIM), D ** -0.5),
        'peer_sub_keys': nrm(ks[19], (DEPTH, 2, PEER_N_KEYS, PEER_KEY_HALF), PEER_KEY_HALF ** -0.5),
        'peer_down': nrm(ks[20], (DEPTH, PEER_N_EXPERTS, D), D ** -0.5),
        'peer_up': nrm(ks[21], (DEPTH, PEER_N_EXPERTS, D), 1.0),
    }


def reference(x, c, positions, ada_w, ada_b, norm_mix_g, norm_ffn_g, final_norm_g,
              even_w_in, even_w_out, gmlp_ln_g, gmlp_ln_b, gmlp_w_s, gmlp_b_s,
              hgrn_lb_logits, hgrn_norm_g, odd_w_qkv, odd_w_out,
              peer_w_query, peer_sub_keys, peer_down, peer_up):
    lower_bounds = jnp.cumsum(jax.nn.softmax(hgrn_lb_logits.astype(jnp.float32), axis=0), axis=0)
    cond = jax.nn.silu(c)
    for layer in range(DEPTH):
        mod = (cond @ ada_w[layer] + ada_b[layer])[:, None, :]
        sh1, sc1, g1, sh2, sc2, g2 = jnp.split(mod, 6, axis=-1)
        h = rms_norm(x, norm_mix_g[layer]) * (1.0 + sc1) + sh1
        j = layer // 2
        if layer % 2 == 0:
            y = even_mixer(h, even_w_in[j], even_w_out[j], gmlp_ln_g[j], gmlp_ln_b[j],
                           gmlp_w_s[j], gmlp_b_s[j], lower_bounds[j], hgrn_norm_g[j])
        else:
            y = odd_mixer(h, positions, odd_w_qkv[j], odd_w_out[j])
        x = x + g1 * y
        h = rms_norm(x, norm_ffn_g[layer]) * (1.0 + sc2) + sh2
        x = x + g2 * peer_ffn(h, peer_w_query[layer], peer_sub_keys[layer], peer_down[layer], peer_up[layer])
    return rms_norm(x, final_norm_g)
```

```cpp
#include <hip/hip_runtime.h>
#include <cstdio>
#include <cstdint>
#include <cmath>
namespace pg8 {
#define PG8_LAS __attribute__((address_space(3)))
typedef unsigned short bf16_t;
typedef short bf16x8 __attribute__((ext_vector_type(8)));
typedef float f32x4 __attribute__((ext_vector_type(4)));
typedef unsigned u32x4 __attribute__((ext_vector_type(4)));
constexpr int BM = 256, BK = 64, HALF = 128, HTB = HALF * BK * 2  , STAGE_BYTES = 8 * HTB, NXCD = 8, WGM = 8;

__host__ __device__ __forceinline__ int lds_byte(int r, int c) { const int st = (r >> 4) * 2 + (c >> 5), rr = r & 15, cc = c & 31, ob = rr * 64 + cc * 2; return st * 1024 + (ob ^ (((ob >> 9) & 1) << 5)); }
__host__ __device__ __forceinline__ void stage_rc(int b, int& R, int& C) { const int st = b / 1024, sb = b % 1024, swz = sb ^ (((sb >> 9) & 1) << 5); R = (st >> 1) * 16 + swz / 64; C = (st & 1) * 32 + (swz % 64) / 2; }
__host__ __device__ __forceinline__ int perm32(int rho) { const int n = rho >> 4, i = rho & 15; return 8 * (i >> 2) + 4 * n + (i & 3); }

struct Unit { int pm, pn; };
struct Gemm { const bf16_t* A; const bf16_t* Bt; int M, N, K; };

struct StaticOrder {
    int nM, nN, nwg, G, c;
    __host__ __device__ void init(int M, int N, int G_, int c_) { nM = M / BM; nN = N / BM; nwg = nM * nN; G = G_; c = c_; }
    __host__ __device__ bool next(int i, Unit& u) const {
        const long L = (long)i * G + c; if (L >= nwg) return false;
        int wgid = (int)L; { const int q = nwg / NXCD, r = nwg % NXCD, xcd = wgid % NXCD, off = wgid / NXCD; wgid = (xcd < r ? xcd * (q + 1) : r * (q + 1) + (xcd - r) * q) + off; }
        const int nig = WGM * nN, gid = wgid / nig, fm = gid * WGM, gsz = (nM - fm) < WGM ? (nM - fm) : WGM;
        u.pm = fm + ((wgid % nig) % gsz); u.pn = (wgid % nig) / gsz; return true;
    }
    __device__ __forceinline__ void a_ready(const Unit&) const {}
    __device__ __forceinline__ void done(const Unit&) const {}
};

__device__ __forceinline__ unsigned cvt_pk_bf16(float lo, float hi) { unsigned r; asm volatile("v_cvt_pk_bf16_f32 %0, %1, %2" : "=v"(r) : "v"(lo), "v"(hi)); return r; }
typedef float f32x2 __attribute__((ext_vector_type(2)));
__device__ __forceinline__ f32x2 gelu_pk(f32x2 v) {
    const f32x2 av = __builtin_elementwise_abs(v), d = av * 0.2316418882f + 1.0f;
    f32x2 t; t.x = __builtin_amdgcn_rcpf(d.x); t.y = __builtin_amdgcn_rcpf(d.y);
    f32x2 q = t * 0.5307027145f + (-0.7265760135f); q = q * t + 0.7107068705f; q = q * t + (-0.142248368f); q = q * t + 0.127414796f; q = q * t;
    const f32x2 s = (v * v) * (-0.72134752044f);
    f32x2 e; e.x = __builtin_amdgcn_exp2f(s.x); e.y = __builtin_amdgcn_exp2f(s.y);
    const f32x2 m = v * (q * e), r = v - m;
    f32x2 o; o.x = v.x < 0.f ? m.x : r.x; o.y = v.y < 0.f ? m.y : r.y; return o;
}

template <class Epi, class Sched, bool ALIGN_EPI = false, bool SP2 = false>
__device__ __forceinline__ void gemm_phase(PG8_LAS unsigned char* lds, const Gemm g, const Sched& S, const Epi& E) {
    const int tid = threadIdx.x, wid = __builtin_amdgcn_readfirstlane(tid >> 6), lane = tid & 63, wr = wid >> 2, wc = wid & 3, fr = lane & 15, fq = lane >> 4;
    const int K = g.K, nt = K / BK;
    unsigned voffA[2], voffB[2];
#pragma unroll
    for (int i = 0; i < 2; ++i) { int R, C; stage_rc(tid * 16 + i * 8192, R, C); const int Rb = Epi::PERM ? ((R & ~31) + perm32(R & 31)) : R;
        voffA[i] = (unsigned)(R * K + C) * 2u; voffB[i] = (unsigned)(Rb * K + C) * 2u; }
    const size_t kstep = (size_t)(BK * 2);
    const size_t hstep = (size_t)HALF * K * 2;
    const size_t tstep = 2 * hstep;
    const unsigned ldsw = (unsigned)wid * 1024u;
    const int aoff = lds_byte(wr * 64 + fr, fq * 8), boff = lds_byte(wc * 32 + fr, fq * 8);
#define PG8_SA(b, h) (((b) * 2 + (h)) * HTB)
#define PG8_SB(b, h) ((4 + (b) * 2 + (h)) * HTB)
#define PG8_STAGE(bufoff, gbase, voff) do { _Pragma("unroll") for (int _i = 0; _i < 2; ++_i) \
        __builtin_amdgcn_global_load_lds((const unsigned*)((const char*)(gbase) + (voff)[_i]), (PG8_LAS unsigned*)(lds + (bufoff) + ldsw + _i * 8192), 16, 0, 0); } while (0)
#define PG8_LDA(dst, b, h) do { _Pragma("unroll") for (int m = 0; m < 4; ++m) _Pragma("unroll") for (int k = 0; k < 2; ++k) dst[m][k] = *(const PG8_LAS bf16x8*)(lds + PG8_SA(b, h) + aoff + m * 2048 + k * 1024); } while (0)
#define PG8_LDB(dst, b, h) do { _Pragma("unroll") for (int n = 0; n < 2; ++n) _Pragma("unroll") for (int k = 0; k < 2; ++k) dst[n][k] = *(const PG8_LAS bf16x8*)(lds + PG8_SB(b, h) + boff + n * 2048 + k * 1024); } while (0)
#define PG8_MMA(ai, bj, At, Bt) do { __builtin_amdgcn_s_setprio(1); _Pragma("unroll") for (int m = 0; m < 4; ++m) _Pragma("unroll") for (int n = 0; n < 2; ++n) _Pragma("unroll") for (int k = 0; k < 2; ++k) \
        acc[ai][bj][m][n] = __builtin_amdgcn_mfma_f32_16x16x32_bf16(Bt[n][k], At[m][k], acc[ai][bj][m][n], 0, 0, 0); __builtin_amdgcn_s_setprio(0); } while (0)
#define PG8_WAIT_V(n) asm volatile("s_waitcnt vmcnt(" #n ")" ::: "memory")
#define PG8_WAIT_L(n) asm volatile("s_waitcnt lgkmcnt(" #n ")" ::: "memory")
#define PG8_BAR __builtin_amdgcn_s_barrier()
#define PG8_SCHED __builtin_amdgcn_sched_barrier(0)
    Unit cur, nxt; int ui = 0;
    if (!S.next(0, cur)) return;
    f32x4 acc[2][2][4][2];
#pragma unroll
    for (int a = 0; a < 2; ++a)
#pragma unroll
        for (int b = 0; b < 2; ++b)
#pragma unroll
            for (int m = 0; m < 4; ++m)
#pragma unroll
                for (int n = 0; n < 2; ++n) acc[a][b][m][n] = (f32x4){0.f, 0.f, 0.f, 0.f};
    bf16x8 At[4][2], B0[2][2], B1[2][2];
    const char* cA = (const char*)g.A + (size_t)cur.pm * tstep; const char* cB = (const char*)g.Bt + (size_t)cur.pn * tstep;
    S.a_ready(cur);
    if constexpr (SP2) {
        PG8_STAGE(PG8_SB(0, 0), cB, voffB); PG8_STAGE(PG8_SB(0, 1), cB + hstep, voffB); PG8_STAGE(PG8_SA(0, 0), cA, voffA); PG8_STAGE(PG8_SA(0, 1), cA + hstep, voffA);
        if (wr == 1) PG8_BAR;
        PG8_WAIT_V(2); PG8_BAR;
        PG8_STAGE(PG8_SB(1, 0), cB + kstep, voffB); PG8_STAGE(PG8_SA(1, 0), cA + kstep, voffA); PG8_STAGE(PG8_SB(1, 1), cB + hstep + kstep, voffB);
        PG8_WAIT_V(6); PG8_BAR;
    } else {
        PG8_STAGE(PG8_SB(0, 0), cB, voffB); PG8_STAGE(PG8_SA(0, 0), cA, voffA); PG8_STAGE(PG8_SB(0, 1), cB + hstep, voffB); PG8_STAGE(PG8_SA(0, 1), cA + hstep, voffA);
        if (wr == 1) PG8_BAR;
        PG8_WAIT_V(4); PG8_BAR;
        PG8_STAGE(PG8_SB(1, 0), cB + kstep, voffB); PG8_STAGE(PG8_SA(1, 0), cA + kstep, voffA); PG8_STAGE(PG8_SB(1, 1), cB + hstep + kstep, voffB);
        PG8_WAIT_V(6); PG8_BAR;
    }
    for (;;) {
        const bool has_next = S.next(ui + 1, nxt);
        const char* nA = has_next ? (const char*)g.A + (size_t)nxt.pm * tstep : cA; const char* nB = has_next ? (const char*)g.Bt + (size_t)nxt.pn * tstep : cB;
        for (int t = 0; t < nt; t += 2) {
            const bool last = (t == nt - 2);
            const char* a1 = cA + (size_t)(t + 1) * kstep;
            const char* a2 = last ? nA : cA + (size_t)(t + 2) * kstep; const char* b2 = last ? nB : cB + (size_t)(t + 2) * kstep;
            const char* a3 = a2 + kstep; const char* b3 = b2 + kstep;
            if (last && has_next) S.a_ready(nxt);
            if constexpr (SP2) {
            PG8_LDB(B0, 0, 0); PG8_LDB(B1, 0, 1); PG8_SCHED; PG8_LDA(At, 0, 0); PG8_STAGE(PG8_SA(1, 1), a1 + hstep, voffA);
            PG8_WAIT_V(8); PG8_WAIT_L(0); PG8_BAR; PG8_MMA(0, 0, At, B0); PG8_MMA(0, 1, At, B1); PG8_BAR; PG8_SCHED;
            PG8_LDA(At, 0, 1); PG8_STAGE(PG8_SB(0, 0), b2, voffB); PG8_STAGE(PG8_SB(0, 1), b2 + hstep, voffB); PG8_STAGE(PG8_SA(0, 0), a2, voffA);
            PG8_WAIT_V(8); PG8_WAIT_L(0); PG8_BAR; PG8_MMA(1, 0, At, B0); PG8_MMA(1, 1, At, B1); PG8_BAR; PG8_SCHED;
            PG8_LDB(B0, 1, 0); PG8_LDB(B1, 1, 1); PG8_SCHED; PG8_LDA(At, 1, 0); PG8_STAGE(PG8_SA(0, 1), a2 + hstep, voffA);
            PG8_WAIT_V(8); PG8_WAIT_L(0); PG8_BAR; PG8_MMA(0, 0, At, B0); PG8_MMA(0, 1, At, B1); PG8_BAR; PG8_SCHED;
            PG8_LDA(At, 1, 1); PG8_STAGE(PG8_SB(1, 0), b3, voffB); PG8_STAGE(PG8_SB(1, 1), b3 + hstep, voffB); PG8_STAGE(PG8_SA(1, 0), a3, voffA);
            PG8_WAIT_V(8); PG8_WAIT_L(0); PG8_BAR; PG8_MMA(1, 0, At, B0); PG8_MMA(1, 1, At, B1); PG8_BAR; PG8_SCHED;
            } else {
            PG8_LDB(B0, 0, 0); PG8_SCHED; PG8_LDA(At, 0, 0); PG8_STAGE(PG8_SA(1, 1), a1 + hstep, voffA);
            PG8_WAIT_L(8); PG8_BAR; PG8_WAIT_L(0); PG8_MMA(0, 0, At, B0); PG8_BAR; PG8_SCHED;
            PG8_LDB(B1, 0, 1); PG8_STAGE(PG8_SB(0, 0), b2, voffB);
            PG8_BAR; PG8_WAIT_L(0); PG8_MMA(0, 1, At, B1); PG8_BAR;
            PG8_LDA(At, 0, 1); PG8_STAGE(PG8_SA(0, 0), a2, voffA);
            PG8_BAR; PG8_WAIT_L(0); PG8_MMA(1, 0, At, B0); PG8_BAR; PG8_SCHED;
            PG8_STAGE(PG8_SB(0, 1), b2 + hstep, voffB);
            PG8_WAIT_V(6); PG8_BAR; PG8_MMA(1, 1, At, B1); PG8_BAR;
            PG8_LDB(B0, 1, 0); PG8_SCHED; PG8_LDA(At, 1, 0); PG8_STAGE(PG8_SA(0, 1), a2 + hstep, voffA);
            PG8_WAIT_L(8); PG8_BAR; PG8_WAIT_L(0); PG8_MMA(0, 0, At, B0); PG8_BAR; PG8_SCHED;
            PG8_LDB(B1, 1, 1); PG8_STAGE(PG8_SB(1, 0), b3, voffB);
            PG8_BAR; PG8_WAIT_L(0); PG8_MMA(0, 1, At, B1); PG8_BAR;
            PG8_LDA(At, 1, 1); PG8_STAGE(PG8_SA(1, 0), a3, voffA);
            PG8_BAR; PG8_WAIT_L(0); PG8_MMA(1, 0, At, B0); PG8_BAR; PG8_SCHED;
            PG8_STAGE(PG8_SB(1, 1), b3 + hstep, voffB);
            PG8_WAIT_V(6); PG8_BAR; PG8_MMA(1, 1, At, B1); PG8_BAR;
            }
        }
        if constexpr (ALIGN_EPI) { if (wr == 0) PG8_BAR; }
        if constexpr (!Epi::AFTER_DRAIN) { E(acc, cur, wr, wc, fr, fq); S.done(cur); }
        if (!has_next) break;
#pragma unroll
        for (int a = 0; a < 2; ++a)
#pragma unroll
            for (int b = 0; b < 2; ++b)
#pragma unroll
                for (int m = 0; m < 4; ++m)
#pragma unroll
                    for (int n = 0; n < 2; ++n) acc[a][b][m][n] = (f32x4){0.f, 0.f, 0.f, 0.f};
        cur = nxt; cA = nA; cB = nB; ++ui;
        if constexpr (ALIGN_EPI) { if (wr == 1) PG8_BAR; }
    }
    PG8_WAIT_V(0);
    if constexpr (!ALIGN_EPI) { if (wr == 0) PG8_BAR; }
    PG8_BAR;
    if constexpr (Epi::AFTER_DRAIN) { E.fused(acc, cur, wr, wc, fr, fq, lds, wid, lane); S.done(cur); }
#undef PG8_SA
#undef PG8_SB
#undef PG8_STAGE
#undef PG8_LDA
#undef PG8_LDB
#undef PG8_MMA
#undef PG8_WAIT_V
#undef PG8_WAIT_L
#undef PG8_BAR
#undef PG8_SCHED
}
}
#define GAS __attribute__((address_space(1)))
#define LAS __attribute__((address_space(3)))
typedef unsigned short bf16;
typedef unsigned v4u __attribute__((ext_vector_type(4)));
typedef float f32x4 __attribute__((ext_vector_type(4)));
typedef short bf16x8 __attribute__((ext_vector_type(8)));
typedef __bf16 bf16x2_t __attribute__((ext_vector_type(2)));
#define LDS_WAIT() asm volatile("s_waitcnt lgkmcnt(0)" ::: "memory")
#define VM_WAIT() asm volatile("s_waitcnt vmcnt(0)" ::: "memory")
__device__ __forceinline__ unsigned f2bf(float f) { unsigned u = __builtin_bit_cast(unsigned, f); return (u + 0x7fffu + ((u >> 16) & 1u)) >> 16; }
__device__ __forceinline__ unsigned pk2(float lo, float hi) { return f2bf(lo) | (f2bf(hi) << 16); }
__device__ __forceinline__ float bflo(unsigned u) { return __builtin_bit_cast(float, u << 16); }
__device__ __forceinline__ float bfhi(unsigned u) { return __builtin_bit_cast(float, u & 0xffff0000u); }
__device__ __forceinline__ float bf2f(bf16 u) { return __builtin_bit_cast(float, (unsigned)u << 16); }
#define XB_TMO      128
#define XB_XCNT(j)  (256  + 64 * (j))
#define XB_XSUB(j)  (1280 + 64 * (j))
#define XB_XGEN(j)  (2304 + 64 * (j))
#define XB_TOP      3328
#define XB_TOPGEN   3392
#define XCD_BAR_WORDS 3456
#define XB_SPIN_CAP (1u << 18)

__device__ __forceinline__ unsigned xb_ld(unsigned* p)              { return __hip_atomic_load(p, __ATOMIC_RELAXED, __HIP_MEMORY_SCOPE_AGENT); }
__device__ __forceinline__ unsigned xb_add(unsigned* p, unsigned v) { return __hip_atomic_fetch_add(p, v, __ATOMIC_RELAXED, __HIP_MEMORY_SCOPE_AGENT); }
__device__ __forceinline__ unsigned xb_xcc_id() { return (unsigned)__builtin_amdgcn_s_getreg((3 << 11) | 20) & 0xFu; }
#define XB_SPIN(cond, bar) do { unsigned _sp = 0; while (cond) { __builtin_amdgcn_s_sleep(1); \
    if ((++_sp & 255u) == 0u) { if (xb_ld(&(bar)[XB_TMO])) break; if (_sp > XB_SPIN_CAP) { atomicAdd(&(bar)[XB_TMO], 1u); break; } } } } while (0)

struct XcdBarrier {
    unsigned* bar; unsigned x;
    volatile LAS unsigned* st;
};

__device__ __forceinline__ XcdBarrier xcd_barrier_post(unsigned* bar, volatile LAS unsigned* st) {
    XcdBarrier b; b.bar = bar; b.x = xb_xcc_id(); b.st = st;
    if (threadIdx.x == 0) (void)xb_add(&bar[XB_XCNT(b.x)], 1u);
    return b;
}
__device__ __forceinline__ void xcd_barrier_complete(unsigned* bar, unsigned x, unsigned& nloc, unsigned& nx) {
    const unsigned G = gridDim.x * gridDim.y * gridDim.z;
    unsigned sum, cnt, mine, sp = 0u;
    for (;;) {
        sum = 0u; cnt = 0u; mine = 0u;
#pragma unroll
        for (unsigned j = 0; j < 16; ++j) { const unsigned c = xb_ld(&bar[XB_XCNT(j)]); sum += c; cnt += (c > 0u) ? 1u : 0u; mine = (j == x) ? c : mine; }
        if (sum == G) break;
        __builtin_amdgcn_s_sleep(1);
        if ((++sp & 255u) == 0u) { if (xb_ld(&bar[XB_TMO])) break; if (sp > XB_SPIN_CAP) { atomicAdd(&bar[XB_TMO], 1u); break; } }
    }
    nloc = mine > 0u ? mine : 1u; nx = cnt > 0u ? cnt : 1u;
}

__device__ __forceinline__ void xcd_barrier(const XcdBarrier& b) {
    asm volatile("s_waitcnt vmcnt(0)" ::: "memory");
    __syncthreads();
    if (threadIdx.x == 0) {
        unsigned* bar = b.bar;
        __builtin_amdgcn_s_waitcnt(0);
        unsigned nloc = b.st[0], nx = b.st[1];
        if (nloc == 0u) { xcd_barrier_complete(bar, b.x, nloc, nx); b.st[0] = nloc; b.st[1] = nx; }
        const unsigned old = xb_add(&bar[XB_XSUB(b.x)], 1u);
        const unsigned gen = old / nloc;
        if (old + 1u == (gen + 1u) * nloc) {
            __builtin_amdgcn_fence(__ATOMIC_RELEASE, "agent");
            asm volatile("s_waitcnt vmcnt(0)" ::: "memory");
            const unsigned og = xb_add(&bar[XB_TOP], 1u);
            const unsigned tg = og / nx;
            if (og + 1u == (tg + 1u) * nx) xb_add(&bar[XB_TOPGEN], 1u);
            else XB_SPIN(xb_ld(&bar[XB_TOPGEN]) == tg, bar);
            __builtin_amdgcn_fence(__ATOMIC_ACQUIRE, "agent");
            xb_add(&bar[XB_XGEN(b.x)], 1u);
            asm volatile("s_waitcnt vmcnt(0)" ::: "memory");
        } else {
            XB_SPIN(xb_ld(&bar[XB_XGEN(b.x)]) == gen, bar);
            __builtin_amdgcn_fence(__ATOMIC_ACQUIRE, "agent");
            asm volatile("s_waitcnt vmcnt(0)" ::: "memory");
        }
    }
    __syncthreads();
}

constexpr int NB = 8, SEQ = 8192, DM = 1024, T = NB * SEQ;
constexpr int NWAVES = 8;
constexpr float NORM_EPS = 1e-6f;
constexpr float C2 = 0.125f * 1.4426950408889634f;

constexpr size_t MiB = 1u << 20;
constexpr size_t WS_CTL = 0, CTL_ZERO_BYTES = 1 * MiB;
constexpr size_t WS_MOD = 1 * MiB;
constexpr size_t WS_SKB = 1 * MiB + 512 * 1024;
constexpr size_t WS_WSB = 1 * MiB + 768 * 1024;
constexpr size_t WS_LB  = 1 * MiB + 960 * 1024;
constexpr size_t WS_CS  = 2 * MiB;
constexpr size_t WS_HD  = 6 * MiB;
constexpr size_t WS_WIN = 16 * MiB, WS_WOUT0 = 22 * MiB, WS_WQKV = 24 * MiB, WS_WOUT1 = 30 * MiB, WS_WQ0 = 32 * MiB, WS_WQ1 = 36 * MiB;
constexpr size_t WS_TABD = 40 * MiB, WS_TABU = 72 * MiB;
constexpr size_t WS_H = 104 * MiB;
constexpr size_t WS_BIG = 232 * MiB;
constexpr size_t WS_PU = WS_BIG, WS_PV = WS_BIG + 64 * MiB, WS_PQ = WS_BIG + 128 * MiB, WS_PI = WS_BIG + 192 * MiB, WS_PG = WS_BIG + 256 * MiB;
constexpr size_t WS_G = WS_BIG + 320 * MiB;
constexpr size_t WS_KVT = WS_BIG + 448 * MiB;
constexpr size_t WS_ST = WS_BIG + 576 * MiB;
constexpr size_t WS_QP = WS_BIG;
constexpr size_t WS_IDX = WS_BIG + 256 * MiB, WS_GATE = WS_BIG + 288 * MiB;
constexpr size_t WS_QK = WS_BIG;
constexpr size_t WS_VT = WS_BIG + 256 * MiB;
constexpr size_t WS_END = WS_BIG + 704 * MiB;
constexpr int CW_BAR = 4096;

constexpr int LDS_BYTES = 147456;
constexpr int LDSCTL_OFF = LDS_BYTES - 512;
constexpr int MISC_OFF = LDSCTL_OFF;

struct Params {
    const float* x; const float* c; const int* positions; const float* ada_w; const float* ada_b; const float* norm_mix_g; const float* norm_ffn_g; const float* final_norm_g;
    const float* even_w_in; const float* even_w_out; const float* gmlp_ln_g; const float* gmlp_ln_b; const float* gmlp_w_s; const float* gmlp_b_s; const float* hgrn_lb_logits; const float* hgrn_norm_g;
    const float* odd_w_qkv; const float* odd_w_out; const float* peer_w_query; const float* peer_sub_keys; const float* peer_down; const float* peer_up;
    float* out; unsigned char* ws; int ph_lo, ph_hi;
};
struct Ctx { LAS unsigned char* lds; int tid, lane, wave, vcu, G; };

__device__ __forceinline__ float wave_sum(float v) {
#pragma unroll
    for (int o = 1; o < 64; o <<= 1) v += __shfl_xor(v, o);
    return v;
}
__device__ __forceinline__ float silu_f(float x) { return x * __builtin_amdgcn_rcpf(1.0f + __builtin_amdgcn_exp2f(-1.4426950408889634f * x)); }
__device__ __forceinline__ float sigmoid_f(float x) { return __builtin_amdgcn_rcpf(1.0f + __builtin_amdgcn_exp2f(-1.4426950408889634f * x)); }
__device__ __forceinline__ float gelu_f(float x) { return 0.5f * x * (1.0f + erff(x * 0.70710678118654752f)); }
__device__ __forceinline__ f32x4 mma16(f32x4 acc, const LAS bf16* A, int lda, const LAS bf16* Bt, int ldb, int K, int r, int q4) {
    const LAS bf16* ap = A + r * lda + 8 * q4; const LAS bf16* bp = Bt + r * ldb + 8 * q4;
    for (int k0 = 0; k0 < K; k0 += 32) {
        const bf16x8 a = *(const LAS bf16x8*)(ap + k0); const bf16x8 b = *(const LAS bf16x8*)(bp + k0);
        acc = __builtin_amdgcn_mfma_f32_16x16x32_bf16(a, b, acc, 0, 0, 0);
    }
    return acc;
}

struct EpiBf16P {
    static constexpr bool PERM = true, AFTER_DRAIN = false;
    bf16* O; size_t ldc;
    __device__ __forceinline__ void operator()(const f32x4 (&acc)[2][2][4][2], const pg8::Unit& u, int wr, int wc, int fr, int fq) const {
        const int row0 = u.pm * 256 + wr * 64 + fr, col0 = u.pn * 256 + wc * 32 + 8 * fq;
#pragma unroll
        for (int ai = 0; ai < 2; ++ai)
#pragma unroll
            for (int m = 0; m < 4; ++m) { bf16* rowp = O + (size_t)(row0 + ai * 128 + m * 16) * ldc + col0;
#pragma unroll
                for (int bj = 0; bj < 2; ++bj) { const f32x4 v0 = acc[ai][bj][m][0], v1 = acc[ai][bj][m][1];
                    v4u w; w.x = pg8::cvt_pk_bf16(v0[0], v0[1]); w.y = pg8::cvt_pk_bf16(v0[2], v0[3]); w.z = pg8::cvt_pk_bf16(v1[0], v1[1]); w.w = pg8::cvt_pk_bf16(v1[2], v1[3]);
                    *(v4u*)(rowp + bj * 128) = w; } }
    }
};
#ifndef ABL_ON
#define ABL_ON 4
#endif
struct EpiResid {
    static constexpr bool PERM = true, AFTER_DRAIN = false;
    const float* xin; float* xout; const float* gate; float gsc;
    __device__ __forceinline__ void operator()(const f32x4 (&acc)[2][2][4][2], const pg8::Unit& u, int wr, int wc, int fr, int fq) const {
        const int row0 = u.pm * 256 + wr * 64 + fr, col0 = u.pn * 256 + wc * 32 + 8 * fq;
        const float* gp = gate + (size_t)((u.pm * 256) >> 13) * 6144 + col0;
        f32x4 gv[2][2];
#pragma unroll
        for (int bj = 0; bj < 2; ++bj) { gv[bj][0] = *(const f32x4*)(gp + bj * 128); gv[bj][1] = *(const f32x4*)(gp + bj * 128 + 4); }
#pragma unroll
        for (int ai = 0; ai < 2; ++ai)
#pragma unroll
            for (int m = 0; m < 4; ++m) { const size_t off = (size_t)(row0 + ai * 128 + m * 16) * 1024 + col0;
#pragma unroll
                for (int bj = 0; bj < 2; ++bj) {
                    const f32x4 x0 = *(const f32x4*)(xin + off + bj * 128), x1 = *(const f32x4*)(xin + off + bj * 128 + 4);
                    *(f32x4*)(xout + off + bj * 128) = x0 + gv[bj][0] * acc[ai][bj][m][0] * gsc;
                    *(f32x4*)(xout + off + bj * 128 + 4) = x1 + gv[bj][1] * acc[ai][bj][m][1] * gsc; }
                asm volatile("" ::: "memory"); }
    }
};
struct EpiInProj {
    static constexpr bool PERM = true, AFTER_DRAIN = false;
    bf16* PU; bf16* PV; bf16* PQ; bf16* PI; bf16* PG; float* G; const float* LB;
    __device__ __forceinline__ void operator()(const f32x4 (&acc)[2][2][4][2], const pg8::Unit& u, int wr, int wc, int fr, int fq) const {
        const int type = u.pn >> 1;
        const int row0 = u.pm * 256 + wr * 64 + fr, lc0 = (u.pn & 1) * 256 + wc * 32 + 8 * fq;
        if (type == 3) {
            f32x4 lb[2][2];
#pragma unroll
            for (int bj = 0; bj < 2; ++bj) { lb[bj][0] = *(const f32x4*)(LB + lc0 + bj * 128); lb[bj][1] = *(const f32x4*)(LB + lc0 + bj * 128 + 4); }
#pragma unroll
            for (int ai = 0; ai < 2; ++ai)
#pragma unroll
                for (int m = 0; m < 4; ++m) { float* rowp = G + (size_t)(row0 + ai * 128 + m * 16) * 512 + lc0;
#pragma unroll
                    for (int bj = 0; bj < 2; ++bj)
#pragma unroll
                        for (int n = 0; n < 2; ++n) { const f32x4 v = acc[ai][bj][m][n]; f32x4 o;
#pragma unroll
                            for (int e = 0; e < 4; ++e) { const float l = lb[bj][n][e]; const float f = l + (1.0f - l) * sigmoid_f(v[e]); o[e] = __logf(f); }
                            *(f32x4*)(rowp + bj * 128 + 4 * n) = o; } }
            return;
        }
        bf16* base = type == 0 ? PU : type == 1 ? PV : type == 2 ? PQ : type == 4 ? PI : PG;
#pragma unroll
        for (int ai = 0; ai < 2; ++ai)
#pragma unroll
            for (int m = 0; m < 4; ++m) { bf16* rowp = base + (size_t)(row0 + ai * 128 + m * 16) * 512 + lc0;
#pragma unroll
                for (int bj = 0; bj < 2; ++bj) { f32x4 v0 = acc[ai][bj][m][0], v1 = acc[ai][bj][m][1];
                    if (type <= 1) { pg8::f32x2 a = pg8::gelu_pk((pg8::f32x2){v0[0], v0[1]}), b = pg8::gelu_pk((pg8::f32x2){v0[2], v0[3]}), c = pg8::gelu_pk((pg8::f32x2){v1[0], v1[1]}), d = pg8::gelu_pk((pg8::f32x2){v1[2], v1[3]});
                        v0 = (f32x4){a.x, a.y, b.x, b.y}; v1 = (f32x4){c.x, c.y, d.x, d.y}; }
                    else if (type == 2) {
#pragma unroll
                        for (int e = 0; e < 4; ++e) { v0[e] = silu_f(v0[e]) * 0.08838834764831845f; v1[e] = silu_f(v1[e]) * 0.08838834764831845f; } }
                    else if (type == 5) {
#pragma unroll
                        for (int e = 0; e < 4; ++e) { v0[e] = silu_f(v0[e]); v1[e] = silu_f(v1[e]); } }
                    v4u w; w.x = pg8::cvt_pk_bf16(v0[0], v0[1]); w.y = pg8::cvt_pk_bf16(v0[2], v0[3]); w.z = pg8::cvt_pk_bf16(v1[0], v1[1]); w.w = pg8::cvt_pk_bf16(v1[2], v1[3]);
                    *(v4u*)(rowp + bj * 128) = w; } }
    }
};
struct EpiQKRot {
    static constexpr bool PERM = true, AFTER_DRAIN = false;
    bf16* O; const float* CS;
    __device__ __forceinline__ void operator()(const f32x4 (&acc)[2][2][4][2], const pg8::Unit& u, int wr, int wc, int fr, int fq) const {
        const int row0 = u.pm * 256 + wr * 64 + fr, col0 = u.pn * 256 + wc * 32 + 8 * fq;
        const float sc = u.pn < 4 ? C2 : 1.0f;
        const bool rotw = (wc & 1) == 0;
        const float sgn = fq == 0 ? -1.0f : 1.0f;
#pragma unroll
        for (int ai = 0; ai < 2; ++ai)
#pragma unroll
            for (int m = 0; m < 4; ++m) { const int row = row0 + ai * 128 + m * 16; bf16* rowp = O + (size_t)row * 2048 + col0;
                f32x4 c0 = (f32x4){1.f, 1.f, 1.f, 1.f}, c1 = c0, s0 = (f32x4){0.f, 0.f, 0.f, 0.f}, s1 = s0;
                if (rotw && fq < 2) { const float* cp = CS + (size_t)row * 16; c0 = *(const f32x4*)(cp); c1 = *(const f32x4*)(cp + 4); s0 = *(const f32x4*)(cp + 8) * sgn; s1 = *(const f32x4*)(cp + 12) * sgn; }
#pragma unroll
                for (int bj = 0; bj < 2; ++bj) { f32x4 v0 = acc[ai][bj][m][0], v1 = acc[ai][bj][m][1];
                    if (rotw) { f32x4 p0, p1;
#pragma unroll
                        for (int e = 0; e < 4; ++e) { p0[e] = __shfl_xor(v0[e], 16); p1[e] = __shfl_xor(v1[e], 16); }
                        v0 = v0 * c0 + p0 * s0; v1 = v1 * c1 + p1 * s1; }
                    v0 = v0 * sc; v1 = v1 * sc;
                    v4u w; w.x = pg8::cvt_pk_bf16(v0[0], v0[1]); w.y = pg8::cvt_pk_bf16(v0[2], v0[3]); w.z = pg8::cvt_pk_bf16(v1[0], v1[1]); w.w = pg8::cvt_pk_bf16(v1[2], v1[3]);
                    *(v4u*)(rowp + bj * 128) = w; } }
    }
};

__device__ __forceinline__ void p0_transpose_item(const float* W, int K, int N, bf16* WT, LAS float* scr, int item, int lane) {
    const int nblk = N / 32, kb = item / nblk, nb = item % nblk, k0 = 64 * kb, n0 = 32 * nb;
#pragma unroll 8
    for (int i = 0; i < 32; ++i) { const int kk = 2 * i + (lane >> 5); scr[kk * 33 + (lane & 31)] = W[(size_t)(k0 + kk) * N + n0 + (lane & 31)]; }
    LDS_WAIT(); asm volatile("" ::: "memory");
    const int c = lane & 7;
#pragma unroll
    for (int j = 0; j < 4; ++j) { const int n = (lane >> 3) + 8 * j; const LAS float* s = scr + (8 * c) * 33 + n;
        v4u o; o.x = pk2(s[0 * 33], s[1 * 33]); o.y = pk2(s[2 * 33], s[3 * 33]); o.z = pk2(s[4 * 33], s[5 * 33]); o.w = pk2(s[6 * 33], s[7 * 33]);
        *(GAS v4u*)(WT + (size_t)(n0 + n) * K + k0 + 8 * c) = o; }
    LDS_WAIT(); asm volatile("" ::: "memory");
}
__device__ __forceinline__ void convert_tables(const Params& P, const Ctx& C, int layer) {
    const size_t NT = (size_t)C.G * 512, gt = (size_t)C.vcu * 512 + C.tid;
    const float* sd = P.peer_down + (size_t)layer * 16384 * 1024; const float* su = P.peer_up + (size_t)layer * 16384 * 1024;
    bf16* dd = (bf16*)(P.ws + WS_TABD); bf16* du = (bf16*)(P.ws + WS_TABU);
    for (size_t i = gt; i < (size_t)2 * 2097152; i += NT) {
        const bool isu = i >= 2097152; const size_t j = isu ? i - 2097152 : i; const float* s = (isu ? su : sd) + j * 8; bf16* d = (isu ? du : dd) + j * 8;
        const f32x4 a = *(const f32x4*)s, b = *(const f32x4*)(s + 4);
        v4u o; o.x = pk2(a[0], a[1]); o.y = pk2(a[2], a[3]); o.z = pk2(b[0], b[1]); o.w = pk2(b[2], b[3]);
        *(v4u*)d = o;
    }
}
__device__ __forceinline__ void phase_prologue(const Params& P, const Ctx& C) {
    float* MOD = (float*)(P.ws + WS_MOD);
    {
        LAS float* cond = (LAS float*)C.lds;
        LAS float* part = (LAS float*)(C.lds + 32768);
        for (int e = C.tid; e < 8192; e += 512) cond[e] = silu_f(P.c[e]);
        __syncthreads();
        for (int item = C.vcu; item < 192; item += C.G) {
            const int l = item / 96, cb = item % 96, col = cb * 64 + C.lane;
            float acc[8];
#pragma unroll
            for (int b = 0; b < 8; ++b) acc[b] = 0.f;
            const float* wp = P.ada_w + ((size_t)l * 1024 + C.wave * 128) * 6144 + col;
#pragma unroll 4
            for (int k = 0; k < 128; ++k) { const float wv = wp[(size_t)k * 6144];
#pragma unroll
                for (int b = 0; b < 8; ++b) acc[b] += cond[b * 1024 + C.wave * 128 + k] * wv; }
#pragma unroll
            for (int b = 0; b < 8; ++b) part[(C.wave * 8 + b) * 64 + C.lane] = acc[b];
            __syncthreads();
            { const int b = C.tid >> 6, ln = C.tid & 63; float s = P.ada_b[l * 6144 + cb * 64 + ln];
#pragma unroll
              for (int w = 0; w < 8; ++w) s += part[(w * 8 + b) * 64 + ln];
              MOD[(size_t)(l * 8 + b) * 6144 + cb * 64 + ln] = s; }
            __syncthreads();
        }
        __syncthreads();
    }
    {
        LAS float* scr = (LAS float*)(C.lds + C.wave * 16384);
        const int gw = C.vcu * NWAVES + C.wave, NGW = C.G * NWAVES;
        for (int it = gw; it < 6144; it += NGW) {
            int r = it;
            if (r < 1536) { p0_transpose_item(P.even_w_in, 1024, 3072, (bf16*)(P.ws + WS_WIN), scr, r, C.lane); continue; } r -= 1536;
            if (r < 512)  { p0_transpose_item(P.even_w_out, 1024, 1024, (bf16*)(P.ws + WS_WOUT0), scr, r, C.lane); continue; } r -= 512;
            if (r < 1536) { p0_transpose_item(P.odd_w_qkv, 1024, 3072, (bf16*)(P.ws + WS_WQKV), scr, r, C.lane); continue; } r -= 1536;
            if (r < 512)  { p0_transpose_item(P.odd_w_out, 1024, 1024, (bf16*)(P.ws + WS_WOUT1), scr, r, C.lane); continue; } r -= 512;
            if (r < 1024) { p0_transpose_item(P.peer_w_query, 1024, 2048, (bf16*)(P.ws + WS_WQ0), scr, r, C.lane); continue; } r -= 1024;
            p0_transpose_item(P.peer_w_query + (size_t)1024 * 2048, 1024, 2048, (bf16*)(P.ws + WS_WQ1), scr, r, C.lane);
        }
    }
    convert_tables(P, C, 0);
    const int NT = C.G * 512, gt = C.vcu * 512 + C.tid;
    { bf16* skb = (bf16*)(P.ws + WS_SKB); for (int i = gt; i < 65536; i += NT) skb[i] = (bf16)f2bf(P.peer_sub_keys[i]); }
    { bf16* wsb = (bf16*)(P.ws + WS_WSB); for (int i = gt; i < 65536; i += NT) { const int t = (i >> 7) & 127, s = i & 127; wsb[i] = (bf16)(s <= t ? f2bf(P.gmlp_w_s[i]) : 0u); } }
    { float* lb = (float*)(P.ws + WS_LB); for (int i = gt; i < 512; i += NT) { const float l0 = P.hgrn_lb_logits[i], l1 = P.hgrn_lb_logits[512 + i]; lb[i] = 1.0f / (1.0f + expf(l1 - l0)); } }
    { float* cs = (float*)(P.ws + WS_CS); for (int i = gt; i < T * 8; i += NT) { const int tok = i >> 3, j = i & 7;
        const float inv = 1.0f / powf(500000.0f, (float)j * 0.125f); const float ang = (float)P.positions[tok] * inv; float sn, cn; sincosf(ang, &sn, &cn);
        cs[(size_t)tok * 16 + j] = cn; cs[(size_t)tok * 16 + 8 + j] = sn; } }
}
__device__ __forceinline__ void norm_row_bf16(const float* xrow, bf16* hrow, const float* g, const float* sh, const float* sc, int lane) {
    const f32x4* xr = (const f32x4*)xrow + lane; f32x4 v[4]; float s = 0.f;
#pragma unroll
    for (int j = 0; j < 4; ++j) { v[j] = xr[64 * j]; s += (v[j][0] * v[j][0] + v[j][1] * v[j][1]) + (v[j][2] * v[j][2] + v[j][3] * v[j][3]); }
    const float rstd = 1.0f / sqrtf(wave_sum(s) * (1.0f / 1024.0f) + NORM_EPS);
    unsigned long long* o8 = (unsigned long long*)hrow + lane;
#pragma unroll
    for (int j = 0; j < 4; ++j) { const f32x4 gg = ((const f32x4*)g)[64 * j + lane], hh = ((const f32x4*)sh)[64 * j + lane], cc = ((const f32x4*)sc)[64 * j + lane];
        const f32x4 y = (v[j] * rstd * gg) * (cc + 1.0f) + hh;
        o8[64 * j] = (unsigned long long)pk2(y[0], y[1]) | ((unsigned long long)pk2(y[2], y[3]) << 32); }
}
__device__ __forceinline__ void phase_norm(const Params& P, const Ctx& C, const float* xsrc, const float* g, int l, int so) {
    const float* MOD = (const float*)(P.ws + WS_MOD); bf16* H = (bf16*)(P.ws + WS_H);
    const int gw = C.vcu * NWAVES + C.wave, NGW = C.G * NWAVES;
    for (int m = gw; m < T; m += NGW) { const float* mb = MOD + (size_t)(l * 8 + (m >> 13)) * 6144 + so;
        norm_row_bf16(xsrc + (size_t)m * 1024, H + (size_t)m * 1024, g, mb, mb + 1024, C.lane); }
}

__device__ __forceinline__ void gmlp_item(const Params& P, const Ctx& C, int n, int g) {
    LAS bf16* Wt = (LAS bf16*)C.lds;
    LAS bf16* vT = (LAS bf16*)(C.lds + 34816);
    const bf16* WSB = (const bf16*)(P.ws + WS_WSB); const bf16* PU = (const bf16*)(P.ws + WS_PU); const bf16* PV = (const bf16*)(P.ws + WS_PV); bf16* MIX = (bf16*)(P.ws + WS_H);
    const int tid = C.tid, r = C.lane & 15, q4 = C.lane >> 4;
    for (int ch = tid; ch < 2048; ch += 512) { const int rr = ch >> 4, c8 = (ch & 15) * 8; *(LAS v4u*)(Wt + rr * 136 + c8) = *(const v4u*)(WSB + (size_t)(g * 128 + rr) * 128 + c8); }
    { const int t = tid >> 2, part = tid & 3; const bf16* src = PV + (size_t)(n * 128 + t) * 512 + g * 128 + part * 32;
      float x[32];
#pragma unroll
      for (int j = 0; j < 4; ++j) { const v4u w = *(const v4u*)(src + 8 * j);
#pragma unroll
          for (int e = 0; e < 4; ++e) { x[8 * j + 2 * e] = bflo(w[e]); x[8 * j + 2 * e + 1] = bfhi(w[e]); } }
      float s = 0.f;
#pragma unroll
      for (int j = 0; j < 32; ++j) s += x[j];
      s += __shfl_xor(s, 1); s += __shfl_xor(s, 2);
      const float mean = s * (1.0f / 128.0f); float q = 0.f;
#pragma unroll
      for (int j = 0; j < 32; ++j) { const float d = x[j] - mean; q += d * d; }
      q += __shfl_xor(q, 1); q += __shfl_xor(q, 2);
      const float rstd = 1.0f / sqrtf(q * (1.0f / 128.0f) + NORM_EPS);
      const float* lg = P.gmlp_ln_g + g * 128 + part * 32; const float* lbp = P.gmlp_ln_b + g * 128 + part * 32;
#pragma unroll
      for (int j = 0; j < 32; ++j) vT[(part * 32 + j) * 136 + t] = (bf16)f2bf((x[j] - mean) * rstd * lg[j] + lbp[j]);
    }
    __syncthreads();
    const int t0 = 16 * C.wave; const int Keff = ((t0 + 16 + 31) >> 5) << 5;
    f32x4 acc[8];
#pragma unroll
    for (int ct = 0; ct < 8; ++ct) { acc[ct] = (f32x4){0.f, 0.f, 0.f, 0.f}; acc[ct] = mma16(acc[ct], Wt + t0 * 136, 136, vT + (16 * ct) * 136, 136, Keff, r, q4); }
#pragma unroll
    for (int i = 0; i < 4; ++i) { const int t = t0 + 4 * q4 + i; const float bs = P.gmlp_b_s[g * 128 + t]; const size_t tok = (size_t)n * 128 + t;
#pragma unroll
        for (int ct = 0; ct < 8; ++ct) { const int c = 16 * ct + r; const float u = bf2f(PU[tok * 512 + g * 128 + c]); MIX[tok * 1024 + g * 128 + c] = (bf16)f2bf(u * (acc[ct][i] + bs)); } }
    __syncthreads();
}
__device__ __forceinline__ void hgrn_cumsum16(const float* G, size_t tok0, int hh, int k, int seg, LAS float* tot, float (&g)[16], float (&bb)[16], float& total) {
    const float* gp = G + (tok0 + seg * 16) * 512 + hh * 128 + k;
#pragma unroll
    for (int j = 0; j < 16; ++j) g[j] = gp[(size_t)j * 512];
    float run = 0.f;
#pragma unroll
    for (int j = 0; j < 16; ++j) { run += g[j]; bb[j] = run; }
    tot[seg * 128 + k] = run;
    __syncthreads();
    const float t0 = tot[k], t1 = tot[128 + k], t2 = tot[256 + k], t3 = tot[384 + k];
    const float pre = seg == 0 ? 0.f : seg == 1 ? t0 : seg == 2 ? t0 + t1 : t0 + t1 + t2;
    total = (t0 + t1) + (t2 + t3);
#pragma unroll
    for (int j = 0; j < 16; ++j) bb[j] += pre;
}
__device__ __forceinline__ void hgrn_stage_iT(const bf16* PI, size_t tok0, int hh, LAS bf16* iT, int tid) {
    const int s = tid >> 3, v0 = (tid & 7) * 16; const bf16* src = PI + (tok0 + s) * 512 + hh * 128 + v0;
#pragma unroll
    for (int h2 = 0; h2 < 2; ++h2) { const v4u w = *(const v4u*)(src + 8 * h2);
#pragma unroll
        for (int e = 0; e < 4; ++e) { iT[(v0 + 8 * h2 + 2 * e) * 72 + s] = (bf16)(w[e] & 0xffffu); iT[(v0 + 8 * h2 + 2 * e + 1) * 72 + s] = (bf16)(w[e] >> 16); } }
}
__device__ __forceinline__ void hgrn_local_item(const Params& P, const Ctx& C, int item) {
    LAS bf16* khT = (LAS bf16*)C.lds;
    LAS bf16* iT = (LAS bf16*)(C.lds + 18432);
    LAS float* tot = (LAS float*)(C.lds + 36864);
    const float* G = (const float*)(P.ws + WS_G); const bf16* PI = (const bf16*)(P.ws + WS_PI); bf16* KVT = (bf16*)(P.ws + WS_KVT); float* HD = (float*)(P.ws + WS_HD);
    const int bh = item >> 7, c = item & 127, b = bh >> 2, hh = bh & 3; const size_t tok0 = (size_t)b * SEQ + c * 64;
    const int tid = C.tid, k = tid & 127, seg = tid >> 7, r = C.lane & 15, q4 = C.lane >> 4;
    float g[16], bb[16], total;
    hgrn_cumsum16(G, tok0, hh, k, seg, tot, g, bb, total);
    { unsigned w[8];
#pragma unroll
      for (int j = 0; j < 8; ++j) { const float a0 = -expm1f(g[2 * j]) * __expf(total - bb[2 * j]), a1 = -expm1f(g[2 * j + 1]) * __expf(total - bb[2 * j + 1]); w[j] = pk2(a0, a1); }
      LAS v4u* dst = (LAS v4u*)(khT + k * 72 + seg * 16); dst[0] = (v4u){w[0], w[1], w[2], w[3]}; dst[1] = (v4u){w[4], w[5], w[6], w[7]}; }
    if (seg == 0) HD[(size_t)item * 128 + k] = __expf(total);
    hgrn_stage_iT(PI, tok0, hh, iT, tid);
    __syncthreads();
    const int v0 = 16 * C.wave;
#pragma unroll
    for (int ct = 0; ct < 8; ++ct) { f32x4 acc = (f32x4){0.f, 0.f, 0.f, 0.f}; acc = mma16(acc, iT + v0 * 72, 72, khT + (16 * ct) * 72, 72, 64, r, q4);
#pragma unroll
        for (int i = 0; i < 4; ++i) KVT[((size_t)item * 128 + v0 + 4 * q4 + i) * 128 + 16 * ct + r] = (bf16)f2bf(acc[i]); }
    __syncthreads();
}
__device__ __forceinline__ void phase_hgrn_scan(const Params& P, const Ctx& C) {
    const bf16* KVT = (const bf16*)(P.ws + WS_KVT); bf16* ST = (bf16*)(P.ws + WS_ST); const float* HD = (const float*)(P.ws + WS_HD);
    for (int task = C.vcu * 256 + C.tid; C.tid < 256 && task < 65536; task += C.G * 256) {
        const int bh = task >> 11, v = (task >> 4) & 127, kb = task & 15;
        float st[8];
#pragma unroll
        for (int e = 0; e < 8; ++e) st[e] = 0.f;
#pragma unroll 4
        for (int c = 0; c < 128; ++c) { const size_t item = (size_t)bh * 128 + c, off = (item * 128 + v) * 128 + kb * 8;
            const v4u kv = *(const v4u*)(KVT + off); const f32x4 d0 = *(const f32x4*)(HD + item * 128 + kb * 8), d1 = *(const f32x4*)(HD + item * 128 + kb * 8 + 4);
            v4u o; o.x = pk2(st[0], st[1]); o.y = pk2(st[2], st[3]); o.z = pk2(st[4], st[5]); o.w = pk2(st[6], st[7]);
            *(v4u*)(ST + off) = o;
#pragma unroll
            for (int e = 0; e < 4; ++e) { st[2 * e] = (e < 2 ? d0[2 * e] : d1[2 * e - 4]) * st[2 * e] + bflo(kv[e]); st[2 * e + 1] = (e < 2 ? d0[2 * e + 1] : d1[2 * e - 3]) * st[2 * e + 1] + bfhi(kv[e]); }
        }
    }
}
__device__ __forceinline__ void hgrn_out_item(const Params& P, const Ctx& C, int item) {
    LAS bf16* qt = (LAS bf16*)C.lds;
    LAS bf16* kt = (LAS bf16*)(C.lds + 17408);
    LAS bf16* iT = (LAS bf16*)(C.lds + 34816);
    LAS bf16* A1 = (LAS bf16*)(C.lds + 53248);
    LAS bf16* STl = (LAS bf16*)(C.lds + 62464);
    LAS float* ol = (LAS float*)(C.lds + 97280);
    LAS float* tot = (LAS float*)(C.lds + 131072);
    const float* G = (const float*)(P.ws + WS_G); const bf16* PQ = (const bf16*)(P.ws + WS_PQ); const bf16* PI = (const bf16*)(P.ws + WS_PI); const bf16* PG = (const bf16*)(P.ws + WS_PG);
    const bf16* ST = (const bf16*)(P.ws + WS_ST); bf16* MIX = (bf16*)(P.ws + WS_H);
    const int bh = item >> 7, c = item & 127, b = bh >> 2, hh = bh & 3; const size_t tok0 = (size_t)b * SEQ + c * 64;
    const int tid = C.tid, k = tid & 127, seg = tid >> 7, r = C.lane & 15, q4 = C.lane >> 4;
    float g[16], bb[16], total;
    hgrn_cumsum16(G, tok0, hh, k, seg, tot, g, bb, total);
#pragma unroll
    for (int j = 0; j < 16; ++j) { const int t = seg * 16 + j; const float qv = bf2f(PQ[(tok0 + t) * 512 + hh * 128 + k]);
        qt[t * 136 + k] = (bf16)f2bf(qv * __expf(bb[j])); kt[t * 136 + k] = (bf16)f2bf(-expm1f(g[j]) * __expf(-bb[j])); }
    hgrn_stage_iT(PI, tok0, hh, iT, tid);
    for (int ch = tid; ch < 2048; ch += 512) { const int rr = ch >> 4, c8 = (ch & 15) * 8; *(LAS v4u*)(STl + rr * 136 + c8) = *(const v4u*)(ST + ((size_t)item * 128 + rr) * 128 + c8); }
    __syncthreads();
    { const int rt = C.wave >> 1;
#pragma unroll
      for (int cc = 0; cc < 2; ++cc) { const int ct = (C.wave & 1) * 2 + cc; f32x4 acc = (f32x4){0.f, 0.f, 0.f, 0.f};
          acc = mma16(acc, qt + (16 * rt) * 136, 136, kt + (16 * ct) * 136, 136, 128, r, q4);
#pragma unroll
          for (int i = 0; i < 4; ++i) { const int t = 16 * rt + 4 * q4 + i, s = 16 * ct + r; A1[t * 72 + s] = (bf16)(s <= t ? f2bf(acc[i]) : 0u); } } }
    __syncthreads();
    { const int rt = C.wave >> 1;
#pragma unroll
      for (int cc = 0; cc < 4; ++cc) { const int ct = (C.wave & 1) * 4 + cc; f32x4 acc = (f32x4){0.f, 0.f, 0.f, 0.f};
          acc = mma16(acc, A1 + (16 * rt) * 72, 72, iT + (16 * ct) * 72, 72, 64, r, q4);
          acc = mma16(acc, qt + (16 * rt) * 136, 136, STl + (16 * ct) * 136, 136, 128, r, q4);
#pragma unroll
          for (int i = 0; i < 4; ++i) ol[(16 * rt + 4 * q4 + i) * 132 + 16 * ct + r] = acc[i]; } }
    __syncthreads();
    { const int t = tid >> 3, v0 = (tid & 7) * 16; float o[16]; float ss = 0.f;
#pragma unroll
      for (int e = 0; e < 16; ++e) { o[e] = ol[t * 132 + v0 + e]; ss += o[e] * o[e]; }
      ss += __shfl_xor(ss, 1); ss += __shfl_xor(ss, 2); ss += __shfl_xor(ss, 4);
      const float rstd = 1.0f / sqrtf(ss * (1.0f / 128.0f) + NORM_EPS);
      const float* ng = P.hgrn_norm_g + hh * 128 + v0; const bf16* gp = PG + (tok0 + t) * 512 + hh * 128 + v0;
      const v4u g0 = *(const v4u*)gp, g1 = *(const v4u*)(gp + 8); unsigned w[8];
#pragma unroll
      for (int e = 0; e < 4; ++e) { w[e] = pk2(o[2 * e] * rstd * ng[2 * e] * bflo(g0[e]), o[2 * e + 1] * rstd * ng[2 * e + 1] * bfhi(g0[e]));
                                    w[4 + e] = pk2(o[8 + 2 * e] * rstd * ng[8 + 2 * e] * bflo(g1[e]), o[9 + 2 * e] * rstd * ng[9 + 2 * e] * bfhi(g1[e])); }
      v4u* dst = (v4u*)(MIX + (tok0 + t) * 1024 + 512 + hh * 128 + v0); dst[0] = (v4u){w[0], w[1], w[2], w[3]}; dst[1] = (v4u){w[4], w[5], w[6], w[7]}; }
    __syncthreads();
}

__device__ __forceinline__ void attn_item(const Params& P, const Ctx& C, int b, int hd, int qt) {
    LAS bf16* Qs = (LAS bf16*)C.lds;
    LAS bf16* Ks = (LAS bf16*)(C.lds + 36864);
    LAS bf16* Vts = (LAS bf16*)(C.lds + 46080);
    LAS bf16* Ps = (LAS bf16*)(C.lds + 55296 + C.wave * 4608);
    const bf16* QK = (const bf16*)(P.ws + WS_QK); const bf16* VT = (const bf16*)(P.ws + WS_VT); bf16* O = (bf16*)(P.ws + WS_H);
    const int tid = C.tid, r = C.lane & 15, q4 = C.lane >> 4, w = C.wave;
    const int t0 = qt * 256; const size_t rowbase = (size_t)b * SEQ;
    __syncthreads();
    for (int ch = tid; ch < 2048; ch += 512) { const int rr = ch >> 3, c8 = (ch & 7) * 8; *(LAS v4u*)(Qs + rr * 72 + c8) = *(const v4u*)(QK + (rowbase + t0 + rr) * 2048 + hd * 64 + c8); }
    const int kt_first = (t0 >= 2048 ? t0 - 2048 : 0) >> 6, kt_last = (t0 >> 6) + 3;
    const int srow = tid >> 3, sc8 = (tid & 7) * 8;
    v4u kreg = *(const v4u*)(QK + (rowbase + kt_first * 64 + srow) * 2048 + 1024 + hd * 64 + sc8);
    v4u vreg = *(const v4u*)(VT + (size_t)(hd * 64 + srow) * T + rowbase + kt_first * 64 + sc8);
    float mrow[2][4], lrow[2][4]; f32x4 oacc[2][4];
#pragma unroll
    for (int i = 0; i < 2; ++i)
#pragma unroll
        for (int e = 0; e < 4; ++e) { mrow[i][e] = -1e30f; lrow[i][e] = 0.f; oacc[i][e] = (f32x4){0.f, 0.f, 0.f, 0.f}; }
    const int tq0 = t0 + 32 * w;
    for (int kt = kt_first; kt <= kt_last; ++kt) {
        __syncthreads();
        *(LAS v4u*)(Ks + srow * 72 + sc8) = kreg; *(LAS v4u*)(Vts + srow * 72 + sc8) = vreg;
        __syncthreads();
        if (kt < kt_last) { kreg = *(const v4u*)(QK + (rowbase + (kt + 1) * 64 + srow) * 2048 + 1024 + hd * 64 + sc8);
                            vreg = *(const v4u*)(VT + (size_t)(hd * 64 + srow) * T + rowbase + (kt + 1) * 64 + sc8); }
        const int tk0 = kt * 64;
        if (tk0 > tq0 + 31 || tk0 + 63 < tq0 - 2048) continue;
        f32x4 s[2][4];
#pragma unroll
        for (int i = 0; i < 2; ++i)
#pragma unroll
            for (int j = 0; j < 4; ++j) { s[i][j] = (f32x4){0.f, 0.f, 0.f, 0.f}; s[i][j] = mma16(s[i][j], Qs + (32 * w + 16 * i) * 72, 72, Ks + (16 * j) * 72, 72, 64, r, q4); }
#pragma unroll
        for (int i = 0; i < 2; ++i)
#pragma unroll
            for (int e = 0; e < 4; ++e) {
                const int tq = tq0 + 16 * i + 4 * q4 + e; float mx = -1e30f;
#pragma unroll
                for (int j = 0; j < 4; ++j) { const int d = tq - (tk0 + 16 * j + r);
                    const int cnt = (d <= 128 ? 1 : 0) + ((((d & 3) == 0) && d <= 512) ? 1 : 0) + (((d & 15) == 0) ? 1 : 0);
                    const bool ok = d >= 0 && d <= 2048 && cnt > 0;
                    const float bias = cnt == 3 ? 1.5849625007f : (cnt == 2 ? 1.0f : 0.0f);
                    const float sv = ok ? s[i][j][e] + bias : -1e30f; s[i][j][e] = sv; mx = fmaxf(mx, sv); }
                mx = fmaxf(mx, __shfl_xor(mx, 1)); mx = fmaxf(mx, __shfl_xor(mx, 2)); mx = fmaxf(mx, __shfl_xor(mx, 4)); mx = fmaxf(mx, __shfl_xor(mx, 8));
                const float mnew = fmaxf(mrow[i][e], mx), alpha = __builtin_amdgcn_exp2f(mrow[i][e] - mnew); mrow[i][e] = mnew;
                float rs = 0.f;
#pragma unroll
                for (int j = 0; j < 4; ++j) { const float sv = s[i][j][e]; const float p = sv > -1e29f ? __builtin_amdgcn_exp2f(sv - mnew) : 0.f; rs += p;
                    Ps[(16 * i + 4 * q4 + e) * 72 + 16 * j + r] = (bf16)f2bf(p); }
                rs += __shfl_xor(rs, 1); rs += __shfl_xor(rs, 2); rs += __shfl_xor(rs, 4); rs += __shfl_xor(rs, 8);
                lrow[i][e] = lrow[i][e] * alpha + rs;
#pragma unroll
                for (int jd = 0; jd < 4; ++jd) oacc[i][jd][e] *= alpha;
            }
        LDS_WAIT();
#pragma unroll
        for (int i = 0; i < 2; ++i)
#pragma unroll
            for (int jd = 0; jd < 4; ++jd) oacc[i][jd] = mma16(oacc[i][jd], Ps + (16 * i) * 72, 72, Vts + (16 * jd) * 72, 72, 64, r, q4);
    }
#pragma unroll
    for (int i = 0; i < 2; ++i)
#pragma unroll
        for (int e = 0; e < 4; ++e) { const float inv = 1.0f / lrow[i][e]; const size_t row = rowbase + tq0 + 16 * i + 4 * q4 + e;
#pragma unroll
            for (int jd = 0; jd < 4; ++jd) O[row * 1024 + hd * 64 + 16 * jd + r] = (bf16)f2bf(oacc[i][jd][e] * inv); }
}

__device__ __forceinline__ unsigned ordf(float s) { const unsigned u = __builtin_bit_cast(unsigned, s); return u ^ ((unsigned)((int)u >> 31) | 0x80000000u); }
__device__ __forceinline__ float unordf(unsigned v) { return __builtin_bit_cast(float, v ^ ((unsigned)((int)(~v) >> 31) | 0x80000000u)); }
__device__ __forceinline__ void ins16(unsigned (&top)[16], unsigned x) {
#pragma unroll
    for (int j = 0; j < 16; ++j) { const unsigned hi = top[j] > x ? top[j] : x; x = top[j] > x ? x : top[j]; top[j] = hi; }
}
__device__ __forceinline__ void merge16(unsigned (&top)[16], int mask) {
    unsigned c[16];
#pragma unroll
    for (int j = 0; j < 16; ++j) { const unsigned o = (unsigned)__shfl_xor((int)top[15 - j], mask); c[j] = top[j] > o ? top[j] : o; }
#pragma unroll
    for (int st = 8; st >= 1; st >>= 1)
#pragma unroll
        for (int j = 0; j < 16; ++j) if ((j & st) == 0) { const unsigned a = c[j], b2 = c[j + st]; c[j] = a > b2 ? a : b2; c[j + st] = a > b2 ? b2 : a; }
#pragma unroll
    for (int j = 0; j < 16; ++j) top[j] = c[j];
}
__device__ __forceinline__ void phase_peer_topk(const Params& P, const Ctx& C, int layer) {
    LAS bf16* SK = (LAS bf16*)C.lds;
    const bf16* SKB = (const bf16*)(P.ws + WS_SKB) + (size_t)layer * 32768; const bf16* QP = (const bf16*)(P.ws + WS_QP);
    int* IDX = (int*)(P.ws + WS_IDX); float* GATE = (float*)(P.ws + WS_GATE);
    for (int ch = C.tid; ch < 4096; ch += 512) { const int rr = ch >> 4, c8 = (ch & 15) * 8; *(LAS v4u*)(SK + rr * 136 + c8) = *(const v4u*)(SKB + (size_t)rr * 128 + c8); }
    __syncthreads();
    const int r = C.lane & 15, q4 = C.lane >> 4;
    const int gw = C.vcu * NWAVES + C.wave, NGW = C.G * NWAVES;
    for (int grp = gw; grp < T * 8 / 16; grp += NGW) {
        const size_t task = (size_t)grp * 16 + r;
        unsigned lst[2][16];
#pragma unroll
        for (int half = 0; half < 2; ++half) {
            bf16x8 bq[4];
#pragma unroll
            for (int ks = 0; ks < 4; ++ks) bq[ks] = *(const bf16x8*)(QP + task * 256 + half * 128 + ks * 32 + 8 * q4);
            unsigned top[16];
#pragma unroll
            for (int j = 0; j < 16; ++j) top[j] = 0u;
#pragma unroll 1
            for (int nt = 0; nt < 8; ++nt) { f32x4 acc = (f32x4){0.f, 0.f, 0.f, 0.f};
#pragma unroll
                for (int ks = 0; ks < 4; ++ks) { const bf16x8 a = *(const LAS bf16x8*)(SK + (half * 128 + 16 * nt + r) * 136 + ks * 32 + 8 * q4); acc = __builtin_amdgcn_mfma_f32_16x16x32_bf16(a, bq[ks], acc, 0, 0, 0); }
#pragma unroll
                for (int i = 0; i < 4; ++i) { const unsigned n = 16 * nt + 4 * q4 + i; ins16(top, (ordf(acc[i]) & ~127u) | (127u - n)); } }
            merge16(top, 16); merge16(top, 32);
#pragma unroll
            for (int j = 0; j < 16; ++j) lst[half][j] = top[j];
        }
        float v1[16], v2[16]; unsigned e1[16], e2[16];
#pragma unroll
        for (int j = 0; j < 16; ++j) { v1[j] = unordf(lst[0][j] & ~127u); v2[j] = unordf(lst[1][j] & ~127u); e1[j] = (127u - (lst[0][j] & 127u)) << 7; e2[j] = 127u - (lst[1][j] & 127u); }
        unsigned top[16];
#pragma unroll
        for (int j = 0; j < 16; ++j) top[j] = 0u;
#pragma unroll
        for (int i = 0; i < 16; ++i)
#pragma unroll
            for (int j = 0; j < 16; ++j) if ((i + 1) * (j + 1) <= 16) ins16(top, (ordf(v1[i] + v2[j]) & ~16383u) | e1[i] | e2[j]);
        float ev[16]; float den = 0.f; const float mx = unordf(top[0] & ~16383u);
#pragma unroll
        for (int j = 0; j < 16; ++j) { ev[j] = __expf(unordf(top[j] & ~16383u) - mx); den += ev[j]; }
        const float inv = 1.0f / den;
        int* ip = IDX + task * 16; float* gp = GATE + task * 16;
        if (q4 == 0) { *(v4u*)(ip) = (v4u){top[0] & 16383u, top[1] & 16383u, top[2] & 16383u, top[3] & 16383u}; *(f32x4*)(gp) = (f32x4){ev[0] * inv, ev[1] * inv, ev[2] * inv, ev[3] * inv}; }
        else if (q4 == 1) { *(v4u*)(ip + 4) = (v4u){top[4] & 16383u, top[5] & 16383u, top[6] & 16383u, top[7] & 16383u}; *(f32x4*)(gp + 4) = (f32x4){ev[4] * inv, ev[5] * inv, ev[6] * inv, ev[7] * inv}; }
        else if (q4 == 2) { *(v4u*)(ip + 8) = (v4u){top[8] & 16383u, top[9] & 16383u, top[10] & 16383u, top[11] & 16383u}; *(f32x4*)(gp + 8) = (f32x4){ev[8] * inv, ev[9] * inv, ev[10] * inv, ev[11] * inv}; }
        else { *(v4u*)(ip + 12) = (v4u){top[12] & 16383u, top[13] & 16383u, top[14] & 16383u, top[15] & 16383u}; *(f32x4*)(gp + 12) = (f32x4){ev[12] * inv, ev[13] * inv, ev[14] * inv, ev[15] * inv}; }
    }
}
__device__ __forceinline__ void phase_peer_experts(const Params& P, const Ctx& C, int layer, bool last) {
    const bf16* TD = (const bf16*)(P.ws + WS_TABD); const bf16* TU = (const bf16*)(P.ws + WS_TABU); bf16* H = (bf16*)(P.ws + WS_H);
    const int* IDX = (const int*)(P.ws + WS_IDX); const float* GATE = (const float*)(P.ws + WS_GATE); const float* MOD = (const float*)(P.ws + WS_MOD);
    const int lane = C.lane, grp = lane >> 4, jl = lane & 15;
    const int gw = C.vcu * NWAVES + C.wave, NGW = C.G * NWAVES;
    for (int tok = gw; tok < T; tok += NGW) {
        const int b = tok >> 13;
        const int i0 = IDX[(size_t)tok * 128 + lane], i1 = IDX[(size_t)tok * 128 + 64 + lane];
        const float g0 = GATE[(size_t)tok * 128 + lane], g1 = GATE[(size_t)tok * 128 + 64 + lane];
        v4u hreg[8];
#pragma unroll
        for (int i = 0; i < 8; ++i) hreg[i] = *(const v4u*)(H + (size_t)tok * 1024 + (i * 16 + jl) * 8);
        float oacc[64];
#pragma unroll
        for (int e = 0; e < 64; ++e) oacc[e] = 0.f;
        for (int it = 0; it < 32; ++it) {
            const int kk = it * 4 + grp;
            const int e_lo = __shfl(i0, kk & 63), e_hi = __shfl(i1, kk & 63); const float gl = __shfl(g0, kk & 63), gh = __shfl(g1, kk & 63);
            const int ex = it < 16 ? e_lo : e_hi; const float gk = it < 16 ? gl : gh;
            const bf16* dr = TD + (size_t)ex * 1024; const bf16* ur = TU + (size_t)ex * 1024;
            v4u dreg[8], ureg[8];
#pragma unroll
            for (int i = 0; i < 8; ++i) dreg[i] = *(const v4u*)(dr + (i * 16 + jl) * 8);
#pragma unroll
            for (int i = 0; i < 8; ++i) ureg[i] = *(const v4u*)(ur + (i * 16 + jl) * 8);
            float a = 0.f;
#pragma unroll
            for (int i = 0; i < 8; ++i)
#pragma unroll
                for (int e = 0; e < 4; ++e) { a += bflo(hreg[i][e]) * bflo(dreg[i][e]); a += bfhi(hreg[i][e]) * bfhi(dreg[i][e]); }
            a += __shfl_xor(a, 1); a += __shfl_xor(a, 2); a += __shfl_xor(a, 4); a += __shfl_xor(a, 8);
            const float wk = gk * gelu_f(a);
#pragma unroll
            for (int i = 0; i < 8; ++i)
#pragma unroll
                for (int e = 0; e < 4; ++e) { oacc[i * 8 + 2 * e] += wk * bflo(ureg[i][e]); oacc[i * 8 + 2 * e + 1] += wk * bfhi(ureg[i][e]); }
        }
        float h1[32];
        { const bool up = (grp & 2) != 0;
#pragma unroll
          for (int e = 0; e < 32; ++e) { const float keep = up ? oacc[32 + e] : oacc[e], send = up ? oacc[e] : oacc[32 + e]; h1[e] = keep + __shfl_xor(send, 32); } }
        float h2[16];
        { const bool up = (grp & 1) != 0;
#pragma unroll
          for (int e = 0; e < 16; ++e) { const float keep = up ? h1[16 + e] : h1[e], send = up ? h1[e] : h1[16 + e]; h2[e] = keep + __shfl_xor(send, 16); } }
        const float* g2p = MOD + (size_t)(layer * 8 + b) * 6144 + 5120; const float psc = (ABL_ON >= (layer == 0 ? 2 : 4)) ? 1.f : 0.f;
        float xn[16]; float ss = 0.f;
#pragma unroll
        for (int cc = 0; cc < 2; ++cc) { const int d0 = ((2 * grp + cc) * 16 + jl) * 8; const float* xp = P.out + (size_t)tok * 1024 + d0;
            const f32x4 xa = *(const f32x4*)xp, xb = *(const f32x4*)(xp + 4), ga = *(const f32x4*)(g2p + d0), gb = *(const f32x4*)(g2p + d0 + 4);
#pragma unroll
            for (int e = 0; e < 4; ++e) { xn[cc * 8 + e] = xa[e] + psc * ga[e] * h2[cc * 8 + e]; xn[cc * 8 + 4 + e] = xb[e] + psc * gb[e] * h2[cc * 8 + 4 + e]; } }
#pragma unroll
        for (int e = 0; e < 16; ++e) ss += xn[e] * xn[e];
        const float rstd = 1.0f / sqrtf(wave_sum(ss) * (1.0f / 1024.0f) + NORM_EPS);
        if (!last) {
            const float* ng = P.norm_mix_g + (layer + 1) * 1024; const float* mb = MOD + (size_t)((layer + 1) * 8 + b) * 6144;
#pragma unroll
            for (int cc = 0; cc < 2; ++cc) { const int d0 = ((2 * grp + cc) * 16 + jl) * 8; float* xp = P.out + (size_t)tok * 1024 + d0;
                *(f32x4*)xp = (f32x4){xn[cc * 8], xn[cc * 8 + 1], xn[cc * 8 + 2], xn[cc * 8 + 3]}; *(f32x4*)(xp + 4) = (f32x4){xn[cc * 8 + 4], xn[cc * 8 + 5], xn[cc * 8 + 6], xn[cc * 8 + 7]};
                unsigned w[4];
#pragma unroll
                for (int e = 0; e < 4; ++e) { const int d = d0 + 2 * e; w[e] = pk2(xn[cc * 8 + 2 * e] * rstd * ng[d] * (1.0f + mb[1024 + d]) + mb[d], xn[cc * 8 + 2 * e + 1] * rstd * ng[d + 1] * (1.0f + mb[1024 + d + 1]) + mb[d + 1]); }
                *(v4u*)(H + (size_t)tok * 1024 + d0) = (v4u){w[0], w[1], w[2], w[3]}; }
        } else {
#pragma unroll
            for (int cc = 0; cc < 2; ++cc) { const int d0 = ((2 * grp + cc) * 16 + jl) * 8; float* xp = P.out + (size_t)tok * 1024 + d0; const float* fg = P.final_norm_g + d0;
                *(f32x4*)xp = (f32x4){xn[cc * 8] * rstd * fg[0], xn[cc * 8 + 1] * rstd * fg[1], xn[cc * 8 + 2] * rstd * fg[2], xn[cc * 8 + 3] * rstd * fg[3]};
                *(f32x4*)(xp + 4) = (f32x4){xn[cc * 8 + 4] * rstd * fg[4], xn[cc * 8 + 5] * rstd * fg[5], xn[cc * 8 + 6] * rstd * fg[6], xn[cc * 8 + 7] * rstd * fg[7]}; }
        }
    }
}


#ifndef NAIVE_TOPK
#define NAIVE_TOPK 0
#endif
#ifndef NAIVE_EXPERTS
#define NAIVE_EXPERTS 0
#endif
__device__ __forceinline__ void phase_peer_topk_naive(const Params& P, const Ctx& C, int layer) {
    LAS float* SC = (LAS float*)C.lds;
    const float* sk = P.peer_sub_keys + (size_t)layer * 32768; const bf16* QP = (const bf16*)(P.ws + WS_QP);
    int* IDX = (int*)(P.ws + WS_IDX); float* GATE = (float*)(P.ws + WS_GATE);
    for (int base = C.vcu * 64; base < T * 8; base += C.G * 64) {
        __syncthreads();
        { const int tl = C.tid & 63, part = C.tid >> 6; const size_t task = (size_t)base + tl;
          for (int col = part * 32; col < part * 32 + 32; ++col) { const int half = col >> 7, n = col & 127; float acc = 0.f;
              for (int c = 0; c < 128; ++c) acc += bf2f(QP[task * 256 + half * 128 + c]) * sk[(half * 128 + n) * 128 + c];
              SC[tl * 257 + col] = acc; } }
        __syncthreads();
        if (C.tid < 64) { const int tl = C.tid; const size_t task = (size_t)base + tl; LAS float* s = SC + tl * 257;
            float v1[16], v2[16]; int i1[16], i2[16];
            for (int k = 0; k < 16; ++k) { float best = -3e38f; int bi = 0; for (int n = 0; n < 128; ++n) { const float x = s[n]; if (x > best) { best = x; bi = n; } } v1[k] = best; i1[k] = bi; s[bi] = -3.1e38f; }
            for (int k = 0; k < 16; ++k) { float best = -3e38f; int bi = 0; for (int n = 0; n < 128; ++n) { const float x = s[128 + n]; if (x > best) { best = x; bi = n; } } v2[k] = best; i2[k] = bi; s[128 + bi] = -3.1e38f; }
            for (int a = 0; a < 16; ++a) for (int b2 = 0; b2 < 16; ++b2) s[a * 16 + b2] = v1[a] + v2[b2];
            float ts[16]; int ti[16];
            for (int k = 0; k < 16; ++k) { float best = -3e38f; int bi = 0; for (int n = 0; n < 256; ++n) { const float x = s[n]; if (x > best) { best = x; bi = n; } } ts[k] = best; ti[k] = bi; s[bi] = -3.1e38f; }
            float den = 0.f; float ev[16];
            for (int k = 0; k < 16; ++k) { ev[k] = expf(ts[k] - ts[0]); den += ev[k]; }
            for (int k = 0; k < 16; ++k) { int a = ti[k] >> 4, b2 = ti[k] & 15; int e1 = 0, e2 = 0;
                for (int z = 0; z < 16; ++z) { if (z == a) e1 = i1[z]; if (z == b2) e2 = i2[z]; }
                IDX[task * 16 + k] = e1 * 128 + e2; GATE[task * 16 + k] = ev[k] / den; }
        }
    }
    __syncthreads();
}
__device__ __forceinline__ void phase_peer_experts_naive(const Params& P, const Ctx& C, int layer, bool last) {
    bf16* H = (bf16*)(P.ws + WS_H); const int* IDX = (const int*)(P.ws + WS_IDX); const float* GATE = (const float*)(P.ws + WS_GATE); const float* MOD = (const float*)(P.ws + WS_MOD);
    const float* TD = P.peer_down + (size_t)layer * 16384 * 1024; const float* TU = P.peer_up + (size_t)layer * 16384 * 1024;
    const int lane = C.lane; const int gw = C.vcu * NWAVES + C.wave, NGW = C.G * NWAVES;
    for (int tok = gw; tok < T; tok += NGW) {
        const int b = tok >> 13; float hv[16], oa[16];
#pragma unroll
        for (int j = 0; j < 16; ++j) { hv[j] = bf2f(H[(size_t)tok * 1024 + j * 64 + lane]); oa[j] = 0.f; }
        for (int k = 0; k < 128; ++k) { const int e = IDX[(size_t)tok * 128 + k]; const float gk = GATE[(size_t)tok * 128 + k];
            float p = 0.f;
#pragma unroll
            for (int j = 0; j < 16; ++j) p += hv[j] * TD[(size_t)e * 1024 + j * 64 + lane];
            const float a = wave_sum(p); const float wk = gk * gelu_f(a);
#pragma unroll
            for (int j = 0; j < 16; ++j) oa[j] += wk * TU[(size_t)e * 1024 + j * 64 + lane]; }
        const float* g2p = MOD + (size_t)(layer * 8 + b) * 6144 + 5120; const float psc = (ABL_ON >= (layer == 0 ? 2 : 4)) ? 1.f : 0.f;
        float xn[16]; float ss = 0.f;
#pragma unroll
        for (int j = 0; j < 16; ++j) { const int d = j * 64 + lane; xn[j] = P.out[(size_t)tok * 1024 + d] + psc * g2p[d] * oa[j]; ss += xn[j] * xn[j]; }
        const float rstd = 1.0f / sqrtf(wave_sum(ss) * (1.0f / 1024.0f) + NORM_EPS);
        if (!last) { const float* ng = P.norm_mix_g + (layer + 1) * 1024; const float* mb = MOD + (size_t)((layer + 1) * 8 + b) * 6144;
#pragma unroll
            for (int j = 0; j < 16; ++j) { const int d = j * 64 + lane; P.out[(size_t)tok * 1024 + d] = xn[j]; H[(size_t)tok * 1024 + d] = (bf16)f2bf(xn[j] * rstd * ng[d] * (1.0f + mb[1024 + d]) + mb[d]); }
        } else {
#pragma unroll
            for (int j = 0; j < 16; ++j) { const int d = j * 64 + lane; P.out[(size_t)tok * 1024 + d] = xn[j] * rstd * P.final_norm_g[d]; } }
    }
}
constexpr int N_PHASES = 18;
#ifndef MK_ONE_LAUNCH
#define MK_ONE_LAUNCH 1
#endif
__global__ void __launch_bounds__(NWAVES * 64, 2) hybrid_fwd(Params P) {
    extern __shared__ __attribute__((aligned(16))) unsigned char lds_raw[];
    Ctx C;
    C.lds = (LAS unsigned char*)lds_raw;
    C.tid = threadIdx.x; C.lane = C.tid & 63; C.wave = __builtin_amdgcn_readfirstlane(C.tid >> 6);
    C.G = gridDim.x; { const int bx = blockIdx.x; C.vcu = (C.G % 8 == 0) ? (bx % 8) * (C.G / 8) + bx / 8 : bx; }
    volatile LAS unsigned* MISC = (volatile LAS unsigned*)(C.lds + MISC_OFF);
    for (int u = C.tid; u < (LDS_BYTES - LDSCTL_OFF) / 4; u += NWAVES * 64) ((LAS unsigned*)(C.lds + LDSCTL_OFF))[u] = 0u;
    __syncthreads();
    unsigned* ctl = (unsigned*)(P.ws + WS_CTL);
    XcdBarrier bar; bar.bar = ctl + CW_BAR; bar.x = 0; bar.st = nullptr;
    const int lo = P.ph_lo, hi = P.ph_hi;
    if (hi - lo > 1) bar = xcd_barrier_post(ctl + CW_BAR, MISC + 8);
#ifndef PH_MASK
#define PH_MASK 0x3ffff
#endif
#define IN(k) (((PH_MASK >> (k)) & 1) && lo <= (k) && (k) < hi)
#define SEAM(k) do { if (IN(k) && IN((k) + 1)) xcd_barrier(bar); } while (0)
    unsigned char* ws = P.ws;
    float* MOD = (float*)(ws + WS_MOD); bf16* H = (bf16*)(ws + WS_H);

    if (IN(0)) { phase_prologue(P, C); } SEAM(0);
    if (IN(1)) { phase_norm(P, C, P.x, P.norm_mix_g, 0, 0); } SEAM(1);
    if (IN(2)) { pg8::Gemm g{H, (const bf16*)(ws + WS_WIN), T, 3072, 1024}; pg8::StaticOrder S; S.init(T, 3072, C.G, (int)blockIdx.x);
        EpiInProj E{(bf16*)(ws + WS_PU), (bf16*)(ws + WS_PV), (bf16*)(ws + WS_PQ), (bf16*)(ws + WS_PI), (bf16*)(ws + WS_PG), (float*)(ws + WS_G), (const float*)(ws + WS_LB)};
        pg8::gemm_phase<EpiInProj, pg8::StaticOrder, true, true>(C.lds, g, S, E); } SEAM(2);
    if (IN(3)) { for (int it = C.vcu; it < 2048; it += C.G) gmlp_item(P, C, it >> 2, it & 3);
                 for (int it = C.vcu; it < 4096; it += C.G) hgrn_local_item(P, C, it); } SEAM(3);
    if (IN(4)) { phase_hgrn_scan(P, C); } SEAM(4);
    if (IN(5)) { for (int it = C.vcu; it < 4096; it += C.G) hgrn_out_item(P, C, it); } SEAM(5);
    if (IN(6)) { pg8::Gemm g{H, (const bf16*)(ws + WS_WOUT0), T, 1024, 1024}; pg8::StaticOrder S; S.init(T, 1024, C.G, (int)blockIdx.x);
        EpiResid E{P.x, P.out, MOD + 2048, ABL_ON >= 1 ? 1.f : 0.f};
        pg8::gemm_phase<EpiResid, pg8::StaticOrder, true, true>(C.lds, g, S, E); } SEAM(6);
    if (IN(7)) { phase_norm(P, C, P.out, P.norm_ffn_g, 0, 3072); } SEAM(7);
    if (IN(8)) { pg8::Gemm g{H, (const bf16*)(ws + WS_WQ0), T, 2048, 1024}; pg8::StaticOrder S; S.init(T, 2048, C.G, (int)blockIdx.x);
        EpiBf16P E{(bf16*)(ws + WS_QP), 2048};
        pg8::gemm_phase<EpiBf16P, pg8::StaticOrder, true, true>(C.lds, g, S, E); } SEAM(8);
    if (IN(9)) { if (NAIVE_TOPK) phase_peer_topk_naive(P, C, 0); else phase_peer_topk(P, C, 0); } SEAM(9);
    if (IN(10)) { if (NAIVE_EXPERTS) phase_peer_experts_naive(P, C, 0, false); else phase_peer_experts(P, C, 0, false); } SEAM(10);
    if (IN(11)) { convert_tables(P, C, 1);
        { pg8::Gemm g{H, (const bf16*)(ws + WS_WQKV), T, 2048, 1024}; pg8::StaticOrder S; S.init(T, 2048, C.G, (int)blockIdx.x);
          EpiQKRot E{(bf16*)(ws + WS_QK), (const float*)(ws + WS_CS)};
          pg8::gemm_phase<EpiQKRot, pg8::StaticOrder, true, true>(C.lds, g, S, E); }
        __syncthreads();
        { pg8::Gemm g{(const bf16*)(ws + WS_WQKV) + (size_t)2048 * 1024, H, 1024, T, 1024}; pg8::StaticOrder S; S.init(1024, T, C.G, (int)blockIdx.x);
          EpiBf16P E{(bf16*)(ws + WS_VT), (size_t)T};
          pg8::gemm_phase<EpiBf16P, pg8::StaticOrder, true, true>(C.lds, g, S, E); } } SEAM(11);
    if (IN(12)) { for (int it = C.vcu; it < NB * 16 * 32; it += C.G) attn_item(P, C, it >> 9, (it >> 5) & 15, it & 31); } SEAM(12);
    if (IN(13)) { pg8::Gemm g{H, (const bf16*)(ws + WS_WOUT1), T, 1024, 1024}; pg8::StaticOrder S; S.init(T, 1024, C.G, (int)blockIdx.x);
        EpiResid E{P.out, P.out, MOD + (size_t)8 * 6144 + 2048, ABL_ON >= 3 ? 1.f : 0.f};
        pg8::gemm_phase<EpiResid, pg8::StaticOrder, true, true>(C.lds, g, S, E); } SEAM(13);
    if (IN(14)) { phase_norm(P, C, P.out, P.norm_ffn_g + 1024, 1, 3072); } SEAM(14);
    if (IN(15)) { pg8::Gemm g{H, (const bf16*)(ws + WS_WQ1), T, 2048, 1024}; pg8::StaticOrder S; S.init(T, 2048, C.G, (int)blockIdx.x);
        EpiBf16P E{(bf16*)(ws + WS_QP), 2048};
        pg8::gemm_phase<EpiBf16P, pg8::StaticOrder, true, true>(C.lds, g, S, E); } SEAM(15);
    if (IN(16)) { if (NAIVE_TOPK) phase_peer_topk_naive(P, C, 1); else phase_peer_topk(P, C, 1); } SEAM(16);
    if (IN(17)) { if (NAIVE_EXPERTS) phase_peer_experts_naive(P, C, 1, true); else phase_peer_experts(P, C, 1, true); }
#undef IN
#undef SEAM
}

extern "C" void kernel_launch(void* const* d_in, const int* in_sizes, int n_in, void* d_out, int out_size, void* d_ws, size_t ws_size, hipStream_t stream) {
    static int grid = 0;
    if (grid == 0) {
        if (n_in != 22 || in_sizes[0] != T * DM || out_size != T * DM || ws_size < WS_END) {
            fprintf(stderr, "kernel_launch: unexpected shapes (n_in %d, in0 %d, out %d, ws %zu); nothing launched\n", n_in, n_in > 0 ? in_sizes[0] : -1, out_size, ws_size); grid = -1; return; }
        int dev = 0, cus = 0;
        if (hipGetDevice(&dev) != hipSuccess || hipDeviceGetAttribute(&cus, hipDeviceAttributeMultiprocessorCount, dev) != hipSuccess) { fprintf(stderr, "kernel_launch: device query failed\n"); grid = -1; return; }
        if (hipFuncSetAttribute((const void*)hybrid_fwd, hipFuncAttributeMaxDynamicSharedMemorySize, LDS_BYTES) != hipSuccess) { fprintf(stderr, "kernel_launch: hipFuncSetAttribute failed\n"); grid = -1; return; }
        (void)hipGetLastError();
        grid = cus;
    }
    if (grid < 0) return;
    if (hipMemsetAsync((char*)d_ws + WS_CTL, 0, CTL_ZERO_BYTES, stream) != hipSuccess) { fprintf(stderr, "kernel_launch: memset failed\n"); return; }
    Params p{};
    p.x = (const float*)d_in[0]; p.c = (const float*)d_in[1]; p.positions = (const int*)d_in[2]; p.ada_w = (const float*)d_in[3]; p.ada_b = (const float*)d_in[4];
    p.norm_mix_g = (const float*)d_in[5]; p.norm_ffn_g = (const float*)d_in[6]; p.final_norm_g = (const float*)d_in[7]; p.even_w_in = (const float*)d_in[8]; p.even_w_out = (const float*)d_in[9];
    p.gmlp_ln_g = (const float*)d_in[10]; p.gmlp_ln_b = (const float*)d_in[11]; p.gmlp_w_s = (const float*)d_in[12]; p.gmlp_b_s = (const float*)d_in[13]; p.hgrn_lb_logits = (const float*)d_in[14];
    p.hgrn_norm_g = (const float*)d_in[15]; p.odd_w_qkv = (const float*)d_in[16]; p.odd_w_out = (const float*)d_in[17]; p.peer_w_query = (const float*)d_in[18]; p.peer_sub_keys = (const float*)d_in[19];
    p.peer_down = (const float*)d_in[20]; p.peer_up = (const float*)d_in[21];
    p.out = (float*)d_out; p.ws = (unsigned char*)d_ws;
#if MK_ONE_LAUNCH
    p.ph_lo = 0; p.ph_hi = N_PHASES;
    hipLaunchKernelGGL(hybrid_fwd, dim3(grid), dim3(NWAVES * 64), LDS_BYTES, stream, p);
#else
    for (int ph = 0; ph < N_PHASES; ++ph) { p.ph_lo = ph; p.ph_hi = ph + 1; hipLaunchKernelGGL(hybrid_fwd, dim3(grid), dim3(NWAVES * 64), LDS_BYTES, stream, p); }
#endif
    const hipError_t le = hipPeekAtLastError();
    if (le != hipSuccess) fprintf(stderr, "kernel_launch: launch failed: %s\n", hipGetErrorName(le));
}
```

```cpp
#include <hip/hip_runtime.h>
#include <cstdio>
#include <cstdint>
#include <cmath>
namespace pg8 {
#define PG8_LAS __attribute__((address_space(3)))
typedef unsigned short bf16_t;
typedef short bf16x8 __attribute__((ext_vector_type(8)));
typedef float f32x4 __attribute__((ext_vector_type(4)));
typedef unsigned u32x4 __attribute__((ext_vector_type(4)));
constexpr int BM = 256, BK = 64, HALF = 128, HTB = HALF * BK * 2  , STAGE_BYTES = 8 * HTB, NXCD = 8, WGM = 8;

__host__ __device__ __forceinline__ int lds_byte(int r, int c) { const int st = (r >> 4) * 2 + (c >> 5), rr = r & 15, cc = c & 31, ob = rr * 64 + cc * 2; return st * 1024 + (ob ^ (((ob >> 9) & 1) << 5)); }
__host__ __device__ __forceinline__ void stage_rc(int b, int& R, int& C) { const int st = b / 1024, sb = b % 1024, swz = sb ^ (((sb >> 9) & 1) << 5); R = (st >> 1) * 16 + swz / 64; C = (st & 1) * 32 + (swz % 64) / 2; }
__host__ __device__ __forceinline__ int perm32(int rho) { const int n = rho >> 4, i = rho & 15; return 8 * (i >> 2) + 4 * n + (i & 3); }

struct Unit { int pm, pn; };
struct Gemm { const bf16_t* A; const bf16_t* Bt; int M, N, K; };

struct StaticOrder {
    int nM, nN, nwg, G, c;
    __host__ __device__ void init(int M, int N, int G_, int c_) { nM = M / BM; nN = N / BM; nwg = nM * nN; G = G_; c = c_; }
    __host__ __device__ bool next(int i, Unit& u) const {
        const long L = (long)i * G + c; if (L >= nwg) return false;
        int wgid = (int)L; { const int q = nwg / NXCD, r = nwg % NXCD, xcd = wgid % NXCD, off = wgid / NXCD; wgid = (xcd < r ? xcd * (q + 1) : r * (q + 1) + (xcd - r) * q) + off; }
        const int nig = WGM * nN, gid = wgid / nig, fm = gid * WGM, gsz = (nM - fm) < WGM ? (nM - fm) : WGM;
        u.pm = fm + ((wgid % nig) % gsz); u.pn = (wgid % nig) / gsz; return true;
    }
    __device__ __forceinline__ void a_ready(const Unit&) const {}
    __device__ __forceinline__ void done(const Unit&) const {}
};

__device__ __forceinline__ unsigned cvt_pk_bf16(float lo, float hi) { unsigned r; asm volatile("v_cvt_pk_bf16_f32 %0, %1, %2" : "=v"(r) : "v"(lo), "v"(hi)); return r; }
typedef float f32x2 __attribute__((ext_vector_type(2)));
__device__ __forceinline__ f32x2 gelu_pk(f32x2 v) {
    const f32x2 av = __builtin_elementwise_abs(v), d = av * 0.2316418882f + 1.0f;
    f32x2 t; t.x = __builtin_amdgcn_rcpf(d.x); t.y = __builtin_amdgcn_rcpf(d.y);
    f32x2 q = t * 0.5307027145f + (-0.7265760135f); q = q * t + 0.7107068705f; q = q * t + (-0.142248368f); q = q * t + 0.127414796f; q = q * t;
    const f32x2 s = (v * v) * (-0.72134752044f);
    f32x2 e; e.x = __builtin_amdgcn_exp2f(s.x); e.y = __builtin_amdgcn_exp2f(s.y);
    const f32x2 m = v * (q * e), r = v - m;
    f32x2 o; o.x = v.x < 0.f ? m.x : r.x; o.y = v.y < 0.f ? m.y : r.y; return o;
}

template <class Epi, class Sched, bool ALIGN_EPI = false, bool SP2 = false>
__device__ __forceinline__ void gemm_phase(PG8_LAS unsigned char* lds, const Gemm g, const Sched& S, const Epi& E) {
    const int tid = threadIdx.x, wid = __builtin_amdgcn_readfirstlane(tid >> 6), lane = tid & 63, wr = wid >> 2, wc = wid & 3, fr = lane & 15, fq = lane >> 4;
    const int K = g.K, nt = K / BK;
    unsigned voffA[2], voffB[2];
#pragma unroll
    for (int i = 0; i < 2; ++i) { int R, C; stage_rc(tid * 16 + i * 8192, R, C); const int Rb = Epi::PERM ? ((R & ~31) + perm32(R & 31)) : R;
        voffA[i] = (unsigned)(R * K + C) * 2u; voffB[i] = (unsigned)(Rb * K + C) * 2u; }
    const size_t kstep = (size_t)(BK * 2);
    const size_t hstep = (size_t)HALF * K * 2;
    const size_t tstep = 2 * hstep;
    const unsigned ldsw = (unsigned)wid * 1024u;
    const int aoff = lds_byte(wr * 64 + fr, fq * 8), boff = lds_byte(wc * 32 + fr, fq * 8);
#define PG8_SA(b, h) (((b) * 2 + (h)) * HTB)
#define PG8_SB(b, h) ((4 + (b) * 2 + (h)) * HTB)
#define PG8_STAGE(bufoff, gbase, voff) do { _Pragma("unroll") for (int _i = 0; _i < 2; ++_i) \
        __builtin_amdgcn_global_load_lds((const unsigned*)((const char*)(gbase) + (voff)[_i]), (PG8_LAS unsigned*)(lds + (bufoff) + ldsw + _i * 8192), 16, 0, 0); } while (0)
#define PG8_LDA(dst, b, h) do { _Pragma("unroll") for (int m = 0; m < 4; ++m) _Pragma("unroll") for (int k = 0; k < 2; ++k) dst[m][k] = *(const PG8_LAS bf16x8*)(lds + PG8_SA(b, h) + aoff + m * 2048 + k * 1024); } while (0)
#define PG8_LDB(dst, b, h) do { _Pragma("unroll") for (int n = 0; n < 2; ++n) _Pragma("unroll") for (int k = 0; k < 2; ++k) dst[n][k] = *(const PG8_LAS bf16x8*)(lds + PG8_SB(b, h) + boff + n * 2048 + k * 1024); } while (0)
#define PG8_MMA(ai, bj, At, Bt) do { __builtin_amdgcn_s_setprio(1); _Pragma("unroll") for (int m = 0; m < 4; ++m) _Pragma("unroll") for (int n = 0; n < 2; ++n) _Pragma("unroll") for (int k = 0; k < 2; ++k) \
        acc[ai][bj][m][n] = __builtin_amdgcn_mfma_f32_16x16x32_bf16(Bt[n][k], At[m][k], acc[ai][bj][m][n], 0, 0, 0); __builtin_amdgcn_s_setprio(0); } while (0)
#define PG8_WAIT_V(n) asm volatile("s_waitcnt vmcnt(" #n ")" ::: "memory")
#define PG8_WAIT_L(n) asm volatile("s_waitcnt lgkmcnt(" #n ")" ::: "memory")
#define PG8_BAR __builtin_amdgcn_s_barrier()
#define PG8_SCHED __builtin_amdgcn_sched_barrier(0)
    Unit cur, nxt; int ui = 0;
    if (!S.next(0, cur)) return;
    f32x4 acc[2][2][4][2];
#pragma unroll
    for (int a = 0; a < 2; ++a)
#pragma unroll
        for (int b = 0; b < 2; ++b)
#pragma unroll
            for (int m = 0; m < 4; ++m)
#pragma unroll
                for (int n = 0; n < 2; ++n) acc[a][b][m][n] = (f32x4){0.f, 0.f, 0.f, 0.f};
    bf16x8 At[4][2], B0[2][2], B1[2][2];
    const char* cA = (const char*)g.A + (size_t)cur.pm * tstep; const char* cB = (const char*)g.Bt + (size_t)cur.pn * tstep;
    S.a_ready(cur);
    if constexpr (SP2) {
        PG8_STAGE(PG8_SB(0, 0), cB, voffB); PG8_STAGE(PG8_SB(0, 1), cB + hstep, voffB); PG8_STAGE(PG8_SA(0, 0), cA, voffA); PG8_STAGE(PG8_SA(0, 1), cA + hstep, voffA);
        if (wr == 1) PG8_BAR;
        PG8_WAIT_V(2); PG8_BAR;
        PG8_STAGE(PG8_SB(1, 0), cB + kstep, voffB); PG8_STAGE(PG8_SA(1, 0), cA + kstep, voffA); PG8_STAGE(PG8_SB(1, 1), cB + hstep + kstep, voffB);
        PG8_WAIT_V(6); PG8_BAR;
    } else {
        PG8_STAGE(PG8_SB(0, 0), cB, voffB); PG8_STAGE(PG8_SA(0, 0), cA, voffA); PG8_STAGE(PG8_SB(0, 1), cB + hstep, voffB); PG8_STAGE(PG8_SA(0, 1), cA + hstep, voffA);
        if (wr == 1) PG8_BAR;
        PG8_WAIT_V(4); PG8_BAR;
        PG8_STAGE(PG8_SB(1, 0), cB + kstep, voffB); PG8_STAGE(PG8_SA(1, 0), cA + kstep, voffA); PG8_STAGE(PG8_SB(1, 1), cB + hstep + kstep, voffB);
        PG8_WAIT_V(6); PG8_BAR;
    }
    for (;;) {
        const bool has_next = S.next(ui + 1, nxt);
        const char* nA = has_next ? (const char*)g.A + (size_t)nxt.pm * tstep : cA; const char* nB = has_next ? (const char*)g.Bt + (size_t)nxt.pn * tstep : cB;
        for (int t = 0; t < nt; t += 2) {
            const bool last = (t == nt - 2);
            const char* a1 = cA + (size_t)(t + 1) * kstep;
            const char* a2 = last ? nA : cA + (size_t)(t + 2) * kstep; const char* b2 = last ? nB : cB + (size_t)(t + 2) * kstep;
            const char* a3 = a2 + kstep; const char* b3 = b2 + kstep;
            if (last && has_next) S.a_ready(nxt);
            if constexpr (SP2) {
            PG8_LDB(B0, 0, 0); PG8_LDB(B1, 0, 1); PG8_SCHED; PG8_LDA(At, 0, 0); PG8_STAGE(PG8_SA(1, 1), a1 + hstep, voffA);
            PG8_WAIT_V(8); PG8_WAIT_L(0); PG8_BAR; PG8_MMA(0, 0, At, B0); PG8_MMA(0, 1, At, B1); PG8_BAR; PG8_SCHED;
            PG8_LDA(At, 0, 1); PG8_STAGE(PG8_SB(0, 0), b2, voffB); PG8_STAGE(PG8_SB(0, 1), b2 + hstep, voffB); PG8_STAGE(PG8_SA(0, 0), a2, voffA);
            PG8_WAIT_V(8); PG8_WAIT_L(0); PG8_BAR; PG8_MMA(1, 0, At, B0); PG8_MMA(1, 1, At, B1); PG8_BAR; PG8_SCHED;
            PG8_LDB(B0, 1, 0); PG8_LDB(B1, 1, 1); PG8_SCHED; PG8_LDA(At, 1, 0); PG8_STAGE(PG8_SA(0, 1), a2 + hstep, voffA);
            PG8_WAIT_V(8); PG8_WAIT_L(0); PG8_BAR; PG8_MMA(0, 0, At, B0); PG8_MMA(0, 1, At, B1); PG8_BAR; PG8_SCHED;
            PG8_LDA(At, 1, 1); PG8_STAGE(PG8_SB(1, 0), b3, voffB); PG8_STAGE(PG8_SB(1, 1), b3 + hstep, voffB); PG8_STAGE(PG8_SA(1, 0), a3, voffA);
            PG8_WAIT_V(8); PG8_WAIT_L(0); PG8_BAR; PG8_MMA(1, 0, At, B0); PG8_MMA(1, 1, At, B1); PG8_BAR; PG8_SCHED;
            } else {
            PG8_LDB(B0, 0, 0); PG8_SCHED; PG8_LDA(At, 0, 0); PG8_STAGE(PG8_SA(1, 1), a1 + hstep, voffA);
            PG8_WAIT_L(8); PG8_BAR; PG8_WAIT_L(0); PG8_MMA(0, 0, At, B0); PG8_BAR; PG8_SCHED;
            PG8_LDB(B1, 0, 1); PG8_STAGE(PG8_SB(0, 0), b2, voffB);
            PG8_BAR; PG8_WAIT_L(0); PG8_MMA(0, 1, At, B1); PG8_BAR;
            PG8_LDA(At, 0, 1); PG8_STAGE(PG8_SA(0, 0), a2, voffA);
            PG8_BAR; PG8_WAIT_L(0); PG8_MMA(1, 0, At, B0); PG8_BAR; PG8_SCHED;
            PG8_STAGE(PG8_SB(0, 1), b2 + hstep, voffB);
            PG8_WAIT_V(6); PG8_BAR; PG8_MMA(1, 1, At, B1); PG8_BAR;
            PG8_LDB(B0, 1, 0); PG8_SCHED; PG8_LDA(At, 1, 0); PG8_STAGE(PG8_SA(0, 1), a2 + hstep, voffA);
            PG8_WAIT_L(8); PG8_BAR; PG8_WAIT_L(0); PG8_MMA(0, 0, At, B0); PG8_BAR; PG8_SCHED;
            PG8_LDB(B1, 1, 1); PG8_STAGE(PG8_SB(1, 0), b3, voffB);
            PG8_BAR; PG8_WAIT_L(0); PG8_MMA(0, 1, At, B1); PG8_BAR;
            PG8_LDA(At, 1, 1); PG8_STAGE(PG8_SA(1, 0), a3, voffA);
            PG8_BAR; PG8_WAIT_L(0); PG8_MMA(1, 0, At, B0); PG8_BAR; PG8_SCHED;
            PG8_STAGE(PG8_SB(1, 1), b3 + hstep, voffB);
            PG8_WAIT_V(6); PG8_BAR; PG8_MMA(1, 1, At, B1); PG8_BAR;
            }
        }
        if constexpr (ALIGN_EPI) { if (wr == 0) PG8_BAR; }
        if constexpr (!Epi::AFTER_DRAIN) { E(acc, cur, wr, wc, fr, fq); S.done(cur); }
        if (!has_next) break;
#pragma unroll
        for (int a = 0; a < 2; ++a)
#pragma unroll
            for (int b = 0; b < 2; ++b)
#pragma unroll
                for (int m = 0; m < 4; ++m)
#pragma unroll
                    for (int n = 0; n < 2; ++n) acc[a][b][m][n] = (f32x4){0.f, 0.f, 0.f, 0.f};
        cur = nxt; cA = nA; cB = nB; ++ui;
        if constexpr (ALIGN_EPI) { if (wr == 1) PG8_BAR; }
    }
    PG8_WAIT_V(0);
    if constexpr (!ALIGN_EPI) { if (wr == 0) PG8_BAR; }
    PG8_BAR;
    if constexpr (Epi::AFTER_DRAIN) { E.fused(acc, cur, wr, wc, fr, fq, lds, wid, lane); S.done(cur); }
#undef PG8_SA
#undef PG8_SB
#undef PG8_STAGE
#undef PG8_LDA
#undef PG8_LDB
#undef PG8_MMA
#undef PG8_WAIT_V
#undef PG8_WAIT_L
#undef PG8_BAR
#undef PG8_SCHED
}
}
#define GAS __attribute__((address_space(1)))
#define LAS __attribute__((address_space(3)))
typedef unsigned short bf16;
typedef unsigned v4u __attribute__((ext_vector_type(4)));
typedef float f32x4 __attribute__((ext_vector_type(4)));
typedef short bf16x8 __attribute__((ext_vector_type(8)));
typedef __bf16 bf16x2_t __attribute__((ext_vector_type(2)));
#define LDS_WAIT() asm volatile("s_waitcnt lgkmcnt(0)" ::: "memory")
#define VM_WAIT() asm volatile("s_waitcnt vmcnt(0)" ::: "memory")
__device__ __forceinline__ unsigned f2bf(float f) { unsigned u = __builtin_bit_cast(unsigned, f); return (u + 0x7fffu + ((u >> 16) & 1u)) >> 16; }
__device__ __forceinline__ unsigned pk2(float lo, float hi) { return f2bf(lo) | (f2bf(hi) << 16); }
__device__ __forceinline__ float bflo(unsigned u) { return __builtin_bit_cast(float, u << 16); }
__device__ __forceinline__ float bfhi(unsigned u) { return __builtin_bit_cast(float, u & 0xffff0000u); }
__device__ __forceinline__ float bf2f(bf16 u) { return __builtin_bit_cast(float, (unsigned)u << 16); }
#define XB_TMO      128
#define XB_XCNT(j)  (256  + 64 * (j))
#define XB_XSUB(j)  (1280 + 64 * (j))
#define XB_XGEN(j)  (2304 + 64 * (j))
#define XB_TOP      3328
#define XB_TOPGEN   3392
#define XCD_BAR_WORDS 3456
#define XB_SPIN_CAP (1u << 18)

__device__ __forceinline__ unsigned xb_ld(unsigned* p)              { return __hip_atomic_load(p, __ATOMIC_RELAXED, __HIP_MEMORY_SCOPE_AGENT); }
__device__ __forceinline__ unsigned xb_add(unsigned* p, unsigned v) { return __hip_atomic_fetch_add(p, v, __ATOMIC_RELAXED, __HIP_MEMORY_SCOPE_AGENT); }
__device__ __forceinline__ unsigned xb_xcc_id() { return (unsigned)__builtin_amdgcn_s_getreg((3 << 11) | 20) & 0xFu; }
#define XB_SPIN(cond, bar) do { unsigned _sp = 0; while (cond) { __builtin_amdgcn_s_sleep(1); \
    if ((++_sp & 255u) == 0u) { if (xb_ld(&(bar)[XB_TMO])) break; if (_sp > XB_SPIN_CAP) { atomicAdd(&(bar)[XB_TMO], 1u); break; } } } } while (0)

struct XcdBarrier {
    unsigned* bar; unsigned x;
    volatile LAS unsigned* st;
};

__device__ __forceinline__ XcdBarrier xcd_barrier_post(unsigned* bar, volatile LAS unsigned* st) {
    XcdBarrier b; b.bar = bar; b.x = xb_xcc_id(); b.st = st;
    if (threadIdx.x == 0) (void)xb_add(&bar[XB_XCNT(b.x)], 1u);
    return b;
}
__device__ __forceinline__ void xcd_barrier_complete(unsigned* bar, unsigned x, unsigned& nloc, unsigned& nx) {
    const unsigned G = gridDim.x * gridDim.y * gridDim.z;
    unsigned sum, cnt, mine, sp = 0u;
    for (;;) {
        sum = 0u; cnt = 0u; mine = 0u;
#pragma unroll
        for (unsigned j = 0; j < 16; ++j) { const unsigned c = xb_ld(&bar[XB_XCNT(j)]); sum += c; cnt += (c > 0u) ? 1u : 0u; mine = (j == x) ? c : mine; }
        if (sum == G) break;
        __builtin_amdgcn_s_sleep(1);
        if ((++sp & 255u) == 0u) { if (xb_ld(&bar[XB_TMO])) break; if (sp > XB_SPIN_CAP) { atomicAdd(&bar[XB_TMO], 1u); break; } }
    }
    nloc = mine > 0u ? mine : 1u; nx = cnt > 0u ? cnt : 1u;
}

__device__ __forceinline__ void xcd_barrier(const XcdBarrier& b) {
    asm volatile("s_waitcnt vmcnt(0)" ::: "memory");
    __syncthreads();
    if (threadIdx.x == 0) {
        unsigned* bar = b.bar;
        __builtin_amdgcn_s_waitcnt(0);
        unsigned nloc = b.st[0], nx = b.st[1];
        if (nloc == 0u) { xcd_barrier_complete(bar, b.x, nloc, nx); b.st[0] = nloc; b.st[1] = nx; }
        const unsigned old = xb_add(&bar[XB_XSUB(b.x)], 1u);
        const unsigned gen = old / nloc;
        if (old + 1u == (gen + 1u) * nloc) {
            __builtin_amdgcn_fence(__ATOMIC_RELEASE, "agent");
            asm volatile("s_waitcnt vmcnt(0)" ::: "memory");
            const unsigned og = xb_add(&bar[XB_TOP], 1u);
            const unsigned tg = og / nx;
            if (og + 1u == (tg + 1u) * nx) xb_add(&bar[XB_TOPGEN], 1u);
            else XB_SPIN(xb_ld(&bar[XB_TOPGEN]) == tg, bar);
            __builtin_amdgcn_fence(__ATOMIC_ACQUIRE, "agent");
            xb_add(&bar[XB_XGEN(b.x)], 1u);
            asm volatile("s_waitcnt vmcnt(0)" ::: "memory");
        } else {
            XB_SPIN(xb_ld(&bar[XB_XGEN(b.x)]) == gen, bar);
            __builtin_amdgcn_fence(__ATOMIC_ACQUIRE, "agent");
            asm volatile("s_waitcnt vmcnt(0)" ::: "memory");
        }
    }
    __syncthreads();
}

constexpr int NB = 8, SEQ = 8192, DM = 1024, T = NB * SEQ;
constexpr int NWAVES = 8;
constexpr float NORM_EPS = 1e-6f;
constexpr float C2 = 0.125f * 1.4426950408889634f;

constexpr size_t MiB = 1u << 20;
constexpr size_t WS_CTL = 0, CTL_ZERO_BYTES = 1 * MiB;
constexpr size_t WS_MOD = 1 * MiB;
constexpr size_t WS_SKB = 1 * MiB + 512 * 1024;
constexpr size_t WS_WSB = 1 * MiB + 768 * 1024;
constexpr size_t WS_LB  = 1 * MiB + 960 * 1024;
constexpr size_t WS_CS  = 2 * MiB;
constexpr size_t WS_HD  = 6 * MiB;
constexpr size_t WS_WIN = 16 * MiB, WS_WOUT0 = 22 * MiB, WS_WQKV = 24 * MiB, WS_WOUT1 = 30 * MiB, WS_WQ0 = 32 * MiB, WS_WQ1 = 36 * MiB;
constexpr size_t WS_TAB8 = 40 * MiB, TAB8_BYTES = 17 * MiB;
constexpr int TROW = 1040;
constexpr size_t WS_H = 108 * MiB;
constexpr size_t WS_BIG = 236 * MiB;
constexpr size_t WS_PU = WS_BIG, WS_PV = WS_BIG + 64 * MiB, WS_PQ = WS_BIG + 128 * MiB, WS_PI = WS_BIG + 192 * MiB, WS_PG = WS_BIG + 256 * MiB;
constexpr size_t WS_G = WS_BIG + 320 * MiB;
constexpr size_t WS_KVT = WS_BIG + 448 * MiB;
constexpr size_t WS_ST = WS_BIG + 576 * MiB;
constexpr size_t WS_QP = WS_BIG;
constexpr size_t WS_IDX = WS_BIG + 256 * MiB, WS_GATE = WS_BIG + 288 * MiB;
constexpr size_t WS_QK = WS_BIG;
constexpr size_t WS_VT = WS_BIG + 256 * MiB;
constexpr size_t WS_END = WS_BIG + 704 * MiB;
constexpr int CW_BAR = 4096;

constexpr int LDS_BYTES = 147456;
constexpr int LDSCTL_OFF = LDS_BYTES - 512;
constexpr int MISC_OFF = LDSCTL_OFF;

struct Params {
    const float* x; const float* c; const int* positions; const float* ada_w; const float* ada_b; const float* norm_mix_g; const float* norm_ffn_g; const float* final_norm_g;
    const float* even_w_in; const float* even_w_out; const float* gmlp_ln_g; const float* gmlp_ln_b; const float* gmlp_w_s; const float* gmlp_b_s; const float* hgrn_lb_logits; const float* hgrn_norm_g;
    const float* odd_w_qkv; const float* odd_w_out; const float* peer_w_query; const float* peer_sub_keys; const float* peer_down; const float* peer_up;
    float* out; unsigned char* ws; int ph_lo, ph_hi;
};
struct Ctx { LAS unsigned char* lds; int tid, lane, wave, vcu, G; };

__device__ __forceinline__ float wave_sum(float v) {
#pragma unroll
    for (int o = 1; o < 64; o <<= 1) v += __shfl_xor(v, o);
    return v;
}
__device__ __forceinline__ float silu_f(float x) { return x * __builtin_amdgcn_rcpf(1.0f + __builtin_amdgcn_exp2f(-1.4426950408889634f * x)); }
__device__ __forceinline__ float sigmoid_f(float x) { return __builtin_amdgcn_rcpf(1.0f + __builtin_amdgcn_exp2f(-1.4426950408889634f * x)); }
__device__ __forceinline__ float gelu_f(float x) { return 0.5f * x * (1.0f + erff(x * 0.70710678118654752f)); }
__device__ __forceinline__ f32x4 mma16(f32x4 acc, const LAS bf16* A, int lda, const LAS bf16* Bt, int ldb, int K, int r, int q4) {
    const LAS bf16* ap = A + r * lda + 8 * q4; const LAS bf16* bp = Bt + r * ldb + 8 * q4;
    for (int k0 = 0; k0 < K; k0 += 32) {
        const bf16x8 a = *(const LAS bf16x8*)(ap + k0); const bf16x8 b = *(const LAS bf16x8*)(bp + k0);
        acc = __builtin_amdgcn_mfma_f32_16x16x32_bf16(a, b, acc, 0, 0, 0);
    }
    return acc;
}

struct EpiBf16P {
    static constexpr bool PERM = true, AFTER_DRAIN = false;
    bf16* O; size_t ldc;
    __device__ __forceinline__ void operator()(const f32x4 (&acc)[2][2][4][2], const pg8::Unit& u, int wr, int wc, int fr, int fq) const {
        const int row0 = u.pm * 256 + wr * 64 + fr, col0 = u.pn * 256 + wc * 32 + 8 * fq;
#pragma unroll
        for (int ai = 0; ai < 2; ++ai)
#pragma unroll
            for (int m = 0; m < 4; ++m) { bf16* rowp = O + (size_t)(row0 + ai * 128 + m * 16) * ldc + col0;
#pragma unroll
                for (int bj = 0; bj < 2; ++bj) { const f32x4 v0 = acc[ai][bj][m][0], v1 = acc[ai][bj][m][1];
                    v4u w; w.x = pg8::cvt_pk_bf16(v0[0], v0[1]); w.y = pg8::cvt_pk_bf16(v0[2], v0[3]); w.z = pg8::cvt_pk_bf16(v1[0], v1[1]); w.w = pg8::cvt_pk_bf16(v1[2], v1[3]);
                    *(v4u*)(rowp + bj * 128) = w; } }
    }
};
#ifndef EXP_REP
#define EXP_REP 1
#endif
#ifndef ATT_REP
#define ATT_REP 1
#endif
#ifndef ABL_ON
#define ABL_ON 4
#endif
struct EpiResid {
    static constexpr bool PERM = true, AFTER_DRAIN = false;
    const float* xin; float* xout; const float* gate; float gsc;
    __device__ __forceinline__ void operator()(const f32x4 (&acc)[2][2][4][2], const pg8::Unit& u, int wr, int wc, int fr, int fq) const {
        const int row0 = u.pm * 256 + wr * 64 + fr, col0 = u.pn * 256 + wc * 32 + 8 * fq;
        const float* gp = gate + (size_t)((u.pm * 256) >> 13) * 6144 + col0;
        f32x4 gv[2][2];
#pragma unroll
        for (int bj = 0; bj < 2; ++bj) { gv[bj][0] = *(const f32x4*)(gp + bj * 128); gv[bj][1] = *(const f32x4*)(gp + bj * 128 + 4); }
#pragma unroll
        for (int ai = 0; ai < 2; ++ai)
#pragma unroll
            for (int m = 0; m < 4; ++m) { const size_t off = (size_t)(row0 + ai * 128 + m * 16) * 1024 + col0;
#pragma unroll
                for (int bj = 0; bj < 2; ++bj) {
                    const f32x4 x0 = *(const f32x4*)(xin + off + bj * 128), x1 = *(const f32x4*)(xin + off + bj * 128 + 4);
                    *(f32x4*)(xout + off + bj * 128) = x0 + gv[bj][0] * acc[ai][bj][m][0] * gsc;
                    *(f32x4*)(xout + off + bj * 128 + 4) = x1 + gv[bj][1] * acc[ai][bj][m][1] * gsc; }
                asm volatile("" ::: "memory"); }
    }
};
struct EpiInProj {
    static constexpr bool PERM = true, AFTER_DRAIN = false;
    bf16* PU; bf16* PV; bf16* PQ; bf16* PI; bf16* PG; float* G; const float* LB;
    __device__ __forceinline__ void operator()(const f32x4 (&acc)[2][2][4][2], const pg8::Unit& u, int wr, int wc, int fr, int fq) const {
        const int type = u.pn >> 1;
        const int row0 = u.pm * 256 + wr * 64 + fr, lc0 = (u.pn & 1) * 256 + wc * 32 + 8 * fq;
        if (type == 3) {
            f32x4 lb[2][2];
#pragma unroll
            for (int bj = 0; bj < 2; ++bj) { lb[bj][0] = *(const f32x4*)(LB + lc0 + bj * 128); lb[bj][1] = *(const f32x4*)(LB + lc0 + bj * 128 + 4); }
#pragma unroll
            for (int ai = 0; ai < 2; ++ai)
#pragma unroll
                for (int m = 0; m < 4; ++m) { float* rowp = G + (size_t)(row0 + ai * 128 + m * 16) * 512 + lc0;
#pragma unroll
                    for (int bj = 0; bj < 2; ++bj)
#pragma unroll
                        for (int n = 0; n < 2; ++n) { const f32x4 v = acc[ai][bj][m][n]; f32x4 o;
#pragma unroll
                            for (int e = 0; e < 4; ++e) { const float l = lb[bj][n][e]; const float f = l + (1.0f - l) * sigmoid_f(v[e]); o[e] = __logf(f); }
                            *(f32x4*)(rowp + bj * 128 + 4 * n) = o; } }
            return;
        }
        bf16* base = type == 0 ? PU : type == 1 ? PV : type == 2 ? PQ : type == 4 ? PI : PG;
#pragma unroll
        for (int ai = 0; ai < 2; ++ai)
#pragma unroll
            for (int m = 0; m < 4; ++m) { bf16* rowp = base + (size_t)(row0 + ai * 128 + m * 16) * 512 + lc0;
#pragma unroll
                for (int bj = 0; bj < 2; ++bj) { f32x4 v0 = acc[ai][bj][m][0], v1 = acc[ai][bj][m][1];
                    if (type <= 1) { pg8::f32x2 a = pg8::gelu_pk((pg8::f32x2){v0[0], v0[1]}), b = pg8::gelu_pk((pg8::f32x2){v0[2], v0[3]}), c = pg8::gelu_pk((pg8::f32x2){v1[0], v1[1]}), d = pg8::gelu_pk((pg8::f32x2){v1[2], v1[3]});
                        v0 = (f32x4){a.x, a.y, b.x, b.y}; v1 = (f32x4){c.x, c.y, d.x, d.y}; }
                    else if (type == 2) {
#pragma unroll
                        for (int e = 0; e < 4; ++e) { v0[e] = silu_f(v0[e]) * 0.08838834764831845f; v1[e] = silu_f(v1[e]) * 0.08838834764831845f; } }
                    else if (type == 5) {
#pragma unroll
                        for (int e = 0; e < 4; ++e) { v0[e] = silu_f(v0[e]); v1[e] = silu_f(v1[e]); } }
                    v4u w; w.x = pg8::cvt_pk_bf16(v0[0], v0[1]); w.y = pg8::cvt_pk_bf16(v0[2], v0[3]); w.z = pg8::cvt_pk_bf16(v1[0], v1[1]); w.w = pg8::cvt_pk_bf16(v1[2], v1[3]);
                    *(v4u*)(rowp + bj * 128) = w; } }
    }
};
struct EpiQKRot {
    static constexpr bool PERM = true, AFTER_DRAIN = false;
    bf16* O; const float* CS;
    __device__ __forceinline__ void operator()(const f32x4 (&acc)[2][2][4][2], const pg8::Unit& u, int wr, int wc, int fr, int fq) const {
        const int row0 = u.pm * 256 + wr * 64 + fr, col0 = u.pn * 256 + wc * 32 + 8 * fq;
        const float sc = u.pn < 4 ? C2 : 1.0f;
        const bool rotw = (wc & 1) == 0;
        const float sgn = fq == 0 ? -1.0f : 1.0f;
#pragma unroll
        for (int ai = 0; ai < 2; ++ai)
#pragma unroll
            for (int m = 0; m < 4; ++m) { const int row = row0 + ai * 128 + m * 16; bf16* rowp = O + (size_t)row * 2048 + col0;
                f32x4 c0 = (f32x4){1.f, 1.f, 1.f, 1.f}, c1 = c0, s0 = (f32x4){0.f, 0.f, 0.f, 0.f}, s1 = s0;
                if (rotw && fq < 2) { const float* cp = CS + (size_t)row * 16; c0 = *(const f32x4*)(cp); c1 = *(const f32x4*)(cp + 4); s0 = *(const f32x4*)(cp + 8) * sgn; s1 = *(const f32x4*)(cp + 12) * sgn; }
#pragma unroll
                for (int bj = 0; bj < 2; ++bj) { f32x4 v0 = acc[ai][bj][m][0], v1 = acc[ai][bj][m][1];
                    if (rotw) { f32x4 p0, p1;
#pragma unroll
                        for (int e = 0; e < 4; ++e) { p0[e] = __shfl_xor(v0[e], 16); p1[e] = __shfl_xor(v1[e], 16); }
                        v0 = v0 * c0 + p0 * s0; v1 = v1 * c1 + p1 * s1; }
                    v0 = v0 * sc; v1 = v1 * sc;
                    v4u w; w.x = pg8::cvt_pk_bf16(v0[0], v0[1]); w.y = pg8::cvt_pk_bf16(v0[2], v0[3]); w.z = pg8::cvt_pk_bf16(v1[0], v1[1]); w.w = pg8::cvt_pk_bf16(v1[2], v1[3]);
                    *(v4u*)(rowp + bj * 128) = w; } }
    }
};

__device__ __forceinline__ void p0_transpose_item(const float* W, int K, int N, bf16* WT, LAS float* scr, int item, int lane) {
    const int nblk = N / 32, kb = item / nblk, nb = item % nblk, k0 = 64 * kb, n0 = 32 * nb;
#pragma unroll 8
    for (int i = 0; i < 32; ++i) { const int kk = 2 * i + (lane >> 5); scr[kk * 33 + (lane & 31)] = W[(size_t)(k0 + kk) * N + n0 + (lane & 31)]; }
    LDS_WAIT(); asm volatile("" ::: "memory");
    const int c = lane & 7;
#pragma unroll
    for (int j = 0; j < 4; ++j) { const int n = (lane >> 3) + 8 * j; const LAS float* s = scr + (8 * c) * 33 + n;
        v4u o; o.x = pk2(s[0 * 33], s[1 * 33]); o.y = pk2(s[2 * 33], s[3 * 33]); o.z = pk2(s[4 * 33], s[5 * 33]); o.w = pk2(s[6 * 33], s[7 * 33]);
        *(GAS v4u*)(WT + (size_t)(n0 + n) * K + k0 + 8 * c) = o; }
    LDS_WAIT(); asm volatile("" ::: "memory");
}
typedef float f32x2 __attribute__((ext_vector_type(2)));
__device__ __forceinline__ void convert_tables(const Params& P, const Ctx& C) {
    const int gw = C.vcu * NWAVES + C.wave, NGW = C.G * NWAVES, lane = C.lane;
    for (int row = gw; row < 4 * 16384; row += NGW) {
        const int tb = row >> 14, e = row & 16383;
        const float* src = ((tb & 1) ? P.peer_up : P.peer_down) + ((size_t)(tb >> 1) * 16384 + e) * 1024;
        unsigned char* dst = P.ws + WS_TAB8 + (size_t)tb * TAB8_BYTES + (size_t)e * TROW;
        f32x4 v[4]; float mx = 0.f;
#pragma unroll
        for (int j = 0; j < 4; ++j) { v[j] = ((const f32x4*)src)[64 * j + lane]; mx = fmaxf(mx, fmaxf(fmaxf(fabsf(v[j][0]), fabsf(v[j][1])), fmaxf(fabsf(v[j][2]), fabsf(v[j][3])))); }
#pragma unroll
        for (int o = 1; o < 64; o <<= 1) mx = fmaxf(mx, __shfl_xor(mx, o));
        const float sc = mx > 0.f ? 400.0f / mx : 0.f;
#pragma unroll
        for (int j = 0; j < 4; ++j) { int p = __builtin_amdgcn_cvt_pk_fp8_f32(v[j][0] * sc, v[j][1] * sc, 0, false); p = __builtin_amdgcn_cvt_pk_fp8_f32(v[j][2] * sc, v[j][3] * sc, p, true);
            ((unsigned*)dst)[64 * j + lane] = (unsigned)p; }
        if (lane == 0) *(float*)(dst + 1024) = mx * (1.0f / 400.0f);
    }
}
__device__ __forceinline__ void phase_prologue(const Params& P, const Ctx& C) {
    float* MOD = (float*)(P.ws + WS_MOD);
    {
        LAS float* cond = (LAS float*)C.lds;
        LAS float* part = (LAS float*)(C.lds + 32768);
        for (int e = C.tid; e < 8192; e += 512) cond[e] = silu_f(P.c[e]);
        __syncthreads();
        for (int item = C.vcu; item < 192; item += C.G) {
            const int l = item / 96, cb = item % 96, col = cb * 64 + C.lane;
            float acc[8];
#pragma unroll
            for (int b = 0; b < 8; ++b) acc[b] = 0.f;
            const float* wp = P.ada_w + ((size_t)l * 1024 + C.wave * 128) * 6144 + col;
#pragma unroll 4
            for (int k = 0; k < 128; ++k) { const float wv = wp[(size_t)k * 6144];
#pragma unroll
                for (int b = 0; b < 8; ++b) acc[b] += cond[b * 1024 + C.wave * 128 + k] * wv; }
#pragma unroll
            for (int b = 0; b < 8; ++b) part[(C.wave * 8 + b) * 64 + C.lane] = acc[b];
            __syncthreads();
            { const int b = C.tid >> 6, ln = C.tid & 63; float s = P.ada_b[l * 6144 + cb * 64 + ln];
#pragma unroll
              for (int w = 0; w < 8; ++w) s += part[(w * 8 + b) * 64 + ln];
              MOD[(size_t)(l * 8 + b) * 6144 + cb * 64 + ln] = s; }
            __syncthreads();
        }
        __syncthreads();
    }
    {
        LAS float* scr = (LAS float*)(C.lds + C.wave * 16384);
        const int gw = C.vcu * NWAVES + C.wave, NGW = C.G * NWAVES;
        for (int it = gw; it < 6144; it += NGW) {
            int r = it;
            if (r < 1536) { p0_transpose_item(P.even_w_in, 1024, 3072, (bf16*)(P.ws + WS_WIN), scr, r, C.lane); continue; } r -= 1536;
            if (r < 512)  { p0_transpose_item(P.even_w_out, 1024, 1024, (bf16*)(P.ws + WS_WOUT0), scr, r, C.lane); continue; } r -= 512;
            if (r < 1536) { p0_transpose_item(P.odd_w_qkv, 1024, 3072, (bf16*)(P.ws + WS_WQKV), scr, r, C.lane); continue; } r -= 1536;
            if (r < 512)  { p0_transpose_item(P.odd_w_out, 1024, 1024, (bf16*)(P.ws + WS_WOUT1), scr, r, C.lane); continue; } r -= 512;
            if (r < 1024) { p0_transpose_item(P.peer_w_query, 1024, 2048, (bf16*)(P.ws + WS_WQ0), scr, r, C.lane); continue; } r -= 1024;
            p0_transpose_item(P.peer_w_query + (size_t)1024 * 2048, 1024, 2048, (bf16*)(P.ws + WS_WQ1), scr, r, C.lane);
        }
    }
    convert_tables(P, C);
    const int NT = C.G * 512, gt = C.vcu * 512 + C.tid;
    { bf16* skb = (bf16*)(P.ws + WS_SKB); for (int i = gt; i < 65536; i += NT) skb[i] = (bf16)f2bf(P.peer_sub_keys[i]); }
    { bf16* wsb = (bf16*)(P.ws + WS_WSB); for (int i = gt; i < 65536; i += NT) { const int t = (i >> 7) & 127, s = i & 127; wsb[i] = (bf16)(s <= t ? f2bf(P.gmlp_w_s[i]) : 0u); } }
    { float* lb = (float*)(P.ws + WS_LB); for (int i = gt; i < 512; i += NT) { const float l0 = P.hgrn_lb_logits[i], l1 = P.hgrn_lb_logits[512 + i]; lb[i] = 1.0f / (1.0f + expf(l1 - l0)); } }
    { float* cs = (float*)(P.ws + WS_CS); for (int i = gt; i < T * 8; i += NT) { const int tok = i >> 3, j = i & 7;
        const float inv = 1.0f / powf(500000.0f, (float)j * 0.125f); const float ang = (float)P.positions[tok] * inv; float sn, cn; sincosf(ang, &sn, &cn);
        cs[(size_t)tok * 16 + j] = cn; cs[(size_t)tok * 16 + 8 + j] = sn; } }
}
__device__ __forceinline__ void norm_row_bf16(const float* xrow, bf16* hrow, const float* g, const float* sh, const float* sc, int lane) {
    const f32x4* xr = (const f32x4*)xrow + lane; f32x4 v[4]; float s = 0.f;
#pragma unroll
    for (int j = 0; j < 4; ++j) { v[j] = xr[64 * j]; s += (v[j][0] * v[j][0] + v[j][1] * v[j][1]) + (v[j][2] * v[j][2] + v[j][3] * v[j][3]); }
    const float rstd = 1.0f / sqrtf(wave_sum(s) * (1.0f / 1024.0f) + NORM_EPS);
    unsigned long long* o8 = (unsigned long long*)hrow + lane;
#pragma unroll
    for (int j = 0; j < 4; ++j) { const f32x4 gg = ((const f32x4*)g)[64 * j + lane], hh = ((const f32x4*)sh)[64 * j + lane], cc = ((const f32x4*)sc)[64 * j + lane];
        const f32x4 y = (v[j] * rstd * gg) * (cc + 1.0f) + hh;
        o8[64 * j] = (unsigned long long)pk2(y[0], y[1]) | ((unsigned long long)pk2(y[2], y[3]) << 32); }
}
__device__ __forceinline__ void phase_norm(const Params& P, const Ctx& C, const float* xsrc, const float* g, int l, int so) {
    const float* MOD = (const float*)(P.ws + WS_MOD); bf16* H = (bf16*)(P.ws + WS_H);
    const int gw = C.vcu * NWAVES + C.wave, NGW = C.G * NWAVES;
    for (int m = gw; m < T; m += NGW) { const float* mb = MOD + (size_t)(l * 8 + (m >> 13)) * 6144 + so;
        norm_row_bf16(xsrc + (size_t)m * 1024, H + (size_t)m * 1024, g, mb, mb + 1024, C.lane); }
}

__device__ __forceinline__ void gmlp_item(const Params& P, const Ctx& C, int n, int g) {
    LAS bf16* Wt = (LAS bf16*)C.lds;
    LAS bf16* vT = (LAS bf16*)(C.lds + 34816);
    const bf16* WSB = (const bf16*)(P.ws + WS_WSB); const bf16* PU = (const bf16*)(P.ws + WS_PU); const bf16* PV = (const bf16*)(P.ws + WS_PV); bf16* MIX = (bf16*)(P.ws + WS_H);
    const int tid = C.tid, r = C.lane & 15, q4 = C.lane >> 4;
    for (int ch = tid; ch < 2048; ch += 512) { const int rr = ch >> 4, c8 = (ch & 15) * 8; *(LAS v4u*)(Wt + rr * 136 + c8) = *(const v4u*)(WSB + (size_t)(g * 128 + rr) * 128 + c8); }
    { const int t = tid >> 2, part = tid & 3; const bf16* src = PV + (size_t)(n * 128 + t) * 512 + g * 128 + part * 32;
      float x[32];
#pragma unroll
      for (int j = 0; j < 4; ++j) { const v4u w = *(const v4u*)(src + 8 * j);
#pragma unroll
          for (int e = 0; e < 4; ++e) { x[8 * j + 2 * e] = bflo(w[e]); x[8 * j + 2 * e + 1] = bfhi(w[e]); } }
      float s = 0.f;
#pragma unroll
      for (int j = 0; j < 32; ++j) s += x[j];
      s += __shfl_xor(s, 1); s += __shfl_xor(s, 2);
      const float mean = s * (1.0f / 128.0f); float q = 0.f;
#pragma unroll
      for (int j = 0; j < 32; ++j) { const float d = x[j] - mean; q += d * d; }
      q += __shfl_xor(q, 1); q += __shfl_xor(q, 2);
      const float rstd = 1.0f / sqrtf(q * (1.0f / 128.0f) + NORM_EPS);
      const float* lg = P.gmlp_ln_g + g * 128 + part * 32; const float* lbp = P.gmlp_ln_b + g * 128 + part * 32;
#pragma unroll
      for (int j = 0; j < 32; ++j) vT[(part * 32 + j) * 136 + t] = (bf16)f2bf((x[j] - mean) * rstd * lg[j] + lbp[j]);
    }
    __syncthreads();
    const int t0 = 16 * C.wave; const int Keff = ((t0 + 16 + 31) >> 5) << 5;
    f32x4 acc[8];
#pragma unroll
    for (int ct = 0; ct < 8; ++ct) { acc[ct] = (f32x4){0.f, 0.f, 0.f, 0.f}; acc[ct] = mma16(acc[ct], Wt + t0 * 136, 136, vT + (16 * ct) * 136, 136, Keff, r, q4); }
#pragma unroll
    for (int i = 0; i < 4; ++i) { const int t = t0 + 4 * q4 + i; const float bs = P.gmlp_b_s[g * 128 + t]; const size_t tok = (size_t)n * 128 + t;
#pragma unroll
        for (int ct = 0; ct < 8; ++ct) { const int c = 16 * ct + r; const float u = bf2f(PU[tok * 512 + g * 128 + c]); MIX[tok * 1024 + g * 128 + c] = (bf16)f2bf(u * (acc[ct][i] + bs)); } }
    __syncthreads();
}
__device__ __forceinline__ void hgrn_cumsum16(const float* G, size_t tok0, int hh, int k, int seg, LAS float* tot, float (&g)[16], float (&bb)[16], float& total) {
    const float* gp = G + (tok0 + seg * 16) * 512 + hh * 128 + k;
#pragma unroll
    for (int j = 0; j < 16; ++j) g[j] = gp[(size_t)j * 512];
    float run = 0.f;
#pragma unroll
    for (int j = 0; j < 16; ++j) { run += g[j]; bb[j] = run; }
    tot[seg * 128 + k] = run;
    __syncthreads();
    const float t0 = tot[k], t1 = tot[128 + k], t2 = tot[256 + k], t3 = tot[384 + k];
    const float pre = seg == 0 ? 0.f : seg == 1 ? t0 : seg == 2 ? t0 + t1 : t0 + t1 + t2;
    total = (t0 + t1) + (t2 + t3);
#pragma unroll
    for (int j = 0; j < 16; ++j) bb[j] += pre;
}
__device__ __forceinline__ void hgrn_stage_iT(const bf16* PI, size_t tok0, int hh, LAS bf16* iT, int tid) {
    const int s = tid >> 3, v0 = (tid & 7) * 16; const bf16* src = PI + (tok0 + s) * 512 + hh * 128 + v0;
#pragma unroll
    for (int h2 = 0; h2 < 2; ++h2) { const v4u w = *(const v4u*)(src + 8 * h2);
#pragma unroll
        for (int e = 0; e < 4; ++e) { iT[(v0 + 8 * h2 + 2 * e) * 72 + s] = (bf16)(w[e] & 0xffffu); iT[(v0 + 8 * h2 + 2 * e + 1) * 72 + s] = (bf16)(w[e] >> 16); } }
}
__device__ __forceinline__ void hgrn_local_item(const Params& P, const Ctx& C, int item) {
    LAS bf16* khT = (LAS bf16*)C.lds;
    LAS bf16* iT = (LAS bf16*)(C.lds + 18432);
    LAS float* tot = (LAS float*)(C.lds + 36864);
    const float* G = (const float*)(P.ws + WS_G); const bf16* PI = (const bf16*)(P.ws + WS_PI); bf16* KVT = (bf16*)(P.ws + WS_KVT); float* HD = (float*)(P.ws + WS_HD);
    const int bh = item >> 7, c = item & 127, b = bh >> 2, hh = bh & 3; const size_t tok0 = (size_t)b * SEQ + c * 64;
    const int tid = C.tid, k = tid & 127, seg = tid >> 7, r = C.lane & 15, q4 = C.lane >> 4;
    float g[16], bb[16], total;
    hgrn_cumsum16(G, tok0, hh, k, seg, tot, g, bb, total);
    { unsigned w[8];
#pragma unroll
      for (int j = 0; j < 8; ++j) { const float a0 = -expm1f(g[2 * j]) * __expf(total - bb[2 * j]), a1 = -expm1f(g[2 * j + 1]) * __expf(total - bb[2 * j + 1]); w[j] = pk2(a0, a1); }
      LAS v4u* dst = (LAS v4u*)(khT + k * 72 + seg * 16); dst[0] = (v4u){w[0], w[1], w[2], w[3]}; dst[1] = (v4u){w[4], w[5], w[6], w[7]}; }
    if (seg == 0) HD[(size_t)item * 128 + k] = __expf(total);
    hgrn_stage_iT(PI, tok0, hh, iT, tid);
    __syncthreads();
    const int v0 = 16 * C.wave;
#pragma unroll
    for (int ct = 0; ct < 8; ++ct) { f32x4 acc = (f32x4){0.f, 0.f, 0.f, 0.f}; acc = mma16(acc, iT + v0 * 72, 72, khT + (16 * ct) * 72, 72, 64, r, q4);
#pragma unroll
        for (int i = 0; i < 4; ++i) KVT[((size_t)item * 128 + v0 + 4 * q4 + i) * 128 + 16 * ct + r] = (bf16)f2bf(acc[i]); }
    __syncthreads();
}
__device__ __forceinline__ void phase_hgrn_scan(const Params& P, const Ctx& C) {
    const bf16* KVT = (const bf16*)(P.ws + WS_KVT); bf16* ST = (bf16*)(P.ws + WS_ST); const float* HD = (const float*)(P.ws + WS_HD);
    for (int task = C.vcu * 256 + C.tid; C.tid < 256 && task < 65536; task += C.G * 256) {
        const int bh = task >> 11, v = (task >> 4) & 127, kb = task & 15;
        float st[8];
#pragma unroll
        for (int e = 0; e < 8; ++e) st[e] = 0.f;
#pragma unroll 4
        for (int c = 0; c < 128; ++c) { const size_t item = (size_t)bh * 128 + c, off = (item * 128 + v) * 128 + kb * 8;
            const v4u kv = *(const v4u*)(KVT + off); const f32x4 d0 = *(const f32x4*)(HD + item * 128 + kb * 8), d1 = *(const f32x4*)(HD + item * 128 + kb * 8 + 4);
            v4u o; o.x = pk2(st[0], st[1]); o.y = pk2(st[2], st[3]); o.z = pk2(st[4], st[5]); o.w = pk2(st[6], st[7]);
            *(v4u*)(ST + off) = o;
#pragma unroll
            for (int e = 0; e < 4; ++e) { st[2 * e] = (e < 2 ? d0[2 * e] : d1[2 * e - 4]) * st[2 * e] + bflo(kv[e]); st[2 * e + 1] = (e < 2 ? d0[2 * e + 1] : d1[2 * e - 3]) * st[2 * e + 1] + bfhi(kv[e]); }
        }
    }
}
__device__ __forceinline__ void hgrn_out_item(const Params& P, const Ctx& C, int item) {
    LAS bf16* qt = (LAS bf16*)C.lds;
    LAS bf16* kt = (LAS bf16*)(C.lds + 17408);
    LAS bf16* iT = (LAS bf16*)(C.lds + 34816);
    LAS bf16* A1 = (LAS bf16*)(C.lds + 53248);
    LAS bf16* STl = (LAS bf16*)(C.lds + 62464);
    LAS float* ol = (LAS float*)(C.lds + 97280);
    LAS float* tot = (LAS float*)(C.lds + 131072);
    const float* G = (const float*)(P.ws + WS_G); const bf16* PQ = (const bf16*)(P.ws + WS_PQ); const bf16* PI = (const bf16*)(P.ws + WS_PI); const bf16* PG = (const bf16*)(P.ws + WS_PG);
    const bf16* ST = (const bf16*)(P.ws + WS_ST); bf16* MIX = (bf16*)(P.ws + WS_H);
    const int bh = item >> 7, c = item & 127, b = bh >> 2, hh = bh & 3; const size_t tok0 = (size_t)b * SEQ + c * 64;
    const int tid = C.tid, k = tid & 127, seg = tid >> 7, r = C.lane & 15, q4 = C.lane >> 4;
    float g[16], bb[16], total;
    hgrn_cumsum16(G, tok0, hh, k, seg, tot, g, bb, total);
#pragma unroll
    for (int j = 0; j < 16; ++j) { const int t = seg * 16 + j; const float qv = bf2f(PQ[(tok0 + t) * 512 + hh * 128 + k]);
        qt[t * 136 + k] = (bf16)f2bf(qv * __expf(bb[j])); kt[t * 136 + k] = (bf16)f2bf(-expm1f(g[j]) * __expf(-bb[j])); }
    hgrn_stage_iT(PI, tok0, hh, iT, tid);
    for (int ch = tid; ch < 2048; ch += 512) { const int rr = ch >> 4, c8 = (ch & 15) * 8; *(LAS v4u*)(STl + rr * 136 + c8) = *(const v4u*)(ST + ((size_t)item * 128 + rr) * 128 + c8); }
    __syncthreads();
    { const int rt = C.wave >> 1;
#pragma unroll
      for (int cc = 0; cc < 2; ++cc) { const int ct = (C.wave & 1) * 2 + cc; f32x4 acc = (f32x4){0.f, 0.f, 0.f, 0.f};
          acc = mma16(acc, qt + (16 * rt) * 136, 136, kt + (16 * ct) * 136, 136, 128, r, q4);
#pragma unroll
          for (int i = 0; i < 4; ++i) { const int t = 16 * rt + 4 * q4 + i, s = 16 * ct + r; A1[t * 72 + s] = (bf16)(s <= t ? f2bf(acc[i]) : 0u); } } }
    __syncthreads();
    { const int rt = C.wave >> 1;
#pragma unroll
      for (int cc = 0; cc < 4; ++cc) { const int ct = (C.wave & 1) * 4 + cc; f32x4 acc = (f32x4){0.f, 0.f, 0.f, 0.f};
          acc = mma16(acc, A1 + (16 * rt) * 72, 72, iT + (16 * ct) * 72, 72, 64, r, q4);
          acc = mma16(acc, qt + (16 * rt) * 136, 136, STl + (16 * ct) * 136, 136, 128, r, q4);
#pragma unroll
          for (int i = 0; i < 4; ++i) ol[(16 * rt + 4 * q4 + i) * 132 + 16 * ct + r] = acc[i]; } }
    __syncthreads();
    { const int t = tid >> 3, v0 = (tid & 7) * 16; float o[16]; float ss = 0.f;
#pragma unroll
      for (int e = 0; e < 16; ++e) { o[e] = ol[t * 132 + v0 + e]; ss += o[e] * o[e]; }
      ss += __shfl_xor(ss, 1); ss += __shfl_xor(ss, 2); ss += __shfl_xor(ss, 4);
      const float rstd = 1.0f / sqrtf(ss * (1.0f / 128.0f) + NORM_EPS);
      const float* ng = P.hgrn_norm_g + hh * 128 + v0; const bf16* gp = PG + (tok0 + t) * 512 + hh * 128 + v0;
      const v4u g0 = *(const v4u*)gp, g1 = *(const v4u*)(gp + 8); unsigned w[8];
#pragma unroll
      for (int e = 0; e < 4; ++e) { w[e] = pk2(o[2 * e] * rstd * ng[2 * e] * bflo(g0[e]), o[2 * e + 1] * rstd * ng[2 * e + 1] * bfhi(g0[e]));
                                    w[4 + e] = pk2(o[8 + 2 * e] * rstd * ng[8 + 2 * e] * bflo(g1[e]), o[9 + 2 * e] * rstd * ng[9 + 2 * e] * bfhi(g1[e])); }
      v4u* dst = (v4u*)(MIX + (tok0 + t) * 1024 + 512 + hh * 128 + v0); dst[0] = (v4u){w[0], w[1], w[2], w[3]}; dst[1] = (v4u){w[4], w[5], w[6], w[7]}; }
    __syncthreads();
}

__device__ __forceinline__ void attn_item(const Params& P, const Ctx& C, int b, int hd, int qt) {
    LAS bf16* Qs = (LAS bf16*)C.lds;
    LAS bf16* Ks = (LAS bf16*)(C.lds + 36864);
    LAS bf16* Vts = (LAS bf16*)(C.lds + 46080);
    LAS bf16* Ps = (LAS bf16*)(C.lds + 55296 + C.wave * 4608);
    const bf16* QK = (const bf16*)(P.ws + WS_QK); const bf16* VT = (const bf16*)(P.ws + WS_VT); bf16* O = (bf16*)(P.ws + WS_H);
    const int tid = C.tid, r = C.lane & 15, q4 = C.lane >> 4, w = C.wave;
    const int t0 = qt * 256; const size_t rowbase = (size_t)b * SEQ;
    __syncthreads();
    for (int ch = tid; ch < 2048; ch += 512) { const int rr = ch >> 3, c8 = (ch & 7) * 8; *(LAS v4u*)(Qs + rr * 72 + c8) = *(const v4u*)(QK + (rowbase + t0 + rr) * 2048 + hd * 64 + c8); }
    const int kt_first = (t0 >= 2048 ? t0 - 2048 : 0) >> 6, kt_last = (t0 >> 6) + 3;
    const int srow = tid >> 3, sc8 = (tid & 7) * 8;
    v4u kreg = *(const v4u*)(QK + (rowbase + kt_first * 64 + srow) * 2048 + 1024 + hd * 64 + sc8);
    v4u vreg = *(const v4u*)(VT + (size_t)(hd * 64 + srow) * T + rowbase + kt_first * 64 + sc8);
    float mrow[2][4], lrow[2][4]; f32x4 oacc[2][4];
#pragma unroll
    for (int i = 0; i < 2; ++i)
#pragma unroll
        for (int e = 0; e < 4; ++e) { mrow[i][e] = -1e30f; lrow[i][e] = 0.f; oacc[i][e] = (f32x4){0.f, 0.f, 0.f, 0.f}; }
    const int tq0 = t0 + 32 * w;
    for (int kt = kt_first; kt <= kt_last; ++kt) {
        __syncthreads();
        *(LAS v4u*)(Ks + srow * 72 + sc8) = kreg; *(LAS v4u*)(Vts + srow * 72 + sc8) = vreg;
        __syncthreads();
        if (kt < kt_last) { kreg = *(const v4u*)(QK + (rowbase + (kt + 1) * 64 + srow) * 2048 + 1024 + hd * 64 + sc8);
                            vreg = *(const v4u*)(VT + (size_t)(hd * 64 + srow) * T + rowbase + (kt + 1) * 64 + sc8); }
        const int tk0 = kt * 64;
        if (tk0 > tq0 + 31 || tk0 + 63 < tq0 - 2048) continue;
        f32x4 s[2][4];
#pragma unroll
        for (int i = 0; i < 2; ++i)
#pragma unroll
            for (int j = 0; j < 4; ++j) { s[i][j] = (f32x4){0.f, 0.f, 0.f, 0.f}; s[i][j] = mma16(s[i][j], Qs + (32 * w + 16 * i) * 72, 72, Ks + (16 * j) * 72, 72, 64, r, q4); }
#pragma unroll
        for (int i = 0; i < 2; ++i)
#pragma unroll
            for (int e = 0; e < 4; ++e) {
                const int tq = tq0 + 16 * i + 4 * q4 + e; float mx = -1e30f;
#pragma unroll
                for (int j = 0; j < 4; ++j) { const int d = tq - (tk0 + 16 * j + r);
                    const int cnt = (d <= 128 ? 1 : 0) + ((((d & 3) == 0) && d <= 512) ? 1 : 0) + (((d & 15) == 0) ? 1 : 0);
                    const bool ok = d >= 0 && d <= 2048 && cnt > 0;
                    const float bias = cnt == 3 ? 1.5849625007f : (cnt == 2 ? 1.0f : 0.0f);
                    const float sv = ok ? s[i][j][e] + bias : -1e30f; s[i][j][e] = sv; mx = fmaxf(mx, sv); }
                mx = fmaxf(mx, __shfl_xor(mx, 1)); mx = fmaxf(mx, __shfl_xor(mx, 2)); mx = fmaxf(mx, __shfl_xor(mx, 4)); mx = fmaxf(mx, __shfl_xor(mx, 8));
                const float mnew = fmaxf(mrow[i][e], mx), alpha = __builtin_amdgcn_exp2f(mrow[i][e] - mnew); mrow[i][e] = mnew;
                float rs = 0.f;
#pragma unroll
                for (int j = 0; j < 4; ++j) { const float sv = s[i][j][e]; const float p = sv > -1e29f ? __builtin_amdgcn_exp2f(sv - mnew) : 0.f; rs += p;
                    Ps[(16 * i + 4 * q4 + e) * 72 + 16 * j + r] = (bf16)f2bf(p); }
                rs += __shfl_xor(rs, 1); rs += __shfl_xor(rs, 2); rs += __shfl_xor(rs, 4); rs += __shfl_xor(rs, 8);
                lrow[i][e] = lrow[i][e] * alpha + rs;
#pragma unroll
                for (int jd = 0; jd < 4; ++jd) oacc[i][jd][e] *= alpha;
            }
        LDS_WAIT();
#pragma unroll
        for (int i = 0; i < 2; ++i)
#pragma unroll
            for (int jd = 0; jd < 4; ++jd) oacc[i][jd] = mma16(oacc[i][jd], Ps + (16 * i) * 72, 72, Vts + (16 * jd) * 72, 72, 64, r, q4);
    }
#pragma unroll
    for (int i = 0; i < 2; ++i)
#pragma unroll
        for (int e = 0; e < 4; ++e) { const float inv = 1.0f / lrow[i][e]; const size_t row = rowbase + tq0 + 16 * i + 4 * q4 + e;
#pragma unroll
            for (int jd = 0; jd < 4; ++jd) O[row * 1024 + hd * 64 + 16 * jd + r] = (bf16)f2bf(oacc[i][jd][e] * inv); }
}

__device__ __forceinline__ unsigned ordf(float s) { const unsigned u = __builtin_bit_cast(unsigned, s); return u ^ ((unsigned)((int)u >> 31) | 0x80000000u); }
__device__ __forceinline__ float unordf(unsigned v) { return __builtin_bit_cast(float, v ^ ((unsigned)((int)(~v) >> 31) | 0x80000000u)); }
__device__ __forceinline__ void ins16(unsigned (&top)[16], unsigned x) {
#pragma unroll
    for (int j = 0; j < 16; ++j) { const unsigned hi = top[j] > x ? top[j] : x; x = top[j] > x ? x : top[j]; top[j] = hi; }
}
__device__ __forceinline__ void merge16(unsigned (&top)[16], int mask) {
    unsigned c[16];
#pragma unroll
    for (int j = 0; j < 16; ++j) { const unsigned o = (unsigned)__shfl_xor((int)top[15 - j], mask); c[j] = top[j] > o ? top[j] : o; }
#pragma unroll
    for (int st = 8; st >= 1; st >>= 1)
#pragma unroll
        for (int j = 0; j < 16; ++j) if ((j & st) == 0) { const unsigned a = c[j], b2 = c[j + st]; c[j] = a > b2 ? a : b2; c[j + st] = a > b2 ? b2 : a; }
#pragma unroll
    for (int j = 0; j < 16; ++j) top[j] = c[j];
}
__device__ __forceinline__ void phase_peer_topk(const Params& P, const Ctx& C, int layer) {
    LAS bf16* SK = (LAS bf16*)C.lds;
    const bf16* SKB = (const bf16*)(P.ws + WS_SKB) + (size_t)layer * 32768; const bf16* QP = (const bf16*)(P.ws + WS_QP);
    int* IDX = (int*)(P.ws + WS_IDX); float* GATE = (float*)(P.ws + WS_GATE);
    for (int ch = C.tid; ch < 4096; ch += 512) { const int rr = ch >> 4, c8 = (ch & 15) * 8; *(LAS v4u*)(SK + rr * 136 + c8) = *(const v4u*)(SKB + (size_t)rr * 128 + c8); }
    __syncthreads();
    const int r = C.lane & 15, q4 = C.lane >> 4;
    const int gw = C.vcu * NWAVES + C.wave, NGW = C.G * NWAVES;
    for (int grp = gw; grp < T * 8 / 16; grp += NGW) {
        const size_t task = (size_t)grp * 16 + r;
        unsigned lst[2][16];
#pragma unroll
        for (int half = 0; half < 2; ++half) {
            bf16x8 bq[4];
#pragma unroll
            for (int ks = 0; ks < 4; ++ks) bq[ks] = *(const bf16x8*)(QP + task * 256 + half * 128 + ks * 32 + 8 * q4);
            unsigned top[16];
#pragma unroll
            for (int j = 0; j < 16; ++j) top[j] = 0u;
#pragma unroll 1
            for (int nt = 0; nt < 8; ++nt) { f32x4 acc = (f32x4){0.f, 0.f, 0.f, 0.f};
#pragma unroll
                for (int ks = 0; ks < 4; ++ks) { const bf16x8 a = *(const LAS bf16x8*)(SK + (half * 128 + 16 * nt + r) * 136 + ks * 32 + 8 * q4); acc = __builtin_amdgcn_mfma_f32_16x16x32_bf16(a, bq[ks], acc, 0, 0, 0); }
#pragma unroll
                for (int i = 0; i < 4; ++i) { const unsigned n = 16 * nt + 4 * q4 + i; ins16(top, (ordf(acc[i]) & ~127u) | (127u - n)); } }
            merge16(top, 16); merge16(top, 32);
#pragma unroll
            for (int j = 0; j < 16; ++j) lst[half][j] = top[j];
        }
        float v1[16], v2[16]; unsigned e1[16], e2[16];
#pragma unroll
        for (int j = 0; j < 16; ++j) { v1[j] = unordf(lst[0][j] & ~127u); v2[j] = unordf(lst[1][j] & ~127u); e1[j] = (127u - (lst[0][j] & 127u)) << 7; e2[j] = 127u - (lst[1][j] & 127u); }
        unsigned top[16];
#pragma unroll
        for (int j = 0; j < 16; ++j) top[j] = 0u;
#pragma unroll
        for (int i = 0; i < 16; ++i)
#pragma unroll
            for (int j = 0; j < 16; ++j) if ((i + 1) * (j + 1) <= 16) ins16(top, (ordf(v1[i] + v2[j]) & ~16383u) | e1[i] | e2[j]);
        float ev[16]; float den = 0.f; const float mx = unordf(top[0] & ~16383u);
#pragma unroll
        for (int j = 0; j < 16; ++j) { ev[j] = __expf(unordf(top[j] & ~16383u) - mx); den += ev[j]; }
        const float inv = 1.0f / den;
        int* ip = IDX + task * 16; float* gp = GATE + task * 16;
        if (q4 == 0) { *(v4u*)(ip) = (v4u){top[0] & 16383u, top[1] & 16383u, top[2] & 16383u, top[3] & 16383u}; *(f32x4*)(gp) = (f32x4){ev[0] * inv, ev[1] * inv, ev[2] * inv, ev[3] * inv}; }
        else if (q4 == 1) { *(v4u*)(ip + 4) = (v4u){top[4] & 16383u, top[5] & 16383u, top[6] & 16383u, top[7] & 16383u}; *(f32x4*)(gp + 4) = (f32x4){ev[4] * inv, ev[5] * inv, ev[6] * inv, ev[7] * inv}; }
        else if (q4 == 2) { *(v4u*)(ip + 8) = (v4u){top[8] & 16383u, top[9] & 16383u, top[10] & 16383u, top[11] & 16383u}; *(f32x4*)(gp + 8) = (f32x4){ev[8] * inv, ev[9] * inv, ev[10] * inv, ev[11] * inv}; }
        else { *(v4u*)(ip + 12) = (v4u){top[12] & 16383u, top[13] & 16383u, top[14] & 16383u, top[15] & 16383u}; *(f32x4*)(gp + 12) = (f32x4){ev[12] * inv, ev[13] * inv, ev[14] * inv, ev[15] * inv}; }
    }
}
struct ExpRow { v4u d[4], u[4]; float ds, us, gk; };
__device__ __forceinline__ void exp_issue(ExpRow& R, const unsigned char* TD, const unsigned char* TU, int ex, float gk, int jl) {
    const unsigned char* dr = TD + (size_t)ex * TROW; const unsigned char* ur = TU + (size_t)ex * TROW;
#pragma unroll
    for (int c = 0; c < 4; ++c) R.d[c] = *(const v4u*)(dr + (c * 16 + jl) * 16);
#pragma unroll
    for (int c = 0; c < 4; ++c) R.u[c] = *(const v4u*)(ur + (c * 16 + jl) * 16);
    R.ds = *(const float*)(dr + 1024); R.us = *(const float*)(ur + 1024); R.gk = gk;
}
__device__ __forceinline__ void exp_consume(const ExpRow& R, const unsigned (&hp)[32], f32x2 (&oacc)[32]) {
    f32x2 a2 = (f32x2){0.f, 0.f};
#pragma unroll
    for (int c = 0; c < 4; ++c)
#pragma unroll
        for (int w = 0; w < 4; ++w) { const f32x2 lo = __builtin_amdgcn_cvt_pk_f32_fp8((int)R.d[c][w], false), hi = __builtin_amdgcn_cvt_pk_f32_fp8((int)R.d[c][w], true);
            unsigned h0 = hp[c * 8 + 2 * w], h1 = hp[c * 8 + 2 * w + 1]; asm volatile("" : "+v"(h0), "+v"(h1));
            a2 = a2 + lo * (f32x2){bflo(h0), bfhi(h0)}; a2 = a2 + hi * (f32x2){bflo(h1), bfhi(h1)}; }
    float a = (a2.x + a2.y) * R.ds;
    a += __shfl_xor(a, 1); a += __shfl_xor(a, 2); a += __shfl_xor(a, 4); a += __shfl_xor(a, 8);
    const float wk = R.gk * gelu_f(a) * R.us; const f32x2 wk2 = (f32x2){wk, wk};
#pragma unroll
    for (int c = 0; c < 4; ++c)
#pragma unroll
        for (int w = 0; w < 4; ++w) { const f32x2 lo = __builtin_amdgcn_cvt_pk_f32_fp8((int)R.u[c][w], false), hi = __builtin_amdgcn_cvt_pk_f32_fp8((int)R.u[c][w], true);
            oacc[c * 8 + 2 * w] = oacc[c * 8 + 2 * w] + wk2 * lo; oacc[c * 8 + 2 * w + 1] = oacc[c * 8 + 2 * w + 1] + wk2 * hi; }
}
__device__ __forceinline__ void phase_peer_experts(const Params& P, const Ctx& C, int layer, bool last) {
    const unsigned char* TD = P.ws + WS_TAB8 + (size_t)(2 * layer) * TAB8_BYTES; const unsigned char* TU = P.ws + WS_TAB8 + (size_t)(2 * layer + 1) * TAB8_BYTES; bf16* H = (bf16*)(P.ws + WS_H);
    const int* IDX = (const int*)(P.ws + WS_IDX); const float* GATE = (const float*)(P.ws + WS_GATE); const float* MOD = (const float*)(P.ws + WS_MOD);
    const int lane = C.lane, grp = lane >> 4, jl = lane & 15;
    const int gw = C.vcu * NWAVES + C.wave, NGW = C.G * NWAVES;
    for (int tok = gw; tok < T; tok += NGW) {
        const int b = tok >> 13;
        const int i0 = IDX[(size_t)tok * 128 + lane], i1 = IDX[(size_t)tok * 128 + 64 + lane];
        const float g0 = GATE[(size_t)tok * 128 + lane], g1 = GATE[(size_t)tok * 128 + 64 + lane];
        unsigned hf[32];
#pragma unroll
        for (int c = 0; c < 4; ++c) { const bf16* hp = H + (size_t)tok * 1024 + (c * 16 + jl) * 16; const v4u w0 = *(const v4u*)hp, w1 = *(const v4u*)(hp + 8);
#pragma unroll
            for (int e = 0; e < 4; ++e) { hf[c * 8 + e] = w0[e]; hf[c * 8 + 4 + e] = w1[e]; } }
        f32x2 oacc[32];
#pragma unroll
        for (int e = 0; e < 32; ++e) oacc[e] = (f32x2){0.f, 0.f};
        ExpRow RA, RB;
        exp_issue(RA, TD, TU, __shfl(i0, grp), __shfl(g0, grp), jl);
        for (int it = 0; it < 32 * EXP_REP; it += 2) {
            { const int kk = ((it + 1) & 31) * 4 + grp; const int el = __shfl(i0, kk & 63), eh = __shfl(i1, kk & 63); const float gl = __shfl(g0, kk & 63), gh = __shfl(g1, kk & 63);
              exp_issue(RB, TD, TU, kk < 64 ? el : eh, kk < 64 ? gl : gh, jl); }
            exp_consume(RA, hf, oacc);
            { const int kk = ((it + 2) & 31) * 4 + grp; const int el = __shfl(i0, kk & 63), eh = __shfl(i1, kk & 63); const float gl = __shfl(g0, kk & 63), gh = __shfl(g1, kk & 63);
              exp_issue(RA, TD, TU, kk < 64 ? el : eh, kk < 64 ? gl : gh, jl); }
            exp_consume(RB, hf, oacc);
        }
        f32x2 h1[16];
        { const bool up = (grp & 2) != 0;
#pragma unroll
          for (int e = 0; e < 16; ++e) { const f32x2 keep = up ? oacc[16 + e] : oacc[e], send = up ? oacc[e] : oacc[16 + e]; h1[e] = keep + (f32x2){__shfl_xor(send.x, 32), __shfl_xor(send.y, 32)}; } }
        f32x2 h2[8];
        { const bool up = (grp & 1) != 0;
#pragma unroll
          for (int e = 0; e < 8; ++e) { const f32x2 keep = up ? h1[8 + e] : h1[e], send = up ? h1[e] : h1[8 + e]; h2[e] = keep + (f32x2){__shfl_xor(send.x, 16), __shfl_xor(send.y, 16)}; } }
        const int d0 = (grp * 16 + jl) * 16;
        const float* g2p = MOD + (size_t)(layer * 8 + b) * 6144 + 5120 + d0; const float psc = ((ABL_ON >= (layer == 0 ? 2 : 4)) ? 1.f : 0.f) * (1.0f / EXP_REP);
        float* xp = P.out + (size_t)tok * 1024 + d0;
        float xn[16]; float ss = 0.f;
#pragma unroll
        for (int q = 0; q < 4; ++q) { const f32x4 xa = *(const f32x4*)(xp + 4 * q), ga = *(const f32x4*)(g2p + 4 * q);
            xn[4 * q] = xa[0] + psc * ga[0] * h2[2 * q].x; xn[4 * q + 1] = xa[1] + psc * ga[1] * h2[2 * q].y; xn[4 * q + 2] = xa[2] + psc * ga[2] * h2[2 * q + 1].x; xn[4 * q + 3] = xa[3] + psc * ga[3] * h2[2 * q + 1].y; }
#pragma unroll
        for (int e = 0; e < 16; ++e) ss += xn[e] * xn[e];
        const float rstd = 1.0f / sqrtf(wave_sum(ss) * (1.0f / 1024.0f) + NORM_EPS);
        if (!last) {
            const float* ng = P.norm_mix_g + (layer + 1) * 1024 + d0; const float* mb = MOD + (size_t)((layer + 1) * 8 + b) * 6144 + d0;
            unsigned w[8];
#pragma unroll
            for (int q = 0; q < 4; ++q) { *(f32x4*)(xp + 4 * q) = (f32x4){xn[4 * q], xn[4 * q + 1], xn[4 * q + 2], xn[4 * q + 3]}; }
#pragma unroll
            for (int e = 0; e < 8; ++e) w[e] = pk2(xn[2 * e] * rstd * ng[2 * e] * (1.0f + mb[1024 + 2 * e]) + mb[2 * e], xn[2 * e + 1] * rstd * ng[2 * e + 1] * (1.0f + mb[1024 + 2 * e + 1]) + mb[2 * e + 1]);
            v4u* hp = (v4u*)(H + (size_t)tok * 1024 + d0); hp[0] = (v4u){w[0], w[1], w[2], w[3]}; hp[1] = (v4u){w[4], w[5], w[6], w[7]};
        } else {
            const float* fg = P.final_norm_g + d0;
#pragma unroll
            for (int q = 0; q < 4; ++q) *(f32x4*)(xp + 4 * q) = (f32x4){xn[4 * q] * rstd * fg[4 * q], xn[4 * q + 1] * rstd * fg[4 * q + 1], xn[4 * q + 2] * rstd * fg[4 * q + 2], xn[4 * q + 3] * rstd * fg[4 * q + 3]};
        }
    }
}
#ifndef NAIVE_TOPK
#define NAIVE_TOPK 0
#endif
#ifndef NAIVE_EXPERTS
#define NAIVE_EXPERTS 0
#endif
__device__ __forceinline__ void phase_peer_topk_naive(const Params& P, const Ctx& C, int layer) {
    LAS float* SC = (LAS float*)C.lds;
    const float* sk = P.peer_sub_keys + (size_t)layer * 32768; const bf16* QP = (const bf16*)(P.ws + WS_QP);
    int* IDX = (int*)(P.ws + WS_IDX); float* GATE = (float*)(P.ws + WS_GATE);
    for (int base = C.vcu * 64; base < T * 8; base += C.G * 64) {
        __syncthreads();
        { const int tl = C.tid & 63, part = C.tid >> 6; const size_t task = (size_t)base + tl;
          for (int col = part * 32; col < part * 32 + 32; ++col) { const int half = col >> 7, n = col & 127; float acc = 0.f;
              for (int c = 0; c < 128; ++c) acc += bf2f(QP[task * 256 + half * 128 + c]) * sk[(half * 128 + n) * 128 + c];
              SC[tl * 257 + col] = acc; } }
        __syncthreads();
        if (C.tid < 64) { const int tl = C.tid; const size_t task = (size_t)base + tl; LAS float* s = SC + tl * 257;
            float v1[16], v2[16]; int i1[16], i2[16];
            for (int k = 0; k < 16; ++k) { float best = -3e38f; int bi = 0; for (int n = 0; n < 128; ++n) { const float x = s[n]; if (x > best) { best = x; bi = n; } } v1[k] = best; i1[k] = bi; s[bi] = -3.1e38f; }
            for (int k = 0; k < 16; ++k) { float best = -3e38f; int bi = 0; for (int n = 0; n < 128; ++n) { const float x = s[128 + n]; if (x > best) { best = x; bi = n; } } v2[k] = best; i2[k] = bi; s[128 + bi] = -3.1e38f; }
            for (int a = 0; a < 16; ++a) for (int b2 = 0; b2 < 16; ++b2) s[a * 16 + b2] = v1[a] + v2[b2];
            float ts[16]; int ti[16];
            for (int k = 0; k < 16; ++k) { float best = -3e38f; int bi = 0; for (int n = 0; n < 256; ++n) { const float x = s[n]; if (x > best) { best = x; bi = n; } } ts[k] = best; ti[k] = bi; s[bi] = -3.1e38f; }
            float den = 0.f; float ev[16];
            for (int k = 0; k < 16; ++k) { ev[k] = expf(ts[k] - ts[0]); den += ev[k]; }
            for (int k = 0; k < 16; ++k) { int a = ti[k] >> 4, b2 = ti[k] & 15; int e1 = 0, e2 = 0;
                for (int z = 0; z < 16; ++z) { if (z == a) e1 = i1[z]; if (z == b2) e2 = i2[z]; }
                IDX[task * 16 + k] = e1 * 128 + e2; GATE[task * 16 + k] = ev[k] / den; }
        }
    }
    __syncthreads();
}
__device__ __forceinline__ void phase_peer_experts_naive(const Params& P, const Ctx& C, int layer, bool last) {
    bf16* H = (bf16*)(P.ws + WS_H); const int* IDX = (const int*)(P.ws + WS_IDX); const float* GATE = (const float*)(P.ws + WS_GATE); const float* MOD = (const float*)(P.ws + WS_MOD);
    const float* TD = P.peer_down + (size_t)layer * 16384 * 1024; const float* TU = P.peer_up + (size_t)layer * 16384 * 1024;
    const int lane = C.lane; const int gw = C.vcu * NWAVES + C.wave, NGW = C.G * NWAVES;
    for (int tok = gw; tok < T; tok += NGW) {
        const int b = tok >> 13; float hv[16], oa[16];
#pragma unroll
        for (int j = 0; j < 16; ++j) { hv[j] = bf2f(H[(size_t)tok * 1024 + j * 64 + lane]); oa[j] = 0.f; }
        for (int k = 0; k < 128; ++k) { const int e = IDX[(size_t)tok * 128 + k]; const float gk = GATE[(size_t)tok * 128 + k];
            float p = 0.f;
#pragma unroll
            for (int j = 0; j < 16; ++j) p += hv[j] * TD[(size_t)e * 1024 + j * 64 + lane];
            const float a = wave_sum(p); const float wk = gk * gelu_f(a);
#pragma unroll
            for (int j = 0; j < 16; ++j) oa[j] += wk * TU[(size_t)e * 1024 + j * 64 + lane]; }
        const float* g2p = MOD + (size_t)(layer * 8 + b) * 6144 + 5120; const float psc = (ABL_ON >= (layer == 0 ? 2 : 4)) ? 1.f : 0.f;
        float xn[16]; float ss = 0.f;
#pragma unroll
        for (int j = 0; j < 16; ++j) { const int d = j * 64 + lane; xn[j] = P.out[(size_t)tok * 1024 + d] + psc * g2p[d] * oa[j]; ss += xn[j] * xn[j]; }
        const float rstd = 1.0f / sqrtf(wave_sum(ss) * (1.0f / 1024.0f) + NORM_EPS);
        if (!last) { const float* ng = P.norm_mix_g + (layer + 1) * 1024; const float* mb = MOD + (size_t)((layer + 1) * 8 + b) * 6144;
#pragma unroll
            for (int j = 0; j < 16; ++j) { const int d = j * 64 + lane; P.out[(size_t)tok * 1024 + d] = xn[j]; H[(size_t)tok * 1024 + d] = (bf16)f2bf(xn[j] * rstd * ng[d] * (1.0f + mb[1024 + d]) + mb[d]); }
        } else {
#pragma unroll
            for (int j = 0; j < 16; ++j) { const int d = j * 64 + lane; P.out[(size_t)tok * 1024 + d] = xn[j] * rstd * P.final_norm_g[d]; } }
    }
}
constexpr int N_PHASES = 18;
#ifndef MK_ONE_LAUNCH
#define MK_ONE_LAUNCH 1
#endif
__global__ void __launch_bounds__(NWAVES * 64, 2) hybrid_fwd(Params P) {
    extern __shared__ __attribute__((aligned(16))) unsigned char lds_raw[];
    Ctx C;
    C.lds = (LAS unsigned char*)lds_raw;
    C.tid = threadIdx.x; C.lane = C.tid & 63; C.wave = __builtin_amdgcn_readfirstlane(C.tid >> 6);
    C.G = gridDim.x; { const int bx = blockIdx.x; C.vcu = (C.G % 8 == 0) ? (bx % 8) * (C.G / 8) + bx / 8 : bx; }
    volatile LAS unsigned* MISC = (volatile LAS unsigned*)(C.lds + MISC_OFF);
    for (int u = C.tid; u < (LDS_BYTES - LDSCTL_OFF) / 4; u += NWAVES * 64) ((LAS unsigned*)(C.lds + LDSCTL_OFF))[u] = 0u;
    __syncthreads();
    unsigned* ctl = (unsigned*)(P.ws + WS_CTL);
    XcdBarrier bar; bar.bar = ctl + CW_BAR; bar.x = 0; bar.st = nullptr;
    const int lo = P.ph_lo, hi = P.ph_hi;
    if (hi - lo > 1) bar = xcd_barrier_post(ctl + CW_BAR, MISC + 8);
#ifndef PH_MASK
#define PH_MASK 0x3ffff
#endif
#define IN(k) (((PH_MASK >> (k)) & 1) && lo <= (k) && (k) < hi)
#define SEAM(k) do { if (IN(k) && IN((k) + 1)) xcd_barrier(bar); } while (0)
    unsigned char* ws = P.ws;
    float* MOD = (float*)(ws + WS_MOD); bf16* H = (bf16*)(ws + WS_H);

    if (IN(0)) { phase_prologue(P, C); } SEAM(0);
    if (IN(1)) { phase_norm(P, C, P.x, P.norm_mix_g, 0, 0); } SEAM(1);
    if (IN(2)) { pg8::Gemm g{H, (const bf16*)(ws + WS_WIN), T, 3072, 1024}; pg8::StaticOrder S; S.init(T, 3072, C.G, (int)blockIdx.x);
        EpiInProj E{(bf16*)(ws + WS_PU), (bf16*)(ws + WS_PV), (bf16*)(ws + WS_PQ), (bf16*)(ws + WS_PI), (bf16*)(ws + WS_PG), (float*)(ws + WS_G), (const float*)(ws + WS_LB)};
        pg8::gemm_phase<EpiInProj, pg8::StaticOrder, true, true>(C.lds, g, S, E); } SEAM(2);
    if (IN(3)) { for (int it = C.vcu; it < 2048; it += C.G) gmlp_item(P, C, it >> 2, it & 3);
                 for (int it = C.vcu; it < 4096; it += C.G) hgrn_local_item(P, C, it); } SEAM(3);
    if (IN(4)) { phase_hgrn_scan(P, C); } SEAM(4);
    if (IN(5)) { for (int it = C.vcu; it < 4096; it += C.G) hgrn_out_item(P, C, it); } SEAM(5);
    if (IN(6)) { pg8::Gemm g{H, (const bf16*)(ws + WS_WOUT0), T, 1024, 1024}; pg8::StaticOrder S; S.init(T, 1024, C.G, (int)blockIdx.x);
        EpiResid E{P.x, P.out, MOD + 2048, ABL_ON >= 1 ? 1.f : 0.f};
        pg8::gemm_phase<EpiResid, pg8::StaticOrder, true, true>(C.lds, g, S, E); } SEAM(6);
    if (IN(7)) { phase_norm(P, C, P.out, P.norm_ffn_g, 0, 3072); } SEAM(7);
    if (IN(8)) { pg8::Gemm g{H, (const bf16*)(ws + WS_WQ0), T, 2048, 1024}; pg8::StaticOrder S; S.init(T, 2048, C.G, (int)blockIdx.x);
        EpiBf16P E{(bf16*)(ws + WS_QP), 2048};
        pg8::gemm_phase<EpiBf16P, pg8::StaticOrder, true, true>(C.lds, g, S, E); } SEAM(8);
    if (IN(9)) { if (NAIVE_TOPK) phase_peer_topk_naive(P, C, 0); else phase_peer_topk(P, C, 0); } SEAM(9);
    if (IN(10)) { if (NAIVE_EXPERTS) phase_peer_experts_naive(P, C, 0, false); else phase_peer_experts(P, C, 0, false); } SEAM(10);
    if (IN(11)) {
        { pg8::Gemm g{H, (const bf16*)(ws + WS_WQKV), T, 2048, 1024}; pg8::StaticOrder S; S.init(T, 2048, C.G, (int)blockIdx.x);
          EpiQKRot E{(bf16*)(ws + WS_QK), (const float*)(ws + WS_CS)};
          pg8::gemm_phase<EpiQKRot, pg8::StaticOrder, true, true>(C.lds, g, S, E); }
        __syncthreads();
        { pg8::Gemm g{(const bf16*)(ws + WS_WQKV) + (size_t)2048 * 1024, H, 1024, T, 1024}; pg8::StaticOrder S; S.init(1024, T, C.G, (int)blockIdx.x);
          EpiBf16P E{(bf16*)(ws + WS_VT), (size_t)T};
          pg8::gemm_phase<EpiBf16P, pg8::StaticOrder, true, true>(C.lds, g, S, E); } } SEAM(11);
    if (IN(12)) { for (int rep = 0; rep < ATT_REP; ++rep) for (int it = C.vcu; it < NB * 16 * 32; it += C.G) attn_item(P, C, it >> 9, (it >> 5) & 15, it & 31); } SEAM(12);
    if (IN(13)) { pg8::Gemm g{H, (const bf16*)(ws + WS_WOUT1), T, 1024, 1024}; pg8::StaticOrder S; S.init(T, 1024, C.G, (int)blockIdx.x);
        EpiResid E{P.out, P.out, MOD + (size_t)8 * 6144 + 2048, ABL_ON >= 3 ? 1.f : 0.f};
        pg8::gemm_phase<EpiResid, pg8::StaticOrder, true, true>(C.lds, g, S, E); } SEAM(13);
    if (IN(14)) { phase_norm(P, C, P.out, P.norm_ffn_g + 1024, 1, 3072); } SEAM(14);
    if (IN(15)) { pg8::Gemm g{H, (const bf16*)(ws + WS_WQ1), T, 2048, 1024}; pg8::StaticOrder S; S.init(T, 2048, C.G, (int)blockIdx.x);
        EpiBf16P E{(bf16*)(ws + WS_QP), 2048};
        pg8::gemm_phase<EpiBf16P, pg8::StaticOrder, true, true>(C.lds, g, S, E); } SEAM(15);
    if (IN(16)) { if (NAIVE_TOPK) phase_peer_topk_naive(P, C, 1); else phase_peer_topk(P, C, 1); } SEAM(16);
    if (IN(17)) { if (NAIVE_EXPERTS) phase_peer_experts_naive(P, C, 1, true); else phase_peer_experts(P, C, 1, true); }
#undef IN
#undef SEAM
}

extern "C" void kernel_launch(void* const* d_in, const int* in_sizes, int n_in, void* d_out, int out_size, void* d_ws, size_t ws_size, hipStream_t stream) {
    static int grid = 0;
    if (grid == 0) {
        if (n_in != 22 || in_sizes[0] != T * DM || out_size != T * DM || ws_size < WS_END) {
            fprintf(stderr, "kernel_launch: unexpected shapes (n_in %d, in0 %d, out %d, ws %zu); nothing launched\n", n_in, n_in > 0 ? in_sizes[0] : -1, out_size, ws_size); grid = -1; return; }
        int dev = 0, cus = 0;
        if (hipGetDevice(&dev) != hipSuccess || hipDeviceGetAttribute(&cus, hipDeviceAttributeMultiprocessorCount, dev) != hipSuccess) { fprintf(stderr, "kernel_launch: device query failed\n"); grid = -1; return; }
        if (hipFuncSetAttribute((const void*)hybrid_fwd, hipFuncAttributeMaxDynamicSharedMemorySize, LDS_BYTES) != hipSuccess) { fprintf(stderr, "kernel_launch: hipFuncSetAttribute failed\n"); grid = -1; return; }
        (void)hipGetLastError();
        grid = cus;
    }
    if (grid < 0) return;
    if (hipMemsetAsync((char*)d_ws + WS_CTL, 0, CTL_ZERO_BYTES, stream) != hipSuccess) { fprintf(stderr, "kernel_launch: memset failed\n"); return; }
    Params p{};
    p.x = (const float*)d_in[0]; p.c = (const float*)d_in[1]; p.positions = (const int*)d_in[2]; p.ada_w = (const float*)d_in[3]; p.ada_b = (const float*)d_in[4];
    p.norm_mix_g = (const float*)d_in[5]; p.norm_ffn_g = (const float*)d_in[6]; p.final_norm_g = (const float*)d_in[7]; p.even_w_in = (const float*)d_in[8]; p.even_w_out = (const float*)d_in[9];
    p.gmlp_ln_g = (const float*)d_in[10]; p.gmlp_ln_b = (const float*)d_in[11]; p.gmlp_w_s = (const float*)d_in[12]; p.gmlp_b_s = (const float*)d_in[13]; p.hgrn_lb_logits = (const float*)d_in[14];
    p.hgrn_norm_g = (const float*)d_in[15]; p.odd_w_qkv = (const float*)d_in[16]; p.odd_w_out = (const float*)d_in[17]; p.peer_w_query = (const float*)d_in[18]; p.peer_sub_keys = (const float*)d_in[19];
    p.peer_down = (const float*)d_in[20]; p.peer_up = (const float*)d_in[21];
    p.out = (float*)d_out; p.ws = (unsigned char*)d_ws;
#if MK_ONE_LAUNCH
    p.ph_lo = 0; p.ph_hi = N_PHASES;
    hipLaunchKernelGGL(hybrid_fwd, dim3(grid), dim3(NWAVES * 64), LDS_BYTES, stream, p);
#else
    for (int ph = 0; ph < N_PHASES; ++ph) { p.ph_lo = ph; p.ph_hi = ph + 1; hipLaunchKernelGGL(hybrid_fwd, dim3(grid), dim3(NWAVES * 64), LDS_BYTES, stream, p); }
#endif
    const hipError_t le = hipPeekAtLastError();
    if (le != hipSuccess) fprintf(stderr, "kernel_launch: launch failed: %s\n", hipGetErrorName(le));
}
```

```cpp
#include <hip/hip_runtime.h>
#include <cstdio>
#include <cstdint>
#include <cmath>
namespace pg8 {
#define PG8_LAS __attribute__((address_space(3)))
typedef unsigned short bf16_t;
typedef short bf16x8 __attribute__((ext_vector_type(8)));
typedef float f32x4 __attribute__((ext_vector_type(4)));
typedef unsigned u32x4 __attribute__((ext_vector_type(4)));
constexpr int BM = 256, BK = 64, HALF = 128, HTB = HALF * BK * 2  , STAGE_BYTES = 8 * HTB, NXCD = 8, WGM = 8;

__host__ __device__ __forceinline__ int lds_byte(int r, int c) { const int st = (r >> 4) * 2 + (c >> 5), rr = r & 15, cc = c & 31, ob = rr * 64 + cc * 2; return st * 1024 + (ob ^ (((ob >> 9) & 1) << 5)); }
__host__ __device__ __forceinline__ void stage_rc(int b, int& R, int& C) { const int st = b / 1024, sb = b % 1024, swz = sb ^ (((sb >> 9) & 1) << 5); R = (st >> 1) * 16 + swz / 64; C = (st & 1) * 32 + (swz % 64) / 2; }
__host__ __device__ __forceinline__ int perm32(int rho) { const int n = rho >> 4, i = rho & 15; return 8 * (i >> 2) + 4 * n + (i & 3); }

struct Unit { int pm, pn; };
struct Gemm { const bf16_t* A; const bf16_t* Bt; int M, N, K; };

struct StaticOrder {
    int nM, nN, nwg, G, c;
    __host__ __device__ void init(int M, int N, int G_, int c_) { nM = M / BM; nN = N / BM; nwg = nM * nN; G = G_; c = c_; }
    __host__ __device__ bool next(int i, Unit& u) const {
        const long L = (long)i * G + c; if (L >= nwg) return false;
        int wgid = (int)L; { const int q = nwg / NXCD, r = nwg % NXCD, xcd = wgid % NXCD, off = wgid / NXCD; wgid = (xcd < r ? xcd * (q + 1) : r * (q + 1) + (xcd - r) * q) + off; }
        const int nig = WGM * nN, gid = wgid / nig, fm = gid * WGM, gsz = (nM - fm) < WGM ? (nM - fm) : WGM;
        u.pm = fm + ((wgid % nig) % gsz); u.pn = (wgid % nig) / gsz; return true;
    }
    __device__ __forceinline__ void a_ready(const Unit&) const {}
    __device__ __forceinline__ void done(const Unit&) const {}
};

__device__ __forceinline__ unsigned cvt_pk_bf16(float lo, float hi) { unsigned r; asm volatile("v_cvt_pk_bf16_f32 %0, %1, %2" : "=v"(r) : "v"(lo), "v"(hi)); return r; }
typedef float f32x2 __attribute__((ext_vector_type(2)));
__device__ __forceinline__ f32x2 gelu_pk(f32x2 v) {
    const f32x2 av = __builtin_elementwise_abs(v), d = av * 0.2316418882f + 1.0f;
    f32x2 t; t.x = __builtin_amdgcn_rcpf(d.x); t.y = __builtin_amdgcn_rcpf(d.y);
    f32x2 q = t * 0.5307027145f + (-0.7265760135f); q = q * t + 0.7107068705f; q = q * t + (-0.142248368f); q = q * t + 0.127414796f; q = q * t;
    const f32x2 s = (v * v) * (-0.72134752044f);
    f32x2 e; e.x = __builtin_amdgcn_exp2f(s.x); e.y = __builtin_amdgcn_exp2f(s.y);
    const f32x2 m = v * (q * e), r = v - m;
    f32x2 o; o.x = v.x < 0.f ? m.x : r.x; o.y = v.y < 0.f ? m.y : r.y; return o;
}

template <class Epi, class Sched, bool ALIGN_EPI = false, bool SP2 = false>
__device__ __forceinline__ void gemm_phase(PG8_LAS unsigned char* lds, const Gemm g, const Sched& S, const Epi& E) {
    const int tid = threadIdx.x, wid = __builtin_amdgcn_readfirstlane(tid >> 6), lane = tid & 63, wr = wid >> 2, wc = wid & 3, fr = lane & 15, fq = lane >> 4;
    const int K = g.K, nt = K / BK;
    unsigned voffA[2], voffB[2];
#pragma unroll
    for (int i = 0; i < 2; ++i) { int R, C; stage_rc(tid * 16 + i * 8192, R, C); const int Rb = Epi::PERM ? ((R & ~31) + perm32(R & 31)) : R;
        voffA[i] = (unsigned)(R * K + C) * 2u; voffB[i] = (unsigned)(Rb * K + C) * 2u; }
    const size_t kstep = (size_t)(BK * 2);
    const size_t hstep = (size_t)HALF * K * 2;
    const size_t tstep = 2 * hstep;
    const unsigned ldsw = (unsigned)wid * 1024u;
    const int aoff = lds_byte(wr * 64 + fr, fq * 8), boff = lds_byte(wc * 32 + fr, fq * 8);
#define PG8_SA(b, h) (((b) * 2 + (h)) * HTB)
#define PG8_SB(b, h) ((4 + (b) * 2 + (h)) * HTB)
#define PG8_STAGE(bufoff, gbase, voff) do { _Pragma("unroll") for (int _i = 0; _i < 2; ++_i) \
        __builtin_amdgcn_global_load_lds((const unsigned*)((const char*)(gbase) + (voff)[_i]), (PG8_LAS unsigned*)(lds + (bufoff) + ldsw + _i * 8192), 16, 0, 0); } while (0)
#define PG8_LDA(dst, b, h) do { _Pragma("unroll") for (int m = 0; m < 4; ++m) _Pragma("unroll") for (int k = 0; k < 2; ++k) dst[m][k] = *(const PG8_LAS bf16x8*)(lds + PG8_SA(b, h) + aoff + m * 2048 + k * 1024); } while (0)
#define PG8_LDB(dst, b, h) do { _Pragma("unroll") for (int n = 0; n < 2; ++n) _Pragma("unroll") for (int k = 0; k < 2; ++k) dst[n][k] = *(const PG8_LAS bf16x8*)(lds + PG8_SB(b, h) + boff + n * 2048 + k * 1024); } while (0)
#define PG8_MMA(ai, bj, At, Bt) do { __builtin_amdgcn_s_setprio(1); _Pragma("unroll") for (int m = 0; m < 4; ++m) _Pragma("unroll") for (int n = 0; n < 2; ++n) _Pragma("unroll") for (int k = 0; k < 2; ++k) \
        acc[ai][bj][m][n] = __builtin_amdgcn_mfma_f32_16x16x32_bf16(Bt[n][k], At[m][k], acc[ai][bj][m][n], 0, 0, 0); __builtin_amdgcn_s_setprio(0); } while (0)
#define PG8_WAIT_V(n) asm volatile("s_waitcnt vmcnt(" #n ")" ::: "memory")
#define PG8_WAIT_L(n) asm volatile("s_waitcnt lgkmcnt(" #n ")" ::: "memory")
#define PG8_BAR __builtin_amdgcn_s_barrier()
#define PG8_SCHED __builtin_amdgcn_sched_barrier(0)
    Unit cur, nxt; int ui = 0;
    if (!S.next(0, cur)) return;
    f32x4 acc[2][2][4][2];
#pragma unroll
    for (int a = 0; a < 2; ++a)
#pragma unroll
        for (int b = 0; b < 2; ++b)
#pragma unroll
            for (int m = 0; m < 4; ++m)
#pragma unroll
                for (int n = 0; n < 2; ++n) acc[a][b][m][n] = (f32x4){0.f, 0.f, 0.f, 0.f};
    bf16x8 At[4][2], B0[2][2], B1[2][2];
    const char* cA = (const char*)g.A + (size_t)cur.pm * tstep; const char* cB = (const char*)g.Bt + (size_t)cur.pn * tstep;
    S.a_ready(cur);
    if constexpr (SP2) {
        PG8_STAGE(PG8_SB(0, 0), cB, voffB); PG8_STAGE(PG8_SB(0, 1), cB + hstep, voffB); PG8_STAGE(PG8_SA(0, 0), cA, voffA); PG8_STAGE(PG8_SA(0, 1), cA + hstep, voffA);
        if (wr == 1) PG8_BAR;
        PG8_WAIT_V(2); PG8_BAR;
        PG8_STAGE(PG8_SB(1, 0), cB + kstep, voffB); PG8_STAGE(PG8_SA(1, 0), cA + kstep, voffA); PG8_STAGE(PG8_SB(1, 1), cB + hstep + kstep, voffB);
        PG8_WAIT_V(6); PG8_BAR;
    } else {
        PG8_STAGE(PG8_SB(0, 0), cB, voffB); PG8_STAGE(PG8_SA(0, 0), cA, voffA); PG8_STAGE(PG8_SB(0, 1), cB + hstep, voffB); PG8_STAGE(PG8_SA(0, 1), cA + hstep, voffA);
        if (wr == 1) PG8_BAR;
        PG8_WAIT_V(4); PG8_BAR;
        PG8_STAGE(PG8_SB(1, 0), cB + kstep, voffB); PG8_STAGE(PG8_SA(1, 0), cA + kstep, voffA); PG8_STAGE(PG8_SB(1, 1), cB + hstep + kstep, voffB);
        PG8_WAIT_V(6); PG8_BAR;
    }
    for (;;) {
        const bool has_next = S.next(ui + 1, nxt);
        const char* nA = has_next ? (const char*)g.A + (size_t)nxt.pm * tstep : cA; const char* nB = has_next ? (const char*)g.Bt + (size_t)nxt.pn * tstep : cB;
        for (int t = 0; t < nt; t += 2) {
            const bool last = (t == nt - 2);
            const char* a1 = cA + (size_t)(t + 1) * kstep;
            const char* a2 = last ? nA : cA + (size_t)(t + 2) * kstep; const char* b2 = last ? nB : cB + (size_t)(t + 2) * kstep;
            const char* a3 = a2 + kstep; const char* b3 = b2 + kstep;
            if (last && has_next) S.a_ready(nxt);
            if constexpr (SP2) {
            PG8_LDB(B0, 0, 0); PG8_LDB(B1, 0, 1); PG8_SCHED; PG8_LDA(At, 0, 0); PG8_STAGE(PG8_SA(1, 1), a1 + hstep, voffA);
            PG8_WAIT_V(8); PG8_WAIT_L(0); PG8_BAR; PG8_MMA(0, 0, At, B0); PG8_MMA(0, 1, At, B1); PG8_BAR; PG8_SCHED;
            PG8_LDA(At, 0, 1); PG8_STAGE(PG8_SB(0, 0), b2, voffB); PG8_STAGE(PG8_SB(0, 1), b2 + hstep, voffB); PG8_STAGE(PG8_SA(0, 0), a2, voffA);
            PG8_WAIT_V(8); PG8_WAIT_L(0); PG8_BAR; PG8_MMA(1, 0, At, B0); PG8_MMA(1, 1, At, B1); PG8_BAR; PG8_SCHED;
            PG8_LDB(B0, 1, 0); PG8_LDB(B1, 1, 1); PG8_SCHED; PG8_LDA(At, 1, 0); PG8_STAGE(PG8_SA(0, 1), a2 + hstep, voffA);
            PG8_WAIT_V(8); PG8_WAIT_L(0); PG8_BAR; PG8_MMA(0, 0, At, B0); PG8_MMA(0, 1, At, B1); PG8_BAR; PG8_SCHED;
            PG8_LDA(At, 1, 1); PG8_STAGE(PG8_SB(1, 0), b3, voffB); PG8_STAGE(PG8_SB(1, 1), b3 + hstep, voffB); PG8_STAGE(PG8_SA(1, 0), a3, voffA);
            PG8_WAIT_V(8); PG8_WAIT_L(0); PG8_BAR; PG8_MMA(1, 0, At, B0); PG8_MMA(1, 1, At, B1); PG8_BAR; PG8_SCHED;
            } else {
            PG8_LDB(B0, 0, 0); PG8_SCHED; PG8_LDA(At, 0, 0); PG8_STAGE(PG8_SA(1, 1), a1 + hstep, voffA);
            PG8_WAIT_L(8); PG8_BAR; PG8_WAIT_L(0); PG8_MMA(0, 0, At, B0); PG8_BAR; PG8_SCHED;
            PG8_LDB(B1, 0, 1); PG8_STAGE(PG8_SB(0, 0), b2, voffB);
            PG8_BAR; PG8_WAIT_L(0); PG8_MMA(0, 1, At, B1); PG8_BAR;
            PG8_LDA(At, 0, 1); PG8_STAGE(PG8_SA(0, 0), a2, voffA);
            PG8_BAR; PG8_WAIT_L(0); PG8_MMA(1, 0, At, B0); PG8_BAR; PG8_SCHED;
            PG8_STAGE(PG8_SB(0, 1), b2 + hstep, voffB);
            PG8_WAIT_V(6); PG8_BAR; PG8_MMA(1, 1, At, B1); PG8_BAR;
            PG8_LDB(B0, 1, 0); PG8_SCHED; PG8_LDA(At, 1, 0); PG8_STAGE(PG8_SA(0, 1), a2 + hstep, voffA);
            PG8_WAIT_L(8); PG8_BAR; PG8_WAIT_L(0); PG8_MMA(0, 0, At, B0); PG8_BAR; PG8_SCHED;
            PG8_LDB(B1, 1, 1); PG8_STAGE(PG8_SB(1, 0), b3, voffB);
            PG8_BAR; PG8_WAIT_L(0); PG8_MMA(0, 1, At, B1); PG8_BAR;
            PG8_LDA(At, 1, 1); PG8_STAGE(PG8_SA(1, 0), a3, voffA);
            PG8_BAR; PG8_WAIT_L(0); PG8_MMA(1, 0, At, B0); PG8_BAR; PG8_SCHED;
            PG8_STAGE(PG8_SB(1, 1), b3 + hstep, voffB);
            PG8_WAIT_V(6); PG8_BAR; PG8_MMA(1, 1, At, B1); PG8_BAR;
            }
        }
        if constexpr (ALIGN_EPI) { if (wr == 0) PG8_BAR; }
        if constexpr (!Epi::AFTER_DRAIN) { E(acc, cur, wr, wc, fr, fq); S.done(cur); }
        if (!has_next) break;
#pragma unroll
        for (int a = 0; a < 2; ++a)
#pragma unroll
            for (int b = 0; b < 2; ++b)
#pragma unroll
                for (int m = 0; m < 4; ++m)
#pragma unroll
                    for (int n = 0; n < 2; ++n) acc[a][b][m][n] = (f32x4){0.f, 0.f, 0.f, 0.f};
        cur = nxt; cA = nA; cB = nB; ++ui;
        if constexpr (ALIGN_EPI) { if (wr == 1) PG8_BAR; }
    }
    PG8_WAIT_V(0);
    if constexpr (!ALIGN_EPI) { if (wr == 0) PG8_BAR; }
    PG8_BAR;
    if constexpr (Epi::AFTER_DRAIN) { E.fused(acc, cur, wr, wc, fr, fq, lds, wid, lane); S.done(cur); }
#undef PG8_SA
#undef PG8_SB
#undef PG8_STAGE
#undef PG8_LDA
#undef PG8_LDB
#undef PG8_MMA
#undef PG8_WAIT_V
#undef PG8_WAIT_L
#undef PG8_BAR
#undef PG8_SCHED
}
}
#define GAS __attribute__((address_space(1)))
#define LAS __attribute__((address_space(3)))
typedef unsigned short bf16;
typedef unsigned v4u __attribute__((ext_vector_type(4)));
typedef float f32x4 __attribute__((ext_vector_type(4)));
typedef short bf16x8 __attribute__((ext_vector_type(8)));
typedef __bf16 bf16x2_t __attribute__((ext_vector_type(2)));
#define LDS_WAIT() asm volatile("s_waitcnt lgkmcnt(0)" ::: "memory")
#define VM_WAIT() asm volatile("s_waitcnt vmcnt(0)" ::: "memory")
__device__ __forceinline__ unsigned f2bf(float f) { unsigned u = __builtin_bit_cast(unsigned, f); return (u + 0x7fffu + ((u >> 16) & 1u)) >> 16; }
__device__ __forceinline__ unsigned pk2(float lo, float hi) { return f2bf(lo) | (f2bf(hi) << 16); }
__device__ __forceinline__ float bflo(unsigned u) { return __builtin_bit_cast(float, u << 16); }
__device__ __forceinline__ float bfhi(unsigned u) { return __builtin_bit_cast(float, u & 0xffff0000u); }
__device__ __forceinline__ float bf2f(bf16 u) { return __builtin_bit_cast(float, (unsigned)u << 16); }
#define XB_TMO      128
#define XB_XCNT(j)  (256  + 64 * (j))
#define XB_XSUB(j)  (1280 + 64 * (j))
#define XB_XGEN(j)  (2304 + 64 * (j))
#define XB_TOP      3328
#define XB_TOPGEN   3392
#define XCD_BAR_WORDS 3456
#define XB_SPIN_CAP (1u << 18)

__device__ __forceinline__ unsigned xb_ld(unsigned* p)              { return __hip_atomic_load(p, __ATOMIC_RELAXED, __HIP_MEMORY_SCOPE_AGENT); }
__device__ __forceinline__ unsigned xb_add(unsigned* p, unsigned v) { return __hip_atomic_fetch_add(p, v, __ATOMIC_RELAXED, __HIP_MEMORY_SCOPE_AGENT); }
__device__ __forceinline__ unsigned xb_xcc_id() { return (unsigned)__builtin_amdgcn_s_getreg((3 << 11) | 20) & 0xFu; }
#define XB_SPIN(cond, bar) do { unsigned _sp = 0; while (cond) { __builtin_amdgcn_s_sleep(1); \
    if ((++_sp & 255u) == 0u) { if (xb_ld(&(bar)[XB_TMO])) break; if (_sp > XB_SPIN_CAP) { atomicAdd(&(bar)[XB_TMO], 1u); break; } } } } while (0)

struct XcdBarrier {
    unsigned* bar; unsigned x;
    volatile LAS unsigned* st;
};

__device__ __forceinline__ XcdBarrier xcd_barrier_post(unsigned* bar, volatile LAS unsigned* st) {
    XcdBarrier b; b.bar = bar; b.x = xb_xcc_id(); b.st = st;
    if (threadIdx.x == 0) (void)xb_add(&bar[XB_XCNT(b.x)], 1u);
    return b;
}
__device__ __forceinline__ void xcd_barrier_complete(unsigned* bar, unsigned x, unsigned& nloc, unsigned& nx) {
    const unsigned G = gridDim.x * gridDim.y * gridDim.z;
    unsigned sum, cnt, mine, sp = 0u;
    for (;;) {
        sum = 0u; cnt = 0u; mine = 0u;
#pragma unroll
        for (unsigned j = 0; j < 16; ++j) { const unsigned c = xb_ld(&bar[XB_XCNT(j)]); sum += c; cnt += (c > 0u) ? 1u : 0u; mine = (j == x) ? c : mine; }
        if (sum == G) break;
        __builtin_amdgcn_s_sleep(1);
        if ((++sp & 255u) == 0u) { if (xb_ld(&bar[XB_TMO])) break; if (sp > XB_SPIN_CAP) { atomicAdd(&bar[XB_TMO], 1u); break; } }
    }
    nloc = mine > 0u ? mine : 1u; nx = cnt > 0u ? cnt : 1u;
}

__device__ __forceinline__ void xcd_barrier(const XcdBarrier& b) {
    asm volatile("s_waitcnt vmcnt(0)" ::: "memory");
    __syncthreads();
    if (threadIdx.x == 0) {
        unsigned* bar = b.bar;
        __builtin_amdgcn_s_waitcnt(0);
        unsigned nloc = b.st[0], nx = b.st[1];
        if (nloc == 0u) { xcd_barrier_complete(bar, b.x, nloc, nx); b.st[0] = nloc; b.st[1] = nx; }
        const unsigned old = xb_add(&bar[XB_XSUB(b.x)], 1u);
        const unsigned gen = old / nloc;
        if (old + 1u == (gen + 1u) * nloc) {
            __builtin_amdgcn_fence(__ATOMIC_RELEASE, "agent");
            asm volatile("s_waitcnt vmcnt(0)" ::: "memory");
            const unsigned og = xb_add(&bar[XB_TOP], 1u);
            const unsigned tg = og / nx;
            if (og + 1u == (tg + 1u) * nx) xb_add(&bar[XB_TOPGEN], 1u);
            else XB_SPIN(xb_ld(&bar[XB_TOPGEN]) == tg, bar);
            __builtin_amdgcn_fence(__ATOMIC_ACQUIRE, "agent");
            xb_add(&bar[XB_XGEN(b.x)], 1u);
            asm volatile("s_waitcnt vmcnt(0)" ::: "memory");
        } else {
            XB_SPIN(xb_ld(&bar[XB_XGEN(b.x)]) == gen, bar);
            __builtin_amdgcn_fence(__ATOMIC_ACQUIRE, "agent");
            asm volatile("s_waitcnt vmcnt(0)" ::: "memory");
        }
    }
    __syncthreads();
}

constexpr int NB = 8, SEQ = 8192, DM = 1024, T = NB * SEQ;
constexpr int NWAVES = 8;
constexpr float NORM_EPS = 1e-6f;
constexpr float C2 = 0.125f * 1.4426950408889634f;

constexpr size_t MiB = 1u << 20;
constexpr size_t WS_CTL = 0, CTL_ZERO_BYTES = 1 * MiB;
constexpr size_t WS_MOD = 1 * MiB;
constexpr size_t WS_SKB = 1 * MiB + 512 * 1024;
constexpr size_t WS_WSB = 1 * MiB + 768 * 1024;
constexpr size_t WS_LB  = 1 * MiB + 960 * 1024;
constexpr size_t WS_CS  = 2 * MiB;
constexpr size_t WS_HD  = 6 * MiB;
constexpr size_t WS_WIN = 16 * MiB, WS_WOUT0 = 22 * MiB, WS_WQKV = 24 * MiB, WS_WOUT1 = 30 * MiB, WS_WQ0 = 32 * MiB, WS_WQ1 = 36 * MiB;
constexpr size_t WS_TAB8 = 40 * MiB, TAB8_BYTES = 17 * MiB;
constexpr int TROW = 1040;
constexpr size_t WS_H = 108 * MiB;
constexpr size_t WS_BIG = 236 * MiB;
constexpr size_t WS_PU = WS_BIG, WS_PV = WS_BIG + 64 * MiB, WS_PQ = WS_BIG + 128 * MiB, WS_PI = WS_BIG + 192 * MiB, WS_PG = WS_BIG + 256 * MiB;
constexpr size_t WS_G = WS_BIG + 320 * MiB;
constexpr size_t WS_KVT = WS_BIG + 448 * MiB;
constexpr size_t WS_ST = WS_BIG + 576 * MiB;
constexpr size_t WS_QP = WS_BIG;
constexpr size_t WS_IDX = WS_BIG + 256 * MiB, WS_GATE = WS_BIG + 288 * MiB;
constexpr size_t WS_QK = WS_BIG;
constexpr size_t WS_VT = WS_BIG + 256 * MiB;
constexpr size_t WS_END = WS_BIG + 704 * MiB;
constexpr int CW_BAR = 4096;

constexpr int LDS_BYTES = 147456;
constexpr int LDSCTL_OFF = LDS_BYTES - 512;
constexpr int MISC_OFF = LDSCTL_OFF;

struct Params {
    const float* x; const float* c; const int* positions; const float* ada_w; const float* ada_b; const float* norm_mix_g; const float* norm_ffn_g; const float* final_norm_g;
    const float* even_w_in; const float* even_w_out; const float* gmlp_ln_g; const float* gmlp_ln_b; const float* gmlp_w_s; const float* gmlp_b_s; const float* hgrn_lb_logits; const float* hgrn_norm_g;
    const float* odd_w_qkv; const float* odd_w_out; const float* peer_w_query; const float* peer_sub_keys; const float* peer_down; const float* peer_up;
    float* out; unsigned char* ws; int ph_lo, ph_hi;
};
struct Ctx { LAS unsigned char* lds; int tid, lane, wave, vcu, G; };

__device__ __forceinline__ float wave_sum(float v) {
#pragma unroll
    for (int o = 1; o < 64; o <<= 1) v += __shfl_xor(v, o);
    return v;
}
__device__ __forceinline__ float silu_f(float x) { return x * __builtin_amdgcn_rcpf(1.0f + __builtin_amdgcn_exp2f(-1.4426950408889634f * x)); }
__device__ __forceinline__ float sigmoid_f(float x) { return __builtin_amdgcn_rcpf(1.0f + __builtin_amdgcn_exp2f(-1.4426950408889634f * x)); }
__device__ __forceinline__ float gelu_f(float x) { return 0.5f * x * (1.0f + erff(x * 0.70710678118654752f)); }
__device__ __forceinline__ f32x4 mma16(f32x4 acc, const LAS bf16* A, int lda, const LAS bf16* Bt, int ldb, int K, int r, int q4) {
    const LAS bf16* ap = A + r * lda + 8 * q4; const LAS bf16* bp = Bt + r * ldb + 8 * q4;
    for (int k0 = 0; k0 < K; k0 += 32) {
        const bf16x8 a = *(const LAS bf16x8*)(ap + k0); const bf16x8 b = *(const LAS bf16x8*)(bp + k0);
        acc = __builtin_amdgcn_mfma_f32_16x16x32_bf16(a, b, acc, 0, 0, 0);
    }
    return acc;
}

struct EpiBf16P {
    static constexpr bool PERM = true, AFTER_DRAIN = false;
    bf16* O; size_t ldc;
    __device__ __forceinline__ void operator()(const f32x4 (&acc)[2][2][4][2], const pg8::Unit& u, int wr, int wc, int fr, int fq) const {
        const int row0 = u.pm * 256 + wr * 64 + fr, col0 = u.pn * 256 + wc * 32 + 8 * fq;
#pragma unroll
        for (int ai = 0; ai < 2; ++ai)
#pragma unroll
            for (int m = 0; m < 4; ++m) { bf16* rowp = O + (size_t)(row0 + ai * 128 + m * 16) * ldc + col0;
#pragma unroll
                for (int bj = 0; bj < 2; ++bj) { const f32x4 v0 = acc[ai][bj][m][0], v1 = acc[ai][bj][m][1];
                    v4u w; w.x = pg8::cvt_pk_bf16(v0[0], v0[1]); w.y = pg8::cvt_pk_bf16(v0[2], v0[3]); w.z = pg8::cvt_pk_bf16(v1[0], v1[1]); w.w = pg8::cvt_pk_bf16(v1[2], v1[3]);
                    *(v4u*)(rowp + bj * 128) = w; } }
    }
};
#ifndef REP_HG
#define REP_HG 1
#endif
#ifndef REP_TOPK
#define REP_TOPK 1
#endif
#ifndef REP_PRO
#define REP_PRO 1
#endif
#ifndef REP_NORM
#define REP_NORM 1
#endif
#ifndef REP_GEMM
#define REP_GEMM 1
#endif
#ifndef EXP_REP
#define EXP_REP 1
#endif
#ifndef ATT_REP
#define ATT_REP 1
#endif
#ifndef ABL_ON
#define ABL_ON 4
#endif
struct EpiResid {
    static constexpr bool PERM = true, AFTER_DRAIN = false;
    const float* xin; float* xout; const float* gate; float gsc;
    __device__ __forceinline__ void operator()(const f32x4 (&acc)[2][2][4][2], const pg8::Unit& u, int wr, int wc, int fr, int fq) const {
        const int row0 = u.pm * 256 + wr * 64 + fr, col0 = u.pn * 256 + wc * 32 + 8 * fq;
        const float* gp = gate + (size_t)((u.pm * 256) >> 13) * 6144 + col0;
        f32x4 gv[2][2];
#pragma unroll
        for (int bj = 0; bj < 2; ++bj) { gv[bj][0] = *(const f32x4*)(gp + bj * 128); gv[bj][1] = *(const f32x4*)(gp + bj * 128 + 4); }
#pragma unroll
        for (int ai = 0; ai < 2; ++ai)
#pragma unroll
            for (int m = 0; m < 4; ++m) { const size_t off = (size_t)(row0 + ai * 128 + m * 16) * 1024 + col0;
#pragma unroll
                for (int bj = 0; bj < 2; ++bj) {
                    const f32x4 x0 = *(const f32x4*)(xin + off + bj * 128), x1 = *(const f32x4*)(xin + off + bj * 128 + 4);
                    *(f32x4*)(xout + off + bj * 128) = x0 + gv[bj][0] * acc[ai][bj][m][0] * gsc;
                    *(f32x4*)(xout + off + bj * 128 + 4) = x1 + gv[bj][1] * acc[ai][bj][m][1] * gsc; }
                asm volatile("" ::: "memory"); }
    }
};
struct EpiInProj {
    static constexpr bool PERM = true, AFTER_DRAIN = false;
    bf16* PU; bf16* PV; bf16* PQ; bf16* PI; bf16* PG; float* G; const float* LB;
    __device__ __forceinline__ void operator()(const f32x4 (&acc)[2][2][4][2], const pg8::Unit& u, int wr, int wc, int fr, int fq) const {
        const int type = u.pn >> 1;
        const int row0 = u.pm * 256 + wr * 64 + fr, lc0 = (u.pn & 1) * 256 + wc * 32 + 8 * fq;
        if (type == 3) {
            f32x4 lb[2][2];
#pragma unroll
            for (int bj = 0; bj < 2; ++bj) { lb[bj][0] = *(const f32x4*)(LB + lc0 + bj * 128); lb[bj][1] = *(const f32x4*)(LB + lc0 + bj * 128 + 4); }
#pragma unroll
            for (int ai = 0; ai < 2; ++ai)
#pragma unroll
                for (int m = 0; m < 4; ++m) { float* rowp = G + (size_t)(row0 + ai * 128 + m * 16) * 512 + lc0;
#pragma unroll
                    for (int bj = 0; bj < 2; ++bj)
#pragma unroll
                        for (int n = 0; n < 2; ++n) { const f32x4 v = acc[ai][bj][m][n]; f32x4 o;
#pragma unroll
                            for (int e = 0; e < 4; ++e) { const float l = lb[bj][n][e]; const float f = l + (1.0f - l) * sigmoid_f(v[e]); o[e] = __logf(f); }
                            *(f32x4*)(rowp + bj * 128 + 4 * n) = o; } }
            return;
        }
        bf16* base = type == 0 ? PU : type == 1 ? PV : type == 2 ? PQ : type == 4 ? PI : PG;
#pragma unroll
        for (int ai = 0; ai < 2; ++ai)
#pragma unroll
            for (int m = 0; m < 4; ++m) { bf16* rowp = base + (size_t)(row0 + ai * 128 + m * 16) * 512 + lc0;
#pragma unroll
                for (int bj = 0; bj < 2; ++bj) { f32x4 v0 = acc[ai][bj][m][0], v1 = acc[ai][bj][m][1];
                    if (type <= 1) { pg8::f32x2 a = pg8::gelu_pk((pg8::f32x2){v0[0], v0[1]}), b = pg8::gelu_pk((pg8::f32x2){v0[2], v0[3]}), c = pg8::gelu_pk((pg8::f32x2){v1[0], v1[1]}), d = pg8::gelu_pk((pg8::f32x2){v1[2], v1[3]});
                        v0 = (f32x4){a.x, a.y, b.x, b.y}; v1 = (f32x4){c.x, c.y, d.x, d.y}; }
                    else if (type == 2) {
#pragma unroll
                        for (int e = 0; e < 4; ++e) { v0[e] = silu_f(v0[e]) * 0.08838834764831845f; v1[e] = silu_f(v1[e]) * 0.08838834764831845f; } }
                    else if (type == 5) {
#pragma unroll
                        for (int e = 0; e < 4; ++e) { v0[e] = silu_f(v0[e]); v1[e] = silu_f(v1[e]); } }
                    v4u w; w.x = pg8::cvt_pk_bf16(v0[0], v0[1]); w.y = pg8::cvt_pk_bf16(v0[2], v0[3]); w.z = pg8::cvt_pk_bf16(v1[0], v1[1]); w.w = pg8::cvt_pk_bf16(v1[2], v1[3]);
                    *(v4u*)(rowp + bj * 128) = w; } }
    }
};
struct EpiQKRot {
    static constexpr bool PERM = true, AFTER_DRAIN = false;
    bf16* O; const float* CS;
    __device__ __forceinline__ void operator()(const f32x4 (&acc)[2][2][4][2], const pg8::Unit& u, int wr, int wc, int fr, int fq) const {
        const int row0 = u.pm * 256 + wr * 64 + fr, col0 = u.pn * 256 + wc * 32 + 8 * fq;
        const float sc = u.pn < 4 ? C2 : 1.0f;
        const bool rotw = (wc & 1) == 0 && u.pn < 8;
        const float sgn = fq == 0 ? -1.0f : 1.0f;
#pragma unroll
        for (int ai = 0; ai < 2; ++ai)
#pragma unroll
            for (int m = 0; m < 4; ++m) { const int row = row0 + ai * 128 + m * 16; bf16* rowp = O + (size_t)row * 3072 + col0;
                f32x4 c0 = (f32x4){1.f, 1.f, 1.f, 1.f}, c1 = c0, s0 = (f32x4){0.f, 0.f, 0.f, 0.f}, s1 = s0;
                if (rotw && fq < 2) { const float* cp = CS + (size_t)row * 16; c0 = *(const f32x4*)(cp); c1 = *(const f32x4*)(cp + 4); s0 = *(const f32x4*)(cp + 8) * sgn; s1 = *(const f32x4*)(cp + 12) * sgn; }
#pragma unroll
                for (int bj = 0; bj < 2; ++bj) { f32x4 v0 = acc[ai][bj][m][0], v1 = acc[ai][bj][m][1];
                    if (rotw) { f32x4 p0, p1;
#pragma unroll
                        for (int e = 0; e < 4; ++e) { p0[e] = __shfl_xor(v0[e], 16); p1[e] = __shfl_xor(v1[e], 16); }
                        v0 = v0 * c0 + p0 * s0; v1 = v1 * c1 + p1 * s1; }
                    v0 = v0 * sc; v1 = v1 * sc;
                    v4u w; w.x = pg8::cvt_pk_bf16(v0[0], v0[1]); w.y = pg8::cvt_pk_bf16(v0[2], v0[3]); w.z = pg8::cvt_pk_bf16(v1[0], v1[1]); w.w = pg8::cvt_pk_bf16(v1[2], v1[3]);
                    *(v4u*)(rowp + bj * 128) = w; } }
    }
};

__device__ __forceinline__ void p0_transpose_item(const float* W, int K, int N, bf16* WT, LAS float* scr, int item, int lane) {
    const int nblk = N / 32, kb = item / nblk, nb = item % nblk, k0 = 64 * kb, n0 = 32 * nb;
#pragma unroll 8
    for (int i = 0; i < 32; ++i) { const int kk = 2 * i + (lane >> 5); scr[kk * 33 + (lane & 31)] = W[(size_t)(k0 + kk) * N + n0 + (lane & 31)]; }
    LDS_WAIT(); asm volatile("" ::: "memory");
    const int c = lane & 7;
#pragma unroll
    for (int j = 0; j < 4; ++j) { const int n = (lane >> 3) + 8 * j; const LAS float* s = scr + (8 * c) * 33 + n;
        v4u o; o.x = pk2(s[0 * 33], s[1 * 33]); o.y = pk2(s[2 * 33], s[3 * 33]); o.z = pk2(s[4 * 33], s[5 * 33]); o.w = pk2(s[6 * 33], s[7 * 33]);
        *(GAS v4u*)(WT + (size_t)(n0 + n) * K + k0 + 8 * c) = o; }
    LDS_WAIT(); asm volatile("" ::: "memory");
}
typedef float f32x2 __attribute__((ext_vector_type(2)));
__device__ __forceinline__ void convert_tables(const Params& P, const Ctx& C) {
    const int gw = C.vcu * NWAVES + C.wave, NGW = C.G * NWAVES, lane = C.lane;
    for (int row = gw; row < 4 * 16384; row += NGW) {
        const int tb = row >> 14, e = row & 16383;
        const float* src = ((tb & 1) ? P.peer_up : P.peer_down) + ((size_t)(tb >> 1) * 16384 + e) * 1024;
        unsigned char* dst = P.ws + WS_TAB8 + (size_t)tb * TAB8_BYTES + (size_t)e * TROW;
        f32x4 v[4]; float mx = 0.f;
#pragma unroll
        for (int j = 0; j < 4; ++j) { v[j] = ((const f32x4*)src)[64 * j + lane]; mx = fmaxf(mx, fmaxf(fmaxf(fabsf(v[j][0]), fabsf(v[j][1])), fmaxf(fabsf(v[j][2]), fabsf(v[j][3])))); }
#pragma unroll
        for (int o = 1; o < 64; o <<= 1) mx = fmaxf(mx, __shfl_xor(mx, o));
        const float sc = mx > 0.f ? 400.0f / mx : 0.f;
#pragma unroll
        for (int j = 0; j < 4; ++j) { int p = __builtin_amdgcn_cvt_pk_fp8_f32(v[j][0] * sc, v[j][1] * sc, 0, false); p = __builtin_amdgcn_cvt_pk_fp8_f32(v[j][2] * sc, v[j][3] * sc, p, true);
            ((unsigned*)dst)[64 * j + lane] = (unsigned)p; }
        if (lane == 0) *(float*)(dst + 1024) = mx * (1.0f / 400.0f);
    }
}
__device__ __forceinline__ void phase_prologue(const Params& P, const Ctx& C) {
    float* MOD = (float*)(P.ws + WS_MOD);
    {
        LAS float* cond = (LAS float*)C.lds;
        LAS float* part = (LAS float*)(C.lds + 32768);
        for (int e = C.tid; e < 8192; e += 512) cond[e] = silu_f(P.c[e]);
        __syncthreads();
        for (int item = C.vcu; item < 192; item += C.G) {
            const int l = item / 96, cb = item % 96, col = cb * 64 + C.lane;
            float acc[8];
#pragma unroll
            for (int b = 0; b < 8; ++b) acc[b] = 0.f;
            const float* wp = P.ada_w + ((size_t)l * 1024 + C.wave * 128) * 6144 + col;
#pragma unroll 4
            for (int k = 0; k < 128; ++k) { const float wv = wp[(size_t)k * 6144];
#pragma unroll
                for (int b = 0; b < 8; ++b) acc[b] += cond[b * 1024 + C.wave * 128 + k] * wv; }
#pragma unroll
            for (int b = 0; b < 8; ++b) part[(C.wave * 8 + b) * 64 + C.lane] = acc[b];
            __syncthreads();
            { const int b = C.tid >> 6, ln = C.tid & 63; float s = P.ada_b[l * 6144 + cb * 64 + ln];
#pragma unroll
              for (int w = 0; w < 8; ++w) s += part[(w * 8 + b) * 64 + ln];
              MOD[(size_t)(l * 8 + b) * 6144 + cb * 64 + ln] = s; }
            __syncthreads();
        }
        __syncthreads();
    }
    {
        LAS float* scr = (LAS float*)(C.lds + C.wave * 16384);
        const int gw = C.vcu * NWAVES + C.wave, NGW = C.G * NWAVES;
        for (int it = gw; it < 6144; it += NGW) {
            int r = it;
            if (r < 1536) { p0_transpose_item(P.even_w_in, 1024, 3072, (bf16*)(P.ws + WS_WIN), scr, r, C.lane); continue; } r -= 1536;
            if (r < 512)  { p0_transpose_item(P.even_w_out, 1024, 1024, (bf16*)(P.ws + WS_WOUT0), scr, r, C.lane); continue; } r -= 512;
            if (r < 1536) { p0_transpose_item(P.odd_w_qkv, 1024, 3072, (bf16*)(P.ws + WS_WQKV), scr, r, C.lane); continue; } r -= 1536;
            if (r < 512)  { p0_transpose_item(P.odd_w_out, 1024, 1024, (bf16*)(P.ws + WS_WOUT1), scr, r, C.lane); continue; } r -= 512;
            if (r < 1024) { p0_transpose_item(P.peer_w_query, 1024, 2048, (bf16*)(P.ws + WS_WQ0), scr, r, C.lane); continue; } r -= 1024;
            p0_transpose_item(P.peer_w_query + (size_t)1024 * 2048, 1024, 2048, (bf16*)(P.ws + WS_WQ1), scr, r, C.lane);
        }
    }
    convert_tables(P, C);
    const int NT = C.G * 512, gt = C.vcu * 512 + C.tid;
    { bf16* skb = (bf16*)(P.ws + WS_SKB); for (int i = gt; i < 65536; i += NT) skb[i] = (bf16)f2bf(P.peer_sub_keys[i]); }
    { bf16* wsb = (bf16*)(P.ws + WS_WSB); for (int i = gt; i < 65536; i += NT) { const int t = (i >> 7) & 127, s = i & 127; wsb[i] = (bf16)(s <= t ? f2bf(P.gmlp_w_s[i]) : 0u); } }
    { float* lb = (float*)(P.ws + WS_LB); for (int i = gt; i < 512; i += NT) { const float l0 = P.hgrn_lb_logits[i], l1 = P.hgrn_lb_logits[512 + i]; lb[i] = 1.0f / (1.0f + expf(l1 - l0)); } }
    { float* cs = (float*)(P.ws + WS_CS); for (int i = gt; i < T * 8; i += NT) { const int tok = i >> 3, j = i & 7;
        const float inv = 1.0f / powf(500000.0f, (float)j * 0.125f); const float ang = (float)P.positions[tok] * inv; float sn, cn; sincosf(ang, &sn, &cn);
        cs[(size_t)tok * 16 + j] = cn; cs[(size_t)tok * 16 + 8 + j] = sn; } }
}
__device__ __forceinline__ void norm_row_bf16(const float* xrow, bf16* hrow, const float* g, const float* sh, const float* sc, int lane) {
    const f32x4* xr = (const f32x4*)xrow + lane; f32x4 v[4]; float s = 0.f;
#pragma unroll
    for (int j = 0; j < 4; ++j) { v[j] = xr[64 * j]; s += (v[j][0] * v[j][0] + v[j][1] * v[j][1]) + (v[j][2] * v[j][2] + v[j][3] * v[j][3]); }
    const float rstd = 1.0f / sqrtf(wave_sum(s) * (1.0f / 1024.0f) + NORM_EPS);
    unsigned long long* o8 = (unsigned long long*)hrow + lane;
#pragma unroll
    for (int j = 0; j < 4; ++j) { const f32x4 gg = ((const f32x4*)g)[64 * j + lane], hh = ((const f32x4*)sh)[64 * j + lane], cc = ((const f32x4*)sc)[64 * j + lane];
        const f32x4 y = (v[j] * rstd * gg) * (cc + 1.0f) + hh;
        o8[64 * j] = (unsigned long long)pk2(y[0], y[1]) | ((unsigned long long)pk2(y[2], y[3]) << 32); }
}
__device__ __forceinline__ void phase_norm(const Params& P, const Ctx& C, const float* xsrc, const float* g, int l, int so) {
    const float* MOD = (const float*)(P.ws + WS_MOD); bf16* H = (bf16*)(P.ws + WS_H);
    const int gw = C.vcu * NWAVES + C.wave, NGW = C.G * NWAVES;
    for (int m = gw; m < T; m += NGW) { const float* mb = MOD + (size_t)(l * 8 + (m >> 13)) * 6144 + so;
        norm_row_bf16(xsrc + (size_t)m * 1024, H + (size_t)m * 1024, g, mb, mb + 1024, C.lane); }
}

__device__ __forceinline__ void gmlp_item(const Params& P, const Ctx& C, int n, int g) {
    LAS bf16* Wt = (LAS bf16*)C.lds;
    LAS bf16* vT = (LAS bf16*)(C.lds + 34816);
    const bf16* WSB = (const bf16*)(P.ws + WS_WSB); const bf16* PU = (const bf16*)(P.ws + WS_PU); const bf16* PV = (const bf16*)(P.ws + WS_PV); bf16* MIX = (bf16*)(P.ws + WS_H);
    const int tid = C.tid, r = C.lane & 15, q4 = C.lane >> 4;
    for (int ch = tid; ch < 2048; ch += 512) { const int rr = ch >> 4, c8 = (ch & 15) * 8; *(LAS v4u*)(Wt + rr * 136 + c8) = *(const v4u*)(WSB + (size_t)(g * 128 + rr) * 128 + c8); }
    { const int t = tid >> 2, part = tid & 3; const bf16* src = PV + (size_t)(n * 128 + t) * 512 + g * 128 + part * 32;
      float x[32];
#pragma unroll
      for (int j = 0; j < 4; ++j) { const v4u w = *(const v4u*)(src + 8 * j);
#pragma unroll
          for (int e = 0; e < 4; ++e) { x[8 * j + 2 * e] = bflo(w[e]); x[8 * j + 2 * e + 1] = bfhi(w[e]); } }
      float s = 0.f;
#pragma unroll
      for (int j = 0; j < 32; ++j) s += x[j];
      s += __shfl_xor(s, 1); s += __shfl_xor(s, 2);
      const float mean = s * (1.0f / 128.0f); float q = 0.f;
#pragma unroll
      for (int j = 0; j < 32; ++j) { const float d = x[j] - mean; q += d * d; }
      q += __shfl_xor(q, 1); q += __shfl_xor(q, 2);
      const float rstd = 1.0f / sqrtf(q * (1.0f / 128.0f) + NORM_EPS);
      const float* lg = P.gmlp_ln_g + g * 128 + part * 32; const float* lbp = P.gmlp_ln_b + g * 128 + part * 32;
#pragma unroll
      for (int j = 0; j < 32; ++j) vT[(part * 32 + j) * 136 + t] = (bf16)f2bf((x[j] - mean) * rstd * lg[j] + lbp[j]);
    }
    __syncthreads();
    const int t0 = 16 * C.wave; const int Keff = ((t0 + 16 + 31) >> 5) << 5;
    f32x4 acc[8];
#pragma unroll
    for (int ct = 0; ct < 8; ++ct) { acc[ct] = (f32x4){0.f, 0.f, 0.f, 0.f}; acc[ct] = mma16(acc[ct], Wt + t0 * 136, 136, vT + (16 * ct) * 136, 136, Keff, r, q4); }
#pragma unroll
    for (int i = 0; i < 4; ++i) { const int t = t0 + 4 * q4 + i; const float bs = P.gmlp_b_s[g * 128 + t]; const size_t tok = (size_t)n * 128 + t;
#pragma unroll
        for (int ct = 0; ct < 8; ++ct) { const int c = 16 * ct + r; const float u = bf2f(PU[tok * 512 + g * 128 + c]); MIX[tok * 1024 + g * 128 + c] = (bf16)f2bf(u * (acc[ct][i] + bs)); } }
    __syncthreads();
}
__device__ __forceinline__ void hgrn_cumsum16(const float* G, size_t tok0, int hh, int k, int seg, LAS float* tot, float (&g)[16], float (&bb)[16], float& total) {
    const float* gp = G + (tok0 + seg * 16) * 512 + hh * 128 + k;
#pragma unroll
    for (int j = 0; j < 16; ++j) g[j] = gp[(size_t)j * 512];
    float run = 0.f;
#pragma unroll
    for (int j = 0; j < 16; ++j) { run += g[j]; bb[j] = run; }
    tot[seg * 128 + k] = run;
    __syncthreads();
    const float t0 = tot[k], t1 = tot[128 + k], t2 = tot[256 + k], t3 = tot[384 + k];
    const float pre = seg == 0 ? 0.f : seg == 1 ? t0 : seg == 2 ? t0 + t1 : t0 + t1 + t2;
    total = (t0 + t1) + (t2 + t3);
#pragma unroll
    for (int j = 0; j < 16; ++j) bb[j] += pre;
}
__device__ __forceinline__ void hgrn_stage_iT(const bf16* PI, size_t tok0, int hh, LAS bf16* iT, int tid) {
    const int s = tid >> 3, v0 = (tid & 7) * 16; const bf16* src = PI + (tok0 + s) * 512 + hh * 128 + v0;
#pragma unroll
    for (int h2 = 0; h2 < 2; ++h2) { const v4u w = *(const v4u*)(src + 8 * h2);
#pragma unroll
        for (int e = 0; e < 4; ++e) { iT[(v0 + 8 * h2 + 2 * e) * 72 + s] = (bf16)(w[e] & 0xffffu); iT[(v0 + 8 * h2 + 2 * e + 1) * 72 + s] = (bf16)(w[e] >> 16); } }
}
__device__ __forceinline__ void hgrn_local_item(const Params& P, const Ctx& C, int item) {
    LAS bf16* khT = (LAS bf16*)C.lds;
    LAS bf16* iT = (LAS bf16*)(C.lds + 18432);
    LAS float* tot = (LAS float*)(C.lds + 36864);
    const float* G = (const float*)(P.ws + WS_G); const bf16* PI = (const bf16*)(P.ws + WS_PI); bf16* KVT = (bf16*)(P.ws + WS_KVT); float* HD = (float*)(P.ws + WS_HD);
    const int bh = item >> 7, c = item & 127, b = bh >> 2, hh = bh & 3; const size_t tok0 = (size_t)b * SEQ + c * 64;
    const int tid = C.tid, k = tid & 127, seg = tid >> 7, r = C.lane & 15, q4 = C.lane >> 4;
    float g[16], bb[16], total;
    hgrn_cumsum16(G, tok0, hh, k, seg, tot, g, bb, total);
    { unsigned w[8];
#pragma unroll
      for (int j = 0; j < 8; ++j) { const float a0 = -expm1f(g[2 * j]) * __expf(total - bb[2 * j]), a1 = -expm1f(g[2 * j + 1]) * __expf(total - bb[2 * j + 1]); w[j] = pk2(a0, a1); }
      LAS v4u* dst = (LAS v4u*)(khT + k * 72 + seg * 16); dst[0] = (v4u){w[0], w[1], w[2], w[3]}; dst[1] = (v4u){w[4], w[5], w[6], w[7]}; }
    if (seg == 0) HD[(size_t)item * 128 + k] = __expf(total);
    hgrn_stage_iT(PI, tok0, hh, iT, tid);
    __syncthreads();
    const int v0 = 16 * C.wave;
#pragma unroll
    for (int ct = 0; ct < 8; ++ct) { f32x4 acc = (f32x4){0.f, 0.f, 0.f, 0.f}; acc = mma16(acc, iT + v0 * 72, 72, khT + (16 * ct) * 72, 72, 64, r, q4);
#pragma unroll
        for (int i = 0; i < 4; ++i) KVT[((size_t)item * 128 + v0 + 4 * q4 + i) * 128 + 16 * ct + r] = (bf16)f2bf(acc[i]); }
    __syncthreads();
}
__device__ __forceinline__ void phase_hgrn_scan(const Params& P, const Ctx& C) {
    const bf16* KVT = (const bf16*)(P.ws + WS_KVT); bf16* ST = (bf16*)(P.ws + WS_ST); const float* HD = (const float*)(P.ws + WS_HD);
    for (int task = C.vcu * 256 + C.tid; C.tid < 256 && task < 65536; task += C.G * 256) {
        const int bh = task >> 11, v = (task >> 4) & 127, kb = task & 15;
        float st[8];
#pragma unroll
        for (int e = 0; e < 8; ++e) st[e] = 0.f;
#pragma unroll 4
        for (int c = 0; c < 128; ++c) { const size_t item = (size_t)bh * 128 + c, off = (item * 128 + v) * 128 + kb * 8;
            const v4u kv = *(const v4u*)(KVT + off); const f32x4 d0 = *(const f32x4*)(HD + item * 128 + kb * 8), d1 = *(const f32x4*)(HD + item * 128 + kb * 8 + 4);
            v4u o; o.x = pk2(st[0], st[1]); o.y = pk2(st[2], st[3]); o.z = pk2(st[4], st[5]); o.w = pk2(st[6], st[7]);
            *(v4u*)(ST + off) = o;
#pragma unroll
            for (int e = 0; e < 4; ++e) { st[2 * e] = (e < 2 ? d0[2 * e] : d1[2 * e - 4]) * st[2 * e] + bflo(kv[e]); st[2 * e + 1] = (e < 2 ? d0[2 * e + 1] : d1[2 * e - 3]) * st[2 * e + 1] + bfhi(kv[e]); }
        }
    }
}
__device__ __forceinline__ void hgrn_out_item(const Params& P, const Ctx& C, int item) {
    LAS bf16* qt = (LAS bf16*)C.lds;
    LAS bf16* kt = (LAS bf16*)(C.lds + 17408);
    LAS bf16* iT = (LAS bf16*)(C.lds + 34816);
    LAS bf16* A1 = (LAS bf16*)(C.lds + 53248);
    LAS bf16* STl = (LAS bf16*)(C.lds + 62464);
    LAS float* ol = (LAS float*)(C.lds + 97280);
    LAS float* tot = (LAS float*)(C.lds + 131072);
    const float* G = (const float*)(P.ws + WS_G); const bf16* PQ = (const bf16*)(P.ws + WS_PQ); const bf16* PI = (const bf16*)(P.ws + WS_PI); const bf16* PG = (const bf16*)(P.ws + WS_PG);
    const bf16* ST = (const bf16*)(P.ws + WS_ST); bf16* MIX = (bf16*)(P.ws + WS_H);
    const int bh = item >> 7, c = item & 127, b = bh >> 2, hh = bh & 3; const size_t tok0 = (size_t)b * SEQ + c * 64;
    const int tid = C.tid, k = tid & 127, seg = tid >> 7, r = C.lane & 15, q4 = C.lane >> 4;
    float g[16], bb[16], total;
    hgrn_cumsum16(G, tok0, hh, k, seg, tot, g, bb, total);
#pragma unroll
    for (int j = 0; j < 16; ++j) { const int t = seg * 16 + j; const float qv = bf2f(PQ[(tok0 + t) * 512 + hh * 128 + k]);
        qt[t * 136 + k] = (bf16)f2bf(qv * __expf(bb[j])); kt[t * 136 + k] = (bf16)f2bf(-expm1f(g[j]) * __expf(-bb[j])); }
    hgrn_stage_iT(PI, tok0, hh, iT, tid);
    for (int ch = tid; ch < 2048; ch += 512) { const int rr = ch >> 4, c8 = (ch & 15) * 8; *(LAS v4u*)(STl + rr * 136 + c8) = *(const v4u*)(ST + ((size_t)item * 128 + rr) * 128 + c8); }
    __syncthreads();
    { const int rt = C.wave >> 1;
#pragma unroll
      for (int cc = 0; cc < 2; ++cc) { const int ct = (C.wave & 1) * 2 + cc; f32x4 acc = (f32x4){0.f, 0.f, 0.f, 0.f};
          acc = mma16(acc, qt + (16 * rt) * 136, 136, kt + (16 * ct) * 136, 136, 128, r, q4);
#pragma unroll
          for (int i = 0; i < 4; ++i) { const int t = 16 * rt + 4 * q4 + i, s = 16 * ct + r; A1[t * 72 + s] = (bf16)(s <= t ? f2bf(acc[i]) : 0u); } } }
    __syncthreads();
    { const int rt = C.wave >> 1;
#pragma unroll
      for (int cc = 0; cc < 4; ++cc) { const int ct = (C.wave & 1) * 4 + cc; f32x4 acc = (f32x4){0.f, 0.f, 0.f, 0.f};
          acc = mma16(acc, A1 + (16 * rt) * 72, 72, iT + (16 * ct) * 72, 72, 64, r, q4);
          acc = mma16(acc, qt + (16 * rt) * 136, 136, STl + (16 * ct) * 136, 136, 128, r, q4);
#pragma unroll
          for (int i = 0; i < 4; ++i) ol[(16 * rt + 4 * q4 + i) * 132 + 16 * ct + r] = acc[i]; } }
    __syncthreads();
    { const int t = tid >> 3, v0 = (tid & 7) * 16; float o[16]; float ss = 0.f;
#pragma unroll
      for (int e = 0; e < 16; ++e) { o[e] = ol[t * 132 + v0 + e]; ss += o[e] * o[e]; }
      ss += __shfl_xor(ss, 1); ss += __shfl_xor(ss, 2); ss += __shfl_xor(ss, 4);
      const float rstd = 1.0f / sqrtf(ss * (1.0f / 128.0f) + NORM_EPS);
      const float* ng = P.hgrn_norm_g + hh * 128 + v0; const bf16* gp = PG + (tok0 + t) * 512 + hh * 128 + v0;
      const v4u g0 = *(const v4u*)gp, g1 = *(const v4u*)(gp + 8); unsigned w[8];
#pragma unroll
      for (int e = 0; e < 4; ++e) { w[e] = pk2(o[2 * e] * rstd * ng[2 * e] * bflo(g0[e]), o[2 * e + 1] * rstd * ng[2 * e + 1] * bfhi(g0[e]));
                                    w[4 + e] = pk2(o[8 + 2 * e] * rstd * ng[8 + 2 * e] * bflo(g1[e]), o[9 + 2 * e] * rstd * ng[9 + 2 * e] * bfhi(g1[e])); }
      v4u* dst = (v4u*)(MIX + (tok0 + t) * 1024 + 512 + hh * 128 + v0); dst[0] = (v4u){w[0], w[1], w[2], w[3]}; dst[1] = (v4u){w[4], w[5], w[6], w[7]}; }
    __syncthreads();
}

typedef short v4i16_t __attribute__((ext_vector_type(4)));
constexpr int AT_ST = 68;
constexpr int AT_VP = 144;
__device__ __forceinline__ void attn_item(const Params& P, const Ctx& C, int b, int hd, int qt) {
    LAS float* St = (LAS float*)C.lds;
    LAS unsigned char* Vw = C.lds + 256 * AT_ST * 4 + C.wave * (64 * AT_VP);
    const bf16* QKV = (const bf16*)(P.ws + WS_QK); bf16* O = (bf16*)(P.ws + WS_H);
    const int lane = C.lane, r = lane & 15, q4 = lane >> 4;
    const int t0 = qt * 256; const size_t rowbase = (size_t)b * SEQ;
    const bf16* Kb = QKV + rowbase * 3072 + 1024 + hd * 64; const bf16* Vb = QKV + rowbase * 3072 + 2048 + hd * 64;
#pragma unroll 1
    for (int g = 0; g < 3; ++g) {
        const int dsh = 4 - 2 * g, d = 1 << dsh;
#pragma unroll 1
        for (int uu = 0; uu < 2; ++uu) {
            const int u = C.wave + 8 * uu;
            const int c = u & (d - 1), j = u >> dsh;
            const int mq0 = (t0 >> dsh) + 16 * j;
            const int qloc = c + d * (16 * j + r);
            const bf16* qp = QKV + (rowbase + t0 + qloc) * 3072 + hd * 64 + 8 * q4;
            const bf16x8 bq0 = *(const bf16x8*)qp, bq1 = *(const bf16x8*)(qp + 32);
            f32x4 sa[9];
#pragma unroll
            for (int t = 0; t < 9; ++t) { int mk = mq0 - 128 + 16 * t + r; mk = mk < 0 ? 0 : mk;
                const bf16* kp = Kb + (size_t)(c + d * mk) * 3072 + 8 * q4;
                const bf16x8 a0 = *(const bf16x8*)kp, a1 = *(const bf16x8*)(kp + 32);
                sa[t] = (f32x4){0.f, 0.f, 0.f, 0.f}; sa[t] = __builtin_amdgcn_mfma_f32_16x16x32_bf16(a0, bq0, sa[t], 0, 0, 0); sa[t] = __builtin_amdgcn_mfma_f32_16x16x32_bf16(a1, bq1, sa[t], 0, 0, 0); }
            float mx = -1e30f;
#pragma unroll
            for (int t = 0; t < 9; ++t)
#pragma unroll
                for (int i = 0; i < 4; ++i) { const int kap = 16 * t + 4 * q4 + i; const bool ok = kap >= r && kap <= r + 128 && (mq0 - 128 + kap) >= 0;
                    sa[t][i] = ok ? sa[t][i] : -1e30f; mx = fmaxf(mx, sa[t][i]); }
            mx = fmaxf(mx, __shfl_xor(mx, 16)); mx = fmaxf(mx, __shfl_xor(mx, 32));
            float ls = 0.f;
#pragma unroll
            for (int t = 0; t < 9; ++t)
#pragma unroll
                for (int i = 0; i < 4; ++i) { const float p = sa[t][i] > -1e29f ? __builtin_amdgcn_exp2f(sa[t][i] - mx) : 0.f; sa[t][i] = p; ls += p; }
            ls += __shfl_xor(ls, 16); ls += __shfl_xor(ls, 32);
            bf16x8 pf[5];
#pragma unroll
            for (int s = 0; s < 5; ++s) { const f32x4 lo = sa[2 * s], hi = (2 * s + 1 < 9) ? sa[2 * s + 1 < 9 ? 2 * s + 1 : 8] : (f32x4){0.f, 0.f, 0.f, 0.f};
                v4u w; w.x = pk2(lo[0], lo[1]); w.y = pk2(lo[2], lo[3]); w.z = pk2(hi[0], hi[1]); w.w = pk2(hi[2], hi[3]); pf[s] = __builtin_bit_cast(bf16x8, w); }
            f32x4 oa[4];
#pragma unroll
            for (int dt = 0; dt < 4; ++dt) oa[dt] = (f32x4){0.f, 0.f, 0.f, 0.f};
#pragma unroll
            for (int ch = 0; ch < 3; ++ch) {
#pragma unroll
                for (int it = 0; it < 8; ++it) { const int row = 8 * it + (lane >> 3); int kap = 64 * ch + row; kap = kap > 143 ? 143 : kap; int mk = mq0 - 128 + kap; mk = mk < 0 ? 0 : mk;
                    const v4u v = *(const v4u*)(Vb + (size_t)(c + d * mk) * 3072 + (lane & 7) * 8);
                    *(LAS v4u*)(Vw + row * AT_VP + (lane & 7) * 16) = v; }
                asm volatile("s_waitcnt lgkmcnt(0)" ::: "memory");
#pragma unroll
                for (int s2 = 0; s2 < 2; ++s2) { const int s = 2 * ch + s2; if (s < 5) {
#pragma unroll
                    for (int dt = 0; dt < 4; ++dt) {
                        const LAS unsigned char* vp = Vw + (32 * s2 + 4 * q4 + (r >> 2)) * AT_VP + dt * 32 + (r & 3) * 8;
                        const v4i16_t x = __builtin_amdgcn_ds_read_tr16_b64_v4i16((LAS v4i16_t*)vp), y = __builtin_amdgcn_ds_read_tr16_b64_v4i16((LAS v4i16_t*)(vp + 16 * AT_VP));
                        const bf16x8 av = (bf16x8){x[0], x[1], x[2], x[3], y[0], y[1], y[2], y[3]};
                        oa[dt] = __builtin_amdgcn_mfma_f32_16x16x32_bf16(av, pf[s], oa[dt], 0, 0, 0); } } }
                asm volatile("s_waitcnt lgkmcnt(0)" ::: "memory");
            }
            LAS float* sp = St + qloc * AT_ST;
            float mo = mx, lo2 = ls;
            if (g > 0) { const float m_old = sp[64], l_old = sp[65]; const float M = fmaxf(m_old, mx); const float fo = __builtin_amdgcn_exp2f(m_old - M), fn = __builtin_amdgcn_exp2f(mx - M);
#pragma unroll
                for (int dt = 0; dt < 4; ++dt) { const f32x4 po = *(const LAS f32x4*)(sp + 16 * dt + 4 * q4); oa[dt] = oa[dt] * fn + po * fo; }
                mo = M; lo2 = ls * fn + l_old * fo; }
            if (g < 2) {
#pragma unroll
                for (int dt = 0; dt < 4; ++dt) *(LAS f32x4*)(sp + 16 * dt + 4 * q4) = oa[dt];
                if (q4 == 0) { sp[64] = mo; sp[65] = lo2; }
            } else { const float inv = 1.0f / lo2; bf16* op = O + (rowbase + t0 + qloc) * 1024 + hd * 64 + 4 * q4;
#pragma unroll
                for (int dt = 0; dt < 4; ++dt) { const f32x4 v = oa[dt] * inv; *(unsigned long long*)(op + 16 * dt) = (unsigned long long)pk2(v[0], v[1]) | ((unsigned long long)pk2(v[2], v[3]) << 32); } }
        }
        __syncthreads();
    }
}

__device__ __forceinline__ unsigned ordf(float s) { const unsigned u = __builtin_bit_cast(unsigned, s); return u ^ ((unsigned)((int)u >> 31) | 0x80000000u); }
__device__ __forceinline__ float unordf(unsigned v) { return __builtin_bit_cast(float, v ^ ((unsigned)((int)(~v) >> 31) | 0x80000000u)); }
__device__ __forceinline__ void ins16(unsigned (&top)[16], unsigned x) {
#pragma unroll
    for (int j = 0; j < 16; ++j) { const unsigned hi = top[j] > x ? top[j] : x; x = top[j] > x ? x : top[j]; top[j] = hi; }
}
__device__ __forceinline__ void merge16(unsigned (&top)[16], int mask) {
    unsigned c[16];
#pragma unroll
    for (int j = 0; j < 16; ++j) { const unsigned o = (unsigned)__shfl_xor((int)top[15 - j], mask); c[j] = top[j] > o ? top[j] : o; }
#pragma unroll
    for (int st = 8; st >= 1; st >>= 1)
#pragma unroll
        for (int j = 0; j < 16; ++j) if ((j & st) == 0) { const unsigned a = c[j], b2 = c[j + st]; c[j] = a > b2 ? a : b2; c[j + st] = a > b2 ? b2 : a; }
#pragma unroll
    for (int j = 0; j < 16; ++j) top[j] = c[j];
}
__device__ __forceinline__ void phase_peer_topk(const Params& P, const Ctx& C, int layer) {
    LAS bf16* SK = (LAS bf16*)C.lds;
    const bf16* SKB = (const bf16*)(P.ws + WS_SKB) + (size_t)layer * 32768; const bf16* QP = (const bf16*)(P.ws + WS_QP);
    int* IDX = (int*)(P.ws + WS_IDX); float* GATE = (float*)(P.ws + WS_GATE);
    for (int ch = C.tid; ch < 4096; ch += 512) { const int rr = ch >> 4, c8 = (ch & 15) * 8; *(LAS v4u*)(SK + rr * 136 + c8) = *(const v4u*)(SKB + (size_t)rr * 128 + c8); }
    __syncthreads();
    const int r = C.lane & 15, q4 = C.lane >> 4;
    const int gw = C.vcu * NWAVES + C.wave, NGW = C.G * NWAVES;
    for (int grp = gw; grp < T * 8 / 16; grp += NGW) {
        const size_t task = (size_t)grp * 16 + r;
        unsigned lst[2][16];
#pragma unroll
        for (int half = 0; half < 2; ++half) {
            bf16x8 bq[4];
#pragma unroll
            for (int ks = 0; ks < 4; ++ks) bq[ks] = *(const bf16x8*)(QP + task * 256 + half * 128 + ks * 32 + 8 * q4);
            unsigned top[16];
#pragma unroll
            for (int j = 0; j < 16; ++j) top[j] = 0u;
#pragma unroll 1
            for (int nt = 0; nt < 8; ++nt) { f32x4 acc = (f32x4){0.f, 0.f, 0.f, 0.f};
#pragma unroll
                for (int ks = 0; ks < 4; ++ks) { const bf16x8 a = *(const LAS bf16x8*)(SK + (half * 128 + 16 * nt + r) * 136 + ks * 32 + 8 * q4); acc = __builtin_amdgcn_mfma_f32_16x16x32_bf16(a, bq[ks], acc, 0, 0, 0); }
#pragma unroll
                for (int i = 0; i < 4; ++i) { const unsigned n = 16 * nt + 4 * q4 + i; ins16(top, (ordf(acc[i]) & ~127u) | (127u - n)); } }
            merge16(top, 16); merge16(top, 32);
#pragma unroll
            for (int j = 0; j < 16; ++j) lst[half][j] = top[j];
        }
        float v1[16], v2[16]; unsigned e1[16], e2[16];
#pragma unroll
        for (int j = 0; j < 16; ++j) { v1[j] = unordf(lst[0][j] & ~127u); v2[j] = unordf(lst[1][j] & ~127u); e1[j] = (127u - (lst[0][j] & 127u)) << 7; e2[j] = 127u - (lst[1][j] & 127u); }
        unsigned top[16];
#pragma unroll
        for (int j = 0; j < 16; ++j) top[j] = 0u;
#pragma unroll
        for (int i = 0; i < 16; ++i)
#pragma unroll
            for (int j = 0; j < 16; ++j) if ((i + 1) * (j + 1) <= 16) ins16(top, (ordf(v1[i] + v2[j]) & ~16383u) | e1[i] | e2[j]);
        float ev[16]; float den = 0.f; const float mx = unordf(top[0] & ~16383u);
#pragma unroll
        for (int j = 0; j < 16; ++j) { ev[j] = __expf(unordf(top[j] & ~16383u) - mx); den += ev[j]; }
        const float inv = 1.0f / den;
        int* ip = IDX + task * 16; float* gp = GATE + task * 16;
        if (q4 == 0) { *(v4u*)(ip) = (v4u){top[0] & 16383u, top[1] & 16383u, top[2] & 16383u, top[3] & 16383u}; *(f32x4*)(gp) = (f32x4){ev[0] * inv, ev[1] * inv, ev[2] * inv, ev[3] * inv}; }
        else if (q4 == 1) { *(v4u*)(ip + 4) = (v4u){top[4] & 16383u, top[5] & 16383u, top[6] & 16383u, top[7] & 16383u}; *(f32x4*)(gp + 4) = (f32x4){ev[4] * inv, ev[5] * inv, ev[6] * inv, ev[7] * inv}; }
        else if (q4 == 2) { *(v4u*)(ip + 8) = (v4u){top[8] & 16383u, top[9] & 16383u, top[10] & 16383u, top[11] & 16383u}; *(f32x4*)(gp + 8) = (f32x4){ev[8] * inv, ev[9] * inv, ev[10] * inv, ev[11] * inv}; }
        else { *(v4u*)(ip + 12) = (v4u){top[12] & 16383u, top[13] & 16383u, top[14] & 16383u, top[15] & 16383u}; *(f32x4*)(gp + 12) = (f32x4){ev[12] * inv, ev[13] * inv, ev[14] * inv, ev[15] * inv}; }
    }
}
struct ExpRow { v4u d[4], u[4]; float ds, us, gk; };
__device__ __forceinline__ void exp_issue(ExpRow& R, const unsigned char* TD, const unsigned char* TU, int ex, float gk, int jl) {
    const unsigned char* dr = TD + (size_t)ex * TROW; const unsigned char* ur = TU + (size_t)ex * TROW;
#pragma unroll
    for (int c = 0; c < 4; ++c) R.d[c] = *(const v4u*)(dr + (c * 16 + jl) * 16);
#pragma unroll
    for (int c = 0; c < 4; ++c) R.u[c] = *(const v4u*)(ur + (c * 16 + jl) * 16);
    R.ds = *(const float*)(dr + 1024); R.us = *(const float*)(ur + 1024); R.gk = gk;
}
__device__ __forceinline__ void exp_consume(const ExpRow& R, const unsigned (&hp)[32], f32x2 (&oacc)[32]) {
    f32x2 a2 = (f32x2){0.f, 0.f};
#pragma unroll
    for (int c = 0; c < 4; ++c)
#pragma unroll
        for (int w = 0; w < 4; ++w) { const f32x2 lo = __builtin_amdgcn_cvt_pk_f32_fp8((int)R.d[c][w], false), hi = __builtin_amdgcn_cvt_pk_f32_fp8((int)R.d[c][w], true);
            unsigned h0 = hp[c * 8 + 2 * w], h1 = hp[c * 8 + 2 * w + 1]; asm volatile("" : "+v"(h0), "+v"(h1));
            a2 = a2 + lo * (f32x2){bflo(h0), bfhi(h0)}; a2 = a2 + hi * (f32x2){bflo(h1), bfhi(h1)}; }
    float a = (a2.x + a2.y) * R.ds;
    a += __shfl_xor(a, 1); a += __shfl_xor(a, 2); a += __shfl_xor(a, 4); a += __shfl_xor(a, 8);
    const float wk = R.gk * gelu_f(a) * R.us; const f32x2 wk2 = (f32x2){wk, wk};
#pragma unroll
    for (int c = 0; c < 4; ++c)
#pragma unroll
        for (int w = 0; w < 4; ++w) { const f32x2 lo = __builtin_amdgcn_cvt_pk_f32_fp8((int)R.u[c][w], false), hi = __builtin_amdgcn_cvt_pk_f32_fp8((int)R.u[c][w], true);
            oacc[c * 8 + 2 * w] = oacc[c * 8 + 2 * w] + wk2 * lo; oacc[c * 8 + 2 * w + 1] = oacc[c * 8 + 2 * w + 1] + wk2 * hi; }
}
__device__ __forceinline__ void phase_peer_experts(const Params& P, const Ctx& C, int layer, bool last) {
    const unsigned char* TD = P.ws + WS_TAB8 + (size_t)(2 * layer) * TAB8_BYTES; const unsigned char* TU = P.ws + WS_TAB8 + (size_t)(2 * layer + 1) * TAB8_BYTES; bf16* H = (bf16*)(P.ws + WS_H);
    const int* IDX = (const int*)(P.ws + WS_IDX); const float* GATE = (const float*)(P.ws + WS_GATE); const float* MOD = (const float*)(P.ws + WS_MOD);
    const int lane = C.lane, grp = lane >> 4, jl = lane & 15;
    const int gw = C.vcu * NWAVES + C.wave, NGW = C.G * NWAVES;
    for (int tok = gw; tok < T; tok += NGW) {
        const int b = tok >> 13;
        const int i0 = IDX[(size_t)tok * 128 + lane], i1 = IDX[(size_t)tok * 128 + 64 + lane];
        const float g0 = GATE[(size_t)tok * 128 + lane], g1 = GATE[(size_t)tok * 128 + 64 + lane];
        unsigned hf[32];
#pragma unroll
        for (int c = 0; c < 4; ++c) { const bf16* hp = H + (size_t)tok * 1024 + (c * 16 + jl) * 16; const v4u w0 = *(const v4u*)hp, w1 = *(const v4u*)(hp + 8);
#pragma unroll
            for (int e = 0; e < 4; ++e) { hf[c * 8 + e] = w0[e]; hf[c * 8 + 4 + e] = w1[e]; } }
        f32x2 oacc[32];
#pragma unroll
        for (int e = 0; e < 32; ++e) oacc[e] = (f32x2){0.f, 0.f};
        ExpRow RA, RB;
        exp_issue(RA, TD, TU, __shfl(i0, grp), __shfl(g0, grp), jl);
        for (int it = 0; it < 32 * EXP_REP; it += 2) {
            { const int kk = ((it + 1) & 31) * 4 + grp; const int el = __shfl(i0, kk & 63), eh = __shfl(i1, kk & 63); const float gl = __shfl(g0, kk & 63), gh = __shfl(g1, kk & 63);
              exp_issue(RB, TD, TU, kk < 64 ? el : eh, kk < 64 ? gl : gh, jl); }
            exp_consume(RA, hf, oacc);
            { const int kk = ((it + 2) & 31) * 4 + grp; const int el = __shfl(i0, kk & 63), eh = __shfl(i1, kk & 63); const float gl = __shfl(g0, kk & 63), gh = __shfl(g1, kk & 63);
              exp_issue(RA, TD, TU, kk < 64 ? el : eh, kk < 64 ? gl : gh, jl); }
            exp_consume(RB, hf, oacc);
        }
        f32x2 h1[16];
        { const bool up = (grp & 2) != 0;
#pragma unroll
          for (int e = 0; e < 16; ++e) { const f32x2 keep = up ? oacc[16 + e] : oacc[e], send = up ? oacc[e] : oacc[16 + e]; h1[e] = keep + (f32x2){__shfl_xor(send.x, 32), __shfl_xor(send.y, 32)}; } }
        f32x2 h2[8];
        { const bool up = (grp & 1) != 0;
#pragma unroll
          for (int e = 0; e < 8; ++e) { const f32x2 keep = up ? h1[8 + e] : h1[e], send = up ? h1[e] : h1[8 + e]; h2[e] = keep + (f32x2){__shfl_xor(send.x, 16), __shfl_xor(send.y, 16)}; } }
        const int d0 = (grp * 16 + jl) * 16;
        const float* g2p = MOD + (size_t)(layer * 8 + b) * 6144 + 5120 + d0; const float psc = ((ABL_ON >= (layer == 0 ? 2 : 4)) ? 1.f : 0.f) * (1.0f / EXP_REP);
        float* xp = P.out + (size_t)tok * 1024 + d0;
        float xn[16]; float ss = 0.f;
#pragma unroll
        for (int q = 0; q < 4; ++q) { const f32x4 xa = *(const f32x4*)(xp + 4 * q), ga = *(const f32x4*)(g2p + 4 * q);
            xn[4 * q] = xa[0] + psc * ga[0] * h2[2 * q].x; xn[4 * q + 1] = xa[1] + psc * ga[1] * h2[2 * q].y; xn[4 * q + 2] = xa[2] + psc * ga[2] * h2[2 * q + 1].x; xn[4 * q + 3] = xa[3] + psc * ga[3] * h2[2 * q + 1].y; }
#pragma unroll
        for (int e = 0; e < 16; ++e) ss += xn[e] * xn[e];
        const float rstd = 1.0f / sqrtf(wave_sum(ss) * (1.0f / 1024.0f) + NORM_EPS);
        if (!last) {
            const float* ng = P.norm_mix_g + (layer + 1) * 1024 + d0; const float* mb = MOD + (size_t)((layer + 1) * 8 + b) * 6144 + d0;
            unsigned w[8];
#pragma unroll
            for (int q = 0; q < 4; ++q) { *(f32x4*)(xp + 4 * q) = (f32x4){xn[4 * q], xn[4 * q + 1], xn[4 * q + 2], xn[4 * q + 3]}; }
#pragma unroll
            for (int e = 0; e < 8; ++e) w[e] = pk2(xn[2 * e] * rstd * ng[2 * e] * (1.0f + mb[1024 + 2 * e]) + mb[2 * e], xn[2 * e + 1] * rstd * ng[2 * e + 1] * (1.0f + mb[1024 + 2 * e + 1]) + mb[2 * e + 1]);
            v4u* hp = (v4u*)(H + (size_t)tok * 1024 + d0); hp[0] = (v4u){w[0], w[1], w[2], w[3]}; hp[1] = (v4u){w[4], w[5], w[6], w[7]};
        } else {
            const float* fg = P.final_norm_g + d0;
#pragma unroll
            for (int q = 0; q < 4; ++q) *(f32x4*)(xp + 4 * q) = (f32x4){xn[4 * q] * rstd * fg[4 * q], xn[4 * q + 1] * rstd * fg[4 * q + 1], xn[4 * q + 2] * rstd * fg[4 * q + 2], xn[4 * q + 3] * rstd * fg[4 * q + 3]};
        }
    }
}
#ifndef NAIVE_TOPK
#define NAIVE_TOPK 0
#endif
#ifndef NAIVE_EXPERTS
#define NAIVE_EXPERTS 0
#endif
__device__ __forceinline__ void phase_peer_topk_naive(const Params& P, const Ctx& C, int layer) {
    LAS float* SC = (LAS float*)C.lds;
    const float* sk = P.peer_sub_keys + (size_t)layer * 32768; const bf16* QP = (const bf16*)(P.ws + WS_QP);
    int* IDX = (int*)(P.ws + WS_IDX); float* GATE = (float*)(P.ws + WS_GATE);
    for (int base = C.vcu * 64; base < T * 8; base += C.G * 64) {
        __syncthreads();
        { const int tl = C.tid & 63, part = C.tid >> 6; const size_t task = (size_t)base + tl;
          for (int col = part * 32; col < part * 32 + 32; ++col) { const int half = col >> 7, n = col & 127; float acc = 0.f;
              for (int c = 0; c < 128; ++c) acc += bf2f(QP[task * 256 + half * 128 + c]) * sk[(half * 128 + n) * 128 + c];
              SC[tl * 257 + col] = acc; } }
        __syncthreads();
        if (C.tid < 64) { const int tl = C.tid; const size_t task = (size_t)base + tl; LAS float* s = SC + tl * 257;
            float v1[16], v2[16]; int i1[16], i2[16];
            for (int k = 0; k < 16; ++k) { float best = -3e38f; int bi = 0; for (int n = 0; n < 128; ++n) { const float x = s[n]; if (x > best) { best = x; bi = n; } } v1[k] = best; i1[k] = bi; s[bi] = -3.1e38f; }
            for (int k = 0; k < 16; ++k) { float best = -3e38f; int bi = 0; for (int n = 0; n < 128; ++n) { const float x = s[128 + n]; if (x > best) { best = x; bi = n; } } v2[k] = best; i2[k] = bi; s[128 + bi] = -3.1e38f; }
            for (int a = 0; a < 16; ++a) for (int b2 = 0; b2 < 16; ++b2) s[a * 16 + b2] = v1[a] + v2[b2];
            float ts[16]; int ti[16];
            for (int k = 0; k < 16; ++k) { float best = -3e38f; int bi = 0; for (int n = 0; n < 256; ++n) { const float x = s[n]; if (x > best) { best = x; bi = n; } } ts[k] = best; ti[k] = bi; s[bi] = -3.1e38f; }
            float den = 0.f; float ev[16];
            for (int k = 0; k < 16; ++k) { ev[k] = expf(ts[k] - ts[0]); den += ev[k]; }
            for (int k = 0; k < 16; ++k) { int a = ti[k] >> 4, b2 = ti[k] & 15; int e1 = 0, e2 = 0;
                for (int z = 0; z < 16; ++z) { if (z == a) e1 = i1[z]; if (z == b2) e2 = i2[z]; }
                IDX[task * 16 + k] = e1 * 128 + e2; GATE[task * 16 + k] = ev[k] / den; }
        }
    }
    __syncthreads();
}
__device__ __forceinline__ void phase_peer_experts_naive(const Params& P, const Ctx& C, int layer, bool last) {
    bf16* H = (bf16*)(P.ws + WS_H); const int* IDX = (const int*)(P.ws + WS_IDX); const float* GATE = (const float*)(P.ws + WS_GATE); const float* MOD = (const float*)(P.ws + WS_MOD);
    const float* TD = P.peer_down + (size_t)layer * 16384 * 1024; const float* TU = P.peer_up + (size_t)layer * 16384 * 1024;
    const int lane = C.lane; const int gw = C.vcu * NWAVES + C.wave, NGW = C.G * NWAVES;
    for (int tok = gw; tok < T; tok += NGW) {
        const int b = tok >> 13; float hv[16], oa[16];
#pragma unroll
        for (int j = 0; j < 16; ++j) { hv[j] = bf2f(H[(size_t)tok * 1024 + j * 64 + lane]); oa[j] = 0.f; }
        for (int k = 0; k < 128; ++k) { const int e = IDX[(size_t)tok * 128 + k]; const float gk = GATE[(size_t)tok * 128 + k];
            float p = 0.f;
#pragma unroll
            for (int j = 0; j < 16; ++j) p += hv[j] * TD[(size_t)e * 1024 + j * 64 + lane];
            const float a = wave_sum(p); const float wk = gk * gelu_f(a);
#pragma unroll
            for (int j = 0; j < 16; ++j) oa[j] += wk * TU[(size_t)e * 1024 + j * 64 + lane]; }
        const float* g2p = MOD + (size_t)(layer * 8 + b) * 6144 + 5120; const float psc = (ABL_ON >= (layer == 0 ? 2 : 4)) ? 1.f : 0.f;
        float xn[16]; float ss = 0.f;
#pragma unroll
        for (int j = 0; j < 16; ++j) { const int d = j * 64 + lane; xn[j] = P.out[(size_t)tok * 1024 + d] + psc * g2p[d] * oa[j]; ss += xn[j] * xn[j]; }
        const float rstd = 1.0f / sqrtf(wave_sum(ss) * (1.0f / 1024.0f) + NORM_EPS);
        if (!last) { const float* ng = P.norm_mix_g + (layer + 1) * 1024; const float* mb = MOD + (size_t)((layer + 1) * 8 + b) * 6144;
#pragma unroll
            for (int j = 0; j < 16; ++j) { const int d = j * 64 + lane; P.out[(size_t)tok * 1024 + d] = xn[j]; H[(size_t)tok * 1024 + d] = (bf16)f2bf(xn[j] * rstd * ng[d] * (1.0f + mb[1024 + d]) + mb[d]); }
        } else {
#pragma unroll
            for (int j = 0; j < 16; ++j) { const int d = j * 64 + lane; P.out[(size_t)tok * 1024 + d] = xn[j] * rstd * P.final_norm_g[d]; } }
    }
}
constexpr int N_PHASES = 18;
#ifndef MK_ONE_LAUNCH
#define MK_ONE_LAUNCH 1
#endif
__global__ void __launch_bounds__(NWAVES * 64, 2) hybrid_fwd(Params P) {
    extern __shared__ __attribute__((aligned(16))) unsigned char lds_raw[];
    Ctx C;
    C.lds = (LAS unsigned char*)lds_raw;
    C.tid = threadIdx.x; C.lane = C.tid & 63; C.wave = __builtin_amdgcn_readfirstlane(C.tid >> 6);
    C.G = gridDim.x; { const int bx = blockIdx.x; C.vcu = (C.G % 8 == 0) ? (bx % 8) * (C.G / 8) + bx / 8 : bx; }
    volatile LAS unsigned* MISC = (volatile LAS unsigned*)(C.lds + MISC_OFF);
    for (int u = C.tid; u < (LDS_BYTES - LDSCTL_OFF) / 4; u += NWAVES * 64) ((LAS unsigned*)(C.lds + LDSCTL_OFF))[u] = 0u;
    __syncthreads();
    unsigned* ctl = (unsigned*)(P.ws + WS_CTL);
    XcdBarrier bar; bar.bar = ctl + CW_BAR; bar.x = 0; bar.st = nullptr;
    const int lo = P.ph_lo, hi = P.ph_hi;
    if (hi - lo > 1) bar = xcd_barrier_post(ctl + CW_BAR, MISC + 8);
#ifndef PH_MASK
#define PH_MASK 0x3ffff
#endif
#define IN(k) (((PH_MASK >> (k)) & 1) && lo <= (k) && (k) < hi)
#define SEAM(k) do { if (IN(k) && IN((k) + 1)) xcd_barrier(bar); } while (0)
    unsigned char* ws = P.ws;
    float* MOD = (float*)(ws + WS_MOD); bf16* H = (bf16*)(ws + WS_H);

    if (IN(0)) { for (int rp = 0; rp < REP_PRO; ++rp) { phase_prologue(P, C); __syncthreads(); } } SEAM(0);
    if (IN(1)) { for (int rp = 0; rp < REP_NORM; ++rp) phase_norm(P, C, P.x, P.norm_mix_g, 0, 0); } SEAM(1);
    if (IN(2)) { pg8::Gemm g{H, (const bf16*)(ws + WS_WIN), T, 3072, 1024}; pg8::StaticOrder S; S.init(T, 3072, C.G, (int)blockIdx.x);
        EpiInProj E{(bf16*)(ws + WS_PU), (bf16*)(ws + WS_PV), (bf16*)(ws + WS_PQ), (bf16*)(ws + WS_PI), (bf16*)(ws + WS_PG), (float*)(ws + WS_G), (const float*)(ws + WS_LB)};
        for (int rp = 0; rp < REP_GEMM; ++rp) { pg8::gemm_phase<EpiInProj, pg8::StaticOrder, true, true>(C.lds, g, S, E); __syncthreads(); } } SEAM(2);
    if (IN(3)) { for (int rp = 0; rp < REP_HG; ++rp) { for (int it = C.vcu; it < 2048; it += C.G) gmlp_item(P, C, it >> 2, it & 3);
                 for (int it = C.vcu; it < 4096; it += C.G) hgrn_local_item(P, C, it); } } SEAM(3);
    if (IN(4)) { for (int rp = 0; rp < REP_HG; ++rp) phase_hgrn_scan(P, C); } SEAM(4);
    if (IN(5)) { for (int rp = 0; rp < REP_HG; ++rp) for (int it = C.vcu; it < 4096; it += C.G) hgrn_out_item(P, C, it); } SEAM(5);
    if (IN(6)) { pg8::Gemm g{H, (const bf16*)(ws + WS_WOUT0), T, 1024, 1024}; pg8::StaticOrder S; S.init(T, 1024, C.G, (int)blockIdx.x);
        EpiResid E{P.x, P.out, MOD + 2048, ABL_ON >= 1 ? 1.f : 0.f};
        pg8::gemm_phase<EpiResid, pg8::StaticOrder, true, true>(C.lds, g, S, E); } SEAM(6);
    if (IN(7)) { for (int rp = 0; rp < REP_NORM; ++rp) phase_norm(P, C, P.out, P.norm_ffn_g, 0, 3072); } SEAM(7);
    if (IN(8)) { pg8::Gemm g{H, (const bf16*)(ws + WS_WQ0), T, 2048, 1024}; pg8::StaticOrder S; S.init(T, 2048, C.G, (int)blockIdx.x);
        EpiBf16P E{(bf16*)(ws + WS_QP), 2048};
        for (int rp = 0; rp < REP_GEMM; ++rp) { pg8::gemm_phase<EpiBf16P, pg8::StaticOrder, true, true>(C.lds, g, S, E); __syncthreads(); } } SEAM(8);
    if (IN(9)) { for (int rp = 0; rp < REP_TOPK; ++rp) { if (NAIVE_TOPK) phase_peer_topk_naive(P, C, 0); else phase_peer_topk(P, C, 0); __syncthreads(); } } SEAM(9);
    if (IN(10)) { if (NAIVE_EXPERTS) phase_peer_experts_naive(P, C, 0, false); else phase_peer_experts(P, C, 0, false); } SEAM(10);
    if (IN(11)) {
        { pg8::Gemm g{H, (const bf16*)(ws + WS_WQKV), T, 3072, 1024}; pg8::StaticOrder S; S.init(T, 3072, C.G, (int)blockIdx.x);
          EpiQKRot E{(bf16*)(ws + WS_QK), (const float*)(ws + WS_CS)};
          pg8::gemm_phase<EpiQKRot, pg8::StaticOrder, true, true>(C.lds, g, S, E); } } SEAM(11);
    if (IN(12)) { for (int rep = 0; rep < ATT_REP; ++rep) for (int it = C.vcu; it < NB * 16 * 32; it += C.G) attn_item(P, C, it >> 9, (it >> 5) & 15, it & 31); } SEAM(12);
    if (IN(13)) { pg8::Gemm g{H, (const bf16*)(ws + WS_WOUT1), T, 1024, 1024}; pg8::StaticOrder S; S.init(T, 1024, C.G, (int)blockIdx.x);
        EpiResid E{P.out, P.out, MOD + (size_t)8 * 6144 + 2048, ABL_ON >= 3 ? 1.f : 0.f};
        pg8::gemm_phase<EpiResid, pg8::StaticOrder, true, true>(C.lds, g, S, E); } SEAM(13);
    if (IN(14)) { for (int rp = 0; rp < REP_NORM; ++rp) phase_norm(P, C, P.out, P.norm_ffn_g + 1024, 1, 3072); } SEAM(14);
    if (IN(15)) { pg8::Gemm g{H, (const bf16*)(ws + WS_WQ1), T, 2048, 1024}; pg8::StaticOrder S; S.init(T, 2048, C.G, (int)blockIdx.x);
        EpiBf16P E{(bf16*)(ws + WS_QP), 2048};
        for (int rp = 0; rp < REP_GEMM; ++rp) { pg8::gemm_phase<EpiBf16P, pg8::StaticOrder, true, true>(C.lds, g, S, E); __syncthreads(); } } SEAM(15);
    if (IN(16)) { for (int rp = 0; rp < REP_TOPK; ++rp) { if (NAIVE_TOPK) phase_peer_topk_naive(P, C, 1); else phase_peer_topk(P, C, 1); __syncthreads(); } } SEAM(16);
    if (IN(17)) { if (NAIVE_EXPERTS) phase_peer_experts_naive(P, C, 1, true); else phase_peer_experts(P, C, 1, true); }
#undef IN
#undef SEAM
}

extern "C" void kernel_launch(void* const* d_in, const int* in_sizes, int n_in, void* d_out, int out_size, void* d_ws, size_t ws_size, hipStream_t stream) {
    static int grid = 0;
    if (grid == 0) {
        if (n_in != 22 || in_sizes[0] != T * DM || out_size != T * DM || ws_size < WS_END) {
            fprintf(stderr, "kernel_launch: unexpected shapes (n_in %d, in0 %d, out %d, ws %zu); nothing launched\n", n_in, n_in > 0 ? in_sizes[0] : -1, out_size, ws_size); grid = -1; return; }
        int dev = 0, cus = 0;
        if (hipGetDevice(&dev) != hipSuccess || hipDeviceGetAttribute(&cus, hipDeviceAttributeMultiprocessorCount, dev) != hipSuccess) { fprintf(stderr, "kernel_launch: device query failed\n"); grid = -1; return; }
        if (hipFuncSetAttribute((const void*)hybrid_fwd, hipFuncAttributeMaxDynamicSharedMemorySize, LDS_BYTES) != hipSuccess) { fprintf(stderr, "kernel_launch: hipFuncSetAttribute failed\n"); grid = -1; return; }
        (void)hipGetLastError();
        grid = cus;
    }
    if (grid < 0) return;
    if (hipMemsetAsync((char*)d_ws + WS_CTL, 0, CTL_ZERO_BYTES, stream) != hipSuccess) { fprintf(stderr, "kernel_launch: memset failed\n"); return; }
    Params p{};
    p.x = (const float*)d_in[0]; p.c = (const float*)d_in[1]; p.positions = (const int*)d_in[2]; p.ada_w = (const float*)d_in[3]; p.ada_b = (const float*)d_in[4];
    p.norm_mix_g = (const float*)d_in[5]; p.norm_ffn_g = (const float*)d_in[6]; p.final_norm_g = (const float*)d_in[7]; p.even_w_in = (const float*)d_in[8]; p.even_w_out = (const float*)d_in[9];
    p.gmlp_ln_g = (const float*)d_in[10]; p.gmlp_ln_b = (const float*)d_in[11]; p.gmlp_w_s = (const float*)d_in[12]; p.gmlp_b_s = (const float*)d_in[13]; p.hgrn_lb_logits = (const float*)d_in[14];
    p.hgrn_norm_g = (const float*)d_in[15]; p.odd_w_qkv = (const float*)d_in[16]; p.odd_w_out = (const float*)d_in[17]; p.peer_w_query = (const float*)d_in[18]; p.peer_sub_keys = (const float*)d_in[19];
    p.peer_down = (const float*)d_in[20]; p.peer_up = (const float*)d_in[21];
    p.out = (float*)d_out; p.ws = (unsigned char*)d_ws;
#if MK_ONE_LAUNCH
    p.ph_lo = 0; p.ph_hi = N_PHASES;
    hipLaunchKernelGGL(hybrid_fwd, dim3(grid), dim3(NWAVES * 64), LDS_BYTES, stream, p);
#else
    for (int ph = 0; ph < N_PHASES; ++ph) { p.ph_lo = ph; p.ph_hi = ph + 1; hipLaunchKernelGGL(hybrid_fwd, dim3(grid), dim3(NWAVES * 64), LDS_BYTES, stream, p); }
#endif
    const hipError_t le = hipPeekAtLastError();
    if (le != hipSuccess) fprintf(stderr, "kernel_launch: launch failed: %s\n", hipGetErrorName(le));
}
```

```cpp
#include <hip/hip_runtime.h>
#include <cstdio>
#include <cstdint>
#include <cmath>
namespace pg8 {
#define PG8_LAS __attribute__((address_space(3)))
typedef unsigned short bf16_t;
typedef short bf16x8 __attribute__((ext_vector_type(8)));
typedef float f32x4 __attribute__((ext_vector_type(4)));
typedef unsigned u32x4 __attribute__((ext_vector_type(4)));
constexpr int BM = 256, BK = 64, HALF = 128, HTB = HALF * BK * 2  , STAGE_BYTES = 8 * HTB, NXCD = 8, WGM = 8;

__host__ __device__ __forceinline__ int lds_byte(int r, int c) { const int st = (r >> 4) * 2 + (c >> 5), rr = r & 15, cc = c & 31, ob = rr * 64 + cc * 2; return st * 1024 + (ob ^ (((ob >> 9) & 1) << 5)); }
__host__ __device__ __forceinline__ void stage_rc(int b, int& R, int& C) { const int st = b / 1024, sb = b % 1024, swz = sb ^ (((sb >> 9) & 1) << 5); R = (st >> 1) * 16 + swz / 64; C = (st & 1) * 32 + (swz % 64) / 2; }
__host__ __device__ __forceinline__ int perm32(int rho) { const int n = rho >> 4, i = rho & 15; return 8 * (i >> 2) + 4 * n + (i & 3); }

struct Unit { int pm, pn; };
struct Gemm { const bf16_t* A; const bf16_t* Bt; int M, N, K; };

struct StaticOrder {
    int nM, nN, nwg, G, c;
    __host__ __device__ void init(int M, int N, int G_, int c_) { nM = M / BM; nN = N / BM; nwg = nM * nN; G = G_; c = c_; }
    __host__ __device__ bool next(int i, Unit& u) const {
        const long L = (long)i * G + c; if (L >= nwg) return false;
        int wgid = (int)L; { const int q = nwg / NXCD, r = nwg % NXCD, xcd = wgid % NXCD, off = wgid / NXCD; wgid = (xcd < r ? xcd * (q + 1) : r * (q + 1) + (xcd - r) * q) + off; }
        const int nig = WGM * nN, gid = wgid / nig, fm = gid * WGM, gsz = (nM - fm) < WGM ? (nM - fm) : WGM;
        u.pm = fm + ((wgid % nig) % gsz); u.pn = (wgid % nig) / gsz; return true;
    }
    __device__ __forceinline__ void a_ready(const Unit&) const {}
    __device__ __forceinline__ void done(const Unit&) const {}
};

__device__ __forceinline__ unsigned cvt_pk_bf16(float lo, float hi) { unsigned r; asm volatile("v_cvt_pk_bf16_f32 %0, %1, %2" : "=v"(r) : "v"(lo), "v"(hi)); return r; }
typedef float f32x2 __attribute__((ext_vector_type(2)));
__device__ __forceinline__ f32x2 gelu_pk(f32x2 v) {
    const f32x2 av = __builtin_elementwise_abs(v), d = av * 0.2316418882f + 1.0f;
    f32x2 t; t.x = __builtin_amdgcn_rcpf(d.x); t.y = __builtin_amdgcn_rcpf(d.y);
    f32x2 q = t * 0.5307027145f + (-0.7265760135f); q = q * t + 0.7107068705f; q = q * t + (-0.142248368f); q = q * t + 0.127414796f; q = q * t;
    const f32x2 s = (v * v) * (-0.72134752044f);
    f32x2 e; e.x = __builtin_amdgcn_exp2f(s.x); e.y = __builtin_amdgcn_exp2f(s.y);
    const f32x2 m = v * (q * e), r = v - m;
    f32x2 o; o.x = v.x < 0.f ? m.x : r.x; o.y = v.y < 0.f ? m.y : r.y; return o;
}

template <class Epi, class Sched, bool ALIGN_EPI = false, bool SP2 = false>
__device__ __forceinline__ void gemm_phase(PG8_LAS unsigned char* lds, const Gemm g, const Sched& S, const Epi& E) {
    const int tid = threadIdx.x, wid = __builtin_amdgcn_readfirstlane(tid >> 6), lane = tid & 63, wr = wid >> 2, wc = wid & 3, fr = lane & 15, fq = lane >> 4;
    const int K = g.K, nt = K / BK;
    unsigned voffA[2], voffB[2];
#pragma unroll
    for (int i = 0; i < 2; ++i) { int R, C; stage_rc(tid * 16 + i * 8192, R, C); const int Rb = Epi::PERM ? ((R & ~31) + perm32(R & 31)) : R;
        voffA[i] = (unsigned)(R * K + C) * 2u; voffB[i] = (unsigned)(Rb * K + C) * 2u; }
    const size_t kstep = (size_t)(BK * 2);
    const size_t hstep = (size_t)HALF * K * 2;
    const size_t tstep = 2 * hstep;
    const unsigned ldsw = (unsigned)wid * 1024u;
    const int aoff = lds_byte(wr * 64 + fr, fq * 8), boff = lds_byte(wc * 32 + fr, fq * 8);
#define PG8_SA(b, h) (((b) * 2 + (h)) * HTB)
#define PG8_SB(b, h) ((4 + (b) * 2 + (h)) * HTB)
#define PG8_STAGE(bufoff, gbase, voff) do { _Pragma("unroll") for (int _i = 0; _i < 2; ++_i) \
        __builtin_amdgcn_global_load_lds((const unsigned*)((const char*)(gbase) + (voff)[_i]), (PG8_LAS unsigned*)(lds + (bufoff) + ldsw + _i * 8192), 16, 0, 0); } while (0)
#define PG8_LDA(dst, b, h) do { _Pragma("unroll") for (int m = 0; m < 4; ++m) _Pragma("unroll") for (int k = 0; k < 2; ++k) dst[m][k] = *(const PG8_LAS bf16x8*)(lds + PG8_SA(b, h) + aoff + m * 2048 + k * 1024); } while (0)
#define PG8_LDB(dst, b, h) do { _Pragma("unroll") for (int n = 0; n < 2; ++n) _Pragma("unroll") for (int k = 0; k < 2; ++k) dst[n][k] = *(const PG8_LAS bf16x8*)(lds + PG8_SB(b, h) + boff + n * 2048 + k * 1024); } while (0)
#define PG8_MMA(ai, bj, At, Bt) do { __builtin_amdgcn_s_setprio(1); _Pragma("unroll") for (int m = 0; m < 4; ++m) _Pragma("unroll") for (int n = 0; n < 2; ++n) _Pragma("unroll") for (int k = 0; k < 2; ++k) \
        acc[ai][bj][m][n] = __builtin_amdgcn_mfma_f32_16x16x32_bf16(Bt[n][k], At[m][k], acc[ai][bj][m][n], 0, 0, 0); __builtin_amdgcn_s_setprio(0); } while (0)
#define PG8_WAIT_V(n) asm volatile("s_waitcnt vmcnt(" #n ")" ::: "memory")
#define PG8_WAIT_L(n) asm volatile("s_waitcnt lgkmcnt(" #n ")" ::: "memory")
#define PG8_BAR __builtin_amdgcn_s_barrier()
#define PG8_SCHED __builtin_amdgcn_sched_barrier(0)
    Unit cur, nxt; int ui = 0;
    if (!S.next(0, cur)) return;
    f32x4 acc[2][2][4][2];
#pragma unroll
    for (int a = 0; a < 2; ++a)
#pragma unroll
        for (int b = 0; b < 2; ++b)
#pragma unroll
            for (int m = 0; m < 4; ++m)
#pragma unroll
                for (int n = 0; n < 2; ++n) acc[a][b][m][n] = (f32x4){0.f, 0.f, 0.f, 0.f};
    bf16x8 At[4][2], B0[2][2], B1[2][2];
    const char* cA = (const char*)g.A + (size_t)cur.pm * tstep; const char* cB = (const char*)g.Bt + (size_t)cur.pn * tstep;
    S.a_ready(cur);
    if constexpr (SP2) {
        PG8_STAGE(PG8_SB(0, 0), cB, voffB); PG8_STAGE(PG8_SB(0, 1), cB + hstep, voffB); PG8_STAGE(PG8_SA(0, 0), cA, voffA); PG8_STAGE(PG8_SA(0, 1), cA + hstep, voffA);
        if (wr == 1) PG8_BAR;
        PG8_WAIT_V(2); PG8_BAR;
        PG8_STAGE(PG8_SB(1, 0), cB + kstep, voffB); PG8_STAGE(PG8_SA(1, 0), cA + kstep, voffA); PG8_STAGE(PG8_SB(1, 1), cB + hstep + kstep, voffB);
        PG8_WAIT_V(6); PG8_BAR;
    } else {
        PG8_STAGE(PG8_SB(0, 0), cB, voffB); PG8_STAGE(PG8_SA(0, 0), cA, voffA); PG8_STAGE(PG8_SB(0, 1), cB + hstep, voffB); PG8_STAGE(PG8_SA(0, 1), cA + hstep, voffA);
        if (wr == 1) PG8_BAR;
        PG8_WAIT_V(4); PG8_BAR;
        PG8_STAGE(PG8_SB(1, 0), cB + kstep, voffB); PG8_STAGE(PG8_SA(1, 0), cA + kstep, voffA); PG8_STAGE(PG8_SB(1, 1), cB + hstep + kstep, voffB);
        PG8_WAIT_V(6); PG8_BAR;
    }
    for (;;) {
        const bool has_next = S.next(ui + 1, nxt);
        const char* nA = has_next ? (const char*)g.A + (size_t)nxt.pm * tstep : cA; const char* nB = has_next ? (const char*)g.Bt + (size_t)nxt.pn * tstep : cB;
        for (int t = 0; t < nt; t += 2) {
            const bool last = (t == nt - 2);
            const char* a1 = cA + (size_t)(t + 1) * kstep;
            const char* a2 = last ? nA : cA + (size_t)(t + 2) * kstep; const char* b2 = last ? nB : cB + (size_t)(t + 2) * kstep;
            const char* a3 = a2 + kstep; const char* b3 = b2 + kstep;
            if (last && has_next) S.a_ready(nxt);
            if constexpr (SP2) {
            PG8_LDB(B0, 0, 0); PG8_LDB(B1, 0, 1); PG8_SCHED; PG8_LDA(At, 0, 0); PG8_STAGE(PG8_SA(1, 1), a1 + hstep, voffA);
            PG8_WAIT_V(8); PG8_WAIT_L(0); PG8_BAR; PG8_MMA(0, 0, At, B0); PG8_MMA(0, 1, At, B1); PG8_BAR; PG8_SCHED;
            PG8_LDA(At, 0, 1); PG8_STAGE(PG8_SB(0, 0), b2, voffB); PG8_STAGE(PG8_SB(0, 1), b2 + hstep, voffB); PG8_STAGE(PG8_SA(0, 0), a2, voffA);
            PG8_WAIT_V(8); PG8_WAIT_L(0); PG8_BAR; PG8_MMA(1, 0, At, B0); PG8_MMA(1, 1, At, B1); PG8_BAR; PG8_SCHED;
            PG8_LDB(B0, 1, 0); PG8_LDB(B1, 1, 1); PG8_SCHED; PG8_LDA(At, 1, 0); PG8_STAGE(PG8_SA(0, 1), a2 + hstep, voffA);
            PG8_WAIT_V(8); PG8_WAIT_L(0); PG8_BAR; PG8_MMA(0, 0, At, B0); PG8_MMA(0, 1, At, B1); PG8_BAR; PG8_SCHED;
            PG8_LDA(At, 1, 1); PG8_STAGE(PG8_SB(1, 0), b3, voffB); PG8_STAGE(PG8_SB(1, 1), b3 + hstep, voffB); PG8_STAGE(PG8_SA(1, 0), a3, voffA);
            PG8_WAIT_V(8); PG8_WAIT_L(0); PG8_BAR; PG8_MMA(1, 0, At, B0); PG8_MMA(1, 1, At, B1); PG8_BAR; PG8_SCHED;
            } else {
            PG8_LDB(B0, 0, 0); PG8_SCHED; PG8_LDA(At, 0, 0); PG8_STAGE(PG8_SA(1, 1), a1 + hstep, voffA);
            PG8_WAIT_L(8); PG8_BAR; PG8_WAIT_L(0); PG8_MMA(0, 0, At, B0); PG8_BAR; PG8_SCHED;
            PG8_LDB(B1, 0, 1); PG8_STAGE(PG8_SB(0, 0), b2, voffB);
            PG8_BAR; PG8_WAIT_L(0); PG8_MMA(0, 1, At, B1); PG8_BAR;
            PG8_LDA(At, 0, 1); PG8_STAGE(PG8_SA(0, 0), a2, voffA);
            PG8_BAR; PG8_WAIT_L(0); PG8_MMA(1, 0, At, B0); PG8_BAR; PG8_SCHED;
            PG8_STAGE(PG8_SB(0, 1), b2 + hstep, voffB);
            PG8_WAIT_V(6); PG8_BAR; PG8_MMA(1, 1, At, B1); PG8_BAR;
            PG8_LDB(B0, 1, 0); PG8_SCHED; PG8_LDA(At, 1, 0); PG8_STAGE(PG8_SA(0, 1), a2 + hstep, voffA);
            PG8_WAIT_L(8); PG8_BAR; PG8_WAIT_L(0); PG8_MMA(0, 0, At, B0); PG8_BAR; PG8_SCHED;
            PG8_LDB(B1, 1, 1); PG8_STAGE(PG8_SB(1, 0), b3, voffB);
            PG8_BAR; PG8_WAIT_L(0); PG8_MMA(0, 1, At, B1); PG8_BAR;
            PG8_LDA(At, 1, 1); PG8_STAGE(PG8_SA(1, 0), a3, voffA);
            PG8_BAR; PG8_WAIT_L(0); PG8_MMA(1, 0, At, B0); PG8_BAR; PG8_SCHED;
            PG8_STAGE(PG8_SB(1, 1), b3 + hstep, voffB);
            PG8_WAIT_V(6); PG8_BAR; PG8_MMA(1, 1, At, B1); PG8_BAR;
            }
        }
        if constexpr (ALIGN_EPI) { if (wr == 0) PG8_BAR; }
        if constexpr (!Epi::AFTER_DRAIN) { E(acc, cur, wr, wc, fr, fq); S.done(cur); }
        if (!has_next) break;
#pragma unroll
        for (int a = 0; a < 2; ++a)
#pragma unroll
            for (int b = 0; b < 2; ++b)
#pragma unroll
                for (int m = 0; m < 4; ++m)
#pragma unroll
                    for (int n = 0; n < 2; ++n) acc[a][b][m][n] = (f32x4){0.f, 0.f, 0.f, 0.f};
        cur = nxt; cA = nA; cB = nB; ++ui;
        if constexpr (ALIGN_EPI) { if (wr == 1) PG8_BAR; }
    }
    PG8_WAIT_V(0);
    if constexpr (!ALIGN_EPI) { if (wr == 0) PG8_BAR; }
    PG8_BAR;
    if constexpr (Epi::AFTER_DRAIN) { E.fused(acc, cur, wr, wc, fr, fq, lds, wid, lane); S.done(cur); }
#undef PG8_SA
#undef PG8_SB
#undef PG8_STAGE
#undef PG8_LDA
#undef PG8_LDB
#undef PG8_MMA
#undef PG8_WAIT_V
#undef PG8_WAIT_L
#undef PG8_BAR
#undef PG8_SCHED
}
}
#define GAS __attribute__((address_space(1)))
#define LAS __attribute__((address_space(3)))
typedef unsigned short bf16;
typedef unsigned v4u __attribute__((ext_vector_type(4)));
typedef float f32x4 __attribute__((ext_vector_type(4)));
typedef short bf16x8 __attribute__((ext_vector_type(8)));
typedef __bf16 bf16x2_t __attribute__((ext_vector_type(2)));
#define LDS_WAIT() asm volatile("s_waitcnt lgkmcnt(0)" ::: "memory")
#define VM_WAIT() asm volatile("s_waitcnt vmcnt(0)" ::: "memory")
__device__ __forceinline__ unsigned f2bf(float f) { unsigned u = __builtin_bit_cast(unsigned, f); return (u + 0x7fffu + ((u >> 16) & 1u)) >> 16; }
__device__ __forceinline__ unsigned pk2(float lo, float hi) { return f2bf(lo) | (f2bf(hi) << 16); }
__device__ __forceinline__ float bflo(unsigned u) { return __builtin_bit_cast(float, u << 16); }
__device__ __forceinline__ float bfhi(unsigned u) { return __builtin_bit_cast(float, u & 0xffff0000u); }
__device__ __forceinline__ float bf2f(bf16 u) { return __builtin_bit_cast(float, (unsigned)u << 16); }
#define XB_TMO      128
#define XB_XCNT(j)  (256  + 64 * (j))
#define XB_XSUB(j)  (1280 + 64 * (j))
#define XB_XGEN(j)  (2304 + 64 * (j))
#define XB_TOP      3328
#define XB_TOPGEN   3392
#define XCD_BAR_WORDS 3456
#define XB_SPIN_CAP (1u << 18)

__device__ __forceinline__ unsigned xb_ld(unsigned* p)              { return __hip_atomic_load(p, __ATOMIC_RELAXED, __HIP_MEMORY_SCOPE_AGENT); }
__device__ __forceinline__ unsigned xb_add(unsigned* p, unsigned v) { return __hip_atomic_fetch_add(p, v, __ATOMIC_RELAXED, __HIP_MEMORY_SCOPE_AGENT); }
__device__ __forceinline__ unsigned xb_xcc_id() { return (unsigned)__builtin_amdgcn_s_getreg((3 << 11) | 20) & 0xFu; }
#define XB_SPIN(cond, bar) do { unsigned _sp = 0; while (cond) { __builtin_amdgcn_s_sleep(1); \
    if ((++_sp & 255u) == 0u) { if (xb_ld(&(bar)[XB_TMO])) break; if (_sp > XB_SPIN_CAP) { atomicAdd(&(bar)[XB_TMO], 1u); break; } } } } while (0)

struct XcdBarrier {
    unsigned* bar; unsigned x;
    volatile LAS unsigned* st;
};

__device__ __forceinline__ XcdBarrier xcd_barrier_post(unsigned* bar, volatile LAS unsigned* st) {
    XcdBarrier b; b.bar = bar; b.x = xb_xcc_id(); b.st = st;
    if (threadIdx.x == 0) (void)xb_add(&bar[XB_XCNT(b.x)], 1u);
    return b;
}
__device__ __forceinline__ void xcd_barrier_complete(unsigned* bar, unsigned x, unsigned& nloc, unsigned& nx) {
    const unsigned G = gridDim.x * gridDim.y * gridDim.z;
    unsigned sum, cnt, mine, sp = 0u;
    for (;;) {
        sum = 0u; cnt = 0u; mine = 0u;
#pragma unroll
        for (unsigned j = 0; j < 16; ++j) { const unsigned c = xb_ld(&bar[XB_XCNT(j)]); sum += c; cnt += (c > 0u) ? 1u : 0u; mine = (j == x) ? c : mine; }
        if (sum == G) break;
        __builtin_amdgcn_s_sleep(1);
        if ((++sp & 255u) == 0u) { if (xb_ld(&bar[XB_TMO])) break; if (sp > XB_SPIN_CAP) { atomicAdd(&bar[XB_TMO], 1u); break; } }
    }
    nloc = mine > 0u ? mine : 1u; nx = cnt > 0u ? cnt : 1u;
}

__device__ __forceinline__ void xcd_barrier(const XcdBarrier& b) {
    asm volatile("s_waitcnt vmcnt(0)" ::: "memory");
    __syncthreads();
    if (threadIdx.x == 0) {
        unsigned* bar = b.bar;
        __builtin_amdgcn_s_waitcnt(0);
        unsigned nloc = b.st[0], nx = b.st[1];
        if (nloc == 0u) { xcd_barrier_complete(bar, b.x, nloc, nx); b.st[0] = nloc; b.st[1] = nx; }
        const unsigned old = xb_add(&bar[XB_XSUB(b.x)], 1u);
        const unsigned gen = old / nloc;
        if (old + 1u == (gen + 1u) * nloc) {
            __builtin_amdgcn_fence(__ATOMIC_RELEASE, "agent");
            asm volatile("s_waitcnt vmcnt(0)" ::: "memory");
            const unsigned og = xb_add(&bar[XB_TOP], 1u);
            const unsigned tg = og / nx;
            if (og + 1u == (tg + 1u) * nx) xb_add(&bar[XB_TOPGEN], 1u);
            else XB_SPIN(xb_ld(&bar[XB_TOPGEN]) == tg, bar);
            __builtin_amdgcn_fence(__ATOMIC_ACQUIRE, "agent");
            xb_add(&bar[XB_XGEN(b.x)], 1u);
            asm volatile("s_waitcnt vmcnt(0)" ::: "memory");
        } else {
            XB_SPIN(xb_ld(&bar[XB_XGEN(b.x)]) == gen, bar);
            __builtin_amdgcn_fence(__ATOMIC_ACQUIRE, "agent");
            asm volatile("s_waitcnt vmcnt(0)" ::: "memory");
        }
    }
    __syncthreads();
}

constexpr int NB = 8, SEQ = 8192, DM = 1024, T = NB * SEQ;
constexpr int NWAVES = 8;
constexpr float NORM_EPS = 1e-6f;
constexpr float C2 = 0.125f * 1.4426950408889634f;

constexpr size_t MiB = 1u << 20;
constexpr size_t WS_CTL = 0, CTL_ZERO_BYTES = 1 * MiB;
constexpr size_t WS_MOD = 1 * MiB;
constexpr size_t WS_SKB = 1 * MiB + 512 * 1024;
constexpr size_t WS_WSB = 1 * MiB + 768 * 1024;
constexpr size_t WS_LB  = 1 * MiB + 960 * 1024;
constexpr size_t WS_CS  = 2 * MiB;
constexpr size_t WS_HD  = 6 * MiB;
constexpr size_t WS_WIN = 16 * MiB, WS_WOUT0 = 22 * MiB, WS_WQKV = 24 * MiB, WS_WOUT1 = 30 * MiB, WS_WQ0 = 32 * MiB, WS_WQ1 = 36 * MiB;
constexpr size_t WS_TAB8 = 40 * MiB, TAB8_BYTES = 16 * MiB;
constexpr int TROW = 1024;
constexpr size_t WS_SC8 = 8 * MiB;
constexpr size_t WS_H = 108 * MiB;
constexpr size_t WS_BIG = 236 * MiB;
constexpr size_t WS_PU = WS_BIG, WS_PV = WS_BIG + 64 * MiB, WS_PQ = WS_BIG + 128 * MiB, WS_PI = WS_BIG + 192 * MiB, WS_PG = WS_BIG + 256 * MiB;
constexpr size_t WS_G = WS_BIG + 320 * MiB;
constexpr size_t WS_KVT = WS_BIG + 448 * MiB;
constexpr size_t WS_ST = WS_BIG + 576 * MiB;
constexpr size_t WS_QP = WS_BIG;
constexpr size_t WS_IDX = WS_BIG + 256 * MiB, WS_GATE = WS_BIG + 288 * MiB;
constexpr size_t WS_QK = WS_BIG;
constexpr size_t WS_VT = WS_BIG + 256 * MiB;
constexpr size_t WS_END = WS_BIG + 704 * MiB;
constexpr int CW_BAR = 4096;

constexpr int LDS_BYTES = 147456;
constexpr int LDSCTL_OFF = LDS_BYTES - 512;
constexpr int MISC_OFF = LDSCTL_OFF;

struct Params {
    const float* x; const float* c; const int* positions; const float* ada_w; const float* ada_b; const float* norm_mix_g; const float* norm_ffn_g; const float* final_norm_g;
    const float* even_w_in; const float* even_w_out; const float* gmlp_ln_g; const float* gmlp_ln_b; const float* gmlp_w_s; const float* gmlp_b_s; const float* hgrn_lb_logits; const float* hgrn_norm_g;
    const float* odd_w_qkv; const float* odd_w_out; const float* peer_w_query; const float* peer_sub_keys; const float* peer_down; const float* peer_up;
    float* out; unsigned char* ws; int ph_lo, ph_hi;
};
struct Ctx { LAS unsigned char* lds; int tid, lane, wave, vcu, G; };

__device__ __forceinline__ float wave_sum(float v) {
#pragma unroll
    for (int o = 1; o < 64; o <<= 1) v += __shfl_xor(v, o);
    return v;
}
__device__ __forceinline__ float silu_f(float x) { return x * __builtin_amdgcn_rcpf(1.0f + __builtin_amdgcn_exp2f(-1.4426950408889634f * x)); }
__device__ __forceinline__ float sigmoid_f(float x) { return __builtin_amdgcn_rcpf(1.0f + __builtin_amdgcn_exp2f(-1.4426950408889634f * x)); }
__device__ __forceinline__ float gelu_f(float x) { return 0.5f * x * (1.0f + erff(x * 0.70710678118654752f)); }
__device__ __forceinline__ f32x4 mma16(f32x4 acc, const LAS bf16* A, int lda, const LAS bf16* Bt, int ldb, int K, int r, int q4) {
    const LAS bf16* ap = A + r * lda + 8 * q4; const LAS bf16* bp = Bt + r * ldb + 8 * q4;
    for (int k0 = 0; k0 < K; k0 += 32) {
        const bf16x8 a = *(const LAS bf16x8*)(ap + k0); const bf16x8 b = *(const LAS bf16x8*)(bp + k0);
        acc = __builtin_amdgcn_mfma_f32_16x16x32_bf16(a, b, acc, 0, 0, 0);
    }
    return acc;
}

struct EpiBf16P {
    static constexpr bool PERM = true, AFTER_DRAIN = false;
    bf16* O; size_t ldc;
    __device__ __forceinline__ void operator()(const f32x4 (&acc)[2][2][4][2], const pg8::Unit& u, int wr, int wc, int fr, int fq) const {
        const int row0 = u.pm * 256 + wr * 64 + fr, col0 = u.pn * 256 + wc * 32 + 8 * fq;
#pragma unroll
        for (int ai = 0; ai < 2; ++ai)
#pragma unroll
            for (int m = 0; m < 4; ++m) { bf16* rowp = O + (size_t)(row0 + ai * 128 + m * 16) * ldc + col0;
#pragma unroll
                for (int bj = 0; bj < 2; ++bj) { const f32x4 v0 = acc[ai][bj][m][0], v1 = acc[ai][bj][m][1];
                    v4u w; w.x = pg8::cvt_pk_bf16(v0[0], v0[1]); w.y = pg8::cvt_pk_bf16(v0[2], v0[3]); w.z = pg8::cvt_pk_bf16(v1[0], v1[1]); w.w = pg8::cvt_pk_bf16(v1[2], v1[3]);
                    *(v4u*)(rowp + bj * 128) = w; } }
    }
};
#ifndef REP_HG
#define REP_HG 1
#endif
#ifndef REP_TOPK
#define REP_TOPK 1
#endif
#ifndef REP_PRO
#define REP_PRO 1
#endif
#ifndef REP_NORM
#define REP_NORM 1
#endif
#ifndef REP_GEMM2
#define REP_GEMM2 1
#endif
#ifndef REP_GEMM
#define REP_GEMM 1
#endif
#ifndef EXP_REP
#define EXP_REP 1
#endif
#ifndef ATT_REP
#define ATT_REP 1
#endif
#ifndef ABL_ON
#define ABL_ON 4
#endif
struct EpiResid {
    static constexpr bool PERM = true, AFTER_DRAIN = false;
    const float* xin; float* xout; const float* gate; float gsc;
    __device__ __forceinline__ void operator()(const f32x4 (&acc)[2][2][4][2], const pg8::Unit& u, int wr, int wc, int fr, int fq) const {
        const int row0 = u.pm * 256 + wr * 64 + fr, col0 = u.pn * 256 + wc * 32 + 8 * fq;
        const float* gp = gate + (size_t)((u.pm * 256) >> 13) * 6144 + col0;
        f32x4 gv[2][2];
#pragma unroll
        for (int bj = 0; bj < 2; ++bj) { gv[bj][0] = *(const f32x4*)(gp + bj * 128); gv[bj][1] = *(const f32x4*)(gp + bj * 128 + 4); }
#pragma unroll
        for (int ai = 0; ai < 2; ++ai)
#pragma unroll
            for (int m = 0; m < 4; ++m) { const size_t off = (size_t)(row0 + ai * 128 + m * 16) * 1024 + col0;
#pragma unroll
                for (int bj = 0; bj < 2; ++bj) {
                    const f32x4 x0 = *(const f32x4*)(xin + off + bj * 128), x1 = *(const f32x4*)(xin + off + bj * 128 + 4);
                    *(f32x4*)(xout + off + bj * 128) = x0 + gv[bj][0] * acc[ai][bj][m][0] * gsc;
                    *(f32x4*)(xout + off + bj * 128 + 4) = x1 + gv[bj][1] * acc[ai][bj][m][1] * gsc; }
                asm volatile("" ::: "memory"); }
    }
};
struct EpiInProj {
    static constexpr bool PERM = true, AFTER_DRAIN = false;
    bf16* PU; bf16* PV; bf16* PQ; bf16* PI; bf16* PG; float* G; const float* LB;
    __device__ __forceinline__ void operator()(const f32x4 (&acc)[2][2][4][2], const pg8::Unit& u, int wr, int wc, int fr, int fq) const {
        const int type = u.pn >> 1;
        const int row0 = u.pm * 256 + wr * 64 + fr, lc0 = (u.pn & 1) * 256 + wc * 32 + 8 * fq;
        if (type == 3) {
            f32x4 lb[2][2];
#pragma unroll
            for (int bj = 0; bj < 2; ++bj) { lb[bj][0] = *(const f32x4*)(LB + lc0 + bj * 128); lb[bj][1] = *(const f32x4*)(LB + lc0 + bj * 128 + 4); }
#pragma unroll
            for (int ai = 0; ai < 2; ++ai)
#pragma unroll
                for (int m = 0; m < 4; ++m) { float* rowp = G + (size_t)(row0 + ai * 128 + m * 16) * 512 + lc0;
#pragma unroll
                    for (int bj = 0; bj < 2; ++bj)
#pragma unroll
                        for (int n = 0; n < 2; ++n) { const f32x4 v = acc[ai][bj][m][n]; f32x4 o;
#pragma unroll
                            for (int e = 0; e < 4; ++e) { const float l = lb[bj][n][e]; const float f = l + (1.0f - l) * sigmoid_f(v[e]); o[e] = __logf(f); }
                            *(f32x4*)(rowp + bj * 128 + 4 * n) = o; } }
            return;
        }
        bf16* base = type == 0 ? PU : type == 1 ? PV : type == 2 ? PQ : type == 4 ? PI : PG;
#pragma unroll
        for (int ai = 0; ai < 2; ++ai)
#pragma unroll
            for (int m = 0; m < 4; ++m) { bf16* rowp = base + (size_t)(row0 + ai * 128 + m * 16) * 512 + lc0;
#pragma unroll
                for (int bj = 0; bj < 2; ++bj) { f32x4 v0 = acc[ai][bj][m][0], v1 = acc[ai][bj][m][1];
                    if (type <= 1) { pg8::f32x2 a = pg8::gelu_pk((pg8::f32x2){v0[0], v0[1]}), b = pg8::gelu_pk((pg8::f32x2){v0[2], v0[3]}), c = pg8::gelu_pk((pg8::f32x2){v1[0], v1[1]}), d = pg8::gelu_pk((pg8::f32x2){v1[2], v1[3]});
                        v0 = (f32x4){a.x, a.y, b.x, b.y}; v1 = (f32x4){c.x, c.y, d.x, d.y}; }
                    else if (type == 2) {
#pragma unroll
                        for (int e = 0; e < 4; ++e) { v0[e] = silu_f(v0[e]) * 0.08838834764831845f; v1[e] = silu_f(v1[e]) * 0.08838834764831845f; } }
                    else if (type == 5) {
#pragma unroll
                        for (int e = 0; e < 4; ++e) { v0[e] = silu_f(v0[e]); v1[e] = silu_f(v1[e]); } }
                    v4u w; w.x = pg8::cvt_pk_bf16(v0[0], v0[1]); w.y = pg8::cvt_pk_bf16(v0[2], v0[3]); w.z = pg8::cvt_pk_bf16(v1[0], v1[1]); w.w = pg8::cvt_pk_bf16(v1[2], v1[3]);
                    *(v4u*)(rowp + bj * 128) = w; } }
    }
};
struct EpiQKRot {
    static constexpr bool PERM = true, AFTER_DRAIN = false;
    bf16* O; const float* CS;
    __device__ __forceinline__ void operator()(const f32x4 (&acc)[2][2][4][2], const pg8::Unit& u, int wr, int wc, int fr, int fq) const {
        const int row0 = u.pm * 256 + wr * 64 + fr, col0 = u.pn * 256 + wc * 32 + 8 * fq;
        const float sc = u.pn < 4 ? C2 : 1.0f;
        const bool rotw = (wc & 1) == 0 && u.pn < 8;
        const float sgn = fq == 0 ? -1.0f : 1.0f;
#pragma unroll
        for (int ai = 0; ai < 2; ++ai)
#pragma unroll
            for (int m = 0; m < 4; ++m) { const int row = row0 + ai * 128 + m * 16; bf16* rowp = O + (size_t)row * 3072 + col0;
                f32x4 c0 = (f32x4){1.f, 1.f, 1.f, 1.f}, c1 = c0, s0 = (f32x4){0.f, 0.f, 0.f, 0.f}, s1 = s0;
                if (rotw && fq < 2) { const float* cp = CS + (size_t)row * 16; c0 = *(const f32x4*)(cp); c1 = *(const f32x4*)(cp + 4); s0 = *(const f32x4*)(cp + 8) * sgn; s1 = *(const f32x4*)(cp + 12) * sgn; }
#pragma unroll
                for (int bj = 0; bj < 2; ++bj) { f32x4 v0 = acc[ai][bj][m][0], v1 = acc[ai][bj][m][1];
                    if (rotw) { f32x4 p0, p1;
#pragma unroll
                        for (int e = 0; e < 4; ++e) { p0[e] = __shfl_xor(v0[e], 16); p1[e] = __shfl_xor(v1[e], 16); }
                        v0 = v0 * c0 + p0 * s0; v1 = v1 * c1 + p1 * s1; }
                    v0 = v0 * sc; v1 = v1 * sc;
                    v4u w; w.x = pg8::cvt_pk_bf16(v0[0], v0[1]); w.y = pg8::cvt_pk_bf16(v0[2], v0[3]); w.z = pg8::cvt_pk_bf16(v1[0], v1[1]); w.w = pg8::cvt_pk_bf16(v1[2], v1[3]);
                    *(v4u*)(rowp + bj * 128) = w; } }
    }
};

__device__ __forceinline__ void p0_transpose_item(const float* W, int K, int N, bf16* WT, LAS float* scr, int item, int lane) {
    const int nblk = N / 32, kb = item / nblk, nb = item % nblk, k0 = 64 * kb, n0 = 32 * nb;
#pragma unroll 8
    for (int i = 0; i < 32; ++i) { const int kk = 2 * i + (lane >> 5); scr[kk * 33 + (lane & 31)] = W[(size_t)(k0 + kk) * N + n0 + (lane & 31)]; }
    LDS_WAIT(); asm volatile("" ::: "memory");
    const int c = lane & 7;
#pragma unroll
    for (int j = 0; j < 4; ++j) { const int n = (lane >> 3) + 8 * j; const LAS float* s = scr + (8 * c) * 33 + n;
        v4u o; o.x = pk2(s[0 * 33], s[1 * 33]); o.y = pk2(s[2 * 33], s[3 * 33]); o.z = pk2(s[4 * 33], s[5 * 33]); o.w = pk2(s[6 * 33], s[7 * 33]);
        *(GAS v4u*)(WT + (size_t)(n0 + n) * K + k0 + 8 * c) = o; }
    LDS_WAIT(); asm volatile("" ::: "memory");
}
typedef float f32x2 __attribute__((ext_vector_type(2)));
__device__ __forceinline__ void convert_tables(const Params& P, const Ctx& C) {
    const int gw = C.vcu * NWAVES + C.wave, NGW = C.G * NWAVES, lane = C.lane;
    for (int row = gw; row < 4 * 16384; row += NGW) {
        const int tb = row >> 14, e = row & 16383;
        const float* src = ((tb & 1) ? P.peer_up : P.peer_down) + ((size_t)(tb >> 1) * 16384 + e) * 1024;
        unsigned char* dst = P.ws + WS_TAB8 + (size_t)tb * TAB8_BYTES + (size_t)e * TROW;
        f32x4 v[4]; float mx = 0.f;
#pragma unroll
        for (int j = 0; j < 4; ++j) { v[j] = ((const f32x4*)src)[64 * j + lane]; mx = fmaxf(mx, fmaxf(fmaxf(fabsf(v[j][0]), fabsf(v[j][1])), fmaxf(fabsf(v[j][2]), fabsf(v[j][3])))); }
#pragma unroll
        for (int o = 1; o < 64; o <<= 1) mx = fmaxf(mx, __shfl_xor(mx, o));
        const float sc = mx > 0.f ? 400.0f / mx : 0.f;
#pragma unroll
        for (int j = 0; j < 4; ++j) { int p = __builtin_amdgcn_cvt_pk_fp8_f32(v[j][0] * sc, v[j][1] * sc, 0, false); p = __builtin_amdgcn_cvt_pk_fp8_f32(v[j][2] * sc, v[j][3] * sc, p, true);
            ((unsigned*)dst)[64 * j + lane] = (unsigned)p; }
        if (lane == 0) ((float*)(P.ws + WS_SC8))[row] = mx * (1.0f / 400.0f);
    }
}
__device__ __forceinline__ void phase_prologue(const Params& P, const Ctx& C) {
    float* MOD = (float*)(P.ws + WS_MOD);
    {
        LAS float* cond = (LAS float*)C.lds;
        LAS float* part = (LAS float*)(C.lds + 32768);
        for (int e = C.tid; e < 8192; e += 512) cond[e] = silu_f(P.c[e]);
        __syncthreads();
        for (int item = C.vcu; item < 192; item += C.G) {
            const int l = item / 96, cb = item % 96, col = cb * 64 + C.lane;
            float acc[8];
#pragma unroll
            for (int b = 0; b < 8; ++b) acc[b] = 0.f;
            const float* wp = P.ada_w + ((size_t)l * 1024 + C.wave * 128) * 6144 + col;
#pragma unroll 4
            for (int k = 0; k < 128; ++k) { const float wv = wp[(size_t)k * 6144];
#pragma unroll
                for (int b = 0; b < 8; ++b) acc[b] += cond[b * 1024 + C.wave * 128 + k] * wv; }
#pragma unroll
            for (int b = 0; b < 8; ++b) part[(C.wave * 8 + b) * 64 + C.lane] = acc[b];
            __syncthreads();
            { const int b = C.tid >> 6, ln = C.tid & 63; float s = P.ada_b[l * 6144 + cb * 64 + ln];
#pragma unroll
              for (int w = 0; w < 8; ++w) s += part[(w * 8 + b) * 64 + ln];
              MOD[(size_t)(l * 8 + b) * 6144 + cb * 64 + ln] = s; }
            __syncthreads();
        }
        __syncthreads();
    }
    {
        LAS float* scr = (LAS float*)(C.lds + C.wave * 16384);
        const int gw = C.vcu * NWAVES + C.wave, NGW = C.G * NWAVES;
        for (int it = gw; it < 6144; it += NGW) {
            int r = it;
            if (r < 1536) { p0_transpose_item(P.even_w_in, 1024, 3072, (bf16*)(P.ws + WS_WIN), scr, r, C.lane); continue; } r -= 1536;
            if (r < 512)  { p0_transpose_item(P.even_w_out, 1024, 1024, (bf16*)(P.ws + WS_WOUT0), scr, r, C.lane); continue; } r -= 512;
            if (r < 1536) { p0_transpose_item(P.odd_w_qkv, 1024, 3072, (bf16*)(P.ws + WS_WQKV), scr, r, C.lane); continue; } r -= 1536;
            if (r < 512)  { p0_transpose_item(P.odd_w_out, 1024, 1024, (bf16*)(P.ws + WS_WOUT1), scr, r, C.lane); continue; } r -= 512;
            if (r < 1024) { p0_transpose_item(P.peer_w_query, 1024, 2048, (bf16*)(P.ws + WS_WQ0), scr, r, C.lane); continue; } r -= 1024;
            p0_transpose_item(P.peer_w_query + (size_t)1024 * 2048, 1024, 2048, (bf16*)(P.ws + WS_WQ1), scr, r, C.lane);
        }
    }
    convert_tables(P, C);
    const int NT = C.G * 512, gt = C.vcu * 512 + C.tid;
    { bf16* skb = (bf16*)(P.ws + WS_SKB); for (int i = gt; i < 65536; i += NT) skb[i] = (bf16)f2bf(P.peer_sub_keys[i]); }
    { bf16* wsb = (bf16*)(P.ws + WS_WSB); for (int i = gt; i < 65536; i += NT) { const int t = (i >> 7) & 127, s = i & 127; wsb[i] = (bf16)(s <= t ? f2bf(P.gmlp_w_s[i]) : 0u); } }
    { float* lb = (float*)(P.ws + WS_LB); for (int i = gt; i < 512; i += NT) { const float l0 = P.hgrn_lb_logits[i], l1 = P.hgrn_lb_logits[512 + i]; lb[i] = 1.0f / (1.0f + expf(l1 - l0)); } }
    { float* cs = (float*)(P.ws + WS_CS); for (int i = gt; i < T * 8; i += NT) { const int tok = i >> 3, j = i & 7;
        const float inv = 1.0f / powf(500000.0f, (float)j * 0.125f); const float ang = (float)P.positions[tok] * inv; float sn, cn; sincosf(ang, &sn, &cn);
        cs[(size_t)tok * 16 + j] = cn; cs[(size_t)tok * 16 + 8 + j] = sn; } }
}
__device__ __forceinline__ void norm_row_bf16(const float* xrow, bf16* hrow, const float* g, const float* sh, const float* sc, int lane) {
    const f32x4* xr = (const f32x4*)xrow + lane; f32x4 v[4]; float s = 0.f;
#pragma unroll
    for (int j = 0; j < 4; ++j) { v[j] = xr[64 * j]; s += (v[j][0] * v[j][0] + v[j][1] * v[j][1]) + (v[j][2] * v[j][2] + v[j][3] * v[j][3]); }
    const float rstd = 1.0f / sqrtf(wave_sum(s) * (1.0f / 1024.0f) + NORM_EPS);
    unsigned long long* o8 = (unsigned long long*)hrow + lane;
#pragma unroll
    for (int j = 0; j < 4; ++j) { const f32x4 gg = ((const f32x4*)g)[64 * j + lane], hh = ((const f32x4*)sh)[64 * j + lane], cc = ((const f32x4*)sc)[64 * j + lane];
        const f32x4 y = (v[j] * rstd * gg) * (cc + 1.0f) + hh;
        o8[64 * j] = (unsigned long long)pk2(y[0], y[1]) | ((unsigned long long)pk2(y[2], y[3]) << 32); }
}
__device__ __forceinline__ void phase_norm(const Params& P, const Ctx& C, const float* xsrc, const float* g, int l, int so) {
    const float* MOD = (const float*)(P.ws + WS_MOD); bf16* H = (bf16*)(P.ws + WS_H);
    const int gw = C.vcu * NWAVES + C.wave, NGW = C.G * NWAVES;
    for (int m = gw; m < T; m += NGW) { const float* mb = MOD + (size_t)(l * 8 + (m >> 13)) * 6144 + so;
        norm_row_bf16(xsrc + (size_t)m * 1024, H + (size_t)m * 1024, g, mb, mb + 1024, C.lane); }
}

__device__ __forceinline__ void gmlp_item(const Params& P, const Ctx& C, int n, int g) {
    LAS bf16* Wt = (LAS bf16*)C.lds;
    LAS bf16* vT = (LAS bf16*)(C.lds + 34816);
    const bf16* WSB = (const bf16*)(P.ws + WS_WSB); const bf16* PU = (const bf16*)(P.ws + WS_PU); const bf16* PV = (const bf16*)(P.ws + WS_PV); bf16* MIX = (bf16*)(P.ws + WS_H);
    const int tid = C.tid, r = C.lane & 15, q4 = C.lane >> 4;
    for (int ch = tid; ch < 2048; ch += 512) { const int rr = ch >> 4, c8 = (ch & 15) * 8; *(LAS v4u*)(Wt + rr * 136 + c8) = *(const v4u*)(WSB + (size_t)(g * 128 + rr) * 128 + c8); }
    { const int t = tid >> 2, part = tid & 3; const bf16* src = PV + (size_t)(n * 128 + t) * 512 + g * 128 + part * 32;
      float x[32];
#pragma unroll
      for (int j = 0; j < 4; ++j) { const v4u w = *(const v4u*)(src + 8 * j);
#pragma unroll
          for (int e = 0; e < 4; ++e) { x[8 * j + 2 * e] = bflo(w[e]); x[8 * j + 2 * e + 1] = bfhi(w[e]); } }
      float s = 0.f;
#pragma unroll
      for (int j = 0; j < 32; ++j) s += x[j];
      s += __shfl_xor(s, 1); s += __shfl_xor(s, 2);
      const float mean = s * (1.0f / 128.0f); float q = 0.f;
#pragma unroll
      for (int j = 0; j < 32; ++j) { const float d = x[j] - mean; q += d * d; }
      q += __shfl_xor(q, 1); q += __shfl_xor(q, 2);
      const float rstd = 1.0f / sqrtf(q * (1.0f / 128.0f) + NORM_EPS);
      const float* lg = P.gmlp_ln_g + g * 128 + part * 32; const float* lbp = P.gmlp_ln_b + g * 128 + part * 32;
#pragma unroll
      for (int j = 0; j < 32; ++j) vT[(part * 32 + j) * 136 + t] = (bf16)f2bf((x[j] - mean) * rstd * lg[j] + lbp[j]);
    }
    __syncthreads();
    const int t0 = 16 * C.wave; const int Keff = ((t0 + 16 + 31) >> 5) << 5;
    f32x4 acc[8];
#pragma unroll
    for (int ct = 0; ct < 8; ++ct) { acc[ct] = (f32x4){0.f, 0.f, 0.f, 0.f}; acc[ct] = mma16(acc[ct], Wt + t0 * 136, 136, vT + (16 * ct) * 136, 136, Keff, r, q4); }
#pragma unroll
    for (int i = 0; i < 4; ++i) { const int t = t0 + 4 * q4 + i; const float bs = P.gmlp_b_s[g * 128 + t]; const size_t tok = (size_t)n * 128 + t;
#pragma unroll
        for (int ct = 0; ct < 8; ++ct) { const int c = 16 * ct + r; const float u = bf2f(PU[tok * 512 + g * 128 + c]); MIX[tok * 1024 + g * 128 + c] = (bf16)f2bf(u * (acc[ct][i] + bs)); } }
    __syncthreads();
}
__device__ __forceinline__ void hgrn_cumsum16(const float* G, size_t tok0, int hh, int k, int seg, LAS float* tot, float (&g)[16], float (&bb)[16], float& total) {
    const float* gp = G + (tok0 + seg * 16) * 512 + hh * 128 + k;
#pragma unroll
    for (int j = 0; j < 16; ++j) g[j] = gp[(size_t)j * 512];
    float run = 0.f;
#pragma unroll
    for (int j = 0; j < 16; ++j) { run += g[j]; bb[j] = run; }
    tot[seg * 128 + k] = run;
    __syncthreads();
    const float t0 = tot[k], t1 = tot[128 + k], t2 = tot[256 + k], t3 = tot[384 + k];
    const float pre = seg == 0 ? 0.f : seg == 1 ? t0 : seg == 2 ? t0 + t1 : t0 + t1 + t2;
    total = (t0 + t1) + (t2 + t3);
#pragma unroll
    for (int j = 0; j < 16; ++j) bb[j] += pre;
}
__device__ __forceinline__ void hgrn_stage_iT(const bf16* PI, size_t tok0, int hh, LAS bf16* iT, int tid) {
    const int s = tid >> 3, v0 = (tid & 7) * 16; const bf16* src = PI + (tok0 + s) * 512 + hh * 128 + v0;
#pragma unroll
    for (int h2 = 0; h2 < 2; ++h2) { const v4u w = *(const v4u*)(src + 8 * h2);
#pragma unroll
        for (int e = 0; e < 4; ++e) { iT[(v0 + 8 * h2 + 2 * e) * 72 + s] = (bf16)(w[e] & 0xffffu); iT[(v0 + 8 * h2 + 2 * e + 1) * 72 + s] = (bf16)(w[e] >> 16); } }
}
__device__ __forceinline__ void hgrn_local_item(const Params& P, const Ctx& C, int item) {
    LAS bf16* khT = (LAS bf16*)C.lds;
    LAS bf16* iT = (LAS bf16*)(C.lds + 18432);
    LAS float* tot = (LAS float*)(C.lds + 36864);
    const float* G = (const float*)(P.ws + WS_G); const bf16* PI = (const bf16*)(P.ws + WS_PI); bf16* KVT = (bf16*)(P.ws + WS_KVT); float* HD = (float*)(P.ws + WS_HD);
    const int bh = item >> 7, c = item & 127, b = bh >> 2, hh = bh & 3; const size_t tok0 = (size_t)b * SEQ + c * 64;
    const int tid = C.tid, k = tid & 127, seg = tid >> 7, r = C.lane & 15, q4 = C.lane >> 4;
    float g[16], bb[16], total;
    hgrn_cumsum16(G, tok0, hh, k, seg, tot, g, bb, total);
    { unsigned w[8];
#pragma unroll
      for (int j = 0; j < 8; ++j) { const float a0 = -expm1f(g[2 * j]) * __expf(total - bb[2 * j]), a1 = -expm1f(g[2 * j + 1]) * __expf(total - bb[2 * j + 1]); w[j] = pk2(a0, a1); }
      LAS v4u* dst = (LAS v4u*)(khT + k * 72 + seg * 16); dst[0] = (v4u){w[0], w[1], w[2], w[3]}; dst[1] = (v4u){w[4], w[5], w[6], w[7]}; }
    if (seg == 0) HD[(size_t)item * 128 + k] = __expf(total);
    hgrn_stage_iT(PI, tok0, hh, iT, tid);
    __syncthreads();
    const int v0 = 16 * C.wave;
#pragma unroll
    for (int ct = 0; ct < 8; ++ct) { f32x4 acc = (f32x4){0.f, 0.f, 0.f, 0.f}; acc = mma16(acc, iT + v0 * 72, 72, khT + (16 * ct) * 72, 72, 64, r, q4);
#pragma unroll
        for (int i = 0; i < 4; ++i) KVT[((size_t)item * 128 + v0 + 4 * q4 + i) * 128 + 16 * ct + r] = (bf16)f2bf(acc[i]); }
    __syncthreads();
}
__device__ __forceinline__ void phase_hgrn_scan(const Params& P, const Ctx& C) {
    const bf16* KVT = (const bf16*)(P.ws + WS_KVT); bf16* ST = (bf16*)(P.ws + WS_ST); const float* HD = (const float*)(P.ws + WS_HD);
    for (int task = C.vcu * 256 + C.tid; C.tid < 256 && task < 65536; task += C.G * 256) {
        const int bh = task >> 11, v = (task >> 4) & 127, kb = task & 15;
        float st[8];
#pragma unroll
        for (int e = 0; e < 8; ++e) st[e] = 0.f;
#pragma unroll 4
        for (int c = 0; c < 128; ++c) { const size_t item = (size_t)bh * 128 + c, off = (item * 128 + v) * 128 + kb * 8;
            const v4u kv = *(const v4u*)(KVT + off); const f32x4 d0 = *(const f32x4*)(HD + item * 128 + kb * 8), d1 = *(const f32x4*)(HD + item * 128 + kb * 8 + 4);
            v4u o; o.x = pk2(st[0], st[1]); o.y = pk2(st[2], st[3]); o.z = pk2(st[4], st[5]); o.w = pk2(st[6], st[7]);
            *(v4u*)(ST + off) = o;
#pragma unroll
            for (int e = 0; e < 4; ++e) { st[2 * e] = (e < 2 ? d0[2 * e] : d1[2 * e - 4]) * st[2 * e] + bflo(kv[e]); st[2 * e + 1] = (e < 2 ? d0[2 * e + 1] : d1[2 * e - 3]) * st[2 * e + 1] + bfhi(kv[e]); }
        }
    }
}
__device__ __forceinline__ void hgrn_out_item(const Params& P, const Ctx& C, int item) {
    LAS bf16* qt = (LAS bf16*)C.lds;
    LAS bf16* kt = (LAS bf16*)(C.lds + 17408);
    LAS bf16* iT = (LAS bf16*)(C.lds + 34816);
    LAS bf16* A1 = (LAS bf16*)(C.lds + 53248);
    LAS bf16* STl = (LAS bf16*)(C.lds + 62464);
    LAS float* ol = (LAS float*)(C.lds + 97280);
    LAS float* tot = (LAS float*)(C.lds + 131072);
    const float* G = (const float*)(P.ws + WS_G); const bf16* PQ = (const bf16*)(P.ws + WS_PQ); const bf16* PI = (const bf16*)(P.ws + WS_PI); const bf16* PG = (const bf16*)(P.ws + WS_PG);
    const bf16* ST = (const bf16*)(P.ws + WS_ST); bf16* MIX = (bf16*)(P.ws + WS_H);
    const int bh = item >> 7, c = item & 127, b = bh >> 2, hh = bh & 3; const size_t tok0 = (size_t)b * SEQ + c * 64;
    const int tid = C.tid, k = tid & 127, seg = tid >> 7, r = C.lane & 15, q4 = C.lane >> 4;
    float g[16], bb[16], total;
    hgrn_cumsum16(G, tok0, hh, k, seg, tot, g, bb, total);
#pragma unroll
    for (int j = 0; j < 16; ++j) { const int t = seg * 16 + j; const float qv = bf2f(PQ[(tok0 + t) * 512 + hh * 128 + k]);
        qt[t * 136 + k] = (bf16)f2bf(qv * __expf(bb[j])); kt[t * 136 + k] = (bf16)f2bf(-expm1f(g[j]) * __expf(-bb[j])); }
    hgrn_stage_iT(PI, tok0, hh, iT, tid);
    for (int ch = tid; ch < 2048; ch += 512) { const int rr = ch >> 4, c8 = (ch & 15) * 8; *(LAS v4u*)(STl + rr * 136 + c8) = *(const v4u*)(ST + ((size_t)item * 128 + rr) * 128 + c8); }
    __syncthreads();
    { const int rt = C.wave >> 1;
#pragma unroll
      for (int cc = 0; cc < 2; ++cc) { const int ct = (C.wave & 1) * 2 + cc; f32x4 acc = (f32x4){0.f, 0.f, 0.f, 0.f};
          acc = mma16(acc, qt + (16 * rt) * 136, 136, kt + (16 * ct) * 136, 136, 128, r, q4);
#pragma unroll
          for (int i = 0; i < 4; ++i) { const int t = 16 * rt + 4 * q4 + i, s = 16 * ct + r; A1[t * 72 + s] = (bf16)(s <= t ? f2bf(acc[i]) : 0u); } } }
    __syncthreads();
    { const int rt = C.wave >> 1;
#pragma unroll
      for (int cc = 0; cc < 4; ++cc) { const int ct = (C.wave & 1) * 4 + cc; f32x4 acc = (f32x4){0.f, 0.f, 0.f, 0.f};
          acc = mma16(acc, A1 + (16 * rt) * 72, 72, iT + (16 * ct) * 72, 72, 64, r, q4);
          acc = mma16(acc, qt + (16 * rt) * 136, 136, STl + (16 * ct) * 136, 136, 128, r, q4);
#pragma unroll
          for (int i = 0; i < 4; ++i) ol[(16 * rt + 4 * q4 + i) * 132 + 16 * ct + r] = acc[i]; } }
    __syncthreads();
    { const int t = tid >> 3, v0 = (tid & 7) * 16; float o[16]; float ss = 0.f;
#pragma unroll
      for (int e = 0; e < 16; ++e) { o[e] = ol[t * 132 + v0 + e]; ss += o[e] * o[e]; }
      ss += __shfl_xor(ss, 1); ss += __shfl_xor(ss, 2); ss += __shfl_xor(ss, 4);
      const float rstd = 1.0f / sqrtf(ss * (1.0f / 128.0f) + NORM_EPS);
      const float* ng = P.hgrn_norm_g + hh * 128 + v0; const bf16* gp = PG + (tok0 + t) * 512 + hh * 128 + v0;
      const v4u g0 = *(const v4u*)gp, g1 = *(const v4u*)(gp + 8); unsigned w[8];
#pragma unroll
      for (int e = 0; e < 4; ++e) { w[e] = pk2(o[2 * e] * rstd * ng[2 * e] * bflo(g0[e]), o[2 * e + 1] * rstd * ng[2 * e + 1] * bfhi(g0[e]));
                                    w[4 + e] = pk2(o[8 + 2 * e] * rstd * ng[8 + 2 * e] * bflo(g1[e]), o[9 + 2 * e] * rstd * ng[9 + 2 * e] * bfhi(g1[e])); }
      v4u* dst = (v4u*)(MIX + (tok0 + t) * 1024 + 512 + hh * 128 + v0); dst[0] = (v4u){w[0], w[1], w[2], w[3]}; dst[1] = (v4u){w[4], w[5], w[6], w[7]}; }
    __syncthreads();
}

typedef short v4i16_t __attribute__((ext_vector_type(4)));
constexpr int AT_ST = 68;
constexpr int AT_VP = 144;
__device__ __forceinline__ void attn_item(const Params& P, const Ctx& C, int b, int hd, int qt) {
    LAS float* St = (LAS float*)C.lds;
    LAS unsigned char* Vw = C.lds + 256 * AT_ST * 4 + C.wave * (64 * AT_VP);
    const bf16* QKV = (const bf16*)(P.ws + WS_QK); bf16* O = (bf16*)(P.ws + WS_H);
    const int lane = C.lane, r = lane & 15, q4 = lane >> 4;
    const int t0 = qt * 256; const size_t rowbase = (size_t)b * SEQ;
    const bf16* Kb = QKV + rowbase * 3072 + 1024 + hd * 64; const bf16* Vb = QKV + rowbase * 3072 + 2048 + hd * 64;
#pragma unroll 1
    for (int g = 0; g < 3; ++g) {
        const int dsh = 4 - 2 * g, d = 1 << dsh;
#pragma unroll 1
        for (int uu = 0; uu < 2; ++uu) {
            const int u = C.wave + 8 * uu;
            const int c = u & (d - 1), j = u >> dsh;
            const int mq0 = (t0 >> dsh) + 16 * j;
            const int qloc = c + d * (16 * j + r);
            const bf16* qp = QKV + (rowbase + t0 + qloc) * 3072 + hd * 64 + 8 * q4;
            const bf16x8 bq0 = *(const bf16x8*)qp, bq1 = *(const bf16x8*)(qp + 32);
            f32x4 sa[9];
#pragma unroll
            for (int t = 0; t < 9; ++t) { int mk = mq0 - 128 + 16 * t + r; mk = mk < 0 ? 0 : mk;
                const bf16* kp = Kb + (size_t)(c + d * mk) * 3072 + 8 * q4;
                const bf16x8 a0 = *(const bf16x8*)kp, a1 = *(const bf16x8*)(kp + 32);
                sa[t] = (f32x4){0.f, 0.f, 0.f, 0.f}; sa[t] = __builtin_amdgcn_mfma_f32_16x16x32_bf16(a0, bq0, sa[t], 0, 0, 0); sa[t] = __builtin_amdgcn_mfma_f32_16x16x32_bf16(a1, bq1, sa[t], 0, 0, 0); }
            float mx = -1e30f;
#pragma unroll
            for (int t = 0; t < 9; ++t)
#pragma unroll
                for (int i = 0; i < 4; ++i) { const int kap = 16 * t + 4 * q4 + i; const bool ok = kap >= r && kap <= r + 128 && (mq0 - 128 + kap) >= 0;
                    sa[t][i] = ok ? sa[t][i] : -1e30f; mx = fmaxf(mx, sa[t][i]); }
            mx = fmaxf(mx, __shfl_xor(mx, 16)); mx = fmaxf(mx, __shfl_xor(mx, 32));
            float ls = 0.f;
#pragma unroll
            for (int t = 0; t < 9; ++t)
#pragma unroll
                for (int i = 0; i < 4; ++i) { const float p = sa[t][i] > -1e29f ? __builtin_amdgcn_exp2f(sa[t][i] - mx) : 0.f; sa[t][i] = p; ls += p; }
            ls += __shfl_xor(ls, 16); ls += __shfl_xor(ls, 32);
            bf16x8 pf[5];
#pragma unroll
            for (int s = 0; s < 5; ++s) { const f32x4 lo = sa[2 * s], hi = (2 * s + 1 < 9) ? sa[2 * s + 1 < 9 ? 2 * s + 1 : 8] : (f32x4){0.f, 0.f, 0.f, 0.f};
                v4u w; w.x = pk2(lo[0], lo[1]); w.y = pk2(lo[2], lo[3]); w.z = pk2(hi[0], hi[1]); w.w = pk2(hi[2], hi[3]); pf[s] = __builtin_bit_cast(bf16x8, w); }
            f32x4 oa[4];
#pragma unroll
            for (int dt = 0; dt < 4; ++dt) oa[dt] = (f32x4){0.f, 0.f, 0.f, 0.f};
#pragma unroll
            for (int ch = 0; ch < 3; ++ch) {
#pragma unroll
                for (int it = 0; it < 8; ++it) { const int row = 8 * it + (lane >> 3); int kap = 64 * ch + row; kap = kap > 143 ? 143 : kap; int mk = mq0 - 128 + kap; mk = mk < 0 ? 0 : mk;
                    const v4u v = *(const v4u*)(Vb + (size_t)(c + d * mk) * 3072 + (lane & 7) * 8);
                    *(LAS v4u*)(Vw + row * AT_VP + (lane & 7) * 16) = v; }
                asm volatile("s_waitcnt lgkmcnt(0)" ::: "memory");
#pragma unroll
                for (int s2 = 0; s2 < 2; ++s2) { const int s = 2 * ch + s2; if (s < 5) {
#pragma unroll
                    for (int dt = 0; dt < 4; ++dt) {
                        const LAS unsigned char* vp = Vw + (32 * s2 + 4 * q4 + (r >> 2)) * AT_VP + dt * 32 + (r & 3) * 8;
                        const v4i16_t x = __builtin_amdgcn_ds_read_tr16_b64_v4i16((LAS v4i16_t*)vp), y = __builtin_amdgcn_ds_read_tr16_b64_v4i16((LAS v4i16_t*)(vp + 16 * AT_VP));
                        const bf16x8 av = (bf16x8){x[0], x[1], x[2], x[3], y[0], y[1], y[2], y[3]};
                        oa[dt] = __builtin_amdgcn_mfma_f32_16x16x32_bf16(av, pf[s], oa[dt], 0, 0, 0); } } }
                asm volatile("s_waitcnt lgkmcnt(0)" ::: "memory");
            }
            LAS float* sp = St + qloc * AT_ST;
            float mo = mx, lo2 = ls;
            if (g > 0) { const float m_old = sp[64], l_old = sp[65]; const float M = fmaxf(m_old, mx); const float fo = __builtin_amdgcn_exp2f(m_old - M), fn = __builtin_amdgcn_exp2f(mx - M);
#pragma unroll
                for (int dt = 0; dt < 4; ++dt) { const f32x4 po = *(const LAS f32x4*)(sp + 16 * dt + 4 * q4); oa[dt] = oa[dt] * fn + po * fo; }
                mo = M; lo2 = ls * fn + l_old * fo; }
            if (g < 2) {
#pragma unroll
                for (int dt = 0; dt < 4; ++dt) *(LAS f32x4*)(sp + 16 * dt + 4 * q4) = oa[dt];
                if (q4 == 0) { sp[64] = mo; sp[65] = lo2; }
            } else { const float inv = 1.0f / lo2; bf16* op = O + (rowbase + t0 + qloc) * 1024 + hd * 64 + 4 * q4;
#pragma unroll
                for (int dt = 0; dt < 4; ++dt) { const f32x4 v = oa[dt] * inv; *(unsigned long long*)(op + 16 * dt) = (unsigned long long)pk2(v[0], v[1]) | ((unsigned long long)pk2(v[2], v[3]) << 32); } }
        }
        __syncthreads();
    }
}

__device__ __forceinline__ unsigned ordf(float s) { const unsigned u = __builtin_bit_cast(unsigned, s); return u ^ ((unsigned)((int)u >> 31) | 0x80000000u); }
__device__ __forceinline__ float unordf(unsigned v) { return __builtin_bit_cast(float, v ^ ((unsigned)((int)(~v) >> 31) | 0x80000000u)); }
__device__ __forceinline__ void ins16(unsigned (&top)[16], unsigned x) {
#pragma unroll
    for (int j = 0; j < 16; ++j) { const unsigned hi = top[j] > x ? top[j] : x; x = top[j] > x ? x : top[j]; top[j] = hi; }
}
__device__ __forceinline__ void merge16(unsigned (&top)[16], int mask) {
    unsigned c[16];
#pragma unroll
    for (int j = 0; j < 16; ++j) { const unsigned o = (unsigned)__shfl_xor((int)top[15 - j], mask); c[j] = top[j] > o ? top[j] : o; }
#pragma unroll
    for (int st = 8; st >= 1; st >>= 1)
#pragma unroll
        for (int j = 0; j < 16; ++j) if ((j & st) == 0) { const unsigned a = c[j], b2 = c[j + st]; c[j] = a > b2 ? a : b2; c[j + st] = a > b2 ? b2 : a; }
#pragma unroll
    for (int j = 0; j < 16; ++j) top[j] = c[j];
}
__device__ __forceinline__ void phase_peer_topk(const Params& P, const Ctx& C, int layer) {
    LAS bf16* SK = (LAS bf16*)C.lds;
    const bf16* SKB = (const bf16*)(P.ws + WS_SKB) + (size_t)layer * 32768; const bf16* QP = (const bf16*)(P.ws + WS_QP);
    int* IDX = (int*)(P.ws + WS_IDX); float* GATE = (float*)(P.ws + WS_GATE);
    for (int ch = C.tid; ch < 4096; ch += 512) { const int rr = ch >> 4, c8 = (ch & 15) * 8; *(LAS v4u*)(SK + rr * 136 + c8) = *(const v4u*)(SKB + (size_t)rr * 128 + c8); }
    __syncthreads();
    const int r = C.lane & 15, q4 = C.lane >> 4;
    const int gw = C.vcu * NWAVES + C.wave, NGW = C.G * NWAVES;
    for (int grp = gw; grp < T * 8 / 16; grp += NGW) {
        const size_t task = (size_t)grp * 16 + r;
        unsigned lst[2][16];
#pragma unroll
        for (int half = 0; half < 2; ++half) {
            bf16x8 bq[4];
#pragma unroll
            for (int ks = 0; ks < 4; ++ks) bq[ks] = *(const bf16x8*)(QP + task * 256 + half * 128 + ks * 32 + 8 * q4);
            unsigned top[16];
#pragma unroll
            for (int j = 0; j < 16; ++j) top[j] = 0u;
#pragma unroll 1
            for (int nt = 0; nt < 8; ++nt) { f32x4 acc = (f32x4){0.f, 0.f, 0.f, 0.f};
#pragma unroll
                for (int ks = 0; ks < 4; ++ks) { const bf16x8 a = *(const LAS bf16x8*)(SK + (half * 128 + 16 * nt + r) * 136 + ks * 32 + 8 * q4); acc = __builtin_amdgcn_mfma_f32_16x16x32_bf16(a, bq[ks], acc, 0, 0, 0); }
#pragma unroll
                for (int i = 0; i < 4; ++i) { const unsigned n = 16 * nt + 4 * q4 + i; ins16(top, (ordf(acc[i]) & ~127u) | (127u - n)); } }
            merge16(top, 16); merge16(top, 32);
#pragma unroll
            for (int j = 0; j < 16; ++j) lst[half][j] = top[j];
        }
        float v1[16], v2[16]; unsigned e1[16], e2[16];
#pragma unroll
        for (int j = 0; j < 16; ++j) { v1[j] = unordf(lst[0][j] & ~127u); v2[j] = unordf(lst[1][j] & ~127u); e1[j] = (127u - (lst[0][j] & 127u)) << 7; e2[j] = 127u - (lst[1][j] & 127u); }
        unsigned top[16];
#pragma unroll
        for (int j = 0; j < 16; ++j) top[j] = 0u;
#pragma unroll
        for (int i = 0; i < 16; ++i)
#pragma unroll
            for (int j = 0; j < 16; ++j) if ((i + 1) * (j + 1) <= 16) ins16(top, (ordf(v1[i] + v2[j]) & ~16383u) | e1[i] | e2[j]);
        float ev[16]; float den = 0.f; const float mx = unordf(top[0] & ~16383u);
#pragma unroll
        for (int j = 0; j < 16; ++j) { ev[j] = __expf(unordf(top[j] & ~16383u) - mx); den += ev[j]; }
        const float inv = 1.0f / den;
        int* ip = IDX + task * 16; float* gp = GATE + task * 16;
        if (q4 == 0) { *(v4u*)(ip) = (v4u){top[0] & 16383u, top[1] & 16383u, top[2] & 16383u, top[3] & 16383u}; *(f32x4*)(gp) = (f32x4){ev[0] * inv, ev[1] * inv, ev[2] * inv, ev[3] * inv}; }
        else if (q4 == 1) { *(v4u*)(ip + 4) = (v4u){top[4] & 16383u, top[5] & 16383u, top[6] & 16383u, top[7] & 16383u}; *(f32x4*)(gp + 4) = (f32x4){ev[4] * inv, ev[5] * inv, ev[6] * inv, ev[7] * inv}; }
        else if (q4 == 2) { *(v4u*)(ip + 8) = (v4u){top[8] & 16383u, top[9] & 16383u, top[10] & 16383u, top[11] & 16383u}; *(f32x4*)(gp + 8) = (f32x4){ev[8] * inv, ev[9] * inv, ev[10] * inv, ev[11] * inv}; }
        else { *(v4u*)(ip + 12) = (v4u){top[12] & 16383u, top[13] & 16383u, top[14] & 16383u, top[15] & 16383u}; *(f32x4*)(gp + 12) = (f32x4){ev[12] * inv, ev[13] * inv, ev[14] * inv, ev[15] * inv}; }
    }
}
struct ExpRow { v4u d[4], u[4]; float ds, us, gk; };
__device__ __forceinline__ void exp_issue(ExpRow& R, const unsigned char* TD, const unsigned char* TU, const float* SD, int ex, float gk, int jl) {
    const unsigned char* dr = TD + (size_t)ex * TROW; const unsigned char* ur = TU + (size_t)ex * TROW;
#pragma unroll
    for (int c = 0; c < 4; ++c) R.d[c] = *(const v4u*)(dr + (c * 16 + jl) * 16);
#pragma unroll
    for (int c = 0; c < 4; ++c) R.u[c] = *(const v4u*)(ur + (c * 16 + jl) * 16);
    R.ds = SD[ex]; R.us = SD[16384 + ex]; R.gk = gk;
}
__device__ __forceinline__ void exp_consume(const ExpRow& R, const unsigned (&hp)[32], f32x2 (&oacc)[32]) {
    f32x2 a2 = (f32x2){0.f, 0.f};
#pragma unroll
    for (int c = 0; c < 4; ++c)
#pragma unroll
        for (int w = 0; w < 4; ++w) { const f32x2 lo = __builtin_amdgcn_cvt_pk_f32_fp8((int)R.d[c][w], false), hi = __builtin_amdgcn_cvt_pk_f32_fp8((int)R.d[c][w], true);
            unsigned h0 = hp[c * 8 + 2 * w], h1 = hp[c * 8 + 2 * w + 1]; asm volatile("" : "+v"(h0), "+v"(h1));
            a2 = a2 + lo * (f32x2){bflo(h0), bfhi(h0)}; a2 = a2 + hi * (f32x2){bflo(h1), bfhi(h1)}; }
    float a = (a2.x + a2.y) * R.ds;
    a += __shfl_xor(a, 1); a += __shfl_xor(a, 2); a += __shfl_xor(a, 4); a += __shfl_xor(a, 8);
    const float wk = R.gk * gelu_f(a) * R.us; const f32x2 wk2 = (f32x2){wk, wk};
#pragma unroll
    for (int c = 0; c < 4; ++c)
#pragma unroll
        for (int w = 0; w < 4; ++w) { const f32x2 lo = __builtin_amdgcn_cvt_pk_f32_fp8((int)R.u[c][w], false), hi = __builtin_amdgcn_cvt_pk_f32_fp8((int)R.u[c][w], true);
            oacc[c * 8 + 2 * w] = oacc[c * 8 + 2 * w] + wk2 * lo; oacc[c * 8 + 2 * w + 1] = oacc[c * 8 + 2 * w + 1] + wk2 * hi; }
}
__device__ __forceinline__ void phase_peer_experts(const Params& P, const Ctx& C, int layer, bool last) {
    const unsigned char* TD = P.ws + WS_TAB8 + (size_t)(2 * layer) * TAB8_BYTES; const unsigned char* TU = P.ws + WS_TAB8 + (size_t)(2 * layer + 1) * TAB8_BYTES; const float* SD = (const float*)(P.ws + WS_SC8) + (size_t)(2 * layer) * 16384; bf16* H = (bf16*)(P.ws + WS_H);
    const int* IDX = (const int*)(P.ws + WS_IDX); const float* GATE = (const float*)(P.ws + WS_GATE); const float* MOD = (const float*)(P.ws + WS_MOD);
    const int lane = C.lane, grp = lane >> 4, jl = lane & 15;
    const int gw = C.vcu * NWAVES + C.wave, NGW = C.G * NWAVES;
    for (int tok = gw; tok < T; tok += NGW) {
        const int b = tok >> 13;
        const int i0 = IDX[(size_t)tok * 128 + lane], i1 = IDX[(size_t)tok * 128 + 64 + lane];
        const float g0 = GATE[(size_t)tok * 128 + lane], g1 = GATE[(size_t)tok * 128 + 64 + lane];
        unsigned hf[32];
#pragma unroll
        for (int c = 0; c < 4; ++c) { const bf16* hp = H + (size_t)tok * 1024 + (c * 16 + jl) * 16; const v4u w0 = *(const v4u*)hp, w1 = *(const v4u*)(hp + 8);
#pragma unroll
            for (int e = 0; e < 4; ++e) { hf[c * 8 + e] = w0[e]; hf[c * 8 + 4 + e] = w1[e]; } }
        f32x2 oacc[32];
#pragma unroll
        for (int e = 0; e < 32; ++e) oacc[e] = (f32x2){0.f, 0.f};
        ExpRow RA, RB;
        exp_issue(RA, TD, TU, SD, __shfl(i0, grp), __shfl(g0, grp), jl);
        for (int it = 0; it < 32 * EXP_REP; it += 2) {
            { const int kk = ((it + 1) & 31) * 4 + grp; const int el = __shfl(i0, kk & 63), eh = __shfl(i1, kk & 63); const float gl = __shfl(g0, kk & 63), gh = __shfl(g1, kk & 63);
              exp_issue(RB, TD, TU, SD, kk < 64 ? el : eh, kk < 64 ? gl : gh, jl); }
            exp_consume(RA, hf, oacc);
            { const int kk = ((it + 2) & 31) * 4 + grp; const int el = __shfl(i0, kk & 63), eh = __shfl(i1, kk & 63); const float gl = __shfl(g0, kk & 63), gh = __shfl(g1, kk & 63);
              exp_issue(RA, TD, TU, SD, kk < 64 ? el : eh, kk < 64 ? gl : gh, jl); }
            exp_consume(RB, hf, oacc);
        }
        f32x2 h1[16];
        { const bool up = (grp & 2) != 0;
#pragma unroll
          for (int e = 0; e < 16; ++e) { const f32x2 keep = up ? oacc[16 + e] : oacc[e], send = up ? oacc[e] : oacc[16 + e]; h1[e] = keep + (f32x2){__shfl_xor(send.x, 32), __shfl_xor(send.y, 32)}; } }
        f32x2 h2[8];
        { const bool up = (grp & 1) != 0;
#pragma unroll
          for (int e = 0; e < 8; ++e) { const f32x2 keep = up ? h1[8 + e] : h1[e], send = up ? h1[e] : h1[8 + e]; h2[e] = keep + (f32x2){__shfl_xor(send.x, 16), __shfl_xor(send.y, 16)}; } }
        const int d0 = (grp * 16 + jl) * 16;
        const float* g2p = MOD + (size_t)(layer * 8 + b) * 6144 + 5120 + d0; const float psc = ((ABL_ON >= (layer == 0 ? 2 : 4)) ? 1.f : 0.f) * (1.0f / EXP_REP);
        float* xp = P.out + (size_t)tok * 1024 + d0;
        float xn[16]; float ss = 0.f;
#pragma unroll
        for (int q = 0; q < 4; ++q) { const f32x4 xa = *(const f32x4*)(xp + 4 * q), ga = *(const f32x4*)(g2p + 4 * q);
            xn[4 * q] = xa[0] + psc * ga[0] * h2[2 * q].x; xn[4 * q + 1] = xa[1] + psc * ga[1] * h2[2 * q].y; xn[4 * q + 2] = xa[2] + psc * ga[2] * h2[2 * q + 1].x; xn[4 * q + 3] = xa[3] + psc * ga[3] * h2[2 * q + 1].y; }
#pragma unroll
        for (int e = 0; e < 16; ++e) ss += xn[e] * xn[e];
        const float rstd = 1.0f / sqrtf(wave_sum(ss) * (1.0f / 1024.0f) + NORM_EPS);
        if (!last) {
            const float* ng = P.norm_mix_g + (layer + 1) * 1024 + d0; const float* mb = MOD + (size_t)((layer + 1) * 8 + b) * 6144 + d0;
            unsigned w[8];
#pragma unroll
            for (int q = 0; q < 4; ++q) { *(f32x4*)(xp + 4 * q) = (f32x4){xn[4 * q], xn[4 * q + 1], xn[4 * q + 2], xn[4 * q + 3]}; }
#pragma unroll
            for (int e = 0; e < 8; ++e) w[e] = pk2(xn[2 * e] * rstd * ng[2 * e] * (1.0f + mb[1024 + 2 * e]) + mb[2 * e], xn[2 * e + 1] * rstd * ng[2 * e + 1] * (1.0f + mb[1024 + 2 * e + 1]) + mb[2 * e + 1]);
            v4u* hp = (v4u*)(H + (size_t)tok * 1024 + d0); hp[0] = (v4u){w[0], w[1], w[2], w[3]}; hp[1] = (v4u){w[4], w[5], w[6], w[7]};
        } else {
            const float* fg = P.final_norm_g + d0;
#pragma unroll
            for (int q = 0; q < 4; ++q) *(f32x4*)(xp + 4 * q) = (f32x4){xn[4 * q] * rstd * fg[4 * q], xn[4 * q + 1] * rstd * fg[4 * q + 1], xn[4 * q + 2] * rstd * fg[4 * q + 2], xn[4 * q + 3] * rstd * fg[4 * q + 3]};
        }
    }
}
#ifndef NAIVE_TOPK
#define NAIVE_TOPK 0
#endif
#ifndef NAIVE_EXPERTS
#define NAIVE_EXPERTS 0
#endif
__device__ __forceinline__ void phase_peer_topk_naive(const Params& P, const Ctx& C, int layer) {
    LAS float* SC = (LAS float*)C.lds;
    const float* sk = P.peer_sub_keys + (size_t)layer * 32768; const bf16* QP = (const bf16*)(P.ws + WS_QP);
    int* IDX = (int*)(P.ws + WS_IDX); float* GATE = (float*)(P.ws + WS_GATE);
    for (int base = C.vcu * 64; base < T * 8; base += C.G * 64) {
        __syncthreads();
        { const int tl = C.tid & 63, part = C.tid >> 6; const size_t task = (size_t)base + tl;
          for (int col = part * 32; col < part * 32 + 32; ++col) { const int half = col >> 7, n = col & 127; float acc = 0.f;
              for (int c = 0; c < 128; ++c) acc += bf2f(QP[task * 256 + half * 128 + c]) * sk[(half * 128 + n) * 128 + c];
              SC[tl * 257 + col] = acc; } }
        __syncthreads();
        if (C.tid < 64) { const int tl = C.tid; const size_t task = (size_t)base + tl; LAS float* s = SC + tl * 257;
            float v1[16], v2[16]; int i1[16], i2[16];
            for (int k = 0; k < 16; ++k) { float best = -3e38f; int bi = 0; for (int n = 0; n < 128; ++n) { const float x = s[n]; if (x > best) { best = x; bi = n; } } v1[k] = best; i1[k] = bi; s[bi] = -3.1e38f; }
            for (int k = 0; k < 16; ++k) { float best = -3e38f; int bi = 0; for (int n = 0; n < 128; ++n) { const float x = s[128 + n]; if (x > best) { best = x; bi = n; } } v2[k] = best; i2[k] = bi; s[128 + bi] = -3.1e38f; }
            for (int a = 0; a < 16; ++a) for (int b2 = 0; b2 < 16; ++b2) s[a * 16 + b2] = v1[a] + v2[b2];
            float ts[16]; int ti[16];
            for (int k = 0; k < 16; ++k) { float best = -3e38f; int bi = 0; for (int n = 0; n < 256; ++n) { const float x = s[n]; if (x > best) { best = x; bi = n; } } ts[k] = best; ti[k] = bi; s[bi] = -3.1e38f; }
            float den = 0.f; float ev[16];
            for (int k = 0; k < 16; ++k) { ev[k] = expf(ts[k] - ts[0]); den += ev[k]; }
            for (int k = 0; k < 16; ++k) { int a = ti[k] >> 4, b2 = ti[k] & 15; int e1 = 0, e2 = 0;
                for (int z = 0; z < 16; ++z) { if (z == a) e1 = i1[z]; if (z == b2) e2 = i2[z]; }
                IDX[task * 16 + k] = e1 * 128 + e2; GATE[task * 16 + k] = ev[k] / den; }
        }
    }
    __syncthreads();
}
__device__ __forceinline__ void phase_peer_experts_naive(const Params& P, const Ctx& C, int layer, bool last) {
    bf16* H = (bf16*)(P.ws + WS_H); const int* IDX = (const int*)(P.ws + WS_IDX); const float* GATE = (const float*)(P.ws + WS_GATE); const float* MOD = (const float*)(P.ws + WS_MOD);
    const float* TD = P.peer_down + (size_t)layer * 16384 * 1024; const float* TU = P.peer_up + (size_t)layer * 16384 * 1024;
    const int lane = C.lane; const int gw = C.vcu * NWAVES + C.wave, NGW = C.G * NWAVES;
    for (int tok = gw; tok < T; tok += NGW) {
        const int b = tok >> 13; float hv[16], oa[16];
#pragma unroll
        for (int j = 0; j < 16; ++j) { hv[j] = bf2f(H[(size_t)tok * 1024 + j * 64 + lane]); oa[j] = 0.f; }
        for (int k = 0; k < 128; ++k) { const int e = IDX[(size_t)tok * 128 + k]; const float gk = GATE[(size_t)tok * 128 + k];
            float p = 0.f;
#pragma unroll
            for (int j = 0; j < 16; ++j) p += hv[j] * TD[(size_t)e * 1024 + j * 64 + lane];
            const float a = wave_sum(p); const float wk = gk * gelu_f(a);
#pragma unroll
            for (int j = 0; j < 16; ++j) oa[j] += wk * TU[(size_t)e * 1024 + j * 64 + lane]; }
        const float* g2p = MOD + (size_t)(layer * 8 + b) * 6144 + 5120; const float psc = (ABL_ON >= (layer == 0 ? 2 : 4)) ? 1.f : 0.f;
        float xn[16]; float ss = 0.f;
#pragma unroll
        for (int j = 0; j < 16; ++j) { const int d = j * 64 + lane; xn[j] = P.out[(size_t)tok * 1024 + d] + psc * g2p[d] * oa[j]; ss += xn[j] * xn[j]; }
        const float rstd = 1.0f / sqrtf(wave_sum(ss) * (1.0f / 1024.0f) + NORM_EPS);
        if (!last) { const float* ng = P.norm_mix_g + (layer + 1) * 1024; const float* mb = MOD + (size_t)((layer + 1) * 8 + b) * 6144;
#pragma unroll
            for (int j = 0; j < 16; ++j) { const int d = j * 64 + lane; P.out[(size_t)tok * 1024 + d] = xn[j]; H[(size_t)tok * 1024 + d] = (bf16)f2bf(xn[j] * rstd * ng[d] * (1.0f + mb[1024 + d]) + mb[d]); }
        } else {
#pragma unroll
            for (int j = 0; j < 16; ++j) { const int d = j * 64 + lane; P.out[(size_t)tok * 1024 + d] = xn[j] * rstd * P.final_norm_g[d]; } }
    }
}
constexpr int N_PHASES = 18;
#ifndef MK_ONE_LAUNCH
#define MK_ONE_LAUNCH 1
#endif
__global__ void __launch_bounds__(NWAVES * 64, 2) hybrid_fwd(Params P) {
    extern __shared__ __attribute__((aligned(16))) unsigned char lds_raw[];
    Ctx C;
    C.lds = (LAS unsigned char*)lds_raw;
    C.tid = threadIdx.x; C.lane = C.tid & 63; C.wave = __builtin_amdgcn_readfirstlane(C.tid >> 6);
    C.G = gridDim.x; { const int bx = blockIdx.x; C.vcu = (C.G % 8 == 0) ? (bx % 8) * (C.G / 8) + bx / 8 : bx; }
    volatile LAS unsigned* MISC = (volatile LAS unsigned*)(C.lds + MISC_OFF);
    for (int u = C.tid; u < (LDS_BYTES - LDSCTL_OFF) / 4; u += NWAVES * 64) ((LAS unsigned*)(C.lds + LDSCTL_OFF))[u] = 0u;
    __syncthreads();
    unsigned* ctl = (unsigned*)(P.ws + WS_CTL);
    XcdBarrier bar; bar.bar = ctl + CW_BAR; bar.x = 0; bar.st = nullptr;
    const int lo = P.ph_lo, hi = P.ph_hi;
    if (hi - lo > 1) bar = xcd_barrier_post(ctl + CW_BAR, MISC + 8);
#ifndef PH_MASK
#define PH_MASK 0x3ffff
#endif
#define IN(k) (((PH_MASK >> (k)) & 1) && lo <= (k) && (k) < hi)
#define SEAM(k) do { if (IN(k) && IN((k) + 1)) xcd_barrier(bar); } while (0)
    unsigned char* ws = P.ws;
    float* MOD = (float*)(ws + WS_MOD); bf16* H = (bf16*)(ws + WS_H);

    if (IN(0)) { for (int rp = 0; rp < REP_PRO; ++rp) { phase_prologue(P, C); __syncthreads(); } } SEAM(0);
    if (IN(1)) { for (int rp = 0; rp < REP_NORM; ++rp) phase_norm(P, C, P.x, P.norm_mix_g, 0, 0); } SEAM(1);
    if (IN(2)) { pg8::Gemm g{H, (const bf16*)(ws + WS_WIN), T, 3072, 1024}; pg8::StaticOrder S; S.init(T, 3072, C.G, (int)blockIdx.x);
        EpiInProj E{(bf16*)(ws + WS_PU), (bf16*)(ws + WS_PV), (bf16*)(ws + WS_PQ), (bf16*)(ws + WS_PI), (bf16*)(ws + WS_PG), (float*)(ws + WS_G), (const float*)(ws + WS_LB)};
        pg8::gemm_phase<EpiInProj, pg8::StaticOrder, true, true>(C.lds, g, S, E); if (REP_GEMM2 > 1) { __syncthreads(); pg8::gemm_phase<EpiInProj, pg8::StaticOrder, true, true>(C.lds, g, S, E); } } SEAM(2);
    if (IN(3)) { for (int rp = 0; rp < REP_HG; ++rp) { for (int it = C.vcu; it < 2048; it += C.G) gmlp_item(P, C, it >> 2, it & 3);
                 for (int it = C.vcu; it < 4096; it += C.G) hgrn_local_item(P, C, it); } } SEAM(3);
    if (IN(4)) { for (int rp = 0; rp < REP_HG; ++rp) phase_hgrn_scan(P, C); } SEAM(4);
    if (IN(5)) { for (int rp = 0; rp < REP_HG; ++rp) for (int it = C.vcu; it < 4096; it += C.G) hgrn_out_item(P, C, it); } SEAM(5);
    if (IN(6)) { pg8::Gemm g{H, (const bf16*)(ws + WS_WOUT0), T, 1024, 1024}; pg8::StaticOrder S; S.init(T, 1024, C.G, (int)blockIdx.x);
        EpiResid E{P.x, P.out, MOD + 2048, ABL_ON >= 1 ? 1.f : 0.f};
        pg8::gemm_phase<EpiResid, pg8::StaticOrder, true, true>(C.lds, g, S, E); } SEAM(6);
    if (IN(7)) { for (int rp = 0; rp < REP_NORM; ++rp) phase_norm(P, C, P.out, P.norm_ffn_g, 0, 3072); } SEAM(7);
    if (IN(8)) { pg8::Gemm g{H, (const bf16*)(ws + WS_WQ0), T, 2048, 1024}; pg8::StaticOrder S; S.init(T, 2048, C.G, (int)blockIdx.x);
        EpiBf16P E{(bf16*)(ws + WS_QP), 2048};
        pg8::gemm_phase<EpiBf16P, pg8::StaticOrder, true, true>(C.lds, g, S, E); if (REP_GEMM > 1) { __syncthreads(); pg8::gemm_phase<EpiBf16P, pg8::StaticOrder, true, true>(C.lds, g, S, E); } } SEAM(8);
    if (IN(9)) { for (int rp = 0; rp < REP_TOPK; ++rp) { if (NAIVE_TOPK) phase_peer_topk_naive(P, C, 0); else phase_peer_topk(P, C, 0); __syncthreads(); } } SEAM(9);
    if (IN(10)) { if (NAIVE_EXPERTS) phase_peer_experts_naive(P, C, 0, false); else phase_peer_experts(P, C, 0, false); } SEAM(10);
    if (IN(11)) {
        { pg8::Gemm g{H, (const bf16*)(ws + WS_WQKV), T, 3072, 1024}; pg8::StaticOrder S; S.init(T, 3072, C.G, (int)blockIdx.x);
          EpiQKRot E{(bf16*)(ws + WS_QK), (const float*)(ws + WS_CS)};
          pg8::gemm_phase<EpiQKRot, pg8::StaticOrder, true, true>(C.lds, g, S, E); } } SEAM(11);
    if (IN(12)) { for (int rep = 0; rep < ATT_REP; ++rep) for (int it = C.vcu; it < NB * 16 * 32; it += C.G) attn_item(P, C, it >> 9, (it >> 5) & 15, it & 31); } SEAM(12);
    if (IN(13)) { pg8::Gemm g{H, (const bf16*)(ws + WS_WOUT1), T, 1024, 1024}; pg8::StaticOrder S; S.init(T, 1024, C.G, (int)blockIdx.x);
        EpiResid E{P.out, P.out, MOD + (size_t)8 * 6144 + 2048, ABL_ON >= 3 ? 1.f : 0.f};
        pg8::gemm_phase<EpiResid, pg8::StaticOrder, true, true>(C.lds, g, S, E); } SEAM(13);
    if (IN(14)) { for (int rp = 0; rp < REP_NORM; ++rp) phase_norm(P, C, P.out, P.norm_ffn_g + 1024, 1, 3072); } SEAM(14);
    if (IN(15)) { pg8::Gemm g{H, (const bf16*)(ws + WS_WQ1), T, 2048, 1024}; pg8::StaticOrder S; S.init(T, 2048, C.G, (int)blockIdx.x);
        EpiBf16P E{(bf16*)(ws + WS_QP), 2048};
        pg8::gemm_phase<EpiBf16P, pg8::StaticOrder, true, true>(C.lds, g, S, E); if (REP_GEMM > 1) { __syncthreads(); pg8::gemm_phase<EpiBf16P, pg8::StaticOrder, true, true>(C.lds, g, S, E); } } SEAM(15);
    if (IN(16)) { for (int rp = 0; rp < REP_TOPK; ++rp) { if (NAIVE_TOPK) phase_peer_topk_naive(P, C, 1); else phase_peer_topk(P, C, 1); __syncthreads(); } } SEAM(16);
    if (IN(17)) { if (NAIVE_EXPERTS) phase_peer_experts_naive(P, C, 1, true); else phase_peer_experts(P, C, 1, true); }
#undef IN
#undef SEAM
}

extern "C" void kernel_launch(void* const* d_in, const int* in_sizes, int n_in, void* d_out, int out_size, void* d_ws, size_t ws_size, hipStream_t stream) {
    static int grid = 0;
    if (grid == 0) {
        if (n_in != 22 || in_sizes[0] != T * DM || out_size != T * DM || ws_size < WS_END) {
            fprintf(stderr, "kernel_launch: unexpected shapes (n_in %d, in0 %d, out %d, ws %zu); nothing launched\n", n_in, n_in > 0 ? in_sizes[0] : -1, out_size, ws_size); grid = -1; return; }
        int dev = 0, cus = 0;
        if (hipGetDevice(&dev) != hipSuccess || hipDeviceGetAttribute(&cus, hipDeviceAttributeMultiprocessorCount, dev) != hipSuccess) { fprintf(stderr, "kernel_launch: device query failed\n"); grid = -1; return; }
        if (hipFuncSetAttribute((const void*)hybrid_fwd, hipFuncAttributeMaxDynamicSharedMemorySize, LDS_BYTES) != hipSuccess) { fprintf(stderr, "kernel_launch: hipFuncSetAttribute failed\n"); grid = -1; return; }
        (void)hipGetLastError();
        grid = cus;
    }
    if (grid < 0) return;
    if (hipMemsetAsync((char*)d_ws + WS_CTL, 0, CTL_ZERO_BYTES, stream) != hipSuccess) { fprintf(stderr, "kernel_launch: memset failed\n"); return; }
    Params p{};
    p.x = (const float*)d_in[0]; p.c = (const float*)d_in[1]; p.positions = (const int*)d_in[2]; p.ada_w = (const float*)d_in[3]; p.ada_b = (const float*)d_in[4];
    p.norm_mix_g = (const float*)d_in[5]; p.norm_ffn_g = (const float*)d_in[6]; p.final_norm_g = (const float*)d_in[7]; p.even_w_in = (const float*)d_in[8]; p.even_w_out = (const float*)d_in[9];
    p.gmlp_ln_g = (const float*)d_in[10]; p.gmlp_ln_b = (const float*)d_in[11]; p.gmlp_w_s = (const float*)d_in[12]; p.gmlp_b_s = (const float*)d_in[13]; p.hgrn_lb_logits = (const float*)d_in[14];
    p.hgrn_norm_g = (const float*)d_in[15]; p.odd_w_qkv = (const float*)d_in[16]; p.odd_w_out = (const float*)d_in[17]; p.peer_w_query = (const float*)d_in[18]; p.peer_sub_keys = (const float*)d_in[19];
    p.peer_down = (const float*)d_in[20]; p.peer_up = (const float*)d_in[21];
    p.out = (float*)d_out; p.ws = (unsigned char*)d_ws;
#if MK_ONE_LAUNCH
    p.ph_lo = 0; p.ph_hi = N_PHASES;
    hipLaunchKernelGGL(hybrid_fwd, dim3(grid), dim3(NWAVES * 64), LDS_BYTES, stream, p);
#else
    for (int ph = 0; ph < N_PHASES; ++ph) { p.ph_lo = ph; p.ph_hi = ph + 1; hipLaunchKernelGGL(hybrid_fwd, dim3(grid), dim3(NWAVES * 64), LDS_BYTES, stream, p); }
#endif
    const hipError_t le = hipPeekAtLastError();
    if (le != hipSuccess) fprintf(stderr, "kernel_launch: launch failed: %s\n", hipGetErrorName(le));
}
```

```cpp
#include <hip/hip_runtime.h>
#include <cstdio>
#include <cstdint>
#include <cmath>
namespace pg8 {
#define PG8_LAS __attribute__((address_space(3)))
typedef unsigned short bf16_t;
typedef short bf16x8 __attribute__((ext_vector_type(8)));
typedef float f32x4 __attribute__((ext_vector_type(4)));
typedef unsigned u32x4 __attribute__((ext_vector_type(4)));
constexpr int BM = 256, BK = 64, HALF = 128, HTB = HALF * BK * 2  , STAGE_BYTES = 8 * HTB, NXCD = 8, WGM = 8;

__host__ __device__ __forceinline__ int lds_byte(int r, int c) { const int st = (r >> 4) * 2 + (c >> 5), rr = r & 15, cc = c & 31, ob = rr * 64 + cc * 2; return st * 1024 + (ob ^ (((ob >> 9) & 1) << 5)); }
__host__ __device__ __forceinline__ void stage_rc(int b, int& R, int& C) { const int st = b / 1024, sb = b % 1024, swz = sb ^ (((sb >> 9) & 1) << 5); R = (st >> 1) * 16 + swz / 64; C = (st & 1) * 32 + (swz % 64) / 2; }
__host__ __device__ __forceinline__ int perm32(int rho) { const int n = rho >> 4, i = rho & 15; return 8 * (i >> 2) + 4 * n + (i & 3); }

struct Unit { int pm, pn; };
struct Gemm { const bf16_t* A; const bf16_t* Bt; int M, N, K; };

struct StaticOrder {
    int nM, nN, nwg, G, c;
    __host__ __device__ void init(int M, int N, int G_, int c_) { nM = M / BM; nN = N / BM; nwg = nM * nN; G = G_; c = c_; }
    __host__ __device__ bool next(int i, Unit& u) const {
        const long L = (long)i * G + c; if (L >= nwg) return false;
        int wgid = (int)L; { const int q = nwg / NXCD, r = nwg % NXCD, xcd = wgid % NXCD, off = wgid / NXCD; wgid = (xcd < r ? xcd * (q + 1) : r * (q + 1) + (xcd - r) * q) + off; }
        const int nig = WGM * nN, gid = wgid / nig, fm = gid * WGM, gsz = (nM - fm) < WGM ? (nM - fm) : WGM;
        u.pm = fm + ((wgid % nig) % gsz); u.pn = (wgid % nig) / gsz; return true;
    }
    __device__ __forceinline__ void a_ready(const Unit&) const {}
    __device__ __forceinline__ void done(const Unit&) const {}
};

__device__ __forceinline__ unsigned cvt_pk_bf16(float lo, float hi) { unsigned r; asm volatile("v_cvt_pk_bf16_f32 %0, %1, %2" : "=v"(r) : "v"(lo), "v"(hi)); return r; }
typedef float f32x2 __attribute__((ext_vector_type(2)));
__device__ __forceinline__ f32x2 gelu_pk(f32x2 v) {
    const f32x2 av = __builtin_elementwise_abs(v), d = av * 0.2316418882f + 1.0f;
    f32x2 t; t.x = __builtin_amdgcn_rcpf(d.x); t.y = __builtin_amdgcn_rcpf(d.y);
    f32x2 q = t * 0.5307027145f + (-0.7265760135f); q = q * t + 0.7107068705f; q = q * t + (-0.142248368f); q = q * t + 0.127414796f; q = q * t;
    const f32x2 s = (v * v) * (-0.72134752044f);
    f32x2 e; e.x = __builtin_amdgcn_exp2f(s.x); e.y = __builtin_amdgcn_exp2f(s.y);
    const f32x2 m = v * (q * e), r = v - m;
    f32x2 o; o.x = v.x < 0.f ? m.x : r.x; o.y = v.y < 0.f ? m.y : r.y; return o;
}

template <class Epi, class Sched, bool ALIGN_EPI = false, bool SP2 = false>
__device__ __forceinline__ void gemm_phase(PG8_LAS unsigned char* lds, const Gemm g, const Sched& S, const Epi& E) {
    const int tid = threadIdx.x, wid = __builtin_amdgcn_readfirstlane(tid >> 6), lane = tid & 63, wr = wid >> 2, wc = wid & 3, fr = lane & 15, fq = lane >> 4;
    const int K = g.K, nt = K / BK;
    unsigned voffA[2], voffB[2];
#pragma unroll
    for (int i = 0; i < 2; ++i) { int R, C; stage_rc(tid * 16 + i * 8192, R, C); const int Rb = Epi::PERM ? ((R & ~31) + perm32(R & 31)) : R;
        voffA[i] = (unsigned)(R * K + C) * 2u; voffB[i] = (unsigned)(Rb * K + C) * 2u; }
    const size_t kstep = (size_t)(BK * 2);
    const size_t hstep = (size_t)HALF * K * 2;
    const size_t tstep = 2 * hstep;
    const unsigned ldsw = (unsigned)wid * 1024u;
    const int aoff = lds_byte(wr * 64 + fr, fq * 8), boff = lds_byte(wc * 32 + fr, fq * 8);
#define PG8_SA(b, h) (((b) * 2 + (h)) * HTB)
#define PG8_SB(b, h) ((4 + (b) * 2 + (h)) * HTB)
#define PG8_STAGE(bufoff, gbase, voff) do { _Pragma("unroll") for (int _i = 0; _i < 2; ++_i) \
        __builtin_amdgcn_global_load_lds((const unsigned*)((const char*)(gbase) + (voff)[_i]), (PG8_LAS unsigned*)(lds + (bufoff) + ldsw + _i * 8192), 16, 0, 0); } while (0)
#define PG8_LDA(dst, b, h) do { _Pragma("unroll") for (int m = 0; m < 4; ++m) _Pragma("unroll") for (int k = 0; k < 2; ++k) dst[m][k] = *(const PG8_LAS bf16x8*)(lds + PG8_SA(b, h) + aoff + m * 2048 + k * 1024); } while (0)
#define PG8_LDB(dst, b, h) do { _Pragma("unroll") for (int n = 0; n < 2; ++n) _Pragma("unroll") for (int k = 0; k < 2; ++k) dst[n][k] = *(const PG8_LAS bf16x8*)(lds + PG8_SB(b, h) + boff + n * 2048 + k * 1024); } while (0)
#define PG8_MMA(ai, bj, At, Bt) do { __builtin_amdgcn_s_setprio(1); _Pragma("unroll") for (int m = 0; m < 4; ++m) _Pragma("unroll") for (int n = 0; n < 2; ++n) _Pragma("unroll") for (int k = 0; k < 2; ++k) \
        acc[ai][bj][m][n] = __builtin_amdgcn_mfma_f32_16x16x32_bf16(Bt[n][k], At[m][k], acc[ai][bj][m][n], 0, 0, 0); __builtin_amdgcn_s_setprio(0); } while (0)
#define PG8_WAIT_V(n) asm volatile("s_waitcnt vmcnt(" #n ")" ::: "memory")
#define PG8_WAIT_L(n) asm volatile("s_waitcnt lgkmcnt(" #n ")" ::: "memory")
#define PG8_BAR __builtin_amdgcn_s_barrier()
#define PG8_SCHED __builtin_amdgcn_sched_barrier(0)
    Unit cur, nxt; int ui = 0;
    if (!S.next(0, cur)) return;
    f32x4 acc[2][2][4][2];
#pragma unroll
    for (int a = 0; a < 2; ++a)
#pragma unroll
        for (int b = 0; b < 2; ++b)
#pragma unroll
            for (int m = 0; m < 4; ++m)
#pragma unroll
                for (int n = 0; n < 2; ++n) acc[a][b][m][n] = (f32x4){0.f, 0.f, 0.f, 0.f};
    bf16x8 At[4][2], B0[2][2], B1[2][2];
    const char* cA = (const char*)g.A + (size_t)cur.pm * tstep; const char* cB = (const char*)g.Bt + (size_t)cur.pn * tstep;
    S.a_ready(cur);
    if constexpr (SP2) {
        PG8_STAGE(PG8_SB(0, 0), cB, voffB); PG8_STAGE(PG8_SB(0, 1), cB + hstep, voffB); PG8_STAGE(PG8_SA(0, 0), cA, voffA); PG8_STAGE(PG8_SA(0, 1), cA + hstep, voffA);
        if (wr == 1) PG8_BAR;
        PG8_WAIT_V(2); PG8_BAR;
        PG8_STAGE(PG8_SB(1, 0), cB + kstep, voffB); PG8_STAGE(PG8_SA(1, 0), cA + kstep, voffA); PG8_STAGE(PG8_SB(1, 1), cB + hstep + kstep, voffB);
        PG8_WAIT_V(6); PG8_BAR;
    } else {
        PG8_STAGE(PG8_SB(0, 0), cB, voffB); PG8_STAGE(PG8_SA(0, 0), cA, voffA); PG8_STAGE(PG8_SB(0, 1), cB + hstep, voffB); PG8_STAGE(PG8_SA(0, 1), cA + hstep, voffA);
        if (wr == 1) PG8_BAR;
        PG8_WAIT_V(4); PG8_BAR;
        PG8_STAGE(PG8_SB(1, 0), cB + kstep, voffB); PG8_STAGE(PG8_SA(1, 0), cA + kstep, voffA); PG8_STAGE(PG8_SB(1, 1), cB + hstep + kstep, voffB);
        PG8_WAIT_V(6); PG8_BAR;
    }
    for (;;) {
        const bool has_next = S.next(ui + 1, nxt);
        const char* nA = has_next ? (const char*)g.A + (size_t)nxt.pm * tstep : cA; const char* nB = has_next ? (const char*)g.Bt + (size_t)nxt.pn * tstep : cB;
        for (int t = 0; t < nt; t += 2) {
            const bool last = (t == nt - 2);
            const char* a1 = cA + (size_t)(t + 1) * kstep;
            const char* a2 = last ? nA : cA + (size_t)(t + 2) * kstep; const char* b2 = last ? nB : cB + (size_t)(t + 2) * kstep;
            const char* a3 = a2 + kstep; const char* b3 = b2 + kstep;
            if (last && has_next) S.a_ready(nxt);
            if constexpr (SP2) {
            PG8_LDB(B0, 0, 0); PG8_LDB(B1, 0, 1); PG8_SCHED; PG8_LDA(At, 0, 0); PG8_STAGE(PG8_SA(1, 1), a1 + hstep, voffA);
            PG8_WAIT_V(8); PG8_WAIT_L(0); PG8_BAR; PG8_MMA(0, 0, At, B0); PG8_MMA(0, 1, At, B1); PG8_BAR; PG8_SCHED;
            PG8_LDA(At, 0, 1); PG8_STAGE(PG8_SB(0, 0), b2, voffB); PG8_STAGE(PG8_SB(0, 1), b2 + hstep, voffB); PG8_STAGE(PG8_SA(0, 0), a2, voffA);
            PG8_WAIT_V(8); PG8_WAIT_L(0); PG8_BAR; PG8_MMA(1, 0, At, B0); PG8_MMA(1, 1, At, B1); PG8_BAR; PG8_SCHED;
            PG8_LDB(B0, 1, 0); PG8_LDB(B1, 1, 1); PG8_SCHED; PG8_LDA(At, 1, 0); PG8_STAGE(PG8_SA(0, 1), a2 + hstep, voffA);
            PG8_WAIT_V(8); PG8_WAIT_L(0); PG8_BAR; PG8_MMA(0, 0, At, B0); PG8_MMA(0, 1, At, B1); PG8_BAR; PG8_SCHED;
            PG8_LDA(At, 1, 1); PG8_STAGE(PG8_SB(1, 0), b3, voffB); PG8_STAGE(PG8_SB(1, 1), b3 + hstep, voffB); PG8_STAGE(PG8_SA(1, 0), a3, voffA);
            PG8_WAIT_V(8); PG8_WAIT_L(0); PG8_BAR; PG8_MMA(1, 0, At, B0); PG8_MMA(1, 1, At, B1); PG8_BAR; PG8_SCHED;
            } else {
            PG8_LDB(B0, 0, 0); PG8_SCHED; PG8_LDA(At, 0, 0); PG8_STAGE(PG8_SA(1, 1), a1 + hstep, voffA);
            PG8_WAIT_L(8); PG8_BAR; PG8_WAIT_L(0); PG8_MMA(0, 0, At, B0); PG8_BAR; PG8_SCHED;
            PG8_LDB(B1, 0, 1); PG8_STAGE(PG8_SB(0, 0), b2, voffB);
            PG8_BAR; PG8_WAIT_L(0); PG8_MMA(0, 1, At, B1); PG8_BAR;
            PG8_LDA(At, 0, 1); PG8_STAGE(PG8_SA(0, 0), a2, voffA);
            PG8_BAR; PG8_WAIT_L(0); PG8_MMA(1, 0, At, B0); PG8_BAR; PG8_SCHED;
            PG8_STAGE(PG8_SB(0, 1), b2 + hstep, voffB);
            PG8_WAIT_V(6); PG8_BAR; PG8_MMA(1, 1, At, B1); PG8_BAR;
            PG8_LDB(B0, 1, 0); PG8_SCHED; PG8_LDA(At, 1, 0); PG8_STAGE(PG8_SA(0, 1), a2 + hstep, voffA);
            PG8_WAIT_L(8); PG8_BAR; PG8_WAIT_L(0); PG8_MMA(0, 0, At, B0); PG8_BAR; PG8_SCHED;
            PG8_LDB(B1, 1, 1); PG8_STAGE(PG8_SB(1, 0), b3, voffB);
            PG8_BAR; PG8_WAIT_L(0); PG8_MMA(0, 1, At, B1); PG8_BAR;
            PG8_LDA(At, 1, 1); PG8_STAGE(PG8_SA(1, 0), a3, voffA);
            PG8_BAR; PG8_WAIT_L(0); PG8_MMA(1, 0, At, B0); PG8_BAR; PG8_SCHED;
            PG8_STAGE(PG8_SB(1, 1), b3 + hstep, voffB);
            PG8_WAIT_V(6); PG8_BAR; PG8_MMA(1, 1, At, B1); PG8_BAR;
            }
        }
        if constexpr (ALIGN_EPI) { if (wr == 0) PG8_BAR; }
        if constexpr (!Epi::AFTER_DRAIN) { E(acc, cur, wr, wc, fr, fq); S.done(cur); }
        if (!has_next) break;
#pragma unroll
        for (int a = 0; a < 2; ++a)
#pragma unroll
            for (int b = 0; b < 2; ++b)
#pragma unroll
                for (int m = 0; m < 4; ++m)
#pragma unroll
                    for (int n = 0; n < 2; ++n) acc[a][b][m][n] = (f32x4){0.f, 0.f, 0.f, 0.f};
        cur = nxt; cA = nA; cB = nB; ++ui;
        if constexpr (ALIGN_EPI) { if (wr == 1) PG8_BAR; }
    }
    PG8_WAIT_V(0);
    if constexpr (!ALIGN_EPI) { if (wr == 0) PG8_BAR; }
    PG8_BAR;
    if constexpr (Epi::AFTER_DRAIN) { E.fused(acc, cur, wr, wc, fr, fq, lds, wid, lane); S.done(cur); }
#undef PG8_SA
#undef PG8_SB
#undef PG8_STAGE
#undef PG8_LDA
#undef PG8_LDB
#undef PG8_MMA
#undef PG8_WAIT_V
#undef PG8_WAIT_L
#undef PG8_BAR
#undef PG8_SCHED
}
}
#define GAS __attribute__((address_space(1)))
#define LAS __attribute__((address_space(3)))
typedef unsigned short bf16;
typedef unsigned v4u __attribute__((ext_vector_type(4)));
typedef float f32x4 __attribute__((ext_vector_type(4)));
typedef short bf16x8 __attribute__((ext_vector_type(8)));
typedef __bf16 bf16x2_t __attribute__((ext_vector_type(2)));
#define LDS_WAIT() asm volatile("s_waitcnt lgkmcnt(0)" ::: "memory")
#define VM_WAIT() asm volatile("s_waitcnt vmcnt(0)" ::: "memory")
__device__ __forceinline__ unsigned f2bf(float f) { unsigned u = __builtin_bit_cast(unsigned, f); return (u + 0x7fffu + ((u >> 16) & 1u)) >> 16; }
__device__ __forceinline__ unsigned pk2(float lo, float hi) { return f2bf(lo) | (f2bf(hi) << 16); }
__device__ __forceinline__ float bflo(unsigned u) { return __builtin_bit_cast(float, u << 16); }
__device__ __forceinline__ float bfhi(unsigned u) { return __builtin_bit_cast(float, u & 0xffff0000u); }
__device__ __forceinline__ float bf2f(bf16 u) { return __builtin_bit_cast(float, (unsigned)u << 16); }
#define XB_TMO      128
#define XB_XCNT(j)  (256  + 64 * (j))
#define XB_XSUB(j)  (1280 + 64 * (j))
#define XB_XGEN(j)  (2304 + 64 * (j))
#define XB_TOP      3328
#define XB_TOPGEN   3392
#define XCD_BAR_WORDS 3456
#define XB_SPIN_CAP (1u << 18)

__device__ __forceinline__ unsigned xb_ld(unsigned* p)              { return __hip_atomic_load(p, __ATOMIC_RELAXED, __HIP_MEMORY_SCOPE_AGENT); }
__device__ __forceinline__ unsigned xb_add(unsigned* p, unsigned v) { return __hip_atomic_fetch_add(p, v, __ATOMIC_RELAXED, __HIP_MEMORY_SCOPE_AGENT); }
__device__ __forceinline__ unsigned xb_xcc_id() { return (unsigned)__builtin_amdgcn_s_getreg((3 << 11) | 20) & 0xFu; }
#define XB_SPIN(cond, bar) do { unsigned _sp = 0; while (cond) { __builtin_amdgcn_s_sleep(1); \
    if ((++_sp & 255u) == 0u) { if (xb_ld(&(bar)[XB_TMO])) break; if (_sp > XB_SPIN_CAP) { atomicAdd(&(bar)[XB_TMO], 1u); break; } } } } while (0)

struct XcdBarrier {
    unsigned* bar; unsigned x;
    volatile LAS unsigned* st;
};

__device__ __forceinline__ XcdBarrier xcd_barrier_post(unsigned* bar, volatile LAS unsigned* st) {
    XcdBarrier b; b.bar = bar; b.x = xb_xcc_id(); b.st = st;
    if (threadIdx.x == 0) (void)xb_add(&bar[XB_XCNT(b.x)], 1u);
    return b;
}
__device__ __forceinline__ void xcd_barrier_complete(unsigned* bar, unsigned x, unsigned& nloc, unsigned& nx) {
    const unsigned G = gridDim.x * gridDim.y * gridDim.z;
    unsigned sum, cnt, mine, sp = 0u;
    for (;;) {
        sum = 0u; cnt = 0u; mine = 0u;
#pragma unroll
        for (unsigned j = 0; j < 16; ++j) { const unsigned c = xb_ld(&bar[XB_XCNT(j)]); sum += c; cnt += (c > 0u) ? 1u : 0u; mine = (j == x) ? c : mine; }
        if (sum == G) break;
        __builtin_amdgcn_s_sleep(1);
        if ((++sp & 255u) == 0u) { if (xb_ld(&bar[XB_TMO])) break; if (sp > XB_SPIN_CAP) { atomicAdd(&bar[XB_TMO], 1u); break; } }
    }
    nloc = mine > 0u ? mine : 1u; nx = cnt > 0u ? cnt : 1u;
}

__device__ __forceinline__ void xcd_barrier(const XcdBarrier& b) {
    asm volatile("s_waitcnt vmcnt(0)" ::: "memory");
    __syncthreads();
    if (threadIdx.x == 0) {
        unsigned* bar = b.bar;
        __builtin_amdgcn_s_waitcnt(0);
        unsigned nloc = b.st[0], nx = b.st[1];
        if (nloc == 0u) { xcd_barrier_complete(bar, b.x, nloc, nx); b.st[0] = nloc; b.st[1] = nx; }
        const unsigned old = xb_add(&bar[XB_XSUB(b.x)], 1u);
        const unsigned gen = old / nloc;
        if (old + 1u == (gen + 1u) * nloc) {
            __builtin_amdgcn_fence(__ATOMIC_RELEASE, "agent");
            asm volatile("s_waitcnt vmcnt(0)" ::: "memory");
            const unsigned og = xb_add(&bar[XB_TOP], 1u);
            const unsigned tg = og / nx;
            if (og + 1u == (tg + 1u) * nx) xb_add(&bar[XB_TOPGEN], 1u);
            else XB_SPIN(xb_ld(&bar[XB_TOPGEN]) == tg, bar);
            __builtin_amdgcn_fence(__ATOMIC_ACQUIRE, "agent");
            xb_add(&bar[XB_XGEN(b.x)], 1u);
            asm volatile("s_waitcnt vmcnt(0)" ::: "memory");
        } else {
            XB_SPIN(xb_ld(&bar[XB_XGEN(b.x)]) == gen, bar);
            __builtin_amdgcn_fence(__ATOMIC_ACQUIRE, "agent");
            asm volatile("s_waitcnt vmcnt(0)" ::: "memory");
        }
    }
    __syncthreads();
}

constexpr int NB = 8, SEQ = 8192, DM = 1024, T = NB * SEQ;
constexpr int NWAVES = 8;
constexpr float NORM_EPS = 1e-6f;
constexpr float C2 = 0.125f * 1.4426950408889634f;

constexpr size_t MiB = 1u << 20;
constexpr size_t WS_CTL = 0, CTL_ZERO_BYTES = 1 * MiB;
constexpr size_t WS_MOD = 1 * MiB;
constexpr size_t WS_SKB = 1 * MiB + 512 * 1024;
constexpr size_t WS_WSB = 1 * MiB + 768 * 1024;
constexpr size_t WS_LB  = 1 * MiB + 960 * 1024;
constexpr size_t WS_CS  = 2 * MiB;
constexpr size_t WS_HD  = 6 * MiB;
constexpr size_t WS_WIN = 16 * MiB, WS_WOUT0 = 22 * MiB, WS_WQKV = 24 * MiB, WS_WOUT1 = 30 * MiB, WS_WQ0 = 32 * MiB, WS_WQ1 = 36 * MiB;
constexpr size_t WS_TAB8 = 40 * MiB, TAB8_BYTES = 16 * MiB;
constexpr int TROW = 1024;
constexpr size_t WS_SC8 = 8 * MiB;
constexpr size_t WS_H = 108 * MiB;
constexpr size_t WS_BIG = 236 * MiB;
constexpr size_t WS_PU = WS_BIG, WS_PV = WS_BIG + 64 * MiB, WS_PQ = WS_BIG + 128 * MiB, WS_PI = WS_BIG + 192 * MiB, WS_PG = WS_BIG + 256 * MiB;
constexpr size_t WS_G = WS_BIG + 320 * MiB;
constexpr size_t WS_KVT = WS_BIG + 448 * MiB;
constexpr size_t WS_ST = WS_BIG + 576 * MiB;
constexpr size_t WS_QP = WS_BIG;
constexpr size_t WS_IDX = WS_BIG + 256 * MiB, WS_GATE = WS_BIG + 288 * MiB;
constexpr size_t WS_QK = WS_BIG;
constexpr size_t WS_VT = WS_BIG + 256 * MiB;
constexpr size_t WS_END = WS_BIG + 704 * MiB;
constexpr int CW_BAR = 4096;

constexpr int LDS_BYTES = 147456;
constexpr int LDSCTL_OFF = LDS_BYTES - 512;
constexpr int MISC_OFF = LDSCTL_OFF;

struct Params {
    const float* x; const float* c; const int* positions; const float* ada_w; const float* ada_b; const float* norm_mix_g; const float* norm_ffn_g; const float* final_norm_g;
    const float* even_w_in; const float* even_w_out; const float* gmlp_ln_g; const float* gmlp_ln_b; const float* gmlp_w_s; const float* gmlp_b_s; const float* hgrn_lb_logits; const float* hgrn_norm_g;
    const float* odd_w_qkv; const float* odd_w_out; const float* peer_w_query; const float* peer_sub_keys; const float* peer_down; const float* peer_up;
    float* out; unsigned char* ws; int ph_lo, ph_hi;
};
struct Ctx { LAS unsigned char* lds; int tid, lane, wave, vcu, G; };

__device__ __forceinline__ float wave_sum(float v) {
#pragma unroll
    for (int o = 1; o < 64; o <<= 1) v += __shfl_xor(v, o);
    return v;
}
__device__ __forceinline__ float silu_f(float x) { return x * __builtin_amdgcn_rcpf(1.0f + __builtin_amdgcn_exp2f(-1.4426950408889634f * x)); }
__device__ __forceinline__ float sigmoid_f(float x) { return __builtin_amdgcn_rcpf(1.0f + __builtin_amdgcn_exp2f(-1.4426950408889634f * x)); }
__device__ __forceinline__ float gelu_f(float x) { return 0.5f * x * (1.0f + erff(x * 0.70710678118654752f)); }
__device__ __forceinline__ f32x4 mma16(f32x4 acc, const LAS bf16* A, int lda, const LAS bf16* Bt, int ldb, int K, int r, int q4) {
    const LAS bf16* ap = A + r * lda + 8 * q4; const LAS bf16* bp = Bt + r * ldb + 8 * q4;
    for (int k0 = 0; k0 < K; k0 += 32) {
        const bf16x8 a = *(const LAS bf16x8*)(ap + k0); const bf16x8 b = *(const LAS bf16x8*)(bp + k0);
        acc = __builtin_amdgcn_mfma_f32_16x16x32_bf16(a, b, acc, 0, 0, 0);
    }
    return acc;
}

struct EpiBf16P {
    static constexpr bool PERM = true, AFTER_DRAIN = false;
    bf16* O; size_t ldc;
    __device__ __forceinline__ void operator()(const f32x4 (&acc)[2][2][4][2], const pg8::Unit& u, int wr, int wc, int fr, int fq) const {
        const int row0 = u.pm * 256 + wr * 64 + fr, col0 = u.pn * 256 + wc * 32 + 8 * fq;
#pragma unroll
        for (int ai = 0; ai < 2; ++ai)
#pragma unroll
            for (int m = 0; m < 4; ++m) { bf16* rowp = O + (size_t)(row0 + ai * 128 + m * 16) * ldc + col0;
#pragma unroll
                for (int bj = 0; bj < 2; ++bj) { const f32x4 v0 = acc[ai][bj][m][0], v1 = acc[ai][bj][m][1];
                    v4u w; w.x = pg8::cvt_pk_bf16(v0[0], v0[1]); w.y = pg8::cvt_pk_bf16(v0[2], v0[3]); w.z = pg8::cvt_pk_bf16(v1[0], v1[1]); w.w = pg8::cvt_pk_bf16(v1[2], v1[3]);
                    *(v4u*)(rowp + bj * 128) = w; } }
    }
};
#ifndef REP_HG
#define REP_HG 1
#endif
#ifndef REP_TOPK
#define REP_TOPK 1
#endif
#ifndef REP_PRO
#define REP_PRO 1
#endif
#ifndef REP_NORM
#define REP_NORM 1
#endif
#ifndef REP_GEMM2
#define REP_GEMM2 1
#endif
#ifndef REP_GEMM
#define REP_GEMM 1
#endif
#ifndef EXP_REP
#define EXP_REP 1
#endif
#ifndef ATT_REP
#define ATT_REP 1
#endif
#ifndef ABL_ON
#define ABL_ON 4
#endif
struct EpiResid {
    static constexpr bool PERM = true, AFTER_DRAIN = false;
    const float* xin; float* xout; const float* gate; float gsc;
    __device__ __forceinline__ void operator()(const f32x4 (&acc)[2][2][4][2], const pg8::Unit& u, int wr, int wc, int fr, int fq) const {
        const int row0 = u.pm * 256 + wr * 64 + fr, col0 = u.pn * 256 + wc * 32 + 8 * fq;
        const float* gp = gate + (size_t)((u.pm * 256) >> 13) * 6144 + col0;
        f32x4 gv[2][2];
#pragma unroll
        for (int bj = 0; bj < 2; ++bj) { gv[bj][0] = *(const f32x4*)(gp + bj * 128); gv[bj][1] = *(const f32x4*)(gp + bj * 128 + 4); }
#pragma unroll
        for (int ai = 0; ai < 2; ++ai)
#pragma unroll
            for (int m = 0; m < 4; ++m) { const size_t off = (size_t)(row0 + ai * 128 + m * 16) * 1024 + col0;
#pragma unroll
                for (int bj = 0; bj < 2; ++bj) {
                    const f32x4 x0 = *(const f32x4*)(xin + off + bj * 128), x1 = *(const f32x4*)(xin + off + bj * 128 + 4);
                    *(f32x4*)(xout + off + bj * 128) = x0 + gv[bj][0] * acc[ai][bj][m][0] * gsc;
                    *(f32x4*)(xout + off + bj * 128 + 4) = x1 + gv[bj][1] * acc[ai][bj][m][1] * gsc; }
                asm volatile("" ::: "memory"); }
    }
};
struct EpiInProj {
    static constexpr bool PERM = true, AFTER_DRAIN = false;
    bf16* PU; bf16* PV; bf16* PQ; bf16* PI; bf16* PG; float* G; const float* LB;
    __device__ __forceinline__ void operator()(const f32x4 (&acc)[2][2][4][2], const pg8::Unit& u, int wr, int wc, int fr, int fq) const {
        const int type = u.pn >> 1;
        const int row0 = u.pm * 256 + wr * 64 + fr, lc0 = (u.pn & 1) * 256 + wc * 32 + 8 * fq;
        if (type == 3) {
            f32x4 lb[2][2];
#pragma unroll
            for (int bj = 0; bj < 2; ++bj) { lb[bj][0] = *(const f32x4*)(LB + lc0 + bj * 128); lb[bj][1] = *(const f32x4*)(LB + lc0 + bj * 128 + 4); }
#pragma unroll
            for (int ai = 0; ai < 2; ++ai)
#pragma unroll
                for (int m = 0; m < 4; ++m) { float* rowp = G + (size_t)(row0 + ai * 128 + m * 16) * 512 + lc0;
#pragma unroll
                    for (int bj = 0; bj < 2; ++bj)
#pragma unroll
                        for (int n = 0; n < 2; ++n) { const f32x4 v = acc[ai][bj][m][n]; f32x4 o;
#pragma unroll
                            for (int e = 0; e < 4; ++e) { const float l = lb[bj][n][e]; const float f = l + (1.0f - l) * sigmoid_f(v[e]); o[e] = __logf(f); }
                            *(f32x4*)(rowp + bj * 128 + 4 * n) = o; } }
            return;
        }
        bf16* base = type == 0 ? PU : type == 1 ? PV : type == 2 ? PQ : type == 4 ? PI : PG;
#pragma unroll
        for (int ai = 0; ai < 2; ++ai)
#pragma unroll
            for (int m = 0; m < 4; ++m) { bf16* rowp = base + (size_t)(row0 + ai * 128 + m * 16) * 512 + lc0;
#pragma unroll
                for (int bj = 0; bj < 2; ++bj) { f32x4 v0 = acc[ai][bj][m][0], v1 = acc[ai][bj][m][1];
                    if (type <= 1) { pg8::f32x2 a = pg8::gelu_pk((pg8::f32x2){v0[0], v0[1]}), b = pg8::gelu_pk((pg8::f32x2){v0[2], v0[3]}), c = pg8::gelu_pk((pg8::f32x2){v1[0], v1[1]}), d = pg8::gelu_pk((pg8::f32x2){v1[2], v1[3]});
                        v0 = (f32x4){a.x, a.y, b.x, b.y}; v1 = (f32x4){c.x, c.y, d.x, d.y}; }
                    else if (type == 2) {
#pragma unroll
                        for (int e = 0; e < 4; ++e) { v0[e] = silu_f(v0[e]) * 0.08838834764831845f; v1[e] = silu_f(v1[e]) * 0.08838834764831845f; } }
                    else if (type == 5) {
#pragma unroll
                        for (int e = 0; e < 4; ++e) { v0[e] = silu_f(v0[e]); v1[e] = silu_f(v1[e]); } }
                    v4u w; w.x = pg8::cvt_pk_bf16(v0[0], v0[1]); w.y = pg8::cvt_pk_bf16(v0[2], v0[3]); w.z = pg8::cvt_pk_bf16(v1[0], v1[1]); w.w = pg8::cvt_pk_bf16(v1[2], v1[3]);
                    *(v4u*)(rowp + bj * 128) = w; } }
    }
};
struct EpiQKRot {
    static constexpr bool PERM = true, AFTER_DRAIN = false;
    bf16* O; const float* CS;
    __device__ __forceinline__ void operator()(const f32x4 (&acc)[2][2][4][2], const pg8::Unit& u, int wr, int wc, int fr, int fq) const {
        const int row0 = u.pm * 256 + wr * 64 + fr, col0 = u.pn * 256 + wc * 32 + 8 * fq;
        const float sc = u.pn < 4 ? C2 : 1.0f;
        const bool rotw = (wc & 1) == 0 && u.pn < 8;
        const float sgn = fq == 0 ? -1.0f : 1.0f;
#pragma unroll
        for (int ai = 0; ai < 2; ++ai)
#pragma unroll
            for (int m = 0; m < 4; ++m) { const int row = row0 + ai * 128 + m * 16; bf16* rowp = O + (size_t)row * 3072 + col0;
                f32x4 c0 = (f32x4){1.f, 1.f, 1.f, 1.f}, c1 = c0, s0 = (f32x4){0.f, 0.f, 0.f, 0.f}, s1 = s0;
                if (rotw && fq < 2) { const float* cp = CS + (size_t)row * 16; c0 = *(const f32x4*)(cp); c1 = *(const f32x4*)(cp + 4); s0 = *(const f32x4*)(cp + 8) * sgn; s1 = *(const f32x4*)(cp + 12) * sgn; }
#pragma unroll
                for (int bj = 0; bj < 2; ++bj) { f32x4 v0 = acc[ai][bj][m][0], v1 = acc[ai][bj][m][1];
                    if (rotw) { f32x4 p0, p1;
#pragma unroll
                        for (int e = 0; e < 4; ++e) { p0[e] = __shfl_xor(v0[e], 16); p1[e] = __shfl_xor(v1[e], 16); }
                        v0 = v0 * c0 + p0 * s0; v1 = v1 * c1 + p1 * s1; }
                    v0 = v0 * sc; v1 = v1 * sc;
                    v4u w; w.x = pg8::cvt_pk_bf16(v0[0], v0[1]); w.y = pg8::cvt_pk_bf16(v0[2], v0[3]); w.z = pg8::cvt_pk_bf16(v1[0], v1[1]); w.w = pg8::cvt_pk_bf16(v1[2], v1[3]);
                    *(v4u*)(rowp + bj * 128) = w; } }
    }
};

__device__ __forceinline__ void p0_transpose_item(const float* W, int K, int N, bf16* WT, LAS float* scr, int item, int lane) {
    const int nblk = N / 32, kb = item / nblk, nb = item % nblk, k0 = 64 * kb, n0 = 32 * nb;
#pragma unroll 8
    for (int i = 0; i < 32; ++i) { const int kk = 2 * i + (lane >> 5); scr[kk * 33 + (lane & 31)] = W[(size_t)(k0 + kk) * N + n0 + (lane & 31)]; }
    LDS_WAIT(); asm volatile("" ::: "memory");
    const int c = lane & 7;
#pragma unroll
    for (int j = 0; j < 4; ++j) { const int n = (lane >> 3) + 8 * j; const LAS float* s = scr + (8 * c) * 33 + n;
        v4u o; o.x = pk2(s[0 * 33], s[1 * 33]); o.y = pk2(s[2 * 33], s[3 * 33]); o.z = pk2(s[4 * 33], s[5 * 33]); o.w = pk2(s[6 * 33], s[7 * 33]);
        *(GAS v4u*)(WT + (size_t)(n0 + n) * K + k0 + 8 * c) = o; }
    LDS_WAIT(); asm volatile("" ::: "memory");
}
typedef float f32x2 __attribute__((ext_vector_type(2)));
__device__ __forceinline__ void convert_tables(const Params& P, const Ctx& C) {
    const int gw = C.vcu * NWAVES + C.wave, NGW = C.G * NWAVES, lane = C.lane;
    for (int row = gw; row < 4 * 16384; row += NGW) {
        const int tb = row >> 14, e = row & 16383;
        const float* src = ((tb & 1) ? P.peer_up : P.peer_down) + ((size_t)(tb >> 1) * 16384 + e) * 1024;
        unsigned char* dst = P.ws + WS_TAB8 + (size_t)tb * TAB8_BYTES + (size_t)e * TROW;
        f32x4 v[4]; float mx = 0.f;
#pragma unroll
        for (int j = 0; j < 4; ++j) { v[j] = ((const f32x4*)src)[64 * j + lane]; mx = fmaxf(mx, fmaxf(fmaxf(fabsf(v[j][0]), fabsf(v[j][1])), fmaxf(fabsf(v[j][2]), fabsf(v[j][3])))); }
#pragma unroll
        for (int o = 1; o < 64; o <<= 1) mx = fmaxf(mx, __shfl_xor(mx, o));
        const float sc = mx > 0.f ? 400.0f / mx : 0.f;
#pragma unroll
        for (int j = 0; j < 4; ++j) { int p = __builtin_amdgcn_cvt_pk_fp8_f32(v[j][0] * sc, v[j][1] * sc, 0, false); p = __builtin_amdgcn_cvt_pk_fp8_f32(v[j][2] * sc, v[j][3] * sc, p, true);
            ((unsigned*)dst)[64 * j + lane] = (unsigned)p; }
        if (lane == 0) ((float*)(P.ws + WS_SC8))[row] = mx * (1.0f / 400.0f);
    }
}
__device__ __forceinline__ void phase_prologue(const Params& P, const Ctx& C) {
    float* MOD = (float*)(P.ws + WS_MOD);
    {
        LAS float* cond = (LAS float*)C.lds;
        LAS float* part = (LAS float*)(C.lds + 32768);
        for (int e = C.tid; e < 8192; e += 512) cond[e] = silu_f(P.c[e]);
        __syncthreads();
        for (int item = C.vcu; item < 192; item += C.G) {
            const int l = item / 96, cb = item % 96, col = cb * 64 + C.lane;
            float acc[8];
#pragma unroll
            for (int b = 0; b < 8; ++b) acc[b] = 0.f;
            const float* wp = P.ada_w + ((size_t)l * 1024 + C.wave * 128) * 6144 + col;
#pragma unroll 4
            for (int k = 0; k < 128; ++k) { const float wv = wp[(size_t)k * 6144];
#pragma unroll
                for (int b = 0; b < 8; ++b) acc[b] += cond[b * 1024 + C.wave * 128 + k] * wv; }
#pragma unroll
            for (int b = 0; b < 8; ++b) part[(C.wave * 8 + b) * 64 + C.lane] = acc[b];
            __syncthreads();
            { const int b = C.tid >> 6, ln = C.tid & 63; float s = P.ada_b[l * 6144 + cb * 64 + ln];
#pragma unroll
              for (int w = 0; w < 8; ++w) s += part[(w * 8 + b) * 64 + ln];
              MOD[(size_t)(l * 8 + b) * 6144 + cb * 64 + ln] = s; }
            __syncthreads();
        }
        __syncthreads();
    }
    {
        LAS float* scr = (LAS float*)(C.lds + C.wave * 16384);
        const int gw = C.vcu * NWAVES + C.wave, NGW = C.G * NWAVES;
        for (int it = gw; it < 6144; it += NGW) {
            int r = it;
            if (r < 1536) { p0_transpose_item(P.even_w_in, 1024, 3072, (bf16*)(P.ws + WS_WIN), scr, r, C.lane); continue; } r -= 1536;
            if (r < 512)  { p0_transpose_item(P.even_w_out, 1024, 1024, (bf16*)(P.ws + WS_WOUT0), scr, r, C.lane); continue; } r -= 512;
            if (r < 1536) { p0_transpose_item(P.odd_w_qkv, 1024, 3072, (bf16*)(P.ws + WS_WQKV), scr, r, C.lane); continue; } r -= 1536;
            if (r < 512)  { p0_transpose_item(P.odd_w_out, 1024, 1024, (bf16*)(P.ws + WS_WOUT1), scr, r, C.lane); continue; } r -= 512;
            if (r < 1024) { p0_transpose_item(P.peer_w_query, 1024, 2048, (bf16*)(P.ws + WS_WQ0), scr, r, C.lane); continue; } r -= 1024;
            p0_transpose_item(P.peer_w_query + (size_t)1024 * 2048, 1024, 2048, (bf16*)(P.ws + WS_WQ1), scr, r, C.lane);
        }
    }
    convert_tables(P, C);
    const int NT = C.G * 512, gt = C.vcu * 512 + C.tid;
    { bf16* skb = (bf16*)(P.ws + WS_SKB); for (int i = gt; i < 65536; i += NT) skb[i] = (bf16)f2bf(P.peer_sub_keys[i]); }
    { bf16* wsb = (bf16*)(P.ws + WS_WSB); for (int i = gt; i < 65536; i += NT) { const int t = (i >> 7) & 127, s = i & 127; wsb[i] = (bf16)(s <= t ? f2bf(P.gmlp_w_s[i]) : 0u); } }
    { float* lb = (float*)(P.ws + WS_LB); for (int i = gt; i < 512; i += NT) { const float l0 = P.hgrn_lb_logits[i], l1 = P.hgrn_lb_logits[512 + i]; lb[i] = 1.0f / (1.0f + expf(l1 - l0)); } }
    { float* cs = (float*)(P.ws + WS_CS); for (int i = gt; i < T * 8; i += NT) { const int tok = i >> 3, j = i & 7;
        const float inv = 1.0f / powf(500000.0f, (float)j * 0.125f); const float ang = (float)P.positions[tok] * inv; float sn, cn; sincosf(ang, &sn, &cn);
        cs[(size_t)tok * 16 + j] = cn; cs[(size_t)tok * 16 + 8 + j] = sn; } }
}
__device__ __forceinline__ void norm_row_bf16(const float* xrow, bf16* hrow, const float* g, const float* sh, const float* sc, int lane) {
    const f32x4* xr = (const f32x4*)xrow + lane; f32x4 v[4]; float s = 0.f;
#pragma unroll
    for (int j = 0; j < 4; ++j) { v[j] = xr[64 * j]; s += (v[j][0] * v[j][0] + v[j][1] * v[j][1]) + (v[j][2] * v[j][2] + v[j][3] * v[j][3]); }
    const float rstd = 1.0f / sqrtf(wave_sum(s) * (1.0f / 1024.0f) + NORM_EPS);
    unsigned long long* o8 = (unsigned long long*)hrow + lane;
#pragma unroll
    for (int j = 0; j < 4; ++j) { const f32x4 gg = ((const f32x4*)g)[64 * j + lane], hh = ((const f32x4*)sh)[64 * j + lane], cc = ((const f32x4*)sc)[64 * j + lane];
        const f32x4 y = (v[j] * rstd * gg) * (cc + 1.0f) + hh;
        o8[64 * j] = (unsigned long long)pk2(y[0], y[1]) | ((unsigned long long)pk2(y[2], y[3]) << 32); }
}
__device__ __forceinline__ void phase_norm(const Params& P, const Ctx& C, const float* xsrc, const float* g, int l, int so) {
    const float* MOD = (const float*)(P.ws + WS_MOD); bf16* H = (bf16*)(P.ws + WS_H);
    const int gw = C.vcu * NWAVES + C.wave, NGW = C.G * NWAVES;
    for (int m = gw; m < T; m += NGW) { const float* mb = MOD + (size_t)(l * 8 + (m >> 13)) * 6144 + so;
        norm_row_bf16(xsrc + (size_t)m * 1024, H + (size_t)m * 1024, g, mb, mb + 1024, C.lane); }
}

__device__ __forceinline__ void gmlp_item(const Params& P, const Ctx& C, int n, int g) {
    LAS bf16* Wt = (LAS bf16*)C.lds;
    LAS bf16* vT = (LAS bf16*)(C.lds + 34816);
    const bf16* WSB = (const bf16*)(P.ws + WS_WSB); const bf16* PU = (const bf16*)(P.ws + WS_PU); const bf16* PV = (const bf16*)(P.ws + WS_PV); bf16* MIX = (bf16*)(P.ws + WS_H);
    const int tid = C.tid, r = C.lane & 15, q4 = C.lane >> 4;
    for (int ch = tid; ch < 2048; ch += 512) { const int rr = ch >> 4, c8 = (ch & 15) * 8; *(LAS v4u*)(Wt + rr * 136 + c8) = *(const v4u*)(WSB + (size_t)(g * 128 + rr) * 128 + c8); }
    { const int t = tid >> 2, part = tid & 3; const bf16* src = PV + (size_t)(n * 128 + t) * 512 + g * 128 + part * 32;
      float x[32];
#pragma unroll
      for (int j = 0; j < 4; ++j) { const v4u w = *(const v4u*)(src + 8 * j);
#pragma unroll
          for (int e = 0; e < 4; ++e) { x[8 * j + 2 * e] = bflo(w[e]); x[8 * j + 2 * e + 1] = bfhi(w[e]); } }
      float s = 0.f;
#pragma unroll
      for (int j = 0; j < 32; ++j) s += x[j];
      s += __shfl_xor(s, 1); s += __shfl_xor(s, 2);
      const float mean = s * (1.0f / 128.0f); float q = 0.f;
#pragma unroll
      for (int j = 0; j < 32; ++j) { const float d = x[j] - mean; q += d * d; }
      q += __shfl_xor(q, 1); q += __shfl_xor(q, 2);
      const float rstd = 1.0f / sqrtf(q * (1.0f / 128.0f) + NORM_EPS);
      const float* lg = P.gmlp_ln_g + g * 128 + part * 32; const float* lbp = P.gmlp_ln_b + g * 128 + part * 32;
#pragma unroll
      for (int j = 0; j < 32; ++j) vT[(part * 32 + j) * 136 + t] = (bf16)f2bf((x[j] - mean) * rstd * lg[j] + lbp[j]);
    }
    __syncthreads();
    const int t0 = 16 * C.wave; const int Keff = ((t0 + 16 + 31) >> 5) << 5;
    f32x4 acc[8];
#pragma unroll
    for (int ct = 0; ct < 8; ++ct) { acc[ct] = (f32x4){0.f, 0.f, 0.f, 0.f}; acc[ct] = mma16(acc[ct], Wt + t0 * 136, 136, vT + (16 * ct) * 136, 136, Keff, r, q4); }
#pragma unroll
    for (int i = 0; i < 4; ++i) { const int t = t0 + 4 * q4 + i; const float bs = P.gmlp_b_s[g * 128 + t]; const size_t tok = (size_t)n * 128 + t;
#pragma unroll
        for (int ct = 0; ct < 8; ++ct) { const int c = 16 * ct + r; const float u = bf2f(PU[tok * 512 + g * 128 + c]); MIX[tok * 1024 + g * 128 + c] = (bf16)f2bf(u * (acc[ct][i] + bs)); } }
    __syncthreads();
}
__device__ __forceinline__ void hgrn_cumsum16(const float* G, size_t tok0, int hh, int k, int seg, LAS float* tot, float (&g)[16], float (&bb)[16], float& total) {
    const float* gp = G + (tok0 + seg * 16) * 512 + hh * 128 + k;
#pragma unroll
    for (int j = 0; j < 16; ++j) g[j] = gp[(size_t)j * 512];
    float run = 0.f;
#pragma unroll
    for (int j = 0; j < 16; ++j) { run += g[j]; bb[j] = run; }
    tot[seg * 128 + k] = run;
    __syncthreads();
    const float t0 = tot[k], t1 = tot[128 + k], t2 = tot[256 + k], t3 = tot[384 + k];
    const float pre = seg == 0 ? 0.f : seg == 1 ? t0 : seg == 2 ? t0 + t1 : t0 + t1 + t2;
    total = (t0 + t1) + (t2 + t3);
#pragma unroll
    for (int j = 0; j < 16; ++j) bb[j] += pre;
}
__device__ __forceinline__ void hgrn_stage_iT(const bf16* PI, size_t tok0, int hh, LAS bf16* iT, int tid) {
    const int s = tid >> 3, v0 = (tid & 7) * 16; const bf16* src = PI + (tok0 + s) * 512 + hh * 128 + v0;
#pragma unroll
    for (int h2 = 0; h2 < 2; ++h2) { const v4u w = *(const v4u*)(src + 8 * h2);
#pragma unroll
        for (int e = 0; e < 4; ++e) { iT[(v0 + 8 * h2 + 2 * e) * 72 + s] = (bf16)(w[e] & 0xffffu); iT[(v0 + 8 * h2 + 2 * e + 1) * 72 + s] = (bf16)(w[e] >> 16); } }
}
__device__ __forceinline__ void hgrn_local_item(const Params& P, const Ctx& C, int item) {
    LAS bf16* khT = (LAS bf16*)C.lds;
    LAS bf16* iT = (LAS bf16*)(C.lds + 18432);
    LAS float* tot = (LAS float*)(C.lds + 36864);
    const float* G = (const float*)(P.ws + WS_G); const bf16* PI = (const bf16*)(P.ws + WS_PI); bf16* KVT = (bf16*)(P.ws + WS_KVT); float* HD = (float*)(P.ws + WS_HD);
    const int bh = item >> 7, c = item & 127, b = bh >> 2, hh = bh & 3; const size_t tok0 = (size_t)b * SEQ + c * 64;
    const int tid = C.tid, k = tid & 127, seg = tid >> 7, r = C.lane & 15, q4 = C.lane >> 4;
    float g[16], bb[16], total;
    hgrn_cumsum16(G, tok0, hh, k, seg, tot, g, bb, total);
    { unsigned w[8];
#pragma unroll
      for (int j = 0; j < 8; ++j) { const float a0 = -expm1f(g[2 * j]) * __expf(total - bb[2 * j]), a1 = -expm1f(g[2 * j + 1]) * __expf(total - bb[2 * j + 1]); w[j] = pk2(a0, a1); }
      LAS v4u* dst = (LAS v4u*)(khT + k * 72 + seg * 16); dst[0] = (v4u){w[0], w[1], w[2], w[3]}; dst[1] = (v4u){w[4], w[5], w[6], w[7]}; }
    if (seg == 0) HD[(size_t)item * 128 + k] = __expf(total);
    hgrn_stage_iT(PI, tok0, hh, iT, tid);
    __syncthreads();
    const int v0 = 16 * C.wave;
#pragma unroll
    for (int ct = 0; ct < 8; ++ct) { f32x4 acc = (f32x4){0.f, 0.f, 0.f, 0.f}; acc = mma16(acc, iT + v0 * 72, 72, khT + (16 * ct) * 72, 72, 64, r, q4);
#pragma unroll
        for (int i = 0; i < 4; ++i) KVT[((size_t)item * 128 + v0 + 4 * q4 + i) * 128 + 16 * ct + r] = (bf16)f2bf(acc[i]); }
    __syncthreads();
}
__device__ __forceinline__ void phase_hgrn_scan(const Params& P, const Ctx& C) {
    const bf16* KVT = (const bf16*)(P.ws + WS_KVT); bf16* ST = (bf16*)(P.ws + WS_ST); const float* HD = (const float*)(P.ws + WS_HD);
    for (int task = C.vcu * 256 + C.tid; C.tid < 256 && task < 65536; task += C.G * 256) {
        const int bh = task >> 11, v = (task >> 4) & 127, kb = task & 15;
        float st[8];
#pragma unroll
        for (int e = 0; e < 8; ++e) st[e] = 0.f;
#pragma unroll 4
        for (int c = 0; c < 128; ++c) { const size_t item = (size_t)bh * 128 + c, off = (item * 128 + v) * 128 + kb * 8;
            const v4u kv = *(const v4u*)(KVT + off); const f32x4 d0 = *(const f32x4*)(HD + item * 128 + kb * 8), d1 = *(const f32x4*)(HD + item * 128 + kb * 8 + 4);
            v4u o; o.x = pk2(st[0], st[1]); o.y = pk2(st[2], st[3]); o.z = pk2(st[4], st[5]); o.w = pk2(st[6], st[7]);
            *(v4u*)(ST + off) = o;
#pragma unroll
            for (int e = 0; e < 4; ++e) { st[2 * e] = (e < 2 ? d0[2 * e] : d1[2 * e - 4]) * st[2 * e] + bflo(kv[e]); st[2 * e + 1] = (e < 2 ? d0[2 * e + 1] : d1[2 * e - 3]) * st[2 * e + 1] + bfhi(kv[e]); }
        }
    }
}
__device__ __forceinline__ void hgrn_out_item(const Params& P, const Ctx& C, int item) {
    LAS bf16* qt = (LAS bf16*)C.lds;
    LAS bf16* kt = (LAS bf16*)(C.lds + 17408);
    LAS bf16* iT = (LAS bf16*)(C.lds + 34816);
    LAS bf16* A1 = (LAS bf16*)(C.lds + 53248);
    LAS bf16* STl = (LAS bf16*)(C.lds + 62464);
    LAS float* ol = (LAS float*)(C.lds + 97280);
    LAS float* tot = (LAS float*)(C.lds + 131072);
    const float* G = (const float*)(P.ws + WS_G); const bf16* PQ = (const bf16*)(P.ws + WS_PQ); const bf16* PI = (const bf16*)(P.ws + WS_PI); const bf16* PG = (const bf16*)(P.ws + WS_PG);
    const bf16* ST = (const bf16*)(P.ws + WS_ST); bf16* MIX = (bf16*)(P.ws + WS_H);
    const int bh = item >> 7, c = item & 127, b = bh >> 2, hh = bh & 3; const size_t tok0 = (size_t)b * SEQ + c * 64;
    const int tid = C.tid, k = tid & 127, seg = tid >> 7, r = C.lane & 15, q4 = C.lane >> 4;
    float g[16], bb[16], total;
    hgrn_cumsum16(G, tok0, hh, k, seg, tot, g, bb, total);
#pragma unroll
    for (int j = 0; j < 16; ++j) { const int t = seg * 16 + j; const float qv = bf2f(PQ[(tok0 + t) * 512 + hh * 128 + k]);
        qt[t * 136 + k] = (bf16)f2bf(qv * __expf(bb[j])); kt[t * 136 + k] = (bf16)f2bf(-expm1f(g[j]) * __expf(-bb[j])); }
    hgrn_stage_iT(PI, tok0, hh, iT, tid);
    for (int ch = tid; ch < 2048; ch += 512) { const int rr = ch >> 4, c8 = (ch & 15) * 8; *(LAS v4u*)(STl + rr * 136 + c8) = *(const v4u*)(ST + ((size_t)item * 128 + rr) * 128 + c8); }
    __syncthreads();
    { const int rt = C.wave >> 1;
#pragma unroll
      for (int cc = 0; cc < 2; ++cc) { const int ct = (C.wave & 1) * 2 + cc; f32x4 acc = (f32x4){0.f, 0.f, 0.f, 0.f};
          acc = mma16(acc, qt + (16 * rt) * 136, 136, kt + (16 * ct) * 136, 136, 128, r, q4);
#pragma unroll
          for (int i = 0; i < 4; ++i) { const int t = 16 * rt + 4 * q4 + i, s = 16 * ct + r; A1[t * 72 + s] = (bf16)(s <= t ? f2bf(acc[i]) : 0u); } } }
    __syncthreads();
    { const int rt = C.wave >> 1;
#pragma unroll
      for (int cc = 0; cc < 4; ++cc) { const int ct = (C.wave & 1) * 4 + cc; f32x4 acc = (f32x4){0.f, 0.f, 0.f, 0.f};
          acc = mma16(acc, A1 + (16 * rt) * 72, 72, iT + (16 * ct) * 72, 72, 64, r, q4);
          acc = mma16(acc, qt + (16 * rt) * 136, 136, STl + (16 * ct) * 136, 136, 128, r, q4);
#pragma unroll
          for (int i = 0; i < 4; ++i) ol[(16 * rt + 4 * q4 + i) * 132 + 16 * ct + r] = acc[i]; } }
    __syncthreads();
    { const int t = tid >> 3, v0 = (tid & 7) * 16; float o[16]; float ss = 0.f;
#pragma unroll
      for (int e = 0; e < 16; ++e) { o[e] = ol[t * 132 + v0 + e]; ss += o[e] * o[e]; }
      ss += __shfl_xor(ss, 1); ss += __shfl_xor(ss, 2); ss += __shfl_xor(ss, 4);
      const float rstd = 1.0f / sqrtf(ss * (1.0f / 128.0f) + NORM_EPS);
      const float* ng = P.hgrn_norm_g + hh * 128 + v0; const bf16* gp = PG + (tok0 + t) * 512 + hh * 128 + v0;
      const v4u g0 = *(const v4u*)gp, g1 = *(const v4u*)(gp + 8); unsigned w[8];
#pragma unroll
      for (int e = 0; e < 4; ++e) { w[e] = pk2(o[2 * e] * rstd * ng[2 * e] * bflo(g0[e]), o[2 * e + 1] * rstd * ng[2 * e + 1] * bfhi(g0[e]));
                                    w[4 + e] = pk2(o[8 + 2 * e] * rstd * ng[8 + 2 * e] * bflo(g1[e]), o[9 + 2 * e] * rstd * ng[9 + 2 * e] * bfhi(g1[e])); }
      v4u* dst = (v4u*)(MIX + (tok0 + t) * 1024 + 512 + hh * 128 + v0); dst[0] = (v4u){w[0], w[1], w[2], w[3]}; dst[1] = (v4u){w[4], w[5], w[6], w[7]}; }
    __syncthreads();
}

typedef short v4i16_t __attribute__((ext_vector_type(4)));
constexpr int AT_ST = 68;
constexpr int AT_VP = 144;
__device__ __forceinline__ void attn_item(const Params& P, const Ctx& C, int b, int hd, int qt) {
    LAS float* St = (LAS float*)C.lds;
    LAS unsigned char* Vw = C.lds + 256 * AT_ST * 4 + C.wave * (64 * AT_VP);
    const bf16* QKV = (const bf16*)(P.ws + WS_QK); bf16* O = (bf16*)(P.ws + WS_H);
    const int lane = C.lane, r = lane & 15, q4 = lane >> 4;
    const int t0 = qt * 256; const size_t rowbase = (size_t)b * SEQ;
    const bf16* Kb = QKV + rowbase * 3072 + 1024 + hd * 64; const bf16* Vb = QKV + rowbase * 3072 + 2048 + hd * 64;
#pragma unroll 1
    for (int g = 0; g < 3; ++g) {
        const int dsh = 4 - 2 * g, d = 1 << dsh;
#pragma unroll 1
        for (int uu = 0; uu < 2; ++uu) {
            const int u = C.wave + 8 * uu;
            const int c = u & (d - 1), j = u >> dsh;
            const int mq0 = (t0 >> dsh) + 16 * j;
            const int qloc = c + d * (16 * j + r);
            const bf16* qp = QKV + (rowbase + t0 + qloc) * 3072 + hd * 64 + 8 * q4;
            const bf16x8 bq0 = *(const bf16x8*)qp, bq1 = *(const bf16x8*)(qp + 32);
            f32x4 sa[9];
#pragma unroll
            for (int t = 0; t < 9; ++t) { int mk = mq0 - 128 + 16 * t + r; mk = mk < 0 ? 0 : mk;
                const bf16* kp = Kb + (size_t)(c + d * mk) * 3072 + 8 * q4;
                const bf16x8 a0 = *(const bf16x8*)kp, a1 = *(const bf16x8*)(kp + 32);
                sa[t] = (f32x4){0.f, 0.f, 0.f, 0.f}; sa[t] = __builtin_amdgcn_mfma_f32_16x16x32_bf16(a0, bq0, sa[t], 0, 0, 0); sa[t] = __builtin_amdgcn_mfma_f32_16x16x32_bf16(a1, bq1, sa[t], 0, 0, 0); }
            float mx = -1e30f;
#pragma unroll
            for (int t = 0; t < 9; ++t)
#pragma unroll
                for (int i = 0; i < 4; ++i) { const int kap = 16 * t + 4 * q4 + i; const bool ok = kap >= r && kap <= r + 128 && (mq0 - 128 + kap) >= 0;
                    sa[t][i] = ok ? sa[t][i] : -1e30f; mx = fmaxf(mx, sa[t][i]); }
            mx = fmaxf(mx, __shfl_xor(mx, 16)); mx = fmaxf(mx, __shfl_xor(mx, 32));
            float ls = 0.f;
#pragma unroll
            for (int t = 0; t < 9; ++t)
#pragma unroll
                for (int i = 0; i < 4; ++i) { const float p = sa[t][i] > -1e29f ? __builtin_amdgcn_exp2f(sa[t][i] - mx) : 0.f; sa[t][i] = p; ls += p; }
            ls += __shfl_xor(ls, 16); ls += __shfl_xor(ls, 32);
            bf16x8 pf[5];
#pragma unroll
            for (int s = 0; s < 5; ++s) { const f32x4 lo = sa[2 * s], hi = (2 * s + 1 < 9) ? sa[2 * s + 1 < 9 ? 2 * s + 1 : 8] : (f32x4){0.f, 0.f, 0.f, 0.f};
                v4u w; w.x = pk2(lo[0], lo[1]); w.y = pk2(lo[2], lo[3]); w.z = pk2(hi[0], hi[1]); w.w = pk2(hi[2], hi[3]); pf[s] = __builtin_bit_cast(bf16x8, w); }
            f32x4 oa[4];
#pragma unroll
            for (int dt = 0; dt < 4; ++dt) oa[dt] = (f32x4){0.f, 0.f, 0.f, 0.f};
#pragma unroll
            for (int ch = 0; ch < 3; ++ch) {
#pragma unroll
                for (int it = 0; it < 8; ++it) { const int row = 8 * it + (lane >> 3); int kap = 64 * ch + row; kap = kap > 143 ? 143 : kap; int mk = mq0 - 128 + kap; mk = mk < 0 ? 0 : mk;
                    const v4u v = *(const v4u*)(Vb + (size_t)(c + d * mk) * 3072 + (lane & 7) * 8);
                    *(LAS v4u*)(Vw + row * AT_VP + (lane & 7) * 16) = v; }
                asm volatile("s_waitcnt lgkmcnt(0)" ::: "memory");
#pragma unroll
                for (int s2 = 0; s2 < 2; ++s2) { const int s = 2 * ch + s2; if (s < 5) {
#pragma unroll
                    for (int dt = 0; dt < 4; ++dt) {
                        const LAS unsigned char* vp = Vw + (32 * s2 + 4 * q4 + (r >> 2)) * AT_VP + dt * 32 + (r & 3) * 8;
                        const v4i16_t x = __builtin_amdgcn_ds_read_tr16_b64_v4i16((LAS v4i16_t*)vp), y = __builtin_amdgcn_ds_read_tr16_b64_v4i16((LAS v4i16_t*)(vp + 16 * AT_VP));
                        const bf16x8 av = (bf16x8){x[0], x[1], x[2], x[3], y[0], y[1], y[2], y[3]};
                        oa[dt] = __builtin_amdgcn_mfma_f32_16x16x32_bf16(av, pf[s], oa[dt], 0, 0, 0); } } }
                asm volatile("s_waitcnt lgkmcnt(0)" ::: "memory");
            }
            LAS float* sp = St + qloc * AT_ST;
            float mo = mx, lo2 = ls;
            if (g > 0) { const float m_old = sp[64], l_old = sp[65]; const float M = fmaxf(m_old, mx); const float fo = __builtin_amdgcn_exp2f(m_old - M), fn = __builtin_amdgcn_exp2f(mx - M);
#pragma unroll
                for (int dt = 0; dt < 4; ++dt) { const f32x4 po = *(const LAS f32x4*)(sp + 16 * dt + 4 * q4); oa[dt] = oa[dt] * fn + po * fo; }
                mo = M; lo2 = ls * fn + l_old * fo; }
            if (g < 2) {
#pragma unroll
                for (int dt = 0; dt < 4; ++dt) *(LAS f32x4*)(sp + 16 * dt + 4 * q4) = oa[dt];
                if (q4 == 0) { sp[64] = mo; sp[65] = lo2; }
            } else { const float inv = 1.0f / lo2; bf16* op = O + (rowbase + t0 + qloc) * 1024 + hd * 64 + 4 * q4;
#pragma unroll
                for (int dt = 0; dt < 4; ++dt) { const f32x4 v = oa[dt] * inv; *(unsigned long long*)(op + 16 * dt) = (unsigned long long)pk2(v[0], v[1]) | ((unsigned long long)pk2(v[2], v[3]) << 32); } }
        }
        __syncthreads();
    }
}

__device__ __forceinline__ unsigned ordf(float s) { const unsigned u = __builtin_bit_cast(unsigned, s); return u ^ ((unsigned)((int)u >> 31) | 0x80000000u); }
__device__ __forceinline__ float unordf(unsigned v) { return __builtin_bit_cast(float, v ^ ((unsigned)((int)(~v) >> 31) | 0x80000000u)); }
__device__ __forceinline__ void ins16(unsigned (&top)[16], unsigned x) {
#pragma unroll
    for (int j = 0; j < 16; ++j) { const unsigned hi = top[j] > x ? top[j] : x; x = top[j] > x ? x : top[j]; top[j] = hi; }
}
#define CE_D(a, b) { const unsigned hi_ = (a) > (b) ? (a) : (b), lo_ = (a) > (b) ? (b) : (a); (a) = hi_; (b) = lo_; }
__device__ __forceinline__ void sort16_desc(unsigned (&v)[16]) {
#pragma unroll
    for (int k = 2; k <= 16; k <<= 1)
#pragma unroll
        for (int j = k >> 1; j > 0; j >>= 1)
#pragma unroll
            for (int i = 0; i < 16; ++i) { const int l = i ^ j; if (l > i) { if ((i & k) == 0) CE_D(v[i], v[l]) else CE_D(v[l], v[i]) } }
}
__device__ __forceinline__ void bitonic_merge16_desc(unsigned (&c)[16]) {
#pragma unroll
    for (int st = 8; st >= 1; st >>= 1)
#pragma unroll
        for (int j = 0; j < 16; ++j) if ((j & st) == 0) CE_D(c[j], c[j + st])
}
__device__ __forceinline__ void top16_of_two(unsigned (&a)[16], const unsigned (&b)[16]) {
#pragma unroll
    for (int j = 0; j < 16; ++j) a[j] = a[j] > b[15 - j] ? a[j] : b[15 - j];
    bitonic_merge16_desc(a);
}
__device__ __forceinline__ void merge16(unsigned (&top)[16], int mask) {
    unsigned o[16];
#pragma unroll
    for (int j = 0; j < 16; ++j) o[j] = (unsigned)__shfl_xor((int)top[j], mask);
    top16_of_two(top, o);
}
__device__ __forceinline__ void phase_peer_topk(const Params& P, const Ctx& C, int layer) {
    LAS bf16* SK = (LAS bf16*)C.lds;
    const bf16* SKB = (const bf16*)(P.ws + WS_SKB) + (size_t)layer * 32768; const bf16* QP = (const bf16*)(P.ws + WS_QP);
    int* IDX = (int*)(P.ws + WS_IDX); float* GATE = (float*)(P.ws + WS_GATE);
    for (int ch = C.tid; ch < 4096; ch += 512) { const int rr = ch >> 4, c8 = (ch & 15) * 8; *(LAS v4u*)(SK + rr * 136 + c8) = *(const v4u*)(SKB + (size_t)rr * 128 + c8); }
    __syncthreads();
    const int r = C.lane & 15, q4 = C.lane >> 4;
    const int gw = C.vcu * NWAVES + C.wave, NGW = C.G * NWAVES;
    for (int grp = gw; grp < T * 8 / 16; grp += NGW) {
        const size_t task = (size_t)grp * 16 + r;
        unsigned lst[2][16];
#pragma unroll
        for (int half = 0; half < 2; ++half) {
            bf16x8 bq[4];
#pragma unroll
            for (int ks = 0; ks < 4; ++ks) bq[ks] = *(const bf16x8*)(QP + task * 256 + half * 128 + ks * 32 + 8 * q4);
            unsigned ka[16], kb[16];
#pragma unroll
            for (int nt = 0; nt < 8; ++nt) { f32x4 acc = (f32x4){0.f, 0.f, 0.f, 0.f};
#pragma unroll
                for (int ks = 0; ks < 4; ++ks) { const bf16x8 a = *(const LAS bf16x8*)(SK + (half * 128 + 16 * nt + r) * 136 + ks * 32 + 8 * q4); acc = __builtin_amdgcn_mfma_f32_16x16x32_bf16(a, bq[ks], acc, 0, 0, 0); }
#pragma unroll
                for (int i = 0; i < 4; ++i) { const unsigned n = 16 * nt + 4 * q4 + i; const unsigned key = (ordf(acc[i]) & ~127u) | (127u - n); if (nt < 4) ka[4 * nt + i] = key; else kb[4 * (nt - 4) + i] = key; }
                if (nt == 3) sort16_desc(ka);
                __builtin_amdgcn_sched_barrier(0); }
            sort16_desc(kb); top16_of_two(ka, kb);
            merge16(ka, 16); merge16(ka, 32);
#pragma unroll
            for (int j = 0; j < 16; ++j) lst[half][j] = ka[j];
        }
        float v2[16]; unsigned e2[16];
#pragma unroll
        for (int j = 0; j < 16; ++j) { v2[j] = unordf(lst[1][j] & ~127u); e2[j] = 127u - (lst[1][j] & 127u); }
        float v1s[4]; unsigned e1s[4];
#pragma unroll
        for (int k = 0; k < 4; ++k) { const unsigned w = q4 == 0 ? lst[0][4 * k] : q4 == 1 ? lst[0][4 * k + 1] : q4 == 2 ? lst[0][4 * k + 2] : lst[0][4 * k + 3];
            v1s[k] = unordf(w & ~127u); e1s[k] = (127u - (w & 127u)) << 7; }
        unsigned top[16];
#pragma unroll
        for (int j = 0; j < 16; ++j) top[j] = (ordf(v1s[0] + v2[j]) & ~16383u) | e1s[0] | e2[j];
        sort16_desc(top);
#pragma unroll
        for (int j = 0; j < 3; ++j) ins16(top, (ordf(v1s[1] + v2[j]) & ~16383u) | e1s[1] | e2[j]);
        ins16(top, (ordf(v1s[2] + v2[0]) & ~16383u) | e1s[2] | e2[0]);
        ins16(top, (ordf(v1s[3] + v2[0]) & ~16383u) | e1s[3] | e2[0]);
        merge16(top, 16); merge16(top, 32);
        float ev[16]; float den = 0.f; const float mx = unordf(top[0] & ~16383u);
#pragma unroll
        for (int j = 0; j < 16; ++j) { ev[j] = __expf(unordf(top[j] & ~16383u) - mx); den += ev[j]; }
        const float inv = 1.0f / den;
        int* ip = IDX + task * 16; float* gp = GATE + task * 16;
        if (q4 == 0) { *(v4u*)(ip) = (v4u){top[0] & 16383u, top[1] & 16383u, top[2] & 16383u, top[3] & 16383u}; *(f32x4*)(gp) = (f32x4){ev[0] * inv, ev[1] * inv, ev[2] * inv, ev[3] * inv}; }
        else if (q4 == 1) { *(v4u*)(ip + 4) = (v4u){top[4] & 16383u, top[5] & 16383u, top[6] & 16383u, top[7] & 16383u}; *(f32x4*)(gp + 4) = (f32x4){ev[4] * inv, ev[5] * inv, ev[6] * inv, ev[7] * inv}; }
        else if (q4 == 2) { *(v4u*)(ip + 8) = (v4u){top[8] & 16383u, top[9] & 16383u, top[10] & 16383u, top[11] & 16383u}; *(f32x4*)(gp + 8) = (f32x4){ev[8] * inv, ev[9] * inv, ev[10] * inv, ev[11] * inv}; }
        else { *(v4u*)(ip + 12) = (v4u){top[12] & 16383u, top[13] & 16383u, top[14] & 16383u, top[15] & 16383u}; *(f32x4*)(gp + 12) = (f32x4){ev[12] * inv, ev[13] * inv, ev[14] * inv, ev[15] * inv}; }
    }
}
struct ExpRow { v4u d[4], u[4]; float ds, us, gk; };
__device__ __forceinline__ void exp_issue(ExpRow& R, const unsigned char* TD, const unsigned char* TU, const float* SD, int ex, float gk, int jl) {
    const unsigned char* dr = TD + (size_t)ex * TROW; const unsigned char* ur = TU + (size_t)ex * TROW;
#pragma unroll
    for (int c = 0; c < 4; ++c) R.d[c] = *(const v4u*)(dr + (c * 16 + jl) * 16);
#pragma unroll
    for (int c = 0; c < 4; ++c) R.u[c] = *(const v4u*)(ur + (c * 16 + jl) * 16);
    R.ds = SD[ex]; R.us = SD[16384 + ex]; R.gk = gk;
}
__device__ __forceinline__ void exp_consume(const ExpRow& R, const unsigned (&hp)[32], f32x2 (&oacc)[32]) {
    f32x2 a2 = (f32x2){0.f, 0.f};
#pragma unroll
    for (int c = 0; c < 4; ++c)
#pragma unroll
        for (int w = 0; w < 4; ++w) { const f32x2 lo = __builtin_amdgcn_cvt_pk_f32_fp8((int)R.d[c][w], false), hi = __builtin_amdgcn_cvt_pk_f32_fp8((int)R.d[c][w], true);
            unsigned h0 = hp[c * 8 + 2 * w], h1 = hp[c * 8 + 2 * w + 1]; asm volatile("" : "+v"(h0), "+v"(h1));
            a2 = a2 + lo * (f32x2){bflo(h0), bfhi(h0)}; a2 = a2 + hi * (f32x2){bflo(h1), bfhi(h1)}; }
    float a = (a2.x + a2.y) * R.ds;
    a += __shfl_xor(a, 1); a += __shfl_xor(a, 2); a += __shfl_xor(a, 4); a += __shfl_xor(a, 8);
    const float wk = R.gk * gelu_f(a) * R.us; const f32x2 wk2 = (f32x2){wk, wk};
#pragma unroll
    for (int c = 0; c < 4; ++c)
#pragma unroll
        for (int w = 0; w < 4; ++w) { const f32x2 lo = __builtin_amdgcn_cvt_pk_f32_fp8((int)R.u[c][w], false), hi = __builtin_amdgcn_cvt_pk_f32_fp8((int)R.u[c][w], true);
            oacc[c * 8 + 2 * w] = oacc[c * 8 + 2 * w] + wk2 * lo; oacc[c * 8 + 2 * w + 1] = oacc[c * 8 + 2 * w + 1] + wk2 * hi; }
}
__device__ __forceinline__ void phase_peer_experts(const Params& P, const Ctx& C, int layer, bool last) {
    const unsigned char* TD = P.ws + WS_TAB8 + (size_t)(2 * layer) * TAB8_BYTES; const unsigned char* TU = P.ws + WS_TAB8 + (size_t)(2 * layer + 1) * TAB8_BYTES; const float* SD = (const float*)(P.ws + WS_SC8) + (size_t)(2 * layer) * 16384; bf16* H = (bf16*)(P.ws + WS_H);
    const int* IDX = (const int*)(P.ws + WS_IDX); const float* GATE = (const float*)(P.ws + WS_GATE); const float* MOD = (const float*)(P.ws + WS_MOD);
    const int lane = C.lane, grp = lane >> 4, jl = lane & 15;
    const int gw = C.vcu * NWAVES + C.wave, NGW = C.G * NWAVES;
    for (int tok = gw; tok < T; tok += NGW) {
        const int b = tok >> 13;
        const int i0 = IDX[(size_t)tok * 128 + lane], i1 = IDX[(size_t)tok * 128 + 64 + lane];
        const float g0 = GATE[(size_t)tok * 128 + lane], g1 = GATE[(size_t)tok * 128 + 64 + lane];
        unsigned hf[32];
#pragma unroll
        for (int c = 0; c < 4; ++c) { const bf16* hp = H + (size_t)tok * 1024 + (c * 16 + jl) * 16; const v4u w0 = *(const v4u*)hp, w1 = *(const v4u*)(hp + 8);
#pragma unroll
            for (int e = 0; e < 4; ++e) { hf[c * 8 + e] = w0[e]; hf[c * 8 + 4 + e] = w1[e]; } }
        f32x2 oacc[32];
#pragma unroll
        for (int e = 0; e < 32; ++e) oacc[e] = (f32x2){0.f, 0.f};
        ExpRow RA, RB;
        exp_issue(RA, TD, TU, SD, __shfl(i0, grp), __shfl(g0, grp), jl);
        for (int it = 0; it < 32 * EXP_REP; it += 2) {
            { const int kk = ((it + 1) & 31) * 4 + grp; const int el = __shfl(i0, kk & 63), eh = __shfl(i1, kk & 63); const float gl = __shfl(g0, kk & 63), gh = __shfl(g1, kk & 63);
              exp_issue(RB, TD, TU, SD, kk < 64 ? el : eh, kk < 64 ? gl : gh, jl); }
            exp_consume(RA, hf, oacc);
            { const int kk = ((it + 2) & 31) * 4 + grp; const int el = __shfl(i0, kk & 63), eh = __shfl(i1, kk & 63); const float gl = __shfl(g0, kk & 63), gh = __shfl(g1, kk & 63);
              exp_issue(RA, TD, TU, SD, kk < 64 ? el : eh, kk < 64 ? gl : gh, jl); }
            exp_consume(RB, hf, oacc);
        }
        f32x2 h1[16];
        { const bool up = (grp & 2) != 0;
#pragma unroll
          for (int e = 0; e < 16; ++e) { const f32x2 keep = up ? oacc[16 + e] : oacc[e], send = up ? oacc[e] : oacc[16 + e]; h1[e] = keep + (f32x2){__shfl_xor(send.x, 32), __shfl_xor(send.y, 32)}; } }
        f32x2 h2[8];
        { const bool up = (grp & 1) != 0;
#pragma unroll
          for (int e = 0; e < 8; ++e) { const f32x2 keep = up ? h1[8 + e] : h1[e], send = up ? h1[e] : h1[8 + e]; h2[e] = keep + (f32x2){__shfl_xor(send.x, 16), __shfl_xor(send.y, 16)}; } }
        const int d0 = (grp * 16 + jl) * 16;
        const float* g2p = MOD + (size_t)(layer * 8 + b) * 6144 + 5120 + d0; const float psc = ((ABL_ON >= (layer == 0 ? 2 : 4)) ? 1.f : 0.f) * (1.0f / EXP_REP);
        float* xp = P.out + (size_t)tok * 1024 + d0;
        float xn[16]; float ss = 0.f;
#pragma unroll
        for (int q = 0; q < 4; ++q) { const f32x4 xa = *(const f32x4*)(xp + 4 * q), ga = *(const f32x4*)(g2p + 4 * q);
            xn[4 * q] = xa[0] + psc * ga[0] * h2[2 * q].x; xn[4 * q + 1] = xa[1] + psc * ga[1] * h2[2 * q].y; xn[4 * q + 2] = xa[2] + psc * ga[2] * h2[2 * q + 1].x; xn[4 * q + 3] = xa[3] + psc * ga[3] * h2[2 * q + 1].y; }
#pragma unroll
        for (int e = 0; e < 16; ++e) ss += xn[e] * xn[e];
        const float rstd = 1.0f / sqrtf(wave_sum(ss) * (1.0f / 1024.0f) + NORM_EPS);
        if (!last) {
            const float* ng = P.norm_mix_g + (layer + 1) * 1024 + d0; const float* mb = MOD + (size_t)((layer + 1) * 8 + b) * 6144 + d0;
            unsigned w[8];
#pragma unroll
            for (int q = 0; q < 4; ++q) { *(f32x4*)(xp + 4 * q) = (f32x4){xn[4 * q], xn[4 * q + 1], xn[4 * q + 2], xn[4 * q + 3]}; }
#pragma unroll
            for (int e = 0; e < 8; ++e) w[e] = pk2(xn[2 * e] * rstd * ng[2 * e] * (1.0f + mb[1024 + 2 * e]) + mb[2 * e], xn[2 * e + 1] * rstd * ng[2 * e + 1] * (1.0f + mb[1024 + 2 * e + 1]) + mb[2 * e + 1]);
            v4u* hp = (v4u*)(H + (size_t)tok * 1024 + d0); hp[0] = (v4u){w[0], w[1], w[2], w[3]}; hp[1] = (v4u){w[4], w[5], w[6], w[7]};
        } else {
            const float* fg = P.final_norm_g + d0;
#pragma unroll
            for (int q = 0; q < 4; ++q) *(f32x4*)(xp + 4 * q) = (f32x4){xn[4 * q] * rstd * fg[4 * q], xn[4 * q + 1] * rstd * fg[4 * q + 1], xn[4 * q + 2] * rstd * fg[4 * q + 2], xn[4 * q + 3] * rstd * fg[4 * q + 3]};
        }
    }
}
#ifndef NAIVE_TOPK
#define NAIVE_TOPK 0
#endif
#ifndef NAIVE_EXPERTS
#define NAIVE_EXPERTS 0
#endif
__device__ __forceinline__ void phase_peer_topk_naive(const Params& P, const Ctx& C, int layer) {
    LAS float* SC = (LAS float*)C.lds;
    const float* sk = P.peer_sub_keys + (size_t)layer * 32768; const bf16* QP = (const bf16*)(P.ws + WS_QP);
    int* IDX = (int*)(P.ws + WS_IDX); float* GATE = (float*)(P.ws + WS_GATE);
    for (int base = C.vcu * 64; base < T * 8; base += C.G * 64) {
        __syncthreads();
        { const int tl = C.tid & 63, part = C.tid >> 6; const size_t task = (size_t)base + tl;
          for (int col = part * 32; col < part * 32 + 32; ++col) { const int half = col >> 7, n = col & 127; float acc = 0.f;
              for (int c = 0; c < 128; ++c) acc += bf2f(QP[task * 256 + half * 128 + c]) * sk[(half * 128 + n) * 128 + c];
              SC[tl * 257 + col] = acc; } }
        __syncthreads();
        if (C.tid < 64) { const int tl = C.tid; const size_t task = (size_t)base + tl; LAS float* s = SC + tl * 257;
            float v1[16], v2[16]; int i1[16], i2[16];
            for (int k = 0; k < 16; ++k) { float best = -3e38f; int bi = 0; for (int n = 0; n < 128; ++n) { const float x = s[n]; if (x > best) { best = x; bi = n; } } v1[k] = best; i1[k] = bi; s[bi] = -3.1e38f; }
            for (int k = 0; k < 16; ++k) { float best = -3e38f; int bi = 0; for (int n = 0; n < 128; ++n) { const float x = s[128 + n]; if (x > best) { best = x; bi = n; } } v2[k] = best; i2[k] = bi; s[128 + bi] = -3.1e38f; }
            for (int a = 0; a < 16; ++a) for (int b2 = 0; b2 < 16; ++b2) s[a * 16 + b2] = v1[a] + v2[b2];
            float ts[16]; int ti[16];
            for (int k = 0; k < 16; ++k) { float best = -3e38f; int bi = 0; for (int n = 0; n < 256; ++n) { const float x = s[n]; if (x > best) { best = x; bi = n; } } ts[k] = best; ti[k] = bi; s[bi] = -3.1e38f; }
            float den = 0.f; float ev[16];
            for (int k = 0; k < 16; ++k) { ev[k] = expf(ts[k] - ts[0]); den += ev[k]; }
            for (int k = 0; k < 16; ++k) { int a = ti[k] >> 4, b2 = ti[k] & 15; int e1 = 0, e2 = 0;
                for (int z = 0; z < 16; ++z) { if (z == a) e1 = i1[z]; if (z == b2) e2 = i2[z]; }
                IDX[task * 16 + k] = e1 * 128 + e2; GATE[task * 16 + k] = ev[k] / den; }
        }
    }
    __syncthreads();
}
__device__ __forceinline__ void phase_peer_experts_naive(const Params& P, const Ctx& C, int layer, bool last) {
    bf16* H = (bf16*)(P.ws + WS_H); const int* IDX = (const int*)(P.ws + WS_IDX); const float* GATE = (const float*)(P.ws + WS_GATE); const float* MOD = (const float*)(P.ws + WS_MOD);
    const float* TD = P.peer_down + (size_t)layer * 16384 * 1024; const float* TU = P.peer_up + (size_t)layer * 16384 * 1024;
    const int lane = C.lane; const int gw = C.vcu * NWAVES + C.wave, NGW = C.G * NWAVES;
    for (int tok = gw; tok < T; tok += NGW) {
        const int b = tok >> 13; float hv[16], oa[16];
#pragma unroll
        for (int j = 0; j < 16; ++j) { hv[j] = bf2f(H[(size_t)tok * 1024 + j * 64 + lane]); oa[j] = 0.f; }
        for (int k = 0; k < 128; ++k) { const int e = IDX[(size_t)tok * 128 + k]; const float gk = GATE[(size_t)tok * 128 + k];
            float p = 0.f;
#pragma unroll
            for (int j = 0; j < 16; ++j) p += hv[j] * TD[(size_t)e * 1024 + j * 64 + lane];
            const float a = wave_sum(p); const float wk = gk * gelu_f(a);
#pragma unroll
            for (int j = 0; j < 16; ++j) oa[j] += wk * TU[(size_t)e * 1024 + j * 64 + lane]; }
        const float* g2p = MOD + (size_t)(layer * 8 + b) * 6144 + 5120; const float psc = (ABL_ON >= (layer == 0 ? 2 : 4)) ? 1.f : 0.f;
        float xn[16]; float ss = 0.f;
#pragma unroll
        for (int j = 0; j < 16; ++j) { const int d = j * 64 + lane; xn[j] = P.out[(size_t)tok * 1024 + d] + psc * g2p[d] * oa[j]; ss += xn[j] * xn[j]; }
        const float rstd = 1.0f / sqrtf(wave_sum(ss) * (1.0f / 1024.0f) + NORM_EPS);
        if (!last) { const float* ng = P.norm_mix_g + (layer + 1) * 1024; const float* mb = MOD + (size_t)((layer + 1) * 8 + b) * 6144;
#pragma unroll
            for (int j = 0; j < 16; ++j) { const int d = j * 64 + lane; P.out[(size_t)tok * 1024 + d] = xn[j]; H[(size_t)tok * 1024 + d] = (bf16)f2bf(xn[j] * rstd * ng[d] * (1.0f + mb[1024 + d]) + mb[d]); }
        } else {
#pragma unroll
            for (int j = 0; j < 16; ++j) { const int d = j * 64 + lane; P.out[(size_t)tok * 1024 + d] = xn[j] * rstd * P.final_norm_g[d]; } }
    }
}
constexpr int N_PHASES = 18;
#ifndef MK_ONE_LAUNCH
#define MK_ONE_LAUNCH 1
#endif
__global__ void __launch_bounds__(NWAVES * 64, 2) hybrid_fwd(Params P) {
    extern __shared__ __attribute__((aligned(16))) unsigned char lds_raw[];
    Ctx C;
    C.lds = (LAS unsigned char*)lds_raw;
    C.tid = threadIdx.x; C.lane = C.tid & 63; C.wave = __builtin_amdgcn_readfirstlane(C.tid >> 6);
    C.G = gridDim.x; { const int bx = blockIdx.x; C.vcu = (C.G % 8 == 0) ? (bx % 8) * (C.G / 8) + bx / 8 : bx; }
    volatile LAS unsigned* MISC = (volatile LAS unsigned*)(C.lds + MISC_OFF);
    for (int u = C.tid; u < (LDS_BYTES - LDSCTL_OFF) / 4; u += NWAVES * 64) ((LAS unsigned*)(C.lds + LDSCTL_OFF))[u] = 0u;
    __syncthreads();
    unsigned* ctl = (unsigned*)(P.ws + WS_CTL);
    XcdBarrier bar; bar.bar = ctl + CW_BAR; bar.x = 0; bar.st = nullptr;
    const int lo = P.ph_lo, hi = P.ph_hi;
    if (hi - lo > 1) bar = xcd_barrier_post(ctl + CW_BAR, MISC + 8);
#ifndef PH_MASK
#define PH_MASK 0x3ffff
#endif
#define IN(k) (((PH_MASK >> (k)) & 1) && lo <= (k) && (k) < hi)
#define SEAM(k) do { if (IN(k) && IN((k) + 1)) xcd_barrier(bar); } while (0)
    unsigned char* ws = P.ws;
    float* MOD = (float*)(ws + WS_MOD); bf16* H = (bf16*)(ws + WS_H);

    if (IN(0)) { for (int rp = 0; rp < REP_PRO; ++rp) { phase_prologue(P, C); __syncthreads(); } } SEAM(0);
    if (IN(1)) { for (int rp = 0; rp < REP_NORM; ++rp) phase_norm(P, C, P.x, P.norm_mix_g, 0, 0); } SEAM(1);
    if (IN(2)) { pg8::Gemm g{H, (const bf16*)(ws + WS_WIN), T, 3072, 1024}; pg8::StaticOrder S; S.init(T, 3072, C.G, (int)blockIdx.x);
        EpiInProj E{(bf16*)(ws + WS_PU), (bf16*)(ws + WS_PV), (bf16*)(ws + WS_PQ), (bf16*)(ws + WS_PI), (bf16*)(ws + WS_PG), (float*)(ws + WS_G), (const float*)(ws + WS_LB)};
        pg8::gemm_phase<EpiInProj, pg8::StaticOrder, true, true>(C.lds, g, S, E); if (REP_GEMM2 > 1) { __syncthreads(); pg8::gemm_phase<EpiInProj, pg8::StaticOrder, true, true>(C.lds, g, S, E); } } SEAM(2);
    if (IN(3)) { for (int rp = 0; rp < REP_HG; ++rp) { for (int it = C.vcu; it < 2048; it += C.G) gmlp_item(P, C, it >> 2, it & 3);
                 for (int it = C.vcu; it < 4096; it += C.G) hgrn_local_item(P, C, it); } } SEAM(3);
    if (IN(4)) { for (int rp = 0; rp < REP_HG; ++rp) phase_hgrn_scan(P, C); } SEAM(4);
    if (IN(5)) { for (int rp = 0; rp < REP_HG; ++rp) for (int it = C.vcu; it < 4096; it += C.G) hgrn_out_item(P, C, it); } SEAM(5);
    if (IN(6)) { pg8::Gemm g{H, (const bf16*)(ws + WS_WOUT0), T, 1024, 1024}; pg8::StaticOrder S; S.init(T, 1024, C.G, (int)blockIdx.x);
        EpiResid E{P.x, P.out, MOD + 2048, ABL_ON >= 1 ? 1.f : 0.f};
        pg8::gemm_phase<EpiResid, pg8::StaticOrder, true, true>(C.lds, g, S, E); } SEAM(6);
    if (IN(7)) { for (int rp = 0; rp < REP_NORM; ++rp) phase_norm(P, C, P.out, P.norm_ffn_g, 0, 3072); } SEAM(7);
    if (IN(8)) { pg8::Gemm g{H, (const bf16*)(ws + WS_WQ0), T, 2048, 1024}; pg8::StaticOrder S; S.init(T, 2048, C.G, (int)blockIdx.x);
        EpiBf16P E{(bf16*)(ws + WS_QP), 2048};
        pg8::gemm_phase<EpiBf16P, pg8::StaticOrder, true, true>(C.lds, g, S, E); if (REP_GEMM > 1) { __syncthreads(); pg8::gemm_phase<EpiBf16P, pg8::StaticOrder, true, true>(C.lds, g, S, E); } } SEAM(8);
    if (IN(9)) { for (int rp = 0; rp < REP_TOPK; ++rp) { if (NAIVE_TOPK) phase_peer_topk_naive(P, C, 0); else phase_peer_topk(P, C, 0); __syncthreads(); } } SEAM(9);
    if (IN(10)) { if (NAIVE_EXPERTS) phase_peer_experts_naive(P, C, 0, false); else phase_peer_experts(P, C, 0, false); } SEAM(10);
    if (IN(11)) {
        { pg8::Gemm g{H, (const bf16*)(ws + WS_WQKV), T, 3072, 1024}; pg8::StaticOrder S; S.init(T, 3072, C.G, (int)blockIdx.x);
          EpiQKRot E{(bf16*)(ws + WS_QK), (const float*)(ws + WS_CS)};
          pg8::gemm_phase<EpiQKRot, pg8::StaticOrder, true, true>(C.lds, g, S, E); } } SEAM(11);
    if (IN(12)) { for (int rep = 0; rep < ATT_REP; ++rep) for (int it = C.vcu; it < NB * 16 * 32; it += C.G) attn_item(P, C, it >> 9, (it >> 5) & 15, it & 31); } SEAM(12);
    if (IN(13)) { pg8::Gemm g{H, (const bf16*)(ws + WS_WOUT1), T, 1024, 1024}; pg8::StaticOrder S; S.init(T, 1024, C.G, (int)blockIdx.x);
        EpiResid E{P.out, P.out, MOD + (size_t)8 * 6144 + 2048, ABL_ON >= 3 ? 1.f : 0.f};
        pg8::gemm_phase<EpiResid, pg8::StaticOrder, true, true>(C.lds, g, S, E); } SEAM(13);
    if (IN(14)) { for (int rp = 0; rp < REP_NORM; ++rp) phase_norm(P, C, P.out, P.norm_ffn_g + 1024, 1, 3072); } SEAM(14);
    if (IN(15)) { pg8::Gemm g{H, (const bf16*)(ws + WS_WQ1), T, 2048, 1024}; pg8::StaticOrder S; S.init(T, 2048, C.G, (int)blockIdx.x);
        EpiBf16P E{(bf16*)(ws + WS_QP), 2048};
        pg8::gemm_phase<EpiBf16P, pg8::StaticOrder, true, true>(C.lds, g, S, E); if (REP_GEMM > 1) { __syncthreads(); pg8::gemm_phase<EpiBf16P, pg8::StaticOrder, true, true>(C.lds, g, S, E); } } SEAM(15);
    if (IN(16)) { for (int rp = 0; rp < REP_TOPK; ++rp) { if (NAIVE_TOPK) phase_peer_topk_naive(P, C, 1); else phase_peer_topk(P, C, 1); __syncthreads(); } } SEAM(16);
    if (IN(17)) { if (NAIVE_EXPERTS) phase_peer_experts_naive(P, C, 1, true); else phase_peer_experts(P, C, 1, true); }
#undef IN
#undef SEAM
}

extern "C" void kernel_launch(void* const* d_in, const int* in_sizes, int n_in, void* d_out, int out_size, void* d_ws, size_t ws_size, hipStream_t stream) {
    static int grid = 0;
    if (grid == 0) {
        if (n_in != 22 || in_sizes[0] != T * DM || out_size != T * DM || ws_size < WS_END) {
            fprintf(stderr, "kernel_launch: unexpected shapes (n_in %d, in0 %d, out %d, ws %zu); nothing launched\n", n_in, n_in > 0 ? in_sizes[0] : -1, out_size, ws_size); grid = -1; return; }
        int dev = 0, cus = 0;
        if (hipGetDevice(&dev) != hipSuccess || hipDeviceGetAttribute(&cus, hipDeviceAttributeMultiprocessorCount, dev) != hipSuccess) { fprintf(stderr, "kernel_launch: device query failed\n"); grid = -1; return; }
        if (hipFuncSetAttribute((const void*)hybrid_fwd, hipFuncAttributeMaxDynamicSharedMemorySize, LDS_BYTES) != hipSuccess) { fprintf(stderr, "kernel_launch: hipFuncSetAttribute failed\n"); grid = -1; return; }
        (void)hipGetLastError();
        grid = cus;
    }
    if (grid < 0) return;
    if (hipMemsetAsync((char*)d_ws + WS_CTL, 0, CTL_ZERO_BYTES, stream) != hipSuccess) { fprintf(stderr, "kernel_launch: memset failed\n"); return; }
    Params p{};
    p.x = (const float*)d_in[0]; p.c = (const float*)d_in[1]; p.positions = (const int*)d_in[2]; p.ada_w = (const float*)d_in[3]; p.ada_b = (const float*)d_in[4];
    p.norm_mix_g = (const float*)d_in[5]; p.norm_ffn_g = (const float*)d_in[6]; p.final_norm_g = (const float*)d_in[7]; p.even_w_in = (const float*)d_in[8]; p.even_w_out = (const float*)d_in[9];
    p.gmlp_ln_g = (const float*)d_in[10]; p.gmlp_ln_b = (const float*)d_in[11]; p.gmlp_w_s = (const float*)d_in[12]; p.gmlp_b_s = (const float*)d_in[13]; p.hgrn_lb_logits = (const float*)d_in[14];
    p.hgrn_norm_g = (const float*)d_in[15]; p.odd_w_qkv = (const float*)d_in[16]; p.odd_w_out = (const float*)d_in[17]; p.peer_w_query = (const float*)d_in[18]; p.peer_sub_keys = (const float*)d_in[19];
    p.peer_down = (const float*)d_in[20]; p.peer_up = (const float*)d_in[21];
    p.out = (float*)d_out; p.ws = (unsigned char*)d_ws;
#if MK_ONE_LAUNCH
    p.ph_lo = 0; p.ph_hi = N_PHASES;
    hipLaunchKernelGGL(hybrid_fwd, dim3(grid), dim3(NWAVES * 64), LDS_BYTES, stream, p);
#else
    for (int ph = 0; ph < N_PHASES; ++ph) { p.ph_lo = ph; p.ph_hi = ph + 1; hipLaunchKernelGGL(hybrid_fwd, dim3(grid), dim3(NWAVES * 64), LDS_BYTES, stream, p); }
#endif
    const hipError_t le = hipPeekAtLastError();
    if (le != hipSuccess) fprintf(stderr, "kernel_launch: launch failed: %s\n", hipGetErrorName(le));
}
```

```cpp
#include <hip/hip_runtime.h>
#include <cstdio>
#include <cstdint>
#include <cmath>
namespace pg8 {
#define PG8_LAS __attribute__((address_space(3)))
typedef unsigned short bf16_t;
typedef short bf16x8 __attribute__((ext_vector_type(8)));
typedef float f32x4 __attribute__((ext_vector_type(4)));
typedef unsigned u32x4 __attribute__((ext_vector_type(4)));
constexpr int BM = 256, BK = 64, HALF = 128, HTB = HALF * BK * 2  , STAGE_BYTES = 8 * HTB, NXCD = 8, WGM = 8;

__host__ __device__ __forceinline__ int lds_byte(int r, int c) { const int st = (r >> 4) * 2 + (c >> 5), rr = r & 15, cc = c & 31, ob = rr * 64 + cc * 2; return st * 1024 + (ob ^ (((ob >> 9) & 1) << 5)); }
__host__ __device__ __forceinline__ void stage_rc(int b, int& R, int& C) { const int st = b / 1024, sb = b % 1024, swz = sb ^ (((sb >> 9) & 1) << 5); R = (st >> 1) * 16 + swz / 64; C = (st & 1) * 32 + (swz % 64) / 2; }
__host__ __device__ __forceinline__ int perm32(int rho) { const int n = rho >> 4, i = rho & 15; return 8 * (i >> 2) + 4 * n + (i & 3); }

struct Unit { int pm, pn; };
struct Gemm { const bf16_t* A; const bf16_t* Bt; int M, N, K; };

struct StaticOrder {
    int nM, nN, nwg, G, c;
    __host__ __device__ void init(int M, int N, int G_, int c_) { nM = M / BM; nN = N / BM; nwg = nM * nN; G = G_; c = c_; }
    __host__ __device__ bool next(int i, Unit& u) const {
        const long L = (long)i * G + c; if (L >= nwg) return false;
        int wgid = (int)L; { const int q = nwg / NXCD, r = nwg % NXCD, xcd = wgid % NXCD, off = wgid / NXCD; wgid = (xcd < r ? xcd * (q + 1) : r * (q + 1) + (xcd - r) * q) + off; }
        const int nig = WGM * nN, gid = wgid / nig, fm = gid * WGM, gsz = (nM - fm) < WGM ? (nM - fm) : WGM;
        u.pm = fm + ((wgid % nig) % gsz); u.pn = (wgid % nig) / gsz; return true;
    }
    __device__ __forceinline__ void a_ready(const Unit&) const {}
    __device__ __forceinline__ void done(const Unit&) const {}
};

__device__ __forceinline__ unsigned cvt_pk_bf16(float lo, float hi) { unsigned r; asm volatile("v_cvt_pk_bf16_f32 %0, %1, %2" : "=v"(r) : "v"(lo), "v"(hi)); return r; }
typedef float f32x2 __attribute__((ext_vector_type(2)));
__device__ __forceinline__ f32x2 gelu_pk(f32x2 v) {
    const f32x2 av = __builtin_elementwise_abs(v), d = av * 0.2316418882f + 1.0f;
    f32x2 t; t.x = __builtin_amdgcn_rcpf(d.x); t.y = __builtin_amdgcn_rcpf(d.y);
    f32x2 q = t * 0.5307027145f + (-0.7265760135f); q = q * t + 0.7107068705f; q = q * t + (-0.142248368f); q = q * t + 0.127414796f; q = q * t;
    const f32x2 s = (v * v) * (-0.72134752044f);
    f32x2 e; e.x = __builtin_amdgcn_exp2f(s.x); e.y = __builtin_amdgcn_exp2f(s.y);
    const f32x2 m = v * (q * e), r = v - m;
    f32x2 o; o.x = v.x < 0.f ? m.x : r.x; o.y = v.y < 0.f ? m.y : r.y; return o;
}

template <class Epi, class Sched, bool ALIGN_EPI = false, bool SP2 = false>
__device__ __forceinline__ void gemm_phase(PG8_LAS unsigned char* lds, const Gemm g, const Sched& S, const Epi& E) {
    int tid_ = threadIdx.x; asm volatile("" : "+v"(tid_));
    const int tid = tid_, wid = __builtin_amdgcn_readfirstlane(tid >> 6), lane = tid & 63, wr = wid >> 2, wc = wid & 3, fr = lane & 15, fq = lane >> 4;
    const int K = g.K, nt = K / BK;
    unsigned voffA[2], voffB[2];
#pragma unroll
    for (int i = 0; i < 2; ++i) { int R, C; stage_rc(tid * 16 + i * 8192, R, C); const int Rb = Epi::PERM ? ((R & ~31) + perm32(R & 31)) : R;
        voffA[i] = (unsigned)(R * K + C) * 2u; voffB[i] = (unsigned)(Rb * K + C) * 2u; }
    const size_t kstep = (size_t)(BK * 2);
    const size_t hstep = (size_t)HALF * K * 2;
    const size_t tstep = 2 * hstep;
    const unsigned ldsw = (unsigned)wid * 1024u;
    const int aoff = lds_byte(wr * 64 + fr, fq * 8), boff = lds_byte(wc * 32 + fr, fq * 8);
#define PG8_SA(b, h) (((b) * 2 + (h)) * HTB)
#define PG8_SB(b, h) ((4 + (b) * 2 + (h)) * HTB)
#define PG8_STAGE(bufoff, gbase, voff) do { _Pragma("unroll") for (int _i = 0; _i < 2; ++_i) \
        __builtin_amdgcn_global_load_lds((const unsigned*)((const char*)(gbase) + (voff)[_i]), (PG8_LAS unsigned*)(lds + (bufoff) + ldsw + _i * 8192), 16, 0, 0); } while (0)
#define PG8_LDA(dst, b, h) do { _Pragma("unroll") for (int m = 0; m < 4; ++m) _Pragma("unroll") for (int k = 0; k < 2; ++k) dst[m][k] = *(const PG8_LAS bf16x8*)(lds + PG8_SA(b, h) + aoff + m * 2048 + k * 1024); } while (0)
#define PG8_LDB(dst, b, h) do { _Pragma("unroll") for (int n = 0; n < 2; ++n) _Pragma("unroll") for (int k = 0; k < 2; ++k) dst[n][k] = *(const PG8_LAS bf16x8*)(lds + PG8_SB(b, h) + boff + n * 2048 + k * 1024); } while (0)
#define PG8_MMA(ai, bj, At, Bt) do { __builtin_amdgcn_s_setprio(1); _Pragma("unroll") for (int m = 0; m < 4; ++m) _Pragma("unroll") for (int n = 0; n < 2; ++n) _Pragma("unroll") for (int k = 0; k < 2; ++k) \
        acc[ai][bj][m][n] = __builtin_amdgcn_mfma_f32_16x16x32_bf16(Bt[n][k], At[m][k], acc[ai][bj][m][n], 0, 0, 0); __builtin_amdgcn_s_setprio(0); } while (0)
#define PG8_WAIT_V(n) asm volatile("s_waitcnt vmcnt(" #n ")" ::: "memory")
#define PG8_WAIT_L(n) asm volatile("s_waitcnt lgkmcnt(" #n ")" ::: "memory")
#define PG8_BAR __builtin_amdgcn_s_barrier()
#define PG8_SCHED __builtin_amdgcn_sched_barrier(0)
    Unit cur, nxt; int ui = 0;
    if (!S.next(0, cur)) return;
    f32x4 acc[2][2][4][2];
#pragma unroll
    for (int a = 0; a < 2; ++a)
#pragma unroll
        for (int b = 0; b < 2; ++b)
#pragma unroll
            for (int m = 0; m < 4; ++m)
#pragma unroll
                for (int n = 0; n < 2; ++n) acc[a][b][m][n] = (f32x4){0.f, 0.f, 0.f, 0.f};
    bf16x8 At[4][2], B0[2][2], B1[2][2];
    const char* cA = (const char*)g.A + (size_t)cur.pm * tstep; const char* cB = (const char*)g.Bt + (size_t)cur.pn * tstep;
    S.a_ready(cur);
    if constexpr (SP2) {
        PG8_STAGE(PG8_SB(0, 0), cB, voffB); PG8_STAGE(PG8_SB(0, 1), cB + hstep, voffB); PG8_STAGE(PG8_SA(0, 0), cA, voffA); PG8_STAGE(PG8_SA(0, 1), cA + hstep, voffA);
        if (wr == 1) PG8_BAR;
        PG8_WAIT_V(2); PG8_BAR;
        PG8_STAGE(PG8_SB(1, 0), cB + kstep, voffB); PG8_STAGE(PG8_SA(1, 0), cA + kstep, voffA); PG8_STAGE(PG8_SB(1, 1), cB + hstep + kstep, voffB);
        PG8_WAIT_V(6); PG8_BAR;
    } else {
        PG8_STAGE(PG8_SB(0, 0), cB, voffB); PG8_STAGE(PG8_SA(0, 0), cA, voffA); PG8_STAGE(PG8_SB(0, 1), cB + hstep, voffB); PG8_STAGE(PG8_SA(0, 1), cA + hstep, voffA);
        if (wr == 1) PG8_BAR;
        PG8_WAIT_V(4); PG8_BAR;
        PG8_STAGE(PG8_SB(1, 0), cB + kstep, voffB); PG8_STAGE(PG8_SA(1, 0), cA + kstep, voffA); PG8_STAGE(PG8_SB(1, 1), cB + hstep + kstep, voffB);
        PG8_WAIT_V(6); PG8_BAR;
    }
    for (;;) {
        const bool has_next = S.next(ui + 1, nxt);
        const char* nA = has_next ? (const char*)g.A + (size_t)nxt.pm * tstep : cA; const char* nB = has_next ? (const char*)g.Bt + (size_t)nxt.pn * tstep : cB;
        for (int t = 0; t < nt; t += 2) {
            const bool last = (t == nt - 2);
            const char* a1 = cA + (size_t)(t + 1) * kstep;
            const char* a2 = last ? nA : cA + (size_t)(t + 2) * kstep; const char* b2 = last ? nB : cB + (size_t)(t + 2) * kstep;
            const char* a3 = a2 + kstep; const char* b3 = b2 + kstep;
            if (last && has_next) S.a_ready(nxt);
            if constexpr (SP2) {
            PG8_LDB(B0, 0, 0); PG8_LDB(B1, 0, 1); PG8_SCHED; PG8_LDA(At, 0, 0); PG8_STAGE(PG8_SA(1, 1), a1 + hstep, voffA);
            PG8_WAIT_V(8); PG8_WAIT_L(0); PG8_BAR; PG8_MMA(0, 0, At, B0); PG8_MMA(0, 1, At, B1); PG8_BAR; PG8_SCHED;
            PG8_LDA(At, 0, 1); PG8_STAGE(PG8_SB(0, 0), b2, voffB); PG8_STAGE(PG8_SB(0, 1), b2 + hstep, voffB); PG8_STAGE(PG8_SA(0, 0), a2, voffA);
            PG8_WAIT_V(8); PG8_WAIT_L(0); PG8_BAR; PG8_MMA(1, 0, At, B0); PG8_MMA(1, 1, At, B1); PG8_BAR; PG8_SCHED;
            PG8_LDB(B0, 1, 0); PG8_LDB(B1, 1, 1); PG8_SCHED; PG8_LDA(At, 1, 0); PG8_STAGE(PG8_SA(0, 1), a2 + hstep, voffA);
            PG8_WAIT_V(8); PG8_WAIT_L(0); PG8_BAR; PG8_MMA(0, 0, At, B0); PG8_MMA(0, 1, At, B1); PG8_BAR; PG8_SCHED;
            PG8_LDA(At, 1, 1); PG8_STAGE(PG8_SB(1, 0), b3, voffB); PG8_STAGE(PG8_SB(1, 1), b3 + hstep, voffB); PG8_STAGE(PG8_SA(1, 0), a3, voffA);
            PG8_WAIT_V(8); PG8_WAIT_L(0); PG8_BAR; PG8_MMA(1, 0, At, B0); PG8_MMA(1, 1, At, B1); PG8_BAR; PG8_SCHED;
            } else {
            PG8_LDB(B0, 0, 0); PG8_SCHED; PG8_LDA(At, 0, 0); PG8_STAGE(PG8_SA(1, 1), a1 + hstep, voffA);
            PG8_WAIT_L(8); PG8_BAR; PG8_WAIT_L(0); PG8_MMA(0, 0, At, B0); PG8_BAR; PG8_SCHED;
            PG8_LDB(B1, 0, 1); PG8_STAGE(PG8_SB(0, 0), b2, voffB);
            PG8_BAR; PG8_WAIT_L(0); PG8_MMA(0, 1, At, B1); PG8_BAR;
            PG8_LDA(At, 0, 1); PG8_STAGE(PG8_SA(0, 0), a2, voffA);
            PG8_BAR; PG8_WAIT_L(0); PG8_MMA(1, 0, At, B0); PG8_BAR; PG8_SCHED;
            PG8_STAGE(PG8_SB(0, 1), b2 + hstep, voffB);
            PG8_WAIT_V(6); PG8_BAR; PG8_MMA(1, 1, At, B1); PG8_BAR;
            PG8_LDB(B0, 1, 0); PG8_SCHED; PG8_LDA(At, 1, 0); PG8_STAGE(PG8_SA(0, 1), a2 + hstep, voffA);
            PG8_WAIT_L(8); PG8_BAR; PG8_WAIT_L(0); PG8_MMA(0, 0, At, B0); PG8_BAR; PG8_SCHED;
            PG8_LDB(B1, 1, 1); PG8_STAGE(PG8_SB(1, 0), b3, voffB);
            PG8_BAR; PG8_WAIT_L(0); PG8_MMA(0, 1, At, B1); PG8_BAR;
            PG8_LDA(At, 1, 1); PG8_STAGE(PG8_SA(1, 0), a3, voffA);
            PG8_BAR; PG8_WAIT_L(0); PG8_MMA(1, 0, At, B0); PG8_BAR; PG8_SCHED;
            PG8_STAGE(PG8_SB(1, 1), b3 + hstep, voffB);
            PG8_WAIT_V(6); PG8_BAR; PG8_MMA(1, 1, At, B1); PG8_BAR;
            }
        }
        if constexpr (ALIGN_EPI) { if (wr == 0) PG8_BAR; }
        if constexpr (!Epi::AFTER_DRAIN) { E(acc, cur, wr, wc, fr, fq); S.done(cur); }
        if (!has_next) break;
#pragma unroll
        for (int a = 0; a < 2; ++a)
#pragma unroll
            for (int b = 0; b < 2; ++b)
#pragma unroll
                for (int m = 0; m < 4; ++m)
#pragma unroll
                    for (int n = 0; n < 2; ++n) acc[a][b][m][n] = (f32x4){0.f, 0.f, 0.f, 0.f};
        cur = nxt; cA = nA; cB = nB; ++ui;
        if constexpr (ALIGN_EPI) { if (wr == 1) PG8_BAR; }
    }
    PG8_WAIT_V(0);
    if constexpr (!ALIGN_EPI) { if (wr == 0) PG8_BAR; }
    PG8_BAR;
    if constexpr (Epi::AFTER_DRAIN) { E.fused(acc, cur, wr, wc, fr, fq, lds, wid, lane); S.done(cur); }
#undef PG8_SA
#undef PG8_SB
#undef PG8_STAGE
#undef PG8_LDA
#undef PG8_LDB
#undef PG8_MMA
#undef PG8_WAIT_V
#undef PG8_WAIT_L
#undef PG8_BAR
#undef PG8_SCHED
}
}
#define GAS __attribute__((address_space(1)))
#define LAS __attribute__((address_space(3)))
typedef unsigned short bf16;
typedef unsigned v4u __attribute__((ext_vector_type(4)));
typedef float f32x4 __attribute__((ext_vector_type(4)));
typedef short bf16x8 __attribute__((ext_vector_type(8)));
typedef __bf16 bf16x2_t __attribute__((ext_vector_type(2)));
#define LDS_WAIT() asm volatile("s_waitcnt lgkmcnt(0)" ::: "memory")
#define VM_WAIT() asm volatile("s_waitcnt vmcnt(0)" ::: "memory")
__device__ __forceinline__ unsigned f2bf(float f) { unsigned u = __builtin_bit_cast(unsigned, f); return (u + 0x7fffu + ((u >> 16) & 1u)) >> 16; }
__device__ __forceinline__ unsigned pk2(float lo, float hi) { return f2bf(lo) | (f2bf(hi) << 16); }
__device__ __forceinline__ float bflo(unsigned u) { return __builtin_bit_cast(float, u << 16); }
__device__ __forceinline__ float bfhi(unsigned u) { return __builtin_bit_cast(float, u & 0xffff0000u); }
__device__ __forceinline__ float bf2f(bf16 u) { return __builtin_bit_cast(float, (unsigned)u << 16); }
#define XB_TMO      128
#define XB_XCNT(j)  (256  + 64 * (j))
#define XB_XSUB(j)  (1280 + 64 * (j))
#define XB_XGEN(j)  (2304 + 64 * (j))
#define XB_TOP      3328
#define XB_TOPGEN   3392
#define XCD_BAR_WORDS 3456
#define XB_SPIN_CAP (1u << 18)

__device__ __forceinline__ unsigned xb_ld(unsigned* p)              { return __hip_atomic_load(p, __ATOMIC_RELAXED, __HIP_MEMORY_SCOPE_AGENT); }
__device__ __forceinline__ unsigned xb_add(unsigned* p, unsigned v) { return __hip_atomic_fetch_add(p, v, __ATOMIC_RELAXED, __HIP_MEMORY_SCOPE_AGENT); }
__device__ __forceinline__ unsigned xb_xcc_id() { return (unsigned)__builtin_amdgcn_s_getreg((3 << 11) | 20) & 0xFu; }
#define XB_SPIN(cond, bar) do { unsigned _sp = 0; while (cond) { __builtin_amdgcn_s_sleep(1); \
    if ((++_sp & 255u) == 0u) { if (xb_ld(&(bar)[XB_TMO])) break; if (_sp > XB_SPIN_CAP) { atomicAdd(&(bar)[XB_TMO], 1u); break; } } } } while (0)

struct XcdBarrier {
    unsigned* bar; unsigned x; unsigned G;
    volatile LAS unsigned* st;
};

__device__ __forceinline__ XcdBarrier xcd_barrier_post(unsigned* bar, volatile LAS unsigned* st) {
    XcdBarrier b; b.bar = bar; b.x = xb_xcc_id(); b.st = st; b.G = gridDim.x;
    if (threadIdx.x == 0) (void)xb_add(&bar[XB_XCNT(b.x)], 1u);
    return b;
}
__device__ __forceinline__ void xcd_barrier_complete(unsigned* bar, unsigned x, unsigned& nloc, unsigned& nx, const unsigned G) {
    unsigned sum, cnt, mine, sp = 0u;
    for (;;) {
        sum = 0u; cnt = 0u; mine = 0u;
#pragma unroll
        for (unsigned j = 0; j < 16; ++j) { const unsigned c = xb_ld(&bar[XB_XCNT(j)]); sum += c; cnt += (c > 0u) ? 1u : 0u; mine = (j == x) ? c : mine; }
        if (sum == G) break;
        __builtin_amdgcn_s_sleep(1);
        if ((++sp & 255u) == 0u) { if (xb_ld(&bar[XB_TMO])) break; if (sp > XB_SPIN_CAP) { atomicAdd(&bar[XB_TMO], 1u); break; } }
    }
    nloc = mine > 0u ? mine : 1u; nx = cnt > 0u ? cnt : 1u;
}

__device__ __forceinline__ void xcd_barrier(const XcdBarrier& b) {
    asm volatile("s_waitcnt vmcnt(0)" ::: "memory");
    __syncthreads();
    if (threadIdx.x == 0) {
        unsigned* bar = b.bar;
        __builtin_amdgcn_s_waitcnt(0);
        unsigned nloc = b.st[0], nx = b.st[1];
        if (nloc == 0u) { xcd_barrier_complete(bar, b.x, nloc, nx, b.G); b.st[0] = nloc; b.st[1] = nx; }
        const unsigned old = xb_add(&bar[XB_XSUB(b.x)], 1u);
        const unsigned gen = old / nloc;
        if (old + 1u == (gen + 1u) * nloc) {
            __builtin_amdgcn_fence(__ATOMIC_RELEASE, "agent");
            asm volatile("s_waitcnt vmcnt(0)" ::: "memory");
            const unsigned og = xb_add(&bar[XB_TOP], 1u);
            const unsigned tg = og / nx;
            if (og + 1u == (tg + 1u) * nx) xb_add(&bar[XB_TOPGEN], 1u);
            else XB_SPIN(xb_ld(&bar[XB_TOPGEN]) == tg, bar);
            __builtin_amdgcn_fence(__ATOMIC_ACQUIRE, "agent");
            xb_add(&bar[XB_XGEN(b.x)], 1u);
            asm volatile("s_waitcnt vmcnt(0)" ::: "memory");
        } else {
            XB_SPIN(xb_ld(&bar[XB_XGEN(b.x)]) == gen, bar);
            __builtin_amdgcn_fence(__ATOMIC_ACQUIRE, "agent");
            asm volatile("s_waitcnt vmcnt(0)" ::: "memory");
        }
    }
    __syncthreads();
}

constexpr int NB = 8, SEQ = 8192, DM = 1024, T = NB * SEQ;
constexpr int NWAVES = 8;
constexpr float NORM_EPS = 1e-6f;
constexpr float C2 = 0.125f * 1.4426950408889634f;

constexpr size_t MiB = 1u << 20;
constexpr size_t WS_CTL = 0, CTL_ZERO_BYTES = 1 * MiB;
constexpr size_t WS_MOD = 1 * MiB;
constexpr size_t WS_SKB = 1 * MiB + 512 * 1024;
constexpr size_t WS_WSB = 1 * MiB + 768 * 1024;
constexpr size_t WS_LB  = 1 * MiB + 960 * 1024;
constexpr size_t WS_CS  = 2 * MiB;
constexpr size_t WS_HD  = 6 * MiB;
constexpr size_t WS_WIN = 16 * MiB, WS_WOUT0 = 22 * MiB, WS_WQKV = 24 * MiB, WS_WOUT1 = 30 * MiB, WS_WQ0 = 32 * MiB, WS_WQ1 = 36 * MiB;
constexpr size_t WS_TAB8 = 40 * MiB, TAB8_BYTES = 16 * MiB;
constexpr int TROW = 1024;
constexpr size_t WS_SC8 = 8 * MiB;
constexpr size_t WS_H = 108 * MiB;
constexpr size_t WS_IDX = 236 * MiB, WS_GATE = 268 * MiB;
constexpr size_t WS_AR0 = 300 * MiB, AR_BYTES = 352 * MiB;
constexpr size_t AR_PU = 0, AR_PV = 32 * MiB, AR_PQ = 64 * MiB, AR_PI = 96 * MiB, AR_PG = 128 * MiB;
constexpr size_t AR_G = 160 * MiB;
constexpr size_t AR_KVT = 224 * MiB, AR_ST = 288 * MiB;
constexpr size_t AR_QP = 0;
constexpr size_t AR_QK = 0;
constexpr size_t WS_END = WS_AR0 + 2 * AR_BYTES;
constexpr int HT = T / 2;
constexpr int CW_BAR = 4096;

constexpr int LDS_BYTES = 147456;
constexpr int LDSCTL_OFF = LDS_BYTES - 512;
constexpr int MISC_OFF = LDSCTL_OFF;

struct Params {
    const float* x; const float* c; const int* positions; const float* ada_w; const float* ada_b; const float* norm_mix_g; const float* norm_ffn_g; const float* final_norm_g;
    const float* even_w_in; const float* even_w_out; const float* gmlp_ln_g; const float* gmlp_ln_b; const float* gmlp_w_s; const float* gmlp_b_s; const float* hgrn_lb_logits; const float* hgrn_norm_g;
    const float* odd_w_qkv; const float* odd_w_out; const float* peer_w_query; const float* peer_sub_keys; const float* peer_down; const float* peer_up;
    float* out; unsigned char* ws; int ph_lo, ph_hi;
};
struct Ctx { LAS unsigned char* lds; int tid, lane, wave, vcu, G; };
__device__ __forceinline__ Ctx fresh_ctx(const Ctx& C0) { Ctx C = C0; int t_ = threadIdx.x; asm volatile("" : "+v"(t_)); C.tid = t_; C.lane = t_ & 63; C.wave = __builtin_amdgcn_readfirstlane(t_ >> 6); return C; }
struct Wk { int lv, n, c, h; };
#define W_TK0(W) ((W).h * (T / 2))
#define W_BT0(W) ((W).h * (NB / 2))
__device__ __forceinline__ unsigned char* w_ar(const Params& P, const Wk& W) { return P.ws + WS_AR0 + (size_t)W.h * AR_BYTES; }
__device__ __forceinline__ bf16* w_tok16(const Params& P, const Wk& W, size_t off, int pitch) { return (bf16*)(w_ar(P, W) + off) - (size_t)W_TK0(W) * pitch; }
__device__ __forceinline__ float* w_tok32(const Params& P, const Wk& W, size_t off, int pitch) { return (float*)(w_ar(P, W) + off) - (size_t)W_TK0(W) * pitch; }
__device__ __forceinline__ bf16* w_item16(const Params& P, const Wk& W, size_t off) { return (bf16*)(w_ar(P, W) + off) - (size_t)W_BT0(W) * 512 * 16384; }

__device__ __forceinline__ float wave_sum(float v) {
#pragma unroll
    for (int o = 1; o < 64; o <<= 1) v += __shfl_xor(v, o);
    return v;
}
__device__ __forceinline__ float silu_f(float x) { return x * __builtin_amdgcn_rcpf(1.0f + __builtin_amdgcn_exp2f(-1.4426950408889634f * x)); }
__device__ __forceinline__ float sigmoid_f(float x) { return __builtin_amdgcn_rcpf(1.0f + __builtin_amdgcn_exp2f(-1.4426950408889634f * x)); }
__device__ __forceinline__ float gelu_f(float x) { return 0.5f * x * (1.0f + erff(x * 0.70710678118654752f)); }
__device__ __forceinline__ f32x4 mma16(f32x4 acc, const LAS bf16* A, int lda, const LAS bf16* Bt, int ldb, int K, int r, int q4) {
    const LAS bf16* ap = A + r * lda + 8 * q4; const LAS bf16* bp = Bt + r * ldb + 8 * q4;
    for (int k0 = 0; k0 < K; k0 += 32) {
        const bf16x8 a = *(const LAS bf16x8*)(ap + k0); const bf16x8 b = *(const LAS bf16x8*)(bp + k0);
        acc = __builtin_amdgcn_mfma_f32_16x16x32_bf16(a, b, acc, 0, 0, 0);
    }
    return acc;
}

struct EpiBf16P {
    static constexpr bool PERM = true, AFTER_DRAIN = false;
    bf16* O; size_t ldc;
    __device__ __forceinline__ void operator()(const f32x4 (&acc)[2][2][4][2], const pg8::Unit& u, int wr, int wc, int fr, int fq) const {
        const int row0 = u.pm * 256 + wr * 64 + fr, col0 = u.pn * 256 + wc * 32 + 8 * fq;
#pragma unroll
        for (int ai = 0; ai < 2; ++ai)
#pragma unroll
            for (int m = 0; m < 4; ++m) { bf16* rowp = O + (size_t)(row0 + ai * 128 + m * 16) * ldc + col0;
#pragma unroll
                for (int bj = 0; bj < 2; ++bj) { const f32x4 v0 = acc[ai][bj][m][0], v1 = acc[ai][bj][m][1];
                    v4u w; w.x = pg8::cvt_pk_bf16(v0[0], v0[1]); w.y = pg8::cvt_pk_bf16(v0[2], v0[3]); w.z = pg8::cvt_pk_bf16(v1[0], v1[1]); w.w = pg8::cvt_pk_bf16(v1[2], v1[3]);
                    *(v4u*)(rowp + bj * 128) = w; } }
    }
};
#ifndef REP_HG
#define REP_HG 1
#endif
#ifndef REP_TOPK
#define REP_TOPK 1
#endif
#ifndef REP_PRO
#define REP_PRO 1
#endif
#ifndef REP_NORM
#define REP_NORM 1
#endif
#ifndef REP_GEMM2
#define REP_GEMM2 1
#endif
#ifndef REP_GEMM
#define REP_GEMM 1
#endif
#ifndef EXP_REP
#define EXP_REP 1
#endif
#ifndef ATT_REP
#define ATT_REP 1
#endif
#ifndef ABL_ON
#define ABL_ON 4
#endif
struct EpiResid {
    static constexpr bool PERM = true, AFTER_DRAIN = false;
    const float* xin; float* xout; const float* gate; float gsc;
    __device__ __forceinline__ void operator()(const f32x4 (&acc)[2][2][4][2], const pg8::Unit& u, int wr, int wc, int fr, int fq) const {
        const int row0 = u.pm * 256 + wr * 64 + fr, col0 = u.pn * 256 + wc * 32 + 8 * fq;
        const float* gp = gate + (size_t)((u.pm * 256) >> 13) * 6144 + col0;
        f32x4 gv[2][2];
#pragma unroll
        for (int bj = 0; bj < 2; ++bj) { gv[bj][0] = *(const f32x4*)(gp + bj * 128); gv[bj][1] = *(const f32x4*)(gp + bj * 128 + 4); }
#pragma unroll
        for (int ai = 0; ai < 2; ++ai)
#pragma unroll
            for (int m = 0; m < 4; ++m) { const size_t off = (size_t)(row0 + ai * 128 + m * 16) * 1024 + col0;
#pragma unroll
                for (int bj = 0; bj < 2; ++bj) {
                    const f32x4 x0 = *(const f32x4*)(xin + off + bj * 128), x1 = *(const f32x4*)(xin + off + bj * 128 + 4);
                    *(f32x4*)(xout + off + bj * 128) = x0 + gv[bj][0] * acc[ai][bj][m][0] * gsc;
                    *(f32x4*)(xout + off + bj * 128 + 4) = x1 + gv[bj][1] * acc[ai][bj][m][1] * gsc; }
                asm volatile("" ::: "memory"); }
    }
};
struct EpiInProj {
    static constexpr bool PERM = true, AFTER_DRAIN = false;
    bf16* PU; bf16* PV; bf16* PQ; bf16* PI; bf16* PG; float* G; const float* LB;
    __device__ __forceinline__ void operator()(const f32x4 (&acc)[2][2][4][2], const pg8::Unit& u, int wr, int wc, int fr, int fq) const {
        const int type = u.pn >> 1;
        const int row0 = u.pm * 256 + wr * 64 + fr, lc0 = (u.pn & 1) * 256 + wc * 32 + 8 * fq;
        if (type == 3) {
            f32x4 lb[2][2];
#pragma unroll
            for (int bj = 0; bj < 2; ++bj) { lb[bj][0] = *(const f32x4*)(LB + lc0 + bj * 128); lb[bj][1] = *(const f32x4*)(LB + lc0 + bj * 128 + 4); }
#pragma unroll
            for (int ai = 0; ai < 2; ++ai)
#pragma unroll
                for (int m = 0; m < 4; ++m) { float* rowp = G + (size_t)(row0 + ai * 128 + m * 16) * 512 + lc0;
#pragma unroll
                    for (int bj = 0; bj < 2; ++bj)
#pragma unroll
                        for (int n = 0; n < 2; ++n) { const f32x4 v = acc[ai][bj][m][n]; f32x4 o;
#pragma unroll
                            for (int e = 0; e < 4; ++e) { const float l = lb[bj][n][e]; const float f = l + (1.0f - l) * sigmoid_f(v[e]); o[e] = __logf(f); }
                            *(f32x4*)(rowp + bj * 128 + 4 * n) = o; } }
            return;
        }
        bf16* base = type == 0 ? PU : type == 1 ? PV : type == 2 ? PQ : type == 4 ? PI : PG;
#pragma unroll
        for (int ai = 0; ai < 2; ++ai)
#pragma unroll
            for (int m = 0; m < 4; ++m) { bf16* rowp = base + (size_t)(row0 + ai * 128 + m * 16) * 512 + lc0;
#pragma unroll
                for (int bj = 0; bj < 2; ++bj) { f32x4 v0 = acc[ai][bj][m][0], v1 = acc[ai][bj][m][1];
                    if (type <= 1) { pg8::f32x2 a = pg8::gelu_pk((pg8::f32x2){v0[0], v0[1]}), b = pg8::gelu_pk((pg8::f32x2){v0[2], v0[3]}), c = pg8::gelu_pk((pg8::f32x2){v1[0], v1[1]}), d = pg8::gelu_pk((pg8::f32x2){v1[2], v1[3]});
                        v0 = (f32x4){a.x, a.y, b.x, b.y}; v1 = (f32x4){c.x, c.y, d.x, d.y}; }
                    else if (type == 2) {
#pragma unroll
                        for (int e = 0; e < 4; ++e) { v0[e] = silu_f(v0[e]) * 0.08838834764831845f; v1[e] = silu_f(v1[e]) * 0.08838834764831845f; } }
                    else if (type == 5) {
#pragma unroll
                        for (int e = 0; e < 4; ++e) { v0[e] = silu_f(v0[e]); v1[e] = silu_f(v1[e]); } }
                    v4u w; w.x = pg8::cvt_pk_bf16(v0[0], v0[1]); w.y = pg8::cvt_pk_bf16(v0[2], v0[3]); w.z = pg8::cvt_pk_bf16(v1[0], v1[1]); w.w = pg8::cvt_pk_bf16(v1[2], v1[3]);
                    *(v4u*)(rowp + bj * 128) = w; } }
    }
};
struct EpiQKRot {
    static constexpr bool PERM = true, AFTER_DRAIN = false;
    bf16* O; const float* CS;
    __device__ __forceinline__ void operator()(const f32x4 (&acc)[2][2][4][2], const pg8::Unit& u, int wr, int wc, int fr, int fq) const {
        const int row0 = u.pm * 256 + wr * 64 + fr, col0 = u.pn * 256 + wc * 32 + 8 * fq;
        const float sc = u.pn < 4 ? C2 : 1.0f;
        const bool rotw = (wc & 1) == 0 && u.pn < 8;
        const float sgn = fq == 0 ? -1.0f : 1.0f;
#pragma unroll
        for (int ai = 0; ai < 2; ++ai)
#pragma unroll
            for (int m = 0; m < 4; ++m) { const int row = row0 + ai * 128 + m * 16; bf16* rowp = O + (size_t)row * 3072 + col0;
                f32x4 c0 = (f32x4){1.f, 1.f, 1.f, 1.f}, c1 = c0, s0 = (f32x4){0.f, 0.f, 0.f, 0.f}, s1 = s0;
                if (rotw && fq < 2) { const float* cp = CS + (size_t)row * 16; c0 = *(const f32x4*)(cp); c1 = *(const f32x4*)(cp + 4); s0 = *(const f32x4*)(cp + 8) * sgn; s1 = *(const f32x4*)(cp + 12) * sgn; }
#pragma unroll
                for (int bj = 0; bj < 2; ++bj) { f32x4 v0 = acc[ai][bj][m][0], v1 = acc[ai][bj][m][1];
                    if (rotw) { f32x4 p0, p1;
#pragma unroll
                        for (int e = 0; e < 4; ++e) { p0[e] = __shfl_xor(v0[e], 16); p1[e] = __shfl_xor(v1[e], 16); }
                        v0 = v0 * c0 + p0 * s0; v1 = v1 * c1 + p1 * s1; }
                    v0 = v0 * sc; v1 = v1 * sc;
                    v4u w; w.x = pg8::cvt_pk_bf16(v0[0], v0[1]); w.y = pg8::cvt_pk_bf16(v0[2], v0[3]); w.z = pg8::cvt_pk_bf16(v1[0], v1[1]); w.w = pg8::cvt_pk_bf16(v1[2], v1[3]);
                    *(v4u*)(rowp + bj * 128) = w; } }
    }
};

__device__ __forceinline__ void p0_transpose_item(const float* W, int K, int N, bf16* WT, LAS float* scr, int item, int lane) {
    const int nblk = N / 32, kb = item / nblk, nb = item % nblk, k0 = 64 * kb, n0 = 32 * nb;
#pragma unroll 8
    for (int i = 0; i < 32; ++i) { const int kk = 2 * i + (lane >> 5); scr[kk * 33 + (lane & 31)] = W[(size_t)(k0 + kk) * N + n0 + (lane & 31)]; }
    LDS_WAIT(); asm volatile("" ::: "memory");
    const int c = lane & 7;
#pragma unroll
    for (int j = 0; j < 4; ++j) { const int n = (lane >> 3) + 8 * j; const LAS float* s = scr + (8 * c) * 33 + n;
        v4u o; o.x = pk2(s[0 * 33], s[1 * 33]); o.y = pk2(s[2 * 33], s[3 * 33]); o.z = pk2(s[4 * 33], s[5 * 33]); o.w = pk2(s[6 * 33], s[7 * 33]);
        *(GAS v4u*)(WT + (size_t)(n0 + n) * K + k0 + 8 * c) = o; }
    LDS_WAIT(); asm volatile("" ::: "memory");
}
typedef float f32x2 __attribute__((ext_vector_type(2)));
__device__ __forceinline__ void convert_tables(const Params& P, const Ctx& C) {
    const int gw = C.vcu * NWAVES + C.wave, NGW = C.G * NWAVES, lane = C.lane;
    for (int row = gw; row < 4 * 16384; row += NGW) {
        const int tb = row >> 14, e = row & 16383;
        const float* src = ((tb & 1) ? P.peer_up : P.peer_down) + ((size_t)(tb >> 1) * 16384 + e) * 1024;
        unsigned char* dst = P.ws + WS_TAB8 + (size_t)tb * TAB8_BYTES + (size_t)e * TROW;
        f32x4 v[4]; float mx = 0.f;
#pragma unroll
        for (int j = 0; j < 4; ++j) { v[j] = ((const f32x4*)src)[64 * j + lane]; mx = fmaxf(mx, fmaxf(fmaxf(fabsf(v[j][0]), fabsf(v[j][1])), fmaxf(fabsf(v[j][2]), fabsf(v[j][3])))); }
#pragma unroll
        for (int o = 1; o < 64; o <<= 1) mx = fmaxf(mx, __shfl_xor(mx, o));
        const float sc = mx > 0.f ? 400.0f / mx : 0.f;
#pragma unroll
        for (int j = 0; j < 4; ++j) { int p = __builtin_amdgcn_cvt_pk_fp8_f32(v[j][0] * sc, v[j][1] * sc, 0, false); p = __builtin_amdgcn_cvt_pk_fp8_f32(v[j][2] * sc, v[j][3] * sc, p, true);
            ((unsigned*)dst)[64 * j + lane] = (unsigned)p; }
        if (lane == 0) ((float*)(P.ws + WS_SC8))[row] = mx * (1.0f / 400.0f);
    }
}
__device__ __forceinline__ void phase_prologue(const Params& P, const Ctx& C) {
    float* MOD = (float*)(P.ws + WS_MOD);
    {
        LAS float* cond = (LAS float*)C.lds;
        LAS float* part = (LAS float*)(C.lds + 32768);
        for (int e = C.tid; e < 8192; e += 512) cond[e] = silu_f(P.c[e]);
        __syncthreads();
        for (int item = C.vcu; item < 192; item += C.G) {
            const int l = item / 96, cb = item % 96, col = cb * 64 + C.lane;
            float acc[8];
#pragma unroll
            for (int b = 0; b < 8; ++b) acc[b] = 0.f;
            const float* wp = P.ada_w + ((size_t)l * 1024 + C.wave * 128) * 6144 + col;
#pragma unroll 4
            for (int k = 0; k < 128; ++k) { const float wv = wp[(size_t)k * 6144];
#pragma unroll
                for (int b = 0; b < 8; ++b) acc[b] += cond[b * 1024 + C.wave * 128 + k] * wv; }
#pragma unroll
            for (int b = 0; b < 8; ++b) part[(C.wave * 8 + b) * 64 + C.lane] = acc[b];
            __syncthreads();
            { const int b = C.tid >> 6, ln = C.tid & 63; float s = P.ada_b[l * 6144 + cb * 64 + ln];
#pragma unroll
              for (int w = 0; w < 8; ++w) s += part[(w * 8 + b) * 64 + ln];
              MOD[(size_t)(l * 8 + b) * 6144 + cb * 64 + ln] = s; }
            __syncthreads();
        }
        __syncthreads();
    }
    {
        LAS float* scr = (LAS float*)(C.lds + C.wave * 16384);
        const int gw = C.vcu * NWAVES + C.wave, NGW = C.G * NWAVES;
        for (int it = gw; it < 6144; it += NGW) {
            int r = it;
            if (r < 1536) { p0_transpose_item(P.even_w_in, 1024, 3072, (bf16*)(P.ws + WS_WIN), scr, r, C.lane); continue; } r -= 1536;
            if (r < 512)  { p0_transpose_item(P.even_w_out, 1024, 1024, (bf16*)(P.ws + WS_WOUT0), scr, r, C.lane); continue; } r -= 512;
            if (r < 1536) { p0_transpose_item(P.odd_w_qkv, 1024, 3072, (bf16*)(P.ws + WS_WQKV), scr, r, C.lane); continue; } r -= 1536;
            if (r < 512)  { p0_transpose_item(P.odd_w_out, 1024, 1024, (bf16*)(P.ws + WS_WOUT1), scr, r, C.lane); continue; } r -= 512;
            if (r < 1024) { p0_transpose_item(P.peer_w_query, 1024, 2048, (bf16*)(P.ws + WS_WQ0), scr, r, C.lane); continue; } r -= 1024;
            p0_transpose_item(P.peer_w_query + (size_t)1024 * 2048, 1024, 2048, (bf16*)(P.ws + WS_WQ1), scr, r, C.lane);
        }
    }
    convert_tables(P, C);
    const int NT = C.G * 512, gt = C.vcu * 512 + C.tid;
    { bf16* skb = (bf16*)(P.ws + WS_SKB); for (int i = gt; i < 65536; i += NT) skb[i] = (bf16)f2bf(P.peer_sub_keys[i]); }
    { bf16* wsb = (bf16*)(P.ws + WS_WSB); for (int i = gt; i < 65536; i += NT) { const int t = (i >> 7) & 127, s = i & 127; wsb[i] = (bf16)(s <= t ? f2bf(P.gmlp_w_s[i]) : 0u); } }
    { float* lb = (float*)(P.ws + WS_LB); for (int i = gt; i < 512; i += NT) { const float l0 = P.hgrn_lb_logits[i], l1 = P.hgrn_lb_logits[512 + i]; lb[i] = 1.0f / (1.0f + expf(l1 - l0)); } }
    { float* cs = (float*)(P.ws + WS_CS); for (int i = gt; i < T * 8; i += NT) { const int tok = i >> 3, j = i & 7;
        const float inv = 1.0f / powf(500000.0f, (float)j * 0.125f); const float ang = (float)P.positions[tok] * inv; float sn, cn; sincosf(ang, &sn, &cn);
        cs[(size_t)tok * 16 + j] = cn; cs[(size_t)tok * 16 + 8 + j] = sn; } }
}
__device__ __forceinline__ void norm_row_bf16(const float* xrow, bf16* hrow, const float* g, const float* sh, const float* sc, int lane) {
    const f32x4* xr = (const f32x4*)xrow + lane; f32x4 v[4]; float s = 0.f;
#pragma unroll
    for (int j = 0; j < 4; ++j) { v[j] = xr[64 * j]; s += (v[j][0] * v[j][0] + v[j][1] * v[j][1]) + (v[j][2] * v[j][2] + v[j][3] * v[j][3]); }
    const float rstd = 1.0f / sqrtf(wave_sum(s) * (1.0f / 1024.0f) + NORM_EPS);
    unsigned long long* o8 = (unsigned long long*)hrow + lane;
#pragma unroll
    for (int j = 0; j < 4; ++j) { const f32x4 gg = ((const f32x4*)g)[64 * j + lane], hh = ((const f32x4*)sh)[64 * j + lane], cc = ((const f32x4*)sc)[64 * j + lane];
        const f32x4 y = (v[j] * rstd * gg) * (cc + 1.0f) + hh;
        o8[64 * j] = (unsigned long long)pk2(y[0], y[1]) | ((unsigned long long)pk2(y[2], y[3]) << 32); }
}
__device__ __forceinline__ void phase_norm(const Params& P, const Ctx& C, const Wk& W, const float* xsrc, const float* g, int l, int so) {
    const float* MOD = (const float*)(P.ws + WS_MOD); bf16* H = (bf16*)(P.ws + WS_H);
    const int gw = W.lv * NWAVES + C.wave, NGW = W.n * NWAVES;
    for (int m = W_TK0(W) + gw; m < W_TK0(W) + HT; m += NGW) { const float* mb = MOD + (size_t)(l * 8 + (m >> 13)) * 6144 + so;
        norm_row_bf16(xsrc + (size_t)m * 1024, H + (size_t)m * 1024, g, mb, mb + 1024, C.lane); }
}

__device__ __forceinline__ void gmlp_item(const Params& P, const Ctx& C, const Wk& W, int n, int g) {
    LAS bf16* Wt = (LAS bf16*)C.lds;
    LAS bf16* vT = (LAS bf16*)(C.lds + 34816);
    const bf16* WSB = (const bf16*)(P.ws + WS_WSB); const bf16* PU = w_tok16(P, W, AR_PU, 512); const bf16* PV = w_tok16(P, W, AR_PV, 512); bf16* MIX = (bf16*)(P.ws + WS_H);
    const int tid = C.tid, r = C.lane & 15, q4 = C.lane >> 4;
    for (int ch = tid; ch < 2048; ch += 512) { const int rr = ch >> 4, c8 = (ch & 15) * 8; *(LAS v4u*)(Wt + rr * 136 + c8) = *(const v4u*)(WSB + (size_t)(g * 128 + rr) * 128 + c8); }
    { const int t = tid >> 2, part = tid & 3; const bf16* src = PV + (size_t)(n * 128 + t) * 512 + g * 128 + part * 32;
      float x[32];
#pragma unroll
      for (int j = 0; j < 4; ++j) { const v4u w = *(const v4u*)(src + 8 * j);
#pragma unroll
          for (int e = 0; e < 4; ++e) { x[8 * j + 2 * e] = bflo(w[e]); x[8 * j + 2 * e + 1] = bfhi(w[e]); } }
      float s = 0.f;
#pragma unroll
      for (int j = 0; j < 32; ++j) s += x[j];
      s += __shfl_xor(s, 1); s += __shfl_xor(s, 2);
      const float mean = s * (1.0f / 128.0f); float q = 0.f;
#pragma unroll
      for (int j = 0; j < 32; ++j) { const float d = x[j] - mean; q += d * d; }
      q += __shfl_xor(q, 1); q += __shfl_xor(q, 2);
      const float rstd = 1.0f / sqrtf(q * (1.0f / 128.0f) + NORM_EPS);
      const float* lg = P.gmlp_ln_g + g * 128 + part * 32; const float* lbp = P.gmlp_ln_b + g * 128 + part * 32;
#pragma unroll
      for (int j = 0; j < 32; ++j) vT[(part * 32 + j) * 136 + t] = (bf16)f2bf((x[j] - mean) * rstd * lg[j] + lbp[j]);
    }
    __syncthreads();
    const int t0 = 16 * C.wave; const int Keff = ((t0 + 16 + 31) >> 5) << 5;
    f32x4 acc[8];
#pragma unroll
    for (int ct = 0; ct < 8; ++ct) { acc[ct] = (f32x4){0.f, 0.f, 0.f, 0.f}; acc[ct] = mma16(acc[ct], Wt + t0 * 136, 136, vT + (16 * ct) * 136, 136, Keff, r, q4); }
#pragma unroll
    for (int i = 0; i < 4; ++i) { const int t = t0 + 4 * q4 + i; const float bs = P.gmlp_b_s[g * 128 + t]; const size_t tok = (size_t)n * 128 + t;
#pragma unroll
        for (int ct = 0; ct < 8; ++ct) { const int c = 16 * ct + r; const float u = bf2f(PU[tok * 512 + g * 128 + c]); MIX[tok * 1024 + g * 128 + c] = (bf16)f2bf(u * (acc[ct][i] + bs)); } }
    __syncthreads();
}
__device__ __forceinline__ void hgrn_cumsum16(const float* G, size_t tok0, int hh, int k, int seg, LAS float* tot, float (&g)[16], float (&bb)[16], float& total) {
    const float* gp = G + (tok0 + seg * 16) * 512 + hh * 128 + k;
#pragma unroll
    for (int j = 0; j < 16; ++j) g[j] = gp[(size_t)j * 512];
    float run = 0.f;
#pragma unroll
    for (int j = 0; j < 16; ++j) { run += g[j]; bb[j] = run; }
    tot[seg * 128 + k] = run;
    __syncthreads();
    const float t0 = tot[k], t1 = tot[128 + k], t2 = tot[256 + k], t3 = tot[384 + k];
    const float pre = seg == 0 ? 0.f : seg == 1 ? t0 : seg == 2 ? t0 + t1 : t0 + t1 + t2;
    total = (t0 + t1) + (t2 + t3);
#pragma unroll
    for (int j = 0; j < 16; ++j) bb[j] += pre;
}
__device__ __forceinline__ void hgrn_stage_iT(const bf16* PI, size_t tok0, int hh, LAS bf16* iT, int tid) {
    const int s = tid >> 3, v0 = (tid & 7) * 16; const bf16* src = PI + (tok0 + s) * 512 + hh * 128 + v0;
#pragma unroll
    for (int h2 = 0; h2 < 2; ++h2) { const v4u w = *(const v4u*)(src + 8 * h2);
#pragma unroll
        for (int e = 0; e < 4; ++e) { iT[(v0 + 8 * h2 + 2 * e) * 72 + s] = (bf16)(w[e] & 0xffffu); iT[(v0 + 8 * h2 + 2 * e + 1) * 72 + s] = (bf16)(w[e] >> 16); } }
}
__device__ __forceinline__ void hgrn_local_item(const Params& P, const Ctx& C, const Wk& W, int item) {
    LAS bf16* khT = (LAS bf16*)C.lds;
    LAS bf16* iT = (LAS bf16*)(C.lds + 18432);
    LAS float* tot = (LAS float*)(C.lds + 36864);
    const float* G = w_tok32(P, W, AR_G, 512); const bf16* PI = w_tok16(P, W, AR_PI, 512); bf16* KVT = w_item16(P, W, AR_KVT); float* HD = (float*)(P.ws + WS_HD);
    const int bh = item >> 7, c = item & 127, b = bh >> 2, hh = bh & 3; const size_t tok0 = (size_t)b * SEQ + c * 64;
    const int tid = C.tid, k = tid & 127, seg = tid >> 7, r = C.lane & 15, q4 = C.lane >> 4;
    float g[16], bb[16], total;
    hgrn_cumsum16(G, tok0, hh, k, seg, tot, g, bb, total);
    { unsigned w[8];
#pragma unroll
      for (int j = 0; j < 8; ++j) { const float a0 = -expm1f(g[2 * j]) * __expf(total - bb[2 * j]), a1 = -expm1f(g[2 * j + 1]) * __expf(total - bb[2 * j + 1]); w[j] = pk2(a0, a1); }
      LAS v4u* dst = (LAS v4u*)(khT + k * 72 + seg * 16); dst[0] = (v4u){w[0], w[1], w[2], w[3]}; dst[1] = (v4u){w[4], w[5], w[6], w[7]}; }
    if (seg == 0) HD[(size_t)item * 128 + k] = __expf(total);
    hgrn_stage_iT(PI, tok0, hh, iT, tid);
    __syncthreads();
    const int v0 = 16 * C.wave;
#pragma unroll
    for (int ct = 0; ct < 8; ++ct) { f32x4 acc = (f32x4){0.f, 0.f, 0.f, 0.f}; acc = mma16(acc, iT + v0 * 72, 72, khT + (16 * ct) * 72, 72, 64, r, q4);
#pragma unroll
        for (int i = 0; i < 4; ++i) KVT[((size_t)item * 128 + v0 + 4 * q4 + i) * 128 + 16 * ct + r] = (bf16)f2bf(acc[i]); }
    __syncthreads();
}
__device__ __forceinline__ void phase_hgrn_scan(const Params& P, const Ctx& C, const Wk& W) {
    const bf16* KVT = w_item16(P, W, AR_KVT); bf16* ST = w_item16(P, W, AR_ST); const float* HD = (const float*)(P.ws + WS_HD);
    for (int task = W.lv * 256 + C.tid; C.tid < 256 && task < 32768; task += W.n * 256) {
        const int bh = W_BT0(W) * 4 + (task >> 11), v = (task >> 4) & 127, kb = task & 15;
        float st[8];
#pragma unroll
        for (int e = 0; e < 8; ++e) st[e] = 0.f;
#pragma unroll 4
        for (int c = 0; c < 128; ++c) { const size_t item = (size_t)bh * 128 + c, off = (item * 128 + v) * 128 + kb * 8;
            const v4u kv = *(const v4u*)(KVT + off); const f32x4 d0 = *(const f32x4*)(HD + item * 128 + kb * 8), d1 = *(const f32x4*)(HD + item * 128 + kb * 8 + 4);
            v4u o; o.x = pk2(st[0], st[1]); o.y = pk2(st[2], st[3]); o.z = pk2(st[4], st[5]); o.w = pk2(st[6], st[7]);
            *(v4u*)(ST + off) = o;
#pragma unroll
            for (int e = 0; e < 4; ++e) { st[2 * e] = (e < 2 ? d0[2 * e] : d1[2 * e - 4]) * st[2 * e] + bflo(kv[e]); st[2 * e + 1] = (e < 2 ? d0[2 * e + 1] : d1[2 * e - 3]) * st[2 * e + 1] + bfhi(kv[e]); }
        }
    }
}
__device__ __forceinline__ void hgrn_out_item(const Params& P, const Ctx& C, const Wk& W, int item) {
    LAS bf16* qt = (LAS bf16*)C.lds;
    LAS bf16* kt = (LAS bf16*)(C.lds + 17408);
    LAS bf16* iT = (LAS bf16*)(C.lds + 34816);
    LAS bf16* A1 = (LAS bf16*)(C.lds + 53248);
    LAS bf16* STl = (LAS bf16*)(C.lds + 62464);
    LAS float* ol = (LAS float*)(C.lds + 97280);
    LAS float* tot = (LAS float*)(C.lds + 131072);
    const float* G = w_tok32(P, W, AR_G, 512); const bf16* PQ = w_tok16(P, W, AR_PQ, 512); const bf16* PI = w_tok16(P, W, AR_PI, 512); const bf16* PG = w_tok16(P, W, AR_PG, 512);
    const bf16* ST = w_item16(P, W, AR_ST); bf16* MIX = (bf16*)(P.ws + WS_H);
    const int bh = item >> 7, c = item & 127, b = bh >> 2, hh = bh & 3; const size_t tok0 = (size_t)b * SEQ + c * 64;
    const int tid = C.tid, k = tid & 127, seg = tid >> 7, r = C.lane & 15, q4 = C.lane >> 4;
    float g[16], bb[16], total;
    hgrn_cumsum16(G, tok0, hh, k, seg, tot, g, bb, total);
#pragma unroll
    for (int j = 0; j < 16; ++j) { const int t = seg * 16 + j; const float qv = bf2f(PQ[(tok0 + t) * 512 + hh * 128 + k]);
        qt[t * 136 + k] = (bf16)f2bf(qv * __expf(bb[j])); kt[t * 136 + k] = (bf16)f2bf(-expm1f(g[j]) * __expf(-bb[j])); }
    hgrn_stage_iT(PI, tok0, hh, iT, tid);
    for (int ch = tid; ch < 2048; ch += 512) { const int rr = ch >> 4, c8 = (ch & 15) * 8; *(LAS v4u*)(STl + rr * 136 + c8) = *(const v4u*)(ST + ((size_t)item * 128 + rr) * 128 + c8); }
    __syncthreads();
    { const int rt = C.wave >> 1;
#pragma unroll
      for (int cc = 0; cc < 2; ++cc) { const int ct = (C.wave & 1) * 2 + cc; f32x4 acc = (f32x4){0.f, 0.f, 0.f, 0.f};
          acc = mma16(acc, qt + (16 * rt) * 136, 136, kt + (16 * ct) * 136, 136, 128, r, q4);
#pragma unroll
          for (int i = 0; i < 4; ++i) { const int t = 16 * rt + 4 * q4 + i, s = 16 * ct + r; A1[t * 72 + s] = (bf16)(s <= t ? f2bf(acc[i]) : 0u); } } }
    __syncthreads();
    { const int rt = C.wave >> 1;
#pragma unroll
      for (int cc = 0; cc < 4; ++cc) { const int ct = (C.wave & 1) * 4 + cc; f32x4 acc = (f32x4){0.f, 0.f, 0.f, 0.f};
          acc = mma16(acc, A1 + (16 * rt) * 72, 72, iT + (16 * ct) * 72, 72, 64, r, q4);
          acc = mma16(acc, qt + (16 * rt) * 136, 136, STl + (16 * ct) * 136, 136, 128, r, q4);
#pragma unroll
          for (int i = 0; i < 4; ++i) ol[(16 * rt + 4 * q4 + i) * 132 + 16 * ct + r] = acc[i]; } }
    __syncthreads();
    { const int t = tid >> 3, v0 = (tid & 7) * 16; float o[16]; float ss = 0.f;
#pragma unroll
      for (int e = 0; e < 16; ++e) { o[e] = ol[t * 132 + v0 + e]; ss += o[e] * o[e]; }
      ss += __shfl_xor(ss, 1); ss += __shfl_xor(ss, 2); ss += __shfl_xor(ss, 4);
      const float rstd = 1.0f / sqrtf(ss * (1.0f / 128.0f) + NORM_EPS);
      const float* ng = P.hgrn_norm_g + hh * 128 + v0; const bf16* gp = PG + (tok0 + t) * 512 + hh * 128 + v0;
      const v4u g0 = *(const v4u*)gp, g1 = *(const v4u*)(gp + 8); unsigned w[8];
#pragma unroll
      for (int e = 0; e < 4; ++e) { w[e] = pk2(o[2 * e] * rstd * ng[2 * e] * bflo(g0[e]), o[2 * e + 1] * rstd * ng[2 * e + 1] * bfhi(g0[e]));
                                    w[4 + e] = pk2(o[8 + 2 * e] * rstd * ng[8 + 2 * e] * bflo(g1[e]), o[9 + 2 * e] * rstd * ng[9 + 2 * e] * bfhi(g1[e])); }
      v4u* dst = (v4u*)(MIX + (tok0 + t) * 1024 + 512 + hh * 128 + v0); dst[0] = (v4u){w[0], w[1], w[2], w[3]}; dst[1] = (v4u){w[4], w[5], w[6], w[7]}; }
    __syncthreads();
}

typedef short v4i16_t __attribute__((ext_vector_type(4)));
constexpr int AT_ST = 68;
constexpr int AT_VP = 144;
__device__ __forceinline__ void attn_item(const Params& P, const Ctx& C, const Wk& W, int b, int hd, int qt) {
    LAS float* St = (LAS float*)C.lds;
    LAS unsigned char* Vw = C.lds + 256 * AT_ST * 4 + C.wave * (64 * AT_VP);
    const bf16* QKV = w_tok16(P, W, AR_QK, 3072); bf16* O = (bf16*)(P.ws + WS_H);
    const int lane = C.lane, r = lane & 15, q4 = lane >> 4;
    const int t0 = qt * 256; const size_t rowbase = (size_t)b * SEQ;
    const bf16* Kb = QKV + rowbase * 3072 + 1024 + hd * 64; const bf16* Vb = QKV + rowbase * 3072 + 2048 + hd * 64;
#pragma unroll 1
    for (int g = 0; g < 3; ++g) {
        const int dsh = 4 - 2 * g, d = 1 << dsh;
#pragma unroll 1
        for (int uu = 0; uu < 2; ++uu) {
            const int u = C.wave + 8 * uu;
            const int c = u & (d - 1), j = u >> dsh;
            const int mq0 = (t0 >> dsh) + 16 * j;
            const int qloc = c + d * (16 * j + r);
            const bf16* qp = QKV + (rowbase + t0 + qloc) * 3072 + hd * 64 + 8 * q4;
            const bf16x8 bq0 = *(const bf16x8*)qp, bq1 = *(const bf16x8*)(qp + 32);
            f32x4 sa[9]; bf16x8 ka[9][2];
#pragma unroll
            for (int t = 0; t < 9; ++t) { int mk = mq0 - 128 + 16 * t + r; mk = mk < 0 ? 0 : mk;
                const bf16* kp = Kb + (size_t)(c + d * mk) * 3072 + 8 * q4;
                ka[t][0] = *(const bf16x8*)kp; ka[t][1] = *(const bf16x8*)(kp + 32); }
            v4u vr[2][8];
#pragma unroll
            for (int ch = 0; ch < 2; ++ch)
#pragma unroll
                for (int it = 0; it < 8; ++it) { const int kap = 64 * ch + 8 * it + (lane >> 3); int mk = mq0 - 128 + kap; mk = mk < 0 ? 0 : mk;
                    vr[ch][it] = *(const v4u*)(Vb + (size_t)(c + d * mk) * 3072 + (lane & 7) * 8); }
            __builtin_amdgcn_sched_barrier(0);
#pragma unroll
            for (int t = 0; t < 9; ++t) { sa[t] = (f32x4){0.f, 0.f, 0.f, 0.f}; sa[t] = __builtin_amdgcn_mfma_f32_16x16x32_bf16(ka[t][0], bq0, sa[t], 0, 0, 0); sa[t] = __builtin_amdgcn_mfma_f32_16x16x32_bf16(ka[t][1], bq1, sa[t], 0, 0, 0); }
            v4u vr2[4];
#pragma unroll
            for (int it = 0; it < 4; ++it) { int kap = 128 + 8 * it + (lane >> 3); kap = kap > 143 ? 143 : kap; const int mk = mq0 - 128 + kap;
                vr2[it] = *(const v4u*)(Vb + (size_t)(c + d * mk) * 3072 + (lane & 7) * 8); }
            float mx = -1e30f;
#pragma unroll
            for (int t = 0; t < 9; ++t)
#pragma unroll
                for (int i = 0; i < 4; ++i) { const int kap = 16 * t + 4 * q4 + i; const bool ok = kap >= r && kap <= r + 128 && (mq0 - 128 + kap) >= 0;
                    sa[t][i] = ok ? sa[t][i] : -1e30f; mx = fmaxf(mx, sa[t][i]); }
            mx = fmaxf(mx, __shfl_xor(mx, 16)); mx = fmaxf(mx, __shfl_xor(mx, 32));
            float ls = 0.f;
#pragma unroll
            for (int t = 0; t < 9; ++t)
#pragma unroll
                for (int i = 0; i < 4; ++i) { const float p = sa[t][i] > -1e29f ? __builtin_amdgcn_exp2f(sa[t][i] - mx) : 0.f; sa[t][i] = p; ls += p; }
            ls += __shfl_xor(ls, 16); ls += __shfl_xor(ls, 32);
            bf16x8 pf[5];
#pragma unroll
            for (int s = 0; s < 5; ++s) { const f32x4 lo = sa[2 * s], hi = (2 * s + 1 < 9) ? sa[2 * s + 1 < 9 ? 2 * s + 1 : 8] : (f32x4){0.f, 0.f, 0.f, 0.f};
                v4u w; w.x = pk2(lo[0], lo[1]); w.y = pk2(lo[2], lo[3]); w.z = pk2(hi[0], hi[1]); w.w = pk2(hi[2], hi[3]); pf[s] = __builtin_bit_cast(bf16x8, w); }
            f32x4 oa[4];
#pragma unroll
            for (int dt = 0; dt < 4; ++dt) oa[dt] = (f32x4){0.f, 0.f, 0.f, 0.f};
#pragma unroll
            for (int ch = 0; ch < 3; ++ch) {
#pragma unroll
                for (int it = 0; it < 8; ++it) { const int row = 8 * it + (lane >> 3);
                    if (ch < 2) *(LAS v4u*)(Vw + row * AT_VP + (lane & 7) * 16) = vr[ch < 2 ? ch : 0][it];
                    else if (it < 4) *(LAS v4u*)(Vw + row * AT_VP + (lane & 7) * 16) = vr2[it < 4 ? it : 0]; }
                asm volatile("s_waitcnt lgkmcnt(0)" ::: "memory");
#pragma unroll
                for (int s2 = 0; s2 < 2; ++s2) { const int s = 2 * ch + s2; if (s < 5) {
#pragma unroll
                    for (int dt = 0; dt < 4; ++dt) {
                        const LAS unsigned char* vp = Vw + (32 * s2 + 4 * q4 + (r >> 2)) * AT_VP + dt * 32 + (r & 3) * 8;
                        const v4i16_t x = __builtin_amdgcn_ds_read_tr16_b64_v4i16((LAS v4i16_t*)vp), y = __builtin_amdgcn_ds_read_tr16_b64_v4i16((LAS v4i16_t*)(vp + 16 * AT_VP));
                        const bf16x8 av = (bf16x8){x[0], x[1], x[2], x[3], y[0], y[1], y[2], y[3]};
                        oa[dt] = __builtin_amdgcn_mfma_f32_16x16x32_bf16(av, pf[s], oa[dt], 0, 0, 0); } } }
                asm volatile("s_waitcnt lgkmcnt(0)" ::: "memory");
            }
            LAS float* sp = St + qloc * AT_ST;
            float mo = mx, lo2 = ls;
            if (g > 0) { const float m_old = sp[64], l_old = sp[65]; const float M = fmaxf(m_old, mx); const float fo = __builtin_amdgcn_exp2f(m_old - M), fn = __builtin_amdgcn_exp2f(mx - M);
#pragma unroll
                for (int dt = 0; dt < 4; ++dt) { const f32x4 po = *(const LAS f32x4*)(sp + 16 * dt + 4 * q4); oa[dt] = oa[dt] * fn + po * fo; }
                mo = M; lo2 = ls * fn + l_old * fo; }
            if (g < 2) {
#pragma unroll
                for (int dt = 0; dt < 4; ++dt) *(LAS f32x4*)(sp + 16 * dt + 4 * q4) = oa[dt];
                if (q4 == 0) { sp[64] = mo; sp[65] = lo2; }
            } else { const float inv = 1.0f / lo2; bf16* op = O + (rowbase + t0 + qloc) * 1024 + hd * 64 + 4 * q4;
#pragma unroll
                for (int dt = 0; dt < 4; ++dt) { const f32x4 v = oa[dt] * inv; *(unsigned long long*)(op + 16 * dt) = (unsigned long long)pk2(v[0], v[1]) | ((unsigned long long)pk2(v[2], v[3]) << 32); } }
        }
        __syncthreads();
    }
}

__device__ __forceinline__ unsigned ordf(float s) { const unsigned u = __builtin_bit_cast(unsigned, s); return u ^ ((unsigned)((int)u >> 31) | 0x80000000u); }
__device__ __forceinline__ float unordf(unsigned v) { return __builtin_bit_cast(float, v ^ ((unsigned)((int)(~v) >> 31) | 0x80000000u)); }
__device__ __forceinline__ void ins16(unsigned (&top)[16], unsigned x) {
#pragma unroll
    for (int j = 0; j < 16; ++j) { const unsigned hi = top[j] > x ? top[j] : x; x = top[j] > x ? x : top[j]; top[j] = hi; }
}
#define CE_D(a, b) { const unsigned hi_ = (a) > (b) ? (a) : (b), lo_ = (a) > (b) ? (b) : (a); (a) = hi_; (b) = lo_; }
__device__ __forceinline__ void sort16_desc(unsigned (&v)[16]) {
#pragma unroll
    for (int k = 2; k <= 16; k <<= 1)
#pragma unroll
        for (int j = k >> 1; j > 0; j >>= 1)
#pragma unroll
            for (int i = 0; i < 16; ++i) { const int l = i ^ j; if (l > i) { if ((i & k) == 0) CE_D(v[i], v[l]) else CE_D(v[l], v[i]) } }
}
__device__ __forceinline__ void bitonic_merge16_desc(unsigned (&c)[16]) {
#pragma unroll
    for (int st = 8; st >= 1; st >>= 1)
#pragma unroll
        for (int j = 0; j < 16; ++j) if ((j & st) == 0) CE_D(c[j], c[j + st])
}
__device__ __forceinline__ void top16_of_two(unsigned (&a)[16], const unsigned (&b)[16]) {
#pragma unroll
    for (int j = 0; j < 16; ++j) a[j] = a[j] > b[15 - j] ? a[j] : b[15 - j];
    bitonic_merge16_desc(a);
}
__device__ __forceinline__ void merge16(unsigned (&top)[16], int mask) {
    unsigned o[16];
#pragma unroll
    for (int j = 0; j < 16; ++j) o[j] = (unsigned)__shfl_xor((int)top[j], mask);
    top16_of_two(top, o);
}
__device__ __forceinline__ void phase_peer_topk(const Params& P, const Ctx& C, const Wk& W, int layer) {
    LAS bf16* SK = (LAS bf16*)C.lds;
    const bf16* SKB = (const bf16*)(P.ws + WS_SKB) + (size_t)layer * 32768; const bf16* QP = w_tok16(P, W, AR_QP, 2048);
    int* IDX = (int*)(P.ws + WS_IDX); float* GATE = (float*)(P.ws + WS_GATE);
    for (int ch = C.tid; ch < 4096; ch += 512) { const int rr = ch >> 4, c8 = (ch & 15) * 8; *(LAS v4u*)(SK + rr * 136 + c8) = *(const v4u*)(SKB + (size_t)rr * 128 + c8); }
    __syncthreads();
    const int r = C.lane & 15, q4 = C.lane >> 4;
    const int gw = W.lv * NWAVES + C.wave, NGW = W.n * NWAVES;
    for (int grp = W_TK0(W) / 2 + gw; grp < W_TK0(W) / 2 + HT * 8 / 16; grp += NGW) {
        const size_t task = (size_t)grp * 16 + r;
        unsigned lst[2][16];
#pragma unroll
        for (int half = 0; half < 2; ++half) {
            bf16x8 bq[4];
#pragma unroll
            for (int ks = 0; ks < 4; ++ks) bq[ks] = *(const bf16x8*)(QP + task * 256 + half * 128 + ks * 32 + 8 * q4);
            unsigned ka[16], kb[16];
#pragma unroll
            for (int nt = 0; nt < 8; ++nt) { f32x4 acc = (f32x4){0.f, 0.f, 0.f, 0.f};
#pragma unroll
                for (int ks = 0; ks < 4; ++ks) { const bf16x8 a = *(const LAS bf16x8*)(SK + (half * 128 + 16 * nt + r) * 136 + ks * 32 + 8 * q4); acc = __builtin_amdgcn_mfma_f32_16x16x32_bf16(a, bq[ks], acc, 0, 0, 0); }
#pragma unroll
                for (int i = 0; i < 4; ++i) { const unsigned n = 16 * nt + 4 * q4 + i; const unsigned key = (ordf(acc[i]) & ~127u) | (127u - n); if (nt < 4) ka[4 * nt + i] = key; else kb[4 * (nt - 4) + i] = key; }
                if (nt == 3) sort16_desc(ka);
                __builtin_amdgcn_sched_barrier(0); }
            sort16_desc(kb); top16_of_two(ka, kb);
            merge16(ka, 16); merge16(ka, 32);
#pragma unroll
            for (int j = 0; j < 16; ++j) lst[half][j] = ka[j];
        }
        float v2[16]; unsigned e2[16];
#pragma unroll
        for (int j = 0; j < 16; ++j) { v2[j] = unordf(lst[1][j] & ~127u); e2[j] = 127u - (lst[1][j] & 127u); }
        float v1s[4]; unsigned e1s[4];
#pragma unroll
        for (int k = 0; k < 4; ++k) { const unsigned w = q4 == 0 ? lst[0][4 * k] : q4 == 1 ? lst[0][4 * k + 1] : q4 == 2 ? lst[0][4 * k + 2] : lst[0][4 * k + 3];
            v1s[k] = unordf(w & ~127u); e1s[k] = (127u - (w & 127u)) << 7; }
        unsigned top[16];
#pragma unroll
        for (int j = 0; j < 16; ++j) top[j] = (ordf(v1s[0] + v2[j]) & ~16383u) | e1s[0] | e2[j];
        sort16_desc(top);
#pragma unroll
        for (int j = 0; j < 3; ++j) ins16(top, (ordf(v1s[1] + v2[j]) & ~16383u) | e1s[1] | e2[j]);
        ins16(top, (ordf(v1s[2] + v2[0]) & ~16383u) | e1s[2] | e2[0]);
        ins16(top, (ordf(v1s[3] + v2[0]) & ~16383u) | e1s[3] | e2[0]);
        merge16(top, 16); merge16(top, 32);
        float ev[16]; float den = 0.f; const float mx = unordf(top[0] & ~16383u);
#pragma unroll
        for (int j = 0; j < 16; ++j) { ev[j] = __expf(unordf(top[j] & ~16383u) - mx); den += ev[j]; }
        const float inv = 1.0f / den;
        int* ip = IDX + task * 16; float* gp = GATE + task * 16;
        if (q4 == 0) { *(v4u*)(ip) = (v4u){top[0] & 16383u, top[1] & 16383u, top[2] & 16383u, top[3] & 16383u}; *(f32x4*)(gp) = (f32x4){ev[0] * inv, ev[1] * inv, ev[2] * inv, ev[3] * inv}; }
        else if (q4 == 1) { *(v4u*)(ip + 4) = (v4u){top[4] & 16383u, top[5] & 16383u, top[6] & 16383u, top[7] & 16383u}; *(f32x4*)(gp + 4) = (f32x4){ev[4] * inv, ev[5] * inv, ev[6] * inv, ev[7] * inv}; }
        else if (q4 == 2) { *(v4u*)(ip + 8) = (v4u){top[8] & 16383u, top[9] & 16383u, top[10] & 16383u, top[11] & 16383u}; *(f32x4*)(gp + 8) = (f32x4){ev[8] * inv, ev[9] * inv, ev[10] * inv, ev[11] * inv}; }
        else { *(v4u*)(ip + 12) = (v4u){top[12] & 16383u, top[13] & 16383u, top[14] & 16383u, top[15] & 16383u}; *(f32x4*)(gp + 12) = (f32x4){ev[12] * inv, ev[13] * inv, ev[14] * inv, ev[15] * inv}; }
    }
}
struct ExpRow { v4u d[4], u[4]; float ds, us, gk; };
__device__ __forceinline__ void exp_issue(ExpRow& R, const unsigned char* TD, const unsigned char* TU, const float* SD, int ex, float gk, int jl) {
    const unsigned char* dr = TD + (size_t)ex * TROW; const unsigned char* ur = TU + (size_t)ex * TROW;
#pragma unroll
    for (int c = 0; c < 4; ++c) R.d[c] = *(const v4u*)(dr + (c * 16 + jl) * 16);
#pragma unroll
    for (int c = 0; c < 4; ++c) R.u[c] = *(const v4u*)(ur + (c * 16 + jl) * 16);
    R.ds = SD[ex]; R.us = SD[16384 + ex]; R.gk = gk;
}
__device__ __forceinline__ void exp_consume(const ExpRow& R, const unsigned (&hp)[32], f32x2 (&oacc)[32]) {
    f32x2 a2 = (f32x2){0.f, 0.f};
#pragma unroll
    for (int c = 0; c < 4; ++c)
#pragma unroll
        for (int w = 0; w < 4; ++w) { const f32x2 lo = __builtin_amdgcn_cvt_pk_f32_fp8((int)R.d[c][w], false), hi = __builtin_amdgcn_cvt_pk_f32_fp8((int)R.d[c][w], true);
            unsigned h0 = hp[c * 8 + 2 * w], h1 = hp[c * 8 + 2 * w + 1]; asm volatile("" : "+v"(h0), "+v"(h1));
            a2 = a2 + lo * (f32x2){bflo(h0), bfhi(h0)}; a2 = a2 + hi * (f32x2){bflo(h1), bfhi(h1)}; }
    float a = (a2.x + a2.y) * R.ds;
    a += __shfl_xor(a, 1); a += __shfl_xor(a, 2); a += __shfl_xor(a, 4); a += __shfl_xor(a, 8);
    const float wk = R.gk * gelu_f(a) * R.us; const f32x2 wk2 = (f32x2){wk, wk};
#pragma unroll
    for (int c = 0; c < 4; ++c)
#pragma unroll
        for (int w = 0; w < 4; ++w) { const f32x2 lo = __builtin_amdgcn_cvt_pk_f32_fp8((int)R.u[c][w], false), hi = __builtin_amdgcn_cvt_pk_f32_fp8((int)R.u[c][w], true);
            oacc[c * 8 + 2 * w] = oacc[c * 8 + 2 * w] + wk2 * lo; oacc[c * 8 + 2 * w + 1] = oacc[c * 8 + 2 * w + 1] + wk2 * hi; }
}
__device__ __forceinline__ void phase_peer_experts(const Params& P, const Ctx& Cin, const Wk& W, int layer, bool last) {
    const Ctx C = fresh_ctx(Cin);
    const unsigned char* TD = P.ws + WS_TAB8 + (size_t)(2 * layer) * TAB8_BYTES; const unsigned char* TU = P.ws + WS_TAB8 + (size_t)(2 * layer + 1) * TAB8_BYTES; const float* SD = (const float*)(P.ws + WS_SC8) + (size_t)(2 * layer) * 16384; bf16* H = (bf16*)(P.ws + WS_H);
    const int* IDX = (const int*)(P.ws + WS_IDX); const float* GATE = (const float*)(P.ws + WS_GATE); const float* MOD = (const float*)(P.ws + WS_MOD);
    const int lane = C.lane, grp = lane >> 4, jl = lane & 15;
    const int gw = W.lv * NWAVES + C.wave, NGW = W.n * NWAVES;
    for (int tok = W_TK0(W) + gw; tok < W_TK0(W) + HT; tok += NGW) {
        const int b = tok >> 13;
        const int i0 = IDX[(size_t)tok * 128 + lane], i1 = IDX[(size_t)tok * 128 + 64 + lane];
        const float g0 = GATE[(size_t)tok * 128 + lane], g1 = GATE[(size_t)tok * 128 + 64 + lane];
        unsigned hf[32];
#pragma unroll
        for (int c = 0; c < 4; ++c) { const bf16* hp = H + (size_t)tok * 1024 + (c * 16 + jl) * 16; const v4u w0 = *(const v4u*)hp, w1 = *(const v4u*)(hp + 8);
#pragma unroll
            for (int e = 0; e < 4; ++e) { hf[c * 8 + e] = w0[e]; hf[c * 8 + 4 + e] = w1[e]; } }
        f32x2 oacc[32];
#pragma unroll
        for (int e = 0; e < 32; ++e) oacc[e] = (f32x2){0.f, 0.f};
        ExpRow RA, RB;
        exp_issue(RA, TD, TU, SD, __shfl(i0, grp), __shfl(g0, grp), jl);
        for (int it = 0; it < 32 * EXP_REP; it += 2) {
            { const int kk = ((it + 1) & 31) * 4 + grp; const int el = __shfl(i0, kk & 63), eh = __shfl(i1, kk & 63); const float gl = __shfl(g0, kk & 63), gh = __shfl(g1, kk & 63);
              exp_issue(RB, TD, TU, SD, kk < 64 ? el : eh, kk < 64 ? gl : gh, jl); }
            exp_consume(RA, hf, oacc);
            { const int kk = ((it + 2) & 31) * 4 + grp; const int el = __shfl(i0, kk & 63), eh = __shfl(i1, kk & 63); const float gl = __shfl(g0, kk & 63), gh = __shfl(g1, kk & 63);
              exp_issue(RA, TD, TU, SD, kk < 64 ? el : eh, kk < 64 ? gl : gh, jl); }
            exp_consume(RB, hf, oacc);
        }
        f32x2 h1[16];
        { const bool up = (grp & 2) != 0;
#pragma unroll
          for (int e = 0; e < 16; ++e) { const f32x2 keep = up ? oacc[16 + e] : oacc[e], send = up ? oacc[e] : oacc[16 + e]; h1[e] = keep + (f32x2){__shfl_xor(send.x, 32), __shfl_xor(send.y, 32)}; } }
        f32x2 h2[8];
        { const bool up = (grp & 1) != 0;
#pragma unroll
          for (int e = 0; e < 8; ++e) { const f32x2 keep = up ? h1[8 + e] : h1[e], send = up ? h1[e] : h1[8 + e]; h2[e] = keep + (f32x2){__shfl_xor(send.x, 16), __shfl_xor(send.y, 16)}; } }
        const int d0 = (grp * 16 + jl) * 16;
        const float* g2p = MOD + (size_t)(layer * 8 + b) * 6144 + 5120 + d0; const float psc = ((ABL_ON >= (layer == 0 ? 2 : 4)) ? 1.f : 0.f) * (1.0f / EXP_REP);
        float* xp = P.out + (size_t)tok * 1024 + d0;
        float xn[16]; float ss = 0.f;
#pragma unroll
        for (int q = 0; q < 4; ++q) { const f32x4 xa = *(const f32x4*)(xp + 4 * q), ga = *(const f32x4*)(g2p + 4 * q);
            xn[4 * q] = xa[0] + psc * ga[0] * h2[2 * q].x; xn[4 * q + 1] = xa[1] + psc * ga[1] * h2[2 * q].y; xn[4 * q + 2] = xa[2] + psc * ga[2] * h2[2 * q + 1].x; xn[4 * q + 3] = xa[3] + psc * ga[3] * h2[2 * q + 1].y; }
#pragma unroll
        for (int e = 0; e < 16; ++e) ss += xn[e] * xn[e];
        const float rstd = 1.0f / sqrtf(wave_sum(ss) * (1.0f / 1024.0f) + NORM_EPS);
        if (!last) {
            const float* ng = P.norm_mix_g + (layer + 1) * 1024 + d0; const float* mb = MOD + (size_t)((layer + 1) * 8 + b) * 6144 + d0;
            unsigned w[8];
#pragma unroll
            for (int q = 0; q < 4; ++q) { *(f32x4*)(xp + 4 * q) = (f32x4){xn[4 * q], xn[4 * q + 1], xn[4 * q + 2], xn[4 * q + 3]}; }
#pragma unroll
            for (int e = 0; e < 8; ++e) w[e] = pk2(xn[2 * e] * rstd * ng[2 * e] * (1.0f + mb[1024 + 2 * e]) + mb[2 * e], xn[2 * e + 1] * rstd * ng[2 * e + 1] * (1.0f + mb[1024 + 2 * e + 1]) + mb[2 * e + 1]);
            v4u* hp = (v4u*)(H + (size_t)tok * 1024 + d0); hp[0] = (v4u){w[0], w[1], w[2], w[3]}; hp[1] = (v4u){w[4], w[5], w[6], w[7]};
        } else {
            const float* fg = P.final_norm_g + d0;
#pragma unroll
            for (int q = 0; q < 4; ++q) *(f32x4*)(xp + 4 * q) = (f32x4){xn[4 * q] * rstd * fg[4 * q], xn[4 * q + 1] * rstd * fg[4 * q + 1], xn[4 * q + 2] * rstd * fg[4 * q + 2], xn[4 * q + 3] * rstd * fg[4 * q + 3]};
        }
    }
}
#ifndef NC_PER_XCD
#define NC_PER_XCD 16
#endif
#ifdef PROBE_SEL
#define SUBSTAMP(i) do { if (W.c == 0 && C.tid == 0) __hip_atomic_store((unsigned*)(P.ws + WS_CTL) + 128 + 16 * W.h + (i), (unsigned)__builtin_amdgcn_s_memrealtime(), __ATOMIC_RELAXED, __HIP_MEMORY_SCOPE_AGENT); } while (0)
#else
#define SUBSTAMP(i) do {} while (0)
#endif
__device__ __forceinline__ void run_C0(const Params& P, const Ctx& Cin, const Wk& W, const XcdBarrier& tb) {
    const Ctx C = fresh_ctx(Cin);
    SUBSTAMP(0);
    unsigned char* ws = P.ws; float* MOD = (float*)(ws + WS_MOD); bf16* H = (bf16*)(ws + WS_H);
    const size_t tk = (size_t)W_TK0(W); unsigned char* const ar = w_ar(P, W);
    phase_norm(P, C, W, P.x, P.norm_mix_g, 0, 0); xcd_barrier(tb); SUBSTAMP(1);
    { pg8::Gemm g{H + tk * 1024, (const bf16*)(ws + WS_WIN), HT, 3072, 1024}; pg8::StaticOrder S; S.init(HT, 3072, W.n, W.c);
      EpiInProj E{(bf16*)(ar + AR_PU), (bf16*)(ar + AR_PV), (bf16*)(ar + AR_PQ), (bf16*)(ar + AR_PI), (bf16*)(ar + AR_PG), (float*)(ar + AR_G), (const float*)(ws + WS_LB)};
      pg8::gemm_phase<EpiInProj, pg8::StaticOrder, true, true>(C.lds, g, S, E); } xcd_barrier(tb); SUBSTAMP(2);
    for (int it = W.lv; it < 1024; it += W.n) gmlp_item(P, C, W, W_TK0(W) / 128 + (it >> 2), it & 3);
    for (int it = W.lv; it < 2048; it += W.n) hgrn_local_item(P, C, W, W_BT0(W) * 512 + it);
    xcd_barrier(tb); SUBSTAMP(3);
    phase_hgrn_scan(P, C, W); xcd_barrier(tb); SUBSTAMP(4);
    for (int it = W.lv; it < 2048; it += W.n) hgrn_out_item(P, C, W, W_BT0(W) * 512 + it);
    xcd_barrier(tb); SUBSTAMP(5);
    { pg8::Gemm g{H + tk * 1024, (const bf16*)(ws + WS_WOUT0), HT, 1024, 1024}; pg8::StaticOrder S; S.init(HT, 1024, W.n, W.c);
      EpiResid E{P.x + tk * 1024, P.out + tk * 1024, MOD + 2048 + (size_t)W_BT0(W) * 6144, 1.f};
      pg8::gemm_phase<EpiResid, pg8::StaticOrder, true, true>(C.lds, g, S, E); } xcd_barrier(tb); SUBSTAMP(6);
    phase_norm(P, C, W, P.out, P.norm_ffn_g, 0, 3072); xcd_barrier(tb); SUBSTAMP(7);
    { pg8::Gemm g{H + tk * 1024, (const bf16*)(ws + WS_WQ0), HT, 2048, 1024}; pg8::StaticOrder S; S.init(HT, 2048, W.n, W.c);
      EpiBf16P E{(bf16*)(ar + AR_QP), 2048};
      pg8::gemm_phase<EpiBf16P, pg8::StaticOrder, true, true>(C.lds, g, S, E); }
    SUBSTAMP(9);
}
__device__ __forceinline__ void run_C1(const Params& P, const Ctx& Cin, const Wk& W, const XcdBarrier& tb) {
    const Ctx C = fresh_ctx(Cin);
    SUBSTAMP(0);
    unsigned char* ws = P.ws; float* MOD = (float*)(ws + WS_MOD); bf16* H = (bf16*)(ws + WS_H);
    const size_t tk = (size_t)W_TK0(W); unsigned char* const ar = w_ar(P, W);
    { pg8::Gemm g{H + tk * 1024, (const bf16*)(ws + WS_WQKV), HT, 3072, 1024}; pg8::StaticOrder S; S.init(HT, 3072, W.n, W.c);
      EpiQKRot E{(bf16*)(ar + AR_QK), (const float*)(ws + WS_CS) + tk * 16};
      pg8::gemm_phase<EpiQKRot, pg8::StaticOrder, true, true>(C.lds, g, S, E); } xcd_barrier(tb); SUBSTAMP(1);
    for (int it = W.lv; it < (NB / 2) * 16 * 32; it += W.n) attn_item(P, C, W, W_BT0(W) + (it >> 9), (it >> 5) & 15, it & 31);
    xcd_barrier(tb); SUBSTAMP(2);
    { pg8::Gemm g{H + tk * 1024, (const bf16*)(ws + WS_WOUT1), HT, 1024, 1024}; pg8::StaticOrder S; S.init(HT, 1024, W.n, W.c);
      EpiResid E{P.out + tk * 1024, P.out + tk * 1024, MOD + (size_t)8 * 6144 + 2048 + (size_t)W_BT0(W) * 6144, 1.f};
      pg8::gemm_phase<EpiResid, pg8::StaticOrder, true, true>(C.lds, g, S, E); } xcd_barrier(tb); SUBSTAMP(3);
    phase_norm(P, C, W, P.out, P.norm_ffn_g + 1024, 1, 3072); xcd_barrier(tb); SUBSTAMP(4);
    { pg8::Gemm g{H + tk * 1024, (const bf16*)(ws + WS_WQ1), HT, 2048, 1024}; pg8::StaticOrder S; S.init(HT, 2048, W.n, W.c);
      EpiBf16P E{(bf16*)(ar + AR_QP), 2048};
      pg8::gemm_phase<EpiBf16P, pg8::StaticOrder, true, true>(C.lds, g, S, E); }
    SUBSTAMP(9);
}
__device__ __forceinline__ void run_E(const Params& P, const Ctx& Cin, const Wk& W, const XcdBarrier& tb, int layer) {
    { const Ctx C = fresh_ctx(Cin); phase_peer_topk(P, C, W, layer); }
    xcd_barrier(tb);
    phase_peer_experts(P, Cin, W, layer, layer == 1);
}
__global__ void __launch_bounds__(NWAVES * 64, 2) hybrid_fwd(Params P) {
    extern __shared__ __attribute__((aligned(16))) unsigned char lds_raw[];
    Ctx C;
    C.lds = (LAS unsigned char*)lds_raw;
    C.tid = threadIdx.x; C.lane = C.tid & 63; C.wave = __builtin_amdgcn_readfirstlane(C.tid >> 6);
    C.G = gridDim.x; const int bx = blockIdx.x; C.vcu = (bx % 8) * (C.G / 8) + bx / 8;
    volatile LAS unsigned* MISC = (volatile LAS unsigned*)(C.lds + MISC_OFF);
    for (int u = C.tid; u < (LDS_BYTES - LDSCTL_OFF) / 4; u += NWAVES * 64) ((LAS unsigned*)(C.lds + LDSCTL_OFF))[u] = 0u;
    __syncthreads();
    unsigned* ctl = (unsigned*)(P.ws + WS_CTL);
    const int xl = bx & 7, jx = bx >> 3, perx = C.G / 8;
    const bool inC = jx < NC_PER_XCD;
    const int nC = 8 * NC_PER_XCD, nE = C.G - nC;
    const XcdBarrier bar_all = xcd_barrier_post(ctl + CW_BAR, MISC + 8);
    XcdBarrier bar_c; bar_c.bar = ctl + CW_BAR + XCD_BAR_WORDS; bar_c.x = bar_all.x; bar_c.st = MISC + 10; bar_c.G = (unsigned)nC;
    if (inC && C.tid == 0) (void)xb_add(&bar_c.bar[XB_XCNT(bar_c.x)], 1u);
    XcdBarrier bar_e; bar_e.bar = ctl + CW_BAR + 2 * XCD_BAR_WORDS; bar_e.x = bar_all.x; bar_e.st = MISC + 12; bar_e.G = (unsigned)nE;
    if (!inC && C.tid == 0) (void)xb_add(&bar_e.bar[XB_XCNT(bar_e.x)], 1u);
    Wk Wall; Wall.lv = C.vcu; Wall.n = C.G; Wall.c = bx; Wall.h = 0;
    Wk Wc; Wc.lv = xl * NC_PER_XCD + jx; Wc.n = nC; Wc.c = jx * 8 + xl; Wc.h = 0;
    Wk We; { const int je = jx - NC_PER_XCD, ne = perx - NC_PER_XCD; We.lv = xl * ne + je; We.n = nE; We.c = je * 8 + xl; We.h = 0; }
    phase_prologue(P, C);
    xcd_barrier(bar_all);
#ifdef PROBE_SEL
    unsigned long long tp0 = __builtin_amdgcn_s_memrealtime(), tp1 = 0, tp2 = 0, tp3 = 0, tp4 = 0, tp5 = 0, tpe1 = 0, tpe2 = 0, tpe3 = 0;
#define STAMP(v) v = __builtin_amdgcn_s_memrealtime()
#else
#define STAMP(v)
#endif
    Wall.h = 0; run_C0(P, C, Wall, bar_all); xcd_barrier(bar_all); STAMP(tp1);
    if (inC) { Wc.h = 1; run_C0(P, C, Wc, bar_c); } else { We.h = 0; run_E(P, C, We, bar_e, 0); }
    STAMP(tpe1); xcd_barrier(bar_all); STAMP(tp2);
    if (inC) { Wc.h = 0; run_C1(P, C, Wc, bar_c); } else { We.h = 1; run_E(P, C, We, bar_e, 0); }
    STAMP(tpe2); xcd_barrier(bar_all); STAMP(tp3);
    if (inC) { Wc.h = 1; run_C1(P, C, Wc, bar_c); } else { We.h = 0; run_E(P, C, We, bar_e, 1); }
    STAMP(tpe3); xcd_barrier(bar_all); STAMP(tp4);
    Wall.h = 1; run_E(P, C, Wall, bar_all, 1);
#ifdef PROBE_SEL
    STAMP(tp5);
    { unsigned long long d = 0; const int sel = PROBE_SEL;
      if (sel == 0) d = tp1 - tp0; if (sel == 1) d = tp2 - tp1; if (sel == 2) d = tp3 - tp2; if (sel == 3) d = tp4 - tp3; if (sel == 4) d = tp5 - tp4;
      if (sel == 5 || sel == 8) d = tpe1 - tp1; if (sel == 6 || sel == 9) d = tpe2 - tp2; if (sel == 7 || sel == 10) d = tpe3 - tp3;
      const int who = sel >= 8 ? 8 * NC_PER_XCD : 0;
      if (sel >= 20) { const unsigned* sp = (const unsigned*)(P.ws + WS_CTL) + 128 + 16 * PROBE_HALF; const int i = sel - 20; const int nxt = (i == PROBE_LAST) ? 9 : i + 1; d = (unsigned long long)(__hip_atomic_load(sp + nxt, __ATOMIC_RELAXED, __HIP_MEMORY_SCOPE_AGENT) - __hip_atomic_load(sp + i, __ATOMIC_RELAXED, __HIP_MEMORY_SCOPE_AGENT)); }
      if (bx == (sel >= 20 ? 0 : who) && C.tid == 0) __hip_atomic_store(ctl + 64, (unsigned)d, __ATOMIC_RELAXED, __HIP_MEMORY_SCOPE_AGENT);
      xcd_barrier(bar_all);
      if (bx == 0 && C.tid == 0) { const unsigned dd = __hip_atomic_load(ctl + 64, __ATOMIC_RELAXED, __HIP_MEMORY_SCOPE_AGENT);
        const unsigned long long t0_ = __builtin_amdgcn_s_memrealtime(); while (__builtin_amdgcn_s_memrealtime() - t0_ < 4ull * dd) __builtin_amdgcn_s_sleep(32); } }
#endif
}

extern "C" void kernel_launch(void* const* d_in, const int* in_sizes, int n_in, void* d_out, int out_size, void* d_ws, size_t ws_size, hipStream_t stream) {
    static int grid = 0;
    if (grid == 0) {
        if (n_in != 22 || in_sizes[0] != T * DM || out_size != T * DM || ws_size < WS_END) {
            fprintf(stderr, "kernel_launch: unexpected shapes (n_in %d, in0 %d, out %d, ws %zu); nothing launched\n", n_in, n_in > 0 ? in_sizes[0] : -1, out_size, ws_size); grid = -1; return; }
        int dev = 0, cus = 0;
        if (hipGetDevice(&dev) != hipSuccess || hipDeviceGetAttribute(&cus, hipDeviceAttributeMultiprocessorCount, dev) != hipSuccess) { fprintf(stderr, "kernel_launch: device query failed\n"); grid = -1; return; }
        if (hipFuncSetAttribute((const void*)hybrid_fwd, hipFuncAttributeMaxDynamicSharedMemorySize, LDS_BYTES) != hipSuccess) { fprintf(stderr, "kernel_launch: hipFuncSetAttribute failed\n"); grid = -1; return; }
        (void)hipGetLastError();
        grid = cus;
        if (grid % 8 != 0 || grid / 8 <= NC_PER_XCD) { fprintf(stderr, "kernel_launch: built for a CU count that is a multiple of 8 and > %d; got %d; nothing launched\n", 8 * NC_PER_XCD, grid); grid = -1; return; }
    }
    if (grid < 0) return;
    if (hipMemsetAsync((char*)d_ws + WS_CTL, 0, CTL_ZERO_BYTES, stream) != hipSuccess) { fprintf(stderr, "kernel_launch: memset failed\n"); return; }
    Params p{};
    p.x = (const float*)d_in[0]; p.c = (const float*)d_in[1]; p.positions = (const int*)d_in[2]; p.ada_w = (const float*)d_in[3]; p.ada_b = (const float*)d_in[4];
    p.norm_mix_g = (const float*)d_in[5]; p.norm_ffn_g = (const float*)d_in[6]; p.final_norm_g = (const float*)d_in[7]; p.even_w_in = (const float*)d_in[8]; p.even_w_out = (const float*)d_in[9];
    p.gmlp_ln_g = (const float*)d_in[10]; p.gmlp_ln_b = (const float*)d_in[11]; p.gmlp_w_s = (const float*)d_in[12]; p.gmlp_b_s = (const float*)d_in[13]; p.hgrn_lb_logits = (const float*)d_in[14];
    p.hgrn_norm_g = (const float*)d_in[15]; p.odd_w_qkv = (const float*)d_in[16]; p.odd_w_out = (const float*)d_in[17]; p.peer_w_query = (const float*)d_in[18]; p.peer_sub_keys = (const float*)d_in[19];
    p.peer_down = (const float*)d_in[20]; p.peer_up = (const float*)d_in[21];
    p.out = (float*)d_out; p.ws = (unsigned char*)d_ws;
    p.ph_lo = 0; p.ph_hi = 0;
    hipLaunchKernelGGL(hybrid_fwd, dim3(grid), dim3(NWAVES * 64), LDS_BYTES, stream, p);
    const hipError_t le = hipPeekAtLastError();
    if (le != hipSuccess) fprintf(stderr, "kernel_launch: launch failed: %s\n", hipGetErrorName(le));
}
```

```cpp
#include <hip/hip_runtime.h>
#include <cstdio>
#include <cstdint>
#include <cmath>
namespace pg8 {
#define PG8_LAS __attribute__((address_space(3)))
typedef unsigned short bf16_t;
typedef short bf16x8 __attribute__((ext_vector_type(8)));
typedef float f32x4 __attribute__((ext_vector_type(4)));
typedef unsigned u32x4 __attribute__((ext_vector_type(4)));
constexpr int BM = 256, BK = 64, HALF = 128, HTB = HALF * BK * 2  , STAGE_BYTES = 8 * HTB, NXCD = 8, WGM = 8;

__host__ __device__ __forceinline__ int lds_byte(int r, int c) { const int st = (r >> 4) * 2 + (c >> 5), rr = r & 15, cc = c & 31, ob = rr * 64 + cc * 2; return st * 1024 + (ob ^ (((ob >> 9) & 1) << 5)); }
__host__ __device__ __forceinline__ void stage_rc(int b, int& R, int& C) { const int st = b / 1024, sb = b % 1024, swz = sb ^ (((sb >> 9) & 1) << 5); R = (st >> 1) * 16 + swz / 64; C = (st & 1) * 32 + (swz % 64) / 2; }
__host__ __device__ __forceinline__ int perm32(int rho) { const int n = rho >> 4, i = rho & 15; return 8 * (i >> 2) + 4 * n + (i & 3); }

struct Unit { int pm, pn; };
struct Gemm { const bf16_t* A; const bf16_t* Bt; int M, N, K; };

struct StaticOrder {
    int nM, nN, nwg, G, c;
    __host__ __device__ void init(int M, int N, int G_, int c_) { nM = M / BM; nN = N / BM; nwg = nM * nN; G = G_; c = c_; }
    __host__ __device__ bool next(int i, Unit& u) const {
        const long L = (long)i * G + c; if (L >= nwg) return false;
        int wgid = (int)L; { const int q = nwg / NXCD, r = nwg % NXCD, xcd = wgid % NXCD, off = wgid / NXCD; wgid = (xcd < r ? xcd * (q + 1) : r * (q + 1) + (xcd - r) * q) + off; }
        const int nig = WGM * nN, gid = wgid / nig, fm = gid * WGM, gsz = (nM - fm) < WGM ? (nM - fm) : WGM;
        u.pm = fm + ((wgid % nig) % gsz); u.pn = (wgid % nig) / gsz; return true;
    }
    __device__ __forceinline__ void a_ready(const Unit&) const {}
    __device__ __forceinline__ void done(const Unit&) const {}
};

__device__ __forceinline__ unsigned cvt_pk_bf16(float lo, float hi) { unsigned r; asm volatile("v_cvt_pk_bf16_f32 %0, %1, %2" : "=v"(r) : "v"(lo), "v"(hi)); return r; }
typedef float f32x2 __attribute__((ext_vector_type(2)));
__device__ __forceinline__ f32x2 gelu_pk(f32x2 v) {
    const f32x2 av = __builtin_elementwise_abs(v), d = av * 0.2316418882f + 1.0f;
    f32x2 t; t.x = __builtin_amdgcn_rcpf(d.x); t.y = __builtin_amdgcn_rcpf(d.y);
    f32x2 q = t * 0.5307027145f + (-0.7265760135f); q = q * t + 0.7107068705f; q = q * t + (-0.142248368f); q = q * t + 0.127414796f; q = q * t;
    const f32x2 s = (v * v) * (-0.72134752044f);
    f32x2 e; e.x = __builtin_amdgcn_exp2f(s.x); e.y = __builtin_amdgcn_exp2f(s.y);
    const f32x2 m = v * (q * e), r = v - m;
    f32x2 o; o.x = v.x < 0.f ? m.x : r.x; o.y = v.y < 0.f ? m.y : r.y; return o;
}

template <class Epi, class Sched, bool ALIGN_EPI = false, bool SP2 = false>
__device__ __forceinline__ void gemm_phase(PG8_LAS unsigned char* lds, const Gemm g, const Sched& S, const Epi& E) {
    int tid_ = threadIdx.x; asm volatile("" : "+v"(tid_));
    const int tid = tid_, wid = __builtin_amdgcn_readfirstlane(tid >> 6), lane = tid & 63, wr = wid >> 2, wc = wid & 3, fr = lane & 15, fq = lane >> 4;
    const int K = g.K, nt = K / BK;
    unsigned voffA[2], voffB[2];
#pragma unroll
    for (int i = 0; i < 2; ++i) { int R, C; stage_rc(tid * 16 + i * 8192, R, C); const int Rb = Epi::PERM ? ((R & ~31) + perm32(R & 31)) : R;
        voffA[i] = (unsigned)(R * K + C) * 2u; voffB[i] = (unsigned)(Rb * K + C) * 2u; }
    const size_t kstep = (size_t)(BK * 2);
    const size_t hstep = (size_t)HALF * K * 2;
    const size_t tstep = 2 * hstep;
    const unsigned ldsw = (unsigned)wid * 1024u;
    const int aoff = lds_byte(wr * 64 + fr, fq * 8), boff = lds_byte(wc * 32 + fr, fq * 8);
#define PG8_SA(b, h) (((b) * 2 + (h)) * HTB)
#define PG8_SB(b, h) ((4 + (b) * 2 + (h)) * HTB)
#define PG8_STAGE(bufoff, gbase, voff) do { _Pragma("unroll") for (int _i = 0; _i < 2; ++_i) \
        __builtin_amdgcn_global_load_lds((const unsigned*)((const char*)(gbase) + (voff)[_i]), (PG8_LAS unsigned*)(lds + (bufoff) + ldsw + _i * 8192), 16, 0, 0); } while (0)
#define PG8_LDA(dst, b, h) do { _Pragma("unroll") for (int m = 0; m < 4; ++m) _Pragma("unroll") for (int k = 0; k < 2; ++k) dst[m][k] = *(const PG8_LAS bf16x8*)(lds + PG8_SA(b, h) + aoff + m * 2048 + k * 1024); } while (0)
#define PG8_LDB(dst, b, h) do { _Pragma("unroll") for (int n = 0; n < 2; ++n) _Pragma("unroll") for (int k = 0; k < 2; ++k) dst[n][k] = *(const PG8_LAS bf16x8*)(lds + PG8_SB(b, h) + boff + n * 2048 + k * 1024); } while (0)
#define PG8_MMA(ai, bj, At, Bt) do { __builtin_amdgcn_s_setprio(1); _Pragma("unroll") for (int m = 0; m < 4; ++m) _Pragma("unroll") for (int n = 0; n < 2; ++n) _Pragma("unroll") for (int k = 0; k < 2; ++k) \
        acc[ai][bj][m][n] = __builtin_amdgcn_mfma_f32_16x16x32_bf16(Bt[n][k], At[m][k], acc[ai][bj][m][n], 0, 0, 0); __builtin_amdgcn_s_setprio(0); } while (0)
#define PG8_WAIT_V(n) asm volatile("s_waitcnt vmcnt(" #n ")" ::: "memory")
#define PG8_WAIT_L(n) asm volatile("s_waitcnt lgkmcnt(" #n ")" ::: "memory")
#define PG8_BAR __builtin_amdgcn_s_barrier()
#define PG8_SCHED __builtin_amdgcn_sched_barrier(0)
    Unit cur, nxt; int ui = 0;
    if (!S.next(0, cur)) return;
    f32x4 acc[2][2][4][2];
#pragma unroll
    for (int a = 0; a < 2; ++a)
#pragma unroll
        for (int b = 0; b < 2; ++b)
#pragma unroll
            for (int m = 0; m < 4; ++m)
#pragma unroll
                for (int n = 0; n < 2; ++n) acc[a][b][m][n] = (f32x4){0.f, 0.f, 0.f, 0.f};
    bf16x8 At[4][2], B0[2][2], B1[2][2];
    const char* cA = (const char*)g.A + (size_t)cur.pm * tstep; const char* cB = (const char*)g.Bt + (size_t)cur.pn * tstep;
    S.a_ready(cur);
    if constexpr (SP2) {
        PG8_STAGE(PG8_SB(0, 0), cB, voffB); PG8_STAGE(PG8_SB(0, 1), cB + hstep, voffB); PG8_STAGE(PG8_SA(0, 0), cA, voffA); PG8_STAGE(PG8_SA(0, 1), cA + hstep, voffA);
        if (wr == 1) PG8_BAR;
        PG8_WAIT_V(2); PG8_BAR;
        PG8_STAGE(PG8_SB(1, 0), cB + kstep, voffB); PG8_STAGE(PG8_SA(1, 0), cA + kstep, voffA); PG8_STAGE(PG8_SB(1, 1), cB + hstep + kstep, voffB);
        PG8_WAIT_V(6); PG8_BAR;
    } else {
        PG8_STAGE(PG8_SB(0, 0), cB, voffB); PG8_STAGE(PG8_SA(0, 0), cA, voffA); PG8_STAGE(PG8_SB(0, 1), cB + hstep, voffB); PG8_STAGE(PG8_SA(0, 1), cA + hstep, voffA);
        if (wr == 1) PG8_BAR;
        PG8_WAIT_V(4); PG8_BAR;
        PG8_STAGE(PG8_SB(1, 0), cB + kstep, voffB); PG8_STAGE(PG8_SA(1, 0), cA + kstep, voffA); PG8_STAGE(PG8_SB(1, 1), cB + hstep + kstep, voffB);
        PG8_WAIT_V(6); PG8_BAR;
    }
    for (;;) {
        const bool has_next = S.next(ui + 1, nxt);
        const char* nA = has_next ? (const char*)g.A + (size_t)nxt.pm * tstep : cA; const char* nB = has_next ? (const char*)g.Bt + (size_t)nxt.pn * tstep : cB;
        for (int t = 0; t < nt; t += 2) {
            const bool last = (t == nt - 2);
            const char* a1 = cA + (size_t)(t + 1) * kstep;
            const char* a2 = last ? nA : cA + (size_t)(t + 2) * kstep; const char* b2 = last ? nB : cB + (size_t)(t + 2) * kstep;
            const char* a3 = a2 + kstep; const char* b3 = b2 + kstep;
            if (last && has_next) S.a_ready(nxt);
            if constexpr (SP2) {
            PG8_LDB(B0, 0, 0); PG8_LDB(B1, 0, 1); PG8_SCHED; PG8_LDA(At, 0, 0); PG8_STAGE(PG8_SA(1, 1), a1 + hstep, voffA);
            PG8_WAIT_V(8); PG8_WAIT_L(0); PG8_BAR; PG8_MMA(0, 0, At, B0); PG8_MMA(0, 1, At, B1); PG8_BAR; PG8_SCHED;
            PG8_LDA(At, 0, 1); PG8_STAGE(PG8_SB(0, 0), b2, voffB); PG8_STAGE(PG8_SB(0, 1), b2 + hstep, voffB); PG8_STAGE(PG8_SA(0, 0), a2, voffA);
            PG8_WAIT_V(8); PG8_WAIT_L(0); PG8_BAR; PG8_MMA(1, 0, At, B0); PG8_MMA(1, 1, At, B1); PG8_BAR; PG8_SCHED;
            PG8_LDB(B0, 1, 0); PG8_LDB(B1, 1, 1); PG8_SCHED; PG8_LDA(At, 1, 0); PG8_STAGE(PG8_SA(0, 1), a2 + hstep, voffA);
            PG8_WAIT_V(8); PG8_WAIT_L(0); PG8_BAR; PG8_MMA(0, 0, At, B0); PG8_MMA(0, 1, At, B1); PG8_BAR; PG8_SCHED;
            PG8_LDA(At, 1, 1); PG8_STAGE(PG8_SB(1, 0), b3, voffB); PG8_STAGE(PG8_SB(1, 1), b3 + hstep, voffB); PG8_STAGE(PG8_SA(1, 0), a3, voffA);
            PG8_WAIT_V(8); PG8_WAIT_L(0); PG8_BAR; PG8_MMA(1, 0, At, B0); PG8_MMA(1, 1, At, B1); PG8_BAR; PG8_SCHED;
            } else {
            PG8_LDB(B0, 0, 0); PG8_SCHED; PG8_LDA(At, 0, 0); PG8_STAGE(PG8_SA(1, 1), a1 + hstep, voffA);
            PG8_WAIT_L(8); PG8_BAR; PG8_WAIT_L(0); PG8_MMA(0, 0, At, B0); PG8_BAR; PG8_SCHED;
            PG8_LDB(B1, 0, 1); PG8_STAGE(PG8_SB(0, 0), b2, voffB);
            PG8_BAR; PG8_WAIT_L(0); PG8_MMA(0, 1, At, B1); PG8_BAR;
            PG8_LDA(At, 0, 1); PG8_STAGE(PG8_SA(0, 0), a2, voffA);
            PG8_BAR; PG8_WAIT_L(0); PG8_MMA(1, 0, At, B0); PG8_BAR; PG8_SCHED;
            PG8_STAGE(PG8_SB(0, 1), b2 + hstep, voffB);
            PG8_WAIT_V(6); PG8_BAR; PG8_MMA(1, 1, At, B1); PG8_BAR;
            PG8_LDB(B0, 1, 0); PG8_SCHED; PG8_LDA(At, 1, 0); PG8_STAGE(PG8_SA(0, 1), a2 + hstep, voffA);
            PG8_WAIT_L(8); PG8_BAR; PG8_WAIT_L(0); PG8_MMA(0, 0, At, B0); PG8_BAR; PG8_SCHED;
            PG8_LDB(B1, 1, 1); PG8_STAGE(PG8_SB(1, 0), b3, voffB);
            PG8_BAR; PG8_WAIT_L(0); PG8_MMA(0, 1, At, B1); PG8_BAR;
            PG8_LDA(At, 1, 1); PG8_STAGE(PG8_SA(1, 0), a3, voffA);
            PG8_BAR; PG8_WAIT_L(0); PG8_MMA(1, 0, At, B0); PG8_BAR; PG8_SCHED;
            PG8_STAGE(PG8_SB(1, 1), b3 + hstep, voffB);
            PG8_WAIT_V(6); PG8_BAR; PG8_MMA(1, 1, At, B1); PG8_BAR;
            }
        }
        if constexpr (ALIGN_EPI) { if (wr == 0) PG8_BAR; }
        if constexpr (!Epi::AFTER_DRAIN) { E(acc, cur, wr, wc, fr, fq); S.done(cur); }
        if (!has_next) break;
#pragma unroll
        for (int a = 0; a < 2; ++a)
#pragma unroll
            for (int b = 0; b < 2; ++b)
#pragma unroll
                for (int m = 0; m < 4; ++m)
#pragma unroll
                    for (int n = 0; n < 2; ++n) acc[a][b][m][n] = (f32x4){0.f, 0.f, 0.f, 0.f};
        cur = nxt; cA = nA; cB = nB; ++ui;
        if constexpr (ALIGN_EPI) { if (wr == 1) PG8_BAR; }
    }
    PG8_WAIT_V(0);
    if constexpr (!ALIGN_EPI) { if (wr == 0) PG8_BAR; }
    PG8_BAR;
    if constexpr (Epi::AFTER_DRAIN) { E.fused(acc, cur, wr, wc, fr, fq, lds, wid, lane); S.done(cur); }
#undef PG8_SA
#undef PG8_SB
#undef PG8_STAGE
#undef PG8_LDA
#undef PG8_LDB
#undef PG8_MMA
#undef PG8_WAIT_V
#undef PG8_WAIT_L
#undef PG8_BAR
#undef PG8_SCHED
}
}
#define GAS __attribute__((address_space(1)))
#define LAS __attribute__((address_space(3)))
typedef unsigned short bf16;
typedef unsigned v4u __attribute__((ext_vector_type(4)));
typedef float f32x4 __attribute__((ext_vector_type(4)));
typedef short bf16x8 __attribute__((ext_vector_type(8)));
typedef __bf16 bf16x2_t __attribute__((ext_vector_type(2)));
#define LDS_WAIT() asm volatile("s_waitcnt lgkmcnt(0)" ::: "memory")
#define VM_WAIT() asm volatile("s_waitcnt vmcnt(0)" ::: "memory")
__device__ __forceinline__ unsigned f2bf(float f) { unsigned u = __builtin_bit_cast(unsigned, f); return (u + 0x7fffu + ((u >> 16) & 1u)) >> 16; }
__device__ __forceinline__ unsigned pk2(float lo, float hi) { return f2bf(lo) | (f2bf(hi) << 16); }
__device__ __forceinline__ float bflo(unsigned u) { return __builtin_bit_cast(float, u << 16); }
__device__ __forceinline__ float bfhi(unsigned u) { return __builtin_bit_cast(float, u & 0xffff0000u); }
__device__ __forceinline__ float bf2f(bf16 u) { return __builtin_bit_cast(float, (unsigned)u << 16); }
#define XB_TMO      128
#define XB_XCNT(j)  (256  + 64 * (j))
#define XB_XSUB(j)  (1280 + 64 * (j))
#define XB_XGEN(j)  (2304 + 64 * (j))
#define XB_TOP      3328
#define XB_TOPGEN   3392
#define XCD_BAR_WORDS 3456
#define XB_SPIN_CAP (1u << 18)

__device__ __forceinline__ unsigned xb_ld(unsigned* p)              { return __hip_atomic_load(p, __ATOMIC_RELAXED, __HIP_MEMORY_SCOPE_AGENT); }
__device__ __forceinline__ unsigned xb_add(unsigned* p, unsigned v) { return __hip_atomic_fetch_add(p, v, __ATOMIC_RELAXED, __HIP_MEMORY_SCOPE_AGENT); }
__device__ __forceinline__ unsigned xb_xcc_id() { return (unsigned)__builtin_amdgcn_s_getreg((3 << 11) | 20) & 0xFu; }
#define XB_SPIN(cond, bar) do { unsigned _sp = 0; while (cond) { __builtin_amdgcn_s_sleep(1); \
    if ((++_sp & 255u) == 0u) { if (xb_ld(&(bar)[XB_TMO])) break; if (_sp > XB_SPIN_CAP) { atomicAdd(&(bar)[XB_TMO], 1u); break; } } } } while (0)

struct XcdBarrier {
    unsigned* bar; unsigned x; unsigned G;
    volatile LAS unsigned* st;
};

__device__ __forceinline__ XcdBarrier xcd_barrier_post(unsigned* bar, volatile LAS unsigned* st) {
    XcdBarrier b; b.bar = bar; b.x = xb_xcc_id(); b.st = st; b.G = gridDim.x;
    if (threadIdx.x == 0) (void)xb_add(&bar[XB_XCNT(b.x)], 1u);
    return b;
}
__device__ __forceinline__ void xcd_barrier_complete(unsigned* bar, unsigned x, unsigned& nloc, unsigned& nx, const unsigned G) {
    unsigned sum, cnt, mine, sp = 0u;
    for (;;) {
        sum = 0u; cnt = 0u; mine = 0u;
#pragma unroll
        for (unsigned j = 0; j < 16; ++j) { const unsigned c = xb_ld(&bar[XB_XCNT(j)]); sum += c; cnt += (c > 0u) ? 1u : 0u; mine = (j == x) ? c : mine; }
        if (sum == G) break;
        __builtin_amdgcn_s_sleep(1);
        if ((++sp & 255u) == 0u) { if (xb_ld(&bar[XB_TMO])) break; if (sp > XB_SPIN_CAP) { atomicAdd(&bar[XB_TMO], 1u); break; } }
    }
    nloc = mine > 0u ? mine : 1u; nx = cnt > 0u ? cnt : 1u;
}

__device__ __forceinline__ void xcd_barrier(const XcdBarrier& b) {
    asm volatile("s_waitcnt vmcnt(0)" ::: "memory");
    __syncthreads();
    if (threadIdx.x == 0) {
        unsigned* bar = b.bar;
        __builtin_amdgcn_s_waitcnt(0);
        unsigned nloc = b.st[0], nx = b.st[1];
        if (nloc == 0u) { xcd_barrier_complete(bar, b.x, nloc, nx, b.G); b.st[0] = nloc; b.st[1] = nx; }
        const unsigned old = xb_add(&bar[XB_XSUB(b.x)], 1u);
        const unsigned gen = old / nloc;
        if (old + 1u == (gen + 1u) * nloc) {
            __builtin_amdgcn_fence(__ATOMIC_RELEASE, "agent");
            asm volatile("s_waitcnt vmcnt(0)" ::: "memory");
            const unsigned og = xb_add(&bar[XB_TOP], 1u);
            const unsigned tg = og / nx;
            if (og + 1u == (tg + 1u) * nx) xb_add(&bar[XB_TOPGEN], 1u);
            else XB_SPIN(xb_ld(&bar[XB_TOPGEN]) == tg, bar);
            __builtin_amdgcn_fence(__ATOMIC_ACQUIRE, "agent");
            xb_add(&bar[XB_XGEN(b.x)], 1u);
            asm volatile("s_waitcnt vmcnt(0)" ::: "memory");
        } else {
            XB_SPIN(xb_ld(&bar[XB_XGEN(b.x)]) == gen, bar);
            __builtin_amdgcn_fence(__ATOMIC_ACQUIRE, "agent");
            asm volatile("s_waitcnt vmcnt(0)" ::: "memory");
        }
    }
    __syncthreads();
}

constexpr int NB = 8, SEQ = 8192, DM = 1024, T = NB * SEQ;
constexpr int NWAVES = 8;
constexpr float NORM_EPS = 1e-6f;
constexpr float C2 = 0.125f * 1.4426950408889634f;

constexpr size_t MiB = 1u << 20;
constexpr size_t WS_CTL = 0, CTL_ZERO_BYTES = 1 * MiB;
constexpr size_t WS_MOD = 1 * MiB;
constexpr size_t WS_SKB = 1 * MiB + 512 * 1024;
constexpr size_t WS_WSB = 1 * MiB + 768 * 1024;
constexpr size_t WS_LB  = 1 * MiB + 960 * 1024;
constexpr size_t WS_CS  = 2 * MiB;
constexpr size_t WS_HD  = 6 * MiB;
constexpr size_t WS_WIN = 16 * MiB, WS_WOUT0 = 22 * MiB, WS_WQKV = 24 * MiB, WS_WOUT1 = 30 * MiB, WS_WQ0 = 32 * MiB, WS_WQ1 = 36 * MiB;
constexpr size_t WS_TAB8 = 40 * MiB, TAB8_BYTES = 16 * MiB;
constexpr int TROW = 1024;
constexpr size_t WS_SC8 = 8 * MiB;
constexpr size_t WS_H = 108 * MiB;
constexpr size_t WS_IDX = 236 * MiB, WS_GATE = 268 * MiB;
constexpr size_t WS_AR0 = 300 * MiB, AR_BYTES = 352 * MiB;
constexpr size_t AR_PU = 0, AR_PV = 32 * MiB, AR_PQ = 64 * MiB, AR_PI = 96 * MiB, AR_PG = 128 * MiB;
constexpr size_t AR_G = 160 * MiB;
constexpr size_t AR_KVT = 224 * MiB, AR_ST = 288 * MiB;
constexpr size_t AR_QP = 0;
constexpr size_t AR_QK = 0;
constexpr size_t WS_END = WS_AR0 + 2 * AR_BYTES;
constexpr int HT = T / 2;
constexpr int CW_BAR = 4096;

constexpr int LDS_BYTES = 147456;
constexpr int LDSCTL_OFF = LDS_BYTES - 512;
constexpr int MISC_OFF = LDSCTL_OFF;

struct Params {
    const float* x; const float* c; const int* positions; const float* ada_w; const float* ada_b; const float* norm_mix_g; const float* norm_ffn_g; const float* final_norm_g;
    const float* even_w_in; const float* even_w_out; const float* gmlp_ln_g; const float* gmlp_ln_b; const float* gmlp_w_s; const float* gmlp_b_s; const float* hgrn_lb_logits; const float* hgrn_norm_g;
    const float* odd_w_qkv; const float* odd_w_out; const float* peer_w_query; const float* peer_sub_keys; const float* peer_down; const float* peer_up;
    float* out; unsigned char* ws; int ph_lo, ph_hi;
};
struct Ctx { LAS unsigned char* lds; int tid, lane, wave, vcu, G; };
__device__ __forceinline__ Ctx fresh_ctx(const Ctx& C0) { Ctx C = C0; int t_ = threadIdx.x; asm volatile("" : "+v"(t_)); C.tid = t_; C.lane = t_ & 63; C.wave = __builtin_amdgcn_readfirstlane(t_ >> 6); return C; }
struct Wk { int lv, n, c, h; };
#define W_TK0(W) ((W).h * (T / 2))
#define W_BT0(W) ((W).h * (NB / 2))
__device__ __forceinline__ unsigned char* w_ar(const Params& P, const Wk& W) { return P.ws + WS_AR0 + (size_t)W.h * AR_BYTES; }
__device__ __forceinline__ bf16* w_tok16(const Params& P, const Wk& W, size_t off, int pitch) { return (bf16*)(w_ar(P, W) + off) - (size_t)W_TK0(W) * pitch; }
__device__ __forceinline__ float* w_tok32(const Params& P, const Wk& W, size_t off, int pitch) { return (float*)(w_ar(P, W) + off) - (size_t)W_TK0(W) * pitch; }
__device__ __forceinline__ bf16* w_item16(const Params& P, const Wk& W, size_t off) { return (bf16*)(w_ar(P, W) + off) - (size_t)W_BT0(W) * 512 * 16384; }

__device__ __forceinline__ float wave_sum(float v) {
#pragma unroll
    for (int o = 1; o < 64; o <<= 1) v += __shfl_xor(v, o);
    return v;
}
__device__ __forceinline__ float silu_f(float x) { return x * __builtin_amdgcn_rcpf(1.0f + __builtin_amdgcn_exp2f(-1.4426950408889634f * x)); }
__device__ __forceinline__ float sigmoid_f(float x) { return __builtin_amdgcn_rcpf(1.0f + __builtin_amdgcn_exp2f(-1.4426950408889634f * x)); }
__device__ __forceinline__ float gelu_f(float x) { return 0.5f * x * (1.0f + erff(x * 0.70710678118654752f)); }
__device__ __forceinline__ f32x4 mma16(f32x4 acc, const LAS bf16* A, int lda, const LAS bf16* Bt, int ldb, int K, int r, int q4) {
    const LAS bf16* ap = A + r * lda + 8 * q4; const LAS bf16* bp = Bt + r * ldb + 8 * q4;
    for (int k0 = 0; k0 < K; k0 += 32) {
        const bf16x8 a = *(const LAS bf16x8*)(ap + k0); const bf16x8 b = *(const LAS bf16x8*)(bp + k0);
        acc = __builtin_amdgcn_mfma_f32_16x16x32_bf16(a, b, acc, 0, 0, 0);
    }
    return acc;
}

struct EpiBf16P {
    static constexpr bool PERM = true, AFTER_DRAIN = false;
    bf16* O; size_t ldc;
    __device__ __forceinline__ void operator()(const f32x4 (&acc)[2][2][4][2], const pg8::Unit& u, int wr, int wc, int fr, int fq) const {
        const int row0 = u.pm * 256 + wr * 64 + fr, col0 = u.pn * 256 + wc * 32 + 8 * fq;
#pragma unroll
        for (int ai = 0; ai < 2; ++ai)
#pragma unroll
            for (int m = 0; m < 4; ++m) { bf16* rowp = O + (size_t)(row0 + ai * 128 + m * 16) * ldc + col0;
#pragma unroll
                for (int bj = 0; bj < 2; ++bj) { const f32x4 v0 = acc[ai][bj][m][0], v1 = acc[ai][bj][m][1];
                    v4u w; w.x = pg8::cvt_pk_bf16(v0[0], v0[1]); w.y = pg8::cvt_pk_bf16(v0[2], v0[3]); w.z = pg8::cvt_pk_bf16(v1[0], v1[1]); w.w = pg8::cvt_pk_bf16(v1[2], v1[3]);
                    *(v4u*)(rowp + bj * 128) = w; } }
    }
};
#ifndef REP_HG
#define REP_HG 1
#endif
#ifndef REP_TOPK
#define REP_TOPK 1
#endif
#ifndef REP_PRO
#define REP_PRO 1
#endif
#ifndef REP_NORM
#define REP_NORM 1
#endif
#ifndef REP_GEMM2
#define REP_GEMM2 1
#endif
#ifndef REP_GEMM
#define REP_GEMM 1
#endif
#ifndef EXP_REP
#define EXP_REP 1
#endif
#ifndef ATT_REP
#define ATT_REP 1
#endif
#ifndef ABL_ON
#define ABL_ON 4
#endif
struct EpiResid {
    static constexpr bool PERM = true, AFTER_DRAIN = false;
    const float* xin; float* xout; const float* gate; float gsc;
    __device__ __forceinline__ void operator()(const f32x4 (&acc)[2][2][4][2], const pg8::Unit& u, int wr, int wc, int fr, int fq) const {
        const int row0 = u.pm * 256 + wr * 64 + fr, col0 = u.pn * 256 + wc * 32 + 8 * fq;
        const float* gp = gate + (size_t)((u.pm * 256) >> 13) * 6144 + col0;
        f32x4 gv[2][2];
#pragma unroll
        for (int bj = 0; bj < 2; ++bj) { gv[bj][0] = *(const f32x4*)(gp + bj * 128); gv[bj][1] = *(const f32x4*)(gp + bj * 128 + 4); }
#pragma unroll
        for (int ai = 0; ai < 2; ++ai)
#pragma unroll
            for (int m = 0; m < 4; ++m) { const size_t off = (size_t)(row0 + ai * 128 + m * 16) * 1024 + col0;
#pragma unroll
                for (int bj = 0; bj < 2; ++bj) {
                    const f32x4 x0 = *(const f32x4*)(xin + off + bj * 128), x1 = *(const f32x4*)(xin + off + bj * 128 + 4);
                    *(f32x4*)(xout + off + bj * 128) = x0 + gv[bj][0] * acc[ai][bj][m][0] * gsc;
                    *(f32x4*)(xout + off + bj * 128 + 4) = x1 + gv[bj][1] * acc[ai][bj][m][1] * gsc; }
                asm volatile("" ::: "memory"); }
    }
};
struct EpiInProj {
    static constexpr bool PERM = true, AFTER_DRAIN = false;
    bf16* PU; bf16* PV; bf16* PQ; bf16* PI; bf16* PG; float* G; const float* LB;
    __device__ __forceinline__ void operator()(const f32x4 (&acc)[2][2][4][2], const pg8::Unit& u, int wr, int wc, int fr, int fq) const {
        const int type = u.pn >> 1;
        const int row0 = u.pm * 256 + wr * 64 + fr, lc0 = (u.pn & 1) * 256 + wc * 32 + 8 * fq;
        if (type == 3) {
            f32x4 lb[2][2];
#pragma unroll
            for (int bj = 0; bj < 2; ++bj) { lb[bj][0] = *(const f32x4*)(LB + lc0 + bj * 128); lb[bj][1] = *(const f32x4*)(LB + lc0 + bj * 128 + 4); }
#pragma unroll
            for (int ai = 0; ai < 2; ++ai)
#pragma unroll
                for (int m = 0; m < 4; ++m) { float* rowp = G + (size_t)(row0 + ai * 128 + m * 16) * 512 + lc0;
#pragma unroll
                    for (int bj = 0; bj < 2; ++bj)
#pragma unroll
                        for (int n = 0; n < 2; ++n) { const f32x4 v = acc[ai][bj][m][n]; f32x4 o;
#pragma unroll
                            for (int e = 0; e < 4; ++e) { const float l = lb[bj][n][e]; const float f = l + (1.0f - l) * sigmoid_f(v[e]); o[e] = __logf(f); }
                            *(f32x4*)(rowp + bj * 128 + 4 * n) = o; } }
            return;
        }
        bf16* base = type == 0 ? PU : type == 1 ? PV : type == 2 ? PQ : type == 4 ? PI : PG;
#pragma unroll
        for (int ai = 0; ai < 2; ++ai)
#pragma unroll
            for (int m = 0; m < 4; ++m) { bf16* rowp = base + (size_t)(row0 + ai * 128 + m * 16) * 512 + lc0;
#pragma unroll
                for (int bj = 0; bj < 2; ++bj) { f32x4 v0 = acc[ai][bj][m][0], v1 = acc[ai][bj][m][1];
                    if (type <= 1) { pg8::f32x2 a = pg8::gelu_pk((pg8::f32x2){v0[0], v0[1]}), b = pg8::gelu_pk((pg8::f32x2){v0[2], v0[3]}), c = pg8::gelu_pk((pg8::f32x2){v1[0], v1[1]}), d = pg8::gelu_pk((pg8::f32x2){v1[2], v1[3]});
                        v0 = (f32x4){a.x, a.y, b.x, b.y}; v1 = (f32x4){c.x, c.y, d.x, d.y}; }
                    else if (type == 2) {
#pragma unroll
                        for (int e = 0; e < 4; ++e) { v0[e] = silu_f(v0[e]) * 0.08838834764831845f; v1[e] = silu_f(v1[e]) * 0.08838834764831845f; } }
                    else if (type == 5) {
#pragma unroll
                        for (int e = 0; e < 4; ++e) { v0[e] = silu_f(v0[e]); v1[e] = silu_f(v1[e]); } }
                    v4u w; w.x = pg8::cvt_pk_bf16(v0[0], v0[1]); w.y = pg8::cvt_pk_bf16(v0[2], v0[3]); w.z = pg8::cvt_pk_bf16(v1[0], v1[1]); w.w = pg8::cvt_pk_bf16(v1[2], v1[3]);
                    *(v4u*)(rowp + bj * 128) = w; } }
    }
};
struct EpiQKRot {
    static constexpr bool PERM = true, AFTER_DRAIN = false;
    bf16* O; const float* CS;
    __device__ __forceinline__ void operator()(const f32x4 (&acc)[2][2][4][2], const pg8::Unit& u, int wr, int wc, int fr, int fq) const {
        const int row0 = u.pm * 256 + wr * 64 + fr, col0 = u.pn * 256 + wc * 32 + 8 * fq;
        const float sc = u.pn < 4 ? C2 : 1.0f;
        const bool rotw = (wc & 1) == 0 && u.pn < 8;
        const float sgn = fq == 0 ? -1.0f : 1.0f;
#pragma unroll
        for (int ai = 0; ai < 2; ++ai)
#pragma unroll
            for (int m = 0; m < 4; ++m) { const int row = row0 + ai * 128 + m * 16; bf16* rowp = O + (size_t)row * 3072 + col0;
                f32x4 c0 = (f32x4){1.f, 1.f, 1.f, 1.f}, c1 = c0, s0 = (f32x4){0.f, 0.f, 0.f, 0.f}, s1 = s0;
                if (rotw && fq < 2) { const float* cp = CS + (size_t)row * 16; c0 = *(const f32x4*)(cp); c1 = *(const f32x4*)(cp + 4); s0 = *(const f32x4*)(cp + 8) * sgn; s1 = *(const f32x4*)(cp + 12) * sgn; }
#pragma unroll
                for (int bj = 0; bj < 2; ++bj) { f32x4 v0 = acc[ai][bj][m][0], v1 = acc[ai][bj][m][1];
                    if (rotw) { f32x4 p0, p1;
#pragma unroll
                        for (int e = 0; e < 4; ++e) { p0[e] = __shfl_xor(v0[e], 16); p1[e] = __shfl_xor(v1[e], 16); }
                        v0 = v0 * c0 + p0 * s0; v1 = v1 * c1 + p1 * s1; }
                    v0 = v0 * sc; v1 = v1 * sc;
                    v4u w; w.x = pg8::cvt_pk_bf16(v0[0], v0[1]); w.y = pg8::cvt_pk_bf16(v0[2], v0[3]); w.z = pg8::cvt_pk_bf16(v1[0], v1[1]); w.w = pg8::cvt_pk_bf16(v1[2], v1[3]);
                    *(v4u*)(rowp + bj * 128) = w; } }
    }
};

__device__ __forceinline__ void p0_transpose_item(const float* W, int K, int N, bf16* WT, LAS float* scr, int item, int lane) {
    const int nblk = N / 32, kb = item / nblk, nb = item % nblk, k0 = 64 * kb, n0 = 32 * nb;
#pragma unroll 8
    for (int i = 0; i < 32; ++i) { const int kk = 2 * i + (lane >> 5); scr[kk * 33 + (lane & 31)] = W[(size_t)(k0 + kk) * N + n0 + (lane & 31)]; }
    LDS_WAIT(); asm volatile("" ::: "memory");
    const int c = lane & 7;
#pragma unroll
    for (int j = 0; j < 4; ++j) { const int n = (lane >> 3) + 8 * j; const LAS float* s = scr + (8 * c) * 33 + n;
        v4u o; o.x = pk2(s[0 * 33], s[1 * 33]); o.y = pk2(s[2 * 33], s[3 * 33]); o.z = pk2(s[4 * 33], s[5 * 33]); o.w = pk2(s[6 * 33], s[7 * 33]);
        *(GAS v4u*)(WT + (size_t)(n0 + n) * K + k0 + 8 * c) = o; }
    LDS_WAIT(); asm volatile("" ::: "memory");
}
typedef float f32x2 __attribute__((ext_vector_type(2)));
__device__ __forceinline__ void convert_tables(const Params& P, const Ctx& C) {
    const int gw = C.vcu * NWAVES + C.wave, NGW = C.G * NWAVES, lane = C.lane;
    for (int row = gw; row < 4 * 16384; row += NGW) {
        const int tb = row >> 14, e = row & 16383;
        const float* src = ((tb & 1) ? P.peer_up : P.peer_down) + ((size_t)(tb >> 1) * 16384 + e) * 1024;
        unsigned char* dst = P.ws + WS_TAB8 + (size_t)tb * TAB8_BYTES + (size_t)e * TROW;
        f32x4 v[4]; float mx = 0.f;
#pragma unroll
        for (int j = 0; j < 4; ++j) { v[j] = ((const f32x4*)src)[64 * j + lane]; mx = fmaxf(mx, fmaxf(fmaxf(fabsf(v[j][0]), fabsf(v[j][1])), fmaxf(fabsf(v[j][2]), fabsf(v[j][3])))); }
#pragma unroll
        for (int o = 1; o < 64; o <<= 1) mx = fmaxf(mx, __shfl_xor(mx, o));
        const float sc = mx > 0.f ? 400.0f / mx : 0.f;
#pragma unroll
        for (int j = 0; j < 4; ++j) { int p = __builtin_amdgcn_cvt_pk_fp8_f32(v[j][0] * sc, v[j][1] * sc, 0, false); p = __builtin_amdgcn_cvt_pk_fp8_f32(v[j][2] * sc, v[j][3] * sc, p, true);
            ((unsigned*)dst)[64 * j + lane] = (unsigned)p; }
        if (lane == 0) ((float*)(P.ws + WS_SC8))[row] = mx * (1.0f / 400.0f);
    }
}
__device__ __forceinline__ void phase_prologue(const Params& P, const Ctx& C) {
    float* MOD = (float*)(P.ws + WS_MOD);
    {
        LAS float* cond = (LAS float*)C.lds;
        LAS float* part = (LAS float*)(C.lds + 32768);
        for (int e = C.tid; e < 8192; e += 512) cond[e] = silu_f(P.c[e]);
        __syncthreads();
        for (int item = C.vcu; item < 192; item += C.G) {
            const int l = item / 96, cb = item % 96, col = cb * 64 + C.lane;
            float acc[8];
#pragma unroll
            for (int b = 0; b < 8; ++b) acc[b] = 0.f;
            const float* wp = P.ada_w + ((size_t)l * 1024 + C.wave * 128) * 6144 + col;
#pragma unroll 4
            for (int k = 0; k < 128; ++k) { const float wv = wp[(size_t)k * 6144];
#pragma unroll
                for (int b = 0; b < 8; ++b) acc[b] += cond[b * 1024 + C.wave * 128 + k] * wv; }
#pragma unroll
            for (int b = 0; b < 8; ++b) part[(C.wave * 8 + b) * 64 + C.lane] = acc[b];
            __syncthreads();
            { const int b = C.tid >> 6, ln = C.tid & 63; float s = P.ada_b[l * 6144 + cb * 64 + ln];
#pragma unroll
              for (int w = 0; w < 8; ++w) s += part[(w * 8 + b) * 64 + ln];
              MOD[(size_t)(l * 8 + b) * 6144 + cb * 64 + ln] = s; }
            __syncthreads();
        }
        __syncthreads();
    }
    {
        LAS float* scr = (LAS float*)(C.lds + C.wave * 16384);
        const int gw = C.vcu * NWAVES + C.wave, NGW = C.G * NWAVES;
        for (int it = gw; it < 6144; it += NGW) {
            int r = it;
            if (r < 1536) { p0_transpose_item(P.even_w_in, 1024, 3072, (bf16*)(P.ws + WS_WIN), scr, r, C.lane); continue; } r -= 1536;
            if (r < 512)  { p0_transpose_item(P.even_w_out, 1024, 1024, (bf16*)(P.ws + WS_WOUT0), scr, r, C.lane); continue; } r -= 512;
            if (r < 1536) { p0_transpose_item(P.odd_w_qkv, 1024, 3072, (bf16*)(P.ws + WS_WQKV), scr, r, C.lane); continue; } r -= 1536;
            if (r < 512)  { p0_transpose_item(P.odd_w_out, 1024, 1024, (bf16*)(P.ws + WS_WOUT1), scr, r, C.lane); continue; } r -= 512;
            if (r < 1024) { p0_transpose_item(P.peer_w_query, 1024, 2048, (bf16*)(P.ws + WS_WQ0), scr, r, C.lane); continue; } r -= 1024;
            p0_transpose_item(P.peer_w_query + (size_t)1024 * 2048, 1024, 2048, (bf16*)(P.ws + WS_WQ1), scr, r, C.lane);
        }
    }
    convert_tables(P, C);
    const int NT = C.G * 512, gt = C.vcu * 512 + C.tid;
    { bf16* skb = (bf16*)(P.ws + WS_SKB); for (int i = gt; i < 65536; i += NT) skb[i] = (bf16)f2bf(P.peer_sub_keys[i]); }
    { bf16* wsb = (bf16*)(P.ws + WS_WSB); for (int i = gt; i < 65536; i += NT) { const int t = (i >> 7) & 127, s = i & 127; wsb[i] = (bf16)(s <= t ? f2bf(P.gmlp_w_s[i]) : 0u); } }
    { float* lb = (float*)(P.ws + WS_LB); for (int i = gt; i < 512; i += NT) { const float l0 = P.hgrn_lb_logits[i], l1 = P.hgrn_lb_logits[512 + i]; lb[i] = 1.0f / (1.0f + expf(l1 - l0)); } }
    { float* cs = (float*)(P.ws + WS_CS); for (int i = gt; i < T * 8; i += NT) { const int tok = i >> 3, j = i & 7;
        const float inv = 1.0f / powf(500000.0f, (float)j * 0.125f); const float ang = (float)P.positions[tok] * inv; float sn, cn; sincosf(ang, &sn, &cn);
        cs[(size_t)tok * 16 + j] = cn; cs[(size_t)tok * 16 + 8 + j] = sn; } }
}
__device__ __forceinline__ void norm_row_bf16(const float* xrow, bf16* hrow, const float* g, const float* sh, const float* sc, int lane) {
    const f32x4* xr = (const f32x4*)xrow + lane; f32x4 v[4]; float s = 0.f;
#pragma unroll
    for (int j = 0; j < 4; ++j) { v[j] = xr[64 * j]; s += (v[j][0] * v[j][0] + v[j][1] * v[j][1]) + (v[j][2] * v[j][2] + v[j][3] * v[j][3]); }
    const float rstd = 1.0f / sqrtf(wave_sum(s) * (1.0f / 1024.0f) + NORM_EPS);
    unsigned long long* o8 = (unsigned long long*)hrow + lane;
#pragma unroll
    for (int j = 0; j < 4; ++j) { const f32x4 gg = ((const f32x4*)g)[64 * j + lane], hh = ((const f32x4*)sh)[64 * j + lane], cc = ((const f32x4*)sc)[64 * j + lane];
        const f32x4 y = (v[j] * rstd * gg) * (cc + 1.0f) + hh;
        o8[64 * j] = (unsigned long long)pk2(y[0], y[1]) | ((unsigned long long)pk2(y[2], y[3]) << 32); }
}
__device__ __forceinline__ void phase_norm(const Params& P, const Ctx& C, const Wk& W, const float* xsrc, const float* g, int l, int so) {
    const float* MOD = (const float*)(P.ws + WS_MOD); bf16* H = (bf16*)(P.ws + WS_H);
    const int gw = W.lv * NWAVES + C.wave, NGW = W.n * NWAVES;
    for (int m = W_TK0(W) + gw; m < W_TK0(W) + HT; m += NGW) { const float* mb = MOD + (size_t)(l * 8 + (m >> 13)) * 6144 + so;
        norm_row_bf16(xsrc + (size_t)m * 1024, H + (size_t)m * 1024, g, mb, mb + 1024, C.lane); }
}

__device__ __forceinline__ void gmlp_item(const Params& P, const Ctx& C, const Wk& W, int n, int g) {
    LAS bf16* Wt = (LAS bf16*)C.lds;
    LAS bf16* vT = (LAS bf16*)(C.lds + 34816);
    const bf16* WSB = (const bf16*)(P.ws + WS_WSB); const bf16* PU = w_tok16(P, W, AR_PU, 512); const bf16* PV = w_tok16(P, W, AR_PV, 512); bf16* MIX = (bf16*)(P.ws + WS_H);
    const int tid = C.tid, r = C.lane & 15, q4 = C.lane >> 4;
    for (int ch = tid; ch < 2048; ch += 512) { const int rr = ch >> 4, c8 = (ch & 15) * 8; *(LAS v4u*)(Wt + rr * 136 + c8) = *(const v4u*)(WSB + (size_t)(g * 128 + rr) * 128 + c8); }
    { const int t = tid >> 2, part = tid & 3; const bf16* src = PV + (size_t)(n * 128 + t) * 512 + g * 128 + part * 32;
      float x[32];
#pragma unroll
      for (int j = 0; j < 4; ++j) { const v4u w = *(const v4u*)(src + 8 * j);
#pragma unroll
          for (int e = 0; e < 4; ++e) { x[8 * j + 2 * e] = bflo(w[e]); x[8 * j + 2 * e + 1] = bfhi(w[e]); } }
      float s = 0.f;
#pragma unroll
      for (int j = 0; j < 32; ++j) s += x[j];
      s += __shfl_xor(s, 1); s += __shfl_xor(s, 2);
      const float mean = s * (1.0f / 128.0f); float q = 0.f;
#pragma unroll
      for (int j = 0; j < 32; ++j) { const float d = x[j] - mean; q += d * d; }
      q += __shfl_xor(q, 1); q += __shfl_xor(q, 2);
      const float rstd = 1.0f / sqrtf(q * (1.0f / 128.0f) + NORM_EPS);
      const float* lg = P.gmlp_ln_g + g * 128 + part * 32; const float* lbp = P.gmlp_ln_b + g * 128 + part * 32;
#pragma unroll
      for (int j = 0; j < 32; ++j) vT[(part * 32 + j) * 136 + t] = (bf16)f2bf((x[j] - mean) * rstd * lg[j] + lbp[j]);
    }
    __syncthreads();
    const int t0 = 16 * C.wave; const int Keff = ((t0 + 16 + 31) >> 5) << 5;
    f32x4 acc[8];
#pragma unroll
    for (int ct = 0; ct < 8; ++ct) { acc[ct] = (f32x4){0.f, 0.f, 0.f, 0.f}; acc[ct] = mma16(acc[ct], Wt + t0 * 136, 136, vT + (16 * ct) * 136, 136, Keff, r, q4); }
#pragma unroll
    for (int i = 0; i < 4; ++i) { const int t = t0 + 4 * q4 + i; const float bs = P.gmlp_b_s[g * 128 + t]; const size_t tok = (size_t)n * 128 + t;
#pragma unroll
        for (int ct = 0; ct < 8; ++ct) { const int c = 16 * ct + r; const float u = bf2f(PU[tok * 512 + g * 128 + c]); MIX[tok * 1024 + g * 128 + c] = (bf16)f2bf(u * (acc[ct][i] + bs)); } }
    __syncthreads();
}
__device__ __forceinline__ void hgrn_cumsum16(const float* G, size_t tok0, int hh, int k, int seg, LAS float* tot, float (&g)[16], float (&bb)[16], float& total) {
    const float* gp = G + (tok0 + seg * 16) * 512 + hh * 128 + k;
#pragma unroll
    for (int j = 0; j < 16; ++j) g[j] = gp[(size_t)j * 512];
    float run = 0.f;
#pragma unroll
    for (int j = 0; j < 16; ++j) { run += g[j]; bb[j] = run; }
    tot[seg * 128 + k] = run;
    __syncthreads();
    const float t0 = tot[k], t1 = tot[128 + k], t2 = tot[256 + k], t3 = tot[384 + k];
    const float pre = seg == 0 ? 0.f : seg == 1 ? t0 : seg == 2 ? t0 + t1 : t0 + t1 + t2;
    total = (t0 + t1) + (t2 + t3);
#pragma unroll
    for (int j = 0; j < 16; ++j) bb[j] += pre;
}
__device__ __forceinline__ void hgrn_stage_iT(const bf16* PI, size_t tok0, int hh, LAS bf16* iT, int tid) {
    const int s = tid >> 3, v0 = (tid & 7) * 16; const bf16* src = PI + (tok0 + s) * 512 + hh * 128 + v0;
#pragma unroll
    for (int h2 = 0; h2 < 2; ++h2) { const v4u w = *(const v4u*)(src + 8 * h2);
#pragma unroll
        for (int e = 0; e < 4; ++e) { iT[(v0 + 8 * h2 + 2 * e) * 72 + s] = (bf16)(w[e] & 0xffffu); iT[(v0 + 8 * h2 + 2 * e + 1) * 72 + s] = (bf16)(w[e] >> 16); } }
}
__device__ __forceinline__ void hgrn_local_item(const Params& P, const Ctx& C, const Wk& W, int item) {
    LAS bf16* khT = (LAS bf16*)C.lds;
    LAS bf16* iT = (LAS bf16*)(C.lds + 18432);
    LAS float* tot = (LAS float*)(C.lds + 36864);
    const float* G = w_tok32(P, W, AR_G, 512); const bf16* PI = w_tok16(P, W, AR_PI, 512); bf16* KVT = w_item16(P, W, AR_KVT); float* HD = (float*)(P.ws + WS_HD);
    const int bh = item >> 7, c = item & 127, b = bh >> 2, hh = bh & 3; const size_t tok0 = (size_t)b * SEQ + c * 64;
    const int tid = C.tid, k = tid & 127, seg = tid >> 7, r = C.lane & 15, q4 = C.lane >> 4;
    float g[16], bb[16], total;
    hgrn_cumsum16(G, tok0, hh, k, seg, tot, g, bb, total);
    { unsigned w[8];
#pragma unroll
      for (int j = 0; j < 8; ++j) { const float a0 = -expm1f(g[2 * j]) * __expf(total - bb[2 * j]), a1 = -expm1f(g[2 * j + 1]) * __expf(total - bb[2 * j + 1]); w[j] = pk2(a0, a1); }
      LAS v4u* dst = (LAS v4u*)(khT + k * 72 + seg * 16); dst[0] = (v4u){w[0], w[1], w[2], w[3]}; dst[1] = (v4u){w[4], w[5], w[6], w[7]}; }
    if (seg == 0) HD[(size_t)item * 128 + k] = __expf(total);
    hgrn_stage_iT(PI, tok0, hh, iT, tid);
    __syncthreads();
    const int v0 = 16 * C.wave;
#pragma unroll
    for (int ct = 0; ct < 8; ++ct) { f32x4 acc = (f32x4){0.f, 0.f, 0.f, 0.f}; acc = mma16(acc, iT + v0 * 72, 72, khT + (16 * ct) * 72, 72, 64, r, q4);
#pragma unroll
        for (int i = 0; i < 4; ++i) KVT[((size_t)item * 128 + v0 + 4 * q4 + i) * 128 + 16 * ct + r] = (bf16)f2bf(acc[i]); }
    __syncthreads();
}
__device__ __forceinline__ void phase_hgrn_scan(const Params& P, const Ctx& C, const Wk& W) {
    const bf16* KVT = w_item16(P, W, AR_KVT); bf16* ST = w_item16(P, W, AR_ST); const float* HD = (const float*)(P.ws + WS_HD);
    for (int task = W.lv * 256 + C.tid; C.tid < 256 && task < 32768; task += W.n * 256) {
        const int bh = W_BT0(W) * 4 + (task >> 11), v = (task >> 4) & 127, kb = task & 15;
        float st[8];
#pragma unroll
        for (int e = 0; e < 8; ++e) st[e] = 0.f;
#pragma unroll 4
        for (int c = 0; c < 128; ++c) { const size_t item = (size_t)bh * 128 + c, off = (item * 128 + v) * 128 + kb * 8;
            const v4u kv = *(const v4u*)(KVT + off); const f32x4 d0 = *(const f32x4*)(HD + item * 128 + kb * 8), d1 = *(const f32x4*)(HD + item * 128 + kb * 8 + 4);
            v4u o; o.x = pk2(st[0], st[1]); o.y = pk2(st[2], st[3]); o.z = pk2(st[4], st[5]); o.w = pk2(st[6], st[7]);
            *(v4u*)(ST + off) = o;
#pragma unroll
            for (int e = 0; e < 4; ++e) { st[2 * e] = (e < 2 ? d0[2 * e] : d1[2 * e - 4]) * st[2 * e] + bflo(kv[e]); st[2 * e + 1] = (e < 2 ? d0[2 * e + 1] : d1[2 * e - 3]) * st[2 * e + 1] + bfhi(kv[e]); }
        }
    }
}
__device__ __forceinline__ void hgrn_out_item(const Params& P, const Ctx& C, const Wk& W, int item) {
    LAS bf16* qt = (LAS bf16*)C.lds;
    LAS bf16* kt = (LAS bf16*)(C.lds + 17408);
    LAS bf16* iT = (LAS bf16*)(C.lds + 34816);
    LAS bf16* A1 = (LAS bf16*)(C.lds + 53248);
    LAS bf16* STl = (LAS bf16*)(C.lds + 62464);
    LAS float* ol = (LAS float*)(C.lds + 97280);
    LAS float* tot = (LAS float*)(C.lds + 131072);
    const float* G = w_tok32(P, W, AR_G, 512); const bf16* PQ = w_tok16(P, W, AR_PQ, 512); const bf16* PI = w_tok16(P, W, AR_PI, 512); const bf16* PG = w_tok16(P, W, AR_PG, 512);
    const bf16* ST = w_item16(P, W, AR_ST); bf16* MIX = (bf16*)(P.ws + WS_H);
    const int bh = item >> 7, c = item & 127, b = bh >> 2, hh = bh & 3; const size_t tok0 = (size_t)b * SEQ + c * 64;
    const int tid = C.tid, k = tid & 127, seg = tid >> 7, r = C.lane & 15, q4 = C.lane >> 4;
    float g[16], bb[16], total;
    hgrn_cumsum16(G, tok0, hh, k, seg, tot, g, bb, total);
#pragma unroll
    for (int j = 0; j < 16; ++j) { const int t = seg * 16 + j; const float qv = bf2f(PQ[(tok0 + t) * 512 + hh * 128 + k]);
        qt[t * 136 + k] = (bf16)f2bf(qv * __expf(bb[j])); kt[t * 136 + k] = (bf16)f2bf(-expm1f(g[j]) * __expf(-bb[j])); }
    hgrn_stage_iT(PI, tok0, hh, iT, tid);
    for (int ch = tid; ch < 2048; ch += 512) { const int rr = ch >> 4, c8 = (ch & 15) * 8; *(LAS v4u*)(STl + rr * 136 + c8) = *(const v4u*)(ST + ((size_t)item * 128 + rr) * 128 + c8); }
    __syncthreads();
    { const int rt = C.wave >> 1;
#pragma unroll
      for (int cc = 0; cc < 2; ++cc) { const int ct = (C.wave & 1) * 2 + cc; f32x4 acc = (f32x4){0.f, 0.f, 0.f, 0.f};
          acc = mma16(acc, qt + (16 * rt) * 136, 136, kt + (16 * ct) * 136, 136, 128, r, q4);
#pragma unroll
          for (int i = 0; i < 4; ++i) { const int t = 16 * rt + 4 * q4 + i, s = 16 * ct + r; A1[t * 72 + s] = (bf16)(s <= t ? f2bf(acc[i]) : 0u); } } }
    __syncthreads();
    { const int rt = C.wave >> 1;
#pragma unroll
      for (int cc = 0; cc < 4; ++cc) { const int ct = (C.wave & 1) * 4 + cc; f32x4 acc = (f32x4){0.f, 0.f, 0.f, 0.f};
          acc = mma16(acc, A1 + (16 * rt) * 72, 72, iT + (16 * ct) * 72, 72, 64, r, q4);
          acc = mma16(acc, qt + (16 * rt) * 136, 136, STl + (16 * ct) * 136, 136, 128, r, q4);
#pragma unroll
          for (int i = 0; i < 4; ++i) ol[(16 * rt + 4 * q4 + i) * 132 + 16 * ct + r] = acc[i]; } }
    __syncthreads();
    { const int t = tid >> 3, v0 = (tid & 7) * 16; float o[16]; float ss = 0.f;
#pragma unroll
      for (int e = 0; e < 16; ++e) { o[e] = ol[t * 132 + v0 + e]; ss += o[e] * o[e]; }
      ss += __shfl_xor(ss, 1); ss += __shfl_xor(ss, 2); ss += __shfl_xor(ss, 4);
      const float rstd = 1.0f / sqrtf(ss * (1.0f / 128.0f) + NORM_EPS);
      const float* ng = P.hgrn_norm_g + hh * 128 + v0; const bf16* gp = PG + (tok0 + t) * 512 + hh * 128 + v0;
      const v4u g0 = *(const v4u*)gp, g1 = *(const v4u*)(gp + 8); unsigned w[8];
#pragma unroll
      for (int e = 0; e < 4; ++e) { w[e] = pk2(o[2 * e] * rstd * ng[2 * e] * bflo(g0[e]), o[2 * e + 1] * rstd * ng[2 * e + 1] * bfhi(g0[e]));
                                    w[4 + e] = pk2(o[8 + 2 * e] * rstd * ng[8 + 2 * e] * bflo(g1[e]), o[9 + 2 * e] * rstd * ng[9 + 2 * e] * bfhi(g1[e])); }
      v4u* dst = (v4u*)(MIX + (tok0 + t) * 1024 + 512 + hh * 128 + v0); dst[0] = (v4u){w[0], w[1], w[2], w[3]}; dst[1] = (v4u){w[4], w[5], w[6], w[7]}; }
    __syncthreads();
}

typedef short v4i16_t __attribute__((ext_vector_type(4)));
constexpr int AT_VP = 144;
constexpr int AT_QI = 512;
constexpr int AT_STO = 0, AT_STML = AT_QI * 128, AT_VW = AT_STML + AT_QI * 8;
__device__ __forceinline__ void attn_softmax_block(f32x4 (&sa)[9], int tile0, int qq, int mq0, int q4, float& mx, float& ls, bf16x8 (&pf)[5]) {
    mx = -1e30f;
#pragma unroll
    for (int t = 0; t < 9; ++t)
#pragma unroll
        for (int i = 0; i < 4; ++i) { const int kap = 16 * (tile0 + t) + 4 * q4 + i; const bool ok = kap >= qq && kap <= qq + 128 && (mq0 - 128 + kap) >= 0;
            sa[t][i] = ok ? sa[t][i] : -1e30f; mx = fmaxf(mx, sa[t][i]); }
    mx = fmaxf(mx, __shfl_xor(mx, 16)); mx = fmaxf(mx, __shfl_xor(mx, 32));
    ls = 0.f;
#pragma unroll
    for (int t = 0; t < 9; ++t)
#pragma unroll
        for (int i = 0; i < 4; ++i) { const float pv = sa[t][i] > -1e29f ? __builtin_amdgcn_exp2f(sa[t][i] - mx) : 0.f; sa[t][i] = pv; ls += pv; }
    ls += __shfl_xor(ls, 16); ls += __shfl_xor(ls, 32);
#pragma unroll
    for (int s2 = 0; s2 < 5; ++s2) { const int tl = 2 * s2 - tile0, th = 2 * s2 + 1 - tile0;
        const f32x4 lo = (tl >= 0 && tl < 9) ? sa[(tl >= 0 && tl < 9) ? tl : 0] : (f32x4){0.f, 0.f, 0.f, 0.f}, hi = (th >= 0 && th < 9) ? sa[(th >= 0 && th < 9) ? th : 0] : (f32x4){0.f, 0.f, 0.f, 0.f};
        v4u w; w.x = pk2(lo[0], lo[1]); w.y = pk2(lo[2], lo[3]); w.z = pk2(hi[0], hi[1]); w.w = pk2(hi[2], hi[3]); pf[s2] = __builtin_bit_cast(bf16x8, w); }
}
__device__ __forceinline__ void attn_merge(int g, LAS unsigned char* lds, int qloc, int q4, f32x4 (&oa)[4], float mx, float ls, bf16* orow) {
    LAS unsigned char* so = lds + AT_STO + qloc * 128 + 8 * q4; LAS float* sml = (LAS float*)(lds + AT_STML) + 2 * qloc;
    float mo = mx, lo2 = ls;
    if (g > 0) { const float m_old = sml[0], l_old = sml[1]; const float M = fmaxf(m_old, mx); const float fo = __builtin_amdgcn_exp2f(m_old - M), fn = __builtin_amdgcn_exp2f(mx - M);
#pragma unroll
        for (int dt = 0; dt < 4; ++dt) { const unsigned long long w = *(const LAS unsigned long long*)(so + 32 * dt); const unsigned w0 = (unsigned)w, w1 = (unsigned)(w >> 32);
            oa[dt] = oa[dt] * fn + (f32x4){bflo(w0), bfhi(w0), bflo(w1), bfhi(w1)} * fo; }
        mo = M; lo2 = ls * fn + l_old * fo; }
    if (g < 2) {
#pragma unroll
        for (int dt = 0; dt < 4; ++dt) *(LAS unsigned long long*)(so + 32 * dt) = (unsigned long long)pk2(oa[dt][0], oa[dt][1]) | ((unsigned long long)pk2(oa[dt][2], oa[dt][3]) << 32);
        if (q4 == 0) { sml[0] = mo; sml[1] = lo2; }
    } else { const float inv = 1.0f / lo2;
#pragma unroll
        for (int dt = 0; dt < 4; ++dt) { const f32x4 v = oa[dt] * inv; *(unsigned long long*)(orow + 16 * dt) = (unsigned long long)pk2(v[0], v[1]) | ((unsigned long long)pk2(v[2], v[3]) << 32); } }
}
__device__ __forceinline__ void attn_item(const Params& P, const Ctx& C, const Wk& W, int b, int hd, int qt) {
    LAS unsigned char* Vw = C.lds + AT_VW + C.wave * (64 * AT_VP);
    const bf16* QKV = w_tok16(P, W, AR_QK, 3072); bf16* O = (bf16*)(P.ws + WS_H);
    const int lane = C.lane, r = lane & 15, q4 = lane >> 4;
    const int t0 = qt * AT_QI; const size_t rowbase = (size_t)b * SEQ;
    const bf16* Kb = QKV + rowbase * 3072 + 1024 + hd * 64; const bf16* Vb = QKV + rowbase * 3072 + 2048 + hd * 64;
#pragma unroll 1
    for (int g = 0; g < 3; ++g) {
        const int dsh = 4 - 2 * g, d = 1 << dsh;
#pragma unroll 1
        for (int uu = 0; uu < 2; ++uu) {
            const int u = C.wave + 8 * uu;
            const int c = u & (d - 1), j = u >> dsh;
            const int mq0 = (t0 >> dsh) + 32 * j;
            const int ql0 = c + d * (32 * j + r), ql1 = ql0 + 16 * d;
            const bf16* qp0 = QKV + (rowbase + t0 + ql0) * 3072 + hd * 64 + 8 * q4; const bf16* qp1 = QKV + (rowbase + t0 + ql1) * 3072 + hd * 64 + 8 * q4;
            const bf16x8 bq00 = *(const bf16x8*)qp0, bq01 = *(const bf16x8*)(qp0 + 32), bq10 = *(const bf16x8*)qp1, bq11 = *(const bf16x8*)(qp1 + 32);
            bf16x8 ka[10][2];
#pragma unroll
            for (int t = 0; t < 10; ++t) { int mk = mq0 - 128 + 16 * t + r; mk = mk < 0 ? 0 : mk;
                const bf16* kp = Kb + (size_t)(c + d * mk) * 3072 + 8 * q4; ka[t][0] = *(const bf16x8*)kp; ka[t][1] = *(const bf16x8*)(kp + 32); }
            v4u vr[2][8];
#pragma unroll
            for (int it = 0; it < 8; ++it) { const int kap = 8 * it + (lane >> 3); int mk = mq0 - 128 + kap; mk = mk < 0 ? 0 : mk;
                vr[0][it] = *(const v4u*)(Vb + (size_t)(c + d * mk) * 3072 + (lane & 7) * 8); }
            __builtin_amdgcn_sched_barrier(0);
            bf16x8 pf0[5], pf1[5]; float mx0, ls0, mx1, ls1;
            { f32x4 sa[9];
#pragma unroll
              for (int t = 0; t < 9; ++t) { sa[t] = (f32x4){0.f, 0.f, 0.f, 0.f}; sa[t] = __builtin_amdgcn_mfma_f32_16x16x32_bf16(ka[t][0], bq00, sa[t], 0, 0, 0); sa[t] = __builtin_amdgcn_mfma_f32_16x16x32_bf16(ka[t][1], bq01, sa[t], 0, 0, 0); }
              attn_softmax_block(sa, 0, r, mq0, q4, mx0, ls0, pf0); }
            { f32x4 sa[9];
#pragma unroll
              for (int t = 0; t < 9; ++t) { sa[t] = (f32x4){0.f, 0.f, 0.f, 0.f}; sa[t] = __builtin_amdgcn_mfma_f32_16x16x32_bf16(ka[t + 1][0], bq10, sa[t], 0, 0, 0); sa[t] = __builtin_amdgcn_mfma_f32_16x16x32_bf16(ka[t + 1][1], bq11, sa[t], 0, 0, 0); }
              __builtin_amdgcn_sched_barrier(0);
#pragma unroll
              for (int it = 0; it < 8; ++it) { const int kap = 64 + 8 * it + (lane >> 3); int mk = mq0 - 128 + kap; mk = mk < 0 ? 0 : mk;
                  vr[1][it] = *(const v4u*)(Vb + (size_t)(c + d * mk) * 3072 + (lane & 7) * 8); }
              __builtin_amdgcn_sched_barrier(0);
              attn_softmax_block(sa, 1, 16 + r, mq0, q4, mx1, ls1, pf1); }
            v4u vr2[4];
#pragma unroll
            for (int it = 0; it < 4; ++it) { const int kap = 128 + 8 * it + (lane >> 3); const int mk = mq0 - 128 + kap;
                vr2[it] = *(const v4u*)(Vb + (size_t)(c + d * mk) * 3072 + (lane & 7) * 8); }
            f32x4 oa0[4], oa1[4];
#pragma unroll
            for (int dt = 0; dt < 4; ++dt) { oa0[dt] = (f32x4){0.f, 0.f, 0.f, 0.f}; oa1[dt] = (f32x4){0.f, 0.f, 0.f, 0.f}; }
#pragma unroll
            for (int ch = 0; ch < 3; ++ch) {
#pragma unroll
                for (int it = 0; it < 8; ++it) { const int row = 8 * it + (lane >> 3);
                    if (ch < 2) *(LAS v4u*)(Vw + row * AT_VP + (lane & 7) * 16) = vr[ch < 2 ? ch : 0][it];
                    else if (it < 4) *(LAS v4u*)(Vw + row * AT_VP + (lane & 7) * 16) = vr2[it < 4 ? it : 0]; }
                asm volatile("s_waitcnt lgkmcnt(0)" ::: "memory");
#pragma unroll
                for (int s2 = 0; s2 < 2; ++s2) { const int sx = 2 * ch + s2; if (sx < 5) {
#pragma unroll
                    for (int dt = 0; dt < 4; ++dt) {
                        const LAS unsigned char* vp = Vw + (32 * s2 + 4 * q4 + (r >> 2)) * AT_VP + dt * 32 + (r & 3) * 8;
                        const v4i16_t x = __builtin_amdgcn_ds_read_tr16_b64_v4i16((LAS v4i16_t*)vp), y = __builtin_amdgcn_ds_read_tr16_b64_v4i16((LAS v4i16_t*)(vp + 16 * AT_VP));
                        const bf16x8 av = (bf16x8){x[0], x[1], x[2], x[3], y[0], y[1], y[2], y[3]};
                        oa0[dt] = __builtin_amdgcn_mfma_f32_16x16x32_bf16(av, pf0[sx], oa0[dt], 0, 0, 0);
                        oa1[dt] = __builtin_amdgcn_mfma_f32_16x16x32_bf16(av, pf1[sx], oa1[dt], 0, 0, 0); } } }
                asm volatile("s_waitcnt lgkmcnt(0)" ::: "memory");
            }
            attn_merge(g, C.lds, ql0, q4, oa0, mx0, ls0, O + (rowbase + t0 + ql0) * 1024 + hd * 64 + 4 * q4);
            attn_merge(g, C.lds, ql1, q4, oa1, mx1, ls1, O + (rowbase + t0 + ql1) * 1024 + hd * 64 + 4 * q4);
        }
        __syncthreads();
    }
}

__device__ __forceinline__ unsigned ordf(float s) { const unsigned u = __builtin_bit_cast(unsigned, s); return u ^ ((unsigned)((int)u >> 31) | 0x80000000u); }
__device__ __forceinline__ float unordf(unsigned v) { return __builtin_bit_cast(float, v ^ ((unsigned)((int)(~v) >> 31) | 0x80000000u)); }
__device__ __forceinline__ void ins16(unsigned (&top)[16], unsigned x) {
#pragma unroll
    for (int j = 0; j < 16; ++j) { const unsigned hi = top[j] > x ? top[j] : x; x = top[j] > x ? x : top[j]; top[j] = hi; }
}
#define CE_D(a, b) { const unsigned hi_ = (a) > (b) ? (a) : (b), lo_ = (a) > (b) ? (b) : (a); (a) = hi_; (b) = lo_; }
__device__ __forceinline__ void sort16_desc(unsigned (&v)[16]) {
#pragma unroll
    for (int k = 2; k <= 16; k <<= 1)
#pragma unroll
        for (int j = k >> 1; j > 0; j >>= 1)
#pragma unroll
            for (int i = 0; i < 16; ++i) { const int l = i ^ j; if (l > i) { if ((i & k) == 0) CE_D(v[i], v[l]) else CE_D(v[l], v[i]) } }
}
__device__ __forceinline__ void bitonic_merge16_desc(unsigned (&c)[16]) {
#pragma unroll
    for (int st = 8; st >= 1; st >>= 1)
#pragma unroll
        for (int j = 0; j < 16; ++j) if ((j & st) == 0) CE_D(c[j], c[j + st])
}
__device__ __forceinline__ void top16_of_two(unsigned (&a)[16], const unsigned (&b)[16]) {
#pragma unroll
    for (int j = 0; j < 16; ++j) a[j] = a[j] > b[15 - j] ? a[j] : b[15 - j];
    bitonic_merge16_desc(a);
}
__device__ __forceinline__ void merge16(unsigned (&top)[16], int mask) {
    unsigned o[16];
#pragma unroll
    for (int j = 0; j < 16; ++j) o[j] = (unsigned)__shfl_xor((int)top[j], mask);
    top16_of_two(top, o);
}
__device__ __forceinline__ void phase_peer_topk(const Params& P, const Ctx& C, const Wk& W, int layer) {
    LAS bf16* SK = (LAS bf16*)C.lds;
    const bf16* SKB = (const bf16*)(P.ws + WS_SKB) + (size_t)layer * 32768; const bf16* QP = w_tok16(P, W, AR_QP, 2048);
    int* IDX = (int*)(P.ws + WS_IDX); float* GATE = (float*)(P.ws + WS_GATE);
    for (int ch = C.tid; ch < 4096; ch += 512) { const int rr = ch >> 4, c8 = (ch & 15) * 8; *(LAS v4u*)(SK + rr * 136 + c8) = *(const v4u*)(SKB + (size_t)rr * 128 + c8); }
    __syncthreads();
    const int r = C.lane & 15, q4 = C.lane >> 4;
    const int gw = W.lv * NWAVES + C.wave, NGW = W.n * NWAVES;
    for (int grp = W_TK0(W) / 2 + gw; grp < W_TK0(W) / 2 + HT * 8 / 16; grp += NGW) {
        const size_t task = (size_t)grp * 16 + r;
        unsigned lst[2][16];
#pragma unroll
        for (int half = 0; half < 2; ++half) {
            bf16x8 bq[4];
#pragma unroll
            for (int ks = 0; ks < 4; ++ks) bq[ks] = *(const bf16x8*)(QP + task * 256 + half * 128 + ks * 32 + 8 * q4);
            unsigned ka[16], kb[16];
#pragma unroll
            for (int nt = 0; nt < 8; ++nt) { f32x4 acc = (f32x4){0.f, 0.f, 0.f, 0.f};
#pragma unroll
                for (int ks = 0; ks < 4; ++ks) { const bf16x8 a = *(const LAS bf16x8*)(SK + (half * 128 + 16 * nt + r) * 136 + ks * 32 + 8 * q4); acc = __builtin_amdgcn_mfma_f32_16x16x32_bf16(a, bq[ks], acc, 0, 0, 0); }
#pragma unroll
                for (int i = 0; i < 4; ++i) { const unsigned n = 16 * nt + 4 * q4 + i; const unsigned key = (ordf(acc[i]) & ~127u) | (127u - n); if (nt < 4) ka[4 * nt + i] = key; else kb[4 * (nt - 4) + i] = key; }
                if (nt == 3) sort16_desc(ka);
                __builtin_amdgcn_sched_barrier(0); }
            sort16_desc(kb); top16_of_two(ka, kb);
            merge16(ka, 16); merge16(ka, 32);
#pragma unroll
            for (int j = 0; j < 16; ++j) lst[half][j] = ka[j];
        }
        float v2[16]; unsigned e2[16];
#pragma unroll
        for (int j = 0; j < 16; ++j) { v2[j] = unordf(lst[1][j] & ~127u); e2[j] = 127u - (lst[1][j] & 127u); }
        float v1s[4]; unsigned e1s[4];
#pragma unroll
        for (int k = 0; k < 4; ++k) { const unsigned w = q4 == 0 ? lst[0][4 * k] : q4 == 1 ? lst[0][4 * k + 1] : q4 == 2 ? lst[0][4 * k + 2] : lst[0][4 * k + 3];
            v1s[k] = unordf(w & ~127u); e1s[k] = (127u - (w & 127u)) << 7; }
        unsigned top[16];
#pragma unroll
        for (int j = 0; j < 16; ++j) top[j] = (ordf(v1s[0] + v2[j]) & ~16383u) | e1s[0] | e2[j];
        sort16_desc(top);
#pragma unroll
        for (int j = 0; j < 3; ++j) ins16(top, (ordf(v1s[1] + v2[j]) & ~16383u) | e1s[1] | e2[j]);
        ins16(top, (ordf(v1s[2] + v2[0]) & ~16383u) | e1s[2] | e2[0]);
        ins16(top, (ordf(v1s[3] + v2[0]) & ~16383u) | e1s[3] | e2[0]);
        merge16(top, 16); merge16(top, 32);
        float ev[16]; float den = 0.f; const float mx = unordf(top[0] & ~16383u);
#pragma unroll
        for (int j = 0; j < 16; ++j) { ev[j] = __expf(unordf(top[j] & ~16383u) - mx); den += ev[j]; }
        const float inv = 1.0f / den;
        int* ip = IDX + task * 16; float* gp = GATE + task * 16;
        if (q4 == 0) { *(v4u*)(ip) = (v4u){top[0] & 16383u, top[1] & 16383u, top[2] & 16383u, top[3] & 16383u}; *(f32x4*)(gp) = (f32x4){ev[0] * inv, ev[1] * inv, ev[2] * inv, ev[3] * inv}; }
        else if (q4 == 1) { *(v4u*)(ip + 4) = (v4u){top[4] & 16383u, top[5] & 16383u, top[6] & 16383u, top[7] & 16383u}; *(f32x4*)(gp + 4) = (f32x4){ev[4] * inv, ev[5] * inv, ev[6] * inv, ev[7] * inv}; }
        else if (q4 == 2) { *(v4u*)(ip + 8) = (v4u){top[8] & 16383u, top[9] & 16383u, top[10] & 16383u, top[11] & 16383u}; *(f32x4*)(gp + 8) = (f32x4){ev[8] * inv, ev[9] * inv, ev[10] * inv, ev[11] * inv}; }
        else { *(v4u*)(ip + 12) = (v4u){top[12] & 16383u, top[13] & 16383u, top[14] & 16383u, top[15] & 16383u}; *(f32x4*)(gp + 12) = (f32x4){ev[12] * inv, ev[13] * inv, ev[14] * inv, ev[15] * inv}; }
    }
}
struct ExpRow { v4u d[4], u[4]; float ds, us, gk; };
__device__ __forceinline__ void exp_issue(ExpRow& R, const unsigned char* TD, const unsigned char* TU, const float* SD, int ex, float gk, int jl) {
    const unsigned char* dr = TD + (size_t)ex * TROW; const unsigned char* ur = TU + (size_t)ex * TROW;
#pragma unroll
    for (int c = 0; c < 4; ++c) R.d[c] = *(const v4u*)(dr + (c * 16 + jl) * 16);
#pragma unroll
    for (int c = 0; c < 4; ++c) R.u[c] = *(const v4u*)(ur + (c * 16 + jl) * 16);
    R.ds = SD[ex]; R.us = SD[16384 + ex]; R.gk = gk;
}
__device__ __forceinline__ void exp_consume(const ExpRow& R, const unsigned (&hp)[32], f32x2 (&oacc)[32]) {
    f32x2 a2 = (f32x2){0.f, 0.f};
#pragma unroll
    for (int c = 0; c < 4; ++c)
#pragma unroll
        for (int w = 0; w < 4; ++w) { const f32x2 lo = __builtin_amdgcn_cvt_pk_f32_fp8((int)R.d[c][w], false), hi = __builtin_amdgcn_cvt_pk_f32_fp8((int)R.d[c][w], true);
            unsigned h0 = hp[c * 8 + 2 * w], h1 = hp[c * 8 + 2 * w + 1]; asm volatile("" : "+v"(h0), "+v"(h1));
            a2 = a2 + lo * (f32x2){bflo(h0), bfhi(h0)}; a2 = a2 + hi * (f32x2){bflo(h1), bfhi(h1)}; }
    float a = (a2.x + a2.y) * R.ds;
    a += __shfl_xor(a, 1); a += __shfl_xor(a, 2); a += __shfl_xor(a, 4); a += __shfl_xor(a, 8);
    const float wk = R.gk * gelu_f(a) * R.us; const f32x2 wk2 = (f32x2){wk, wk};
#pragma unroll
    for (int c = 0; c < 4; ++c)
#pragma unroll
        for (int w = 0; w < 4; ++w) { const f32x2 lo = __builtin_amdgcn_cvt_pk_f32_fp8((int)R.u[c][w], false), hi = __builtin_amdgcn_cvt_pk_f32_fp8((int)R.u[c][w], true);
            oacc[c * 8 + 2 * w] = oacc[c * 8 + 2 * w] + wk2 * lo; oacc[c * 8 + 2 * w + 1] = oacc[c * 8 + 2 * w + 1] + wk2 * hi; }
}
__device__ __forceinline__ void phase_peer_experts(const Params& P, const Ctx& Cin, const Wk& W, int layer, bool last) {
    const Ctx C = fresh_ctx(Cin);
    const unsigned char* TD = P.ws + WS_TAB8 + (size_t)(2 * layer) * TAB8_BYTES; const unsigned char* TU = P.ws + WS_TAB8 + (size_t)(2 * layer + 1) * TAB8_BYTES; const float* SD = (const float*)(P.ws + WS_SC8) + (size_t)(2 * layer) * 16384; bf16* H = (bf16*)(P.ws + WS_H);
    const int* IDX = (const int*)(P.ws + WS_IDX); const float* GATE = (const float*)(P.ws + WS_GATE); const float* MOD = (const float*)(P.ws + WS_MOD);
    const int lane = C.lane, grp = lane >> 4, jl = lane & 15;
    unsigned* ticket = (unsigned*)(P.ws + WS_CTL) + 96 + 2 * layer + W.h;
    int tnext = 0; if (lane == 0) tnext = (int)atomicAdd(ticket, 1u); tnext = __builtin_amdgcn_readfirstlane(tnext);
    while (tnext < HT) {
        const int tok = W_TK0(W) + tnext;
        { int tn = 0; if (lane == 0) tn = (int)atomicAdd(ticket, 1u); tnext = tn; }
        const int b = tok >> 13;
        const int i0 = IDX[(size_t)tok * 128 + lane], i1 = IDX[(size_t)tok * 128 + 64 + lane];
        const float g0 = GATE[(size_t)tok * 128 + lane], g1 = GATE[(size_t)tok * 128 + 64 + lane];
        unsigned hf[32];
#pragma unroll
        for (int c = 0; c < 4; ++c) { const bf16* hp = H + (size_t)tok * 1024 + (c * 16 + jl) * 16; const v4u w0 = *(const v4u*)hp, w1 = *(const v4u*)(hp + 8);
#pragma unroll
            for (int e = 0; e < 4; ++e) { hf[c * 8 + e] = w0[e]; hf[c * 8 + 4 + e] = w1[e]; } }
        f32x2 oacc[32];
#pragma unroll
        for (int e = 0; e < 32; ++e) oacc[e] = (f32x2){0.f, 0.f};
        ExpRow RA, RB;
        exp_issue(RA, TD, TU, SD, __shfl(i0, grp), __shfl(g0, grp), jl);
        for (int it = 0; it < 32 * EXP_REP; it += 2) {
            { const int kk = ((it + 1) & 31) * 4 + grp; const int el = __shfl(i0, kk & 63), eh = __shfl(i1, kk & 63); const float gl = __shfl(g0, kk & 63), gh = __shfl(g1, kk & 63);
              exp_issue(RB, TD, TU, SD, kk < 64 ? el : eh, kk < 64 ? gl : gh, jl); }
            exp_consume(RA, hf, oacc);
            { const int kk = ((it + 2) & 31) * 4 + grp; const int el = __shfl(i0, kk & 63), eh = __shfl(i1, kk & 63); const float gl = __shfl(g0, kk & 63), gh = __shfl(g1, kk & 63);
              exp_issue(RA, TD, TU, SD, kk < 64 ? el : eh, kk < 64 ? gl : gh, jl); }
            exp_consume(RB, hf, oacc);
        }
        f32x2 h1[16];
        { const bool up = (grp & 2) != 0;
#pragma unroll
          for (int e = 0; e < 16; ++e) { const f32x2 keep = up ? oacc[16 + e] : oacc[e], send = up ? oacc[e] : oacc[16 + e]; h1[e] = keep + (f32x2){__shfl_xor(send.x, 32), __shfl_xor(send.y, 32)}; } }
        f32x2 h2[8];
        { const bool up = (grp & 1) != 0;
#pragma unroll
          for (int e = 0; e < 8; ++e) { const f32x2 keep = up ? h1[8 + e] : h1[e], send = up ? h1[e] : h1[8 + e]; h2[e] = keep + (f32x2){__shfl_xor(send.x, 16), __shfl_xor(send.y, 16)}; } }
        const int d0 = (grp * 16 + jl) * 16;
        const float* g2p = MOD + (size_t)(layer * 8 + b) * 6144 + 5120 + d0; const float psc = ((ABL_ON >= (layer == 0 ? 2 : 4)) ? 1.f : 0.f) * (1.0f / EXP_REP);
        float* xp = P.out + (size_t)tok * 1024 + d0;
        float xn[16]; float ss = 0.f;
#pragma unroll
        for (int q = 0; q < 4; ++q) { const f32x4 xa = *(const f32x4*)(xp + 4 * q), ga = *(const f32x4*)(g2p + 4 * q);
            xn[4 * q] = xa[0] + psc * ga[0] * h2[2 * q].x; xn[4 * q + 1] = xa[1] + psc * ga[1] * h2[2 * q].y; xn[4 * q + 2] = xa[2] + psc * ga[2] * h2[2 * q + 1].x; xn[4 * q + 3] = xa[3] + psc * ga[3] * h2[2 * q + 1].y; }
#pragma unroll
        for (int e = 0; e < 16; ++e) ss += xn[e] * xn[e];
        const float rstd = 1.0f / sqrtf(wave_sum(ss) * (1.0f / 1024.0f) + NORM_EPS);
        if (!last) {
            const float* ng = P.norm_mix_g + (layer + 1) * 1024 + d0; const float* mb = MOD + (size_t)((layer + 1) * 8 + b) * 6144 + d0;
            unsigned w[8];
#pragma unroll
            for (int q = 0; q < 4; ++q) { *(f32x4*)(xp + 4 * q) = (f32x4){xn[4 * q], xn[4 * q + 1], xn[4 * q + 2], xn[4 * q + 3]}; }
#pragma unroll
            for (int e = 0; e < 8; ++e) w[e] = pk2(xn[2 * e] * rstd * ng[2 * e] * (1.0f + mb[1024 + 2 * e]) + mb[2 * e], xn[2 * e + 1] * rstd * ng[2 * e + 1] * (1.0f + mb[1024 + 2 * e + 1]) + mb[2 * e + 1]);
            v4u* hp = (v4u*)(H + (size_t)tok * 1024 + d0); hp[0] = (v4u){w[0], w[1], w[2], w[3]}; hp[1] = (v4u){w[4], w[5], w[6], w[7]};
        } else {
            const float* fg = P.final_norm_g + d0;
#pragma unroll
            for (int q = 0; q < 4; ++q) *(f32x4*)(xp + 4 * q) = (f32x4){xn[4 * q] * rstd * fg[4 * q], xn[4 * q + 1] * rstd * fg[4 * q + 1], xn[4 * q + 2] * rstd * fg[4 * q + 2], xn[4 * q + 3] * rstd * fg[4 * q + 3]};
        }
        tnext = __builtin_amdgcn_readfirstlane(tnext);
    }
}

#ifndef NC_PER_XCD
#define NC_PER_XCD 16
#endif
#ifdef PROBE_SEL
#define SUBSTAMP(i) do { if (W.c == 0 && C.tid == 0) __hip_atomic_store((unsigned*)(P.ws + WS_CTL) + 128 + 16 * W.h + (i), (unsigned)__builtin_amdgcn_s_memrealtime(), __ATOMIC_RELAXED, __HIP_MEMORY_SCOPE_AGENT); } while (0)
#else
#define SUBSTAMP(i) do {} while (0)
#endif
__device__ __forceinline__ void run_C0(const Params& P, const Ctx& Cin, const Wk& W, const XcdBarrier& tb) {
    const Ctx C = fresh_ctx(Cin);
    SUBSTAMP(0);
    unsigned char* ws = P.ws; float* MOD = (float*)(ws + WS_MOD); bf16* H = (bf16*)(ws + WS_H);
    const size_t tk = (size_t)W_TK0(W); unsigned char* const ar = w_ar(P, W);
    phase_norm(P, C, W, P.x, P.norm_mix_g, 0, 0); xcd_barrier(tb); SUBSTAMP(1);
    { pg8::Gemm g{H + tk * 1024, (const bf16*)(ws + WS_WIN), HT, 3072, 1024}; pg8::StaticOrder S; S.init(HT, 3072, W.n, W.c);
      EpiInProj E{(bf16*)(ar + AR_PU), (bf16*)(ar + AR_PV), (bf16*)(ar + AR_PQ), (bf16*)(ar + AR_PI), (bf16*)(ar + AR_PG), (float*)(ar + AR_G), (const float*)(ws + WS_LB)};
      pg8::gemm_phase<EpiInProj, pg8::StaticOrder, true, true>(C.lds, g, S, E); } xcd_barrier(tb); SUBSTAMP(2);
    for (int it = W.lv; it < 1024; it += W.n) gmlp_item(P, C, W, W_TK0(W) / 128 + (it >> 2), it & 3);
    for (int it = W.lv; it < 2048; it += W.n) hgrn_local_item(P, C, W, W_BT0(W) * 512 + it);
    xcd_barrier(tb); SUBSTAMP(3);
    phase_hgrn_scan(P, C, W); xcd_barrier(tb); SUBSTAMP(4);
    for (int it = W.lv; it < 2048; it += W.n) hgrn_out_item(P, C, W, W_BT0(W) * 512 + it);
    xcd_barrier(tb); SUBSTAMP(5);
    { pg8::Gemm g{H + tk * 1024, (const bf16*)(ws + WS_WOUT0), HT, 1024, 1024}; pg8::StaticOrder S; S.init(HT, 1024, W.n, W.c);
      EpiResid E{P.x + tk * 1024, P.out + tk * 1024, MOD + 2048 + (size_t)W_BT0(W) * 6144, 1.f};
      pg8::gemm_phase<EpiResid, pg8::StaticOrder, true, true>(C.lds, g, S, E); } xcd_barrier(tb); SUBSTAMP(6);
    phase_norm(P, C, W, P.out, P.norm_ffn_g, 0, 3072); xcd_barrier(tb); SUBSTAMP(7);
    { pg8::Gemm g{H + tk * 1024, (const bf16*)(ws + WS_WQ0), HT, 2048, 1024}; pg8::StaticOrder S; S.init(HT, 2048, W.n, W.c);
      EpiBf16P E{(bf16*)(ar + AR_QP), 2048};
      pg8::gemm_phase<EpiBf16P, pg8::StaticOrder, true, true>(C.lds, g, S, E); }
    SUBSTAMP(9);
}
__device__ __forceinline__ void run_C1(const Params& P, const Ctx& Cin, const Wk& W, const XcdBarrier& tb) {
    const Ctx C = fresh_ctx(Cin);
    SUBSTAMP(0);
    unsigned char* ws = P.ws; float* MOD = (float*)(ws + WS_MOD); bf16* H = (bf16*)(ws + WS_H);
    const size_t tk = (size_t)W_TK0(W); unsigned char* const ar = w_ar(P, W);
    { pg8::Gemm g{H + tk * 1024, (const bf16*)(ws + WS_WQKV), HT, 3072, 1024}; pg8::StaticOrder S; S.init(HT, 3072, W.n, W.c);
      EpiQKRot E{(bf16*)(ar + AR_QK), (const float*)(ws + WS_CS) + tk * 16};
      pg8::gemm_phase<EpiQKRot, pg8::StaticOrder, true, true>(C.lds, g, S, E); } xcd_barrier(tb); SUBSTAMP(1);
    for (int it = W.lv; it < (NB / 2) * 16 * 16; it += W.n) attn_item(P, C, W, W_BT0(W) + (it >> 8), (it >> 4) & 15, it & 15);
    xcd_barrier(tb); SUBSTAMP(2);
    { pg8::Gemm g{H + tk * 1024, (const bf16*)(ws + WS_WOUT1), HT, 1024, 1024}; pg8::StaticOrder S; S.init(HT, 1024, W.n, W.c);
      EpiResid E{P.out + tk * 1024, P.out + tk * 1024, MOD + (size_t)8 * 6144 + 2048 + (size_t)W_BT0(W) * 6144, 1.f};
      pg8::gemm_phase<EpiResid, pg8::StaticOrder, true, true>(C.lds, g, S, E); } xcd_barrier(tb); SUBSTAMP(3);
    phase_norm(P, C, W, P.out, P.norm_ffn_g + 1024, 1, 3072); xcd_barrier(tb); SUBSTAMP(4);
    { pg8::Gemm g{H + tk * 1024, (const bf16*)(ws + WS_WQ1), HT, 2048, 1024}; pg8::StaticOrder S; S.init(HT, 2048, W.n, W.c);
      EpiBf16P E{(bf16*)(ar + AR_QP), 2048};
      pg8::gemm_phase<EpiBf16P, pg8::StaticOrder, true, true>(C.lds, g, S, E); }
    SUBSTAMP(9);
}
__device__ __forceinline__ void run_E(const Params& P, const Ctx& Cin, const Wk& W, const XcdBarrier& tb, int layer) {
    { const Ctx C = fresh_ctx(Cin); phase_peer_topk(P, C, W, layer); }
    xcd_barrier(tb);
    phase_peer_experts(P, Cin, W, layer, layer == 1);
}
__global__ void __launch_bounds__(NWAVES * 64, 2) hybrid_fwd(Params P) {
    extern __shared__ __attribute__((aligned(16))) unsigned char lds_raw[];
    Ctx C;
    C.lds = (LAS unsigned char*)lds_raw;
    C.tid = threadIdx.x; C.lane = C.tid & 63; C.wave = __builtin_amdgcn_readfirstlane(C.tid >> 6);
    C.G = gridDim.x; const int bx = blockIdx.x; C.vcu = (bx % 8) * (C.G / 8) + bx / 8;
    volatile LAS unsigned* MISC = (volatile LAS unsigned*)(C.lds + MISC_OFF);
    for (int u = C.tid; u < (LDS_BYTES - LDSCTL_OFF) / 4; u += NWAVES * 64) ((LAS unsigned*)(C.lds + LDSCTL_OFF))[u] = 0u;
    __syncthreads();
    unsigned* ctl = (unsigned*)(P.ws + WS_CTL);
    const int xl = bx & 7, jx = bx >> 3, perx = C.G / 8;
    const bool inC = jx < NC_PER_XCD;
    const int nC = 8 * NC_PER_XCD, nE = C.G - nC;
    const XcdBarrier bar_all = xcd_barrier_post(ctl + CW_BAR, MISC + 8);
    XcdBarrier bar_c; bar_c.bar = ctl + CW_BAR + XCD_BAR_WORDS; bar_c.x = bar_all.x; bar_c.st = MISC + 10; bar_c.G = (unsigned)nC;
    if (inC && C.tid == 0) (void)xb_add(&bar_c.bar[XB_XCNT(bar_c.x)], 1u);
    XcdBarrier bar_e; bar_e.bar = ctl + CW_BAR + 2 * XCD_BAR_WORDS; bar_e.x = bar_all.x; bar_e.st = MISC + 12; bar_e.G = (unsigned)nE;
    if (!inC && C.tid == 0) (void)xb_add(&bar_e.bar[XB_XCNT(bar_e.x)], 1u);
    Wk Wall; Wall.lv = C.vcu; Wall.n = C.G; Wall.c = bx; Wall.h = 0;
    Wk Wc; Wc.lv = xl * NC_PER_XCD + jx; Wc.n = nC; Wc.c = jx * 8 + xl; Wc.h = 0;
    Wk We; { const int je = jx - NC_PER_XCD, ne = perx - NC_PER_XCD; We.lv = xl * ne + je; We.n = nE; We.c = je * 8 + xl; We.h = 0; }
    phase_prologue(P, C);
    xcd_barrier(bar_all);
#ifdef PROBE_SEL
    unsigned long long tp0 = __builtin_amdgcn_s_memrealtime(), tp1 = 0, tp2 = 0, tp3 = 0, tp4 = 0, tp5 = 0, tpe1 = 0, tpe2 = 0, tpe3 = 0;
#define STAMP(v) v = __builtin_amdgcn_s_memrealtime()
#else
#define STAMP(v)
#endif
    Wall.h = 0; run_C0(P, C, Wall, bar_all); xcd_barrier(bar_all); STAMP(tp1);
    if (inC) { Wc.h = 1; run_C0(P, C, Wc, bar_c); } else { We.h = 0; run_E(P, C, We, bar_e, 0); }
    STAMP(tpe1);
#ifdef PROBE_SEL
    if (C.tid == 0) atomicMax(ctl + 80 + (inC ? 0 : 1), (unsigned)(tpe1 - tp1));
#endif
    xcd_barrier(bar_all); STAMP(tp2);
    if (inC) { Wc.h = 0; run_C1(P, C, Wc, bar_c); } else { We.h = 1; run_E(P, C, We, bar_e, 0); }
    STAMP(tpe2);
#ifdef PROBE_SEL
    if (C.tid == 0) atomicMax(ctl + 82 + (inC ? 0 : 1), (unsigned)(tpe2 - tp2));
#endif
    xcd_barrier(bar_all); STAMP(tp3);
    if (inC) { Wc.h = 1; run_C1(P, C, Wc, bar_c); } else { We.h = 0; run_E(P, C, We, bar_e, 1); }
    STAMP(tpe3);
#ifdef PROBE_SEL
    if (C.tid == 0) atomicMax(ctl + 84 + (inC ? 0 : 1), (unsigned)(tpe3 - tp3));
#endif
    xcd_barrier(bar_all); STAMP(tp4);
    Wall.h = 1; run_E(P, C, Wall, bar_all, 1);
#ifdef PROBE_SEL
    STAMP(tp5);
    { unsigned long long d = 0; const int sel = PROBE_SEL;
      if (sel == 0) d = tp1 - tp0; if (sel == 1) d = tp2 - tp1; if (sel == 2) d = tp3 - tp2; if (sel == 3) d = tp4 - tp3; if (sel == 4) d = tp5 - tp4;
      if (sel == 5 || sel == 8) d = tpe1 - tp1; if (sel == 6 || sel == 9) d = tpe2 - tp2; if (sel == 7 || sel == 10) d = tpe3 - tp3;
      const int who = sel >= 8 ? 8 * NC_PER_XCD : 0;
      if (sel >= 20) { const unsigned* sp = (const unsigned*)(P.ws + WS_CTL) + 128 + 16 * PROBE_HALF; const int i = sel - 20; const int nxt = (i == PROBE_LAST) ? 9 : i + 1; d = (unsigned long long)(__hip_atomic_load(sp + nxt, __ATOMIC_RELAXED, __HIP_MEMORY_SCOPE_AGENT) - __hip_atomic_load(sp + i, __ATOMIC_RELAXED, __HIP_MEMORY_SCOPE_AGENT)); }
      if (sel >= 30) d = 0;
      if (bx == (sel >= 20 ? 0 : who) && C.tid == 0) __hip_atomic_store(ctl + 64, (unsigned)d, __ATOMIC_RELAXED, __HIP_MEMORY_SCOPE_AGENT);
      xcd_barrier(bar_all);
      if (bx == 0 && C.tid == 0) { const unsigned dd = sel >= 30 ? __hip_atomic_load(ctl + 80 + (sel - 30), __ATOMIC_RELAXED, __HIP_MEMORY_SCOPE_AGENT) : __hip_atomic_load(ctl + 64, __ATOMIC_RELAXED, __HIP_MEMORY_SCOPE_AGENT);
        const unsigned long long t0_ = __builtin_amdgcn_s_memrealtime(); while (__builtin_amdgcn_s_memrealtime() - t0_ < 4ull * dd) __builtin_amdgcn_s_sleep(32); } }
#endif
}

extern "C" void kernel_launch(void* const* d_in, const int* in_sizes, int n_in, void* d_out, int out_size, void* d_ws, size_t ws_size, hipStream_t stream) {
    static int grid = 0;
    if (grid == 0) {
        if (n_in != 22 || in_sizes[0] != T * DM || out_size != T * DM || ws_size < WS_END) {
            fprintf(stderr, "kernel_launch: unexpected shapes (n_in %d, in0 %d, out %d, ws %zu); nothing launched\n", n_in, n_in > 0 ? in_sizes[0] : -1, out_size, ws_size); grid = -1; return; }
        int dev = 0, cus = 0;
        if (hipGetDevice(&dev) != hipSuccess || hipDeviceGetAttribute(&cus, hipDeviceAttributeMultiprocessorCount, dev) != hipSuccess) { fprintf(stderr, "kernel_launch: device query failed\n"); grid = -1; return; }
        if (hipFuncSetAttribute((const void*)hybrid_fwd, hipFuncAttributeMaxDynamicSharedMemorySize, LDS_BYTES) != hipSuccess) { fprintf(stderr, "kernel_launch: hipFuncSetAttribute failed\n"); grid = -1; return; }
        (void)hipGetLastError();
        grid = cus;
        if (grid % 8 != 0 || grid / 8 <= NC_PER_XCD) { fprintf(stderr, "kernel_launch: built for a CU count that is a multiple of 8 and > %d; got %d; nothing launched\n", 8 * NC_PER_XCD, grid); grid = -1; return; }
    }
    if (grid < 0) return;
    if (hipMemsetAsync((char*)d_ws + WS_CTL, 0, CTL_ZERO_BYTES, stream) != hipSuccess) { fprintf(stderr, "kernel_launch: memset failed\n"); return; }
    Params p{};
    p.x = (const float*)d_in[0]; p.c = (const float*)d_in[1]; p.positions = (const int*)d_in[2]; p.ada_w = (const float*)d_in[3]; p.ada_b = (const float*)d_in[4];
    p.norm_mix_g = (const float*)d_in[5]; p.norm_ffn_g = (const float*)d_in[6]; p.final_norm_g = (const float*)d_in[7]; p.even_w_in = (const float*)d_in[8]; p.even_w_out = (const float*)d_in[9];
    p.gmlp_ln_g = (const float*)d_in[10]; p.gmlp_ln_b = (const float*)d_in[11]; p.gmlp_w_s = (const float*)d_in[12]; p.gmlp_b_s = (const float*)d_in[13]; p.hgrn_lb_logits = (const float*)d_in[14];
    p.hgrn_norm_g = (const float*)d_in[15]; p.odd_w_qkv = (const float*)d_in[16]; p.odd_w_out = (const float*)d_in[17]; p.peer_w_query = (const float*)d_in[18]; p.peer_sub_keys = (const float*)d_in[19];
    p.peer_down = (const float*)d_in[20]; p.peer_up = (const float*)d_in[21];
    p.out = (float*)d_out; p.ws = (unsigned char*)d_ws;
    p.ph_lo = 0; p.ph_hi = 0;
    hipLaunchKernelGGL(hybrid_fwd, dim3(grid), dim3(NWAVES * 64), LDS_BYTES, stream, p);
    const hipError_t le = hipPeekAtLastError();
    if (le != hipSuccess) fprintf(stderr, "kernel_launch: launch failed: %s\n", hipGetErrorName(le));
}
```

```cpp
#include <hip/hip_runtime.h>
#include <cstdio>
#include <cstdint>
#include <cmath>
namespace pg8 {
#define PG8_LAS __attribute__((address_space(3)))
typedef unsigned short bf16_t;
typedef short bf16x8 __attribute__((ext_vector_type(8)));
typedef float f32x4 __attribute__((ext_vector_type(4)));
typedef unsigned u32x4 __attribute__((ext_vector_type(4)));
constexpr int BM = 256, BK = 64, HALF = 128, HTB = HALF * BK * 2  , STAGE_BYTES = 8 * HTB, NXCD = 8, WGM = 8;

__host__ __device__ __forceinline__ int lds_byte(int r, int c) { const int st = (r >> 4) * 2 + (c >> 5), rr = r & 15, cc = c & 31, ob = rr * 64 + cc * 2; return st * 1024 + (ob ^ (((ob >> 9) & 1) << 5)); }
__host__ __device__ __forceinline__ void stage_rc(int b, int& R, int& C) { const int st = b / 1024, sb = b % 1024, swz = sb ^ (((sb >> 9) & 1) << 5); R = (st >> 1) * 16 + swz / 64; C = (st & 1) * 32 + (swz % 64) / 2; }
__host__ __device__ __forceinline__ int perm32(int rho) { const int n = rho >> 4, i = rho & 15; return 8 * (i >> 2) + 4 * n + (i & 3); }

struct Unit { int pm, pn; };
struct Gemm { const bf16_t* A; const bf16_t* Bt; int M, N, K; };

struct StaticOrder {
    int nM, nN, nwg, G, c;
    __host__ __device__ void init(int M, int N, int G_, int c_) { nM = M / BM; nN = N / BM; nwg = nM * nN; G = G_; c = c_; }
    __host__ __device__ bool next(int i, Unit& u) const {
        const long L = (long)i * G + c; if (L >= nwg) return false;
        int wgid = (int)L; { const int q = nwg / NXCD, r = nwg % NXCD, xcd = wgid % NXCD, off = wgid / NXCD; wgid = (xcd < r ? xcd * (q + 1) : r * (q + 1) + (xcd - r) * q) + off; }
        const int nig = WGM * nN, gid = wgid / nig, fm = gid * WGM, gsz = (nM - fm) < WGM ? (nM - fm) : WGM;
        u.pm = fm + ((wgid % nig) % gsz); u.pn = (wgid % nig) / gsz; return true;
    }
    __device__ __forceinline__ void a_ready(const Unit&) const {}
    __device__ __forceinline__ void done(const Unit&) const {}
};

__device__ __forceinline__ unsigned cvt_pk_bf16(float lo, float hi) { unsigned r; asm volatile("v_cvt_pk_bf16_f32 %0, %1, %2" : "=v"(r) : "v"(lo), "v"(hi)); return r; }
typedef float f32x2 __attribute__((ext_vector_type(2)));
__device__ __forceinline__ f32x2 gelu_pk(f32x2 v) {
    const f32x2 av = __builtin_elementwise_abs(v), d = av * 0.2316418882f + 1.0f;
    f32x2 t; t.x = __builtin_amdgcn_rcpf(d.x); t.y = __builtin_amdgcn_rcpf(d.y);
    f32x2 q = t * 0.5307027145f + (-0.7265760135f); q = q * t + 0.7107068705f; q = q * t + (-0.142248368f); q = q * t + 0.127414796f; q = q * t;
    const f32x2 s = (v * v) * (-0.72134752044f);
    f32x2 e; e.x = __builtin_amdgcn_exp2f(s.x); e.y = __builtin_amdgcn_exp2f(s.y);
    const f32x2 m = v * (q * e), r = v - m;
    f32x2 o; o.x = v.x < 0.f ? m.x : r.x; o.y = v.y < 0.f ? m.y : r.y; return o;
}

template <class Epi, class Sched, bool ALIGN_EPI = false, bool SP2 = false>
__device__ __forceinline__ void gemm_phase(PG8_LAS unsigned char* lds, const Gemm g, const Sched& S, const Epi& E) {
    int tid_ = threadIdx.x; asm volatile("" : "+v"(tid_));
    const int tid = tid_, wid = __builtin_amdgcn_readfirstlane(tid >> 6), lane = tid & 63, wr = wid >> 2, wc = wid & 3, fr = lane & 15, fq = lane >> 4;
    const int K = g.K, nt = K / BK;
    unsigned voffA[2], voffB[2];
#pragma unroll
    for (int i = 0; i < 2; ++i) { int R, C; stage_rc(tid * 16 + i * 8192, R, C); const int Rb = Epi::PERM ? ((R & ~31) + perm32(R & 31)) : R;
        voffA[i] = (unsigned)(R * K + C) * 2u; voffB[i] = (unsigned)(Rb * K + C) * 2u; }
    const size_t kstep = (size_t)(BK * 2);
    const size_t hstep = (size_t)HALF * K * 2;
    const size_t tstep = 2 * hstep;
    const unsigned ldsw = (unsigned)wid * 1024u;
    const int aoff = lds_byte(wr * 64 + fr, fq * 8), boff = lds_byte(wc * 32 + fr, fq * 8);
#define PG8_SA(b, h) (((b) * 2 + (h)) * HTB)
#define PG8_SB(b, h) ((4 + (b) * 2 + (h)) * HTB)
#define PG8_STAGE(bufoff, gbase, voff) do { _Pragma("unroll") for (int _i = 0; _i < 2; ++_i) \
        __builtin_amdgcn_global_load_lds((const unsigned*)((const char*)(gbase) + (voff)[_i]), (PG8_LAS unsigned*)(lds + (bufoff) + ldsw + _i * 8192), 16, 0, 0); } while (0)
#define PG8_LDA(dst, b, h) do { _Pragma("unroll") for (int m = 0; m < 4; ++m) _Pragma("unroll") for (int k = 0; k < 2; ++k) dst[m][k] = *(const PG8_LAS bf16x8*)(lds + PG8_SA(b, h) + aoff + m * 2048 + k * 1024); } while (0)
#define PG8_LDB(dst, b, h) do { _Pragma("unroll") for (int n = 0; n < 2; ++n) _Pragma("unroll") for (int k = 0; k < 2; ++k) dst[n][k] = *(const PG8_LAS bf16x8*)(lds + PG8_SB(b, h) + boff + n * 2048 + k * 1024); } while (0)
#define PG8_MMA(ai, bj, At, Bt) do { __builtin_amdgcn_s_setprio(1); _Pragma("unroll") for (int m = 0; m < 4; ++m) _Pragma("unroll") for (int n = 0; n < 2; ++n) _Pragma("unroll") for (int k = 0; k < 2; ++k) \
        acc[ai][bj][m][n] = __builtin_amdgcn_mfma_f32_16x16x32_bf16(Bt[n][k], At[m][k], acc[ai][bj][m][n], 0, 0, 0); __builtin_amdgcn_s_setprio(0); } while (0)
#define PG8_WAIT_V(n) asm volatile("s_waitcnt vmcnt(" #n ")" ::: "memory")
#define PG8_WAIT_L(n) asm volatile("s_waitcnt lgkmcnt(" #n ")" ::: "memory")
#define PG8_BAR __builtin_amdgcn_s_barrier()
#define PG8_SCHED __builtin_amdgcn_sched_barrier(0)
    Unit cur, nxt; int ui = 0;
    if (!S.next(0, cur)) return;
    f32x4 acc[2][2][4][2];
#pragma unroll
    for (int a = 0; a < 2; ++a)
#pragma unroll
        for (int b = 0; b < 2; ++b)
#pragma unroll
            for (int m = 0; m < 4; ++m)
#pragma unroll
                for (int n = 0; n < 2; ++n) acc[a][b][m][n] = (f32x4){0.f, 0.f, 0.f, 0.f};
    bf16x8 At[4][2], B0[2][2], B1[2][2];
    const char* cA = (const char*)g.A + (size_t)cur.pm * tstep; const char* cB = (const char*)g.Bt + (size_t)cur.pn * tstep;
    S.a_ready(cur);
    if constexpr (SP2) {
        PG8_STAGE(PG8_SB(0, 0), cB, voffB); PG8_STAGE(PG8_SB(0, 1), cB + hstep, voffB); PG8_STAGE(PG8_SA(0, 0), cA, voffA); PG8_STAGE(PG8_SA(0, 1), cA + hstep, voffA);
        if (wr == 1) PG8_BAR;
        PG8_WAIT_V(2); PG8_BAR;
        PG8_STAGE(PG8_SB(1, 0), cB + kstep, voffB); PG8_STAGE(PG8_SA(1, 0), cA + kstep, voffA); PG8_STAGE(PG8_SB(1, 1), cB + hstep + kstep, voffB);
        PG8_WAIT_V(6); PG8_BAR;
    } else {
        PG8_STAGE(PG8_SB(0, 0), cB, voffB); PG8_STAGE(PG8_SA(0, 0), cA, voffA); PG8_STAGE(PG8_SB(0, 1), cB + hstep, voffB); PG8_STAGE(PG8_SA(0, 1), cA + hstep, voffA);
        if (wr == 1) PG8_BAR;
        PG8_WAIT_V(4); PG8_BAR;
        PG8_STAGE(PG8_SB(1, 0), cB + kstep, voffB); PG8_STAGE(PG8_SA(1, 0), cA + kstep, voffA); PG8_STAGE(PG8_SB(1, 1), cB + hstep + kstep, voffB);
        PG8_WAIT_V(6); PG8_BAR;
    }
    for (;;) {
        const bool has_next = S.next(ui + 1, nxt);
        const char* nA = has_next ? (const char*)g.A + (size_t)nxt.pm * tstep : cA; const char* nB = has_next ? (const char*)g.Bt + (size_t)nxt.pn * tstep : cB;
        for (int t = 0; t < nt; t += 2) {
            const bool last = (t == nt - 2);
            const char* a1 = cA + (size_t)(t + 1) * kstep;
            const char* a2 = last ? nA : cA + (size_t)(t + 2) * kstep; const char* b2 = last ? nB : cB + (size_t)(t + 2) * kstep;
            const char* a3 = a2 + kstep; const char* b3 = b2 + kstep;
            if (last && has_next) S.a_ready(nxt);
            if constexpr (SP2) {
            PG8_LDB(B0, 0, 0); PG8_LDB(B1, 0, 1); PG8_SCHED; PG8_LDA(At, 0, 0); PG8_STAGE(PG8_SA(1, 1), a1 + hstep, voffA);
            PG8_WAIT_V(8); PG8_WAIT_L(0); PG8_BAR; PG8_MMA(0, 0, At, B0); PG8_MMA(0, 1, At, B1); PG8_BAR; PG8_SCHED;
            PG8_LDA(At, 0, 1); PG8_STAGE(PG8_SB(0, 0), b2, voffB); PG8_STAGE(PG8_SB(0, 1), b2 + hstep, voffB); PG8_STAGE(PG8_SA(0, 0), a2, voffA);
            PG8_WAIT_V(8); PG8_WAIT_L(0); PG8_BAR; PG8_MMA(1, 0, At, B0); PG8_MMA(1, 1, At, B1); PG8_BAR; PG8_SCHED;
            PG8_LDB(B0, 1, 0); PG8_LDB(B1, 1, 1); PG8_SCHED; PG8_LDA(At, 1, 0); PG8_STAGE(PG8_SA(0, 1), a2 + hstep, voffA);
            PG8_WAIT_V(8); PG8_WAIT_L(0); PG8_BAR; PG8_MMA(0, 0, At, B0); PG8_MMA(0, 1, At, B1); PG8_BAR; PG8_SCHED;
            PG8_LDA(At, 1, 1); PG8_STAGE(PG8_SB(1, 0), b3, voffB); PG8_STAGE(PG8_SB(1, 1), b3 + hstep, voffB); PG8_STAGE(PG8_SA(1, 0), a3, voffA);
            PG8_WAIT_V(8); PG8_WAIT_L(0); PG8_BAR; PG8_MMA(1, 0, At, B0); PG8_MMA(1, 1, At, B1); PG8_BAR; PG8_SCHED;
            } else {
            PG8_LDB(B0, 0, 0); PG8_SCHED; PG8_LDA(At, 0, 0); PG8_STAGE(PG8_SA(1, 1), a1 + hstep, voffA);
            PG8_WAIT_L(8); PG8_BAR; PG8_WAIT_L(0); PG8_MMA(0, 0, At, B0); PG8_BAR; PG8_SCHED;
            PG8_LDB(B1, 0, 1); PG8_STAGE(PG8_SB(0, 0), b2, voffB);
            PG8_BAR; PG8_WAIT_L(0); PG8_MMA(0, 1, At, B1); PG8_BAR;
            PG8_LDA(At, 0, 1); PG8_STAGE(PG8_SA(0, 0), a2, voffA);
            PG8_BAR; PG8_WAIT_L(0); PG8_MMA(1, 0, At, B0); PG8_BAR; PG8_SCHED;
            PG8_STAGE(PG8_SB(0, 1), b2 + hstep, voffB);
            PG8_WAIT_V(6); PG8_BAR; PG8_MMA(1, 1, At, B1); PG8_BAR;
            PG8_LDB(B0, 1, 0); PG8_SCHED; PG8_LDA(At, 1, 0); PG8_STAGE(PG8_SA(0, 1), a2 + hstep, voffA);
            PG8_WAIT_L(8); PG8_BAR; PG8_WAIT_L(0); PG8_MMA(0, 0, At, B0); PG8_BAR; PG8_SCHED;
            PG8_LDB(B1, 1, 1); PG8_STAGE(PG8_SB(1, 0), b3, voffB);
            PG8_BAR; PG8_WAIT_L(0); PG8_MMA(0, 1, At, B1); PG8_BAR;
            PG8_LDA(At, 1, 1); PG8_STAGE(PG8_SA(1, 0), a3, voffA);
            PG8_BAR; PG8_WAIT_L(0); PG8_MMA(1, 0, At, B0); PG8_BAR; PG8_SCHED;
            PG8_STAGE(PG8_SB(1, 1), b3 + hstep, voffB);
            PG8_WAIT_V(6); PG8_BAR; PG8_MMA(1, 1, At, B1); PG8_BAR;
            }
        }
        if constexpr (ALIGN_EPI) { if (wr == 0) PG8_BAR; }
        if constexpr (!Epi::AFTER_DRAIN) { E(acc, cur, wr, wc, fr, fq); S.done(cur); }
        if (!has_next) break;
#pragma unroll
        for (int a = 0; a < 2; ++a)
#pragma unroll
            for (int b = 0; b < 2; ++b)
#pragma unroll
                for (int m = 0; m < 4; ++m)
#pragma unroll
                    for (int n = 0; n < 2; ++n) acc[a][b][m][n] = (f32x4){0.f, 0.f, 0.f, 0.f};
        cur = nxt; cA = nA; cB = nB; ++ui;
        if constexpr (ALIGN_EPI) { if (wr == 1) PG8_BAR; }
    }
    PG8_WAIT_V(0);
    if constexpr (!ALIGN_EPI) { if (wr == 0) PG8_BAR; }
    PG8_BAR;
    if constexpr (Epi::AFTER_DRAIN) { E.fused(acc, cur, wr, wc, fr, fq, lds, wid, lane); S.done(cur); }
#undef PG8_SA
#undef PG8_SB
#undef PG8_STAGE
#undef PG8_LDA
#undef PG8_LDB
#undef PG8_MMA
#undef PG8_WAIT_V
#undef PG8_WAIT_L
#undef PG8_BAR
#undef PG8_SCHED
}
}
#define GAS __attribute__((address_space(1)))
#define LAS __attribute__((address_space(3)))
typedef unsigned short bf16;
typedef unsigned v4u __attribute__((ext_vector_type(4)));
typedef float f32x4 __attribute__((ext_vector_type(4)));
typedef short bf16x8 __attribute__((ext_vector_type(8)));
typedef __bf16 bf16x2_t __attribute__((ext_vector_type(2)));
#define LDS_WAIT() asm volatile("s_waitcnt lgkmcnt(0)" ::: "memory")
#define VM_WAIT() asm volatile("s_waitcnt vmcnt(0)" ::: "memory")
__device__ __forceinline__ unsigned f2bf(float f) { unsigned u = __builtin_bit_cast(unsigned, f); return (u + 0x7fffu + ((u >> 16) & 1u)) >> 16; }
__device__ __forceinline__ unsigned pk2(float lo, float hi) { return f2bf(lo) | (f2bf(hi) << 16); }
__device__ __forceinline__ float bflo(unsigned u) { return __builtin_bit_cast(float, u << 16); }
__device__ __forceinline__ float bfhi(unsigned u) { return __builtin_bit_cast(float, u & 0xffff0000u); }
__device__ __forceinline__ float bf2f(bf16 u) { return __builtin_bit_cast(float, (unsigned)u << 16); }
#define XB_TMO      128
#define XB_XCNT(j)  (256  + 64 * (j))
#define XB_XSUB(j)  (1280 + 64 * (j))
#define XB_XGEN(j)  (2304 + 64 * (j))
#define XB_TOP      3328
#define XB_TOPGEN   3392
#define XCD_BAR_WORDS 3456
#define XB_SPIN_CAP (1u << 18)

__device__ __forceinline__ unsigned xb_ld(unsigned* p)              { return __hip_atomic_load(p, __ATOMIC_RELAXED, __HIP_MEMORY_SCOPE_AGENT); }
__device__ __forceinline__ unsigned xb_add(unsigned* p, unsigned v) { return __hip_atomic_fetch_add(p, v, __ATOMIC_RELAXED, __HIP_MEMORY_SCOPE_AGENT); }
__device__ __forceinline__ unsigned xb_xcc_id() { return (unsigned)__builtin_amdgcn_s_getreg((3 << 11) | 20) & 0xFu; }
#define XB_SPIN(cond, bar) do { unsigned _sp = 0; while (cond) { __builtin_amdgcn_s_sleep(1); \
    if ((++_sp & 255u) == 0u) { if (xb_ld(&(bar)[XB_TMO])) break; if (_sp > XB_SPIN_CAP) { atomicAdd(&(bar)[XB_TMO], 1u); break; } } } } while (0)

struct XcdBarrier {
    unsigned* bar; unsigned x; unsigned G;
    volatile LAS unsigned* st;
};

__device__ __forceinline__ XcdBarrier xcd_barrier_post(unsigned* bar, volatile LAS unsigned* st) {
    XcdBarrier b; b.bar = bar; b.x = xb_xcc_id(); b.st = st; b.G = gridDim.x;
    if (threadIdx.x == 0) (void)xb_add(&bar[XB_XCNT(b.x)], 1u);
    return b;
}
__device__ __forceinline__ void xcd_barrier_complete(unsigned* bar, unsigned x, unsigned& nloc, unsigned& nx, const unsigned G) {
    unsigned sum, cnt, mine, sp = 0u;
    for (;;) {
        sum = 0u; cnt = 0u; mine = 0u;
#pragma unroll
        for (unsigned j = 0; j < 16; ++j) { const unsigned c = xb_ld(&bar[XB_XCNT(j)]); sum += c; cnt += (c > 0u) ? 1u : 0u; mine = (j == x) ? c : mine; }
        if (sum == G) break;
        __builtin_amdgcn_s_sleep(1);
        if ((++sp & 255u) == 0u) { if (xb_ld(&bar[XB_TMO])) break; if (sp > XB_SPIN_CAP) { atomicAdd(&bar[XB_TMO], 1u); break; } }
    }
    nloc = mine > 0u ? mine : 1u; nx = cnt > 0u ? cnt : 1u;
}

__device__ __forceinline__ void xcd_barrier(const XcdBarrier& b) {
    asm volatile("s_waitcnt vmcnt(0)" ::: "memory");
    __syncthreads();
    if (threadIdx.x == 0) {
        unsigned* bar = b.bar;
        __builtin_amdgcn_s_waitcnt(0);
        unsigned nloc = b.st[0], nx = b.st[1];
        if (nloc == 0u) { xcd_barrier_complete(bar, b.x, nloc, nx, b.G); b.st[0] = nloc; b.st[1] = nx; }
        const unsigned old = xb_add(&bar[XB_XSUB(b.x)], 1u);
        const unsigned gen = old / nloc;
        if (old + 1u == (gen + 1u) * nloc) {
            __builtin_amdgcn_fence(__ATOMIC_RELEASE, "agent");
            asm volatile("s_waitcnt vmcnt(0)" ::: "memory");
            const unsigned og = xb_add(&bar[XB_TOP], 1u);
            const unsigned tg = og / nx;
            if (og + 1u == (tg + 1u) * nx) xb_add(&bar[XB_TOPGEN], 1u);
            else XB_SPIN(xb_ld(&bar[XB_TOPGEN]) == tg, bar);
            __builtin_amdgcn_fence(__ATOMIC_ACQUIRE, "agent");
            xb_add(&bar[XB_XGEN(b.x)], 1u);
            asm volatile("s_waitcnt vmcnt(0)" ::: "memory");
        } else {
            XB_SPIN(xb_ld(&bar[XB_XGEN(b.x)]) == gen, bar);
            __builtin_amdgcn_fence(__ATOMIC_ACQUIRE, "agent");
            asm volatile("s_waitcnt vmcnt(0)" ::: "memory");
        }
    }
    __syncthreads();
}

constexpr int NB = 8, SEQ = 8192, DM = 1024, T = NB * SEQ;
constexpr int NWAVES = 8;
constexpr float NORM_EPS = 1e-6f;
constexpr float C2 = 0.125f * 1.4426950408889634f;

constexpr size_t MiB = 1u << 20;
constexpr size_t WS_CTL = 0, CTL_ZERO_BYTES = 1 * MiB;
constexpr size_t WS_MOD = 1 * MiB;
constexpr size_t WS_SKB = 1 * MiB + 512 * 1024;
constexpr size_t WS_WSB = 1 * MiB + 768 * 1024;
constexpr size_t WS_LB  = 1 * MiB + 960 * 1024;
constexpr size_t WS_CS  = 2 * MiB;
constexpr size_t WS_HD  = 6 * MiB;
constexpr size_t WS_WIN = 16 * MiB, WS_WOUT0 = 22 * MiB, WS_WQKV = 24 * MiB, WS_WOUT1 = 30 * MiB, WS_WQ0 = 32 * MiB, WS_WQ1 = 36 * MiB;
constexpr size_t WS_TAB8 = 40 * MiB, TAB8_BYTES = 16 * MiB;
constexpr int TROW = 1024;
constexpr size_t WS_SC8 = 8 * MiB;
constexpr size_t WS_H = 108 * MiB;
constexpr size_t WS_IDX = 236 * MiB, WS_GATE = 268 * MiB;
constexpr size_t WS_AR0 = 300 * MiB, AR_BYTES = 352 * MiB;
constexpr size_t AR_PU = 0, AR_PV = 32 * MiB, AR_PQ = 64 * MiB, AR_PI = 96 * MiB, AR_PG = 128 * MiB;
constexpr size_t AR_G = 160 * MiB;
constexpr size_t AR_KVT = 224 * MiB, AR_ST = 288 * MiB;
constexpr size_t AR_QP = 0;
constexpr size_t AR_QK = 0;
constexpr size_t WS_END = WS_AR0 + 2 * AR_BYTES;
constexpr int HT = T / 2;
constexpr int CW_BAR = 4096;

constexpr int LDS_BYTES = 147456;
constexpr int LDSCTL_OFF = LDS_BYTES - 512;
constexpr int MISC_OFF = LDSCTL_OFF;

struct Params {
    const float* x; const float* c; const int* positions; const float* ada_w; const float* ada_b; const float* norm_mix_g; const float* norm_ffn_g; const float* final_norm_g;
    const float* even_w_in; const float* even_w_out; const float* gmlp_ln_g; const float* gmlp_ln_b; const float* gmlp_w_s; const float* gmlp_b_s; const float* hgrn_lb_logits; const float* hgrn_norm_g;
    const float* odd_w_qkv; const float* odd_w_out; const float* peer_w_query; const float* peer_sub_keys; const float* peer_down; const float* peer_up;
    float* out; unsigned char* ws; int ph_lo, ph_hi;
};
struct Ctx { LAS unsigned char* lds; int tid, lane, wave, vcu, G; };
__device__ __forceinline__ Ctx fresh_ctx(const Ctx& C0) { Ctx C = C0; int t_ = threadIdx.x; asm volatile("" : "+v"(t_)); C.tid = t_; C.lane = t_ & 63; C.wave = __builtin_amdgcn_readfirstlane(t_ >> 6); return C; }
struct Wk { int lv, n, c, h; };
#define W_TK0(W) ((W).h * (T / 2))
#define W_BT0(W) ((W).h * (NB / 2))
__device__ __forceinline__ unsigned char* w_ar(const Params& P, const Wk& W) { return P.ws + WS_AR0 + (size_t)W.h * AR_BYTES; }
__device__ __forceinline__ bf16* w_tok16(const Params& P, const Wk& W, size_t off, int pitch) { return (bf16*)(w_ar(P, W) + off) - (size_t)W_TK0(W) * pitch; }
__device__ __forceinline__ float* w_tok32(const Params& P, const Wk& W, size_t off, int pitch) { return (float*)(w_ar(P, W) + off) - (size_t)W_TK0(W) * pitch; }
__device__ __forceinline__ bf16* w_item16(const Params& P, const Wk& W, size_t off) { return (bf16*)(w_ar(P, W) + off) - (size_t)W_BT0(W) * 512 * 16384; }

__device__ __forceinline__ float wave_sum(float v) {
#pragma unroll
    for (int o = 1; o < 64; o <<= 1) v += __shfl_xor(v, o);
    return v;
}
__device__ __forceinline__ float silu_f(float x) { return x * __builtin_amdgcn_rcpf(1.0f + __builtin_amdgcn_exp2f(-1.4426950408889634f * x)); }
__device__ __forceinline__ float sigmoid_f(float x) { return __builtin_amdgcn_rcpf(1.0f + __builtin_amdgcn_exp2f(-1.4426950408889634f * x)); }
__device__ __forceinline__ float gelu_f(float x) { return 0.5f * x * (1.0f + erff(x * 0.70710678118654752f)); }
__device__ __forceinline__ f32x4 mma16(f32x4 acc, const LAS bf16* A, int lda, const LAS bf16* Bt, int ldb, int K, int r, int q4) {
    const LAS bf16* ap = A + r * lda + 8 * q4; const LAS bf16* bp = Bt + r * ldb + 8 * q4;
    for (int k0 = 0; k0 < K; k0 += 32) {
        const bf16x8 a = *(const LAS bf16x8*)(ap + k0); const bf16x8 b = *(const LAS bf16x8*)(bp + k0);
        acc = __builtin_amdgcn_mfma_f32_16x16x32_bf16(a, b, acc, 0, 0, 0);
    }
    return acc;
}

struct EpiBf16P {
    static constexpr bool PERM = true, AFTER_DRAIN = false;
    bf16* O; size_t ldc;
    __device__ __forceinline__ void operator()(const f32x4 (&acc)[2][2][4][2], const pg8::Unit& u, int wr, int wc, int fr, int fq) const {
        const int row0 = u.pm * 256 + wr * 64 + fr, col0 = u.pn * 256 + wc * 32 + 8 * fq;
#pragma unroll
        for (int ai = 0; ai < 2; ++ai)
#pragma unroll
            for (int m = 0; m < 4; ++m) { bf16* rowp = O + (size_t)(row0 + ai * 128 + m * 16) * ldc + col0;
#pragma unroll
                for (int bj = 0; bj < 2; ++bj) { const f32x4 v0 = acc[ai][bj][m][0], v1 = acc[ai][bj][m][1];
                    v4u w; w.x = pg8::cvt_pk_bf16(v0[0], v0[1]); w.y = pg8::cvt_pk_bf16(v0[2], v0[3]); w.z = pg8::cvt_pk_bf16(v1[0], v1[1]); w.w = pg8::cvt_pk_bf16(v1[2], v1[3]);
                    *(v4u*)(rowp + bj * 128) = w; } }
    }
};
#ifndef REP_HG
#define REP_HG 1
#endif
#ifndef REP_TOPK
#define REP_TOPK 1
#endif
#ifndef REP_PRO
#define REP_PRO 1
#endif
#ifndef REP_NORM
#define REP_NORM 1
#endif
#ifndef REP_GEMM2
#define REP_GEMM2 1
#endif
#ifndef REP_GEMM
#define REP_GEMM 1
#endif
#ifndef EXP_REP
#define EXP_REP 1
#endif
#ifndef ATT_REP
#define ATT_REP 1
#endif
#ifndef ABL_ON
#define ABL_ON 4
#endif
struct EpiResid {
    static constexpr bool PERM = true, AFTER_DRAIN = false;
    const float* xin; float* xout; const float* gate; float gsc;
    __device__ __forceinline__ void operator()(const f32x4 (&acc)[2][2][4][2], const pg8::Unit& u, int wr, int wc, int fr, int fq) const {
        const int row0 = u.pm * 256 + wr * 64 + fr, col0 = u.pn * 256 + wc * 32 + 8 * fq;
        const float* gp = gate + (size_t)((u.pm * 256) >> 13) * 6144 + col0;
        f32x4 gv[2][2];
#pragma unroll
        for (int bj = 0; bj < 2; ++bj) { gv[bj][0] = *(const f32x4*)(gp + bj * 128); gv[bj][1] = *(const f32x4*)(gp + bj * 128 + 4); }
#pragma unroll
        for (int ai = 0; ai < 2; ++ai)
#pragma unroll
            for (int m = 0; m < 4; ++m) { const size_t off = (size_t)(row0 + ai * 128 + m * 16) * 1024 + col0;
#pragma unroll
                for (int bj = 0; bj < 2; ++bj) {
                    const f32x4 x0 = *(const f32x4*)(xin + off + bj * 128), x1 = *(const f32x4*)(xin + off + bj * 128 + 4);
                    *(f32x4*)(xout + off + bj * 128) = x0 + gv[bj][0] * acc[ai][bj][m][0] * gsc;
                    *(f32x4*)(xout + off + bj * 128 + 4) = x1 + gv[bj][1] * acc[ai][bj][m][1] * gsc; }
                asm volatile("" ::: "memory"); }
    }
};
struct EpiInProj {
    static constexpr bool PERM = true, AFTER_DRAIN = false;
    bf16* PU; bf16* PV; bf16* PQ; bf16* PI; bf16* PG; float* G; const float* LB;
    __device__ __forceinline__ void operator()(const f32x4 (&acc)[2][2][4][2], const pg8::Unit& u, int wr, int wc, int fr, int fq) const {
        const int type = u.pn >> 1;
        const int row0 = u.pm * 256 + wr * 64 + fr, lc0 = (u.pn & 1) * 256 + wc * 32 + 8 * fq;
        if (type == 3) {
            f32x4 lb[2][2];
#pragma unroll
            for (int bj = 0; bj < 2; ++bj) { lb[bj][0] = *(const f32x4*)(LB + lc0 + bj * 128); lb[bj][1] = *(const f32x4*)(LB + lc0 + bj * 128 + 4); }
#pragma unroll
            for (int ai = 0; ai < 2; ++ai)
#pragma unroll
                for (int m = 0; m < 4; ++m) { float* rowp = G + (size_t)(row0 + ai * 128 + m * 16) * 512 + lc0;
#pragma unroll
                    for (int bj = 0; bj < 2; ++bj)
#pragma unroll
                        for (int n = 0; n < 2; ++n) { const f32x4 v = acc[ai][bj][m][n]; f32x4 o;
#pragma unroll
                            for (int e = 0; e < 4; ++e) { const float l = lb[bj][n][e]; const float f = l + (1.0f - l) * sigmoid_f(v[e]); o[e] = __logf(f); }
                            *(f32x4*)(rowp + bj * 128 + 4 * n) = o; } }
            return;
        }
        bf16* base = type == 0 ? PU : type == 1 ? PV : type == 2 ? PQ : type == 4 ? PI : PG;
#pragma unroll
        for (int ai = 0; ai < 2; ++ai)
#pragma unroll
            for (int m = 0; m < 4; ++m) { bf16* rowp = base + (size_t)(row0 + ai * 128 + m * 16) * 512 + lc0;
#pragma unroll
                for (int bj = 0; bj < 2; ++bj) { f32x4 v0 = acc[ai][bj][m][0], v1 = acc[ai][bj][m][1];
                    if (type <= 1) { pg8::f32x2 a = pg8::gelu_pk((pg8::f32x2){v0[0], v0[1]}), b = pg8::gelu_pk((pg8::f32x2){v0[2], v0[3]}), c = pg8::gelu_pk((pg8::f32x2){v1[0], v1[1]}), d = pg8::gelu_pk((pg8::f32x2){v1[2], v1[3]});
                        v0 = (f32x4){a.x, a.y, b.x, b.y}; v1 = (f32x4){c.x, c.y, d.x, d.y}; }
                    else if (type == 2) {
#pragma unroll
                        for (int e = 0; e < 4; ++e) { v0[e] = silu_f(v0[e]) * 0.08838834764831845f; v1[e] = silu_f(v1[e]) * 0.08838834764831845f; } }
                    else if (type == 5) {
#pragma unroll
                        for (int e = 0; e < 4; ++e) { v0[e] = silu_f(v0[e]); v1[e] = silu_f(v1[e]); } }
                    v4u w; w.x = pg8::cvt_pk_bf16(v0[0], v0[1]); w.y = pg8::cvt_pk_bf16(v0[2], v0[3]); w.z = pg8::cvt_pk_bf16(v1[0], v1[1]); w.w = pg8::cvt_pk_bf16(v1[2], v1[3]);
                    *(v4u*)(rowp + bj * 128) = w; } }
    }
};
struct EpiQKRot {
    static constexpr bool PERM = true, AFTER_DRAIN = false;
    bf16* O; const float* CS;
    __device__ __forceinline__ void operator()(const f32x4 (&acc)[2][2][4][2], const pg8::Unit& u, int wr, int wc, int fr, int fq) const {
        const int row0 = u.pm * 256 + wr * 64 + fr, col0 = u.pn * 256 + wc * 32 + 8 * fq;
        const float sc = u.pn < 4 ? C2 : 1.0f;
        const bool rotw = (wc & 1) == 0 && u.pn < 8;
        const float sgn = fq == 0 ? -1.0f : 1.0f;
#pragma unroll
        for (int ai = 0; ai < 2; ++ai)
#pragma unroll
            for (int m = 0; m < 4; ++m) { const int row = row0 + ai * 128 + m * 16; bf16* rowp = O + (size_t)row * 3072 + col0;
                f32x4 c0 = (f32x4){1.f, 1.f, 1.f, 1.f}, c1 = c0, s0 = (f32x4){0.f, 0.f, 0.f, 0.f}, s1 = s0;
                if (rotw && fq < 2) { const float* cp = CS + (size_t)row * 16; c0 = *(const f32x4*)(cp); c1 = *(const f32x4*)(cp + 4); s0 = *(const f32x4*)(cp + 8) * sgn; s1 = *(const f32x4*)(cp + 12) * sgn; }
#pragma unroll
                for (int bj = 0; bj < 2; ++bj) { f32x4 v0 = acc[ai][bj][m][0], v1 = acc[ai][bj][m][1];
                    if (rotw) { f32x4 p0, p1;
#pragma unroll
                        for (int e = 0; e < 4; ++e) { p0[e] = __shfl_xor(v0[e], 16); p1[e] = __shfl_xor(v1[e], 16); }
                        v0 = v0 * c0 + p0 * s0; v1 = v1 * c1 + p1 * s1; }
                    v0 = v0 * sc; v1 = v1 * sc;
                    v4u w; w.x = pg8::cvt_pk_bf16(v0[0], v0[1]); w.y = pg8::cvt_pk_bf16(v0[2], v0[3]); w.z = pg8::cvt_pk_bf16(v1[0], v1[1]); w.w = pg8::cvt_pk_bf16(v1[2], v1[3]);
                    *(v4u*)(rowp + bj * 128) = w; } }
    }
};

__device__ __forceinline__ void p0_transpose_item(const float* W, int K, int N, bf16* WT, LAS float* scr, int item, int lane) {
    const int nblk = N / 32, kb = item / nblk, nb = item % nblk, k0 = 64 * kb, n0 = 32 * nb;
#pragma unroll 8
    for (int i = 0; i < 32; ++i) { const int kk = 2 * i + (lane >> 5); scr[kk * 33 + (lane & 31)] = W[(size_t)(k0 + kk) * N + n0 + (lane & 31)]; }
    LDS_WAIT(); asm volatile("" ::: "memory");
    const int c = lane & 7;
#pragma unroll
    for (int j = 0; j < 4; ++j) { const int n = (lane >> 3) + 8 * j; const LAS float* s = scr + (8 * c) * 33 + n;
        v4u o; o.x = pk2(s[0 * 33], s[1 * 33]); o.y = pk2(s[2 * 33], s[3 * 33]); o.z = pk2(s[4 * 33], s[5 * 33]); o.w = pk2(s[6 * 33], s[7 * 33]);
        *(GAS v4u*)(WT + (size_t)(n0 + n) * K + k0 + 8 * c) = o; }
    LDS_WAIT(); asm volatile("" ::: "memory");
}
typedef float f32x2 __attribute__((ext_vector_type(2)));
__device__ __forceinline__ void convert_tables(const Params& P, const Ctx& C) {
    const int gw = C.vcu * NWAVES + C.wave, NGW = C.G * NWAVES, lane = C.lane;
    for (int row = gw; row < 4 * 16384; row += NGW) {
        const int tb = row >> 14, e = row & 16383;
        const float* src = ((tb & 1) ? P.peer_up : P.peer_down) + ((size_t)(tb >> 1) * 16384 + e) * 1024;
        unsigned char* dst = P.ws + WS_TAB8 + (size_t)tb * TAB8_BYTES + (size_t)e * TROW;
        f32x4 v[4]; float mx = 0.f;
#pragma unroll
        for (int j = 0; j < 4; ++j) { v[j] = ((const f32x4*)src)[64 * j + lane]; mx = fmaxf(mx, fmaxf(fmaxf(fabsf(v[j][0]), fabsf(v[j][1])), fmaxf(fabsf(v[j][2]), fabsf(v[j][3])))); }
#pragma unroll
        for (int o = 1; o < 64; o <<= 1) mx = fmaxf(mx, __shfl_xor(mx, o));
        const float sc = mx > 0.f ? 400.0f / mx : 0.f;
#pragma unroll
        for (int j = 0; j < 4; ++j) { int p = __builtin_amdgcn_cvt_pk_fp8_f32(v[j][0] * sc, v[j][1] * sc, 0, false); p = __builtin_amdgcn_cvt_pk_fp8_f32(v[j][2] * sc, v[j][3] * sc, p, true);
            ((unsigned*)dst)[64 * j + lane] = (unsigned)p; }
        if (lane == 0) ((float*)(P.ws + WS_SC8))[row] = mx * (1.0f / 400.0f);
    }
}
__device__ __forceinline__ void phase_prologue(const Params& P, const Ctx& C) {
    float* MOD = (float*)(P.ws + WS_MOD);
    {
        LAS float* cond = (LAS float*)C.lds;
        LAS float* part = (LAS float*)(C.lds + 32768);
        for (int e = C.tid; e < 8192; e += 512) cond[e] = silu_f(P.c[e]);
        __syncthreads();
        for (int item = C.vcu; item < 192; item += C.G) {
            const int l = item / 96, cb = item % 96, col = cb * 64 + C.lane;
            float acc[8];
#pragma unroll
            for (int b = 0; b < 8; ++b) acc[b] = 0.f;
            const float* wp = P.ada_w + ((size_t)l * 1024 + C.wave * 128) * 6144 + col;
#pragma unroll 4
            for (int k = 0; k < 128; ++k) { const float wv = wp[(size_t)k * 6144];
#pragma unroll
                for (int b = 0; b < 8; ++b) acc[b] += cond[b * 1024 + C.wave * 128 + k] * wv; }
#pragma unroll
            for (int b = 0; b < 8; ++b) part[(C.wave * 8 + b) * 64 + C.lane] = acc[b];
            __syncthreads();
            { const int b = C.tid >> 6, ln = C.tid & 63; float s = P.ada_b[l * 6144 + cb * 64 + ln];
#pragma unroll
              for (int w = 0; w < 8; ++w) s += part[(w * 8 + b) * 64 + ln];
              MOD[(size_t)(l * 8 + b) * 6144 + cb * 64 + ln] = s; }
            __syncthreads();
        }
        __syncthreads();
    }
    {
        LAS float* scr = (LAS float*)(C.lds + C.wave * 16384);
        const int gw = C.vcu * NWAVES + C.wave, NGW = C.G * NWAVES;
        for (int it = gw; it < 6144; it += NGW) {
            int r = it;
            if (r < 1536) { p0_transpose_item(P.even_w_in, 1024, 3072, (bf16*)(P.ws + WS_WIN), scr, r, C.lane); continue; } r -= 1536;
            if (r < 512)  { p0_transpose_item(P.even_w_out, 1024, 1024, (bf16*)(P.ws + WS_WOUT0), scr, r, C.lane); continue; } r -= 512;
            if (r < 1536) { p0_transpose_item(P.odd_w_qkv, 1024, 3072, (bf16*)(P.ws + WS_WQKV), scr, r, C.lane); continue; } r -= 1536;
            if (r < 512)  { p0_transpose_item(P.odd_w_out, 1024, 1024, (bf16*)(P.ws + WS_WOUT1), scr, r, C.lane); continue; } r -= 512;
            if (r < 1024) { p0_transpose_item(P.peer_w_query, 1024, 2048, (bf16*)(P.ws + WS_WQ0), scr, r, C.lane); continue; } r -= 1024;
            p0_transpose_item(P.peer_w_query + (size_t)1024 * 2048, 1024, 2048, (bf16*)(P.ws + WS_WQ1), scr, r, C.lane);
        }
    }
    convert_tables(P, C);
    const int NT = C.G * 512, gt = C.vcu * 512 + C.tid;
    { bf16* skb = (bf16*)(P.ws + WS_SKB); for (int i = gt; i < 65536; i += NT) skb[i] = (bf16)f2bf(P.peer_sub_keys[i]); }
    { bf16* wsb = (bf16*)(P.ws + WS_WSB); for (int i = gt; i < 65536; i += NT) { const int t = (i >> 7) & 127, s = i & 127; wsb[i] = (bf16)(s <= t ? f2bf(P.gmlp_w_s[i]) : 0u); } }
    { float* lb = (float*)(P.ws + WS_LB); for (int i = gt; i < 512; i += NT) { const float l0 = P.hgrn_lb_logits[i], l1 = P.hgrn_lb_logits[512 + i]; lb[i] = 1.0f / (1.0f + expf(l1 - l0)); } }
    { float* cs = (float*)(P.ws + WS_CS); for (int i = gt; i < T * 8; i += NT) { const int tok = i >> 3, j = i & 7;
        const float inv = 1.0f / powf(500000.0f, (float)j * 0.125f); const float ang = (float)P.positions[tok] * inv; float sn, cn; sincosf(ang, &sn, &cn);
        cs[(size_t)tok * 16 + j] = cn; cs[(size_t)tok * 16 + 8 + j] = sn; } }
}
__device__ __forceinline__ void norm_row_bf16(const float* xrow, bf16* hrow, const float* g, const float* sh, const float* sc, int lane) {
    const f32x4* xr = (const f32x4*)xrow + lane; f32x4 v[4]; float s = 0.f;
#pragma unroll
    for (int j = 0; j < 4; ++j) { v[j] = xr[64 * j]; s += (v[j][0] * v[j][0] + v[j][1] * v[j][1]) + (v[j][2] * v[j][2] + v[j][3] * v[j][3]); }
    const float rstd = 1.0f / sqrtf(wave_sum(s) * (1.0f / 1024.0f) + NORM_EPS);
    unsigned long long* o8 = (unsigned long long*)hrow + lane;
#pragma unroll
    for (int j = 0; j < 4; ++j) { const f32x4 gg = ((const f32x4*)g)[64 * j + lane], hh = ((const f32x4*)sh)[64 * j + lane], cc = ((const f32x4*)sc)[64 * j + lane];
        const f32x4 y = (v[j] * rstd * gg) * (cc + 1.0f) + hh;
        o8[64 * j] = (unsigned long long)pk2(y[0], y[1]) | ((unsigned long long)pk2(y[2], y[3]) << 32); }
}
__device__ __forceinline__ void phase_norm(const Params& P, const Ctx& C, const Wk& W, const float* xsrc, const float* g, int l, int so) {
    const float* MOD = (const float*)(P.ws + WS_MOD); bf16* H = (bf16*)(P.ws + WS_H);
    const int gw = W.lv * NWAVES + C.wave, NGW = W.n * NWAVES;
    for (int m = W_TK0(W) + gw; m < W_TK0(W) + HT; m += NGW) { const float* mb = MOD + (size_t)(l * 8 + (m >> 13)) * 6144 + so;
        norm_row_bf16(xsrc + (size_t)m * 1024, H + (size_t)m * 1024, g, mb, mb + 1024, C.lane); }
}

__device__ __forceinline__ void gmlp_item(const Params& P, const Ctx& C, const Wk& W, int n, int g) {
    LAS bf16* Wt = (LAS bf16*)C.lds;
    LAS bf16* vT = (LAS bf16*)(C.lds + 34816);
    const bf16* WSB = (const bf16*)(P.ws + WS_WSB); const bf16* PU = w_tok16(P, W, AR_PU, 512); const bf16* PV = w_tok16(P, W, AR_PV, 512); bf16* MIX = (bf16*)(P.ws + WS_H);
    const int tid = C.tid, r = C.lane & 15, q4 = C.lane >> 4;
    for (int ch = tid; ch < 2048; ch += 512) { const int rr = ch >> 4, c8 = (ch & 15) * 8; *(LAS v4u*)(Wt + rr * 136 + c8) = *(const v4u*)(WSB + (size_t)(g * 128 + rr) * 128 + c8); }
    { const int t = tid >> 2, part = tid & 3; const bf16* src = PV + (size_t)(n * 128 + t) * 512 + g * 128 + part * 32;
      float x[32];
#pragma unroll
      for (int j = 0; j < 4; ++j) { const v4u w = *(const v4u*)(src + 8 * j);
#pragma unroll
          for (int e = 0; e < 4; ++e) { x[8 * j + 2 * e] = bflo(w[e]); x[8 * j + 2 * e + 1] = bfhi(w[e]); } }
      float s = 0.f;
#pragma unroll
      for (int j = 0; j < 32; ++j) s += x[j];
      s += __shfl_xor(s, 1); s += __shfl_xor(s, 2);
      const float mean = s * (1.0f / 128.0f); float q = 0.f;
#pragma unroll
      for (int j = 0; j < 32; ++j) { const float d = x[j] - mean; q += d * d; }
      q += __shfl_xor(q, 1); q += __shfl_xor(q, 2);
      const float rstd = 1.0f / sqrtf(q * (1.0f / 128.0f) + NORM_EPS);
      const float* lg = P.gmlp_ln_g + g * 128 + part * 32; const float* lbp = P.gmlp_ln_b + g * 128 + part * 32;
#pragma unroll
      for (int j = 0; j < 32; ++j) vT[(part * 32 + j) * 136 + t] = (bf16)f2bf((x[j] - mean) * rstd * lg[j] + lbp[j]);
    }
    __syncthreads();
    const int t0 = 16 * C.wave; const int Keff = ((t0 + 16 + 31) >> 5) << 5;
    f32x4 acc[8];
#pragma unroll
    for (int ct = 0; ct < 8; ++ct) { acc[ct] = (f32x4){0.f, 0.f, 0.f, 0.f}; acc[ct] = mma16(acc[ct], Wt + t0 * 136, 136, vT + (16 * ct) * 136, 136, Keff, r, q4); }
#pragma unroll
    for (int i = 0; i < 4; ++i) { const int t = t0 + 4 * q4 + i; const float bs = P.gmlp_b_s[g * 128 + t]; const size_t tok = (size_t)n * 128 + t;
#pragma unroll
        for (int ct = 0; ct < 8; ++ct) { const int c = 16 * ct + r; const float u = bf2f(PU[tok * 512 + g * 128 + c]); MIX[tok * 1024 + g * 128 + c] = (bf16)f2bf(u * (acc[ct][i] + bs)); } }
    __syncthreads();
}
__device__ __forceinline__ void hgrn_cumsum16(const float* G, size_t tok0, int hh, int k, int seg, LAS float* tot, float (&g)[16], float (&bb)[16], float& total) {
    const float* gp = G + (tok0 + seg * 16) * 512 + hh * 128 + k;
#pragma unroll
    for (int j = 0; j < 16; ++j) g[j] = gp[(size_t)j * 512];
    float run = 0.f;
#pragma unroll
    for (int j = 0; j < 16; ++j) { run += g[j]; bb[j] = run; }
    tot[seg * 128 + k] = run;
    __syncthreads();
    const float t0 = tot[k], t1 = tot[128 + k], t2 = tot[256 + k], t3 = tot[384 + k];
    const float pre = seg == 0 ? 0.f : seg == 1 ? t0 : seg == 2 ? t0 + t1 : t0 + t1 + t2;
    total = (t0 + t1) + (t2 + t3);
#pragma unroll
    for (int j = 0; j < 16; ++j) bb[j] += pre;
}
__device__ __forceinline__ void hgrn_stage_iT(const bf16* PI, size_t tok0, int hh, LAS bf16* iT, int tid) {
    const int s = tid >> 3, v0 = (tid & 7) * 16; const bf16* src = PI + (tok0 + s) * 512 + hh * 128 + v0;
#pragma unroll
    for (int h2 = 0; h2 < 2; ++h2) { const v4u w = *(const v4u*)(src + 8 * h2);
#pragma unroll
        for (int e = 0; e < 4; ++e) { iT[(v0 + 8 * h2 + 2 * e) * 72 + s] = (bf16)(w[e] & 0xffffu); iT[(v0 + 8 * h2 + 2 * e + 1) * 72 + s] = (bf16)(w[e] >> 16); } }
}
__device__ __forceinline__ void hgrn_local_item(const Params& P, const Ctx& C, const Wk& W, int item) {
    LAS bf16* khT = (LAS bf16*)C.lds;
    LAS bf16* iT = (LAS bf16*)(C.lds + 18432);
    LAS float* tot = (LAS float*)(C.lds + 36864);
    const float* G = w_tok32(P, W, AR_G, 512); const bf16* PI = w_tok16(P, W, AR_PI, 512); bf16* KVT = w_item16(P, W, AR_KVT); float* HD = (float*)(P.ws + WS_HD);
    const int bh = item >> 7, c = item & 127, b = bh >> 2, hh = bh & 3; const size_t tok0 = (size_t)b * SEQ + c * 64;
    const int tid = C.tid, k = tid & 127, seg = tid >> 7, r = C.lane & 15, q4 = C.lane >> 4;
    float g[16], bb[16], total;
    hgrn_cumsum16(G, tok0, hh, k, seg, tot, g, bb, total);
    { unsigned w[8];
#pragma unroll
      for (int j = 0; j < 8; ++j) { const float a0 = -expm1f(g[2 * j]) * __expf(total - bb[2 * j]), a1 = -expm1f(g[2 * j + 1]) * __expf(total - bb[2 * j + 1]); w[j] = pk2(a0, a1); }
      LAS v4u* dst = (LAS v4u*)(khT + k * 72 + seg * 16); dst[0] = (v4u){w[0], w[1], w[2], w[3]}; dst[1] = (v4u){w[4], w[5], w[6], w[7]}; }
    if (seg == 0) HD[(size_t)item * 128 + k] = __expf(total);
    hgrn_stage_iT(PI, tok0, hh, iT, tid);
    __syncthreads();
    const int v0 = 16 * C.wave;
#pragma unroll
    for (int ct = 0; ct < 8; ++ct) { f32x4 acc = (f32x4){0.f, 0.f, 0.f, 0.f}; acc = mma16(acc, iT + v0 * 72, 72, khT + (16 * ct) * 72, 72, 64, r, q4);
#pragma unroll
        for (int i = 0; i < 4; ++i) KVT[((size_t)item * 128 + v0 + 4 * q4 + i) * 128 + 16 * ct + r] = (bf16)f2bf(acc[i]); }
    __syncthreads();
}
__device__ __forceinline__ void phase_hgrn_scan(const Params& P, const Ctx& C, const Wk& W) {
    const bf16* KVT = w_item16(P, W, AR_KVT); bf16* ST = w_item16(P, W, AR_ST); const float* HD = (const float*)(P.ws + WS_HD);
    for (int task = W.lv * 256 + C.tid; C.tid < 256 && task < 32768; task += W.n * 256) {
        const int bh = W_BT0(W) * 4 + (task >> 11), v = (task >> 4) & 127, kb = task & 15;
        float st[8];
#pragma unroll
        for (int e = 0; e < 8; ++e) st[e] = 0.f;
#pragma unroll 4
        for (int c = 0; c < 128; ++c) { const size_t item = (size_t)bh * 128 + c, off = (item * 128 + v) * 128 + kb * 8;
            const v4u kv = *(const v4u*)(KVT + off); const f32x4 d0 = *(const f32x4*)(HD + item * 128 + kb * 8), d1 = *(const f32x4*)(HD + item * 128 + kb * 8 + 4);
            v4u o; o.x = pk2(st[0], st[1]); o.y = pk2(st[2], st[3]); o.z = pk2(st[4], st[5]); o.w = pk2(st[6], st[7]);
            *(v4u*)(ST + off) = o;
#pragma unroll
            for (int e = 0; e < 4; ++e) { st[2 * e] = (e < 2 ? d0[2 * e] : d1[2 * e - 4]) * st[2 * e] + bflo(kv[e]); st[2 * e + 1] = (e < 2 ? d0[2 * e + 1] : d1[2 * e - 3]) * st[2 * e + 1] + bfhi(kv[e]); }
        }
    }
}
__device__ __forceinline__ void hgrn_out_item(const Params& P, const Ctx& C, const Wk& W, int item) {
    LAS bf16* qt = (LAS bf16*)C.lds;
    LAS bf16* kt = (LAS bf16*)(C.lds + 17408);
    LAS bf16* iT = (LAS bf16*)(C.lds + 34816);
    LAS bf16* A1 = (LAS bf16*)(C.lds + 53248);
    LAS bf16* STl = (LAS bf16*)(C.lds + 62464);
    LAS float* ol = (LAS float*)(C.lds + 97280);
    LAS float* tot = (LAS float*)(C.lds + 131072);
    const float* G = w_tok32(P, W, AR_G, 512); const bf16* PQ = w_tok16(P, W, AR_PQ, 512); const bf16* PI = w_tok16(P, W, AR_PI, 512); const bf16* PG = w_tok16(P, W, AR_PG, 512);
    const bf16* ST = w_item16(P, W, AR_ST); bf16* MIX = (bf16*)(P.ws + WS_H);
    const int bh = item >> 7, c = item & 127, b = bh >> 2, hh = bh & 3; const size_t tok0 = (size_t)b * SEQ + c * 64;
    const int tid = C.tid, k = tid & 127, seg = tid >> 7, r = C.lane & 15, q4 = C.lane >> 4;
    float g[16], bb[16], total;
    hgrn_cumsum16(G, tok0, hh, k, seg, tot, g, bb, total);
#pragma unroll
    for (int j = 0; j < 16; ++j) { const int t = seg * 16 + j; const float qv = bf2f(PQ[(tok0 + t) * 512 + hh * 128 + k]);
        qt[t * 136 + k] = (bf16)f2bf(qv * __expf(bb[j])); kt[t * 136 + k] = (bf16)f2bf(-expm1f(g[j]) * __expf(-bb[j])); }
    hgrn_stage_iT(PI, tok0, hh, iT, tid);
    for (int ch = tid; ch < 2048; ch += 512) { const int rr = ch >> 4, c8 = (ch & 15) * 8; *(LAS v4u*)(STl + rr * 136 + c8) = *(const v4u*)(ST + ((size_t)item * 128 + rr) * 128 + c8); }
    __syncthreads();
    { const int rt = C.wave >> 1;
#pragma unroll
      for (int cc = 0; cc < 2; ++cc) { const int ct = (C.wave & 1) * 2 + cc; f32x4 acc = (f32x4){0.f, 0.f, 0.f, 0.f};
          acc = mma16(acc, qt + (16 * rt) * 136, 136, kt + (16 * ct) * 136, 136, 128, r, q4);
#pragma unroll
          for (int i = 0; i < 4; ++i) { const int t = 16 * rt + 4 * q4 + i, s = 16 * ct + r; A1[t * 72 + s] = (bf16)(s <= t ? f2bf(acc[i]) : 0u); } } }
    __syncthreads();
    { const int rt = C.wave >> 1;
#pragma unroll
      for (int cc = 0; cc < 4; ++cc) { const int ct = (C.wave & 1) * 4 + cc; f32x4 acc = (f32x4){0.f, 0.f, 0.f, 0.f};
          acc = mma16(acc, A1 + (16 * rt) * 72, 72, iT + (16 * ct) * 72, 72, 64, r, q4);
          acc = mma16(acc, qt + (16 * rt) * 136, 136, STl + (16 * ct) * 136, 136, 128, r, q4);
#pragma unroll
          for (int i = 0; i < 4; ++i) ol[(16 * rt + 4 * q4 + i) * 132 + 16 * ct + r] = acc[i]; } }
    __syncthreads();
    { const int t = tid >> 3, v0 = (tid & 7) * 16; float o[16]; float ss = 0.f;
#pragma unroll
      for (int e = 0; e < 16; ++e) { o[e] = ol[t * 132 + v0 + e]; ss += o[e] * o[e]; }
      ss += __shfl_xor(ss, 1); ss += __shfl_xor(ss, 2); ss += __shfl_xor(ss, 4);
      const float rstd = 1.0f / sqrtf(ss * (1.0f / 128.0f) + NORM_EPS);
      const float* ng = P.hgrn_norm_g + hh * 128 + v0; const bf16* gp = PG + (tok0 + t) * 512 + hh * 128 + v0;
      const v4u g0 = *(const v4u*)gp, g1 = *(const v4u*)(gp + 8); unsigned w[8];
#pragma unroll
      for (int e = 0; e < 4; ++e) { w[e] = pk2(o[2 * e] * rstd * ng[2 * e] * bflo(g0[e]), o[2 * e + 1] * rstd * ng[2 * e + 1] * bfhi(g0[e]));
                                    w[4 + e] = pk2(o[8 + 2 * e] * rstd * ng[8 + 2 * e] * bflo(g1[e]), o[9 + 2 * e] * rstd * ng[9 + 2 * e] * bfhi(g1[e])); }
      v4u* dst = (v4u*)(MIX + (tok0 + t) * 1024 + 512 + hh * 128 + v0); dst[0] = (v4u){w[0], w[1], w[2], w[3]}; dst[1] = (v4u){w[4], w[5], w[6], w[7]}; }
    __syncthreads();
}

typedef short v4i16_t __attribute__((ext_vector_type(4)));
constexpr int AT_VP = 144;
constexpr int AT_QI = 512;
constexpr int AT_STO = 0, AT_STML = AT_QI * 128, AT_VW = AT_STML + AT_QI * 8;
__device__ __forceinline__ void attn_softmax_block(f32x4 (&sa)[9], int tile0, int qq, int mq0, int q4, float& mx, float& ls, bf16x8 (&pf)[5]) {
    mx = -1e30f;
#pragma unroll
    for (int t = 0; t < 9; ++t)
#pragma unroll
        for (int i = 0; i < 4; ++i) { const int kap = 16 * (tile0 + t) + 4 * q4 + i; const bool ok = kap >= qq && kap <= qq + 128 && (mq0 - 128 + kap) >= 0;
            sa[t][i] = ok ? sa[t][i] : -1e30f; mx = fmaxf(mx, sa[t][i]); }
    mx = fmaxf(mx, __shfl_xor(mx, 16)); mx = fmaxf(mx, __shfl_xor(mx, 32));
    ls = 0.f;
#pragma unroll
    for (int t = 0; t < 9; ++t)
#pragma unroll
        for (int i = 0; i < 4; ++i) { const float pv = sa[t][i] > -1e29f ? __builtin_amdgcn_exp2f(sa[t][i] - mx) : 0.f; sa[t][i] = pv; ls += pv; }
    ls += __shfl_xor(ls, 16); ls += __shfl_xor(ls, 32);
#pragma unroll
    for (int s2 = 0; s2 < 5; ++s2) { const int tl = 2 * s2 - tile0, th = 2 * s2 + 1 - tile0;
        const f32x4 lo = (tl >= 0 && tl < 9) ? sa[(tl >= 0 && tl < 9) ? tl : 0] : (f32x4){0.f, 0.f, 0.f, 0.f}, hi = (th >= 0 && th < 9) ? sa[(th >= 0 && th < 9) ? th : 0] : (f32x4){0.f, 0.f, 0.f, 0.f};
        v4u w; w.x = pk2(lo[0], lo[1]); w.y = pk2(lo[2], lo[3]); w.z = pk2(hi[0], hi[1]); w.w = pk2(hi[2], hi[3]); pf[s2] = __builtin_bit_cast(bf16x8, w); }
}
__device__ __forceinline__ void attn_merge(int g, LAS unsigned char* lds, int qloc, int q4, f32x4 (&oa)[4], float mx, float ls, bf16* orow) {
    LAS unsigned char* so = lds + AT_STO + qloc * 128 + 8 * q4; LAS float* sml = (LAS float*)(lds + AT_STML) + 2 * qloc;
    float mo = mx, lo2 = ls;
    if (g > 0) { const float m_old = sml[0], l_old = sml[1]; const float M = fmaxf(m_old, mx); const float fo = __builtin_amdgcn_exp2f(m_old - M), fn = __builtin_amdgcn_exp2f(mx - M);
#pragma unroll
        for (int dt = 0; dt < 4; ++dt) { const unsigned long long w = *(const LAS unsigned long long*)(so + 32 * dt); const unsigned w0 = (unsigned)w, w1 = (unsigned)(w >> 32);
            oa[dt] = oa[dt] * fn + (f32x4){bflo(w0), bfhi(w0), bflo(w1), bfhi(w1)} * fo; }
        mo = M; lo2 = ls * fn + l_old * fo; }
    if (g < 2) {
#pragma unroll
        for (int dt = 0; dt < 4; ++dt) *(LAS unsigned long long*)(so + 32 * dt) = (unsigned long long)pk2(oa[dt][0], oa[dt][1]) | ((unsigned long long)pk2(oa[dt][2], oa[dt][3]) << 32);
        if (q4 == 0) { sml[0] = mo; sml[1] = lo2; }
    } else { const float inv = 1.0f / lo2;
#pragma unroll
        for (int dt = 0; dt < 4; ++dt) { const f32x4 v = oa[dt] * inv; *(unsigned long long*)(orow + 16 * dt) = (unsigned long long)pk2(v[0], v[1]) | ((unsigned long long)pk2(v[2], v[3]) << 32); } }
}
__device__ __forceinline__ void attn_item(const Params& P, const Ctx& C, const Wk& W, int b, int hd, int qt) {
    LAS unsigned char* Vw = C.lds + AT_VW + C.wave * (64 * AT_VP);
    const bf16* QKV = w_tok16(P, W, AR_QK, 3072); bf16* O = (bf16*)(P.ws + WS_H);
    const int lane = C.lane, r = lane & 15, q4 = lane >> 4;
    const int t0 = qt * AT_QI; const size_t rowbase = (size_t)b * SEQ;
    const bf16* Kb = QKV + rowbase * 3072 + 1024 + hd * 64; const bf16* Vb = QKV + rowbase * 3072 + 2048 + hd * 64;
#pragma unroll 1
    for (int g = 0; g < 3; ++g) {
        const int dsh = 4 - 2 * g, d = 1 << dsh;
#pragma unroll 1
        for (int uu = 0; uu < 2; ++uu) {
            const int u = C.wave + 8 * uu;
            const int c = u & (d - 1), j = u >> dsh;
            const int mq0 = (t0 >> dsh) + 32 * j;
            const int ql0 = c + d * (32 * j + r), ql1 = ql0 + 16 * d;
            const bf16* qp0 = QKV + (rowbase + t0 + ql0) * 3072 + hd * 64 + 8 * q4; const bf16* qp1 = QKV + (rowbase + t0 + ql1) * 3072 + hd * 64 + 8 * q4;
            const bf16x8 bq00 = *(const bf16x8*)qp0, bq01 = *(const bf16x8*)(qp0 + 32), bq10 = *(const bf16x8*)qp1, bq11 = *(const bf16x8*)(qp1 + 32);
            bf16x8 ka[10][2];
#pragma unroll
            for (int t = 0; t < 10; ++t) { int mk = mq0 - 128 + 16 * t + r; mk = mk < 0 ? 0 : mk;
                const bf16* kp = Kb + (size_t)(c + d * mk) * 3072 + 8 * q4; ka[t][0] = *(const bf16x8*)kp; ka[t][1] = *(const bf16x8*)(kp + 32); }
            v4u vr[2][8];
#pragma unroll
            for (int it = 0; it < 8; ++it) { const int kap = 8 * it + (lane >> 3); int mk = mq0 - 128 + kap; mk = mk < 0 ? 0 : mk;
                vr[0][it] = *(const v4u*)(Vb + (size_t)(c + d * mk) * 3072 + (lane & 7) * 8); }
            __builtin_amdgcn_sched_barrier(0);
            bf16x8 pf0[5], pf1[5]; float mx0, ls0, mx1, ls1;
            { f32x4 sa[9];
#pragma unroll
              for (int t = 0; t < 9; ++t) { sa[t] = (f32x4){0.f, 0.f, 0.f, 0.f}; sa[t] = __builtin_amdgcn_mfma_f32_16x16x32_bf16(ka[t][0], bq00, sa[t], 0, 0, 0); sa[t] = __builtin_amdgcn_mfma_f32_16x16x32_bf16(ka[t][1], bq01, sa[t], 0, 0, 0); }
              attn_softmax_block(sa, 0, r, mq0, q4, mx0, ls0, pf0); }
            { f32x4 sa[9];
#pragma unroll
              for (int t = 0; t < 9; ++t) { sa[t] = (f32x4){0.f, 0.f, 0.f, 0.f}; sa[t] = __builtin_amdgcn_mfma_f32_16x16x32_bf16(ka[t + 1][0], bq10, sa[t], 0, 0, 0); sa[t] = __builtin_amdgcn_mfma_f32_16x16x32_bf16(ka[t + 1][1], bq11, sa[t], 0, 0, 0); }
              __builtin_amdgcn_sched_barrier(0);
#pragma unroll
              for (int it = 0; it < 8; ++it) { const int kap = 64 + 8 * it + (lane >> 3); int mk = mq0 - 128 + kap; mk = mk < 0 ? 0 : mk;
                  vr[1][it] = *(const v4u*)(Vb + (size_t)(c + d * mk) * 3072 + (lane & 7) * 8); }
              __builtin_amdgcn_sched_barrier(0);
              attn_softmax_block(sa, 1, 16 + r, mq0, q4, mx1, ls1, pf1); }
            v4u vr2[4];
#pragma unroll
            for (int it = 0; it < 4; ++it) { const int kap = 128 + 8 * it + (lane >> 3); const int mk = mq0 - 128 + kap;
                vr2[it] = *(const v4u*)(Vb + (size_t)(c + d * mk) * 3072 + (lane & 7) * 8); }
            f32x4 oa0[4], oa1[4];
#pragma unroll
            for (int dt = 0; dt < 4; ++dt) { oa0[dt] = (f32x4){0.f, 0.f, 0.f, 0.f}; oa1[dt] = (f32x4){0.f, 0.f, 0.f, 0.f}; }
#pragma unroll
            for (int ch = 0; ch < 3; ++ch) {
#pragma unroll
                for (int it = 0; it < 8; ++it) { const int row = 8 * it + (lane >> 3);
                    if (ch < 2) *(LAS v4u*)(Vw + row * AT_VP + (lane & 7) * 16) = vr[ch < 2 ? ch : 0][it];
                    else if (it < 4) *(LAS v4u*)(Vw + row * AT_VP + (lane & 7) * 16) = vr2[it < 4 ? it : 0]; }
                asm volatile("s_waitcnt lgkmcnt(0)" ::: "memory");
#pragma unroll
                for (int s2 = 0; s2 < 2; ++s2) { const int sx = 2 * ch + s2; if (sx < 5) {
#pragma unroll
                    for (int dt = 0; dt < 4; ++dt) {
                        const LAS unsigned char* vp = Vw + (32 * s2 + 4 * q4 + (r >> 2)) * AT_VP + dt * 32 + (r & 3) * 8;
                        const v4i16_t x = __builtin_amdgcn_ds_read_tr16_b64_v4i16((LAS v4i16_t*)vp), y = __builtin_amdgcn_ds_read_tr16_b64_v4i16((LAS v4i16_t*)(vp + 16 * AT_VP));
                        const bf16x8 av = (bf16x8){x[0], x[1], x[2], x[3], y[0], y[1], y[2], y[3]};
                        oa0[dt] = __builtin_amdgcn_mfma_f32_16x16x32_bf16(av, pf0[sx], oa0[dt], 0, 0, 0);
                        oa1[dt] = __builtin_amdgcn_mfma_f32_16x16x32_bf16(av, pf1[sx], oa1[dt], 0, 0, 0); } } }
                asm volatile("s_waitcnt lgkmcnt(0)" ::: "memory");
            }
            attn_merge(g, C.lds, ql0, q4, oa0, mx0, ls0, O + (rowbase + t0 + ql0) * 1024 + hd * 64 + 4 * q4);
            attn_merge(g, C.lds, ql1, q4, oa1, mx1, ls1, O + (rowbase + t0 + ql1) * 1024 + hd * 64 + 4 * q4);
        }
        __syncthreads();
    }
}

__device__ __forceinline__ unsigned ordf(float s) { const unsigned u = __builtin_bit_cast(unsigned, s); return u ^ ((unsigned)((int)u >> 31) | 0x80000000u); }
__device__ __forceinline__ float unordf(unsigned v) { return __builtin_bit_cast(float, v ^ ((unsigned)((int)(~v) >> 31) | 0x80000000u)); }
__device__ __forceinline__ void ins16(unsigned (&top)[16], unsigned x) {
#pragma unroll
    for (int j = 0; j < 16; ++j) { const unsigned hi = top[j] > x ? top[j] : x; x = top[j] > x ? x : top[j]; top[j] = hi; }
}
#define CE_D(a, b) { const unsigned hi_ = (a) > (b) ? (a) : (b), lo_ = (a) > (b) ? (b) : (a); (a) = hi_; (b) = lo_; }
__device__ __forceinline__ void sort16_desc(unsigned (&v)[16]) {
#pragma unroll
    for (int k = 2; k <= 16; k <<= 1)
#pragma unroll
        for (int j = k >> 1; j > 0; j >>= 1)
#pragma unroll
            for (int i = 0; i < 16; ++i) { const int l = i ^ j; if (l > i) { if ((i & k) == 0) CE_D(v[i], v[l]) else CE_D(v[l], v[i]) } }
}
__device__ __forceinline__ void bitonic_merge16_desc(unsigned (&c)[16]) {
#pragma unroll
    for (int st = 8; st >= 1; st >>= 1)
#pragma unroll
        for (int j = 0; j < 16; ++j) if ((j & st) == 0) CE_D(c[j], c[j + st])
}
__device__ __forceinline__ void top16_of_two(unsigned (&a)[16], const unsigned (&b)[16]) {
#pragma unroll
    for (int j = 0; j < 16; ++j) a[j] = a[j] > b[15 - j] ? a[j] : b[15 - j];
    bitonic_merge16_desc(a);
}
__device__ __forceinline__ void merge16(unsigned (&top)[16], int mask) {
    unsigned o[16];
#pragma unroll
    for (int j = 0; j < 16; ++j) o[j] = (unsigned)__shfl_xor((int)top[j], mask);
    top16_of_two(top, o);
}
__device__ __forceinline__ void phase_peer_topk(const Params& P, const Ctx& C, const Wk& W, int layer) {
    LAS bf16* SK = (LAS bf16*)C.lds;
    const bf16* SKB = (const bf16*)(P.ws + WS_SKB) + (size_t)layer * 32768; const bf16* QP = w_tok16(P, W, AR_QP, 2048);
    int* IDX = (int*)(P.ws + WS_IDX); float* GATE = (float*)(P.ws + WS_GATE);
    for (int ch = C.tid; ch < 4096; ch += 512) { const int rr = ch >> 4, c8 = (ch & 15) * 8; *(LAS v4u*)(SK + rr * 136 + c8) = *(const v4u*)(SKB + (size_t)rr * 128 + c8); }
    __syncthreads();
    const int r = C.lane & 15, q4 = C.lane >> 4;
    const int gw = W.lv * NWAVES + C.wave, NGW = W.n * NWAVES;
    for (int grp = W_TK0(W) / 2 + gw; grp < W_TK0(W) / 2 + HT * 8 / 16; grp += NGW) {
        const size_t task = (size_t)grp * 16 + r;
        unsigned lst[2][16];
#pragma unroll
        for (int half = 0; half < 2; ++half) {
            bf16x8 bq[4];
#pragma unroll
            for (int ks = 0; ks < 4; ++ks) bq[ks] = *(const bf16x8*)(QP + task * 256 + half * 128 + ks * 32 + 8 * q4);
            unsigned ka[16], kb[16];
#pragma unroll
            for (int nt = 0; nt < 8; ++nt) { f32x4 acc = (f32x4){0.f, 0.f, 0.f, 0.f};
#pragma unroll
                for (int ks = 0; ks < 4; ++ks) { const bf16x8 a = *(const LAS bf16x8*)(SK + (half * 128 + 16 * nt + r) * 136 + ks * 32 + 8 * q4); acc = __builtin_amdgcn_mfma_f32_16x16x32_bf16(a, bq[ks], acc, 0, 0, 0); }
#pragma unroll
                for (int i = 0; i < 4; ++i) { const unsigned n = 16 * nt + 4 * q4 + i; const unsigned key = (ordf(acc[i]) & ~127u) | (127u - n); if (nt < 4) ka[4 * nt + i] = key; else kb[4 * (nt - 4) + i] = key; }
                if (nt == 3) sort16_desc(ka);
                __builtin_amdgcn_sched_barrier(0); }
            sort16_desc(kb); top16_of_two(ka, kb);
            merge16(ka, 16); merge16(ka, 32);
#pragma unroll
            for (int j = 0; j < 16; ++j) lst[half][j] = ka[j];
        }
        float v2[16]; unsigned e2[16];
#pragma unroll
        for (int j = 0; j < 16; ++j) { v2[j] = unordf(lst[1][j] & ~127u); e2[j] = 127u - (lst[1][j] & 127u); }
        float v1s[4]; unsigned e1s[4];
#pragma unroll
        for (int k = 0; k < 4; ++k) { const unsigned w = q4 == 0 ? lst[0][4 * k] : q4 == 1 ? lst[0][4 * k + 1] : q4 == 2 ? lst[0][4 * k + 2] : lst[0][4 * k + 3];
            v1s[k] = unordf(w & ~127u); e1s[k] = (127u - (w & 127u)) << 7; }
        unsigned top[16];
#pragma unroll
        for (int j = 0; j < 16; ++j) top[j] = (ordf(v1s[0] + v2[j]) & ~16383u) | e1s[0] | e2[j];
        sort16_desc(top);
#pragma unroll
        for (int j = 0; j < 3; ++j) ins16(top, (ordf(v1s[1] + v2[j]) & ~16383u) | e1s[1] | e2[j]);
        ins16(top, (ordf(v1s[2] + v2[0]) & ~16383u) | e1s[2] | e2[0]);
        ins16(top, (ordf(v1s[3] + v2[0]) & ~16383u) | e1s[3] | e2[0]);
        merge16(top, 16); merge16(top, 32);
        float ev[16]; float den = 0.f; const float mx = unordf(top[0] & ~16383u);
#pragma unroll
        for (int j = 0; j < 16; ++j) { ev[j] = __expf(unordf(top[j] & ~16383u) - mx); den += ev[j]; }
        const float inv = 1.0f / den;
        int* ip = IDX + task * 16; float* gp = GATE + task * 16;
        if (q4 == 0) { *(v4u*)(ip) = (v4u){top[0] & 16383u, top[1] & 16383u, top[2] & 16383u, top[3] & 16383u}; *(f32x4*)(gp) = (f32x4){ev[0] * inv, ev[1] * inv, ev[2] * inv, ev[3] * inv}; }
        else if (q4 == 1) { *(v4u*)(ip + 4) = (v4u){top[4] & 16383u, top[5] & 16383u, top[6] & 16383u, top[7] & 16383u}; *(f32x4*)(gp + 4) = (f32x4){ev[4] * inv, ev[5] * inv, ev[6] * inv, ev[7] * inv}; }
        else if (q4 == 2) { *(v4u*)(ip + 8) = (v4u){top[8] & 16383u, top[9] & 16383u, top[10] & 16383u, top[11] & 16383u}; *(f32x4*)(gp + 8) = (f32x4){ev[8] * inv, ev[9] * inv, ev[10] * inv, ev[11] * inv}; }
        else { *(v4u*)(ip + 12) = (v4u){top[12] & 16383u, top[13] & 16383u, top[14] & 16383u, top[15] & 16383u}; *(f32x4*)(gp + 12) = (f32x4){ev[12] * inv, ev[13] * inv, ev[14] * inv, ev[15] * inv}; }
    }
}
struct ExpRow { v4u d[4], u[4]; float ds, us, gk; };
__device__ __forceinline__ void exp_issue(ExpRow& R, const unsigned char* TD, const unsigned char* TU, const float* SD, int ex, float gk, int jl) {
    const unsigned char* dr = TD + (size_t)ex * TROW; const unsigned char* ur = TU + (size_t)ex * TROW;
#pragma unroll
    for (int c = 0; c < 4; ++c) R.d[c] = *(const v4u*)(dr + (c * 16 + jl) * 16);
#pragma unroll
    for (int c = 0; c < 4; ++c) R.u[c] = *(const v4u*)(ur + (c * 16 + jl) * 16);
    R.ds = SD[ex]; R.us = SD[16384 + ex]; R.gk = gk;
}
__device__ __forceinline__ void exp_consume(const ExpRow& R, const unsigned (&hp)[32], f32x2 (&oacc)[32]) {
    f32x2 a2 = (f32x2){0.f, 0.f};
#pragma unroll
    for (int c = 0; c < 4; ++c)
#pragma unroll
        for (int w = 0; w < 4; ++w) { const f32x2 lo = __builtin_amdgcn_cvt_pk_f32_fp8((int)R.d[c][w], false), hi = __builtin_amdgcn_cvt_pk_f32_fp8((int)R.d[c][w], true);
            unsigned h0 = hp[c * 8 + 2 * w], h1 = hp[c * 8 + 2 * w + 1]; asm volatile("" : "+v"(h0), "+v"(h1));
            a2 = a2 + lo * (f32x2){bflo(h0), bfhi(h0)}; a2 = a2 + hi * (f32x2){bflo(h1), bfhi(h1)}; }
    float a = (a2.x + a2.y) * R.ds;
    a += __shfl_xor(a, 1); a += __shfl_xor(a, 2); a += __shfl_xor(a, 4); a += __shfl_xor(a, 8);
    const float wk = R.gk * gelu_f(a) * R.us; const f32x2 wk2 = (f32x2){wk, wk};
#pragma unroll
    for (int c = 0; c < 4; ++c)
#pragma unroll
        for (int w = 0; w < 4; ++w) { const f32x2 lo = __builtin_amdgcn_cvt_pk_f32_fp8((int)R.u[c][w], false), hi = __builtin_amdgcn_cvt_pk_f32_fp8((int)R.u[c][w], true);
            oacc[c * 8 + 2 * w] = oacc[c * 8 + 2 * w] + wk2 * lo; oacc[c * 8 + 2 * w + 1] = oacc[c * 8 + 2 * w + 1] + wk2 * hi; }
}
__device__ __forceinline__ void phase_peer_experts(const Params& P, const Ctx& Cin, const Wk& W, int layer, bool last) {
    const Ctx C = fresh_ctx(Cin);
    const unsigned char* TD = P.ws + WS_TAB8 + (size_t)(2 * layer) * TAB8_BYTES; const unsigned char* TU = P.ws + WS_TAB8 + (size_t)(2 * layer + 1) * TAB8_BYTES; const float* SD = (const float*)(P.ws + WS_SC8) + (size_t)(2 * layer) * 16384; bf16* H = (bf16*)(P.ws + WS_H);
    const int* IDX = (const int*)(P.ws + WS_IDX); const float* GATE = (const float*)(P.ws + WS_GATE); const float* MOD = (const float*)(P.ws + WS_MOD);
    const int lane = C.lane, grp = lane >> 4, jl = lane & 15;
    unsigned* ticket = (unsigned*)(P.ws + WS_CTL) + 96 + 2 * layer + W.h;
    int tnext = 0; if (lane == 0) tnext = (int)atomicAdd(ticket, 1u); tnext = __builtin_amdgcn_readfirstlane(tnext);
    while (tnext < HT) {
        const int tok = W_TK0(W) + tnext;
        { int tn = 0; if (lane == 0) tn = (int)atomicAdd(ticket, 1u); tnext = tn; }
        const int b = tok >> 13;
        const int i0 = IDX[(size_t)tok * 128 + lane], i1 = IDX[(size_t)tok * 128 + 64 + lane];
        const float g0 = GATE[(size_t)tok * 128 + lane], g1 = GATE[(size_t)tok * 128 + 64 + lane];
        unsigned hf[32];
#pragma unroll
        for (int c = 0; c < 4; ++c) { const bf16* hp = H + (size_t)tok * 1024 + (c * 16 + jl) * 16; const v4u w0 = *(const v4u*)hp, w1 = *(const v4u*)(hp + 8);
#pragma unroll
            for (int e = 0; e < 4; ++e) { hf[c * 8 + e] = w0[e]; hf[c * 8 + 4 + e] = w1[e]; } }
        f32x2 oacc[32];
#pragma unroll
        for (int e = 0; e < 32; ++e) oacc[e] = (f32x2){0.f, 0.f};
        ExpRow RA, RB;
        exp_issue(RA, TD, TU, SD, __shfl(i0, grp), __shfl(g0, grp), jl);
        for (int it = 0; it < 32 * EXP_REP; it += 2) {
            { const int kk = ((it + 1) & 31) * 4 + grp; const int el = __shfl(i0, kk & 63), eh = __shfl(i1, kk & 63); const float gl = __shfl(g0, kk & 63), gh = __shfl(g1, kk & 63);
              exp_issue(RB, TD, TU, SD, kk < 64 ? el : eh, kk < 64 ? gl : gh, jl); }
            exp_consume(RA, hf, oacc);
            { const int kk = ((it + 2) & 31) * 4 + grp; const int el = __shfl(i0, kk & 63), eh = __shfl(i1, kk & 63); const float gl = __shfl(g0, kk & 63), gh = __shfl(g1, kk & 63);
              exp_issue(RA, TD, TU, SD, kk < 64 ? el : eh, kk < 64 ? gl : gh, jl); }
            exp_consume(RB, hf, oacc);
        }
        f32x2 h1[16];
        { const bool up = (grp & 2) != 0;
#pragma unroll
          for (int e = 0; e < 16; ++e) { const f32x2 keep = up ? oacc[16 + e] : oacc[e], send = up ? oacc[e] : oacc[16 + e]; h1[e] = keep + (f32x2){__shfl_xor(send.x, 32), __shfl_xor(send.y, 32)}; } }
        f32x2 h2[8];
        { const bool up = (grp & 1) != 0;
#pragma unroll
          for (int e = 0; e < 8; ++e) { const f32x2 keep = up ? h1[8 + e] : h1[e], send = up ? h1[e] : h1[8 + e]; h2[e] = keep + (f32x2){__shfl_xor(send.x, 16), __shfl_xor(send.y, 16)}; } }
        const int d0 = (grp * 16 + jl) * 16;
        const float* g2p = MOD + (size_t)(layer * 8 + b) * 6144 + 5120 + d0; const float psc = ((ABL_ON >= (layer == 0 ? 2 : 4)) ? 1.f : 0.f) * (1.0f / EXP_REP);
        float* xp = P.out + (size_t)tok * 1024 + d0;
        float xn[16]; float ss = 0.f;
#pragma unroll
        for (int q = 0; q < 4; ++q) { const f32x4 xa = *(const f32x4*)(xp + 4 * q), ga = *(const f32x4*)(g2p + 4 * q);
            xn[4 * q] = xa[0] + psc * ga[0] * h2[2 * q].x; xn[4 * q + 1] = xa[1] + psc * ga[1] * h2[2 * q].y; xn[4 * q + 2] = xa[2] + psc * ga[2] * h2[2 * q + 1].x; xn[4 * q + 3] = xa[3] + psc * ga[3] * h2[2 * q + 1].y; }
#pragma unroll
        for (int e = 0; e < 16; ++e) ss += xn[e] * xn[e];
        const float rstd = 1.0f / sqrtf(wave_sum(ss) * (1.0f / 1024.0f) + NORM_EPS);
        if (!last) {
            const float* ng = P.norm_mix_g + (layer + 1) * 1024 + d0; const float* mb = MOD + (size_t)((layer + 1) * 8 + b) * 6144 + d0;
            unsigned w[8];
#pragma unroll
            for (int q = 0; q < 4; ++q) { *(f32x4*)(xp + 4 * q) = (f32x4){xn[4 * q], xn[4 * q + 1], xn[4 * q + 2], xn[4 * q + 3]}; }
#pragma unroll
            for (int e = 0; e < 8; ++e) w[e] = pk2(xn[2 * e] * rstd * ng[2 * e] * (1.0f + mb[1024 + 2 * e]) + mb[2 * e], xn[2 * e + 1] * rstd * ng[2 * e + 1] * (1.0f + mb[1024 + 2 * e + 1]) + mb[2 * e + 1]);
            v4u* hp = (v4u*)(H + (size_t)tok * 1024 + d0); hp[0] = (v4u){w[0], w[1], w[2], w[3]}; hp[1] = (v4u){w[4], w[5], w[6], w[7]};
        } else {
            const float* fg = P.final_norm_g + d0;
#pragma unroll
            for (int q = 0; q < 4; ++q) *(f32x4*)(xp + 4 * q) = (f32x4){xn[4 * q] * rstd * fg[4 * q], xn[4 * q + 1] * rstd * fg[4 * q + 1], xn[4 * q + 2] * rstd * fg[4 * q + 2], xn[4 * q + 3] * rstd * fg[4 * q + 3]};
        }
        tnext = __builtin_amdgcn_readfirstlane(tnext);
    }
}

#ifndef NC_PER_XCD
#define NC_PER_XCD 16
#endif
#ifdef PROBE_SEL
#define SUBSTAMP(i) do { if (W.c == 0 && C.tid == 0) __hip_atomic_store((unsigned*)(P.ws + WS_CTL) + 128 + 16 * W.h + (i), (unsigned)__builtin_amdgcn_s_memrealtime(), __ATOMIC_RELAXED, __HIP_MEMORY_SCOPE_AGENT); } while (0)
#else
#define SUBSTAMP(i) do {} while (0)
#endif
__device__ __forceinline__ void run_C0(const Params& P, const Ctx& Cin, const Wk& W, const XcdBarrier& tb) {
    const Ctx C = fresh_ctx(Cin);
    SUBSTAMP(0);
    unsigned char* ws = P.ws; float* MOD = (float*)(ws + WS_MOD); bf16* H = (bf16*)(ws + WS_H);
    const size_t tk = (size_t)W_TK0(W); unsigned char* const ar = w_ar(P, W);
    phase_norm(P, C, W, P.x, P.norm_mix_g, 0, 0); xcd_barrier(tb); SUBSTAMP(1);
    { pg8::Gemm g{H + tk * 1024, (const bf16*)(ws + WS_WIN), HT, 3072, 1024}; pg8::StaticOrder S; S.init(HT, 3072, W.n, W.c);
      EpiInProj E{(bf16*)(ar + AR_PU), (bf16*)(ar + AR_PV), (bf16*)(ar + AR_PQ), (bf16*)(ar + AR_PI), (bf16*)(ar + AR_PG), (float*)(ar + AR_G), (const float*)(ws + WS_LB)};
      pg8::gemm_phase<EpiInProj, pg8::StaticOrder, true, true>(C.lds, g, S, E); } xcd_barrier(tb); SUBSTAMP(2);
    for (int it = W.lv; it < 1024; it += W.n) gmlp_item(P, C, W, W_TK0(W) / 128 + (it >> 2), it & 3);
    for (int it = W.lv; it < 2048; it += W.n) hgrn_local_item(P, C, W, W_BT0(W) * 512 + it);
    xcd_barrier(tb); SUBSTAMP(3);
    phase_hgrn_scan(P, C, W); xcd_barrier(tb); SUBSTAMP(4);
    for (int it = W.lv; it < 2048; it += W.n) hgrn_out_item(P, C, W, W_BT0(W) * 512 + it);
    xcd_barrier(tb); SUBSTAMP(5);
    { pg8::Gemm g{H + tk * 1024, (const bf16*)(ws + WS_WOUT0), HT, 1024, 1024}; pg8::StaticOrder S; S.init(HT, 1024, W.n, W.c);
      EpiResid E{P.x + tk * 1024, P.out + tk * 1024, MOD + 2048 + (size_t)W_BT0(W) * 6144, 1.f};
      pg8::gemm_phase<EpiResid, pg8::StaticOrder, true, true>(C.lds, g, S, E); } xcd_barrier(tb); SUBSTAMP(6);
    phase_norm(P, C, W, P.out, P.norm_ffn_g, 0, 3072); xcd_barrier(tb); SUBSTAMP(7);
    { pg8::Gemm g{H + tk * 1024, (const bf16*)(ws + WS_WQ0), HT, 2048, 1024}; pg8::StaticOrder S; S.init(HT, 2048, W.n, W.c);
      EpiBf16P E{(bf16*)(ar + AR_QP), 2048};
      pg8::gemm_phase<EpiBf16P, pg8::StaticOrder, true, true>(C.lds, g, S, E); }
    SUBSTAMP(9);
}
__device__ __forceinline__ void run_C1(const Params& P, const Ctx& Cin, const Wk& W, const XcdBarrier& tb) {
    const Ctx C = fresh_ctx(Cin);
    SUBSTAMP(0);
    unsigned char* ws = P.ws; float* MOD = (float*)(ws + WS_MOD); bf16* H = (bf16*)(ws + WS_H);
    const size_t tk = (size_t)W_TK0(W); unsigned char* const ar = w_ar(P, W);
    { pg8::Gemm g{H + tk * 1024, (const bf16*)(ws + WS_WQKV), HT, 3072, 1024}; pg8::StaticOrder S; S.init(HT, 3072, W.n, W.c);
      EpiQKRot E{(bf16*)(ar + AR_QK), (const float*)(ws + WS_CS) + tk * 16};
      pg8::gemm_phase<EpiQKRot, pg8::StaticOrder, true, true>(C.lds, g, S, E); } xcd_barrier(tb); SUBSTAMP(1);
    for (int it = W.lv; it < (NB / 2) * 16 * 16; it += W.n) attn_item(P, C, W, W_BT0(W) + (it >> 8), (it >> 4) & 15, it & 15);
    xcd_barrier(tb); SUBSTAMP(2);
    { pg8::Gemm g{H + tk * 1024, (const bf16*)(ws + WS_WOUT1), HT, 1024, 1024}; pg8::StaticOrder S; S.init(HT, 1024, W.n, W.c);
      EpiResid E{P.out + tk * 1024, P.out + tk * 1024, MOD + (size_t)8 * 6144 + 2048 + (size_t)W_BT0(W) * 6144, 1.f};
      pg8::gemm_phase<EpiResid, pg8::StaticOrder, true, true>(C.lds, g, S, E); } xcd_barrier(tb); SUBSTAMP(3);
    phase_norm(P, C, W, P.out, P.norm_ffn_g + 1024, 1, 3072); xcd_barrier(tb); SUBSTAMP(4);
    { pg8::Gemm g{H + tk * 1024, (const bf16*)(ws + WS_WQ1), HT, 2048, 1024}; pg8::StaticOrder S; S.init(HT, 2048, W.n, W.c);
      EpiBf16P E{(bf16*)(ar + AR_QP), 2048};
      pg8::gemm_phase<EpiBf16P, pg8::StaticOrder, true, true>(C.lds, g, S, E); }
    SUBSTAMP(9);
}
__device__ __forceinline__ void run_E(const Params& P, const Ctx& Cin, const Wk& W, const XcdBarrier& tb, int layer) {
    { const Ctx C = fresh_ctx(Cin); phase_peer_topk(P, C, W, layer); }
    xcd_barrier(tb);
    if (W.c == 0 && Cin.tid == 0) __hip_atomic_store((unsigned*)(P.ws + WS_CTL) + 112 + 2 * layer + W.h, 1u, __ATOMIC_RELAXED, __HIP_MEMORY_SCOPE_AGENT);
    phase_peer_experts(P, Cin, W, layer, layer == 1);
}
__device__ __forceinline__ void help_E(const Params& P, const Ctx& Cin, int h, int layer) {
    volatile LAS unsigned* okw = (volatile LAS unsigned*)(Cin.lds + LDSCTL_OFF + 192);
    if (Cin.tid == 0) { unsigned* flag = (unsigned*)(P.ws + WS_CTL) + 112 + 2 * layer + h; unsigned ok = 0u;
        for (unsigned sp = 0; sp < (1u << 16); ++sp) { if (__hip_atomic_load(flag, __ATOMIC_RELAXED, __HIP_MEMORY_SCOPE_AGENT) != 0u) { ok = 1u; break; } __builtin_amdgcn_s_sleep(8); }
        __builtin_amdgcn_fence(__ATOMIC_ACQUIRE, "agent"); asm volatile("s_waitcnt vmcnt(0)" ::: "memory");
        *okw = ok; }
    __syncthreads();
    const bool ok = *okw != 0u;
    __syncthreads();
    if (ok) { Wk W; W.lv = 0; W.n = 1; W.c = 1; W.h = h; phase_peer_experts(P, Cin, W, layer, layer == 1); }
}
__global__ void __launch_bounds__(NWAVES * 64, 2) hybrid_fwd(Params P) {
    extern __shared__ __attribute__((aligned(16))) unsigned char lds_raw[];
    Ctx C;
    C.lds = (LAS unsigned char*)lds_raw;
    C.tid = threadIdx.x; C.lane = C.tid & 63; C.wave = __builtin_amdgcn_readfirstlane(C.tid >> 6);
    C.G = gridDim.x; const int bx = blockIdx.x; C.vcu = (bx % 8) * (C.G / 8) + bx / 8;
    volatile LAS unsigned* MISC = (volatile LAS unsigned*)(C.lds + MISC_OFF);
    for (int u = C.tid; u < (LDS_BYTES - LDSCTL_OFF) / 4; u += NWAVES * 64) ((LAS unsigned*)(C.lds + LDSCTL_OFF))[u] = 0u;
    __syncthreads();
    unsigned* ctl = (unsigned*)(P.ws + WS_CTL);
    const int xl = bx & 7, jx = bx >> 3, perx = C.G / 8;
    const bool inC = jx < NC_PER_XCD;
    const int nC = 8 * NC_PER_XCD, nE = C.G - nC;
    const XcdBarrier bar_all = xcd_barrier_post(ctl + CW_BAR, MISC + 8);
    XcdBarrier bar_c; bar_c.bar = ctl + CW_BAR + XCD_BAR_WORDS; bar_c.x = bar_all.x; bar_c.st = MISC + 10; bar_c.G = (unsigned)nC;
    if (inC && C.tid == 0) (void)xb_add(&bar_c.bar[XB_XCNT(bar_c.x)], 1u);
    XcdBarrier bar_e; bar_e.bar = ctl + CW_BAR + 2 * XCD_BAR_WORDS; bar_e.x = bar_all.x; bar_e.st = MISC + 12; bar_e.G = (unsigned)nE;
    if (!inC && C.tid == 0) (void)xb_add(&bar_e.bar[XB_XCNT(bar_e.x)], 1u);
    Wk Wall; Wall.lv = C.vcu; Wall.n = C.G; Wall.c = bx; Wall.h = 0;
    Wk Wc; Wc.lv = xl * NC_PER_XCD + jx; Wc.n = nC; Wc.c = jx * 8 + xl; Wc.h = 0;
    Wk We; { const int je = jx - NC_PER_XCD, ne = perx - NC_PER_XCD; We.lv = xl * ne + je; We.n = nE; We.c = je * 8 + xl; We.h = 0; }
    phase_prologue(P, C);
    xcd_barrier(bar_all);
#ifdef PROBE_SEL
    unsigned long long tp0 = __builtin_amdgcn_s_memrealtime(), tp1 = 0, tp2 = 0, tp3 = 0, tp4 = 0, tp5 = 0, tpe1 = 0, tpe2 = 0, tpe3 = 0;
#define STAMP(v) v = __builtin_amdgcn_s_memrealtime()
#else
#define STAMP(v)
#endif
    Wall.h = 0; run_C0(P, C, Wall, bar_all); xcd_barrier(bar_all); STAMP(tp1);
    if (inC) { Wc.h = 1; run_C0(P, C, Wc, bar_c); help_E(P, C, 0, 0); } else { We.h = 0; run_E(P, C, We, bar_e, 0); }
    STAMP(tpe1);
#ifdef PROBE_SEL
    if (C.tid == 0) atomicMax(ctl + 80 + (inC ? 0 : 1), (unsigned)(tpe1 - tp1));
#endif
    xcd_barrier(bar_all); STAMP(tp2);
    if (inC) { Wc.h = 0; run_C1(P, C, Wc, bar_c); help_E(P, C, 1, 0); } else { We.h = 1; run_E(P, C, We, bar_e, 0); }
    STAMP(tpe2);
#ifdef PROBE_SEL
    if (C.tid == 0) atomicMax(ctl + 82 + (inC ? 0 : 1), (unsigned)(tpe2 - tp2));
#endif
    xcd_barrier(bar_all); STAMP(tp3);
    if (inC) { Wc.h = 1; run_C1(P, C, Wc, bar_c); help_E(P, C, 0, 1); } else { We.h = 0; run_E(P, C, We, bar_e, 1); }
    STAMP(tpe3);
#ifdef PROBE_SEL
    if (C.tid == 0) atomicMax(ctl + 84 + (inC ? 0 : 1), (unsigned)(tpe3 - tp3));
#endif
    xcd_barrier(bar_all); STAMP(tp4);
    Wall.h = 1; run_E(P, C, Wall, bar_all, 1);
#ifdef PROBE_SEL
    STAMP(tp5);
    { unsigned long long d = 0; const int sel = PROBE_SEL;
      if (sel == 0) d = tp1 - tp0; if (sel == 1) d = tp2 - tp1; if (sel == 2) d = tp3 - tp2; if (sel == 3) d = tp4 - tp3; if (sel == 4) d = tp5 - tp4;
      if (sel == 5 || sel == 8) d = tpe1 - tp1; if (sel == 6 || sel == 9) d = tpe2 - tp2; if (sel == 7 || sel == 10) d = tpe3 - tp3;
      const int who = sel >= 8 ? 8 * NC_PER_XCD : 0;
      if (sel >= 20) { const unsigned* sp = (const unsigned*)(P.ws + WS_CTL) + 128 + 16 * PROBE_HALF; const int i = sel - 20; const int nxt = (i == PROBE_LAST) ? 9 : i + 1; d = (unsigned long long)(__hip_atomic_load(sp + nxt, __ATOMIC_RELAXED, __HIP_MEMORY_SCOPE_AGENT) - __hip_atomic_load(sp + i, __ATOMIC_RELAXED, __HIP_MEMORY_SCOPE_AGENT)); }
      if (sel >= 30) d = 0;
      if (bx == (sel >= 20 ? 0 : who) && C.tid == 0) __hip_atomic_store(ctl + 64, (unsigned)d, __ATOMIC_RELAXED, __HIP_MEMORY_SCOPE_AGENT);
      xcd_barrier(bar_all);
      if (bx == 0 && C.tid == 0) { const unsigned dd = sel >= 30 ? __hip_atomic_load(ctl + 80 + (sel - 30), __ATOMIC_RELAXED, __HIP_MEMORY_SCOPE_AGENT) : __hip_atomic_load(ctl + 64, __ATOMIC_RELAXED, __HIP_MEMORY_SCOPE_AGENT);
        const unsigned long long t0_ = __builtin_amdgcn_s_memrealtime(); while (__builtin_amdgcn_s_memrealtime() - t0_ < 4ull * dd) __builtin_amdgcn_s_sleep(32); } }
#endif
}

extern "C" void kernel_launch(void* const* d_in, const int* in_sizes, int n_in, void* d_out, int out_size, void* d_ws, size_t ws_size, hipStream_t stream) {
    static int grid = 0;
    if (grid == 0) {
        if (n_in != 22 || in_sizes[0] != T * DM || out_size != T * DM || ws_size < WS_END) {
            fprintf(stderr, "kernel_launch: unexpected shapes (n_in %d, in0 %d, out %d, ws %zu); nothing launched\n", n_in, n_in > 0 ? in_sizes[0] : -1, out_size, ws_size); grid = -1; return; }
        int dev = 0, cus = 0;
        if (hipGetDevice(&dev) != hipSuccess || hipDeviceGetAttribute(&cus, hipDeviceAttributeMultiprocessorCount, dev) != hipSuccess) { fprintf(stderr, "kernel_launch: device query failed\n"); grid = -1; return; }
        if (hipFuncSetAttribute((const void*)hybrid_fwd, hipFuncAttributeMaxDynamicSharedMemorySize, LDS_BYTES) != hipSuccess) { fprintf(stderr, "kernel_launch: hipFuncSetAttribute failed\n"); grid = -1; return; }
        (void)hipGetLastError();
        grid = cus;
        if (grid % 8 != 0 || grid / 8 <= NC_PER_XCD) { fprintf(stderr, "kernel_launch: built for a CU count that is a multiple of 8 and > %d; got %d; nothing launched\n", 8 * NC_PER_XCD, grid); grid = -1; return; }
    }
    if (grid < 0) return;
    if (hipMemsetAsync((char*)d_ws + WS_CTL, 0, CTL_ZERO_BYTES, stream) != hipSuccess) { fprintf(stderr, "kernel_launch: memset failed\n"); return; }
    Params p{};
    p.x = (const float*)d_in[0]; p.c = (const float*)d_in[1]; p.positions = (const int*)d_in[2]; p.ada_w = (const float*)d_in[3]; p.ada_b = (const float*)d_in[4];
    p.norm_mix_g = (const float*)d_in[5]; p.norm_ffn_g = (const float*)d_in[6]; p.final_norm_g = (const float*)d_in[7]; p.even_w_in = (const float*)d_in[8]; p.even_w_out = (const float*)d_in[9];
    p.gmlp_ln_g = (const float*)d_in[10]; p.gmlp_ln_b = (const float*)d_in[11]; p.gmlp_w_s = (const float*)d_in[12]; p.gmlp_b_s = (const float*)d_in[13]; p.hgrn_lb_logits = (const float*)d_in[14];
    p.hgrn_norm_g = (const float*)d_in[15]; p.odd_w_qkv = (const float*)d_in[16]; p.odd_w_out = (const float*)d_in[17]; p.peer_w_query = (const float*)d_in[18]; p.peer_sub_keys = (const float*)d_in[19];
    p.peer_down = (const float*)d_in[20]; p.peer_up = (const float*)d_in[21];
    p.out = (float*)d_out; p.ws = (unsigned char*)d_ws;
    p.ph_lo = 0; p.ph_hi = 0;
    hipLaunchKernelGGL(hybrid_fwd, dim3(grid), dim3(NWAVES * 64), LDS_BYTES, stream, p);
    const hipError_t le = hipPeekAtLastError();
    if (le != hipSuccess) fprintf(stderr, "kernel_launch: launch failed: %s\n", hipGetErrorName(le));
}
```

```cpp
#include <hip/hip_runtime.h>
#include <cstdio>
#include <cstdint>
#include <cmath>
namespace pg8 {
#define PG8_LAS __attribute__((address_space(3)))
typedef unsigned short bf16_t;
typedef short bf16x8 __attribute__((ext_vector_type(8)));
typedef float f32x4 __attribute__((ext_vector_type(4)));
typedef unsigned u32x4 __attribute__((ext_vector_type(4)));
constexpr int BM = 256, BK = 64, HALF = 128, HTB = HALF * BK * 2  , STAGE_BYTES = 8 * HTB, NXCD = 8, WGM = 8;

__host__ __device__ __forceinline__ int lds_byte(int r, int c) { const int st = (r >> 4) * 2 + (c >> 5), rr = r & 15, cc = c & 31, ob = rr * 64 + cc * 2; return st * 1024 + (ob ^ (((ob >> 9) & 1) << 5)); }
__host__ __device__ __forceinline__ void stage_rc(int b, int& R, int& C) { const int st = b / 1024, sb = b % 1024, swz = sb ^ (((sb >> 9) & 1) << 5); R = (st >> 1) * 16 + swz / 64; C = (st & 1) * 32 + (swz % 64) / 2; }
__host__ __device__ __forceinline__ int perm32(int rho) { const int n = rho >> 4, i = rho & 15; return 8 * (i >> 2) + 4 * n + (i & 3); }

struct Unit { int pm, pn; };
struct Gemm { const bf16_t* A; const bf16_t* Bt; int M, N, K; };

struct StaticOrder {
    int nM, nN, nwg, G, c;
    __host__ __device__ void init(int M, int N, int G_, int c_) { nM = M / BM; nN = N / BM; nwg = nM * nN; G = G_; c = c_; }
    __host__ __device__ bool next(int i, Unit& u) const {
        const long L = (long)i * G + c; if (L >= nwg) return false;
        int wgid = (int)L; { const int q = nwg / NXCD, r = nwg % NXCD, xcd = wgid % NXCD, off = wgid / NXCD; wgid = (xcd < r ? xcd * (q + 1) : r * (q + 1) + (xcd - r) * q) + off; }
        const int nig = WGM * nN, gid = wgid / nig, fm = gid * WGM, gsz = (nM - fm) < WGM ? (nM - fm) : WGM;
        u.pm = fm + ((wgid % nig) % gsz); u.pn = (wgid % nig) / gsz; return true;
    }
    __device__ __forceinline__ void a_ready(const Unit&) const {}
    __device__ __forceinline__ void done(const Unit&) const {}
};

__device__ __forceinline__ unsigned cvt_pk_bf16(float lo, float hi) { unsigned r; asm volatile("v_cvt_pk_bf16_f32 %0, %1, %2" : "=v"(r) : "v"(lo), "v"(hi)); return r; }
typedef float f32x2 __attribute__((ext_vector_type(2)));
__device__ __forceinline__ f32x2 gelu_pk(f32x2 v) {
    const f32x2 av = __builtin_elementwise_abs(v), d = av * 0.2316418882f + 1.0f;
    f32x2 t; t.x = __builtin_amdgcn_rcpf(d.x); t.y = __builtin_amdgcn_rcpf(d.y);
    f32x2 q = t * 0.5307027145f + (-0.7265760135f); q = q * t + 0.7107068705f; q = q * t + (-0.142248368f); q = q * t + 0.127414796f; q = q * t;
    const f32x2 s = (v * v) * (-0.72134752044f);
    f32x2 e; e.x = __builtin_amdgcn_exp2f(s.x); e.y = __builtin_amdgcn_exp2f(s.y);
    const f32x2 m = v * (q * e), r = v - m;
    f32x2 o; o.x = v.x < 0.f ? m.x : r.x; o.y = v.y < 0.f ? m.y : r.y; return o;
}

template <class Epi, class Sched, bool ALIGN_EPI = false, bool SP2 = false>
__device__ __forceinline__ void gemm_phase(PG8_LAS unsigned char* lds, const Gemm g, const Sched& S, const Epi& E) {
    int tid_ = threadIdx.x; asm volatile("" : "+v"(tid_));
    const int tid = tid_, wid = __builtin_amdgcn_readfirstlane(tid >> 6), lane = tid & 63, wr = wid >> 2, wc = wid & 3, fr = lane & 15, fq = lane >> 4;
    const int K = g.K, nt = K / BK;
    unsigned voffA[2], voffB[2];
#pragma unroll
    for (int i = 0; i < 2; ++i) { int R, C; stage_rc(tid * 16 + i * 8192, R, C); const int Rb = Epi::PERM ? ((R & ~31) + perm32(R & 31)) : R;
        voffA[i] = (unsigned)(R * K + C) * 2u; voffB[i] = (unsigned)(Rb * K + C) * 2u; }
    const size_t kstep = (size_t)(BK * 2);
    const size_t hstep = (size_t)HALF * K * 2;
    const size_t tstep = 2 * hstep;
    const unsigned ldsw = (unsigned)wid * 1024u;
    const int aoff = lds_byte(wr * 64 + fr, fq * 8), boff = lds_byte(wc * 32 + fr, fq * 8);
#define PG8_SA(b, h) (((b) * 2 + (h)) * HTB)
#define PG8_SB(b, h) ((4 + (b) * 2 + (h)) * HTB)
#define PG8_STAGE(bufoff, gbase, voff) do { _Pragma("unroll") for (int _i = 0; _i < 2; ++_i) \
        __builtin_amdgcn_global_load_lds((const unsigned*)((const char*)(gbase) + (voff)[_i]), (PG8_LAS unsigned*)(lds + (bufoff) + ldsw + _i * 8192), 16, 0, 0); } while (0)
#define PG8_LDA(dst, b, h) do { _Pragma("unroll") for (int m = 0; m < 4; ++m) _Pragma("unroll") for (int k = 0; k < 2; ++k) dst[m][k] = *(const PG8_LAS bf16x8*)(lds + PG8_SA(b, h) + aoff + m * 2048 + k * 1024); } while (0)
#define PG8_LDB(dst, b, h) do { _Pragma("unroll") for (int n = 0; n < 2; ++n) _Pragma("unroll") for (int k = 0; k < 2; ++k) dst[n][k] = *(const PG8_LAS bf16x8*)(lds + PG8_SB(b, h) + boff + n * 2048 + k * 1024); } while (0)
#define PG8_MMA(ai, bj, At, Bt) do { __builtin_amdgcn_s_setprio(1); _Pragma("unroll") for (int m = 0; m < 4; ++m) _Pragma("unroll") for (int n = 0; n < 2; ++n) _Pragma("unroll") for (int k = 0; k < 2; ++k) \
        acc[ai][bj][m][n] = __builtin_amdgcn_mfma_f32_16x16x32_bf16(Bt[n][k], At[m][k], acc[ai][bj][m][n], 0, 0, 0); __builtin_amdgcn_s_setprio(0); } while (0)
#define PG8_WAIT_V(n) asm volatile("s_waitcnt vmcnt(" #n ")" ::: "memory")
#define PG8_WAIT_L(n) asm volatile("s_waitcnt lgkmcnt(" #n ")" ::: "memory")
#define PG8_BAR __builtin_amdgcn_s_barrier()
#define PG8_SCHED __builtin_amdgcn_sched_barrier(0)
    Unit cur, nxt; int ui = 0;
    if (!S.next(0, cur)) return;
    f32x4 acc[2][2][4][2];
#pragma unroll
    for (int a = 0; a < 2; ++a)
#pragma unroll
        for (int b = 0; b < 2; ++b)
#pragma unroll
            for (int m = 0; m < 4; ++m)
#pragma unroll
                for (int n = 0; n < 2; ++n) acc[a][b][m][n] = (f32x4){0.f, 0.f, 0.f, 0.f};
    bf16x8 At[4][2], B0[2][2], B1[2][2];
    const char* cA = (const char*)g.A + (size_t)cur.pm * tstep; const char* cB = (const char*)g.Bt + (size_t)cur.pn * tstep;
    S.a_ready(cur);
    if constexpr (SP2) {
        PG8_STAGE(PG8_SB(0, 0), cB, voffB); PG8_STAGE(PG8_SB(0, 1), cB + hstep, voffB); PG8_STAGE(PG8_SA(0, 0), cA, voffA); PG8_STAGE(PG8_SA(0, 1), cA + hstep, voffA);
        if (wr == 1) PG8_BAR;
        PG8_WAIT_V(2); PG8_BAR;
        PG8_STAGE(PG8_SB(1, 0), cB + kstep, voffB); PG8_STAGE(PG8_SA(1, 0), cA + kstep, voffA); PG8_STAGE(PG8_SB(1, 1), cB + hstep + kstep, voffB);
        PG8_WAIT_V(6); PG8_BAR;
    } else {
        PG8_STAGE(PG8_SB(0, 0), cB, voffB); PG8_STAGE(PG8_SA(0, 0), cA, voffA); PG8_STAGE(PG8_SB(0, 1), cB + hstep, voffB); PG8_STAGE(PG8_SA(0, 1), cA + hstep, voffA);
        if (wr == 1) PG8_BAR;
        PG8_WAIT_V(4); PG8_BAR;
        PG8_STAGE(PG8_SB(1, 0), cB + kstep, voffB); PG8_STAGE(PG8_SA(1, 0), cA + kstep, voffA); PG8_STAGE(PG8_SB(1, 1), cB + hstep + kstep, voffB);
        PG8_WAIT_V(6); PG8_BAR;
    }
    for (;;) {
        const bool has_next = S.next(ui + 1, nxt);
        const char* nA = has_next ? (const char*)g.A + (size_t)nxt.pm * tstep : cA; const char* nB = has_next ? (const char*)g.Bt + (size_t)nxt.pn * tstep : cB;
        for (int t = 0; t < nt; t += 2) {
            const bool last = (t == nt - 2);
            const char* a1 = cA + (size_t)(t + 1) * kstep;
            const char* a2 = last ? nA : cA + (size_t)(t + 2) * kstep; const char* b2 = last ? nB : cB + (size_t)(t + 2) * kstep;
            const char* a3 = a2 + kstep; const char* b3 = b2 + kstep;
            if (last && has_next) S.a_ready(nxt);
            if constexpr (SP2) {
            PG8_LDB(B0, 0, 0); PG8_LDB(B1, 0, 1); PG8_SCHED; PG8_LDA(At, 0, 0); PG8_STAGE(PG8_SA(1, 1), a1 + hstep, voffA);
            PG8_WAIT_V(8); PG8_WAIT_L(0); PG8_BAR; PG8_MMA(0, 0, At, B0); PG8_MMA(0, 1, At, B1); PG8_BAR; PG8_SCHED;
            PG8_LDA(At, 0, 1); PG8_STAGE(PG8_SB(0, 0), b2, voffB); PG8_STAGE(PG8_SB(0, 1), b2 + hstep, voffB); PG8_STAGE(PG8_SA(0, 0), a2, voffA);
            PG8_WAIT_V(8); PG8_WAIT_L(0); PG8_BAR; PG8_MMA(1, 0, At, B0); PG8_MMA(1, 1, At, B1); PG8_BAR; PG8_SCHED;
            PG8_LDB(B0, 1, 0); PG8_LDB(B1, 1, 1); PG8_SCHED; PG8_LDA(At, 1, 0); PG8_STAGE(PG8_SA(0, 1), a2 + hstep, voffA);
            PG8_WAIT_V(8); PG8_WAIT_L(0); PG8_BAR; PG8_MMA(0, 0, At, B0); PG8_MMA(0, 1, At, B1); PG8_BAR; PG8_SCHED;
            PG8_LDA(At, 1, 1); PG8_STAGE(PG8_SB(1, 0), b3, voffB); PG8_STAGE(PG8_SB(1, 1), b3 + hstep, voffB); PG8_STAGE(PG8_SA(1, 0), a3, voffA);
            PG8_WAIT_V(8); PG8_WAIT_L(0); PG8_BAR; PG8_MMA(1, 0, At, B0); PG8_MMA(1, 1, At, B1); PG8_BAR; PG8_SCHED;
            } else {
            PG8_LDB(B0, 0, 0); PG8_SCHED; PG8_LDA(At, 0, 0); PG8_STAGE(PG8_SA(1, 1), a1 + hstep, voffA);
            PG8_WAIT_L(8); PG8_BAR; PG8_WAIT_L(0); PG8_MMA(0, 0, At, B0); PG8_BAR; PG8_SCHED;
            PG8_LDB(B1, 0, 1); PG8_STAGE(PG8_SB(0, 0), b2, voffB);
            PG8_BAR; PG8_WAIT_L(0); PG8_MMA(0, 1, At, B1); PG8_BAR;
            PG8_LDA(At, 0, 1); PG8_STAGE(PG8_SA(0, 0), a2, voffA);
            PG8_BAR; PG8_WAIT_L(0); PG8_MMA(1, 0, At, B0); PG8_BAR; PG8_SCHED;
            PG8_STAGE(PG8_SB(0, 1), b2 + hstep, voffB);
            PG8_WAIT_V(6); PG8_BAR; PG8_MMA(1, 1, At, B1); PG8_BAR;
            PG8_LDB(B0, 1, 0); PG8_SCHED; PG8_LDA(At, 1, 0); PG8_STAGE(PG8_SA(0, 1), a2 + hstep, voffA);
            PG8_WAIT_L(8); PG8_BAR; PG8_WAIT_L(0); PG8_MMA(0, 0, At, B0); PG8_BAR; PG8_SCHED;
            PG8_LDB(B1, 1, 1); PG8_STAGE(PG8_SB(1, 0), b3, voffB);
            PG8_BAR; PG8_WAIT_L(0); PG8_MMA(0, 1, At, B1); PG8_BAR;
            PG8_LDA(At, 1, 1); PG8_STAGE(PG8_SA(1, 0), a3, voffA);
            PG8_BAR; PG8_WAIT_L(0); PG8_MMA(1, 0, At, B0); PG8_BAR; PG8_SCHED;
            PG8_STAGE(PG8_SB(1, 1), b3 + hstep, voffB);
            PG8_WAIT_V(6); PG8_BAR; PG8_MMA(1, 1, At, B1); PG8_BAR;
            }
        }
        if constexpr (ALIGN_EPI) { if (wr == 0) PG8_BAR; }
        if constexpr (!Epi::AFTER_DRAIN) { E(acc, cur, wr, wc, fr, fq); S.done(cur); }
        if (!has_next) break;
#pragma unroll
        for (int a = 0; a < 2; ++a)
#pragma unroll
            for (int b = 0; b < 2; ++b)
#pragma unroll
                for (int m = 0; m < 4; ++m)
#pragma unroll
                    for (int n = 0; n < 2; ++n) acc[a][b][m][n] = (f32x4){0.f, 0.f, 0.f, 0.f};
        cur = nxt; cA = nA; cB = nB; ++ui;
        if constexpr (ALIGN_EPI) { if (wr == 1) PG8_BAR; }
    }
    PG8_WAIT_V(0);
    if constexpr (!ALIGN_EPI) { if (wr == 0) PG8_BAR; }
    PG8_BAR;
    if constexpr (Epi::AFTER_DRAIN) { E.fused(acc, cur, wr, wc, fr, fq, lds, wid, lane); S.done(cur); }
#undef PG8_SA
#undef PG8_SB
#undef PG8_STAGE
#undef PG8_LDA
#undef PG8_LDB
#undef PG8_MMA
#undef PG8_WAIT_V
#undef PG8_WAIT_L
#undef PG8_BAR
#undef PG8_SCHED
}
}
#define GAS __attribute__((address_space(1)))
#define LAS __attribute__((address_space(3)))
typedef unsigned short bf16;
typedef unsigned v4u __attribute__((ext_vector_type(4)));
typedef float f32x4 __attribute__((ext_vector_type(4)));
typedef short bf16x8 __attribute__((ext_vector_type(8)));
typedef __bf16 bf16x2_t __attribute__((ext_vector_type(2)));
#define LDS_WAIT() asm volatile("s_waitcnt lgkmcnt(0)" ::: "memory")
#define VM_WAIT() asm volatile("s_waitcnt vmcnt(0)" ::: "memory")
__device__ __forceinline__ unsigned f2bf(float f) { unsigned u = __builtin_bit_cast(unsigned, f); return (u + 0x7fffu + ((u >> 16) & 1u)) >> 16; }
__device__ __forceinline__ unsigned pk2(float lo, float hi) { return f2bf(lo) | (f2bf(hi) << 16); }
__device__ __forceinline__ float bflo(unsigned u) { return __builtin_bit_cast(float, u << 16); }
__device__ __forceinline__ float bfhi(unsigned u) { return __builtin_bit_cast(float, u & 0xffff0000u); }
__device__ __forceinline__ float bf2f(bf16 u) { return __builtin_bit_cast(float, (unsigned)u << 16); }
#define XB_TMO      128
#define XB_XCNT(j)  (256  + 64 * (j))
#define XB_XSUB(j)  (1280 + 64 * (j))
#define XB_XGEN(j)  (2304 + 64 * (j))
#define XB_TOP      3328
#define XB_TOPGEN   3392
#define XCD_BAR_WORDS 3456
#define XB_SPIN_CAP (1u << 18)

__device__ __forceinline__ unsigned xb_ld(unsigned* p)              { return __hip_atomic_load(p, __ATOMIC_RELAXED, __HIP_MEMORY_SCOPE_AGENT); }
__device__ __forceinline__ unsigned xb_add(unsigned* p, unsigned v) { return __hip_atomic_fetch_add(p, v, __ATOMIC_RELAXED, __HIP_MEMORY_SCOPE_AGENT); }
__device__ __forceinline__ unsigned xb_xcc_id() { return (unsigned)__builtin_amdgcn_s_getreg((3 << 11) | 20) & 0xFu; }
#define XB_SPIN(cond, bar) do { unsigned _sp = 0; while (cond) { __builtin_amdgcn_s_sleep(1); \
    if ((++_sp & 255u) == 0u) { if (xb_ld(&(bar)[XB_TMO])) break; if (_sp > XB_SPIN_CAP) { atomicAdd(&(bar)[XB_TMO], 1u); break; } } } } while (0)

struct XcdBarrier {
    unsigned* bar; unsigned x; unsigned G;
    volatile LAS unsigned* st;
};

__device__ __forceinline__ XcdBarrier xcd_barrier_post(unsigned* bar, volatile LAS unsigned* st) {
    XcdBarrier b; b.bar = bar; b.x = xb_xcc_id(); b.st = st; b.G = gridDim.x;
    if (threadIdx.x == 0) (void)xb_add(&bar[XB_XCNT(b.x)], 1u);
    return b;
}
__device__ __forceinline__ void xcd_barrier_complete(unsigned* bar, unsigned x, unsigned& nloc, unsigned& nx, const unsigned G) {
    unsigned sum, cnt, mine, sp = 0u;
    for (;;) {
        sum = 0u; cnt = 0u; mine = 0u;
#pragma unroll
        for (unsigned j = 0; j < 16; ++j) { const unsigned c = xb_ld(&bar[XB_XCNT(j)]); sum += c; cnt += (c > 0u) ? 1u : 0u; mine = (j == x) ? c : mine; }
        if (sum == G) break;
        __builtin_amdgcn_s_sleep(1);
        if ((++sp & 255u) == 0u) { if (xb_ld(&bar[XB_TMO])) break; if (sp > XB_SPIN_CAP) { atomicAdd(&bar[XB_TMO], 1u); break; } }
    }
    nloc = mine > 0u ? mine : 1u; nx = cnt > 0u ? cnt : 1u;
}

__device__ __forceinline__ void xcd_barrier(const XcdBarrier& b) {
    asm volatile("s_waitcnt vmcnt(0)" ::: "memory");
    __syncthreads();
    if (threadIdx.x == 0) {
        unsigned* bar = b.bar;
        __builtin_amdgcn_s_waitcnt(0);
        unsigned nloc = b.st[0], nx = b.st[1];
        if (nloc == 0u) { xcd_barrier_complete(bar, b.x, nloc, nx, b.G); b.st[0] = nloc; b.st[1] = nx; }
        const unsigned old = xb_add(&bar[XB_XSUB(b.x)], 1u);
        const unsigned gen = old / nloc;
        if (old + 1u == (gen + 1u) * nloc) {
            __builtin_amdgcn_fence(__ATOMIC_RELEASE, "agent");
            asm volatile("s_waitcnt vmcnt(0)" ::: "memory");
            const unsigned og = xb_add(&bar[XB_TOP], 1u);
            const unsigned tg = og / nx;
            if (og + 1u == (tg + 1u) * nx) xb_add(&bar[XB_TOPGEN], 1u);
            else XB_SPIN(xb_ld(&bar[XB_TOPGEN]) == tg, bar);
            __builtin_amdgcn_fence(__ATOMIC_ACQUIRE, "agent");
            xb_add(&bar[XB_XGEN(b.x)], 1u);
            asm volatile("s_waitcnt vmcnt(0)" ::: "memory");
        } else {
            XB_SPIN(xb_ld(&bar[XB_XGEN(b.x)]) == gen, bar);
            __builtin_amdgcn_fence(__ATOMIC_ACQUIRE, "agent");
            asm volatile("s_waitcnt vmcnt(0)" ::: "memory");
        }
    }
    __syncthreads();
}

constexpr int NB = 8, SEQ = 8192, DM = 1024, T = NB * SEQ;
constexpr int NWAVES = 8;
constexpr float NORM_EPS = 1e-6f;
constexpr float C2 = 0.125f * 1.4426950408889634f;

constexpr size_t MiB = 1u << 20;
constexpr size_t WS_CTL = 0, CTL_ZERO_BYTES = 1 * MiB;
constexpr size_t WS_MOD = 1 * MiB;
constexpr size_t WS_SKB = 1 * MiB + 512 * 1024;
constexpr size_t WS_WSB = 1 * MiB + 768 * 1024;
constexpr size_t WS_LB  = 1 * MiB + 960 * 1024;
constexpr size_t WS_CS  = 2 * MiB;
constexpr size_t WS_HD  = 6 * MiB;
constexpr size_t WS_WIN = 16 * MiB, WS_WOUT0 = 22 * MiB, WS_WQKV = 24 * MiB, WS_WOUT1 = 30 * MiB, WS_WQ0 = 32 * MiB, WS_WQ1 = 36 * MiB;
constexpr size_t WS_TAB8 = 40 * MiB, TAB8_BYTES = 16 * MiB;
constexpr int TROW = 1024;
constexpr size_t WS_SC8 = 8 * MiB;
constexpr size_t WS_H = 108 * MiB;
constexpr size_t WS_IDX = 236 * MiB, WS_GATE = 268 * MiB;
constexpr size_t WS_AR0 = 300 * MiB, AR_BYTES = 352 * MiB;
constexpr size_t AR_PU = 0, AR_PV = 32 * MiB, AR_PQ = 64 * MiB, AR_PI = 96 * MiB, AR_PG = 128 * MiB;
constexpr size_t AR_G = 160 * MiB;
constexpr size_t AR_KVT = 224 * MiB, AR_ST = 288 * MiB;
constexpr size_t AR_QP = 0;
constexpr size_t AR_QK = 0;
constexpr size_t WS_END = WS_AR0 + 2 * AR_BYTES;
constexpr int HT = T / 2;
constexpr int CW_BAR = 4096;

constexpr int LDS_BYTES = 147456;
constexpr int LDSCTL_OFF = LDS_BYTES - 512;
constexpr int MISC_OFF = LDSCTL_OFF;

struct Params {
    const float* x; const float* c; const int* positions; const float* ada_w; const float* ada_b; const float* norm_mix_g; const float* norm_ffn_g; const float* final_norm_g;
    const float* even_w_in; const float* even_w_out; const float* gmlp_ln_g; const float* gmlp_ln_b; const float* gmlp_w_s; const float* gmlp_b_s; const float* hgrn_lb_logits; const float* hgrn_norm_g;
    const float* odd_w_qkv; const float* odd_w_out; const float* peer_w_query; const float* peer_sub_keys; const float* peer_down; const float* peer_up;
    float* out; unsigned char* ws; int ph_lo, ph_hi;
};
struct Ctx { LAS unsigned char* lds; int tid, lane, wave, vcu, G; };
__device__ __forceinline__ Ctx fresh_ctx(const Ctx& C0) { Ctx C = C0; int t_ = threadIdx.x; asm volatile("" : "+v"(t_)); C.tid = t_; C.lane = t_ & 63; C.wave = __builtin_amdgcn_readfirstlane(t_ >> 6); return C; }
struct Wk { int lv, n, c, h; };
#define W_TK0(W) ((W).h * (T / 2))
#define W_BT0(W) ((W).h * (NB / 2))
__device__ __forceinline__ unsigned char* w_ar(const Params& P, const Wk& W) { return P.ws + WS_AR0 + (size_t)W.h * AR_BYTES; }
__device__ __forceinline__ bf16* w_tok16(const Params& P, const Wk& W, size_t off, int pitch) { return (bf16*)(w_ar(P, W) + off) - (size_t)W_TK0(W) * pitch; }
__device__ __forceinline__ float* w_tok32(const Params& P, const Wk& W, size_t off, int pitch) { return (float*)(w_ar(P, W) + off) - (size_t)W_TK0(W) * pitch; }
__device__ __forceinline__ bf16* w_item16(const Params& P, const Wk& W, size_t off) { return (bf16*)(w_ar(P, W) + off) - (size_t)W_BT0(W) * 512 * 16384; }

__device__ __forceinline__ float wave_sum(float v) {
#pragma unroll
    for (int o = 1; o < 64; o <<= 1) v += __shfl_xor(v, o);
    return v;
}
__device__ __forceinline__ float silu_f(float x) { return x * __builtin_amdgcn_rcpf(1.0f + __builtin_amdgcn_exp2f(-1.4426950408889634f * x)); }
__device__ __forceinline__ float sigmoid_f(float x) { return __builtin_amdgcn_rcpf(1.0f + __builtin_amdgcn_exp2f(-1.4426950408889634f * x)); }
__device__ __forceinline__ float gelu_f(float x) { return 0.5f * x * (1.0f + erff(x * 0.70710678118654752f)); }
__device__ __forceinline__ f32x4 mma16(f32x4 acc, const LAS bf16* A, int lda, const LAS bf16* Bt, int ldb, int K, int r, int q4) {
    const LAS bf16* ap = A + r * lda + 8 * q4; const LAS bf16* bp = Bt + r * ldb + 8 * q4;
    for (int k0 = 0; k0 < K; k0 += 32) {
        const bf16x8 a = *(const LAS bf16x8*)(ap + k0); const bf16x8 b = *(const LAS bf16x8*)(bp + k0);
        acc = __builtin_amdgcn_mfma_f32_16x16x32_bf16(a, b, acc, 0, 0, 0);
    }
    return acc;
}

struct EpiBf16P {
    static constexpr bool PERM = true, AFTER_DRAIN = false;
    bf16* O; size_t ldc;
    __device__ __forceinline__ void operator()(const f32x4 (&acc)[2][2][4][2], const pg8::Unit& u, int wr, int wc, int fr, int fq) const {
        const int row0 = u.pm * 256 + wr * 64 + fr, col0 = u.pn * 256 + wc * 32 + 8 * fq;
#pragma unroll
        for (int ai = 0; ai < 2; ++ai)
#pragma unroll
            for (int m = 0; m < 4; ++m) { bf16* rowp = O + (size_t)(row0 + ai * 128 + m * 16) * ldc + col0;
#pragma unroll
                for (int bj = 0; bj < 2; ++bj) { const f32x4 v0 = acc[ai][bj][m][0], v1 = acc[ai][bj][m][1];
                    v4u w; w.x = pg8::cvt_pk_bf16(v0[0], v0[1]); w.y = pg8::cvt_pk_bf16(v0[2], v0[3]); w.z = pg8::cvt_pk_bf16(v1[0], v1[1]); w.w = pg8::cvt_pk_bf16(v1[2], v1[3]);
                    *(v4u*)(rowp + bj * 128) = w; } }
    }
};
#ifndef REP_HG
#define REP_HG 1
#endif
#ifndef REP_TOPK
#define REP_TOPK 1
#endif
#ifndef REP_PRO
#define REP_PRO 1
#endif
#ifndef REP_NORM
#define REP_NORM 1
#endif
#ifndef REP_GEMM2
#define REP_GEMM2 1
#endif
#ifndef REP_GEMM
#define REP_GEMM 1
#endif
#ifndef EXP_REP
#define EXP_REP 1
#endif
#ifndef ATT_REP
#define ATT_REP 1
#endif
#ifndef ABL_ON
#define ABL_ON 4
#endif
struct EpiResid {
    static constexpr bool PERM = true, AFTER_DRAIN = false;
    const float* xin; float* xout; const float* gate; float gsc;
    __device__ __forceinline__ void operator()(const f32x4 (&acc)[2][2][4][2], const pg8::Unit& u, int wr, int wc, int fr, int fq) const {
        const int row0 = u.pm * 256 + wr * 64 + fr, col0 = u.pn * 256 + wc * 32 + 8 * fq;
        const float* gp = gate + (size_t)((u.pm * 256) >> 13) * 6144 + col0;
        f32x4 gv[2][2];
#pragma unroll
        for (int bj = 0; bj < 2; ++bj) { gv[bj][0] = *(const f32x4*)(gp + bj * 128); gv[bj][1] = *(const f32x4*)(gp + bj * 128 + 4); }
#pragma unroll
        for (int ai = 0; ai < 2; ++ai)
#pragma unroll
            for (int m = 0; m < 4; ++m) { const size_t off = (size_t)(row0 + ai * 128 + m * 16) * 1024 + col0;
#pragma unroll
                for (int bj = 0; bj < 2; ++bj) {
                    const f32x4 x0 = *(const f32x4*)(xin + off + bj * 128), x1 = *(const f32x4*)(xin + off + bj * 128 + 4);
                    *(f32x4*)(xout + off + bj * 128) = x0 + gv[bj][0] * acc[ai][bj][m][0] * gsc;
                    *(f32x4*)(xout + off + bj * 128 + 4) = x1 + gv[bj][1] * acc[ai][bj][m][1] * gsc; }
                asm volatile("" ::: "memory"); }
    }
};
struct EpiInProj {
    static constexpr bool PERM = true, AFTER_DRAIN = false;
    bf16* PU; bf16* PV; bf16* PQ; bf16* PI; bf16* PG; float* G; const float* LB;
    __device__ __forceinline__ void operator()(const f32x4 (&acc)[2][2][4][2], const pg8::Unit& u, int wr, int wc, int fr, int fq) const {
        const int type = u.pn >> 1;
        const int row0 = u.pm * 256 + wr * 64 + fr, lc0 = (u.pn & 1) * 256 + wc * 32 + 8 * fq;
        if (type == 3) {
            f32x4 lb[2][2];
#pragma unroll
            for (int bj = 0; bj < 2; ++bj) { lb[bj][0] = *(const f32x4*)(LB + lc0 + bj * 128); lb[bj][1] = *(const f32x4*)(LB + lc0 + bj * 128 + 4); }
#pragma unroll
            for (int ai = 0; ai < 2; ++ai)
#pragma unroll
                for (int m = 0; m < 4; ++m) { float* rowp = G + (size_t)(row0 + ai * 128 + m * 16) * 512 + lc0;
#pragma unroll
                    for (int bj = 0; bj < 2; ++bj)
#pragma unroll
                        for (int n = 0; n < 2; ++n) { const f32x4 v = acc[ai][bj][m][n]; f32x4 o;
#pragma unroll
                            for (int e = 0; e < 4; ++e) { const float l = lb[bj][n][e]; const float f = l + (1.0f - l) * sigmoid_f(v[e]); o[e] = __logf(f); }
                            *(f32x4*)(rowp + bj * 128 + 4 * n) = o; } }
            return;
        }
        bf16* base = type == 0 ? PU : type == 1 ? PV : type == 2 ? PQ : type == 4 ? PI : PG;
#pragma unroll
        for (int ai = 0; ai < 2; ++ai)
#pragma unroll
            for (int m = 0; m < 4; ++m) { bf16* rowp = base + (size_t)(row0 + ai * 128 + m * 16) * 512 + lc0;
#pragma unroll
                for (int bj = 0; bj < 2; ++bj) { f32x4 v0 = acc[ai][bj][m][0], v1 = acc[ai][bj][m][1];
                    if (type <= 1) { pg8::f32x2 a = pg8::gelu_pk((pg8::f32x2){v0[0], v0[1]}), b = pg8::gelu_pk((pg8::f32x2){v0[2], v0[3]}), c = pg8::gelu_pk((pg8::f32x2){v1[0], v1[1]}), d = pg8::gelu_pk((pg8::f32x2){v1[2], v1[3]});
                        v0 = (f32x4){a.x, a.y, b.x, b.y}; v1 = (f32x4){c.x, c.y, d.x, d.y}; }
                    else if (type == 2) {
#pragma unroll
                        for (int e = 0; e < 4; ++e) { v0[e] = silu_f(v0[e]) * 0.08838834764831845f; v1[e] = silu_f(v1[e]) * 0.08838834764831845f; } }
                    else if (type == 5) {
#pragma unroll
                        for (int e = 0; e < 4; ++e) { v0[e] = silu_f(v0[e]); v1[e] = silu_f(v1[e]); } }
                    v4u w; w.x = pg8::cvt_pk_bf16(v0[0], v0[1]); w.y = pg8::cvt_pk_bf16(v0[2], v0[3]); w.z = pg8::cvt_pk_bf16(v1[0], v1[1]); w.w = pg8::cvt_pk_bf16(v1[2], v1[3]);
                    *(v4u*)(rowp + bj * 128) = w; } }
    }
};
struct EpiQKRot {
    static constexpr bool PERM = true, AFTER_DRAIN = false;
    bf16* O; const float* CS;
    __device__ __forceinline__ void operator()(const f32x4 (&acc)[2][2][4][2], const pg8::Unit& u, int wr, int wc, int fr, int fq) const {
        const int row0 = u.pm * 256 + wr * 64 + fr, col0 = u.pn * 256 + wc * 32 + 8 * fq;
        const float sc = u.pn < 4 ? C2 : 1.0f;
        const bool rotw = (wc & 1) == 0 && u.pn < 8;
        const float sgn = fq == 0 ? -1.0f : 1.0f;
#pragma unroll
        for (int ai = 0; ai < 2; ++ai)
#pragma unroll
            for (int m = 0; m < 4; ++m) { const int row = row0 + ai * 128 + m * 16; bf16* rowp = O + (size_t)row * 3072 + col0;
                f32x4 c0 = (f32x4){1.f, 1.f, 1.f, 1.f}, c1 = c0, s0 = (f32x4){0.f, 0.f, 0.f, 0.f}, s1 = s0;
                if (rotw && fq < 2) { const float* cp = CS + (size_t)row * 16; c0 = *(const f32x4*)(cp); c1 = *(const f32x4*)(cp + 4); s0 = *(const f32x4*)(cp + 8) * sgn; s1 = *(const f32x4*)(cp + 12) * sgn; }
#pragma unroll
                for (int bj = 0; bj < 2; ++bj) { f32x4 v0 = acc[ai][bj][m][0], v1 = acc[ai][bj][m][1];
                    if (rotw) { f32x4 p0, p1;
#pragma unroll
                        for (int e = 0; e < 4; ++e) { p0[e] = __shfl_xor(v0[e], 16); p1[e] = __shfl_xor(v1[e], 16); }
                        v0 = v0 * c0 + p0 * s0; v1 = v1 * c1 + p1 * s1; }
                    v0 = v0 * sc; v1 = v1 * sc;
                    v4u w; w.x = pg8::cvt_pk_bf16(v0[0], v0[1]); w.y = pg8::cvt_pk_bf16(v0[2], v0[3]); w.z = pg8::cvt_pk_bf16(v1[0], v1[1]); w.w = pg8::cvt_pk_bf16(v1[2], v1[3]);
                    *(v4u*)(rowp + bj * 128) = w; } }
    }
};

__device__ __forceinline__ void p0_transpose_item(const float* W, int K, int N, bf16* WT, LAS float* scr, int item, int lane) {
    const int nblk = N / 32, kb = item / nblk, nb = item % nblk, k0 = 64 * kb, n0 = 32 * nb;
#pragma unroll 8
    for (int i = 0; i < 32; ++i) { const int kk = 2 * i + (lane >> 5); scr[kk * 33 + (lane & 31)] = W[(size_t)(k0 + kk) * N + n0 + (lane & 31)]; }
    LDS_WAIT(); asm volatile("" ::: "memory");
    const int c = lane & 7;
#pragma unroll
    for (int j = 0; j < 4; ++j) { const int n = (lane >> 3) + 8 * j; const LAS float* s = scr + (8 * c) * 33 + n;
        v4u o; o.x = pk2(s[0 * 33], s[1 * 33]); o.y = pk2(s[2 * 33], s[3 * 33]); o.z = pk2(s[4 * 33], s[5 * 33]); o.w = pk2(s[6 * 33], s[7 * 33]);
        *(GAS v4u*)(WT + (size_t)(n0 + n) * K + k0 + 8 * c) = o; }
    LDS_WAIT(); asm volatile("" ::: "memory");
}
typedef float f32x2 __attribute__((ext_vector_type(2)));
__device__ __forceinline__ void convert_tables(const Params& P, const Ctx& C) {
    const int gw = C.vcu * NWAVES + C.wave, NGW = C.G * NWAVES, lane = C.lane;
    for (int row = gw; row < 4 * 16384; row += NGW) {
        const int tb = row >> 14, e = row & 16383;
        const float* src = ((tb & 1) ? P.peer_up : P.peer_down) + ((size_t)(tb >> 1) * 16384 + e) * 1024;
        unsigned char* dst = P.ws + WS_TAB8 + (size_t)tb * TAB8_BYTES + (size_t)e * TROW;
        f32x4 v[4]; float mx = 0.f;
#pragma unroll
        for (int j = 0; j < 4; ++j) { v[j] = ((const f32x4*)src)[64 * j + lane]; mx = fmaxf(mx, fmaxf(fmaxf(fabsf(v[j][0]), fabsf(v[j][1])), fmaxf(fabsf(v[j][2]), fabsf(v[j][3])))); }
#pragma unroll
        for (int o = 1; o < 64; o <<= 1) mx = fmaxf(mx, __shfl_xor(mx, o));
        const float sc = mx > 0.f ? 400.0f / mx : 0.f;
#pragma unroll
        for (int j = 0; j < 4; ++j) { int p = __builtin_amdgcn_cvt_pk_fp8_f32(v[j][0] * sc, v[j][1] * sc, 0, false); p = __builtin_amdgcn_cvt_pk_fp8_f32(v[j][2] * sc, v[j][3] * sc, p, true);
            ((unsigned*)dst)[64 * j + lane] = (unsigned)p; }
        if (lane == 0) ((float*)(P.ws + WS_SC8))[row] = mx * (1.0f / 400.0f);
    }
}
__device__ __forceinline__ void phase_prologue(const Params& P, const Ctx& C) {
    float* MOD = (float*)(P.ws + WS_MOD);
    {
        LAS float* cond = (LAS float*)C.lds;
        LAS float* part = (LAS float*)(C.lds + 32768);
        for (int e = C.tid; e < 8192; e += 512) cond[e] = silu_f(P.c[e]);
        __syncthreads();
        for (int item = C.vcu; item < 192; item += C.G) {
            const int l = item / 96, cb = item % 96, col = cb * 64 + C.lane;
            float acc[8];
#pragma unroll
            for (int b = 0; b < 8; ++b) acc[b] = 0.f;
            const float* wp = P.ada_w + ((size_t)l * 1024 + C.wave * 128) * 6144 + col;
#pragma unroll 4
            for (int k = 0; k < 128; ++k) { const float wv = wp[(size_t)k * 6144];
#pragma unroll
                for (int b = 0; b < 8; ++b) acc[b] += cond[b * 1024 + C.wave * 128 + k] * wv; }
#pragma unroll
            for (int b = 0; b < 8; ++b) part[(C.wave * 8 + b) * 64 + C.lane] = acc[b];
            __syncthreads();
            { const int b = C.tid >> 6, ln = C.tid & 63; float s = P.ada_b[l * 6144 + cb * 64 + ln];
#pragma unroll
              for (int w = 0; w < 8; ++w) s += part[(w * 8 + b) * 64 + ln];
              MOD[(size_t)(l * 8 + b) * 6144 + cb * 64 + ln] = s; }
            __syncthreads();
        }
        __syncthreads();
    }
    {
        LAS float* scr = (LAS float*)(C.lds + C.wave * 16384);
        const int gw = C.vcu * NWAVES + C.wave, NGW = C.G * NWAVES;
        for (int it = gw; it < 6144; it += NGW) {
            int r = it;
            if (r < 1536) { p0_transpose_item(P.even_w_in, 1024, 3072, (bf16*)(P.ws + WS_WIN), scr, r, C.lane); continue; } r -= 1536;
            if (r < 512)  { p0_transpose_item(P.even_w_out, 1024, 1024, (bf16*)(P.ws + WS_WOUT0), scr, r, C.lane); continue; } r -= 512;
            if (r < 1536) { p0_transpose_item(P.odd_w_qkv, 1024, 3072, (bf16*)(P.ws + WS_WQKV), scr, r, C.lane); continue; } r -= 1536;
            if (r < 512)  { p0_transpose_item(P.odd_w_out, 1024, 1024, (bf16*)(P.ws + WS_WOUT1), scr, r, C.lane); continue; } r -= 512;
            if (r < 1024) { p0_transpose_item(P.peer_w_query, 1024, 2048, (bf16*)(P.ws + WS_WQ0), scr, r, C.lane); continue; } r -= 1024;
            p0_transpose_item(P.peer_w_query + (size_t)1024 * 2048, 1024, 2048, (bf16*)(P.ws + WS_WQ1), scr, r, C.lane);
        }
    }
    convert_tables(P, C);
    const int NT = C.G * 512, gt = C.vcu * 512 + C.tid;
    { bf16* skb = (bf16*)(P.ws + WS_SKB); for (int i = gt; i < 65536; i += NT) skb[i] = (bf16)f2bf(P.peer_sub_keys[i]); }
    { bf16* wsb = (bf16*)(P.ws + WS_WSB); for (int i = gt; i < 65536; i += NT) { const int t = (i >> 7) & 127, s = i & 127; wsb[i] = (bf16)(s <= t ? f2bf(P.gmlp_w_s[i]) : 0u); } }
    { float* lb = (float*)(P.ws + WS_LB); for (int i = gt; i < 512; i += NT) { const float l0 = P.hgrn_lb_logits[i], l1 = P.hgrn_lb_logits[512 + i]; lb[i] = 1.0f / (1.0f + expf(l1 - l0)); } }
    { float* cs = (float*)(P.ws + WS_CS); for (int i = gt; i < T * 8; i += NT) { const int tok = i >> 3, j = i & 7;
        const float inv = 1.0f / powf(500000.0f, (float)j * 0.125f); const float ang = (float)P.positions[tok] * inv; float sn, cn; sincosf(ang, &sn, &cn);
        cs[(size_t)tok * 16 + j] = cn; cs[(size_t)tok * 16 + 8 + j] = sn; } }
}
__device__ __forceinline__ void norm_row_bf16(const float* xrow, bf16* hrow, const float* g, const float* sh, const float* sc, int lane) {
    const f32x4* xr = (const f32x4*)xrow + lane; f32x4 v[4]; float s = 0.f;
#pragma unroll
    for (int j = 0; j < 4; ++j) { v[j] = xr[64 * j]; s += (v[j][0] * v[j][0] + v[j][1] * v[j][1]) + (v[j][2] * v[j][2] + v[j][3] * v[j][3]); }
    const float rstd = 1.0f / sqrtf(wave_sum(s) * (1.0f / 1024.0f) + NORM_EPS);
    unsigned long long* o8 = (unsigned long long*)hrow + lane;
#pragma unroll
    for (int j = 0; j < 4; ++j) { const f32x4 gg = ((const f32x4*)g)[64 * j + lane], hh = ((const f32x4*)sh)[64 * j + lane], cc = ((const f32x4*)sc)[64 * j + lane];
        const f32x4 y = (v[j] * rstd * gg) * (cc + 1.0f) + hh;
        o8[64 * j] = (unsigned long long)pk2(y[0], y[1]) | ((unsigned long long)pk2(y[2], y[3]) << 32); }
}
__device__ __forceinline__ void phase_norm(const Params& P, const Ctx& C, const Wk& W, const float* xsrc, const float* g, int l, int so) {
    const float* MOD = (const float*)(P.ws + WS_MOD); bf16* H = (bf16*)(P.ws + WS_H);
    const int gw = W.lv * NWAVES + C.wave, NGW = W.n * NWAVES;
    for (int m = W_TK0(W) + gw; m < W_TK0(W) + HT; m += NGW) { const float* mb = MOD + (size_t)(l * 8 + (m >> 13)) * 6144 + so;
        norm_row_bf16(xsrc + (size_t)m * 1024, H + (size_t)m * 1024, g, mb, mb + 1024, C.lane); }
}

__device__ __forceinline__ void gmlp_item(const Params& P, const Ctx& C, const Wk& W, int n, int g) {
    LAS bf16* Wt = (LAS bf16*)C.lds;
    LAS bf16* vT = (LAS bf16*)(C.lds + 34816);
    const bf16* WSB = (const bf16*)(P.ws + WS_WSB); const bf16* PU = w_tok16(P, W, AR_PU, 512); const bf16* PV = w_tok16(P, W, AR_PV, 512); bf16* MIX = (bf16*)(P.ws + WS_H);
    const int tid = C.tid, r = C.lane & 15, q4 = C.lane >> 4;
    for (int ch = tid; ch < 2048; ch += 512) { const int rr = ch >> 4, c8 = (ch & 15) * 8; *(LAS v4u*)(Wt + rr * 136 + c8) = *(const v4u*)(WSB + (size_t)(g * 128 + rr) * 128 + c8); }
    { const int t = tid >> 2, part = tid & 3; const bf16* src = PV + (size_t)(n * 128 + t) * 512 + g * 128 + part * 32;
      float x[32];
#pragma unroll
      for (int j = 0; j < 4; ++j) { const v4u w = *(const v4u*)(src + 8 * j);
#pragma unroll
          for (int e = 0; e < 4; ++e) { x[8 * j + 2 * e] = bflo(w[e]); x[8 * j + 2 * e + 1] = bfhi(w[e]); } }
      float s = 0.f;
#pragma unroll
      for (int j = 0; j < 32; ++j) s += x[j];
      s += __shfl_xor(s, 1); s += __shfl_xor(s, 2);
      const float mean = s * (1.0f / 128.0f); float q = 0.f;
#pragma unroll
      for (int j = 0; j < 32; ++j) { const float d = x[j] - mean; q += d * d; }
      q += __shfl_xor(q, 1); q += __shfl_xor(q, 2);
      const float rstd = 1.0f / sqrtf(q * (1.0f / 128.0f) + NORM_EPS);
      const float* lg = P.gmlp_ln_g + g * 128 + part * 32; const float* lbp = P.gmlp_ln_b + g * 128 + part * 32;
#pragma unroll
      for (int j = 0; j < 32; ++j) vT[(part * 32 + j) * 136 + t] = (bf16)f2bf((x[j] - mean) * rstd * lg[j] + lbp[j]);
    }
    __syncthreads();
    const int t0 = 16 * C.wave; const int Keff = ((t0 + 16 + 31) >> 5) << 5;
    f32x4 acc[8];
#pragma unroll
    for (int ct = 0; ct < 8; ++ct) { acc[ct] = (f32x4){0.f, 0.f, 0.f, 0.f}; acc[ct] = mma16(acc[ct], Wt + t0 * 136, 136, vT + (16 * ct) * 136, 136, Keff, r, q4); }
#pragma unroll
    for (int i = 0; i < 4; ++i) { const int t = t0 + 4 * q4 + i; const float bs = P.gmlp_b_s[g * 128 + t]; const size_t tok = (size_t)n * 128 + t;
#pragma unroll
        for (int ct = 0; ct < 8; ++ct) { const int c = 16 * ct + r; const float u = bf2f(PU[tok * 512 + g * 128 + c]); MIX[tok * 1024 + g * 128 + c] = (bf16)f2bf(u * (acc[ct][i] + bs)); } }
    __syncthreads();
}
__device__ __forceinline__ void hgrn_cumsum16(const float* G, size_t tok0, int hh, int k, int seg, LAS float* tot, float (&g)[16], float (&bb)[16], float& total) {
    const float* gp = G + (tok0 + seg * 16) * 512 + hh * 128 + k;
#pragma unroll
    for (int j = 0; j < 16; ++j) g[j] = gp[(size_t)j * 512];
    float run = 0.f;
#pragma unroll
    for (int j = 0; j < 16; ++j) { run += g[j]; bb[j] = run; }
    tot[seg * 128 + k] = run;
    __syncthreads();
    const float t0 = tot[k], t1 = tot[128 + k], t2 = tot[256 + k], t3 = tot[384 + k];
    const float pre = seg == 0 ? 0.f : seg == 1 ? t0 : seg == 2 ? t0 + t1 : t0 + t1 + t2;
    total = (t0 + t1) + (t2 + t3);
#pragma unroll
    for (int j = 0; j < 16; ++j) bb[j] += pre;
}
__device__ __forceinline__ void hgrn_stage_iT(const bf16* PI, size_t tok0, int hh, LAS bf16* iT, int tid) {
    const int s = tid >> 3, v0 = (tid & 7) * 16; const bf16* src = PI + (tok0 + s) * 512 + hh * 128 + v0;
#pragma unroll
    for (int h2 = 0; h2 < 2; ++h2) { const v4u w = *(const v4u*)(src + 8 * h2);
#pragma unroll
        for (int e = 0; e < 4; ++e) { iT[(v0 + 8 * h2 + 2 * e) * 72 + s] = (bf16)(w[e] & 0xffffu); iT[(v0 + 8 * h2 + 2 * e + 1) * 72 + s] = (bf16)(w[e] >> 16); } }
}
__device__ __forceinline__ void hgrn_local_item(const Params& P, const Ctx& C, const Wk& W, int item) {
    LAS bf16* khT = (LAS bf16*)C.lds;
    LAS bf16* iT = (LAS bf16*)(C.lds + 18432);
    LAS float* tot = (LAS float*)(C.lds + 36864);
    const float* G = w_tok32(P, W, AR_G, 512); const bf16* PI = w_tok16(P, W, AR_PI, 512); bf16* KVT = w_item16(P, W, AR_KVT); float* HD = (float*)(P.ws + WS_HD);
    const int bh = item >> 7, c = item & 127, b = bh >> 2, hh = bh & 3; const size_t tok0 = (size_t)b * SEQ + c * 64;
    const int tid = C.tid, k = tid & 127, seg = tid >> 7, r = C.lane & 15, q4 = C.lane >> 4;
    float g[16], bb[16], total;
    hgrn_cumsum16(G, tok0, hh, k, seg, tot, g, bb, total);
    { unsigned w[8];
#pragma unroll
      for (int j = 0; j < 8; ++j) { const float a0 = -expm1f(g[2 * j]) * __expf(total - bb[2 * j]), a1 = -expm1f(g[2 * j + 1]) * __expf(total - bb[2 * j + 1]); w[j] = pk2(a0, a1); }
      LAS v4u* dst = (LAS v4u*)(khT + k * 72 + seg * 16); dst[0] = (v4u){w[0], w[1], w[2], w[3]}; dst[1] = (v4u){w[4], w[5], w[6], w[7]}; }
    if (seg == 0) HD[(size_t)item * 128 + k] = __expf(total);
    hgrn_stage_iT(PI, tok0, hh, iT, tid);
    __syncthreads();
    const int v0 = 16 * C.wave;
#pragma unroll
    for (int ct = 0; ct < 8; ++ct) { f32x4 acc = (f32x4){0.f, 0.f, 0.f, 0.f}; acc = mma16(acc, iT + v0 * 72, 72, khT + (16 * ct) * 72, 72, 64, r, q4);
#pragma unroll
        for (int i = 0; i < 4; ++i) KVT[((size_t)item * 128 + v0 + 4 * q4 + i) * 128 + 16 * ct + r] = (bf16)f2bf(acc[i]); }
    __syncthreads();
}
__device__ __forceinline__ void phase_hgrn_scan(const Params& P, const Ctx& C, const Wk& W) {
    const bf16* KVT = w_item16(P, W, AR_KVT); bf16* ST = w_item16(P, W, AR_ST); const float* HD = (const float*)(P.ws + WS_HD);
    for (int task = W.lv * 256 + C.tid; C.tid < 256 && task < 32768; task += W.n * 256) {
        const int bh = W_BT0(W) * 4 + (task >> 11), v = (task >> 4) & 127, kb = task & 15;
        float st[8];
#pragma unroll
        for (int e = 0; e < 8; ++e) st[e] = 0.f;
#pragma unroll 4
        for (int c = 0; c < 128; ++c) { const size_t item = (size_t)bh * 128 + c, off = (item * 128 + v) * 128 + kb * 8;
            const v4u kv = *(const v4u*)(KVT + off); const f32x4 d0 = *(const f32x4*)(HD + item * 128 + kb * 8), d1 = *(const f32x4*)(HD + item * 128 + kb * 8 + 4);
            v4u o; o.x = pk2(st[0], st[1]); o.y = pk2(st[2], st[3]); o.z = pk2(st[4], st[5]); o.w = pk2(st[6], st[7]);
            *(v4u*)(ST + off) = o;
#pragma unroll
            for (int e = 0; e < 4; ++e) { st[2 * e] = (e < 2 ? d0[2 * e] : d1[2 * e - 4]) * st[2 * e] + bflo(kv[e]); st[2 * e + 1] = (e < 2 ? d0[2 * e + 1] : d1[2 * e - 3]) * st[2 * e + 1] + bfhi(kv[e]); }
        }
    }
}
__device__ __forceinline__ void hgrn_out_item(const Params& P, const Ctx& C, const Wk& W, int item) {
    LAS bf16* qt = (LAS bf16*)C.lds;
    LAS bf16* kt = (LAS bf16*)(C.lds + 17408);
    LAS bf16* iT = (LAS bf16*)(C.lds + 34816);
    LAS bf16* A1 = (LAS bf16*)(C.lds + 53248);
    LAS bf16* STl = (LAS bf16*)(C.lds + 62464);
    LAS float* ol = (LAS float*)(C.lds + 97280);
    LAS float* tot = (LAS float*)(C.lds + 131072);
    const float* G = w_tok32(P, W, AR_G, 512); const bf16* PQ = w_tok16(P, W, AR_PQ, 512); const bf16* PI = w_tok16(P, W, AR_PI, 512); const bf16* PG = w_tok16(P, W, AR_PG, 512);
    const bf16* ST = w_item16(P, W, AR_ST); bf16* MIX = (bf16*)(P.ws + WS_H);
    const int bh = item >> 7, c = item & 127, b = bh >> 2, hh = bh & 3; const size_t tok0 = (size_t)b * SEQ + c * 64;
    const int tid = C.tid, k = tid & 127, seg = tid >> 7, r = C.lane & 15, q4 = C.lane >> 4;
    float g[16], bb[16], total;
    hgrn_cumsum16(G, tok0, hh, k, seg, tot, g, bb, total);
#pragma unroll
    for (int j = 0; j < 16; ++j) { const int t = seg * 16 + j; const float qv = bf2f(PQ[(tok0 + t) * 512 + hh * 128 + k]);
        qt[t * 136 + k] = (bf16)f2bf(qv * __expf(bb[j])); kt[t * 136 + k] = (bf16)f2bf(-expm1f(g[j]) * __expf(-bb[j])); }
    hgrn_stage_iT(PI, tok0, hh, iT, tid);
    for (int ch = tid; ch < 2048; ch += 512) { const int rr = ch >> 4, c8 = (ch & 15) * 8; *(LAS v4u*)(STl + rr * 136 + c8) = *(const v4u*)(ST + ((size_t)item * 128 + rr) * 128 + c8); }
    __syncthreads();
    { const int rt = C.wave >> 1;
#pragma unroll
      for (int cc = 0; cc < 2; ++cc) { const int ct = (C.wave & 1) * 2 + cc; f32x4 acc = (f32x4){0.f, 0.f, 0.f, 0.f};
          acc = mma16(acc, qt + (16 * rt) * 136, 136, kt + (16 * ct) * 136, 136, 128, r, q4);
#pragma unroll
          for (int i = 0; i < 4; ++i) { const int t = 16 * rt + 4 * q4 + i, s = 16 * ct + r; A1[t * 72 + s] = (bf16)(s <= t ? f2bf(acc[i]) : 0u); } } }
    __syncthreads();
    { const int rt = C.wave >> 1;
#pragma unroll
      for (int cc = 0; cc < 4; ++cc) { const int ct = (C.wave & 1) * 4 + cc; f32x4 acc = (f32x4){0.f, 0.f, 0.f, 0.f};
          acc = mma16(acc, A1 + (16 * rt) * 72, 72, iT + (16 * ct) * 72, 72, 64, r, q4);
          acc = mma16(acc, qt + (16 * rt) * 136, 136, STl + (16 * ct) * 136, 136, 128, r, q4);
#pragma unroll
          for (int i = 0; i < 4; ++i) ol[(16 * rt + 4 * q4 + i) * 132 + 16 * ct + r] = acc[i]; } }
    __syncthreads();
    { const int t = tid >> 3, v0 = (tid & 7) * 16; float o[16]; float ss = 0.f;
#pragma unroll
      for (int e = 0; e < 16; ++e) { o[e] = ol[t * 132 + v0 + e]; ss += o[e] * o[e]; }
      ss += __shfl_xor(ss, 1); ss += __shfl_xor(ss, 2); ss += __shfl_xor(ss, 4);
      const float rstd = 1.0f / sqrtf(ss * (1.0f / 128.0f) + NORM_EPS);
      const float* ng = P.hgrn_norm_g + hh * 128 + v0; const bf16* gp = PG + (tok0 + t) * 512 + hh * 128 + v0;
      const v4u g0 = *(const v4u*)gp, g1 = *(const v4u*)(gp + 8); unsigned w[8];
#pragma unroll
      for (int e = 0; e < 4; ++e) { w[e] = pk2(o[2 * e] * rstd * ng[2 * e] * bflo(g0[e]), o[2 * e + 1] * rstd * ng[2 * e + 1] * bfhi(g0[e]));
                                    w[4 + e] = pk2(o[8 + 2 * e] * rstd * ng[8 + 2 * e] * bflo(g1[e]), o[9 + 2 * e] * rstd * ng[9 + 2 * e] * bfhi(g1[e])); }
      v4u* dst = (v4u*)(MIX + (tok0 + t) * 1024 + 512 + hh * 128 + v0); dst[0] = (v4u){w[0], w[1], w[2], w[3]}; dst[1] = (v4u){w[4], w[5], w[6], w[7]}; }
    __syncthreads();
}

typedef short v4i16_t __attribute__((ext_vector_type(4)));
constexpr int AT_VP = 144;
constexpr int AT_QI = 512;
constexpr int AT_STO = 0, AT_STML = AT_QI * 128, AT_VW = AT_STML + AT_QI * 8;
__device__ __forceinline__ void attn_softmax_block(f32x4 (&sa)[9], int tile0, int qq, int mq0, int q4, float& mx, float& ls, bf16x8 (&pf)[5]) {
    mx = -1e30f;
#pragma unroll
    for (int t = 0; t < 9; ++t)
#pragma unroll
        for (int i = 0; i < 4; ++i) { const int kap = 16 * (tile0 + t) + 4 * q4 + i; const bool ok = kap >= qq && kap <= qq + 128 && (mq0 - 128 + kap) >= 0;
            sa[t][i] = ok ? sa[t][i] : -1e30f; mx = fmaxf(mx, sa[t][i]); }
    mx = fmaxf(mx, __shfl_xor(mx, 16)); mx = fmaxf(mx, __shfl_xor(mx, 32));
    ls = 0.f;
#pragma unroll
    for (int t = 0; t < 9; ++t)
#pragma unroll
        for (int i = 0; i < 4; ++i) { const float pv = sa[t][i] > -1e29f ? __builtin_amdgcn_exp2f(sa[t][i] - mx) : 0.f; sa[t][i] = pv; ls += pv; }
    ls += __shfl_xor(ls, 16); ls += __shfl_xor(ls, 32);
#pragma unroll
    for (int s2 = 0; s2 < 5; ++s2) { const int tl = 2 * s2 - tile0, th = 2 * s2 + 1 - tile0;
        const f32x4 lo = (tl >= 0 && tl < 9) ? sa[(tl >= 0 && tl < 9) ? tl : 0] : (f32x4){0.f, 0.f, 0.f, 0.f}, hi = (th >= 0 && th < 9) ? sa[(th >= 0 && th < 9) ? th : 0] : (f32x4){0.f, 0.f, 0.f, 0.f};
        v4u w; w.x = pk2(lo[0], lo[1]); w.y = pk2(lo[2], lo[3]); w.z = pk2(hi[0], hi[1]); w.w = pk2(hi[2], hi[3]); pf[s2] = __builtin_bit_cast(bf16x8, w); }
}
__device__ __forceinline__ void attn_merge(int g, LAS unsigned char* lds, int qloc, int q4, f32x4 (&oa)[4], float mx, float ls, bf16* orow) {
    LAS unsigned char* so = lds + AT_STO + qloc * 128 + 8 * q4; LAS float* sml = (LAS float*)(lds + AT_STML) + 2 * qloc;
    float mo = mx, lo2 = ls;
    if (g > 0) { const float m_old = sml[0], l_old = sml[1]; const float M = fmaxf(m_old, mx); const float fo = __builtin_amdgcn_exp2f(m_old - M), fn = __builtin_amdgcn_exp2f(mx - M);
#pragma unroll
        for (int dt = 0; dt < 4; ++dt) { const unsigned long long w = *(const LAS unsigned long long*)(so + 32 * dt); const unsigned w0 = (unsigned)w, w1 = (unsigned)(w >> 32);
            oa[dt] = oa[dt] * fn + (f32x4){bflo(w0), bfhi(w0), bflo(w1), bfhi(w1)} * fo; }
        mo = M; lo2 = ls * fn + l_old * fo; }
    if (g < 2) {
#pragma unroll
        for (int dt = 0; dt < 4; ++dt) *(LAS unsigned long long*)(so + 32 * dt) = (unsigned long long)pk2(oa[dt][0], oa[dt][1]) | ((unsigned long long)pk2(oa[dt][2], oa[dt][3]) << 32);
        if (q4 == 0) { sml[0] = mo; sml[1] = lo2; }
    } else { const float inv = 1.0f / lo2;
#pragma unroll
        for (int dt = 0; dt < 4; ++dt) { const f32x4 v = oa[dt] * inv; *(unsigned long long*)(orow + 16 * dt) = (unsigned long long)pk2(v[0], v[1]) | ((unsigned long long)pk2(v[2], v[3]) << 32); } }
}
__device__ __forceinline__ void attn_item(const Params& P, const Ctx& C, const Wk& W, int b, int hd, int qt) {
    LAS unsigned char* Vw = C.lds + AT_VW + C.wave * (64 * AT_VP);
    const bf16* QKV = w_tok16(P, W, AR_QK, 3072); bf16* O = (bf16*)(P.ws + WS_H);
    const int lane = C.lane, r = lane & 15, q4 = lane >> 4;
    const int t0 = qt * AT_QI; const size_t rowbase = (size_t)b * SEQ;
    const bf16* Kb = QKV + rowbase * 3072 + 1024 + hd * 64; const bf16* Vb = QKV + rowbase * 3072 + 2048 + hd * 64;
#pragma unroll 1
    for (int g = 0; g < 3; ++g) {
        const int dsh = 4 - 2 * g, d = 1 << dsh;
#pragma unroll 1
        for (int uu = 0; uu < 2; ++uu) {
            const int u = C.wave + 8 * uu;
            const int c = u & (d - 1), j = u >> dsh;
            const int mq0 = (t0 >> dsh) + 32 * j;
            const int ql0 = c + d * (32 * j + r), ql1 = ql0 + 16 * d;
            const bf16* qp0 = QKV + (rowbase + t0 + ql0) * 3072 + hd * 64 + 8 * q4; const bf16* qp1 = QKV + (rowbase + t0 + ql1) * 3072 + hd * 64 + 8 * q4;
            const bf16x8 bq00 = *(const bf16x8*)qp0, bq01 = *(const bf16x8*)(qp0 + 32), bq10 = *(const bf16x8*)qp1, bq11 = *(const bf16x8*)(qp1 + 32);
            bf16x8 ka[10][2];
#pragma unroll
            for (int t = 0; t < 10; ++t) { int mk = mq0 - 128 + 16 * t + r; mk = mk < 0 ? 0 : mk;
                const bf16* kp = Kb + (size_t)(c + d * mk) * 3072 + 8 * q4; ka[t][0] = *(const bf16x8*)kp; ka[t][1] = *(const bf16x8*)(kp + 32); }
            v4u vr[2][8];
#pragma unroll
            for (int it = 0; it < 8; ++it) { const int kap = 8 * it + (lane >> 3); int mk = mq0 - 128 + kap; mk = mk < 0 ? 0 : mk;
                vr[0][it] = *(const v4u*)(Vb + (size_t)(c + d * mk) * 3072 + (lane & 7) * 8); }
            __builtin_amdgcn_sched_barrier(0);
            bf16x8 pf0[5], pf1[5]; float mx0, ls0, mx1, ls1;
            { f32x4 sa[9];
#pragma unroll
              for (int t = 0; t < 9; ++t) { sa[t] = (f32x4){0.f, 0.f, 0.f, 0.f}; sa[t] = __builtin_amdgcn_mfma_f32_16x16x32_bf16(ka[t][0], bq00, sa[t], 0, 0, 0); sa[t] = __builtin_amdgcn_mfma_f32_16x16x32_bf16(ka[t][1], bq01, sa[t], 0, 0, 0); }
              attn_softmax_block(sa, 0, r, mq0, q4, mx0, ls0, pf0); }
            { f32x4 sa[9];
#pragma unroll
              for (int t = 0; t < 9; ++t) { sa[t] = (f32x4){0.f, 0.f, 0.f, 0.f}; sa[t] = __builtin_amdgcn_mfma_f32_16x16x32_bf16(ka[t + 1][0], bq10, sa[t], 0, 0, 0); sa[t] = __builtin_amdgcn_mfma_f32_16x16x32_bf16(ka[t + 1][1], bq11, sa[t], 0, 0, 0); }
              __builtin_amdgcn_sched_barrier(0);
#pragma unroll
              for (int it = 0; it < 8; ++it) { const int kap = 64 + 8 * it + (lane >> 3); int mk = mq0 - 128 + kap; mk = mk < 0 ? 0 : mk;
                  vr[1][it] = *(const v4u*)(Vb + (size_t)(c + d * mk) * 3072 + (lane & 7) * 8); }
              __builtin_amdgcn_sched_barrier(0);
              attn_softmax_block(sa, 1, 16 + r, mq0, q4, mx1, ls1, pf1); }
            v4u vr2[4];
#pragma unroll
            for (int it = 0; it < 4; ++it) { const int kap = 128 + 8 * it + (lane >> 3); const int mk = mq0 - 128 + kap;
                vr2[it] = *(const v4u*)(Vb + (size_t)(c + d * mk) * 3072 + (lane & 7) * 8); }
            f32x4 oa0[4], oa1[4];
#pragma unroll
            for (int dt = 0; dt < 4; ++dt) { oa0[dt] = (f32x4){0.f, 0.f, 0.f, 0.f}; oa1[dt] = (f32x4){0.f, 0.f, 0.f, 0.f}; }
#pragma unroll
            for (int ch = 0; ch < 3; ++ch) {
#pragma unroll
                for (int it = 0; it < 8; ++it) { const int row = 8 * it + (lane >> 3);
                    if (ch < 2) *(LAS v4u*)(Vw + row * AT_VP + (lane & 7) * 16) = vr[ch < 2 ? ch : 0][it];
                    else if (it < 4) *(LAS v4u*)(Vw + row * AT_VP + (lane & 7) * 16) = vr2[it < 4 ? it : 0]; }
                asm volatile("s_waitcnt lgkmcnt(0)" ::: "memory");
#pragma unroll
                for (int s2 = 0; s2 < 2; ++s2) { const int sx = 2 * ch + s2; if (sx < 5) {
#pragma unroll
                    for (int dt = 0; dt < 4; ++dt) {
                        const LAS unsigned char* vp = Vw + (32 * s2 + 4 * q4 + (r >> 2)) * AT_VP + dt * 32 + (r & 3) * 8;
                        const v4i16_t x = __builtin_amdgcn_ds_read_tr16_b64_v4i16((LAS v4i16_t*)vp), y = __builtin_amdgcn_ds_read_tr16_b64_v4i16((LAS v4i16_t*)(vp + 16 * AT_VP));
                        const bf16x8 av = (bf16x8){x[0], x[1], x[2], x[3], y[0], y[1], y[2], y[3]};
                        oa0[dt] = __builtin_amdgcn_mfma_f32_16x16x32_bf16(av, pf0[sx], oa0[dt], 0, 0, 0);
                        oa1[dt] = __builtin_amdgcn_mfma_f32_16x16x32_bf16(av, pf1[sx], oa1[dt], 0, 0, 0); } } }
                asm volatile("s_waitcnt lgkmcnt(0)" ::: "memory");
            }
            attn_merge(g, C.lds, ql0, q4, oa0, mx0, ls0, O + (rowbase + t0 + ql0) * 1024 + hd * 64 + 4 * q4);
            attn_merge(g, C.lds, ql1, q4, oa1, mx1, ls1, O + (rowbase + t0 + ql1) * 1024 + hd * 64 + 4 * q4);
        }
        __syncthreads();
    }
}

__device__ __forceinline__ unsigned ordf(float s) { const unsigned u = __builtin_bit_cast(unsigned, s); return u ^ ((unsigned)((int)u >> 31) | 0x80000000u); }
__device__ __forceinline__ float unordf(unsigned v) { return __builtin_bit_cast(float, v ^ ((unsigned)((int)(~v) >> 31) | 0x80000000u)); }
__device__ __forceinline__ void ins16(unsigned (&top)[16], unsigned x) {
#pragma unroll
    for (int j = 0; j < 16; ++j) { const unsigned hi = top[j] > x ? top[j] : x; x = top[j] > x ? x : top[j]; top[j] = hi; }
}
#define CE_D(a, b) { const unsigned hi_ = (a) > (b) ? (a) : (b), lo_ = (a) > (b) ? (b) : (a); (a) = hi_; (b) = lo_; }
__device__ __forceinline__ void sort16_desc(unsigned (&v)[16]) {
#pragma unroll
    for (int k = 2; k <= 16; k <<= 1)
#pragma unroll
        for (int j = k >> 1; j > 0; j >>= 1)
#pragma unroll
            for (int i = 0; i < 16; ++i) { const int l = i ^ j; if (l > i) { if ((i & k) == 0) CE_D(v[i], v[l]) else CE_D(v[l], v[i]) } }
}
__device__ __forceinline__ void bitonic_merge16_desc(unsigned (&c)[16]) {
#pragma unroll
    for (int st = 8; st >= 1; st >>= 1)
#pragma unroll
        for (int j = 0; j < 16; ++j) if ((j & st) == 0) CE_D(c[j], c[j + st])
}
__device__ __forceinline__ void top16_of_two(unsigned (&a)[16], const unsigned (&b)[16]) {
#pragma unroll
    for (int j = 0; j < 16; ++j) a[j] = a[j] > b[15 - j] ? a[j] : b[15 - j];
    bitonic_merge16_desc(a);
}
__device__ __forceinline__ void merge16(unsigned (&top)[16], int mask) {
    unsigned o[16];
#pragma unroll
    for (int j = 0; j < 16; ++j) o[j] = (unsigned)__shfl_xor((int)top[j], mask);
    top16_of_two(top, o);
}
__device__ __forceinline__ void phase_peer_topk(const Params& P, const Ctx& C, const Wk& W, int layer) {
    LAS bf16* SK = (LAS bf16*)C.lds;
    const bf16* SKB = (const bf16*)(P.ws + WS_SKB) + (size_t)layer * 32768; const bf16* QP = w_tok16(P, W, AR_QP, 2048);
    int* IDX = (int*)(P.ws + WS_IDX); float* GATE = (float*)(P.ws + WS_GATE);
    for (int ch = C.tid; ch < 4096; ch += 512) { const int rr = ch >> 4, c8 = (ch & 15) * 8; *(LAS v4u*)(SK + rr * 136 + c8) = *(const v4u*)(SKB + (size_t)rr * 128 + c8); }
    __syncthreads();
    const int r = C.lane & 15, q4 = C.lane >> 4;
    const int gw = W.lv * NWAVES + C.wave, NGW = W.n * NWAVES;
    for (int grp = W_TK0(W) / 2 + gw; grp < W_TK0(W) / 2 + HT * 8 / 16; grp += NGW) {
        const size_t task = (size_t)grp * 16 + r;
        unsigned lst[2][16];
#pragma unroll
        for (int half = 0; half < 2; ++half) {
            bf16x8 bq[4];
#pragma unroll
            for (int ks = 0; ks < 4; ++ks) bq[ks] = *(const bf16x8*)(QP + task * 256 + half * 128 + ks * 32 + 8 * q4);
            unsigned ka[16], kb[16];
#pragma unroll
            for (int nt = 0; nt < 8; ++nt) { f32x4 acc = (f32x4){0.f, 0.f, 0.f, 0.f};
#pragma unroll
                for (int ks = 0; ks < 4; ++ks) { const bf16x8 a = *(const LAS bf16x8*)(SK + (half * 128 + 16 * nt + r) * 136 + ks * 32 + 8 * q4); acc = __builtin_amdgcn_mfma_f32_16x16x32_bf16(a, bq[ks], acc, 0, 0, 0); }
#pragma unroll
                for (int i = 0; i < 4; ++i) { const unsigned n = 16 * nt + 4 * q4 + i; const unsigned key = (ordf(acc[i]) & ~127u) | (127u - n); if (nt < 4) ka[4 * nt + i] = key; else kb[4 * (nt - 4) + i] = key; }
                if (nt == 3) sort16_desc(ka);
                __builtin_amdgcn_sched_barrier(0); }
            sort16_desc(kb); top16_of_two(ka, kb);
            merge16(ka, 16); merge16(ka, 32);
#pragma unroll
            for (int j = 0; j < 16; ++j) lst[half][j] = ka[j];
        }
        float v2[16]; unsigned e2[16];
#pragma unroll
        for (int j = 0; j < 16; ++j) { v2[j] = unordf(lst[1][j] & ~127u); e2[j] = 127u - (lst[1][j] & 127u); }
        float v1s[4]; unsigned e1s[4];
#pragma unroll
        for (int k = 0; k < 4; ++k) { const unsigned w = q4 == 0 ? lst[0][4 * k] : q4 == 1 ? lst[0][4 * k + 1] : q4 == 2 ? lst[0][4 * k + 2] : lst[0][4 * k + 3];
            v1s[k] = unordf(w & ~127u); e1s[k] = (127u - (w & 127u)) << 7; }
        unsigned top[16];
#pragma unroll
        for (int j = 0; j < 16; ++j) top[j] = (ordf(v1s[0] + v2[j]) & ~16383u) | e1s[0] | e2[j];
        sort16_desc(top);
#pragma unroll
        for (int j = 0; j < 3; ++j) ins16(top, (ordf(v1s[1] + v2[j]) & ~16383u) | e1s[1] | e2[j]);
        ins16(top, (ordf(v1s[2] + v2[0]) & ~16383u) | e1s[2] | e2[0]);
        ins16(top, (ordf(v1s[3] + v2[0]) & ~16383u) | e1s[3] | e2[0]);
        merge16(top, 16); merge16(top, 32);
        float ev[16]; float den = 0.f; const float mx = unordf(top[0] & ~16383u);
#pragma unroll
        for (int j = 0; j < 16; ++j) { ev[j] = __expf(unordf(top[j] & ~16383u) - mx); den += ev[j]; }
        const float inv = 1.0f / den;
        int* ip = IDX + task * 16; float* gp = GATE + task * 16;
        if (q4 == 0) { *(v4u*)(ip) = (v4u){top[0] & 16383u, top[1] & 16383u, top[2] & 16383u, top[3] & 16383u}; *(f32x4*)(gp) = (f32x4){ev[0] * inv, ev[1] * inv, ev[2] * inv, ev[3] * inv}; }
        else if (q4 == 1) { *(v4u*)(ip + 4) = (v4u){top[4] & 16383u, top[5] & 16383u, top[6] & 16383u, top[7] & 16383u}; *(f32x4*)(gp + 4) = (f32x4){ev[4] * inv, ev[5] * inv, ev[6] * inv, ev[7] * inv}; }
        else if (q4 == 2) { *(v4u*)(ip + 8) = (v4u){top[8] & 16383u, top[9] & 16383u, top[10] & 16383u, top[11] & 16383u}; *(f32x4*)(gp + 8) = (f32x4){ev[8] * inv, ev[9] * inv, ev[10] * inv, ev[11] * inv}; }
        else { *(v4u*)(ip + 12) = (v4u){top[12] & 16383u, top[13] & 16383u, top[14] & 16383u, top[15] & 16383u}; *(f32x4*)(gp + 12) = (f32x4){ev[12] * inv, ev[13] * inv, ev[14] * inv, ev[15] * inv}; }
    }
}
struct ExpRow { v4u d[4], u[4]; float ds, us, gk; };
__device__ __forceinline__ void exp_issue(ExpRow& R, const unsigned char* TD, const unsigned char* TU, const float* SD, int ex, float gk, int jl) {
    const unsigned char* dr = TD + (size_t)ex * TROW; const unsigned char* ur = TU + (size_t)ex * TROW;
#pragma unroll
    for (int c = 0; c < 4; ++c) R.d[c] = *(const v4u*)(dr + (c * 16 + jl) * 16);
#pragma unroll
    for (int c = 0; c < 4; ++c) R.u[c] = *(const v4u*)(ur + (c * 16 + jl) * 16);
    R.ds = SD[ex]; R.us = SD[16384 + ex]; R.gk = gk;
}
__device__ __forceinline__ void exp_consume(const ExpRow& R, const unsigned (&hp)[32], f32x2 (&oacc)[32]) {
    f32x2 a2 = (f32x2){0.f, 0.f};
#pragma unroll
    for (int c = 0; c < 4; ++c)
#pragma unroll
        for (int w = 0; w < 4; ++w) { const f32x2 lo = __builtin_amdgcn_cvt_pk_f32_fp8((int)R.d[c][w], false), hi = __builtin_amdgcn_cvt_pk_f32_fp8((int)R.d[c][w], true);
            unsigned h0 = hp[c * 8 + 2 * w], h1 = hp[c * 8 + 2 * w + 1]; asm volatile("" : "+v"(h0), "+v"(h1));
            a2 = a2 + lo * (f32x2){bflo(h0), bfhi(h0)}; a2 = a2 + hi * (f32x2){bflo(h1), bfhi(h1)}; }
    float a = (a2.x + a2.y) * R.ds;
    a += __shfl_xor(a, 1); a += __shfl_xor(a, 2); a += __shfl_xor(a, 4); a += __shfl_xor(a, 8);
    const float wk = R.gk * gelu_f(a) * R.us; const f32x2 wk2 = (f32x2){wk, wk};
#pragma unroll
    for (int c = 0; c < 4; ++c)
#pragma unroll
        for (int w = 0; w < 4; ++w) { const f32x2 lo = __builtin_amdgcn_cvt_pk_f32_fp8((int)R.u[c][w], false), hi = __builtin_amdgcn_cvt_pk_f32_fp8((int)R.u[c][w], true);
            oacc[c * 8 + 2 * w] = oacc[c * 8 + 2 * w] + wk2 * lo; oacc[c * 8 + 2 * w + 1] = oacc[c * 8 + 2 * w + 1] + wk2 * hi; }
}
__device__ __forceinline__ void phase_peer_experts(const Params& P, const Ctx& Cin, const Wk& W, int layer, bool last) {
    const Ctx C = fresh_ctx(Cin);
    const unsigned char* TD = P.ws + WS_TAB8 + (size_t)(2 * layer) * TAB8_BYTES; const unsigned char* TU = P.ws + WS_TAB8 + (size_t)(2 * layer + 1) * TAB8_BYTES; const float* SD = (const float*)(P.ws + WS_SC8) + (size_t)(2 * layer) * 16384; bf16* H = (bf16*)(P.ws + WS_H);
    const int* IDX = (const int*)(P.ws + WS_IDX); const float* GATE = (const float*)(P.ws + WS_GATE); const float* MOD = (const float*)(P.ws + WS_MOD);
    const int lane = C.lane, grp = lane >> 4, jl = lane & 15;
    unsigned* ticket = (unsigned*)(P.ws + WS_CTL) + 96 + 2 * layer + W.h;
    const bool dyn = W.n != C.G;
    const int gws = W.lv * NWAVES + C.wave, NGWS = W.n * NWAVES;
    int tnext = gws; if (dyn) { if (lane == 0) tnext = (int)atomicAdd(ticket, 1u); tnext = __builtin_amdgcn_readfirstlane(tnext); }
    while (tnext < HT) {
        const int tok = W_TK0(W) + tnext;
        if (dyn) { int tn = 0; if (lane == 0) tn = (int)atomicAdd(ticket, 1u); tnext = tn; } else tnext += NGWS;
        const int b = tok >> 13;
        const int i0 = IDX[(size_t)tok * 128 + lane], i1 = IDX[(size_t)tok * 128 + 64 + lane];
        const float g0 = GATE[(size_t)tok * 128 + lane], g1 = GATE[(size_t)tok * 128 + 64 + lane];
        unsigned hf[32];
#pragma unroll
        for (int c = 0; c < 4; ++c) { const bf16* hp = H + (size_t)tok * 1024 + (c * 16 + jl) * 16; const v4u w0 = *(const v4u*)hp, w1 = *(const v4u*)(hp + 8);
#pragma unroll
            for (int e = 0; e < 4; ++e) { hf[c * 8 + e] = w0[e]; hf[c * 8 + 4 + e] = w1[e]; } }
        f32x2 oacc[32];
#pragma unroll
        for (int e = 0; e < 32; ++e) oacc[e] = (f32x2){0.f, 0.f};
        ExpRow RA, RB;
        exp_issue(RA, TD, TU, SD, __shfl(i0, grp), __shfl(g0, grp), jl);
        for (int it = 0; it < 32 * EXP_REP; it += 2) {
            { const int kk = ((it + 1) & 31) * 4 + grp; const int el = __shfl(i0, kk & 63), eh = __shfl(i1, kk & 63); const float gl = __shfl(g0, kk & 63), gh = __shfl(g1, kk & 63);
              exp_issue(RB, TD, TU, SD, kk < 64 ? el : eh, kk < 64 ? gl : gh, jl); }
            exp_consume(RA, hf, oacc);
            { const int kk = ((it + 2) & 31) * 4 + grp; const int el = __shfl(i0, kk & 63), eh = __shfl(i1, kk & 63); const float gl = __shfl(g0, kk & 63), gh = __shfl(g1, kk & 63);
              exp_issue(RA, TD, TU, SD, kk < 64 ? el : eh, kk < 64 ? gl : gh, jl); }
            exp_consume(RB, hf, oacc);
        }
        f32x2 h1[16];
        { const bool up = (grp & 2) != 0;
#pragma unroll
          for (int e = 0; e < 16; ++e) { const f32x2 keep = up ? oacc[16 + e] : oacc[e], send = up ? oacc[e] : oacc[16 + e]; h1[e] = keep + (f32x2){__shfl_xor(send.x, 32), __shfl_xor(send.y, 32)}; } }
        f32x2 h2[8];
        { const bool up = (grp & 1) != 0;
#pragma unroll
          for (int e = 0; e < 8; ++e) { const f32x2 keep = up ? h1[8 + e] : h1[e], send = up ? h1[e] : h1[8 + e]; h2[e] = keep + (f32x2){__shfl_xor(send.x, 16), __shfl_xor(send.y, 16)}; } }
        const int d0 = (grp * 16 + jl) * 16;
        const float* g2p = MOD + (size_t)(layer * 8 + b) * 6144 + 5120 + d0; const float psc = ((ABL_ON >= (layer == 0 ? 2 : 4)) ? 1.f : 0.f) * (1.0f / EXP_REP);
        float* xp = P.out + (size_t)tok * 1024 + d0;
        float xn[16]; float ss = 0.f;
#pragma unroll
        for (int q = 0; q < 4; ++q) { const f32x4 xa = *(const f32x4*)(xp + 4 * q), ga = *(const f32x4*)(g2p + 4 * q);
            xn[4 * q] = xa[0] + psc * ga[0] * h2[2 * q].x; xn[4 * q + 1] = xa[1] + psc * ga[1] * h2[2 * q].y; xn[4 * q + 2] = xa[2] + psc * ga[2] * h2[2 * q + 1].x; xn[4 * q + 3] = xa[3] + psc * ga[3] * h2[2 * q + 1].y; }
#pragma unroll
        for (int e = 0; e < 16; ++e) ss += xn[e] * xn[e];
        const float rstd = 1.0f / sqrtf(wave_sum(ss) * (1.0f / 1024.0f) + NORM_EPS);
        if (!last) {
            const float* ng = P.norm_mix_g + (layer + 1) * 1024 + d0; const float* mb = MOD + (size_t)((layer + 1) * 8 + b) * 6144 + d0;
            unsigned w[8];
#pragma unroll
            for (int q = 0; q < 4; ++q) { *(f32x4*)(xp + 4 * q) = (f32x4){xn[4 * q], xn[4 * q + 1], xn[4 * q + 2], xn[4 * q + 3]}; }
#pragma unroll
            for (int e = 0; e < 8; ++e) w[e] = pk2(xn[2 * e] * rstd * ng[2 * e] * (1.0f + mb[1024 + 2 * e]) + mb[2 * e], xn[2 * e + 1] * rstd * ng[2 * e + 1] * (1.0f + mb[1024 + 2 * e + 1]) + mb[2 * e + 1]);
            v4u* hp = (v4u*)(H + (size_t)tok * 1024 + d0); hp[0] = (v4u){w[0], w[1], w[2], w[3]}; hp[1] = (v4u){w[4], w[5], w[6], w[7]};
        } else {
            const float* fg = P.final_norm_g + d0;
#pragma unroll
            for (int q = 0; q < 4; ++q) *(f32x4*)(xp + 4 * q) = (f32x4){xn[4 * q] * rstd * fg[4 * q], xn[4 * q + 1] * rstd * fg[4 * q + 1], xn[4 * q + 2] * rstd * fg[4 * q + 2], xn[4 * q + 3] * rstd * fg[4 * q + 3]};
        }
        if (dyn) tnext = __builtin_amdgcn_readfirstlane(tnext);
    }
}

#ifndef NC_PER_XCD
#define NC_PER_XCD 16
#endif
#ifdef PROBE_SEL
#define SUBSTAMP(i) do { if (W.c == 0 && C.tid == 0) __hip_atomic_store((unsigned*)(P.ws + WS_CTL) + 128 + 16 * W.h + (i), (unsigned)__builtin_amdgcn_s_memrealtime(), __ATOMIC_RELAXED, __HIP_MEMORY_SCOPE_AGENT); } while (0)
#else
#define SUBSTAMP(i) do {} while (0)
#endif
__device__ __forceinline__ void run_C0(const Params& P, const Ctx& Cin, const Wk& W, const XcdBarrier& tb) {
    const Ctx C = fresh_ctx(Cin);
    SUBSTAMP(0);
    unsigned char* ws = P.ws; float* MOD = (float*)(ws + WS_MOD); bf16* H = (bf16*)(ws + WS_H);
    const size_t tk = (size_t)W_TK0(W); unsigned char* const ar = w_ar(P, W);
    phase_norm(P, C, W, P.x, P.norm_mix_g, 0, 0); xcd_barrier(tb); SUBSTAMP(1);
    { pg8::Gemm g{H + tk * 1024, (const bf16*)(ws + WS_WIN), HT, 3072, 1024}; pg8::StaticOrder S; S.init(HT, 3072, W.n, W.c);
      EpiInProj E{(bf16*)(ar + AR_PU), (bf16*)(ar + AR_PV), (bf16*)(ar + AR_PQ), (bf16*)(ar + AR_PI), (bf16*)(ar + AR_PG), (float*)(ar + AR_G), (const float*)(ws + WS_LB)};
      pg8::gemm_phase<EpiInProj, pg8::StaticOrder, true, true>(C.lds, g, S, E); } xcd_barrier(tb); SUBSTAMP(2);
    for (int it = W.lv; it < 1024; it += W.n) gmlp_item(P, C, W, W_TK0(W) / 128 + (it >> 2), it & 3);
    for (int it = W.lv; it < 2048; it += W.n) hgrn_local_item(P, C, W, W_BT0(W) * 512 + it);
    xcd_barrier(tb); SUBSTAMP(3);
    phase_hgrn_scan(P, C, W); xcd_barrier(tb); SUBSTAMP(4);
    for (int it = W.lv; it < 2048; it += W.n) hgrn_out_item(P, C, W, W_BT0(W) * 512 + it);
    xcd_barrier(tb); SUBSTAMP(5);
    { pg8::Gemm g{H + tk * 1024, (const bf16*)(ws + WS_WOUT0), HT, 1024, 1024}; pg8::StaticOrder S; S.init(HT, 1024, W.n, W.c);
      EpiResid E{P.x + tk * 1024, P.out + tk * 1024, MOD + 2048 + (size_t)W_BT0(W) * 6144, 1.f};
      pg8::gemm_phase<EpiResid, pg8::StaticOrder, true, true>(C.lds, g, S, E); } xcd_barrier(tb); SUBSTAMP(6);
    phase_norm(P, C, W, P.out, P.norm_ffn_g, 0, 3072); xcd_barrier(tb); SUBSTAMP(7);
    { pg8::Gemm g{H + tk * 1024, (const bf16*)(ws + WS_WQ0), HT, 2048, 1024}; pg8::StaticOrder S; S.init(HT, 2048, W.n, W.c);
      EpiBf16P E{(bf16*)(ar + AR_QP), 2048};
      pg8::gemm_phase<EpiBf16P, pg8::StaticOrder, true, true>(C.lds, g, S, E); }
    SUBSTAMP(9);
}
__device__ __forceinline__ void run_C1(const Params& P, const Ctx& Cin, const Wk& W, const XcdBarrier& tb) {
    const Ctx C = fresh_ctx(Cin);
    SUBSTAMP(0);
    unsigned char* ws = P.ws; float* MOD = (float*)(ws + WS_MOD); bf16* H = (bf16*)(ws + WS_H);
    const size_t tk = (size_t)W_TK0(W); unsigned char* const ar = w_ar(P, W);
    { pg8::Gemm g{H + tk * 1024, (const bf16*)(ws + WS_WQKV), HT, 3072, 1024}; pg8::StaticOrder S; S.init(HT, 3072, W.n, W.c);
      EpiQKRot E{(bf16*)(ar + AR_QK), (const float*)(ws + WS_CS) + tk * 16};
      pg8::gemm_phase<EpiQKRot, pg8::StaticOrder, true, true>(C.lds, g, S, E); } xcd_barrier(tb); SUBSTAMP(1);
    for (int it = W.lv; it < (NB / 2) * 16 * 16; it += W.n) attn_item(P, C, W, W_BT0(W) + (it >> 8), (it >> 4) & 15, it & 15);
    xcd_barrier(tb); SUBSTAMP(2);
    { pg8::Gemm g{H + tk * 1024, (const bf16*)(ws + WS_WOUT1), HT, 1024, 1024}; pg8::StaticOrder S; S.init(HT, 1024, W.n, W.c);
      EpiResid E{P.out + tk * 1024, P.out + tk * 1024, MOD + (size_t)8 * 6144 + 2048 + (size_t)W_BT0(W) * 6144, 1.f};
      pg8::gemm_phase<EpiResid, pg8::StaticOrder, true, true>(C.lds, g, S, E); } xcd_barrier(tb); SUBSTAMP(3);
    phase_norm(P, C, W, P.out, P.norm_ffn_g + 1024, 1, 3072); xcd_barrier(tb); SUBSTAMP(4);
    { pg8::Gemm g{H + tk * 1024, (const bf16*)(ws + WS_WQ1), HT, 2048, 1024}; pg8::StaticOrder S; S.init(HT, 2048, W.n, W.c);
      EpiBf16P E{(bf16*)(ar + AR_QP), 2048};
      pg8::gemm_phase<EpiBf16P, pg8::StaticOrder, true, true>(C.lds, g, S, E); }
    SUBSTAMP(9);
}
__device__ __forceinline__ void run_E(const Params& P, const Ctx& Cin, const Wk& W, const XcdBarrier& tb, int layer) {
    { const Ctx C = fresh_ctx(Cin); phase_peer_topk(P, C, W, layer); }
    xcd_barrier(tb);
    if (W.c == 0 && Cin.tid == 0) __hip_atomic_store((unsigned*)(P.ws + WS_CTL) + 112 + 2 * layer + W.h, 1u, __ATOMIC_RELAXED, __HIP_MEMORY_SCOPE_AGENT);
    phase_peer_experts(P, Cin, W, layer, layer == 1);
}
__device__ __forceinline__ void help_E(const Params& P, const Ctx& Cin, int h, int layer) {
    volatile LAS unsigned* okw = (volatile LAS unsigned*)(Cin.lds + LDSCTL_OFF + 192);
    if (Cin.tid == 0) { unsigned* flag = (unsigned*)(P.ws + WS_CTL) + 112 + 2 * layer + h; unsigned ok = 0u;
        for (unsigned sp = 0; sp < (1u << 16); ++sp) { if (__hip_atomic_load(flag, __ATOMIC_RELAXED, __HIP_MEMORY_SCOPE_AGENT) != 0u) { ok = 1u; break; } __builtin_amdgcn_s_sleep(8); }
        __builtin_amdgcn_fence(__ATOMIC_ACQUIRE, "agent"); asm volatile("s_waitcnt vmcnt(0)" ::: "memory");
        *okw = ok; }
    __syncthreads();
    const bool ok = *okw != 0u;
    __syncthreads();
    if (ok) { Wk W; W.lv = 0; W.n = 1; W.c = 1; W.h = h; phase_peer_experts(P, Cin, W, layer, layer == 1); }
}
__global__ void __launch_bounds__(NWAVES * 64, 2) hybrid_fwd(Params P) {
    extern __shared__ __attribute__((aligned(16))) unsigned char lds_raw[];
    Ctx C;
    C.lds = (LAS unsigned char*)lds_raw;
    C.tid = threadIdx.x; C.lane = C.tid & 63; C.wave = __builtin_amdgcn_readfirstlane(C.tid >> 6);
    C.G = gridDim.x; const int bx = blockIdx.x; C.vcu = (bx % 8) * (C.G / 8) + bx / 8;
    volatile LAS unsigned* MISC = (volatile LAS unsigned*)(C.lds + MISC_OFF);
    for (int u = C.tid; u < (LDS_BYTES - LDSCTL_OFF) / 4; u += NWAVES * 64) ((LAS unsigned*)(C.lds + LDSCTL_OFF))[u] = 0u;
    __syncthreads();
    unsigned* ctl = (unsigned*)(P.ws + WS_CTL);
    const int xl = bx & 7, jx = bx >> 3, perx = C.G / 8;
    const bool inC = jx < NC_PER_XCD;
    const int nC = 8 * NC_PER_XCD, nE = C.G - nC;
    const XcdBarrier bar_all = xcd_barrier_post(ctl + CW_BAR, MISC + 8);
    XcdBarrier bar_c; bar_c.bar = ctl + CW_BAR + XCD_BAR_WORDS; bar_c.x = bar_all.x; bar_c.st = MISC + 10; bar_c.G = (unsigned)nC;
    if (inC && C.tid == 0) (void)xb_add(&bar_c.bar[XB_XCNT(bar_c.x)], 1u);
    XcdBarrier bar_e; bar_e.bar = ctl + CW_BAR + 2 * XCD_BAR_WORDS; bar_e.x = bar_all.x; bar_e.st = MISC + 12; bar_e.G = (unsigned)nE;
    if (!inC && C.tid == 0) (void)xb_add(&bar_e.bar[XB_XCNT(bar_e.x)], 1u);
    Wk Wall; Wall.lv = C.vcu; Wall.n = C.G; Wall.c = bx; Wall.h = 0;
    Wk Wc; Wc.lv = xl * NC_PER_XCD + jx; Wc.n = nC; Wc.c = jx * 8 + xl; Wc.h = 0;
    Wk We; { const int je = jx - NC_PER_XCD, ne = perx - NC_PER_XCD; We.lv = xl * ne + je; We.n = nE; We.c = je * 8 + xl; We.h = 0; }
    phase_prologue(P, C);
    xcd_barrier(bar_all);
#ifdef PROBE_SEL
    unsigned long long tp0 = __builtin_amdgcn_s_memrealtime(), tp1 = 0, tp2 = 0, tp3 = 0, tp4 = 0, tp5 = 0, tpe1 = 0, tpe2 = 0, tpe3 = 0;
#define STAMP(v) v = __builtin_amdgcn_s_memrealtime()
#else
#define STAMP(v)
#endif
    Wall.h = 0; run_C0(P, C, Wall, bar_all); xcd_barrier(bar_all); STAMP(tp1);
    if (inC) { Wc.h = 1; run_C0(P, C, Wc, bar_c); help_E(P, C, 0, 0); } else { We.h = 0; run_E(P, C, We, bar_e, 0); }
    STAMP(tpe1);
#ifdef PROBE_SEL
    if (C.tid == 0) atomicMax(ctl + 80 + (inC ? 0 : 1), (unsigned)(tpe1 - tp1));
#endif
    xcd_barrier(bar_all); STAMP(tp2);
    if (inC) { Wc.h = 0; run_C1(P, C, Wc, bar_c); help_E(P, C, 1, 0); } else { We.h = 1; run_E(P, C, We, bar_e, 0); }
    STAMP(tpe2);
#ifdef PROBE_SEL
    if (C.tid == 0) atomicMax(ctl + 82 + (inC ? 0 : 1), (unsigned)(tpe2 - tp2));
#endif
    xcd_barrier(bar_all); STAMP(tp3);
    if (inC) { Wc.h = 1; run_C1(P, C, Wc, bar_c); help_E(P, C, 0, 1); } else { We.h = 0; run_E(P, C, We, bar_e, 1); }
    STAMP(tpe3);
#ifdef PROBE_SEL
    if (C.tid == 0) atomicMax(ctl + 84 + (inC ? 0 : 1), (unsigned)(tpe3 - tp3));
#endif
    xcd_barrier(bar_all); STAMP(tp4);
    Wall.h = 1; run_E(P, C, Wall, bar_all, 1);
#ifdef PROBE_SEL
    STAMP(tp5);
    { unsigned long long d = 0; const int sel = PROBE_SEL;
      if (sel == 0) d = tp1 - tp0; if (sel == 1) d = tp2 - tp1; if (sel == 2) d = tp3 - tp2; if (sel == 3) d = tp4 - tp3; if (sel == 4) d = tp5 - tp4;
      if (sel == 5 || sel == 8) d = tpe1 - tp1; if (sel == 6 || sel == 9) d = tpe2 - tp2; if (sel == 7 || sel == 10) d = tpe3 - tp3;
      const int who = sel >= 8 ? 8 * NC_PER_XCD : 0;
      if (sel >= 20) { const unsigned* sp = (const unsigned*)(P.ws + WS_CTL) + 128 + 16 * PROBE_HALF; const int i = sel - 20; const int nxt = (i == PROBE_LAST) ? 9 : i + 1; d = (unsigned long long)(__hip_atomic_load(sp + nxt, __ATOMIC_RELAXED, __HIP_MEMORY_SCOPE_AGENT) - __hip_atomic_load(sp + i, __ATOMIC_RELAXED, __HIP_MEMORY_SCOPE_AGENT)); }
      if (sel >= 30) d = 0;
      if (bx == (sel >= 20 ? 0 : who) && C.tid == 0) __hip_atomic_store(ctl + 64, (unsigned)d, __ATOMIC_RELAXED, __HIP_MEMORY_SCOPE_AGENT);
      xcd_barrier(bar_all);
      if (bx == 0 && C.tid == 0) { const unsigned dd = sel >= 30 ? __hip_atomic_load(ctl + 80 + (sel - 30), __ATOMIC_RELAXED, __HIP_MEMORY_SCOPE_AGENT) : __hip_atomic_load(ctl + 64, __ATOMIC_RELAXED, __HIP_MEMORY_SCOPE_AGENT);
        const unsigned long long t0_ = __builtin_amdgcn_s_memrealtime(); while (__builtin_amdgcn_s_memrealtime() - t0_ < 4ull * dd) __builtin_amdgcn_s_sleep(32); } }
#endif
}

extern "C" void kernel_launch(void* const* d_in, const int* in_sizes, int n_in, void* d_out, int out_size, void* d_ws, size_t ws_size, hipStream_t stream) {
    static int grid = 0;
    if (grid == 0) {
        if (n_in != 22 || in_sizes[0] != T * DM || out_size != T * DM || ws_size < WS_END) {
            fprintf(stderr, "kernel_launch: unexpected shapes (n_in %d, in0 %d, out %d, ws %zu); nothing launched\n", n_in, n_in > 0 ? in_sizes[0] : -1, out_size, ws_size); grid = -1; return; }
        int dev = 0, cus = 0;
        if (hipGetDevice(&dev) != hipSuccess || hipDeviceGetAttribute(&cus, hipDeviceAttributeMultiprocessorCount, dev) != hipSuccess) { fprintf(stderr, "kernel_launch: device query failed\n"); grid = -1; return; }
        if (hipFuncSetAttribute((const void*)hybrid_fwd, hipFuncAttributeMaxDynamicSharedMemorySize, LDS_BYTES) != hipSuccess) { fprintf(stderr, "kernel_launch: hipFuncSetAttribute failed\n"); grid = -1; return; }
        (void)hipGetLastError();
        grid = cus;
        if (grid % 8 != 0 || grid / 8 <= NC_PER_XCD) { fprintf(stderr, "kernel_launch: built for a CU count that is a multiple of 8 and > %d; got %d; nothing launched\n", 8 * NC_PER_XCD, grid); grid = -1; return; }
    }
    if (grid < 0) return;
    if (hipMemsetAsync((char*)d_ws + WS_CTL, 0, CTL_ZERO_BYTES, stream) != hipSuccess) { fprintf(stderr, "kernel_launch: memset failed\n"); return; }
    Params p{};
    p.x = (const float*)d_in[0]; p.c = (const float*)d_in[1]; p.positions = (const int*)d_in[2]; p.ada_w = (const float*)d_in[3]; p.ada_b = (const float*)d_in[4];
    p.norm_mix_g = (const float*)d_in[5]; p.norm_ffn_g = (const float*)d_in[6]; p.final_norm_g = (const float*)d_in[7]; p.even_w_in = (const float*)d_in[8]; p.even_w_out = (const float*)d_in[9];
    p.gmlp_ln_g = (const float*)d_in[10]; p.gmlp_ln_b = (const float*)d_in[11]; p.gmlp_w_s = (const float*)d_in[12]; p.gmlp_b_s = (const float*)d_in[13]; p.hgrn_lb_logits = (const float*)d_in[14];
    p.hgrn_norm_g = (const float*)d_in[15]; p.odd_w_qkv = (const float*)d_in[16]; p.odd_w_out = (const float*)d_in[17]; p.peer_w_query = (const float*)d_in[18]; p.peer_sub_keys = (const float*)d_in[19];
    p.peer_down = (const float*)d_in[20]; p.peer_up = (const float*)d_in[21];
    p.out = (float*)d_out; p.ws = (unsigned char*)d_ws;
    p.ph_lo = 0; p.ph_hi = 0;
    hipLaunchKernelGGL(hybrid_fwd, dim3(grid), dim3(NWAVES * 64), LDS_BYTES, stream, p);
    const hipError_t le = hipPeekAtLastError();
    if (le != hipSuccess) fprintf(stderr, "kernel_launch: launch failed: %s\n", hipGetErrorName(le));
}
```

```cpp
#include <hip/hip_runtime.h>
#include <cstdio>
#include <cstdint>
#include <cmath>
namespace pg8 {
#define PG8_LAS __attribute__((address_space(3)))
typedef unsigned short bf16_t;
typedef short bf16x8 __attribute__((ext_vector_type(8)));
typedef float f32x4 __attribute__((ext_vector_type(4)));
typedef unsigned u32x4 __attribute__((ext_vector_type(4)));
constexpr int BM = 256, BK = 64, HALF = 128, HTB = HALF * BK * 2  , STAGE_BYTES = 8 * HTB, NXCD = 8, WGM = 8;

__host__ __device__ __forceinline__ int lds_byte(int r, int c) { const int st = (r >> 4) * 2 + (c >> 5), rr = r & 15, cc = c & 31, ob = rr * 64 + cc * 2; return st * 1024 + (ob ^ (((ob >> 9) & 1) << 5)); }
__host__ __device__ __forceinline__ void stage_rc(int b, int& R, int& C) { const int st = b / 1024, sb = b % 1024, swz = sb ^ (((sb >> 9) & 1) << 5); R = (st >> 1) * 16 + swz / 64; C = (st & 1) * 32 + (swz % 64) / 2; }
__host__ __device__ __forceinline__ int perm32(int rho) { const int n = rho >> 4, i = rho & 15; return 8 * (i >> 2) + 4 * n + (i & 3); }

struct Unit { int pm, pn; };
struct Gemm { const bf16_t* A; const bf16_t* Bt; int M, N, K; };

struct StaticOrder {
    int nM, nN, nwg, G, c;
    __host__ __device__ void init(int M, int N, int G_, int c_) { nM = M / BM; nN = N / BM; nwg = nM * nN; G = G_; c = c_; }
    __host__ __device__ bool next(int i, Unit& u) const {
        const long L = (long)i * G + c; if (L >= nwg) return false;
        int wgid = (int)L; { const int q = nwg / NXCD, r = nwg % NXCD, xcd = wgid % NXCD, off = wgid / NXCD; wgid = (xcd < r ? xcd * (q + 1) : r * (q + 1) + (xcd - r) * q) + off; }
        const int nig = WGM * nN, gid = wgid / nig, fm = gid * WGM, gsz = (nM - fm) < WGM ? (nM - fm) : WGM;
        u.pm = fm + ((wgid % nig) % gsz); u.pn = (wgid % nig) / gsz; return true;
    }
    __device__ __forceinline__ void a_ready(const Unit&) const {}
    __device__ __forceinline__ void done(const Unit&) const {}
};

__device__ __forceinline__ unsigned cvt_pk_bf16(float lo, float hi) { unsigned r; asm volatile("v_cvt_pk_bf16_f32 %0, %1, %2" : "=v"(r) : "v"(lo), "v"(hi)); return r; }
typedef float f32x2 __attribute__((ext_vector_type(2)));
__device__ __forceinline__ f32x2 gelu_pk(f32x2 v) {
    const f32x2 av = __builtin_elementwise_abs(v), d = av * 0.2316418882f + 1.0f;
    f32x2 t; t.x = __builtin_amdgcn_rcpf(d.x); t.y = __builtin_amdgcn_rcpf(d.y);
    f32x2 q = t * 0.5307027145f + (-0.7265760135f); q = q * t + 0.7107068705f; q = q * t + (-0.142248368f); q = q * t + 0.127414796f; q = q * t;
    const f32x2 s = (v * v) * (-0.72134752044f);
    f32x2 e; e.x = __builtin_amdgcn_exp2f(s.x); e.y = __builtin_amdgcn_exp2f(s.y);
    const f32x2 m = v * (q * e), r = v - m;
    f32x2 o; o.x = v.x < 0.f ? m.x : r.x; o.y = v.y < 0.f ? m.y : r.y; return o;
}

template <class Epi, class Sched, bool ALIGN_EPI = false, bool SP2 = false>
__device__ __forceinline__ void gemm_phase(PG8_LAS unsigned char* lds, const Gemm g, const Sched& S, const Epi& E) {
    int tid_ = threadIdx.x; asm volatile("" : "+v"(tid_));
    const int tid = tid_, wid = __builtin_amdgcn_readfirstlane(tid >> 6), lane = tid & 63, wr = wid >> 2, wc = wid & 3, fr = lane & 15, fq = lane >> 4;
    const int K = g.K, nt = K / BK;
    unsigned voffA[2], voffB[2];
#pragma unroll
    for (int i = 0; i < 2; ++i) { int R, C; stage_rc(tid * 16 + i * 8192, R, C); const int Rb = Epi::PERM ? ((R & ~31) + perm32(R & 31)) : R;
        voffA[i] = (unsigned)(R * K + C) * 2u; voffB[i] = (unsigned)(Rb * K + C) * 2u; }
    const size_t kstep = (size_t)(BK * 2);
    const size_t hstep = (size_t)HALF * K * 2;
    const size_t tstep = 2 * hstep;
    const unsigned ldsw = (unsigned)wid * 1024u;
    const int aoff = lds_byte(wr * 64 + fr, fq * 8), boff = lds_byte(wc * 32 + fr, fq * 8);
#define PG8_SA(b, h) (((b) * 2 + (h)) * HTB)
#define PG8_SB(b, h) ((4 + (b) * 2 + (h)) * HTB)
#define PG8_STAGE(bufoff, gbase, voff) do { _Pragma("unroll") for (int _i = 0; _i < 2; ++_i) \
        __builtin_amdgcn_global_load_lds((const unsigned*)((const char*)(gbase) + (voff)[_i]), (PG8_LAS unsigned*)(lds + (bufoff) + ldsw + _i * 8192), 16, 0, 0); } while (0)
#define PG8_LDA(dst, b, h) do { _Pragma("unroll") for (int m = 0; m < 4; ++m) _Pragma("unroll") for (int k = 0; k < 2; ++k) dst[m][k] = *(const PG8_LAS bf16x8*)(lds + PG8_SA(b, h) + aoff + m * 2048 + k * 1024); } while (0)
#define PG8_LDB(dst, b, h) do { _Pragma("unroll") for (int n = 0; n < 2; ++n) _Pragma("unroll") for (int k = 0; k < 2; ++k) dst[n][k] = *(const PG8_LAS bf16x8*)(lds + PG8_SB(b, h) + boff + n * 2048 + k * 1024); } while (0)
#define PG8_MMA(ai, bj, At, Bt) do { __builtin_amdgcn_s_setprio(1); _Pragma("unroll") for (int m = 0; m < 4; ++m) _Pragma("unroll") for (int n = 0; n < 2; ++n) _Pragma("unroll") for (int k = 0; k < 2; ++k) \
        acc[ai][bj][m][n] = __builtin_amdgcn_mfma_f32_16x16x32_bf16(Bt[n][k], At[m][k], acc[ai][bj][m][n], 0, 0, 0); __builtin_amdgcn_s_setprio(0); } while (0)
#define PG8_WAIT_V(n) asm volatile("s_waitcnt vmcnt(" #n ")" ::: "memory")
#define PG8_WAIT_L(n) asm volatile("s_waitcnt lgkmcnt(" #n ")" ::: "memory")
#define PG8_BAR __builtin_amdgcn_s_barrier()
#define PG8_SCHED __builtin_amdgcn_sched_barrier(0)
    Unit cur, nxt; int ui = 0;
    if (!S.next(0, cur)) return;
    f32x4 acc[2][2][4][2];
#pragma unroll
    for (int a = 0; a < 2; ++a)
#pragma unroll
        for (int b = 0; b < 2; ++b)
#pragma unroll
            for (int m = 0; m < 4; ++m)
#pragma unroll
                for (int n = 0; n < 2; ++n) acc[a][b][m][n] = (f32x4){0.f, 0.f, 0.f, 0.f};
    bf16x8 At[4][2], B0[2][2], B1[2][2];
    const char* cA = (const char*)g.A + (size_t)cur.pm * tstep; const char* cB = (const char*)g.Bt + (size_t)cur.pn * tstep;
    S.a_ready(cur);
    if constexpr (SP2) {
        PG8_STAGE(PG8_SB(0, 0), cB, voffB); PG8_STAGE(PG8_SB(0, 1), cB + hstep, voffB); PG8_STAGE(PG8_SA(0, 0), cA, voffA); PG8_STAGE(PG8_SA(0, 1), cA + hstep, voffA);
        if (wr == 1) PG8_BAR;
        PG8_WAIT_V(2); PG8_BAR;
        PG8_STAGE(PG8_SB(1, 0), cB + kstep, voffB); PG8_STAGE(PG8_SA(1, 0), cA + kstep, voffA); PG8_STAGE(PG8_SB(1, 1), cB + hstep + kstep, voffB);
        PG8_WAIT_V(6); PG8_BAR;
    } else {
        PG8_STAGE(PG8_SB(0, 0), cB, voffB); PG8_STAGE(PG8_SA(0, 0), cA, voffA); PG8_STAGE(PG8_SB(0, 1), cB + hstep, voffB); PG8_STAGE(PG8_SA(0, 1), cA + hstep, voffA);
        if (wr == 1) PG8_BAR;
        PG8_WAIT_V(4); PG8_BAR;
        PG8_STAGE(PG8_SB(1, 0), cB + kstep, voffB); PG8_STAGE(PG8_SA(1, 0), cA + kstep, voffA); PG8_STAGE(PG8_SB(1, 1), cB + hstep + kstep, voffB);
        PG8_WAIT_V(6); PG8_BAR;
    }
    for (;;) {
        const bool has_next = S.next(ui + 1, nxt);
        const char* nA = has_next ? (const char*)g.A + (size_t)nxt.pm * tstep : cA; const char* nB = has_next ? (const char*)g.Bt + (size_t)nxt.pn * tstep : cB;
        for (int t = 0; t < nt; t += 2) {
            const bool last = (t == nt - 2);
            const char* a1 = cA + (size_t)(t + 1) * kstep;
            const char* a2 = last ? nA : cA + (size_t)(t + 2) * kstep; const char* b2 = last ? nB : cB + (size_t)(t + 2) * kstep;
            const char* a3 = a2 + kstep; const char* b3 = b2 + kstep;
            if (last && has_next) S.a_ready(nxt);
            if constexpr (SP2) {
            PG8_LDB(B0, 0, 0); PG8_LDB(B1, 0, 1); PG8_SCHED; PG8_LDA(At, 0, 0); PG8_STAGE(PG8_SA(1, 1), a1 + hstep, voffA);
            PG8_WAIT_V(8); PG8_WAIT_L(0); PG8_BAR; PG8_MMA(0, 0, At, B0); PG8_MMA(0, 1, At, B1); PG8_BAR; PG8_SCHED;
            PG8_LDA(At, 0, 1); PG8_STAGE(PG8_SB(0, 0), b2, voffB); PG8_STAGE(PG8_SB(0, 1), b2 + hstep, voffB); PG8_STAGE(PG8_SA(0, 0), a2, voffA);
            PG8_WAIT_V(8); PG8_WAIT_L(0); PG8_BAR; PG8_MMA(1, 0, At, B0); PG8_MMA(1, 1, At, B1); PG8_BAR; PG8_SCHED;
            PG8_LDB(B0, 1, 0); PG8_LDB(B1, 1, 1); PG8_SCHED; PG8_LDA(At, 1, 0); PG8_STAGE(PG8_SA(0, 1), a2 + hstep, voffA);
            PG8_WAIT_V(8); PG8_WAIT_L(0); PG8_BAR; PG8_MMA(0, 0, At, B0); PG8_MMA(0, 1, At, B1); PG8_BAR; PG8_SCHED;
            PG8_LDA(At, 1, 1); PG8_STAGE(PG8_SB(1, 0), b3, voffB); PG8_STAGE(PG8_SB(1, 1), b3 + hstep, voffB); PG8_STAGE(PG8_SA(1, 0), a3, voffA);
            PG8_WAIT_V(8); PG8_WAIT_L(0); PG8_BAR; PG8_MMA(1, 0, At, B0); PG8_MMA(1, 1, At, B1); PG8_BAR; PG8_SCHED;
            } else {
            PG8_LDB(B0, 0, 0); PG8_SCHED; PG8_LDA(At, 0, 0); PG8_STAGE(PG8_SA(1, 1), a1 + hstep, voffA);
            PG8_WAIT_L(8); PG8_BAR; PG8_WAIT_L(0); PG8_MMA(0, 0, At, B0); PG8_BAR; PG8_SCHED;
            PG8_LDB(B1, 0, 1); PG8_STAGE(PG8_SB(0, 0), b2, voffB);
            PG8_BAR; PG8_WAIT_L(0); PG8_MMA(0, 1, At, B1); PG8_BAR;
            PG8_LDA(At, 0, 1); PG8_STAGE(PG8_SA(0, 0), a2, voffA);
            PG8_BAR; PG8_WAIT_L(0); PG8_MMA(1, 0, At, B0); PG8_BAR; PG8_SCHED;
            PG8_STAGE(PG8_SB(0, 1), b2 + hstep, voffB);
            PG8_WAIT_V(6); PG8_BAR; PG8_MMA(1, 1, At, B1); PG8_BAR;
            PG8_LDB(B0, 1, 0); PG8_SCHED; PG8_LDA(At, 1, 0); PG8_STAGE(PG8_SA(0, 1), a2 + hstep, voffA);
            PG8_WAIT_L(8); PG8_BAR; PG8_WAIT_L(0); PG8_MMA(0, 0, At, B0); PG8_BAR; PG8_SCHED;
            PG8_LDB(B1, 1, 1); PG8_STAGE(PG8_SB(1, 0), b3, voffB);
            PG8_BAR; PG8_WAIT_L(0); PG8_MMA(0, 1, At, B1); PG8_BAR;
            PG8_LDA(At, 1, 1); PG8_STAGE(PG8_SA(1, 0), a3, voffA);
            PG8_BAR; PG8_WAIT_L(0); PG8_MMA(1, 0, At, B0); PG8_BAR; PG8_SCHED;
            PG8_STAGE(PG8_SB(1, 1), b3 + hstep, voffB);
            PG8_WAIT_V(6); PG8_BAR; PG8_MMA(1, 1, At, B1); PG8_BAR;
            }
        }
        if constexpr (ALIGN_EPI) { if (wr == 0) PG8_BAR; }
        if constexpr (!Epi::AFTER_DRAIN) { E(acc, cur, wr, wc, fr, fq); S.done(cur); }
        if (!has_next) break;
#pragma unroll
        for (int a = 0; a < 2; ++a)
#pragma unroll
            for (int b = 0; b < 2; ++b)
#pragma unroll
                for (int m = 0; m < 4; ++m)
#pragma unroll
                    for (int n = 0; n < 2; ++n) acc[a][b][m][n] = (f32x4){0.f, 0.f, 0.f, 0.f};
        cur = nxt; cA = nA; cB = nB; ++ui;
        if constexpr (ALIGN_EPI) { if (wr == 1) PG8_BAR; }
    }
    PG8_WAIT_V(0);
    if constexpr (!ALIGN_EPI) { if (wr == 0) PG8_BAR; }
    PG8_BAR;
    if constexpr (Epi::AFTER_DRAIN) { E.fused(acc, cur, wr, wc, fr, fq, lds, wid, lane); S.done(cur); }
#undef PG8_SA
#undef PG8_SB
#undef PG8_STAGE
#undef PG8_LDA
#undef PG8_LDB
#undef PG8_MMA
#undef PG8_WAIT_V
#undef PG8_WAIT_L
#undef PG8_BAR
#undef PG8_SCHED
}
}
#define GAS __attribute__((address_space(1)))
#define LAS __attribute__((address_space(3)))
typedef unsigned short bf16;
typedef unsigned v4u __attribute__((ext_vector_type(4)));
typedef float f32x4 __attribute__((ext_vector_type(4)));
typedef short bf16x8 __attribute__((ext_vector_type(8)));
typedef __bf16 bf16x2_t __attribute__((ext_vector_type(2)));
#define LDS_WAIT() asm volatile("s_waitcnt lgkmcnt(0)" ::: "memory")
#define VM_WAIT() asm volatile("s_waitcnt vmcnt(0)" ::: "memory")
typedef float f32x2_cv __attribute__((ext_vector_type(2)));
__device__ __forceinline__ unsigned pk2(float lo, float hi) { const f32x2_cv v = {lo, hi}; return __builtin_bit_cast(unsigned, __builtin_convertvector(v, bf16x2_t)); }
__device__ __forceinline__ unsigned f2bf(float f) { return pk2(f, 0.f) & 0xffffu; }
__device__ __forceinline__ float bflo(unsigned u) { return __builtin_bit_cast(float, u << 16); }
__device__ __forceinline__ float bfhi(unsigned u) { return __builtin_bit_cast(float, u & 0xffff0000u); }
__device__ __forceinline__ float bf2f(bf16 u) { return __builtin_bit_cast(float, (unsigned)u << 16); }
#define XB_TMO      128
#define XB_XCNT(j)  (256  + 64 * (j))
#define XB_XSUB(j)  (1280 + 64 * (j))
#define XB_XGEN(j)  (2304 + 64 * (j))
#define XB_TOP      3328
#define XB_TOPGEN   3392
#define XCD_BAR_WORDS 3456
#define XB_SPIN_CAP (1u << 18)

__device__ __forceinline__ unsigned xb_ld(unsigned* p)              { return __hip_atomic_load(p, __ATOMIC_RELAXED, __HIP_MEMORY_SCOPE_AGENT); }
__device__ __forceinline__ unsigned xb_add(unsigned* p, unsigned v) { return __hip_atomic_fetch_add(p, v, __ATOMIC_RELAXED, __HIP_MEMORY_SCOPE_AGENT); }
__device__ __forceinline__ unsigned xb_xcc_id() { return (unsigned)__builtin_amdgcn_s_getreg((3 << 11) | 20) & 0xFu; }
#define XB_SPIN(cond, bar) do { unsigned _sp = 0; while (cond) { __builtin_amdgcn_s_sleep(1); \
    if ((++_sp & 255u) == 0u) { if (xb_ld(&(bar)[XB_TMO])) break; if (_sp > XB_SPIN_CAP) { atomicAdd(&(bar)[XB_TMO], 1u); break; } } } } while (0)

struct XcdBarrier {
    unsigned* bar; unsigned x; unsigned G;
    volatile LAS unsigned* st;
};

__device__ __forceinline__ XcdBarrier xcd_barrier_post(unsigned* bar, volatile LAS unsigned* st) {
    XcdBarrier b; b.bar = bar; b.x = xb_xcc_id(); b.st = st; b.G = gridDim.x;
    if (threadIdx.x == 0) (void)xb_add(&bar[XB_XCNT(b.x)], 1u);
    return b;
}
__device__ __forceinline__ void xcd_barrier_complete(unsigned* bar, unsigned x, unsigned& nloc, unsigned& nx, const unsigned G) {
    unsigned sum, cnt, mine, sp = 0u;
    for (;;) {
        sum = 0u; cnt = 0u; mine = 0u;
#pragma unroll
        for (unsigned j = 0; j < 16; ++j) { const unsigned c = xb_ld(&bar[XB_XCNT(j)]); sum += c; cnt += (c > 0u) ? 1u : 0u; mine = (j == x) ? c : mine; }
        if (sum == G) break;
        __builtin_amdgcn_s_sleep(1);
        if ((++sp & 255u) == 0u) { if (xb_ld(&bar[XB_TMO])) break; if (sp > XB_SPIN_CAP) { atomicAdd(&bar[XB_TMO], 1u); break; } }
    }
    nloc = mine > 0u ? mine : 1u; nx = cnt > 0u ? cnt : 1u;
}

__device__ __forceinline__ void xcd_barrier(const XcdBarrier& b) {
    asm volatile("s_waitcnt vmcnt(0)" ::: "memory");
    __syncthreads();
    if (threadIdx.x == 0) {
        unsigned* bar = b.bar;
        __builtin_amdgcn_s_waitcnt(0);
        unsigned nloc = b.st[0], nx = b.st[1];
        if (nloc == 0u) { xcd_barrier_complete(bar, b.x, nloc, nx, b.G); b.st[0] = nloc; b.st[1] = nx; }
        const unsigned old = xb_add(&bar[XB_XSUB(b.x)], 1u);
        const unsigned gen = old / nloc;
        if (old + 1u == (gen + 1u) * nloc) {
            __builtin_amdgcn_fence(__ATOMIC_RELEASE, "agent");
            asm volatile("s_waitcnt vmcnt(0)" ::: "memory");
            const unsigned og = xb_add(&bar[XB_TOP], 1u);
            const unsigned tg = og / nx;
            if (og + 1u == (tg + 1u) * nx) xb_add(&bar[XB_TOPGEN], 1u);
            else XB_SPIN(xb_ld(&bar[XB_TOPGEN]) == tg, bar);
            __builtin_amdgcn_fence(__ATOMIC_ACQUIRE, "agent");
            xb_add(&bar[XB_XGEN(b.x)], 1u);
            asm volatile("s_waitcnt vmcnt(0)" ::: "memory");
        } else {
            XB_SPIN(xb_ld(&bar[XB_XGEN(b.x)]) == gen, bar);
            __builtin_amdgcn_fence(__ATOMIC_ACQUIRE, "agent");
            asm volatile("s_waitcnt vmcnt(0)" ::: "memory");
        }
    }
    __syncthreads();
}

constexpr int NB = 8, SEQ = 8192, DM = 1024, T = NB * SEQ;
constexpr int NWAVES = 8;
constexpr float NORM_EPS = 1e-6f;
constexpr float C2 = 0.125f * 1.4426950408889634f;

constexpr size_t MiB = 1u << 20;
constexpr size_t WS_CTL = 0, CTL_ZERO_BYTES = 1 * MiB;
constexpr size_t WS_MOD = 1 * MiB;
constexpr size_t WS_SKB = 1 * MiB + 512 * 1024;
constexpr size_t WS_WSB = 1 * MiB + 768 * 1024;
constexpr size_t WS_LB  = 1 * MiB + 960 * 1024;
constexpr size_t WS_CS  = 2 * MiB;
constexpr size_t WS_HD  = 6 * MiB;
constexpr size_t WS_WIN = 16 * MiB, WS_WOUT0 = 22 * MiB, WS_WQKV = 24 * MiB, WS_WOUT1 = 30 * MiB, WS_WQ0 = 32 * MiB, WS_WQ1 = 36 * MiB;
constexpr size_t WS_TAB8 = 40 * MiB, TAB8_BYTES = 16 * MiB;
constexpr int TROW = 1024;
constexpr size_t WS_SC8 = 8 * MiB;
constexpr size_t WS_H = 108 * MiB;
constexpr size_t WS_IDX = 236 * MiB, WS_GATE = 268 * MiB;
constexpr size_t WS_AR0 = 300 * MiB, AR_BYTES = 352 * MiB;
constexpr size_t AR_PU = 0, AR_PV = 32 * MiB, AR_PQ = 64 * MiB, AR_PI = 96 * MiB, AR_PG = 128 * MiB;
constexpr size_t AR_G = 160 * MiB;
constexpr size_t AR_KVT = 224 * MiB, AR_ST = 288 * MiB;
constexpr size_t AR_QP = 0;
constexpr size_t AR_QK = 0;
constexpr size_t WS_END = WS_AR0 + 2 * AR_BYTES;
constexpr int HT = T / 2;
constexpr int CW_BAR = 4096;

constexpr int LDS_BYTES = 147456;
constexpr int LDSCTL_OFF = LDS_BYTES - 512;
constexpr int MISC_OFF = LDSCTL_OFF;

struct Params {
    const float* x; const float* c; const int* positions; const float* ada_w; const float* ada_b; const float* norm_mix_g; const float* norm_ffn_g; const float* final_norm_g;
    const float* even_w_in; const float* even_w_out; const float* gmlp_ln_g; const float* gmlp_ln_b; const float* gmlp_w_s; const float* gmlp_b_s; const float* hgrn_lb_logits; const float* hgrn_norm_g;
    const float* odd_w_qkv; const float* odd_w_out; const float* peer_w_query; const float* peer_sub_keys; const float* peer_down; const float* peer_up;
    float* out; unsigned char* ws; int ph_lo, ph_hi;
};
struct Ctx { LAS unsigned char* lds; int tid, lane, wave, vcu, G; };
__device__ __forceinline__ Ctx fresh_ctx(const Ctx& C0) { Ctx C = C0; int t_ = threadIdx.x; asm volatile("" : "+v"(t_)); C.tid = t_; C.lane = t_ & 63; C.wave = __builtin_amdgcn_readfirstlane(t_ >> 6); return C; }
struct Wk { int lv, n, c, h; };
#define W_TK0(W) ((W).h * (T / 2))
#define W_BT0(W) ((W).h * (NB / 2))
__device__ __forceinline__ unsigned char* w_ar(const Params& P, const Wk& W) { return P.ws + WS_AR0 + (size_t)W.h * AR_BYTES; }
__device__ __forceinline__ bf16* w_tok16(const Params& P, const Wk& W, size_t off, int pitch) { return (bf16*)(w_ar(P, W) + off) - (size_t)W_TK0(W) * pitch; }
__device__ __forceinline__ float* w_tok32(const Params& P, const Wk& W, size_t off, int pitch) { return (float*)(w_ar(P, W) + off) - (size_t)W_TK0(W) * pitch; }
__device__ __forceinline__ bf16* w_item16(const Params& P, const Wk& W, size_t off) { return (bf16*)(w_ar(P, W) + off) - (size_t)W_BT0(W) * 512 * 16384; }

__device__ __forceinline__ float wave_sum(float v) {
#pragma unroll
    for (int o = 1; o < 64; o <<= 1) v += __shfl_xor(v, o);
    return v;
}
__device__ __forceinline__ float silu_f(float x) { return x * __builtin_amdgcn_rcpf(1.0f + __builtin_amdgcn_exp2f(-1.4426950408889634f * x)); }
__device__ __forceinline__ float sigmoid_f(float x) { return __builtin_amdgcn_rcpf(1.0f + __builtin_amdgcn_exp2f(-1.4426950408889634f * x)); }
__device__ __forceinline__ float gelu_f(float x) { return 0.5f * x * (1.0f + erff(x * 0.70710678118654752f)); }
__device__ __forceinline__ f32x4 mma16(f32x4 acc, const LAS bf16* A, int lda, const LAS bf16* Bt, int ldb, int K, int r, int q4) {
    const LAS bf16* ap = A + r * lda + 8 * q4; const LAS bf16* bp = Bt + r * ldb + 8 * q4;
    for (int k0 = 0; k0 < K; k0 += 32) {
        const bf16x8 a = *(const LAS bf16x8*)(ap + k0); const bf16x8 b = *(const LAS bf16x8*)(bp + k0);
        acc = __builtin_amdgcn_mfma_f32_16x16x32_bf16(a, b, acc, 0, 0, 0);
    }
    return acc;
}

struct EpiBf16P {
    static constexpr bool PERM = true, AFTER_DRAIN = false;
    bf16* O; size_t ldc;
    __device__ __forceinline__ void operator()(const f32x4 (&acc)[2][2][4][2], const pg8::Unit& u, int wr, int wc, int fr, int fq) const {
        const int row0 = u.pm * 256 + wr * 64 + fr, col0 = u.pn * 256 + wc * 32 + 8 * fq;
#pragma unroll
        for (int ai = 0; ai < 2; ++ai)
#pragma unroll
            for (int m = 0; m < 4; ++m) { bf16* rowp = O + (size_t)(row0 + ai * 128 + m * 16) * ldc + col0;
#pragma unroll
                for (int bj = 0; bj < 2; ++bj) { const f32x4 v0 = acc[ai][bj][m][0], v1 = acc[ai][bj][m][1];
                    v4u w; w.x = pg8::cvt_pk_bf16(v0[0], v0[1]); w.y = pg8::cvt_pk_bf16(v0[2], v0[3]); w.z = pg8::cvt_pk_bf16(v1[0], v1[1]); w.w = pg8::cvt_pk_bf16(v1[2], v1[3]);
                    *(v4u*)(rowp + bj * 128) = w; } }
    }
};
#ifndef REP_HG
#define REP_HG 1
#endif
#ifndef REP_TOPK
#define REP_TOPK 1
#endif
#ifndef REP_PRO
#define REP_PRO 1
#endif
#ifndef REP_NORM
#define REP_NORM 1
#endif
#ifndef REP_GEMM2
#define REP_GEMM2 1
#endif
#ifndef REP_GEMM
#define REP_GEMM 1
#endif
#ifndef EXP_REP
#define EXP_REP 1
#endif
#ifndef ATT_REP
#define ATT_REP 1
#endif
#ifndef ABL_ON
#define ABL_ON 4
#endif
struct EpiResid {
    static constexpr bool PERM = true, AFTER_DRAIN = false;
    const float* xin; float* xout; const float* gate; float gsc;
    __device__ __forceinline__ void operator()(const f32x4 (&acc)[2][2][4][2], const pg8::Unit& u, int wr, int wc, int fr, int fq) const {
        const int row0 = u.pm * 256 + wr * 64 + fr, col0 = u.pn * 256 + wc * 32 + 8 * fq;
        const float* gp = gate + (size_t)((u.pm * 256) >> 13) * 6144 + col0;
        f32x4 gv[2][2];
#pragma unroll
        for (int bj = 0; bj < 2; ++bj) { gv[bj][0] = *(const f32x4*)(gp + bj * 128); gv[bj][1] = *(const f32x4*)(gp + bj * 128 + 4); }
#pragma unroll
        for (int ai = 0; ai < 2; ++ai)
#pragma unroll
            for (int m = 0; m < 4; ++m) { const size_t off = (size_t)(row0 + ai * 128 + m * 16) * 1024 + col0;
#pragma unroll
                for (int bj = 0; bj < 2; ++bj) {
                    const f32x4 x0 = *(const f32x4*)(xin + off + bj * 128), x1 = *(const f32x4*)(xin + off + bj * 128 + 4);
                    *(f32x4*)(xout + off + bj * 128) = x0 + gv[bj][0] * acc[ai][bj][m][0] * gsc;
                    *(f32x4*)(xout + off + bj * 128 + 4) = x1 + gv[bj][1] * acc[ai][bj][m][1] * gsc; }
                asm volatile("" ::: "memory"); }
    }
};
struct EpiInProj {
    static constexpr bool PERM = true, AFTER_DRAIN = false;
    bf16* PU; bf16* PV; bf16* PQ; bf16* PI; bf16* PG; float* G; const float* LB;
    __device__ __forceinline__ void operator()(const f32x4 (&acc)[2][2][4][2], const pg8::Unit& u, int wr, int wc, int fr, int fq) const {
        const int type = u.pn >> 1;
        const int row0 = u.pm * 256 + wr * 64 + fr, lc0 = (u.pn & 1) * 256 + wc * 32 + 8 * fq;
        if (type == 3) {
            f32x4 lb[2][2];
#pragma unroll
            for (int bj = 0; bj < 2; ++bj) { lb[bj][0] = *(const f32x4*)(LB + lc0 + bj * 128); lb[bj][1] = *(const f32x4*)(LB + lc0 + bj * 128 + 4); }
#pragma unroll
            for (int ai = 0; ai < 2; ++ai)
#pragma unroll
                for (int m = 0; m < 4; ++m) { float* rowp = G + (size_t)(row0 + ai * 128 + m * 16) * 512 + lc0;
#pragma unroll
                    for (int bj = 0; bj < 2; ++bj)
#pragma unroll
                        for (int n = 0; n < 2; ++n) { const f32x4 v = acc[ai][bj][m][n]; f32x4 o;
#pragma unroll
                            for (int e = 0; e < 4; ++e) { const float l = lb[bj][n][e]; const float f = l + (1.0f - l) * sigmoid_f(v[e]); o[e] = __logf(f); }
                            *(f32x4*)(rowp + bj * 128 + 4 * n) = o; } }
            return;
        }
        bf16* base = type == 0 ? PU : type == 1 ? PV : type == 2 ? PQ : type == 4 ? PI : PG;
#pragma unroll
        for (int ai = 0; ai < 2; ++ai)
#pragma unroll
            for (int m = 0; m < 4; ++m) { bf16* rowp = base + (size_t)(row0 + ai * 128 + m * 16) * 512 + lc0;
#pragma unroll
                for (int bj = 0; bj < 2; ++bj) { f32x4 v0 = acc[ai][bj][m][0], v1 = acc[ai][bj][m][1];
                    if (type <= 1) { pg8::f32x2 a = pg8::gelu_pk((pg8::f32x2){v0[0], v0[1]}), b = pg8::gelu_pk((pg8::f32x2){v0[2], v0[3]}), c = pg8::gelu_pk((pg8::f32x2){v1[0], v1[1]}), d = pg8::gelu_pk((pg8::f32x2){v1[2], v1[3]});
                        v0 = (f32x4){a.x, a.y, b.x, b.y}; v1 = (f32x4){c.x, c.y, d.x, d.y}; }
                    else if (type == 2) {
#pragma unroll
                        for (int e = 0; e < 4; ++e) { v0[e] = silu_f(v0[e]) * 0.08838834764831845f; v1[e] = silu_f(v1[e]) * 0.08838834764831845f; } }
                    else if (type == 5) {
#pragma unroll
                        for (int e = 0; e < 4; ++e) { v0[e] = silu_f(v0[e]); v1[e] = silu_f(v1[e]); } }
                    v4u w; w.x = pg8::cvt_pk_bf16(v0[0], v0[1]); w.y = pg8::cvt_pk_bf16(v0[2], v0[3]); w.z = pg8::cvt_pk_bf16(v1[0], v1[1]); w.w = pg8::cvt_pk_bf16(v1[2], v1[3]);
                    *(v4u*)(rowp + bj * 128) = w; } }
    }
};
struct EpiQKRot {
    static constexpr bool PERM = true, AFTER_DRAIN = false;
    bf16* O; const float* CS;
    __device__ __forceinline__ void operator()(const f32x4 (&acc)[2][2][4][2], const pg8::Unit& u, int wr, int wc, int fr, int fq) const {
        const int row0 = u.pm * 256 + wr * 64 + fr, col0 = u.pn * 256 + wc * 32 + 8 * fq;
        const float sc = u.pn < 4 ? C2 : 1.0f;
        const bool rotw = (wc & 1) == 0 && u.pn < 8;
        const float sgn = fq == 0 ? -1.0f : 1.0f;
#pragma unroll
        for (int ai = 0; ai < 2; ++ai)
#pragma unroll
            for (int m = 0; m < 4; ++m) { const int row = row0 + ai * 128 + m * 16; bf16* rowp = O + (size_t)row * 3072 + col0;
                f32x4 c0 = (f32x4){1.f, 1.f, 1.f, 1.f}, c1 = c0, s0 = (f32x4){0.f, 0.f, 0.f, 0.f}, s1 = s0;
                if (rotw && fq < 2) { const float* cp = CS + (size_t)row * 16; c0 = *(const f32x4*)(cp); c1 = *(const f32x4*)(cp + 4); s0 = *(const f32x4*)(cp + 8) * sgn; s1 = *(const f32x4*)(cp + 12) * sgn; }
#pragma unroll
                for (int bj = 0; bj < 2; ++bj) { f32x4 v0 = acc[ai][bj][m][0], v1 = acc[ai][bj][m][1];
                    if (rotw) { f32x4 p0, p1;
#pragma unroll
                        for (int e = 0; e < 4; ++e) { p0[e] = __shfl_xor(v0[e], 16); p1[e] = __shfl_xor(v1[e], 16); }
                        v0 = v0 * c0 + p0 * s0; v1 = v1 * c1 + p1 * s1; }
                    v0 = v0 * sc; v1 = v1 * sc;
                    v4u w; w.x = pg8::cvt_pk_bf16(v0[0], v0[1]); w.y = pg8::cvt_pk_bf16(v0[2], v0[3]); w.z = pg8::cvt_pk_bf16(v1[0], v1[1]); w.w = pg8::cvt_pk_bf16(v1[2], v1[3]);
                    *(v4u*)(rowp + bj * 128) = w; } }
    }
};

__device__ __forceinline__ void p0_transpose_item(const float* W, int K, int N, bf16* WT, LAS float* scr, int item, int lane) {
    const int nblk = N / 32, kb = item / nblk, nb = item % nblk, k0 = 64 * kb, n0 = 32 * nb;
#pragma unroll 8
    for (int i = 0; i < 32; ++i) { const int kk = 2 * i + (lane >> 5); scr[kk * 33 + (lane & 31)] = W[(size_t)(k0 + kk) * N + n0 + (lane & 31)]; }
    LDS_WAIT(); asm volatile("" ::: "memory");
    const int c = lane & 7;
#pragma unroll
    for (int j = 0; j < 4; ++j) { const int n = (lane >> 3) + 8 * j; const LAS float* s = scr + (8 * c) * 33 + n;
        v4u o; o.x = pk2(s[0 * 33], s[1 * 33]); o.y = pk2(s[2 * 33], s[3 * 33]); o.z = pk2(s[4 * 33], s[5 * 33]); o.w = pk2(s[6 * 33], s[7 * 33]);
        *(GAS v4u*)(WT + (size_t)(n0 + n) * K + k0 + 8 * c) = o; }
    LDS_WAIT(); asm volatile("" ::: "memory");
}
typedef float f32x2 __attribute__((ext_vector_type(2)));
__device__ __forceinline__ void convert_tables(const Params& P, const Ctx& C) {
    const int gw = C.vcu * NWAVES + C.wave, NGW = C.G * NWAVES, lane = C.lane;
    for (int row = gw; row < 4 * 16384; row += NGW) {
        const int tb = row >> 14, e = row & 16383;
        const float* src = ((tb & 1) ? P.peer_up : P.peer_down) + ((size_t)(tb >> 1) * 16384 + e) * 1024;
        unsigned char* dst = P.ws + WS_TAB8 + (size_t)tb * TAB8_BYTES + (size_t)e * TROW;
        f32x4 v[4]; float mx = 0.f;
#pragma unroll
        for (int j = 0; j < 4; ++j) { v[j] = ((const f32x4*)src)[64 * j + lane]; mx = fmaxf(mx, fmaxf(fmaxf(fabsf(v[j][0]), fabsf(v[j][1])), fmaxf(fabsf(v[j][2]), fabsf(v[j][3])))); }
#pragma unroll
        for (int o = 1; o < 64; o <<= 1) mx = fmaxf(mx, __shfl_xor(mx, o));
        const float sc = mx > 0.f ? 400.0f / mx : 0.f;
#pragma unroll
        for (int j = 0; j < 4; ++j) { int p = __builtin_amdgcn_cvt_pk_fp8_f32(v[j][0] * sc, v[j][1] * sc, 0, false); p = __builtin_amdgcn_cvt_pk_fp8_f32(v[j][2] * sc, v[j][3] * sc, p, true);
            ((unsigned*)dst)[64 * j + lane] = (unsigned)p; }
        if (lane == 0) ((float*)(P.ws + WS_SC8))[row] = mx * (1.0f / 400.0f);
    }
}
__device__ __forceinline__ void phase_prologue(const Params& P, const Ctx& C) {
    float* MOD = (float*)(P.ws + WS_MOD);
    {
        LAS float* cond = (LAS float*)C.lds;
        LAS float* part = (LAS float*)(C.lds + 32768);
        for (int e = C.tid; e < 8192; e += 512) cond[e] = silu_f(P.c[e]);
        __syncthreads();
        for (int item = C.vcu; item < 192; item += C.G) {
            const int l = item / 96, cb = item % 96, col = cb * 64 + C.lane;
            float acc[8];
#pragma unroll
            for (int b = 0; b < 8; ++b) acc[b] = 0.f;
            const float* wp = P.ada_w + ((size_t)l * 1024 + C.wave * 128) * 6144 + col;
#pragma unroll 4
            for (int k = 0; k < 128; ++k) { const float wv = wp[(size_t)k * 6144];
#pragma unroll
                for (int b = 0; b < 8; ++b) acc[b] += cond[b * 1024 + C.wave * 128 + k] * wv; }
#pragma unroll
            for (int b = 0; b < 8; ++b) part[(C.wave * 8 + b) * 64 + C.lane] = acc[b];
            __syncthreads();
            { const int b = C.tid >> 6, ln = C.tid & 63; float s = P.ada_b[l * 6144 + cb * 64 + ln];
#pragma unroll
              for (int w = 0; w < 8; ++w) s += part[(w * 8 + b) * 64 + ln];
              MOD[(size_t)(l * 8 + b) * 6144 + cb * 64 + ln] = s; }
            __syncthreads();
        }
        __syncthreads();
    }
    {
        LAS float* scr = (LAS float*)(C.lds + C.wave * 16384);
        const int gw = C.vcu * NWAVES + C.wave, NGW = C.G * NWAVES;
        for (int it = gw; it < 6144; it += NGW) {
            int r = it;
            if (r < 1536) { p0_transpose_item(P.even_w_in, 1024, 3072, (bf16*)(P.ws + WS_WIN), scr, r, C.lane); continue; } r -= 1536;
            if (r < 512)  { p0_transpose_item(P.even_w_out, 1024, 1024, (bf16*)(P.ws + WS_WOUT0), scr, r, C.lane); continue; } r -= 512;
            if (r < 1536) { p0_transpose_item(P.odd_w_qkv, 1024, 3072, (bf16*)(P.ws + WS_WQKV), scr, r, C.lane); continue; } r -= 1536;
            if (r < 512)  { p0_transpose_item(P.odd_w_out, 1024, 1024, (bf16*)(P.ws + WS_WOUT1), scr, r, C.lane); continue; } r -= 512;
            if (r < 1024) { p0_transpose_item(P.peer_w_query, 1024, 2048, (bf16*)(P.ws + WS_WQ0), scr, r, C.lane); continue; } r -= 1024;
            p0_transpose_item(P.peer_w_query + (size_t)1024 * 2048, 1024, 2048, (bf16*)(P.ws + WS_WQ1), scr, r, C.lane);
        }
    }
    convert_tables(P, C);
    const int NT = C.G * 512, gt = C.vcu * 512 + C.tid;
    { bf16* skb = (bf16*)(P.ws + WS_SKB); for (int i = gt; i < 65536; i += NT) skb[i] = (bf16)f2bf(P.peer_sub_keys[i]); }
    { bf16* wsb = (bf16*)(P.ws + WS_WSB); for (int i = gt; i < 65536; i += NT) { const int t = (i >> 7) & 127, s = i & 127; wsb[i] = (bf16)(s <= t ? f2bf(P.gmlp_w_s[i]) : 0u); } }
    { float* lb = (float*)(P.ws + WS_LB); for (int i = gt; i < 512; i += NT) { const float l0 = P.hgrn_lb_logits[i], l1 = P.hgrn_lb_logits[512 + i]; lb[i] = 1.0f / (1.0f + expf(l1 - l0)); } }
    { float* cs = (float*)(P.ws + WS_CS); for (int i = gt; i < T * 8; i += NT) { const int tok = i >> 3, j = i & 7;
        const float inv = 1.0f / powf(500000.0f, (float)j * 0.125f); const float ang = (float)P.positions[tok] * inv; float sn, cn; sincosf(ang, &sn, &cn);
        cs[(size_t)tok * 16 + j] = cn; cs[(size_t)tok * 16 + 8 + j] = sn; } }
}
__device__ __forceinline__ void norm_row_bf16(const float* xrow, bf16* hrow, const float* g, const float* sh, const float* sc, int lane) {
    const f32x4* xr = (const f32x4*)xrow + lane; f32x4 v[4]; float s = 0.f;
#pragma unroll
    for (int j = 0; j < 4; ++j) { v[j] = xr[64 * j]; s += (v[j][0] * v[j][0] + v[j][1] * v[j][1]) + (v[j][2] * v[j][2] + v[j][3] * v[j][3]); }
    const float rstd = 1.0f / sqrtf(wave_sum(s) * (1.0f / 1024.0f) + NORM_EPS);
    unsigned long long* o8 = (unsigned long long*)hrow + lane;
#pragma unroll
    for (int j = 0; j < 4; ++j) { const f32x4 gg = ((const f32x4*)g)[64 * j + lane], hh = ((const f32x4*)sh)[64 * j + lane], cc = ((const f32x4*)sc)[64 * j + lane];
        const f32x4 y = (v[j] * rstd * gg) * (cc + 1.0f) + hh;
        o8[64 * j] = (unsigned long long)pk2(y[0], y[1]) | ((unsigned long long)pk2(y[2], y[3]) << 32); }
}
__device__ __forceinline__ void phase_norm(const Params& P, const Ctx& C, const Wk& W, const float* xsrc, const float* g, int l, int so) {
    const float* MOD = (const float*)(P.ws + WS_MOD); bf16* H = (bf16*)(P.ws + WS_H);
    const int gw = W.lv * NWAVES + C.wave, NGW = W.n * NWAVES;
    for (int m = W_TK0(W) + gw; m < W_TK0(W) + HT; m += NGW) { const float* mb = MOD + (size_t)(l * 8 + (m >> 13)) * 6144 + so;
        norm_row_bf16(xsrc + (size_t)m * 1024, H + (size_t)m * 1024, g, mb, mb + 1024, C.lane); }
}

__device__ __forceinline__ void gmlp_item(const Params& P, const Ctx& C, const Wk& W, int n, int g) {
    LAS bf16* Wt = (LAS bf16*)C.lds;
    LAS bf16* vT = (LAS bf16*)(C.lds + 34816);
    const bf16* WSB = (const bf16*)(P.ws + WS_WSB); const bf16* PU = w_tok16(P, W, AR_PU, 512); const bf16* PV = w_tok16(P, W, AR_PV, 512); bf16* MIX = (bf16*)(P.ws + WS_H);
    const int tid = C.tid, r = C.lane & 15, q4 = C.lane >> 4;
    for (int ch = tid; ch < 2048; ch += 512) { const int rr = ch >> 4, c8 = (ch & 15) * 8; *(LAS v4u*)(Wt + rr * 136 + c8) = *(const v4u*)(WSB + (size_t)(g * 128 + rr) * 128 + c8); }
    { const int t = tid >> 2, part = tid & 3; const bf16* src = PV + (size_t)(n * 128 + t) * 512 + g * 128 + part * 32;
      float x[32];
#pragma unroll
      for (int j = 0; j < 4; ++j) { const v4u w = *(const v4u*)(src + 8 * j);
#pragma unroll
          for (int e = 0; e < 4; ++e) { x[8 * j + 2 * e] = bflo(w[e]); x[8 * j + 2 * e + 1] = bfhi(w[e]); } }
      float s = 0.f;
#pragma unroll
      for (int j = 0; j < 32; ++j) s += x[j];
      s += __shfl_xor(s, 1); s += __shfl_xor(s, 2);
      const float mean = s * (1.0f / 128.0f); float q = 0.f;
#pragma unroll
      for (int j = 0; j < 32; ++j) { const float d = x[j] - mean; q += d * d; }
      q += __shfl_xor(q, 1); q += __shfl_xor(q, 2);
      const float rstd = 1.0f / sqrtf(q * (1.0f / 128.0f) + NORM_EPS);
      const float* lg = P.gmlp_ln_g + g * 128 + part * 32; const float* lbp = P.gmlp_ln_b + g * 128 + part * 32;
#pragma unroll
      for (int j = 0; j < 32; ++j) vT[(part * 32 + j) * 136 + t] = (bf16)f2bf((x[j] - mean) * rstd * lg[j] + lbp[j]);
    }
    __syncthreads();
    const int t0 = 16 * C.wave; const int Keff = ((t0 + 16 + 31) >> 5) << 5;
    f32x4 acc[8];
#pragma unroll
    for (int ct = 0; ct < 8; ++ct) { acc[ct] = (f32x4){0.f, 0.f, 0.f, 0.f}; acc[ct] = mma16(acc[ct], Wt + t0 * 136, 136, vT + (16 * ct) * 136, 136, Keff, r, q4); }
#pragma unroll
    for (int i = 0; i < 4; ++i) { const int t = t0 + 4 * q4 + i; const float bs = P.gmlp_b_s[g * 128 + t]; const size_t tok = (size_t)n * 128 + t;
#pragma unroll
        for (int ct = 0; ct < 8; ++ct) { const int c = 16 * ct + r; const float u = bf2f(PU[tok * 512 + g * 128 + c]); MIX[tok * 1024 + g * 128 + c] = (bf16)f2bf(u * (acc[ct][i] + bs)); } }
    __syncthreads();
}
__device__ __forceinline__ void hgrn_cumsum16(const float* G, size_t tok0, int hh, int k, int seg, LAS float* tot, float (&g)[16], float (&bb)[16], float& total) {
    const float* gp = G + (tok0 + seg * 16) * 512 + hh * 128 + k;
#pragma unroll
    for (int j = 0; j < 16; ++j) g[j] = gp[(size_t)j * 512];
    float run = 0.f;
#pragma unroll
    for (int j = 0; j < 16; ++j) { run += g[j]; bb[j] = run; }
    tot[seg * 128 + k] = run;
    __syncthreads();
    const float t0 = tot[k], t1 = tot[128 + k], t2 = tot[256 + k], t3 = tot[384 + k];
    const float pre = seg == 0 ? 0.f : seg == 1 ? t0 : seg == 2 ? t0 + t1 : t0 + t1 + t2;
    total = (t0 + t1) + (t2 + t3);
#pragma unroll
    for (int j = 0; j < 16; ++j) bb[j] += pre;
}
__device__ __forceinline__ void hgrn_stage_iT(const bf16* PI, size_t tok0, int hh, LAS bf16* iT, int tid) {
    const int s = tid >> 3, v0 = (tid & 7) * 16; const bf16* src = PI + (tok0 + s) * 512 + hh * 128 + v0;
#pragma unroll
    for (int h2 = 0; h2 < 2; ++h2) { const v4u w = *(const v4u*)(src + 8 * h2);
#pragma unroll
        for (int e = 0; e < 4; ++e) { iT[(v0 + 8 * h2 + 2 * e) * 72 + s] = (bf16)(w[e] & 0xffffu); iT[(v0 + 8 * h2 + 2 * e + 1) * 72 + s] = (bf16)(w[e] >> 16); } }
}
__device__ __forceinline__ void hgrn_local_item(const Params& P, const Ctx& C, const Wk& W, int item) {
    LAS bf16* khT = (LAS bf16*)C.lds;
    LAS bf16* iT = (LAS bf16*)(C.lds + 18432);
    LAS float* tot = (LAS float*)(C.lds + 36864);
    const float* G = w_tok32(P, W, AR_G, 512); const bf16* PI = w_tok16(P, W, AR_PI, 512); bf16* KVT = w_item16(P, W, AR_KVT); float* HD = (float*)(P.ws + WS_HD);
    const int bh = item >> 7, c = item & 127, b = bh >> 2, hh = bh & 3; const size_t tok0 = (size_t)b * SEQ + c * 64;
    const int tid = C.tid, k = tid & 127, seg = tid >> 7, r = C.lane & 15, q4 = C.lane >> 4;
    float g[16], bb[16], total;
    hgrn_cumsum16(G, tok0, hh, k, seg, tot, g, bb, total);
    { unsigned w[8];
#pragma unroll
      for (int j = 0; j < 8; ++j) { const float a0 = -expm1f(g[2 * j]) * __expf(total - bb[2 * j]), a1 = -expm1f(g[2 * j + 1]) * __expf(total - bb[2 * j + 1]); w[j] = pk2(a0, a1); }
      LAS v4u* dst = (LAS v4u*)(khT + k * 72 + seg * 16); dst[0] = (v4u){w[0], w[1], w[2], w[3]}; dst[1] = (v4u){w[4], w[5], w[6], w[7]}; }
    if (seg == 0) HD[(size_t)item * 128 + k] = __expf(total);
    hgrn_stage_iT(PI, tok0, hh, iT, tid);
    __syncthreads();
    const int v0 = 16 * C.wave;
#pragma unroll
    for (int ct = 0; ct < 8; ++ct) { f32x4 acc = (f32x4){0.f, 0.f, 0.f, 0.f}; acc = mma16(acc, iT + v0 * 72, 72, khT + (16 * ct) * 72, 72, 64, r, q4);
#pragma unroll
        for (int i = 0; i < 4; ++i) KVT[((size_t)item * 128 + v0 + 4 * q4 + i) * 128 + 16 * ct + r] = (bf16)f2bf(acc[i]); }
    __syncthreads();
}
__device__ __forceinline__ void phase_hgrn_scan(const Params& P, const Ctx& C, const Wk& W) {
    const bf16* KVT = w_item16(P, W, AR_KVT); bf16* ST = w_item16(P, W, AR_ST); const float* HD = (const float*)(P.ws + WS_HD);
    for (int task = W.lv * 256 + C.tid; C.tid < 256 && task < 32768; task += W.n * 256) {
        const int bh = W_BT0(W) * 4 + (task >> 11), v = (task >> 4) & 127, kb = task & 15;
        float st[8];
#pragma unroll
        for (int e = 0; e < 8; ++e) st[e] = 0.f;
#pragma unroll 4
        for (int c = 0; c < 128; ++c) { const size_t item = (size_t)bh * 128 + c, off = (item * 128 + v) * 128 + kb * 8;
            const v4u kv = *(const v4u*)(KVT + off); const f32x4 d0 = *(const f32x4*)(HD + item * 128 + kb * 8), d1 = *(const f32x4*)(HD + item * 128 + kb * 8 + 4);
            v4u o; o.x = pk2(st[0], st[1]); o.y = pk2(st[2], st[3]); o.z = pk2(st[4], st[5]); o.w = pk2(st[6], st[7]);
            *(v4u*)(ST + off) = o;
#pragma unroll
            for (int e = 0; e < 4; ++e) { st[2 * e] = (e < 2 ? d0[2 * e] : d1[2 * e - 4]) * st[2 * e] + bflo(kv[e]); st[2 * e + 1] = (e < 2 ? d0[2 * e + 1] : d1[2 * e - 3]) * st[2 * e + 1] + bfhi(kv[e]); }
        }
    }
}
__device__ __forceinline__ void hgrn_out_item(const Params& P, const Ctx& C, const Wk& W, int item) {
    LAS bf16* qt = (LAS bf16*)C.lds;
    LAS bf16* kt = (LAS bf16*)(C.lds + 17408);
    LAS bf16* iT = (LAS bf16*)(C.lds + 34816);
    LAS bf16* A1 = (LAS bf16*)(C.lds + 53248);
    LAS bf16* STl = (LAS bf16*)(C.lds + 62464);
    LAS float* ol = (LAS float*)(C.lds + 97280);
    LAS float* tot = (LAS float*)(C.lds + 131072);
    const float* G = w_tok32(P, W, AR_G, 512); const bf16* PQ = w_tok16(P, W, AR_PQ, 512); const bf16* PI = w_tok16(P, W, AR_PI, 512); const bf16* PG = w_tok16(P, W, AR_PG, 512);
    const bf16* ST = w_item16(P, W, AR_ST); bf16* MIX = (bf16*)(P.ws + WS_H);
    const int bh = item >> 7, c = item & 127, b = bh >> 2, hh = bh & 3; const size_t tok0 = (size_t)b * SEQ + c * 64;
    const int tid = C.tid, k = tid & 127, seg = tid >> 7, r = C.lane & 15, q4 = C.lane >> 4;
    float g[16], bb[16], total;
    hgrn_cumsum16(G, tok0, hh, k, seg, tot, g, bb, total);
#pragma unroll
    for (int j = 0; j < 16; ++j) { const int t = seg * 16 + j; const float qv = bf2f(PQ[(tok0 + t) * 512 + hh * 128 + k]);
        qt[t * 136 + k] = (bf16)f2bf(qv * __expf(bb[j])); kt[t * 136 + k] = (bf16)f2bf(-expm1f(g[j]) * __expf(-bb[j])); }
    hgrn_stage_iT(PI, tok0, hh, iT, tid);
    for (int ch = tid; ch < 2048; ch += 512) { const int rr = ch >> 4, c8 = (ch & 15) * 8; *(LAS v4u*)(STl + rr * 136 + c8) = *(const v4u*)(ST + ((size_t)item * 128 + rr) * 128 + c8); }
    __syncthreads();
    { const int rt = C.wave >> 1;
#pragma unroll
      for (int cc = 0; cc < 2; ++cc) { const int ct = (C.wave & 1) * 2 + cc; f32x4 acc = (f32x4){0.f, 0.f, 0.f, 0.f};
          acc = mma16(acc, qt + (16 * rt) * 136, 136, kt + (16 * ct) * 136, 136, 128, r, q4);
#pragma unroll
          for (int i = 0; i < 4; ++i) { const int t = 16 * rt + 4 * q4 + i, s = 16 * ct + r; A1[t * 72 + s] = (bf16)(s <= t ? f2bf(acc[i]) : 0u); } } }
    __syncthreads();
    { const int rt = C.wave >> 1;
#pragma unroll
      for (int cc = 0; cc < 4; ++cc) { const int ct = (C.wave & 1) * 4 + cc; f32x4 acc = (f32x4){0.f, 0.f, 0.f, 0.f};
          acc = mma16(acc, A1 + (16 * rt) * 72, 72, iT + (16 * ct) * 72, 72, 64, r, q4);
          acc = mma16(acc, qt + (16 * rt) * 136, 136, STl + (16 * ct) * 136, 136, 128, r, q4);
#pragma unroll
          for (int i = 0; i < 4; ++i) ol[(16 * rt + 4 * q4 + i) * 132 + 16 * ct + r] = acc[i]; } }
    __syncthreads();
    { const int t = tid >> 3, v0 = (tid & 7) * 16; float o[16]; float ss = 0.f;
#pragma unroll
      for (int e = 0; e < 16; ++e) { o[e] = ol[t * 132 + v0 + e]; ss += o[e] * o[e]; }
      ss += __shfl_xor(ss, 1); ss += __shfl_xor(ss, 2); ss += __shfl_xor(ss, 4);
      const float rstd = 1.0f / sqrtf(ss * (1.0f / 128.0f) + NORM_EPS);
      const float* ng = P.hgrn_norm_g + hh * 128 + v0; const bf16* gp = PG + (tok0 + t) * 512 + hh * 128 + v0;
      const v4u g0 = *(const v4u*)gp, g1 = *(const v4u*)(gp + 8); unsigned w[8];
#pragma unroll
      for (int e = 0; e < 4; ++e) { w[e] = pk2(o[2 * e] * rstd * ng[2 * e] * bflo(g0[e]), o[2 * e + 1] * rstd * ng[2 * e + 1] * bfhi(g0[e]));
                                    w[4 + e] = pk2(o[8 + 2 * e] * rstd * ng[8 + 2 * e] * bflo(g1[e]), o[9 + 2 * e] * rstd * ng[9 + 2 * e] * bfhi(g1[e])); }
      v4u* dst = (v4u*)(MIX + (tok0 + t) * 1024 + 512 + hh * 128 + v0); dst[0] = (v4u){w[0], w[1], w[2], w[3]}; dst[1] = (v4u){w[4], w[5], w[6], w[7]}; }
    __syncthreads();
}

typedef short v4i16_t __attribute__((ext_vector_type(4)));
constexpr int AT_VP = 144;
constexpr int AT_QI = 512;
constexpr int AT_STO = 0, AT_STML = AT_QI * 128, AT_VW = AT_STML + AT_QI * 8;
__device__ __forceinline__ void attn_softmax_block(f32x4 (&sa)[9], int tile0, int qq, int mq0, int q4, float& mx, float& ls, bf16x8 (&pf)[5]) {
    mx = -1e30f;
#pragma unroll
    for (int t = 0; t < 9; ++t)
#pragma unroll
        for (int i = 0; i < 4; ++i) { const int kap = 16 * (tile0 + t) + 4 * q4 + i; const bool ok = kap >= qq && kap <= qq + 128 && (mq0 - 128 + kap) >= 0;
            sa[t][i] = ok ? sa[t][i] : -1e30f; mx = fmaxf(mx, sa[t][i]); }
    mx = fmaxf(mx, __shfl_xor(mx, 16)); mx = fmaxf(mx, __shfl_xor(mx, 32));
    ls = 0.f;
#pragma unroll
    for (int t = 0; t < 9; ++t)
#pragma unroll
        for (int i = 0; i < 4; ++i) { const float pv = sa[t][i] > -1e29f ? __builtin_amdgcn_exp2f(sa[t][i] - mx) : 0.f; sa[t][i] = pv; ls += pv; }
    ls += __shfl_xor(ls, 16); ls += __shfl_xor(ls, 32);
#pragma unroll
    for (int s2 = 0; s2 < 5; ++s2) { const int tl = 2 * s2 - tile0, th = 2 * s2 + 1 - tile0;
        const f32x4 lo = (tl >= 0 && tl < 9) ? sa[(tl >= 0 && tl < 9) ? tl : 0] : (f32x4){0.f, 0.f, 0.f, 0.f}, hi = (th >= 0 && th < 9) ? sa[(th >= 0 && th < 9) ? th : 0] : (f32x4){0.f, 0.f, 0.f, 0.f};
        v4u w; w.x = pk2(lo[0], lo[1]); w.y = pk2(lo[2], lo[3]); w.z = pk2(hi[0], hi[1]); w.w = pk2(hi[2], hi[3]); pf[s2] = __builtin_bit_cast(bf16x8, w); }
}
__device__ __forceinline__ void attn_merge(int g, LAS unsigned char* lds, int qloc, int q4, f32x4 (&oa)[4], float mx, float ls, bf16* orow) {
    LAS unsigned char* so = lds + AT_STO + qloc * 128 + 8 * q4; LAS float* sml = (LAS float*)(lds + AT_STML) + 2 * qloc;
    float mo = mx, lo2 = ls;
    if (g > 0) { const float m_old = sml[0], l_old = sml[1]; const float M = fmaxf(m_old, mx); const float fo = __builtin_amdgcn_exp2f(m_old - M), fn = __builtin_amdgcn_exp2f(mx - M);
#pragma unroll
        for (int dt = 0; dt < 4; ++dt) { const unsigned long long w = *(const LAS unsigned long long*)(so + 32 * dt); const unsigned w0 = (unsigned)w, w1 = (unsigned)(w >> 32);
            oa[dt] = oa[dt] * fn + (f32x4){bflo(w0), bfhi(w0), bflo(w1), bfhi(w1)} * fo; }
        mo = M; lo2 = ls * fn + l_old * fo; }
    if (g < 2) {
#pragma unroll
        for (int dt = 0; dt < 4; ++dt) *(LAS unsigned long long*)(so + 32 * dt) = (unsigned long long)pk2(oa[dt][0], oa[dt][1]) | ((unsigned long long)pk2(oa[dt][2], oa[dt][3]) << 32);
        if (q4 == 0) { sml[0] = mo; sml[1] = lo2; }
    } else { const float inv = 1.0f / lo2;
#pragma unroll
        for (int dt = 0; dt < 4; ++dt) { const f32x4 v = oa[dt] * inv; *(unsigned long long*)(orow + 16 * dt) = (unsigned long long)pk2(v[0], v[1]) | ((unsigned long long)pk2(v[2], v[3]) << 32); } }
}
__device__ __forceinline__ void attn_item(const Params& P, const Ctx& C, const Wk& W, int b, int hd, int qt) {
    LAS unsigned char* Vw = C.lds + AT_VW + C.wave * (64 * AT_VP);
    const bf16* QKV = w_tok16(P, W, AR_QK, 3072); bf16* O = (bf16*)(P.ws + WS_H);
    const int lane = C.lane, r = lane & 15, q4 = lane >> 4;
    const int t0 = qt * AT_QI; const size_t rowbase = (size_t)b * SEQ;
    const bf16* Kb = QKV + rowbase * 3072 + 1024 + hd * 64; const bf16* Vb = QKV + rowbase * 3072 + 2048 + hd * 64;
#pragma unroll 1
    for (int g = 0; g < 3; ++g) {
        const int dsh = 4 - 2 * g, d = 1 << dsh;
#pragma unroll 1
        for (int uu = 0; uu < 2; ++uu) {
            const int u = C.wave + 8 * uu;
            const int c = u & (d - 1), j = u >> dsh;
            const int mq0 = (t0 >> dsh) + 32 * j;
            const int ql0 = c + d * (32 * j + r), ql1 = ql0 + 16 * d;
            const bf16* qp0 = QKV + (rowbase + t0 + ql0) * 3072 + hd * 64 + 8 * q4; const bf16* qp1 = QKV + (rowbase + t0 + ql1) * 3072 + hd * 64 + 8 * q4;
            const bf16x8 bq00 = *(const bf16x8*)qp0, bq01 = *(const bf16x8*)(qp0 + 32), bq10 = *(const bf16x8*)qp1, bq11 = *(const bf16x8*)(qp1 + 32);
            bf16x8 ka[10][2];
#pragma unroll
            for (int t = 0; t < 10; ++t) { int mk = mq0 - 128 + 16 * t + r; mk = mk < 0 ? 0 : mk;
                const bf16* kp = Kb + (size_t)(c + d * mk) * 3072 + 8 * q4; ka[t][0] = *(const bf16x8*)kp; ka[t][1] = *(const bf16x8*)(kp + 32); }
            v4u vr[2][8];
#pragma unroll
            for (int it = 0; it < 8; ++it) { const int kap = 8 * it + (lane >> 3); int mk = mq0 - 128 + kap; mk = mk < 0 ? 0 : mk;
                vr[0][it] = *(const v4u*)(Vb + (size_t)(c + d * mk) * 3072 + (lane & 7) * 8); }
            __builtin_amdgcn_sched_barrier(0);
            bf16x8 pf0[5], pf1[5]; float mx0, ls0, mx1, ls1;
            { f32x4 sa[9];
#pragma unroll
              for (int t = 0; t < 9; ++t) { sa[t] = (f32x4){0.f, 0.f, 0.f, 0.f}; sa[t] = __builtin_amdgcn_mfma_f32_16x16x32_bf16(ka[t][0], bq00, sa[t], 0, 0, 0); sa[t] = __builtin_amdgcn_mfma_f32_16x16x32_bf16(ka[t][1], bq01, sa[t], 0, 0, 0); }
              attn_softmax_block(sa, 0, r, mq0, q4, mx0, ls0, pf0); }
            { f32x4 sa[9];
#pragma unroll
              for (int t = 0; t < 9; ++t) { sa[t] = (f32x4){0.f, 0.f, 0.f, 0.f}; sa[t] = __builtin_amdgcn_mfma_f32_16x16x32_bf16(ka[t + 1][0], bq10, sa[t], 0, 0, 0); sa[t] = __builtin_amdgcn_mfma_f32_16x16x32_bf16(ka[t + 1][1], bq11, sa[t], 0, 0, 0); }
              __builtin_amdgcn_sched_barrier(0);
#pragma unroll
              for (int it = 0; it < 8; ++it) { const int kap = 64 + 8 * it + (lane >> 3); int mk = mq0 - 128 + kap; mk = mk < 0 ? 0 : mk;
                  vr[1][it] = *(const v4u*)(Vb + (size_t)(c + d * mk) * 3072 + (lane & 7) * 8); }
              __builtin_amdgcn_sched_barrier(0);
              attn_softmax_block(sa, 1, 16 + r, mq0, q4, mx1, ls1, pf1); }
            v4u vr2[4];
#pragma unroll
            for (int it = 0; it < 4; ++it) { const int kap = 128 + 8 * it + (lane >> 3); const int mk = mq0 - 128 + kap;
                vr2[it] = *(const v4u*)(Vb + (size_t)(c + d * mk) * 3072 + (lane & 7) * 8); }
            f32x4 oa0[4], oa1[4];
#pragma unroll
            for (int dt = 0; dt < 4; ++dt) { oa0[dt] = (f32x4){0.f, 0.f, 0.f, 0.f}; oa1[dt] = (f32x4){0.f, 0.f, 0.f, 0.f}; }
#pragma unroll
            for (int ch = 0; ch < 3; ++ch) {
#pragma unroll
                for (int it = 0; it < 8; ++it) { const int row = 8 * it + (lane >> 3);
                    if (ch < 2) *(LAS v4u*)(Vw + row * AT_VP + (lane & 7) * 16) = vr[ch < 2 ? ch : 0][it];
                    else if (it < 4) *(LAS v4u*)(Vw + row * AT_VP + (lane & 7) * 16) = vr2[it < 4 ? it : 0]; }
                asm volatile("s_waitcnt lgkmcnt(0)" ::: "memory");
#pragma unroll
                for (int s2 = 0; s2 < 2; ++s2) { const int sx = 2 * ch + s2; if (sx < 5) {
#pragma unroll
                    for (int dt = 0; dt < 4; ++dt) {
                        const LAS unsigned char* vp = Vw + (32 * s2 + 4 * q4 + (r >> 2)) * AT_VP + dt * 32 + (r & 3) * 8;
                        const v4i16_t x = __builtin_amdgcn_ds_read_tr16_b64_v4i16((LAS v4i16_t*)vp), y = __builtin_amdgcn_ds_read_tr16_b64_v4i16((LAS v4i16_t*)(vp + 16 * AT_VP));
                        const bf16x8 av = (bf16x8){x[0], x[1], x[2], x[3], y[0], y[1], y[2], y[3]};
                        oa0[dt] = __builtin_amdgcn_mfma_f32_16x16x32_bf16(av, pf0[sx], oa0[dt], 0, 0, 0);
                        oa1[dt] = __builtin_amdgcn_mfma_f32_16x16x32_bf16(av, pf1[sx], oa1[dt], 0, 0, 0); } } }
                asm volatile("s_waitcnt lgkmcnt(0)" ::: "memory");
            }
            attn_merge(g, C.lds, ql0, q4, oa0, mx0, ls0, O + (rowbase + t0 + ql0) * 1024 + hd * 64 + 4 * q4);
            attn_merge(g, C.lds, ql1, q4, oa1, mx1, ls1, O + (rowbase + t0 + ql1) * 1024 + hd * 64 + 4 * q4);
        }
        __syncthreads();
    }
}

__device__ __forceinline__ unsigned ordf(float s) { const unsigned u = __builtin_bit_cast(unsigned, s); return u ^ ((unsigned)((int)u >> 31) | 0x80000000u); }
__device__ __forceinline__ float unordf(unsigned v) { return __builtin_bit_cast(float, v ^ ((unsigned)((int)(~v) >> 31) | 0x80000000u)); }
__device__ __forceinline__ void ins16(unsigned (&top)[16], unsigned x) {
#pragma unroll
    for (int j = 0; j < 16; ++j) { const unsigned hi = top[j] > x ? top[j] : x; x = top[j] > x ? x : top[j]; top[j] = hi; }
}
#define CE_D(a, b) { const unsigned hi_ = (a) > (b) ? (a) : (b), lo_ = (a) > (b) ? (b) : (a); (a) = hi_; (b) = lo_; }
__device__ __forceinline__ void sort16_desc(unsigned (&v)[16]) {
#pragma unroll
    for (int k = 2; k <= 16; k <<= 1)
#pragma unroll
        for (int j = k >> 1; j > 0; j >>= 1)
#pragma unroll
            for (int i = 0; i < 16; ++i) { const int l = i ^ j; if (l > i) { if ((i & k) == 0) CE_D(v[i], v[l]) else CE_D(v[l], v[i]) } }
}
__device__ __forceinline__ void bitonic_merge16_desc(unsigned (&c)[16]) {
#pragma unroll
    for (int st = 8; st >= 1; st >>= 1)
#pragma unroll
        for (int j = 0; j < 16; ++j) if ((j & st) == 0) CE_D(c[j], c[j + st])
}
__device__ __forceinline__ void top16_of_two(unsigned (&a)[16], const unsigned (&b)[16]) {
#pragma unroll
    for (int j = 0; j < 16; ++j) a[j] = a[j] > b[15 - j] ? a[j] : b[15 - j];
    bitonic_merge16_desc(a);
}
__device__ __forceinline__ void merge16(unsigned (&top)[16], int mask) {
    unsigned o[16];
#pragma unroll
    for (int j = 0; j < 16; ++j) o[j] = (unsigned)__shfl_xor((int)top[j], mask);
    top16_of_two(top, o);
}
__device__ __forceinline__ void phase_peer_topk(const Params& P, const Ctx& C, const Wk& W, int layer) {
    LAS bf16* SK = (LAS bf16*)C.lds;
    const bf16* SKB = (const bf16*)(P.ws + WS_SKB) + (size_t)layer * 32768; const bf16* QP = w_tok16(P, W, AR_QP, 2048);
    int* IDX = (int*)(P.ws + WS_IDX); float* GATE = (float*)(P.ws + WS_GATE);
    for (int ch = C.tid; ch < 4096; ch += 512) { const int rr = ch >> 4, c8 = (ch & 15) * 8; *(LAS v4u*)(SK + rr * 136 + c8) = *(const v4u*)(SKB + (size_t)rr * 128 + c8); }
    __syncthreads();
    const int r = C.lane & 15, q4 = C.lane >> 4;
    const int gw = W.lv * NWAVES + C.wave, NGW = W.n * NWAVES;
    for (int grp = W_TK0(W) / 2 + gw; grp < W_TK0(W) / 2 + HT * 8 / 16; grp += NGW) {
        const size_t task = (size_t)grp * 16 + r;
        unsigned lst[2][16];
#pragma unroll
        for (int half = 0; half < 2; ++half) {
            bf16x8 bq[4];
#pragma unroll
            for (int ks = 0; ks < 4; ++ks) bq[ks] = *(const bf16x8*)(QP + task * 256 + half * 128 + ks * 32 + 8 * q4);
            unsigned ka[16], kb[16];
#pragma unroll
            for (int nt = 0; nt < 8; ++nt) { f32x4 acc = (f32x4){0.f, 0.f, 0.f, 0.f};
#pragma unroll
                for (int ks = 0; ks < 4; ++ks) { const bf16x8 a = *(const LAS bf16x8*)(SK + (half * 128 + 16 * nt + r) * 136 + ks * 32 + 8 * q4); acc = __builtin_amdgcn_mfma_f32_16x16x32_bf16(a, bq[ks], acc, 0, 0, 0); }
#pragma unroll
                for (int i = 0; i < 4; ++i) { const unsigned n = 16 * nt + 4 * q4 + i; const unsigned key = (ordf(acc[i]) & ~127u) | (127u - n); if (nt < 4) ka[4 * nt + i] = key; else kb[4 * (nt - 4) + i] = key; }
                if (nt == 3) sort16_desc(ka);
                __builtin_amdgcn_sched_barrier(0); }
            sort16_desc(kb); top16_of_two(ka, kb);
            merge16(ka, 16); merge16(ka, 32);
#pragma unroll
            for (int j = 0; j < 16; ++j) lst[half][j] = ka[j];
        }
        float v2[16]; unsigned e2[16];
#pragma unroll
        for (int j = 0; j < 16; ++j) { v2[j] = unordf(lst[1][j] & ~127u); e2[j] = 127u - (lst[1][j] & 127u); }
        float v1s[4]; unsigned e1s[4];
#pragma unroll
        for (int k = 0; k < 4; ++k) { const unsigned w = q4 == 0 ? lst[0][4 * k] : q4 == 1 ? lst[0][4 * k + 1] : q4 == 2 ? lst[0][4 * k + 2] : lst[0][4 * k + 3];
            v1s[k] = unordf(w & ~127u); e1s[k] = (127u - (w & 127u)) << 7; }
        unsigned top[16];
#pragma unroll
        for (int j = 0; j < 16; ++j) top[j] = (ordf(v1s[0] + v2[j]) & ~16383u) | e1s[0] | e2[j];
        sort16_desc(top);
#pragma unroll
        for (int j = 0; j < 3; ++j) ins16(top, (ordf(v1s[1] + v2[j]) & ~16383u) | e1s[1] | e2[j]);
        ins16(top, (ordf(v1s[2] + v2[0]) & ~16383u) | e1s[2] | e2[0]);
        ins16(top, (ordf(v1s[3] + v2[0]) & ~16383u) | e1s[3] | e2[0]);
        merge16(top, 16); merge16(top, 32);
        float ev[16]; float den = 0.f; const float mx = unordf(top[0] & ~16383u);
#pragma unroll
        for (int j = 0; j < 16; ++j) { ev[j] = __expf(unordf(top[j] & ~16383u) - mx); den += ev[j]; }
        const float inv = 1.0f / den;
        int* ip = IDX + task * 16; float* gp = GATE + task * 16;
        if (q4 == 0) { *(v4u*)(ip) = (v4u){top[0] & 16383u, top[1] & 16383u, top[2] & 16383u, top[3] & 16383u}; *(f32x4*)(gp) = (f32x4){ev[0] * inv, ev[1] * inv, ev[2] * inv, ev[3] * inv}; }
        else if (q4 == 1) { *(v4u*)(ip + 4) = (v4u){top[4] & 16383u, top[5] & 16383u, top[6] & 16383u, top[7] & 16383u}; *(f32x4*)(gp + 4) = (f32x4){ev[4] * inv, ev[5] * inv, ev[6] * inv, ev[7] * inv}; }
        else if (q4 == 2) { *(v4u*)(ip + 8) = (v4u){top[8] & 16383u, top[9] & 16383u, top[10] & 16383u, top[11] & 16383u}; *(f32x4*)(gp + 8) = (f32x4){ev[8] * inv, ev[9] * inv, ev[10] * inv, ev[11] * inv}; }
        else { *(v4u*)(ip + 12) = (v4u){top[12] & 16383u, top[13] & 16383u, top[14] & 16383u, top[15] & 16383u}; *(f32x4*)(gp + 12) = (f32x4){ev[12] * inv, ev[13] * inv, ev[14] * inv, ev[15] * inv}; }
    }
}
struct ExpRow { v4u d[4], u[4]; float ds, us, gk; };
__device__ __forceinline__ void exp_issue(ExpRow& R, const unsigned char* TD, const unsigned char* TU, const float* SD, int ex, float gk, int jl) {
    const unsigned char* dr = TD + (size_t)ex * TROW; const unsigned char* ur = TU + (size_t)ex * TROW;
#pragma unroll
    for (int c = 0; c < 4; ++c) R.d[c] = *(const v4u*)(dr + (c * 16 + jl) * 16);
#pragma unroll
    for (int c = 0; c < 4; ++c) R.u[c] = *(const v4u*)(ur + (c * 16 + jl) * 16);
    R.ds = SD[ex]; R.us = SD[16384 + ex]; R.gk = gk;
}
__device__ __forceinline__ void exp_consume(const ExpRow& R, const unsigned (&hp)[32], f32x2 (&oacc)[32]) {
    f32x2 a2 = (f32x2){0.f, 0.f};
#pragma unroll
    for (int c = 0; c < 4; ++c)
#pragma unroll
        for (int w = 0; w < 4; ++w) { const f32x2 lo = __builtin_amdgcn_cvt_pk_f32_fp8((int)R.d[c][w], false), hi = __builtin_amdgcn_cvt_pk_f32_fp8((int)R.d[c][w], true);
            unsigned h0 = hp[c * 8 + 2 * w], h1 = hp[c * 8 + 2 * w + 1]; asm volatile("" : "+v"(h0), "+v"(h1));
            a2 = a2 + lo * (f32x2){bflo(h0), bfhi(h0)}; a2 = a2 + hi * (f32x2){bflo(h1), bfhi(h1)}; }
    float a = (a2.x + a2.y) * R.ds;
    a += __shfl_xor(a, 1); a += __shfl_xor(a, 2); a += __shfl_xor(a, 4); a += __shfl_xor(a, 8);
    const float wk = R.gk * gelu_f(a) * R.us; const f32x2 wk2 = (f32x2){wk, wk};
#pragma unroll
    for (int c = 0; c < 4; ++c)
#pragma unroll
        for (int w = 0; w < 4; ++w) { const f32x2 lo = __builtin_amdgcn_cvt_pk_f32_fp8((int)R.u[c][w], false), hi = __builtin_amdgcn_cvt_pk_f32_fp8((int)R.u[c][w], true);
            oacc[c * 8 + 2 * w] = oacc[c * 8 + 2 * w] + wk2 * lo; oacc[c * 8 + 2 * w + 1] = oacc[c * 8 + 2 * w + 1] + wk2 * hi; }
}
__device__ __forceinline__ void phase_peer_experts(const Params& P, const Ctx& Cin, const Wk& W, int layer, bool last) {
    const Ctx C = fresh_ctx(Cin);
    const unsigned char* TD = P.ws + WS_TAB8 + (size_t)(2 * layer) * TAB8_BYTES; const unsigned char* TU = P.ws + WS_TAB8 + (size_t)(2 * layer + 1) * TAB8_BYTES; const float* SD = (const float*)(P.ws + WS_SC8) + (size_t)(2 * layer) * 16384; bf16* H = (bf16*)(P.ws + WS_H);
    const int* IDX = (const int*)(P.ws + WS_IDX); const float* GATE = (const float*)(P.ws + WS_GATE); const float* MOD = (const float*)(P.ws + WS_MOD);
    const int lane = C.lane, grp = lane >> 4, jl = lane & 15;
    unsigned* ticket = (unsigned*)(P.ws + WS_CTL) + 96 + 2 * layer + W.h;
    const bool dyn = W.n != C.G;
    const int gws = W.lv * NWAVES + C.wave, NGWS = W.n * NWAVES;
    int tnext = gws; if (dyn) { if (lane == 0) tnext = (int)atomicAdd(ticket, 1u); tnext = __builtin_amdgcn_readfirstlane(tnext); }
    while (tnext < HT) {
        const int tok = W_TK0(W) + tnext;
        if (dyn) { int tn = 0; if (lane == 0) tn = (int)atomicAdd(ticket, 1u); tnext = tn; } else tnext += NGWS;
        const int b = tok >> 13;
        const int i0 = IDX[(size_t)tok * 128 + lane], i1 = IDX[(size_t)tok * 128 + 64 + lane];
        const float g0 = GATE[(size_t)tok * 128 + lane], g1 = GATE[(size_t)tok * 128 + 64 + lane];
        unsigned hf[32];
#pragma unroll
        for (int c = 0; c < 4; ++c) { const bf16* hp = H + (size_t)tok * 1024 + (c * 16 + jl) * 16; const v4u w0 = *(const v4u*)hp, w1 = *(const v4u*)(hp + 8);
#pragma unroll
            for (int e = 0; e < 4; ++e) { hf[c * 8 + e] = w0[e]; hf[c * 8 + 4 + e] = w1[e]; } }
        f32x2 oacc[32];
#pragma unroll
        for (int e = 0; e < 32; ++e) oacc[e] = (f32x2){0.f, 0.f};
        ExpRow RA, RB;
        exp_issue(RA, TD, TU, SD, __shfl(i0, grp), __shfl(g0, grp), jl);
        for (int it = 0; it < 32 * EXP_REP; it += 2) {
            { const int kk = ((it + 1) & 31) * 4 + grp; const int el = __shfl(i0, kk & 63), eh = __shfl(i1, kk & 63); const float gl = __shfl(g0, kk & 63), gh = __shfl(g1, kk & 63);
              exp_issue(RB, TD, TU, SD, kk < 64 ? el : eh, kk < 64 ? gl : gh, jl); }
            exp_consume(RA, hf, oacc);
            { const int kk = ((it + 2) & 31) * 4 + grp; const int el = __shfl(i0, kk & 63), eh = __shfl(i1, kk & 63); const float gl = __shfl(g0, kk & 63), gh = __shfl(g1, kk & 63);
              exp_issue(RA, TD, TU, SD, kk < 64 ? el : eh, kk < 64 ? gl : gh, jl); }
            exp_consume(RB, hf, oacc);
        }
        f32x2 h1[16];
        { const bool up = (grp & 2) != 0;
#pragma unroll
          for (int e = 0; e < 16; ++e) { const f32x2 keep = up ? oacc[16 + e] : oacc[e], send = up ? oacc[e] : oacc[16 + e]; h1[e] = keep + (f32x2){__shfl_xor(send.x, 32), __shfl_xor(send.y, 32)}; } }
        f32x2 h2[8];
        { const bool up = (grp & 1) != 0;
#pragma unroll
          for (int e = 0; e < 8; ++e) { const f32x2 keep = up ? h1[8 + e] : h1[e], send = up ? h1[e] : h1[8 + e]; h2[e] = keep + (f32x2){__shfl_xor(send.x, 16), __shfl_xor(send.y, 16)}; } }
        const int d0 = (grp * 16 + jl) * 16;
        const float* g2p = MOD + (size_t)(layer * 8 + b) * 6144 + 5120 + d0; const float psc = ((ABL_ON >= (layer == 0 ? 2 : 4)) ? 1.f : 0.f) * (1.0f / EXP_REP);
        float* xp = P.out + (size_t)tok * 1024 + d0;
        float xn[16]; float ss = 0.f;
#pragma unroll
        for (int q = 0; q < 4; ++q) { const f32x4 xa = *(const f32x4*)(xp + 4 * q), ga = *(const f32x4*)(g2p + 4 * q);
            xn[4 * q] = xa[0] + psc * ga[0] * h2[2 * q].x; xn[4 * q + 1] = xa[1] + psc * ga[1] * h2[2 * q].y; xn[4 * q + 2] = xa[2] + psc * ga[2] * h2[2 * q + 1].x; xn[4 * q + 3] = xa[3] + psc * ga[3] * h2[2 * q + 1].y; }
#pragma unroll
        for (int e = 0; e < 16; ++e) ss += xn[e] * xn[e];
        const float rstd = 1.0f / sqrtf(wave_sum(ss) * (1.0f / 1024.0f) + NORM_EPS);
        if (!last) {
            const float* ng = P.norm_mix_g + (layer + 1) * 1024 + d0; const float* mb = MOD + (size_t)((layer + 1) * 8 + b) * 6144 + d0;
            unsigned w[8];
#pragma unroll
            for (int q = 0; q < 4; ++q) { *(f32x4*)(xp + 4 * q) = (f32x4){xn[4 * q], xn[4 * q + 1], xn[4 * q + 2], xn[4 * q + 3]}; }
#pragma unroll
            for (int e = 0; e < 8; ++e) w[e] = pk2(xn[2 * e] * rstd * ng[2 * e] * (1.0f + mb[1024 + 2 * e]) + mb[2 * e], xn[2 * e + 1] * rstd * ng[2 * e + 1] * (1.0f + mb[1024 + 2 * e + 1]) + mb[2 * e + 1]);
            v4u* hp = (v4u*)(H + (size_t)tok * 1024 + d0); hp[0] = (v4u){w[0], w[1], w[2], w[3]}; hp[1] = (v4u){w[4], w[5], w[6], w[7]};
        } else {
            const float* fg = P.final_norm_g + d0;
#pragma unroll
            for (int q = 0; q < 4; ++q) *(f32x4*)(xp + 4 * q) = (f32x4){xn[4 * q] * rstd * fg[4 * q], xn[4 * q + 1] * rstd * fg[4 * q + 1], xn[4 * q + 2] * rstd * fg[4 * q + 2], xn[4 * q + 3] * rstd * fg[4 * q + 3]};
        }
        if (dyn) tnext = __builtin_amdgcn_readfirstlane(tnext);
    }
}

#ifndef NC_PER_XCD
#define NC_PER_XCD 16
#endif
#ifdef PROBE_SEL
#define SUBSTAMP(i) do { if (W.c == 0 && C.tid == 0) __hip_atomic_store((unsigned*)(P.ws + WS_CTL) + 128 + 16 * W.h + (i), (unsigned)__builtin_amdgcn_s_memrealtime(), __ATOMIC_RELAXED, __HIP_MEMORY_SCOPE_AGENT); } while (0)
#else
#define SUBSTAMP(i) do {} while (0)
#endif
__device__ __forceinline__ void run_C0(const Params& P, const Ctx& Cin, const Wk& W, const XcdBarrier& tb) {
    const Ctx C = fresh_ctx(Cin);
    SUBSTAMP(0);
    unsigned char* ws = P.ws; float* MOD = (float*)(ws + WS_MOD); bf16* H = (bf16*)(ws + WS_H);
    const size_t tk = (size_t)W_TK0(W); unsigned char* const ar = w_ar(P, W);
    phase_norm(P, C, W, P.x, P.norm_mix_g, 0, 0); xcd_barrier(tb); SUBSTAMP(1);
    { pg8::Gemm g{H + tk * 1024, (const bf16*)(ws + WS_WIN), HT, 3072, 1024}; pg8::StaticOrder S; S.init(HT, 3072, W.n, W.c);
      EpiInProj E{(bf16*)(ar + AR_PU), (bf16*)(ar + AR_PV), (bf16*)(ar + AR_PQ), (bf16*)(ar + AR_PI), (bf16*)(ar + AR_PG), (float*)(ar + AR_G), (const float*)(ws + WS_LB)};
      pg8::gemm_phase<EpiInProj, pg8::StaticOrder, true, true>(C.lds, g, S, E); } xcd_barrier(tb); SUBSTAMP(2);
    for (int it = W.lv; it < 1024; it += W.n) gmlp_item(P, C, W, W_TK0(W) / 128 + (it >> 2), it & 3);
    for (int it = W.lv; it < 2048; it += W.n) hgrn_local_item(P, C, W, W_BT0(W) * 512 + it);
    xcd_barrier(tb); SUBSTAMP(3);
    phase_hgrn_scan(P, C, W); xcd_barrier(tb); SUBSTAMP(4);
    for (int it = W.lv; it < 2048; it += W.n) hgrn_out_item(P, C, W, W_BT0(W) * 512 + it);
    xcd_barrier(tb); SUBSTAMP(5);
    { pg8::Gemm g{H + tk * 1024, (const bf16*)(ws + WS_WOUT0), HT, 1024, 1024}; pg8::StaticOrder S; S.init(HT, 1024, W.n, W.c);
      EpiResid E{P.x + tk * 1024, P.out + tk * 1024, MOD + 2048 + (size_t)W_BT0(W) * 6144, 1.f};
      pg8::gemm_phase<EpiResid, pg8::StaticOrder, true, true>(C.lds, g, S, E); } xcd_barrier(tb); SUBSTAMP(6);
    phase_norm(P, C, W, P.out, P.norm_ffn_g, 0, 3072); xcd_barrier(tb); SUBSTAMP(7);
    { pg8::Gemm g{H + tk * 1024, (const bf16*)(ws + WS_WQ0), HT, 2048, 1024}; pg8::StaticOrder S; S.init(HT, 2048, W.n, W.c);
      EpiBf16P E{(bf16*)(ar + AR_QP), 2048};
      pg8::gemm_phase<EpiBf16P, pg8::StaticOrder, true, true>(C.lds, g, S, E); }
    SUBSTAMP(9);
}
__device__ __forceinline__ void run_C1(const Params& P, const Ctx& Cin, const Wk& W, const XcdBarrier& tb) {
    const Ctx C = fresh_ctx(Cin);
    SUBSTAMP(0);
    unsigned char* ws = P.ws; float* MOD = (float*)(ws + WS_MOD); bf16* H = (bf16*)(ws + WS_H);
    const size_t tk = (size_t)W_TK0(W); unsigned char* const ar = w_ar(P, W);
    { pg8::Gemm g{H + tk * 1024, (const bf16*)(ws + WS_WQKV), HT, 3072, 1024}; pg8::StaticOrder S; S.init(HT, 3072, W.n, W.c);
      EpiQKRot E{(bf16*)(ar + AR_QK), (const float*)(ws + WS_CS) + tk * 16};
      pg8::gemm_phase<EpiQKRot, pg8::StaticOrder, true, true>(C.lds, g, S, E); } xcd_barrier(tb); SUBSTAMP(1);
    for (int it = W.lv; it < (NB / 2) * 16 * 16; it += W.n) attn_item(P, C, W, W_BT0(W) + (it >> 8), (it >> 4) & 15, it & 15);
    xcd_barrier(tb); SUBSTAMP(2);
    { pg8::Gemm g{H + tk * 1024, (const bf16*)(ws + WS_WOUT1), HT, 1024, 1024}; pg8::StaticOrder S; S.init(HT, 1024, W.n, W.c);
      EpiResid E{P.out + tk * 1024, P.out + tk * 1024, MOD + (size_t)8 * 6144 + 2048 + (size_t)W_BT0(W) * 6144, 1.f};
      pg8::gemm_phase<EpiResid, pg8::StaticOrder, true, true>(C.lds, g, S, E); } xcd_barrier(tb); SUBSTAMP(3);
    phase_norm(P, C, W, P.out, P.norm_ffn_g + 1024, 1, 3072); xcd_barrier(tb); SUBSTAMP(4);
    { pg8::Gemm g{H + tk * 1024, (const bf16*)(ws + WS_WQ1), HT, 2048, 1024}; pg8::StaticOrder S; S.init(HT, 2048, W.n, W.c);
      EpiBf16P E{(bf16*)(ar + AR_QP), 2048};
      pg8::gemm_phase<EpiBf16P, pg8::StaticOrder, true, true>(C.lds, g, S, E); }
    SUBSTAMP(9);
}
__device__ __forceinline__ void run_E(const Params& P, const Ctx& Cin, const Wk& W, const XcdBarrier& tb, int layer) {
    { const Ctx C = fresh_ctx(Cin); phase_peer_topk(P, C, W, layer); }
    xcd_barrier(tb);
    if (W.c == 0 && Cin.tid == 0) __hip_atomic_store((unsigned*)(P.ws + WS_CTL) + 112 + 2 * layer + W.h, 1u, __ATOMIC_RELAXED, __HIP_MEMORY_SCOPE_AGENT);
    phase_peer_experts(P, Cin, W, layer, layer == 1);
}
__device__ __forceinline__ void help_E(const Params& P, const Ctx& Cin, int h, int layer) {
    volatile LAS unsigned* okw = (volatile LAS unsigned*)(Cin.lds + LDSCTL_OFF + 192);
    if (Cin.tid == 0) { unsigned* flag = (unsigned*)(P.ws + WS_CTL) + 112 + 2 * layer + h; unsigned ok = 0u;
        for (unsigned sp = 0; sp < (1u << 16); ++sp) { if (__hip_atomic_load(flag, __ATOMIC_RELAXED, __HIP_MEMORY_SCOPE_AGENT) != 0u) { ok = 1u; break; } __builtin_amdgcn_s_sleep(8); }
        __builtin_amdgcn_fence(__ATOMIC_ACQUIRE, "agent"); asm volatile("s_waitcnt vmcnt(0)" ::: "memory");
        *okw = ok; }
    __syncthreads();
    const bool ok = *okw != 0u;
    __syncthreads();
    if (ok) { Wk W; W.lv = 0; W.n = 1; W.c = 1; W.h = h; phase_peer_experts(P, Cin, W, layer, layer == 1); }
}
__global__ void __launch_bounds__(NWAVES * 64, 2) hybrid_fwd(Params P) {
    extern __shared__ __attribute__((aligned(16))) unsigned char lds_raw[];
    Ctx C;
    C.lds = (LAS unsigned char*)lds_raw;
    C.tid = threadIdx.x; C.lane = C.tid & 63; C.wave = __builtin_amdgcn_readfirstlane(C.tid >> 6);
    C.G = gridDim.x; const int bx = blockIdx.x; C.vcu = (bx % 8) * (C.G / 8) + bx / 8;
    volatile LAS unsigned* MISC = (volatile LAS unsigned*)(C.lds + MISC_OFF);
    for (int u = C.tid; u < (LDS_BYTES - LDSCTL_OFF) / 4; u += NWAVES * 64) ((LAS unsigned*)(C.lds + LDSCTL_OFF))[u] = 0u;
    __syncthreads();
    unsigned* ctl = (unsigned*)(P.ws + WS_CTL);
    const int xl = bx & 7, jx = bx >> 3, perx = C.G / 8;
    const bool inC = jx < NC_PER_XCD;
    const int nC = 8 * NC_PER_XCD, nE = C.G - nC;
    const XcdBarrier bar_all = xcd_barrier_post(ctl + CW_BAR, MISC + 8);
    XcdBarrier bar_c; bar_c.bar = ctl + CW_BAR + XCD_BAR_WORDS; bar_c.x = bar_all.x; bar_c.st = MISC + 10; bar_c.G = (unsigned)nC;
    if (inC && C.tid == 0) (void)xb_add(&bar_c.bar[XB_XCNT(bar_c.x)], 1u);
    XcdBarrier bar_e; bar_e.bar = ctl + CW_BAR + 2 * XCD_BAR_WORDS; bar_e.x = bar_all.x; bar_e.st = MISC + 12; bar_e.G = (unsigned)nE;
    if (!inC && C.tid == 0) (void)xb_add(&bar_e.bar[XB_XCNT(bar_e.x)], 1u);
    Wk Wall; Wall.lv = C.vcu; Wall.n = C.G; Wall.c = bx; Wall.h = 0;
    Wk Wc; Wc.lv = xl * NC_PER_XCD + jx; Wc.n = nC; Wc.c = jx * 8 + xl; Wc.h = 0;
    Wk We; { const int je = jx - NC_PER_XCD, ne = perx - NC_PER_XCD; We.lv = xl * ne + je; We.n = nE; We.c = je * 8 + xl; We.h = 0; }
    phase_prologue(P, C);
    xcd_barrier(bar_all);
#ifdef PROBE_SEL
    unsigned long long tp0 = __builtin_amdgcn_s_memrealtime(), tp1 = 0, tp2 = 0, tp3 = 0, tp4 = 0, tp5 = 0, tpe1 = 0, tpe2 = 0, tpe3 = 0;
#define STAMP(v) v = __builtin_amdgcn_s_memrealtime()
#else
#define STAMP(v)
#endif
    Wall.h = 0; run_C0(P, C, Wall, bar_all); xcd_barrier(bar_all); STAMP(tp1);
    if (inC) { Wc.h = 1; run_C0(P, C, Wc, bar_c); help_E(P, C, 0, 0); } else { We.h = 0; run_E(P, C, We, bar_e, 0); }
    STAMP(tpe1);
#ifdef PROBE_SEL
    if (C.tid == 0) atomicMax(ctl + 80 + (inC ? 0 : 1), (unsigned)(tpe1 - tp1));
#endif
    xcd_barrier(bar_all); STAMP(tp2);
    if (inC) { Wc.h = 0; run_C1(P, C, Wc, bar_c); help_E(P, C, 1, 0); } else { We.h = 1; run_E(P, C, We, bar_e, 0); }
    STAMP(tpe2);
#ifdef PROBE_SEL
    if (C.tid == 0) atomicMax(ctl + 82 + (inC ? 0 : 1), (unsigned)(tpe2 - tp2));
#endif
    xcd_barrier(bar_all); STAMP(tp3);
    if (inC) { Wc.h = 1; run_C1(P, C, Wc, bar_c); help_E(P, C, 0, 1); } else { We.h = 0; run_E(P, C, We, bar_e, 1); }
    STAMP(tpe3);
#ifdef PROBE_SEL
    if (C.tid == 0) atomicMax(ctl + 84 + (inC ? 0 : 1), (unsigned)(tpe3 - tp3));
#endif
    xcd_barrier(bar_all); STAMP(tp4);
    Wall.h = 1; run_E(P, C, Wall, bar_all, 1);
#ifdef PROBE_SEL
    STAMP(tp5);
    { unsigned long long d = 0; const int sel = PROBE_SEL;
      if (sel == 0) d = tp1 - tp0; if (sel == 1) d = tp2 - tp1; if (sel == 2) d = tp3 - tp2; if (sel == 3) d = tp4 - tp3; if (sel == 4) d = tp5 - tp4;
      if (sel == 5 || sel == 8) d = tpe1 - tp1; if (sel == 6 || sel == 9) d = tpe2 - tp2; if (sel == 7 || sel == 10) d = tpe3 - tp3;
      const int who = sel >= 8 ? 8 * NC_PER_XCD : 0;
      if (sel >= 20) { const unsigned* sp = (const unsigned*)(P.ws + WS_CTL) + 128 + 16 * PROBE_HALF; const int i = sel - 20; const int nxt = (i == PROBE_LAST) ? 9 : i + 1; d = (unsigned long long)(__hip_atomic_load(sp + nxt, __ATOMIC_RELAXED, __HIP_MEMORY_SCOPE_AGENT) - __hip_atomic_load(sp + i, __ATOMIC_RELAXED, __HIP_MEMORY_SCOPE_AGENT)); }
      if (sel >= 30) d = 0;
      if (bx == (sel >= 20 ? 0 : who) && C.tid == 0) __hip_atomic_store(ctl + 64, (unsigned)d, __ATOMIC_RELAXED, __HIP_MEMORY_SCOPE_AGENT);
      xcd_barrier(bar_all);
      if (bx == 0 && C.tid == 0) { const unsigned dd = sel >= 30 ? __hip_atomic_load(ctl + 80 + (sel - 30), __ATOMIC_RELAXED, __HIP_MEMORY_SCOPE_AGENT) : __hip_atomic_load(ctl + 64, __ATOMIC_RELAXED, __HIP_MEMORY_SCOPE_AGENT);
        const unsigned long long t0_ = __builtin_amdgcn_s_memrealtime(); while (__builtin_amdgcn_s_memrealtime() - t0_ < 4ull * dd) __builtin_amdgcn_s_sleep(32); } }
#endif
}

extern "C" void kernel_launch(void* const* d_in, const int* in_sizes, int n_in, void* d_out, int out_size, void* d_ws, size_t ws_size, hipStream_t stream) {
    static int grid = 0;
    if (grid == 0) {
        if (n_in != 22 || in_sizes[0] != T * DM || out_size != T * DM || ws_size < WS_END) {
            fprintf(stderr, "kernel_launch: unexpected shapes (n_in %d, in0 %d, out %d, ws %zu); nothing launched\n", n_in, n_in > 0 ? in_sizes[0] : -1, out_size, ws_size); grid = -1; return; }
        int dev = 0, cus = 0;
        if (hipGetDevice(&dev) != hipSuccess || hipDeviceGetAttribute(&cus, hipDeviceAttributeMultiprocessorCount, dev) != hipSuccess) { fprintf(stderr, "kernel_launch: device query failed\n"); grid = -1; return; }
        if (hipFuncSetAttribute((const void*)hybrid_fwd, hipFuncAttributeMaxDynamicSharedMemorySize, LDS_BYTES) != hipSuccess) { fprintf(stderr, "kernel_launch: hipFuncSetAttribute failed\n"); grid = -1; return; }
        (void)hipGetLastError();
        grid = cus;
        if (grid % 8 != 0 || grid / 8 <= NC_PER_XCD) { fprintf(stderr, "kernel_launch: built for a CU count that is a multiple of 8 and > %d; got %d; nothing launched\n", 8 * NC_PER_XCD, grid); grid = -1; return; }
    }
    if (grid < 0) return;
    if (hipMemsetAsync((char*)d_ws + WS_CTL, 0, CTL_ZERO_BYTES, stream) != hipSuccess) { fprintf(stderr, "kernel_launch: memset failed\n"); return; }
    Params p{};
    p.x = (const float*)d_in[0]; p.c = (const float*)d_in[1]; p.positions = (const int*)d_in[2]; p.ada_w = (const float*)d_in[3]; p.ada_b = (const float*)d_in[4];
    p.norm_mix_g = (const float*)d_in[5]; p.norm_ffn_g = (const float*)d_in[6]; p.final_norm_g = (const float*)d_in[7]; p.even_w_in = (const float*)d_in[8]; p.even_w_out = (const float*)d_in[9];
    p.gmlp_ln_g = (const float*)d_in[10]; p.gmlp_ln_b = (const float*)d_in[11]; p.gmlp_w_s = (const float*)d_in[12]; p.gmlp_b_s = (const float*)d_in[13]; p.hgrn_lb_logits = (const float*)d_in[14];
    p.hgrn_norm_g = (const float*)d_in[15]; p.odd_w_qkv = (const float*)d_in[16]; p.odd_w_out = (const float*)d_in[17]; p.peer_w_query = (const float*)d_in[18]; p.peer_sub_keys = (const float*)d_in[19];
    p.peer_down = (const float*)d_in[20]; p.peer_up = (const float*)d_in[21];
    p.out = (float*)d_out; p.ws = (unsigned char*)d_ws;
    p.ph_lo = 0; p.ph_hi = 0;
    hipLaunchKernelGGL(hybrid_fwd, dim3(grid), dim3(NWAVES * 64), LDS_BYTES, stream, p);
    const hipError_t le = hipPeekAtLastError();
    if (le != hipSuccess) fprintf(stderr, "kernel_launch: launch failed: %s\n", hipGetErrorName(le));
}
```

```cpp
#include <hip/hip_runtime.h>
#include <cstdio>
#include <cstdint>
#include <cmath>
namespace pg8 {
#define PG8_LAS __attribute__((address_space(3)))
typedef unsigned short bf16_t;
typedef short bf16x8 __attribute__((ext_vector_type(8)));
typedef float f32x4 __attribute__((ext_vector_type(4)));
typedef unsigned u32x4 __attribute__((ext_vector_type(4)));
constexpr int BM = 256, BK = 64, HALF = 128, HTB = HALF * BK * 2  , STAGE_BYTES = 8 * HTB, NXCD = 8, WGM = 8;

__host__ __device__ __forceinline__ int lds_byte(int r, int c) { const int st = (r >> 4) * 2 + (c >> 5), rr = r & 15, cc = c & 31, ob = rr * 64 + cc * 2; return st * 1024 + (ob ^ (((ob >> 9) & 1) << 5)); }
__host__ __device__ __forceinline__ void stage_rc(int b, int& R, int& C) { const int st = b / 1024, sb = b % 1024, swz = sb ^ (((sb >> 9) & 1) << 5); R = (st >> 1) * 16 + swz / 64; C = (st & 1) * 32 + (swz % 64) / 2; }
__host__ __device__ __forceinline__ int perm32(int rho) { const int n = rho >> 4, i = rho & 15; return 8 * (i >> 2) + 4 * n + (i & 3); }

struct Unit { int pm, pn; };
struct Gemm { const bf16_t* A; const bf16_t* Bt; int M, N, K; };

struct StaticOrder {
    int nM, nN, nwg, G, c;
    __host__ __device__ void init(int M, int N, int G_, int c_) { nM = M / BM; nN = N / BM; nwg = nM * nN; G = G_; c = c_; }
    __host__ __device__ bool next(int i, Unit& u) const {
        const long L = (long)i * G + c; if (L >= nwg) return false;
        int wgid = (int)L; { const int q = nwg / NXCD, r = nwg % NXCD, xcd = wgid % NXCD, off = wgid / NXCD; wgid = (xcd < r ? xcd * (q + 1) : r * (q + 1) + (xcd - r) * q) + off; }
        const int nig = WGM * nN, gid = wgid / nig, fm = gid * WGM, gsz = (nM - fm) < WGM ? (nM - fm) : WGM;
        u.pm = fm + ((wgid % nig) % gsz); u.pn = (wgid % nig) / gsz; return true;
    }
    __device__ __forceinline__ void a_ready(const Unit&) const {}
    __device__ __forceinline__ void done(const Unit&) const {}
};

__device__ __forceinline__ unsigned cvt_pk_bf16(float lo, float hi) { unsigned r; asm volatile("v_cvt_pk_bf16_f32 %0, %1, %2" : "=v"(r) : "v"(lo), "v"(hi)); return r; }
typedef float f32x2 __attribute__((ext_vector_type(2)));
__device__ __forceinline__ f32x2 gelu_pk(f32x2 v) {
    const f32x2 av = __builtin_elementwise_abs(v), d = av * 0.2316418882f + 1.0f;
    f32x2 t; t.x = __builtin_amdgcn_rcpf(d.x); t.y = __builtin_amdgcn_rcpf(d.y);
    f32x2 q = t * 0.5307027145f + (-0.7265760135f); q = q * t + 0.7107068705f; q = q * t + (-0.142248368f); q = q * t + 0.127414796f; q = q * t;
    const f32x2 s = (v * v) * (-0.72134752044f);
    f32x2 e; e.x = __builtin_amdgcn_exp2f(s.x); e.y = __builtin_amdgcn_exp2f(s.y);
    const f32x2 m = v * (q * e), r = v - m;
    f32x2 o; o.x = v.x < 0.f ? m.x : r.x; o.y = v.y < 0.f ? m.y : r.y; return o;
}

template <class Epi, class Sched, bool ALIGN_EPI = false, bool SP2 = false>
__device__ __forceinline__ void gemm_phase(PG8_LAS unsigned char* lds, const Gemm g, const Sched& S, const Epi& E) {
    int tid_ = threadIdx.x; asm volatile("" : "+v"(tid_));
    const int tid = tid_, wid = __builtin_amdgcn_readfirstlane(tid >> 6), lane = tid & 63, wr = wid >> 2, wc = wid & 3, fr = lane & 15, fq = lane >> 4;
    const int K = g.K, nt = K / BK;
    unsigned voffA[2], voffB[2];
#pragma unroll
    for (int i = 0; i < 2; ++i) { int R, C; stage_rc(tid * 16 + i * 8192, R, C); const int Rb = Epi::PERM ? ((R & ~31) + perm32(R & 31)) : R;
        voffA[i] = (unsigned)(R * K + C) * 2u; voffB[i] = (unsigned)(Rb * K + C) * 2u; }
    const size_t kstep = (size_t)(BK * 2);
    const size_t hstep = (size_t)HALF * K * 2;
    const size_t tstep = 2 * hstep;
    const unsigned ldsw = (unsigned)wid * 1024u;
    const int aoff = lds_byte(wr * 64 + fr, fq * 8), boff = lds_byte(wc * 32 + fr, fq * 8);
#define PG8_SA(b, h) (((b) * 2 + (h)) * HTB)
#define PG8_SB(b, h) ((4 + (b) * 2 + (h)) * HTB)
#define PG8_STAGE(bufoff, gbase, voff) do { _Pragma("unroll") for (int _i = 0; _i < 2; ++_i) \
        __builtin_amdgcn_global_load_lds((const unsigned*)((const char*)(gbase) + (voff)[_i]), (PG8_LAS unsigned*)(lds + (bufoff) + ldsw + _i * 8192), 16, 0, 0); } while (0)
#define PG8_LDA(dst, b, h) do { _Pragma("unroll") for (int m = 0; m < 4; ++m) _Pragma("unroll") for (int k = 0; k < 2; ++k) dst[m][k] = *(const PG8_LAS bf16x8*)(lds + PG8_SA(b, h) + aoff + m * 2048 + k * 1024); } while (0)
#define PG8_LDB(dst, b, h) do { _Pragma("unroll") for (int n = 0; n < 2; ++n) _Pragma("unroll") for (int k = 0; k < 2; ++k) dst[n][k] = *(const PG8_LAS bf16x8*)(lds + PG8_SB(b, h) + boff + n * 2048 + k * 1024); } while (0)
#define PG8_MMA(ai, bj, At, Bt) do { __builtin_amdgcn_s_setprio(1); _Pragma("unroll") for (int m = 0; m < 4; ++m) _Pragma("unroll") for (int n = 0; n < 2; ++n) _Pragma("unroll") for (int k = 0; k < 2; ++k) \
        acc[ai][bj][m][n] = __builtin_amdgcn_mfma_f32_16x16x32_bf16(Bt[n][k], At[m][k], acc[ai][bj][m][n], 0, 0, 0); __builtin_amdgcn_s_setprio(0); } while (0)
#define PG8_WAIT_V(n) asm volatile("s_waitcnt vmcnt(" #n ")" ::: "memory")
#define PG8_WAIT_L(n) asm volatile("s_waitcnt lgkmcnt(" #n ")" ::: "memory")
#define PG8_BAR __builtin_amdgcn_s_barrier()
#define PG8_SCHED __builtin_amdgcn_sched_barrier(0)
    Unit cur, nxt; int ui = 0;
    if (!S.next(0, cur)) return;
    f32x4 acc[2][2][4][2];
#pragma unroll
    for (int a = 0; a < 2; ++a)
#pragma unroll
        for (int b = 0; b < 2; ++b)
#pragma unroll
            for (int m = 0; m < 4; ++m)
#pragma unroll
                for (int n = 0; n < 2; ++n) acc[a][b][m][n] = (f32x4){0.f, 0.f, 0.f, 0.f};
    bf16x8 At[4][2], B0[2][2], B1[2][2];
    const char* cA = (const char*)g.A + (size_t)cur.pm * tstep; const char* cB = (const char*)g.Bt + (size_t)cur.pn * tstep;
    S.a_ready(cur);
    if constexpr (SP2) {
        PG8_STAGE(PG8_SB(0, 0), cB, voffB); PG8_STAGE(PG8_SB(0, 1), cB + hstep, voffB); PG8_STAGE(PG8_SA(0, 0), cA, voffA); PG8_STAGE(PG8_SA(0, 1), cA + hstep, voffA);
        if (wr == 1) PG8_BAR;
        PG8_WAIT_V(2); PG8_BAR;
        PG8_STAGE(PG8_SB(1, 0), cB + kstep, voffB); PG8_STAGE(PG8_SA(1, 0), cA + kstep, voffA); PG8_STAGE(PG8_SB(1, 1), cB + hstep + kstep, voffB);
        PG8_WAIT_V(6); PG8_BAR;
    } else {
        PG8_STAGE(PG8_SB(0, 0), cB, voffB); PG8_STAGE(PG8_SA(0, 0), cA, voffA); PG8_STAGE(PG8_SB(0, 1), cB + hstep, voffB); PG8_STAGE(PG8_SA(0, 1), cA + hstep, voffA);
        if (wr == 1) PG8_BAR;
        PG8_WAIT_V(4); PG8_BAR;
        PG8_STAGE(PG8_SB(1, 0), cB + kstep, voffB); PG8_STAGE(PG8_SA(1, 0), cA + kstep, voffA); PG8_STAGE(PG8_SB(1, 1), cB + hstep + kstep, voffB);
        PG8_WAIT_V(6); PG8_BAR;
    }
    for (;;) {
        const bool has_next = S.next(ui + 1, nxt);
        const char* nA = has_next ? (const char*)g.A + (size_t)nxt.pm * tstep : cA; const char* nB = has_next ? (const char*)g.Bt + (size_t)nxt.pn * tstep : cB;
        for (int t = 0; t < nt; t += 2) {
            const bool last = (t == nt - 2);
            const char* a1 = cA + (size_t)(t + 1) * kstep;
            const char* a2 = last ? nA : cA + (size_t)(t + 2) * kstep; const char* b2 = last ? nB : cB + (size_t)(t + 2) * kstep;
            const char* a3 = a2 + kstep; const char* b3 = b2 + kstep;
            if (last && has_next) S.a_ready(nxt);
            if constexpr (SP2) {
            PG8_LDB(B0, 0, 0); PG8_LDB(B1, 0, 1); PG8_SCHED; PG8_LDA(At, 0, 0); PG8_STAGE(PG8_SA(1, 1), a1 + hstep, voffA);
            PG8_WAIT_V(8); PG8_WAIT_L(0); PG8_BAR; PG8_MMA(0, 0, At, B0); PG8_MMA(0, 1, At, B1); PG8_BAR; PG8_SCHED;
            PG8_LDA(At, 0, 1); PG8_STAGE(PG8_SB(0, 0), b2, voffB); PG8_STAGE(PG8_SB(0, 1), b2 + hstep, voffB); PG8_STAGE(PG8_SA(0, 0), a2, voffA);
            PG8_WAIT_V(8); PG8_WAIT_L(0); PG8_BAR; PG8_MMA(1, 0, At, B0); PG8_MMA(1, 1, At, B1); PG8_BAR; PG8_SCHED;
            PG8_LDB(B0, 1, 0); PG8_LDB(B1, 1, 1); PG8_SCHED; PG8_LDA(At, 1, 0); PG8_STAGE(PG8_SA(0, 1), a2 + hstep, voffA);
            PG8_WAIT_V(8); PG8_WAIT_L(0); PG8_BAR; PG8_MMA(0, 0, At, B0); PG8_MMA(0, 1, At, B1); PG8_BAR; PG8_SCHED;
            PG8_LDA(At, 1, 1); PG8_STAGE(PG8_SB(1, 0), b3, voffB); PG8_STAGE(PG8_SB(1, 1), b3 + hstep, voffB); PG8_STAGE(PG8_SA(1, 0), a3, voffA);
            PG8_WAIT_V(8); PG8_WAIT_L(0); PG8_BAR; PG8_MMA(1, 0, At, B0); PG8_MMA(1, 1, At, B1); PG8_BAR; PG8_SCHED;
            } else {
            PG8_LDB(B0, 0, 0); PG8_SCHED; PG8_LDA(At, 0, 0); PG8_STAGE(PG8_SA(1, 1), a1 + hstep, voffA);
            PG8_WAIT_L(8); PG8_BAR; PG8_WAIT_L(0); PG8_MMA(0, 0, At, B0); PG8_BAR; PG8_SCHED;
            PG8_LDB(B1, 0, 1); PG8_STAGE(PG8_SB(0, 0), b2, voffB);
            PG8_BAR; PG8_WAIT_L(0); PG8_MMA(0, 1, At, B1); PG8_BAR;
            PG8_LDA(At, 0, 1); PG8_STAGE(PG8_SA(0, 0), a2, voffA);
            PG8_BAR; PG8_WAIT_L(0); PG8_MMA(1, 0, At, B0); PG8_BAR; PG8_SCHED;
            PG8_STAGE(PG8_SB(0, 1), b2 + hstep, voffB);
            PG8_WAIT_V(6); PG8_BAR; PG8_MMA(1, 1, At, B1); PG8_BAR;
            PG8_LDB(B0, 1, 0); PG8_SCHED; PG8_LDA(At, 1, 0); PG8_STAGE(PG8_SA(0, 1), a2 + hstep, voffA);
            PG8_WAIT_L(8); PG8_BAR; PG8_WAIT_L(0); PG8_MMA(0, 0, At, B0); PG8_BAR; PG8_SCHED;
            PG8_LDB(B1, 1, 1); PG8_STAGE(PG8_SB(1, 0), b3, voffB);
            PG8_BAR; PG8_WAIT_L(0); PG8_MMA(0, 1, At, B1); PG8_BAR;
            PG8_LDA(At, 1, 1); PG8_STAGE(PG8_SA(1, 0), a3, voffA);
            PG8_BAR; PG8_WAIT_L(0); PG8_MMA(1, 0, At, B0); PG8_BAR; PG8_SCHED;
            PG8_STAGE(PG8_SB(1, 1), b3 + hstep, voffB);
            PG8_WAIT_V(6); PG8_BAR; PG8_MMA(1, 1, At, B1); PG8_BAR;
            }
        }
        if constexpr (ALIGN_EPI) { if (wr == 0) PG8_BAR; }
        if constexpr (!Epi::AFTER_DRAIN) { E(acc, cur, wr, wc, fr, fq); S.done(cur); }
        if (!has_next) break;
#pragma unroll
        for (int a = 0; a < 2; ++a)
#pragma unroll
            for (int b = 0; b < 2; ++b)
#pragma unroll
                for (int m = 0; m < 4; ++m)
#pragma unroll
                    for (int n = 0; n < 2; ++n) acc[a][b][m][n] = (f32x4){0.f, 0.f, 0.f, 0.f};
        cur = nxt; cA = nA; cB = nB; ++ui;
        if constexpr (ALIGN_EPI) { if (wr == 1) PG8_BAR; }
    }
    PG8_WAIT_V(0);
    if constexpr (!ALIGN_EPI) { if (wr == 0) PG8_BAR; }
    PG8_BAR;
    if constexpr (Epi::AFTER_DRAIN) { E.fused(acc, cur, wr, wc, fr, fq, lds, wid, lane); S.done(cur); }
#undef PG8_SA
#undef PG8_SB
#undef PG8_STAGE
#undef PG8_LDA
#undef PG8_LDB
#undef PG8_MMA
#undef PG8_WAIT_V
#undef PG8_WAIT_L
#undef PG8_BAR
#undef PG8_SCHED
}
}
#define GAS __attribute__((address_space(1)))
#define LAS __attribute__((address_space(3)))
typedef unsigned short bf16;
typedef unsigned v4u __attribute__((ext_vector_type(4)));
typedef float f32x4 __attribute__((ext_vector_type(4)));
typedef short bf16x8 __attribute__((ext_vector_type(8)));
typedef __bf16 bf16x2_t __attribute__((ext_vector_type(2)));
#define LDS_WAIT() asm volatile("s_waitcnt lgkmcnt(0)" ::: "memory")
#define VM_WAIT() asm volatile("s_waitcnt vmcnt(0)" ::: "memory")
typedef float f32x2_cv __attribute__((ext_vector_type(2)));
__device__ __forceinline__ unsigned pk2(float lo, float hi) { const f32x2_cv v = {lo, hi}; return __builtin_bit_cast(unsigned, __builtin_convertvector(v, bf16x2_t)); }
__device__ __forceinline__ unsigned f2bf(float f) { return pk2(f, 0.f) & 0xffffu; }
__device__ __forceinline__ float bflo(unsigned u) { return __builtin_bit_cast(float, u << 16); }
__device__ __forceinline__ float bfhi(unsigned u) { return __builtin_bit_cast(float, u & 0xffff0000u); }
__device__ __forceinline__ float bf2f(bf16 u) { return __builtin_bit_cast(float, (unsigned)u << 16); }
#define XB_TMO      128
#define XB_XCNT(j)  (256  + 64 * (j))
#define XB_XSUB(j)  (1280 + 64 * (j))
#define XB_XGEN(j)  (2304 + 64 * (j))
#define XB_TOP      3328
#define XB_TOPGEN   3392
#define XCD_BAR_WORDS 3456
#define XB_SPIN_CAP (1u << 18)

__device__ __forceinline__ unsigned xb_ld(unsigned* p)              { return __hip_atomic_load(p, __ATOMIC_RELAXED, __HIP_MEMORY_SCOPE_AGENT); }
__device__ __forceinline__ unsigned xb_add(unsigned* p, unsigned v) { return __hip_atomic_fetch_add(p, v, __ATOMIC_RELAXED, __HIP_MEMORY_SCOPE_AGENT); }
__device__ __forceinline__ unsigned xb_xcc_id() { return (unsigned)__builtin_amdgcn_s_getreg((3 << 11) | 20) & 0xFu; }
#define XB_SPIN(cond, bar) do { unsigned _sp = 0; while (cond) { __builtin_amdgcn_s_sleep(1); \
    if ((++_sp & 255u) == 0u) { if (xb_ld(&(bar)[XB_TMO])) break; if (_sp > XB_SPIN_CAP) { atomicAdd(&(bar)[XB_TMO], 1u); break; } } } } while (0)

struct XcdBarrier {
    unsigned* bar; unsigned x; unsigned G;
    volatile LAS unsigned* st;
};

__device__ __forceinline__ XcdBarrier xcd_barrier_post(unsigned* bar, volatile LAS unsigned* st) {
    XcdBarrier b; b.bar = bar; b.x = xb_xcc_id(); b.st = st; b.G = gridDim.x;
    if (threadIdx.x == 0) (void)xb_add(&bar[XB_XCNT(b.x)], 1u);
    return b;
}
__device__ __forceinline__ void xcd_barrier_complete(unsigned* bar, unsigned x, unsigned& nloc, unsigned& nx, const unsigned G) {
    unsigned sum, cnt, mine, sp = 0u;
    for (;;) {
        sum = 0u; cnt = 0u; mine = 0u;
#pragma unroll
        for (unsigned j = 0; j < 16; ++j) { const unsigned c = xb_ld(&bar[XB_XCNT(j)]); sum += c; cnt += (c > 0u) ? 1u : 0u; mine = (j == x) ? c : mine; }
        if (sum == G) break;
        __builtin_amdgcn_s_sleep(1);
        if ((++sp & 255u) == 0u) { if (xb_ld(&bar[XB_TMO])) break; if (sp > XB_SPIN_CAP) { atomicAdd(&bar[XB_TMO], 1u); break; } }
    }
    nloc = mine > 0u ? mine : 1u; nx = cnt > 0u ? cnt : 1u;
}

__device__ __forceinline__ void xcd_barrier(const XcdBarrier& b) {
    asm volatile("s_waitcnt vmcnt(0)" ::: "memory");
    __syncthreads();
    if (threadIdx.x == 0) {
        unsigned* bar = b.bar;
        __builtin_amdgcn_s_waitcnt(0);
        unsigned nloc = b.st[0], nx = b.st[1];
        if (nloc == 0u) { xcd_barrier_complete(bar, b.x, nloc, nx, b.G); b.st[0] = nloc; b.st[1] = nx; }
        const unsigned old = xb_add(&bar[XB_XSUB(b.x)], 1u);
        const unsigned gen = old / nloc;
        if (old + 1u == (gen + 1u) * nloc) {
            __builtin_amdgcn_fence(__ATOMIC_RELEASE, "agent");
            asm volatile("s_waitcnt vmcnt(0)" ::: "memory");
            const unsigned og = xb_add(&bar[XB_TOP], 1u);
            const unsigned tg = og / nx;
            if (og + 1u == (tg + 1u) * nx) xb_add(&bar[XB_TOPGEN], 1u);
            else XB_SPIN(xb_ld(&bar[XB_TOPGEN]) == tg, bar);
            __builtin_amdgcn_fence(__ATOMIC_ACQUIRE, "agent");
            xb_add(&bar[XB_XGEN(b.x)], 1u);
            asm volatile("s_waitcnt vmcnt(0)" ::: "memory");
        } else {
            XB_SPIN(xb_ld(&bar[XB_XGEN(b.x)]) == gen, bar);
            __builtin_amdgcn_fence(__ATOMIC_ACQUIRE, "agent");
            asm volatile("s_waitcnt vmcnt(0)" ::: "memory");
        }
    }
    __syncthreads();
}

constexpr int NB = 8, SEQ = 8192, DM = 1024, T = NB * SEQ;
constexpr int NWAVES = 8;
constexpr float NORM_EPS = 1e-6f;
constexpr float C2 = 0.125f * 1.4426950408889634f;

constexpr size_t MiB = 1u << 20;
constexpr size_t WS_CTL = 0, CTL_ZERO_BYTES = 1 * MiB;
constexpr size_t WS_MOD = 1 * MiB;
constexpr size_t WS_SKB = 1 * MiB + 512 * 1024;
constexpr size_t WS_WSB = 1 * MiB + 768 * 1024;
constexpr size_t WS_LB  = 1 * MiB + 960 * 1024;
constexpr size_t WS_CS  = 2 * MiB;
constexpr size_t WS_HD  = 6 * MiB;
constexpr size_t WS_WIN = 16 * MiB, WS_WOUT0 = 22 * MiB, WS_WQKV = 24 * MiB, WS_WOUT1 = 30 * MiB, WS_WQ0 = 32 * MiB, WS_WQ1 = 36 * MiB;
constexpr size_t WS_TAB8 = 40 * MiB, TAB8_BYTES = 12 * MiB;
constexpr int TROW = 768;
constexpr size_t WS_SC8 = 8 * MiB;
constexpr size_t WS_H = 108 * MiB;
constexpr size_t WS_IDX = 236 * MiB, WS_GATE = 268 * MiB;
constexpr size_t WS_AR0 = 300 * MiB, AR_BYTES = 352 * MiB;
constexpr size_t AR_PU = 0, AR_PV = 32 * MiB, AR_PQ = 64 * MiB, AR_PI = 96 * MiB, AR_PG = 128 * MiB;
constexpr size_t AR_G = 160 * MiB;
constexpr size_t AR_KVT = 224 * MiB, AR_ST = 288 * MiB;
constexpr size_t AR_QP = 0;
constexpr size_t AR_QK = 0;
constexpr size_t WS_END = WS_AR0 + 2 * AR_BYTES;
constexpr int HT = T / 2;
constexpr int CW_BAR = 4096;

constexpr int LDS_BYTES = 147456;
constexpr int LDSCTL_OFF = LDS_BYTES - 512;
constexpr int MISC_OFF = LDSCTL_OFF;

struct Params {
    const float* x; const float* c; const int* positions; const float* ada_w; const float* ada_b; const float* norm_mix_g; const float* norm_ffn_g; const float* final_norm_g;
    const float* even_w_in; const float* even_w_out; const float* gmlp_ln_g; const float* gmlp_ln_b; const float* gmlp_w_s; const float* gmlp_b_s; const float* hgrn_lb_logits; const float* hgrn_norm_g;
    const float* odd_w_qkv; const float* odd_w_out; const float* peer_w_query; const float* peer_sub_keys; const float* peer_down; const float* peer_up;
    float* out; unsigned char* ws; int ph_lo, ph_hi;
};
struct Ctx { LAS unsigned char* lds; int tid, lane, wave, vcu, G; };
__device__ __forceinline__ Ctx fresh_ctx(const Ctx& C0) { Ctx C = C0; int t_ = threadIdx.x; asm volatile("" : "+v"(t_)); C.tid = t_; C.lane = t_ & 63; C.wave = __builtin_amdgcn_readfirstlane(t_ >> 6); return C; }
struct Wk { int lv, n, c, h; };
#define W_TK0(W) ((W).h * (T / 2))
#define W_BT0(W) ((W).h * (NB / 2))
__device__ __forceinline__ unsigned char* w_ar(const Params& P, const Wk& W) { return P.ws + WS_AR0 + (size_t)W.h * AR_BYTES; }
__device__ __forceinline__ bf16* w_tok16(const Params& P, const Wk& W, size_t off, int pitch) { return (bf16*)(w_ar(P, W) + off) - (size_t)W_TK0(W) * pitch; }
__device__ __forceinline__ float* w_tok32(const Params& P, const Wk& W, size_t off, int pitch) { return (float*)(w_ar(P, W) + off) - (size_t)W_TK0(W) * pitch; }
__device__ __forceinline__ bf16* w_item16(const Params& P, const Wk& W, size_t off) { return (bf16*)(w_ar(P, W) + off) - (size_t)W_BT0(W) * 512 * 16384; }

__device__ __forceinline__ float wave_sum(float v) {
#pragma unroll
    for (int o = 1; o < 64; o <<= 1) v += __shfl_xor(v, o);
    return v;
}
__device__ __forceinline__ float silu_f(float x) { return x * __builtin_amdgcn_rcpf(1.0f + __builtin_amdgcn_exp2f(-1.4426950408889634f * x)); }
__device__ __forceinline__ float sigmoid_f(float x) { return __builtin_amdgcn_rcpf(1.0f + __builtin_amdgcn_exp2f(-1.4426950408889634f * x)); }
__device__ __forceinline__ float gelu_f(float x) { return 0.5f * x * (1.0f + erff(x * 0.70710678118654752f)); }
__device__ __forceinline__ f32x4 mma16(f32x4 acc, const LAS bf16* A, int lda, const LAS bf16* Bt, int ldb, int K, int r, int q4) {
    const LAS bf16* ap = A + r * lda + 8 * q4; const LAS bf16* bp = Bt + r * ldb + 8 * q4;
    for (int k0 = 0; k0 < K; k0 += 32) {
        const bf16x8 a = *(const LAS bf16x8*)(ap + k0); const bf16x8 b = *(const LAS bf16x8*)(bp + k0);
        acc = __builtin_amdgcn_mfma_f32_16x16x32_bf16(a, b, acc, 0, 0, 0);
    }
    return acc;
}

struct EpiBf16P {
    static constexpr bool PERM = true, AFTER_DRAIN = false;
    bf16* O; size_t ldc;
    __device__ __forceinline__ void operator()(const f32x4 (&acc)[2][2][4][2], const pg8::Unit& u, int wr, int wc, int fr, int fq) const {
        const int row0 = u.pm * 256 + wr * 64 + fr, col0 = u.pn * 256 + wc * 32 + 8 * fq;
#pragma unroll
        for (int ai = 0; ai < 2; ++ai)
#pragma unroll
            for (int m = 0; m < 4; ++m) { bf16* rowp = O + (size_t)(row0 + ai * 128 + m * 16) * ldc + col0;
#pragma unroll
                for (int bj = 0; bj < 2; ++bj) { const f32x4 v0 = acc[ai][bj][m][0], v1 = acc[ai][bj][m][1];
                    v4u w; w.x = pg8::cvt_pk_bf16(v0[0], v0[1]); w.y = pg8::cvt_pk_bf16(v0[2], v0[3]); w.z = pg8::cvt_pk_bf16(v1[0], v1[1]); w.w = pg8::cvt_pk_bf16(v1[2], v1[3]);
                    *(v4u*)(rowp + bj * 128) = w; } }
    }
};
#ifndef REP_HG
#define REP_HG 1
#endif
#ifndef REP_TOPK
#define REP_TOPK 1
#endif
#ifndef REP_PRO
#define REP_PRO 1
#endif
#ifndef REP_NORM
#define REP_NORM 1
#endif
#ifndef REP_GEMM2
#define REP_GEMM2 1
#endif
#ifndef REP_GEMM
#define REP_GEMM 1
#endif
#ifndef EXP_REP
#define EXP_REP 1
#endif
#ifndef ATT_REP
#define ATT_REP 1
#endif
#ifndef ABL_ON
#define ABL_ON 4
#endif
struct EpiResid {
    static constexpr bool PERM = true, AFTER_DRAIN = false;
    const float* xin; float* xout; const float* gate; float gsc;
    __device__ __forceinline__ void operator()(const f32x4 (&acc)[2][2][4][2], const pg8::Unit& u, int wr, int wc, int fr, int fq) const {
        const int row0 = u.pm * 256 + wr * 64 + fr, col0 = u.pn * 256 + wc * 32 + 8 * fq;
        const float* gp = gate + (size_t)((u.pm * 256) >> 13) * 6144 + col0;
        f32x4 gv[2][2];
#pragma unroll
        for (int bj = 0; bj < 2; ++bj) { gv[bj][0] = *(const f32x4*)(gp + bj * 128); gv[bj][1] = *(const f32x4*)(gp + bj * 128 + 4); }
#pragma unroll
        for (int ai = 0; ai < 2; ++ai)
#pragma unroll
            for (int m = 0; m < 4; ++m) { const size_t off = (size_t)(row0 + ai * 128 + m * 16) * 1024 + col0;
#pragma unroll
                for (int bj = 0; bj < 2; ++bj) {
                    const f32x4 x0 = *(const f32x4*)(xin + off + bj * 128), x1 = *(const f32x4*)(xin + off + bj * 128 + 4);
                    *(f32x4*)(xout + off + bj * 128) = x0 + gv[bj][0] * acc[ai][bj][m][0] * gsc;
                    *(f32x4*)(xout + off + bj * 128 + 4) = x1 + gv[bj][1] * acc[ai][bj][m][1] * gsc; }
                asm volatile("" ::: "memory"); }
    }
};
struct EpiInProj {
    static constexpr bool PERM = true, AFTER_DRAIN = false;
    bf16* PU; bf16* PV; bf16* PQ; bf16* PI; bf16* PG; float* G; const float* LB;
    __device__ __forceinline__ void operator()(const f32x4 (&acc)[2][2][4][2], const pg8::Unit& u, int wr, int wc, int fr, int fq) const {
        const int type = u.pn >> 1;
        const int row0 = u.pm * 256 + wr * 64 + fr, lc0 = (u.pn & 1) * 256 + wc * 32 + 8 * fq;
        if (type == 3) {
            f32x4 lb[2][2];
#pragma unroll
            for (int bj = 0; bj < 2; ++bj) { lb[bj][0] = *(const f32x4*)(LB + lc0 + bj * 128); lb[bj][1] = *(const f32x4*)(LB + lc0 + bj * 128 + 4); }
#pragma unroll
            for (int ai = 0; ai < 2; ++ai)
#pragma unroll
                for (int m = 0; m < 4; ++m) { float* rowp = G + (size_t)(row0 + ai * 128 + m * 16) * 512 + lc0;
#pragma unroll
                    for (int bj = 0; bj < 2; ++bj)
#pragma unroll
                        for (int n = 0; n < 2; ++n) { const f32x4 v = acc[ai][bj][m][n]; f32x4 o;
#pragma unroll
                            for (int e = 0; e < 4; ++e) { const float l = lb[bj][n][e]; const float f = l + (1.0f - l) * sigmoid_f(v[e]); o[e] = __logf(f); }
                            *(f32x4*)(rowp + bj * 128 + 4 * n) = o; } }
            return;
        }
        bf16* base = type == 0 ? PU : type == 1 ? PV : type == 2 ? PQ : type == 4 ? PI : PG;
#pragma unroll
        for (int ai = 0; ai < 2; ++ai)
#pragma unroll
            for (int m = 0; m < 4; ++m) { bf16* rowp = base + (size_t)(row0 + ai * 128 + m * 16) * 512 + lc0;
#pragma unroll
                for (int bj = 0; bj < 2; ++bj) { f32x4 v0 = acc[ai][bj][m][0], v1 = acc[ai][bj][m][1];
                    if (type <= 1) { pg8::f32x2 a = pg8::gelu_pk((pg8::f32x2){v0[0], v0[1]}), b = pg8::gelu_pk((pg8::f32x2){v0[2], v0[3]}), c = pg8::gelu_pk((pg8::f32x2){v1[0], v1[1]}), d = pg8::gelu_pk((pg8::f32x2){v1[2], v1[3]});
                        v0 = (f32x4){a.x, a.y, b.x, b.y}; v1 = (f32x4){c.x, c.y, d.x, d.y}; }
                    else if (type == 2) {
#pragma unroll
                        for (int e = 0; e < 4; ++e) { v0[e] = silu_f(v0[e]) * 0.08838834764831845f; v1[e] = silu_f(v1[e]) * 0.08838834764831845f; } }
                    else if (type == 5) {
#pragma unroll
                        for (int e = 0; e < 4; ++e) { v0[e] = silu_f(v0[e]); v1[e] = silu_f(v1[e]); } }
                    v4u w; w.x = pg8::cvt_pk_bf16(v0[0], v0[1]); w.y = pg8::cvt_pk_bf16(v0[2], v0[3]); w.z = pg8::cvt_pk_bf16(v1[0], v1[1]); w.w = pg8::cvt_pk_bf16(v1[2], v1[3]);
                    *(v4u*)(rowp + bj * 128) = w; } }
    }
};
struct EpiQKRot {
    static constexpr bool PERM = true, AFTER_DRAIN = false;
    bf16* O; const float* CS;
    __device__ __forceinline__ void operator()(const f32x4 (&acc)[2][2][4][2], const pg8::Unit& u, int wr, int wc, int fr, int fq) const {
        const int row0 = u.pm * 256 + wr * 64 + fr, col0 = u.pn * 256 + wc * 32 + 8 * fq;
        const float sc = u.pn < 4 ? C2 : 1.0f;
        const bool rotw = (wc & 1) == 0 && u.pn < 8;
        const float sgn = fq == 0 ? -1.0f : 1.0f;
#pragma unroll
        for (int ai = 0; ai < 2; ++ai)
#pragma unroll
            for (int m = 0; m < 4; ++m) { const int row = row0 + ai * 128 + m * 16; bf16* rowp = O + (size_t)row * 3072 + col0;
                f32x4 c0 = (f32x4){1.f, 1.f, 1.f, 1.f}, c1 = c0, s0 = (f32x4){0.f, 0.f, 0.f, 0.f}, s1 = s0;
                if (rotw && fq < 2) { const float* cp = CS + (size_t)row * 16; c0 = *(const f32x4*)(cp); c1 = *(const f32x4*)(cp + 4); s0 = *(const f32x4*)(cp + 8) * sgn; s1 = *(const f32x4*)(cp + 12) * sgn; }
#pragma unroll
                for (int bj = 0; bj < 2; ++bj) { f32x4 v0 = acc[ai][bj][m][0], v1 = acc[ai][bj][m][1];
                    if (rotw) { f32x4 p0, p1;
#pragma unroll
                        for (int e = 0; e < 4; ++e) { p0[e] = __shfl_xor(v0[e], 16); p1[e] = __shfl_xor(v1[e], 16); }
                        v0 = v0 * c0 + p0 * s0; v1 = v1 * c1 + p1 * s1; }
                    v0 = v0 * sc; v1 = v1 * sc;
                    v4u w; w.x = pg8::cvt_pk_bf16(v0[0], v0[1]); w.y = pg8::cvt_pk_bf16(v0[2], v0[3]); w.z = pg8::cvt_pk_bf16(v1[0], v1[1]); w.w = pg8::cvt_pk_bf16(v1[2], v1[3]);
                    *(v4u*)(rowp + bj * 128) = w; } }
    }
};

__device__ __forceinline__ void p0_transpose_item(const float* W, int K, int N, bf16* WT, LAS float* scr, int item, int lane) {
    const int nblk = N / 32, kb = item / nblk, nb = item % nblk, k0 = 64 * kb, n0 = 32 * nb;
#pragma unroll 8
    for (int i = 0; i < 32; ++i) { const int kk = 2 * i + (lane >> 5); scr[kk * 33 + (lane & 31)] = W[(size_t)(k0 + kk) * N + n0 + (lane & 31)]; }
    LDS_WAIT(); asm volatile("" ::: "memory");
    const int c = lane & 7;
#pragma unroll
    for (int j = 0; j < 4; ++j) { const int n = (lane >> 3) + 8 * j; const LAS float* s = scr + (8 * c) * 33 + n;
        v4u o; o.x = pk2(s[0 * 33], s[1 * 33]); o.y = pk2(s[2 * 33], s[3 * 33]); o.z = pk2(s[4 * 33], s[5 * 33]); o.w = pk2(s[6 * 33], s[7 * 33]);
        *(GAS v4u*)(WT + (size_t)(n0 + n) * K + k0 + 8 * c) = o; }
    LDS_WAIT(); asm volatile("" ::: "memory");
}
typedef float f32x2 __attribute__((ext_vector_type(2)));
typedef float f32x16v __attribute__((ext_vector_type(16)));
typedef float f32x32v __attribute__((ext_vector_type(32)));
typedef unsigned v6u __attribute__((ext_vector_type(6)));
__device__ __forceinline__ void convert_tables(const Params& P, const Ctx& C) {
    const int gw = C.vcu * NWAVES + C.wave, NGW = C.G * NWAVES, lane = C.lane, hl = lane & 31;
    for (int rp = gw; rp < 2 * 16384; rp += NGW) {
        const int row = 2 * rp + (lane >> 5), tb = row >> 14, e = row & 16383;
        const float* src = ((tb & 1) ? P.peer_up : P.peer_down) + ((size_t)(tb >> 1) * 16384 + e) * 1024 + 32 * hl;
        unsigned char* dst = P.ws + WS_TAB8 + (size_t)tb * TAB8_BYTES + (size_t)e * TROW + 24 * hl;
        f32x16v a, b2; float mx = 0.f;
#pragma unroll
        for (int j = 0; j < 4; ++j) { const f32x4 v = ((const f32x4*)src)[j], w = ((const f32x4*)src)[4 + j];
#pragma unroll
            for (int i = 0; i < 4; ++i) { mx = fmaxf(mx, fmaxf(fabsf(v[i]), fabsf(w[i]))); }
            a[2 * j] = v[0]; b2[2 * j] = v[1]; a[2 * j + 1] = v[2]; b2[2 * j + 1] = v[3]; a[8 + 2 * j] = w[0]; b2[8 + 2 * j] = w[1]; a[8 + 2 * j + 1] = w[2]; b2[8 + 2 * j + 1] = w[3]; }
#pragma unroll
        for (int o = 1; o < 32; o <<= 1) mx = fmaxf(mx, __shfl_xor(mx, o));
        const float sc = mx > 0.f ? 7.0f / mx : 0.f;
        a = a * sc; b2 = b2 * sc;
        const v6u p = __builtin_amdgcn_cvt_scalef32_2xpk16_fp6_f32(a, b2, 1.0f);
        unsigned long long* d8 = (unsigned long long*)dst;
        d8[0] = ((unsigned long long)p[1] << 32) | p[0]; d8[1] = ((unsigned long long)p[3] << 32) | p[2]; d8[2] = ((unsigned long long)p[5] << 32) | p[4];
        if (hl == 0) ((float*)(P.ws + WS_SC8))[row] = mx * (1.0f / 7.0f);
    }
}
__device__ __forceinline__ void phase_prologue(const Params& P, const Ctx& C) {
    float* MOD = (float*)(P.ws + WS_MOD);
    {
        LAS float* cond = (LAS float*)C.lds;
        LAS float* part = (LAS float*)(C.lds + 32768);
        for (int e = C.tid; e < 8192; e += 512) cond[e] = silu_f(P.c[e]);
        __syncthreads();
        for (int item = C.vcu; item < 192; item += C.G) {
            const int l = item / 96, cb = item % 96, col = cb * 64 + C.lane;
            float acc[8];
#pragma unroll
            for (int b = 0; b < 8; ++b) acc[b] = 0.f;
            const float* wp = P.ada_w + ((size_t)l * 1024 + C.wave * 128) * 6144 + col;
#pragma unroll 4
            for (int k = 0; k < 128; ++k) { const float wv = wp[(size_t)k * 6144];
#pragma unroll
                for (int b = 0; b < 8; ++b) acc[b] += cond[b * 1024 + C.wave * 128 + k] * wv; }
#pragma unroll
            for (int b = 0; b < 8; ++b) part[(C.wave * 8 + b) * 64 + C.lane] = acc[b];
            __syncthreads();
            { const int b = C.tid >> 6, ln = C.tid & 63; float s = P.ada_b[l * 6144 + cb * 64 + ln];
#pragma unroll
              for (int w = 0; w < 8; ++w) s += part[(w * 8 + b) * 64 + ln];
              MOD[(size_t)(l * 8 + b) * 6144 + cb * 64 + ln] = s; }
            __syncthreads();
        }
        __syncthreads();
    }
    {
        LAS float* scr = (LAS float*)(C.lds + C.wave * 16384);
        const int gw = C.vcu * NWAVES + C.wave, NGW = C.G * NWAVES;
        for (int it = gw; it < 6144; it += NGW) {
            int r = it;
            if (r < 1536) { p0_transpose_item(P.even_w_in, 1024, 3072, (bf16*)(P.ws + WS_WIN), scr, r, C.lane); continue; } r -= 1536;
            if (r < 512)  { p0_transpose_item(P.even_w_out, 1024, 1024, (bf16*)(P.ws + WS_WOUT0), scr, r, C.lane); continue; } r -= 512;
            if (r < 1536) { p0_transpose_item(P.odd_w_qkv, 1024, 3072, (bf16*)(P.ws + WS_WQKV), scr, r, C.lane); continue; } r -= 1536;
            if (r < 512)  { p0_transpose_item(P.odd_w_out, 1024, 1024, (bf16*)(P.ws + WS_WOUT1), scr, r, C.lane); continue; } r -= 512;
            if (r < 1024) { p0_transpose_item(P.peer_w_query, 1024, 2048, (bf16*)(P.ws + WS_WQ0), scr, r, C.lane); continue; } r -= 1024;
            p0_transpose_item(P.peer_w_query + (size_t)1024 * 2048, 1024, 2048, (bf16*)(P.ws + WS_WQ1), scr, r, C.lane);
        }
    }
    convert_tables(P, C);
    const int NT = C.G * 512, gt = C.vcu * 512 + C.tid;
    { bf16* skb = (bf16*)(P.ws + WS_SKB); for (int i = gt; i < 65536; i += NT) skb[i] = (bf16)f2bf(P.peer_sub_keys[i]); }
    { bf16* wsb = (bf16*)(P.ws + WS_WSB); for (int i = gt; i < 65536; i += NT) { const int t = (i >> 7) & 127, s = i & 127; wsb[i] = (bf16)(s <= t ? f2bf(P.gmlp_w_s[i]) : 0u); } }
    { float* lb = (float*)(P.ws + WS_LB); for (int i = gt; i < 512; i += NT) { const float l0 = P.hgrn_lb_logits[i], l1 = P.hgrn_lb_logits[512 + i]; lb[i] = 1.0f / (1.0f + expf(l1 - l0)); } }
    { float* cs = (float*)(P.ws + WS_CS); for (int i = gt; i < T * 8; i += NT) { const int tok = i >> 3, j = i & 7;
        const float inv = 1.0f / powf(500000.0f, (float)j * 0.125f); const float ang = (float)P.positions[tok] * inv; float sn, cn; sincosf(ang, &sn, &cn);
        cs[(size_t)tok * 16 + j] = cn; cs[(size_t)tok * 16 + 8 + j] = sn; } }
}
__device__ __forceinline__ void norm_row_bf16(const float* xrow, bf16* hrow, const float* g, const float* sh, const float* sc, int lane) {
    const f32x4* xr = (const f32x4*)xrow + lane; f32x4 v[4]; float s = 0.f;
#pragma unroll
    for (int j = 0; j < 4; ++j) { v[j] = xr[64 * j]; s += (v[j][0] * v[j][0] + v[j][1] * v[j][1]) + (v[j][2] * v[j][2] + v[j][3] * v[j][3]); }
    const float rstd = 1.0f / sqrtf(wave_sum(s) * (1.0f / 1024.0f) + NORM_EPS);
    unsigned long long* o8 = (unsigned long long*)hrow + lane;
#pragma unroll
    for (int j = 0; j < 4; ++j) { const f32x4 gg = ((const f32x4*)g)[64 * j + lane], hh = ((const f32x4*)sh)[64 * j + lane], cc = ((const f32x4*)sc)[64 * j + lane];
        const f32x4 y = (v[j] * rstd * gg) * (cc + 1.0f) + hh;
        o8[64 * j] = (unsigned long long)pk2(y[0], y[1]) | ((unsigned long long)pk2(y[2], y[3]) << 32); }
}
__device__ __forceinline__ void phase_norm(const Params& P, const Ctx& C, const Wk& W, const float* xsrc, const float* g, int l, int so) {
    const float* MOD = (const float*)(P.ws + WS_MOD); bf16* H = (bf16*)(P.ws + WS_H);
    const int gw = W.lv * NWAVES + C.wave, NGW = W.n * NWAVES;
    for (int m = W_TK0(W) + gw; m < W_TK0(W) + HT; m += NGW) { const float* mb = MOD + (size_t)(l * 8 + (m >> 13)) * 6144 + so;
        norm_row_bf16(xsrc + (size_t)m * 1024, H + (size_t)m * 1024, g, mb, mb + 1024, C.lane); }
}

__device__ __forceinline__ void gmlp_item(const Params& P, const Ctx& C, const Wk& W, int n, int g) {
    LAS bf16* Wt = (LAS bf16*)C.lds;
    LAS bf16* vT = (LAS bf16*)(C.lds + 34816);
    const bf16* WSB = (const bf16*)(P.ws + WS_WSB); const bf16* PU = w_tok16(P, W, AR_PU, 512); const bf16* PV = w_tok16(P, W, AR_PV, 512); bf16* MIX = (bf16*)(P.ws + WS_H);
    const int tid = C.tid, r = C.lane & 15, q4 = C.lane >> 4;
    for (int ch = tid; ch < 2048; ch += 512) { const int rr = ch >> 4, c8 = (ch & 15) * 8; *(LAS v4u*)(Wt + rr * 136 + c8) = *(const v4u*)(WSB + (size_t)(g * 128 + rr) * 128 + c8); }
    { const int t = tid >> 2, part = tid & 3; const bf16* src = PV + (size_t)(n * 128 + t) * 512 + g * 128 + part * 32;
      float x[32];
#pragma unroll
      for (int j = 0; j < 4; ++j) { const v4u w = *(const v4u*)(src + 8 * j);
#pragma unroll
          for (int e = 0; e < 4; ++e) { x[8 * j + 2 * e] = bflo(w[e]); x[8 * j + 2 * e + 1] = bfhi(w[e]); } }
      float s = 0.f;
#pragma unroll
      for (int j = 0; j < 32; ++j) s += x[j];
      s += __shfl_xor(s, 1); s += __shfl_xor(s, 2);
      const float mean = s * (1.0f / 128.0f); float q = 0.f;
#pragma unroll
      for (int j = 0; j < 32; ++j) { const float d = x[j] - mean; q += d * d; }
      q += __shfl_xor(q, 1); q += __shfl_xor(q, 2);
      const float rstd = 1.0f / sqrtf(q * (1.0f / 128.0f) + NORM_EPS);
      const float* lg = P.gmlp_ln_g + g * 128 + part * 32; const float* lbp = P.gmlp_ln_b + g * 128 + part * 32;
#pragma unroll
      for (int j = 0; j < 32; ++j) vT[(part * 32 + j) * 136 + t] = (bf16)f2bf((x[j] - mean) * rstd * lg[j] + lbp[j]);
    }
    __syncthreads();
    const int t0 = 16 * C.wave; const int Keff = ((t0 + 16 + 31) >> 5) << 5;
    f32x4 acc[8];
#pragma unroll
    for (int ct = 0; ct < 8; ++ct) { acc[ct] = (f32x4){0.f, 0.f, 0.f, 0.f}; acc[ct] = mma16(acc[ct], Wt + t0 * 136, 136, vT + (16 * ct) * 136, 136, Keff, r, q4); }
#pragma unroll
    for (int i = 0; i < 4; ++i) { const int t = t0 + 4 * q4 + i; const float bs = P.gmlp_b_s[g * 128 + t]; const size_t tok = (size_t)n * 128 + t;
#pragma unroll
        for (int ct = 0; ct < 8; ++ct) { const int c = 16 * ct + r; const float u = bf2f(PU[tok * 512 + g * 128 + c]); MIX[tok * 1024 + g * 128 + c] = (bf16)f2bf(u * (acc[ct][i] + bs)); } }
    __syncthreads();
}
__device__ __forceinline__ void hgrn_cumsum16(const float* G, size_t tok0, int hh, int k, int seg, LAS float* tot, float (&g)[16], float (&bb)[16], float& total) {
    const float* gp = G + (tok0 + seg * 16) * 512 + hh * 128 + k;
#pragma unroll
    for (int j = 0; j < 16; ++j) g[j] = gp[(size_t)j * 512];
    float run = 0.f;
#pragma unroll
    for (int j = 0; j < 16; ++j) { run += g[j]; bb[j] = run; }
    tot[seg * 128 + k] = run;
    __syncthreads();
    const float t0 = tot[k], t1 = tot[128 + k], t2 = tot[256 + k], t3 = tot[384 + k];
    const float pre = seg == 0 ? 0.f : seg == 1 ? t0 : seg == 2 ? t0 + t1 : t0 + t1 + t2;
    total = (t0 + t1) + (t2 + t3);
#pragma unroll
    for (int j = 0; j < 16; ++j) bb[j] += pre;
}
__device__ __forceinline__ void hgrn_stage_iT(const bf16* PI, size_t tok0, int hh, LAS bf16* iT, int tid) {
    const int s = tid >> 3, v0 = (tid & 7) * 16; const bf16* src = PI + (tok0 + s) * 512 + hh * 128 + v0;
#pragma unroll
    for (int h2 = 0; h2 < 2; ++h2) { const v4u w = *(const v4u*)(src + 8 * h2);
#pragma unroll
        for (int e = 0; e < 4; ++e) { iT[(v0 + 8 * h2 + 2 * e) * 72 + s] = (bf16)(w[e] & 0xffffu); iT[(v0 + 8 * h2 + 2 * e + 1) * 72 + s] = (bf16)(w[e] >> 16); } }
}
__device__ __forceinline__ void hgrn_local_item(const Params& P, const Ctx& C, const Wk& W, int item) {
    LAS bf16* khT = (LAS bf16*)C.lds;
    LAS bf16* iT = (LAS bf16*)(C.lds + 18432);
    LAS float* tot = (LAS float*)(C.lds + 36864);
    const float* G = w_tok32(P, W, AR_G, 512); const bf16* PI = w_tok16(P, W, AR_PI, 512); bf16* KVT = w_item16(P, W, AR_KVT); float* HD = (float*)(P.ws + WS_HD);
    const int bh = item >> 7, c = item & 127, b = bh >> 2, hh = bh & 3; const size_t tok0 = (size_t)b * SEQ + c * 64;
    const int tid = C.tid, k = tid & 127, seg = tid >> 7, r = C.lane & 15, q4 = C.lane >> 4;
    float g[16], bb[16], total;
    hgrn_cumsum16(G, tok0, hh, k, seg, tot, g, bb, total);
    { unsigned w[8];
#pragma unroll
      for (int j = 0; j < 8; ++j) { const float a0 = -expm1f(g[2 * j]) * __expf(total - bb[2 * j]), a1 = -expm1f(g[2 * j + 1]) * __expf(total - bb[2 * j + 1]); w[j] = pk2(a0, a1); }
      LAS v4u* dst = (LAS v4u*)(khT + k * 72 + seg * 16); dst[0] = (v4u){w[0], w[1], w[2], w[3]}; dst[1] = (v4u){w[4], w[5], w[6], w[7]}; }
    if (seg == 0) HD[(size_t)item * 128 + k] = __expf(total);
    hgrn_stage_iT(PI, tok0, hh, iT, tid);
    __syncthreads();
    const int v0 = 16 * C.wave;
#pragma unroll
    for (int ct = 0; ct < 8; ++ct) { f32x4 acc = (f32x4){0.f, 0.f, 0.f, 0.f}; acc = mma16(acc, iT + v0 * 72, 72, khT + (16 * ct) * 72, 72, 64, r, q4);
#pragma unroll
        for (int i = 0; i < 4; ++i) KVT[((size_t)item * 128 + v0 + 4 * q4 + i) * 128 + 16 * ct + r] = (bf16)f2bf(acc[i]); }
    __syncthreads();
}
__device__ __forceinline__ void phase_hgrn_scan(const Params& P, const Ctx& C, const Wk& W) {
    const bf16* KVT = w_item16(P, W, AR_KVT); bf16* ST = w_item16(P, W, AR_ST); const float* HD = (const float*)(P.ws + WS_HD);
    for (int task = W.lv * 256 + C.tid; C.tid < 256 && task < 32768; task += W.n * 256) {
        const int bh = W_BT0(W) * 4 + (task >> 11), v = (task >> 4) & 127, kb = task & 15;
        float st[8];
#pragma unroll
        for (int e = 0; e < 8; ++e) st[e] = 0.f;
#pragma unroll 4
        for (int c = 0; c < 128; ++c) { const size_t item = (size_t)bh * 128 + c, off = (item * 128 + v) * 128 + kb * 8;
            const v4u kv = *(const v4u*)(KVT + off); const f32x4 d0 = *(const f32x4*)(HD + item * 128 + kb * 8), d1 = *(const f32x4*)(HD + item * 128 + kb * 8 + 4);
            v4u o; o.x = pk2(st[0], st[1]); o.y = pk2(st[2], st[3]); o.z = pk2(st[4], st[5]); o.w = pk2(st[6], st[7]);
            *(v4u*)(ST + off) = o;
#pragma unroll
            for (int e = 0; e < 4; ++e) { st[2 * e] = (e < 2 ? d0[2 * e] : d1[2 * e - 4]) * st[2 * e] + bflo(kv[e]); st[2 * e + 1] = (e < 2 ? d0[2 * e + 1] : d1[2 * e - 3]) * st[2 * e + 1] + bfhi(kv[e]); }
        }
    }
}
__device__ __forceinline__ void hgrn_out_item(const Params& P, const Ctx& C, const Wk& W, int item) {
    LAS bf16* qt = (LAS bf16*)C.lds;
    LAS bf16* kt = (LAS bf16*)(C.lds + 17408);
    LAS bf16* iT = (LAS bf16*)(C.lds + 34816);
    LAS bf16* A1 = (LAS bf16*)(C.lds + 53248);
    LAS bf16* STl = (LAS bf16*)(C.lds + 62464);
    LAS float* ol = (LAS float*)(C.lds + 97280);
    LAS float* tot = (LAS float*)(C.lds + 131072);
    const float* G = w_tok32(P, W, AR_G, 512); const bf16* PQ = w_tok16(P, W, AR_PQ, 512); const bf16* PI = w_tok16(P, W, AR_PI, 512); const bf16* PG = w_tok16(P, W, AR_PG, 512);
    const bf16* ST = w_item16(P, W, AR_ST); bf16* MIX = (bf16*)(P.ws + WS_H);
    const int bh = item >> 7, c = item & 127, b = bh >> 2, hh = bh & 3; const size_t tok0 = (size_t)b * SEQ + c * 64;
    const int tid = C.tid, k = tid & 127, seg = tid >> 7, r = C.lane & 15, q4 = C.lane >> 4;
    float g[16], bb[16], total;
    hgrn_cumsum16(G, tok0, hh, k, seg, tot, g, bb, total);
#pragma unroll
    for (int j = 0; j < 16; ++j) { const int t = seg * 16 + j; const float qv = bf2f(PQ[(tok0 + t) * 512 + hh * 128 + k]);
        qt[t * 136 + k] = (bf16)f2bf(qv * __expf(bb[j])); kt[t * 136 + k] = (bf16)f2bf(-expm1f(g[j]) * __expf(-bb[j])); }
    hgrn_stage_iT(PI, tok0, hh, iT, tid);
    for (int ch = tid; ch < 2048; ch += 512) { const int rr = ch >> 4, c8 = (ch & 15) * 8; *(LAS v4u*)(STl + rr * 136 + c8) = *(const v4u*)(ST + ((size_t)item * 128 + rr) * 128 + c8); }
    __syncthreads();
    { const int rt = C.wave >> 1;
#pragma unroll
      for (int cc = 0; cc < 2; ++cc) { const int ct = (C.wave & 1) * 2 + cc; f32x4 acc = (f32x4){0.f, 0.f, 0.f, 0.f};
          acc = mma16(acc, qt + (16 * rt) * 136, 136, kt + (16 * ct) * 136, 136, 128, r, q4);
#pragma unroll
          for (int i = 0; i < 4; ++i) { const int t = 16 * rt + 4 * q4 + i, s = 16 * ct + r; A1[t * 72 + s] = (bf16)(s <= t ? f2bf(acc[i]) : 0u); } } }
    __syncthreads();
    { const int rt = C.wave >> 1;
#pragma unroll
      for (int cc = 0; cc < 4; ++cc) { const int ct = (C.wave & 1) * 4 + cc; f32x4 acc = (f32x4){0.f, 0.f, 0.f, 0.f};
          acc = mma16(acc, A1 + (16 * rt) * 72, 72, iT + (16 * ct) * 72, 72, 64, r, q4);
          acc = mma16(acc, qt + (16 * rt) * 136, 136, STl + (16 * ct) * 136, 136, 128, r, q4);
#pragma unroll
          for (int i = 0; i < 4; ++i) ol[(16 * rt + 4 * q4 + i) * 132 + 16 * ct + r] = acc[i]; } }
    __syncthreads();
    { const int t = tid >> 3, v0 = (tid & 7) * 16; float o[16]; float ss = 0.f;
#pragma unroll
      for (int e = 0; e < 16; ++e) { o[e] = ol[t * 132 + v0 + e]; ss += o[e] * o[e]; }
      ss += __shfl_xor(ss, 1); ss += __shfl_xor(ss, 2); ss += __shfl_xor(ss, 4);
      const float rstd = 1.0f / sqrtf(ss * (1.0f / 128.0f) + NORM_EPS);
      const float* ng = P.hgrn_norm_g + hh * 128 + v0; const bf16* gp = PG + (tok0 + t) * 512 + hh * 128 + v0;
      const v4u g0 = *(const v4u*)gp, g1 = *(const v4u*)(gp + 8); unsigned w[8];
#pragma unroll
      for (int e = 0; e < 4; ++e) { w[e] = pk2(o[2 * e] * rstd * ng[2 * e] * bflo(g0[e]), o[2 * e + 1] * rstd * ng[2 * e + 1] * bfhi(g0[e]));
                                    w[4 + e] = pk2(o[8 + 2 * e] * rstd * ng[8 + 2 * e] * bflo(g1[e]), o[9 + 2 * e] * rstd * ng[9 + 2 * e] * bfhi(g1[e])); }
      v4u* dst = (v4u*)(MIX + (tok0 + t) * 1024 + 512 + hh * 128 + v0); dst[0] = (v4u){w[0], w[1], w[2], w[3]}; dst[1] = (v4u){w[4], w[5], w[6], w[7]}; }
    __syncthreads();
}

typedef short v4i16_t __attribute__((ext_vector_type(4)));
constexpr int AT_VP = 144;
constexpr int AT_QI = 512;
constexpr int AT_STO = 0, AT_STML = AT_QI * 128, AT_VW = AT_STML + AT_QI * 8;
__device__ __forceinline__ void attn_softmax_block(f32x4 (&sa)[9], int tile0, int qq, int mq0, int q4, float& mx, float& ls, bf16x8 (&pf)[5]) {
    mx = -1e30f;
#pragma unroll
    for (int t = 0; t < 9; ++t)
#pragma unroll
        for (int i = 0; i < 4; ++i) { const int kap = 16 * (tile0 + t) + 4 * q4 + i; const bool ok = kap >= qq && kap <= qq + 128 && (mq0 - 128 + kap) >= 0;
            sa[t][i] = ok ? sa[t][i] : -1e30f; mx = fmaxf(mx, sa[t][i]); }
    mx = fmaxf(mx, __shfl_xor(mx, 16)); mx = fmaxf(mx, __shfl_xor(mx, 32));
    ls = 0.f;
#pragma unroll
    for (int t = 0; t < 9; ++t)
#pragma unroll
        for (int i = 0; i < 4; ++i) { const float pv = sa[t][i] > -1e29f ? __builtin_amdgcn_exp2f(sa[t][i] - mx) : 0.f; sa[t][i] = pv; ls += pv; }
    ls += __shfl_xor(ls, 16); ls += __shfl_xor(ls, 32);
#pragma unroll
    for (int s2 = 0; s2 < 5; ++s2) { const int tl = 2 * s2 - tile0, th = 2 * s2 + 1 - tile0;
        const f32x4 lo = (tl >= 0 && tl < 9) ? sa[(tl >= 0 && tl < 9) ? tl : 0] : (f32x4){0.f, 0.f, 0.f, 0.f}, hi = (th >= 0 && th < 9) ? sa[(th >= 0 && th < 9) ? th : 0] : (f32x4){0.f, 0.f, 0.f, 0.f};
        v4u w; w.x = pk2(lo[0], lo[1]); w.y = pk2(lo[2], lo[3]); w.z = pk2(hi[0], hi[1]); w.w = pk2(hi[2], hi[3]); pf[s2] = __builtin_bit_cast(bf16x8, w); }
}
__device__ __forceinline__ void attn_merge(int g, LAS unsigned char* lds, int qloc, int q4, f32x4 (&oa)[4], float mx, float ls, bf16* orow) {
    LAS unsigned char* so = lds + AT_STO + qloc * 128 + 8 * q4; LAS float* sml = (LAS float*)(lds + AT_STML) + 2 * qloc;
    float mo = mx, lo2 = ls;
    if (g > 0) { const float m_old = sml[0], l_old = sml[1]; const float M = fmaxf(m_old, mx); const float fo = __builtin_amdgcn_exp2f(m_old - M), fn = __builtin_amdgcn_exp2f(mx - M);
#pragma unroll
        for (int dt = 0; dt < 4; ++dt) { const unsigned long long w = *(const LAS unsigned long long*)(so + 32 * dt); const unsigned w0 = (unsigned)w, w1 = (unsigned)(w >> 32);
            oa[dt] = oa[dt] * fn + (f32x4){bflo(w0), bfhi(w0), bflo(w1), bfhi(w1)} * fo; }
        mo = M; lo2 = ls * fn + l_old * fo; }
    if (g < 2) {
#pragma unroll
        for (int dt = 0; dt < 4; ++dt) *(LAS unsigned long long*)(so + 32 * dt) = (unsigned long long)pk2(oa[dt][0], oa[dt][1]) | ((unsigned long long)pk2(oa[dt][2], oa[dt][3]) << 32);
        if (q4 == 0) { sml[0] = mo; sml[1] = lo2; }
    } else { const float inv = 1.0f / lo2;
#pragma unroll
        for (int dt = 0; dt < 4; ++dt) { const f32x4 v = oa[dt] * inv; *(unsigned long long*)(orow + 16 * dt) = (unsigned long long)pk2(v[0], v[1]) | ((unsigned long long)pk2(v[2], v[3]) << 32); } }
}
__device__ __forceinline__ void attn_item(const Params& P, const Ctx& C, const Wk& W, int b, int hd, int qt) {
    LAS unsigned char* Vw = C.lds + AT_VW + C.wave * (64 * AT_VP);
    const bf16* QKV = w_tok16(P, W, AR_QK, 3072); bf16* O = (bf16*)(P.ws + WS_H);
    const int lane = C.lane, r = lane & 15, q4 = lane >> 4;
    const int t0 = qt * AT_QI; const size_t rowbase = (size_t)b * SEQ;
    const bf16* Kb = QKV + rowbase * 3072 + 1024 + hd * 64; const bf16* Vb = QKV + rowbase * 3072 + 2048 + hd * 64;
#pragma unroll 1
    for (int g = 0; g < 3; ++g) {
        const int dsh = 4 - 2 * g, d = 1 << dsh;
#pragma unroll 1
        for (int uu = 0; uu < 2; ++uu) {
            const int u = C.wave + 8 * uu;
            const int c = u & (d - 1), j = u >> dsh;
            const int mq0 = (t0 >> dsh) + 32 * j;
            const int ql0 = c + d * (32 * j + r), ql1 = ql0 + 16 * d;
            const bf16* qp0 = QKV + (rowbase + t0 + ql0) * 3072 + hd * 64 + 8 * q4; const bf16* qp1 = QKV + (rowbase + t0 + ql1) * 3072 + hd * 64 + 8 * q4;
            const bf16x8 bq00 = *(const bf16x8*)qp0, bq01 = *(const bf16x8*)(qp0 + 32), bq10 = *(const bf16x8*)qp1, bq11 = *(const bf16x8*)(qp1 + 32);
            bf16x8 ka[10][2];
#pragma unroll
            for (int t = 0; t < 10; ++t) { int mk = mq0 - 128 + 16 * t + r; mk = mk < 0 ? 0 : mk;
                const bf16* kp = Kb + (size_t)(c + d * mk) * 3072 + 8 * q4; ka[t][0] = *(const bf16x8*)kp; ka[t][1] = *(const bf16x8*)(kp + 32); }
            v4u vr[2][8];
#pragma unroll
            for (int it = 0; it < 8; ++it) { const int kap = 8 * it + (lane >> 3); int mk = mq0 - 128 + kap; mk = mk < 0 ? 0 : mk;
                vr[0][it] = *(const v4u*)(Vb + (size_t)(c + d * mk) * 3072 + (lane & 7) * 8); }
            __builtin_amdgcn_sched_barrier(0);
            bf16x8 pf0[5], pf1[5]; float mx0, ls0, mx1, ls1;
            { f32x4 sa[9];
#pragma unroll
              for (int t = 0; t < 9; ++t) { sa[t] = (f32x4){0.f, 0.f, 0.f, 0.f}; sa[t] = __builtin_amdgcn_mfma_f32_16x16x32_bf16(ka[t][0], bq00, sa[t], 0, 0, 0); sa[t] = __builtin_amdgcn_mfma_f32_16x16x32_bf16(ka[t][1], bq01, sa[t], 0, 0, 0); }
              attn_softmax_block(sa, 0, r, mq0, q4, mx0, ls0, pf0); }
            { f32x4 sa[9];
#pragma unroll
              for (int t = 0; t < 9; ++t) { sa[t] = (f32x4){0.f, 0.f, 0.f, 0.f}; sa[t] = __builtin_amdgcn_mfma_f32_16x16x32_bf16(ka[t + 1][0], bq10, sa[t], 0, 0, 0); sa[t] = __builtin_amdgcn_mfma_f32_16x16x32_bf16(ka[t + 1][1], bq11, sa[t], 0, 0, 0); }
              __builtin_amdgcn_sched_barrier(0);
#pragma unroll
              for (int it = 0; it < 8; ++it) { const int kap = 64 + 8 * it + (lane >> 3); int mk = mq0 - 128 + kap; mk = mk < 0 ? 0 : mk;
                  vr[1][it] = *(const v4u*)(Vb + (size_t)(c + d * mk) * 3072 + (lane & 7) * 8); }
              __builtin_amdgcn_sched_barrier(0);
              attn_softmax_block(sa, 1, 16 + r, mq0, q4, mx1, ls1, pf1); }
            v4u vr2[4];
#pragma unroll
            for (int it = 0; it < 4; ++it) { const int kap = 128 + 8 * it + (lane >> 3); const int mk = mq0 - 128 + kap;
                vr2[it] = *(const v4u*)(Vb + (size_t)(c + d * mk) * 3072 + (lane & 7) * 8); }
            f32x4 oa0[4], oa1[4];
#pragma unroll
            for (int dt = 0; dt < 4; ++dt) { oa0[dt] = (f32x4){0.f, 0.f, 0.f, 0.f}; oa1[dt] = (f32x4){0.f, 0.f, 0.f, 0.f}; }
#pragma unroll
            for (int ch = 0; ch < 3; ++ch) {
#pragma unroll
                for (int it = 0; it < 8; ++it) { const int row = 8 * it + (lane >> 3);
                    if (ch < 2) *(LAS v4u*)(Vw + row * AT_VP + (lane & 7) * 16) = vr[ch < 2 ? ch : 0][it];
                    else if (it < 4) *(LAS v4u*)(Vw + row * AT_VP + (lane & 7) * 16) = vr2[it < 4 ? it : 0]; }
                asm volatile("s_waitcnt lgkmcnt(0)" ::: "memory");
#pragma unroll
                for (int s2 = 0; s2 < 2; ++s2) { const int sx = 2 * ch + s2; if (sx < 5) {
#pragma unroll
                    for (int dt = 0; dt < 4; ++dt) {
                        const LAS unsigned char* vp = Vw + (32 * s2 + 4 * q4 + (r >> 2)) * AT_VP + dt * 32 + (r & 3) * 8;
                        const v4i16_t x = __builtin_amdgcn_ds_read_tr16_b64_v4i16((LAS v4i16_t*)vp), y = __builtin_amdgcn_ds_read_tr16_b64_v4i16((LAS v4i16_t*)(vp + 16 * AT_VP));
                        const bf16x8 av = (bf16x8){x[0], x[1], x[2], x[3], y[0], y[1], y[2], y[3]};
                        oa0[dt] = __builtin_amdgcn_mfma_f32_16x16x32_bf16(av, pf0[sx], oa0[dt], 0, 0, 0);
                        oa1[dt] = __builtin_amdgcn_mfma_f32_16x16x32_bf16(av, pf1[sx], oa1[dt], 0, 0, 0); } } }
                asm volatile("s_waitcnt lgkmcnt(0)" ::: "memory");
            }
            attn_merge(g, C.lds, ql0, q4, oa0, mx0, ls0, O + (rowbase + t0 + ql0) * 1024 + hd * 64 + 4 * q4);
            attn_merge(g, C.lds, ql1, q4, oa1, mx1, ls1, O + (rowbase + t0 + ql1) * 1024 + hd * 64 + 4 * q4);
        }
        __syncthreads();
    }
}

__device__ __forceinline__ unsigned ordf(float s) { const unsigned u = __builtin_bit_cast(unsigned, s); return u ^ ((unsigned)((int)u >> 31) | 0x80000000u); }
__device__ __forceinline__ float unordf(unsigned v) { return __builtin_bit_cast(float, v ^ ((unsigned)((int)(~v) >> 31) | 0x80000000u)); }
__device__ __forceinline__ void ins16(unsigned (&top)[16], unsigned x) {
#pragma unroll
    for (int j = 0; j < 16; ++j) { const unsigned hi = top[j] > x ? top[j] : x; x = top[j] > x ? x : top[j]; top[j] = hi; }
}
#define CE_D(a, b) { const unsigned hi_ = (a) > (b) ? (a) : (b), lo_ = (a) > (b) ? (b) : (a); (a) = hi_; (b) = lo_; }
__device__ __forceinline__ void sort16_desc(unsigned (&v)[16]) {
#pragma unroll
    for (int k = 2; k <= 16; k <<= 1)
#pragma unroll
        for (int j = k >> 1; j > 0; j >>= 1)
#pragma unroll
            for (int i = 0; i < 16; ++i) { const int l = i ^ j; if (l > i) { if ((i & k) == 0) CE_D(v[i], v[l]) else CE_D(v[l], v[i]) } }
}
__device__ __forceinline__ void bitonic_merge16_desc(unsigned (&c)[16]) {
#pragma unroll
    for (int st = 8; st >= 1; st >>= 1)
#pragma unroll
        for (int j = 0; j < 16; ++j) if ((j & st) == 0) CE_D(c[j], c[j + st])
}
__device__ __forceinline__ void top16_of_two(unsigned (&a)[16], const unsigned (&b)[16]) {
#pragma unroll
    for (int j = 0; j < 16; ++j) a[j] = a[j] > b[15 - j] ? a[j] : b[15 - j];
    bitonic_merge16_desc(a);
}
__device__ __forceinline__ void merge16(unsigned (&top)[16], int mask) {
    unsigned o[16];
#pragma unroll
    for (int j = 0; j < 16; ++j) o[j] = (unsigned)__shfl_xor((int)top[j], mask);
    top16_of_two(top, o);
}
__device__ __forceinline__ void phase_peer_topk(const Params& P, const Ctx& C, const Wk& W, int layer) {
    LAS bf16* SK = (LAS bf16*)C.lds;
    const bf16* SKB = (const bf16*)(P.ws + WS_SKB) + (size_t)layer * 32768; const bf16* QP = w_tok16(P, W, AR_QP, 2048);
    int* IDX = (int*)(P.ws + WS_IDX); float* GATE = (float*)(P.ws + WS_GATE);
    for (int ch = C.tid; ch < 4096; ch += 512) { const int rr = ch >> 4, c8 = (ch & 15) * 8; *(LAS v4u*)(SK + rr * 136 + c8) = *(const v4u*)(SKB + (size_t)rr * 128 + c8); }
    __syncthreads();
    const int r = C.lane & 15, q4 = C.lane >> 4;
    const int gw = W.lv * NWAVES + C.wave, NGW = W.n * NWAVES;
    for (int grp = W_TK0(W) / 2 + gw; grp < W_TK0(W) / 2 + HT * 8 / 16; grp += NGW) {
        const size_t task = (size_t)grp * 16 + r;
        unsigned lst[2][16];
#pragma unroll
        for (int half = 0; half < 2; ++half) {
            bf16x8 bq[4];
#pragma unroll
            for (int ks = 0; ks < 4; ++ks) bq[ks] = *(const bf16x8*)(QP + task * 256 + half * 128 + ks * 32 + 8 * q4);
            unsigned ka[16], kb[16];
#pragma unroll
            for (int nt = 0; nt < 8; ++nt) { f32x4 acc = (f32x4){0.f, 0.f, 0.f, 0.f};
#pragma unroll
                for (int ks = 0; ks < 4; ++ks) { const bf16x8 a = *(const LAS bf16x8*)(SK + (half * 128 + 16 * nt + r) * 136 + ks * 32 + 8 * q4); acc = __builtin_amdgcn_mfma_f32_16x16x32_bf16(a, bq[ks], acc, 0, 0, 0); }
#pragma unroll
                for (int i = 0; i < 4; ++i) { const unsigned n = 16 * nt + 4 * q4 + i; const unsigned key = (ordf(acc[i]) & ~127u) | (127u - n); if (nt < 4) ka[4 * nt + i] = key; else kb[4 * (nt - 4) + i] = key; }
                if (nt == 3) sort16_desc(ka);
                __builtin_amdgcn_sched_barrier(0); }
            sort16_desc(kb); top16_of_two(ka, kb);
            merge16(ka, 16); merge16(ka, 32);
#pragma unroll
            for (int j = 0; j < 16; ++j) lst[half][j] = ka[j];
        }
        float v2[16]; unsigned e2[16];
#pragma unroll
        for (int j = 0; j < 16; ++j) { v2[j] = unordf(lst[1][j] & ~127u); e2[j] = 127u - (lst[1][j] & 127u); }
        float v1s[4]; unsigned e1s[4];
#pragma unroll
        for (int k = 0; k < 4; ++k) { const unsigned w = q4 == 0 ? lst[0][4 * k] : q4 == 1 ? lst[0][4 * k + 1] : q4 == 2 ? lst[0][4 * k + 2] : lst[0][4 * k + 3];
            v1s[k] = unordf(w & ~127u); e1s[k] = (127u - (w & 127u)) << 7; }
        unsigned top[16];
#pragma unroll
        for (int j = 0; j < 16; ++j) top[j] = (ordf(v1s[0] + v2[j]) & ~16383u) | e1s[0] | e2[j];
        sort16_desc(top);
#pragma unroll
        for (int j = 0; j < 3; ++j) ins16(top, (ordf(v1s[1] + v2[j]) & ~16383u) | e1s[1] | e2[j]);
        ins16(top, (ordf(v1s[2] + v2[0]) & ~16383u) | e1s[2] | e2[0]);
        ins16(top, (ordf(v1s[3] + v2[0]) & ~16383u) | e1s[3] | e2[0]);
        merge16(top, 16); merge16(top, 32);
        float ev[16]; float den = 0.f; const float mx = unordf(top[0] & ~16383u);
#pragma unroll
        for (int j = 0; j < 16; ++j) { ev[j] = __expf(unordf(top[j] & ~16383u) - mx); den += ev[j]; }
        const float inv = 1.0f / den;
        int* ip = IDX + task * 16; float* gp = GATE + task * 16;
        if (q4 == 0) { *(v4u*)(ip) = (v4u){top[0] & 16383u, top[1] & 16383u, top[2] & 16383u, top[3] & 16383u}; *(f32x4*)(gp) = (f32x4){ev[0] * inv, ev[1] * inv, ev[2] * inv, ev[3] * inv}; }
        else if (q4 == 1) { *(v4u*)(ip + 4) = (v4u){top[4] & 16383u, top[5] & 16383u, top[6] & 16383u, top[7] & 16383u}; *(f32x4*)(gp + 4) = (f32x4){ev[4] * inv, ev[5] * inv, ev[6] * inv, ev[7] * inv}; }
        else if (q4 == 2) { *(v4u*)(ip + 8) = (v4u){top[8] & 16383u, top[9] & 16383u, top[10] & 16383u, top[11] & 16383u}; *(f32x4*)(gp + 8) = (f32x4){ev[8] * inv, ev[9] * inv, ev[10] * inv, ev[11] * inv}; }
        else { *(v4u*)(ip + 12) = (v4u){top[12] & 16383u, top[13] & 16383u, top[14] & 16383u, top[15] & 16383u}; *(f32x4*)(gp + 12) = (f32x4){ev[12] * inv, ev[13] * inv, ev[14] * inv, ev[15] * inv}; }
    }
}
struct ExpRow { v4u d[3], u[3]; float ds, us, gk; };
__device__ __forceinline__ void exp_issue(ExpRow& R, const unsigned char* TD, const unsigned char* TU, const float* SD, int ex, float gk, int jl) {
    const unsigned char* dr = TD + (size_t)ex * TROW + 48 * jl; const unsigned char* ur = TU + (size_t)ex * TROW + 48 * jl;
#pragma unroll
    for (int c = 0; c < 3; ++c) R.d[c] = *(const v4u*)(dr + 16 * c);
#pragma unroll
    for (int c = 0; c < 3; ++c) R.u[c] = *(const v4u*)(ur + 16 * c);
    R.ds = SD[ex]; R.us = SD[16384 + ex]; R.gk = gk;
}
__device__ __forceinline__ void exp_consume(const ExpRow& R, const unsigned (&hp)[32], f32x2 (&oacc)[32]) {
    f32x2 a2 = (f32x2){0.f, 0.f};
#pragma unroll
    for (int gsel = 0; gsel < 2; ++gsel) {
        const v6u pk = gsel == 0 ? (v6u){R.d[0].x, R.d[0].y, R.d[0].z, R.d[0].w, R.d[1].x, R.d[1].y} : (v6u){R.d[1].z, R.d[1].w, R.d[2].x, R.d[2].y, R.d[2].z, R.d[2].w};
        const f32x32v f = __builtin_amdgcn_cvt_scalef32_pk32_f32_fp6(pk, 1.0f);
#pragma unroll
        for (int p = 0; p < 16; ++p) { unsigned h0 = hp[16 * gsel + p]; asm volatile("" : "+v"(h0));
            a2 = a2 + (f32x2){f[2 * p], f[2 * p + 1]} * (f32x2){bflo(h0), bfhi(h0)}; } }
    float a = (a2.x + a2.y) * R.ds;
    a += __shfl_xor(a, 1); a += __shfl_xor(a, 2); a += __shfl_xor(a, 4); a += __shfl_xor(a, 8);
    const float wk = R.gk * gelu_f(a) * R.us; const f32x2 wk2 = (f32x2){wk, wk};
#pragma unroll
    for (int gsel = 0; gsel < 2; ++gsel) {
        const v6u pk = gsel == 0 ? (v6u){R.u[0].x, R.u[0].y, R.u[0].z, R.u[0].w, R.u[1].x, R.u[1].y} : (v6u){R.u[1].z, R.u[1].w, R.u[2].x, R.u[2].y, R.u[2].z, R.u[2].w};
        const f32x32v f = __builtin_amdgcn_cvt_scalef32_pk32_f32_fp6(pk, 1.0f);
#pragma unroll
        for (int p = 0; p < 16; ++p) oacc[16 * gsel + p] = oacc[16 * gsel + p] + wk2 * (f32x2){f[2 * p], f[2 * p + 1]}; }
}
__device__ __forceinline__ void phase_peer_experts(const Params& P, const Ctx& Cin, const Wk& W, int layer, bool last) {
    const Ctx C = fresh_ctx(Cin);
    const unsigned char* TD = P.ws + WS_TAB8 + (size_t)(2 * layer) * TAB8_BYTES; const unsigned char* TU = P.ws + WS_TAB8 + (size_t)(2 * layer + 1) * TAB8_BYTES; const float* SD = (const float*)(P.ws + WS_SC8) + (size_t)(2 * layer) * 16384; bf16* H = (bf16*)(P.ws + WS_H);
    const int* IDX = (const int*)(P.ws + WS_IDX); const float* GATE = (const float*)(P.ws + WS_GATE); const float* MOD = (const float*)(P.ws + WS_MOD);
    const int lane = C.lane, grp = lane >> 4, jl = lane & 15;
    unsigned* ticket = (unsigned*)(P.ws + WS_CTL) + 96 + 2 * layer + W.h;
    const bool dyn = W.n != C.G;
    const int gws = W.lv * NWAVES + C.wave, NGWS = W.n * NWAVES;
    int tnext = gws; if (dyn) { if (lane == 0) tnext = (int)atomicAdd(ticket, 1u); tnext = __builtin_amdgcn_readfirstlane(tnext); }
    while (tnext < HT) {
        const int tok = W_TK0(W) + tnext;
        if (dyn) { int tn = 0; if (lane == 0) tn = (int)atomicAdd(ticket, 1u); tnext = tn; } else tnext += NGWS;
        const int b = tok >> 13;
        const int i0 = IDX[(size_t)tok * 128 + lane], i1 = IDX[(size_t)tok * 128 + 64 + lane];
        const float g0 = GATE[(size_t)tok * 128 + lane], g1 = GATE[(size_t)tok * 128 + 64 + lane];
        unsigned hf[32];
#pragma unroll
        for (int c = 0; c < 8; ++c) { const v4u w0 = *(const v4u*)(H + (size_t)tok * 1024 + 64 * jl + 8 * c);
#pragma unroll
            for (int e = 0; e < 4; ++e) hf[c * 4 + e] = w0[e]; }
        f32x2 oacc[32];
#pragma unroll
        for (int e = 0; e < 32; ++e) oacc[e] = (f32x2){0.f, 0.f};
        ExpRow RA, RB;
        exp_issue(RA, TD, TU, SD, __shfl(i0, grp), __shfl(g0, grp), jl);
        for (int it = 0; it < 32 * EXP_REP; it += 2) {
            { const int kk = ((it + 1) & 31) * 4 + grp; const int el = __shfl(i0, kk & 63), eh = __shfl(i1, kk & 63); const float gl = __shfl(g0, kk & 63), gh = __shfl(g1, kk & 63);
              exp_issue(RB, TD, TU, SD, kk < 64 ? el : eh, kk < 64 ? gl : gh, jl); }
            exp_consume(RA, hf, oacc);
            { const int kk = ((it + 2) & 31) * 4 + grp; const int el = __shfl(i0, kk & 63), eh = __shfl(i1, kk & 63); const float gl = __shfl(g0, kk & 63), gh = __shfl(g1, kk & 63);
              exp_issue(RA, TD, TU, SD, kk < 64 ? el : eh, kk < 64 ? gl : gh, jl); }
            exp_consume(RB, hf, oacc);
        }
        f32x2 h1[16];
        { const bool up = (grp & 2) != 0;
#pragma unroll
          for (int e = 0; e < 16; ++e) { const f32x2 keep = up ? oacc[16 + e] : oacc[e], send = up ? oacc[e] : oacc[16 + e]; h1[e] = keep + (f32x2){__shfl_xor(send.x, 32), __shfl_xor(send.y, 32)}; } }
        f32x2 h2[8];
        { const bool up = (grp & 1) != 0;
#pragma unroll
          for (int e = 0; e < 8; ++e) { const f32x2 keep = up ? h1[8 + e] : h1[e], send = up ? h1[e] : h1[8 + e]; h2[e] = keep + (f32x2){__shfl_xor(send.x, 16), __shfl_xor(send.y, 16)}; } }
        const int d0 = 64 * jl + 16 * grp;
        const float* g2p = MOD + (size_t)(layer * 8 + b) * 6144 + 5120 + d0; const float psc = ((ABL_ON >= (layer == 0 ? 2 : 4)) ? 1.f : 0.f) * (1.0f / EXP_REP);
        float* xp = P.out + (size_t)tok * 1024 + d0;
        float xn[16]; float ss = 0.f;
#pragma unroll
        for (int q = 0; q < 4; ++q) { const f32x4 xa = *(const f32x4*)(xp + 4 * q), ga = *(const f32x4*)(g2p + 4 * q);
            xn[4 * q] = xa[0] + psc * ga[0] * h2[2 * q].x; xn[4 * q + 1] = xa[1] + psc * ga[1] * h2[2 * q].y; xn[4 * q + 2] = xa[2] + psc * ga[2] * h2[2 * q + 1].x; xn[4 * q + 3] = xa[3] + psc * ga[3] * h2[2 * q + 1].y; }
#pragma unroll
        for (int e = 0; e < 16; ++e) ss += xn[e] * xn[e];
        const float rstd = 1.0f / sqrtf(wave_sum(ss) * (1.0f / 1024.0f) + NORM_EPS);
        if (!last) {
            const float* ng = P.norm_mix_g + (layer + 1) * 1024 + d0; const float* mb = MOD + (size_t)((layer + 1) * 8 + b) * 6144 + d0;
            unsigned w[8];
#pragma unroll
            for (int q = 0; q < 4; ++q) { *(f32x4*)(xp + 4 * q) = (f32x4){xn[4 * q], xn[4 * q + 1], xn[4 * q + 2], xn[4 * q + 3]}; }
#pragma unroll
            for (int e = 0; e < 8; ++e) w[e] = pk2(xn[2 * e] * rstd * ng[2 * e] * (1.0f + mb[1024 + 2 * e]) + mb[2 * e], xn[2 * e + 1] * rstd * ng[2 * e + 1] * (1.0f + mb[1024 + 2 * e + 1]) + mb[2 * e + 1]);
            v4u* hp = (v4u*)(H + (size_t)tok * 1024 + d0); hp[0] = (v4u){w[0], w[1], w[2], w[3]}; hp[1] = (v4u){w[4], w[5], w[6], w[7]};
        } else {
            const float* fg = P.final_norm_g + d0;
#pragma unroll
            for (int q = 0; q < 4; ++q) *(f32x4*)(xp + 4 * q) = (f32x4){xn[4 * q] * rstd * fg[4 * q], xn[4 * q + 1] * rstd * fg[4 * q + 1], xn[4 * q + 2] * rstd * fg[4 * q + 2], xn[4 * q + 3] * rstd * fg[4 * q + 3]};
        }
        if (dyn) tnext = __builtin_amdgcn_readfirstlane(tnext);
    }
}

#ifndef NC_PER_XCD
#define NC_PER_XCD 16
#endif
#ifdef PROBE_SEL
#define SUBSTAMP(i) do { if (W.c == 0 && C.tid == 0) __hip_atomic_store((unsigned*)(P.ws + WS_CTL) + 128 + 16 * W.h + (i), (unsigned)__builtin_amdgcn_s_memrealtime(), __ATOMIC_RELAXED, __HIP_MEMORY_SCOPE_AGENT); } while (0)
#else
#define SUBSTAMP(i) do {} while (0)
#endif
__device__ __forceinline__ void run_C0(const Params& P, const Ctx& Cin, const Wk& W, const XcdBarrier& tb) {
    const Ctx C = fresh_ctx(Cin);
    SUBSTAMP(0);
    unsigned char* ws = P.ws; float* MOD = (float*)(ws + WS_MOD); bf16* H = (bf16*)(ws + WS_H);
    const size_t tk = (size_t)W_TK0(W); unsigned char* const ar = w_ar(P, W);
    phase_norm(P, C, W, P.x, P.norm_mix_g, 0, 0); xcd_barrier(tb); SUBSTAMP(1);
    { pg8::Gemm g{H + tk * 1024, (const bf16*)(ws + WS_WIN), HT, 3072, 1024}; pg8::StaticOrder S; S.init(HT, 3072, W.n, W.c);
      EpiInProj E{(bf16*)(ar + AR_PU), (bf16*)(ar + AR_PV), (bf16*)(ar + AR_PQ), (bf16*)(ar + AR_PI), (bf16*)(ar + AR_PG), (float*)(ar + AR_G), (const float*)(ws + WS_LB)};
      pg8::gemm_phase<EpiInProj, pg8::StaticOrder, true, true>(C.lds, g, S, E); } xcd_barrier(tb); SUBSTAMP(2);
    for (int it = W.lv; it < 1024; it += W.n) gmlp_item(P, C, W, W_TK0(W) / 128 + (it >> 2), it & 3);
    for (int it = W.lv; it < 2048; it += W.n) hgrn_local_item(P, C, W, W_BT0(W) * 512 + it);
    xcd_barrier(tb); SUBSTAMP(3);
    phase_hgrn_scan(P, C, W); xcd_barrier(tb); SUBSTAMP(4);
    for (int it = W.lv; it < 2048; it += W.n) hgrn_out_item(P, C, W, W_BT0(W) * 512 + it);
    xcd_barrier(tb); SUBSTAMP(5);
    { pg8::Gemm g{H + tk * 1024, (const bf16*)(ws + WS_WOUT0), HT, 1024, 1024}; pg8::StaticOrder S; S.init(HT, 1024, W.n, W.c);
      EpiResid E{P.x + tk * 1024, P.out + tk * 1024, MOD + 2048 + (size_t)W_BT0(W) * 6144, 1.f};
      pg8::gemm_phase<EpiResid, pg8::StaticOrder, true, true>(C.lds, g, S, E); } xcd_barrier(tb); SUBSTAMP(6);
    phase_norm(P, C, W, P.out, P.norm_ffn_g, 0, 3072); xcd_barrier(tb); SUBSTAMP(7);
    { pg8::Gemm g{H + tk * 1024, (const bf16*)(ws + WS_WQ0), HT, 2048, 1024}; pg8::StaticOrder S; S.init(HT, 2048, W.n, W.c);
      EpiBf16P E{(bf16*)(ar + AR_QP), 2048};
      pg8::gemm_phase<EpiBf16P, pg8::StaticOrder, true, true>(C.lds, g, S, E); }
    SUBSTAMP(9);
}
__device__ __forceinline__ void run_C1(const Params& P, const Ctx& Cin, const Wk& W, const XcdBarrier& tb) {
    const Ctx C = fresh_ctx(Cin);
    SUBSTAMP(0);
    unsigned char* ws = P.ws; float* MOD = (float*)(ws + WS_MOD); bf16* H = (bf16*)(ws + WS_H);
    const size_t tk = (size_t)W_TK0(W); unsigned char* const ar = w_ar(P, W);
    { pg8::Gemm g{H + tk * 1024, (const bf16*)(ws + WS_WQKV), HT, 3072, 1024}; pg8::StaticOrder S; S.init(HT, 3072, W.n, W.c);
      EpiQKRot E{(bf16*)(ar + AR_QK), (const float*)(ws + WS_CS) + tk * 16};
      pg8::gemm_phase<EpiQKRot, pg8::StaticOrder, true, true>(C.lds, g, S, E); } xcd_barrier(tb); SUBSTAMP(1);
    for (int it = W.lv; it < (NB / 2) * 16 * 16; it += W.n) attn_item(P, C, W, W_BT0(W) + (it >> 8), (it >> 4) & 15, it & 15);
    xcd_barrier(tb); SUBSTAMP(2);
    { pg8::Gemm g{H + tk * 1024, (const bf16*)(ws + WS_WOUT1), HT, 1024, 1024}; pg8::StaticOrder S; S.init(HT, 1024, W.n, W.c);
      EpiResid E{P.out + tk * 1024, P.out + tk * 1024, MOD + (size_t)8 * 6144 + 2048 + (size_t)W_BT0(W) * 6144, 1.f};
      pg8::gemm_phase<EpiResid, pg8::StaticOrder, true, true>(C.lds, g, S, E); } xcd_barrier(tb); SUBSTAMP(3);
    phase_norm(P, C, W, P.out, P.norm_ffn_g + 1024, 1, 3072); xcd_barrier(tb); SUBSTAMP(4);
    { pg8::Gemm g{H + tk * 1024, (const bf16*)(ws + WS_WQ1), HT, 2048, 1024}; pg8::StaticOrder S; S.init(HT, 2048, W.n, W.c);
      EpiBf16P E{(bf16*)(ar + AR_QP), 2048};
      pg8::gemm_phase<EpiBf16P, pg8::StaticOrder, true, true>(C.lds, g, S, E); }
    SUBSTAMP(9);
}
__device__ __forceinline__ void run_E(const Params& P, const Ctx& Cin, const Wk& W, const XcdBarrier& tb, int layer) {
    { const Ctx C = fresh_ctx(Cin); phase_peer_topk(P, C, W, layer); }
    xcd_barrier(tb);
    if (W.c == 0 && Cin.tid == 0) __hip_atomic_store((unsigned*)(P.ws + WS_CTL) + 112 + 2 * layer + W.h, 1u, __ATOMIC_RELAXED, __HIP_MEMORY_SCOPE_AGENT);
    phase_peer_experts(P, Cin, W, layer, layer == 1);
}
__device__ __forceinline__ void help_E(const Params& P, const Ctx& Cin, int h, int layer) {
    volatile LAS unsigned* okw = (volatile LAS unsigned*)(Cin.lds + LDSCTL_OFF + 192);
    if (Cin.tid == 0) { unsigned* flag = (unsigned*)(P.ws + WS_CTL) + 112 + 2 * layer + h; unsigned ok = 0u;
        for (unsigned sp = 0; sp < (1u << 16); ++sp) { if (__hip_atomic_load(flag, __ATOMIC_RELAXED, __HIP_MEMORY_SCOPE_AGENT) != 0u) { ok = 1u; break; } __builtin_amdgcn_s_sleep(8); }
        __builtin_amdgcn_fence(__ATOMIC_ACQUIRE, "agent"); asm volatile("s_waitcnt vmcnt(0)" ::: "memory");
        *okw = ok; }
    __syncthreads();
    const bool ok = *okw != 0u;
    __syncthreads();
    if (ok) { Wk W; W.lv = 0; W.n = 1; W.c = 1; W.h = h; phase_peer_experts(P, Cin, W, layer, layer == 1); }
}
__global__ void __launch_bounds__(NWAVES * 64, 2) hybrid_fwd(Params P) {
    extern __shared__ __attribute__((aligned(16))) unsigned char lds_raw[];
    Ctx C;
    C.lds = (LAS unsigned char*)lds_raw;
    C.tid = threadIdx.x; C.lane = C.tid & 63; C.wave = __builtin_amdgcn_readfirstlane(C.tid >> 6);
    C.G = gridDim.x; const int bx = blockIdx.x; C.vcu = (bx % 8) * (C.G / 8) + bx / 8;
    volatile LAS unsigned* MISC = (volatile LAS unsigned*)(C.lds + MISC_OFF);
    for (int u = C.tid; u < (LDS_BYTES - LDSCTL_OFF) / 4; u += NWAVES * 64) ((LAS unsigned*)(C.lds + LDSCTL_OFF))[u] = 0u;
    __syncthreads();
    unsigned* ctl = (unsigned*)(P.ws + WS_CTL);
    const int xl = bx & 7, jx = bx >> 3, perx = C.G / 8;
    const bool inC = jx < NC_PER_XCD;
    const int nC = 8 * NC_PER_XCD, nE = C.G - nC;
    const XcdBarrier bar_all = xcd_barrier_post(ctl + CW_BAR, MISC + 8);
    XcdBarrier bar_c; bar_c.bar = ctl + CW_BAR + XCD_BAR_WORDS; bar_c.x = bar_all.x; bar_c.st = MISC + 10; bar_c.G = (unsigned)nC;
    if (inC && C.tid == 0) (void)xb_add(&bar_c.bar[XB_XCNT(bar_c.x)], 1u);
    XcdBarrier bar_e; bar_e.bar = ctl + CW_BAR + 2 * XCD_BAR_WORDS; bar_e.x = bar_all.x; bar_e.st = MISC + 12; bar_e.G = (unsigned)nE;
    if (!inC && C.tid == 0) (void)xb_add(&bar_e.bar[XB_XCNT(bar_e.x)], 1u);
    Wk Wall; Wall.lv = C.vcu; Wall.n = C.G; Wall.c = bx; Wall.h = 0;
    Wk Wc; Wc.lv = xl * NC_PER_XCD + jx; Wc.n = nC; Wc.c = jx * 8 + xl; Wc.h = 0;
    Wk We; { const int je = jx - NC_PER_XCD, ne = perx - NC_PER_XCD; We.lv = xl * ne + je; We.n = nE; We.c = je * 8 + xl; We.h = 0; }
    phase_prologue(P, C);
    xcd_barrier(bar_all);
#ifdef PROBE_SEL
    unsigned long long tp0 = __builtin_amdgcn_s_memrealtime(), tp1 = 0, tp2 = 0, tp3 = 0, tp4 = 0, tp5 = 0, tpe1 = 0, tpe2 = 0, tpe3 = 0;
#define STAMP(v) v = __builtin_amdgcn_s_memrealtime()
#else
#define STAMP(v)
#endif
    Wall.h = 0; run_C0(P, C, Wall, bar_all); xcd_barrier(bar_all); STAMP(tp1);
    if (inC) { Wc.h = 1; run_C0(P, C, Wc, bar_c); help_E(P, C, 0, 0); } else { We.h = 0; run_E(P, C, We, bar_e, 0); }
    STAMP(tpe1);
#ifdef PROBE_SEL
    if (C.tid == 0) atomicMax(ctl + 80 + (inC ? 0 : 1), (unsigned)(tpe1 - tp1));
#endif
    xcd_barrier(bar_all); STAMP(tp2);
    if (inC) { Wc.h = 0; run_C1(P, C, Wc, bar_c); help_E(P, C, 1, 0); } else { We.h = 1; run_E(P, C, We, bar_e, 0); }
    STAMP(tpe2);
#ifdef PROBE_SEL
    if (C.tid == 0) atomicMax(ctl + 82 + (inC ? 0 : 1), (unsigned)(tpe2 - tp2));
#endif
    xcd_barrier(bar_all); STAMP(tp3);
    if (inC) { Wc.h = 1; run_C1(P, C, Wc, bar_c); help_E(P, C, 0, 1); } else { We.h = 0; run_E(P, C, We, bar_e, 1); }
    STAMP(tpe3);
#ifdef PROBE_SEL
    if (C.tid == 0) atomicMax(ctl + 84 + (inC ? 0 : 1), (unsigned)(tpe3 - tp3));
#endif
    xcd_barrier(bar_all); STAMP(tp4);
    Wall.h = 1; run_E(P, C, Wall, bar_all, 1);
#ifdef PROBE_SEL
    STAMP(tp5);
    { unsigned long long d = 0; const int sel = PROBE_SEL;
      if (sel == 0) d = tp1 - tp0; if (sel == 1) d = tp2 - tp1; if (sel == 2) d = tp3 - tp2; if (sel == 3) d = tp4 - tp3; if (sel == 4) d = tp5 - tp4;
      if (sel == 5 || sel == 8) d = tpe1 - tp1; if (sel == 6 || sel == 9) d = tpe2 - tp2; if (sel == 7 || sel == 10) d = tpe3 - tp3;
      const int who = sel >= 8 ? 8 * NC_PER_XCD : 0;
      if (sel >= 20) { const unsigned* sp = (const unsigned*)(P.ws + WS_CTL) + 128 + 16 * PROBE_HALF; const int i = sel - 20; const int nxt = (i == PROBE_LAST) ? 9 : i + 1; d = (unsigned long long)(__hip_atomic_load(sp + nxt, __ATOMIC_RELAXED, __HIP_MEMORY_SCOPE_AGENT) - __hip_atomic_load(sp + i, __ATOMIC_RELAXED, __HIP_MEMORY_SCOPE_AGENT)); }
      if (sel >= 30) d = 0;
      if (bx == (sel >= 20 ? 0 : who) && C.tid == 0) __hip_atomic_store(ctl + 64, (unsigned)d, __ATOMIC_RELAXED, __HIP_MEMORY_SCOPE_AGENT);
      xcd_barrier(bar_all);
      if (bx == 0 && C.tid == 0) { const unsigned dd = sel >= 30 ? __hip_atomic_load(ctl + 80 + (sel - 30), __ATOMIC_RELAXED, __HIP_MEMORY_SCOPE_AGENT) : __hip_atomic_load(ctl + 64, __ATOMIC_RELAXED, __HIP_MEMORY_SCOPE_AGENT);
        const unsigned long long t0_ = __builtin_amdgcn_s_memrealtime(); while (__builtin_amdgcn_s_memrealtime() - t0_ < 4ull * dd) __builtin_amdgcn_s_sleep(32); } }
#endif
}

extern "C" void kernel_launch(void* const* d_in, const int* in_sizes, int n_in, void* d_out, int out_size, void* d_ws, size_t ws_size, hipStream_t stream) {
    static int grid = 0;
    if (grid == 0) {
        if (n_in != 22 || in_sizes[0] != T * DM || out_size != T * DM || ws_size < WS_END) {
            fprintf(stderr, "kernel_launch: unexpected shapes (n_in %d, in0 %d, out %d, ws %zu); nothing launched\n", n_in, n_in > 0 ? in_sizes[0] : -1, out_size, ws_size); grid = -1; return; }
        int dev = 0, cus = 0;
        if (hipGetDevice(&dev) != hipSuccess || hipDeviceGetAttribute(&cus, hipDeviceAttributeMultiprocessorCount, dev) != hipSuccess) { fprintf(stderr, "kernel_launch: device query failed\n"); grid = -1; return; }
        if (hipFuncSetAttribute((const void*)hybrid_fwd, hipFuncAttributeMaxDynamicSharedMemorySize, LDS_BYTES) != hipSuccess) { fprintf(stderr, "kernel_launch: hipFuncSetAttribute failed\n"); grid = -1; return; }
        (void)hipGetLastError();
        grid = cus;
        if (grid % 8 != 0 || grid / 8 <= NC_PER_XCD) { fprintf(stderr, "kernel_launch: built for a CU count that is a multiple of 8 and > %d; got %d; nothing launched\n", 8 * NC_PER_XCD, grid); grid = -1; return; }
    }
    if (grid < 0) return;
    if (hipMemsetAsync((char*)d_ws + WS_CTL, 0, CTL_ZERO_BYTES, stream) != hipSuccess) { fprintf(stderr, "kernel_launch: memset failed\n"); return; }
    Params p{};
    p.x = (const float*)d_in[0]; p.c = (const float*)d_in[1]; p.positions = (const int*)d_in[2]; p.ada_w = (const float*)d_in[3]; p.ada_b = (const float*)d_in[4];
    p.norm_mix_g = (const float*)d_in[5]; p.norm_ffn_g = (const float*)d_in[6]; p.final_norm_g = (const float*)d_in[7]; p.even_w_in = (const float*)d_in[8]; p.even_w_out = (const float*)d_in[9];
    p.gmlp_ln_g = (const float*)d_in[10]; p.gmlp_ln_b = (const float*)d_in[11]; p.gmlp_w_s = (const float*)d_in[12]; p.gmlp_b_s = (const float*)d_in[13]; p.hgrn_lb_logits = (const float*)d_in[14];
    p.hgrn_norm_g = (const float*)d_in[15]; p.odd_w_qkv = (const float*)d_in[16]; p.odd_w_out = (const float*)d_in[17]; p.peer_w_query = (const float*)d_in[18]; p.peer_sub_keys = (const float*)d_in[19];
    p.peer_down = (const float*)d_in[20]; p.peer_up = (const float*)d_in[21];
    p.out = (float*)d_out; p.ws = (unsigned char*)d_ws;
    p.ph_lo = 0; p.ph_hi = 0;
    hipLaunchKernelGGL(hybrid_fwd, dim3(grid), dim3(NWAVES * 64), LDS_BYTES, stream, p);
    const hipError_t le = hipPeekAtLastError();
    if (le != hipSuccess) fprintf(stderr, "kernel_launch: launch failed: %s\n", hipGetErrorName(le));
}
```

```cpp
#include <hip/hip_runtime.h>
#include <cstdio>
#include <cstdint>
#include <cmath>
namespace pg8 {
#define PG8_LAS __attribute__((address_space(3)))
typedef unsigned short bf16_t;
typedef short bf16x8 __attribute__((ext_vector_type(8)));
typedef float f32x4 __attribute__((ext_vector_type(4)));
typedef unsigned u32x4 __attribute__((ext_vector_type(4)));
constexpr int BM = 256, BK = 64, HALF = 128, HTB = HALF * BK * 2  , STAGE_BYTES = 8 * HTB, NXCD = 8, WGM = 8;

__host__ __device__ __forceinline__ int lds_byte(int r, int c) { const int st = (r >> 4) * 2 + (c >> 5), rr = r & 15, cc = c & 31, ob = rr * 64 + cc * 2; return st * 1024 + (ob ^ (((ob >> 9) & 1) << 5)); }
__host__ __device__ __forceinline__ void stage_rc(int b, int& R, int& C) { const int st = b / 1024, sb = b % 1024, swz = sb ^ (((sb >> 9) & 1) << 5); R = (st >> 1) * 16 + swz / 64; C = (st & 1) * 32 + (swz % 64) / 2; }
__host__ __device__ __forceinline__ int perm32(int rho) { const int n = rho >> 4, i = rho & 15; return 8 * (i >> 2) + 4 * n + (i & 3); }

struct Unit { int pm, pn; };
struct Gemm { const bf16_t* A; const bf16_t* Bt; int M, N, K; };

struct StaticOrder {
    int nM, nN, nwg, G, c;
    __host__ __device__ void init(int M, int N, int G_, int c_) { nM = M / BM; nN = N / BM; nwg = nM * nN; G = G_; c = c_; }
    __host__ __device__ bool next(int i, Unit& u) const {
        const long L = (long)i * G + c; if (L >= nwg) return false;
        int wgid = (int)L; { const int q = nwg / NXCD, r = nwg % NXCD, xcd = wgid % NXCD, off = wgid / NXCD; wgid = (xcd < r ? xcd * (q + 1) : r * (q + 1) + (xcd - r) * q) + off; }
        const int nig = WGM * nN, gid = wgid / nig, fm = gid * WGM, gsz = (nM - fm) < WGM ? (nM - fm) : WGM;
        u.pm = fm + ((wgid % nig) % gsz); u.pn = (wgid % nig) / gsz; return true;
    }
    __device__ __forceinline__ void a_ready(const Unit&) const {}
    __device__ __forceinline__ void done(const Unit&) const {}
};

__device__ __forceinline__ unsigned cvt_pk_bf16(float lo, float hi) { unsigned r; asm volatile("v_cvt_pk_bf16_f32 %0, %1, %2" : "=v"(r) : "v"(lo), "v"(hi)); return r; }
typedef float f32x2 __attribute__((ext_vector_type(2)));
__device__ __forceinline__ f32x2 gelu_pk(f32x2 v) {
    const f32x2 av = __builtin_elementwise_abs(v), d = av * 0.2316418882f + 1.0f;
    f32x2 t; t.x = __builtin_amdgcn_rcpf(d.x); t.y = __builtin_amdgcn_rcpf(d.y);
    f32x2 q = t * 0.5307027145f + (-0.7265760135f); q = q * t + 0.7107068705f; q = q * t + (-0.142248368f); q = q * t + 0.127414796f; q = q * t;
    const f32x2 s = (v * v) * (-0.72134752044f);
    f32x2 e; e.x = __builtin_amdgcn_exp2f(s.x); e.y = __builtin_amdgcn_exp2f(s.y);
    const f32x2 m = v * (q * e), r = v - m;
    f32x2 o; o.x = v.x < 0.f ? m.x : r.x; o.y = v.y < 0.f ? m.y : r.y; return o;
}

template <class Epi, class Sched, bool ALIGN_EPI = false, bool SP2 = false>
__device__ __forceinline__ void gemm_phase(PG8_LAS unsigned char* lds, const Gemm g, const Sched& S, const Epi& E) {
    int tid_ = threadIdx.x; asm volatile("" : "+v"(tid_));
    const int tid = tid_, wid = __builtin_amdgcn_readfirstlane(tid >> 6), lane = tid & 63, wr = wid >> 2, wc = wid & 3, fr = lane & 15, fq = lane >> 4;
    const int K = g.K, nt = K / BK;
    unsigned voffA[2], voffB[2];
#pragma unroll
    for (int i = 0; i < 2; ++i) { int R, C; stage_rc(tid * 16 + i * 8192, R, C); const int Rb = Epi::PERM ? ((R & ~31) + perm32(R & 31)) : R;
        voffA[i] = (unsigned)(R * K + C) * 2u; voffB[i] = (unsigned)(Rb * K + C) * 2u; }
    const size_t kstep = (size_t)(BK * 2);
    const size_t hstep = (size_t)HALF * K * 2;
    const size_t tstep = 2 * hstep;
    const unsigned ldsw = (unsigned)wid * 1024u;
    const int aoff = lds_byte(wr * 64 + fr, fq * 8), boff = lds_byte(wc * 32 + fr, fq * 8);
#define PG8_SA(b, h) (((b) * 2 + (h)) * HTB)
#define PG8_SB(b, h) ((4 + (b) * 2 + (h)) * HTB)
#define PG8_STAGE(bufoff, gbase, voff) do { _Pragma("unroll") for (int _i = 0; _i < 2; ++_i) \
        __builtin_amdgcn_global_load_lds((const unsigned*)((const char*)(gbase) + (voff)[_i]), (PG8_LAS unsigned*)(lds + (bufoff) + ldsw + _i * 8192), 16, 0, 0); } while (0)
#define PG8_LDA(dst, b, h) do { _Pragma("unroll") for (int m = 0; m < 4; ++m) _Pragma("unroll") for (int k = 0; k < 2; ++k) dst[m][k] = *(const PG8_LAS bf16x8*)(lds + PG8_SA(b, h) + aoff + m * 2048 + k * 1024); } while (0)
#define PG8_LDB(dst, b, h) do { _Pragma("unroll") for (int n = 0; n < 2; ++n) _Pragma("unroll") for (int k = 0; k < 2; ++k) dst[n][k] = *(const PG8_LAS bf16x8*)(lds + PG8_SB(b, h) + boff + n * 2048 + k * 1024); } while (0)
#define PG8_MMA(ai, bj, At, Bt) do { __builtin_amdgcn_s_setprio(1); _Pragma("unroll") for (int m = 0; m < 4; ++m) _Pragma("unroll") for (int n = 0; n < 2; ++n) _Pragma("unroll") for (int k = 0; k < 2; ++k) \
        acc[ai][bj][m][n] = __builtin_amdgcn_mfma_f32_16x16x32_bf16(Bt[n][k], At[m][k], acc[ai][bj][m][n], 0, 0, 0); __builtin_amdgcn_s_setprio(0); } while (0)
#define PG8_WAIT_V(n) asm volatile("s_waitcnt vmcnt(" #n ")" ::: "memory")
#define PG8_WAIT_L(n) asm volatile("s_waitcnt lgkmcnt(" #n ")" ::: "memory")
#define PG8_BAR __builtin_amdgcn_s_barrier()
#define PG8_SCHED __builtin_amdgcn_sched_barrier(0)
    Unit cur, nxt; int ui = 0;
    if (!S.next(0, cur)) return;
    f32x4 acc[2][2][4][2];
#pragma unroll
    for (int a = 0; a < 2; ++a)
#pragma unroll
        for (int b = 0; b < 2; ++b)
#pragma unroll
            for (int m = 0; m < 4; ++m)
#pragma unroll
                for (int n = 0; n < 2; ++n) acc[a][b][m][n] = (f32x4){0.f, 0.f, 0.f, 0.f};
    bf16x8 At[4][2], B0[2][2], B1[2][2];
    const char* cA = (const char*)g.A + (size_t)cur.pm * tstep; const char* cB = (const char*)g.Bt + (size_t)cur.pn * tstep;
    S.a_ready(cur);
    if constexpr (SP2) {
        PG8_STAGE(PG8_SB(0, 0), cB, voffB); PG8_STAGE(PG8_SB(0, 1), cB + hstep, voffB); PG8_STAGE(PG8_SA(0, 0), cA, voffA); PG8_STAGE(PG8_SA(0, 1), cA + hstep, voffA);
        if (wr == 1) PG8_BAR;
        PG8_WAIT_V(2); PG8_BAR;
        PG8_STAGE(PG8_SB(1, 0), cB + kstep, voffB); PG8_STAGE(PG8_SA(1, 0), cA + kstep, voffA); PG8_STAGE(PG8_SB(1, 1), cB + hstep + kstep, voffB);
        PG8_WAIT_V(6); PG8_BAR;
    } else {
        PG8_STAGE(PG8_SB(0, 0), cB, voffB); PG8_STAGE(PG8_SA(0, 0), cA, voffA); PG8_STAGE(PG8_SB(0, 1), cB + hstep, voffB); PG8_STAGE(PG8_SA(0, 1), cA + hstep, voffA);
        if (wr == 1) PG8_BAR;
        PG8_WAIT_V(4); PG8_BAR;
        PG8_STAGE(PG8_SB(1, 0), cB + kstep, voffB); PG8_STAGE(PG8_SA(1, 0), cA + kstep, voffA); PG8_STAGE(PG8_SB(1, 1), cB + hstep + kstep, voffB);
        PG8_WAIT_V(6); PG8_BAR;
    }
    for (;;) {
        const bool has_next = S.next(ui + 1, nxt);
        const char* nA = has_next ? (const char*)g.A + (size_t)nxt.pm * tstep : cA; const char* nB = has_next ? (const char*)g.Bt + (size_t)nxt.pn * tstep : cB;
        for (int t = 0; t < nt; t += 2) {
            const bool last = (t == nt - 2);
            const char* a1 = cA + (size_t)(t + 1) * kstep;
            const char* a2 = last ? nA : cA + (size_t)(t + 2) * kstep; const char* b2 = last ? nB : cB + (size_t)(t + 2) * kstep;
            const char* a3 = a2 + kstep; const char* b3 = b2 + kstep;
            if (last && has_next) S.a_ready(nxt);
            if constexpr (SP2) {
            PG8_LDB(B0, 0, 0); PG8_LDB(B1, 0, 1); PG8_SCHED; PG8_LDA(At, 0, 0); PG8_STAGE(PG8_SA(1, 1), a1 + hstep, voffA);
            PG8_WAIT_V(8); PG8_WAIT_L(0); PG8_BAR; PG8_MMA(0, 0, At, B0); PG8_MMA(0, 1, At, B1); PG8_BAR; PG8_SCHED;
            PG8_LDA(At, 0, 1); PG8_STAGE(PG8_SB(0, 0), b2, voffB); PG8_STAGE(PG8_SB(0, 1), b2 + hstep, voffB); PG8_STAGE(PG8_SA(0, 0), a2, voffA);
            PG8_WAIT_V(8); PG8_WAIT_L(0); PG8_BAR; PG8_MMA(1, 0, At, B0); PG8_MMA(1, 1, At, B1); PG8_BAR; PG8_SCHED;
            PG8_LDB(B0, 1, 0); PG8_LDB(B1, 1, 1); PG8_SCHED; PG8_LDA(At, 1, 0); PG8_STAGE(PG8_SA(0, 1), a2 + hstep, voffA);
            PG8_WAIT_V(8); PG8_WAIT_L(0); PG8_BAR; PG8_MMA(0, 0, At, B0); PG8_MMA(0, 1, At, B1); PG8_BAR; PG8_SCHED;
            PG8_LDA(At, 1, 1); PG8_STAGE(PG8_SB(1, 0), b3, voffB); PG8_STAGE(PG8_SB(1, 1), b3 + hstep, voffB); PG8_STAGE(PG8_SA(1, 0), a3, voffA);
            PG8_WAIT_V(8); PG8_WAIT_L(0); PG8_BAR; PG8_MMA(1, 0, At, B0); PG8_MMA(1, 1, At, B1); PG8_BAR; PG8_SCHED;
            } else {
            PG8_LDB(B0, 0, 0); PG8_SCHED; PG8_LDA(At, 0, 0); PG8_STAGE(PG8_SA(1, 1), a1 + hstep, voffA);
            PG8_WAIT_L(8); PG8_BAR; PG8_WAIT_L(0); PG8_MMA(0, 0, At, B0); PG8_BAR; PG8_SCHED;
            PG8_LDB(B1, 0, 1); PG8_STAGE(PG8_SB(0, 0), b2, voffB);
            PG8_BAR; PG8_WAIT_L(0); PG8_MMA(0, 1, At, B1); PG8_BAR;
            PG8_LDA(At, 0, 1); PG8_STAGE(PG8_SA(0, 0), a2, voffA);
            PG8_BAR; PG8_WAIT_L(0); PG8_MMA(1, 0, At, B0); PG8_BAR; PG8_SCHED;
            PG8_STAGE(PG8_SB(0, 1), b2 + hstep, voffB);
            PG8_WAIT_V(6); PG8_BAR; PG8_MMA(1, 1, At, B1); PG8_BAR;
            PG8_LDB(B0, 1, 0); PG8_SCHED; PG8_LDA(At, 1, 0); PG8_STAGE(PG8_SA(0, 1), a2 + hstep, voffA);
            PG8_WAIT_L(8); PG8_BAR; PG8_WAIT_L(0); PG8_MMA(0, 0, At, B0); PG8_BAR; PG8_SCHED;
            PG8_LDB(B1, 1, 1); PG8_STAGE(PG8_SB(1, 0), b3, voffB);
            PG8_BAR; PG8_WAIT_L(0); PG8_MMA(0, 1, At, B1); PG8_BAR;
            PG8_LDA(At, 1, 1); PG8_STAGE(PG8_SA(1, 0), a3, voffA);
            PG8_BAR; PG8_WAIT_L(0); PG8_MMA(1, 0, At, B0); PG8_BAR; PG8_SCHED;
            PG8_STAGE(PG8_SB(1, 1), b3 + hstep, voffB);
            PG8_WAIT_V(6); PG8_BAR; PG8_MMA(1, 1, At, B1); PG8_BAR;
            }
        }
        if constexpr (ALIGN_EPI) { if (wr == 0) PG8_BAR; }
        if constexpr (!Epi::AFTER_DRAIN) { E(acc, cur, wr, wc, fr, fq); S.done(cur); }
        if (!has_next) break;
#pragma unroll
        for (int a = 0; a < 2; ++a)
#pragma unroll
            for (int b = 0; b < 2; ++b)
#pragma unroll
                for (int m = 0; m < 4; ++m)
#pragma unroll
                    for (int n = 0; n < 2; ++n) acc[a][b][m][n] = (f32x4){0.f, 0.f, 0.f, 0.f};
        cur = nxt; cA = nA; cB = nB; ++ui;
        if constexpr (ALIGN_EPI) { if (wr == 1) PG8_BAR; }
    }
    PG8_WAIT_V(0);
    if constexpr (!ALIGN_EPI) { if (wr == 0) PG8_BAR; }
    PG8_BAR;
    if constexpr (Epi::AFTER_DRAIN) { E.fused(acc, cur, wr, wc, fr, fq, lds, wid, lane); S.done(cur); }
#undef PG8_SA
#undef PG8_SB
#undef PG8_STAGE
#undef PG8_LDA
#undef PG8_LDB
#undef PG8_MMA
#undef PG8_WAIT_V
#undef PG8_WAIT_L
#undef PG8_BAR
#undef PG8_SCHED
}
}
#define GAS __attribute__((address_space(1)))
#define LAS __attribute__((address_space(3)))
typedef unsigned short bf16;
typedef unsigned v4u __attribute__((ext_vector_type(4)));
typedef float f32x4 __attribute__((ext_vector_type(4)));
typedef short bf16x8 __attribute__((ext_vector_type(8)));
typedef __bf16 bf16x2_t __attribute__((ext_vector_type(2)));
#define LDS_WAIT() asm volatile("s_waitcnt lgkmcnt(0)" ::: "memory")
#define VM_WAIT() asm volatile("s_waitcnt vmcnt(0)" ::: "memory")
typedef float f32x2_cv __attribute__((ext_vector_type(2)));
__device__ __forceinline__ unsigned pk2(float lo, float hi) { const f32x2_cv v = {lo, hi}; return __builtin_bit_cast(unsigned, __builtin_convertvector(v, bf16x2_t)); }
__device__ __forceinline__ unsigned f2bf(float f) { return pk2(f, 0.f) & 0xffffu; }
__device__ __forceinline__ float bflo(unsigned u) { return __builtin_bit_cast(float, u << 16); }
__device__ __forceinline__ float bfhi(unsigned u) { return __builtin_bit_cast(float, u & 0xffff0000u); }
__device__ __forceinline__ float bf2f(bf16 u) { return __builtin_bit_cast(float, (unsigned)u << 16); }
#define XB_TMO      128
#define XB_XCNT(j)  (256  + 64 * (j))
#define XB_XSUB(j)  (1280 + 64 * (j))
#define XB_XGEN(j)  (2304 + 64 * (j))
#define XB_TOP      3328
#define XB_TOPGEN   3392
#define XCD_BAR_WORDS 3456
#define XB_SPIN_CAP (1u << 18)

__device__ __forceinline__ unsigned xb_ld(unsigned* p)              { return __hip_atomic_load(p, __ATOMIC_RELAXED, __HIP_MEMORY_SCOPE_AGENT); }
__device__ __forceinline__ unsigned xb_add(unsigned* p, unsigned v) { return __hip_atomic_fetch_add(p, v, __ATOMIC_RELAXED, __HIP_MEMORY_SCOPE_AGENT); }
__device__ __forceinline__ unsigned xb_xcc_id() { return (unsigned)__builtin_amdgcn_s_getreg((3 << 11) | 20) & 0xFu; }
#define XB_SPIN(cond, bar) do { unsigned _sp = 0; while (cond) { __builtin_amdgcn_s_sleep(1); \
    if ((++_sp & 255u) == 0u) { if (xb_ld(&(bar)[XB_TMO])) break; if (_sp > XB_SPIN_CAP) { atomicAdd(&(bar)[XB_TMO], 1u); break; } } } } while (0)

struct XcdBarrier {
    unsigned* bar; unsigned x; unsigned G;
    volatile LAS unsigned* st;
};

__device__ __forceinline__ XcdBarrier xcd_barrier_post(unsigned* bar, volatile LAS unsigned* st) {
    XcdBarrier b; b.bar = bar; b.x = xb_xcc_id(); b.st = st; b.G = gridDim.x;
    if (threadIdx.x == 0) (void)xb_add(&bar[XB_XCNT(b.x)], 1u);
    return b;
}
__device__ __forceinline__ void xcd_barrier_complete(unsigned* bar, unsigned x, unsigned& nloc, unsigned& nx, const unsigned G) {
    unsigned sum, cnt, mine, sp = 0u;
    for (;;) {
        sum = 0u; cnt = 0u; mine = 0u;
#pragma unroll
        for (unsigned j = 0; j < 16; ++j) { const unsigned c = xb_ld(&bar[XB_XCNT(j)]); sum += c; cnt += (c > 0u) ? 1u : 0u; mine = (j == x) ? c : mine; }
        if (sum == G) break;
        __builtin_amdgcn_s_sleep(1);
        if ((++sp & 255u) == 0u) { if (xb_ld(&bar[XB_TMO])) break; if (sp > XB_SPIN_CAP) { atomicAdd(&bar[XB_TMO], 1u); break; } }
    }
    nloc = mine > 0u ? mine : 1u; nx = cnt > 0u ? cnt : 1u;
}

__device__ __forceinline__ void xcd_barrier(const XcdBarrier& b) {
    asm volatile("s_waitcnt vmcnt(0)" ::: "memory");
    __syncthreads();
    if (threadIdx.x == 0) {
        unsigned* bar = b.bar;
        __builtin_amdgcn_s_waitcnt(0);
        unsigned nloc = b.st[0], nx = b.st[1];
        if (nloc == 0u) { xcd_barrier_complete(bar, b.x, nloc, nx, b.G); b.st[0] = nloc; b.st[1] = nx; }
        const unsigned old = xb_add(&bar[XB_XSUB(b.x)], 1u);
        const unsigned gen = old / nloc;
        if (old + 1u == (gen + 1u) * nloc) {
            __builtin_amdgcn_fence(__ATOMIC_RELEASE, "agent");
            asm volatile("s_waitcnt vmcnt(0)" ::: "memory");
            const unsigned og = xb_add(&bar[XB_TOP], 1u);
            const unsigned tg = og / nx;
            if (og + 1u == (tg + 1u) * nx) xb_add(&bar[XB_TOPGEN], 1u);
            else XB_SPIN(xb_ld(&bar[XB_TOPGEN]) == tg, bar);
            __builtin_amdgcn_fence(__ATOMIC_ACQUIRE, "agent");
            xb_add(&bar[XB_XGEN(b.x)], 1u);
            asm volatile("s_waitcnt vmcnt(0)" ::: "memory");
        } else {
            XB_SPIN(xb_ld(&bar[XB_XGEN(b.x)]) == gen, bar);
            __builtin_amdgcn_fence(__ATOMIC_ACQUIRE, "agent");
            asm volatile("s_waitcnt vmcnt(0)" ::: "memory");
        }
    }
    __syncthreads();
}

constexpr int NB = 8, SEQ = 8192, DM = 1024, T = NB * SEQ;
constexpr int NWAVES = 8;
constexpr float NORM_EPS = 1e-6f;
constexpr float C2 = 0.125f * 1.4426950408889634f;

constexpr size_t MiB = 1u << 20;
constexpr size_t WS_CTL = 0, CTL_ZERO_BYTES = 1 * MiB;
constexpr size_t WS_MOD = 1 * MiB;
constexpr size_t WS_SKB = 1 * MiB + 512 * 1024;
constexpr size_t WS_WSB = 1 * MiB + 768 * 1024;
constexpr size_t WS_LB  = 1 * MiB + 960 * 1024;
constexpr size_t WS_CS  = 2 * MiB;
constexpr size_t WS_HD  = 6 * MiB;
constexpr size_t WS_WIN = 16 * MiB, WS_WOUT0 = 22 * MiB, WS_WQKV = 24 * MiB, WS_WOUT1 = 30 * MiB, WS_WQ0 = 32 * MiB, WS_WQ1 = 36 * MiB;
constexpr size_t WS_TAB8 = 40 * MiB, TAB8_BYTES = 12 * MiB;
constexpr int TROW = 768;
constexpr size_t WS_SC8 = 8 * MiB;
constexpr size_t WS_H = 108 * MiB;
constexpr size_t WS_IDX = 236 * MiB, WS_GATE = 268 * MiB;
constexpr size_t WS_AR0 = 300 * MiB, AR_BYTES = 352 * MiB;
constexpr size_t AR_PU = 0, AR_PV = 32 * MiB, AR_PQ = 64 * MiB, AR_PI = 96 * MiB, AR_PG = 128 * MiB;
constexpr size_t AR_G = 160 * MiB;
constexpr size_t AR_KVT = 224 * MiB, AR_ST = 288 * MiB;
constexpr size_t AR_QP = 0;
constexpr size_t AR_QK = 0;
constexpr size_t WS_END = WS_AR0 + 2 * AR_BYTES;
constexpr int HT = T / 2;
constexpr int CW_BAR = 4096;

constexpr int LDS_BYTES = 147456;
constexpr int LDSCTL_OFF = LDS_BYTES - 512;
constexpr int MISC_OFF = LDSCTL_OFF;

struct Params {
    const float* x; const float* c; const int* positions; const float* ada_w; const float* ada_b; const float* norm_mix_g; const float* norm_ffn_g; const float* final_norm_g;
    const float* even_w_in; const float* even_w_out; const float* gmlp_ln_g; const float* gmlp_ln_b; const float* gmlp_w_s; const float* gmlp_b_s; const float* hgrn_lb_logits; const float* hgrn_norm_g;
    const float* odd_w_qkv; const float* odd_w_out; const float* peer_w_query; const float* peer_sub_keys; const float* peer_down; const float* peer_up;
    float* out; unsigned char* ws; int ph_lo, ph_hi;
};
struct Ctx { LAS unsigned char* lds; int tid, lane, wave, vcu, G; };
__device__ __forceinline__ Ctx fresh_ctx(const Ctx& C0) { Ctx C = C0; int t_ = threadIdx.x; asm volatile("" : "+v"(t_)); C.tid = t_; C.lane = t_ & 63; C.wave = __builtin_amdgcn_readfirstlane(t_ >> 6); return C; }
struct Wk { int lv, n, c, h; };
#define W_TK0(W) ((W).h * (T / 2))
#define W_BT0(W) ((W).h * (NB / 2))
__device__ __forceinline__ unsigned char* w_ar(const Params& P, const Wk& W) { return P.ws + WS_AR0 + (size_t)W.h * AR_BYTES; }
__device__ __forceinline__ bf16* w_tok16(const Params& P, const Wk& W, size_t off, int pitch) { return (bf16*)(w_ar(P, W) + off) - (size_t)W_TK0(W) * pitch; }
__device__ __forceinline__ float* w_tok32(const Params& P, const Wk& W, size_t off, int pitch) { return (float*)(w_ar(P, W) + off) - (size_t)W_TK0(W) * pitch; }
__device__ __forceinline__ bf16* w_item16(const Params& P, const Wk& W, size_t off) { return (bf16*)(w_ar(P, W) + off) - (size_t)W_BT0(W) * 512 * 16384; }

__device__ __forceinline__ float wave_sum(float v) {
#pragma unroll
    for (int o = 1; o < 64; o <<= 1) v += __shfl_xor(v, o);
    return v;
}
__device__ __forceinline__ float silu_f(float x) { return x * __builtin_amdgcn_rcpf(1.0f + __builtin_amdgcn_exp2f(-1.4426950408889634f * x)); }
__device__ __forceinline__ float sigmoid_f(float x) { return __builtin_amdgcn_rcpf(1.0f + __builtin_amdgcn_exp2f(-1.4426950408889634f * x)); }
__device__ __forceinline__ float gelu_f(float x) { return 0.5f * x * (1.0f + erff(x * 0.70710678118654752f)); }
__device__ __forceinline__ f32x4 mma16(f32x4 acc, const LAS bf16* A, int lda, const LAS bf16* Bt, int ldb, int K, int r, int q4) {
    const LAS bf16* ap = A + r * lda + 8 * q4; const LAS bf16* bp = Bt + r * ldb + 8 * q4;
    for (int k0 = 0; k0 < K; k0 += 32) {
        const bf16x8 a = *(const LAS bf16x8*)(ap + k0); const bf16x8 b = *(const LAS bf16x8*)(bp + k0);
        acc = __builtin_amdgcn_mfma_f32_16x16x32_bf16(a, b, acc, 0, 0, 0);
    }
    return acc;
}

struct EpiBf16P {
    static constexpr bool PERM = true, AFTER_DRAIN = false;
    bf16* O; size_t ldc;
    __device__ __forceinline__ void operator()(const f32x4 (&acc)[2][2][4][2], const pg8::Unit& u, int wr, int wc, int fr, int fq) const {
        const int row0 = u.pm * 256 + wr * 64 + fr, col0 = u.pn * 256 + wc * 32 + 8 * fq;
#pragma unroll
        for (int ai = 0; ai < 2; ++ai)
#pragma unroll
            for (int m = 0; m < 4; ++m) { bf16* rowp = O + (size_t)(row0 + ai * 128 + m * 16) * ldc + col0;
#pragma unroll
                for (int bj = 0; bj < 2; ++bj) { const f32x4 v0 = acc[ai][bj][m][0], v1 = acc[ai][bj][m][1];
                    v4u w; w.x = pg8::cvt_pk_bf16(v0[0], v0[1]); w.y = pg8::cvt_pk_bf16(v0[2], v0[3]); w.z = pg8::cvt_pk_bf16(v1[0], v1[1]); w.w = pg8::cvt_pk_bf16(v1[2], v1[3]);
                    *(v4u*)(rowp + bj * 128) = w; } }
    }
};
#ifndef REP_HG
#define REP_HG 1
#endif
#ifndef REP_TOPK
#define REP_TOPK 1
#endif
#ifndef REP_PRO
#define REP_PRO 1
#endif
#ifndef REP_NORM
#define REP_NORM 1
#endif
#ifndef REP_GEMM2
#define REP_GEMM2 1
#endif
#ifndef REP_GEMM
#define REP_GEMM 1
#endif
#ifndef EXP_REP
#define EXP_REP 1
#endif
#ifndef ATT_REP
#define ATT_REP 1
#endif
#ifndef ABL_ON
#define ABL_ON 4
#endif
struct EpiResid {
    static constexpr bool PERM = true, AFTER_DRAIN = false;
    const float* xin; float* xout; const float* gate; float gsc;
    __device__ __forceinline__ void operator()(const f32x4 (&acc)[2][2][4][2], const pg8::Unit& u, int wr, int wc, int fr, int fq) const {
        const int row0 = u.pm * 256 + wr * 64 + fr, col0 = u.pn * 256 + wc * 32 + 8 * fq;
        const float* gp = gate + (size_t)((u.pm * 256) >> 13) * 6144 + col0;
        f32x4 gv[2][2];
#pragma unroll
        for (int bj = 0; bj < 2; ++bj) { gv[bj][0] = *(const f32x4*)(gp + bj * 128); gv[bj][1] = *(const f32x4*)(gp + bj * 128 + 4); }
#pragma unroll
        for (int ai = 0; ai < 2; ++ai)
#pragma unroll
            for (int m = 0; m < 4; ++m) { const size_t off = (size_t)(row0 + ai * 128 + m * 16) * 1024 + col0;
#pragma unroll
                for (int bj = 0; bj < 2; ++bj) {
                    const f32x4 x0 = *(const f32x4*)(xin + off + bj * 128), x1 = *(const f32x4*)(xin + off + bj * 128 + 4);
                    *(f32x4*)(xout + off + bj * 128) = x0 + gv[bj][0] * acc[ai][bj][m][0] * gsc;
                    *(f32x4*)(xout + off + bj * 128 + 4) = x1 + gv[bj][1] * acc[ai][bj][m][1] * gsc; }
                asm volatile("" ::: "memory"); }
    }
};
struct EpiInProj {
    static constexpr bool PERM = true, AFTER_DRAIN = false;
    bf16* PU; bf16* PV; bf16* PQ; bf16* PI; bf16* PG; float* G; const float* LB;
    __device__ __forceinline__ void operator()(const f32x4 (&acc)[2][2][4][2], const pg8::Unit& u, int wr, int wc, int fr, int fq) const {
        const int type = u.pn >> 1;
        const int row0 = u.pm * 256 + wr * 64 + fr, lc0 = (u.pn & 1) * 256 + wc * 32 + 8 * fq;
        if (type == 3) {
            f32x4 lb[2][2];
#pragma unroll
            for (int bj = 0; bj < 2; ++bj) { lb[bj][0] = *(const f32x4*)(LB + lc0 + bj * 128); lb[bj][1] = *(const f32x4*)(LB + lc0 + bj * 128 + 4); }
#pragma unroll
            for (int ai = 0; ai < 2; ++ai)
#pragma unroll
                for (int m = 0; m < 4; ++m) { float* rowp = G + (size_t)(row0 + ai * 128 + m * 16) * 512 + lc0;
#pragma unroll
                    for (int bj = 0; bj < 2; ++bj)
#pragma unroll
                        for (int n = 0; n < 2; ++n) { const f32x4 v = acc[ai][bj][m][n]; f32x4 o;
#pragma unroll
                            for (int e = 0; e < 4; ++e) { const float l = lb[bj][n][e]; const float f = l + (1.0f - l) * sigmoid_f(v[e]); o[e] = __logf(f); }
                            *(f32x4*)(rowp + bj * 128 + 4 * n) = o; } }
            return;
        }
        bf16* base = type == 0 ? PU : type == 1 ? PV : type == 2 ? PQ : type == 4 ? PI : PG;
#pragma unroll
        for (int ai = 0; ai < 2; ++ai)
#pragma unroll
            for (int m = 0; m < 4; ++m) { bf16* rowp = base + (size_t)(row0 + ai * 128 + m * 16) * 512 + lc0;
#pragma unroll
                for (int bj = 0; bj < 2; ++bj) { f32x4 v0 = acc[ai][bj][m][0], v1 = acc[ai][bj][m][1];
                    if (type <= 1) { pg8::f32x2 a = pg8::gelu_pk((pg8::f32x2){v0[0], v0[1]}), b = pg8::gelu_pk((pg8::f32x2){v0[2], v0[3]}), c = pg8::gelu_pk((pg8::f32x2){v1[0], v1[1]}), d = pg8::gelu_pk((pg8::f32x2){v1[2], v1[3]});
                        v0 = (f32x4){a.x, a.y, b.x, b.y}; v1 = (f32x4){c.x, c.y, d.x, d.y}; }
                    else if (type == 2) {
#pragma unroll
                        for (int e = 0; e < 4; ++e) { v0[e] = silu_f(v0[e]) * 0.08838834764831845f; v1[e] = silu_f(v1[e]) * 0.08838834764831845f; } }
                    else if (type == 5) {
#pragma unroll
                        for (int e = 0; e < 4; ++e) { v0[e] = silu_f(v0[e]); v1[e] = silu_f(v1[e]); } }
                    v4u w; w.x = pg8::cvt_pk_bf16(v0[0], v0[1]); w.y = pg8::cvt_pk_bf16(v0[2], v0[3]); w.z = pg8::cvt_pk_bf16(v1[0], v1[1]); w.w = pg8::cvt_pk_bf16(v1[2], v1[3]);
                    *(v4u*)(rowp + bj * 128) = w; } }
    }
};
struct EpiQKRot {
    static constexpr bool PERM = true, AFTER_DRAIN = false;
    bf16* O; const float* CS;
    __device__ __forceinline__ void operator()(const f32x4 (&acc)[2][2][4][2], const pg8::Unit& u, int wr, int wc, int fr, int fq) const {
        const int row0 = u.pm * 256 + wr * 64 + fr, col0 = u.pn * 256 + wc * 32 + 8 * fq;
        const float sc = u.pn < 4 ? C2 : 1.0f;
        const bool rotw = (wc & 1) == 0 && u.pn < 8;
        const float sgn = fq == 0 ? -1.0f : 1.0f;
#pragma unroll
        for (int ai = 0; ai < 2; ++ai)
#pragma unroll
            for (int m = 0; m < 4; ++m) { const int row = row0 + ai * 128 + m * 16; bf16* rowp = O + (size_t)row * 3072 + col0;
                f32x4 c0 = (f32x4){1.f, 1.f, 1.f, 1.f}, c1 = c0, s0 = (f32x4){0.f, 0.f, 0.f, 0.f}, s1 = s0;
                if (rotw && fq < 2) { const float* cp = CS + (size_t)row * 16; c0 = *(const f32x4*)(cp); c1 = *(const f32x4*)(cp + 4); s0 = *(const f32x4*)(cp + 8) * sgn; s1 = *(const f32x4*)(cp + 12) * sgn; }
#pragma unroll
                for (int bj = 0; bj < 2; ++bj) { f32x4 v0 = acc[ai][bj][m][0], v1 = acc[ai][bj][m][1];
                    if (rotw) { f32x4 p0, p1;
#pragma unroll
                        for (int e = 0; e < 4; ++e) { p0[e] = __shfl_xor(v0[e], 16); p1[e] = __shfl_xor(v1[e], 16); }
                        v0 = v0 * c0 + p0 * s0; v1 = v1 * c1 + p1 * s1; }
                    v0 = v0 * sc; v1 = v1 * sc;
                    v4u w; w.x = pg8::cvt_pk_bf16(v0[0], v0[1]); w.y = pg8::cvt_pk_bf16(v0[2], v0[3]); w.z = pg8::cvt_pk_bf16(v1[0], v1[1]); w.w = pg8::cvt_pk_bf16(v1[2], v1[3]);
                    *(v4u*)(rowp + bj * 128) = w; } }
    }
};

__device__ __forceinline__ void p0_transpose_item(const float* W, int K, int N, bf16* WT, LAS float* scr, int item, int lane) {
    const int nblk = N / 32, kb = item / nblk, nb = item % nblk, k0 = 64 * kb, n0 = 32 * nb;
#pragma unroll 8
    for (int i = 0; i < 32; ++i) { const int kk = 2 * i + (lane >> 5); scr[kk * 33 + (lane & 31)] = W[(size_t)(k0 + kk) * N + n0 + (lane & 31)]; }
    LDS_WAIT(); asm volatile("" ::: "memory");
    const int c = lane & 7;
#pragma unroll
    for (int j = 0; j < 4; ++j) { const int n = (lane >> 3) + 8 * j; const LAS float* s = scr + (8 * c) * 33 + n;
        v4u o; o.x = pk2(s[0 * 33], s[1 * 33]); o.y = pk2(s[2 * 33], s[3 * 33]); o.z = pk2(s[4 * 33], s[5 * 33]); o.w = pk2(s[6 * 33], s[7 * 33]);
        *(GAS v4u*)(WT + (size_t)(n0 + n) * K + k0 + 8 * c) = o; }
    LDS_WAIT(); asm volatile("" ::: "memory");
}
typedef float f32x2 __attribute__((ext_vector_type(2)));
typedef float f32x16v __attribute__((ext_vector_type(16)));
typedef float f32x32v __attribute__((ext_vector_type(32)));
typedef unsigned v6u __attribute__((ext_vector_type(6)));
__device__ __forceinline__ void convert_tables(const Params& P, const Ctx& C) {
    const int gw = C.vcu * NWAVES + C.wave, NGW = C.G * NWAVES, lane = C.lane, hl = lane & 31;
    LAS float* stg = (LAS float*)(C.lds + C.wave * 16384);
    for (int rp = gw; rp < 2 * 16384; rp += NGW) {
#pragma unroll
        for (int rr = 0; rr < 2; ++rr) { const int row_ = 2 * rp + rr, tb_ = row_ >> 14, e_ = row_ & 16383;
            const f32x4* src = (const f32x4*)(((tb_ & 1) ? P.peer_up : P.peer_down) + ((size_t)(tb_ >> 1) * 16384 + e_) * 1024);
#pragma unroll
            for (int j = 0; j < 4; ++j) *(LAS f32x4*)(stg + rr * 1024 + 4 * (64 * j + lane)) = src[64 * j + lane]; }
        LDS_WAIT(); asm volatile("" ::: "memory");
        const int row = 2 * rp + (lane >> 5), tb = row >> 14, e = row & 16383;
        const LAS f32x4* sp = (const LAS f32x4*)(stg + (lane >> 5) * 1024 + 32 * hl);
        unsigned char* dst = P.ws + WS_TAB8 + (size_t)tb * TAB8_BYTES + (size_t)e * TROW + 24 * hl;
        f32x16v a, b2; float mx = 0.f;
#pragma unroll
        for (int j = 0; j < 4; ++j) { const f32x4 v = sp[j], w = sp[4 + j];
#pragma unroll
            for (int i = 0; i < 4; ++i) { mx = fmaxf(mx, fmaxf(fabsf(v[i]), fabsf(w[i]))); }
            a[2 * j] = v[0]; b2[2 * j] = v[1]; a[2 * j + 1] = v[2]; b2[2 * j + 1] = v[3]; a[8 + 2 * j] = w[0]; b2[8 + 2 * j] = w[1]; a[8 + 2 * j + 1] = w[2]; b2[8 + 2 * j + 1] = w[3]; }
        LDS_WAIT(); asm volatile("" ::: "memory");
#pragma unroll
        for (int o = 1; o < 32; o <<= 1) mx = fmaxf(mx, __shfl_xor(mx, o));
        const float sc = mx > 0.f ? 7.0f / mx : 0.f;
        a = a * sc; b2 = b2 * sc;
        const v6u p = __builtin_amdgcn_cvt_scalef32_2xpk16_fp6_f32(a, b2, 1.0f);
        unsigned long long* d8 = (unsigned long long*)dst;
        d8[0] = ((unsigned long long)p[1] << 32) | p[0]; d8[1] = ((unsigned long long)p[3] << 32) | p[2]; d8[2] = ((unsigned long long)p[5] << 32) | p[4];
        if (hl == 0) ((float*)(P.ws + WS_SC8))[row] = mx * (1.0f / 7.0f);
    }
}
__device__ __forceinline__ void phase_prologue(const Params& P, const Ctx& C) {
    float* MOD = (float*)(P.ws + WS_MOD);
    {
        LAS float* cond = (LAS float*)C.lds;
        LAS float* part = (LAS float*)(C.lds + 32768);
        for (int e = C.tid; e < 8192; e += 512) cond[e] = silu_f(P.c[e]);
        __syncthreads();
        for (int item = C.vcu; item < 192; item += C.G) {
            const int l = item / 96, cb = item % 96, col = cb * 64 + C.lane;
            float acc[8];
#pragma unroll
            for (int b = 0; b < 8; ++b) acc[b] = 0.f;
            const float* wp = P.ada_w + ((size_t)l * 1024 + C.wave * 128) * 6144 + col;
#pragma unroll 4
            for (int k = 0; k < 128; ++k) { const float wv = wp[(size_t)k * 6144];
#pragma unroll
                for (int b = 0; b < 8; ++b) acc[b] += cond[b * 1024 + C.wave * 128 + k] * wv; }
#pragma unroll
            for (int b = 0; b < 8; ++b) part[(C.wave * 8 + b) * 64 + C.lane] = acc[b];
            __syncthreads();
            { const int b = C.tid >> 6, ln = C.tid & 63; float s = P.ada_b[l * 6144 + cb * 64 + ln];
#pragma unroll
              for (int w = 0; w < 8; ++w) s += part[(w * 8 + b) * 64 + ln];
              MOD[(size_t)(l * 8 + b) * 6144 + cb * 64 + ln] = s; }
            __syncthreads();
        }
        __syncthreads();
    }
    {
        LAS float* scr = (LAS float*)(C.lds + C.wave * 16384);
        const int gw = C.vcu * NWAVES + C.wave, NGW = C.G * NWAVES;
        for (int it = gw; it < 6144; it += NGW) {
            int r = it;
            if (r < 1536) { p0_transpose_item(P.even_w_in, 1024, 3072, (bf16*)(P.ws + WS_WIN), scr, r, C.lane); continue; } r -= 1536;
            if (r < 512)  { p0_transpose_item(P.even_w_out, 1024, 1024, (bf16*)(P.ws + WS_WOUT0), scr, r, C.lane); continue; } r -= 512;
            if (r < 1536) { p0_transpose_item(P.odd_w_qkv, 1024, 3072, (bf16*)(P.ws + WS_WQKV), scr, r, C.lane); continue; } r -= 1536;
            if (r < 512)  { p0_transpose_item(P.odd_w_out, 1024, 1024, (bf16*)(P.ws + WS_WOUT1), scr, r, C.lane); continue; } r -= 512;
            if (r < 1024) { p0_transpose_item(P.peer_w_query, 1024, 2048, (bf16*)(P.ws + WS_WQ0), scr, r, C.lane); continue; } r -= 1024;
            p0_transpose_item(P.peer_w_query + (size_t)1024 * 2048, 1024, 2048, (bf16*)(P.ws + WS_WQ1), scr, r, C.lane);
        }
    }
    convert_tables(P, C);
    const int NT = C.G * 512, gt = C.vcu * 512 + C.tid;
    { bf16* skb = (bf16*)(P.ws + WS_SKB); for (int i = gt; i < 65536; i += NT) skb[i] = (bf16)f2bf(P.peer_sub_keys[i]); }
    { bf16* wsb = (bf16*)(P.ws + WS_WSB); for (int i = gt; i < 65536; i += NT) { const int t = (i >> 7) & 127, s = i & 127; wsb[i] = (bf16)(s <= t ? f2bf(P.gmlp_w_s[i]) : 0u); } }
    { float* lb = (float*)(P.ws + WS_LB); for (int i = gt; i < 512; i += NT) { const float l0 = P.hgrn_lb_logits[i], l1 = P.hgrn_lb_logits[512 + i]; lb[i] = 1.0f / (1.0f + expf(l1 - l0)); } }
    { float* cs = (float*)(P.ws + WS_CS); for (int i = gt; i < T * 8; i += NT) { const int tok = i >> 3, j = i & 7;
        const float inv = 1.0f / powf(500000.0f, (float)j * 0.125f); const float ang = (float)P.positions[tok] * inv; float sn, cn; sincosf(ang, &sn, &cn);
        cs[(size_t)tok * 16 + j] = cn; cs[(size_t)tok * 16 + 8 + j] = sn; } }
}
__device__ __forceinline__ void norm_row_bf16(const float* xrow, bf16* hrow, const float* g, const float* sh, const float* sc, int lane) {
    const f32x4* xr = (const f32x4*)xrow + lane; f32x4 v[4]; float s = 0.f;
#pragma unroll
    for (int j = 0; j < 4; ++j) { v[j] = xr[64 * j]; s += (v[j][0] * v[j][0] + v[j][1] * v[j][1]) + (v[j][2] * v[j][2] + v[j][3] * v[j][3]); }
    const float rstd = 1.0f / sqrtf(wave_sum(s) * (1.0f / 1024.0f) + NORM_EPS);
    unsigned long long* o8 = (unsigned long long*)hrow + lane;
#pragma unroll
    for (int j = 0; j < 4; ++j) { const f32x4 gg = ((const f32x4*)g)[64 * j + lane], hh = ((const f32x4*)sh)[64 * j + lane], cc = ((const f32x4*)sc)[64 * j + lane];
        const f32x4 y = (v[j] * rstd * gg) * (cc + 1.0f) + hh;
        o8[64 * j] = (unsigned long long)pk2(y[0], y[1]) | ((unsigned long long)pk2(y[2], y[3]) << 32); }
}
__device__ __forceinline__ void phase_norm(const Params& P, const Ctx& C, const Wk& W, const float* xsrc, const float* g, int l, int so) {
    const float* MOD = (const float*)(P.ws + WS_MOD); bf16* H = (bf16*)(P.ws + WS_H);
    const int gw = W.lv * NWAVES + C.wave, NGW = W.n * NWAVES;
    for (int m = W_TK0(W) + gw; m < W_TK0(W) + HT; m += NGW) { const float* mb = MOD + (size_t)(l * 8 + (m >> 13)) * 6144 + so;
        norm_row_bf16(xsrc + (size_t)m * 1024, H + (size_t)m * 1024, g, mb, mb + 1024, C.lane); }
}

__device__ __forceinline__ void gmlp_item(const Params& P, const Ctx& C, const Wk& W, int n, int g) {
    LAS bf16* Wt = (LAS bf16*)C.lds;
    LAS bf16* vT = (LAS bf16*)(C.lds + 34816);
    const bf16* WSB = (const bf16*)(P.ws + WS_WSB); const bf16* PU = w_tok16(P, W, AR_PU, 512); const bf16* PV = w_tok16(P, W, AR_PV, 512); bf16* MIX = (bf16*)(P.ws + WS_H);
    const int tid = C.tid, r = C.lane & 15, q4 = C.lane >> 4;
    for (int ch = tid; ch < 2048; ch += 512) { const int rr = ch >> 4, c8 = (ch & 15) * 8; *(LAS v4u*)(Wt + rr * 136 + c8) = *(const v4u*)(WSB + (size_t)(g * 128 + rr) * 128 + c8); }
    { const int t = tid >> 2, part = tid & 3; const bf16* src = PV + (size_t)(n * 128 + t) * 512 + g * 128 + part * 32;
      float x[32];
#pragma unroll
      for (int j = 0; j < 4; ++j) { const v4u w = *(const v4u*)(src + 8 * j);
#pragma unroll
          for (int e = 0; e < 4; ++e) { x[8 * j + 2 * e] = bflo(w[e]); x[8 * j + 2 * e + 1] = bfhi(w[e]); } }
      float s = 0.f;
#pragma unroll
      for (int j = 0; j < 32; ++j) s += x[j];
      s += __shfl_xor(s, 1); s += __shfl_xor(s, 2);
      const float mean = s * (1.0f / 128.0f); float q = 0.f;
#pragma unroll
      for (int j = 0; j < 32; ++j) { const float d = x[j] - mean; q += d * d; }
      q += __shfl_xor(q, 1); q += __shfl_xor(q, 2);
      const float rstd = 1.0f / sqrtf(q * (1.0f / 128.0f) + NORM_EPS);
      const float* lg = P.gmlp_ln_g + g * 128 + part * 32; const float* lbp = P.gmlp_ln_b + g * 128 + part * 32;
#pragma unroll
      for (int j = 0; j < 32; ++j) vT[(part * 32 + j) * 136 + t] = (bf16)f2bf((x[j] - mean) * rstd * lg[j] + lbp[j]);
    }
    __syncthreads();
    const int t0 = 16 * C.wave; const int Keff = ((t0 + 16 + 31) >> 5) << 5;
    f32x4 acc[8];
#pragma unroll
    for (int ct = 0; ct < 8; ++ct) { acc[ct] = (f32x4){0.f, 0.f, 0.f, 0.f}; acc[ct] = mma16(acc[ct], Wt + t0 * 136, 136, vT + (16 * ct) * 136, 136, Keff, r, q4); }
#pragma unroll
    for (int i = 0; i < 4; ++i) { const int t = t0 + 4 * q4 + i; const float bs = P.gmlp_b_s[g * 128 + t]; const size_t tok = (size_t)n * 128 + t;
#pragma unroll
        for (int ct = 0; ct < 8; ++ct) { const int c = 16 * ct + r; const float u = bf2f(PU[tok * 512 + g * 128 + c]); MIX[tok * 1024 + g * 128 + c] = (bf16)f2bf(u * (acc[ct][i] + bs)); } }
    __syncthreads();
}
__device__ __forceinline__ void hgrn_cumsum16(const float* G, size_t tok0, int hh, int k, int seg, LAS float* tot, float (&g)[16], float (&bb)[16], float& total) {
    const float* gp = G + (tok0 + seg * 16) * 512 + hh * 128 + k;
#pragma unroll
    for (int j = 0; j < 16; ++j) g[j] = gp[(size_t)j * 512];
    float run = 0.f;
#pragma unroll
    for (int j = 0; j < 16; ++j) { run += g[j]; bb[j] = run; }
    tot[seg * 128 + k] = run;
    __syncthreads();
    const float t0 = tot[k], t1 = tot[128 + k], t2 = tot[256 + k], t3 = tot[384 + k];
    const float pre = seg == 0 ? 0.f : seg == 1 ? t0 : seg == 2 ? t0 + t1 : t0 + t1 + t2;
    total = (t0 + t1) + (t2 + t3);
#pragma unroll
    for (int j = 0; j < 16; ++j) bb[j] += pre;
}
__device__ __forceinline__ void hgrn_stage_iT(const bf16* PI, size_t tok0, int hh, LAS bf16* iT, int tid) {
    const int s = tid >> 3, v0 = (tid & 7) * 16; const bf16* src = PI + (tok0 + s) * 512 + hh * 128 + v0;
#pragma unroll
    for (int h2 = 0; h2 < 2; ++h2) { const v4u w = *(const v4u*)(src + 8 * h2);
#pragma unroll
        for (int e = 0; e < 4; ++e) { iT[(v0 + 8 * h2 + 2 * e) * 72 + s] = (bf16)(w[e] & 0xffffu); iT[(v0 + 8 * h2 + 2 * e + 1) * 72 + s] = (bf16)(w[e] >> 16); } }
}
__device__ __forceinline__ void hgrn_local_item(const Params& P, const Ctx& C, const Wk& W, int item) {
    LAS bf16* khT = (LAS bf16*)C.lds;
    LAS bf16* iT = (LAS bf16*)(C.lds + 18432);
    LAS float* tot = (LAS float*)(C.lds + 36864);
    const float* G = w_tok32(P, W, AR_G, 512); const bf16* PI = w_tok16(P, W, AR_PI, 512); bf16* KVT = w_item16(P, W, AR_KVT); float* HD = (float*)(P.ws + WS_HD);
    const int bh = item >> 7, c = item & 127, b = bh >> 2, hh = bh & 3; const size_t tok0 = (size_t)b * SEQ + c * 64;
    const int tid = C.tid, k = tid & 127, seg = tid >> 7, r = C.lane & 15, q4 = C.lane >> 4;
    float g[16], bb[16], total;
    hgrn_cumsum16(G, tok0, hh, k, seg, tot, g, bb, total);
    { unsigned w[8];
#pragma unroll
      for (int j = 0; j < 8; ++j) { const float a0 = -expm1f(g[2 * j]) * __expf(total - bb[2 * j]), a1 = -expm1f(g[2 * j + 1]) * __expf(total - bb[2 * j + 1]); w[j] = pk2(a0, a1); }
      LAS v4u* dst = (LAS v4u*)(khT + k * 72 + seg * 16); dst[0] = (v4u){w[0], w[1], w[2], w[3]}; dst[1] = (v4u){w[4], w[5], w[6], w[7]}; }
    if (seg == 0) HD[(size_t)item * 128 + k] = __expf(total);
    hgrn_stage_iT(PI, tok0, hh, iT, tid);
    __syncthreads();
    const int v0 = 16 * C.wave;
#pragma unroll
    for (int ct = 0; ct < 8; ++ct) { f32x4 acc = (f32x4){0.f, 0.f, 0.f, 0.f}; acc = mma16(acc, iT + v0 * 72, 72, khT + (16 * ct) * 72, 72, 64, r, q4);
#pragma unroll
        for (int i = 0; i < 4; ++i) KVT[((size_t)item * 128 + v0 + 4 * q4 + i) * 128 + 16 * ct + r] = (bf16)f2bf(acc[i]); }
    __syncthreads();
}
__device__ __forceinline__ void phase_hgrn_scan(const Params& P, const Ctx& C, const Wk& W) {
    const bf16* KVT = w_item16(P, W, AR_KVT); bf16* ST = w_item16(P, W, AR_ST); const float* HD = (const float*)(P.ws + WS_HD);
    for (int task = W.lv * 256 + C.tid; C.tid < 256 && task < 32768; task += W.n * 256) {
        const int bh = W_BT0(W) * 4 + (task >> 11), v = (task >> 4) & 127, kb = task & 15;
        float st[8];
#pragma unroll
        for (int e = 0; e < 8; ++e) st[e] = 0.f;
#pragma unroll 4
        for (int c = 0; c < 128; ++c) { const size_t item = (size_t)bh * 128 + c, off = (item * 128 + v) * 128 + kb * 8;
            const v4u kv = *(const v4u*)(KVT + off); const f32x4 d0 = *(const f32x4*)(HD + item * 128 + kb * 8), d1 = *(const f32x4*)(HD + item * 128 + kb * 8 + 4);
            v4u o; o.x = pk2(st[0], st[1]); o.y = pk2(st[2], st[3]); o.z = pk2(st[4], st[5]); o.w = pk2(st[6], st[7]);
            *(v4u*)(ST + off) = o;
#pragma unroll
            for (int e = 0; e < 4; ++e) { st[2 * e] = (e < 2 ? d0[2 * e] : d1[2 * e - 4]) * st[2 * e] + bflo(kv[e]); st[2 * e + 1] = (e < 2 ? d0[2 * e + 1] : d1[2 * e - 3]) * st[2 * e + 1] + bfhi(kv[e]); }
        }
    }
}
__device__ __forceinline__ void hgrn_out_item(const Params& P, const Ctx& C, const Wk& W, int item) {
    LAS bf16* qt = (LAS bf16*)C.lds;
    LAS bf16* kt = (LAS bf16*)(C.lds + 17408);
    LAS bf16* iT = (LAS bf16*)(C.lds + 34816);
    LAS bf16* A1 = (LAS bf16*)(C.lds + 53248);
    LAS bf16* STl = (LAS bf16*)(C.lds + 62464);
    LAS float* ol = (LAS float*)(C.lds + 97280);
    LAS float* tot = (LAS float*)(C.lds + 131072);
    const float* G = w_tok32(P, W, AR_G, 512); const bf16* PQ = w_tok16(P, W, AR_PQ, 512); const bf16* PI = w_tok16(P, W, AR_PI, 512); const bf16* PG = w_tok16(P, W, AR_PG, 512);
    const bf16* ST = w_item16(P, W, AR_ST); bf16* MIX = (bf16*)(P.ws + WS_H);
    const int bh = item >> 7, c = item & 127, b = bh >> 2, hh = bh & 3; const size_t tok0 = (size_t)b * SEQ + c * 64;
    const int tid = C.tid, k = tid & 127, seg = tid >> 7, r = C.lane & 15, q4 = C.lane >> 4;
    float g[16], bb[16], total;
    hgrn_cumsum16(G, tok0, hh, k, seg, tot, g, bb, total);
#pragma unroll
    for (int j = 0; j < 16; ++j) { const int t = seg * 16 + j; const float qv = bf2f(PQ[(tok0 + t) * 512 + hh * 128 + k]);
        qt[t * 136 + k] = (bf16)f2bf(qv * __expf(bb[j])); kt[t * 136 + k] = (bf16)f2bf(-expm1f(g[j]) * __expf(-bb[j])); }
    hgrn_stage_iT(PI, tok0, hh, iT, tid);
    for (int ch = tid; ch < 2048; ch += 512) { const int rr = ch >> 4, c8 = (ch & 15) * 8; *(LAS v4u*)(STl + rr * 136 + c8) = *(const v4u*)(ST + ((size_t)item * 128 + rr) * 128 + c8); }
    __syncthreads();
    { const int rt = C.wave >> 1;
#pragma unroll
      for (int cc = 0; cc < 2; ++cc) { const int ct = (C.wave & 1) * 2 + cc; f32x4 acc = (f32x4){0.f, 0.f, 0.f, 0.f};
          acc = mma16(acc, qt + (16 * rt) * 136, 136, kt + (16 * ct) * 136, 136, 128, r, q4);
#pragma unroll
          for (int i = 0; i < 4; ++i) { const int t = 16 * rt + 4 * q4 + i, s = 16 * ct + r; A1[t * 72 + s] = (bf16)(s <= t ? f2bf(acc[i]) : 0u); } } }
    __syncthreads();
    { const int rt = C.wave >> 1;
#pragma unroll
      for (int cc = 0; cc < 4; ++cc) { const int ct = (C.wave & 1) * 4 + cc; f32x4 acc = (f32x4){0.f, 0.f, 0.f, 0.f};
          acc = mma16(acc, A1 + (16 * rt) * 72, 72, iT + (16 * ct) * 72, 72, 64, r, q4);
          acc = mma16(acc, qt + (16 * rt) * 136, 136, STl + (16 * ct) * 136, 136, 128, r, q4);
#pragma unroll
          for (int i = 0; i < 4; ++i) ol[(16 * rt + 4 * q4 + i) * 132 + 16 * ct + r] = acc[i]; } }
    __syncthreads();
    { const int t = tid >> 3, v0 = (tid & 7) * 16; float o[16]; float ss = 0.f;
#pragma unroll
      for (int e = 0; e < 16; ++e) { o[e] = ol[t * 132 + v0 + e]; ss += o[e] * o[e]; }
      ss += __shfl_xor(ss, 1); ss += __shfl_xor(ss, 2); ss += __shfl_xor(ss, 4);
      const float rstd = 1.0f / sqrtf(ss * (1.0f / 128.0f) + NORM_EPS);
      const float* ng = P.hgrn_norm_g + hh * 128 + v0; const bf16* gp = PG + (tok0 + t) * 512 + hh * 128 + v0;
      const v4u g0 = *(const v4u*)gp, g1 = *(const v4u*)(gp + 8); unsigned w[8];
#pragma unroll
      for (int e = 0; e < 4; ++e) { w[e] = pk2(o[2 * e] * rstd * ng[2 * e] * bflo(g0[e]), o[2 * e + 1] * rstd * ng[2 * e + 1] * bfhi(g0[e]));
                                    w[4 + e] = pk2(o[8 + 2 * e] * rstd * ng[8 + 2 * e] * bflo(g1[e]), o[9 + 2 * e] * rstd * ng[9 + 2 * e] * bfhi(g1[e])); }
      v4u* dst = (v4u*)(MIX + (tok0 + t) * 1024 + 512 + hh * 128 + v0); dst[0] = (v4u){w[0], w[1], w[2], w[3]}; dst[1] = (v4u){w[4], w[5], w[6], w[7]}; }
    __syncthreads();
}

typedef short v4i16_t __attribute__((ext_vector_type(4)));
constexpr int AT_VP = 144;
constexpr int AT_QI = 512;
constexpr int AT_STO = 0, AT_STML = AT_QI * 128, AT_VW = AT_STML + AT_QI * 8;
__device__ __forceinline__ void attn_softmax_block(f32x4 (&sa)[9], int tile0, int qq, int mq0, int q4, float& mx, float& ls, bf16x8 (&pf)[5]) {
    mx = -1e30f;
#pragma unroll
    for (int t = 0; t < 9; ++t)
#pragma unroll
        for (int i = 0; i < 4; ++i) { const int kap = 16 * (tile0 + t) + 4 * q4 + i; const bool ok = kap >= qq && kap <= qq + 128 && (mq0 - 128 + kap) >= 0;
            sa[t][i] = ok ? sa[t][i] : -1e30f; mx = fmaxf(mx, sa[t][i]); }
    mx = fmaxf(mx, __shfl_xor(mx, 16)); mx = fmaxf(mx, __shfl_xor(mx, 32));
    ls = 0.f;
#pragma unroll
    for (int t = 0; t < 9; ++t)
#pragma unroll
        for (int i = 0; i < 4; ++i) { const float pv = sa[t][i] > -1e29f ? __builtin_amdgcn_exp2f(sa[t][i] - mx) : 0.f; sa[t][i] = pv; ls += pv; }
    ls += __shfl_xor(ls, 16); ls += __shfl_xor(ls, 32);
#pragma unroll
    for (int s2 = 0; s2 < 5; ++s2) { const int tl = 2 * s2 - tile0, th = 2 * s2 + 1 - tile0;
        const f32x4 lo = (tl >= 0 && tl < 9) ? sa[(tl >= 0 && tl < 9) ? tl : 0] : (f32x4){0.f, 0.f, 0.f, 0.f}, hi = (th >= 0 && th < 9) ? sa[(th >= 0 && th < 9) ? th : 0] : (f32x4){0.f, 0.f, 0.f, 0.f};
        v4u w; w.x = pk2(lo[0], lo[1]); w.y = pk2(lo[2], lo[3]); w.z = pk2(hi[0], hi[1]); w.w = pk2(hi[2], hi[3]); pf[s2] = __builtin_bit_cast(bf16x8, w); }
}
__device__ __forceinline__ void attn_merge(int g, LAS unsigned char* lds, int qloc, int q4, f32x4 (&oa)[4], float mx, float ls, bf16* orow) {
    LAS unsigned char* so = lds + AT_STO + qloc * 128 + 8 * q4; LAS float* sml = (LAS float*)(lds + AT_STML) + 2 * qloc;
    float mo = mx, lo2 = ls;
    if (g > 0) { const float m_old = sml[0], l_old = sml[1]; const float M = fmaxf(m_old, mx); const float fo = __builtin_amdgcn_exp2f(m_old - M), fn = __builtin_amdgcn_exp2f(mx - M);
#pragma unroll
        for (int dt = 0; dt < 4; ++dt) { const unsigned long long w = *(const LAS unsigned long long*)(so + 32 * dt); const unsigned w0 = (unsigned)w, w1 = (unsigned)(w >> 32);
            oa[dt] = oa[dt] * fn + (f32x4){bflo(w0), bfhi(w0), bflo(w1), bfhi(w1)} * fo; }
        mo = M; lo2 = ls * fn + l_old * fo; }
    if (g < 2) {
#pragma unroll
        for (int dt = 0; dt < 4; ++dt) *(LAS unsigned long long*)(so + 32 * dt) = (unsigned long long)pk2(oa[dt][0], oa[dt][1]) | ((unsigned long long)pk2(oa[dt][2], oa[dt][3]) << 32);
        if (q4 == 0) { sml[0] = mo; sml[1] = lo2; }
    } else { const float inv = 1.0f / lo2;
#pragma unroll
        for (int dt = 0; dt < 4; ++dt) { const f32x4 v = oa[dt] * inv; *(unsigned long long*)(orow + 16 * dt) = (unsigned long long)pk2(v[0], v[1]) | ((unsigned long long)pk2(v[2], v[3]) << 32); } }
}
__device__ __forceinline__ void attn_item(const Params& P, const Ctx& C, const Wk& W, int b, int hd, int qt) {
    LAS unsigned char* Vw = C.lds + AT_VW + C.wave * (64 * AT_VP);
    const bf16* QKV = w_tok16(P, W, AR_QK, 3072); bf16* O = (bf16*)(P.ws + WS_H);
    const int lane = C.lane, r = lane & 15, q4 = lane >> 4;
    const int t0 = qt * AT_QI; const size_t rowbase = (size_t)b * SEQ;
    const bf16* Kb = QKV + rowbase * 3072 + 1024 + hd * 64; const bf16* Vb = QKV + rowbase * 3072 + 2048 + hd * 64;
#pragma unroll 1
    for (int g = 0; g < 3; ++g) {
        const int dsh = 4 - 2 * g, d = 1 << dsh;
#pragma unroll 1
        for (int uu = 0; uu < 2; ++uu) {
            const int u = C.wave + 8 * uu;
            const int c = u & (d - 1), j = u >> dsh;
            const int mq0 = (t0 >> dsh) + 32 * j;
            const int ql0 = c + d * (32 * j + r), ql1 = ql0 + 16 * d;
            const bf16* qp0 = QKV + (rowbase + t0 + ql0) * 3072 + hd * 64 + 8 * q4; const bf16* qp1 = QKV + (rowbase + t0 + ql1) * 3072 + hd * 64 + 8 * q4;
            const bf16x8 bq00 = *(const bf16x8*)qp0, bq01 = *(const bf16x8*)(qp0 + 32), bq10 = *(const bf16x8*)qp1, bq11 = *(const bf16x8*)(qp1 + 32);
            bf16x8 ka[10][2];
#pragma unroll
            for (int t = 0; t < 10; ++t) { int mk = mq0 - 128 + 16 * t + r; mk = mk < 0 ? 0 : mk;
                const bf16* kp = Kb + (size_t)(c + d * mk) * 3072 + 8 * q4; ka[t][0] = *(const bf16x8*)kp; ka[t][1] = *(const bf16x8*)(kp + 32); }
            v4u vr[2][8];
#pragma unroll
            for (int it = 0; it < 8; ++it) { const int kap = 8 * it + (lane >> 3); int mk = mq0 - 128 + kap; mk = mk < 0 ? 0 : mk;
                vr[0][it] = *(const v4u*)(Vb + (size_t)(c + d * mk) * 3072 + (lane & 7) * 8); }
            __builtin_amdgcn_sched_barrier(0);
            bf16x8 pf0[5], pf1[5]; float mx0, ls0, mx1, ls1;
            { f32x4 sa[9];
#pragma unroll
              for (int t = 0; t < 9; ++t) { sa[t] = (f32x4){0.f, 0.f, 0.f, 0.f}; sa[t] = __builtin_amdgcn_mfma_f32_16x16x32_bf16(ka[t][0], bq00, sa[t], 0, 0, 0); sa[t] = __builtin_amdgcn_mfma_f32_16x16x32_bf16(ka[t][1], bq01, sa[t], 0, 0, 0); }
              attn_softmax_block(sa, 0, r, mq0, q4, mx0, ls0, pf0); }
            { f32x4 sa[9];
#pragma unroll
              for (int t = 0; t < 9; ++t) { sa[t] = (f32x4){0.f, 0.f, 0.f, 0.f}; sa[t] = __builtin_amdgcn_mfma_f32_16x16x32_bf16(ka[t + 1][0], bq10, sa[t], 0, 0, 0); sa[t] = __builtin_amdgcn_mfma_f32_16x16x32_bf16(ka[t + 1][1], bq11, sa[t], 0, 0, 0); }
              __builtin_amdgcn_sched_barrier(0);
#pragma unroll
              for (int it = 0; it < 8; ++it) { const int kap = 64 + 8 * it + (lane >> 3); int mk = mq0 - 128 + kap; mk = mk < 0 ? 0 : mk;
                  vr[1][it] = *(const v4u*)(Vb + (size_t)(c + d * mk) * 3072 + (lane & 7) * 8); }
              __builtin_amdgcn_sched_barrier(0);
              attn_softmax_block(sa, 1, 16 + r, mq0, q4, mx1, ls1, pf1); }
            v4u vr2[4];
#pragma unroll
            for (int it = 0; it < 4; ++it) { const int kap = 128 + 8 * it + (lane >> 3); const int mk = mq0 - 128 + kap;
                vr2[it] = *(const v4u*)(Vb + (size_t)(c + d * mk) * 3072 + (lane & 7) * 8); }
            f32x4 oa0[4], oa1[4];
#pragma unroll
            for (int dt = 0; dt < 4; ++dt) { oa0[dt] = (f32x4){0.f, 0.f, 0.f, 0.f}; oa1[dt] = (f32x4){0.f, 0.f, 0.f, 0.f}; }
#pragma unroll
            for (int ch = 0; ch < 3; ++ch) {
#pragma unroll
                for (int it = 0; it < 8; ++it) { const int row = 8 * it + (lane >> 3);
                    if (ch < 2) *(LAS v4u*)(Vw + row * AT_VP + (lane & 7) * 16) = vr[ch < 2 ? ch : 0][it];
                    else if (it < 4) *(LAS v4u*)(Vw + row * AT_VP + (lane & 7) * 16) = vr2[it < 4 ? it : 0]; }
                asm volatile("s_waitcnt lgkmcnt(0)" ::: "memory");
#pragma unroll
                for (int s2 = 0; s2 < 2; ++s2) { const int sx = 2 * ch + s2; if (sx < 5) {
#pragma unroll
                    for (int dt = 0; dt < 4; ++dt) {
                        const LAS unsigned char* vp = Vw + (32 * s2 + 4 * q4 + (r >> 2)) * AT_VP + dt * 32 + (r & 3) * 8;
                        const v4i16_t x = __builtin_amdgcn_ds_read_tr16_b64_v4i16((LAS v4i16_t*)vp), y = __builtin_amdgcn_ds_read_tr16_b64_v4i16((LAS v4i16_t*)(vp + 16 * AT_VP));
                        const bf16x8 av = (bf16x8){x[0], x[1], x[2], x[3], y[0], y[1], y[2], y[3]};
                        oa0[dt] = __builtin_amdgcn_mfma_f32_16x16x32_bf16(av, pf0[sx], oa0[dt], 0, 0, 0);
                        oa1[dt] = __builtin_amdgcn_mfma_f32_16x16x32_bf16(av, pf1[sx], oa1[dt], 0, 0, 0); } } }
                asm volatile("s_waitcnt lgkmcnt(0)" ::: "memory");
            }
            attn_merge(g, C.lds, ql0, q4, oa0, mx0, ls0, O + (rowbase + t0 + ql0) * 1024 + hd * 64 + 4 * q4);
            attn_merge(g, C.lds, ql1, q4, oa1, mx1, ls1, O + (rowbase + t0 + ql1) * 1024 + hd * 64 + 4 * q4);
        }
        __syncthreads();
    }
}

__device__ __forceinline__ unsigned ordf(float s) { const unsigned u = __builtin_bit_cast(unsigned, s); return u ^ ((unsigned)((int)u >> 31) | 0x80000000u); }
__device__ __forceinline__ float unordf(unsigned v) { return __builtin_bit_cast(float, v ^ ((unsigned)((int)(~v) >> 31) | 0x80000000u)); }
__device__ __forceinline__ void ins16(unsigned (&top)[16], unsigned x) {
#pragma unroll
    for (int j = 0; j < 16; ++j) { const unsigned hi = top[j] > x ? top[j] : x; x = top[j] > x ? x : top[j]; top[j] = hi; }
}
#define CE_D(a, b) { const unsigned hi_ = (a) > (b) ? (a) : (b), lo_ = (a) > (b) ? (b) : (a); (a) = hi_; (b) = lo_; }
__device__ __forceinline__ void sort16_desc(unsigned (&v)[16]) {
#pragma unroll
    for (int k = 2; k <= 16; k <<= 1)
#pragma unroll
        for (int j = k >> 1; j > 0; j >>= 1)
#pragma unroll
            for (int i = 0; i < 16; ++i) { const int l = i ^ j; if (l > i) { if ((i & k) == 0) CE_D(v[i], v[l]) else CE_D(v[l], v[i]) } }
}
__device__ __forceinline__ void bitonic_merge16_desc(unsigned (&c)[16]) {
#pragma unroll
    for (int st = 8; st >= 1; st >>= 1)
#pragma unroll
        for (int j = 0; j < 16; ++j) if ((j & st) == 0) CE_D(c[j], c[j + st])
}
__device__ __forceinline__ void top16_of_two(unsigned (&a)[16], const unsigned (&b)[16]) {
#pragma unroll
    for (int j = 0; j < 16; ++j) a[j] = a[j] > b[15 - j] ? a[j] : b[15 - j];
    bitonic_merge16_desc(a);
}
__device__ __forceinline__ void merge16(unsigned (&top)[16], int mask) {
    unsigned o[16];
#pragma unroll
    for (int j = 0; j < 16; ++j) o[j] = (unsigned)__shfl_xor((int)top[j], mask);
    top16_of_two(top, o);
}
__device__ __forceinline__ void phase_peer_topk(const Params& P, const Ctx& C, const Wk& W, int layer) {
    LAS bf16* SK = (LAS bf16*)C.lds;
    const bf16* SKB = (const bf16*)(P.ws + WS_SKB) + (size_t)layer * 32768; const bf16* QP = w_tok16(P, W, AR_QP, 2048);
    int* IDX = (int*)(P.ws + WS_IDX); float* GATE = (float*)(P.ws + WS_GATE);
    for (int ch = C.tid; ch < 4096; ch += 512) { const int rr = ch >> 4, c8 = (ch & 15) * 8; *(LAS v4u*)(SK + rr * 136 + c8) = *(const v4u*)(SKB + (size_t)rr * 128 + c8); }
    __syncthreads();
    const int r = C.lane & 15, q4 = C.lane >> 4;
    const int gw = W.lv * NWAVES + C.wave, NGW = W.n * NWAVES;
    for (int grp = W_TK0(W) / 2 + gw; grp < W_TK0(W) / 2 + HT * 8 / 16; grp += NGW) {
        const size_t task = (size_t)grp * 16 + r;
        unsigned lst[2][16];
#pragma unroll
        for (int half = 0; half < 2; ++half) {
            bf16x8 bq[4];
#pragma unroll
            for (int ks = 0; ks < 4; ++ks) bq[ks] = *(const bf16x8*)(QP + task * 256 + half * 128 + ks * 32 + 8 * q4);
            unsigned ka[16], kb[16];
#pragma unroll
            for (int nt = 0; nt < 8; ++nt) { f32x4 acc = (f32x4){0.f, 0.f, 0.f, 0.f};
#pragma unroll
                for (int ks = 0; ks < 4; ++ks) { const bf16x8 a = *(const LAS bf16x8*)(SK + (half * 128 + 16 * nt + r) * 136 + ks * 32 + 8 * q4); acc = __builtin_amdgcn_mfma_f32_16x16x32_bf16(a, bq[ks], acc, 0, 0, 0); }
#pragma unroll
                for (int i = 0; i < 4; ++i) { const unsigned n = 16 * nt + 4 * q4 + i; const unsigned key = (ordf(acc[i]) & ~127u) | (127u - n); if (nt < 4) ka[4 * nt + i] = key; else kb[4 * (nt - 4) + i] = key; }
                if (nt == 3) sort16_desc(ka);
                __builtin_amdgcn_sched_barrier(0); }
            sort16_desc(kb); top16_of_two(ka, kb);
            merge16(ka, 16); merge16(ka, 32);
#pragma unroll
            for (int j = 0; j < 16; ++j) lst[half][j] = ka[j];
        }
        float v2[16]; unsigned e2[16];
#pragma unroll
        for (int j = 0; j < 16; ++j) { v2[j] = unordf(lst[1][j] & ~127u); e2[j] = 127u - (lst[1][j] & 127u); }
        float v1s[4]; unsigned e1s[4];
#pragma unroll
        for (int k = 0; k < 4; ++k) { const unsigned w = q4 == 0 ? lst[0][4 * k] : q4 == 1 ? lst[0][4 * k + 1] : q4 == 2 ? lst[0][4 * k + 2] : lst[0][4 * k + 3];
            v1s[k] = unordf(w & ~127u); e1s[k] = (127u - (w & 127u)) << 7; }
        unsigned top[16];
#pragma unroll
        for (int j = 0; j < 16; ++j) top[j] = (ordf(v1s[0] + v2[j]) & ~16383u) | e1s[0] | e2[j];
        sort16_desc(top);
#pragma unroll
        for (int j = 0; j < 3; ++j) ins16(top, (ordf(v1s[1] + v2[j]) & ~16383u) | e1s[1] | e2[j]);
        ins16(top, (ordf(v1s[2] + v2[0]) & ~16383u) | e1s[2] | e2[0]);
        ins16(top, (ordf(v1s[3] + v2[0]) & ~16383u) | e1s[3] | e2[0]);
        merge16(top, 16); merge16(top, 32);
        float ev[16]; float den = 0.f; const float mx = unordf(top[0] & ~16383u);
#pragma unroll
        for (int j = 0; j < 16; ++j) { ev[j] = __expf(unordf(top[j] & ~16383u) - mx); den += ev[j]; }
        const float inv = 1.0f / den;
        int* ip = IDX + task * 16; float* gp = GATE + task * 16;
        if (q4 == 0) { *(v4u*)(ip) = (v4u){top[0] & 16383u, top[1] & 16383u, top[2] & 16383u, top[3] & 16383u}; *(f32x4*)(gp) = (f32x4){ev[0] * inv, ev[1] * inv, ev[2] * inv, ev[3] * inv}; }
        else if (q4 == 1) { *(v4u*)(ip + 4) = (v4u){top[4] & 16383u, top[5] & 16383u, top[6] & 16383u, top[7] & 16383u}; *(f32x4*)(gp + 4) = (f32x4){ev[4] * inv, ev[5] * inv, ev[6] * inv, ev[7] * inv}; }
        else if (q4 == 2) { *(v4u*)(ip + 8) = (v4u){top[8] & 16383u, top[9] & 16383u, top[10] & 16383u, top[11] & 16383u}; *(f32x4*)(gp + 8) = (f32x4){ev[8] * inv, ev[9] * inv, ev[10] * inv, ev[11] * inv}; }
        else { *(v4u*)(ip + 12) = (v4u){top[12] & 16383u, top[13] & 16383u, top[14] & 16383u, top[15] & 16383u}; *(f32x4*)(gp + 12) = (f32x4){ev[12] * inv, ev[13] * inv, ev[14] * inv, ev[15] * inv}; }
    }
}
struct ExpRow { v4u d[3], u[3]; float ds, us, gk; };
__device__ __forceinline__ void exp_issue(ExpRow& R, const unsigned char* TD, const unsigned char* TU, const float* SD, int ex, float gk, int jl) {
    const unsigned char* dr = TD + (size_t)ex * TROW + 48 * jl; const unsigned char* ur = TU + (size_t)ex * TROW + 48 * jl;
#pragma unroll
    for (int c = 0; c < 3; ++c) R.d[c] = *(const v4u*)(dr + 16 * c);
#pragma unroll
    for (int c = 0; c < 3; ++c) R.u[c] = *(const v4u*)(ur + 16 * c);
    R.ds = SD[ex]; R.us = SD[16384 + ex]; R.gk = gk;
}
__device__ __forceinline__ void exp_consume(const ExpRow& R, const unsigned (&hp)[32], f32x2 (&oacc)[32]) {
    f32x2 a2 = (f32x2){0.f, 0.f};
#pragma unroll
    for (int gsel = 0; gsel < 2; ++gsel) {
        const v6u pk = gsel == 0 ? (v6u){R.d[0].x, R.d[0].y, R.d[0].z, R.d[0].w, R.d[1].x, R.d[1].y} : (v6u){R.d[1].z, R.d[1].w, R.d[2].x, R.d[2].y, R.d[2].z, R.d[2].w};
        const f32x32v f = __builtin_amdgcn_cvt_scalef32_pk32_f32_fp6(pk, 1.0f);
#pragma unroll
        for (int p = 0; p < 16; ++p) { unsigned h0 = hp[16 * gsel + p]; asm volatile("" : "+v"(h0));
            a2 = a2 + (f32x2){f[2 * p], f[2 * p + 1]} * (f32x2){bflo(h0), bfhi(h0)}; } }
    float a = (a2.x + a2.y) * R.ds;
    a += __shfl_xor(a, 1); a += __shfl_xor(a, 2); a += __shfl_xor(a, 4); a += __shfl_xor(a, 8);
    const float wk = R.gk * gelu_f(a) * R.us; const f32x2 wk2 = (f32x2){wk, wk};
#pragma unroll
    for (int gsel = 0; gsel < 2; ++gsel) {
        const v6u pk = gsel == 0 ? (v6u){R.u[0].x, R.u[0].y, R.u[0].z, R.u[0].w, R.u[1].x, R.u[1].y} : (v6u){R.u[1].z, R.u[1].w, R.u[2].x, R.u[2].y, R.u[2].z, R.u[2].w};
        const f32x32v f = __builtin_amdgcn_cvt_scalef32_pk32_f32_fp6(pk, 1.0f);
#pragma unroll
        for (int p = 0; p < 16; ++p) oacc[16 * gsel + p] = oacc[16 * gsel + p] + wk2 * (f32x2){f[2 * p], f[2 * p + 1]}; }
}
__device__ __forceinline__ void phase_peer_experts(const Params& P, const Ctx& Cin, const Wk& W, int layer, bool last) {
    const Ctx C = fresh_ctx(Cin);
    const unsigned char* TD = P.ws + WS_TAB8 + (size_t)(2 * layer) * TAB8_BYTES; const unsigned char* TU = P.ws + WS_TAB8 + (size_t)(2 * layer + 1) * TAB8_BYTES; const float* SD = (const float*)(P.ws + WS_SC8) + (size_t)(2 * layer) * 16384; bf16* H = (bf16*)(P.ws + WS_H);
    const int* IDX = (const int*)(P.ws + WS_IDX); const float* GATE = (const float*)(P.ws + WS_GATE); const float* MOD = (const float*)(P.ws + WS_MOD);
    const int lane = C.lane, grp = lane >> 4, jl = lane & 15;
    unsigned* ticket = (unsigned*)(P.ws + WS_CTL) + 96 + 2 * layer + W.h;
    const bool dyn = W.n != C.G;
    const int gws = W.lv * NWAVES + C.wave, NGWS = W.n * NWAVES;
    int tnext = gws; if (dyn) { if (lane == 0) tnext = (int)atomicAdd(ticket, 1u); tnext = __builtin_amdgcn_readfirstlane(tnext); }
    while (tnext < HT) {
        const int tok = W_TK0(W) + tnext;
        if (dyn) { int tn = 0; if (lane == 0) tn = (int)atomicAdd(ticket, 1u); tnext = tn; } else tnext += NGWS;
        const int b = tok >> 13;
        const int i0 = IDX[(size_t)tok * 128 + lane], i1 = IDX[(size_t)tok * 128 + 64 + lane];
        const float g0 = GATE[(size_t)tok * 128 + lane], g1 = GATE[(size_t)tok * 128 + 64 + lane];
        unsigned hf[32];
#pragma unroll
        for (int c = 0; c < 8; ++c) { const v4u w0 = *(const v4u*)(H + (size_t)tok * 1024 + 64 * jl + 8 * c);
#pragma unroll
            for (int e = 0; e < 4; ++e) hf[c * 4 + e] = w0[e]; }
        f32x2 oacc[32];
#pragma unroll
        for (int e = 0; e < 32; ++e) oacc[e] = (f32x2){0.f, 0.f};
        ExpRow RA, RB;
        exp_issue(RA, TD, TU, SD, __shfl(i0, grp), __shfl(g0, grp), jl);
        for (int it = 0; it < 32 * EXP_REP; it += 2) {
            { const int kk = ((it + 1) & 31) * 4 + grp; const int el = __shfl(i0, kk & 63), eh = __shfl(i1, kk & 63); const float gl = __shfl(g0, kk & 63), gh = __shfl(g1, kk & 63);
              exp_issue(RB, TD, TU, SD, kk < 64 ? el : eh, kk < 64 ? gl : gh, jl); }
            exp_consume(RA, hf, oacc);
            { const int kk = ((it + 2) & 31) * 4 + grp; const int el = __shfl(i0, kk & 63), eh = __shfl(i1, kk & 63); const float gl = __shfl(g0, kk & 63), gh = __shfl(g1, kk & 63);
              exp_issue(RA, TD, TU, SD, kk < 64 ? el : eh, kk < 64 ? gl : gh, jl); }
            exp_consume(RB, hf, oacc);
        }
        f32x2 h1[16];
        { const bool up = (grp & 2) != 0;
#pragma unroll
          for (int e = 0; e < 16; ++e) { const f32x2 keep = up ? oacc[16 + e] : oacc[e], send = up ? oacc[e] : oacc[16 + e]; h1[e] = keep + (f32x2){__shfl_xor(send.x, 32), __shfl_xor(send.y, 32)}; } }
        f32x2 h2[8];
        { const bool up = (grp & 1) != 0;
#pragma unroll
          for (int e = 0; e < 8; ++e) { const f32x2 keep = up ? h1[8 + e] : h1[e], send = up ? h1[e] : h1[8 + e]; h2[e] = keep + (f32x2){__shfl_xor(send.x, 16), __shfl_xor(send.y, 16)}; } }
        const int d0 = 64 * jl + 16 * grp;
        const float* g2p = MOD + (size_t)(layer * 8 + b) * 6144 + 5120 + d0; const float psc = ((ABL_ON >= (layer == 0 ? 2 : 4)) ? 1.f : 0.f) * (1.0f / EXP_REP);
        float* xp = P.out + (size_t)tok * 1024 + d0;
        float xn[16]; float ss = 0.f;
#pragma unroll
        for (int q = 0; q < 4; ++q) { const f32x4 xa = *(const f32x4*)(xp + 4 * q), ga = *(const f32x4*)(g2p + 4 * q);
            xn[4 * q] = xa[0] + psc * ga[0] * h2[2 * q].x; xn[4 * q + 1] = xa[1] + psc * ga[1] * h2[2 * q].y; xn[4 * q + 2] = xa[2] + psc * ga[2] * h2[2 * q + 1].x; xn[4 * q + 3] = xa[3] + psc * ga[3] * h2[2 * q + 1].y; }
#pragma unroll
        for (int e = 0; e < 16; ++e) ss += xn[e] * xn[e];
        const float rstd = 1.0f / sqrtf(wave_sum(ss) * (1.0f / 1024.0f) + NORM_EPS);
        if (!last) {
            const float* ng = P.norm_mix_g + (layer + 1) * 1024 + d0; const float* mb = MOD + (size_t)((layer + 1) * 8 + b) * 6144 + d0;
            unsigned w[8];
#pragma unroll
            for (int q = 0; q < 4; ++q) { *(f32x4*)(xp + 4 * q) = (f32x4){xn[4 * q], xn[4 * q + 1], xn[4 * q + 2], xn[4 * q + 3]}; }
#pragma unroll
            for (int e = 0; e < 8; ++e) w[e] = pk2(xn[2 * e] * rstd * ng[2 * e] * (1.0f + mb[1024 + 2 * e]) + mb[2 * e], xn[2 * e + 1] * rstd * ng[2 * e + 1] * (1.0f + mb[1024 + 2 * e + 1]) + mb[2 * e + 1]);
            v4u* hp = (v4u*)(H + (size_t)tok * 1024 + d0); hp[0] = (v4u){w[0], w[1], w[2], w[3]}; hp[1] = (v4u){w[4], w[5], w[6], w[7]};
        } else {
            const float* fg = P.final_norm_g + d0;
#pragma unroll
            for (int q = 0; q < 4; ++q) *(f32x4*)(xp + 4 * q) = (f32x4){xn[4 * q] * rstd * fg[4 * q], xn[4 * q + 1] * rstd * fg[4 * q + 1], xn[4 * q + 2] * rstd * fg[4 * q + 2], xn[4 * q + 3] * rstd * fg[4 * q + 3]};
        }
        if (dyn) tnext = __builtin_amdgcn_readfirstlane(tnext);
    }
}

#ifndef NC_PER_XCD
#define NC_PER_XCD 16
#endif
#ifdef PROBE_SEL
#define SUBSTAMP(i) do { if (W.c == 0 && C.tid == 0) __hip_atomic_store((unsigned*)(P.ws + WS_CTL) + 128 + 16 * W.h + (i), (unsigned)__builtin_amdgcn_s_memrealtime(), __ATOMIC_RELAXED, __HIP_MEMORY_SCOPE_AGENT); } while (0)
#else
#define SUBSTAMP(i) do {} while (0)
#endif
__device__ __forceinline__ void run_C0(const Params& P, const Ctx& Cin, const Wk& W, const XcdBarrier& tb) {
    const Ctx C = fresh_ctx(Cin);
    SUBSTAMP(0);
    unsigned char* ws = P.ws; float* MOD = (float*)(ws + WS_MOD); bf16* H = (bf16*)(ws + WS_H);
    const size_t tk = (size_t)W_TK0(W); unsigned char* const ar = w_ar(P, W);
    phase_norm(P, C, W, P.x, P.norm_mix_g, 0, 0); xcd_barrier(tb); SUBSTAMP(1);
    { pg8::Gemm g{H + tk * 1024, (const bf16*)(ws + WS_WIN), HT, 3072, 1024}; pg8::StaticOrder S; S.init(HT, 3072, W.n, W.c);
      EpiInProj E{(bf16*)(ar + AR_PU), (bf16*)(ar + AR_PV), (bf16*)(ar + AR_PQ), (bf16*)(ar + AR_PI), (bf16*)(ar + AR_PG), (float*)(ar + AR_G), (const float*)(ws + WS_LB)};
      pg8::gemm_phase<EpiInProj, pg8::StaticOrder, true, true>(C.lds, g, S, E); } xcd_barrier(tb); SUBSTAMP(2);
    for (int it = W.lv; it < 1024; it += W.n) gmlp_item(P, C, W, W_TK0(W) / 128 + (it >> 2), it & 3);
    for (int it = W.lv; it < 2048; it += W.n) hgrn_local_item(P, C, W, W_BT0(W) * 512 + it);
    xcd_barrier(tb); SUBSTAMP(3);
    phase_hgrn_scan(P, C, W); xcd_barrier(tb); SUBSTAMP(4);
    for (int it = W.lv; it < 2048; it += W.n) hgrn_out_item(P, C, W, W_BT0(W) * 512 + it);
    xcd_barrier(tb); SUBSTAMP(5);
    { pg8::Gemm g{H + tk * 1024, (const bf16*)(ws + WS_WOUT0), HT, 1024, 1024}; pg8::StaticOrder S; S.init(HT, 1024, W.n, W.c);
      EpiResid E{P.x + tk * 1024, P.out + tk * 1024, MOD + 2048 + (size_t)W_BT0(W) * 6144, 1.f};
      pg8::gemm_phase<EpiResid, pg8::StaticOrder, true, true>(C.lds, g, S, E); } xcd_barrier(tb); SUBSTAMP(6);
    phase_norm(P, C, W, P.out, P.norm_ffn_g, 0, 3072); xcd_barrier(tb); SUBSTAMP(7);
    { pg8::Gemm g{H + tk * 1024, (const bf16*)(ws + WS_WQ0), HT, 2048, 1024}; pg8::StaticOrder S; S.init(HT, 2048, W.n, W.c);
      EpiBf16P E{(bf16*)(ar + AR_QP), 2048};
      pg8::gemm_phase<EpiBf16P, pg8::StaticOrder, true, true>(C.lds, g, S, E); }
    SUBSTAMP(9);
}
__device__ __forceinline__ void run_C1(const Params& P, const Ctx& Cin, const Wk& W, const XcdBarrier& tb) {
    const Ctx C = fresh_ctx(Cin);
    SUBSTAMP(0);
    unsigned char* ws = P.ws; float* MOD = (float*)(ws + WS_MOD); bf16* H = (bf16*)(ws + WS_H);
    const size_t tk = (size_t)W_TK0(W); unsigned char* const ar = w_ar(P, W);
    { pg8::Gemm g{H + tk * 1024, (const bf16*)(ws + WS_WQKV), HT, 3072, 1024}; pg8::StaticOrder S; S.init(HT, 3072, W.n, W.c);
      EpiQKRot E{(bf16*)(ar + AR_QK), (const float*)(ws + WS_CS) + tk * 16};
      pg8::gemm_phase<EpiQKRot, pg8::StaticOrder, true, true>(C.lds, g, S, E); } xcd_barrier(tb); SUBSTAMP(1);
    for (int it = W.lv; it < (NB / 2) * 16 * 16; it += W.n) attn_item(P, C, W, W_BT0(W) + (it >> 8), (it >> 4) & 15, it & 15);
    xcd_barrier(tb); SUBSTAMP(2);
    { pg8::Gemm g{H + tk * 1024, (const bf16*)(ws + WS_WOUT1), HT, 1024, 1024}; pg8::StaticOrder S; S.init(HT, 1024, W.n, W.c);
      EpiResid E{P.out + tk * 1024, P.out + tk * 1024, MOD + (size_t)8 * 6144 + 2048 + (size_t)W_BT0(W) * 6144, 1.f};
      pg8::gemm_phase<EpiResid, pg8::StaticOrder, true, true>(C.lds, g, S, E); } xcd_barrier(tb); SUBSTAMP(3);
    phase_norm(P, C, W, P.out, P.norm_ffn_g + 1024, 1, 3072); xcd_barrier(tb); SUBSTAMP(4);
    { pg8::Gemm g{H + tk * 1024, (const bf16*)(ws + WS_WQ1), HT, 2048, 1024}; pg8::StaticOrder S; S.init(HT, 2048, W.n, W.c);
      EpiBf16P E{(bf16*)(ar + AR_QP), 2048};
      pg8::gemm_phase<EpiBf16P, pg8::StaticOrder, true, true>(C.lds, g, S, E); }
    SUBSTAMP(9);
}
__device__ __forceinline__ void run_E(const Params& P, const Ctx& Cin, const Wk& W, const XcdBarrier& tb, int layer) {
    { const Ctx C = fresh_ctx(Cin); phase_peer_topk(P, C, W, layer); }
    xcd_barrier(tb);
    if (W.c == 0 && Cin.tid == 0) __hip_atomic_store((unsigned*)(P.ws + WS_CTL) + 112 + 2 * layer + W.h, 1u, __ATOMIC_RELAXED, __HIP_MEMORY_SCOPE_AGENT);
    phase_peer_experts(P, Cin, W, layer, layer == 1);
}
__device__ __forceinline__ void help_E(const Params& P, const Ctx& Cin, int h, int layer) {
    volatile LAS unsigned* okw = (volatile LAS unsigned*)(Cin.lds + LDSCTL_OFF + 192);
    if (Cin.tid == 0) { unsigned* flag = (unsigned*)(P.ws + WS_CTL) + 112 + 2 * layer + h; unsigned ok = 0u;
        for (unsigned sp = 0; sp < (1u << 16); ++sp) { if (__hip_atomic_load(flag, __ATOMIC_RELAXED, __HIP_MEMORY_SCOPE_AGENT) != 0u) { ok = 1u; break; } __builtin_amdgcn_s_sleep(8); }
        __builtin_amdgcn_fence(__ATOMIC_ACQUIRE, "agent"); asm volatile("s_waitcnt vmcnt(0)" ::: "memory");
        *okw = ok; }
    __syncthreads();
    const bool ok = *okw != 0u;
    __syncthreads();
    if (ok) { Wk W; W.lv = 0; W.n = 1; W.c = 1; W.h = h; phase_peer_experts(P, Cin, W, layer, layer == 1); }
}
__global__ void __launch_bounds__(NWAVES * 64, 2) hybrid_fwd(Params P) {
    extern __shared__ __attribute__((aligned(16))) unsigned char lds_raw[];
    Ctx C;
    C.lds = (LAS unsigned char*)lds_raw;
    C.tid = threadIdx.x; C.lane = C.tid & 63; C.wave = __builtin_amdgcn_readfirstlane(C.tid >> 6);
    C.G = gridDim.x; const int bx = blockIdx.x; C.vcu = (bx % 8) * (C.G / 8) + bx / 8;
    volatile LAS unsigned* MISC = (volatile LAS unsigned*)(C.lds + MISC_OFF);
    for (int u = C.tid; u < (LDS_BYTES - LDSCTL_OFF) / 4; u += NWAVES * 64) ((LAS unsigned*)(C.lds + LDSCTL_OFF))[u] = 0u;
    __syncthreads();
    unsigned* ctl = (unsigned*)(P.ws + WS_CTL);
    const int xl = bx & 7, jx = bx >> 3, perx = C.G / 8;
    const bool inC = jx < NC_PER_XCD;
    const int nC = 8 * NC_PER_XCD, nE = C.G - nC;
    const XcdBarrier bar_all = xcd_barrier_post(ctl + CW_BAR, MISC + 8);
    XcdBarrier bar_c; bar_c.bar = ctl + CW_BAR + XCD_BAR_WORDS; bar_c.x = bar_all.x; bar_c.st = MISC + 10; bar_c.G = (unsigned)nC;
    if (inC && C.tid == 0) (void)xb_add(&bar_c.bar[XB_XCNT(bar_c.x)], 1u);
    XcdBarrier bar_e; bar_e.bar = ctl + CW_BAR + 2 * XCD_BAR_WORDS; bar_e.x = bar_all.x; bar_e.st = MISC + 12; bar_e.G = (unsigned)nE;
    if (!inC && C.tid == 0) (void)xb_add(&bar_e.bar[XB_XCNT(bar_e.x)], 1u);
    Wk Wall; Wall.lv = C.vcu; Wall.n = C.G; Wall.c = bx; Wall.h = 0;
    Wk Wc; Wc.lv = xl * NC_PER_XCD + jx; Wc.n = nC; Wc.c = jx * 8 + xl; Wc.h = 0;
    Wk We; { const int je = jx - NC_PER_XCD, ne = perx - NC_PER_XCD; We.lv = xl * ne + je; We.n = nE; We.c = je * 8 + xl; We.h = 0; }
    phase_prologue(P, C);
    xcd_barrier(bar_all);
#ifdef PROBE_SEL
    unsigned long long tp0 = __builtin_amdgcn_s_memrealtime(), tp1 = 0, tp2 = 0, tp3 = 0, tp4 = 0, tp5 = 0, tpe1 = 0, tpe2 = 0, tpe3 = 0;
#define STAMP(v) v = __builtin_amdgcn_s_memrealtime()
#else
#define STAMP(v)
#endif
    Wall.h = 0; run_C0(P, C, Wall, bar_all); xcd_barrier(bar_all); STAMP(tp1);
    if (inC) { Wc.h = 1; run_C0(P, C, Wc, bar_c); help_E(P, C, 0, 0); } else { We.h = 0; run_E(P, C, We, bar_e, 0); }
    STAMP(tpe1);
#ifdef PROBE_SEL
    if (C.tid == 0) atomicMax(ctl + 80 + (inC ? 0 : 1), (unsigned)(tpe1 - tp1));
#endif
    xcd_barrier(bar_all); STAMP(tp2);
    if (inC) { Wc.h = 0; run_C1(P, C, Wc, bar_c); help_E(P, C, 1, 0); } else { We.h = 1; run_E(P, C, We, bar_e, 0); }
    STAMP(tpe2);
#ifdef PROBE_SEL
    if (C.tid == 0) atomicMax(ctl + 82 + (inC ? 0 : 1), (unsigned)(tpe2 - tp2));
#endif
    xcd_barrier(bar_all); STAMP(tp3);
    if (inC) { Wc.h = 1; run_C1(P, C, Wc, bar_c); help_E(P, C, 0, 1); } else { We.h = 0; run_E(P, C, We, bar_e, 1); }
    STAMP(tpe3);
#ifdef PROBE_SEL
    if (C.tid == 0) atomicMax(ctl + 84 + (inC ? 0 : 1), (unsigned)(tpe3 - tp3));
#endif
    xcd_barrier(bar_all); STAMP(tp4);
    Wall.h = 1; run_E(P, C, Wall, bar_all, 1);
#ifdef PROBE_SEL
    STAMP(tp5);
    { unsigned long long d = 0; const int sel = PROBE_SEL;
      if (sel == 0) d = tp1 - tp0; if (sel == 1) d = tp2 - tp1; if (sel == 2) d = tp3 - tp2; if (sel == 3) d = tp4 - tp3; if (sel == 4) d = tp5 - tp4;
      if (sel == 5 || sel == 8) d = tpe1 - tp1; if (sel == 6 || sel == 9) d = tpe2 - tp2; if (sel == 7 || sel == 10) d = tpe3 - tp3;
      const int who = sel >= 8 ? 8 * NC_PER_XCD : 0;
      if (sel >= 20) { const unsigned* sp = (const unsigned*)(P.ws + WS_CTL) + 128 + 16 * PROBE_HALF; const int i = sel - 20; const int nxt = (i == PROBE_LAST) ? 9 : i + 1; d = (unsigned long long)(__hip_atomic_load(sp + nxt, __ATOMIC_RELAXED, __HIP_MEMORY_SCOPE_AGENT) - __hip_atomic_load(sp + i, __ATOMIC_RELAXED, __HIP_MEMORY_SCOPE_AGENT)); }
      if (sel >= 30) d = 0;
      if (bx == (sel >= 20 ? 0 : who) && C.tid == 0) __hip_atomic_store(ctl + 64, (unsigned)d, __ATOMIC_RELAXED, __HIP_MEMORY_SCOPE_AGENT);
      xcd_barrier(bar_all);
      if (bx == 0 && C.tid == 0) { const unsigned dd = sel >= 30 ? __hip_atomic_load(ctl + 80 + (sel - 30), __ATOMIC_RELAXED, __HIP_MEMORY_SCOPE_AGENT) : __hip_atomic_load(ctl + 64, __ATOMIC_RELAXED, __HIP_MEMORY_SCOPE_AGENT);
        const unsigned long long t0_ = __builtin_amdgcn_s_memrealtime(); while (__builtin_amdgcn_s_memrealtime() - t0_ < 4ull * dd) __builtin_amdgcn_s_sleep(32); } }
#endif
}

extern "C" void kernel_launch(void* const* d_in, const int* in_sizes, int n_in, void* d_out, int out_size, void* d_ws, size_t ws_size, hipStream_t stream) {
    static int grid = 0;
    if (grid == 0) {
        if (n_in != 22 || in_sizes[0] != T * DM || out_size != T * DM || ws_size < WS_END) {
            fprintf(stderr, "kernel_launch: unexpected shapes (n_in %d, in0 %d, out %d, ws %zu); nothing launched\n", n_in, n_in > 0 ? in_sizes[0] : -1, out_size, ws_size); grid = -1; return; }
        int dev = 0, cus = 0;
        if (hipGetDevice(&dev) != hipSuccess || hipDeviceGetAttribute(&cus, hipDeviceAttributeMultiprocessorCount, dev) != hipSuccess) { fprintf(stderr, "kernel_launch: device query failed\n"); grid = -1; return; }
        if (hipFuncSetAttribute((const void*)hybrid_fwd, hipFuncAttributeMaxDynamicSharedMemorySize, LDS_BYTES) != hipSuccess) { fprintf(stderr, "kernel_launch: hipFuncSetAttribute failed\n"); grid = -1; return; }
        (void)hipGetLastError();
        grid = cus;
        if (grid % 8 != 0 || grid / 8 <= NC_PER_XCD) { fprintf(stderr, "kernel_launch: built for a CU count that is a multiple of 8 and > %d; got %d; nothing launched\n", 8 * NC_PER_XCD, grid); grid = -1; return; }
    }
    if (grid < 0) return;
    if (hipMemsetAsync((char*)d_ws + WS_CTL, 0, CTL_ZERO_BYTES, stream) != hipSuccess) { fprintf(stderr, "kernel_launch: memset failed\n"); return; }
    Params p{};
    p.x = (const float*)d_in[0]; p.c = (const float*)d_in[1]; p.positions = (const int*)d_in[2]; p.ada_w = (const float*)d_in[3]; p.ada_b = (const float*)d_in[4];
    p.norm_mix_g = (const float*)d_in[5]; p.norm_ffn_g = (const float*)d_in[6]; p.final_norm_g = (const float*)d_in[7]; p.even_w_in = (const float*)d_in[8]; p.even_w_out = (const float*)d_in[9];
    p.gmlp_ln_g = (const float*)d_in[10]; p.gmlp_ln_b = (const float*)d_in[11]; p.gmlp_w_s = (const float*)d_in[12]; p.gmlp_b_s = (const float*)d_in[13]; p.hgrn_lb_logits = (const float*)d_in[14];
    p.hgrn_norm_g = (const float*)d_in[15]; p.odd_w_qkv = (const float*)d_in[16]; p.odd_w_out = (const float*)d_in[17]; p.peer_w_query = (const float*)d_in[18]; p.peer_sub_keys = (const float*)d_in[19];
    p.peer_down = (const float*)d_in[20]; p.peer_up = (const float*)d_in[21];
    p.out = (float*)d_out; p.ws = (unsigned char*)d_ws;
    p.ph_lo = 0; p.ph_hi = 0;
    hipLaunchKernelGGL(hybrid_fwd, dim3(grid), dim3(NWAVES * 64), LDS_BYTES, stream, p);
    const hipError_t le = hipPeekAtLastError();
    if (le != hipSuccess) fprintf(stderr, "kernel_launch: launch failed: %s\n", hipGetErrorName(le));
}
```

```cpp
#include <hip/hip_runtime.h>
#include <cstdio>
#include <cstdint>
#include <cmath>
namespace pg8 {
#define PG8_LAS __attribute__((address_space(3)))
typedef unsigned short bf16_t;
typedef short bf16x8 __attribute__((ext_vector_type(8)));
typedef float f32x4 __attribute__((ext_vector_type(4)));
typedef unsigned u32x4 __attribute__((ext_vector_type(4)));
constexpr int BM = 256, BK = 64, HALF = 128, HTB = HALF * BK * 2  , STAGE_BYTES = 8 * HTB, NXCD = 8, WGM = 8;

__host__ __device__ __forceinline__ int lds_byte(int r, int c) { const int st = (r >> 4) * 2 + (c >> 5), rr = r & 15, cc = c & 31, ob = rr * 64 + cc * 2; return st * 1024 + (ob ^ (((ob >> 9) & 1) << 5)); }
__host__ __device__ __forceinline__ void stage_rc(int b, int& R, int& C) { const int st = b / 1024, sb = b % 1024, swz = sb ^ (((sb >> 9) & 1) << 5); R = (st >> 1) * 16 + swz / 64; C = (st & 1) * 32 + (swz % 64) / 2; }
__host__ __device__ __forceinline__ int perm32(int rho) { const int n = rho >> 4, i = rho & 15; return 8 * (i >> 2) + 4 * n + (i & 3); }

struct Unit { int pm, pn; };
struct Gemm { const bf16_t* A; const bf16_t* Bt; int M, N, K; };

struct StaticOrder {
    int nM, nN, nwg, G, c;
    __host__ __device__ void init(int M, int N, int G_, int c_) { nM = M / BM; nN = N / BM; nwg = nM * nN; G = G_; c = c_; }
    __host__ __device__ bool next(int i, Unit& u) const {
        const long L = (long)i * G + c; if (L >= nwg) return false;
        int wgid = (int)L; { const int q = nwg / NXCD, r = nwg % NXCD, xcd = wgid % NXCD, off = wgid / NXCD; wgid = (xcd < r ? xcd * (q + 1) : r * (q + 1) + (xcd - r) * q) + off; }
        const int nig = WGM * nN, gid = wgid / nig, fm = gid * WGM, gsz = (nM - fm) < WGM ? (nM - fm) : WGM;
        u.pm = fm + ((wgid % nig) % gsz); u.pn = (wgid % nig) / gsz; return true;
    }
    __device__ __forceinline__ void a_ready(const Unit&) const {}
    __device__ __forceinline__ void done(const Unit&) const {}
};

__device__ __forceinline__ unsigned cvt_pk_bf16(float lo, float hi) { unsigned r; asm volatile("v_cvt_pk_bf16_f32 %0, %1, %2" : "=v"(r) : "v"(lo), "v"(hi)); return r; }
typedef float f32x2 __attribute__((ext_vector_type(2)));
__device__ __forceinline__ f32x2 gelu_pk(f32x2 v) {
    const f32x2 av = __builtin_elementwise_abs(v), d = av * 0.2316418882f + 1.0f;
    f32x2 t; t.x = __builtin_amdgcn_rcpf(d.x); t.y = __builtin_amdgcn_rcpf(d.y);
    f32x2 q = t * 0.5307027145f + (-0.7265760135f); q = q * t + 0.7107068705f; q = q * t + (-0.142248368f); q = q * t + 0.127414796f; q = q * t;
    const f32x2 s = (v * v) * (-0.72134752044f);
    f32x2 e; e.x = __builtin_amdgcn_exp2f(s.x); e.y = __builtin_amdgcn_exp2f(s.y);
    const f32x2 m = v * (q * e), r = v - m;
    f32x2 o; o.x = v.x < 0.f ? m.x : r.x; o.y = v.y < 0.f ? m.y : r.y; return o;
}

template <class Epi, class Sched, bool ALIGN_EPI = false, bool SP2 = false>
__device__ __forceinline__ void gemm_phase(PG8_LAS unsigned char* lds, const Gemm g, const Sched& S, const Epi& E) {
    int tid_ = threadIdx.x; asm volatile("" : "+v"(tid_));
    const int tid = tid_, wid = __builtin_amdgcn_readfirstlane(tid >> 6), lane = tid & 63, wr = wid >> 2, wc = wid & 3, fr = lane & 15, fq = lane >> 4;
    const int K = g.K, nt = K / BK;
    unsigned voffA[2], voffB[2];
#pragma unroll
    for (int i = 0; i < 2; ++i) { int R, C; stage_rc(tid * 16 + i * 8192, R, C); const int Rb = Epi::PERM ? ((R & ~31) + perm32(R & 31)) : R;
        voffA[i] = (unsigned)(R * K + C) * 2u; voffB[i] = (unsigned)(Rb * K + C) * 2u; }
    const size_t kstep = (size_t)(BK * 2);
    const size_t hstep = (size_t)HALF * K * 2;
    const size_t tstep = 2 * hstep;
    const unsigned ldsw = (unsigned)wid * 1024u;
    const int aoff = lds_byte(wr * 64 + fr, fq * 8), boff = lds_byte(wc * 32 + fr, fq * 8);
#define PG8_SA(b, h) (((b) * 2 + (h)) * HTB)
#define PG8_SB(b, h) ((4 + (b) * 2 + (h)) * HTB)
#define PG8_STAGE(bufoff, gbase, voff) do { _Pragma("unroll") for (int _i = 0; _i < 2; ++_i) \
        __builtin_amdgcn_global_load_lds((const unsigned*)((const char*)(gbase) + (voff)[_i]), (PG8_LAS unsigned*)(lds + (bufoff) + ldsw + _i * 8192), 16, 0, 0); } while (0)
#define PG8_LDA(dst, b, h) do { _Pragma("unroll") for (int m = 0; m < 4; ++m) _Pragma("unroll") for (int k = 0; k < 2; ++k) dst[m][k] = *(const PG8_LAS bf16x8*)(lds + PG8_SA(b, h) + aoff + m * 2048 + k * 1024); } while (0)
#define PG8_LDB(dst, b, h) do { _Pragma("unroll") for (int n = 0; n < 2; ++n) _Pragma("unroll") for (int k = 0; k < 2; ++k) dst[n][k] = *(const PG8_LAS bf16x8*)(lds + PG8_SB(b, h) + boff + n * 2048 + k * 1024); } while (0)
#define PG8_MMA(ai, bj, At, Bt) do { __builtin_amdgcn_s_setprio(1); _Pragma("unroll") for (int m = 0; m < 4; ++m) _Pragma("unroll") for (int n = 0; n < 2; ++n) _Pragma("unroll") for (int k = 0; k < 2; ++k) \
        acc[ai][bj][m][n] = __builtin_amdgcn_mfma_f32_16x16x32_bf16(Bt[n][k], At[m][k], acc[ai][bj][m][n], 0, 0, 0); __builtin_amdgcn_s_setprio(0); } while (0)
#define PG8_WAIT_V(n) asm volatile("s_waitcnt vmcnt(" #n ")" ::: "memory")
#define PG8_WAIT_L(n) asm volatile("s_waitcnt lgkmcnt(" #n ")" ::: "memory")
#define PG8_BAR __builtin_amdgcn_s_barrier()
#define PG8_SCHED __builtin_amdgcn_sched_barrier(0)
    Unit cur, nxt; int ui = 0;
    if (!S.next(0, cur)) return;
    f32x4 acc[2][2][4][2];
#pragma unroll
    for (int a = 0; a < 2; ++a)
#pragma unroll
        for (int b = 0; b < 2; ++b)
#pragma unroll
            for (int m = 0; m < 4; ++m)
#pragma unroll
                for (int n = 0; n < 2; ++n) acc[a][b][m][n] = (f32x4){0.f, 0.f, 0.f, 0.f};
    bf16x8 At[4][2], B0[2][2], B1[2][2];
    const char* cA = (const char*)g.A + (size_t)cur.pm * tstep; const char* cB = (const char*)g.Bt + (size_t)cur.pn * tstep;
    S.a_ready(cur);
    if constexpr (SP2) {
        PG8_STAGE(PG8_SB(0, 0), cB, voffB); PG8_STAGE(PG8_SB(0, 1), cB + hstep, voffB); PG8_STAGE(PG8_SA(0, 0), cA, voffA); PG8_STAGE(PG8_SA(0, 1), cA + hstep, voffA);
        if (wr == 1) PG8_BAR;
        PG8_WAIT_V(2); PG8_BAR;
        PG8_STAGE(PG8_SB(1, 0), cB + kstep, voffB); PG8_STAGE(PG8_SA(1, 0), cA + kstep, voffA); PG8_STAGE(PG8_SB(1, 1), cB + hstep + kstep, voffB);
        PG8_WAIT_V(6); PG8_BAR;
    } else {
        PG8_STAGE(PG8_SB(0, 0), cB, voffB); PG8_STAGE(PG8_SA(0, 0), cA, voffA); PG8_STAGE(PG8_SB(0, 1), cB + hstep, voffB); PG8_STAGE(PG8_SA(0, 1), cA + hstep, voffA);
        if (wr == 1) PG8_BAR;
        PG8_WAIT_V(4); PG8_BAR;
        PG8_STAGE(PG8_SB(1, 0), cB + kstep, voffB); PG8_STAGE(PG8_SA(1, 0), cA + kstep, voffA); PG8_STAGE(PG8_SB(1, 1), cB + hstep + kstep, voffB);
        PG8_WAIT_V(6); PG8_BAR;
    }
    for (;;) {
        const bool has_next = S.next(ui + 1, nxt);
        const char* nA = has_next ? (const char*)g.A + (size_t)nxt.pm * tstep : cA; const char* nB = has_next ? (const char*)g.Bt + (size_t)nxt.pn * tstep : cB;
        for (int t = 0; t < nt; t += 2) {
            const bool last = (t == nt - 2);
            const char* a1 = cA + (size_t)(t + 1) * kstep;
            const char* a2 = last ? nA : cA + (size_t)(t + 2) * kstep; const char* b2 = last ? nB : cB + (size_t)(t + 2) * kstep;
            const char* a3 = a2 + kstep; const char* b3 = b2 + kstep;
            if (last && has_next) S.a_ready(nxt);
            if constexpr (SP2) {
            PG8_LDB(B0, 0, 0); PG8_LDB(B1, 0, 1); PG8_SCHED; PG8_LDA(At, 0, 0); PG8_STAGE(PG8_SA(1, 1), a1 + hstep, voffA);
            PG8_WAIT_V(8); PG8_WAIT_L(0); PG8_BAR; PG8_MMA(0, 0, At, B0); PG8_MMA(0, 1, At, B1); PG8_BAR; PG8_SCHED;
            PG8_LDA(At, 0, 1); PG8_STAGE(PG8_SB(0, 0), b2, voffB); PG8_STAGE(PG8_SB(0, 1), b2 + hstep, voffB); PG8_STAGE(PG8_SA(0, 0), a2, voffA);
            PG8_WAIT_V(8); PG8_WAIT_L(0); PG8_BAR; PG8_MMA(1, 0, At, B0); PG8_MMA(1, 1, At, B1); PG8_BAR; PG8_SCHED;
            PG8_LDB(B0, 1, 0); PG8_LDB(B1, 1, 1); PG8_SCHED; PG8_LDA(At, 1, 0); PG8_STAGE(PG8_SA(0, 1), a2 + hstep, voffA);
            PG8_WAIT_V(8); PG8_WAIT_L(0); PG8_BAR; PG8_MMA(0, 0, At, B0); PG8_MMA(0, 1, At, B1); PG8_BAR; PG8_SCHED;
            PG8_LDA(At, 1, 1); PG8_STAGE(PG8_SB(1, 0), b3, voffB); PG8_STAGE(PG8_SB(1, 1), b3 + hstep, voffB); PG8_STAGE(PG8_SA(1, 0), a3, voffA);
            PG8_WAIT_V(8); PG8_WAIT_L(0); PG8_BAR; PG8_MMA(1, 0, At, B0); PG8_MMA(1, 1, At, B1); PG8_BAR; PG8_SCHED;
            } else {
            PG8_LDB(B0, 0, 0); PG8_SCHED; PG8_LDA(At, 0, 0); PG8_STAGE(PG8_SA(1, 1), a1 + hstep, voffA);
            PG8_WAIT_L(8); PG8_BAR; PG8_WAIT_L(0); PG8_MMA(0, 0, At, B0); PG8_BAR; PG8_SCHED;
            PG8_LDB(B1, 0, 1); PG8_STAGE(PG8_SB(0, 0), b2, voffB);
            PG8_BAR; PG8_WAIT_L(0); PG8_MMA(0, 1, At, B1); PG8_BAR;
            PG8_LDA(At, 0, 1); PG8_STAGE(PG8_SA(0, 0), a2, voffA);
            PG8_BAR; PG8_WAIT_L(0); PG8_MMA(1, 0, At, B0); PG8_BAR; PG8_SCHED;
            PG8_STAGE(PG8_SB(0, 1), b2 + hstep, voffB);
            PG8_WAIT_V(6); PG8_BAR; PG8_MMA(1, 1, At, B1); PG8_BAR;
            PG8_LDB(B0, 1, 0); PG8_SCHED; PG8_LDA(At, 1, 0); PG8_STAGE(PG8_SA(0, 1), a2 + hstep, voffA);
            PG8_WAIT_L(8); PG8_BAR; PG8_WAIT_L(0); PG8_MMA(0, 0, At, B0); PG8_BAR; PG8_SCHED;
            PG8_LDB(B1, 1, 1); PG8_STAGE(PG8_SB(1, 0), b3, voffB);
            PG8_BAR; PG8_WAIT_L(0); PG8_MMA(0, 1, At, B1); PG8_BAR;
            PG8_LDA(At, 1, 1); PG8_STAGE(PG8_SA(1, 0), a3, voffA);
            PG8_BAR; PG8_WAIT_L(0); PG8_MMA(1, 0, At, B0); PG8_BAR; PG8_SCHED;
            PG8_STAGE(PG8_SB(1, 1), b3 + hstep, voffB);
            PG8_WAIT_V(6); PG8_BAR; PG8_MMA(1, 1, At, B1); PG8_BAR;
            }
        }
        if constexpr (ALIGN_EPI) { if (wr == 0) PG8_BAR; }
        if constexpr (!Epi::AFTER_DRAIN) { E(acc, cur, wr, wc, fr, fq); S.done(cur); }
        if (!has_next) break;
#pragma unroll
        for (int a = 0; a < 2; ++a)
#pragma unroll
            for (int b = 0; b < 2; ++b)
#pragma unroll
                for (int m = 0; m < 4; ++m)
#pragma unroll
                    for (int n = 0; n < 2; ++n) acc[a][b][m][n] = (f32x4){0.f, 0.f, 0.f, 0.f};
        cur = nxt; cA = nA; cB = nB; ++ui;
        if constexpr (ALIGN_EPI) { if (wr == 1) PG8_BAR; }
    }
    PG8_WAIT_V(0);
    if constexpr (!ALIGN_EPI) { if (wr == 0) PG8_BAR; }
    PG8_BAR;
    if constexpr (Epi::AFTER_DRAIN) { E.fused(acc, cur, wr, wc, fr, fq, lds, wid, lane); S.done(cur); }
#undef PG8_SA
#undef PG8_SB
#undef PG8_STAGE
#undef PG8_LDA
#undef PG8_LDB
#undef PG8_MMA
#undef PG8_WAIT_V
#undef PG8_WAIT_L
#undef PG8_BAR
#undef PG8_SCHED
}
}
#define GAS __attribute__((address_space(1)))
#define LAS __attribute__((address_space(3)))
typedef unsigned short bf16;
typedef unsigned v4u __attribute__((ext_vector_type(4)));
typedef float f32x4 __attribute__((ext_vector_type(4)));
typedef short bf16x8 __attribute__((ext_vector_type(8)));
typedef __bf16 bf16x2_t __attribute__((ext_vector_type(2)));
#define LDS_WAIT() asm volatile("s_waitcnt lgkmcnt(0)" ::: "memory")
#define VM_WAIT() asm volatile("s_waitcnt vmcnt(0)" ::: "memory")
typedef float f32x2_cv __attribute__((ext_vector_type(2)));
__device__ __forceinline__ unsigned pk2(float lo, float hi) { const f32x2_cv v = {lo, hi}; return __builtin_bit_cast(unsigned, __builtin_convertvector(v, bf16x2_t)); }
__device__ __forceinline__ unsigned f2bf(float f) { return pk2(f, 0.f) & 0xffffu; }
__device__ __forceinline__ float bflo(unsigned u) { return __builtin_bit_cast(float, u << 16); }
__device__ __forceinline__ float bfhi(unsigned u) { return __builtin_bit_cast(float, u & 0xffff0000u); }
__device__ __forceinline__ float bf2f(bf16 u) { return __builtin_bit_cast(float, (unsigned)u << 16); }
#define XB_TMO      128
#define XB_XCNT(j)  (256  + 64 * (j))
#define XB_XSUB(j)  (1280 + 64 * (j))
#define XB_XGEN(j)  (2304 + 64 * (j))
#define XB_TOP      3328
#define XB_TOPGEN   3392
#define XCD_BAR_WORDS 3456
#define XB_SPIN_CAP (1u << 18)

__device__ __forceinline__ unsigned xb_ld(unsigned* p)              { return __hip_atomic_load(p, __ATOMIC_RELAXED, __HIP_MEMORY_SCOPE_AGENT); }
__device__ __forceinline__ unsigned xb_add(unsigned* p, unsigned v) { return __hip_atomic_fetch_add(p, v, __ATOMIC_RELAXED, __HIP_MEMORY_SCOPE_AGENT); }
__device__ __forceinline__ unsigned xb_xcc_id() { return (unsigned)__builtin_amdgcn_s_getreg((3 << 11) | 20) & 0xFu; }
#define XB_SPIN(cond, bar) do { unsigned _sp = 0; while (cond) { __builtin_amdgcn_s_sleep(1); \
    if ((++_sp & 255u) == 0u) { if (xb_ld(&(bar)[XB_TMO])) break; if (_sp > XB_SPIN_CAP) { atomicAdd(&(bar)[XB_TMO], 1u); break; } } } } while (0)

struct XcdBarrier {
    unsigned* bar; unsigned x; unsigned G;
    volatile LAS unsigned* st;
};

__device__ __forceinline__ XcdBarrier xcd_barrier_post(unsigned* bar, volatile LAS unsigned* st) {
    XcdBarrier b; b.bar = bar; b.x = xb_xcc_id(); b.st = st; b.G = gridDim.x;
    if (threadIdx.x == 0) (void)xb_add(&bar[XB_XCNT(b.x)], 1u);
    return b;
}
__device__ __forceinline__ void xcd_barrier_complete(unsigned* bar, unsigned x, unsigned& nloc, unsigned& nx, const unsigned G) {
    unsigned sum, cnt, mine, sp = 0u;
    for (;;) {
        sum = 0u; cnt = 0u; mine = 0u;
#pragma unroll
        for (unsigned j = 0; j < 16; ++j) { const unsigned c = xb_ld(&bar[XB_XCNT(j)]); sum += c; cnt += (c > 0u) ? 1u : 0u; mine = (j == x) ? c : mine; }
        if (sum == G) break;
        __builtin_amdgcn_s_sleep(1);
        if ((++sp & 255u) == 0u) { if (xb_ld(&bar[XB_TMO])) break; if (sp > XB_SPIN_CAP) { atomicAdd(&bar[XB_TMO], 1u); break; } }
    }
    nloc = mine > 0u ? mine : 1u; nx = cnt > 0u ? cnt : 1u;
}

__device__ __forceinline__ void xcd_barrier(const XcdBarrier& b) {
    asm volatile("s_waitcnt vmcnt(0)" ::: "memory");
    __syncthreads();
    if (threadIdx.x == 0) {
        unsigned* bar = b.bar;
        __builtin_amdgcn_s_waitcnt(0);
        unsigned nloc = b.st[0], nx = b.st[1];
        if (nloc == 0u) { xcd_barrier_complete(bar, b.x, nloc, nx, b.G); b.st[0] = nloc; b.st[1] = nx; }
        const unsigned old = xb_add(&bar[XB_XSUB(b.x)], 1u);
        const unsigned gen = old / nloc;
        if (old + 1u == (gen + 1u) * nloc) {
            __builtin_amdgcn_fence(__ATOMIC_RELEASE, "agent");
            asm volatile("s_waitcnt vmcnt(0)" ::: "memory");
            const unsigned og = xb_add(&bar[XB_TOP], 1u);
            const unsigned tg = og / nx;
            if (og + 1u == (tg + 1u) * nx) xb_add(&bar[XB_TOPGEN], 1u);
            else XB_SPIN(xb_ld(&bar[XB_TOPGEN]) == tg, bar);
            __builtin_amdgcn_fence(__ATOMIC_ACQUIRE, "agent");
            xb_add(&bar[XB_XGEN(b.x)], 1u);
            asm volatile("s_waitcnt vmcnt(0)" ::: "memory");
        } else {
            XB_SPIN(xb_ld(&bar[XB_XGEN(b.x)]) == gen, bar);
            __builtin_amdgcn_fence(__ATOMIC_ACQUIRE, "agent");
            asm volatile("s_waitcnt vmcnt(0)" ::: "memory");
        }
    }
    __syncthreads();
}

constexpr int NB = 8, SEQ = 8192, DM = 1024, T = NB * SEQ;
constexpr int NWAVES = 8;
constexpr float NORM_EPS = 1e-6f;
constexpr float C2 = 0.125f * 1.4426950408889634f;

constexpr size_t MiB = 1u << 20;
constexpr size_t WS_CTL = 0, CTL_ZERO_BYTES = 1 * MiB;
constexpr size_t WS_MOD = 1 * MiB;
constexpr size_t WS_SKB = 1 * MiB + 512 * 1024;
constexpr size_t WS_WSB = 1 * MiB + 768 * 1024;
constexpr size_t WS_LB  = 1 * MiB + 960 * 1024;
constexpr size_t WS_CS  = 2 * MiB;
constexpr size_t WS_HD  = 6 * MiB;
constexpr size_t WS_WIN = 16 * MiB, WS_WOUT0 = 22 * MiB, WS_WQKV = 24 * MiB, WS_WOUT1 = 30 * MiB, WS_WQ0 = 32 * MiB, WS_WQ1 = 36 * MiB;
constexpr size_t WS_TAB8 = 40 * MiB, TAB8_BYTES = 12 * MiB;
constexpr int TROW = 768;
constexpr size_t WS_SC8 = 8 * MiB;
constexpr size_t WS_H = 108 * MiB;
constexpr size_t WS_IDX = 236 * MiB, WS_GATE = 268 * MiB;
constexpr size_t WS_AR0 = 300 * MiB, AR_BYTES = 352 * MiB;
constexpr size_t AR_PU = 0, AR_PV = 32 * MiB, AR_PQ = 64 * MiB, AR_PI = 96 * MiB, AR_PG = 128 * MiB;
constexpr size_t AR_G = 160 * MiB;
constexpr size_t AR_KVT = 224 * MiB, AR_ST = 288 * MiB;
constexpr size_t AR_QP = 0;
constexpr size_t AR_QK = 0;
constexpr int QK_ROWS = SEQ + SEQ / 16;
__host__ __device__ __forceinline__ int qk_row(int t) { return t + (t >> 4); }
constexpr size_t WS_END = WS_AR0 + 2 * AR_BYTES;
constexpr int HT = T / 2;
constexpr int CW_BAR = 4096;

constexpr int LDS_BYTES = 147456;
constexpr int LDSCTL_OFF = LDS_BYTES - 512;
constexpr int MISC_OFF = LDSCTL_OFF;

struct Params {
    const float* x; const float* c; const int* positions; const float* ada_w; const float* ada_b; const float* norm_mix_g; const float* norm_ffn_g; const float* final_norm_g;
    const float* even_w_in; const float* even_w_out; const float* gmlp_ln_g; const float* gmlp_ln_b; const float* gmlp_w_s; const float* gmlp_b_s; const float* hgrn_lb_logits; const float* hgrn_norm_g;
    const float* odd_w_qkv; const float* odd_w_out; const float* peer_w_query; const float* peer_sub_keys; const float* peer_down; const float* peer_up;
    float* out; unsigned char* ws; int ph_lo, ph_hi;
};
struct Ctx { LAS unsigned char* lds; int tid, lane, wave, vcu, G; };
__device__ __forceinline__ Ctx fresh_ctx(const Ctx& C0) { Ctx C = C0; int t_ = threadIdx.x; asm volatile("" : "+v"(t_)); C.tid = t_; C.lane = t_ & 63; C.wave = __builtin_amdgcn_readfirstlane(t_ >> 6); return C; }
struct Wk { int lv, n, c, h; };
#define W_TK0(W) ((W).h * (T / 2))
#define W_BT0(W) ((W).h * (NB / 2))
__device__ __forceinline__ unsigned char* w_ar(const Params& P, const Wk& W) { return P.ws + WS_AR0 + (size_t)W.h * AR_BYTES; }
__device__ __forceinline__ bf16* w_tok16(const Params& P, const Wk& W, size_t off, int pitch) { return (bf16*)(w_ar(P, W) + off) - (size_t)W_TK0(W) * pitch; }
__device__ __forceinline__ float* w_tok32(const Params& P, const Wk& W, size_t off, int pitch) { return (float*)(w_ar(P, W) + off) - (size_t)W_TK0(W) * pitch; }
__device__ __forceinline__ bf16* w_item16(const Params& P, const Wk& W, size_t off) { return (bf16*)(w_ar(P, W) + off) - (size_t)W_BT0(W) * 512 * 16384; }

__device__ __forceinline__ float wave_sum(float v) {
#pragma unroll
    for (int o = 1; o < 64; o <<= 1) v += __shfl_xor(v, o);
    return v;
}
__device__ __forceinline__ float silu_f(float x) { return x * __builtin_amdgcn_rcpf(1.0f + __builtin_amdgcn_exp2f(-1.4426950408889634f * x)); }
__device__ __forceinline__ float sigmoid_f(float x) { return __builtin_amdgcn_rcpf(1.0f + __builtin_amdgcn_exp2f(-1.4426950408889634f * x)); }
__device__ __forceinline__ float gelu_f(float x) { return 0.5f * x * (1.0f + erff(x * 0.70710678118654752f)); }
__device__ __forceinline__ f32x4 mma16(f32x4 acc, const LAS bf16* A, int lda, const LAS bf16* Bt, int ldb, int K, int r, int q4) {
    const LAS bf16* ap = A + r * lda + 8 * q4; const LAS bf16* bp = Bt + r * ldb + 8 * q4;
    for (int k0 = 0; k0 < K; k0 += 32) {
        const bf16x8 a = *(const LAS bf16x8*)(ap + k0); const bf16x8 b = *(const LAS bf16x8*)(bp + k0);
        acc = __builtin_amdgcn_mfma_f32_16x16x32_bf16(a, b, acc, 0, 0, 0);
    }
    return acc;
}

struct EpiBf16P {
    static constexpr bool PERM = true, AFTER_DRAIN = false;
    bf16* O; size_t ldc;
    __device__ __forceinline__ void operator()(const f32x4 (&acc)[2][2][4][2], const pg8::Unit& u, int wr, int wc, int fr, int fq) const {
        const int row0 = u.pm * 256 + wr * 64 + fr, col0 = u.pn * 256 + wc * 32 + 8 * fq;
#pragma unroll
        for (int ai = 0; ai < 2; ++ai)
#pragma unroll
            for (int m = 0; m < 4; ++m) { bf16* rowp = O + (size_t)(row0 + ai * 128 + m * 16) * ldc + col0;
#pragma unroll
                for (int bj = 0; bj < 2; ++bj) { const f32x4 v0 = acc[ai][bj][m][0], v1 = acc[ai][bj][m][1];
                    v4u w; w.x = pg8::cvt_pk_bf16(v0[0], v0[1]); w.y = pg8::cvt_pk_bf16(v0[2], v0[3]); w.z = pg8::cvt_pk_bf16(v1[0], v1[1]); w.w = pg8::cvt_pk_bf16(v1[2], v1[3]);
                    *(v4u*)(rowp + bj * 128) = w; } }
    }
};
#ifndef REP_HG
#define REP_HG 1
#endif
#ifndef REP_TOPK
#define REP_TOPK 1
#endif
#ifndef REP_PRO
#define REP_PRO 1
#endif
#ifndef REP_NORM
#define REP_NORM 1
#endif
#ifndef REP_GEMM2
#define REP_GEMM2 1
#endif
#ifndef REP_GEMM
#define REP_GEMM 1
#endif
#ifndef EXP_REP
#define EXP_REP 1
#endif
#ifndef ATT_REP
#define ATT_REP 1
#endif
#ifndef ABL_ON
#define ABL_ON 4
#endif
struct EpiResid {
    static constexpr bool PERM = true, AFTER_DRAIN = false;
    const float* xin; float* xout; const float* gate; float gsc;
    __device__ __forceinline__ void operator()(const f32x4 (&acc)[2][2][4][2], const pg8::Unit& u, int wr, int wc, int fr, int fq) const {
        const int row0 = u.pm * 256 + wr * 64 + fr, col0 = u.pn * 256 + wc * 32 + 8 * fq;
        const float* gp = gate + (size_t)((u.pm * 256) >> 13) * 6144 + col0;
        f32x4 gv[2][2];
#pragma unroll
        for (int bj = 0; bj < 2; ++bj) { gv[bj][0] = *(const f32x4*)(gp + bj * 128); gv[bj][1] = *(const f32x4*)(gp + bj * 128 + 4); }
#pragma unroll
        for (int ai = 0; ai < 2; ++ai)
#pragma unroll
            for (int m = 0; m < 4; ++m) { const size_t off = (size_t)(row0 + ai * 128 + m * 16) * 1024 + col0;
#pragma unroll
                for (int bj = 0; bj < 2; ++bj) {
                    const f32x4 x0 = *(const f32x4*)(xin + off + bj * 128), x1 = *(const f32x4*)(xin + off + bj * 128 + 4);
                    *(f32x4*)(xout + off + bj * 128) = x0 + gv[bj][0] * acc[ai][bj][m][0] * gsc;
                    *(f32x4*)(xout + off + bj * 128 + 4) = x1 + gv[bj][1] * acc[ai][bj][m][1] * gsc; }
                asm volatile("" ::: "memory"); }
    }
};
struct EpiInProj {
    static constexpr bool PERM = true, AFTER_DRAIN = false;
    bf16* PU; bf16* PV; bf16* PQ; bf16* PI; bf16* PG; float* G; const float* LB;
    __device__ __forceinline__ void operator()(const f32x4 (&acc)[2][2][4][2], const pg8::Unit& u, int wr, int wc, int fr, int fq) const {
        const int type = u.pn >> 1;
        const int row0 = u.pm * 256 + wr * 64 + fr, lc0 = (u.pn & 1) * 256 + wc * 32 + 8 * fq;
        if (type == 3) {
            f32x4 lb[2][2];
#pragma unroll
            for (int bj = 0; bj < 2; ++bj) { lb[bj][0] = *(const f32x4*)(LB + lc0 + bj * 128); lb[bj][1] = *(const f32x4*)(LB + lc0 + bj * 128 + 4); }
#pragma unroll
            for (int ai = 0; ai < 2; ++ai)
#pragma unroll
                for (int m = 0; m < 4; ++m) { float* rowp = G + (size_t)(row0 + ai * 128 + m * 16) * 512 + lc0;
#pragma unroll
                    for (int bj = 0; bj < 2; ++bj)
#pragma unroll
                        for (int n = 0; n < 2; ++n) { const f32x4 v = acc[ai][bj][m][n]; f32x4 o;
#pragma unroll
                            for (int e = 0; e < 4; ++e) { const float l = lb[bj][n][e]; const float f = l + (1.0f - l) * sigmoid_f(v[e]); o[e] = __logf(f); }
                            *(f32x4*)(rowp + bj * 128 + 4 * n) = o; } }
            return;
        }
        bf16* base = type == 0 ? PU : type == 1 ? PV : type == 2 ? PQ : type == 4 ? PI : PG;
#pragma unroll
        for (int ai = 0; ai < 2; ++ai)
#pragma unroll
            for (int m = 0; m < 4; ++m) { bf16* rowp = base + (size_t)(row0 + ai * 128 + m * 16) * 512 + lc0;
#pragma unroll
                for (int bj = 0; bj < 2; ++bj) { f32x4 v0 = acc[ai][bj][m][0], v1 = acc[ai][bj][m][1];
                    if (type <= 1) { pg8::f32x2 a = pg8::gelu_pk((pg8::f32x2){v0[0], v0[1]}), b = pg8::gelu_pk((pg8::f32x2){v0[2], v0[3]}), c = pg8::gelu_pk((pg8::f32x2){v1[0], v1[1]}), d = pg8::gelu_pk((pg8::f32x2){v1[2], v1[3]});
                        v0 = (f32x4){a.x, a.y, b.x, b.y}; v1 = (f32x4){c.x, c.y, d.x, d.y}; }
                    else if (type == 2) {
#pragma unroll
                        for (int e = 0; e < 4; ++e) { v0[e] = silu_f(v0[e]) * 0.08838834764831845f; v1[e] = silu_f(v1[e]) * 0.08838834764831845f; } }
                    else if (type == 5) {
#pragma unroll
                        for (int e = 0; e < 4; ++e) { v0[e] = silu_f(v0[e]); v1[e] = silu_f(v1[e]); } }
                    v4u w; w.x = pg8::cvt_pk_bf16(v0[0], v0[1]); w.y = pg8::cvt_pk_bf16(v0[2], v0[3]); w.z = pg8::cvt_pk_bf16(v1[0], v1[1]); w.w = pg8::cvt_pk_bf16(v1[2], v1[3]);
                    *(v4u*)(rowp + bj * 128) = w; } }
    }
};
struct EpiQKRot {
    static constexpr bool PERM = true, AFTER_DRAIN = false;
    bf16* O; const float* CS;
    __device__ __forceinline__ void operator()(const f32x4 (&acc)[2][2][4][2], const pg8::Unit& u, int wr, int wc, int fr, int fq) const {
        const int row0 = u.pm * 256 + wr * 64 + fr, col0 = u.pn * 256 + wc * 32 + 8 * fq;
        const float sc = u.pn < 4 ? C2 : 1.0f;
        const bool rotw = (wc & 1) == 0 && u.pn < 8;
        const float sgn = fq == 0 ? -1.0f : 1.0f;
#pragma unroll
        for (int ai = 0; ai < 2; ++ai)
#pragma unroll
            for (int m = 0; m < 4; ++m) { const int row = row0 + ai * 128 + m * 16;
                bf16* rowp = O + ((size_t)(((u.pn >> 2) * 4 + (row >> 13)) * 16 + (u.pn & 3) * 4 + (wc >> 1)) * QK_ROWS + qk_row(row & 8191)) * 64 + (wc & 1) * 32 + 8 * fq;
                f32x4 c0 = (f32x4){1.f, 1.f, 1.f, 1.f}, c1 = c0, s0 = (f32x4){0.f, 0.f, 0.f, 0.f}, s1 = s0;
                if (rotw && fq < 2) { const float* cp = CS + (size_t)row * 16; c0 = *(const f32x4*)(cp); c1 = *(const f32x4*)(cp + 4); s0 = *(const f32x4*)(cp + 8) * sgn; s1 = *(const f32x4*)(cp + 12) * sgn; }
#pragma unroll
                for (int bj = 0; bj < 2; ++bj) { f32x4 v0 = acc[ai][bj][m][0], v1 = acc[ai][bj][m][1];
                    if (rotw) { f32x4 p0, p1;
#pragma unroll
                        for (int e = 0; e < 4; ++e) { p0[e] = __shfl_xor(v0[e], 16); p1[e] = __shfl_xor(v1[e], 16); }
                        v0 = v0 * c0 + p0 * s0; v1 = v1 * c1 + p1 * s1; }
                    v0 = v0 * sc; v1 = v1 * sc;
                    v4u w; w.x = pg8::cvt_pk_bf16(v0[0], v0[1]); w.y = pg8::cvt_pk_bf16(v0[2], v0[3]); w.z = pg8::cvt_pk_bf16(v1[0], v1[1]); w.w = pg8::cvt_pk_bf16(v1[2], v1[3]);
                    *(v4u*)(rowp + (size_t)bj * 2 * QK_ROWS * 64) = w; } }
    }
};

__device__ __forceinline__ void p0_transpose_item(const float* W, int K, int N, bf16* WT, LAS float* scr, int item, int lane) {
    const int nblk = N / 32, kb = item / nblk, nb = item % nblk, k0 = 64 * kb, n0 = 32 * nb;
#pragma unroll 8
    for (int i = 0; i < 32; ++i) { const int kk = 2 * i + (lane >> 5); scr[kk * 33 + (lane & 31)] = W[(size_t)(k0 + kk) * N + n0 + (lane & 31)]; }
    LDS_WAIT(); asm volatile("" ::: "memory");
    const int c = lane & 7;
#pragma unroll
    for (int j = 0; j < 4; ++j) { const int n = (lane >> 3) + 8 * j; const LAS float* s = scr + (8 * c) * 33 + n;
        v4u o; o.x = pk2(s[0 * 33], s[1 * 33]); o.y = pk2(s[2 * 33], s[3 * 33]); o.z = pk2(s[4 * 33], s[5 * 33]); o.w = pk2(s[6 * 33], s[7 * 33]);
        *(GAS v4u*)(WT + (size_t)(n0 + n) * K + k0 + 8 * c) = o; }
    LDS_WAIT(); asm volatile("" ::: "memory");
}
typedef float f32x2 __attribute__((ext_vector_type(2)));
typedef float f32x16v __attribute__((ext_vector_type(16)));
typedef float f32x32v __attribute__((ext_vector_type(32)));
typedef unsigned v6u __attribute__((ext_vector_type(6)));
__device__ __forceinline__ void convert_tables(const Params& P, const Ctx& C) {
    const int gw = C.vcu * NWAVES + C.wave, NGW = C.G * NWAVES, lane = C.lane, hl = lane & 31;
    LAS float* stg = (LAS float*)(C.lds + C.wave * 16384);
    for (int rp = gw; rp < 2 * 16384; rp += NGW) {
#pragma unroll
        for (int rr = 0; rr < 2; ++rr) { const int row_ = 2 * rp + rr, tb_ = row_ >> 14, e_ = row_ & 16383;
            const f32x4* src = (const f32x4*)(((tb_ & 1) ? P.peer_up : P.peer_down) + ((size_t)(tb_ >> 1) * 16384 + e_) * 1024);
#pragma unroll
            for (int j = 0; j < 4; ++j) *(LAS f32x4*)(stg + rr * 1024 + 4 * (64 * j + lane)) = src[64 * j + lane]; }
        LDS_WAIT(); asm volatile("" ::: "memory");
        const int row = 2 * rp + (lane >> 5), tb = row >> 14, e = row & 16383;
        const LAS f32x4* sp = (const LAS f32x4*)(stg + (lane >> 5) * 1024 + 32 * hl);
        unsigned char* dst = P.ws + WS_TAB8 + (size_t)tb * TAB8_BYTES + (size_t)e * TROW + 24 * hl;
        f32x16v a, b2; float mx = 0.f;
#pragma unroll
        for (int j = 0; j < 4; ++j) { const f32x4 v = sp[j], w = sp[4 + j];
#pragma unroll
            for (int i = 0; i < 4; ++i) { mx = fmaxf(mx, fmaxf(fabsf(v[i]), fabsf(w[i]))); }
            a[2 * j] = v[0]; b2[2 * j] = v[1]; a[2 * j + 1] = v[2]; b2[2 * j + 1] = v[3]; a[8 + 2 * j] = w[0]; b2[8 + 2 * j] = w[1]; a[8 + 2 * j + 1] = w[2]; b2[8 + 2 * j + 1] = w[3]; }
        LDS_WAIT(); asm volatile("" ::: "memory");
#pragma unroll
        for (int o = 1; o < 32; o <<= 1) mx = fmaxf(mx, __shfl_xor(mx, o));
        const float sc = mx > 0.f ? 7.0f / mx : 0.f;
        a = a * sc; b2 = b2 * sc;
        const v6u p = __builtin_amdgcn_cvt_scalef32_2xpk16_fp6_f32(a, b2, 1.0f);
        unsigned long long* d8 = (unsigned long long*)dst;
        d8[0] = ((unsigned long long)p[1] << 32) | p[0]; d8[1] = ((unsigned long long)p[3] << 32) | p[2]; d8[2] = ((unsigned long long)p[5] << 32) | p[4];
        if (hl == 0) ((float*)(P.ws + WS_SC8))[row] = mx * (1.0f / 7.0f);
    }
}
__device__ __forceinline__ void phase_prologue(const Params& P, const Ctx& C) {
    float* MOD = (float*)(P.ws + WS_MOD);
    {
        LAS float* cond = (LAS float*)C.lds;
        LAS float* part = (LAS float*)(C.lds + 32768);
        for (int e = C.tid; e < 8192; e += 512) cond[e] = silu_f(P.c[e]);
        __syncthreads();
        for (int item = C.vcu; item < 192; item += C.G) {
            const int l = item / 96, cb = item % 96, col = cb * 64 + C.lane;
            float acc[8];
#pragma unroll
            for (int b = 0; b < 8; ++b) acc[b] = 0.f;
            const float* wp = P.ada_w + ((size_t)l * 1024 + C.wave * 128) * 6144 + col;
#pragma unroll 4
            for (int k = 0; k < 128; ++k) { const float wv = wp[(size_t)k * 6144];
#pragma unroll
                for (int b = 0; b < 8; ++b) acc[b] += cond[b * 1024 + C.wave * 128 + k] * wv; }
#pragma unroll
            for (int b = 0; b < 8; ++b) part[(C.wave * 8 + b) * 64 + C.lane] = acc[b];
            __syncthreads();
            { const int b = C.tid >> 6, ln = C.tid & 63; float s = P.ada_b[l * 6144 + cb * 64 + ln];
#pragma unroll
              for (int w = 0; w < 8; ++w) s += part[(w * 8 + b) * 64 + ln];
              MOD[(size_t)(l * 8 + b) * 6144 + cb * 64 + ln] = s; }
            __syncthreads();
        }
        __syncthreads();
    }
    {
        LAS float* scr = (LAS float*)(C.lds + C.wave * 16384);
        const int gw = C.vcu * NWAVES + C.wave, NGW = C.G * NWAVES;
        for (int it = gw; it < 6144; it += NGW) {
            int r = it;
            if (r < 1536) { p0_transpose_item(P.even_w_in, 1024, 3072, (bf16*)(P.ws + WS_WIN), scr, r, C.lane); continue; } r -= 1536;
            if (r < 512)  { p0_transpose_item(P.even_w_out, 1024, 1024, (bf16*)(P.ws + WS_WOUT0), scr, r, C.lane); continue; } r -= 512;
            if (r < 1536) { p0_transpose_item(P.odd_w_qkv, 1024, 3072, (bf16*)(P.ws + WS_WQKV), scr, r, C.lane); continue; } r -= 1536;
            if (r < 512)  { p0_transpose_item(P.odd_w_out, 1024, 1024, (bf16*)(P.ws + WS_WOUT1), scr, r, C.lane); continue; } r -= 512;
            if (r < 1024) { p0_transpose_item(P.peer_w_query, 1024, 2048, (bf16*)(P.ws + WS_WQ0), scr, r, C.lane); continue; } r -= 1024;
            p0_transpose_item(P.peer_w_query + (size_t)1024 * 2048, 1024, 2048, (bf16*)(P.ws + WS_WQ1), scr, r, C.lane);
        }
    }
    convert_tables(P, C);
    const int NT = C.G * 512, gt = C.vcu * 512 + C.tid;
    { bf16* skb = (bf16*)(P.ws + WS_SKB); for (int i = gt; i < 65536; i += NT) skb[i] = (bf16)f2bf(P.peer_sub_keys[i]); }
    { bf16* wsb = (bf16*)(P.ws + WS_WSB); for (int i = gt; i < 65536; i += NT) { const int t = (i >> 7) & 127, s = i & 127; wsb[i] = (bf16)(s <= t ? f2bf(P.gmlp_w_s[i]) : 0u); } }
    { float* lb = (float*)(P.ws + WS_LB); for (int i = gt; i < 512; i += NT) { const float l0 = P.hgrn_lb_logits[i], l1 = P.hgrn_lb_logits[512 + i]; lb[i] = 1.0f / (1.0f + expf(l1 - l0)); } }
    { float* cs = (float*)(P.ws + WS_CS); for (int i = gt; i < T * 8; i += NT) { const int tok = i >> 3, j = i & 7;
        const float inv = 1.0f / powf(500000.0f, (float)j * 0.125f); const float ang = (float)P.positions[tok] * inv; float sn, cn; sincosf(ang, &sn, &cn);
        cs[(size_t)tok * 16 + j] = cn; cs[(size_t)tok * 16 + 8 + j] = sn; } }
}
__device__ __forceinline__ void norm_row_bf16(const float* xrow, bf16* hrow, const float* g, const float* sh, const float* sc, int lane) {
    const f32x4* xr = (const f32x4*)xrow + lane; f32x4 v[4]; float s = 0.f;
#pragma unroll
    for (int j = 0; j < 4; ++j) { v[j] = xr[64 * j]; s += (v[j][0] * v[j][0] + v[j][1] * v[j][1]) + (v[j][2] * v[j][2] + v[j][3] * v[j][3]); }
    const float rstd = 1.0f / sqrtf(wave_sum(s) * (1.0f / 1024.0f) + NORM_EPS);
    unsigned long long* o8 = (unsigned long long*)hrow + lane;
#pragma unroll
    for (int j = 0; j < 4; ++j) { const f32x4 gg = ((const f32x4*)g)[64 * j + lane], hh = ((const f32x4*)sh)[64 * j + lane], cc = ((const f32x4*)sc)[64 * j + lane];
        const f32x4 y = (v[j] * rstd * gg) * (cc + 1.0f) + hh;
        o8[64 * j] = (unsigned long long)pk2(y[0], y[1]) | ((unsigned long long)pk2(y[2], y[3]) << 32); }
}
__device__ __forceinline__ void phase_norm(const Params& P, const Ctx& C, const Wk& W, const float* xsrc, const float* g, int l, int so) {
    const float* MOD = (const float*)(P.ws + WS_MOD); bf16* H = (bf16*)(P.ws + WS_H);
    const int gw = W.lv * NWAVES + C.wave, NGW = W.n * NWAVES;
    for (int m = W_TK0(W) + gw; m < W_TK0(W) + HT; m += NGW) { const float* mb = MOD + (size_t)(l * 8 + (m >> 13)) * 6144 + so;
        norm_row_bf16(xsrc + (size_t)m * 1024, H + (size_t)m * 1024, g, mb, mb + 1024, C.lane); }
}

__device__ __forceinline__ void gmlp_item(const Params& P, const Ctx& C, const Wk& W, int n, int g) {
    LAS bf16* Wt = (LAS bf16*)C.lds;
    LAS bf16* vT = (LAS bf16*)(C.lds + 34816);
    const bf16* WSB = (const bf16*)(P.ws + WS_WSB); const bf16* PU = w_tok16(P, W, AR_PU, 512); const bf16* PV = w_tok16(P, W, AR_PV, 512); bf16* MIX = (bf16*)(P.ws + WS_H);
    const int tid = C.tid, r = C.lane & 15, q4 = C.lane >> 4;
    for (int ch = tid; ch < 2048; ch += 512) { const int rr = ch >> 4, c8 = (ch & 15) * 8; *(LAS v4u*)(Wt + rr * 136 + c8) = *(const v4u*)(WSB + (size_t)(g * 128 + rr) * 128 + c8); }
    { const int t = tid >> 2, part = tid & 3; const bf16* src = PV + (size_t)(n * 128 + t) * 512 + g * 128 + part * 32;
      float x[32];
#pragma unroll
      for (int j = 0; j < 4; ++j) { const v4u w = *(const v4u*)(src + 8 * j);
#pragma unroll
          for (int e = 0; e < 4; ++e) { x[8 * j + 2 * e] = bflo(w[e]); x[8 * j + 2 * e + 1] = bfhi(w[e]); } }
      float s = 0.f;
#pragma unroll
      for (int j = 0; j < 32; ++j) s += x[j];
      s += __shfl_xor(s, 1); s += __shfl_xor(s, 2);
      const float mean = s * (1.0f / 128.0f); float q = 0.f;
#pragma unroll
      for (int j = 0; j < 32; ++j) { const float d = x[j] - mean; q += d * d; }
      q += __shfl_xor(q, 1); q += __shfl_xor(q, 2);
      const float rstd = 1.0f / sqrtf(q * (1.0f / 128.0f) + NORM_EPS);
      const float* lg = P.gmlp_ln_g + g * 128 + part * 32; const float* lbp = P.gmlp_ln_b + g * 128 + part * 32;
#pragma unroll
      for (int j = 0; j < 32; ++j) vT[(part * 32 + j) * 136 + t] = (bf16)f2bf((x[j] - mean) * rstd * lg[j] + lbp[j]);
    }
    __syncthreads();
    const int t0 = 16 * C.wave; const int Keff = ((t0 + 16 + 31) >> 5) << 5;
    f32x4 acc[8];
#pragma unroll
    for (int ct = 0; ct < 8; ++ct) { acc[ct] = (f32x4){0.f, 0.f, 0.f, 0.f}; acc[ct] = mma16(acc[ct], Wt + t0 * 136, 136, vT + (16 * ct) * 136, 136, Keff, r, q4); }
#pragma unroll
    for (int i = 0; i < 4; ++i) { const int t = t0 + 4 * q4 + i; const float bs = P.gmlp_b_s[g * 128 + t]; const size_t tok = (size_t)n * 128 + t;
#pragma unroll
        for (int ct = 0; ct < 8; ++ct) { const int c = 16 * ct + r; const float u = bf2f(PU[tok * 512 + g * 128 + c]); MIX[tok * 1024 + g * 128 + c] = (bf16)f2bf(u * (acc[ct][i] + bs)); } }
    __syncthreads();
}
__device__ __forceinline__ void hgrn_cumsum16(const float* G, size_t tok0, int hh, int k, int seg, LAS float* tot, float (&g)[16], float (&bb)[16], float& total) {
    const float* gp = G + (tok0 + seg * 16) * 512 + hh * 128 + k;
#pragma unroll
    for (int j = 0; j < 16; ++j) g[j] = gp[(size_t)j * 512];
    float run = 0.f;
#pragma unroll
    for (int j = 0; j < 16; ++j) { run += g[j]; bb[j] = run; }
    tot[seg * 128 + k] = run;
    __syncthreads();
    const float t0 = tot[k], t1 = tot[128 + k], t2 = tot[256 + k], t3 = tot[384 + k];
    const float pre = seg == 0 ? 0.f : seg == 1 ? t0 : seg == 2 ? t0 + t1 : t0 + t1 + t2;
    total = (t0 + t1) + (t2 + t3);
#pragma unroll
    for (int j = 0; j < 16; ++j) bb[j] += pre;
}
__device__ __forceinline__ void hgrn_stage_iT(const bf16* PI, size_t tok0, int hh, LAS bf16* iT, int tid) {
    const int s = tid >> 3, v0 = (tid & 7) * 16; const bf16* src = PI + (tok0 + s) * 512 + hh * 128 + v0;
#pragma unroll
    for (int h2 = 0; h2 < 2; ++h2) { const v4u w = *(const v4u*)(src + 8 * h2);
#pragma unroll
        for (int e = 0; e < 4; ++e) { iT[(v0 + 8 * h2 + 2 * e) * 72 + s] = (bf16)(w[e] & 0xffffu); iT[(v0 + 8 * h2 + 2 * e + 1) * 72 + s] = (bf16)(w[e] >> 16); } }
}
__device__ __forceinline__ void hgrn_local_item(const Params& P, const Ctx& C, const Wk& W, int item) {
    LAS bf16* khT = (LAS bf16*)C.lds;
    LAS bf16* iT = (LAS bf16*)(C.lds + 18432);
    LAS float* tot = (LAS float*)(C.lds + 36864);
    const float* G = w_tok32(P, W, AR_G, 512); const bf16* PI = w_tok16(P, W, AR_PI, 512); bf16* KVT = w_item16(P, W, AR_KVT); float* HD = (float*)(P.ws + WS_HD);
    const int bh = item >> 7, c = item & 127, b = bh >> 2, hh = bh & 3; const size_t tok0 = (size_t)b * SEQ + c * 64;
    const int tid = C.tid, k = tid & 127, seg = tid >> 7, r = C.lane & 15, q4 = C.lane >> 4;
    float g[16], bb[16], total;
    hgrn_cumsum16(G, tok0, hh, k, seg, tot, g, bb, total);
    { unsigned w[8];
#pragma unroll
      for (int j = 0; j < 8; ++j) { const float a0 = -expm1f(g[2 * j]) * __expf(total - bb[2 * j]), a1 = -expm1f(g[2 * j + 1]) * __expf(total - bb[2 * j + 1]); w[j] = pk2(a0, a1); }
      LAS v4u* dst = (LAS v4u*)(khT + k * 72 + seg * 16); dst[0] = (v4u){w[0], w[1], w[2], w[3]}; dst[1] = (v4u){w[4], w[5], w[6], w[7]}; }
    if (seg == 0) HD[(size_t)item * 128 + k] = __expf(total);
    hgrn_stage_iT(PI, tok0, hh, iT, tid);
    __syncthreads();
    const int v0 = 16 * C.wave;
#pragma unroll
    for (int ct = 0; ct < 8; ++ct) { f32x4 acc = (f32x4){0.f, 0.f, 0.f, 0.f}; acc = mma16(acc, iT + v0 * 72, 72, khT + (16 * ct) * 72, 72, 64, r, q4);
#pragma unroll
        for (int i = 0; i < 4; ++i) KVT[((size_t)item * 128 + v0 + 4 * q4 + i) * 128 + 16 * ct + r] = (bf16)f2bf(acc[i]); }
    __syncthreads();
}
__device__ __forceinline__ void phase_hgrn_scan(const Params& P, const Ctx& C, const Wk& W) {
    const bf16* KVT = w_item16(P, W, AR_KVT); bf16* ST = w_item16(P, W, AR_ST); const float* HD = (const float*)(P.ws + WS_HD);
    for (int task = W.lv * 256 + C.tid; C.tid < 256 && task < 32768; task += W.n * 256) {
        const int bh = W_BT0(W) * 4 + (task >> 11), v = (task >> 4) & 127, kb = task & 15;
        float st[8];
#pragma unroll
        for (int e = 0; e < 8; ++e) st[e] = 0.f;
#pragma unroll 4
        for (int c = 0; c < 128; ++c) { const size_t item = (size_t)bh * 128 + c, off = (item * 128 + v) * 128 + kb * 8;
            const v4u kv = *(const v4u*)(KVT + off); const f32x4 d0 = *(const f32x4*)(HD + item * 128 + kb * 8), d1 = *(const f32x4*)(HD + item * 128 + kb * 8 + 4);
            v4u o; o.x = pk2(st[0], st[1]); o.y = pk2(st[2], st[3]); o.z = pk2(st[4], st[5]); o.w = pk2(st[6], st[7]);
            *(v4u*)(ST + off) = o;
#pragma unroll
            for (int e = 0; e < 4; ++e) { st[2 * e] = (e < 2 ? d0[2 * e] : d1[2 * e - 4]) * st[2 * e] + bflo(kv[e]); st[2 * e + 1] = (e < 2 ? d0[2 * e + 1] : d1[2 * e - 3]) * st[2 * e + 1] + bfhi(kv[e]); }
        }
    }
}
__device__ __forceinline__ void hgrn_out_item(const Params& P, const Ctx& C, const Wk& W, int item) {
    LAS bf16* qt = (LAS bf16*)C.lds;
    LAS bf16* kt = (LAS bf16*)(C.lds + 17408);
    LAS bf16* iT = (LAS bf16*)(C.lds + 34816);
    LAS bf16* A1 = (LAS bf16*)(C.lds + 53248);
    LAS bf16* STl = (LAS bf16*)(C.lds + 62464);
    LAS float* ol = (LAS float*)(C.lds + 97280);
    LAS float* tot = (LAS float*)(C.lds + 131072);
    const float* G = w_tok32(P, W, AR_G, 512); const bf16* PQ = w_tok16(P, W, AR_PQ, 512); const bf16* PI = w_tok16(P, W, AR_PI, 512); const bf16* PG = w_tok16(P, W, AR_PG, 512);
    const bf16* ST = w_item16(P, W, AR_ST); bf16* MIX = (bf16*)(P.ws + WS_H);
    const int bh = item >> 7, c = item & 127, b = bh >> 2, hh = bh & 3; const size_t tok0 = (size_t)b * SEQ + c * 64;
    const int tid = C.tid, k = tid & 127, seg = tid >> 7, r = C.lane & 15, q4 = C.lane >> 4;
    float g[16], bb[16], total;
    hgrn_cumsum16(G, tok0, hh, k, seg, tot, g, bb, total);
#pragma unroll
    for (int j = 0; j < 16; ++j) { const int t = seg * 16 + j; const float qv = bf2f(PQ[(tok0 + t) * 512 + hh * 128 + k]);
        qt[t * 136 + k] = (bf16)f2bf(qv * __expf(bb[j])); kt[t * 136 + k] = (bf16)f2bf(-expm1f(g[j]) * __expf(-bb[j])); }
    hgrn_stage_iT(PI, tok0, hh, iT, tid);
    for (int ch = tid; ch < 2048; ch += 512) { const int rr = ch >> 4, c8 = (ch & 15) * 8; *(LAS v4u*)(STl + rr * 136 + c8) = *(const v4u*)(ST + ((size_t)item * 128 + rr) * 128 + c8); }
    __syncthreads();
    { const int rt = C.wave >> 1;
#pragma unroll
      for (int cc = 0; cc < 2; ++cc) { const int ct = (C.wave & 1) * 2 + cc; f32x4 acc = (f32x4){0.f, 0.f, 0.f, 0.f};
          acc = mma16(acc, qt + (16 * rt) * 136, 136, kt + (16 * ct) * 136, 136, 128, r, q4);
#pragma unroll
          for (int i = 0; i < 4; ++i) { const int t = 16 * rt + 4 * q4 + i, s = 16 * ct + r; A1[t * 72 + s] = (bf16)(s <= t ? f2bf(acc[i]) : 0u); } } }
    __syncthreads();
    { const int rt = C.wave >> 1;
#pragma unroll
      for (int cc = 0; cc < 4; ++cc) { const int ct = (C.wave & 1) * 4 + cc; f32x4 acc = (f32x4){0.f, 0.f, 0.f, 0.f};
          acc = mma16(acc, A1 + (16 * rt) * 72, 72, iT + (16 * ct) * 72, 72, 64, r, q4);
          acc = mma16(acc, qt + (16 * rt) * 136, 136, STl + (16 * ct) * 136, 136, 128, r, q4);
#pragma unroll
          for (int i = 0; i < 4; ++i) ol[(16 * rt + 4 * q4 + i) * 132 + 16 * ct + r] = acc[i]; } }
    __syncthreads();
    { const int t = tid >> 3, v0 = (tid & 7) * 16; float o[16]; float ss = 0.f;
#pragma unroll
      for (int e = 0; e < 16; ++e) { o[e] = ol[t * 132 + v0 + e]; ss += o[e] * o[e]; }
      ss += __shfl_xor(ss, 1); ss += __shfl_xor(ss, 2); ss += __shfl_xor(ss, 4);
      const float rstd = 1.0f / sqrtf(ss * (1.0f / 128.0f) + NORM_EPS);
      const float* ng = P.hgrn_norm_g + hh * 128 + v0; const bf16* gp = PG + (tok0 + t) * 512 + hh * 128 + v0;
      const v4u g0 = *(const v4u*)gp, g1 = *(const v4u*)(gp + 8); unsigned w[8];
#pragma unroll
      for (int e = 0; e < 4; ++e) { w[e] = pk2(o[2 * e] * rstd * ng[2 * e] * bflo(g0[e]), o[2 * e + 1] * rstd * ng[2 * e + 1] * bfhi(g0[e]));
                                    w[4 + e] = pk2(o[8 + 2 * e] * rstd * ng[8 + 2 * e] * bflo(g1[e]), o[9 + 2 * e] * rstd * ng[9 + 2 * e] * bfhi(g1[e])); }
      v4u* dst = (v4u*)(MIX + (tok0 + t) * 1024 + 512 + hh * 128 + v0); dst[0] = (v4u){w[0], w[1], w[2], w[3]}; dst[1] = (v4u){w[4], w[5], w[6], w[7]}; }
    __syncthreads();
}

typedef short v4i16_t __attribute__((ext_vector_type(4)));
constexpr int AT_VP = 144;
constexpr int AT_QI = 512;
constexpr int AT_STO = 0, AT_STML = AT_QI * 128, AT_VW = AT_STML + AT_QI * 8;
__device__ __forceinline__ void attn_softmax_block(f32x4 (&sa)[9], int tile0, int qq, int mq0, int q4, float& mx, float& ls, bf16x8 (&pf)[5]) {
    const int lo4 = (qq > 128 - mq0 ? qq : 128 - mq0) - 4 * q4, hi4 = qq + 128 - 4 * q4;
    mx = -1e30f;
#pragma unroll
    for (int t = 0; t < 9; ++t)
#pragma unroll
        for (int i = 0; i < 4; ++i) { const int K0 = 16 * (tile0 + t) + i; const bool ok = K0 >= lo4 && K0 <= hi4;
            sa[t][i] = ok ? sa[t][i] : -1e30f; mx = fmaxf(mx, sa[t][i]); }
    mx = fmaxf(mx, __shfl_xor(mx, 16)); mx = fmaxf(mx, __shfl_xor(mx, 32));
    ls = 0.f;
#pragma unroll
    for (int t = 0; t < 9; ++t)
#pragma unroll
        for (int i = 0; i < 4; ++i) { const float pv = __builtin_amdgcn_exp2f(sa[t][i] - mx); sa[t][i] = pv; ls += pv; }
    ls += __shfl_xor(ls, 16); ls += __shfl_xor(ls, 32);
#pragma unroll
    for (int s2 = 0; s2 < 5; ++s2) { const int tl = 2 * s2 - tile0, th = 2 * s2 + 1 - tile0;
        const f32x4 lo = (tl >= 0 && tl < 9) ? sa[(tl >= 0 && tl < 9) ? tl : 0] : (f32x4){0.f, 0.f, 0.f, 0.f}, hi = (th >= 0 && th < 9) ? sa[(th >= 0 && th < 9) ? th : 0] : (f32x4){0.f, 0.f, 0.f, 0.f};
        v4u w; w.x = pk2(lo[0], lo[1]); w.y = pk2(lo[2], lo[3]); w.z = pk2(hi[0], hi[1]); w.w = pk2(hi[2], hi[3]); pf[s2] = __builtin_bit_cast(bf16x8, w); }
}
__device__ __forceinline__ void attn_merge(int g, LAS unsigned char* lds, int qloc, int q4, f32x4 (&oa)[4], float mx, float ls, bf16* orow) {
    LAS unsigned char* so = lds + AT_STO + qloc * 128 + 8 * q4; LAS float* sml = (LAS float*)(lds + AT_STML) + 2 * qloc;
    float mo = mx, lo2 = ls;
    if (g > 0) { const float m_old = sml[0], l_old = sml[1]; const float M = fmaxf(m_old, mx); const float fo = __builtin_amdgcn_exp2f(m_old - M), fn = __builtin_amdgcn_exp2f(mx - M);
#pragma unroll
        for (int dt = 0; dt < 4; ++dt) { const unsigned long long w = *(const LAS unsigned long long*)(so + 32 * dt); const unsigned w0 = (unsigned)w, w1 = (unsigned)(w >> 32);
            oa[dt] = oa[dt] * fn + (f32x4){bflo(w0), bfhi(w0), bflo(w1), bfhi(w1)} * fo; }
        mo = M; lo2 = ls * fn + l_old * fo; }
    if (g < 2) {
#pragma unroll
        for (int dt = 0; dt < 4; ++dt) *(LAS unsigned long long*)(so + 32 * dt) = (unsigned long long)pk2(oa[dt][0], oa[dt][1]) | ((unsigned long long)pk2(oa[dt][2], oa[dt][3]) << 32);
        if (q4 == 0) { sml[0] = mo; sml[1] = lo2; }
    } else { const float inv = 1.0f / lo2;
#pragma unroll
        for (int dt = 0; dt < 4; ++dt) { const f32x4 v = oa[dt] * inv; *(unsigned long long*)(orow + 16 * dt) = (unsigned long long)pk2(v[0], v[1]) | ((unsigned long long)pk2(v[2], v[3]) << 32); } }
}
__device__ __forceinline__ void attn_item(const Params& P, const Ctx& C, const Wk& W, int b, int hd, int qt) {
    LAS unsigned char* Vw = C.lds + AT_VW + C.wave * (64 * AT_VP);
    const bf16* QKV = (const bf16*)(w_ar(P, W) + AR_QK); bf16* O = (bf16*)(P.ws + WS_H); const int bl = b - W_BT0(W);
    const int lane = C.lane, r = lane & 15, q4 = lane >> 4;
    const int t0 = qt * AT_QI; const size_t rowbase = (size_t)b * SEQ;
    const bf16* Qh = QKV + (size_t)((0 * 4 + bl) * 16 + hd) * QK_ROWS * 64; const bf16* Kb = QKV + (size_t)((1 * 4 + bl) * 16 + hd) * QK_ROWS * 64; const bf16* Vb = QKV + (size_t)((2 * 4 + bl) * 16 + hd) * QK_ROWS * 64;
#pragma unroll 1
    for (int g = 0; g < 3; ++g) {
        const int dsh = 4 - 2 * g, d = 1 << dsh;
#pragma unroll 1
        for (int uu = 0; uu < 2; ++uu) {
            const int u = C.wave + 8 * uu;
            const int c = u & (d - 1), j = u >> dsh;
            const int mq0 = (t0 >> dsh) + 32 * j;
            const int ql0 = c + d * (32 * j + r), ql1 = ql0 + 16 * d;
            const bf16* qp0 = Qh + (size_t)qk_row(t0 + ql0) * 64 + 8 * q4; const bf16* qp1 = Qh + (size_t)qk_row(t0 + ql1) * 64 + 8 * q4;
            const bf16x8 bq00 = *(const bf16x8*)qp0, bq01 = *(const bf16x8*)(qp0 + 32), bq10 = *(const bf16x8*)qp1, bq11 = *(const bf16x8*)(qp1 + 32);
            bf16x8 ka[10][2];
#pragma unroll
            for (int t = 0; t < 10; ++t) { int mk = mq0 - 128 + 16 * t + r; mk = mk < 0 ? 0 : mk;
                const unsigned ko = (unsigned)qk_row(c + (mk << dsh)) * 128u + 16u * q4; ka[t][0] = *(const bf16x8*)((const char*)Kb + ko); ka[t][1] = *(const bf16x8*)((const char*)Kb + ko + 64); }
            v4u vr[2][8];
#pragma unroll
            for (int it = 0; it < 8; ++it) { const int kap = 8 * it + (lane >> 3); int mk = mq0 - 128 + kap; mk = mk < 0 ? 0 : mk;
                vr[0][it] = *(const v4u*)((const char*)Vb + (unsigned)qk_row(c + (mk << dsh)) * 128u + (lane & 7) * 16u); }
            __builtin_amdgcn_sched_barrier(0);
            bf16x8 pf0[5], pf1[5]; float mx0, ls0, mx1, ls1;
            { f32x4 sa[9];
#pragma unroll
              for (int t = 0; t < 9; ++t) { sa[t] = (f32x4){0.f, 0.f, 0.f, 0.f}; sa[t] = __builtin_amdgcn_mfma_f32_16x16x32_bf16(ka[t][0], bq00, sa[t], 0, 0, 0); sa[t] = __builtin_amdgcn_mfma_f32_16x16x32_bf16(ka[t][1], bq01, sa[t], 0, 0, 0); }
              attn_softmax_block(sa, 0, r, mq0, q4, mx0, ls0, pf0); }
            { f32x4 sa[9];
#pragma unroll
              for (int t = 0; t < 9; ++t) { sa[t] = (f32x4){0.f, 0.f, 0.f, 0.f}; sa[t] = __builtin_amdgcn_mfma_f32_16x16x32_bf16(ka[t + 1][0], bq10, sa[t], 0, 0, 0); sa[t] = __builtin_amdgcn_mfma_f32_16x16x32_bf16(ka[t + 1][1], bq11, sa[t], 0, 0, 0); }
              __builtin_amdgcn_sched_barrier(0);
#pragma unroll
              for (int it = 0; it < 8; ++it) { const int kap = 64 + 8 * it + (lane >> 3); int mk = mq0 - 128 + kap; mk = mk < 0 ? 0 : mk;
                  vr[1][it] = *(const v4u*)((const char*)Vb + (unsigned)qk_row(c + (mk << dsh)) * 128u + (lane & 7) * 16u); }
              __builtin_amdgcn_sched_barrier(0);
              attn_softmax_block(sa, 1, 16 + r, mq0, q4, mx1, ls1, pf1); }
            v4u vr2[4];
#pragma unroll
            for (int it = 0; it < 4; ++it) { const int kap = 128 + 8 * it + (lane >> 3); const int mk = mq0 - 128 + kap;
                vr2[it] = *(const v4u*)((const char*)Vb + (unsigned)qk_row(c + (mk << dsh)) * 128u + (lane & 7) * 16u); }
            f32x4 oa0[4], oa1[4];
#pragma unroll
            for (int dt = 0; dt < 4; ++dt) { oa0[dt] = (f32x4){0.f, 0.f, 0.f, 0.f}; oa1[dt] = (f32x4){0.f, 0.f, 0.f, 0.f}; }
#pragma unroll
            for (int ch = 0; ch < 3; ++ch) {
#pragma unroll
                for (int it = 0; it < 8; ++it) { const int row = 8 * it + (lane >> 3);
                    if (ch < 2) *(LAS v4u*)(Vw + row * AT_VP + (lane & 7) * 16) = vr[ch < 2 ? ch : 0][it];
                    else if (it < 4) *(LAS v4u*)(Vw + row * AT_VP + (lane & 7) * 16) = vr2[it < 4 ? it : 0]; }
                asm volatile("s_waitcnt lgkmcnt(0)" ::: "memory");
#pragma unroll
                for (int s2 = 0; s2 < 2; ++s2) { const int sx = 2 * ch + s2; if (sx < 5) {
#pragma unroll
                    for (int dt = 0; dt < 4; ++dt) {
                        const LAS unsigned char* vp = Vw + (32 * s2 + 4 * q4 + (r >> 2)) * AT_VP + dt * 32 + (r & 3) * 8;
                        const v4i16_t x = __builtin_amdgcn_ds_read_tr16_b64_v4i16((LAS v4i16_t*)vp), y = __builtin_amdgcn_ds_read_tr16_b64_v4i16((LAS v4i16_t*)(vp + 16 * AT_VP));
                        const bf16x8 av = (bf16x8){x[0], x[1], x[2], x[3], y[0], y[1], y[2], y[3]};
                        oa0[dt] = __builtin_amdgcn_mfma_f32_16x16x32_bf16(av, pf0[sx], oa0[dt], 0, 0, 0);
                        oa1[dt] = __builtin_amdgcn_mfma_f32_16x16x32_bf16(av, pf1[sx], oa1[dt], 0, 0, 0); } } }
                asm volatile("s_waitcnt lgkmcnt(0)" ::: "memory");
            }
            attn_merge(g, C.lds, ql0, q4, oa0, mx0, ls0, O + (rowbase + t0 + ql0) * 1024 + hd * 64 + 4 * q4);
            attn_merge(g, C.lds, ql1, q4, oa1, mx1, ls1, O + (rowbase + t0 + ql1) * 1024 + hd * 64 + 4 * q4);
        }
        __syncthreads();
    }
}

__device__ __forceinline__ unsigned ordf(float s) { const unsigned u = __builtin_bit_cast(unsigned, s); return u ^ ((unsigned)((int)u >> 31) | 0x80000000u); }
__device__ __forceinline__ float unordf(unsigned v) { return __builtin_bit_cast(float, v ^ ((unsigned)((int)(~v) >> 31) | 0x80000000u)); }
__device__ __forceinline__ void ins16(unsigned (&top)[16], unsigned x) {
#pragma unroll
    for (int j = 0; j < 16; ++j) { const unsigned hi = top[j] > x ? top[j] : x; x = top[j] > x ? x : top[j]; top[j] = hi; }
}
#define CE_D(a, b) { const unsigned hi_ = (a) > (b) ? (a) : (b), lo_ = (a) > (b) ? (b) : (a); (a) = hi_; (b) = lo_; }
__device__ __forceinline__ void sort16_desc(unsigned (&v)[16]) {
#pragma unroll
    for (int k = 2; k <= 16; k <<= 1)
#pragma unroll
        for (int j = k >> 1; j > 0; j >>= 1)
#pragma unroll
            for (int i = 0; i < 16; ++i) { const int l = i ^ j; if (l > i) { if ((i & k) == 0) CE_D(v[i], v[l]) else CE_D(v[l], v[i]) } }
}
__device__ __forceinline__ void bitonic_merge16_desc(unsigned (&c)[16]) {
#pragma unroll
    for (int st = 8; st >= 1; st >>= 1)
#pragma unroll
        for (int j = 0; j < 16; ++j) if ((j & st) == 0) CE_D(c[j], c[j + st])
}
__device__ __forceinline__ void top16_of_two(unsigned (&a)[16], const unsigned (&b)[16]) {
#pragma unroll
    for (int j = 0; j < 16; ++j) a[j] = a[j] > b[15 - j] ? a[j] : b[15 - j];
    bitonic_merge16_desc(a);
}
__device__ __forceinline__ void merge16(unsigned (&top)[16], int mask) {
    unsigned o[16];
#pragma unroll
    for (int j = 0; j < 16; ++j) o[j] = (unsigned)__shfl_xor((int)top[j], mask);
    top16_of_two(top, o);
}
__device__ __forceinline__ void phase_peer_topk(const Params& P, const Ctx& C, const Wk& W, int layer) {
    LAS bf16* SK = (LAS bf16*)C.lds;
    const bf16* SKB = (const bf16*)(P.ws + WS_SKB) + (size_t)layer * 32768; const bf16* QP = w_tok16(P, W, AR_QP, 2048);
    int* IDX = (int*)(P.ws + WS_IDX); float* GATE = (float*)(P.ws + WS_GATE);
    for (int ch = C.tid; ch < 4096; ch += 512) { const int rr = ch >> 4, c8 = (ch & 15) * 8; *(LAS v4u*)(SK + rr * 136 + c8) = *(const v4u*)(SKB + (size_t)rr * 128 + c8); }
    __syncthreads();
    const int r = C.lane & 15, q4 = C.lane >> 4;
    const int gw = W.lv * NWAVES + C.wave, NGW = W.n * NWAVES;
    for (int grp = W_TK0(W) / 2 + gw; grp < W_TK0(W) / 2 + HT * 8 / 16; grp += NGW) {
        const size_t task = (size_t)grp * 16 + r;
        unsigned lst[2][16];
#pragma unroll
        for (int half = 0; half < 2; ++half) {
            bf16x8 bq[4];
#pragma unroll
            for (int ks = 0; ks < 4; ++ks) bq[ks] = *(const bf16x8*)(QP + task * 256 + half * 128 + ks * 32 + 8 * q4);
            unsigned ka[16], kb[16];
#pragma unroll
            for (int nt = 0; nt < 8; ++nt) { f32x4 acc = (f32x4){0.f, 0.f, 0.f, 0.f};
#pragma unroll
                for (int ks = 0; ks < 4; ++ks) { const bf16x8 a = *(const LAS bf16x8*)(SK + (half * 128 + 16 * nt + r) * 136 + ks * 32 + 8 * q4); acc = __builtin_amdgcn_mfma_f32_16x16x32_bf16(a, bq[ks], acc, 0, 0, 0); }
#pragma unroll
                for (int i = 0; i < 4; ++i) { const unsigned n = 16 * nt + 4 * q4 + i; const unsigned key = (ordf(acc[i]) & ~127u) | (127u - n); if (nt < 4) ka[4 * nt + i] = key; else kb[4 * (nt - 4) + i] = key; }
                if (nt == 3) sort16_desc(ka);
                __builtin_amdgcn_sched_barrier(0); }
            sort16_desc(kb); top16_of_two(ka, kb);
            merge16(ka, 16); merge16(ka, 32);
#pragma unroll
            for (int j = 0; j < 16; ++j) lst[half][j] = ka[j];
        }
        float v2[16]; unsigned e2[16];
#pragma unroll
        for (int j = 0; j < 16; ++j) { v2[j] = unordf(lst[1][j] & ~127u); e2[j] = 127u - (lst[1][j] & 127u); }
        float v1s[4]; unsigned e1s[4];
#pragma unroll
        for (int k = 0; k < 4; ++k) { const unsigned w = q4 == 0 ? lst[0][4 * k] : q4 == 1 ? lst[0][4 * k + 1] : q4 == 2 ? lst[0][4 * k + 2] : lst[0][4 * k + 3];
            v1s[k] = unordf(w & ~127u); e1s[k] = (127u - (w & 127u)) << 7; }
        unsigned top[16];
#pragma unroll
        for (int j = 0; j < 16; ++j) top[j] = (ordf(v1s[0] + v2[j]) & ~16383u) | e1s[0] | e2[j];
        sort16_desc(top);
#pragma unroll
        for (int j = 0; j < 3; ++j) ins16(top, (ordf(v1s[1] + v2[j]) & ~16383u) | e1s[1] | e2[j]);
        ins16(top, (ordf(v1s[2] + v2[0]) & ~16383u) | e1s[2] | e2[0]);
        ins16(top, (ordf(v1s[3] + v2[0]) & ~16383u) | e1s[3] | e2[0]);
        merge16(top, 16); merge16(top, 32);
        float ev[16]; float den = 0.f; const float mx = unordf(top[0] & ~16383u);
#pragma unroll
        for (int j = 0; j < 16; ++j) { ev[j] = __expf(unordf(top[j] & ~16383u) - mx); den += ev[j]; }
        const float inv = 1.0f / den;
        int* ip = IDX + task * 16; float* gp = GATE + task * 16;
        if (q4 == 0) { *(v4u*)(ip) = (v4u){top[0] & 16383u, top[1] & 16383u, top[2] & 16383u, top[3] & 16383u}; *(f32x4*)(gp) = (f32x4){ev[0] * inv, ev[1] * inv, ev[2] * inv, ev[3] * inv}; }
        else if (q4 == 1) { *(v4u*)(ip + 4) = (v4u){top[4] & 16383u, top[5] & 16383u, top[6] & 16383u, top[7] & 16383u}; *(f32x4*)(gp + 4) = (f32x4){ev[4] * inv, ev[5] * inv, ev[6] * inv, ev[7] * inv}; }
        else if (q4 == 2) { *(v4u*)(ip + 8) = (v4u){top[8] & 16383u, top[9] & 16383u, top[10] & 16383u, top[11] & 16383u}; *(f32x4*)(gp + 8) = (f32x4){ev[8] * inv, ev[9] * inv, ev[10] * inv, ev[11] * inv}; }
        else { *(v4u*)(ip + 12) = (v4u){top[12] & 16383u, top[13] & 16383u, top[14] & 16383u, top[15] & 16383u}; *(f32x4*)(gp + 12) = (f32x4){ev[12] * inv, ev[13] * inv, ev[14] * inv, ev[15] * inv}; }
    }
}
struct ExpRow { v4u d[3], u[3]; float ds, us, gk; };
__device__ __forceinline__ void exp_issue(ExpRow& R, const unsigned char* TD, const unsigned char* TU, const float* SD, int ex, float gk, int jl) {
    const unsigned char* dr = TD + (size_t)ex * TROW + 48 * jl; const unsigned char* ur = TU + (size_t)ex * TROW + 48 * jl;
#pragma unroll
    for (int c = 0; c < 3; ++c) R.d[c] = *(const v4u*)(dr + 16 * c);
#pragma unroll
    for (int c = 0; c < 3; ++c) R.u[c] = *(const v4u*)(ur + 16 * c);
    R.ds = SD[ex]; R.us = SD[16384 + ex]; R.gk = gk;
}
__device__ __forceinline__ void exp_consume(const ExpRow& R, const unsigned (&hp)[32], f32x2 (&oacc)[32]) {
    f32x2 a2 = (f32x2){0.f, 0.f};
#pragma unroll
    for (int gsel = 0; gsel < 2; ++gsel) {
        const v6u pk = gsel == 0 ? (v6u){R.d[0].x, R.d[0].y, R.d[0].z, R.d[0].w, R.d[1].x, R.d[1].y} : (v6u){R.d[1].z, R.d[1].w, R.d[2].x, R.d[2].y, R.d[2].z, R.d[2].w};
        const f32x32v f = __builtin_amdgcn_cvt_scalef32_pk32_f32_fp6(pk, 1.0f);
#pragma unroll
        for (int p = 0; p < 16; ++p) { unsigned h0 = hp[16 * gsel + p]; asm volatile("" : "+v"(h0));
            a2 = a2 + (f32x2){f[2 * p], f[2 * p + 1]} * (f32x2){bflo(h0), bfhi(h0)}; } }
    float a = (a2.x + a2.y) * R.ds;
    a += __shfl_xor(a, 1); a += __shfl_xor(a, 2); a += __shfl_xor(a, 4); a += __shfl_xor(a, 8);
    const float wk = R.gk * gelu_f(a) * R.us; const f32x2 wk2 = (f32x2){wk, wk};
#pragma unroll
    for (int gsel = 0; gsel < 2; ++gsel) {
        const v6u pk = gsel == 0 ? (v6u){R.u[0].x, R.u[0].y, R.u[0].z, R.u[0].w, R.u[1].x, R.u[1].y} : (v6u){R.u[1].z, R.u[1].w, R.u[2].x, R.u[2].y, R.u[2].z, R.u[2].w};
        const f32x32v f = __builtin_amdgcn_cvt_scalef32_pk32_f32_fp6(pk, 1.0f);
#pragma unroll
        for (int p = 0; p < 16; ++p) oacc[16 * gsel + p] = oacc[16 * gsel + p] + wk2 * (f32x2){f[2 * p], f[2 * p + 1]}; }
}
__device__ __forceinline__ void phase_peer_experts(const Params& P, const Ctx& Cin, const Wk& W, int layer, bool last) {
    const Ctx C = fresh_ctx(Cin);
    const unsigned char* TD = P.ws + WS_TAB8 + (size_t)(2 * layer) * TAB8_BYTES; const unsigned char* TU = P.ws + WS_TAB8 + (size_t)(2 * layer + 1) * TAB8_BYTES; const float* SD = (const float*)(P.ws + WS_SC8) + (size_t)(2 * layer) * 16384; bf16* H = (bf16*)(P.ws + WS_H);
    const int* IDX = (const int*)(P.ws + WS_IDX); const float* GATE = (const float*)(P.ws + WS_GATE); const float* MOD = (const float*)(P.ws + WS_MOD);
    const int lane = C.lane, grp = lane >> 4, jl = lane & 15;
    unsigned* ticket = (unsigned*)(P.ws + WS_CTL) + 96 + 2 * layer + W.h;
    const bool dyn = W.n != C.G;
    const int gws = W.lv * NWAVES + C.wave, NGWS = W.n * NWAVES;
    int tnext = gws; if (dyn) { if (lane == 0) tnext = (int)atomicAdd(ticket, 1u); tnext = __builtin_amdgcn_readfirstlane(tnext); }
    while (tnext < HT) {
        const int tok = W_TK0(W) + tnext;
        if (dyn) { int tn = 0; if (lane == 0) tn = (int)atomicAdd(ticket, 1u); tnext = tn; } else tnext += NGWS;
        const int b = tok >> 13;
        const int i0 = IDX[(size_t)tok * 128 + lane], i1 = IDX[(size_t)tok * 128 + 64 + lane];
        const float g0 = GATE[(size_t)tok * 128 + lane], g1 = GATE[(size_t)tok * 128 + 64 + lane];
        unsigned hf[32];
#pragma unroll
        for (int c = 0; c < 8; ++c) { const v4u w0 = *(const v4u*)(H + (size_t)tok * 1024 + 64 * jl + 8 * c);
#pragma unroll
            for (int e = 0; e < 4; ++e) hf[c * 4 + e] = w0[e]; }
        f32x2 oacc[32];
#pragma unroll
        for (int e = 0; e < 32; ++e) oacc[e] = (f32x2){0.f, 0.f};
        ExpRow RA, RB;
        exp_issue(RA, TD, TU, SD, __shfl(i0, grp), __shfl(g0, grp), jl);
        for (int it = 0; it < 32 * EXP_REP; it += 2) {
            { const int kk = ((it + 1) & 31) * 4 + grp; const int el = __shfl(i0, kk & 63), eh = __shfl(i1, kk & 63); const float gl = __shfl(g0, kk & 63), gh = __shfl(g1, kk & 63);
              exp_issue(RB, TD, TU, SD, kk < 64 ? el : eh, kk < 64 ? gl : gh, jl); }
            exp_consume(RA, hf, oacc);
            { const int kk = ((it + 2) & 31) * 4 + grp; const int el = __shfl(i0, kk & 63), eh = __shfl(i1, kk & 63); const float gl = __shfl(g0, kk & 63), gh = __shfl(g1, kk & 63);
              exp_issue(RA, TD, TU, SD, kk < 64 ? el : eh, kk < 64 ? gl : gh, jl); }
            exp_consume(RB, hf, oacc);
        }
        f32x2 h1[16];
        { const bool up = (grp & 2) != 0;
#pragma unroll
          for (int e = 0; e < 16; ++e) { const f32x2 keep = up ? oacc[16 + e] : oacc[e], send = up ? oacc[e] : oacc[16 + e]; h1[e] = keep + (f32x2){__shfl_xor(send.x, 32), __shfl_xor(send.y, 32)}; } }
        f32x2 h2[8];
        { const bool up = (grp & 1) != 0;
#pragma unroll
          for (int e = 0; e < 8; ++e) { const f32x2 keep = up ? h1[8 + e] : h1[e], send = up ? h1[e] : h1[8 + e]; h2[e] = keep + (f32x2){__shfl_xor(send.x, 16), __shfl_xor(send.y, 16)}; } }
        const int d0 = 64 * jl + 16 * grp;
        const float* g2p = MOD + (size_t)(layer * 8 + b) * 6144 + 5120 + d0; const float psc = ((ABL_ON >= (layer == 0 ? 2 : 4)) ? 1.f : 0.f) * (1.0f / EXP_REP);
        float* xp = P.out + (size_t)tok * 1024 + d0;
        float xn[16]; float ss = 0.f;
#pragma unroll
        for (int q = 0; q < 4; ++q) { const f32x4 xa = *(const f32x4*)(xp + 4 * q), ga = *(const f32x4*)(g2p + 4 * q);
            xn[4 * q] = xa[0] + psc * ga[0] * h2[2 * q].x; xn[4 * q + 1] = xa[1] + psc * ga[1] * h2[2 * q].y; xn[4 * q + 2] = xa[2] + psc * ga[2] * h2[2 * q + 1].x; xn[4 * q + 3] = xa[3] + psc * ga[3] * h2[2 * q + 1].y; }
#pragma unroll
        for (int e = 0; e < 16; ++e) ss += xn[e] * xn[e];
        const float rstd = 1.0f / sqrtf(wave_sum(ss) * (1.0f / 1024.0f) + NORM_EPS);
        if (!last) {
            const float* ng = P.norm_mix_g + (layer + 1) * 1024 + d0; const float* mb = MOD + (size_t)((layer + 1) * 8 + b) * 6144 + d0;
            unsigned w[8];
#pragma unroll
            for (int q = 0; q < 4; ++q) { *(f32x4*)(xp + 4 * q) = (f32x4){xn[4 * q], xn[4 * q + 1], xn[4 * q + 2], xn[4 * q + 3]}; }
#pragma unroll
            for (int e = 0; e < 8; ++e) w[e] = pk2(xn[2 * e] * rstd * ng[2 * e] * (1.0f + mb[1024 + 2 * e]) + mb[2 * e], xn[2 * e + 1] * rstd * ng[2 * e + 1] * (1.0f + mb[1024 + 2 * e + 1]) + mb[2 * e + 1]);
            v4u* hp = (v4u*)(H + (size_t)tok * 1024 + d0); hp[0] = (v4u){w[0], w[1], w[2], w[3]}; hp[1] = (v4u){w[4], w[5], w[6], w[7]};
        } else {
            const float* fg = P.final_norm_g + d0;
#pragma unroll
            for (int q = 0; q < 4; ++q) *(f32x4*)(xp + 4 * q) = (f32x4){xn[4 * q] * rstd * fg[4 * q], xn[4 * q + 1] * rstd * fg[4 * q + 1], xn[4 * q + 2] * rstd * fg[4 * q + 2], xn[4 * q + 3] * rstd * fg[4 * q + 3]};
        }
        if (dyn) tnext = __builtin_amdgcn_readfirstlane(tnext);
    }
}

#ifndef NC_PER_XCD
#define NC_PER_XCD 16
#endif
#ifdef PROBE_SEL
#define SUBSTAMP(i) do { if (W.c == 0 && C.tid == 0) __hip_atomic_store((unsigned*)(P.ws + WS_CTL) + 128 + 16 * W.h + (i), (unsigned)__builtin_amdgcn_s_memrealtime(), __ATOMIC_RELAXED, __HIP_MEMORY_SCOPE_AGENT); } while (0)
#else
#define SUBSTAMP(i) do {} while (0)
#endif
__device__ __forceinline__ void run_C0(const Params& P, const Ctx& Cin, const Wk& W, const XcdBarrier& tb) {
    const Ctx C = fresh_ctx(Cin);
    SUBSTAMP(0);
    unsigned char* ws = P.ws; float* MOD = (float*)(ws + WS_MOD); bf16* H = (bf16*)(ws + WS_H);
    const size_t tk = (size_t)W_TK0(W); unsigned char* const ar = w_ar(P, W);
    phase_norm(P, C, W, P.x, P.norm_mix_g, 0, 0); xcd_barrier(tb); SUBSTAMP(1);
    { pg8::Gemm g{H + tk * 1024, (const bf16*)(ws + WS_WIN), HT, 3072, 1024}; pg8::StaticOrder S; S.init(HT, 3072, W.n, W.c);
      EpiInProj E{(bf16*)(ar + AR_PU), (bf16*)(ar + AR_PV), (bf16*)(ar + AR_PQ), (bf16*)(ar + AR_PI), (bf16*)(ar + AR_PG), (float*)(ar + AR_G), (const float*)(ws + WS_LB)};
      pg8::gemm_phase<EpiInProj, pg8::StaticOrder, true, true>(C.lds, g, S, E); } xcd_barrier(tb); SUBSTAMP(2);
    for (int it = W.lv; it < 1024; it += W.n) gmlp_item(P, C, W, W_TK0(W) / 128 + (it >> 2), it & 3);
    for (int it = W.lv; it < 2048; it += W.n) hgrn_local_item(P, C, W, W_BT0(W) * 512 + it);
    xcd_barrier(tb); SUBSTAMP(3);
    phase_hgrn_scan(P, C, W); xcd_barrier(tb); SUBSTAMP(4);
    for (int it = W.lv; it < 2048; it += W.n) hgrn_out_item(P, C, W, W_BT0(W) * 512 + it);
    xcd_barrier(tb); SUBSTAMP(5);
    { pg8::Gemm g{H + tk * 1024, (const bf16*)(ws + WS_WOUT0), HT, 1024, 1024}; pg8::StaticOrder S; S.init(HT, 1024, W.n, W.c);
      EpiResid E{P.x + tk * 1024, P.out + tk * 1024, MOD + 2048 + (size_t)W_BT0(W) * 6144, 1.f};
      pg8::gemm_phase<EpiResid, pg8::StaticOrder, true, true>(C.lds, g, S, E); } xcd_barrier(tb); SUBSTAMP(6);
    phase_norm(P, C, W, P.out, P.norm_ffn_g, 0, 3072); xcd_barrier(tb); SUBSTAMP(7);
    { pg8::Gemm g{H + tk * 1024, (const bf16*)(ws + WS_WQ0), HT, 2048, 1024}; pg8::StaticOrder S; S.init(HT, 2048, W.n, W.c);
      EpiBf16P E{(bf16*)(ar + AR_QP), 2048};
      pg8::gemm_phase<EpiBf16P, pg8::StaticOrder, true, true>(C.lds, g, S, E); }
    SUBSTAMP(9);
}
__device__ __forceinline__ void run_C1(const Params& P, const Ctx& Cin, const Wk& W, const XcdBarrier& tb) {
    const Ctx C = fresh_ctx(Cin);
    SUBSTAMP(0);
    unsigned char* ws = P.ws; float* MOD = (float*)(ws + WS_MOD); bf16* H = (bf16*)(ws + WS_H);
    const size_t tk = (size_t)W_TK0(W); unsigned char* const ar = w_ar(P, W);
    { pg8::Gemm g{H + tk * 1024, (const bf16*)(ws + WS_WQKV), HT, 3072, 1024}; pg8::StaticOrder S; S.init(HT, 3072, W.n, W.c);
      EpiQKRot E{(bf16*)(ar + AR_QK), (const float*)(ws + WS_CS) + tk * 16};
      pg8::gemm_phase<EpiQKRot, pg8::StaticOrder, true, true>(C.lds, g, S, E); } xcd_barrier(tb); SUBSTAMP(1);
    for (int it = W.lv; it < (NB / 2) * 16 * 16; it += W.n) attn_item(P, C, W, W_BT0(W) + (it >> 8), (it >> 4) & 15, it & 15);
    xcd_barrier(tb); SUBSTAMP(2);
    { pg8::Gemm g{H + tk * 1024, (const bf16*)(ws + WS_WOUT1), HT, 1024, 1024}; pg8::StaticOrder S; S.init(HT, 1024, W.n, W.c);
      EpiResid E{P.out + tk * 1024, P.out + tk * 1024, MOD + (size_t)8 * 6144 + 2048 + (size_t)W_BT0(W) * 6144, 1.f};
      pg8::gemm_phase<EpiResid, pg8::StaticOrder, true, true>(C.lds, g, S, E); } xcd_barrier(tb); SUBSTAMP(3);
    phase_norm(P, C, W, P.out, P.norm_ffn_g + 1024, 1, 3072); xcd_barrier(tb); SUBSTAMP(4);
    { pg8::Gemm g{H + tk * 1024, (const bf16*)(ws + WS_WQ1), HT, 2048, 1024}; pg8::StaticOrder S; S.init(HT, 2048, W.n, W.c);
      EpiBf16P E{(bf16*)(ar + AR_QP), 2048};
      pg8::gemm_phase<EpiBf16P, pg8::StaticOrder, true, true>(C.lds, g, S, E); }
    SUBSTAMP(9);
}
__device__ __forceinline__ void run_E(const Params& P, const Ctx& Cin, const Wk& W, const XcdBarrier& tb, int layer) {
    { const Ctx C = fresh_ctx(Cin); phase_peer_topk(P, C, W, layer); }
    xcd_barrier(tb);
    if (W.c == 0 && Cin.tid == 0) __hip_atomic_store((unsigned*)(P.ws + WS_CTL) + 112 + 2 * layer + W.h, 1u, __ATOMIC_RELAXED, __HIP_MEMORY_SCOPE_AGENT);
    phase_peer_experts(P, Cin, W, layer, layer == 1);
}
__device__ __forceinline__ void help_E(const Params& P, const Ctx& Cin, int h, int layer) {
    volatile LAS unsigned* okw = (volatile LAS unsigned*)(Cin.lds + LDSCTL_OFF + 192);
    if (Cin.tid == 0) { unsigned* flag = (unsigned*)(P.ws + WS_CTL) + 112 + 2 * layer + h; unsigned ok = 0u;
        for (unsigned sp = 0; sp < (1u << 16); ++sp) { if (__hip_atomic_load(flag, __ATOMIC_RELAXED, __HIP_MEMORY_SCOPE_AGENT) != 0u) { ok = 1u; break; } __builtin_amdgcn_s_sleep(8); }
        __builtin_amdgcn_fence(__ATOMIC_ACQUIRE, "agent"); asm volatile("s_waitcnt vmcnt(0)" ::: "memory");
        *okw = ok; }
    __syncthreads();
    const bool ok = *okw != 0u;
    __syncthreads();
    if (ok) { Wk W; W.lv = 0; W.n = 1; W.c = 1; W.h = h; phase_peer_experts(P, Cin, W, layer, layer == 1); }
}
__global__ void __launch_bounds__(NWAVES * 64, 2) hybrid_fwd(Params P) {
    extern __shared__ __attribute__((aligned(16))) unsigned char lds_raw[];
    Ctx C;
    C.lds = (LAS unsigned char*)lds_raw;
    C.tid = threadIdx.x; C.lane = C.tid & 63; C.wave = __builtin_amdgcn_readfirstlane(C.tid >> 6);
    C.G = gridDim.x; const int bx = blockIdx.x; C.vcu = (bx % 8) * (C.G / 8) + bx / 8;
    volatile LAS unsigned* MISC = (volatile LAS unsigned*)(C.lds + MISC_OFF);
    for (int u = C.tid; u < (LDS_BYTES - LDSCTL_OFF) / 4; u += NWAVES * 64) ((LAS unsigned*)(C.lds + LDSCTL_OFF))[u] = 0u;
    __syncthreads();
    unsigned* ctl = (unsigned*)(P.ws + WS_CTL);
    const int xl = bx & 7, jx = bx >> 3, perx = C.G / 8;
    const bool inC = jx < NC_PER_XCD;
    const int nC = 8 * NC_PER_XCD, nE = C.G - nC;
    const XcdBarrier bar_all = xcd_barrier_post(ctl + CW_BAR, MISC + 8);
    XcdBarrier bar_c; bar_c.bar = ctl + CW_BAR + XCD_BAR_WORDS; bar_c.x = bar_all.x; bar_c.st = MISC + 10; bar_c.G = (unsigned)nC;
    if (inC && C.tid == 0) (void)xb_add(&bar_c.bar[XB_XCNT(bar_c.x)], 1u);
    XcdBarrier bar_e; bar_e.bar = ctl + CW_BAR + 2 * XCD_BAR_WORDS; bar_e.x = bar_all.x; bar_e.st = MISC + 12; bar_e.G = (unsigned)nE;
    if (!inC && C.tid == 0) (void)xb_add(&bar_e.bar[XB_XCNT(bar_e.x)], 1u);
    Wk Wall; Wall.lv = C.vcu; Wall.n = C.G; Wall.c = bx; Wall.h = 0;
    Wk Wc; Wc.lv = xl * NC_PER_XCD + jx; Wc.n = nC; Wc.c = jx * 8 + xl; Wc.h = 0;
    Wk We; { const int je = jx - NC_PER_XCD, ne = perx - NC_PER_XCD; We.lv = xl * ne + je; We.n = nE; We.c = je * 8 + xl; We.h = 0; }
    phase_prologue(P, C);
    xcd_barrier(bar_all);
#ifdef PROBE_SEL
    unsigned long long tp0 = __builtin_amdgcn_s_memrealtime(), tp1 = 0, tp2 = 0, tp3 = 0, tp4 = 0, tp5 = 0, tpe1 = 0, tpe2 = 0, tpe3 = 0;
#define STAMP(v) v = __builtin_amdgcn_s_memrealtime()
#else
#define STAMP(v)
#endif
    Wall.h = 0; run_C0(P, C, Wall, bar_all); xcd_barrier(bar_all); STAMP(tp1);
    if (inC) { Wc.h = 1; run_C0(P, C, Wc, bar_c); help_E(P, C, 0, 0); } else { We.h = 0; run_E(P, C, We, bar_e, 0); }
    STAMP(tpe1);
#ifdef PROBE_SEL
    if (C.tid == 0) atomicMax(ctl + 80 + (inC ? 0 : 1), (unsigned)(tpe1 - tp1));
#endif
    xcd_barrier(bar_all); STAMP(tp2);
    if (inC) { Wc.h = 0; run_C1(P, C, Wc, bar_c); help_E(P, C, 1, 0); } else { We.h = 1; run_E(P, C, We, bar_e, 0); }
    STAMP(tpe2);
#ifdef PROBE_SEL
    if (C.tid == 0) atomicMax(ctl + 82 + (inC ? 0 : 1), (unsigned)(tpe2 - tp2));
#endif
    xcd_barrier(bar_all); STAMP(tp3);
    if (inC) { Wc.h = 1; run_C1(P, C, Wc, bar_c); help_E(P, C, 0, 1); } else { We.h = 0; run_E(P, C, We, bar_e, 1); }
    STAMP(tpe3);
#ifdef PROBE_SEL
    if (C.tid == 0) atomicMax(ctl + 84 + (inC ? 0 : 1), (unsigned)(tpe3 - tp3));
#endif
    xcd_barrier(bar_all); STAMP(tp4);
    Wall.h = 1; run_E(P, C, Wall, bar_all, 1);
#ifdef PROBE_SEL
    STAMP(tp5);
    { unsigned long long d = 0; const int sel = PROBE_SEL;
      if (sel == 0) d = tp1 - tp0; if (sel == 1) d = tp2 - tp1; if (sel == 2) d = tp3 - tp2; if (sel == 3) d = tp4 - tp3; if (sel == 4) d = tp5 - tp4;
      if (sel == 5 || sel == 8) d = tpe1 - tp1; if (sel == 6 || sel == 9) d = tpe2 - tp2; if (sel == 7 || sel == 10) d = tpe3 - tp3;
      const int who = sel >= 8 ? 8 * NC_PER_XCD : 0;
      if (sel >= 20) { const unsigned* sp = (const unsigned*)(P.ws + WS_CTL) + 128 + 16 * PROBE_HALF; const int i = sel - 20; const int nxt = (i == PROBE_LAST) ? 9 : i + 1; d = (unsigned long long)(__hip_atomic_load(sp + nxt, __ATOMIC_RELAXED, __HIP_MEMORY_SCOPE_AGENT) - __hip_atomic_load(sp + i, __ATOMIC_RELAXED, __HIP_MEMORY_SCOPE_AGENT)); }
      if (sel >= 30) d = 0;
      if (bx == (sel >= 20 ? 0 : who) && C.tid == 0) __hip_atomic_store(ctl + 64, (unsigned)d, __ATOMIC_RELAXED, __HIP_MEMORY_SCOPE_AGENT);
      xcd_barrier(bar_all);
      if (bx == 0 && C.tid == 0) { const unsigned dd = sel >= 30 ? __hip_atomic_load(ctl + 80 + (sel - 30), __ATOMIC_RELAXED, __HIP_MEMORY_SCOPE_AGENT) : __hip_atomic_load(ctl + 64, __ATOMIC_RELAXED, __HIP_MEMORY_SCOPE_AGENT);
        const unsigned long long t0_ = __builtin_amdgcn_s_memrealtime(); while (__builtin_amdgcn_s_memrealtime() - t0_ < 4ull * dd) __builtin_amdgcn_s_sleep(32); } }
#endif
}

extern "C" void kernel_launch(void* const* d_in, const int* in_sizes, int n_in, void* d_out, int out_size, void* d_ws, size_t ws_size, hipStream_t stream) {
    static int grid = 0;
    if (grid == 0) {
        if (n_in != 22 || in_sizes[0] != T * DM || out_size != T * DM || ws_size < WS_END) {
            fprintf(stderr, "kernel_launch: unexpected shapes (n_in %d, in0 %d, out %d, ws %zu); nothing launched\n", n_in, n_in > 0 ? in_sizes[0] : -1, out_size, ws_size); grid = -1; return; }
        int dev = 0, cus = 0;
        if (hipGetDevice(&dev) != hipSuccess || hipDeviceGetAttribute(&cus, hipDeviceAttributeMultiprocessorCount, dev) != hipSuccess) { fprintf(stderr, "kernel_launch: device query failed\n"); grid = -1; return; }
        if (hipFuncSetAttribute((const void*)hybrid_fwd, hipFuncAttributeMaxDynamicSharedMemorySize, LDS_BYTES) != hipSuccess) { fprintf(stderr, "kernel_launch: hipFuncSetAttribute failed\n"); grid = -1; return; }
        (void)hipGetLastError();
        grid = cus;
        if (grid % 8 != 0 || grid / 8 <= NC_PER_XCD) { fprintf(stderr, "kernel_launch: built for a CU count that is a multiple of 8 and > %d; got %d; nothing launched\n", 8 * NC_PER_XCD, grid); grid = -1; return; }
    }
    if (grid < 0) return;
    if (hipMemsetAsync((char*)d_ws + WS_CTL, 0, CTL_ZERO_BYTES, stream) != hipSuccess) { fprintf(stderr, "kernel_launch: memset failed\n"); return; }
    Params p{};
    p.x = (const float*)d_in[0]; p.c = (const float*)d_in[1]; p.positions = (const int*)d_in[2]; p.ada_w = (const float*)d_in[3]; p.ada_b = (const float*)d_in[4];
    p.norm_mix_g = (const float*)d_in[5]; p.norm_ffn_g = (const float*)d_in[6]; p.final_norm_g = (const float*)d_in[7]; p.even_w_in = (const float*)d_in[8]; p.even_w_out = (const float*)d_in[9];
    p.gmlp_ln_g = (const float*)d_in[10]; p.gmlp_ln_b = (const float*)d_in[11]; p.gmlp_w_s = (const float*)d_in[12]; p.gmlp_b_s = (const float*)d_in[13]; p.hgrn_lb_logits = (const float*)d_in[14];
    p.hgrn_norm_g = (const float*)d_in[15]; p.odd_w_qkv = (const float*)d_in[16]; p.odd_w_out = (const float*)d_in[17]; p.peer_w_query = (const float*)d_in[18]; p.peer_sub_keys = (const float*)d_in[19];
    p.peer_down = (const float*)d_in[20]; p.peer_up = (const float*)d_in[21];
    p.out = (float*)d_out; p.ws = (unsigned char*)d_ws;
    p.ph_lo = 0; p.ph_hi = 0;
    hipLaunchKernelGGL(hybrid_fwd, dim3(grid), dim3(NWAVES * 64), LDS_BYTES, stream, p);
    const hipError_t le = hipPeekAtLastError();
    if (le != hipSuccess) fprintf(stderr, "kernel_launch: launch failed: %s\n", hipGetErrorName(le));
}
```

```cpp
#include <hip/hip_runtime.h>
#include <cstdio>
#include <cstdint>
#include <cmath>
namespace pg8 {
#define PG8_LAS __attribute__((address_space(3)))
typedef unsigned short bf16_t;
typedef short bf16x8 __attribute__((ext_vector_type(8)));
typedef float f32x4 __attribute__((ext_vector_type(4)));
typedef unsigned u32x4 __attribute__((ext_vector_type(4)));
constexpr int BM = 256, BK = 64, HALF = 128, HTB = HALF * BK * 2  , STAGE_BYTES = 8 * HTB, NXCD = 8, WGM = 8;

__host__ __device__ __forceinline__ int lds_byte(int r, int c) { const int st = (r >> 4) * 2 + (c >> 5), rr = r & 15, cc = c & 31, ob = rr * 64 + cc * 2; return st * 1024 + (ob ^ (((ob >> 9) & 1) << 5)); }
__host__ __device__ __forceinline__ void stage_rc(int b, int& R, int& C) { const int st = b / 1024, sb = b % 1024, swz = sb ^ (((sb >> 9) & 1) << 5); R = (st >> 1) * 16 + swz / 64; C = (st & 1) * 32 + (swz % 64) / 2; }
__host__ __device__ __forceinline__ int perm32(int rho) { const int n = rho >> 4, i = rho & 15; return 8 * (i >> 2) + 4 * n + (i & 3); }

struct Unit { int pm, pn; };
struct Gemm { const bf16_t* A; const bf16_t* Bt; int M, N, K; };

struct StaticOrder {
    int nM, nN, nwg, G, c;
    __host__ __device__ void init(int M, int N, int G_, int c_) { nM = M / BM; nN = N / BM; nwg = nM * nN; G = G_; c = c_; }
    __host__ __device__ bool next(int i, Unit& u) const {
        const long L = (long)i * G + c; if (L >= nwg) return false;
        int wgid = (int)L; { const int q = nwg / NXCD, r = nwg % NXCD, xcd = wgid % NXCD, off = wgid / NXCD; wgid = (xcd < r ? xcd * (q + 1) : r * (q + 1) + (xcd - r) * q) + off; }
        const int nig = WGM * nN, gid = wgid / nig, fm = gid * WGM, gsz = (nM - fm) < WGM ? (nM - fm) : WGM;
        u.pm = fm + ((wgid % nig) % gsz); u.pn = (wgid % nig) / gsz; return true;
    }
    __device__ __forceinline__ void a_ready(const Unit&) const {}
    __device__ __forceinline__ void done(const Unit&) const {}
};

__device__ __forceinline__ unsigned cvt_pk_bf16(float lo, float hi) { unsigned r; asm volatile("v_cvt_pk_bf16_f32 %0, %1, %2" : "=v"(r) : "v"(lo), "v"(hi)); return r; }
typedef float f32x2 __attribute__((ext_vector_type(2)));
__device__ __forceinline__ f32x2 gelu_pk(f32x2 v) {
    const f32x2 av = __builtin_elementwise_abs(v), d = av * 0.2316418882f + 1.0f;
    f32x2 t; t.x = __builtin_amdgcn_rcpf(d.x); t.y = __builtin_amdgcn_rcpf(d.y);
    f32x2 q = t * 0.5307027145f + (-0.7265760135f); q = q * t + 0.7107068705f; q = q * t + (-0.142248368f); q = q * t + 0.127414796f; q = q * t;
    const f32x2 s = (v * v) * (-0.72134752044f);
    f32x2 e; e.x = __builtin_amdgcn_exp2f(s.x); e.y = __builtin_amdgcn_exp2f(s.y);
    const f32x2 m = v * (q * e), r = v - m;
    f32x2 o; o.x = v.x < 0.f ? m.x : r.x; o.y = v.y < 0.f ? m.y : r.y; return o;
}

template <class Epi, class Sched, bool ALIGN_EPI = false, bool SP2 = false>
__device__ __forceinline__ void gemm_phase(PG8_LAS unsigned char* lds, const Gemm g, const Sched& S, const Epi& E) {
    int tid_ = threadIdx.x; asm volatile("" : "+v"(tid_));
    const int tid = tid_, wid = __builtin_amdgcn_readfirstlane(tid >> 6), lane = tid & 63, wr = wid >> 2, wc = wid & 3, fr = lane & 15, fq = lane >> 4;
    const int K = g.K, nt = K / BK;
    unsigned voffA[2], voffB[2];
#pragma unroll
    for (int i = 0; i < 2; ++i) { int R, C; stage_rc(tid * 16 + i * 8192, R, C); const int Rb = Epi::PERM ? ((R & ~31) + perm32(R & 31)) : R;
        voffA[i] = (unsigned)(R * K + C) * 2u; voffB[i] = (unsigned)(Rb * K + C) * 2u; }
    const size_t kstep = (size_t)(BK * 2);
    const size_t hstep = (size_t)HALF * K * 2;
    const size_t tstep = 2 * hstep;
    const unsigned ldsw = (unsigned)wid * 1024u;
    const int aoff = lds_byte(wr * 64 + fr, fq * 8), boff = lds_byte(wc * 32 + fr, fq * 8);
#define PG8_SA(b, h) (((b) * 2 + (h)) * HTB)
#define PG8_SB(b, h) ((4 + (b) * 2 + (h)) * HTB)
#define PG8_STAGE(bufoff, gbase, voff) do { _Pragma("unroll") for (int _i = 0; _i < 2; ++_i) \
        __builtin_amdgcn_global_load_lds((const unsigned*)((const char*)(gbase) + (voff)[_i]), (PG8_LAS unsigned*)(lds + (bufoff) + ldsw + _i * 8192), 16, 0, 0); } while (0)
#define PG8_LDA(dst, b, h) do { _Pragma("unroll") for (int m = 0; m < 4; ++m) _Pragma("unroll") for (int k = 0; k < 2; ++k) dst[m][k] = *(const PG8_LAS bf16x8*)(lds + PG8_SA(b, h) + aoff + m * 2048 + k * 1024); } while (0)
#define PG8_LDB(dst, b, h) do { _Pragma("unroll") for (int n = 0; n < 2; ++n) _Pragma("unroll") for (int k = 0; k < 2; ++k) dst[n][k] = *(const PG8_LAS bf16x8*)(lds + PG8_SB(b, h) + boff + n * 2048 + k * 1024); } while (0)
#define PG8_MMA(ai, bj, At, Bt) do { __builtin_amdgcn_s_setprio(1); _Pragma("unroll") for (int m = 0; m < 4; ++m) _Pragma("unroll") for (int n = 0; n < 2; ++n) _Pragma("unroll") for (int k = 0; k < 2; ++k) \
        acc[ai][bj][m][n] = __builtin_amdgcn_mfma_f32_16x16x32_bf16(Bt[n][k], At[m][k], acc[ai][bj][m][n], 0, 0, 0); __builtin_amdgcn_s_setprio(0); } while (0)
#define PG8_WAIT_V(n) asm volatile("s_waitcnt vmcnt(" #n ")" ::: "memory")
#define PG8_WAIT_L(n) asm volatile("s_waitcnt lgkmcnt(" #n ")" ::: "memory")
#define PG8_BAR __builtin_amdgcn_s_barrier()
#define PG8_SCHED __builtin_amdgcn_sched_barrier(0)
    Unit cur, nxt; int ui = 0;
    if (!S.next(0, cur)) return;
    f32x4 acc[2][2][4][2];
#pragma unroll
    for (int a = 0; a < 2; ++a)
#pragma unroll
        for (int b = 0; b < 2; ++b)
#pragma unroll
            for (int m = 0; m < 4; ++m)
#pragma unroll
                for (int n = 0; n < 2; ++n) acc[a][b][m][n] = (f32x4){0.f, 0.f, 0.f, 0.f};
    bf16x8 At[4][2], B0[2][2], B1[2][2];
    const char* cA = (const char*)g.A + (size_t)cur.pm * tstep; const char* cB = (const char*)g.Bt + (size_t)cur.pn * tstep;
    S.a_ready(cur);
    if constexpr (SP2) {
        PG8_STAGE(PG8_SB(0, 0), cB, voffB); PG8_STAGE(PG8_SB(0, 1), cB + hstep, voffB); PG8_STAGE(PG8_SA(0, 0), cA, voffA); PG8_STAGE(PG8_SA(0, 1), cA + hstep, voffA);
        if (wr == 1) PG8_BAR;
        PG8_WAIT_V(2); PG8_BAR;
        PG8_STAGE(PG8_SB(1, 0), cB + kstep, voffB); PG8_STAGE(PG8_SA(1, 0), cA + kstep, voffA); PG8_STAGE(PG8_SB(1, 1), cB + hstep + kstep, voffB);
        PG8_WAIT_V(6); PG8_BAR;
    } else {
        PG8_STAGE(PG8_SB(0, 0), cB, voffB); PG8_STAGE(PG8_SA(0, 0), cA, voffA); PG8_STAGE(PG8_SB(0, 1), cB + hstep, voffB); PG8_STAGE(PG8_SA(0, 1), cA + hstep, voffA);
        if (wr == 1) PG8_BAR;
        PG8_WAIT_V(4); PG8_BAR;
        PG8_STAGE(PG8_SB(1, 0), cB + kstep, voffB); PG8_STAGE(PG8_SA(1, 0), cA + kstep, voffA); PG8_STAGE(PG8_SB(1, 1), cB + hstep + kstep, voffB);
        PG8_WAIT_V(6); PG8_BAR;
    }
    for (;;) {
        const bool has_next = S.next(ui + 1, nxt);
        const char* nA = has_next ? (const char*)g.A + (size_t)nxt.pm * tstep : cA; const char* nB = has_next ? (const char*)g.Bt + (size_t)nxt.pn * tstep : cB;
        for (int t = 0; t < nt; t += 2) {
            const bool last = (t == nt - 2);
            const char* a1 = cA + (size_t)(t + 1) * kstep;
            const char* a2 = last ? nA : cA + (size_t)(t + 2) * kstep; const char* b2 = last ? nB : cB + (size_t)(t + 2) * kstep;
            const char* a3 = a2 + kstep; const char* b3 = b2 + kstep;
            if (last && has_next) S.a_ready(nxt);
            if constexpr (SP2) {
            PG8_LDB(B0, 0, 0); PG8_LDB(B1, 0, 1); PG8_SCHED; PG8_LDA(At, 0, 0); PG8_STAGE(PG8_SA(1, 1), a1 + hstep, voffA);
            PG8_WAIT_V(8); PG8_WAIT_L(0); PG8_BAR; PG8_MMA(0, 0, At, B0); PG8_MMA(0, 1, At, B1); PG8_BAR; PG8_SCHED;
            PG8_LDA(At, 0, 1); PG8_STAGE(PG8_SB(0, 0), b2, voffB); PG8_STAGE(PG8_SB(0, 1), b2 + hstep, voffB); PG8_STAGE(PG8_SA(0, 0), a2, voffA);
            PG8_WAIT_V(8); PG8_WAIT_L(0); PG8_BAR; PG8_MMA(1, 0, At, B0); PG8_MMA(1, 1, At, B1); PG8_BAR; PG8_SCHED;
            PG8_LDB(B0, 1, 0); PG8_LDB(B1, 1, 1); PG8_SCHED; PG8_LDA(At, 1, 0); PG8_STAGE(PG8_SA(0, 1), a2 + hstep, voffA);
            PG8_WAIT_V(8); PG8_WAIT_L(0); PG8_BAR; PG8_MMA(0, 0, At, B0); PG8_MMA(0, 1, At, B1); PG8_BAR; PG8_SCHED;
            PG8_LDA(At, 1, 1); PG8_STAGE(PG8_SB(1, 0), b3, voffB); PG8_STAGE(PG8_SB(1, 1), b3 + hstep, voffB); PG8_STAGE(PG8_SA(1, 0), a3, voffA);
            PG8_WAIT_V(8); PG8_WAIT_L(0); PG8_BAR; PG8_MMA(1, 0, At, B0); PG8_MMA(1, 1, At, B1); PG8_BAR; PG8_SCHED;
            } else {
            PG8_LDB(B0, 0, 0); PG8_SCHED; PG8_LDA(At, 0, 0); PG8_STAGE(PG8_SA(1, 1), a1 + hstep, voffA);
            PG8_WAIT_L(8); PG8_BAR; PG8_WAIT_L(0); PG8_MMA(0, 0, At, B0); PG8_BAR; PG8_SCHED;
            PG8_LDB(B1, 0, 1); PG8_STAGE(PG8_SB(0, 0), b2, voffB);
            PG8_BAR; PG8_WAIT_L(0); PG8_MMA(0, 1, At, B1); PG8_BAR;
            PG8_LDA(At, 0, 1); PG8_STAGE(PG8_SA(0, 0), a2, voffA);
            PG8_BAR; PG8_WAIT_L(0); PG8_MMA(1, 0, At, B0); PG8_BAR; PG8_SCHED;
            PG8_STAGE(PG8_SB(0, 1), b2 + hstep, voffB);
            PG8_WAIT_V(6); PG8_BAR; PG8_MMA(1, 1, At, B1); PG8_BAR;
            PG8_LDB(B0, 1, 0); PG8_SCHED; PG8_LDA(At, 1, 0); PG8_STAGE(PG8_SA(0, 1), a2 + hstep, voffA);
            PG8_WAIT_L(8); PG8_BAR; PG8_WAIT_L(0); PG8_MMA(0, 0, At, B0); PG8_BAR; PG8_SCHED;
            PG8_LDB(B1, 1, 1); PG8_STAGE(PG8_SB(1, 0), b3, voffB);
            PG8_BAR; PG8_WAIT_L(0); PG8_MMA(0, 1, At, B1); PG8_BAR;
            PG8_LDA(At, 1, 1); PG8_STAGE(PG8_SA(1, 0), a3, voffA);
            PG8_BAR; PG8_WAIT_L(0); PG8_MMA(1, 0, At, B0); PG8_BAR; PG8_SCHED;
            PG8_STAGE(PG8_SB(1, 1), b3 + hstep, voffB);
            PG8_WAIT_V(6); PG8_BAR; PG8_MMA(1, 1, At, B1); PG8_BAR;
            }
        }
        if constexpr (ALIGN_EPI) { if (wr == 0) PG8_BAR; }
        if constexpr (!Epi::AFTER_DRAIN) { E(acc, cur, wr, wc, fr, fq); S.done(cur); }
        if (!has_next) break;
#pragma unroll
        for (int a = 0; a < 2; ++a)
#pragma unroll
            for (int b = 0; b < 2; ++b)
#pragma unroll
                for (int m = 0; m < 4; ++m)
#pragma unroll
                    for (int n = 0; n < 2; ++n) acc[a][b][m][n] = (f32x4){0.f, 0.f, 0.f, 0.f};
        cur = nxt; cA = nA; cB = nB; ++ui;
        if constexpr (ALIGN_EPI) { if (wr == 1) PG8_BAR; }
    }
    PG8_WAIT_V(0);
    if constexpr (!ALIGN_EPI) { if (wr == 0) PG8_BAR; }
    PG8_BAR;
    if constexpr (Epi::AFTER_DRAIN) { E.fused(acc, cur, wr, wc, fr, fq, lds, wid, lane); S.done(cur); }
#undef PG8_SA
#undef PG8_SB
#undef PG8_STAGE
#undef PG8_LDA
#undef PG8_LDB
#undef PG8_MMA
#undef PG8_WAIT_V
#undef PG8_WAIT_L
#undef PG8_BAR
#undef PG8_SCHED
}
}
#define GAS __attribute__((address_space(1)))
#define LAS __attribute__((address_space(3)))
typedef unsigned short bf16;
typedef unsigned v4u __attribute__((ext_vector_type(4)));
typedef float f32x4 __attribute__((ext_vector_type(4)));
typedef short bf16x8 __attribute__((ext_vector_type(8)));
typedef __bf16 bf16x2_t __attribute__((ext_vector_type(2)));
#define LDS_WAIT() asm volatile("s_waitcnt lgkmcnt(0)" ::: "memory")
#define VM_WAIT() asm volatile("s_waitcnt vmcnt(0)" ::: "memory")
typedef float f32x2_cv __attribute__((ext_vector_type(2)));
__device__ __forceinline__ unsigned pk2(float lo, float hi) { const f32x2_cv v = {lo, hi}; return __builtin_bit_cast(unsigned, __builtin_convertvector(v, bf16x2_t)); }
__device__ __forceinline__ unsigned f2bf(float f) { return pk2(f, 0.f) & 0xffffu; }
__device__ __forceinline__ float bflo(unsigned u) { return __builtin_bit_cast(float, u << 16); }
__device__ __forceinline__ float bfhi(unsigned u) { return __builtin_bit_cast(float, u & 0xffff0000u); }
__device__ __forceinline__ float bf2f(bf16 u) { return __builtin_bit_cast(float, (unsigned)u << 16); }
#define XB_TMO      128
#define XB_XCNT(j)  (256  + 64 * (j))
#define XB_XSUB(j)  (1280 + 64 * (j))
#define XB_XGEN(j)  (2304 + 64 * (j))
#define XB_TOP      3328
#define XB_TOPGEN   3392
#define XCD_BAR_WORDS 3456
#define XB_SPIN_CAP (1u << 18)

__device__ __forceinline__ unsigned xb_ld(unsigned* p)              { return __hip_atomic_load(p, __ATOMIC_RELAXED, __HIP_MEMORY_SCOPE_AGENT); }
__device__ __forceinline__ unsigned xb_add(unsigned* p, unsigned v) { return __hip_atomic_fetch_add(p, v, __ATOMIC_RELAXED, __HIP_MEMORY_SCOPE_AGENT); }
__device__ __forceinline__ unsigned xb_xcc_id() { return (unsigned)__builtin_amdgcn_s_getreg((3 << 11) | 20) & 0xFu; }
#define XB_SPIN(cond, bar) do { unsigned _sp = 0; while (cond) { __builtin_amdgcn_s_sleep(1); \
    if ((++_sp & 255u) == 0u) { if (xb_ld(&(bar)[XB_TMO])) break; if (_sp > XB_SPIN_CAP) { atomicAdd(&(bar)[XB_TMO], 1u); break; } } } } while (0)

struct XcdBarrier {
    unsigned* bar; unsigned x; unsigned G;
    volatile LAS unsigned* st;
};

__device__ __forceinline__ XcdBarrier xcd_barrier_post(unsigned* bar, volatile LAS unsigned* st) {
    XcdBarrier b; b.bar = bar; b.x = xb_xcc_id(); b.st = st; b.G = gridDim.x;
    if (threadIdx.x == 0) (void)xb_add(&bar[XB_XCNT(b.x)], 1u);
    return b;
}
__device__ __forceinline__ void xcd_barrier_complete(unsigned* bar, unsigned x, unsigned& nloc, unsigned& nx, const unsigned G) {
    unsigned sum, cnt, mine, sp = 0u;
    for (;;) {
        sum = 0u; cnt = 0u; mine = 0u;
#pragma unroll
        for (unsigned j = 0; j < 16; ++j) { const unsigned c = xb_ld(&bar[XB_XCNT(j)]); sum += c; cnt += (c > 0u) ? 1u : 0u; mine = (j == x) ? c : mine; }
        if (sum == G) break;
        __builtin_amdgcn_s_sleep(1);
        if ((++sp & 255u) == 0u) { if (xb_ld(&bar[XB_TMO])) break; if (sp > XB_SPIN_CAP) { atomicAdd(&bar[XB_TMO], 1u); break; } }
    }
    nloc = mine > 0u ? mine : 1u; nx = cnt > 0u ? cnt : 1u;
}

__device__ __forceinline__ void xcd_barrier(const XcdBarrier& b) {
    asm volatile("s_waitcnt vmcnt(0)" ::: "memory");
    __syncthreads();
    if (threadIdx.x == 0) {
        unsigned* bar = b.bar;
        __builtin_amdgcn_s_waitcnt(0);
        unsigned nloc = b.st[0], nx = b.st[1];
        if (nloc == 0u) { xcd_barrier_complete(bar, b.x, nloc, nx, b.G); b.st[0] = nloc; b.st[1] = nx; }
        const unsigned old = xb_add(&bar[XB_XSUB(b.x)], 1u);
        const unsigned gen = old / nloc;
        if (old + 1u == (gen + 1u) * nloc) {
            __builtin_amdgcn_fence(__ATOMIC_RELEASE, "agent");
            asm volatile("s_waitcnt vmcnt(0)" ::: "memory");
            const unsigned og = xb_add(&bar[XB_TOP], 1u);
            const unsigned tg = og / nx;
            if (og + 1u == (tg + 1u) * nx) xb_add(&bar[XB_TOPGEN], 1u);
            else XB_SPIN(xb_ld(&bar[XB_TOPGEN]) == tg, bar);
            __builtin_amdgcn_fence(__ATOMIC_ACQUIRE, "agent");
            xb_add(&bar[XB_XGEN(b.x)], 1u);
            asm volatile("s_waitcnt vmcnt(0)" ::: "memory");
        } else {
            XB_SPIN(xb_ld(&bar[XB_XGEN(b.x)]) == gen, bar);
            __builtin_amdgcn_fence(__ATOMIC_ACQUIRE, "agent");
            asm volatile("s_waitcnt vmcnt(0)" ::: "memory");
        }
    }
    __syncthreads();
}

constexpr int NB = 8, SEQ = 8192, DM = 1024, T = NB * SEQ;
constexpr int NWAVES = 8;
constexpr float NORM_EPS = 1e-6f;
constexpr float C2 = 0.125f * 1.4426950408889634f;

constexpr size_t MiB = 1u << 20;
constexpr size_t WS_CTL = 0, CTL_ZERO_BYTES = 1 * MiB;
constexpr size_t WS_MOD = 1 * MiB;
constexpr size_t WS_SKB = 1 * MiB + 512 * 1024;
constexpr size_t WS_WSB = 1 * MiB + 768 * 1024;
constexpr size_t WS_LB  = 1 * MiB + 960 * 1024;
constexpr size_t WS_CS  = 2 * MiB;
constexpr size_t WS_HD  = 6 * MiB;
constexpr size_t WS_WIN = 16 * MiB, WS_WOUT0 = 22 * MiB, WS_WQKV = 24 * MiB, WS_WOUT1 = 30 * MiB, WS_WQ0 = 32 * MiB, WS_WQ1 = 36 * MiB;
constexpr size_t WS_TAB8 = 40 * MiB, TAB8_BYTES = 12 * MiB;
constexpr int TROW = 768;
constexpr size_t WS_SC8 = 8 * MiB;
constexpr size_t WS_H = 108 * MiB;
constexpr size_t WS_IDX = 236 * MiB, WS_GATE = 268 * MiB;
constexpr size_t WS_AR0 = 300 * MiB, AR_BYTES = 352 * MiB;
constexpr size_t AR_PU = 0, AR_PV = 32 * MiB, AR_PQ = 64 * MiB, AR_PI = 96 * MiB, AR_PG = 128 * MiB;
constexpr size_t AR_G = 160 * MiB;
constexpr size_t AR_KVT = 224 * MiB, AR_ST = 288 * MiB;
constexpr size_t AR_QP = 0;
constexpr size_t AR_QK = 0;
constexpr int QK_ROWS = SEQ + SEQ / 16;
__host__ __device__ __forceinline__ int qk_row(int t) { return t + (t >> 4); }
constexpr size_t WS_END = WS_AR0 + 2 * AR_BYTES;
constexpr int HT = T / 2;
constexpr int CW_BAR = 4096;

constexpr int LDS_BYTES = 147456;
constexpr int LDSCTL_OFF = LDS_BYTES - 512;
constexpr int MISC_OFF = LDSCTL_OFF;

struct Params {
    const float* x; const float* c; const int* positions; const float* ada_w; const float* ada_b; const float* norm_mix_g; const float* norm_ffn_g; const float* final_norm_g;
    const float* even_w_in; const float* even_w_out; const float* gmlp_ln_g; const float* gmlp_ln_b; const float* gmlp_w_s; const float* gmlp_b_s; const float* hgrn_lb_logits; const float* hgrn_norm_g;
    const float* odd_w_qkv; const float* odd_w_out; const float* peer_w_query; const float* peer_sub_keys; const float* peer_down; const float* peer_up;
    float* out; unsigned char* ws; int ph_lo, ph_hi;
};
struct Ctx { LAS unsigned char* lds; int tid, lane, wave, vcu, G; };
__device__ __forceinline__ Ctx fresh_ctx(const Ctx& C0) { Ctx C = C0; int t_ = threadIdx.x; asm volatile("" : "+v"(t_)); C.tid = t_; C.lane = t_ & 63; C.wave = __builtin_amdgcn_readfirstlane(t_ >> 6); return C; }
struct Wk { int lv, n, c, h; };
#define W_TK0(W) ((W).h * (T / 2))
#define W_BT0(W) ((W).h * (NB / 2))
__device__ __forceinline__ unsigned char* w_ar(const Params& P, const Wk& W) { return P.ws + WS_AR0 + (size_t)W.h * AR_BYTES; }
__device__ __forceinline__ bf16* w_tok16(const Params& P, const Wk& W, size_t off, int pitch) { return (bf16*)(w_ar(P, W) + off) - (size_t)W_TK0(W) * pitch; }
__device__ __forceinline__ float* w_tok32(const Params& P, const Wk& W, size_t off, int pitch) { return (float*)(w_ar(P, W) + off) - (size_t)W_TK0(W) * pitch; }
__device__ __forceinline__ bf16* w_item16(const Params& P, const Wk& W, size_t off) { return (bf16*)(w_ar(P, W) + off) - (size_t)W_BT0(W) * 512 * 16384; }

__device__ __forceinline__ float wave_sum(float v) {
#pragma unroll
    for (int o = 1; o < 64; o <<= 1) v += __shfl_xor(v, o);
    return v;
}
__device__ __forceinline__ float silu_f(float x) { return x * __builtin_amdgcn_rcpf(1.0f + __builtin_amdgcn_exp2f(-1.4426950408889634f * x)); }
__device__ __forceinline__ float sigmoid_f(float x) { return __builtin_amdgcn_rcpf(1.0f + __builtin_amdgcn_exp2f(-1.4426950408889634f * x)); }
__device__ __forceinline__ float gelu_f(float x) { return 0.5f * x * (1.0f + erff(x * 0.70710678118654752f)); }
__device__ __forceinline__ f32x4 mma16(f32x4 acc, const LAS bf16* A, int lda, const LAS bf16* Bt, int ldb, int K, int r, int q4) {
    const LAS bf16* ap = A + r * lda + 8 * q4; const LAS bf16* bp = Bt + r * ldb + 8 * q4;
    for (int k0 = 0; k0 < K; k0 += 32) {
        const bf16x8 a = *(const LAS bf16x8*)(ap + k0); const bf16x8 b = *(const LAS bf16x8*)(bp + k0);
        acc = __builtin_amdgcn_mfma_f32_16x16x32_bf16(a, b, acc, 0, 0, 0);
    }
    return acc;
}

struct EpiBf16P {
    static constexpr bool PERM = true, AFTER_DRAIN = false;
    bf16* O; size_t ldc;
    __device__ __forceinline__ void operator()(const f32x4 (&acc)[2][2][4][2], const pg8::Unit& u, int wr, int wc, int fr, int fq) const {
        const int row0 = u.pm * 256 + wr * 64 + fr, col0 = u.pn * 256 + wc * 32 + 8 * fq;
#pragma unroll
        for (int ai = 0; ai < 2; ++ai)
#pragma unroll
            for (int m = 0; m < 4; ++m) { bf16* rowp = O + (size_t)(row0 + ai * 128 + m * 16) * ldc + col0;
#pragma unroll
                for (int bj = 0; bj < 2; ++bj) { const f32x4 v0 = acc[ai][bj][m][0], v1 = acc[ai][bj][m][1];
                    v4u w; w.x = pg8::cvt_pk_bf16(v0[0], v0[1]); w.y = pg8::cvt_pk_bf16(v0[2], v0[3]); w.z = pg8::cvt_pk_bf16(v1[0], v1[1]); w.w = pg8::cvt_pk_bf16(v1[2], v1[3]);
                    *(v4u*)(rowp + bj * 128) = w; } }
    }
};
#ifndef REP_HG
#define REP_HG 1
#endif
#ifndef REP_TOPK
#define REP_TOPK 1
#endif
#ifndef REP_PRO
#define REP_PRO 1
#endif
#ifndef REP_NORM
#define REP_NORM 1
#endif
#ifndef REP_GEMM2
#define REP_GEMM2 1
#endif
#ifndef REP_GEMM
#define REP_GEMM 1
#endif
#ifndef EXP_REP
#define EXP_REP 1
#endif
#ifndef ATT_REP
#define ATT_REP 1
#endif
#ifndef ABL_ON
#define ABL_ON 4
#endif
struct EpiResid {
    static constexpr bool PERM = true, AFTER_DRAIN = false;
    const float* xin; float* xout; const float* gate; float gsc;
    __device__ __forceinline__ void operator()(const f32x4 (&acc)[2][2][4][2], const pg8::Unit& u, int wr, int wc, int fr, int fq) const {
        const int row0 = u.pm * 256 + wr * 64 + fr, col0 = u.pn * 256 + wc * 32 + 8 * fq;
        const float* gp = gate + (size_t)((u.pm * 256) >> 13) * 6144 + col0;
        f32x4 gv[2][2];
#pragma unroll
        for (int bj = 0; bj < 2; ++bj) { gv[bj][0] = *(const f32x4*)(gp + bj * 128); gv[bj][1] = *(const f32x4*)(gp + bj * 128 + 4); }
#pragma unroll
        for (int ai = 0; ai < 2; ++ai)
#pragma unroll
            for (int m = 0; m < 4; ++m) { const size_t off = (size_t)(row0 + ai * 128 + m * 16) * 1024 + col0;
#pragma unroll
                for (int bj = 0; bj < 2; ++bj) {
                    const f32x4 x0 = *(const f32x4*)(xin + off + bj * 128), x1 = *(const f32x4*)(xin + off + bj * 128 + 4);
                    *(f32x4*)(xout + off + bj * 128) = x0 + gv[bj][0] * acc[ai][bj][m][0] * gsc;
                    *(f32x4*)(xout + off + bj * 128 + 4) = x1 + gv[bj][1] * acc[ai][bj][m][1] * gsc; }
                asm volatile("" ::: "memory"); }
    }
};
struct EpiInProj {
    static constexpr bool PERM = true, AFTER_DRAIN = false;
    bf16* PU; bf16* PV; bf16* PQ; bf16* PI; bf16* PG; float* G; const float* LB;
    __device__ __forceinline__ void operator()(const f32x4 (&acc)[2][2][4][2], const pg8::Unit& u, int wr, int wc, int fr, int fq) const {
        const int type = u.pn >> 1;
        const int row0 = u.pm * 256 + wr * 64 + fr, lc0 = (u.pn & 1) * 256 + wc * 32 + 8 * fq;
        if (type == 3) {
            f32x4 lb[2][2];
#pragma unroll
            for (int bj = 0; bj < 2; ++bj) { lb[bj][0] = *(const f32x4*)(LB + lc0 + bj * 128); lb[bj][1] = *(const f32x4*)(LB + lc0 + bj * 128 + 4); }
#pragma unroll
            for (int ai = 0; ai < 2; ++ai)
#pragma unroll
                for (int m = 0; m < 4; ++m) { float* rowp = G + (size_t)(row0 + ai * 128 + m * 16) * 512 + lc0;
#pragma unroll
                    for (int bj = 0; bj < 2; ++bj)
#pragma unroll
                        for (int n = 0; n < 2; ++n) { const f32x4 v = acc[ai][bj][m][n]; f32x4 o;
#pragma unroll
                            for (int e = 0; e < 4; ++e) { const float l = lb[bj][n][e]; const float f = l + (1.0f - l) * sigmoid_f(v[e]); o[e] = __logf(f); }
                            *(f32x4*)(rowp + bj * 128 + 4 * n) = o; } }
            return;
        }
        bf16* base = type == 0 ? PU : type == 1 ? PV : type == 2 ? PQ : type == 4 ? PI : PG;
#pragma unroll
        for (int ai = 0; ai < 2; ++ai)
#pragma unroll
            for (int m = 0; m < 4; ++m) { bf16* rowp = base + (size_t)(row0 + ai * 128 + m * 16) * 512 + lc0;
#pragma unroll
                for (int bj = 0; bj < 2; ++bj) { f32x4 v0 = acc[ai][bj][m][0], v1 = acc[ai][bj][m][1];
                    if (type <= 1) { pg8::f32x2 a = pg8::gelu_pk((pg8::f32x2){v0[0], v0[1]}), b = pg8::gelu_pk((pg8::f32x2){v0[2], v0[3]}), c = pg8::gelu_pk((pg8::f32x2){v1[0], v1[1]}), d = pg8::gelu_pk((pg8::f32x2){v1[2], v1[3]});
                        v0 = (f32x4){a.x, a.y, b.x, b.y}; v1 = (f32x4){c.x, c.y, d.x, d.y}; }
                    else if (type == 2) {
#pragma unroll
                        for (int e = 0; e < 4; ++e) { v0[e] = silu_f(v0[e]) * 0.08838834764831845f; v1[e] = silu_f(v1[e]) * 0.08838834764831845f; } }
                    else if (type == 5) {
#pragma unroll
                        for (int e = 0; e < 4; ++e) { v0[e] = silu_f(v0[e]); v1[e] = silu_f(v1[e]); } }
                    v4u w; w.x = pg8::cvt_pk_bf16(v0[0], v0[1]); w.y = pg8::cvt_pk_bf16(v0[2], v0[3]); w.z = pg8::cvt_pk_bf16(v1[0], v1[1]); w.w = pg8::cvt_pk_bf16(v1[2], v1[3]);
                    *(v4u*)(rowp + bj * 128) = w; } }
    }
};
struct EpiQKRot {
    static constexpr bool PERM = true, AFTER_DRAIN = false;
    bf16* O; const float* CS;
    __device__ __forceinline__ void operator()(const f32x4 (&acc)[2][2][4][2], const pg8::Unit& u, int wr, int wc, int fr, int fq) const {
        const int row0 = u.pm * 256 + wr * 64 + fr, col0 = u.pn * 256 + wc * 32 + 8 * fq;
        const float sc = u.pn < 4 ? C2 : 1.0f;
        const bool rotw = (wc & 1) == 0 && u.pn < 8;
        const float sgn = fq == 0 ? -1.0f : 1.0f;
#pragma unroll
        for (int ai = 0; ai < 2; ++ai)
#pragma unroll
            for (int m = 0; m < 4; ++m) { const int row = row0 + ai * 128 + m * 16;
                bf16* rowp = O + ((size_t)(((u.pn >> 2) * 4 + (row >> 13)) * 16 + (u.pn & 3) * 4 + (wc >> 1)) * QK_ROWS + qk_row(row & 8191)) * 64 + (wc & 1) * 32 + 8 * fq;
                f32x4 c0 = (f32x4){1.f, 1.f, 1.f, 1.f}, c1 = c0, s0 = (f32x4){0.f, 0.f, 0.f, 0.f}, s1 = s0;
                if (rotw && fq < 2) { const float* cp = CS + (size_t)row * 16; c0 = *(const f32x4*)(cp); c1 = *(const f32x4*)(cp + 4); s0 = *(const f32x4*)(cp + 8) * sgn; s1 = *(const f32x4*)(cp + 12) * sgn; }
#pragma unroll
                for (int bj = 0; bj < 2; ++bj) { f32x4 v0 = acc[ai][bj][m][0], v1 = acc[ai][bj][m][1];
                    if (rotw) { f32x4 p0, p1;
#pragma unroll
                        for (int e = 0; e < 4; ++e) { p0[e] = __shfl_xor(v0[e], 16); p1[e] = __shfl_xor(v1[e], 16); }
                        v0 = v0 * c0 + p0 * s0; v1 = v1 * c1 + p1 * s1; }
                    v0 = v0 * sc; v1 = v1 * sc;
                    v4u w; w.x = pg8::cvt_pk_bf16(v0[0], v0[1]); w.y = pg8::cvt_pk_bf16(v0[2], v0[3]); w.z = pg8::cvt_pk_bf16(v1[0], v1[1]); w.w = pg8::cvt_pk_bf16(v1[2], v1[3]);
                    *(v4u*)(rowp + (size_t)bj * 2 * QK_ROWS * 64) = w; } }
    }
};

__device__ __forceinline__ void p0_transpose_item(const float* W, int K, int N, bf16* WT, LAS float* scr, int item, int lane) {
    const int nblk = N / 32, kb = item / nblk, nb = item % nblk, k0 = 64 * kb, n0 = 32 * nb;
#pragma unroll 8
    for (int i = 0; i < 32; ++i) { const int kk = 2 * i + (lane >> 5); scr[kk * 33 + (lane & 31)] = W[(size_t)(k0 + kk) * N + n0 + (lane & 31)]; }
    LDS_WAIT(); asm volatile("" ::: "memory");
    const int c = lane & 7;
#pragma unroll
    for (int j = 0; j < 4; ++j) { const int n = (lane >> 3) + 8 * j; const LAS float* s = scr + (8 * c) * 33 + n;
        v4u o; o.x = pk2(s[0 * 33], s[1 * 33]); o.y = pk2(s[2 * 33], s[3 * 33]); o.z = pk2(s[4 * 33], s[5 * 33]); o.w = pk2(s[6 * 33], s[7 * 33]);
        *(GAS v4u*)(WT + (size_t)(n0 + n) * K + k0 + 8 * c) = o; }
    LDS_WAIT(); asm volatile("" ::: "memory");
}
typedef float f32x2 __attribute__((ext_vector_type(2)));
typedef float f32x16v __attribute__((ext_vector_type(16)));
typedef float f32x32v __attribute__((ext_vector_type(32)));
typedef unsigned v6u __attribute__((ext_vector_type(6)));
__device__ __forceinline__ void convert_tables(const Params& P, const Ctx& C) {
    const int gw = C.vcu * NWAVES + C.wave, NGW = C.G * NWAVES, lane = C.lane, hl = lane & 31;
    LAS float* stg = (LAS float*)(C.lds + C.wave * 16384);
    for (int rp = gw; rp < 2 * 16384; rp += NGW) {
#pragma unroll
        for (int rr = 0; rr < 2; ++rr) { const int row_ = 2 * rp + rr, tb_ = row_ >> 14, e_ = row_ & 16383;
            const f32x4* src = (const f32x4*)(((tb_ & 1) ? P.peer_up : P.peer_down) + ((size_t)(tb_ >> 1) * 16384 + e_) * 1024);
#pragma unroll
            for (int j = 0; j < 4; ++j) *(LAS f32x4*)(stg + rr * 1024 + 4 * (64 * j + lane)) = src[64 * j + lane]; }
        LDS_WAIT(); asm volatile("" ::: "memory");
        const int row = 2 * rp + (lane >> 5), tb = row >> 14, e = row & 16383;
        const LAS f32x4* sp = (const LAS f32x4*)(stg + (lane >> 5) * 1024 + 32 * hl);
        unsigned char* dst = P.ws + WS_TAB8 + (size_t)tb * TAB8_BYTES + (size_t)e * TROW + 24 * hl;
        f32x16v a, b2; float mx = 0.f;
#pragma unroll
        for (int j = 0; j < 4; ++j) { const f32x4 v = sp[j], w = sp[4 + j];
#pragma unroll
            for (int i = 0; i < 4; ++i) { mx = fmaxf(mx, fmaxf(fabsf(v[i]), fabsf(w[i]))); }
            a[2 * j] = v[0]; b2[2 * j] = v[1]; a[2 * j + 1] = v[2]; b2[2 * j + 1] = v[3]; a[8 + 2 * j] = w[0]; b2[8 + 2 * j] = w[1]; a[8 + 2 * j + 1] = w[2]; b2[8 + 2 * j + 1] = w[3]; }
        LDS_WAIT(); asm volatile("" ::: "memory");
#pragma unroll
        for (int o = 1; o < 32; o <<= 1) mx = fmaxf(mx, __shfl_xor(mx, o));
        const float sc = mx > 0.f ? 7.0f / mx : 0.f;
        a = a * sc; b2 = b2 * sc;
        const v6u p = __builtin_amdgcn_cvt_scalef32_2xpk16_fp6_f32(a, b2, 1.0f);
        unsigned long long* d8 = (unsigned long long*)dst;
        d8[0] = ((unsigned long long)p[1] << 32) | p[0]; d8[1] = ((unsigned long long)p[3] << 32) | p[2]; d8[2] = ((unsigned long long)p[5] << 32) | p[4];
        if (hl == 0) ((float*)(P.ws + WS_SC8))[row] = mx * (1.0f / 7.0f);
    }
}
__device__ __forceinline__ void phase_prologue(const Params& P, const Ctx& C) {
    float* MOD = (float*)(P.ws + WS_MOD);
    {
        LAS float* cond = (LAS float*)C.lds;
        LAS float* part = (LAS float*)(C.lds + 32768);
        for (int e = C.tid; e < 8192; e += 512) cond[e] = silu_f(P.c[e]);
        __syncthreads();
        for (int item = C.vcu; item < 192; item += C.G) {
            const int l = item / 96, cb = item % 96, col = cb * 64 + C.lane;
            float acc[8];
#pragma unroll
            for (int b = 0; b < 8; ++b) acc[b] = 0.f;
            const float* wp = P.ada_w + ((size_t)l * 1024 + C.wave * 128) * 6144 + col;
#pragma unroll 4
            for (int k = 0; k < 128; ++k) { const float wv = wp[(size_t)k * 6144];
#pragma unroll
                for (int b = 0; b < 8; ++b) acc[b] += cond[b * 1024 + C.wave * 128 + k] * wv; }
#pragma unroll
            for (int b = 0; b < 8; ++b) part[(C.wave * 8 + b) * 64 + C.lane] = acc[b];
            __syncthreads();
            { const int b = C.tid >> 6, ln = C.tid & 63; float s = P.ada_b[l * 6144 + cb * 64 + ln];
#pragma unroll
              for (int w = 0; w < 8; ++w) s += part[(w * 8 + b) * 64 + ln];
              MOD[(size_t)(l * 8 + b) * 6144 + cb * 64 + ln] = s; }
            __syncthreads();
        }
        __syncthreads();
    }
    {
        LAS float* scr = (LAS float*)(C.lds + C.wave * 16384);
        const int gw = C.vcu * NWAVES + C.wave, NGW = C.G * NWAVES;
        for (int it = gw; it < 6144; it += NGW) {
            int r = it;
            if (r < 1536) { p0_transpose_item(P.even_w_in, 1024, 3072, (bf16*)(P.ws + WS_WIN), scr, r, C.lane); continue; } r -= 1536;
            if (r < 512)  { p0_transpose_item(P.even_w_out, 1024, 1024, (bf16*)(P.ws + WS_WOUT0), scr, r, C.lane); continue; } r -= 512;
            if (r < 1536) { p0_transpose_item(P.odd_w_qkv, 1024, 3072, (bf16*)(P.ws + WS_WQKV), scr, r, C.lane); continue; } r -= 1536;
            if (r < 512)  { p0_transpose_item(P.odd_w_out, 1024, 1024, (bf16*)(P.ws + WS_WOUT1), scr, r, C.lane); continue; } r -= 512;
            if (r < 1024) { p0_transpose_item(P.peer_w_query, 1024, 2048, (bf16*)(P.ws + WS_WQ0), scr, r, C.lane); continue; } r -= 1024;
            p0_transpose_item(P.peer_w_query + (size_t)1024 * 2048, 1024, 2048, (bf16*)(P.ws + WS_WQ1), scr, r, C.lane);
        }
    }
    convert_tables(P, C);
    const int NT = C.G * 512, gt = C.vcu * 512 + C.tid;
    { bf16* skb = (bf16*)(P.ws + WS_SKB); for (int i = gt; i < 65536; i += NT) skb[i] = (bf16)f2bf(P.peer_sub_keys[i]); }
    { bf16* wsb = (bf16*)(P.ws + WS_WSB); for (int i = gt; i < 65536; i += NT) { const int t = (i >> 7) & 127, s = i & 127; wsb[i] = (bf16)(s <= t ? f2bf(P.gmlp_w_s[i]) : 0u); } }
    { float* lb = (float*)(P.ws + WS_LB); for (int i = gt; i < 512; i += NT) { const float l0 = P.hgrn_lb_logits[i], l1 = P.hgrn_lb_logits[512 + i]; lb[i] = 1.0f / (1.0f + expf(l1 - l0)); } }
    { float* cs = (float*)(P.ws + WS_CS); for (int i = gt; i < T * 8; i += NT) { const int tok = i >> 3, j = i & 7;
        const float inv = 1.0f / powf(500000.0f, (float)j * 0.125f); const float ang = (float)P.positions[tok] * inv; float sn, cn; sincosf(ang, &sn, &cn);
        cs[(size_t)tok * 16 + j] = cn; cs[(size_t)tok * 16 + 8 + j] = sn; } }
}
__device__ __forceinline__ void norm_row_bf16(const float* xrow, bf16* hrow, const float* g, const float* sh, const float* sc, int lane) {
    const f32x4* xr = (const f32x4*)xrow + lane; f32x4 v[4]; float s = 0.f;
#pragma unroll
    for (int j = 0; j < 4; ++j) { v[j] = xr[64 * j]; s += (v[j][0] * v[j][0] + v[j][1] * v[j][1]) + (v[j][2] * v[j][2] + v[j][3] * v[j][3]); }
    const float rstd = 1.0f / sqrtf(wave_sum(s) * (1.0f / 1024.0f) + NORM_EPS);
    unsigned long long* o8 = (unsigned long long*)hrow + lane;
#pragma unroll
    for (int j = 0; j < 4; ++j) { const f32x4 gg = ((const f32x4*)g)[64 * j + lane], hh = ((const f32x4*)sh)[64 * j + lane], cc = ((const f32x4*)sc)[64 * j + lane];
        const f32x4 y = (v[j] * rstd * gg) * (cc + 1.0f) + hh;
        o8[64 * j] = (unsigned long long)pk2(y[0], y[1]) | ((unsigned long long)pk2(y[2], y[3]) << 32); }
}
__device__ __forceinline__ void phase_norm(const Params& P, const Ctx& C, const Wk& W, const float* xsrc, const float* g, int l, int so) {
    const float* MOD = (const float*)(P.ws + WS_MOD); bf16* H = (bf16*)(P.ws + WS_H);
    const int gw = W.lv * NWAVES + C.wave, NGW = W.n * NWAVES;
    for (int m = W_TK0(W) + gw; m < W_TK0(W) + HT; m += NGW) { const float* mb = MOD + (size_t)(l * 8 + (m >> 13)) * 6144 + so;
        norm_row_bf16(xsrc + (size_t)m * 1024, H + (size_t)m * 1024, g, mb, mb + 1024, C.lane); }
}

__device__ __forceinline__ void gmlp_item(const Params& P, const Ctx& C, const Wk& W, int n, int g) {
    LAS bf16* Wt = (LAS bf16*)C.lds;
    LAS bf16* vT = (LAS bf16*)(C.lds + 34816);
    const bf16* WSB = (const bf16*)(P.ws + WS_WSB); const bf16* PU = w_tok16(P, W, AR_PU, 512); const bf16* PV = w_tok16(P, W, AR_PV, 512); bf16* MIX = (bf16*)(P.ws + WS_H);
    const int tid = C.tid, r = C.lane & 15, q4 = C.lane >> 4;
    for (int ch = tid; ch < 2048; ch += 512) { const int rr = ch >> 4, c8 = (ch & 15) * 8; *(LAS v4u*)(Wt + rr * 136 + c8) = *(const v4u*)(WSB + (size_t)(g * 128 + rr) * 128 + c8); }
    { const int t = tid >> 2, part = tid & 3; const bf16* src = PV + (size_t)(n * 128 + t) * 512 + g * 128 + part * 32;
      float x[32];
#pragma unroll
      for (int j = 0; j < 4; ++j) { const v4u w = *(const v4u*)(src + 8 * j);
#pragma unroll
          for (int e = 0; e < 4; ++e) { x[8 * j + 2 * e] = bflo(w[e]); x[8 * j + 2 * e + 1] = bfhi(w[e]); } }
      float s = 0.f;
#pragma unroll
      for (int j = 0; j < 32; ++j) s += x[j];
      s += __shfl_xor(s, 1); s += __shfl_xor(s, 2);
      const float mean = s * (1.0f / 128.0f); float q = 0.f;
#pragma unroll
      for (int j = 0; j < 32; ++j) { const float d = x[j] - mean; q += d * d; }
      q += __shfl_xor(q, 1); q += __shfl_xor(q, 2);
      const float rstd = 1.0f / sqrtf(q * (1.0f / 128.0f) + NORM_EPS);
      const float* lg = P.gmlp_ln_g + g * 128 + part * 32; const float* lbp = P.gmlp_ln_b + g * 128 + part * 32;
#pragma unroll
      for (int j = 0; j < 32; ++j) vT[(part * 32 + j) * 136 + t] = (bf16)f2bf((x[j] - mean) * rstd * lg[j] + lbp[j]);
    }
    __syncthreads();
    const int t0 = 16 * C.wave; const int Keff = ((t0 + 16 + 31) >> 5) << 5;
    f32x4 acc[8];
#pragma unroll
    for (int ct = 0; ct < 8; ++ct) { acc[ct] = (f32x4){0.f, 0.f, 0.f, 0.f}; acc[ct] = mma16(acc[ct], Wt + t0 * 136, 136, vT + (16 * ct) * 136, 136, Keff, r, q4); }
#pragma unroll
    for (int i = 0; i < 4; ++i) { const int t = t0 + 4 * q4 + i; const float bs = P.gmlp_b_s[g * 128 + t]; const size_t tok = (size_t)n * 128 + t;
#pragma unroll
        for (int ct = 0; ct < 8; ++ct) { const int c = 16 * ct + r; const float u = bf2f(PU[tok * 512 + g * 128 + c]); MIX[tok * 1024 + g * 128 + c] = (bf16)f2bf(u * (acc[ct][i] + bs)); } }
    __syncthreads();
}
__device__ __forceinline__ void hgrn_cumsum16(const float* G, size_t tok0, int hh, int k, int seg, LAS float* tot, float (&g)[16], float (&bb)[16], float& total) {
    const float* gp = G + (tok0 + seg * 16) * 512 + hh * 128 + k;
#pragma unroll
    for (int j = 0; j < 16; ++j) g[j] = gp[(size_t)j * 512];
    float run = 0.f;
#pragma unroll
    for (int j = 0; j < 16; ++j) { run += g[j]; bb[j] = run; }
    tot[seg * 128 + k] = run;
    __syncthreads();
    const float t0 = tot[k], t1 = tot[128 + k], t2 = tot[256 + k], t3 = tot[384 + k];
    const float pre = seg == 0 ? 0.f : seg == 1 ? t0 : seg == 2 ? t0 + t1 : t0 + t1 + t2;
    total = (t0 + t1) + (t2 + t3);
#pragma unroll
    for (int j = 0; j < 16; ++j) bb[j] += pre;
}
__device__ __forceinline__ void hgrn_stage_iT(const bf16* PI, size_t tok0, int hh, LAS bf16* iT, int tid) {
    const int s = tid >> 3, v0 = (tid & 7) * 16; const bf16* src = PI + (tok0 + s) * 512 + hh * 128 + v0;
#pragma unroll
    for (int h2 = 0; h2 < 2; ++h2) { const v4u w = *(const v4u*)(src + 8 * h2);
#pragma unroll
        for (int e = 0; e < 4; ++e) { iT[(v0 + 8 * h2 + 2 * e) * 72 + s] = (bf16)(w[e] & 0xffffu); iT[(v0 + 8 * h2 + 2 * e + 1) * 72 + s] = (bf16)(w[e] >> 16); } }
}
__device__ __forceinline__ void hgrn_local_item(const Params& P, const Ctx& C, const Wk& W, int item) {
    LAS bf16* khT = (LAS bf16*)C.lds;
    LAS bf16* iT = (LAS bf16*)(C.lds + 18432);
    LAS float* tot = (LAS float*)(C.lds + 36864);
    const float* G = w_tok32(P, W, AR_G, 512); const bf16* PI = w_tok16(P, W, AR_PI, 512); bf16* KVT = w_item16(P, W, AR_KVT); float* HD = (float*)(P.ws + WS_HD);
    const int bh = item >> 7, c = item & 127, b = bh >> 2, hh = bh & 3; const size_t tok0 = (size_t)b * SEQ + c * 64;
    const int tid = C.tid, k = tid & 127, seg = tid >> 7, r = C.lane & 15, q4 = C.lane >> 4;
    float g[16], bb[16], total;
    hgrn_cumsum16(G, tok0, hh, k, seg, tot, g, bb, total);
    { unsigned w[8];
#pragma unroll
      for (int j = 0; j < 8; ++j) { const float a0 = -expm1f(g[2 * j]) * __expf(total - bb[2 * j]), a1 = -expm1f(g[2 * j + 1]) * __expf(total - bb[2 * j + 1]); w[j] = pk2(a0, a1); }
      LAS v4u* dst = (LAS v4u*)(khT + k * 72 + seg * 16); dst[0] = (v4u){w[0], w[1], w[2], w[3]}; dst[1] = (v4u){w[4], w[5], w[6], w[7]}; }
    if (seg == 0) HD[(size_t)item * 128 + k] = __expf(total);
    hgrn_stage_iT(PI, tok0, hh, iT, tid);
    __syncthreads();
    const int v0 = 16 * C.wave;
#pragma unroll
    for (int ct = 0; ct < 8; ++ct) { f32x4 acc = (f32x4){0.f, 0.f, 0.f, 0.f}; acc = mma16(acc, iT + v0 * 72, 72, khT + (16 * ct) * 72, 72, 64, r, q4);
#pragma unroll
        for (int i = 0; i < 4; ++i) KVT[((size_t)item * 128 + v0 + 4 * q4 + i) * 128 + 16 * ct + r] = (bf16)f2bf(acc[i]); }
    __syncthreads();
}
__device__ __forceinline__ void phase_hgrn_scan(const Params& P, const Ctx& C, const Wk& W) {
    const bf16* KVT = w_item16(P, W, AR_KVT); bf16* ST = w_item16(P, W, AR_ST); const float* HD = (const float*)(P.ws + WS_HD);
    for (int task = W.lv * 256 + C.tid; C.tid < 256 && task < 32768; task += W.n * 256) {
        const int bh = W_BT0(W) * 4 + (task >> 11), v = (task >> 4) & 127, kb = task & 15;
        float st[8];
#pragma unroll
        for (int e = 0; e < 8; ++e) st[e] = 0.f;
#pragma unroll 4
        for (int c = 0; c < 128; ++c) { const size_t item = (size_t)bh * 128 + c, off = (item * 128 + v) * 128 + kb * 8;
            const v4u kv = *(const v4u*)(KVT + off); const f32x4 d0 = *(const f32x4*)(HD + item * 128 + kb * 8), d1 = *(const f32x4*)(HD + item * 128 + kb * 8 + 4);
            v4u o; o.x = pk2(st[0], st[1]); o.y = pk2(st[2], st[3]); o.z = pk2(st[4], st[5]); o.w = pk2(st[6], st[7]);
            *(v4u*)(ST + off) = o;
#pragma unroll
            for (int e = 0; e < 4; ++e) { st[2 * e] = (e < 2 ? d0[2 * e] : d1[2 * e - 4]) * st[2 * e] + bflo(kv[e]); st[2 * e + 1] = (e < 2 ? d0[2 * e + 1] : d1[2 * e - 3]) * st[2 * e + 1] + bfhi(kv[e]); }
        }
    }
}
__device__ __forceinline__ void hgrn_out_item(const Params& P, const Ctx& C, const Wk& W, int item) {
    LAS bf16* qt = (LAS bf16*)C.lds;
    LAS bf16* kt = (LAS bf16*)(C.lds + 17408);
    LAS bf16* iT = (LAS bf16*)(C.lds + 34816);
    LAS bf16* A1 = (LAS bf16*)(C.lds + 53248);
    LAS bf16* STl = (LAS bf16*)(C.lds + 62464);
    LAS float* ol = (LAS float*)(C.lds + 97280);
    LAS float* tot = (LAS float*)(C.lds + 131072);
    const float* G = w_tok32(P, W, AR_G, 512); const bf16* PQ = w_tok16(P, W, AR_PQ, 512); const bf16* PI = w_tok16(P, W, AR_PI, 512); const bf16* PG = w_tok16(P, W, AR_PG, 512);
    const bf16* ST = w_item16(P, W, AR_ST); bf16* MIX = (bf16*)(P.ws + WS_H);
    const int bh = item >> 7, c = item & 127, b = bh >> 2, hh = bh & 3; const size_t tok0 = (size_t)b * SEQ + c * 64;
    const int tid = C.tid, k = tid & 127, seg = tid >> 7, r = C.lane & 15, q4 = C.lane >> 4;
    float g[16], bb[16], total;
    hgrn_cumsum16(G, tok0, hh, k, seg, tot, g, bb, total);
#pragma unroll
    for (int j = 0; j < 16; ++j) { const int t = seg * 16 + j; const float qv = bf2f(PQ[(tok0 + t) * 512 + hh * 128 + k]);
        qt[t * 136 + k] = (bf16)f2bf(qv * __expf(bb[j])); kt[t * 136 + k] = (bf16)f2bf(-expm1f(g[j]) * __expf(-bb[j])); }
    hgrn_stage_iT(PI, tok0, hh, iT, tid);
    for (int ch = tid; ch < 2048; ch += 512) { const int rr = ch >> 4, c8 = (ch & 15) * 8; *(LAS v4u*)(STl + rr * 136 + c8) = *(const v4u*)(ST + ((size_t)item * 128 + rr) * 128 + c8); }
    __syncthreads();
    { const int rt = C.wave >> 1;
#pragma unroll
      for (int cc = 0; cc < 2; ++cc) { const int ct = (C.wave & 1) * 2 + cc; f32x4 acc = (f32x4){0.f, 0.f, 0.f, 0.f};
          acc = mma16(acc, qt + (16 * rt) * 136, 136, kt + (16 * ct) * 136, 136, 128, r, q4);
#pragma unroll
          for (int i = 0; i < 4; ++i) { const int t = 16 * rt + 4 * q4 + i, s = 16 * ct + r; A1[t * 72 + s] = (bf16)(s <= t ? f2bf(acc[i]) : 0u); } } }
    __syncthreads();
    { const int rt = C.wave >> 1;
#pragma unroll
      for (int cc = 0; cc < 4; ++cc) { const int ct = (C.wave & 1) * 4 + cc; f32x4 acc = (f32x4){0.f, 0.f, 0.f, 0.f};
          acc = mma16(acc, A1 + (16 * rt) * 72, 72, iT + (16 * ct) * 72, 72, 64, r, q4);
          acc = mma16(acc, qt + (16 * rt) * 136, 136, STl + (16 * ct) * 136, 136, 128, r, q4);
#pragma unroll
          for (int i = 0; i < 4; ++i) ol[(16 * rt + 4 * q4 + i) * 132 + 16 * ct + r] = acc[i]; } }
    __syncthreads();
    { const int t = tid >> 3, v0 = (tid & 7) * 16; float o[16]; float ss = 0.f;
#pragma unroll
      for (int e = 0; e < 16; ++e) { o[e] = ol[t * 132 + v0 + e]; ss += o[e] * o[e]; }
      ss += __shfl_xor(ss, 1); ss += __shfl_xor(ss, 2); ss += __shfl_xor(ss, 4);
      const float rstd = 1.0f / sqrtf(ss * (1.0f / 128.0f) + NORM_EPS);
      const float* ng = P.hgrn_norm_g + hh * 128 + v0; const bf16* gp = PG + (tok0 + t) * 512 + hh * 128 + v0;
      const v4u g0 = *(const v4u*)gp, g1 = *(const v4u*)(gp + 8); unsigned w[8];
#pragma unroll
      for (int e = 0; e < 4; ++e) { w[e] = pk2(o[2 * e] * rstd * ng[2 * e] * bflo(g0[e]), o[2 * e + 1] * rstd * ng[2 * e + 1] * bfhi(g0[e]));
                                    w[4 + e] = pk2(o[8 + 2 * e] * rstd * ng[8 + 2 * e] * bflo(g1[e]), o[9 + 2 * e] * rstd * ng[9 + 2 * e] * bfhi(g1[e])); }
      v4u* dst = (v4u*)(MIX + (tok0 + t) * 1024 + 512 + hh * 128 + v0); dst[0] = (v4u){w[0], w[1], w[2], w[3]}; dst[1] = (v4u){w[4], w[5], w[6], w[7]}; }
    __syncthreads();
}

typedef short v4i16_t __attribute__((ext_vector_type(4)));
constexpr int AT_VP = 144;
constexpr int AT_QI = 512;
constexpr int AT_STO = 0, AT_STML = AT_QI * 128, AT_VW = AT_STML + AT_QI * 8;
__device__ __forceinline__ void attn_softmax_block(f32x4 (&sa)[9], int tile0, int qq, int mq0, int q4, float& mx, float& ls, bf16x8 (&pf)[5]) {
    const int lo4 = (qq > 128 - mq0 ? qq : 128 - mq0) - 4 * q4, hi4 = qq + 128 - 4 * q4;
    mx = -1e30f;
#pragma unroll
    for (int t = 0; t < 9; ++t)
#pragma unroll
        for (int i = 0; i < 4; ++i) { const int K0 = 16 * (tile0 + t) + i; const bool ok = K0 >= lo4 && K0 <= hi4;
            sa[t][i] = ok ? sa[t][i] : -1e30f; mx = fmaxf(mx, sa[t][i]); }
    mx = fmaxf(mx, __shfl_xor(mx, 16)); mx = fmaxf(mx, __shfl_xor(mx, 32));
    ls = 0.f;
#pragma unroll
    for (int t = 0; t < 9; ++t)
#pragma unroll
        for (int i = 0; i < 4; ++i) { const float pv = __builtin_amdgcn_exp2f(sa[t][i] - mx); sa[t][i] = pv; ls += pv; }
    ls += __shfl_xor(ls, 16); ls += __shfl_xor(ls, 32);
#pragma unroll
    for (int s2 = 0; s2 < 5; ++s2) { const int tl = 2 * s2 - tile0, th = 2 * s2 + 1 - tile0;
        const f32x4 lo = (tl >= 0 && tl < 9) ? sa[(tl >= 0 && tl < 9) ? tl : 0] : (f32x4){0.f, 0.f, 0.f, 0.f}, hi = (th >= 0 && th < 9) ? sa[(th >= 0 && th < 9) ? th : 0] : (f32x4){0.f, 0.f, 0.f, 0.f};
        v4u w; w.x = pk2(lo[0], lo[1]); w.y = pk2(lo[2], lo[3]); w.z = pk2(hi[0], hi[1]); w.w = pk2(hi[2], hi[3]); pf[s2] = __builtin_bit_cast(bf16x8, w); }
}
__device__ __forceinline__ void attn_merge(int g, LAS unsigned char* lds, int qloc, int q4, f32x4 (&oa)[4], float mx, float ls, bf16* orow) {
    LAS unsigned char* so = lds + AT_STO + qloc * 128 + 8 * q4; LAS float* sml = (LAS float*)(lds + AT_STML) + 2 * qloc;
    float mo = mx, lo2 = ls;
    if (g > 0) { const float m_old = sml[0], l_old = sml[1]; const float M = fmaxf(m_old, mx); const float fo = __builtin_amdgcn_exp2f(m_old - M), fn = __builtin_amdgcn_exp2f(mx - M);
#pragma unroll
        for (int dt = 0; dt < 4; ++dt) { const unsigned long long w = *(const LAS unsigned long long*)(so + 32 * dt); const unsigned w0 = (unsigned)w, w1 = (unsigned)(w >> 32);
            oa[dt] = oa[dt] * fn + (f32x4){bflo(w0), bfhi(w0), bflo(w1), bfhi(w1)} * fo; }
        mo = M; lo2 = ls * fn + l_old * fo; }
    if (g < 2) {
#pragma unroll
        for (int dt = 0; dt < 4; ++dt) *(LAS unsigned long long*)(so + 32 * dt) = (unsigned long long)pk2(oa[dt][0], oa[dt][1]) | ((unsigned long long)pk2(oa[dt][2], oa[dt][3]) << 32);
        if (q4 == 0) { sml[0] = mo; sml[1] = lo2; }
    } else { const float inv = 1.0f / lo2;
#pragma unroll
        for (int dt = 0; dt < 4; ++dt) { const f32x4 v = oa[dt] * inv; *(unsigned long long*)(orow + 16 * dt) = (unsigned long long)pk2(v[0], v[1]) | ((unsigned long long)pk2(v[2], v[3]) << 32); } }
}
__device__ __forceinline__ void attn_item(const Params& P, const Ctx& C, const Wk& W, int b, int hd, int qt) {
    LAS unsigned char* Vw = C.lds + AT_VW + C.wave * (64 * AT_VP);
    const bf16* QKV = (const bf16*)(w_ar(P, W) + AR_QK); bf16* O = (bf16*)(P.ws + WS_H); const int bl = b - W_BT0(W);
    const int lane = C.lane, r = lane & 15, q4 = lane >> 4;
    const int t0 = qt * AT_QI; const size_t rowbase = (size_t)b * SEQ;
    const bf16* Qh = QKV + (size_t)((0 * 4 + bl) * 16 + hd) * QK_ROWS * 64; const bf16* Kb = QKV + (size_t)((1 * 4 + bl) * 16 + hd) * QK_ROWS * 64; const bf16* Vb = QKV + (size_t)((2 * 4 + bl) * 16 + hd) * QK_ROWS * 64;
#pragma unroll 1
    for (int g = 0; g < 3; ++g) {
        const int dsh = 4 - 2 * g, d = 1 << dsh;
#pragma unroll 1
        for (int uu = 0; uu < 2; ++uu) {
            const int u = C.wave + 8 * uu;
            const int c = u & (d - 1), j = u >> dsh;
            const int mq0 = (t0 >> dsh) + 32 * j;
            const int ql0 = c + d * (32 * j + r), ql1 = ql0 + 16 * d;
            const bf16* qp0 = Qh + (size_t)qk_row(t0 + ql0) * 64 + 8 * q4; const bf16* qp1 = Qh + (size_t)qk_row(t0 + ql1) * 64 + 8 * q4;
            const bf16x8 bq00 = *(const bf16x8*)qp0, bq01 = *(const bf16x8*)(qp0 + 32), bq10 = *(const bf16x8*)qp1, bq11 = *(const bf16x8*)(qp1 + 32);
            bf16x8 ka[10][2];
#pragma unroll
            for (int t = 0; t < 10; ++t) { int mk = mq0 - 128 + 16 * t + r; mk = mk < 0 ? 0 : mk;
                const unsigned ko = (unsigned)qk_row(c + (mk << dsh)) * 128u + 16u * q4; ka[t][0] = *(const bf16x8*)((const char*)Kb + ko); ka[t][1] = *(const bf16x8*)((const char*)Kb + ko + 64); }
            v4u vr[2][8];
#pragma unroll
            for (int it = 0; it < 8; ++it) { const int kap = 8 * it + (lane >> 3); int mk = mq0 - 128 + kap; mk = mk < 0 ? 0 : mk;
                vr[0][it] = *(const v4u*)((const char*)Vb + (unsigned)qk_row(c + (mk << dsh)) * 128u + (lane & 7) * 16u); }
            __builtin_amdgcn_sched_barrier(0);
            bf16x8 pf0[5], pf1[5]; float mx0, ls0, mx1, ls1;
            { f32x4 sa[9];
#pragma unroll
              for (int t = 0; t < 9; ++t) { sa[t] = (f32x4){0.f, 0.f, 0.f, 0.f}; sa[t] = __builtin_amdgcn_mfma_f32_16x16x32_bf16(ka[t][0], bq00, sa[t], 0, 0, 0); sa[t] = __builtin_amdgcn_mfma_f32_16x16x32_bf16(ka[t][1], bq01, sa[t], 0, 0, 0); }
              attn_softmax_block(sa, 0, r, mq0, q4, mx0, ls0, pf0); }
            { f32x4 sa[9];
#pragma unroll
              for (int t = 0; t < 9; ++t) { sa[t] = (f32x4){0.f, 0.f, 0.f, 0.f}; sa[t] = __builtin_amdgcn_mfma_f32_16x16x32_bf16(ka[t + 1][0], bq10, sa[t], 0, 0, 0); sa[t] = __builtin_amdgcn_mfma_f32_16x16x32_bf16(ka[t + 1][1], bq11, sa[t], 0, 0, 0); }
              __builtin_amdgcn_sched_barrier(0);
#pragma unroll
              for (int it = 0; it < 8; ++it) { const int kap = 64 + 8 * it + (lane >> 3); int mk = mq0 - 128 + kap; mk = mk < 0 ? 0 : mk;
                  vr[1][it] = *(const v4u*)((const char*)Vb + (unsigned)qk_row(c + (mk << dsh)) * 128u + (lane & 7) * 16u); }
              __builtin_amdgcn_sched_barrier(0);
              attn_softmax_block(sa, 1, 16 + r, mq0, q4, mx1, ls1, pf1); }
            v4u vr2[4];
#pragma unroll
            for (int it = 0; it < 4; ++it) { const int kap = 128 + 8 * it + (lane >> 3); const int mk = mq0 - 128 + kap;
                vr2[it] = *(const v4u*)((const char*)Vb + (unsigned)qk_row(c + (mk << dsh)) * 128u + (lane & 7) * 16u); }
            f32x4 oa0[4], oa1[4];
#pragma unroll
            for (int dt = 0; dt < 4; ++dt) { oa0[dt] = (f32x4){0.f, 0.f, 0.f, 0.f}; oa1[dt] = (f32x4){0.f, 0.f, 0.f, 0.f}; }
#pragma unroll
            for (int ch = 0; ch < 3; ++ch) {
#pragma unroll
                for (int it = 0; it < 8; ++it) { const int row = 8 * it + (lane >> 3);
                    if (ch < 2) *(LAS v4u*)(Vw + row * AT_VP + (lane & 7) * 16) = vr[ch < 2 ? ch : 0][it];
                    else if (it < 4) *(LAS v4u*)(Vw + row * AT_VP + (lane & 7) * 16) = vr2[it < 4 ? it : 0]; }
                asm volatile("s_waitcnt lgkmcnt(0)" ::: "memory");
#pragma unroll
                for (int s2 = 0; s2 < 2; ++s2) { const int sx = 2 * ch + s2; if (sx < 5) {
#pragma unroll
                    for (int dt = 0; dt < 4; ++dt) {
                        const LAS unsigned char* vp = Vw + (32 * s2 + 4 * q4 + (r >> 2)) * AT_VP + dt * 32 + (r & 3) * 8;
                        const v4i16_t x = __builtin_amdgcn_ds_read_tr16_b64_v4i16((LAS v4i16_t*)vp), y = __builtin_amdgcn_ds_read_tr16_b64_v4i16((LAS v4i16_t*)(vp + 16 * AT_VP));
                        const bf16x8 av = (bf16x8){x[0], x[1], x[2], x[3], y[0], y[1], y[2], y[3]};
                        oa0[dt] = __builtin_amdgcn_mfma_f32_16x16x32_bf16(av, pf0[sx], oa0[dt], 0, 0, 0);
                        oa1[dt] = __builtin_amdgcn_mfma_f32_16x16x32_bf16(av, pf1[sx], oa1[dt], 0, 0, 0); } } }
                asm volatile("s_waitcnt lgkmcnt(0)" ::: "memory");
            }
            attn_merge(g, C.lds, ql0, q4, oa0, mx0, ls0, O + (rowbase + t0 + ql0) * 1024 + hd * 64 + 4 * q4);
            attn_merge(g, C.lds, ql1, q4, oa1, mx1, ls1, O + (rowbase + t0 + ql1) * 1024 + hd * 64 + 4 * q4);
        }
        __syncthreads();
    }
}

__device__ __forceinline__ unsigned ordf(float s) { const unsigned u = __builtin_bit_cast(unsigned, s); return u ^ ((unsigned)((int)u >> 31) | 0x80000000u); }
__device__ __forceinline__ float unordf(unsigned v) { return __builtin_bit_cast(float, v ^ ((unsigned)((int)(~v) >> 31) | 0x80000000u)); }
__device__ __forceinline__ void ins16(unsigned (&top)[16], unsigned x) {
#pragma unroll
    for (int j = 0; j < 16; ++j) { const unsigned hi = top[j] > x ? top[j] : x; x = top[j] > x ? x : top[j]; top[j] = hi; }
}
#define CE_D(a, b) { const unsigned hi_ = (a) > (b) ? (a) : (b), lo_ = (a) > (b) ? (b) : (a); (a) = hi_; (b) = lo_; }
__device__ __forceinline__ void sort16_desc(unsigned (&v)[16]) {
#pragma unroll
    for (int k = 2; k <= 16; k <<= 1)
#pragma unroll
        for (int j = k >> 1; j > 0; j >>= 1)
#pragma unroll
            for (int i = 0; i < 16; ++i) { const int l = i ^ j; if (l > i) { if ((i & k) == 0) CE_D(v[i], v[l]) else CE_D(v[l], v[i]) } }
}
__device__ __forceinline__ void bitonic_merge16_desc(unsigned (&c)[16]) {
#pragma unroll
    for (int st = 8; st >= 1; st >>= 1)
#pragma unroll
        for (int j = 0; j < 16; ++j) if ((j & st) == 0) CE_D(c[j], c[j + st])
}
__device__ __forceinline__ void top16_of_two(unsigned (&a)[16], const unsigned (&b)[16]) {
#pragma unroll
    for (int j = 0; j < 16; ++j) a[j] = a[j] > b[15 - j] ? a[j] : b[15 - j];
    bitonic_merge16_desc(a);
}
__device__ __forceinline__ void merge16(unsigned (&top)[16], int mask) {
    unsigned o[16];
#pragma unroll
    for (int j = 0; j < 16; ++j) o[j] = (unsigned)__shfl_xor((int)top[j], mask);
    top16_of_two(top, o);
}
__device__ __forceinline__ void phase_peer_topk(const Params& P, const Ctx& C, const Wk& W, int layer) {
    LAS bf16* SK = (LAS bf16*)C.lds;
    const bf16* SKB = (const bf16*)(P.ws + WS_SKB) + (size_t)layer * 32768; const bf16* QP = w_tok16(P, W, AR_QP, 2048);
    int* IDX = (int*)(P.ws + WS_IDX); float* GATE = (float*)(P.ws + WS_GATE);
    for (int ch = C.tid; ch < 4096; ch += 512) { const int rr = ch >> 4, c8 = (ch & 15) * 8; *(LAS v4u*)(SK + rr * 136 + c8) = *(const v4u*)(SKB + (size_t)rr * 128 + c8); }
    __syncthreads();
    const int r = C.lane & 15, q4 = C.lane >> 4;
    const int gw = W.lv * NWAVES + C.wave, NGW = W.n * NWAVES;
    for (int grp = W_TK0(W) / 2 + gw; grp < W_TK0(W) / 2 + HT * 8 / 16; grp += NGW) {
        const size_t task = (size_t)grp * 16 + r;
        unsigned lst[2][16];
#pragma unroll
        for (int half = 0; half < 2; ++half) {
            bf16x8 bq[4];
#pragma unroll
            for (int ks = 0; ks < 4; ++ks) bq[ks] = *(const bf16x8*)(QP + task * 256 + half * 128 + ks * 32 + 8 * q4);
            unsigned ka[16], kb[16];
#pragma unroll
            for (int nt = 0; nt < 8; ++nt) { f32x4 acc = (f32x4){0.f, 0.f, 0.f, 0.f};
#pragma unroll
                for (int ks = 0; ks < 4; ++ks) { const bf16x8 a = *(const LAS bf16x8*)(SK + (half * 128 + 16 * nt + r) * 136 + ks * 32 + 8 * q4); acc = __builtin_amdgcn_mfma_f32_16x16x32_bf16(a, bq[ks], acc, 0, 0, 0); }
#pragma unroll
                for (int i = 0; i < 4; ++i) { const unsigned n = 16 * nt + 4 * q4 + i; const unsigned key = (ordf(acc[i]) & ~127u) | (127u - n); if (nt < 4) ka[4 * nt + i] = key; else kb[4 * (nt - 4) + i] = key; }
                if (nt == 3) sort16_desc(ka);
                __builtin_amdgcn_sched_barrier(0); }
            sort16_desc(kb); top16_of_two(ka, kb);
            merge16(ka, 16); merge16(ka, 32);
#pragma unroll
            for (int j = 0; j < 16; ++j) lst[half][j] = ka[j];
        }
        float v2[16]; unsigned e2[16];
#pragma unroll
        for (int j = 0; j < 16; ++j) { v2[j] = unordf(lst[1][j] & ~127u); e2[j] = 127u - (lst[1][j] & 127u); }
        float v1s[4]; unsigned e1s[4];
#pragma unroll
        for (int k = 0; k < 4; ++k) { const unsigned w = q4 == 0 ? lst[0][4 * k] : q4 == 1 ? lst[0][4 * k + 1] : q4 == 2 ? lst[0][4 * k + 2] : lst[0][4 * k + 3];
            v1s[k] = unordf(w & ~127u); e1s[k] = (127u - (w & 127u)) << 7; }
        unsigned top[16];
#pragma unroll
        for (int j = 0; j < 16; ++j) top[j] = (ordf(v1s[0] + v2[j]) & ~16383u) | e1s[0] | e2[j];
        sort16_desc(top);
#pragma unroll
        for (int j = 0; j < 3; ++j) ins16(top, (ordf(v1s[1] + v2[j]) & ~16383u) | e1s[1] | e2[j]);
        ins16(top, (ordf(v1s[2] + v2[0]) & ~16383u) | e1s[2] | e2[0]);
        ins16(top, (ordf(v1s[3] + v2[0]) & ~16383u) | e1s[3] | e2[0]);
        merge16(top, 16); merge16(top, 32);
        float ev[16]; float den = 0.f; const float mx = unordf(top[0] & ~16383u);
#pragma unroll
        for (int j = 0; j < 16; ++j) { ev[j] = __expf(unordf(top[j] & ~16383u) - mx); den += ev[j]; }
        const float inv = 1.0f / den;
        int* ip = IDX + task * 16; float* gp = GATE + task * 16;
        if (q4 == 0) { *(v4u*)(ip) = (v4u){top[0] & 16383u, top[1] & 16383u, top[2] & 16383u, top[3] & 16383u}; *(f32x4*)(gp) = (f32x4){ev[0] * inv, ev[1] * inv, ev[2] * inv, ev[3] * inv}; }
        else if (q4 == 1) { *(v4u*)(ip + 4) = (v4u){top[4] & 16383u, top[5] & 16383u, top[6] & 16383u, top[7] & 16383u}; *(f32x4*)(gp + 4) = (f32x4){ev[4] * inv, ev[5] * inv, ev[6] * inv, ev[7] * inv}; }
        else if (q4 == 2) { *(v4u*)(ip + 8) = (v4u){top[8] & 16383u, top[9] & 16383u, top[10] & 16383u, top[11] & 16383u}; *(f32x4*)(gp + 8) = (f32x4){ev[8] * inv, ev[9] * inv, ev[10] * inv, ev[11] * inv}; }
        else { *(v4u*)(ip + 12) = (v4u){top[12] & 16383u, top[13] & 16383u, top[14] & 16383u, top[15] & 16383u}; *(f32x4*)(gp + 12) = (f32x4){ev[12] * inv, ev[13] * inv, ev[14] * inv, ev[15] * inv}; }
    }
}
struct ExpRow { v4u d[3], u[3]; float ds, us, gk; };
__device__ __forceinline__ void exp_issue(ExpRow& R, const unsigned char* TD, const unsigned char* TU, const float* SD, int ex, float gk, int jl) {
    const unsigned off = (unsigned)ex * (unsigned)TROW + 48u * (unsigned)jl;
#pragma unroll
    for (int c = 0; c < 3; ++c) R.d[c] = *(const v4u*)(TD + off + 16 * c);
#pragma unroll
    for (int c = 0; c < 3; ++c) R.u[c] = *(const v4u*)(TU + off + 16 * c);
    R.ds = SD[ex]; R.us = SD[16384 + ex]; R.gk = gk;
}
__device__ __forceinline__ void exp_consume(const ExpRow& R, const unsigned (&hp)[32], f32x2 (&oacc)[32]) {
    f32x2 a2 = (f32x2){0.f, 0.f};
#pragma unroll
    for (int gsel = 0; gsel < 2; ++gsel) {
        const v6u pk = gsel == 0 ? (v6u){R.d[0].x, R.d[0].y, R.d[0].z, R.d[0].w, R.d[1].x, R.d[1].y} : (v6u){R.d[1].z, R.d[1].w, R.d[2].x, R.d[2].y, R.d[2].z, R.d[2].w};
        const f32x32v f = __builtin_amdgcn_cvt_scalef32_pk32_f32_fp6(pk, 1.0f);
#pragma unroll
        for (int p = 0; p < 16; ++p) { unsigned h0 = hp[16 * gsel + p]; asm volatile("" : "+v"(h0));
            a2 = a2 + (f32x2){f[2 * p], f[2 * p + 1]} * (f32x2){bflo(h0), bfhi(h0)}; } }
    float a = (a2.x + a2.y) * R.ds;
    a += __shfl_xor(a, 1); a += __shfl_xor(a, 2); a += __shfl_xor(a, 4); a += __shfl_xor(a, 8);
    const float wk = R.gk * gelu_f(a) * R.us; const f32x2 wk2 = (f32x2){wk, wk};
#pragma unroll
    for (int gsel = 0; gsel < 2; ++gsel) {
        const v6u pk = gsel == 0 ? (v6u){R.u[0].x, R.u[0].y, R.u[0].z, R.u[0].w, R.u[1].x, R.u[1].y} : (v6u){R.u[1].z, R.u[1].w, R.u[2].x, R.u[2].y, R.u[2].z, R.u[2].w};
        const f32x32v f = __builtin_amdgcn_cvt_scalef32_pk32_f32_fp6(pk, 1.0f);
#pragma unroll
        for (int p = 0; p < 16; ++p) oacc[16 * gsel + p] = oacc[16 * gsel + p] + wk2 * (f32x2){f[2 * p], f[2 * p + 1]}; }
}
__device__ __forceinline__ void phase_peer_experts(const Params& P, const Ctx& Cin, const Wk& W, int layer, bool last) {
    const Ctx C = fresh_ctx(Cin);
    const unsigned char* TD = P.ws + WS_TAB8 + (size_t)(2 * layer) * TAB8_BYTES; const unsigned char* TU = P.ws + WS_TAB8 + (size_t)(2 * layer + 1) * TAB8_BYTES; const float* SD = (const float*)(P.ws + WS_SC8) + (size_t)(2 * layer) * 16384; bf16* H = (bf16*)(P.ws + WS_H);
    const int* IDX = (const int*)(P.ws + WS_IDX); const float* GATE = (const float*)(P.ws + WS_GATE); const float* MOD = (const float*)(P.ws + WS_MOD);
    const int lane = C.lane, grp = lane >> 4, jl = lane & 15;
    unsigned* ticket = (unsigned*)(P.ws + WS_CTL) + 96 + 2 * layer + W.h;
    const bool dyn = W.n != C.G;
    const int gws = W.lv * NWAVES + C.wave, NGWS = W.n * NWAVES;
    int tnext = gws; if (dyn) { if (lane == 0) tnext = (int)atomicAdd(ticket, 1u); tnext = __builtin_amdgcn_readfirstlane(tnext); }
    while (tnext < HT) {
        const int tok = W_TK0(W) + tnext;
        if (dyn) { int tn = 0; if (lane == 0) tn = (int)atomicAdd(ticket, 1u); tnext = tn; } else tnext += NGWS;
        const int b = tok >> 13;
        const int i0 = IDX[(size_t)tok * 128 + lane], i1 = IDX[(size_t)tok * 128 + 64 + lane];
        const float g0 = GATE[(size_t)tok * 128 + lane], g1 = GATE[(size_t)tok * 128 + 64 + lane];
        unsigned hf[32];
#pragma unroll
        for (int c = 0; c < 8; ++c) { const v4u w0 = *(const v4u*)(H + (size_t)tok * 1024 + 64 * jl + 8 * c);
#pragma unroll
            for (int e = 0; e < 4; ++e) hf[c * 4 + e] = w0[e]; }
        f32x2 oacc[32];
#pragma unroll
        for (int e = 0; e < 32; ++e) oacc[e] = (f32x2){0.f, 0.f};
        ExpRow RA, RB;
        exp_issue(RA, TD, TU, SD, __shfl(i0, grp), __shfl(g0, grp), jl);
        for (int it = 0; it < 32 * EXP_REP; it += 2) {
            { const int kk = ((it + 1) & 31) * 4 + grp; const int el = __shfl(i0, kk & 63), eh = __shfl(i1, kk & 63); const float gl = __shfl(g0, kk & 63), gh = __shfl(g1, kk & 63);
              exp_issue(RB, TD, TU, SD, kk < 64 ? el : eh, kk < 64 ? gl : gh, jl); }
            exp_consume(RA, hf, oacc);
            { const int kk = ((it + 2) & 31) * 4 + grp; const int el = __shfl(i0, kk & 63), eh = __shfl(i1, kk & 63); const float gl = __shfl(g0, kk & 63), gh = __shfl(g1, kk & 63);
              exp_issue(RA, TD, TU, SD, kk < 64 ? el : eh, kk < 64 ? gl : gh, jl); }
            exp_consume(RB, hf, oacc);
        }
        f32x2 h1[16];
        { const bool up = (grp & 2) != 0;
#pragma unroll
          for (int e = 0; e < 16; ++e) { const f32x2 keep = up ? oacc[16 + e] : oacc[e], send = up ? oacc[e] : oacc[16 + e]; h1[e] = keep + (f32x2){__shfl_xor(send.x, 32), __shfl_xor(send.y, 32)}; } }
        f32x2 h2[8];
        { const bool up = (grp & 1) != 0;
#pragma unroll
          for (int e = 0; e < 8; ++e) { const f32x2 keep = up ? h1[8 + e] : h1[e], send = up ? h1[e] : h1[8 + e]; h2[e] = keep + (f32x2){__shfl_xor(send.x, 16), __shfl_xor(send.y, 16)}; } }
        const int d0 = 64 * jl + 16 * grp;
        const float* g2p = MOD + (size_t)(layer * 8 + b) * 6144 + 5120 + d0; const float psc = ((ABL_ON >= (layer == 0 ? 2 : 4)) ? 1.f : 0.f) * (1.0f / EXP_REP);
        float* xp = P.out + (size_t)tok * 1024 + d0;
        float xn[16]; float ss = 0.f;
#pragma unroll
        for (int q = 0; q < 4; ++q) { const f32x4 xa = *(const f32x4*)(xp + 4 * q), ga = *(const f32x4*)(g2p + 4 * q);
            xn[4 * q] = xa[0] + psc * ga[0] * h2[2 * q].x; xn[4 * q + 1] = xa[1] + psc * ga[1] * h2[2 * q].y; xn[4 * q + 2] = xa[2] + psc * ga[2] * h2[2 * q + 1].x; xn[4 * q + 3] = xa[3] + psc * ga[3] * h2[2 * q + 1].y; }
#pragma unroll
        for (int e = 0; e < 16; ++e) ss += xn[e] * xn[e];
        const float rstd = 1.0f / sqrtf(wave_sum(ss) * (1.0f / 1024.0f) + NORM_EPS);
        if (!last) {
            const float* ng = P.norm_mix_g + (layer + 1) * 1024 + d0; const float* mb = MOD + (size_t)((layer + 1) * 8 + b) * 6144 + d0;
            unsigned w[8];
#pragma unroll
            for (int q = 0; q < 4; ++q) { *(f32x4*)(xp + 4 * q) = (f32x4){xn[4 * q], xn[4 * q + 1], xn[4 * q + 2], xn[4 * q + 3]}; }
#pragma unroll
            for (int e = 0; e < 8; ++e) w[e] = pk2(xn[2 * e] * rstd * ng[2 * e] * (1.0f + mb[1024 + 2 * e]) + mb[2 * e], xn[2 * e + 1] * rstd * ng[2 * e + 1] * (1.0f + mb[1024 + 2 * e + 1]) + mb[2 * e + 1]);
            v4u* hp = (v4u*)(H + (size_t)tok * 1024 + d0); hp[0] = (v4u){w[0], w[1], w[2], w[3]}; hp[1] = (v4u){w[4], w[5], w[6], w[7]};
        } else {
            const float* fg = P.final_norm_g + d0;
#pragma unroll
            for (int q = 0; q < 4; ++q) *(f32x4*)(xp + 4 * q) = (f32x4){xn[4 * q] * rstd * fg[4 * q], xn[4 * q + 1] * rstd * fg[4 * q + 1], xn[4 * q + 2] * rstd * fg[4 * q + 2], xn[4 * q + 3] * rstd * fg[4 * q + 3]};
        }
        if (dyn) tnext = __builtin_amdgcn_readfirstlane(tnext);
    }
}

#ifndef NC_PER_XCD
#define NC_PER_XCD 16
#endif
#ifdef PROBE_SEL
#define SUBSTAMP(i) do { if (W.c == 0 && C.tid == 0) __hip_atomic_store((unsigned*)(P.ws + WS_CTL) + 128 + 16 * W.h + (i), (unsigned)__builtin_amdgcn_s_memrealtime(), __ATOMIC_RELAXED, __HIP_MEMORY_SCOPE_AGENT); } while (0)
#else
#define SUBSTAMP(i) do {} while (0)
#endif
__device__ __forceinline__ void run_C0(const Params& P, const Ctx& Cin, const Wk& W, const XcdBarrier& tb) {
    const Ctx C = fresh_ctx(Cin);
    SUBSTAMP(0);
    unsigned char* ws = P.ws; float* MOD = (float*)(ws + WS_MOD); bf16* H = (bf16*)(ws + WS_H);
    const size_t tk = (size_t)W_TK0(W); unsigned char* const ar = w_ar(P, W);
    phase_norm(P, C, W, P.x, P.norm_mix_g, 0, 0); xcd_barrier(tb); SUBSTAMP(1);
    { pg8::Gemm g{H + tk * 1024, (const bf16*)(ws + WS_WIN), HT, 3072, 1024}; pg8::StaticOrder S; S.init(HT, 3072, W.n, W.c);
      EpiInProj E{(bf16*)(ar + AR_PU), (bf16*)(ar + AR_PV), (bf16*)(ar + AR_PQ), (bf16*)(ar + AR_PI), (bf16*)(ar + AR_PG), (float*)(ar + AR_G), (const float*)(ws + WS_LB)};
      pg8::gemm_phase<EpiInProj, pg8::StaticOrder, true, true>(C.lds, g, S, E); } xcd_barrier(tb); SUBSTAMP(2);
    for (int it = W.lv; it < 1024; it += W.n) gmlp_item(P, C, W, W_TK0(W) / 128 + (it >> 2), it & 3);
    for (int it = W.lv; it < 2048; it += W.n) hgrn_local_item(P, C, W, W_BT0(W) * 512 + it);
    xcd_barrier(tb); SUBSTAMP(3);
    phase_hgrn_scan(P, C, W); xcd_barrier(tb); SUBSTAMP(4);
    for (int it = W.lv; it < 2048; it += W.n) hgrn_out_item(P, C, W, W_BT0(W) * 512 + it);
    xcd_barrier(tb); SUBSTAMP(5);
    { pg8::Gemm g{H + tk * 1024, (const bf16*)(ws + WS_WOUT0), HT, 1024, 1024}; pg8::StaticOrder S; S.init(HT, 1024, W.n, W.c);
      EpiResid E{P.x + tk * 1024, P.out + tk * 1024, MOD + 2048 + (size_t)W_BT0(W) * 6144, 1.f};
      pg8::gemm_phase<EpiResid, pg8::StaticOrder, true, true>(C.lds, g, S, E); } xcd_barrier(tb); SUBSTAMP(6);
    phase_norm(P, C, W, P.out, P.norm_ffn_g, 0, 3072); xcd_barrier(tb); SUBSTAMP(7);
    { pg8::Gemm g{H + tk * 1024, (const bf16*)(ws + WS_WQ0), HT, 2048, 1024}; pg8::StaticOrder S; S.init(HT, 2048, W.n, W.c);
      EpiBf16P E{(bf16*)(ar + AR_QP), 2048};
      pg8::gemm_phase<EpiBf16P, pg8::StaticOrder, true, true>(C.lds, g, S, E); }
    SUBSTAMP(9);
}
__device__ __forceinline__ void run_C1(const Params& P, const Ctx& Cin, const Wk& W, const XcdBarrier& tb) {
    const Ctx C = fresh_ctx(Cin);
    SUBSTAMP(0);
    unsigned char* ws = P.ws; float* MOD = (float*)(ws + WS_MOD); bf16* H = (bf16*)(ws + WS_H);
    const size_t tk = (size_t)W_TK0(W); unsigned char* const ar = w_ar(P, W);
    { pg8::Gemm g{H + tk * 1024, (const bf16*)(ws + WS_WQKV), HT, 3072, 1024}; pg8::StaticOrder S; S.init(HT, 3072, W.n, W.c);
      EpiQKRot E{(bf16*)(ar + AR_QK), (const float*)(ws + WS_CS) + tk * 16};
      pg8::gemm_phase<EpiQKRot, pg8::StaticOrder, true, true>(C.lds, g, S, E); } xcd_barrier(tb); SUBSTAMP(1);
    for (int it = W.lv; it < (NB / 2) * 16 * 16; it += W.n) attn_item(P, C, W, W_BT0(W) + (it >> 8), (it >> 4) & 15, it & 15);
    xcd_barrier(tb); SUBSTAMP(2);
    { pg8::Gemm g{H + tk * 1024, (const bf16*)(ws + WS_WOUT1), HT, 1024, 1024}; pg8::StaticOrder S; S.init(HT, 1024, W.n, W.c);
      EpiResid E{P.out + tk * 1024, P.out + tk * 1024, MOD + (size_t)8 * 6144 + 2048 + (size_t)W_BT0(W) * 6144, 1.f};
      pg8::gemm_phase<EpiResid, pg8::StaticOrder, true, true>(C.lds, g, S, E); } xcd_barrier(tb); SUBSTAMP(3);
    phase_norm(P, C, W, P.out, P.norm_ffn_g + 1024, 1, 3072); xcd_barrier(tb); SUBSTAMP(4);
    { pg8::Gemm g{H + tk * 1024, (const bf16*)(ws + WS_WQ1), HT, 2048, 1024}; pg8::StaticOrder S; S.init(HT, 2048, W.n, W.c);
      EpiBf16P E{(bf16*)(ar + AR_QP), 2048};
      pg8::gemm_phase<EpiBf16P, pg8::StaticOrder, true, true>(C.lds, g, S, E); }
    SUBSTAMP(9);
}
__device__ __forceinline__ void run_E(const Params& P, const Ctx& Cin, const Wk& W, const XcdBarrier& tb, int layer) {
    { const Ctx C = fresh_ctx(Cin); phase_peer_topk(P, C, W, layer); }
    xcd_barrier(tb);
    if (W.c == 0 && Cin.tid == 0) __hip_atomic_store((unsigned*)(P.ws + WS_CTL) + 112 + 2 * layer + W.h, 1u, __ATOMIC_RELAXED, __HIP_MEMORY_SCOPE_AGENT);
    phase_peer_experts(P, Cin, W, layer, layer == 1);
}
__device__ __forceinline__ void help_E(const Params& P, const Ctx& Cin, int h, int layer) {
    volatile LAS unsigned* okw = (volatile LAS unsigned*)(Cin.lds + LDSCTL_OFF + 192);
    if (Cin.tid == 0) { unsigned* flag = (unsigned*)(P.ws + WS_CTL) + 112 + 2 * layer + h; unsigned ok = 0u;
        for (unsigned sp = 0; sp < (1u << 16); ++sp) { if (__hip_atomic_load(flag, __ATOMIC_RELAXED, __HIP_MEMORY_SCOPE_AGENT) != 0u) { ok = 1u; break; } __builtin_amdgcn_s_sleep(8); }
        __builtin_amdgcn_fence(__ATOMIC_ACQUIRE, "agent"); asm volatile("s_waitcnt vmcnt(0)" ::: "memory");
        *okw = ok; }
    __syncthreads();
    const bool ok = *okw != 0u;
    __syncthreads();
    if (ok) { Wk W; W.lv = 0; W.n = 1; W.c = 1; W.h = h; phase_peer_experts(P, Cin, W, layer, layer == 1); }
}
__global__ void __launch_bounds__(NWAVES * 64, 2) hybrid_fwd(Params P) {
    extern __shared__ __attribute__((aligned(16))) unsigned char lds_raw[];
    Ctx C;
    C.lds = (LAS unsigned char*)lds_raw;
    C.tid = threadIdx.x; C.lane = C.tid & 63; C.wave = __builtin_amdgcn_readfirstlane(C.tid >> 6);
    C.G = gridDim.x; const int bx = blockIdx.x; C.vcu = (bx % 8) * (C.G / 8) + bx / 8;
    volatile LAS unsigned* MISC = (volatile LAS unsigned*)(C.lds + MISC_OFF);
    for (int u = C.tid; u < (LDS_BYTES - LDSCTL_OFF) / 4; u += NWAVES * 64) ((LAS unsigned*)(C.lds + LDSCTL_OFF))[u] = 0u;
    __syncthreads();
    unsigned* ctl = (unsigned*)(P.ws + WS_CTL);
    const int xl = bx & 7, jx = bx >> 3, perx = C.G / 8;
    const bool inC = jx < NC_PER_XCD;
    const int nC = 8 * NC_PER_XCD, nE = C.G - nC;
    const XcdBarrier bar_all = xcd_barrier_post(ctl + CW_BAR, MISC + 8);
    XcdBarrier bar_c; bar_c.bar = ctl + CW_BAR + XCD_BAR_WORDS; bar_c.x = bar_all.x; bar_c.st = MISC + 10; bar_c.G = (unsigned)nC;
    if (inC && C.tid == 0) (void)xb_add(&bar_c.bar[XB_XCNT(bar_c.x)], 1u);
    XcdBarrier bar_e; bar_e.bar = ctl + CW_BAR + 2 * XCD_BAR_WORDS; bar_e.x = bar_all.x; bar_e.st = MISC + 12; bar_e.G = (unsigned)nE;
    if (!inC && C.tid == 0) (void)xb_add(&bar_e.bar[XB_XCNT(bar_e.x)], 1u);
    Wk Wall; Wall.lv = C.vcu; Wall.n = C.G; Wall.c = bx; Wall.h = 0;
    Wk Wc; Wc.lv = xl * NC_PER_XCD + jx; Wc.n = nC; Wc.c = jx * 8 + xl; Wc.h = 0;
    Wk We; { const int je = jx - NC_PER_XCD, ne = perx - NC_PER_XCD; We.lv = xl * ne + je; We.n = nE; We.c = je * 8 + xl; We.h = 0; }
    phase_prologue(P, C);
    xcd_barrier(bar_all);
#ifdef PROBE_SEL
    unsigned long long tp0 = __builtin_amdgcn_s_memrealtime(), tp1 = 0, tp2 = 0, tp3 = 0, tp4 = 0, tp5 = 0, tpe1 = 0, tpe2 = 0, tpe3 = 0;
#define STAMP(v) v = __builtin_amdgcn_s_memrealtime()
#else
#define STAMP(v)
#endif
    Wall.h = 0; run_C0(P, C, Wall, bar_all); xcd_barrier(bar_all); STAMP(tp1);
    if (inC) { Wc.h = 1; run_C0(P, C, Wc, bar_c); help_E(P, C, 0, 0); } else { We.h = 0; run_E(P, C, We, bar_e, 0); }
    STAMP(tpe1);
#ifdef PROBE_SEL
    if (C.tid == 0) atomicMax(ctl + 80 + (inC ? 0 : 1), (unsigned)(tpe1 - tp1));
#endif
    xcd_barrier(bar_all); STAMP(tp2);
    if (inC) { Wc.h = 0; run_C1(P, C, Wc, bar_c); help_E(P, C, 1, 0); } else { We.h = 1; run_E(P, C, We, bar_e, 0); }
    STAMP(tpe2);
#ifdef PROBE_SEL
    if (C.tid == 0) atomicMax(ctl + 82 + (inC ? 0 : 1), (unsigned)(tpe2 - tp2));
#endif
    xcd_barrier(bar_all); STAMP(tp3);
    if (inC) { Wc.h = 1; run_C1(P, C, Wc, bar_c); help_E(P, C, 0, 1); } else { We.h = 0; run_E(P, C, We, bar_e, 1); }
    STAMP(tpe3);
#ifdef PROBE_SEL
    if (C.tid == 0) atomicMax(ctl + 84 + (inC ? 0 : 1), (unsigned)(tpe3 - tp3));
#endif
    xcd_barrier(bar_all); STAMP(tp4);
    Wall.h = 1; run_E(P, C, Wall, bar_all, 1);
#ifdef PROBE_SEL
    STAMP(tp5);
    { unsigned long long d = 0; const int sel = PROBE_SEL;
      if (sel == 0) d = tp1 - tp0; if (sel == 1) d = tp2 - tp1; if (sel == 2) d = tp3 - tp2; if (sel == 3) d = tp4 - tp3; if (sel == 4) d = tp5 - tp4;
      if (sel == 5 || sel == 8) d = tpe1 - tp1; if (sel == 6 || sel == 9) d = tpe2 - tp2; if (sel == 7 || sel == 10) d = tpe3 - tp3;
      const int who = sel >= 8 ? 8 * NC_PER_XCD : 0;
      if (sel >= 20) { const unsigned* sp = (const unsigned*)(P.ws + WS_CTL) + 128 + 16 * PROBE_HALF; const int i = sel - 20; const int nxt = (i == PROBE_LAST) ? 9 : i + 1; d = (unsigned long long)(__hip_atomic_load(sp + nxt, __ATOMIC_RELAXED, __HIP_MEMORY_SCOPE_AGENT) - __hip_atomic_load(sp + i, __ATOMIC_RELAXED, __HIP_MEMORY_SCOPE_AGENT)); }
      if (sel >= 30) d = 0;
      if (bx == (sel >= 20 ? 0 : who) && C.tid == 0) __hip_atomic_store(ctl + 64, (unsigned)d, __ATOMIC_RELAXED, __HIP_MEMORY_SCOPE_AGENT);
      xcd_barrier(bar_all);
      if (bx == 0 && C.tid == 0) { const unsigned dd = sel >= 30 ? __hip_atomic_load(ctl + 80 + (sel - 30), __ATOMIC_RELAXED, __HIP_MEMORY_SCOPE_AGENT) : __hip_atomic_load(ctl + 64, __ATOMIC_RELAXED, __HIP_MEMORY_SCOPE_AGENT);
        const unsigned long long t0_ = __builtin_amdgcn_s_memrealtime(); while (__builtin_amdgcn_s_memrealtime() - t0_ < 4ull * dd) __builtin_amdgcn_s_sleep(32); } }
#endif
}

extern "C" void kernel_launch(void* const* d_in, const int* in_sizes, int n_in, void* d_out, int out_size, void* d_ws, size_t ws_size, hipStream_t stream) {
    static int grid = 0;
    if (grid == 0) {
        if (n_in != 22 || in_sizes[0] != T * DM || out_size != T * DM || ws_size < WS_END) {
            fprintf(stderr, "kernel_launch: unexpected shapes (n_in %d, in0 %d, out %d, ws %zu); nothing launched\n", n_in, n_in > 0 ? in_sizes[0] : -1, out_size, ws_size); grid = -1; return; }
        int dev = 0, cus = 0;
        if (hipGetDevice(&dev) != hipSuccess || hipDeviceGetAttribute(&cus, hipDeviceAttributeMultiprocessorCount, dev) != hipSuccess) { fprintf(stderr, "kernel_launch: device query failed\n"); grid = -1; return; }
        if (hipFuncSetAttribute((const void*)hybrid_fwd, hipFuncAttributeMaxDynamicSharedMemorySize, LDS_BYTES) != hipSuccess) { fprintf(stderr, "kernel_launch: hipFuncSetAttribute failed\n"); grid = -1; return; }
        (void)hipGetLastError();
        grid = cus;
        if (grid % 8 != 0 || grid / 8 <= NC_PER_XCD) { fprintf(stderr, "kernel_launch: built for a CU count that is a multiple of 8 and > %d; got %d; nothing launched\n", 8 * NC_PER_XCD, grid); grid = -1; return; }
    }
    if (grid < 0) return;
    if (hipMemsetAsync((char*)d_ws + WS_CTL, 0, CTL_ZERO_BYTES, stream) != hipSuccess) { fprintf(stderr, "kernel_launch: memset failed\n"); return; }
    Params p{};
    p.x = (const float*)d_in[0]; p.c = (const float*)d_in[1]; p.positions = (const int*)d_in[2]; p.ada_w = (const float*)d_in[3]; p.ada_b = (const float*)d_in[4];
    p.norm_mix_g = (const float*)d_in[5]; p.norm_ffn_g = (const float*)d_in[6]; p.final_norm_g = (const float*)d_in[7]; p.even_w_in = (const float*)d_in[8]; p.even_w_out = (const float*)d_in[9];
    p.gmlp_ln_g = (const float*)d_in[10]; p.gmlp_ln_b = (const float*)d_in[11]; p.gmlp_w_s = (const float*)d_in[12]; p.gmlp_b_s = (const float*)d_in[13]; p.hgrn_lb_logits = (const float*)d_in[14];
    p.hgrn_norm_g = (const float*)d_in[15]; p.odd_w_qkv = (const float*)d_in[16]; p.odd_w_out = (const float*)d_in[17]; p.peer_w_query = (const float*)d_in[18]; p.peer_sub_keys = (const float*)d_in[19];
    p.peer_down = (const float*)d_in[20]; p.peer_up = (const float*)d_in[21];
    p.out = (float*)d_out; p.ws = (unsigned char*)d_ws;
    p.ph_lo = 0; p.ph_hi = 0;
    hipLaunchKernelGGL(hybrid_fwd, dim3(grid), dim3(NWAVES * 64), LDS_BYTES, stream, p);
    const hipError_t le = hipPeekAtLastError();
    if (le != hipSuccess) fprintf(stderr, "kernel_launch: launch failed: %s\n", hipGetErrorName(le));
}
```

```cpp
#include <hip/hip_runtime.h>
#include <cstdio>
#include <cstdint>
#include <cmath>
namespace pg8 {
#define PG8_LAS __attribute__((address_space(3)))
typedef unsigned short bf16_t;
typedef short bf16x8 __attribute__((ext_vector_type(8)));
typedef float f32x4 __attribute__((ext_vector_type(4)));
typedef unsigned u32x4 __attribute__((ext_vector_type(4)));
constexpr int BM = 256, BK = 64, HALF = 128, HTB = HALF * BK * 2  , STAGE_BYTES = 8 * HTB, NXCD = 8, WGM = 8;

__host__ __device__ __forceinline__ int lds_byte(int r, int c) { const int st = (r >> 4) * 2 + (c >> 5), rr = r & 15, cc = c & 31, ob = rr * 64 + cc * 2; return st * 1024 + (ob ^ (((ob >> 9) & 1) << 5)); }
__host__ __device__ __forceinline__ void stage_rc(int b, int& R, int& C) { const int st = b / 1024, sb = b % 1024, swz = sb ^ (((sb >> 9) & 1) << 5); R = (st >> 1) * 16 + swz / 64; C = (st & 1) * 32 + (swz % 64) / 2; }
__host__ __device__ __forceinline__ int perm32(int rho) { const int n = rho >> 4, i = rho & 15; return 8 * (i >> 2) + 4 * n + (i & 3); }

struct Unit { int pm, pn; };
struct Gemm { const bf16_t* A; const bf16_t* Bt; int M, N, K; };

struct StaticOrder {
    int nM, nN, nwg, G, c;
    __host__ __device__ void init(int M, int N, int G_, int c_) { nM = M / BM; nN = N / BM; nwg = nM * nN; G = G_; c = c_; }
    __host__ __device__ bool next(int i, Unit& u) const {
        const long L = (long)i * G + c; if (L >= nwg) return false;
        int wgid = (int)L; { const int q = nwg / NXCD, r = nwg % NXCD, xcd = wgid % NXCD, off = wgid / NXCD; wgid = (xcd < r ? xcd * (q + 1) : r * (q + 1) + (xcd - r) * q) + off; }
        const int nig = WGM * nN, gid = wgid / nig, fm = gid * WGM, gsz = (nM - fm) < WGM ? (nM - fm) : WGM;
        u.pm = fm + ((wgid % nig) % gsz); u.pn = (wgid % nig) / gsz; return true;
    }
    __device__ __forceinline__ void a_ready(const Unit&) const {}
    __device__ __forceinline__ void done(const Unit&) const {}
};

__device__ __forceinline__ unsigned cvt_pk_bf16(float lo, float hi) { unsigned r; asm volatile("v_cvt_pk_bf16_f32 %0, %1, %2" : "=v"(r) : "v"(lo), "v"(hi)); return r; }
typedef float f32x2 __attribute__((ext_vector_type(2)));
__device__ __forceinline__ f32x2 gelu_pk(f32x2 v) {
    const f32x2 av = __builtin_elementwise_abs(v), d = av * 0.2316418882f + 1.0f;
    f32x2 t; t.x = __builtin_amdgcn_rcpf(d.x); t.y = __builtin_amdgcn_rcpf(d.y);
    f32x2 q = t * 0.5307027145f + (-0.7265760135f); q = q * t + 0.7107068705f; q = q * t + (-0.142248368f); q = q * t + 0.127414796f; q = q * t;
    const f32x2 s = (v * v) * (-0.72134752044f);
    f32x2 e; e.x = __builtin_amdgcn_exp2f(s.x); e.y = __builtin_amdgcn_exp2f(s.y);
    const f32x2 m = v * (q * e), r = v - m;
    f32x2 o; o.x = v.x < 0.f ? m.x : r.x; o.y = v.y < 0.f ? m.y : r.y; return o;
}

template <class Epi, class Sched, bool ALIGN_EPI = false, bool SP2 = false>
__device__ __forceinline__ void gemm_phase(PG8_LAS unsigned char* lds, const Gemm g, const Sched& S, const Epi& E) {
    int tid_ = threadIdx.x; asm volatile("" : "+v"(tid_));
    const int tid = tid_, wid = __builtin_amdgcn_readfirstlane(tid >> 6), lane = tid & 63, wr = wid >> 2, wc = wid & 3, fr = lane & 15, fq = lane >> 4;
    const int K = g.K, nt = K / BK;
    unsigned voffA[2], voffB[2];
#pragma unroll
    for (int i = 0; i < 2; ++i) { int R, C; stage_rc(tid * 16 + i * 8192, R, C); const int Rb = Epi::PERM ? ((R & ~31) + perm32(R & 31)) : R;
        voffA[i] = (unsigned)(R * K + C) * 2u; voffB[i] = (unsigned)(Rb * K + C) * 2u; }
    const size_t kstep = (size_t)(BK * 2);
    const size_t hstep = (size_t)HALF * K * 2;
    const size_t tstep = 2 * hstep;
    const unsigned ldsw = (unsigned)wid * 1024u;
    const int aoff = lds_byte(wr * 64 + fr, fq * 8), boff = lds_byte(wc * 32 + fr, fq * 8);
#define PG8_SA(b, h) (((b) * 2 + (h)) * HTB)
#define PG8_SB(b, h) ((4 + (b) * 2 + (h)) * HTB)
#define PG8_STAGE(bufoff, gbase, voff) do { _Pragma("unroll") for (int _i = 0; _i < 2; ++_i) \
        __builtin_amdgcn_global_load_lds((const unsigned*)((const char*)(gbase) + (voff)[_i]), (PG8_LAS unsigned*)(lds + (bufoff) + ldsw + _i * 8192), 16, 0, 0); } while (0)
#define PG8_LDA(dst, b, h) do { _Pragma("unroll") for (int m = 0; m < 4; ++m) _Pragma("unroll") for (int k = 0; k < 2; ++k) dst[m][k] = *(const PG8_LAS bf16x8*)(lds + PG8_SA(b, h) + aoff + m * 2048 + k * 1024); } while (0)
#define PG8_LDB(dst, b, h) do { _Pragma("unroll") for (int n = 0; n < 2; ++n) _Pragma("unroll") for (int k = 0; k < 2; ++k) dst[n][k] = *(const PG8_LAS bf16x8*)(lds + PG8_SB(b, h) + boff + n * 2048 + k * 1024); } while (0)
#define PG8_MMA(ai, bj, At, Bt) do { __builtin_amdgcn_s_setprio(1); _Pragma("unroll") for (int m = 0; m < 4; ++m) _Pragma("unroll") for (int n = 0; n < 2; ++n) _Pragma("unroll") for (int k = 0; k < 2; ++k) \
        acc[ai][bj][m][n] = __builtin_amdgcn_mfma_f32_16x16x32_bf16(Bt[n][k], At[m][k], acc[ai][bj][m][n], 0, 0, 0); __builtin_amdgcn_s_setprio(0); } while (0)
#define PG8_WAIT_V(n) asm volatile("s_waitcnt vmcnt(" #n ")" ::: "memory")
#define PG8_WAIT_L(n) asm volatile("s_waitcnt lgkmcnt(" #n ")" ::: "memory")
#define PG8_BAR __builtin_amdgcn_s_barrier()
#define PG8_SCHED __builtin_amdgcn_sched_barrier(0)
    Unit cur, nxt; int ui = 0;
    if (!S.next(0, cur)) return;
    f32x4 acc[2][2][4][2];
#pragma unroll
    for (int a = 0; a < 2; ++a)
#pragma unroll
        for (int b = 0; b < 2; ++b)
#pragma unroll
            for (int m = 0; m < 4; ++m)
#pragma unroll
                for (int n = 0; n < 2; ++n) acc[a][b][m][n] = (f32x4){0.f, 0.f, 0.f, 0.f};
    bf16x8 At[4][2], B0[2][2], B1[2][2];
    const char* cA = (const char*)g.A + (size_t)cur.pm * tstep; const char* cB = (const char*)g.Bt + (size_t)cur.pn * tstep;
    S.a_ready(cur);
    if constexpr (SP2) {
        PG8_STAGE(PG8_SB(0, 0), cB, voffB); PG8_STAGE(PG8_SB(0, 1), cB + hstep, voffB); PG8_STAGE(PG8_SA(0, 0), cA, voffA); PG8_STAGE(PG8_SA(0, 1), cA + hstep, voffA);
        if (wr == 1) PG8_BAR;
        PG8_WAIT_V(2); PG8_BAR;
        PG8_STAGE(PG8_SB(1, 0), cB + kstep, voffB); PG8_STAGE(PG8_SA(1, 0), cA + kstep, voffA); PG8_STAGE(PG8_SB(1, 1), cB + hstep + kstep, voffB);
        PG8_WAIT_V(6); PG8_BAR;
    } else {
        PG8_STAGE(PG8_SB(0, 0), cB, voffB); PG8_STAGE(PG8_SA(0, 0), cA, voffA); PG8_STAGE(PG8_SB(0, 1), cB + hstep, voffB); PG8_STAGE(PG8_SA(0, 1), cA + hstep, voffA);
        if (wr == 1) PG8_BAR;
        PG8_WAIT_V(4); PG8_BAR;
        PG8_STAGE(PG8_SB(1, 0), cB + kstep, voffB); PG8_STAGE(PG8_SA(1, 0), cA + kstep, voffA); PG8_STAGE(PG8_SB(1, 1), cB + hstep + kstep, voffB);
        PG8_WAIT_V(6); PG8_BAR;
    }
    for (;;) {
        const bool has_next = S.next(ui + 1, nxt);
        const char* nA = has_next ? (const char*)g.A + (size_t)nxt.pm * tstep : cA; const char* nB = has_next ? (const char*)g.Bt + (size_t)nxt.pn * tstep : cB;
        for (int t = 0; t < nt; t += 2) {
            const bool last = (t == nt - 2);
            const char* a1 = cA + (size_t)(t + 1) * kstep;
            const char* a2 = last ? nA : cA + (size_t)(t + 2) * kstep; const char* b2 = last ? nB : cB + (size_t)(t + 2) * kstep;
            const char* a3 = a2 + kstep; const char* b3 = b2 + kstep;
            if (last && has_next) S.a_ready(nxt);
            if constexpr (SP2) {
            PG8_LDB(B0, 0, 0); PG8_LDB(B1, 0, 1); PG8_SCHED; PG8_LDA(At, 0, 0); PG8_STAGE(PG8_SA(1, 1), a1 + hstep, voffA);
            PG8_WAIT_V(8); PG8_WAIT_L(0); PG8_BAR; PG8_MMA(0, 0, At, B0); PG8_MMA(0, 1, At, B1); PG8_BAR; PG8_SCHED;
            PG8_LDA(At, 0, 1); PG8_STAGE(PG8_SB(0, 0), b2, voffB); PG8_STAGE(PG8_SB(0, 1), b2 + hstep, voffB); PG8_STAGE(PG8_SA(0, 0), a2, voffA);
            PG8_WAIT_V(8); PG8_WAIT_L(0); PG8_BAR; PG8_MMA(1, 0, At, B0); PG8_MMA(1, 1, At, B1); PG8_BAR; PG8_SCHED;
            PG8_LDB(B0, 1, 0); PG8_LDB(B1, 1, 1); PG8_SCHED; PG8_LDA(At, 1, 0); PG8_STAGE(PG8_SA(0, 1), a2 + hstep, voffA);
            PG8_WAIT_V(8); PG8_WAIT_L(0); PG8_BAR; PG8_MMA(0, 0, At, B0); PG8_MMA(0, 1, At, B1); PG8_BAR; PG8_SCHED;
            PG8_LDA(At, 1, 1); PG8_STAGE(PG8_SB(1, 0), b3, voffB); PG8_STAGE(PG8_SB(1, 1), b3 + hstep, voffB); PG8_STAGE(PG8_SA(1, 0), a3, voffA);
            PG8_WAIT_V(8); PG8_WAIT_L(0); PG8_BAR; PG8_MMA(1, 0, At, B0); PG8_MMA(1, 1, At, B1); PG8_BAR; PG8_SCHED;
            } else {
            PG8_LDB(B0, 0, 0); PG8_SCHED; PG8_LDA(At, 0, 0); PG8_STAGE(PG8_SA(1, 1), a1 + hstep, voffA);
            PG8_WAIT_L(8); PG8_BAR; PG8_WAIT_L(0); PG8_MMA(0, 0, At, B0); PG8_BAR; PG8_SCHED;
            PG8_LDB(B1, 0, 1); PG8_STAGE(PG8_SB(0, 0), b2, voffB);
            PG8_BAR; PG8_WAIT_L(0); PG8_MMA(0, 1, At, B1); PG8_BAR;
            PG8_LDA(At, 0, 1); PG8_STAGE(PG8_SA(0, 0), a2, voffA);
            PG8_BAR; PG8_WAIT_L(0); PG8_MMA(1, 0, At, B0); PG8_BAR; PG8_SCHED;
            PG8_STAGE(PG8_SB(0, 1), b2 + hstep, voffB);
            PG8_WAIT_V(6); PG8_BAR; PG8_MMA(1, 1, At, B1); PG8_BAR;
            PG8_LDB(B0, 1, 0); PG8_SCHED; PG8_LDA(At, 1, 0); PG8_STAGE(PG8_SA(0, 1), a2 + hstep, voffA);
            PG8_WAIT_L(8); PG8_BAR; PG8_WAIT_L(0); PG8_MMA(0, 0, At, B0); PG8_BAR; PG8_SCHED;
            PG8_LDB(B1, 1, 1); PG8_STAGE(PG8_SB(1, 0), b3, voffB);
            PG8_BAR; PG8_WAIT_L(0); PG8_MMA(0, 1, At, B1); PG8_BAR;
            PG8_LDA(At, 1, 1); PG8_STAGE(PG8_SA(1, 0), a3, voffA);
            PG8_BAR; PG8_WAIT_L(0); PG8_MMA(1, 0, At, B0); PG8_BAR; PG8_SCHED;
            PG8_STAGE(PG8_SB(1, 1), b3 + hstep, voffB);
            PG8_WAIT_V(6); PG8_BAR; PG8_MMA(1, 1, At, B1); PG8_BAR;
            }
        }
        if constexpr (ALIGN_EPI) { if (wr == 0) PG8_BAR; }
        if constexpr (!Epi::AFTER_DRAIN) { E(acc, cur, wr, wc, fr, fq); S.done(cur); }
        if (!has_next) break;
#pragma unroll
        for (int a = 0; a < 2; ++a)
#pragma unroll
            for (int b = 0; b < 2; ++b)
#pragma unroll
                for (int m = 0; m < 4; ++m)
#pragma unroll
                    for (int n = 0; n < 2; ++n) acc[a][b][m][n] = (f32x4){0.f, 0.f, 0.f, 0.f};
        cur = nxt; cA = nA; cB = nB; ++ui;
        if constexpr (ALIGN_EPI) { if (wr == 1) PG8_BAR; }
    }
    PG8_WAIT_V(0);
    if constexpr (!ALIGN_EPI) { if (wr == 0) PG8_BAR; }
    PG8_BAR;
    if constexpr (Epi::AFTER_DRAIN) { E.fused(acc, cur, wr, wc, fr, fq, lds, wid, lane); S.done(cur); }
#undef PG8_SA
#undef PG8_SB
#undef PG8_STAGE
#undef PG8_LDA
#undef PG8_LDB
#undef PG8_MMA
#undef PG8_WAIT_V
#undef PG8_WAIT_L
#undef PG8_BAR
#undef PG8_SCHED
}
}
#define GAS __attribute__((address_space(1)))
#define LAS __attribute__((address_space(3)))
typedef unsigned short bf16;
typedef unsigned v4u __attribute__((ext_vector_type(4)));
typedef float f32x4 __attribute__((ext_vector_type(4)));
typedef short bf16x8 __attribute__((ext_vector_type(8)));
typedef __bf16 bf16x2_t __attribute__((ext_vector_type(2)));
#define LDS_WAIT() asm volatile("s_waitcnt lgkmcnt(0)" ::: "memory")
#define VM_WAIT() asm volatile("s_waitcnt vmcnt(0)" ::: "memory")
typedef float f32x2_cv __attribute__((ext_vector_type(2)));
__device__ __forceinline__ unsigned pk2(float lo, float hi) { const f32x2_cv v = {lo, hi}; return __builtin_bit_cast(unsigned, __builtin_convertvector(v, bf16x2_t)); }
__device__ __forceinline__ unsigned f2bf(float f) { return pk2(f, 0.f) & 0xffffu; }
__device__ __forceinline__ float bflo(unsigned u) { return __builtin_bit_cast(float, u << 16); }
__device__ __forceinline__ float bfhi(unsigned u) { return __builtin_bit_cast(float, u & 0xffff0000u); }
__device__ __forceinline__ float bf2f(bf16 u) { return __builtin_bit_cast(float, (unsigned)u << 16); }
#define XB_TMO      128
#define XB_XCNT(j)  (256  + 64 * (j))
#define XB_XSUB(j)  (1280 + 64 * (j))
#define XB_XGEN(j)  (2304 + 64 * (j))
#define XB_TOP      3328
#define XB_TOPGEN   3392
#define XCD_BAR_WORDS 3456
#define XB_SPIN_CAP (1u << 18)

__device__ __forceinline__ unsigned xb_ld(unsigned* p)              { return __hip_atomic_load(p, __ATOMIC_RELAXED, __HIP_MEMORY_SCOPE_AGENT); }
__device__ __forceinline__ unsigned xb_add(unsigned* p, unsigned v) { return __hip_atomic_fetch_add(p, v, __ATOMIC_RELAXED, __HIP_MEMORY_SCOPE_AGENT); }
__device__ __forceinline__ unsigned xb_xcc_id() { return (unsigned)__builtin_amdgcn_s_getreg((3 << 11) | 20) & 0xFu; }
#define XB_SPIN(cond, bar) do { unsigned _sp = 0; while (cond) { __builtin_amdgcn_s_sleep(1); \
    if ((++_sp & 255u) == 0u) { if (xb_ld(&(bar)[XB_TMO])) break; if (_sp > XB_SPIN_CAP) { atomicAdd(&(bar)[XB_TMO], 1u); break; } } } } while (0)

struct XcdBarrier {
    unsigned* bar; unsigned x; unsigned G;
    volatile LAS unsigned* st;
};

__device__ __forceinline__ XcdBarrier xcd_barrier_post(unsigned* bar, volatile LAS unsigned* st) {
    XcdBarrier b; b.bar = bar; b.x = xb_xcc_id(); b.st = st; b.G = gridDim.x;
    if (threadIdx.x == 0) (void)xb_add(&bar[XB_XCNT(b.x)], 1u);
    return b;
}
__device__ __forceinline__ void xcd_barrier_complete(unsigned* bar, unsigned x, unsigned& nloc, unsigned& nx, const unsigned G) {
    unsigned sum, cnt, mine, sp = 0u;
    for (;;) {
        sum = 0u; cnt = 0u; mine = 0u;
#pragma unroll
        for (unsigned j = 0; j < 16; ++j) { const unsigned c = xb_ld(&bar[XB_XCNT(j)]); sum += c; cnt += (c > 0u) ? 1u : 0u; mine = (j == x) ? c : mine; }
        if (sum == G) break;
        __builtin_amdgcn_s_sleep(1);
        if ((++sp & 255u) == 0u) { if (xb_ld(&bar[XB_TMO])) break; if (sp > XB_SPIN_CAP) { atomicAdd(&bar[XB_TMO], 1u); break; } }
    }
    nloc = mine > 0u ? mine : 1u; nx = cnt > 0u ? cnt : 1u;
}

__device__ __forceinline__ void xcd_barrier(const XcdBarrier& b) {
    asm volatile("s_waitcnt vmcnt(0)" ::: "memory");
    __syncthreads();
    if (threadIdx.x == 0) {
        unsigned* bar = b.bar;
        __builtin_amdgcn_s_waitcnt(0);
        unsigned nloc = b.st[0], nx = b.st[1];
        if (nloc == 0u) { xcd_barrier_complete(bar, b.x, nloc, nx, b.G); b.st[0] = nloc; b.st[1] = nx; }
        const unsigned old = xb_add(&bar[XB_XSUB(b.x)], 1u);
        const unsigned gen = old / nloc;
        if (old + 1u == (gen + 1u) * nloc) {
            __builtin_amdgcn_fence(__ATOMIC_RELEASE, "agent");
            asm volatile("s_waitcnt vmcnt(0)" ::: "memory");
            const unsigned og = xb_add(&bar[XB_TOP], 1u);
            const unsigned tg = og / nx;
            if (og + 1u == (tg + 1u) * nx) xb_add(&bar[XB_TOPGEN], 1u);
            else XB_SPIN(xb_ld(&bar[XB_TOPGEN]) == tg, bar);
            __builtin_amdgcn_fence(__ATOMIC_ACQUIRE, "agent");
            xb_add(&bar[XB_XGEN(b.x)], 1u);
            asm volatile("s_waitcnt vmcnt(0)" ::: "memory");
        } else {
            XB_SPIN(xb_ld(&bar[XB_XGEN(b.x)]) == gen, bar);
            __builtin_amdgcn_fence(__ATOMIC_ACQUIRE, "agent");
            asm volatile("s_waitcnt vmcnt(0)" ::: "memory");
        }
    }
    __syncthreads();
}

constexpr int NB = 8, SEQ = 8192, DM = 1024, T = NB * SEQ;
constexpr int NWAVES = 8;
constexpr float NORM_EPS = 1e-6f;
constexpr float C2 = 0.125f * 1.4426950408889634f;

constexpr size_t MiB = 1u << 20;
constexpr size_t WS_CTL = 0, CTL_ZERO_BYTES = 1 * MiB;
constexpr size_t WS_MOD = 1 * MiB;
constexpr size_t WS_SKB = 1 * MiB + 512 * 1024;
constexpr size_t WS_WSB = 1 * MiB + 768 * 1024;
constexpr size_t WS_LB  = 1 * MiB + 960 * 1024;
constexpr size_t WS_CS  = 2 * MiB;
constexpr size_t WS_HD  = 6 * MiB;
constexpr size_t WS_WIN = 16 * MiB, WS_WOUT0 = 22 * MiB, WS_WQKV = 24 * MiB, WS_WOUT1 = 30 * MiB, WS_WQ0 = 32 * MiB, WS_WQ1 = 36 * MiB;
constexpr size_t WS_TAB8 = 40 * MiB, TAB8_BYTES = 12 * MiB;
constexpr int TROW = 768;
constexpr size_t WS_SC8 = 8 * MiB;
constexpr size_t WS_H = 108 * MiB;
constexpr size_t WS_IDX = 236 * MiB, WS_GATE = 268 * MiB;
constexpr size_t WS_AR0 = 300 * MiB, AR_BYTES = 352 * MiB;
constexpr size_t AR_PU = 0, AR_PV = 32 * MiB, AR_PQ = 64 * MiB, AR_PI = 96 * MiB, AR_PG = 128 * MiB;
constexpr size_t AR_G = 160 * MiB;
constexpr size_t AR_KVT = 224 * MiB, AR_ST = 288 * MiB;
constexpr size_t AR_QP = 0;
constexpr size_t AR_QK = 0;
constexpr int QK_ROWS = SEQ + SEQ / 16;
__host__ __device__ __forceinline__ int qk_row(int t) { return t + (t >> 4); }
constexpr size_t WS_END = WS_AR0 + 2 * AR_BYTES;
constexpr int HT = T / 2;
constexpr int CW_BAR = 4096;

constexpr int LDS_BYTES = 147456;
constexpr int LDSCTL_OFF = LDS_BYTES - 512;
constexpr int MISC_OFF = LDSCTL_OFF;

struct Params {
    const float* x; const float* c; const int* positions; const float* ada_w; const float* ada_b; const float* norm_mix_g; const float* norm_ffn_g; const float* final_norm_g;
    const float* even_w_in; const float* even_w_out; const float* gmlp_ln_g; const float* gmlp_ln_b; const float* gmlp_w_s; const float* gmlp_b_s; const float* hgrn_lb_logits; const float* hgrn_norm_g;
    const float* odd_w_qkv; const float* odd_w_out; const float* peer_w_query; const float* peer_sub_keys; const float* peer_down; const float* peer_up;
    float* out; unsigned char* ws; int ph_lo, ph_hi;
};
struct Ctx { LAS unsigned char* lds; int tid, lane, wave, vcu, G; };
__device__ __forceinline__ Ctx fresh_ctx(const Ctx& C0) { Ctx C = C0; int t_ = threadIdx.x; asm volatile("" : "+v"(t_)); C.tid = t_; C.lane = t_ & 63; C.wave = __builtin_amdgcn_readfirstlane(t_ >> 6); return C; }
struct Wk { int lv, n, c, h; };
#define W_TK0(W) ((W).h * (T / 2))
#define W_BT0(W) ((W).h * (NB / 2))
__device__ __forceinline__ unsigned char* w_ar(const Params& P, const Wk& W) { return P.ws + WS_AR0 + (size_t)W.h * AR_BYTES; }
__device__ __forceinline__ bf16* w_tok16(const Params& P, const Wk& W, size_t off, int pitch) { return (bf16*)(w_ar(P, W) + off) - (size_t)W_TK0(W) * pitch; }
__device__ __forceinline__ float* w_tok32(const Params& P, const Wk& W, size_t off, int pitch) { return (float*)(w_ar(P, W) + off) - (size_t)W_TK0(W) * pitch; }
__device__ __forceinline__ bf16* w_item16(const Params& P, const Wk& W, size_t off) { return (bf16*)(w_ar(P, W) + off) - (size_t)W_BT0(W) * 512 * 16384; }

__device__ __forceinline__ float wave_sum(float v) {
#pragma unroll
    for (int o = 1; o < 64; o <<= 1) v += __shfl_xor(v, o);
    return v;
}
__device__ __forceinline__ float silu_f(float x) { return x * __builtin_amdgcn_rcpf(1.0f + __builtin_amdgcn_exp2f(-1.4426950408889634f * x)); }
__device__ __forceinline__ float sigmoid_f(float x) { return __builtin_amdgcn_rcpf(1.0f + __builtin_amdgcn_exp2f(-1.4426950408889634f * x)); }
__device__ __forceinline__ float gelu_f(float x) { return 0.5f * x * (1.0f + erff(x * 0.70710678118654752f)); }
__device__ __forceinline__ f32x4 mma16(f32x4 acc, const LAS bf16* A, int lda, const LAS bf16* Bt, int ldb, int K, int r, int q4) {
    const LAS bf16* ap = A + r * lda + 8 * q4; const LAS bf16* bp = Bt + r * ldb + 8 * q4;
    for (int k0 = 0; k0 < K; k0 += 32) {
        const bf16x8 a = *(const LAS bf16x8*)(ap + k0); const bf16x8 b = *(const LAS bf16x8*)(bp + k0);
        acc = __builtin_amdgcn_mfma_f32_16x16x32_bf16(a, b, acc, 0, 0, 0);
    }
    return acc;
}

struct EpiBf16P {
    static constexpr bool PERM = true, AFTER_DRAIN = false;
    bf16* O; size_t ldc;
    __device__ __forceinline__ void operator()(const f32x4 (&acc)[2][2][4][2], const pg8::Unit& u, int wr, int wc, int fr, int fq) const {
        const int row0 = u.pm * 256 + wr * 64 + fr, col0 = u.pn * 256 + wc * 32 + 8 * fq;
#pragma unroll
        for (int ai = 0; ai < 2; ++ai)
#pragma unroll
            for (int m = 0; m < 4; ++m) { bf16* rowp = O + (size_t)(row0 + ai * 128 + m * 16) * ldc + col0;
#pragma unroll
                for (int bj = 0; bj < 2; ++bj) { const f32x4 v0 = acc[ai][bj][m][0], v1 = acc[ai][bj][m][1];
                    v4u w; w.x = pg8::cvt_pk_bf16(v0[0], v0[1]); w.y = pg8::cvt_pk_bf16(v0[2], v0[3]); w.z = pg8::cvt_pk_bf16(v1[0], v1[1]); w.w = pg8::cvt_pk_bf16(v1[2], v1[3]);
                    *(v4u*)(rowp + bj * 128) = w; } }
    }
};
#ifndef REP_HG
#define REP_HG 1
#endif
#ifndef REP_TOPK
#define REP_TOPK 1
#endif
#ifndef REP_PRO
#define REP_PRO 1
#endif
#ifndef REP_NORM
#define REP_NORM 1
#endif
#ifndef REP_GEMM2
#define REP_GEMM2 1
#endif
#ifndef REP_GEMM
#define REP_GEMM 1
#endif
#ifndef EXP_REP
#define EXP_REP 1
#endif
#ifndef ATT_REP
#define ATT_REP 1
#endif
#ifndef ABL_ON
#define ABL_ON 4
#endif
struct EpiResid {
    static constexpr bool PERM = true, AFTER_DRAIN = false;
    const float* xin; float* xout; const float* gate; float gsc;
    __device__ __forceinline__ void operator()(const f32x4 (&acc)[2][2][4][2], const pg8::Unit& u, int wr, int wc, int fr, int fq) const {
        const int row0 = u.pm * 256 + wr * 64 + fr, col0 = u.pn * 256 + wc * 32 + 8 * fq;
        const float* gp = gate + (size_t)((u.pm * 256) >> 13) * 6144 + col0;
        f32x4 gv[2][2];
#pragma unroll
        for (int bj = 0; bj < 2; ++bj) { gv[bj][0] = *(const f32x4*)(gp + bj * 128); gv[bj][1] = *(const f32x4*)(gp + bj * 128 + 4); }
#pragma unroll
        for (int ai = 0; ai < 2; ++ai)
#pragma unroll
            for (int m = 0; m < 4; ++m) { const size_t off = (size_t)(row0 + ai * 128 + m * 16) * 1024 + col0;
#pragma unroll
                for (int bj = 0; bj < 2; ++bj) {
                    const f32x4 x0 = *(const f32x4*)(xin + off + bj * 128), x1 = *(const f32x4*)(xin + off + bj * 128 + 4);
                    *(f32x4*)(xout + off + bj * 128) = x0 + gv[bj][0] * acc[ai][bj][m][0] * gsc;
                    *(f32x4*)(xout + off + bj * 128 + 4) = x1 + gv[bj][1] * acc[ai][bj][m][1] * gsc; }
                asm volatile("" ::: "memory"); }
    }
};
struct EpiInProj {
    static constexpr bool PERM = true, AFTER_DRAIN = false;
    bf16* PU; bf16* PV; bf16* PQ; bf16* PI; bf16* PG; float* G; const float* LB;
    __device__ __forceinline__ void operator()(const f32x4 (&acc)[2][2][4][2], const pg8::Unit& u, int wr, int wc, int fr, int fq) const {
        const int type = u.pn >> 1;
        const int row0 = u.pm * 256 + wr * 64 + fr, lc0 = (u.pn & 1) * 256 + wc * 32 + 8 * fq;
        if (type == 3) {
            f32x4 lb[2][2];
#pragma unroll
            for (int bj = 0; bj < 2; ++bj) { lb[bj][0] = *(const f32x4*)(LB + lc0 + bj * 128); lb[bj][1] = *(const f32x4*)(LB + lc0 + bj * 128 + 4); }
#pragma unroll
            for (int ai = 0; ai < 2; ++ai)
#pragma unroll
                for (int m = 0; m < 4; ++m) { float* rowp = G + (size_t)(row0 + ai * 128 + m * 16) * 512 + lc0;
#pragma unroll
                    for (int bj = 0; bj < 2; ++bj)
#pragma unroll
                        for (int n = 0; n < 2; ++n) { const f32x4 v = acc[ai][bj][m][n]; f32x4 o;
#pragma unroll
                            for (int e = 0; e < 4; ++e) { const float l = lb[bj][n][e]; const float f = l + (1.0f - l) * sigmoid_f(v[e]); o[e] = __logf(f); }
                            *(f32x4*)(rowp + bj * 128 + 4 * n) = o; } }
            return;
        }
        bf16* base = type == 0 ? PU : type == 1 ? PV : type == 2 ? PQ : type == 4 ? PI : PG;
#pragma unroll
        for (int ai = 0; ai < 2; ++ai)
#pragma unroll
            for (int m = 0; m < 4; ++m) { bf16* rowp = base + (size_t)(row0 + ai * 128 + m * 16) * 512 + lc0;
#pragma unroll
                for (int bj = 0; bj < 2; ++bj) { f32x4 v0 = acc[ai][bj][m][0], v1 = acc[ai][bj][m][1];
                    if (type <= 1) { pg8::f32x2 a = pg8::gelu_pk((pg8::f32x2){v0[0], v0[1]}), b = pg8::gelu_pk((pg8::f32x2){v0[2], v0[3]}), c = pg8::gelu_pk((pg8::f32x2){v1[0], v1[1]}), d = pg8::gelu_pk((pg8::f32x2){v1[2], v1[3]});
                        v0 = (f32x4){a.x, a.y, b.x, b.y}; v1 = (f32x4){c.x, c.y, d.x, d.y}; }
                    else if (type == 2) {
#pragma unroll
                        for (int e = 0; e < 4; ++e) { v0[e] = silu_f(v0[e]) * 0.08838834764831845f; v1[e] = silu_f(v1[e]) * 0.08838834764831845f; } }
                    else if (type == 5) {
#pragma unroll
                        for (int e = 0; e < 4; ++e) { v0[e] = silu_f(v0[e]); v1[e] = silu_f(v1[e]); } }
                    v4u w; w.x = pg8::cvt_pk_bf16(v0[0], v0[1]); w.y = pg8::cvt_pk_bf16(v0[2], v0[3]); w.z = pg8::cvt_pk_bf16(v1[0], v1[1]); w.w = pg8::cvt_pk_bf16(v1[2], v1[3]);
                    *(v4u*)(rowp + bj * 128) = w; } }
    }
};
struct EpiQKRot {
    static constexpr bool PERM = true, AFTER_DRAIN = false;
    bf16* O; const float* CS;
    __device__ __forceinline__ void operator()(const f32x4 (&acc)[2][2][4][2], const pg8::Unit& u, int wr, int wc, int fr, int fq) const {
        const int row0 = u.pm * 256 + wr * 64 + fr, col0 = u.pn * 256 + wc * 32 + 8 * fq;
        const float sc = u.pn < 4 ? C2 : 1.0f;
        const bool rotw = (wc & 1) == 0 && u.pn < 8;
        const float sgn = fq == 0 ? -1.0f : 1.0f;
#pragma unroll
        for (int ai = 0; ai < 2; ++ai)
#pragma unroll
            for (int m = 0; m < 4; ++m) { const int row = row0 + ai * 128 + m * 16;
                bf16* rowp = O + ((size_t)(((u.pn >> 2) * 4 + (row >> 13)) * 16 + (u.pn & 3) * 4 + (wc >> 1)) * QK_ROWS + qk_row(row & 8191)) * 64 + (wc & 1) * 32 + 8 * fq;
                f32x4 c0 = (f32x4){1.f, 1.f, 1.f, 1.f}, c1 = c0, s0 = (f32x4){0.f, 0.f, 0.f, 0.f}, s1 = s0;
                if (rotw && fq < 2) { const float* cp = CS + (size_t)row * 16; c0 = *(const f32x4*)(cp); c1 = *(const f32x4*)(cp + 4); s0 = *(const f32x4*)(cp + 8) * sgn; s1 = *(const f32x4*)(cp + 12) * sgn; }
#pragma unroll
                for (int bj = 0; bj < 2; ++bj) { f32x4 v0 = acc[ai][bj][m][0], v1 = acc[ai][bj][m][1];
                    if (rotw) { f32x4 p0, p1;
#pragma unroll
                        for (int e = 0; e < 4; ++e) { p0[e] = __shfl_xor(v0[e], 16); p1[e] = __shfl_xor(v1[e], 16); }
                        v0 = v0 * c0 + p0 * s0; v1 = v1 * c1 + p1 * s1; }
                    v0 = v0 * sc; v1 = v1 * sc;
                    v4u w; w.x = pg8::cvt_pk_bf16(v0[0], v0[1]); w.y = pg8::cvt_pk_bf16(v0[2], v0[3]); w.z = pg8::cvt_pk_bf16(v1[0], v1[1]); w.w = pg8::cvt_pk_bf16(v1[2], v1[3]);
                    *(v4u*)(rowp + (size_t)bj * 2 * QK_ROWS * 64) = w; } }
    }
};

__device__ __forceinline__ void p0_transpose_item(const float* W, int K, int N, bf16* WT, LAS float* scr, int item, int lane) {
    const int nblk = N / 32, kb = item / nblk, nb = item % nblk, k0 = 64 * kb, n0 = 32 * nb;
#pragma unroll 8
    for (int i = 0; i < 32; ++i) { const int kk = 2 * i + (lane >> 5); scr[kk * 33 + (lane & 31)] = W[(size_t)(k0 + kk) * N + n0 + (lane & 31)]; }
    LDS_WAIT(); asm volatile("" ::: "memory");
    const int c = lane & 7;
#pragma unroll
    for (int j = 0; j < 4; ++j) { const int n = (lane >> 3) + 8 * j; const LAS float* s = scr + (8 * c) * 33 + n;
        v4u o; o.x = pk2(s[0 * 33], s[1 * 33]); o.y = pk2(s[2 * 33], s[3 * 33]); o.z = pk2(s[4 * 33], s[5 * 33]); o.w = pk2(s[6 * 33], s[7 * 33]);
        *(GAS v4u*)(WT + (size_t)(n0 + n) * K + k0 + 8 * c) = o; }
    LDS_WAIT(); asm volatile("" ::: "memory");
}
typedef float f32x2 __attribute__((ext_vector_type(2)));
typedef float f32x16v __attribute__((ext_vector_type(16)));
typedef float f32x32v __attribute__((ext_vector_type(32)));
typedef unsigned v6u __attribute__((ext_vector_type(6)));
__device__ __forceinline__ void convert_tables(const Params& P, const Ctx& C) {
    const int gw = C.vcu * NWAVES + C.wave, NGW = C.G * NWAVES, lane = C.lane, hl = lane & 31;
    LAS float* stg = (LAS float*)(C.lds + C.wave * 16384);
    for (int rp = gw; rp < 2 * 16384; rp += NGW) {
#pragma unroll
        for (int rr = 0; rr < 2; ++rr) { const int row_ = 2 * rp + rr, tb_ = row_ >> 14, e_ = row_ & 16383;
            const f32x4* src = (const f32x4*)(((tb_ & 1) ? P.peer_up : P.peer_down) + ((size_t)(tb_ >> 1) * 16384 + e_) * 1024);
#pragma unroll
            for (int j = 0; j < 4; ++j) *(LAS f32x4*)(stg + rr * 1024 + 4 * (64 * j + lane)) = src[64 * j + lane]; }
        LDS_WAIT(); asm volatile("" ::: "memory");
        const int row = 2 * rp + (lane >> 5), tb = row >> 14, e = row & 16383;
        const LAS f32x4* sp = (const LAS f32x4*)(stg + (lane >> 5) * 1024 + 32 * hl);
        unsigned char* dst = P.ws + WS_TAB8 + (size_t)tb * TAB8_BYTES + (size_t)e * TROW;
        f32x16v a, b2; float mx = 0.f;
#pragma unroll
        for (int j = 0; j < 4; ++j) { const f32x4 v = sp[j], w = sp[4 + j];
#pragma unroll
            for (int i = 0; i < 4; ++i) { mx = fmaxf(mx, fmaxf(fabsf(v[i]), fabsf(w[i]))); }
            a[2 * j] = v[0]; b2[2 * j] = v[1]; a[2 * j + 1] = v[2]; b2[2 * j + 1] = v[3]; a[8 + 2 * j] = w[0]; b2[8 + 2 * j] = w[1]; a[8 + 2 * j + 1] = w[2]; b2[8 + 2 * j + 1] = w[3]; }
        LDS_WAIT(); asm volatile("" ::: "memory");
#pragma unroll
        for (int o = 1; o < 32; o <<= 1) mx = fmaxf(mx, __shfl_xor(mx, o));
        const float sc = mx > 0.f ? 7.0f / mx : 0.f;
        a = a * sc; b2 = b2 * sc;
        const v6u p = __builtin_amdgcn_cvt_scalef32_2xpk16_fp6_f32(a, b2, 1.0f);
        *(v4u*)(dst + 256 * (hl & 1) + 16 * (hl >> 1)) = (v4u){p[0], p[1], p[2], p[3]}; *(unsigned long long*)(dst + 512 + 128 * (hl & 1) + 8 * (hl >> 1)) = ((unsigned long long)p[5] << 32) | p[4];
        if (hl == 0) ((float*)(P.ws + WS_SC8))[row] = mx * (1.0f / 7.0f);
    }
}
__device__ __forceinline__ void phase_prologue(const Params& P, const Ctx& C) {
    float* MOD = (float*)(P.ws + WS_MOD);
    {
        LAS float* cond = (LAS float*)C.lds;
        LAS float* part = (LAS float*)(C.lds + 32768);
        for (int e = C.tid; e < 8192; e += 512) cond[e] = silu_f(P.c[e]);
        __syncthreads();
        for (int item = C.vcu; item < 192; item += C.G) {
            const int l = item / 96, cb = item % 96, col = cb * 64 + C.lane;
            float acc[8];
#pragma unroll
            for (int b = 0; b < 8; ++b) acc[b] = 0.f;
            const float* wp = P.ada_w + ((size_t)l * 1024 + C.wave * 128) * 6144 + col;
#pragma unroll 4
            for (int k = 0; k < 128; ++k) { const float wv = wp[(size_t)k * 6144];
#pragma unroll
                for (int b = 0; b < 8; ++b) acc[b] += cond[b * 1024 + C.wave * 128 + k] * wv; }
#pragma unroll
            for (int b = 0; b < 8; ++b) part[(C.wave * 8 + b) * 64 + C.lane] = acc[b];
            __syncthreads();
            { const int b = C.tid >> 6, ln = C.tid & 63; float s = P.ada_b[l * 6144 + cb * 64 + ln];
#pragma unroll
              for (int w = 0; w < 8; ++w) s += part[(w * 8 + b) * 64 + ln];
              MOD[(size_t)(l * 8 + b) * 6144 + cb * 64 + ln] = s; }
            __syncthreads();
        }
        __syncthreads();
    }
    {
        LAS float* scr = (LAS float*)(C.lds + C.wave * 16384);
        const int gw = C.vcu * NWAVES + C.wave, NGW = C.G * NWAVES;
        for (int it = gw; it < 6144; it += NGW) {
            int r = it;
            if (r < 1536) { p0_transpose_item(P.even_w_in, 1024, 3072, (bf16*)(P.ws + WS_WIN), scr, r, C.lane); continue; } r -= 1536;
            if (r < 512)  { p0_transpose_item(P.even_w_out, 1024, 1024, (bf16*)(P.ws + WS_WOUT0), scr, r, C.lane); continue; } r -= 512;
            if (r < 1536) { p0_transpose_item(P.odd_w_qkv, 1024, 3072, (bf16*)(P.ws + WS_WQKV), scr, r, C.lane); continue; } r -= 1536;
            if (r < 512)  { p0_transpose_item(P.odd_w_out, 1024, 1024, (bf16*)(P.ws + WS_WOUT1), scr, r, C.lane); continue; } r -= 512;
            if (r < 1024) { p0_transpose_item(P.peer_w_query, 1024, 2048, (bf16*)(P.ws + WS_WQ0), scr, r, C.lane); continue; } r -= 1024;
            p0_transpose_item(P.peer_w_query + (size_t)1024 * 2048, 1024, 2048, (bf16*)(P.ws + WS_WQ1), scr, r, C.lane);
        }
    }
    convert_tables(P, C);
    const int NT = C.G * 512, gt = C.vcu * 512 + C.tid;
    { bf16* skb = (bf16*)(P.ws + WS_SKB); for (int i = gt; i < 65536; i += NT) skb[i] = (bf16)f2bf(P.peer_sub_keys[i]); }
    { bf16* wsb = (bf16*)(P.ws + WS_WSB); for (int i = gt; i < 65536; i += NT) { const int t = (i >> 7) & 127, s = i & 127; wsb[i] = (bf16)(s <= t ? f2bf(P.gmlp_w_s[i]) : 0u); } }
    { float* lb = (float*)(P.ws + WS_LB); for (int i = gt; i < 512; i += NT) { const float l0 = P.hgrn_lb_logits[i], l1 = P.hgrn_lb_logits[512 + i]; lb[i] = 1.0f / (1.0f + expf(l1 - l0)); } }
    { float* cs = (float*)(P.ws + WS_CS); for (int i = gt; i < T * 8; i += NT) { const int tok = i >> 3, j = i & 7;
        const float inv = 1.0f / powf(500000.0f, (float)j * 0.125f); const float ang = (float)P.positions[tok] * inv; float sn, cn; sincosf(ang, &sn, &cn);
        cs[(size_t)tok * 16 + j] = cn; cs[(size_t)tok * 16 + 8 + j] = sn; } }
}
__device__ __forceinline__ void norm_row_bf16(const float* xrow, bf16* hrow, const float* g, const float* sh, const float* sc, int lane) {
    const f32x4* xr = (const f32x4*)xrow + lane; f32x4 v[4]; float s = 0.f;
#pragma unroll
    for (int j = 0; j < 4; ++j) { v[j] = xr[64 * j]; s += (v[j][0] * v[j][0] + v[j][1] * v[j][1]) + (v[j][2] * v[j][2] + v[j][3] * v[j][3]); }
    const float rstd = 1.0f / sqrtf(wave_sum(s) * (1.0f / 1024.0f) + NORM_EPS);
    unsigned long long* o8 = (unsigned long long*)hrow + lane;
#pragma unroll
    for (int j = 0; j < 4; ++j) { const f32x4 gg = ((const f32x4*)g)[64 * j + lane], hh = ((const f32x4*)sh)[64 * j + lane], cc = ((const f32x4*)sc)[64 * j + lane];
        const f32x4 y = (v[j] * rstd * gg) * (cc + 1.0f) + hh;
        o8[64 * j] = (unsigned long long)pk2(y[0], y[1]) | ((unsigned long long)pk2(y[2], y[3]) << 32); }
}
__device__ __forceinline__ void phase_norm(const Params& P, const Ctx& C, const Wk& W, const float* xsrc, const float* g, int l, int so) {
    const float* MOD = (const float*)(P.ws + WS_MOD); bf16* H = (bf16*)(P.ws + WS_H);
    const int gw = W.lv * NWAVES + C.wave, NGW = W.n * NWAVES;
    for (int m = W_TK0(W) + gw; m < W_TK0(W) + HT; m += NGW) { const float* mb = MOD + (size_t)(l * 8 + (m >> 13)) * 6144 + so;
        norm_row_bf16(xsrc + (size_t)m * 1024, H + (size_t)m * 1024, g, mb, mb + 1024, C.lane); }
}

__device__ __forceinline__ void gmlp_item(const Params& P, const Ctx& C, const Wk& W, int n, int g) {
    LAS bf16* Wt = (LAS bf16*)C.lds;
    LAS bf16* vT = (LAS bf16*)(C.lds + 34816);
    const bf16* WSB = (const bf16*)(P.ws + WS_WSB); const bf16* PU = w_tok16(P, W, AR_PU, 512); const bf16* PV = w_tok16(P, W, AR_PV, 512); bf16* MIX = (bf16*)(P.ws + WS_H);
    const int tid = C.tid, r = C.lane & 15, q4 = C.lane >> 4;
    for (int ch = tid; ch < 2048; ch += 512) { const int rr = ch >> 4, c8 = (ch & 15) * 8; *(LAS v4u*)(Wt + rr * 136 + c8) = *(const v4u*)(WSB + (size_t)(g * 128 + rr) * 128 + c8); }
    { const int t = tid >> 2, part = tid & 3; const bf16* src = PV + (size_t)(n * 128 + t) * 512 + g * 128 + part * 32;
      float x[32];
#pragma unroll
      for (int j = 0; j < 4; ++j) { const v4u w = *(const v4u*)(src + 8 * j);
#pragma unroll
          for (int e = 0; e < 4; ++e) { x[8 * j + 2 * e] = bflo(w[e]); x[8 * j + 2 * e + 1] = bfhi(w[e]); } }
      float s = 0.f;
#pragma unroll
      for (int j = 0; j < 32; ++j) s += x[j];
      s += __shfl_xor(s, 1); s += __shfl_xor(s, 2);
      const float mean = s * (1.0f / 128.0f); float q = 0.f;
#pragma unroll
      for (int j = 0; j < 32; ++j) { const float d = x[j] - mean; q += d * d; }
      q += __shfl_xor(q, 1); q += __shfl_xor(q, 2);
      const float rstd = 1.0f / sqrtf(q * (1.0f / 128.0f) + NORM_EPS);
      const float* lg = P.gmlp_ln_g + g * 128 + part * 32; const float* lbp = P.gmlp_ln_b + g * 128 + part * 32;
#pragma unroll
      for (int j = 0; j < 32; ++j) vT[(part * 32 + j) * 136 + t] = (bf16)f2bf((x[j] - mean) * rstd * lg[j] + lbp[j]);
    }
    __syncthreads();
    const int t0 = 16 * C.wave; const int Keff = ((t0 + 16 + 31) >> 5) << 5;
    f32x4 acc[8];
#pragma unroll
    for (int ct = 0; ct < 8; ++ct) { acc[ct] = (f32x4){0.f, 0.f, 0.f, 0.f}; acc[ct] = mma16(acc[ct], Wt + t0 * 136, 136, vT + (16 * ct) * 136, 136, Keff, r, q4); }
#pragma unroll
    for (int i = 0; i < 4; ++i) { const int t = t0 + 4 * q4 + i; const float bs = P.gmlp_b_s[g * 128 + t]; const size_t tok = (size_t)n * 128 + t;
#pragma unroll
        for (int ct = 0; ct < 8; ++ct) { const int c = 16 * ct + r; const float u = bf2f(PU[tok * 512 + g * 128 + c]); MIX[tok * 1024 + g * 128 + c] = (bf16)f2bf(u * (acc[ct][i] + bs)); } }
    __syncthreads();
}
__device__ __forceinline__ void hgrn_cumsum16(const float* G, size_t tok0, int hh, int k, int seg, LAS float* tot, float (&g)[16], float (&bb)[16], float& total) {
    const float* gp = G + (tok0 + seg * 16) * 512 + hh * 128 + k;
#pragma unroll
    for (int j = 0; j < 16; ++j) g[j] = gp[(size_t)j * 512];
    float run = 0.f;
#pragma unroll
    for (int j = 0; j < 16; ++j) { run += g[j]; bb[j] = run; }
    tot[seg * 128 + k] = run;
    __syncthreads();
    const float t0 = tot[k], t1 = tot[128 + k], t2 = tot[256 + k], t3 = tot[384 + k];
    const float pre = seg == 0 ? 0.f : seg == 1 ? t0 : seg == 2 ? t0 + t1 : t0 + t1 + t2;
    total = (t0 + t1) + (t2 + t3);
#pragma unroll
    for (int j = 0; j < 16; ++j) bb[j] += pre;
}
__device__ __forceinline__ void hgrn_stage_iT(const bf16* PI, size_t tok0, int hh, LAS bf16* iT, int tid) {
    const int s = tid >> 3, v0 = (tid & 7) * 16; const bf16* src = PI + (tok0 + s) * 512 + hh * 128 + v0;
#pragma unroll
    for (int h2 = 0; h2 < 2; ++h2) { const v4u w = *(const v4u*)(src + 8 * h2);
#pragma unroll
        for (int e = 0; e < 4; ++e) { iT[(v0 + 8 * h2 + 2 * e) * 72 + s] = (bf16)(w[e] & 0xffffu); iT[(v0 + 8 * h2 + 2 * e + 1) * 72 + s] = (bf16)(w[e] >> 16); } }
}
__device__ __forceinline__ void hgrn_local_item(const Params& P, const Ctx& C, const Wk& W, int item) {
    LAS bf16* khT = (LAS bf16*)C.lds;
    LAS bf16* iT = (LAS bf16*)(C.lds + 18432);
    LAS float* tot = (LAS float*)(C.lds + 36864);
    const float* G = w_tok32(P, W, AR_G, 512); const bf16* PI = w_tok16(P, W, AR_PI, 512); bf16* KVT = w_item16(P, W, AR_KVT); float* HD = (float*)(P.ws + WS_HD);
    const int bh = item >> 7, c = item & 127, b = bh >> 2, hh = bh & 3; const size_t tok0 = (size_t)b * SEQ + c * 64;
    const int tid = C.tid, k = tid & 127, seg = tid >> 7, r = C.lane & 15, q4 = C.lane >> 4;
    float g[16], bb[16], total;
    hgrn_cumsum16(G, tok0, hh, k, seg, tot, g, bb, total);
    { unsigned w[8];
#pragma unroll
      for (int j = 0; j < 8; ++j) { const float a0 = -expm1f(g[2 * j]) * __expf(total - bb[2 * j]), a1 = -expm1f(g[2 * j + 1]) * __expf(total - bb[2 * j + 1]); w[j] = pk2(a0, a1); }
      LAS v4u* dst = (LAS v4u*)(khT + k * 72 + seg * 16); dst[0] = (v4u){w[0], w[1], w[2], w[3]}; dst[1] = (v4u){w[4], w[5], w[6], w[7]}; }
    if (seg == 0) HD[(size_t)item * 128 + k] = __expf(total);
    hgrn_stage_iT(PI, tok0, hh, iT, tid);
    __syncthreads();
    const int v0 = 16 * C.wave;
#pragma unroll
    for (int ct = 0; ct < 8; ++ct) { f32x4 acc = (f32x4){0.f, 0.f, 0.f, 0.f}; acc = mma16(acc, iT + v0 * 72, 72, khT + (16 * ct) * 72, 72, 64, r, q4);
#pragma unroll
        for (int i = 0; i < 4; ++i) KVT[((size_t)item * 128 + v0 + 4 * q4 + i) * 128 + 16 * ct + r] = (bf16)f2bf(acc[i]); }
    __syncthreads();
}
__device__ __forceinline__ void phase_hgrn_scan(const Params& P, const Ctx& C, const Wk& W) {
    const bf16* KVT = w_item16(P, W, AR_KVT); bf16* ST = w_item16(P, W, AR_ST); const float* HD = (const float*)(P.ws + WS_HD);
    for (int task = W.lv * 256 + C.tid; C.tid < 256 && task < 32768; task += W.n * 256) {
        const int bh = W_BT0(W) * 4 + (task >> 11), v = (task >> 4) & 127, kb = task & 15;
        float st[8];
#pragma unroll
        for (int e = 0; e < 8; ++e) st[e] = 0.f;
#pragma unroll 4
        for (int c = 0; c < 128; ++c) { const size_t item = (size_t)bh * 128 + c, off = (item * 128 + v) * 128 + kb * 8;
            const v4u kv = *(const v4u*)(KVT + off); const f32x4 d0 = *(const f32x4*)(HD + item * 128 + kb * 8), d1 = *(const f32x4*)(HD + item * 128 + kb * 8 + 4);
            v4u o; o.x = pk2(st[0], st[1]); o.y = pk2(st[2], st[3]); o.z = pk2(st[4], st[5]); o.w = pk2(st[6], st[7]);
            *(v4u*)(ST + off) = o;
#pragma unroll
            for (int e = 0; e < 4; ++e) { st[2 * e] = (e < 2 ? d0[2 * e] : d1[2 * e - 4]) * st[2 * e] + bflo(kv[e]); st[2 * e + 1] = (e < 2 ? d0[2 * e + 1] : d1[2 * e - 3]) * st[2 * e + 1] + bfhi(kv[e]); }
        }
    }
}
__device__ __forceinline__ void hgrn_out_item(const Params& P, const Ctx& C, const Wk& W, int item) {
    LAS bf16* qt = (LAS bf16*)C.lds;
    LAS bf16* kt = (LAS bf16*)(C.lds + 17408);
    LAS bf16* iT = (LAS bf16*)(C.lds + 34816);
    LAS bf16* A1 = (LAS bf16*)(C.lds + 53248);
    LAS bf16* STl = (LAS bf16*)(C.lds + 62464);
    LAS float* ol = (LAS float*)(C.lds + 97280);
    LAS float* tot = (LAS float*)(C.lds + 131072);
    const float* G = w_tok32(P, W, AR_G, 512); const bf16* PQ = w_tok16(P, W, AR_PQ, 512); const bf16* PI = w_tok16(P, W, AR_PI, 512); const bf16* PG = w_tok16(P, W, AR_PG, 512);
    const bf16* ST = w_item16(P, W, AR_ST); bf16* MIX = (bf16*)(P.ws + WS_H);
    const int bh = item >> 7, c = item & 127, b = bh >> 2, hh = bh & 3; const size_t tok0 = (size_t)b * SEQ + c * 64;
    const int tid = C.tid, k = tid & 127, seg = tid >> 7, r = C.lane & 15, q4 = C.lane >> 4;
    float g[16], bb[16], total;
    hgrn_cumsum16(G, tok0, hh, k, seg, tot, g, bb, total);
#pragma unroll
    for (int j = 0; j < 16; ++j) { const int t = seg * 16 + j; const float qv = bf2f(PQ[(tok0 + t) * 512 + hh * 128 + k]);
        qt[t * 136 + k] = (bf16)f2bf(qv * __expf(bb[j])); kt[t * 136 + k] = (bf16)f2bf(-expm1f(g[j]) * __expf(-bb[j])); }
    hgrn_stage_iT(PI, tok0, hh, iT, tid);
    for (int ch = tid; ch < 2048; ch += 512) { const int rr = ch >> 4, c8 = (ch & 15) * 8; *(LAS v4u*)(STl + rr * 136 + c8) = *(const v4u*)(ST + ((size_t)item * 128 + rr) * 128 + c8); }
    __syncthreads();
    { const int rt = C.wave >> 1;
#pragma unroll
      for (int cc = 0; cc < 2; ++cc) { const int ct = (C.wave & 1) * 2 + cc; f32x4 acc = (f32x4){0.f, 0.f, 0.f, 0.f};
          acc = mma16(acc, qt + (16 * rt) * 136, 136, kt + (16 * ct) * 136, 136, 128, r, q4);
#pragma unroll
          for (int i = 0; i < 4; ++i) { const int t = 16 * rt + 4 * q4 + i, s = 16 * ct + r; A1[t * 72 + s] = (bf16)(s <= t ? f2bf(acc[i]) : 0u); } } }
    __syncthreads();
    { const int rt = C.wave >> 1;
#pragma unroll
      for (int cc = 0; cc < 4; ++cc) { const int ct = (C.wave & 1) * 4 + cc; f32x4 acc = (f32x4){0.f, 0.f, 0.f, 0.f};
          acc = mma16(acc, A1 + (16 * rt) * 72, 72, iT + (16 * ct) * 72, 72, 64, r, q4);
          acc = mma16(acc, qt + (16 * rt) * 136, 136, STl + (16 * ct) * 136, 136, 128, r, q4);
#pragma unroll
          for (int i = 0; i < 4; ++i) ol[(16 * rt + 4 * q4 + i) * 132 + 16 * ct + r] = acc[i]; } }
    __syncthreads();
    { const int t = tid >> 3, v0 = (tid & 7) * 16; float o[16]; float ss = 0.f;
#pragma unroll
      for (int e = 0; e < 16; ++e) { o[e] = ol[t * 132 + v0 + e]; ss += o[e] * o[e]; }
      ss += __shfl_xor(ss, 1); ss += __shfl_xor(ss, 2); ss += __shfl_xor(ss, 4);
      const float rstd = 1.0f / sqrtf(ss * (1.0f / 128.0f) + NORM_EPS);
      const float* ng = P.hgrn_norm_g + hh * 128 + v0; const bf16* gp = PG + (tok0 + t) * 512 + hh * 128 + v0;
      const v4u g0 = *(const v4u*)gp, g1 = *(const v4u*)(gp + 8); unsigned w[8];
#pragma unroll
      for (int e = 0; e < 4; ++e) { w[e] = pk2(o[2 * e] * rstd * ng[2 * e] * bflo(g0[e]), o[2 * e + 1] * rstd * ng[2 * e + 1] * bfhi(g0[e]));
                                    w[4 + e] = pk2(o[8 + 2 * e] * rstd * ng[8 + 2 * e] * bflo(g1[e]), o[9 + 2 * e] * rstd * ng[9 + 2 * e] * bfhi(g1[e])); }
      v4u* dst = (v4u*)(MIX + (tok0 + t) * 1024 + 512 + hh * 128 + v0); dst[0] = (v4u){w[0], w[1], w[2], w[3]}; dst[1] = (v4u){w[4], w[5], w[6], w[7]}; }
    __syncthreads();
}

typedef short v4i16_t __attribute__((ext_vector_type(4)));
constexpr int AT_VP = 144;
constexpr int AT_QI = 512;
constexpr int AT_STO = 0, AT_STML = AT_QI * 128, AT_VW = AT_STML + AT_QI * 8;
__device__ __forceinline__ void attn_softmax_block(f32x4 (&sa)[9], int tile0, int qq, int mq0, int q4, float& mx, float& ls, bf16x8 (&pf)[5]) {
    const int lo4 = (qq > 128 - mq0 ? qq : 128 - mq0) - 4 * q4, hi4 = qq + 128 - 4 * q4;
    mx = -1e30f;
#pragma unroll
    for (int t = 0; t < 9; ++t)
#pragma unroll
        for (int i = 0; i < 4; ++i) { const int K0 = 16 * (tile0 + t) + i; const bool ok = K0 >= lo4 && K0 <= hi4;
            sa[t][i] = ok ? sa[t][i] : -1e30f; mx = fmaxf(mx, sa[t][i]); }
    mx = fmaxf(mx, __shfl_xor(mx, 16)); mx = fmaxf(mx, __shfl_xor(mx, 32));
    ls = 0.f;
#pragma unroll
    for (int t = 0; t < 9; ++t)
#pragma unroll
        for (int i = 0; i < 4; ++i) { const float pv = __builtin_amdgcn_exp2f(sa[t][i] - mx); sa[t][i] = pv; ls += pv; }
    ls += __shfl_xor(ls, 16); ls += __shfl_xor(ls, 32);
#pragma unroll
    for (int s2 = 0; s2 < 5; ++s2) { const int tl = 2 * s2 - tile0, th = 2 * s2 + 1 - tile0;
        const f32x4 lo = (tl >= 0 && tl < 9) ? sa[(tl >= 0 && tl < 9) ? tl : 0] : (f32x4){0.f, 0.f, 0.f, 0.f}, hi = (th >= 0 && th < 9) ? sa[(th >= 0 && th < 9) ? th : 0] : (f32x4){0.f, 0.f, 0.f, 0.f};
        v4u w; w.x = pk2(lo[0], lo[1]); w.y = pk2(lo[2], lo[3]); w.z = pk2(hi[0], hi[1]); w.w = pk2(hi[2], hi[3]); pf[s2] = __builtin_bit_cast(bf16x8, w); }
}
__device__ __forceinline__ void attn_merge(int g, LAS unsigned char* lds, int qloc, int q4, f32x4 (&oa)[4], float mx, float ls, bf16* orow) {
    LAS unsigned char* so = lds + AT_STO + qloc * 128 + 8 * q4; LAS float* sml = (LAS float*)(lds + AT_STML) + 2 * qloc;
    float mo = mx, lo2 = ls;
    if (g > 0) { const float m_old = sml[0], l_old = sml[1]; const float M = fmaxf(m_old, mx); const float fo = __builtin_amdgcn_exp2f(m_old - M), fn = __builtin_amdgcn_exp2f(mx - M);
#pragma unroll
        for (int dt = 0; dt < 4; ++dt) { const unsigned long long w = *(const LAS unsigned long long*)(so + 32 * dt); const unsigned w0 = (unsigned)w, w1 = (unsigned)(w >> 32);
            oa[dt] = oa[dt] * fn + (f32x4){bflo(w0), bfhi(w0), bflo(w1), bfhi(w1)} * fo; }
        mo = M; lo2 = ls * fn + l_old * fo; }
    if (g < 2) {
#pragma unroll
        for (int dt = 0; dt < 4; ++dt) *(LAS unsigned long long*)(so + 32 * dt) = (unsigned long long)pk2(oa[dt][0], oa[dt][1]) | ((unsigned long long)pk2(oa[dt][2], oa[dt][3]) << 32);
        if (q4 == 0) { sml[0] = mo; sml[1] = lo2; }
    } else { const float inv = 1.0f / lo2;
#pragma unroll
        for (int dt = 0; dt < 4; ++dt) { const f32x4 v = oa[dt] * inv; *(unsigned long long*)(orow + 16 * dt) = (unsigned long long)pk2(v[0], v[1]) | ((unsigned long long)pk2(v[2], v[3]) << 32); } }
}
__device__ __forceinline__ void attn_item(const Params& P, const Ctx& C, const Wk& W, int b, int hd, int qt) {
    LAS unsigned char* Vw = C.lds + AT_VW + C.wave * (64 * AT_VP);
    const bf16* QKV = (const bf16*)(w_ar(P, W) + AR_QK); bf16* O = (bf16*)(P.ws + WS_H); const int bl = b - W_BT0(W);
    const int lane = C.lane, r = lane & 15, q4 = lane >> 4;
    const int t0 = qt * AT_QI; const size_t rowbase = (size_t)b * SEQ;
    const bf16* Qh = QKV + (size_t)((0 * 4 + bl) * 16 + hd) * QK_ROWS * 64; const bf16* Kb = QKV + (size_t)((1 * 4 + bl) * 16 + hd) * QK_ROWS * 64; const bf16* Vb = QKV + (size_t)((2 * 4 + bl) * 16 + hd) * QK_ROWS * 64;
#pragma unroll 1
    for (int g = 0; g < 3; ++g) {
        const int dsh = 4 - 2 * g, d = 1 << dsh;
#pragma unroll 1
        for (int uu = 0; uu < 2; ++uu) {
            const int u = C.wave + 8 * uu;
            const int c = u & (d - 1), j = u >> dsh;
            const int mq0 = (t0 >> dsh) + 32 * j;
            const int ql0 = c + d * (32 * j + r), ql1 = ql0 + 16 * d;
            const bf16* qp0 = Qh + (size_t)qk_row(t0 + ql0) * 64 + 8 * q4; const bf16* qp1 = Qh + (size_t)qk_row(t0 + ql1) * 64 + 8 * q4;
            const bf16x8 bq00 = *(const bf16x8*)qp0, bq01 = *(const bf16x8*)(qp0 + 32), bq10 = *(const bf16x8*)qp1, bq11 = *(const bf16x8*)(qp1 + 32);
            bf16x8 ka[10][2];
#pragma unroll
            for (int t = 0; t < 10; ++t) { int mk = mq0 - 128 + 16 * t + r; mk = mk < 0 ? 0 : mk;
                const unsigned ko = (unsigned)qk_row(c + (mk << dsh)) * 128u + 16u * q4; ka[t][0] = *(const bf16x8*)((const char*)Kb + ko); ka[t][1] = *(const bf16x8*)((const char*)Kb + ko + 64); }
            v4u vr[2][8];
#pragma unroll
            for (int it = 0; it < 8; ++it) { const int kap = 8 * it + (lane >> 3); int mk = mq0 - 128 + kap; mk = mk < 0 ? 0 : mk;
                vr[0][it] = *(const v4u*)((const char*)Vb + (unsigned)qk_row(c + (mk << dsh)) * 128u + (lane & 7) * 16u); }
            __builtin_amdgcn_sched_barrier(0);
            bf16x8 pf0[5], pf1[5]; float mx0, ls0, mx1, ls1;
            { f32x4 sa[9];
#pragma unroll
              for (int t = 0; t < 9; ++t) { sa[t] = (f32x4){0.f, 0.f, 0.f, 0.f}; sa[t] = __builtin_amdgcn_mfma_f32_16x16x32_bf16(ka[t][0], bq00, sa[t], 0, 0, 0); sa[t] = __builtin_amdgcn_mfma_f32_16x16x32_bf16(ka[t][1], bq01, sa[t], 0, 0, 0); }
              attn_softmax_block(sa, 0, r, mq0, q4, mx0, ls0, pf0); }
            { f32x4 sa[9];
#pragma unroll
              for (int t = 0; t < 9; ++t) { sa[t] = (f32x4){0.f, 0.f, 0.f, 0.f}; sa[t] = __builtin_amdgcn_mfma_f32_16x16x32_bf16(ka[t + 1][0], bq10, sa[t], 0, 0, 0); sa[t] = __builtin_amdgcn_mfma_f32_16x16x32_bf16(ka[t + 1][1], bq11, sa[t], 0, 0, 0); }
              __builtin_amdgcn_sched_barrier(0);
#pragma unroll
              for (int it = 0; it < 8; ++it) { const int kap = 64 + 8 * it + (lane >> 3); int mk = mq0 - 128 + kap; mk = mk < 0 ? 0 : mk;
                  vr[1][it] = *(const v4u*)((const char*)Vb + (unsigned)qk_row(c + (mk << dsh)) * 128u + (lane & 7) * 16u); }
              __builtin_amdgcn_sched_barrier(0);
              attn_softmax_block(sa, 1, 16 + r, mq0, q4, mx1, ls1, pf1); }
            v4u vr2[4];
#pragma unroll
            for (int it = 0; it < 4; ++it) { const int kap = 128 + 8 * it + (lane >> 3); const int mk = mq0 - 128 + kap;
                vr2[it] = *(const v4u*)((const char*)Vb + (unsigned)qk_row(c + (mk << dsh)) * 128u + (lane & 7) * 16u); }
            f32x4 oa0[4], oa1[4];
#pragma unroll
            for (int dt = 0; dt < 4; ++dt) { oa0[dt] = (f32x4){0.f, 0.f, 0.f, 0.f}; oa1[dt] = (f32x4){0.f, 0.f, 0.f, 0.f}; }
#pragma unroll
            for (int ch = 0; ch < 3; ++ch) {
#pragma unroll
                for (int it = 0; it < 8; ++it) { const int row = 8 * it + (lane >> 3);
                    if (ch < 2) *(LAS v4u*)(Vw + row * AT_VP + (lane & 7) * 16) = vr[ch < 2 ? ch : 0][it];
                    else if (it < 4) *(LAS v4u*)(Vw + row * AT_VP + (lane & 7) * 16) = vr2[it < 4 ? it : 0]; }
                asm volatile("s_waitcnt lgkmcnt(0)" ::: "memory");
#pragma unroll
                for (int s2 = 0; s2 < 2; ++s2) { const int sx = 2 * ch + s2; if (sx < 5) {
#pragma unroll
                    for (int dt = 0; dt < 4; ++dt) {
                        const LAS unsigned char* vp = Vw + (32 * s2 + 4 * q4 + (r >> 2)) * AT_VP + dt * 32 + (r & 3) * 8;
                        const v4i16_t x = __builtin_amdgcn_ds_read_tr16_b64_v4i16((LAS v4i16_t*)vp), y = __builtin_amdgcn_ds_read_tr16_b64_v4i16((LAS v4i16_t*)(vp + 16 * AT_VP));
                        const bf16x8 av = (bf16x8){x[0], x[1], x[2], x[3], y[0], y[1], y[2], y[3]};
                        oa0[dt] = __builtin_amdgcn_mfma_f32_16x16x32_bf16(av, pf0[sx], oa0[dt], 0, 0, 0);
                        oa1[dt] = __builtin_amdgcn_mfma_f32_16x16x32_bf16(av, pf1[sx], oa1[dt], 0, 0, 0); } } }
                asm volatile("s_waitcnt lgkmcnt(0)" ::: "memory");
            }
            attn_merge(g, C.lds, ql0, q4, oa0, mx0, ls0, O + (rowbase + t0 + ql0) * 1024 + hd * 64 + 4 * q4);
            attn_merge(g, C.lds, ql1, q4, oa1, mx1, ls1, O + (rowbase + t0 + ql1) * 1024 + hd * 64 + 4 * q4);
        }
        __syncthreads();
    }
}

__device__ __forceinline__ unsigned ordf(float s) { const unsigned u = __builtin_bit_cast(unsigned, s); return u ^ ((unsigned)((int)u >> 31) | 0x80000000u); }
__device__ __forceinline__ float unordf(unsigned v) { return __builtin_bit_cast(float, v ^ ((unsigned)((int)(~v) >> 31) | 0x80000000u)); }
__device__ __forceinline__ void ins16(unsigned (&top)[16], unsigned x) {
#pragma unroll
    for (int j = 0; j < 16; ++j) { const unsigned hi = top[j] > x ? top[j] : x; x = top[j] > x ? x : top[j]; top[j] = hi; }
}
#define CE_D(a, b) { const unsigned hi_ = (a) > (b) ? (a) : (b), lo_ = (a) > (b) ? (b) : (a); (a) = hi_; (b) = lo_; }
__device__ __forceinline__ void sort16_desc(unsigned (&v)[16]) {
#pragma unroll
    for (int k = 2; k <= 16; k <<= 1)
#pragma unroll
        for (int j = k >> 1; j > 0; j >>= 1)
#pragma unroll
            for (int i = 0; i < 16; ++i) { const int l = i ^ j; if (l > i) { if ((i & k) == 0) CE_D(v[i], v[l]) else CE_D(v[l], v[i]) } }
}
__device__ __forceinline__ void bitonic_merge16_desc(unsigned (&c)[16]) {
#pragma unroll
    for (int st = 8; st >= 1; st >>= 1)
#pragma unroll
        for (int j = 0; j < 16; ++j) if ((j & st) == 0) CE_D(c[j], c[j + st])
}
__device__ __forceinline__ void top16_of_two(unsigned (&a)[16], const unsigned (&b)[16]) {
#pragma unroll
    for (int j = 0; j < 16; ++j) a[j] = a[j] > b[15 - j] ? a[j] : b[15 - j];
    bitonic_merge16_desc(a);
}
__device__ __forceinline__ void merge16(unsigned (&top)[16], int mask) {
    unsigned o[16];
#pragma unroll
    for (int j = 0; j < 16; ++j) o[j] = (unsigned)__shfl_xor((int)top[j], mask);
    top16_of_two(top, o);
}
__device__ __forceinline__ void phase_peer_topk(const Params& P, const Ctx& C, const Wk& W, int layer) {
    LAS bf16* SK = (LAS bf16*)C.lds;
    const bf16* SKB = (const bf16*)(P.ws + WS_SKB) + (size_t)layer * 32768; const bf16* QP = w_tok16(P, W, AR_QP, 2048);
    int* IDX = (int*)(P.ws + WS_IDX); float* GATE = (float*)(P.ws + WS_GATE);
    for (int ch = C.tid; ch < 4096; ch += 512) { const int rr = ch >> 4, c8 = (ch & 15) * 8; *(LAS v4u*)(SK + rr * 136 + c8) = *(const v4u*)(SKB + (size_t)rr * 128 + c8); }
    __syncthreads();
    const int r = C.lane & 15, q4 = C.lane >> 4;
    const int gw = W.lv * NWAVES + C.wave, NGW = W.n * NWAVES;
    for (int grp = W_TK0(W) / 2 + gw; grp < W_TK0(W) / 2 + HT * 8 / 16; grp += NGW) {
        const size_t task = (size_t)grp * 16 + r;
        unsigned lst[2][16];
#pragma unroll
        for (int half = 0; half < 2; ++half) {
            bf16x8 bq[4];
#pragma unroll
            for (int ks = 0; ks < 4; ++ks) bq[ks] = *(const bf16x8*)(QP + task * 256 + half * 128 + ks * 32 + 8 * q4);
            unsigned ka[16], kb[16];
#pragma unroll
            for (int nt = 0; nt < 8; ++nt) { f32x4 acc = (f32x4){0.f, 0.f, 0.f, 0.f};
#pragma unroll
                for (int ks = 0; ks < 4; ++ks) { const bf16x8 a = *(const LAS bf16x8*)(SK + (half * 128 + 16 * nt + r) * 136 + ks * 32 + 8 * q4); acc = __builtin_amdgcn_mfma_f32_16x16x32_bf16(a, bq[ks], acc, 0, 0, 0); }
#pragma unroll
                for (int i = 0; i < 4; ++i) { const unsigned n = 16 * nt + 4 * q4 + i; const unsigned key = (ordf(acc[i]) & ~127u) | (127u - n); if (nt < 4) ka[4 * nt + i] = key; else kb[4 * (nt - 4) + i] = key; }
                if (nt == 3) sort16_desc(ka);
                __builtin_amdgcn_sched_barrier(0); }
            sort16_desc(kb); top16_of_two(ka, kb);
            merge16(ka, 16); merge16(ka, 32);
#pragma unroll
            for (int j = 0; j < 16; ++j) lst[half][j] = ka[j];
        }
        float v2[16]; unsigned e2[16];
#pragma unroll
        for (int j = 0; j < 16; ++j) { v2[j] = unordf(lst[1][j] & ~127u); e2[j] = 127u - (lst[1][j] & 127u); }
        float v1s[4]; unsigned e1s[4];
#pragma unroll
        for (int k = 0; k < 4; ++k) { const unsigned w = q4 == 0 ? lst[0][4 * k] : q4 == 1 ? lst[0][4 * k + 1] : q4 == 2 ? lst[0][4 * k + 2] : lst[0][4 * k + 3];
            v1s[k] = unordf(w & ~127u); e1s[k] = (127u - (w & 127u)) << 7; }
        unsigned top[16];
#pragma unroll
        for (int j = 0; j < 16; ++j) top[j] = (ordf(v1s[0] + v2[j]) & ~16383u) | e1s[0] | e2[j];
        sort16_desc(top);
#pragma unroll
        for (int j = 0; j < 3; ++j) ins16(top, (ordf(v1s[1] + v2[j]) & ~16383u) | e1s[1] | e2[j]);
        ins16(top, (ordf(v1s[2] + v2[0]) & ~16383u) | e1s[2] | e2[0]);
        ins16(top, (ordf(v1s[3] + v2[0]) & ~16383u) | e1s[3] | e2[0]);
        merge16(top, 16); merge16(top, 32);
        float ev[16]; float den = 0.f; const float mx = unordf(top[0] & ~16383u);
#pragma unroll
        for (int j = 0; j < 16; ++j) { ev[j] = __expf(unordf(top[j] & ~16383u) - mx); den += ev[j]; }
        const float inv = 1.0f / den;
        int* ip = IDX + task * 16; float* gp = GATE + task * 16;
        if (q4 == 0) { *(v4u*)(ip) = (v4u){top[0] & 16383u, top[1] & 16383u, top[2] & 16383u, top[3] & 16383u}; *(f32x4*)(gp) = (f32x4){ev[0] * inv, ev[1] * inv, ev[2] * inv, ev[3] * inv}; }
        else if (q4 == 1) { *(v4u*)(ip + 4) = (v4u){top[4] & 16383u, top[5] & 16383u, top[6] & 16383u, top[7] & 16383u}; *(f32x4*)(gp + 4) = (f32x4){ev[4] * inv, ev[5] * inv, ev[6] * inv, ev[7] * inv}; }
        else if (q4 == 2) { *(v4u*)(ip + 8) = (v4u){top[8] & 16383u, top[9] & 16383u, top[10] & 16383u, top[11] & 16383u}; *(f32x4*)(gp + 8) = (f32x4){ev[8] * inv, ev[9] * inv, ev[10] * inv, ev[11] * inv}; }
        else { *(v4u*)(ip + 12) = (v4u){top[12] & 16383u, top[13] & 16383u, top[14] & 16383u, top[15] & 16383u}; *(f32x4*)(gp + 12) = (f32x4){ev[12] * inv, ev[13] * inv, ev[14] * inv, ev[15] * inv}; }
    }
}
#ifndef EXP_LA
#define EXP_LA 7
#endif
typedef unsigned v2u __attribute__((ext_vector_type(2)));
struct ExpRow { v6u lo, hi; };
__device__ __forceinline__ void exp_issue(ExpRow& R, const unsigned char* T, int ex, int jl) {
    const unsigned oA = (unsigned)ex * (unsigned)TROW + 16u * (unsigned)jl, oB = (unsigned)ex * (unsigned)TROW + 512u + 8u * (unsigned)jl;
    const v4u loA = *(const v4u*)(T + oA), hiA = *(const v4u*)(T + oA + 256); const v2u loB = *(const v2u*)(T + oB), hiB = *(const v2u*)(T + oB + 128);
    R.lo = (v6u){loA.x, loA.y, loA.z, loA.w, loB.x, loB.y}; R.hi = (v6u){hiA.x, hiA.y, hiA.z, hiA.w, hiB.x, hiB.y};
}
__device__ __forceinline__ float exp_down(const ExpRow& R, const f32x2 (&hq)[32]) {
    f32x2 a2 = (f32x2){0.f, 0.f}, b2 = (f32x2){0.f, 0.f};
    { const f32x32v f = __builtin_amdgcn_cvt_scalef32_pk32_f32_fp6(R.lo, 1.0f);
#pragma unroll
      for (int p = 0; p < 16; p += 2) { a2 = a2 + (f32x2){f[2 * p], f[2 * p + 1]} * hq[p]; b2 = b2 + (f32x2){f[2 * p + 2], f[2 * p + 3]} * hq[p + 1]; } }
    { const f32x32v f = __builtin_amdgcn_cvt_scalef32_pk32_f32_fp6(R.hi, 1.0f);
#pragma unroll
      for (int p = 0; p < 16; p += 2) { a2 = a2 + (f32x2){f[2 * p], f[2 * p + 1]} * hq[16 + p]; b2 = b2 + (f32x2){f[2 * p + 2], f[2 * p + 3]} * hq[16 + p + 1]; } }
    a2 = a2 + b2;
    float a = a2.x + a2.y; asm volatile("" : "+v"(a));
    return a;
}
__device__ __forceinline__ void exp_up(const ExpRow& R, float wk, f32x2 (&oacc)[32]) {
    const f32x2 wk2 = (f32x2){wk, wk};
    { const f32x32v f = __builtin_amdgcn_cvt_scalef32_pk32_f32_fp6(R.lo, 1.0f);
#pragma unroll
      for (int p = 0; p < 16; ++p) oacc[p] = oacc[p] + wk2 * (f32x2){f[2 * p], f[2 * p + 1]}; }
    { const f32x32v f = __builtin_amdgcn_cvt_scalef32_pk32_f32_fp6(R.hi, 1.0f);
#pragma unroll
      for (int p = 0; p < 16; ++p) oacc[16 + p] = oacc[16 + p] + wk2 * (f32x2){f[2 * p], f[2 * p + 1]}; }
    asm volatile("" : "+v"(oacc[0]), "+v"(oacc[1]), "+v"(oacc[2]), "+v"(oacc[3]), "+v"(oacc[4]), "+v"(oacc[5]), "+v"(oacc[6]), "+v"(oacc[7]),
                      "+v"(oacc[8]), "+v"(oacc[9]), "+v"(oacc[10]), "+v"(oacc[11]), "+v"(oacc[12]), "+v"(oacc[13]), "+v"(oacc[14]), "+v"(oacc[15]));
    asm volatile("" : "+v"(oacc[16]), "+v"(oacc[17]), "+v"(oacc[18]), "+v"(oacc[19]), "+v"(oacc[20]), "+v"(oacc[21]), "+v"(oacc[22]), "+v"(oacc[23]),
                      "+v"(oacc[24]), "+v"(oacc[25]), "+v"(oacc[26]), "+v"(oacc[27]), "+v"(oacc[28]), "+v"(oacc[29]), "+v"(oacc[30]), "+v"(oacc[31]));
}
__device__ __forceinline__ float exp_rs(float a, float b, int mask, bool hi) { const float keep = hi ? b : a, send = hi ? a : b; return keep + __shfl_xor(send, mask); }
__device__ __forceinline__ void phase_peer_experts(const Params& P, const Ctx& Cin, const Wk& W, int layer, bool last) {
    const Ctx C = fresh_ctx(Cin);
    const unsigned char* TD = P.ws + WS_TAB8 + (size_t)(2 * layer) * TAB8_BYTES; const unsigned char* TU = P.ws + WS_TAB8 + (size_t)(2 * layer + 1) * TAB8_BYTES; const float* SD = (const float*)(P.ws + WS_SC8) + (size_t)(2 * layer) * 16384; bf16* H = (bf16*)(P.ws + WS_H);
    const int* IDX = (const int*)(P.ws + WS_IDX); const float* GATE = (const float*)(P.ws + WS_GATE); const float* MOD = (const float*)(P.ws + WS_MOD);
    const int lane = C.lane, grp = lane >> 4, jl = lane & 15;
    unsigned* ticket = (unsigned*)(P.ws + WS_CTL) + 96 + 2 * layer + W.h;
    const bool dyn = W.n != C.G;
    const int gws = W.lv * NWAVES + C.wave, NGWS = W.n * NWAVES;
    int tnext = gws; if (dyn) { if (lane == 0) tnext = (int)atomicAdd(ticket, 1u); tnext = __builtin_amdgcn_readfirstlane(tnext); }
    while (tnext < HT) {
        const int tok = W_TK0(W) + tnext;
        if (dyn) { int tn = 0; if (lane == 0) tn = (int)atomicAdd(ticket, 1u); tnext = tn; } else tnext += NGWS;
        const int b = tok >> 13;
        const int i0 = IDX[(size_t)tok * 128 + lane], i1 = IDX[(size_t)tok * 128 + 64 + lane];
        const float g0 = GATE[(size_t)tok * 128 + lane], g1 = GATE[(size_t)tok * 128 + 64 + lane];
        f32x2 hq[32];
#pragma unroll
        for (int c = 0; c < 8; ++c) { const v4u w0 = *(const v4u*)(H + (size_t)tok * 1024 + 64 * jl + 8 * c);
#pragma unroll
            for (int e = 0; e < 4; ++e) hq[c * 4 + e] = (f32x2){bflo(w0[e]), bfhi(w0[e])}; }
#define SB __builtin_amdgcn_sched_barrier(0);
#define EXP_ISSUE(R, GS) { const int gs_ = (GS); const int src_ = (gs_ & 16) ? i1 : i0; exp_issue(R, (gs_ & 32) ? TU : TD, __shfl(src_, (grp << 4) | (gs_ & 15)), jl); }
        ExpRow R0, R1, R2, R3, R4, R5, R6, R7;
#define RS_(k) R##k
#define RSLOT(k) RS_(k)
#define ISS(S) EXP_ISSUE(RSLOT(EXP_SL(S)), g8 + (S) + EXP_LA)
#if EXP_LA == 5
#define EXP_SL(S) EXP_SL5_##S
#define EXP_SL5_0 5
#define EXP_SL5_1 6
#define EXP_SL5_2 7
#define EXP_SL5_3 0
#define EXP_SL5_4 1
#define EXP_SL5_5 2
#define EXP_SL5_6 3
#define EXP_SL5_7 4
        EXP_ISSUE(R0, 0) EXP_ISSUE(R1, 1) EXP_ISSUE(R2, 2) EXP_ISSUE(R3, 3) EXP_ISSUE(R4, 4) SB
#elif EXP_LA == 6
#define EXP_SL(S) EXP_SL6_##S
#define EXP_SL6_0 6
#define EXP_SL6_1 7
#define EXP_SL6_2 0
#define EXP_SL6_3 1
#define EXP_SL6_4 2
#define EXP_SL6_5 3
#define EXP_SL6_6 4
#define EXP_SL6_7 5
        EXP_ISSUE(R0, 0) EXP_ISSUE(R1, 1) EXP_ISSUE(R2, 2) EXP_ISSUE(R3, 3) EXP_ISSUE(R4, 4) EXP_ISSUE(R5, 5) SB
#elif EXP_LA == 4
#define EXP_SL(S) EXP_SL4_##S
#define EXP_SL4_0 4
#define EXP_SL4_1 5
#define EXP_SL4_2 6
#define EXP_SL4_3 7
#define EXP_SL4_4 0
#define EXP_SL4_5 1
#define EXP_SL4_6 2
#define EXP_SL4_7 3
        EXP_ISSUE(R0, 0) EXP_ISSUE(R1, 1) EXP_ISSUE(R2, 2) EXP_ISSUE(R3, 3) SB
#else
#define EXP_SL(S) EXP_SL7_##S
#define EXP_SL7_0 7
#define EXP_SL7_1 0
#define EXP_SL7_2 1
#define EXP_SL7_3 2
#define EXP_SL7_4 3
#define EXP_SL7_5 4
#define EXP_SL7_6 5
#define EXP_SL7_7 6
        EXP_ISSUE(R0, 0) EXP_ISSUE(R1, 1) EXP_ISSUE(R2, 2) EXP_ISSUE(R3, 3) EXP_ISSUE(R4, 4) EXP_ISSUE(R5, 5) EXP_ISSUE(R6, 6) SB
#endif
        const float sd0 = SD[(unsigned)i0], sd1 = SD[(unsigned)i1], su0 = SD[16384u + (unsigned)i0], su1 = SD[16384u + (unsigned)i1];
        float U0 = 0.f, U1 = 0.f, tprev = 0.f;
        const bool j1 = (jl & 1) != 0, j2 = (jl & 2) != 0, j4 = (jl & 4) != 0, j8 = (jl & 8) != 0;
#pragma unroll 1
        for (int it = 0; it < 4; ++it) {
            const int g8 = 8 * it;
            ISS(0) SB const float p0 = exp_down(R0, hq); SB
            ISS(1) SB const float p1 = exp_down(R1, hq); SB
            const float q0 = exp_rs(p0, p1, 1, j1);
            ISS(2) SB const float p2 = exp_down(R2, hq); SB
            ISS(3) SB const float p3 = exp_down(R3, hq); SB
            const float q1 = exp_rs(p2, p3, 1, j1); const float r0 = exp_rs(q0, q1, 2, j2);
            ISS(4) SB const float p4 = exp_down(R4, hq); SB
            ISS(5) SB const float p5 = exp_down(R5, hq); SB
            const float q2 = exp_rs(p4, p5, 1, j1);
            ISS(6) SB const float p6 = exp_down(R6, hq); SB
            ISS(7) SB const float p7 = exp_down(R7, hq); SB
            const float q3 = exp_rs(p6, p7, 1, j1); const float r1 = exp_rs(q2, q3, 2, j2); const float t = exp_rs(r0, r1, 4, j4);
            if (it & 1) { const float u = exp_rs(tprev, t, 8, j8); if (it == 1) U0 = u; else U1 = u; } else tprev = t;
        }
        const float wk0 = g0 * gelu_f(U0 * sd0) * su0, wk1 = g1 * gelu_f(U1 * sd1) * su1;
        f32x2 oacc[32];
#pragma unroll
        for (int e = 0; e < 32; ++e) oacc[e] = (f32x2){0.f, 0.f};
#define EXP_WK(GS) __shfl(((GS) & 16) ? wk1 : wk0, (grp << 4) | ((GS) & 15))
#define ISC(S) if ((S) + EXP_LA < 8 || it < 7) { ISS(S) }
#pragma unroll 1
        for (int it = 4; it < 8; ++it) {
            const int g8 = 8 * it;
            ISC(0) SB exp_up(R0, EXP_WK(g8), oacc); SB
            ISC(1) SB exp_up(R1, EXP_WK(g8 + 1), oacc); SB
            ISC(2) SB exp_up(R2, EXP_WK(g8 + 2), oacc); SB
            ISC(3) SB exp_up(R3, EXP_WK(g8 + 3), oacc); SB
            ISC(4) SB exp_up(R4, EXP_WK(g8 + 4), oacc); SB
            ISC(5) SB exp_up(R5, EXP_WK(g8 + 5), oacc); SB
            ISC(6) SB exp_up(R6, EXP_WK(g8 + 6), oacc); SB
            ISC(7) SB exp_up(R7, EXP_WK(g8 + 7), oacc); SB
        }
#undef ISC
#undef ISS
#undef EXP_WK
#undef EXP_ISSUE
#undef SB
        f32x2 h1[16];
        { const bool up = (grp & 2) != 0;
#pragma unroll
          for (int e = 0; e < 16; ++e) { const f32x2 keep = up ? oacc[16 + e] : oacc[e], send = up ? oacc[e] : oacc[16 + e]; h1[e] = keep + (f32x2){__shfl_xor(send.x, 32), __shfl_xor(send.y, 32)}; } }
        f32x2 h2[8];
        { const bool up = (grp & 1) != 0;
#pragma unroll
          for (int e = 0; e < 8; ++e) { const f32x2 keep = up ? h1[8 + e] : h1[e], send = up ? h1[e] : h1[8 + e]; h2[e] = keep + (f32x2){__shfl_xor(send.x, 16), __shfl_xor(send.y, 16)}; } }
        const int d0 = 64 * jl + 16 * grp;
        const float* g2p = MOD + (size_t)(layer * 8 + b) * 6144 + 5120 + d0; const float psc = ((ABL_ON >= (layer == 0 ? 2 : 4)) ? 1.f : 0.f) * (1.0f / EXP_REP);
        float* xp = P.out + (size_t)tok * 1024 + d0;
        float xn[16]; float ss = 0.f;
#pragma unroll
        for (int q = 0; q < 4; ++q) { const f32x4 xa = *(const f32x4*)(xp + 4 * q), ga = *(const f32x4*)(g2p + 4 * q);
            xn[4 * q] = xa[0] + psc * ga[0] * h2[2 * q].x; xn[4 * q + 1] = xa[1] + psc * ga[1] * h2[2 * q].y; xn[4 * q + 2] = xa[2] + psc * ga[2] * h2[2 * q + 1].x; xn[4 * q + 3] = xa[3] + psc * ga[3] * h2[2 * q + 1].y; }
#pragma unroll
        for (int e = 0; e < 16; ++e) ss += xn[e] * xn[e];
        const float rstd = 1.0f / sqrtf(wave_sum(ss) * (1.0f / 1024.0f) + NORM_EPS);
        if (!last) {
            const float* ng = P.norm_mix_g + (layer + 1) * 1024 + d0; const float* mb = MOD + (size_t)((layer + 1) * 8 + b) * 6144 + d0;
            unsigned w[8];
#pragma unroll
            for (int q = 0; q < 4; ++q) { *(f32x4*)(xp + 4 * q) = (f32x4){xn[4 * q], xn[4 * q + 1], xn[4 * q + 2], xn[4 * q + 3]}; }
#pragma unroll
            for (int e = 0; e < 8; ++e) w[e] = pk2(xn[2 * e] * rstd * ng[2 * e] * (1.0f + mb[1024 + 2 * e]) + mb[2 * e], xn[2 * e + 1] * rstd * ng[2 * e + 1] * (1.0f + mb[1024 + 2 * e + 1]) + mb[2 * e + 1]);
            v4u* hp = (v4u*)(H + (size_t)tok * 1024 + d0); hp[0] = (v4u){w[0], w[1], w[2], w[3]}; hp[1] = (v4u){w[4], w[5], w[6], w[7]};
        } else {
            const float* fg = P.final_norm_g + d0;
#pragma unroll
            for (int q = 0; q < 4; ++q) *(f32x4*)(xp + 4 * q) = (f32x4){xn[4 * q] * rstd * fg[4 * q], xn[4 * q + 1] * rstd * fg[4 * q + 1], xn[4 * q + 2] * rstd * fg[4 * q + 2], xn[4 * q + 3] * rstd * fg[4 * q + 3]};
        }
        if (dyn) tnext = __builtin_amdgcn_readfirstlane(tnext);
    }
}

#ifndef NC_PER_XCD
#define NC_PER_XCD 16
#endif
#ifdef PROBE_SEL
#define SUBSTAMP(i) do { if (W.c == 0 && C.tid == 0) __hip_atomic_store((unsigned*)(P.ws + WS_CTL) + 128 + 16 * W.h + (i), (unsigned)__builtin_amdgcn_s_memrealtime(), __ATOMIC_RELAXED, __HIP_MEMORY_SCOPE_AGENT); } while (0)
#else
#define SUBSTAMP(i) do {} while (0)
#endif
__device__ __forceinline__ void run_C0(const Params& P, const Ctx& Cin, const Wk& W, const XcdBarrier& tb) {
    const Ctx C = fresh_ctx(Cin);
    SUBSTAMP(0);
    unsigned char* ws = P.ws; float* MOD = (float*)(ws + WS_MOD); bf16* H = (bf16*)(ws + WS_H);
    const size_t tk = (size_t)W_TK0(W); unsigned char* const ar = w_ar(P, W);
    phase_norm(P, C, W, P.x, P.norm_mix_g, 0, 0); xcd_barrier(tb); SUBSTAMP(1);
    { pg8::Gemm g{H + tk * 1024, (const bf16*)(ws + WS_WIN), HT, 3072, 1024}; pg8::StaticOrder S; S.init(HT, 3072, W.n, W.c);
      EpiInProj E{(bf16*)(ar + AR_PU), (bf16*)(ar + AR_PV), (bf16*)(ar + AR_PQ), (bf16*)(ar + AR_PI), (bf16*)(ar + AR_PG), (float*)(ar + AR_G), (const float*)(ws + WS_LB)};
      pg8::gemm_phase<EpiInProj, pg8::StaticOrder, true, true>(C.lds, g, S, E); } xcd_barrier(tb); SUBSTAMP(2);
    for (int it = W.lv; it < 1024; it += W.n) gmlp_item(P, C, W, W_TK0(W) / 128 + (it >> 2), it & 3);
    for (int it = W.lv; it < 2048; it += W.n) hgrn_local_item(P, C, W, W_BT0(W) * 512 + it);
    xcd_barrier(tb); SUBSTAMP(3);
    phase_hgrn_scan(P, C, W); xcd_barrier(tb); SUBSTAMP(4);
    for (int it = W.lv; it < 2048; it += W.n) hgrn_out_item(P, C, W, W_BT0(W) * 512 + it);
    xcd_barrier(tb); SUBSTAMP(5);
    { pg8::Gemm g{H + tk * 1024, (const bf16*)(ws + WS_WOUT0), HT, 1024, 1024}; pg8::StaticOrder S; S.init(HT, 1024, W.n, W.c);
      EpiResid E{P.x + tk * 1024, P.out + tk * 1024, MOD + 2048 + (size_t)W_BT0(W) * 6144, 1.f};
      pg8::gemm_phase<EpiResid, pg8::StaticOrder, true, true>(C.lds, g, S, E); } xcd_barrier(tb); SUBSTAMP(6);
    phase_norm(P, C, W, P.out, P.norm_ffn_g, 0, 3072); xcd_barrier(tb); SUBSTAMP(7);
    { pg8::Gemm g{H + tk * 1024, (const bf16*)(ws + WS_WQ0), HT, 2048, 1024}; pg8::StaticOrder S; S.init(HT, 2048, W.n, W.c);
      EpiBf16P E{(bf16*)(ar + AR_QP), 2048};
      pg8::gemm_phase<EpiBf16P, pg8::StaticOrder, true, true>(C.lds, g, S, E); }
    SUBSTAMP(9);
}
__device__ __forceinline__ void run_C1(const Params& P, const Ctx& Cin, const Wk& W, const XcdBarrier& tb) {
    const Ctx C = fresh_ctx(Cin);
    SUBSTAMP(0);
    unsigned char* ws = P.ws; float* MOD = (float*)(ws + WS_MOD); bf16* H = (bf16*)(ws + WS_H);
    const size_t tk = (size_t)W_TK0(W); unsigned char* const ar = w_ar(P, W);
    { pg8::Gemm g{H + tk * 1024, (const bf16*)(ws + WS_WQKV), HT, 3072, 1024}; pg8::StaticOrder S; S.init(HT, 3072, W.n, W.c);
      EpiQKRot E{(bf16*)(ar + AR_QK), (const float*)(ws + WS_CS) + tk * 16};
      pg8::gemm_phase<EpiQKRot, pg8::StaticOrder, true, true>(C.lds, g, S, E); } xcd_barrier(tb); SUBSTAMP(1);
    for (int it = W.lv; it < (NB / 2) * 16 * 16; it += W.n) attn_item(P, C, W, W_BT0(W) + (it >> 8), (it >> 4) & 15, it & 15);
    xcd_barrier(tb); SUBSTAMP(2);
    { pg8::Gemm g{H + tk * 1024, (const bf16*)(ws + WS_WOUT1), HT, 1024, 1024}; pg8::StaticOrder S; S.init(HT, 1024, W.n, W.c);
      EpiResid E{P.out + tk * 1024, P.out + tk * 1024, MOD + (size_t)8 * 6144 + 2048 + (size_t)W_BT0(W) * 6144, 1.f};
      pg8::gemm_phase<EpiResid, pg8::StaticOrder, true, true>(C.lds, g, S, E); } xcd_barrier(tb); SUBSTAMP(3);
    phase_norm(P, C, W, P.out, P.norm_ffn_g + 1024, 1, 3072); xcd_barrier(tb); SUBSTAMP(4);
    { pg8::Gemm g{H + tk * 1024, (const bf16*)(ws + WS_WQ1), HT, 2048, 1024}; pg8::StaticOrder S; S.init(HT, 2048, W.n, W.c);
      EpiBf16P E{(bf16*)(ar + AR_QP), 2048};
      pg8::gemm_phase<EpiBf16P, pg8::StaticOrder, true, true>(C.lds, g, S, E); }
    SUBSTAMP(9);
}
__device__ __forceinline__ void run_E(const Params& P, const Ctx& Cin, const Wk& W, const XcdBarrier& tb, int layer) {
    { const Ctx C = fresh_ctx(Cin); phase_peer_topk(P, C, W, layer); }
    xcd_barrier(tb);
    if (W.c == 0 && Cin.tid == 0) __hip_atomic_store((unsigned*)(P.ws + WS_CTL) + 112 + 2 * layer + W.h, 1u, __ATOMIC_RELAXED, __HIP_MEMORY_SCOPE_AGENT);
    phase_peer_experts(P, Cin, W, layer, layer == 1);
}
__device__ __forceinline__ void help_E(const Params& P, const Ctx& Cin, int h, int layer) {
    volatile LAS unsigned* okw = (volatile LAS unsigned*)(Cin.lds + LDSCTL_OFF + 192);
    if (Cin.tid == 0) { unsigned* flag = (unsigned*)(P.ws + WS_CTL) + 112 + 2 * layer + h; unsigned ok = 0u;
        for (unsigned sp = 0; sp < (1u << 16); ++sp) { if (__hip_atomic_load(flag, __ATOMIC_RELAXED, __HIP_MEMORY_SCOPE_AGENT) != 0u) { ok = 1u; break; } __builtin_amdgcn_s_sleep(8); }
        __builtin_amdgcn_fence(__ATOMIC_ACQUIRE, "agent"); asm volatile("s_waitcnt vmcnt(0)" ::: "memory");
        *okw = ok; }
    __syncthreads();
    const bool ok = *okw != 0u;
    __syncthreads();
    if (ok) { Wk W; W.lv = 0; W.n = 1; W.c = 1; W.h = h; phase_peer_experts(P, Cin, W, layer, layer == 1); }
}
__global__ void __launch_bounds__(NWAVES * 64, 2) hybrid_fwd(Params P) {
    extern __shared__ __attribute__((aligned(16))) unsigned char lds_raw[];
    Ctx C;
    C.lds = (LAS unsigned char*)lds_raw;
    C.tid = threadIdx.x; C.lane = C.tid & 63; C.wave = __builtin_amdgcn_readfirstlane(C.tid >> 6);
    C.G = gridDim.x; const int bx = blockIdx.x; C.vcu = (bx % 8) * (C.G / 8) + bx / 8;
    volatile LAS unsigned* MISC = (volatile LAS unsigned*)(C.lds + MISC_OFF);
    for (int u = C.tid; u < (LDS_BYTES - LDSCTL_OFF) / 4; u += NWAVES * 64) ((LAS unsigned*)(C.lds + LDSCTL_OFF))[u] = 0u;
    __syncthreads();
    unsigned* ctl = (unsigned*)(P.ws + WS_CTL);
    const int xl = bx & 7, jx = bx >> 3, perx = C.G / 8;
    const bool inC = jx < NC_PER_XCD;
    const int nC = 8 * NC_PER_XCD, nE = C.G - nC;
    const XcdBarrier bar_all = xcd_barrier_post(ctl + CW_BAR, MISC + 8);
    XcdBarrier bar_c; bar_c.bar = ctl + CW_BAR + XCD_BAR_WORDS; bar_c.x = bar_all.x; bar_c.st = MISC + 10; bar_c.G = (unsigned)nC;
    if (inC && C.tid == 0) (void)xb_add(&bar_c.bar[XB_XCNT(bar_c.x)], 1u);
    XcdBarrier bar_e; bar_e.bar = ctl + CW_BAR + 2 * XCD_BAR_WORDS; bar_e.x = bar_all.x; bar_e.st = MISC + 12; bar_e.G = (unsigned)nE;
    if (!inC && C.tid == 0) (void)xb_add(&bar_e.bar[XB_XCNT(bar_e.x)], 1u);
    Wk Wall; Wall.lv = C.vcu; Wall.n = C.G; Wall.c = bx; Wall.h = 0;
    Wk Wc; Wc.lv = xl * NC_PER_XCD + jx; Wc.n = nC; Wc.c = jx * 8 + xl; Wc.h = 0;
    Wk We; { const int je = jx - NC_PER_XCD, ne = perx - NC_PER_XCD; We.lv = xl * ne + je; We.n = nE; We.c = je * 8 + xl; We.h = 0; }
    phase_prologue(P, C);
    xcd_barrier(bar_all);
#ifdef PROBE_SEL
    unsigned long long tp0 = __builtin_amdgcn_s_memrealtime(), tp1 = 0, tp2 = 0, tp3 = 0, tp4 = 0, tp5 = 0, tpe1 = 0, tpe2 = 0, tpe3 = 0;
#define STAMP(v) v = __builtin_amdgcn_s_memrealtime()
#else
#define STAMP(v)
#endif
    Wall.h = 0; run_C0(P, C, Wall, bar_all); xcd_barrier(bar_all); STAMP(tp1);
    if (inC) { Wc.h = 1; run_C0(P, C, Wc, bar_c); help_E(P, C, 0, 0); } else { We.h = 0; run_E(P, C, We, bar_e, 0); }
    STAMP(tpe1);
#ifdef PROBE_SEL
    if (C.tid == 0) atomicMax(ctl + 80 + (inC ? 0 : 1), (unsigned)(tpe1 - tp1));
#endif
    xcd_barrier(bar_all); STAMP(tp2);
    if (inC) { Wc.h = 0; run_C1(P, C, Wc, bar_c); help_E(P, C, 1, 0); } else { We.h = 1; run_E(P, C, We, bar_e, 0); }
    STAMP(tpe2);
#ifdef PROBE_SEL
    if (C.tid == 0) atomicMax(ctl + 82 + (inC ? 0 : 1), (unsigned)(tpe2 - tp2));
#endif
    xcd_barrier(bar_all); STAMP(tp3);
    if (inC) { Wc.h = 1; run_C1(P, C, Wc, bar_c); help_E(P, C, 0, 1); } else { We.h = 0; run_E(P, C, We, bar_e, 1); }
    STAMP(tpe3);
#ifdef PROBE_SEL
    if (C.tid == 0) atomicMax(ctl + 84 + (inC ? 0 : 1), (unsigned)(tpe3 - tp3));
#endif
    xcd_barrier(bar_all); STAMP(tp4);
    Wall.h = 1; run_E(P, C, Wall, bar_all, 1);
#ifdef PROBE_SEL
    STAMP(tp5);
    { unsigned long long d = 0; const int sel = PROBE_SEL;
      if (sel == 0) d = tp1 - tp0; if (sel == 1) d = tp2 - tp1; if (sel == 2) d = tp3 - tp2; if (sel == 3) d = tp4 - tp3; if (sel == 4) d = tp5 - tp4;
      if (sel == 5 || sel == 8) d = tpe1 - tp1; if (sel == 6 || sel == 9) d = tpe2 - tp2; if (sel == 7 || sel == 10) d = tpe3 - tp3;
      const int who = sel >= 8 ? 8 * NC_PER_XCD : 0;
      if (sel >= 20) { const unsigned* sp = (const unsigned*)(P.ws + WS_CTL) + 128 + 16 * PROBE_HALF; const int i = sel - 20; const int nxt = (i == PROBE_LAST) ? 9 : i + 1; d = (unsigned long long)(__hip_atomic_load(sp + nxt, __ATOMIC_RELAXED, __HIP_MEMORY_SCOPE_AGENT) - __hip_atomic_load(sp + i, __ATOMIC_RELAXED, __HIP_MEMORY_SCOPE_AGENT)); }
      if (sel >= 30) d = 0;
      if (bx == (sel >= 20 ? 0 : who) && C.tid == 0) __hip_atomic_store(ctl + 64, (unsigned)d, __ATOMIC_RELAXED, __HIP_MEMORY_SCOPE_AGENT);
      xcd_barrier(bar_all);
      if (bx == 0 && C.tid == 0) { const unsigned dd = sel >= 30 ? __hip_atomic_load(ctl + 80 + (sel - 30), __ATOMIC_RELAXED, __HIP_MEMORY_SCOPE_AGENT) : __hip_atomic_load(ctl + 64, __ATOMIC_RELAXED, __HIP_MEMORY_SCOPE_AGENT);
        const unsigned long long t0_ = __builtin_amdgcn_s_memrealtime(); while (__builtin_amdgcn_s_memrealtime() - t0_ < 4ull * dd) __builtin_amdgcn_s_sleep(32); } }
#endif
}

extern "C" void kernel_launch(void* const* d_in, const int* in_sizes, int n_in, void* d_out, int out_size, void* d_ws, size_t ws_size, hipStream_t stream) {
    static int grid = 0;
    if (grid == 0) {
        if (n_in != 22 || in_sizes[0] != T * DM || out_size != T * DM || ws_size < WS_END) {
            fprintf(stderr, "kernel_launch: unexpected shapes (n_in %d, in0 %d, out %d, ws %zu); nothing launched\n", n_in, n_in > 0 ? in_sizes[0] : -1, out_size, ws_size); grid = -1; return; }
        int dev = 0, cus = 0;
        if (hipGetDevice(&dev) != hipSuccess || hipDeviceGetAttribute(&cus, hipDeviceAttributeMultiprocessorCount, dev) != hipSuccess) { fprintf(stderr, "kernel_launch: device query failed\n"); grid = -1; return; }
        if (hipFuncSetAttribute((const void*)hybrid_fwd, hipFuncAttributeMaxDynamicSharedMemorySize, LDS_BYTES) != hipSuccess) { fprintf(stderr, "kernel_launch: hipFuncSetAttribute failed\n"); grid = -1; return; }
        (void)hipGetLastError();
        grid = cus;
        if (grid % 8 != 0 || grid / 8 <= NC_PER_XCD) { fprintf(stderr, "kernel_launch: built for a CU count that is a multiple of 8 and > %d; got %d; nothing launched\n", 8 * NC_PER_XCD, grid); grid = -1; return; }
    }
    if (grid < 0) return;
    if (hipMemsetAsync((char*)d_ws + WS_CTL, 0, CTL_ZERO_BYTES, stream) != hipSuccess) { fprintf(stderr, "kernel_launch: memset failed\n"); return; }
    Params p{};
    p.x = (const float*)d_in[0]; p.c = (const float*)d_in[1]; p.positions = (const int*)d_in[2]; p.ada_w = (const float*)d_in[3]; p.ada_b = (const float*)d_in[4];
    p.norm_mix_g = (const float*)d_in[5]; p.norm_ffn_g = (const float*)d_in[6]; p.final_norm_g = (const float*)d_in[7]; p.even_w_in = (const float*)d_in[8]; p.even_w_out = (const float*)d_in[9];
    p.gmlp_ln_g = (const float*)d_in[10]; p.gmlp_ln_b = (const float*)d_in[11]; p.gmlp_w_s = (const float*)d_in[12]; p.gmlp_b_s = (const float*)d_in[13]; p.hgrn_lb_logits = (const float*)d_in[14];
    p.hgrn_norm_g = (const float*)d_in[15]; p.odd_w_qkv = (const float*)d_in[16]; p.odd_w_out = (const float*)d_in[17]; p.peer_w_query = (const float*)d_in[18]; p.peer_sub_keys = (const float*)d_in[19];
    p.peer_down = (const float*)d_in[20]; p.peer_up = (const float*)d_in[21];
    p.out = (float*)d_out; p.ws = (unsigned char*)d_ws;
    p.ph_lo = 0; p.ph_hi = 0;
    hipLaunchKernelGGL(hybrid_fwd, dim3(grid), dim3(NWAVES * 64), LDS_BYTES, stream, p);
    const hipError_t le = hipPeekAtLastError();
    if (le != hipSuccess) fprintf(stderr, "kernel_launch: launch failed: %s\n", hipGetErrorName(le));
}
```

```cpp
#include <hip/hip_runtime.h>
#include <cstdio>
#include <cstdint>
#include <cmath>
namespace pg8 {
#define PG8_LAS __attribute__((address_space(3)))
typedef unsigned short bf16_t;
typedef short bf16x8 __attribute__((ext_vector_type(8)));
typedef float f32x4 __attribute__((ext_vector_type(4)));
typedef unsigned u32x4 __attribute__((ext_vector_type(4)));
constexpr int BM = 256, BK = 64, HALF = 128, HTB = HALF * BK * 2  , STAGE_BYTES = 8 * HTB, NXCD = 8, WGM = 8;

__host__ __device__ __forceinline__ int lds_byte(int r, int c) { const int st = (r >> 4) * 2 + (c >> 5), rr = r & 15, cc = c & 31, ob = rr * 64 + cc * 2; return st * 1024 + (ob ^ (((ob >> 9) & 1) << 5)); }
__host__ __device__ __forceinline__ void stage_rc(int b, int& R, int& C) { const int st = b / 1024, sb = b % 1024, swz = sb ^ (((sb >> 9) & 1) << 5); R = (st >> 1) * 16 + swz / 64; C = (st & 1) * 32 + (swz % 64) / 2; }
__host__ __device__ __forceinline__ int perm32(int rho) { const int n = rho >> 4, i = rho & 15; return 8 * (i >> 2) + 4 * n + (i & 3); }

struct Unit { int pm, pn; };
struct Gemm { const bf16_t* A; const bf16_t* Bt; int M, N, K; };

struct StaticOrder {
    int nM, nN, nwg, G, c;
    __host__ __device__ void init(int M, int N, int G_, int c_) { nM = M / BM; nN = N / BM; nwg = nM * nN; G = G_; c = c_; }
    __host__ __device__ bool next(int i, Unit& u) const {
        const long L = (long)i * G + c; if (L >= nwg) return false;
        int wgid = (int)L; { const int q = nwg / NXCD, r = nwg % NXCD, xcd = wgid % NXCD, off = wgid / NXCD; wgid = (xcd < r ? xcd * (q + 1) : r * (q + 1) + (xcd - r) * q) + off; }
        const int nig = WGM * nN, gid = wgid / nig, fm = gid * WGM, gsz = (nM - fm) < WGM ? (nM - fm) : WGM;
        u.pm = fm + ((wgid % nig) % gsz); u.pn = (wgid % nig) / gsz; return true;
    }
    __device__ __forceinline__ void a_ready(const Unit&) const {}
    __device__ __forceinline__ void done(const Unit&) const {}
};

__device__ __forceinline__ unsigned cvt_pk_bf16(float lo, float hi) { unsigned r; asm volatile("v_cvt_pk_bf16_f32 %0, %1, %2" : "=v"(r) : "v"(lo), "v"(hi)); return r; }
typedef float f32x2 __attribute__((ext_vector_type(2)));
__device__ __forceinline__ f32x2 gelu_pk(f32x2 v) {
    const f32x2 av = __builtin_elementwise_abs(v), d = av * 0.2316418882f + 1.0f;
    f32x2 t; t.x = __builtin_amdgcn_rcpf(d.x); t.y = __builtin_amdgcn_rcpf(d.y);
    f32x2 q = t * 0.5307027145f + (-0.7265760135f); q = q * t + 0.7107068705f; q = q * t + (-0.142248368f); q = q * t + 0.127414796f; q = q * t;
    const f32x2 s = (v * v) * (-0.72134752044f);
    f32x2 e; e.x = __builtin_amdgcn_exp2f(s.x); e.y = __builtin_amdgcn_exp2f(s.y);
    const f32x2 m = v * (q * e), r = v - m;
    f32x2 o; o.x = v.x < 0.f ? m.x : r.x; o.y = v.y < 0.f ? m.y : r.y; return o;
}

template <class Epi, class Sched, bool ALIGN_EPI = false, bool SP2 = false>
__device__ __forceinline__ void gemm_phase(PG8_LAS unsigned char* lds, const Gemm g, const Sched& S, const Epi& E) {
    int tid_ = threadIdx.x; asm volatile("" : "+v"(tid_));
    const int tid = tid_, wid = __builtin_amdgcn_readfirstlane(tid >> 6), lane = tid & 63, wr = wid >> 2, wc = wid & 3, fr = lane & 15, fq = lane >> 4;
    const int K = g.K, nt = K / BK;
    unsigned voffA[2], voffB[2];
#pragma unroll
    for (int i = 0; i < 2; ++i) { int R, C; stage_rc(tid * 16 + i * 8192, R, C); const int Rb = Epi::PERM ? ((R & ~31) + perm32(R & 31)) : R;
        voffA[i] = (unsigned)(R * K + C) * 2u; voffB[i] = (unsigned)(Rb * K + C) * 2u; }
    const size_t kstep = (size_t)(BK * 2);
    const size_t hstep = (size_t)HALF * K * 2;
    const size_t tstep = 2 * hstep;
    const unsigned ldsw = (unsigned)wid * 1024u;
    const int aoff = lds_byte(wr * 64 + fr, fq * 8), boff = lds_byte(wc * 32 + fr, fq * 8);
#define PG8_SA(b, h) (((b) * 2 + (h)) * HTB)
#define PG8_SB(b, h) ((4 + (b) * 2 + (h)) * HTB)
#define PG8_STAGE(bufoff, gbase, voff) do { _Pragma("unroll") for (int _i = 0; _i < 2; ++_i) \
        __builtin_amdgcn_global_load_lds((const unsigned*)((const char*)(gbase) + (voff)[_i]), (PG8_LAS unsigned*)(lds + (bufoff) + ldsw + _i * 8192), 16, 0, 0); } while (0)
#define PG8_LDA(dst, b, h) do { _Pragma("unroll") for (int m = 0; m < 4; ++m) _Pragma("unroll") for (int k = 0; k < 2; ++k) dst[m][k] = *(const PG8_LAS bf16x8*)(lds + PG8_SA(b, h) + aoff + m * 2048 + k * 1024); } while (0)
#define PG8_LDB(dst, b, h) do { _Pragma("unroll") for (int n = 0; n < 2; ++n) _Pragma("unroll") for (int k = 0; k < 2; ++k) dst[n][k] = *(const PG8_LAS bf16x8*)(lds + PG8_SB(b, h) + boff + n * 2048 + k * 1024); } while (0)
#define PG8_MMA(ai, bj, At, Bt) do { __builtin_amdgcn_s_setprio(1); _Pragma("unroll") for (int m = 0; m < 4; ++m) _Pragma("unroll") for (int n = 0; n < 2; ++n) _Pragma("unroll") for (int k = 0; k < 2; ++k) \
        acc[ai][bj][m][n] = __builtin_amdgcn_mfma_f32_16x16x32_bf16(Bt[n][k], At[m][k], acc[ai][bj][m][n], 0, 0, 0); __builtin_amdgcn_s_setprio(0); } while (0)
#define PG8_WAIT_V(n) asm volatile("s_waitcnt vmcnt(" #n ")" ::: "memory")
#define PG8_WAIT_L(n) asm volatile("s_waitcnt lgkmcnt(" #n ")" ::: "memory")
#define PG8_BAR __builtin_amdgcn_s_barrier()
#define PG8_SCHED __builtin_amdgcn_sched_barrier(0)
    Unit cur, nxt; int ui = 0;
    if (!S.next(0, cur)) return;
    f32x4 acc[2][2][4][2];
#pragma unroll
    for (int a = 0; a < 2; ++a)
#pragma unroll
        for (int b = 0; b < 2; ++b)
#pragma unroll
            for (int m = 0; m < 4; ++m)
#pragma unroll
                for (int n = 0; n < 2; ++n) acc[a][b][m][n] = (f32x4){0.f, 0.f, 0.f, 0.f};
    bf16x8 At[4][2], B0[2][2], B1[2][2];
    const char* cA = (const char*)g.A + (size_t)cur.pm * tstep; const char* cB = (const char*)g.Bt + (size_t)cur.pn * tstep;
    S.a_ready(cur);
    if constexpr (SP2) {
        PG8_STAGE(PG8_SB(0, 0), cB, voffB); PG8_STAGE(PG8_SB(0, 1), cB + hstep, voffB); PG8_STAGE(PG8_SA(0, 0), cA, voffA); PG8_STAGE(PG8_SA(0, 1), cA + hstep, voffA);
        if (wr == 1) PG8_BAR;
        PG8_WAIT_V(2); PG8_BAR;
        PG8_STAGE(PG8_SB(1, 0), cB + kstep, voffB); PG8_STAGE(PG8_SA(1, 0), cA + kstep, voffA); PG8_STAGE(PG8_SB(1, 1), cB + hstep + kstep, voffB);
        PG8_WAIT_V(6); PG8_BAR;
    } else {
        PG8_STAGE(PG8_SB(0, 0), cB, voffB); PG8_STAGE(PG8_SA(0, 0), cA, voffA); PG8_STAGE(PG8_SB(0, 1), cB + hstep, voffB); PG8_STAGE(PG8_SA(0, 1), cA + hstep, voffA);
        if (wr == 1) PG8_BAR;
        PG8_WAIT_V(4); PG8_BAR;
        PG8_STAGE(PG8_SB(1, 0), cB + kstep, voffB); PG8_STAGE(PG8_SA(1, 0), cA + kstep, voffA); PG8_STAGE(PG8_SB(1, 1), cB + hstep + kstep, voffB);
        PG8_WAIT_V(6); PG8_BAR;
    }
    for (;;) {
        const bool has_next = S.next(ui + 1, nxt);
        const char* nA = has_next ? (const char*)g.A + (size_t)nxt.pm * tstep : cA; const char* nB = has_next ? (const char*)g.Bt + (size_t)nxt.pn * tstep : cB;
        for (int t = 0; t < nt; t += 2) {
            const bool last = (t == nt - 2);
            const char* a1 = cA + (size_t)(t + 1) * kstep;
            const char* a2 = last ? nA : cA + (size_t)(t + 2) * kstep; const char* b2 = last ? nB : cB + (size_t)(t + 2) * kstep;
            const char* a3 = a2 + kstep; const char* b3 = b2 + kstep;
            if (last && has_next) S.a_ready(nxt);
            if constexpr (SP2) {
            PG8_LDB(B0, 0, 0); PG8_LDB(B1, 0, 1); PG8_SCHED; PG8_LDA(At, 0, 0); PG8_STAGE(PG8_SA(1, 1), a1 + hstep, voffA);
            PG8_WAIT_V(8); PG8_WAIT_L(0); PG8_BAR; PG8_MMA(0, 0, At, B0); PG8_MMA(0, 1, At, B1); PG8_BAR; PG8_SCHED;
            PG8_LDA(At, 0, 1); PG8_STAGE(PG8_SB(0, 0), b2, voffB); PG8_STAGE(PG8_SB(0, 1), b2 + hstep, voffB); PG8_STAGE(PG8_SA(0, 0), a2, voffA);
            PG8_WAIT_V(8); PG8_WAIT_L(0); PG8_BAR; PG8_MMA(1, 0, At, B0); PG8_MMA(1, 1, At, B1); PG8_BAR; PG8_SCHED;
            PG8_LDB(B0, 1, 0); PG8_LDB(B1, 1, 1); PG8_SCHED; PG8_LDA(At, 1, 0); PG8_STAGE(PG8_SA(0, 1), a2 + hstep, voffA);
            PG8_WAIT_V(8); PG8_WAIT_L(0); PG8_BAR; PG8_MMA(0, 0, At, B0); PG8_MMA(0, 1, At, B1); PG8_BAR; PG8_SCHED;
            PG8_LDA(At, 1, 1); PG8_STAGE(PG8_SB(1, 0), b3, voffB); PG8_STAGE(PG8_SB(1, 1), b3 + hstep, voffB); PG8_STAGE(PG8_SA(1, 0), a3, voffA);
            PG8_WAIT_V(8); PG8_WAIT_L(0); PG8_BAR; PG8_MMA(1, 0, At, B0); PG8_MMA(1, 1, At, B1); PG8_BAR; PG8_SCHED;
            } else {
            PG8_LDB(B0, 0, 0); PG8_SCHED; PG8_LDA(At, 0, 0); PG8_STAGE(PG8_SA(1, 1), a1 + hstep, voffA);
            PG8_WAIT_L(8); PG8_BAR; PG8_WAIT_L(0); PG8_MMA(0, 0, At, B0); PG8_BAR; PG8_SCHED;
            PG8_LDB(B1, 0, 1); PG8_STAGE(PG8_SB(0, 0), b2, voffB);
            PG8_BAR; PG8_WAIT_L(0); PG8_MMA(0, 1, At, B1); PG8_BAR;
            PG8_LDA(At, 0, 1); PG8_STAGE(PG8_SA(0, 0), a2, voffA);
            PG8_BAR; PG8_WAIT_L(0); PG8_MMA(1, 0, At, B0); PG8_BAR; PG8_SCHED;
            PG8_STAGE(PG8_SB(0, 1), b2 + hstep, voffB);
            PG8_WAIT_V(6); PG8_BAR; PG8_MMA(1, 1, At, B1); PG8_BAR;
            PG8_LDB(B0, 1, 0); PG8_SCHED; PG8_LDA(At, 1, 0); PG8_STAGE(PG8_SA(0, 1), a2 + hstep, voffA);
            PG8_WAIT_L(8); PG8_BAR; PG8_WAIT_L(0); PG8_MMA(0, 0, At, B0); PG8_BAR; PG8_SCHED;
            PG8_LDB(B1, 1, 1); PG8_STAGE(PG8_SB(1, 0), b3, voffB);
            PG8_BAR; PG8_WAIT_L(0); PG8_MMA(0, 1, At, B1); PG8_BAR;
            PG8_LDA(At, 1, 1); PG8_STAGE(PG8_SA(1, 0), a3, voffA);
            PG8_BAR; PG8_WAIT_L(0); PG8_MMA(1, 0, At, B0); PG8_BAR; PG8_SCHED;
            PG8_STAGE(PG8_SB(1, 1), b3 + hstep, voffB);
            PG8_WAIT_V(6); PG8_BAR; PG8_MMA(1, 1, At, B1); PG8_BAR;
            }
        }
        if constexpr (ALIGN_EPI) { if (wr == 0) PG8_BAR; }
        if constexpr (!Epi::AFTER_DRAIN) { E(acc, cur, wr, wc, fr, fq); S.done(cur); }
        if (!has_next) break;
#pragma unroll
        for (int a = 0; a < 2; ++a)
#pragma unroll
            for (int b = 0; b < 2; ++b)
#pragma unroll
                for (int m = 0; m < 4; ++m)
#pragma unroll
                    for (int n = 0; n < 2; ++n) acc[a][b][m][n] = (f32x4){0.f, 0.f, 0.f, 0.f};
        cur = nxt; cA = nA; cB = nB; ++ui;
        if constexpr (ALIGN_EPI) { if (wr == 1) PG8_BAR; }
    }
    PG8_WAIT_V(0);
    if constexpr (!ALIGN_EPI) { if (wr == 0) PG8_BAR; }
    PG8_BAR;
    if constexpr (Epi::AFTER_DRAIN) { E.fused(acc, cur, wr, wc, fr, fq, lds, wid, lane); S.done(cur); }
#undef PG8_SA
#undef PG8_SB
#undef PG8_STAGE
#undef PG8_LDA
#undef PG8_LDB
#undef PG8_MMA
#undef PG8_WAIT_V
#undef PG8_WAIT_L
#undef PG8_BAR
#undef PG8_SCHED
}
}
#define GAS __attribute__((address_space(1)))
#define LAS __attribute__((address_space(3)))
typedef unsigned short bf16;
typedef unsigned v4u __attribute__((ext_vector_type(4)));
typedef float f32x4 __attribute__((ext_vector_type(4)));
typedef short bf16x8 __attribute__((ext_vector_type(8)));
typedef __bf16 bf16x2_t __attribute__((ext_vector_type(2)));
#define LDS_WAIT() asm volatile("s_waitcnt lgkmcnt(0)" ::: "memory")
#define VM_WAIT() asm volatile("s_waitcnt vmcnt(0)" ::: "memory")
typedef float f32x2_cv __attribute__((ext_vector_type(2)));
__device__ __forceinline__ unsigned pk2(float lo, float hi) { const f32x2_cv v = {lo, hi}; return __builtin_bit_cast(unsigned, __builtin_convertvector(v, bf16x2_t)); }
__device__ __forceinline__ unsigned f2bf(float f) { return pk2(f, 0.f) & 0xffffu; }
__device__ __forceinline__ float bflo(unsigned u) { return __builtin_bit_cast(float, u << 16); }
__device__ __forceinline__ float bfhi(unsigned u) { return __builtin_bit_cast(float, u & 0xffff0000u); }
__device__ __forceinline__ float bf2f(bf16 u) { return __builtin_bit_cast(float, (unsigned)u << 16); }
#define XB_TMO      128
#define XB_XCNT(j)  (256  + 64 * (j))
#define XB_XSUB(j)  (1280 + 64 * (j))
#define XB_XGEN(j)  (2304 + 64 * (j))
#define XB_TOP      3328
#define XB_TOPGEN   3392
#define XCD_BAR_WORDS 3456
#define XB_SPIN_CAP (1u << 18)

__device__ __forceinline__ unsigned xb_ld(unsigned* p)              { return __hip_atomic_load(p, __ATOMIC_RELAXED, __HIP_MEMORY_SCOPE_AGENT); }
__device__ __forceinline__ unsigned xb_add(unsigned* p, unsigned v) { return __hip_atomic_fetch_add(p, v, __ATOMIC_RELAXED, __HIP_MEMORY_SCOPE_AGENT); }
__device__ __forceinline__ unsigned xb_xcc_id() { return (unsigned)__builtin_amdgcn_s_getreg((3 << 11) | 20) & 0xFu; }
#define XB_SPIN(cond, bar) do { unsigned _sp = 0; while (cond) { __builtin_amdgcn_s_sleep(1); \
    if ((++_sp & 255u) == 0u) { if (xb_ld(&(bar)[XB_TMO])) break; if (_sp > XB_SPIN_CAP) { atomicAdd(&(bar)[XB_TMO], 1u); break; } } } } while (0)

struct XcdBarrier {
    unsigned* bar; unsigned x; unsigned G;
    volatile LAS unsigned* st;
};

__device__ __forceinline__ XcdBarrier xcd_barrier_post(unsigned* bar, volatile LAS unsigned* st) {
    XcdBarrier b; b.bar = bar; b.x = xb_xcc_id(); b.st = st; b.G = gridDim.x;
    if (threadIdx.x == 0) (void)xb_add(&bar[XB_XCNT(b.x)], 1u);
    return b;
}
__device__ __forceinline__ void xcd_barrier_complete(unsigned* bar, unsigned x, unsigned& nloc, unsigned& nx, const unsigned G) {
    unsigned sum, cnt, mine, sp = 0u;
    for (;;) {
        sum = 0u; cnt = 0u; mine = 0u;
#pragma unroll
        for (unsigned j = 0; j < 16; ++j) { const unsigned c = xb_ld(&bar[XB_XCNT(j)]); sum += c; cnt += (c > 0u) ? 1u : 0u; mine = (j == x) ? c : mine; }
        if (sum == G) break;
        __builtin_amdgcn_s_sleep(1);
        if ((++sp & 255u) == 0u) { if (xb_ld(&bar[XB_TMO])) break; if (sp > XB_SPIN_CAP) { atomicAdd(&bar[XB_TMO], 1u); break; } }
    }
    nloc = mine > 0u ? mine : 1u; nx = cnt > 0u ? cnt : 1u;
}

__device__ __forceinline__ void xcd_barrier(const XcdBarrier& b) {
    asm volatile("s_waitcnt vmcnt(0)" ::: "memory");
    __syncthreads();
    if (threadIdx.x == 0) {
        unsigned* bar = b.bar;
        __builtin_amdgcn_s_waitcnt(0);
        unsigned nloc = b.st[0], nx = b.st[1];
        if (nloc == 0u) { xcd_barrier_complete(bar, b.x, nloc, nx, b.G); b.st[0] = nloc; b.st[1] = nx; }
        const unsigned old = xb_add(&bar[XB_XSUB(b.x)], 1u);
        const unsigned gen = old / nloc;
        if (old + 1u == (gen + 1u) * nloc) {
            __builtin_amdgcn_fence(__ATOMIC_RELEASE, "agent");
            asm volatile("s_waitcnt vmcnt(0)" ::: "memory");
            const unsigned og = xb_add(&bar[XB_TOP], 1u);
            const unsigned tg = og / nx;
            if (og + 1u == (tg + 1u) * nx) xb_add(&bar[XB_TOPGEN], 1u);
            else XB_SPIN(xb_ld(&bar[XB_TOPGEN]) == tg, bar);
            __builtin_amdgcn_fence(__ATOMIC_ACQUIRE, "agent");
            xb_add(&bar[XB_XGEN(b.x)], 1u);
            asm volatile("s_waitcnt vmcnt(0)" ::: "memory");
        } else {
            XB_SPIN(xb_ld(&bar[XB_XGEN(b.x)]) == gen, bar);
            __builtin_amdgcn_fence(__ATOMIC_ACQUIRE, "agent");
            asm volatile("s_waitcnt vmcnt(0)" ::: "memory");
        }
    }
    __syncthreads();
}

constexpr int NB = 8, SEQ = 8192, DM = 1024, T = NB * SEQ;
constexpr int NWAVES = 8;
constexpr float NORM_EPS = 1e-6f;
constexpr float C2 = 0.125f * 1.4426950408889634f;

constexpr size_t MiB = 1u << 20;
constexpr size_t WS_CTL = 0, CTL_ZERO_BYTES = 1 * MiB;
constexpr size_t WS_MOD = 1 * MiB;
constexpr size_t WS_SKB = 1 * MiB + 512 * 1024;
constexpr size_t WS_WSB = 1 * MiB + 768 * 1024;
constexpr size_t WS_LB  = 1 * MiB + 960 * 1024;
constexpr size_t WS_CS  = 2 * MiB;
constexpr size_t WS_HD  = 6 * MiB;
constexpr size_t WS_WIN = 16 * MiB, WS_WOUT0 = 22 * MiB, WS_WQKV = 24 * MiB, WS_WOUT1 = 30 * MiB, WS_WQ0 = 32 * MiB, WS_WQ1 = 36 * MiB;
constexpr size_t WS_TAB8 = 40 * MiB, TAB8_BYTES = 12 * MiB;
constexpr int TROW = 768;
constexpr size_t WS_SC8 = 8 * MiB;
constexpr size_t WS_H = 108 * MiB;
constexpr size_t WS_IDX = 236 * MiB, WS_GATE = 268 * MiB;
constexpr size_t WS_AR0 = 300 * MiB, AR_BYTES = 352 * MiB;
constexpr size_t AR_PU = 0, AR_PV = 32 * MiB, AR_PQ = 64 * MiB, AR_PI = 96 * MiB, AR_PG = 128 * MiB;
constexpr size_t AR_G = 160 * MiB;
constexpr size_t AR_KVT = 224 * MiB, AR_ST = 288 * MiB;
constexpr size_t AR_QP = 0;
constexpr size_t AR_QK = 0;
constexpr int QK_ROWS = SEQ + SEQ / 16;
__host__ __device__ __forceinline__ int qk_row(int t) { return t + (t >> 4); }
constexpr size_t WS_END = WS_AR0 + 2 * AR_BYTES;
constexpr int HT = T / 2;
constexpr int CW_BAR = 4096;

constexpr int LDS_BYTES = 147456;
constexpr int LDSCTL_OFF = LDS_BYTES - 512;
constexpr int MISC_OFF = LDSCTL_OFF;

struct Params {
    const float* x; const float* c; const int* positions; const float* ada_w; const float* ada_b; const float* norm_mix_g; const float* norm_ffn_g; const float* final_norm_g;
    const float* even_w_in; const float* even_w_out; const float* gmlp_ln_g; const float* gmlp_ln_b; const float* gmlp_w_s; const float* gmlp_b_s; const float* hgrn_lb_logits; const float* hgrn_norm_g;
    const float* odd_w_qkv; const float* odd_w_out; const float* peer_w_query; const float* peer_sub_keys; const float* peer_down; const float* peer_up;
    float* out; unsigned char* ws; int ph_lo, ph_hi;
};
struct Ctx { LAS unsigned char* lds; int tid, lane, wave, vcu, G; };
__device__ __forceinline__ Ctx fresh_ctx(const Ctx& C0) { Ctx C = C0; int t_ = threadIdx.x; asm volatile("" : "+v"(t_)); C.tid = t_; C.lane = t_ & 63; C.wave = __builtin_amdgcn_readfirstlane(t_ >> 6); return C; }
struct Wk { int lv, n, c, h; };
#define W_TK0(W) ((W).h * (T / 2))
#define W_BT0(W) ((W).h * (NB / 2))
__device__ __forceinline__ unsigned char* w_ar(const Params& P, const Wk& W) { return P.ws + WS_AR0 + (size_t)W.h * AR_BYTES; }
__device__ __forceinline__ bf16* w_tok16(const Params& P, const Wk& W, size_t off, int pitch) { return (bf16*)(w_ar(P, W) + off) - (size_t)W_TK0(W) * pitch; }
__device__ __forceinline__ float* w_tok32(const Params& P, const Wk& W, size_t off, int pitch) { return (float*)(w_ar(P, W) + off) - (size_t)W_TK0(W) * pitch; }
__device__ __forceinline__ bf16* w_item16(const Params& P, const Wk& W, size_t off) { return (bf16*)(w_ar(P, W) + off) - (size_t)W_BT0(W) * 512 * 16384; }

__device__ __forceinline__ float wave_sum(float v) {
#pragma unroll
    for (int o = 1; o < 64; o <<= 1) v += __shfl_xor(v, o);
    return v;
}
__device__ __forceinline__ float silu_f(float x) { return x * __builtin_amdgcn_rcpf(1.0f + __builtin_amdgcn_exp2f(-1.4426950408889634f * x)); }
__device__ __forceinline__ float sigmoid_f(float x) { return __builtin_amdgcn_rcpf(1.0f + __builtin_amdgcn_exp2f(-1.4426950408889634f * x)); }
__device__ __forceinline__ float gelu_f(float x) { return 0.5f * x * (1.0f + erff(x * 0.70710678118654752f)); }
__device__ __forceinline__ f32x4 mma16(f32x4 acc, const LAS bf16* A, int lda, const LAS bf16* Bt, int ldb, int K, int r, int q4) {
    const LAS bf16* ap = A + r * lda + 8 * q4; const LAS bf16* bp = Bt + r * ldb + 8 * q4;
    for (int k0 = 0; k0 < K; k0 += 32) {
        const bf16x8 a = *(const LAS bf16x8*)(ap + k0); const bf16x8 b = *(const LAS bf16x8*)(bp + k0);
        acc = __builtin_amdgcn_mfma_f32_16x16x32_bf16(a, b, acc, 0, 0, 0);
    }
    return acc;
}

struct EpiBf16P {
    static constexpr bool PERM = true, AFTER_DRAIN = false;
    bf16* O; size_t ldc;
    __device__ __forceinline__ void operator()(const f32x4 (&acc)[2][2][4][2], const pg8::Unit& u, int wr, int wc, int fr, int fq) const {
        const int row0 = u.pm * 256 + wr * 64 + fr, col0 = u.pn * 256 + wc * 32 + 8 * fq;
#pragma unroll
        for (int ai = 0; ai < 2; ++ai)
#pragma unroll
            for (int m = 0; m < 4; ++m) { bf16* rowp = O + (size_t)(row0 + ai * 128 + m * 16) * ldc + col0;
#pragma unroll
                for (int bj = 0; bj < 2; ++bj) { const f32x4 v0 = acc[ai][bj][m][0], v1 = acc[ai][bj][m][1];
                    v4u w; w.x = pg8::cvt_pk_bf16(v0[0], v0[1]); w.y = pg8::cvt_pk_bf16(v0[2], v0[3]); w.z = pg8::cvt_pk_bf16(v1[0], v1[1]); w.w = pg8::cvt_pk_bf16(v1[2], v1[3]);
                    *(v4u*)(rowp + bj * 128) = w; } }
    }
};
#ifndef REP_HG
#define REP_HG 1
#endif
#ifndef REP_TOPK
#define REP_TOPK 1
#endif
#ifndef REP_PRO
#define REP_PRO 1
#endif
#ifndef REP_NORM
#define REP_NORM 1
#endif
#ifndef REP_GEMM2
#define REP_GEMM2 1
#endif
#ifndef REP_GEMM
#define REP_GEMM 1
#endif
#ifndef EXP_REP
#define EXP_REP 1
#endif
#ifndef ATT_REP
#define ATT_REP 1
#endif
#ifndef ABL_ON
#define ABL_ON 4
#endif
struct EpiResid {
    static constexpr bool PERM = true, AFTER_DRAIN = false;
    const float* xin; float* xout; const float* gate; float gsc;
    __device__ __forceinline__ void operator()(const f32x4 (&acc)[2][2][4][2], const pg8::Unit& u, int wr, int wc, int fr, int fq) const {
        const int row0 = u.pm * 256 + wr * 64 + fr, col0 = u.pn * 256 + wc * 32 + 8 * fq;
        const float* gp = gate + (size_t)((u.pm * 256) >> 13) * 6144 + col0;
        f32x4 gv[2][2];
#pragma unroll
        for (int bj = 0; bj < 2; ++bj) { gv[bj][0] = *(const f32x4*)(gp + bj * 128); gv[bj][1] = *(const f32x4*)(gp + bj * 128 + 4); }
#pragma unroll
        for (int ai = 0; ai < 2; ++ai)
#pragma unroll
            for (int m = 0; m < 4; ++m) { const size_t off = (size_t)(row0 + ai * 128 + m * 16) * 1024 + col0;
#pragma unroll
                for (int bj = 0; bj < 2; ++bj) {
                    const f32x4 x0 = *(const f32x4*)(xin + off + bj * 128), x1 = *(const f32x4*)(xin + off + bj * 128 + 4);
                    *(f32x4*)(xout + off + bj * 128) = x0 + gv[bj][0] * acc[ai][bj][m][0] * gsc;
                    *(f32x4*)(xout + off + bj * 128 + 4) = x1 + gv[bj][1] * acc[ai][bj][m][1] * gsc; }
                asm volatile("" ::: "memory"); }
    }
};
struct EpiInProj {
    static constexpr bool PERM = true, AFTER_DRAIN = false;
    bf16* PU; bf16* PV; bf16* PQ; bf16* PI; bf16* PG; float* G; const float* LB;
    __device__ __forceinline__ void operator()(const f32x4 (&acc)[2][2][4][2], const pg8::Unit& u, int wr, int wc, int fr, int fq) const {
        const int type = u.pn >> 1;
        const int row0 = u.pm * 256 + wr * 64 + fr, lc0 = (u.pn & 1) * 256 + wc * 32 + 8 * fq;
        if (type == 3) {
            f32x4 lb[2][2];
#pragma unroll
            for (int bj = 0; bj < 2; ++bj) { lb[bj][0] = *(const f32x4*)(LB + lc0 + bj * 128); lb[bj][1] = *(const f32x4*)(LB + lc0 + bj * 128 + 4); }
#pragma unroll
            for (int ai = 0; ai < 2; ++ai)
#pragma unroll
                for (int m = 0; m < 4; ++m) { float* rowp = G + (size_t)(row0 + ai * 128 + m * 16) * 512 + lc0;
#pragma unroll
                    for (int bj = 0; bj < 2; ++bj)
#pragma unroll
                        for (int n = 0; n < 2; ++n) { const f32x4 v = acc[ai][bj][m][n]; f32x4 o;
#pragma unroll
                            for (int e = 0; e < 4; ++e) { const float l = lb[bj][n][e]; const float f = l + (1.0f - l) * sigmoid_f(v[e]); o[e] = __logf(f); }
                            *(f32x4*)(rowp + bj * 128 + 4 * n) = o; } }
            return;
        }
        bf16* base = type == 0 ? PU : type == 1 ? PV : type == 2 ? PQ : type == 4 ? PI : PG;
#pragma unroll
        for (int ai = 0; ai < 2; ++ai)
#pragma unroll
            for (int m = 0; m < 4; ++m) { bf16* rowp = base + (size_t)(row0 + ai * 128 + m * 16) * 512 + lc0;
#pragma unroll
                for (int bj = 0; bj < 2; ++bj) { f32x4 v0 = acc[ai][bj][m][0], v1 = acc[ai][bj][m][1];
                    if (type <= 1) { pg8::f32x2 a = pg8::gelu_pk((pg8::f32x2){v0[0], v0[1]}), b = pg8::gelu_pk((pg8::f32x2){v0[2], v0[3]}), c = pg8::gelu_pk((pg8::f32x2){v1[0], v1[1]}), d = pg8::gelu_pk((pg8::f32x2){v1[2], v1[3]});
                        v0 = (f32x4){a.x, a.y, b.x, b.y}; v1 = (f32x4){c.x, c.y, d.x, d.y}; }
                    else if (type == 2) {
#pragma unroll
                        for (int e = 0; e < 4; ++e) { v0[e] = silu_f(v0[e]) * 0.08838834764831845f; v1[e] = silu_f(v1[e]) * 0.08838834764831845f; } }
                    else if (type == 5) {
#pragma unroll
                        for (int e = 0; e < 4; ++e) { v0[e] = silu_f(v0[e]); v1[e] = silu_f(v1[e]); } }
                    v4u w; w.x = pg8::cvt_pk_bf16(v0[0], v0[1]); w.y = pg8::cvt_pk_bf16(v0[2], v0[3]); w.z = pg8::cvt_pk_bf16(v1[0], v1[1]); w.w = pg8::cvt_pk_bf16(v1[2], v1[3]);
                    *(v4u*)(rowp + bj * 128) = w; } }
    }
};
struct EpiQKRot {
    static constexpr bool PERM = true, AFTER_DRAIN = false;
    bf16* O; const float* CS;
    __device__ __forceinline__ void operator()(const f32x4 (&acc)[2][2][4][2], const pg8::Unit& u, int wr, int wc, int fr, int fq) const {
        const int row0 = u.pm * 256 + wr * 64 + fr, col0 = u.pn * 256 + wc * 32 + 8 * fq;
        const float sc = u.pn < 4 ? C2 : 1.0f;
        const bool rotw = (wc & 1) == 0 && u.pn < 8;
        const float sgn = fq == 0 ? -1.0f : 1.0f;
#pragma unroll
        for (int ai = 0; ai < 2; ++ai)
#pragma unroll
            for (int m = 0; m < 4; ++m) { const int row = row0 + ai * 128 + m * 16;
                bf16* rowp = O + ((size_t)(((u.pn >> 2) * 4 + (row >> 13)) * 16 + (u.pn & 3) * 4 + (wc >> 1)) * QK_ROWS + qk_row(row & 8191)) * 64 + (wc & 1) * 32 + 8 * fq;
                f32x4 c0 = (f32x4){1.f, 1.f, 1.f, 1.f}, c1 = c0, s0 = (f32x4){0.f, 0.f, 0.f, 0.f}, s1 = s0;
                if (rotw && fq < 2) { const float* cp = CS + (size_t)row * 16; c0 = *(const f32x4*)(cp); c1 = *(const f32x4*)(cp + 4); s0 = *(const f32x4*)(cp + 8) * sgn; s1 = *(const f32x4*)(cp + 12) * sgn; }
#pragma unroll
                for (int bj = 0; bj < 2; ++bj) { f32x4 v0 = acc[ai][bj][m][0], v1 = acc[ai][bj][m][1];
                    if (rotw) { f32x4 p0, p1;
#pragma unroll
                        for (int e = 0; e < 4; ++e) { p0[e] = __shfl_xor(v0[e], 16); p1[e] = __shfl_xor(v1[e], 16); }
                        v0 = v0 * c0 + p0 * s0; v1 = v1 * c1 + p1 * s1; }
                    v0 = v0 * sc; v1 = v1 * sc;
                    v4u w; w.x = pg8::cvt_pk_bf16(v0[0], v0[1]); w.y = pg8::cvt_pk_bf16(v0[2], v0[3]); w.z = pg8::cvt_pk_bf16(v1[0], v1[1]); w.w = pg8::cvt_pk_bf16(v1[2], v1[3]);
                    *(v4u*)(rowp + (size_t)bj * 2 * QK_ROWS * 64) = w; } }
    }
};

__device__ __forceinline__ void p0_transpose_item(const float* W, int K, int N, bf16* WT, LAS float* scr, int item, int lane) {
    const int nblk = N / 32, kb = item / nblk, nb = item % nblk, k0 = 64 * kb, n0 = 32 * nb;
#pragma unroll 8
    for (int i = 0; i < 32; ++i) { const int kk = 2 * i + (lane >> 5); scr[kk * 33 + (lane & 31)] = W[(size_t)(k0 + kk) * N + n0 + (lane & 31)]; }
    LDS_WAIT(); asm volatile("" ::: "memory");
    const int c = lane & 7;
#pragma unroll
    for (int j = 0; j < 4; ++j) { const int n = (lane >> 3) + 8 * j; const LAS float* s = scr + (8 * c) * 33 + n;
        v4u o; o.x = pk2(s[0 * 33], s[1 * 33]); o.y = pk2(s[2 * 33], s[3 * 33]); o.z = pk2(s[4 * 33], s[5 * 33]); o.w = pk2(s[6 * 33], s[7 * 33]);
        *(GAS v4u*)(WT + (size_t)(n0 + n) * K + k0 + 8 * c) = o; }
    LDS_WAIT(); asm volatile("" ::: "memory");
}
typedef float f32x2 __attribute__((ext_vector_type(2)));
typedef float f32x16v __attribute__((ext_vector_type(16)));
typedef float f32x32v __attribute__((ext_vector_type(32)));
typedef unsigned v6u __attribute__((ext_vector_type(6)));
__device__ __forceinline__ void convert_tables(const Params& P, const Ctx& C) {
    const int gw = C.vcu * NWAVES + C.wave, NGW = C.G * NWAVES, lane = C.lane, hl = lane & 31;
    LAS float* stg = (LAS float*)(C.lds + C.wave * 16384);
    for (int rp = gw; rp < 2 * 16384; rp += NGW) {
#pragma unroll
        for (int rr = 0; rr < 2; ++rr) { const int row_ = 2 * rp + rr, tb_ = row_ >> 14, e_ = row_ & 16383;
            const f32x4* src = (const f32x4*)(((tb_ & 1) ? P.peer_up : P.peer_down) + ((size_t)(tb_ >> 1) * 16384 + e_) * 1024);
#pragma unroll
            for (int j = 0; j < 4; ++j) *(LAS f32x4*)(stg + rr * 1024 + 4 * (64 * j + lane)) = src[64 * j + lane]; }
        LDS_WAIT(); asm volatile("" ::: "memory");
        const int row = 2 * rp + (lane >> 5), tb = row >> 14, e = row & 16383;
        const LAS f32x4* sp = (const LAS f32x4*)(stg + (lane >> 5) * 1024 + 32 * hl);
        unsigned char* dst = P.ws + WS_TAB8 + (size_t)tb * TAB8_BYTES + (size_t)e * TROW;
        f32x16v a, b2; float mx = 0.f;
#pragma unroll
        for (int j = 0; j < 4; ++j) { const f32x4 v = sp[j], w = sp[4 + j];
#pragma unroll
            for (int i = 0; i < 4; ++i) { mx = fmaxf(mx, fmaxf(fabsf(v[i]), fabsf(w[i]))); }
            a[2 * j] = v[0]; b2[2 * j] = v[1]; a[2 * j + 1] = v[2]; b2[2 * j + 1] = v[3]; a[8 + 2 * j] = w[0]; b2[8 + 2 * j] = w[1]; a[8 + 2 * j + 1] = w[2]; b2[8 + 2 * j + 1] = w[3]; }
        LDS_WAIT(); asm volatile("" ::: "memory");
#pragma unroll
        for (int o = 1; o < 32; o <<= 1) mx = fmaxf(mx, __shfl_xor(mx, o));
        const float sc = mx > 0.f ? 7.0f / mx : 0.f;
        a = a * sc; b2 = b2 * sc;
        const v6u p = __builtin_amdgcn_cvt_scalef32_2xpk16_fp6_f32(a, b2, 1.0f);
        *(v4u*)(dst + 256 * (hl & 1) + 16 * (hl >> 1)) = (v4u){p[0], p[1], p[2], p[3]}; *(unsigned long long*)(dst + 512 + 128 * (hl & 1) + 8 * (hl >> 1)) = ((unsigned long long)p[5] << 32) | p[4];
        if (hl == 0) ((float*)(P.ws + WS_SC8))[row] = mx * (1.0f / 7.0f);
    }
}
__device__ __forceinline__ void phase_prologue(const Params& P, const Ctx& C) {
    float* MOD = (float*)(P.ws + WS_MOD);
    {
        LAS float* cond = (LAS float*)C.lds;
        LAS float* part = (LAS float*)(C.lds + 32768);
        for (int e = C.tid; e < 8192; e += 512) cond[e] = silu_f(P.c[e]);
        __syncthreads();
        for (int item = C.vcu; item < 192; item += C.G) {
            const int l = item / 96, cb = item % 96, col = cb * 64 + C.lane;
            float acc[8];
#pragma unroll
            for (int b = 0; b < 8; ++b) acc[b] = 0.f;
            const float* wp = P.ada_w + ((size_t)l * 1024 + C.wave * 128) * 6144 + col;
#pragma unroll 4
            for (int k = 0; k < 128; ++k) { const float wv = wp[(size_t)k * 6144];
#pragma unroll
                for (int b = 0; b < 8; ++b) acc[b] += cond[b * 1024 + C.wave * 128 + k] * wv; }
#pragma unroll
            for (int b = 0; b < 8; ++b) part[(C.wave * 8 + b) * 64 + C.lane] = acc[b];
            __syncthreads();
            { const int b = C.tid >> 6, ln = C.tid & 63; float s = P.ada_b[l * 6144 + cb * 64 + ln];
#pragma unroll
              for (int w = 0; w < 8; ++w) s += part[(w * 8 + b) * 64 + ln];
              MOD[(size_t)(l * 8 + b) * 6144 + cb * 64 + ln] = s; }
            __syncthreads();
        }
        __syncthreads();
    }
    {
        LAS float* scr = (LAS float*)(C.lds + C.wave * 16384);
        const int gw = C.vcu * NWAVES + C.wave, NGW = C.G * NWAVES;
        for (int it = gw; it < 6144; it += NGW) {
            int r = it;
            if (r < 1536) { p0_transpose_item(P.even_w_in, 1024, 3072, (bf16*)(P.ws + WS_WIN), scr, r, C.lane); continue; } r -= 1536;
            if (r < 512)  { p0_transpose_item(P.even_w_out, 1024, 1024, (bf16*)(P.ws + WS_WOUT0), scr, r, C.lane); continue; } r -= 512;
            if (r < 1536) { p0_transpose_item(P.odd_w_qkv, 1024, 3072, (bf16*)(P.ws + WS_WQKV), scr, r, C.lane); continue; } r -= 1536;
            if (r < 512)  { p0_transpose_item(P.odd_w_out, 1024, 1024, (bf16*)(P.ws + WS_WOUT1), scr, r, C.lane); continue; } r -= 512;
            if (r < 1024) { p0_transpose_item(P.peer_w_query, 1024, 2048, (bf16*)(P.ws + WS_WQ0), scr, r, C.lane); continue; } r -= 1024;
            p0_transpose_item(P.peer_w_query + (size_t)1024 * 2048, 1024, 2048, (bf16*)(P.ws + WS_WQ1), scr, r, C.lane);
        }
    }
    convert_tables(P, C);
    const int NT = C.G * 512, gt = C.vcu * 512 + C.tid;
    { bf16* skb = (bf16*)(P.ws + WS_SKB); for (int i = gt; i < 65536; i += NT) skb[i] = (bf16)f2bf(P.peer_sub_keys[i]); }
    { bf16* wsb = (bf16*)(P.ws + WS_WSB); for (int i = gt; i < 65536; i += NT) { const int t = (i >> 7) & 127, s = i & 127; wsb[i] = (bf16)(s <= t ? f2bf(P.gmlp_w_s[i]) : 0u); } }
    { float* lb = (float*)(P.ws + WS_LB); for (int i = gt; i < 512; i += NT) { const float l0 = P.hgrn_lb_logits[i], l1 = P.hgrn_lb_logits[512 + i]; lb[i] = 1.0f / (1.0f + expf(l1 - l0)); } }
    { float* cs = (float*)(P.ws + WS_CS); for (int i = gt; i < T * 8; i += NT) { const int tok = i >> 3, j = i & 7;
        const float inv = 1.0f / powf(500000.0f, (float)j * 0.125f); const float ang = (float)P.positions[tok] * inv; float sn, cn; sincosf(ang, &sn, &cn);
        cs[(size_t)tok * 16 + j] = cn; cs[(size_t)tok * 16 + 8 + j] = sn; } }
}
__device__ __forceinline__ void norm_row_bf16(const float* xrow, bf16* hrow, const float* g, const float* sh, const float* sc, int lane) {
    const f32x4* xr = (const f32x4*)xrow + lane; f32x4 v[4]; float s = 0.f;
#pragma unroll
    for (int j = 0; j < 4; ++j) { v[j] = xr[64 * j]; s += (v[j][0] * v[j][0] + v[j][1] * v[j][1]) + (v[j][2] * v[j][2] + v[j][3] * v[j][3]); }
    const float rstd = 1.0f / sqrtf(wave_sum(s) * (1.0f / 1024.0f) + NORM_EPS);
    unsigned long long* o8 = (unsigned long long*)hrow + lane;
#pragma unroll
    for (int j = 0; j < 4; ++j) { const f32x4 gg = ((const f32x4*)g)[64 * j + lane], hh = ((const f32x4*)sh)[64 * j + lane], cc = ((const f32x4*)sc)[64 * j + lane];
        const f32x4 y = (v[j] * rstd * gg) * (cc + 1.0f) + hh;
        o8[64 * j] = (unsigned long long)pk2(y[0], y[1]) | ((unsigned long long)pk2(y[2], y[3]) << 32); }
}
__device__ __forceinline__ void phase_norm(const Params& P, const Ctx& C, const Wk& W, const float* xsrc, const float* g, int l, int so) {
    const float* MOD = (const float*)(P.ws + WS_MOD); bf16* H = (bf16*)(P.ws + WS_H);
    const int gw = W.lv * NWAVES + C.wave, NGW = W.n * NWAVES;
    for (int m = W_TK0(W) + gw; m < W_TK0(W) + HT; m += NGW) { const float* mb = MOD + (size_t)(l * 8 + (m >> 13)) * 6144 + so;
        norm_row_bf16(xsrc + (size_t)m * 1024, H + (size_t)m * 1024, g, mb, mb + 1024, C.lane); }
}

__device__ __forceinline__ void gmlp_item(const Params& P, const Ctx& C, const Wk& W, int n, int g) {
    LAS bf16* Wt = (LAS bf16*)C.lds;
    LAS bf16* vT = (LAS bf16*)(C.lds + 34816);
    const bf16* WSB = (const bf16*)(P.ws + WS_WSB); const bf16* PU = w_tok16(P, W, AR_PU, 512); const bf16* PV = w_tok16(P, W, AR_PV, 512); bf16* MIX = (bf16*)(P.ws + WS_H);
    const int tid = C.tid, r = C.lane & 15, q4 = C.lane >> 4;
    for (int ch = tid; ch < 2048; ch += 512) { const int rr = ch >> 4, c8 = (ch & 15) * 8; *(LAS v4u*)(Wt + rr * 136 + c8) = *(const v4u*)(WSB + (size_t)(g * 128 + rr) * 128 + c8); }
    { const int t = tid >> 2, part = tid & 3; const bf16* src = PV + (size_t)(n * 128 + t) * 512 + g * 128 + part * 32;
      float x[32];
#pragma unroll
      for (int j = 0; j < 4; ++j) { const v4u w = *(const v4u*)(src + 8 * j);
#pragma unroll
          for (int e = 0; e < 4; ++e) { x[8 * j + 2 * e] = bflo(w[e]); x[8 * j + 2 * e + 1] = bfhi(w[e]); } }
      float s = 0.f;
#pragma unroll
      for (int j = 0; j < 32; ++j) s += x[j];
      s += __shfl_xor(s, 1); s += __shfl_xor(s, 2);
      const float mean = s * (1.0f / 128.0f); float q = 0.f;
#pragma unroll
      for (int j = 0; j < 32; ++j) { const float d = x[j] - mean; q += d * d; }
      q += __shfl_xor(q, 1); q += __shfl_xor(q, 2);
      const float rstd = 1.0f / sqrtf(q * (1.0f / 128.0f) + NORM_EPS);
      const float* lg = P.gmlp_ln_g + g * 128 + part * 32; const float* lbp = P.gmlp_ln_b + g * 128 + part * 32;
#pragma unroll
      for (int j = 0; j < 32; ++j) vT[(part * 32 + j) * 136 + t] = (bf16)f2bf((x[j] - mean) * rstd * lg[j] + lbp[j]);
    }
    __syncthreads();
    const int t0 = 16 * C.wave; const int Keff = ((t0 + 16 + 31) >> 5) << 5;
    f32x4 acc[8];
#pragma unroll
    for (int ct = 0; ct < 8; ++ct) { acc[ct] = (f32x4){0.f, 0.f, 0.f, 0.f}; acc[ct] = mma16(acc[ct], Wt + t0 * 136, 136, vT + (16 * ct) * 136, 136, Keff, r, q4); }
#pragma unroll
    for (int i = 0; i < 4; ++i) { const int t = t0 + 4 * q4 + i; const float bs = P.gmlp_b_s[g * 128 + t]; const size_t tok = (size_t)n * 128 + t;
#pragma unroll
        for (int ct = 0; ct < 8; ++ct) { const int c = 16 * ct + r; const float u = bf2f(PU[tok * 512 + g * 128 + c]); MIX[tok * 1024 + g * 128 + c] = (bf16)f2bf(u * (acc[ct][i] + bs)); } }
    __syncthreads();
}
__device__ __forceinline__ void hgrn_cumsum16(const float* G, size_t tok0, int hh, int k, int seg, LAS float* tot, float (&g)[16], float (&bb)[16], float& total) {
    const float* gp = G + (tok0 + seg * 16) * 512 + hh * 128 + k;
#pragma unroll
    for (int j = 0; j < 16; ++j) g[j] = gp[(size_t)j * 512];
    float run = 0.f;
#pragma unroll
    for (int j = 0; j < 16; ++j) { run += g[j]; bb[j] = run; }
    tot[seg * 128 + k] = run;
    __syncthreads();
    const float t0 = tot[k], t1 = tot[128 + k], t2 = tot[256 + k], t3 = tot[384 + k];
    const float pre = seg == 0 ? 0.f : seg == 1 ? t0 : seg == 2 ? t0 + t1 : t0 + t1 + t2;
    total = (t0 + t1) + (t2 + t3);
#pragma unroll
    for (int j = 0; j < 16; ++j) bb[j] += pre;
}
__device__ __forceinline__ void hgrn_stage_iT(const bf16* PI, size_t tok0, int hh, LAS bf16* iT, int tid) {
    const int s = tid >> 3, v0 = (tid & 7) * 16; const bf16* src = PI + (tok0 + s) * 512 + hh * 128 + v0;
#pragma unroll
    for (int h2 = 0; h2 < 2; ++h2) { const v4u w = *(const v4u*)(src + 8 * h2);
#pragma unroll
        for (int e = 0; e < 4; ++e) { iT[(v0 + 8 * h2 + 2 * e) * 72 + s] = (bf16)(w[e] & 0xffffu); iT[(v0 + 8 * h2 + 2 * e + 1) * 72 + s] = (bf16)(w[e] >> 16); } }
}
__device__ __forceinline__ void hgrn_local_item(const Params& P, const Ctx& C, const Wk& W, int item) {
    LAS bf16* khT = (LAS bf16*)C.lds;
    LAS bf16* iT = (LAS bf16*)(C.lds + 18432);
    LAS float* tot = (LAS float*)(C.lds + 36864);
    const float* G = w_tok32(P, W, AR_G, 512); const bf16* PI = w_tok16(P, W, AR_PI, 512); bf16* KVT = w_item16(P, W, AR_KVT); float* HD = (float*)(P.ws + WS_HD);
    const int bh = item >> 7, c = item & 127, b = bh >> 2, hh = bh & 3; const size_t tok0 = (size_t)b * SEQ + c * 64;
    const int tid = C.tid, k = tid & 127, seg = tid >> 7, r = C.lane & 15, q4 = C.lane >> 4;
    float g[16], bb[16], total;
    hgrn_cumsum16(G, tok0, hh, k, seg, tot, g, bb, total);
    { unsigned w[8];
#pragma unroll
      for (int j = 0; j < 8; ++j) { const float a0 = -expm1f(g[2 * j]) * __expf(total - bb[2 * j]), a1 = -expm1f(g[2 * j + 1]) * __expf(total - bb[2 * j + 1]); w[j] = pk2(a0, a1); }
      LAS v4u* dst = (LAS v4u*)(khT + k * 72 + seg * 16); dst[0] = (v4u){w[0], w[1], w[2], w[3]}; dst[1] = (v4u){w[4], w[5], w[6], w[7]}; }
    if (seg == 0) HD[(size_t)item * 128 + k] = __expf(total);
    hgrn_stage_iT(PI, tok0, hh, iT, tid);
    __syncthreads();
    const int v0 = 16 * C.wave;
#pragma unroll
    for (int ct = 0; ct < 8; ++ct) { f32x4 acc = (f32x4){0.f, 0.f, 0.f, 0.f}; acc = mma16(acc, iT + v0 * 72, 72, khT + (16 * ct) * 72, 72, 64, r, q4);
#pragma unroll
        for (int i = 0; i < 4; ++i) KVT[((size_t)item * 128 + v0 + 4 * q4 + i) * 128 + 16 * ct + r] = (bf16)f2bf(acc[i]); }
    __syncthreads();
}
__device__ __forceinline__ void phase_hgrn_scan(const Params& P, const Ctx& C, const Wk& W) {
    const bf16* KVT = w_item16(P, W, AR_KVT); bf16* ST = w_item16(P, W, AR_ST); const float* HD = (const float*)(P.ws + WS_HD);
    for (int task = W.lv * 256 + C.tid; C.tid < 256 && task < 32768; task += W.n * 256) {
        const int bh = W_BT0(W) * 4 + (task >> 11), v = (task >> 4) & 127, kb = task & 15;
        float st[8];
#pragma unroll
        for (int e = 0; e < 8; ++e) st[e] = 0.f;
#pragma unroll 4
        for (int c = 0; c < 128; ++c) { const size_t item = (size_t)bh * 128 + c, off = (item * 128 + v) * 128 + kb * 8;
            const v4u kv = *(const v4u*)(KVT + off); const f32x4 d0 = *(const f32x4*)(HD + item * 128 + kb * 8), d1 = *(const f32x4*)(HD + item * 128 + kb * 8 + 4);
            v4u o; o.x = pk2(st[0], st[1]); o.y = pk2(st[2], st[3]); o.z = pk2(st[4], st[5]); o.w = pk2(st[6], st[7]);
            *(v4u*)(ST + off) = o;
#pragma unroll
            for (int e = 0; e < 4; ++e) { st[2 * e] = (e < 2 ? d0[2 * e] : d1[2 * e - 4]) * st[2 * e] + bflo(kv[e]); st[2 * e + 1] = (e < 2 ? d0[2 * e + 1] : d1[2 * e - 3]) * st[2 * e + 1] + bfhi(kv[e]); }
        }
    }
}
__device__ __forceinline__ void hgrn_out_item(const Params& P, const Ctx& C, const Wk& W, int item) {
    LAS bf16* qt = (LAS bf16*)C.lds;
    LAS bf16* kt = (LAS bf16*)(C.lds + 17408);
    LAS bf16* iT = (LAS bf16*)(C.lds + 34816);
    LAS bf16* A1 = (LAS bf16*)(C.lds + 53248);
    LAS bf16* STl = (LAS bf16*)(C.lds + 62464);
    LAS float* ol = (LAS float*)(C.lds + 97280);
    LAS float* tot = (LAS float*)(C.lds + 131072);
    const float* G = w_tok32(P, W, AR_G, 512); const bf16* PQ = w_tok16(P, W, AR_PQ, 512); const bf16* PI = w_tok16(P, W, AR_PI, 512); const bf16* PG = w_tok16(P, W, AR_PG, 512);
    const bf16* ST = w_item16(P, W, AR_ST); bf16* MIX = (bf16*)(P.ws + WS_H);
    const int bh = item >> 7, c = item & 127, b = bh >> 2, hh = bh & 3; const size_t tok0 = (size_t)b * SEQ + c * 64;
    const int tid = C.tid, k = tid & 127, seg = tid >> 7, r = C.lane & 15, q4 = C.lane >> 4;
    float g[16], bb[16], total;
    hgrn_cumsum16(G, tok0, hh, k, seg, tot, g, bb, total);
#pragma unroll
    for (int j = 0; j < 16; ++j) { const int t = seg * 16 + j; const float qv = bf2f(PQ[(tok0 + t) * 512 + hh * 128 + k]);
        qt[t * 136 + k] = (bf16)f2bf(qv * __expf(bb[j])); kt[t * 136 + k] = (bf16)f2bf(-expm1f(g[j]) * __expf(-bb[j])); }
    hgrn_stage_iT(PI, tok0, hh, iT, tid);
    for (int ch = tid; ch < 2048; ch += 512) { const int rr = ch >> 4, c8 = (ch & 15) * 8; *(LAS v4u*)(STl + rr * 136 + c8) = *(const v4u*)(ST + ((size_t)item * 128 + rr) * 128 + c8); }
    __syncthreads();
    { const int rt = C.wave >> 1;
#pragma unroll
      for (int cc = 0; cc < 2; ++cc) { const int ct = (C.wave & 1) * 2 + cc; f32x4 acc = (f32x4){0.f, 0.f, 0.f, 0.f};
          acc = mma16(acc, qt + (16 * rt) * 136, 136, kt + (16 * ct) * 136, 136, 128, r, q4);
#pragma unroll
          for (int i = 0; i < 4; ++i) { const int t = 16 * rt + 4 * q4 + i, s = 16 * ct + r; A1[t * 72 + s] = (bf16)(s <= t ? f2bf(acc[i]) : 0u); } } }
    __syncthreads();
    { const int rt = C.wave >> 1;
#pragma unroll
      for (int cc = 0; cc < 4; ++cc) { const int ct = (C.wave & 1) * 4 + cc; f32x4 acc = (f32x4){0.f, 0.f, 0.f, 0.f};
          acc = mma16(acc, A1 + (16 * rt) * 72, 72, iT + (16 * ct) * 72, 72, 64, r, q4);
          acc = mma16(acc, qt + (16 * rt) * 136, 136, STl + (16 * ct) * 136, 136, 128, r, q4);
#pragma unroll
          for (int i = 0; i < 4; ++i) ol[(16 * rt + 4 * q4 + i) * 132 + 16 * ct + r] = acc[i]; } }
    __syncthreads();
    { const int t = tid >> 3, v0 = (tid & 7) * 16; float o[16]; float ss = 0.f;
#pragma unroll
      for (int e = 0; e < 16; ++e) { o[e] = ol[t * 132 + v0 + e]; ss += o[e] * o[e]; }
      ss += __shfl_xor(ss, 1); ss += __shfl_xor(ss, 2); ss += __shfl_xor(ss, 4);
      const float rstd = 1.0f / sqrtf(ss * (1.0f / 128.0f) + NORM_EPS);
      const float* ng = P.hgrn_norm_g + hh * 128 + v0; const bf16* gp = PG + (tok0 + t) * 512 + hh * 128 + v0;
      const v4u g0 = *(const v4u*)gp, g1 = *(const v4u*)(gp + 8); unsigned w[8];
#pragma unroll
      for (int e = 0; e < 4; ++e) { w[e] = pk2(o[2 * e] * rstd * ng[2 * e] * bflo(g0[e]), o[2 * e + 1] * rstd * ng[2 * e + 1] * bfhi(g0[e]));
                                    w[4 + e] = pk2(o[8 + 2 * e] * rstd * ng[8 + 2 * e] * bflo(g1[e]), o[9 + 2 * e] * rstd * ng[9 + 2 * e] * bfhi(g1[e])); }
      v4u* dst = (v4u*)(MIX + (tok0 + t) * 1024 + 512 + hh * 128 + v0); dst[0] = (v4u){w[0], w[1], w[2], w[3]}; dst[1] = (v4u){w[4], w[5], w[6], w[7]}; }
    __syncthreads();
}

typedef short v4i16_t __attribute__((ext_vector_type(4)));
constexpr int AT_VP = 144;
constexpr int AT_QI = 512;
constexpr int AT_STO = 0, AT_STML = AT_QI * 128, AT_VW = AT_STML + AT_QI * 8;
__device__ __forceinline__ void attn_softmax_block(f32x4 (&sa)[9], int tile0, int qq, int mq0, int q4, float& mx, float& ls, bf16x8 (&pf)[5]) {
    const int lo4 = (qq > 128 - mq0 ? qq : 128 - mq0) - 4 * q4, hi4 = qq + 128 - 4 * q4;
    mx = -1e30f;
#pragma unroll
    for (int t = 0; t < 9; ++t)
#pragma unroll
        for (int i = 0; i < 4; ++i) { const int K0 = 16 * (tile0 + t) + i; const bool ok = K0 >= lo4 && K0 <= hi4;
            sa[t][i] = ok ? sa[t][i] : -1e30f; mx = fmaxf(mx, sa[t][i]); }
    mx = fmaxf(mx, __shfl_xor(mx, 16)); mx = fmaxf(mx, __shfl_xor(mx, 32));
    ls = 0.f;
#pragma unroll
    for (int t = 0; t < 9; ++t)
#pragma unroll
        for (int i = 0; i < 4; ++i) { const float pv = __builtin_amdgcn_exp2f(sa[t][i] - mx); sa[t][i] = pv; ls += pv; }
    ls += __shfl_xor(ls, 16); ls += __shfl_xor(ls, 32);
#pragma unroll
    for (int s2 = 0; s2 < 5; ++s2) { const int tl = 2 * s2 - tile0, th = 2 * s2 + 1 - tile0;
        const f32x4 lo = (tl >= 0 && tl < 9) ? sa[(tl >= 0 && tl < 9) ? tl : 0] : (f32x4){0.f, 0.f, 0.f, 0.f}, hi = (th >= 0 && th < 9) ? sa[(th >= 0 && th < 9) ? th : 0] : (f32x4){0.f, 0.f, 0.f, 0.f};
        v4u w; w.x = pk2(lo[0], lo[1]); w.y = pk2(lo[2], lo[3]); w.z = pk2(hi[0], hi[1]); w.w = pk2(hi[2], hi[3]); pf[s2] = __builtin_bit_cast(bf16x8, w); }
}
__device__ __forceinline__ void attn_merge(int g, LAS unsigned char* lds, int qloc, int q4, f32x4 (&oa)[4], float mx, float ls, bf16* orow) {
    LAS unsigned char* so = lds + AT_STO + qloc * 128 + 8 * q4; LAS float* sml = (LAS float*)(lds + AT_STML) + 2 * qloc;
    float mo = mx, lo2 = ls;
    if (g > 0) { const float m_old = sml[0], l_old = sml[1]; const float M = fmaxf(m_old, mx); const float fo = __builtin_amdgcn_exp2f(m_old - M), fn = __builtin_amdgcn_exp2f(mx - M);
#pragma unroll
        for (int dt = 0; dt < 4; ++dt) { const unsigned long long w = *(const LAS unsigned long long*)(so + 32 * dt); const unsigned w0 = (unsigned)w, w1 = (unsigned)(w >> 32);
            oa[dt] = oa[dt] * fn + (f32x4){bflo(w0), bfhi(w0), bflo(w1), bfhi(w1)} * fo; }
        mo = M; lo2 = ls * fn + l_old * fo; }
    if (g < 2) {
#pragma unroll
        for (int dt = 0; dt < 4; ++dt) *(LAS unsigned long long*)(so + 32 * dt) = (unsigned long long)pk2(oa[dt][0], oa[dt][1]) | ((unsigned long long)pk2(oa[dt][2], oa[dt][3]) << 32);
        if (q4 == 0) { sml[0] = mo; sml[1] = lo2; }
    } else { const float inv = 1.0f / lo2;
#pragma unroll
        for (int dt = 0; dt < 4; ++dt) { const f32x4 v = oa[dt] * inv; *(unsigned long long*)(orow + 16 * dt) = (unsigned long long)pk2(v[0], v[1]) | ((unsigned long long)pk2(v[2], v[3]) << 32); } }
}
__device__ __forceinline__ void attn_item(const Params& P, const Ctx& C, const Wk& W, int b, int hd, int qt) {
    LAS unsigned char* Vw = C.lds + AT_VW + C.wave * (64 * AT_VP);
    const bf16* QKV = (const bf16*)(w_ar(P, W) + AR_QK); bf16* O = (bf16*)(P.ws + WS_H); const int bl = b - W_BT0(W);
    const int lane = C.lane, r = lane & 15, q4 = lane >> 4;
    const int t0 = qt * AT_QI; const size_t rowbase = (size_t)b * SEQ;
    const bf16* Qh = QKV + (size_t)((0 * 4 + bl) * 16 + hd) * QK_ROWS * 64; const bf16* Kb = QKV + (size_t)((1 * 4 + bl) * 16 + hd) * QK_ROWS * 64; const bf16* Vb = QKV + (size_t)((2 * 4 + bl) * 16 + hd) * QK_ROWS * 64;
#pragma unroll 1
    for (int g = 0; g < 3; ++g) {
        const int dsh = 4 - 2 * g, d = 1 << dsh;
#pragma unroll 1
        for (int uu = 0; uu < 2; ++uu) {
            const int u = C.wave + 8 * uu;
            const int c = u & (d - 1), j = u >> dsh;
            const int mq0 = (t0 >> dsh) + 32 * j;
            const int ql0 = c + d * (32 * j + r), ql1 = ql0 + 16 * d;
            const bf16* qp0 = Qh + (size_t)qk_row(t0 + ql0) * 64 + 8 * q4; const bf16* qp1 = Qh + (size_t)qk_row(t0 + ql1) * 64 + 8 * q4;
            const bf16x8 bq00 = *(const bf16x8*)qp0, bq01 = *(const bf16x8*)(qp0 + 32), bq10 = *(const bf16x8*)qp1, bq11 = *(const bf16x8*)(qp1 + 32);
            bf16x8 ka[10][2];
#pragma unroll
            for (int t = 0; t < 10; ++t) { int mk = mq0 - 128 + 16 * t + r; mk = mk < 0 ? 0 : mk;
                const unsigned ko = (unsigned)qk_row(c + (mk << dsh)) * 128u + 16u * q4; ka[t][0] = *(const bf16x8*)((const char*)Kb + ko); ka[t][1] = *(const bf16x8*)((const char*)Kb + ko + 64); }
            v4u vr[2][8];
#pragma unroll
            for (int it = 0; it < 8; ++it) { const int kap = 8 * it + (lane >> 3); int mk = mq0 - 128 + kap; mk = mk < 0 ? 0 : mk;
                vr[0][it] = *(const v4u*)((const char*)Vb + (unsigned)qk_row(c + (mk << dsh)) * 128u + (lane & 7) * 16u); }
            __builtin_amdgcn_sched_barrier(0);
            bf16x8 pf0[5], pf1[5]; float mx0, ls0, mx1, ls1;
            { f32x4 sa[9];
#pragma unroll
              for (int t = 0; t < 9; ++t) { sa[t] = (f32x4){0.f, 0.f, 0.f, 0.f}; sa[t] = __builtin_amdgcn_mfma_f32_16x16x32_bf16(ka[t][0], bq00, sa[t], 0, 0, 0); sa[t] = __builtin_amdgcn_mfma_f32_16x16x32_bf16(ka[t][1], bq01, sa[t], 0, 0, 0); }
              attn_softmax_block(sa, 0, r, mq0, q4, mx0, ls0, pf0); }
            { f32x4 sa[9];
#pragma unroll
              for (int t = 0; t < 9; ++t) { sa[t] = (f32x4){0.f, 0.f, 0.f, 0.f}; sa[t] = __builtin_amdgcn_mfma_f32_16x16x32_bf16(ka[t + 1][0], bq10, sa[t], 0, 0, 0); sa[t] = __builtin_amdgcn_mfma_f32_16x16x32_bf16(ka[t + 1][1], bq11, sa[t], 0, 0, 0); }
              __builtin_amdgcn_sched_barrier(0);
#pragma unroll
              for (int it = 0; it < 8; ++it) { const int kap = 64 + 8 * it + (lane >> 3); int mk = mq0 - 128 + kap; mk = mk < 0 ? 0 : mk;
                  vr[1][it] = *(const v4u*)((const char*)Vb + (unsigned)qk_row(c + (mk << dsh)) * 128u + (lane & 7) * 16u); }
              __builtin_amdgcn_sched_barrier(0);
              attn_softmax_block(sa, 1, 16 + r, mq0, q4, mx1, ls1, pf1); }
            v4u vr2[4];
#pragma unroll
            for (int it = 0; it < 4; ++it) { const int kap = 128 + 8 * it + (lane >> 3); const int mk = mq0 - 128 + kap;
                vr2[it] = *(const v4u*)((const char*)Vb + (unsigned)qk_row(c + (mk << dsh)) * 128u + (lane & 7) * 16u); }
            f32x4 oa0[4], oa1[4];
#pragma unroll
            for (int dt = 0; dt < 4; ++dt) { oa0[dt] = (f32x4){0.f, 0.f, 0.f, 0.f}; oa1[dt] = (f32x4){0.f, 0.f, 0.f, 0.f}; }
#pragma unroll
            for (int ch = 0; ch < 3; ++ch) {
#pragma unroll
                for (int it = 0; it < 8; ++it) { const int row = 8 * it + (lane >> 3);
                    if (ch < 2) *(LAS v4u*)(Vw + row * AT_VP + (lane & 7) * 16) = vr[ch < 2 ? ch : 0][it];
                    else if (it < 4) *(LAS v4u*)(Vw + row * AT_VP + (lane & 7) * 16) = vr2[it < 4 ? it : 0]; }
                asm volatile("s_waitcnt lgkmcnt(0)" ::: "memory");
#pragma unroll
                for (int s2 = 0; s2 < 2; ++s2) { const int sx = 2 * ch + s2; if (sx < 5) {
#pragma unroll
                    for (int dt = 0; dt < 4; ++dt) {
                        const LAS unsigned char* vp = Vw + (32 * s2 + 4 * q4 + (r >> 2)) * AT_VP + dt * 32 + (r & 3) * 8;
                        const v4i16_t x = __builtin_amdgcn_ds_read_tr16_b64_v4i16((LAS v4i16_t*)vp), y = __builtin_amdgcn_ds_read_tr16_b64_v4i16((LAS v4i16_t*)(vp + 16 * AT_VP));
                        const bf16x8 av = (bf16x8){x[0], x[1], x[2], x[3], y[0], y[1], y[2], y[3]};
                        oa0[dt] = __builtin_amdgcn_mfma_f32_16x16x32_bf16(av, pf0[sx], oa0[dt], 0, 0, 0);
                        oa1[dt] = __builtin_amdgcn_mfma_f32_16x16x32_bf16(av, pf1[sx], oa1[dt], 0, 0, 0); } } }
                asm volatile("s_waitcnt lgkmcnt(0)" ::: "memory");
            }
            attn_merge(g, C.lds, ql0, q4, oa0, mx0, ls0, O + (rowbase + t0 + ql0) * 1024 + hd * 64 + 4 * q4);
            attn_merge(g, C.lds, ql1, q4, oa1, mx1, ls1, O + (rowbase + t0 + ql1) * 1024 + hd * 64 + 4 * q4);
        }
        __syncthreads();
    }
}

__device__ __forceinline__ unsigned ordf(float s) { const unsigned u = __builtin_bit_cast(unsigned, s); return u ^ ((unsigned)((int)u >> 31) | 0x80000000u); }
__device__ __forceinline__ float unordf(unsigned v) { return __builtin_bit_cast(float, v ^ ((unsigned)((int)(~v) >> 31) | 0x80000000u)); }
__device__ __forceinline__ void ins16(unsigned (&top)[16], unsigned x) {
#pragma unroll
    for (int j = 0; j < 16; ++j) { const unsigned hi = top[j] > x ? top[j] : x; x = top[j] > x ? x : top[j]; top[j] = hi; }
}
#define CE_D(a, b) { const unsigned hi_ = (a) > (b) ? (a) : (b), lo_ = (a) > (b) ? (b) : (a); (a) = hi_; (b) = lo_; }
__device__ __forceinline__ void sort16_desc(unsigned (&v)[16]) {
#pragma unroll
    for (int k = 2; k <= 16; k <<= 1)
#pragma unroll
        for (int j = k >> 1; j > 0; j >>= 1)
#pragma unroll
            for (int i = 0; i < 16; ++i) { const int l = i ^ j; if (l > i) { if ((i & k) == 0) CE_D(v[i], v[l]) else CE_D(v[l], v[i]) } }
}
__device__ __forceinline__ void bitonic_merge16_desc(unsigned (&c)[16]) {
#pragma unroll
    for (int st = 8; st >= 1; st >>= 1)
#pragma unroll
        for (int j = 0; j < 16; ++j) if ((j & st) == 0) CE_D(c[j], c[j + st])
}
__device__ __forceinline__ void top16_of_two(unsigned (&a)[16], const unsigned (&b)[16]) {
#pragma unroll
    for (int j = 0; j < 16; ++j) a[j] = a[j] > b[15 - j] ? a[j] : b[15 - j];
    bitonic_merge16_desc(a);
}
__device__ __forceinline__ void merge16(unsigned (&top)[16], int mask) {
    unsigned o[16];
#pragma unroll
    for (int j = 0; j < 16; ++j) o[j] = (unsigned)__shfl_xor((int)top[j], mask);
    top16_of_two(top, o);
}
__device__ __forceinline__ void phase_peer_topk(const Params& P, const Ctx& C, const Wk& W, int layer) {
    LAS bf16* SK = (LAS bf16*)C.lds;
    const bf16* SKB = (const bf16*)(P.ws + WS_SKB) + (size_t)layer * 32768; const bf16* QP = w_tok16(P, W, AR_QP, 2048);
    int* IDX = (int*)(P.ws + WS_IDX); float* GATE = (float*)(P.ws + WS_GATE);
    for (int ch = C.tid; ch < 4096; ch += 512) { const int rr = ch >> 4, c8 = (ch & 15) * 8; *(LAS v4u*)(SK + rr * 136 + c8) = *(const v4u*)(SKB + (size_t)rr * 128 + c8); }
    __syncthreads();
    const int r = C.lane & 15, q4 = C.lane >> 4;
    const int gw = W.lv * NWAVES + C.wave, NGW = W.n * NWAVES;
    for (int grp = W_TK0(W) / 2 + gw; grp < W_TK0(W) / 2 + HT * 8 / 16; grp += NGW) {
        const size_t task = (size_t)grp * 16 + r;
        unsigned lst[2][16];
#pragma unroll
        for (int half = 0; half < 2; ++half) {
            bf16x8 bq[4];
#pragma unroll
            for (int ks = 0; ks < 4; ++ks) bq[ks] = *(const bf16x8*)(QP + task * 256 + half * 128 + ks * 32 + 8 * q4);
            unsigned ka[16], kb[16];
#pragma unroll
            for (int nt = 0; nt < 8; ++nt) { f32x4 acc = (f32x4){0.f, 0.f, 0.f, 0.f};
#pragma unroll
                for (int ks = 0; ks < 4; ++ks) { const bf16x8 a = *(const LAS bf16x8*)(SK + (half * 128 + 16 * nt + r) * 136 + ks * 32 + 8 * q4); acc = __builtin_amdgcn_mfma_f32_16x16x32_bf16(a, bq[ks], acc, 0, 0, 0); }
#pragma unroll
                for (int i = 0; i < 4; ++i) { const unsigned n = 16 * nt + 4 * q4 + i; const unsigned key = (ordf(acc[i]) & ~127u) | (127u - n); if (nt < 4) ka[4 * nt + i] = key; else kb[4 * (nt - 4) + i] = key; }
                if (nt == 3) sort16_desc(ka);
                __builtin_amdgcn_sched_barrier(0); }
            sort16_desc(kb); top16_of_two(ka, kb);
            merge16(ka, 16); merge16(ka, 32);
#pragma unroll
            for (int j = 0; j < 16; ++j) lst[half][j] = ka[j];
        }
        float v2[16]; unsigned e2[16];
#pragma unroll
        for (int j = 0; j < 16; ++j) { v2[j] = unordf(lst[1][j] & ~127u); e2[j] = 127u - (lst[1][j] & 127u); }
        float v1s[4]; unsigned e1s[4];
#pragma unroll
        for (int k = 0; k < 4; ++k) { const unsigned w = q4 == 0 ? lst[0][4 * k] : q4 == 1 ? lst[0][4 * k + 1] : q4 == 2 ? lst[0][4 * k + 2] : lst[0][4 * k + 3];
            v1s[k] = unordf(w & ~127u); e1s[k] = (127u - (w & 127u)) << 7; }
        unsigned top[16];
#pragma unroll
        for (int j = 0; j < 16; ++j) top[j] = (ordf(v1s[0] + v2[j]) & ~16383u) | e1s[0] | e2[j];
        sort16_desc(top);
#pragma unroll
        for (int j = 0; j < 3; ++j) ins16(top, (ordf(v1s[1] + v2[j]) & ~16383u) | e1s[1] | e2[j]);
        ins16(top, (ordf(v1s[2] + v2[0]) & ~16383u) | e1s[2] | e2[0]);
        ins16(top, (ordf(v1s[3] + v2[0]) & ~16383u) | e1s[3] | e2[0]);
        merge16(top, 16); merge16(top, 32);
        float ev[16]; float den = 0.f; const float mx = unordf(top[0] & ~16383u);
#pragma unroll
        for (int j = 0; j < 16; ++j) { ev[j] = __expf(unordf(top[j] & ~16383u) - mx); den += ev[j]; }
        const float inv = 1.0f / den;
        int* ip = IDX + task * 16; float* gp = GATE + task * 16;
        if (q4 == 0) { *(v4u*)(ip) = (v4u){top[0] & 16383u, top[1] & 16383u, top[2] & 16383u, top[3] & 16383u}; *(f32x4*)(gp) = (f32x4){ev[0] * inv, ev[1] * inv, ev[2] * inv, ev[3] * inv}; }
        else if (q4 == 1) { *(v4u*)(ip + 4) = (v4u){top[4] & 16383u, top[5] & 16383u, top[6] & 16383u, top[7] & 16383u}; *(f32x4*)(gp + 4) = (f32x4){ev[4] * inv, ev[5] * inv, ev[6] * inv, ev[7] * inv}; }
        else if (q4 == 2) { *(v4u*)(ip + 8) = (v4u){top[8] & 16383u, top[9] & 16383u, top[10] & 16383u, top[11] & 16383u}; *(f32x4*)(gp + 8) = (f32x4){ev[8] * inv, ev[9] * inv, ev[10] * inv, ev[11] * inv}; }
        else { *(v4u*)(ip + 12) = (v4u){top[12] & 16383u, top[13] & 16383u, top[14] & 16383u, top[15] & 16383u}; *(f32x4*)(gp + 12) = (f32x4){ev[12] * inv, ev[13] * inv, ev[14] * inv, ev[15] * inv}; }
    }
}
#ifndef EXP_LA
#define EXP_LA 7
#endif
typedef unsigned v2u __attribute__((ext_vector_type(2)));
struct ExpRow { v6u lo, hi; };
__device__ __forceinline__ void exp_issue(ExpRow& R, const unsigned char* T, int ex, int jl) {
    const unsigned oA = (unsigned)ex * (unsigned)TROW + 16u * (unsigned)jl, oB = (unsigned)ex * (unsigned)TROW + 512u + 8u * (unsigned)jl;
    const v4u loA = *(const v4u*)(T + oA), hiA = *(const v4u*)(T + oA + 256); const v2u loB = *(const v2u*)(T + oB), hiB = *(const v2u*)(T + oB + 128);
    R.lo = (v6u){loA.x, loA.y, loA.z, loA.w, loB.x, loB.y}; R.hi = (v6u){hiA.x, hiA.y, hiA.z, hiA.w, hiB.x, hiB.y};
}
__device__ __forceinline__ float exp_down(const ExpRow& R, const f32x2 (&hq)[32]) {
    f32x2 a2 = (f32x2){0.f, 0.f}, b2 = (f32x2){0.f, 0.f};
    { const f32x32v f = __builtin_amdgcn_cvt_scalef32_pk32_f32_fp6(R.lo, 1.0f);
#pragma unroll
      for (int p = 0; p < 16; p += 2) { a2 = a2 + (f32x2){f[2 * p], f[2 * p + 1]} * hq[p]; b2 = b2 + (f32x2){f[2 * p + 2], f[2 * p + 3]} * hq[p + 1]; } }
    { const f32x32v f = __builtin_amdgcn_cvt_scalef32_pk32_f32_fp6(R.hi, 1.0f);
#pragma unroll
      for (int p = 0; p < 16; p += 2) { a2 = a2 + (f32x2){f[2 * p], f[2 * p + 1]} * hq[16 + p]; b2 = b2 + (f32x2){f[2 * p + 2], f[2 * p + 3]} * hq[16 + p + 1]; } }
    a2 = a2 + b2;
    float a = a2.x + a2.y; asm volatile("" : "+v"(a));
    return a;
}
__device__ __forceinline__ void exp_up(const ExpRow& R, float wk, f32x2 (&oacc)[32]) {
    const f32x2 wk2 = (f32x2){wk, wk};
    { const f32x32v f = __builtin_amdgcn_cvt_scalef32_pk32_f32_fp6(R.lo, 1.0f);
#pragma unroll
      for (int p = 0; p < 16; ++p) oacc[p] = oacc[p] + wk2 * (f32x2){f[2 * p], f[2 * p + 1]}; }
    { const f32x32v f = __builtin_amdgcn_cvt_scalef32_pk32_f32_fp6(R.hi, 1.0f);
#pragma unroll
      for (int p = 0; p < 16; ++p) oacc[16 + p] = oacc[16 + p] + wk2 * (f32x2){f[2 * p], f[2 * p + 1]}; }
    asm volatile("" : "+v"(oacc[0]), "+v"(oacc[1]), "+v"(oacc[2]), "+v"(oacc[3]), "+v"(oacc[4]), "+v"(oacc[5]), "+v"(oacc[6]), "+v"(oacc[7]),
                      "+v"(oacc[8]), "+v"(oacc[9]), "+v"(oacc[10]), "+v"(oacc[11]), "+v"(oacc[12]), "+v"(oacc[13]), "+v"(oacc[14]), "+v"(oacc[15]));
    asm volatile("" : "+v"(oacc[16]), "+v"(oacc[17]), "+v"(oacc[18]), "+v"(oacc[19]), "+v"(oacc[20]), "+v"(oacc[21]), "+v"(oacc[22]), "+v"(oacc[23]),
                      "+v"(oacc[24]), "+v"(oacc[25]), "+v"(oacc[26]), "+v"(oacc[27]), "+v"(oacc[28]), "+v"(oacc[29]), "+v"(oacc[30]), "+v"(oacc[31]));
}
__device__ __forceinline__ float exp_rs(float a, float b, int mask, bool hi) { const float keep = hi ? b : a, send = hi ? a : b; return keep + __shfl_xor(send, mask); }
__device__ __forceinline__ void phase_peer_experts(const Params& P, const Ctx& Cin, const Wk& W, int layer, bool last) {
    const Ctx C = fresh_ctx(Cin);
    const unsigned char* TD = P.ws + WS_TAB8 + (size_t)(2 * layer) * TAB8_BYTES; const unsigned char* TU = P.ws + WS_TAB8 + (size_t)(2 * layer + 1) * TAB8_BYTES; const float* SD = (const float*)(P.ws + WS_SC8) + (size_t)(2 * layer) * 16384; bf16* H = (bf16*)(P.ws + WS_H);
    const int* IDX = (const int*)(P.ws + WS_IDX); const float* GATE = (const float*)(P.ws + WS_GATE); const float* MOD = (const float*)(P.ws + WS_MOD);
    const int lane = C.lane, grp = lane >> 4, jl = lane & 15;
    unsigned* ticket = (unsigned*)(P.ws + WS_CTL) + 96 + 2 * layer + W.h;
    const bool dyn = W.n != C.G;
    const int gws = W.lv * NWAVES + C.wave, NGWS = W.n * NWAVES;
    int tnext = gws; if (dyn) { if (lane == 0) tnext = (int)atomicAdd(ticket, 1u); tnext = __builtin_amdgcn_readfirstlane(tnext); }
    if (tnext >= HT) return;
#define SB __builtin_amdgcn_sched_barrier(0);
#define EXP_SRC(GS) (((GS) & 16) ? i1 : i0)
#define EXP_ISSUE(R, GS) { const int gs_ = (GS); const int src_ = EXP_SRC(gs_); exp_issue(R, (gs_ & 32) ? TU : TD, __shfl(src_, (grp << 4) | (gs_ & 15)), jl); }
    int tok = W_TK0(W) + tnext;
    if (dyn) { int tn = 0; if (lane == 0) tn = (int)atomicAdd(ticket, 1u); tnext = tn; } else tnext += NGWS;
    int i0 = IDX[(size_t)tok * 128 + lane], i1 = IDX[(size_t)tok * 128 + 64 + lane];
    float g0 = GATE[(size_t)tok * 128 + lane], g1 = GATE[(size_t)tok * 128 + 64 + lane];
    v4u hn[8];
#pragma unroll
    for (int c = 0; c < 8; ++c) hn[c] = *(const v4u*)(H + (size_t)tok * 1024 + 64 * jl + 8 * c);
    ExpRow R0, R1, R2, R3, R4, R5, R6, R7;
    EXP_ISSUE(R0, 0) EXP_ISSUE(R1, 1) EXP_ISSUE(R2, 2) EXP_ISSUE(R3, 3) EXP_ISSUE(R4, 4) EXP_ISSUE(R5, 5) EXP_ISSUE(R6, 6) SB
    bool more = true;
    while (more) {
        const int b = tok >> 13;
        f32x2 hq[32];
#pragma unroll
        for (int c = 0; c < 8; ++c) {
#pragma unroll
            for (int e = 0; e < 4; ++e) hq[c * 4 + e] = (f32x2){bflo(hn[c][e]), bfhi(hn[c][e])}; }
        const float sd0 = SD[(unsigned)i0], sd1 = SD[(unsigned)i1], su0 = SD[16384u + (unsigned)i0], su1 = SD[16384u + (unsigned)i1];
        float U0 = 0.f, U1 = 0.f, tprev = 0.f;
        const bool j1 = (jl & 1) != 0, j2 = (jl & 2) != 0, j4 = (jl & 4) != 0, j8 = (jl & 8) != 0;
#define EXP_EX(GS) __shfl(EXP_SRC(GS), (grp << 4) | ((GS) & 15))
#define EXP_TAB(GS) (((GS) & 32) ? TU : TD)
#define STEP1(S, RC, RI, PV) { const int ex_ = EXP_EX(g8 + (S) + 7); SB PV = exp_down(RC, hq); SB exp_issue(RI, EXP_TAB(g8 + (S) + 7), ex_, jl); SB }
#pragma unroll 1
        for (int it = 0; it < 4; ++it) {
            const int g8 = 8 * it;
            float p0, p1, p2, p3, p4, p5, p6, p7;
            STEP1(0, R0, R7, p0) STEP1(1, R1, R0, p1)
            const float q0 = exp_rs(p0, p1, 1, j1);
            STEP1(2, R2, R1, p2) STEP1(3, R3, R2, p3)
            const float q1 = exp_rs(p2, p3, 1, j1); const float r0 = exp_rs(q0, q1, 2, j2);
            STEP1(4, R4, R3, p4) STEP1(5, R5, R4, p5)
            const float q2 = exp_rs(p4, p5, 1, j1);
            STEP1(6, R6, R5, p6) STEP1(7, R7, R6, p7)
            const float q3 = exp_rs(p6, p7, 1, j1); const float r1 = exp_rs(q2, q3, 2, j2); const float t = exp_rs(r0, r1, 4, j4);
            if (it & 1) { const float u = exp_rs(tprev, t, 8, j8); if (it == 1) U0 = u; else U1 = u; } else tprev = t;
        }
#undef STEP1
        const float wk0 = g0 * gelu_f(U0 * sd0) * su0, wk1 = g1 * gelu_f(U1 * sd1) * su1;
        if (dyn) tnext = __builtin_amdgcn_readfirstlane(tnext);
        more = tnext < HT;
        const int tokn = more ? W_TK0(W) + tnext : tok;
        if (dyn) { int tn = 0; if (more && lane == 0) tn = (int)atomicAdd(ticket, 1u); tnext = tn; } else tnext += NGWS;
        const int i0n = IDX[(size_t)tokn * 128 + lane], i1n = IDX[(size_t)tokn * 128 + 64 + lane];
        const float g0n = GATE[(size_t)tokn * 128 + lane], g1n = GATE[(size_t)tokn * 128 + 64 + lane];
        f32x2 oacc[32];
#pragma unroll
        for (int e = 0; e < 32; ++e) oacc[e] = (f32x2){0.f, 0.f};
#define EXP_WK(GS) __shfl(((GS) & 16) ? wk1 : wk0, (grp << 4) | ((GS) & 15))
#define EXP_EX2(GS) __shfl((GS) >= 64 ? i0n : EXP_SRC(GS), (grp << 4) | ((GS) & 15))
#define STEP2(S, RC, RI) { const int ex_ = EXP_EX2(g8 + (S) + 7); const float wn_ = EXP_WK(g8 + (S) + 1); SB exp_up(RC, wkc, oacc); SB exp_issue(RI, EXP_TAB(g8 + (S) + 7), ex_, jl); wkc = wn_; SB }
        float wkc = EXP_WK(32);
#pragma unroll 1
        for (int it = 4; it < 8; ++it) {
            const int g8 = 8 * it;
            STEP2(0, R0, R7) STEP2(1, R1, R0) STEP2(2, R2, R1) STEP2(3, R3, R2) STEP2(4, R4, R3) STEP2(5, R5, R4) STEP2(6, R6, R5) STEP2(7, R7, R6)
        }
#undef STEP2
#undef EXP_EX2
#undef EXP_WK
#undef EXP_EX
#undef EXP_TAB
#pragma unroll
        for (int c = 0; c < 8; ++c) hn[c] = *(const v4u*)(H + (size_t)tokn * 1024 + 64 * jl + 8 * c);
        f32x2 h1[16];
        { const bool up = (grp & 2) != 0;
#pragma unroll
          for (int e = 0; e < 16; ++e) { const f32x2 keep = up ? oacc[16 + e] : oacc[e], send = up ? oacc[e] : oacc[16 + e]; h1[e] = keep + (f32x2){__shfl_xor(send.x, 32), __shfl_xor(send.y, 32)}; } }
        f32x2 h2[8];
        { const bool up = (grp & 1) != 0;
#pragma unroll
          for (int e = 0; e < 8; ++e) { const f32x2 keep = up ? h1[8 + e] : h1[e], send = up ? h1[e] : h1[8 + e]; h2[e] = keep + (f32x2){__shfl_xor(send.x, 16), __shfl_xor(send.y, 16)}; } }
        const int d0 = 64 * jl + 16 * grp;
        const float* g2p = MOD + (size_t)(layer * 8 + b) * 6144 + 5120 + d0; const float psc = ((ABL_ON >= (layer == 0 ? 2 : 4)) ? 1.f : 0.f) * (1.0f / EXP_REP);
        float* xp = P.out + (size_t)tok * 1024 + d0;
        float xn[16]; float ss = 0.f;
#pragma unroll
        for (int q = 0; q < 4; ++q) { const f32x4 xa = *(const f32x4*)(xp + 4 * q), ga = *(const f32x4*)(g2p + 4 * q);
            xn[4 * q] = xa[0] + psc * ga[0] * h2[2 * q].x; xn[4 * q + 1] = xa[1] + psc * ga[1] * h2[2 * q].y; xn[4 * q + 2] = xa[2] + psc * ga[2] * h2[2 * q + 1].x; xn[4 * q + 3] = xa[3] + psc * ga[3] * h2[2 * q + 1].y; }
#pragma unroll
        for (int e = 0; e < 16; ++e) ss += xn[e] * xn[e];
        const float rstd = 1.0f / sqrtf(wave_sum(ss) * (1.0f / 1024.0f) + NORM_EPS);
        if (!last) {
            const float* ng = P.norm_mix_g + (layer + 1) * 1024 + d0; const float* mb = MOD + (size_t)((layer + 1) * 8 + b) * 6144 + d0;
            unsigned w[8];
#pragma unroll
            for (int q = 0; q < 4; ++q) { *(f32x4*)(xp + 4 * q) = (f32x4){xn[4 * q], xn[4 * q + 1], xn[4 * q + 2], xn[4 * q + 3]}; }
#pragma unroll
            for (int e = 0; e < 8; ++e) w[e] = pk2(xn[2 * e] * rstd * ng[2 * e] * (1.0f + mb[1024 + 2 * e]) + mb[2 * e], xn[2 * e + 1] * rstd * ng[2 * e + 1] * (1.0f + mb[1024 + 2 * e + 1]) + mb[2 * e + 1]);
            v4u* hp = (v4u*)(H + (size_t)tok * 1024 + d0); hp[0] = (v4u){w[0], w[1], w[2], w[3]}; hp[1] = (v4u){w[4], w[5], w[6], w[7]};
        } else {
            const float* fg = P.final_norm_g + d0;
#pragma unroll
            for (int q = 0; q < 4; ++q) *(f32x4*)(xp + 4 * q) = (f32x4){xn[4 * q] * rstd * fg[4 * q], xn[4 * q + 1] * rstd * fg[4 * q + 1], xn[4 * q + 2] * rstd * fg[4 * q + 2], xn[4 * q + 3] * rstd * fg[4 * q + 3]};
        }
        i0 = i0n; i1 = i1n; g0 = g0n; g1 = g1n; tok = tokn;
    }
#undef EXP_ISSUE
#undef EXP_SRC
#undef SB
}

#ifndef NC_PER_XCD
#define NC_PER_XCD 16
#endif
#ifdef PROBE_SEL
#define SUBSTAMP(i) do { if (W.c == 0 && C.tid == 0) __hip_atomic_store((unsigned*)(P.ws + WS_CTL) + 128 + 16 * W.h + (i), (unsigned)__builtin_amdgcn_s_memrealtime(), __ATOMIC_RELAXED, __HIP_MEMORY_SCOPE_AGENT); } while (0)
#else
#define SUBSTAMP(i) do {} while (0)
#endif
__device__ __forceinline__ void run_C0(const Params& P, const Ctx& Cin, const Wk& W, const XcdBarrier& tb) {
    const Ctx C = fresh_ctx(Cin);
    SUBSTAMP(0);
    unsigned char* ws = P.ws; float* MOD = (float*)(ws + WS_MOD); bf16* H = (bf16*)(ws + WS_H);
    const size_t tk = (size_t)W_TK0(W); unsigned char* const ar = w_ar(P, W);
    phase_norm(P, C, W, P.x, P.norm_mix_g, 0, 0); xcd_barrier(tb); SUBSTAMP(1);
    { pg8::Gemm g{H + tk * 1024, (const bf16*)(ws + WS_WIN), HT, 3072, 1024}; pg8::StaticOrder S; S.init(HT, 3072, W.n, W.c);
      EpiInProj E{(bf16*)(ar + AR_PU), (bf16*)(ar + AR_PV), (bf16*)(ar + AR_PQ), (bf16*)(ar + AR_PI), (bf16*)(ar + AR_PG), (float*)(ar + AR_G), (const float*)(ws + WS_LB)};
      pg8::gemm_phase<EpiInProj, pg8::StaticOrder, true, true>(C.lds, g, S, E); } xcd_barrier(tb); SUBSTAMP(2);
    for (int it = W.lv; it < 1024; it += W.n) gmlp_item(P, C, W, W_TK0(W) / 128 + (it >> 2), it & 3);
    for (int it = W.lv; it < 2048; it += W.n) hgrn_local_item(P, C, W, W_BT0(W) * 512 + it);
    xcd_barrier(tb); SUBSTAMP(3);
    phase_hgrn_scan(P, C, W); xcd_barrier(tb); SUBSTAMP(4);
    for (int it = W.lv; it < 2048; it += W.n) hgrn_out_item(P, C, W, W_BT0(W) * 512 + it);
    xcd_barrier(tb); SUBSTAMP(5);
    { pg8::Gemm g{H + tk * 1024, (const bf16*)(ws + WS_WOUT0), HT, 1024, 1024}; pg8::StaticOrder S; S.init(HT, 1024, W.n, W.c);
      EpiResid E{P.x + tk * 1024, P.out + tk * 1024, MOD + 2048 + (size_t)W_BT0(W) * 6144, 1.f};
      pg8::gemm_phase<EpiResid, pg8::StaticOrder, true, true>(C.lds, g, S, E); } xcd_barrier(tb); SUBSTAMP(6);
    phase_norm(P, C, W, P.out, P.norm_ffn_g, 0, 3072); xcd_barrier(tb); SUBSTAMP(7);
    { pg8::Gemm g{H + tk * 1024, (const bf16*)(ws + WS_WQ0), HT, 2048, 1024}; pg8::StaticOrder S; S.init(HT, 2048, W.n, W.c);
      EpiBf16P E{(bf16*)(ar + AR_QP), 2048};
      pg8::gemm_phase<EpiBf16P, pg8::StaticOrder, true, true>(C.lds, g, S, E); }
    SUBSTAMP(9);
}
__device__ __forceinline__ void run_C1(const Params& P, const Ctx& Cin, const Wk& W, const XcdBarrier& tb) {
    const Ctx C = fresh_ctx(Cin);
    SUBSTAMP(0);
    unsigned char* ws = P.ws; float* MOD = (float*)(ws + WS_MOD); bf16* H = (bf16*)(ws + WS_H);
    const size_t tk = (size_t)W_TK0(W); unsigned char* const ar = w_ar(P, W);
    { pg8::Gemm g{H + tk * 1024, (const bf16*)(ws + WS_WQKV), HT, 3072, 1024}; pg8::StaticOrder S; S.init(HT, 3072, W.n, W.c);
      EpiQKRot E{(bf16*)(ar + AR_QK), (const float*)(ws + WS_CS) + tk * 16};
      pg8::gemm_phase<EpiQKRot, pg8::StaticOrder, true, true>(C.lds, g, S, E); } xcd_barrier(tb); SUBSTAMP(1);
    for (int it = W.lv; it < (NB / 2) * 16 * 16; it += W.n) attn_item(P, C, W, W_BT0(W) + (it >> 8), (it >> 4) & 15, it & 15);
    xcd_barrier(tb); SUBSTAMP(2);
    { pg8::Gemm g{H + tk * 1024, (const bf16*)(ws + WS_WOUT1), HT, 1024, 1024}; pg8::StaticOrder S; S.init(HT, 1024, W.n, W.c);
      EpiResid E{P.out + tk * 1024, P.out + tk * 1024, MOD + (size_t)8 * 6144 + 2048 + (size_t)W_BT0(W) * 6144, 1.f};
      pg8::gemm_phase<EpiResid, pg8::StaticOrder, true, true>(C.lds, g, S, E); } xcd_barrier(tb); SUBSTAMP(3);
    phase_norm(P, C, W, P.out, P.norm_ffn_g + 1024, 1, 3072); xcd_barrier(tb); SUBSTAMP(4);
    { pg8::Gemm g{H + tk * 1024, (const bf16*)(ws + WS_WQ1), HT, 2048, 1024}; pg8::StaticOrder S; S.init(HT, 2048, W.n, W.c);
      EpiBf16P E{(bf16*)(ar + AR_QP), 2048};
      pg8::gemm_phase<EpiBf16P, pg8::StaticOrder, true, true>(C.lds, g, S, E); }
    SUBSTAMP(9);
}
__device__ __forceinline__ void run_E(const Params& P, const Ctx& Cin, const Wk& W, const XcdBarrier& tb, int layer) {
    { const Ctx C = fresh_ctx(Cin); phase_peer_topk(P, C, W, layer); }
    xcd_barrier(tb);
    if (W.c == 0 && Cin.tid == 0) __hip_atomic_store((unsigned*)(P.ws + WS_CTL) + 112 + 2 * layer + W.h, 1u, __ATOMIC_RELAXED, __HIP_MEMORY_SCOPE_AGENT);
    phase_peer_experts(P, Cin, W, layer, layer == 1);
}
__device__ __forceinline__ void help_E(const Params& P, const Ctx& Cin, int h, int layer) {
    volatile LAS unsigned* okw = (volatile LAS unsigned*)(Cin.lds + LDSCTL_OFF + 192);
    if (Cin.tid == 0) { unsigned* flag = (unsigned*)(P.ws + WS_CTL) + 112 + 2 * layer + h; unsigned ok = 0u;
        for (unsigned sp = 0; sp < (1u << 16); ++sp) { if (__hip_atomic_load(flag, __ATOMIC_RELAXED, __HIP_MEMORY_SCOPE_AGENT) != 0u) { ok = 1u; break; } __builtin_amdgcn_s_sleep(8); }
        __builtin_amdgcn_fence(__ATOMIC_ACQUIRE, "agent"); asm volatile("s_waitcnt vmcnt(0)" ::: "memory");
        *okw = ok; }
    __syncthreads();
    const bool ok = *okw != 0u;
    __syncthreads();
    if (ok) { Wk W; W.lv = 0; W.n = 1; W.c = 1; W.h = h; phase_peer_experts(P, Cin, W, layer, layer == 1); }
}
__global__ void __launch_bounds__(NWAVES * 64, 2) hybrid_fwd(Params P) {
    extern __shared__ __attribute__((aligned(16))) unsigned char lds_raw[];
    Ctx C;
    C.lds = (LAS unsigned char*)lds_raw;
    C.tid = threadIdx.x; C.lane = C.tid & 63; C.wave = __builtin_amdgcn_readfirstlane(C.tid >> 6);
    C.G = gridDim.x; const int bx = blockIdx.x; C.vcu = (bx % 8) * (C.G / 8) + bx / 8;
    volatile LAS unsigned* MISC = (volatile LAS unsigned*)(C.lds + MISC_OFF);
    for (int u = C.tid; u < (LDS_BYTES - LDSCTL_OFF) / 4; u += NWAVES * 64) ((LAS unsigned*)(C.lds + LDSCTL_OFF))[u] = 0u;
    __syncthreads();
    unsigned* ctl = (unsigned*)(P.ws + WS_CTL);
    const int xl = bx & 7, jx = bx >> 3, perx = C.G / 8;
    const bool inC = jx < NC_PER_XCD;
    const int nC = 8 * NC_PER_XCD, nE = C.G - nC;
    const XcdBarrier bar_all = xcd_barrier_post(ctl + CW_BAR, MISC + 8);
    XcdBarrier bar_c; bar_c.bar = ctl + CW_BAR + XCD_BAR_WORDS; bar_c.x = bar_all.x; bar_c.st = MISC + 10; bar_c.G = (unsigned)nC;
    if (inC && C.tid == 0) (void)xb_add(&bar_c.bar[XB_XCNT(bar_c.x)], 1u);
    XcdBarrier bar_e; bar_e.bar = ctl + CW_BAR + 2 * XCD_BAR_WORDS; bar_e.x = bar_all.x; bar_e.st = MISC + 12; bar_e.G = (unsigned)nE;
    if (!inC && C.tid == 0) (void)xb_add(&bar_e.bar[XB_XCNT(bar_e.x)], 1u);
    Wk Wall; Wall.lv = C.vcu; Wall.n = C.G; Wall.c = bx; Wall.h = 0;
    Wk Wc; Wc.lv = xl * NC_PER_XCD + jx; Wc.n = nC; Wc.c = jx * 8 + xl; Wc.h = 0;
    Wk We; { const int je = jx - NC_PER_XCD, ne = perx - NC_PER_XCD; We.lv = xl * ne + je; We.n = nE; We.c = je * 8 + xl; We.h = 0; }
    phase_prologue(P, C);
    xcd_barrier(bar_all);
#ifdef PROBE_SEL
    unsigned long long tp0 = __builtin_amdgcn_s_memrealtime(), tp1 = 0, tp2 = 0, tp3 = 0, tp4 = 0, tp5 = 0, tpe1 = 0, tpe2 = 0, tpe3 = 0;
#define STAMP(v) v = __builtin_amdgcn_s_memrealtime()
#else
#define STAMP(v)
#endif
    Wall.h = 0; run_C0(P, C, Wall, bar_all); xcd_barrier(bar_all); STAMP(tp1);
    if (inC) { Wc.h = 1; run_C0(P, C, Wc, bar_c); help_E(P, C, 0, 0); } else { We.h = 0; run_E(P, C, We, bar_e, 0); }
    STAMP(tpe1);
#ifdef PROBE_SEL
    if (C.tid == 0) atomicMax(ctl + 80 + (inC ? 0 : 1), (unsigned)(tpe1 - tp1));
#endif
    xcd_barrier(bar_all); STAMP(tp2);
    if (inC) { Wc.h = 0; run_C1(P, C, Wc, bar_c); help_E(P, C, 1, 0); } else { We.h = 1; run_E(P, C, We, bar_e, 0); }
    STAMP(tpe2);
#ifdef PROBE_SEL
    if (C.tid == 0) atomicMax(ctl + 82 + (inC ? 0 : 1), (unsigned)(tpe2 - tp2));
#endif
    xcd_barrier(bar_all); STAMP(tp3);
    if (inC) { Wc.h = 1; run_C1(P, C, Wc, bar_c); help_E(P, C, 0, 1); } else { We.h = 0; run_E(P, C, We, bar_e, 1); }
    STAMP(tpe3);
#ifdef PROBE_SEL
    if (C.tid == 0) atomicMax(ctl + 84 + (inC ? 0 : 1), (unsigned)(tpe3 - tp3));
#endif
    xcd_barrier(bar_all); STAMP(tp4);
    Wall.h = 1; run_E(P, C, Wall, bar_all, 1);
#ifdef PROBE_SEL
    STAMP(tp5);
    { unsigned long long d = 0; const int sel = PROBE_SEL;
      if (sel == 0) d = tp1 - tp0; if (sel == 1) d = tp2 - tp1; if (sel == 2) d = tp3 - tp2; if (sel == 3) d = tp4 - tp3; if (sel == 4) d = tp5 - tp4;
      if (sel == 5 || sel == 8) d = tpe1 - tp1; if (sel == 6 || sel == 9) d = tpe2 - tp2; if (sel == 7 || sel == 10) d = tpe3 - tp3;
      const int who = sel >= 8 ? 8 * NC_PER_XCD : 0;
      if (sel >= 20) { const unsigned* sp = (const unsigned*)(P.ws + WS_CTL) + 128 + 16 * PROBE_HALF; const int i = sel - 20; const int nxt = (i == PROBE_LAST) ? 9 : i + 1; d = (unsigned long long)(__hip_atomic_load(sp + nxt, __ATOMIC_RELAXED, __HIP_MEMORY_SCOPE_AGENT) - __hip_atomic_load(sp + i, __ATOMIC_RELAXED, __HIP_MEMORY_SCOPE_AGENT)); }
      if (sel >= 30) d = 0;
      if (bx == (sel >= 20 ? 0 : who) && C.tid == 0) __hip_atomic_store(ctl + 64, (unsigned)d, __ATOMIC_RELAXED, __HIP_MEMORY_SCOPE_AGENT);
      xcd_barrier(bar_all);
      if (bx == 0 && C.tid == 0) { const unsigned dd = sel >= 30 ? __hip_atomic_load(ctl + 80 + (sel - 30), __ATOMIC_RELAXED, __HIP_MEMORY_SCOPE_AGENT) : __hip_atomic_load(ctl + 64, __ATOMIC_RELAXED, __HIP_MEMORY_SCOPE_AGENT);
        const unsigned long long t0_ = __builtin_amdgcn_s_memrealtime(); while (__builtin_amdgcn_s_memrealtime() - t0_ < 4ull * dd) __builtin_amdgcn_s_sleep(32); } }
#endif
}

extern "C" void kernel_launch(void* const* d_in, const int* in_sizes, int n_in, void* d_out, int out_size, void* d_ws, size_t ws_size, hipStream_t stream) {
    static int grid = 0;
    if (grid == 0) {
        if (n_in != 22 || in_sizes[0] != T * DM || out_size != T * DM || ws_size < WS_END) {
            fprintf(stderr, "kernel_launch: unexpected shapes (n_in %d, in0 %d, out %d, ws %zu); nothing launched\n", n_in, n_in > 0 ? in_sizes[0] : -1, out_size, ws_size); grid = -1; return; }
        int dev = 0, cus = 0;
        if (hipGetDevice(&dev) != hipSuccess || hipDeviceGetAttribute(&cus, hipDeviceAttributeMultiprocessorCount, dev) != hipSuccess) { fprintf(stderr, "kernel_launch: device query failed\n"); grid = -1; return; }
        if (hipFuncSetAttribute((const void*)hybrid_fwd, hipFuncAttributeMaxDynamicSharedMemorySize, LDS_BYTES) != hipSuccess) { fprintf(stderr, "kernel_launch: hipFuncSetAttribute failed\n"); grid = -1; return; }
        (void)hipGetLastError();
        grid = cus;
        if (grid % 8 != 0 || grid / 8 <= NC_PER_XCD) { fprintf(stderr, "kernel_launch: built for a CU count that is a multiple of 8 and > %d; got %d; nothing launched\n", 8 * NC_PER_XCD, grid); grid = -1; return; }
    }
    if (grid < 0) return;
    if (hipMemsetAsync((char*)d_ws + WS_CTL, 0, CTL_ZERO_BYTES, stream) != hipSuccess) { fprintf(stderr, "kernel_launch: memset failed\n"); return; }
    Params p{};
    p.x = (const float*)d_in[0]; p.c = (const float*)d_in[1]; p.positions = (const int*)d_in[2]; p.ada_w = (const float*)d_in[3]; p.ada_b = (const float*)d_in[4];
    p.norm_mix_g = (const float*)d_in[5]; p.norm_ffn_g = (const float*)d_in[6]; p.final_norm_g = (const float*)d_in[7]; p.even_w_in = (const float*)d_in[8]; p.even_w_out = (const float*)d_in[9];
    p.gmlp_ln_g = (const float*)d_in[10]; p.gmlp_ln_b = (const float*)d_in[11]; p.gmlp_w_s = (const float*)d_in[12]; p.gmlp_b_s = (const float*)d_in[13]; p.hgrn_lb_logits = (const float*)d_in[14];
    p.hgrn_norm_g = (const float*)d_in[15]; p.odd_w_qkv = (const float*)d_in[16]; p.odd_w_out = (const float*)d_in[17]; p.peer_w_query = (const float*)d_in[18]; p.peer_sub_keys = (const float*)d_in[19];
    p.peer_down = (const float*)d_in[20]; p.peer_up = (const float*)d_in[21];
    p.out = (float*)d_out; p.ws = (unsigned char*)d_ws;
    p.ph_lo = 0; p.ph_hi = 0;
    hipLaunchKernelGGL(hybrid_fwd, dim3(grid), dim3(NWAVES * 64), LDS_BYTES, stream, p);
    const hipError_t le = hipPeekAtLastError();
    if (le != hipSuccess) fprintf(stderr, "kernel_launch: launch failed: %s\n", hipGetErrorName(le));
}
```

```cpp
#include <hip/hip_runtime.h>
#include <cstdio>
#include <cstdint>
#include <cmath>
namespace pg8 {
#define PG8_LAS __attribute__((address_space(3)))
typedef unsigned short bf16_t;
typedef short bf16x8 __attribute__((ext_vector_type(8)));
typedef float f32x4 __attribute__((ext_vector_type(4)));
typedef unsigned u32x4 __attribute__((ext_vector_type(4)));
constexpr int BM = 256, BK = 64, HALF = 128, HTB = HALF * BK * 2  , STAGE_BYTES = 8 * HTB, NXCD = 8, WGM = 8;

__host__ __device__ __forceinline__ int lds_byte(int r, int c) { const int st = (r >> 4) * 2 + (c >> 5), rr = r & 15, cc = c & 31, ob = rr * 64 + cc * 2; return st * 1024 + (ob ^ (((ob >> 9) & 1) << 5)); }
__host__ __device__ __forceinline__ void stage_rc(int b, int& R, int& C) { const int st = b / 1024, sb = b % 1024, swz = sb ^ (((sb >> 9) & 1) << 5); R = (st >> 1) * 16 + swz / 64; C = (st & 1) * 32 + (swz % 64) / 2; }
__host__ __device__ __forceinline__ int perm32(int rho) { const int n = rho >> 4, i = rho & 15; return 8 * (i >> 2) + 4 * n + (i & 3); }

struct Unit { int pm, pn; };
struct Gemm { const bf16_t* A; const bf16_t* Bt; int M, N, K; };

struct StaticOrder {
    int nM, nN, nwg, G, c;
    __host__ __device__ void init(int M, int N, int G_, int c_) { nM = M / BM; nN = N / BM; nwg = nM * nN; G = G_; c = c_; }
    __host__ __device__ bool next(int i, Unit& u) const {
        const long L = (long)i * G + c; if (L >= nwg) return false;
        int wgid = (int)L; { const int q = nwg / NXCD, r = nwg % NXCD, xcd = wgid % NXCD, off = wgid / NXCD; wgid = (xcd < r ? xcd * (q + 1) : r * (q + 1) + (xcd - r) * q) + off; }
        const int nig = WGM * nN, gid = wgid / nig, fm = gid * WGM, gsz = (nM - fm) < WGM ? (nM - fm) : WGM;
        u.pm = fm + ((wgid % nig) % gsz); u.pn = (wgid % nig) / gsz; return true;
    }
    __device__ __forceinline__ void a_ready(const Unit&) const {}
    __device__ __forceinline__ void done(const Unit&) const {}
};

__device__ __forceinline__ unsigned cvt_pk_bf16(float lo, float hi) { unsigned r; asm volatile("v_cvt_pk_bf16_f32 %0, %1, %2" : "=v"(r) : "v"(lo), "v"(hi)); return r; }
typedef float f32x2 __attribute__((ext_vector_type(2)));
__device__ __forceinline__ f32x2 gelu_pk(f32x2 v) {
    const f32x2 av = __builtin_elementwise_abs(v), d = av * 0.2316418882f + 1.0f;
    f32x2 t; t.x = __builtin_amdgcn_rcpf(d.x); t.y = __builtin_amdgcn_rcpf(d.y);
    f32x2 q = t * 0.5307027145f + (-0.7265760135f); q = q * t + 0.7107068705f; q = q * t + (-0.142248368f); q = q * t + 0.127414796f; q = q * t;
    const f32x2 s = (v * v) * (-0.72134752044f);
    f32x2 e; e.x = __builtin_amdgcn_exp2f(s.x); e.y = __builtin_amdgcn_exp2f(s.y);
    const f32x2 m = v * (q * e), r = v - m;
    f32x2 o; o.x = v.x < 0.f ? m.x : r.x; o.y = v.y < 0.f ? m.y : r.y; return o;
}

template <class Epi, class Sched, bool ALIGN_EPI = false, bool SP2 = false>
__device__ __forceinline__ void gemm_phase(PG8_LAS unsigned char* lds, const Gemm g, const Sched& S, const Epi& E) {
    int tid_ = threadIdx.x; asm volatile("" : "+v"(tid_));
    const int tid = tid_, wid = __builtin_amdgcn_readfirstlane(tid >> 6), lane = tid & 63, wr = wid >> 2, wc = wid & 3, fr = lane & 15, fq = lane >> 4;
    const int K = g.K, nt = K / BK;
    unsigned voffA[2], voffB[2];
#pragma unroll
    for (int i = 0; i < 2; ++i) { int R, C; stage_rc(tid * 16 + i * 8192, R, C); const int Rb = Epi::PERM ? ((R & ~31) + perm32(R & 31)) : R;
        voffA[i] = (unsigned)(R * K + C) * 2u; voffB[i] = (unsigned)(Rb * K + C) * 2u; }
    const size_t kstep = (size_t)(BK * 2);
    const size_t hstep = (size_t)HALF * K * 2;
    const size_t tstep = 2 * hstep;
    const unsigned ldsw = (unsigned)wid * 1024u;
    const int aoff = lds_byte(wr * 64 + fr, fq * 8), boff = lds_byte(wc * 32 + fr, fq * 8);
#define PG8_SA(b, h) (((b) * 2 + (h)) * HTB)
#define PG8_SB(b, h) ((4 + (b) * 2 + (h)) * HTB)
#define PG8_STAGE(bufoff, gbase, voff) do { _Pragma("unroll") for (int _i = 0; _i < 2; ++_i) \
        __builtin_amdgcn_global_load_lds((const unsigned*)((const char*)(gbase) + (voff)[_i]), (PG8_LAS unsigned*)(lds + (bufoff) + ldsw + _i * 8192), 16, 0, 0); } while (0)
#define PG8_LDA(dst, b, h) do { _Pragma("unroll") for (int m = 0; m < 4; ++m) _Pragma("unroll") for (int k = 0; k < 2; ++k) dst[m][k] = *(const PG8_LAS bf16x8*)(lds + PG8_SA(b, h) + aoff + m * 2048 + k * 1024); } while (0)
#define PG8_LDB(dst, b, h) do { _Pragma("unroll") for (int n = 0; n < 2; ++n) _Pragma("unroll") for (int k = 0; k < 2; ++k) dst[n][k] = *(const PG8_LAS bf16x8*)(lds + PG8_SB(b, h) + boff + n * 2048 + k * 1024); } while (0)
#define PG8_MMA(ai, bj, At, Bt) do { __builtin_amdgcn_s_setprio(1); _Pragma("unroll") for (int m = 0; m < 4; ++m) _Pragma("unroll") for (int n = 0; n < 2; ++n) _Pragma("unroll") for (int k = 0; k < 2; ++k) \
        acc[ai][bj][m][n] = __builtin_amdgcn_mfma_f32_16x16x32_bf16(Bt[n][k], At[m][k], acc[ai][bj][m][n], 0, 0, 0); __builtin_amdgcn_s_setprio(0); } while (0)
#define PG8_WAIT_V(n) asm volatile("s_waitcnt vmcnt(" #n ")" ::: "memory")
#define PG8_WAIT_L(n) asm volatile("s_waitcnt lgkmcnt(" #n ")" ::: "memory")
#define PG8_BAR __builtin_amdgcn_s_barrier()
#define PG8_SCHED __builtin_amdgcn_sched_barrier(0)
    Unit cur, nxt; int ui = 0;
    if (!S.next(0, cur)) return;
    f32x4 acc[2][2][4][2];
#pragma unroll
    for (int a = 0; a < 2; ++a)
#pragma unroll
        for (int b = 0; b < 2; ++b)
#pragma unroll
            for (int m = 0; m < 4; ++m)
#pragma unroll
                for (int n = 0; n < 2; ++n) acc[a][b][m][n] = (f32x4){0.f, 0.f, 0.f, 0.f};
    bf16x8 At[4][2], B0[2][2], B1[2][2];
    const char* cA = (const char*)g.A + (size_t)cur.pm * tstep; const char* cB = (const char*)g.Bt + (size_t)cur.pn * tstep;
    S.a_ready(cur);
    if constexpr (SP2) {
        PG8_STAGE(PG8_SB(0, 0), cB, voffB); PG8_STAGE(PG8_SB(0, 1), cB + hstep, voffB); PG8_STAGE(PG8_SA(0, 0), cA, voffA); PG8_STAGE(PG8_SA(0, 1), cA + hstep, voffA);
        if (wr == 1) PG8_BAR;
        PG8_WAIT_V(2); PG8_BAR;
        PG8_STAGE(PG8_SB(1, 0), cB + kstep, voffB); PG8_STAGE(PG8_SA(1, 0), cA + kstep, voffA); PG8_STAGE(PG8_SB(1, 1), cB + hstep + kstep, voffB);
        PG8_WAIT_V(6); PG8_BAR;
    } else {
        PG8_STAGE(PG8_SB(0, 0), cB, voffB); PG8_STAGE(PG8_SA(0, 0), cA, voffA); PG8_STAGE(PG8_SB(0, 1), cB + hstep, voffB); PG8_STAGE(PG8_SA(0, 1), cA + hstep, voffA);
        if (wr == 1) PG8_BAR;
        PG8_WAIT_V(4); PG8_BAR;
        PG8_STAGE(PG8_SB(1, 0), cB + kstep, voffB); PG8_STAGE(PG8_SA(1, 0), cA + kstep, voffA); PG8_STAGE(PG8_SB(1, 1), cB + hstep + kstep, voffB);
        PG8_WAIT_V(6); PG8_BAR;
    }
    for (;;) {
        const bool has_next = S.next(ui + 1, nxt);
        const char* nA = has_next ? (const char*)g.A + (size_t)nxt.pm * tstep : cA; const char* nB = has_next ? (const char*)g.Bt + (size_t)nxt.pn * tstep : cB;
        for (int t = 0; t < nt; t += 2) {
            const bool last = (t == nt - 2);
            const char* a1 = cA + (size_t)(t + 1) * kstep;
            const char* a2 = last ? nA : cA + (size_t)(t + 2) * kstep; const char* b2 = last ? nB : cB + (size_t)(t + 2) * kstep;
            const char* a3 = a2 + kstep; const char* b3 = b2 + kstep;
            if (last && has_next) S.a_ready(nxt);
            if constexpr (SP2) {
            PG8_LDB(B0, 0, 0); PG8_LDB(B1, 0, 1); PG8_SCHED; PG8_LDA(At, 0, 0); PG8_STAGE(PG8_SA(1, 1), a1 + hstep, voffA);
            PG8_WAIT_V(8); PG8_WAIT_L(0); PG8_BAR; PG8_MMA(0, 0, At, B0); PG8_MMA(0, 1, At, B1); PG8_BAR; PG8_SCHED;
            PG8_LDA(At, 0, 1); PG8_STAGE(PG8_SB(0, 0), b2, voffB); PG8_STAGE(PG8_SB(0, 1), b2 + hstep, voffB); PG8_STAGE(PG8_SA(0, 0), a2, voffA);
            PG8_WAIT_V(8); PG8_WAIT_L(0); PG8_BAR; PG8_MMA(1, 0, At, B0); PG8_MMA(1, 1, At, B1); PG8_BAR; PG8_SCHED;
            PG8_LDB(B0, 1, 0); PG8_LDB(B1, 1, 1); PG8_SCHED; PG8_LDA(At, 1, 0); PG8_STAGE(PG8_SA(0, 1), a2 + hstep, voffA);
            PG8_WAIT_V(8); PG8_WAIT_L(0); PG8_BAR; PG8_MMA(0, 0, At, B0); PG8_MMA(0, 1, At, B1); PG8_BAR; PG8_SCHED;
            PG8_LDA(At, 1, 1); PG8_STAGE(PG8_SB(1, 0), b3, voffB); PG8_STAGE(PG8_SB(1, 1), b3 + hstep, voffB); PG8_STAGE(PG8_SA(1, 0), a3, voffA);
            PG8_WAIT_V(8); PG8_WAIT_L(0); PG8_BAR; PG8_MMA(1, 0, At, B0); PG8_MMA(1, 1, At, B1); PG8_BAR; PG8_SCHED;
            } else {
            PG8_LDB(B0, 0, 0); PG8_SCHED; PG8_LDA(At, 0, 0); PG8_STAGE(PG8_SA(1, 1), a1 + hstep, voffA);
            PG8_WAIT_L(8); PG8_BAR; PG8_WAIT_L(0); PG8_MMA(0, 0, At, B0); PG8_BAR; PG8_SCHED;
            PG8_LDB(B1, 0, 1); PG8_STAGE(PG8_SB(0, 0), b2, voffB);
            PG8_BAR; PG8_WAIT_L(0); PG8_MMA(0, 1, At, B1); PG8_BAR;
            PG8_LDA(At, 0, 1); PG8_STAGE(PG8_SA(0, 0), a2, voffA);
            PG8_BAR; PG8_WAIT_L(0); PG8_MMA(1, 0, At, B0); PG8_BAR; PG8_SCHED;
            PG8_STAGE(PG8_SB(0, 1), b2 + hstep, voffB);
            PG8_WAIT_V(6); PG8_BAR; PG8_MMA(1, 1, At, B1); PG8_BAR;
            PG8_LDB(B0, 1, 0); PG8_SCHED; PG8_LDA(At, 1, 0); PG8_STAGE(PG8_SA(0, 1), a2 + hstep, voffA);
            PG8_WAIT_L(8); PG8_BAR; PG8_WAIT_L(0); PG8_MMA(0, 0, At, B0); PG8_BAR; PG8_SCHED;
            PG8_LDB(B1, 1, 1); PG8_STAGE(PG8_SB(1, 0), b3, voffB);
            PG8_BAR; PG8_WAIT_L(0); PG8_MMA(0, 1, At, B1); PG8_BAR;
            PG8_LDA(At, 1, 1); PG8_STAGE(PG8_SA(1, 0), a3, voffA);
            PG8_BAR; PG8_WAIT_L(0); PG8_MMA(1, 0, At, B0); PG8_BAR; PG8_SCHED;
            PG8_STAGE(PG8_SB(1, 1), b3 + hstep, voffB);
            PG8_WAIT_V(6); PG8_BAR; PG8_MMA(1, 1, At, B1); PG8_BAR;
            }
        }
        if constexpr (ALIGN_EPI) { if (wr == 0) PG8_BAR; }
        if constexpr (!Epi::AFTER_DRAIN) { E(acc, cur, wr, wc, fr, fq); S.done(cur); }
        if (!has_next) break;
#pragma unroll
        for (int a = 0; a < 2; ++a)
#pragma unroll
            for (int b = 0; b < 2; ++b)
#pragma unroll
                for (int m = 0; m < 4; ++m)
#pragma unroll
                    for (int n = 0; n < 2; ++n) acc[a][b][m][n] = (f32x4){0.f, 0.f, 0.f, 0.f};
        cur = nxt; cA = nA; cB = nB; ++ui;
        if constexpr (ALIGN_EPI) { if (wr == 1) PG8_BAR; }
    }
    PG8_WAIT_V(0);
    if constexpr (!ALIGN_EPI) { if (wr == 0) PG8_BAR; }
    PG8_BAR;
    if constexpr (Epi::AFTER_DRAIN) { E.fused(acc, cur, wr, wc, fr, fq, lds, wid, lane); S.done(cur); }
#undef PG8_SA
#undef PG8_SB
#undef PG8_STAGE
#undef PG8_LDA
#undef PG8_LDB
#undef PG8_MMA
#undef PG8_WAIT_V
#undef PG8_WAIT_L
#undef PG8_BAR
#undef PG8_SCHED
}
}
#define GAS __attribute__((address_space(1)))
#define LAS __attribute__((address_space(3)))
typedef unsigned short bf16;
typedef unsigned v4u __attribute__((ext_vector_type(4)));
typedef float f32x4 __attribute__((ext_vector_type(4)));
typedef short bf16x8 __attribute__((ext_vector_type(8)));
typedef __bf16 bf16x2_t __attribute__((ext_vector_type(2)));
#define LDS_WAIT() asm volatile("s_waitcnt lgkmcnt(0)" ::: "memory")
#define VM_WAIT() asm volatile("s_waitcnt vmcnt(0)" ::: "memory")
typedef float f32x2_cv __attribute__((ext_vector_type(2)));
__device__ __forceinline__ unsigned pk2(float lo, float hi) { const f32x2_cv v = {lo, hi}; return __builtin_bit_cast(unsigned, __builtin_convertvector(v, bf16x2_t)); }
__device__ __forceinline__ unsigned f2bf(float f) { return pk2(f, 0.f) & 0xffffu; }
__device__ __forceinline__ float bflo(unsigned u) { return __builtin_bit_cast(float, u << 16); }
__device__ __forceinline__ float bfhi(unsigned u) { return __builtin_bit_cast(float, u & 0xffff0000u); }
__device__ __forceinline__ float bf2f(bf16 u) { return __builtin_bit_cast(float, (unsigned)u << 16); }
#define XB_TMO      128
#define XB_XCNT(j)  (256  + 64 * (j))
#define XB_XSUB(j)  (1280 + 64 * (j))
#define XB_XGEN(j)  (2304 + 64 * (j))
#define XB_TOP      3328
#define XB_TOPGEN   3392
#define XCD_BAR_WORDS 3456
#define XB_SPIN_CAP (1u << 18)

__device__ __forceinline__ unsigned xb_ld(unsigned* p)              { return __hip_atomic_load(p, __ATOMIC_RELAXED, __HIP_MEMORY_SCOPE_AGENT); }
__device__ __forceinline__ unsigned xb_add(unsigned* p, unsigned v) { return __hip_atomic_fetch_add(p, v, __ATOMIC_RELAXED, __HIP_MEMORY_SCOPE_AGENT); }
__device__ __forceinline__ unsigned xb_xcc_id() { return (unsigned)__builtin_amdgcn_s_getreg((3 << 11) | 20) & 0xFu; }
#define XB_SPIN(cond, bar) do { unsigned _sp = 0; while (cond) { __builtin_amdgcn_s_sleep(1); \
    if ((++_sp & 255u) == 0u) { if (xb_ld(&(bar)[XB_TMO])) break; if (_sp > XB_SPIN_CAP) { atomicAdd(&(bar)[XB_TMO], 1u); break; } } } } while (0)

struct XcdBarrier {
    unsigned* bar; unsigned x; unsigned G;
    volatile LAS unsigned* st;
};

__device__ __forceinline__ XcdBarrier xcd_barrier_post(unsigned* bar, volatile LAS unsigned* st) {
    XcdBarrier b; b.bar = bar; b.x = xb_xcc_id(); b.st = st; b.G = gridDim.x;
    if (threadIdx.x == 0) (void)xb_add(&bar[XB_XCNT(b.x)], 1u);
    return b;
}
__device__ __forceinline__ void xcd_barrier_complete(unsigned* bar, unsigned x, unsigned& nloc, unsigned& nx, const unsigned G) {
    unsigned sum, cnt, mine, sp = 0u;
    for (;;) {
        sum = 0u; cnt = 0u; mine = 0u;
#pragma unroll
        for (unsigned j = 0; j < 16; ++j) { const unsigned c = xb_ld(&bar[XB_XCNT(j)]); sum += c; cnt += (c > 0u) ? 1u : 0u; mine = (j == x) ? c : mine; }
        if (sum == G) break;
        __builtin_amdgcn_s_sleep(1);
        if ((++sp & 255u) == 0u) { if (xb_ld(&bar[XB_TMO])) break; if (sp > XB_SPIN_CAP) { atomicAdd(&bar[XB_TMO], 1u); break; } }
    }
    nloc = mine > 0u ? mine : 1u; nx = cnt > 0u ? cnt : 1u;
}

__device__ __forceinline__ void xcd_barrier(const XcdBarrier& b) {
    asm volatile("s_waitcnt vmcnt(0)" ::: "memory");
    __syncthreads();
    if (threadIdx.x == 0) {
        unsigned* bar = b.bar;
        __builtin_amdgcn_s_waitcnt(0);
        unsigned nloc = b.st[0], nx = b.st[1];
        if (nloc == 0u) { xcd_barrier_complete(bar, b.x, nloc, nx, b.G); b.st[0] = nloc; b.st[1] = nx; }
        const unsigned old = xb_add(&bar[XB_XSUB(b.x)], 1u);
        const unsigned gen = old / nloc;
        if (old + 1u == (gen + 1u) * nloc) {
            __builtin_amdgcn_fence(__ATOMIC_RELEASE, "agent");
            asm volatile("s_waitcnt vmcnt(0)" ::: "memory");
            const unsigned og = xb_add(&bar[XB_TOP], 1u);
            const unsigned tg = og / nx;
            if (og + 1u == (tg + 1u) * nx) xb_add(&bar[XB_TOPGEN], 1u);
            else XB_SPIN(xb_ld(&bar[XB_TOPGEN]) == tg, bar);
            __builtin_amdgcn_fence(__ATOMIC_ACQUIRE, "agent");
            xb_add(&bar[XB_XGEN(b.x)], 1u);
            asm volatile("s_waitcnt vmcnt(0)" ::: "memory");
        } else {
            XB_SPIN(xb_ld(&bar[XB_XGEN(b.x)]) == gen, bar);
            __builtin_amdgcn_fence(__ATOMIC_ACQUIRE, "agent");
            asm volatile("s_waitcnt vmcnt(0)" ::: "memory");
        }
    }
    __syncthreads();
}

constexpr int NB = 8, SEQ = 8192, DM = 1024, T = NB * SEQ;
constexpr int NWAVES = 8;
constexpr float NORM_EPS = 1e-6f;
constexpr float C2 = 0.125f * 1.4426950408889634f;

constexpr size_t MiB = 1u << 20;
constexpr size_t WS_CTL = 0, CTL_ZERO_BYTES = 1 * MiB;
constexpr size_t WS_MOD = 1 * MiB;
constexpr size_t WS_SKB = 1 * MiB + 512 * 1024;
constexpr size_t WS_WSB = 1 * MiB + 768 * 1024;
constexpr size_t WS_LB  = 1 * MiB + 960 * 1024;
constexpr size_t WS_CS  = 2 * MiB;
constexpr size_t WS_HD  = 6 * MiB;
constexpr size_t WS_WIN = 16 * MiB, WS_WOUT0 = 22 * MiB, WS_WQKV = 24 * MiB, WS_WOUT1 = 30 * MiB, WS_WQ0 = 32 * MiB, WS_WQ1 = 36 * MiB;
constexpr size_t WS_TAB8 = 40 * MiB, TAB8_BYTES = 12 * MiB;
constexpr int TROW = 512;
constexpr size_t WS_SC8 = 8 * MiB;
constexpr size_t WS_H = 108 * MiB;
constexpr size_t WS_IDX = 236 * MiB, WS_GATE = 268 * MiB;
constexpr size_t WS_AR0 = 300 * MiB, AR_BYTES = 352 * MiB;
constexpr size_t AR_PU = 0, AR_PV = 32 * MiB, AR_PQ = 64 * MiB, AR_PI = 96 * MiB, AR_PG = 128 * MiB;
constexpr size_t AR_G = 160 * MiB;
constexpr size_t AR_KVT = 224 * MiB, AR_ST = 288 * MiB;
constexpr size_t AR_QP = 0;
constexpr size_t AR_QK = 0;
constexpr int QK_ROWS = SEQ + SEQ / 16;
__host__ __device__ __forceinline__ int qk_row(int t) { return t + (t >> 4); }
constexpr size_t WS_END = WS_AR0 + 2 * AR_BYTES;
constexpr int HT = T / 2;
constexpr int CW_BAR = 4096;

constexpr int LDS_BYTES = 147456;
constexpr int LDSCTL_OFF = LDS_BYTES - 512;
constexpr int MISC_OFF = LDSCTL_OFF;

struct Params {
    const float* x; const float* c; const int* positions; const float* ada_w; const float* ada_b; const float* norm_mix_g; const float* norm_ffn_g; const float* final_norm_g;
    const float* even_w_in; const float* even_w_out; const float* gmlp_ln_g; const float* gmlp_ln_b; const float* gmlp_w_s; const float* gmlp_b_s; const float* hgrn_lb_logits; const float* hgrn_norm_g;
    const float* odd_w_qkv; const float* odd_w_out; const float* peer_w_query; const float* peer_sub_keys; const float* peer_down; const float* peer_up;
    float* out; unsigned char* ws; int ph_lo, ph_hi;
};
struct Ctx { LAS unsigned char* lds; int tid, lane, wave, vcu, G; };
__device__ __forceinline__ Ctx fresh_ctx(const Ctx& C0) { Ctx C = C0; int t_ = threadIdx.x; asm volatile("" : "+v"(t_)); C.tid = t_; C.lane = t_ & 63; C.wave = __builtin_amdgcn_readfirstlane(t_ >> 6); return C; }
struct Wk { int lv, n, c, h; };
#define W_TK0(W) ((W).h * (T / 2))
#define W_BT0(W) ((W).h * (NB / 2))
__device__ __forceinline__ unsigned char* w_ar(const Params& P, const Wk& W) { return P.ws + WS_AR0 + (size_t)W.h * AR_BYTES; }
__device__ __forceinline__ bf16* w_tok16(const Params& P, const Wk& W, size_t off, int pitch) { return (bf16*)(w_ar(P, W) + off) - (size_t)W_TK0(W) * pitch; }
__device__ __forceinline__ float* w_tok32(const Params& P, const Wk& W, size_t off, int pitch) { return (float*)(w_ar(P, W) + off) - (size_t)W_TK0(W) * pitch; }
__device__ __forceinline__ bf16* w_item16(const Params& P, const Wk& W, size_t off) { return (bf16*)(w_ar(P, W) + off) - (size_t)W_BT0(W) * 512 * 16384; }

__device__ __forceinline__ float wave_sum(float v) {
#pragma unroll
    for (int o = 1; o < 64; o <<= 1) v += __shfl_xor(v, o);
    return v;
}
__device__ __forceinline__ float silu_f(float x) { return x * __builtin_amdgcn_rcpf(1.0f + __builtin_amdgcn_exp2f(-1.4426950408889634f * x)); }
__device__ __forceinline__ float sigmoid_f(float x) { return __builtin_amdgcn_rcpf(1.0f + __builtin_amdgcn_exp2f(-1.4426950408889634f * x)); }
__device__ __forceinline__ float gelu_f(float x) { return 0.5f * x * (1.0f + erff(x * 0.70710678118654752f)); }
__device__ __forceinline__ f32x4 mma16(f32x4 acc, const LAS bf16* A, int lda, const LAS bf16* Bt, int ldb, int K, int r, int q4) {
    const LAS bf16* ap = A + r * lda + 8 * q4; const LAS bf16* bp = Bt + r * ldb + 8 * q4;
    for (int k0 = 0; k0 < K; k0 += 32) {
        const bf16x8 a = *(const LAS bf16x8*)(ap + k0); const bf16x8 b = *(const LAS bf16x8*)(bp + k0);
        acc = __builtin_amdgcn_mfma_f32_16x16x32_bf16(a, b, acc, 0, 0, 0);
    }
    return acc;
}

struct EpiBf16P {
    static constexpr bool PERM = true, AFTER_DRAIN = false;
    bf16* O; size_t ldc;
    __device__ __forceinline__ void operator()(const f32x4 (&acc)[2][2][4][2], const pg8::Unit& u, int wr, int wc, int fr, int fq) const {
        const int row0 = u.pm * 256 + wr * 64 + fr, col0 = u.pn * 256 + wc * 32 + 8 * fq;
#pragma unroll
        for (int ai = 0; ai < 2; ++ai)
#pragma unroll
            for (int m = 0; m < 4; ++m) { bf16* rowp = O + (size_t)(row0 + ai * 128 + m * 16) * ldc + col0;
#pragma unroll
                for (int bj = 0; bj < 2; ++bj) { const f32x4 v0 = acc[ai][bj][m][0], v1 = acc[ai][bj][m][1];
                    v4u w; w.x = pg8::cvt_pk_bf16(v0[0], v0[1]); w.y = pg8::cvt_pk_bf16(v0[2], v0[3]); w.z = pg8::cvt_pk_bf16(v1[0], v1[1]); w.w = pg8::cvt_pk_bf16(v1[2], v1[3]);
                    *(v4u*)(rowp + bj * 128) = w; } }
    }
};
#ifndef REP_HG
#define REP_HG 1
#endif
#ifndef REP_TOPK
#define REP_TOPK 1
#endif
#ifndef REP_PRO
#define REP_PRO 1
#endif
#ifndef REP_NORM
#define REP_NORM 1
#endif
#ifndef REP_GEMM2
#define REP_GEMM2 1
#endif
#ifndef REP_GEMM
#define REP_GEMM 1
#endif
#ifndef EXP_REP
#define EXP_REP 1
#endif
#ifndef ATT_REP
#define ATT_REP 1
#endif
#ifndef ABL_ON
#define ABL_ON 4
#endif
struct EpiResid {
    static constexpr bool PERM = true, AFTER_DRAIN = false;
    const float* xin; float* xout; const float* gate; float gsc;
    __device__ __forceinline__ void operator()(const f32x4 (&acc)[2][2][4][2], const pg8::Unit& u, int wr, int wc, int fr, int fq) const {
        const int row0 = u.pm * 256 + wr * 64 + fr, col0 = u.pn * 256 + wc * 32 + 8 * fq;
        const float* gp = gate + (size_t)((u.pm * 256) >> 13) * 6144 + col0;
        f32x4 gv[2][2];
#pragma unroll
        for (int bj = 0; bj < 2; ++bj) { gv[bj][0] = *(const f32x4*)(gp + bj * 128); gv[bj][1] = *(const f32x4*)(gp + bj * 128 + 4); }
#pragma unroll
        for (int ai = 0; ai < 2; ++ai)
#pragma unroll
            for (int m = 0; m < 4; ++m) { const size_t off = (size_t)(row0 + ai * 128 + m * 16) * 1024 + col0;
#pragma unroll
                for (int bj = 0; bj < 2; ++bj) {
                    const f32x4 x0 = *(const f32x4*)(xin + off + bj * 128), x1 = *(const f32x4*)(xin + off + bj * 128 + 4);
                    *(f32x4*)(xout + off + bj * 128) = x0 + gv[bj][0] * acc[ai][bj][m][0] * gsc;
                    *(f32x4*)(xout + off + bj * 128 + 4) = x1 + gv[bj][1] * acc[ai][bj][m][1] * gsc; }
                asm volatile("" ::: "memory"); }
    }
};
struct EpiInProj {
    static constexpr bool PERM = true, AFTER_DRAIN = false;
    bf16* PU; bf16* PV; bf16* PQ; bf16* PI; bf16* PG; float* G; const float* LB;
    __device__ __forceinline__ void operator()(const f32x4 (&acc)[2][2][4][2], const pg8::Unit& u, int wr, int wc, int fr, int fq) const {
        const int type = u.pn >> 1;
        const int row0 = u.pm * 256 + wr * 64 + fr, lc0 = (u.pn & 1) * 256 + wc * 32 + 8 * fq;
        if (type == 3) {
            f32x4 lb[2][2];
#pragma unroll
            for (int bj = 0; bj < 2; ++bj) { lb[bj][0] = *(const f32x4*)(LB + lc0 + bj * 128); lb[bj][1] = *(const f32x4*)(LB + lc0 + bj * 128 + 4); }
#pragma unroll
            for (int ai = 0; ai < 2; ++ai)
#pragma unroll
                for (int m = 0; m < 4; ++m) { float* rowp = G + (size_t)(row0 + ai * 128 + m * 16) * 512 + lc0;
#pragma unroll
                    for (int bj = 0; bj < 2; ++bj)
#pragma unroll
                        for (int n = 0; n < 2; ++n) { const f32x4 v = acc[ai][bj][m][n]; f32x4 o;
#pragma unroll
                            for (int e = 0; e < 4; ++e) { const float l = lb[bj][n][e]; const float f = l + (1.0f - l) * sigmoid_f(v[e]); o[e] = __logf(f); }
                            *(f32x4*)(rowp + bj * 128 + 4 * n) = o; } }
            return;
        }
        bf16* base = type == 0 ? PU : type == 1 ? PV : type == 2 ? PQ : type == 4 ? PI : PG;
#pragma unroll
        for (int ai = 0; ai < 2; ++ai)
#pragma unroll
            for (int m = 0; m < 4; ++m) { bf16* rowp = base + (size_t)(row0 + ai * 128 + m * 16) * 512 + lc0;
#pragma unroll
                for (int bj = 0; bj < 2; ++bj) { f32x4 v0 = acc[ai][bj][m][0], v1 = acc[ai][bj][m][1];
                    if (type <= 1) { pg8::f32x2 a = pg8::gelu_pk((pg8::f32x2){v0[0], v0[1]}), b = pg8::gelu_pk((pg8::f32x2){v0[2], v0[3]}), c = pg8::gelu_pk((pg8::f32x2){v1[0], v1[1]}), d = pg8::gelu_pk((pg8::f32x2){v1[2], v1[3]});
                        v0 = (f32x4){a.x, a.y, b.x, b.y}; v1 = (f32x4){c.x, c.y, d.x, d.y}; }
                    else if (type == 2) {
#pragma unroll
                        for (int e = 0; e < 4; ++e) { v0[e] = silu_f(v0[e]) * 0.08838834764831845f; v1[e] = silu_f(v1[e]) * 0.08838834764831845f; } }
                    else if (type == 5) {
#pragma unroll
                        for (int e = 0; e < 4; ++e) { v0[e] = silu_f(v0[e]); v1[e] = silu_f(v1[e]); } }
                    v4u w; w.x = pg8::cvt_pk_bf16(v0[0], v0[1]); w.y = pg8::cvt_pk_bf16(v0[2], v0[3]); w.z = pg8::cvt_pk_bf16(v1[0], v1[1]); w.w = pg8::cvt_pk_bf16(v1[2], v1[3]);
                    *(v4u*)(rowp + bj * 128) = w; } }
    }
};
struct EpiQKRot {
    static constexpr bool PERM = true, AFTER_DRAIN = false;
    bf16* O; const float* CS;
    __device__ __forceinline__ void operator()(const f32x4 (&acc)[2][2][4][2], const pg8::Unit& u, int wr, int wc, int fr, int fq) const {
        const int row0 = u.pm * 256 + wr * 64 + fr, col0 = u.pn * 256 + wc * 32 + 8 * fq;
        const float sc = u.pn < 4 ? C2 : 1.0f;
        const bool rotw = (wc & 1) == 0 && u.pn < 8;
        const float sgn = fq == 0 ? -1.0f : 1.0f;
#pragma unroll
        for (int ai = 0; ai < 2; ++ai)
#pragma unroll
            for (int m = 0; m < 4; ++m) { const int row = row0 + ai * 128 + m * 16;
                bf16* rowp = O + ((size_t)(((u.pn >> 2) * 4 + (row >> 13)) * 16 + (u.pn & 3) * 4 + (wc >> 1)) * QK_ROWS + qk_row(row & 8191)) * 64 + (wc & 1) * 32 + 8 * fq;
                f32x4 c0 = (f32x4){1.f, 1.f, 1.f, 1.f}, c1 = c0, s0 = (f32x4){0.f, 0.f, 0.f, 0.f}, s1 = s0;
                if (rotw && fq < 2) { const float* cp = CS + (size_t)row * 16; c0 = *(const f32x4*)(cp); c1 = *(const f32x4*)(cp + 4); s0 = *(const f32x4*)(cp + 8) * sgn; s1 = *(const f32x4*)(cp + 12) * sgn; }
#pragma unroll
                for (int bj = 0; bj < 2; ++bj) { f32x4 v0 = acc[ai][bj][m][0], v1 = acc[ai][bj][m][1];
                    if (rotw) { f32x4 p0, p1;
#pragma unroll
                        for (int e = 0; e < 4; ++e) { p0[e] = __shfl_xor(v0[e], 16); p1[e] = __shfl_xor(v1[e], 16); }
                        v0 = v0 * c0 + p0 * s0; v1 = v1 * c1 + p1 * s1; }
                    v0 = v0 * sc; v1 = v1 * sc;
                    v4u w; w.x = pg8::cvt_pk_bf16(v0[0], v0[1]); w.y = pg8::cvt_pk_bf16(v0[2], v0[3]); w.z = pg8::cvt_pk_bf16(v1[0], v1[1]); w.w = pg8::cvt_pk_bf16(v1[2], v1[3]);
                    *(v4u*)(rowp + (size_t)bj * 2 * QK_ROWS * 64) = w; } }
    }
};

__device__ __forceinline__ void p0_transpose_item(const float* W, int K, int N, bf16* WT, LAS float* scr, int item, int lane) {
    const int nblk = N / 32, kb = item / nblk, nb = item % nblk, k0 = 64 * kb, n0 = 32 * nb;
#pragma unroll 8
    for (int i = 0; i < 32; ++i) { const int kk = 2 * i + (lane >> 5); scr[kk * 33 + (lane & 31)] = W[(size_t)(k0 + kk) * N + n0 + (lane & 31)]; }
    LDS_WAIT(); asm volatile("" ::: "memory");
    const int c = lane & 7;
#pragma unroll
    for (int j = 0; j < 4; ++j) { const int n = (lane >> 3) + 8 * j; const LAS float* s = scr + (8 * c) * 33 + n;
        v4u o; o.x = pk2(s[0 * 33], s[1 * 33]); o.y = pk2(s[2 * 33], s[3 * 33]); o.z = pk2(s[4 * 33], s[5 * 33]); o.w = pk2(s[6 * 33], s[7 * 33]);
        *(GAS v4u*)(WT + (size_t)(n0 + n) * K + k0 + 8 * c) = o; }
    LDS_WAIT(); asm volatile("" ::: "memory");
}
typedef float f32x2 __attribute__((ext_vector_type(2)));
typedef float f32x16v __attribute__((ext_vector_type(16)));
typedef float f32x32v __attribute__((ext_vector_type(32)));
typedef unsigned v6u __attribute__((ext_vector_type(6)));
__device__ __forceinline__ void convert_tables(const Params& P, const Ctx& C) {
    const int gw = C.vcu * NWAVES + C.wave, NGW = C.G * NWAVES, lane = C.lane, hl = lane & 31;
    LAS float* stg = (LAS float*)(C.lds + C.wave * 16384);
    for (int rp = gw; rp < 2 * 16384; rp += NGW) {
#pragma unroll
        for (int rr = 0; rr < 2; ++rr) { const int row_ = 2 * rp + rr, tb_ = row_ >> 14, e_ = row_ & 16383;
            const f32x4* src = (const f32x4*)(((tb_ & 1) ? P.peer_up : P.peer_down) + ((size_t)(tb_ >> 1) * 16384 + e_) * 1024);
#pragma unroll
            for (int j = 0; j < 4; ++j) *(LAS f32x4*)(stg + rr * 1024 + 4 * (64 * j + lane)) = src[64 * j + lane]; }
        LDS_WAIT(); asm volatile("" ::: "memory");
        const int row = 2 * rp + (lane >> 5), tb = row >> 14, e = row & 16383;
        const LAS f32x4* sp = (const LAS f32x4*)(stg + (lane >> 5) * 1024 + 32 * hl);
        unsigned char* dst = P.ws + WS_TAB8 + (size_t)tb * TAB8_BYTES + (size_t)e * TROW;
        f32x16v a, b2; float mx = 0.f;
#pragma unroll
        for (int j = 0; j < 4; ++j) { const f32x4 v = sp[j], w = sp[4 + j];
#pragma unroll
            for (int i = 0; i < 4; ++i) { mx = fmaxf(mx, fmaxf(fabsf(v[i]), fabsf(w[i]))); }
            a[2 * j] = v[0]; b2[2 * j] = v[1]; a[2 * j + 1] = v[2]; b2[2 * j + 1] = v[3]; a[8 + 2 * j] = w[0]; b2[8 + 2 * j] = w[1]; a[8 + 2 * j + 1] = w[2]; b2[8 + 2 * j + 1] = w[3]; }
        LDS_WAIT(); asm volatile("" ::: "memory");
#pragma unroll
        for (int o = 1; o < 32; o <<= 1) mx = fmaxf(mx, __shfl_xor(mx, o));
        const float sc = mx > 0.f ? 6.0f / mx : 0.f;
        a = a * sc; b2 = b2 * sc;
        unsigned p[4] = {0u, 0u, 0u, 0u};
#define PK4(D) p[D] = __builtin_amdgcn_cvt_scalef32_pk_fp4_f32(p[D], a[4 * (D)], b2[4 * (D)], 1.0f, 0); p[D] = __builtin_amdgcn_cvt_scalef32_pk_fp4_f32(p[D], a[4 * (D) + 1], b2[4 * (D) + 1], 1.0f, 1); \
               p[D] = __builtin_amdgcn_cvt_scalef32_pk_fp4_f32(p[D], a[4 * (D) + 2], b2[4 * (D) + 2], 1.0f, 2); p[D] = __builtin_amdgcn_cvt_scalef32_pk_fp4_f32(p[D], a[4 * (D) + 3], b2[4 * (D) + 3], 1.0f, 3);
        PK4(0) PK4(1) PK4(2) PK4(3)
#undef PK4
        *(v4u*)(dst + 256 * (hl & 1) + 16 * (hl >> 1)) = (v4u){p[0], p[1], p[2], p[3]};
        if (hl == 0) ((float*)(P.ws + WS_SC8))[row] = mx * (1.0f / 6.0f);
    }
}
__device__ __forceinline__ void phase_prologue(const Params& P, const Ctx& C) {
    float* MOD = (float*)(P.ws + WS_MOD);
    {
        LAS float* cond = (LAS float*)C.lds;
        LAS float* part = (LAS float*)(C.lds + 32768);
        for (int e = C.tid; e < 8192; e += 512) cond[e] = silu_f(P.c[e]);
        __syncthreads();
        for (int item = C.vcu; item < 192; item += C.G) {
            const int l = item / 96, cb = item % 96, col = cb * 64 + C.lane;
            float acc[8];
#pragma unroll
            for (int b = 0; b < 8; ++b) acc[b] = 0.f;
            const float* wp = P.ada_w + ((size_t)l * 1024 + C.wave * 128) * 6144 + col;
#pragma unroll 4
            for (int k = 0; k < 128; ++k) { const float wv = wp[(size_t)k * 6144];
#pragma unroll
                for (int b = 0; b < 8; ++b) acc[b] += cond[b * 1024 + C.wave * 128 + k] * wv; }
#pragma unroll
            for (int b = 0; b < 8; ++b) part[(C.wave * 8 + b) * 64 + C.lane] = acc[b];
            __syncthreads();
            { const int b = C.tid >> 6, ln = C.tid & 63; float s = P.ada_b[l * 6144 + cb * 64 + ln];
#pragma unroll
              for (int w = 0; w < 8; ++w) s += part[(w * 8 + b) * 64 + ln];
              MOD[(size_t)(l * 8 + b) * 6144 + cb * 64 + ln] = s; }
            __syncthreads();
        }
        __syncthreads();
    }
    {
        LAS float* scr = (LAS float*)(C.lds + C.wave * 16384);
        const int gw = C.vcu * NWAVES + C.wave, NGW = C.G * NWAVES;
        for (int it = gw; it < 6144; it += NGW) {
            int r = it;
            if (r < 1536) { p0_transpose_item(P.even_w_in, 1024, 3072, (bf16*)(P.ws + WS_WIN), scr, r, C.lane); continue; } r -= 1536;
            if (r < 512)  { p0_transpose_item(P.even_w_out, 1024, 1024, (bf16*)(P.ws + WS_WOUT0), scr, r, C.lane); continue; } r -= 512;
            if (r < 1536) { p0_transpose_item(P.odd_w_qkv, 1024, 3072, (bf16*)(P.ws + WS_WQKV), scr, r, C.lane); continue; } r -= 1536;
            if (r < 512)  { p0_transpose_item(P.odd_w_out, 1024, 1024, (bf16*)(P.ws + WS_WOUT1), scr, r, C.lane); continue; } r -= 512;
            if (r < 1024) { p0_transpose_item(P.peer_w_query, 1024, 2048, (bf16*)(P.ws + WS_WQ0), scr, r, C.lane); continue; } r -= 1024;
            p0_transpose_item(P.peer_w_query + (size_t)1024 * 2048, 1024, 2048, (bf16*)(P.ws + WS_WQ1), scr, r, C.lane);
        }
    }
    convert_tables(P, C);
    const int NT = C.G * 512, gt = C.vcu * 512 + C.tid;
    { bf16* skb = (bf16*)(P.ws + WS_SKB); for (int i = gt; i < 65536; i += NT) skb[i] = (bf16)f2bf(P.peer_sub_keys[i]); }
    { bf16* wsb = (bf16*)(P.ws + WS_WSB); for (int i = gt; i < 65536; i += NT) { const int t = (i >> 7) & 127, s = i & 127; wsb[i] = (bf16)(s <= t ? f2bf(P.gmlp_w_s[i]) : 0u); } }
    { float* lb = (float*)(P.ws + WS_LB); for (int i = gt; i < 512; i += NT) { const float l0 = P.hgrn_lb_logits[i], l1 = P.hgrn_lb_logits[512 + i]; lb[i] = 1.0f / (1.0f + expf(l1 - l0)); } }
    { float* cs = (float*)(P.ws + WS_CS); for (int i = gt; i < T * 8; i += NT) { const int tok = i >> 3, j = i & 7;
        const float inv = 1.0f / powf(500000.0f, (float)j * 0.125f); const float ang = (float)P.positions[tok] * inv; float sn, cn; sincosf(ang, &sn, &cn);
        cs[(size_t)tok * 16 + j] = cn; cs[(size_t)tok * 16 + 8 + j] = sn; } }
}
__device__ __forceinline__ void norm_row_bf16(const float* xrow, bf16* hrow, const float* g, const float* sh, const float* sc, int lane) {
    const f32x4* xr = (const f32x4*)xrow + lane; f32x4 v[4]; float s = 0.f;
#pragma unroll
    for (int j = 0; j < 4; ++j) { v[j] = xr[64 * j]; s += (v[j][0] * v[j][0] + v[j][1] * v[j][1]) + (v[j][2] * v[j][2] + v[j][3] * v[j][3]); }
    const float rstd = 1.0f / sqrtf(wave_sum(s) * (1.0f / 1024.0f) + NORM_EPS);
    unsigned long long* o8 = (unsigned long long*)hrow + lane;
#pragma unroll
    for (int j = 0; j < 4; ++j) { const f32x4 gg = ((const f32x4*)g)[64 * j + lane], hh = ((const f32x4*)sh)[64 * j + lane], cc = ((const f32x4*)sc)[64 * j + lane];
        const f32x4 y = (v[j] * rstd * gg) * (cc + 1.0f) + hh;
        o8[64 * j] = (unsigned long long)pk2(y[0], y[1]) | ((unsigned long long)pk2(y[2], y[3]) << 32); }
}
__device__ __forceinline__ void phase_norm(const Params& P, const Ctx& C, const Wk& W, const float* xsrc, const float* g, int l, int so) {
    const float* MOD = (const float*)(P.ws + WS_MOD); bf16* H = (bf16*)(P.ws + WS_H);
    const int gw = W.lv * NWAVES + C.wave, NGW = W.n * NWAVES;
    for (int m = W_TK0(W) + gw; m < W_TK0(W) + HT; m += NGW) { const float* mb = MOD + (size_t)(l * 8 + (m >> 13)) * 6144 + so;
        norm_row_bf16(xsrc + (size_t)m * 1024, H + (size_t)m * 1024, g, mb, mb + 1024, C.lane); }
}

__device__ __forceinline__ void gmlp_item(const Params& P, const Ctx& C, const Wk& W, int n, int g) {
    LAS bf16* Wt = (LAS bf16*)C.lds;
    LAS bf16* vT = (LAS bf16*)(C.lds + 34816);
    const bf16* WSB = (const bf16*)(P.ws + WS_WSB); const bf16* PU = w_tok16(P, W, AR_PU, 512); const bf16* PV = w_tok16(P, W, AR_PV, 512); bf16* MIX = (bf16*)(P.ws + WS_H);
    const int tid = C.tid, r = C.lane & 15, q4 = C.lane >> 4;
    for (int ch = tid; ch < 2048; ch += 512) { const int rr = ch >> 4, c8 = (ch & 15) * 8; *(LAS v4u*)(Wt + rr * 136 + c8) = *(const v4u*)(WSB + (size_t)(g * 128 + rr) * 128 + c8); }
    { const int t = tid >> 2, part = tid & 3; const bf16* src = PV + (size_t)(n * 128 + t) * 512 + g * 128 + part * 32;
      float x[32];
#pragma unroll
      for (int j = 0; j < 4; ++j) { const v4u w = *(const v4u*)(src + 8 * j);
#pragma unroll
          for (int e = 0; e < 4; ++e) { x[8 * j + 2 * e] = bflo(w[e]); x[8 * j + 2 * e + 1] = bfhi(w[e]); } }
      float s = 0.f;
#pragma unroll
      for (int j = 0; j < 32; ++j) s += x[j];
      s += __shfl_xor(s, 1); s += __shfl_xor(s, 2);
      const float mean = s * (1.0f / 128.0f); float q = 0.f;
#pragma unroll
      for (int j = 0; j < 32; ++j) { const float d = x[j] - mean; q += d * d; }
      q += __shfl_xor(q, 1); q += __shfl_xor(q, 2);
      const float rstd = 1.0f / sqrtf(q * (1.0f / 128.0f) + NORM_EPS);
      const float* lg = P.gmlp_ln_g + g * 128 + part * 32; const float* lbp = P.gmlp_ln_b + g * 128 + part * 32;
#pragma unroll
      for (int j = 0; j < 32; ++j) vT[(part * 32 + j) * 136 + t] = (bf16)f2bf((x[j] - mean) * rstd * lg[j] + lbp[j]);
    }
    __syncthreads();
    const int t0 = 16 * C.wave; const int Keff = ((t0 + 16 + 31) >> 5) << 5;
    f32x4 acc[8];
#pragma unroll
    for (int ct = 0; ct < 8; ++ct) { acc[ct] = (f32x4){0.f, 0.f, 0.f, 0.f}; acc[ct] = mma16(acc[ct], Wt + t0 * 136, 136, vT + (16 * ct) * 136, 136, Keff, r, q4); }
#pragma unroll
    for (int i = 0; i < 4; ++i) { const int t = t0 + 4 * q4 + i; const float bs = P.gmlp_b_s[g * 128 + t]; const size_t tok = (size_t)n * 128 + t;
#pragma unroll
        for (int ct = 0; ct < 8; ++ct) { const int c = 16 * ct + r; const float u = bf2f(PU[tok * 512 + g * 128 + c]); MIX[tok * 1024 + g * 128 + c] = (bf16)f2bf(u * (acc[ct][i] + bs)); } }
    __syncthreads();
}
__device__ __forceinline__ void hgrn_cumsum16(const float* G, size_t tok0, int hh, int k, int seg, LAS float* tot, float (&g)[16], float (&bb)[16], float& total) {
    const float* gp = G + (tok0 + seg * 16) * 512 + hh * 128 + k;
#pragma unroll
    for (int j = 0; j < 16; ++j) g[j] = gp[(size_t)j * 512];
    float run = 0.f;
#pragma unroll
    for (int j = 0; j < 16; ++j) { run += g[j]; bb[j] = run; }
    tot[seg * 128 + k] = run;
    __syncthreads();
    const float t0 = tot[k], t1 = tot[128 + k], t2 = tot[256 + k], t3 = tot[384 + k];
    const float pre = seg == 0 ? 0.f : seg == 1 ? t0 : seg == 2 ? t0 + t1 : t0 + t1 + t2;
    total = (t0 + t1) + (t2 + t3);
#pragma unroll
    for (int j = 0; j < 16; ++j) bb[j] += pre;
}
__device__ __forceinline__ void hgrn_stage_iT(const bf16* PI, size_t tok0, int hh, LAS bf16* iT, int tid) {
    const int s = tid >> 3, v0 = (tid & 7) * 16; const bf16* src = PI + (tok0 + s) * 512 + hh * 128 + v0;
#pragma unroll
    for (int h2 = 0; h2 < 2; ++h2) { const v4u w = *(const v4u*)(src + 8 * h2);
#pragma unroll
        for (int e = 0; e < 4; ++e) { iT[(v0 + 8 * h2 + 2 * e) * 72 + s] = (bf16)(w[e] & 0xffffu); iT[(v0 + 8 * h2 + 2 * e + 1) * 72 + s] = (bf16)(w[e] >> 16); } }
}
__device__ __forceinline__ void hgrn_local_item(const Params& P, const Ctx& C, const Wk& W, int item) {
    LAS bf16* khT = (LAS bf16*)C.lds;
    LAS bf16* iT = (LAS bf16*)(C.lds + 18432);
    LAS float* tot = (LAS float*)(C.lds + 36864);
    const float* G = w_tok32(P, W, AR_G, 512); const bf16* PI = w_tok16(P, W, AR_PI, 512); bf16* KVT = w_item16(P, W, AR_KVT); float* HD = (float*)(P.ws + WS_HD);
    const int bh = item >> 7, c = item & 127, b = bh >> 2, hh = bh & 3; const size_t tok0 = (size_t)b * SEQ + c * 64;
    const int tid = C.tid, k = tid & 127, seg = tid >> 7, r = C.lane & 15, q4 = C.lane >> 4;
    float g[16], bb[16], total;
    hgrn_cumsum16(G, tok0, hh, k, seg, tot, g, bb, total);
    { unsigned w[8];
#pragma unroll
      for (int j = 0; j < 8; ++j) { const float a0 = -expm1f(g[2 * j]) * __expf(total - bb[2 * j]), a1 = -expm1f(g[2 * j + 1]) * __expf(total - bb[2 * j + 1]); w[j] = pk2(a0, a1); }
      LAS v4u* dst = (LAS v4u*)(khT + k * 72 + seg * 16); dst[0] = (v4u){w[0], w[1], w[2], w[3]}; dst[1] = (v4u){w[4], w[5], w[6], w[7]}; }
    if (seg == 0) HD[(size_t)item * 128 + k] = __expf(total);
    hgrn_stage_iT(PI, tok0, hh, iT, tid);
    __syncthreads();
    const int v0 = 16 * C.wave;
#pragma unroll
    for (int ct = 0; ct < 8; ++ct) { f32x4 acc = (f32x4){0.f, 0.f, 0.f, 0.f}; acc = mma16(acc, iT + v0 * 72, 72, khT + (16 * ct) * 72, 72, 64, r, q4);
#pragma unroll
        for (int i = 0; i < 4; ++i) KVT[((size_t)item * 128 + v0 + 4 * q4 + i) * 128 + 16 * ct + r] = (bf16)f2bf(acc[i]); }
    __syncthreads();
}
__device__ __forceinline__ void phase_hgrn_scan(const Params& P, const Ctx& C, const Wk& W) {
    const bf16* KVT = w_item16(P, W, AR_KVT); bf16* ST = w_item16(P, W, AR_ST); const float* HD = (const float*)(P.ws + WS_HD);
    for (int task = W.lv * 256 + C.tid; C.tid < 256 && task < 32768; task += W.n * 256) {
        const int bh = W_BT0(W) * 4 + (task >> 11), v = (task >> 4) & 127, kb = task & 15;
        float st[8];
#pragma unroll
        for (int e = 0; e < 8; ++e) st[e] = 0.f;
#pragma unroll 4
        for (int c = 0; c < 128; ++c) { const size_t item = (size_t)bh * 128 + c, off = (item * 128 + v) * 128 + kb * 8;
            const v4u kv = *(const v4u*)(KVT + off); const f32x4 d0 = *(const f32x4*)(HD + item * 128 + kb * 8), d1 = *(const f32x4*)(HD + item * 128 + kb * 8 + 4);
            v4u o; o.x = pk2(st[0], st[1]); o.y = pk2(st[2], st[3]); o.z = pk2(st[4], st[5]); o.w = pk2(st[6], st[7]);
            *(v4u*)(ST + off) = o;
#pragma unroll
            for (int e = 0; e < 4; ++e) { st[2 * e] = (e < 2 ? d0[2 * e] : d1[2 * e - 4]) * st[2 * e] + bflo(kv[e]); st[2 * e + 1] = (e < 2 ? d0[2 * e + 1] : d1[2 * e - 3]) * st[2 * e + 1] + bfhi(kv[e]); }
        }
    }
}
__device__ __forceinline__ void hgrn_out_item(const Params& P, const Ctx& C, const Wk& W, int item) {
    LAS bf16* qt = (LAS bf16*)C.lds;
    LAS bf16* kt = (LAS bf16*)(C.lds + 17408);
    LAS bf16* iT = (LAS bf16*)(C.lds + 34816);
    LAS bf16* A1 = (LAS bf16*)(C.lds + 53248);
    LAS bf16* STl = (LAS bf16*)(C.lds + 62464);
    LAS float* ol = (LAS float*)(C.lds + 97280);
    LAS float* tot = (LAS float*)(C.lds + 131072);
    const float* G = w_tok32(P, W, AR_G, 512); const bf16* PQ = w_tok16(P, W, AR_PQ, 512); const bf16* PI = w_tok16(P, W, AR_PI, 512); const bf16* PG = w_tok16(P, W, AR_PG, 512);
    const bf16* ST = w_item16(P, W, AR_ST); bf16* MIX = (bf16*)(P.ws + WS_H);
    const int bh = item >> 7, c = item & 127, b = bh >> 2, hh = bh & 3; const size_t tok0 = (size_t)b * SEQ + c * 64;
    const int tid = C.tid, k = tid & 127, seg = tid >> 7, r = C.lane & 15, q4 = C.lane >> 4;
    float g[16], bb[16], total;
    hgrn_cumsum16(G, tok0, hh, k, seg, tot, g, bb, total);
#pragma unroll
    for (int j = 0; j < 16; ++j) { const int t = seg * 16 + j; const float qv = bf2f(PQ[(tok0 + t) * 512 + hh * 128 + k]);
        qt[t * 136 + k] = (bf16)f2bf(qv * __expf(bb[j])); kt[t * 136 + k] = (bf16)f2bf(-expm1f(g[j]) * __expf(-bb[j])); }
    hgrn_stage_iT(PI, tok0, hh, iT, tid);
    for (int ch = tid; ch < 2048; ch += 512) { const int rr = ch >> 4, c8 = (ch & 15) * 8; *(LAS v4u*)(STl + rr * 136 + c8) = *(const v4u*)(ST + ((size_t)item * 128 + rr) * 128 + c8); }
    __syncthreads();
    { const int rt = C.wave >> 1;
#pragma unroll
      for (int cc = 0; cc < 2; ++cc) { const int ct = (C.wave & 1) * 2 + cc; f32x4 acc = (f32x4){0.f, 0.f, 0.f, 0.f};
          acc = mma16(acc, qt + (16 * rt) * 136, 136, kt + (16 * ct) * 136, 136, 128, r, q4);
#pragma unroll
          for (int i = 0; i < 4; ++i) { const int t = 16 * rt + 4 * q4 + i, s = 16 * ct + r; A1[t * 72 + s] = (bf16)(s <= t ? f2bf(acc[i]) : 0u); } } }
    __syncthreads();
    { const int rt = C.wave >> 1;
#pragma unroll
      for (int cc = 0; cc < 4; ++cc) { const int ct = (C.wave & 1) * 4 + cc; f32x4 acc = (f32x4){0.f, 0.f, 0.f, 0.f};
          acc = mma16(acc, A1 + (16 * rt) * 72, 72, iT + (16 * ct) * 72, 72, 64, r, q4);
          acc = mma16(acc, qt + (16 * rt) * 136, 136, STl + (16 * ct) * 136, 136, 128, r, q4);
#pragma unroll
          for (int i = 0; i < 4; ++i) ol[(16 * rt + 4 * q4 + i) * 132 + 16 * ct + r] = acc[i]; } }
    __syncthreads();
    { const int t = tid >> 3, v0 = (tid & 7) * 16; float o[16]; float ss = 0.f;
#pragma unroll
      for (int e = 0; e < 16; ++e) { o[e] = ol[t * 132 + v0 + e]; ss += o[e] * o[e]; }
      ss += __shfl_xor(ss, 1); ss += __shfl_xor(ss, 2); ss += __shfl_xor(ss, 4);
      const float rstd = 1.0f / sqrtf(ss * (1.0f / 128.0f) + NORM_EPS);
      const float* ng = P.hgrn_norm_g + hh * 128 + v0; const bf16* gp = PG + (tok0 + t) * 512 + hh * 128 + v0;
      const v4u g0 = *(const v4u*)gp, g1 = *(const v4u*)(gp + 8); unsigned w[8];
#pragma unroll
      for (int e = 0; e < 4; ++e) { w[e] = pk2(o[2 * e] * rstd * ng[2 * e] * bflo(g0[e]), o[2 * e + 1] * rstd * ng[2 * e + 1] * bfhi(g0[e]));
                                    w[4 + e] = pk2(o[8 + 2 * e] * rstd * ng[8 + 2 * e] * bflo(g1[e]), o[9 + 2 * e] * rstd * ng[9 + 2 * e] * bfhi(g1[e])); }
      v4u* dst = (v4u*)(MIX + (tok0 + t) * 1024 + 512 + hh * 128 + v0); dst[0] = (v4u){w[0], w[1], w[2], w[3]}; dst[1] = (v4u){w[4], w[5], w[6], w[7]}; }
    __syncthreads();
}

typedef short v4i16_t __attribute__((ext_vector_type(4)));
constexpr int AT_VP = 144;
constexpr int AT_QI = 512;
constexpr int AT_STO = 0, AT_STML = AT_QI * 128, AT_VW = AT_STML + AT_QI * 8;
__device__ __forceinline__ void attn_softmax_block(f32x4 (&sa)[9], int tile0, int qq, int mq0, int q4, float& mx, float& ls, bf16x8 (&pf)[5]) {
    const int lo4 = (qq > 128 - mq0 ? qq : 128 - mq0) - 4 * q4, hi4 = qq + 128 - 4 * q4;
    mx = -1e30f;
#pragma unroll
    for (int t = 0; t < 9; ++t)
#pragma unroll
        for (int i = 0; i < 4; ++i) { const int K0 = 16 * (tile0 + t) + i; const bool ok = K0 >= lo4 && K0 <= hi4;
            sa[t][i] = ok ? sa[t][i] : -1e30f; mx = fmaxf(mx, sa[t][i]); }
    mx = fmaxf(mx, __shfl_xor(mx, 16)); mx = fmaxf(mx, __shfl_xor(mx, 32));
    ls = 0.f;
#pragma unroll
    for (int t = 0; t < 9; ++t)
#pragma unroll
        for (int i = 0; i < 4; ++i) { const float pv = __builtin_amdgcn_exp2f(sa[t][i] - mx); sa[t][i] = pv; ls += pv; }
    ls += __shfl_xor(ls, 16); ls += __shfl_xor(ls, 32);
#pragma unroll
    for (int s2 = 0; s2 < 5; ++s2) { const int tl = 2 * s2 - tile0, th = 2 * s2 + 1 - tile0;
        const f32x4 lo = (tl >= 0 && tl < 9) ? sa[(tl >= 0 && tl < 9) ? tl : 0] : (f32x4){0.f, 0.f, 0.f, 0.f}, hi = (th >= 0 && th < 9) ? sa[(th >= 0 && th < 9) ? th : 0] : (f32x4){0.f, 0.f, 0.f, 0.f};
        v4u w; w.x = pk2(lo[0], lo[1]); w.y = pk2(lo[2], lo[3]); w.z = pk2(hi[0], hi[1]); w.w = pk2(hi[2], hi[3]); pf[s2] = __builtin_bit_cast(bf16x8, w); }
}
__device__ __forceinline__ void attn_merge(int g, LAS unsigned char* lds, int qloc, int q4, f32x4 (&oa)[4], float mx, float ls, bf16* orow) {
    LAS unsigned char* so = lds + AT_STO + qloc * 128 + 8 * q4; LAS float* sml = (LAS float*)(lds + AT_STML) + 2 * qloc;
    float mo = mx, lo2 = ls;
    if (g > 0) { const float m_old = sml[0], l_old = sml[1]; const float M = fmaxf(m_old, mx); const float fo = __builtin_amdgcn_exp2f(m_old - M), fn = __builtin_amdgcn_exp2f(mx - M);
#pragma unroll
        for (int dt = 0; dt < 4; ++dt) { const unsigned long long w = *(const LAS unsigned long long*)(so + 32 * dt); const unsigned w0 = (unsigned)w, w1 = (unsigned)(w >> 32);
            oa[dt] = oa[dt] * fn + (f32x4){bflo(w0), bfhi(w0), bflo(w1), bfhi(w1)} * fo; }
        mo = M; lo2 = ls * fn + l_old * fo; }
    if (g < 2) {
#pragma unroll
        for (int dt = 0; dt < 4; ++dt) *(LAS unsigned long long*)(so + 32 * dt) = (unsigned long long)pk2(oa[dt][0], oa[dt][1]) | ((unsigned long long)pk2(oa[dt][2], oa[dt][3]) << 32);
        if (q4 == 0) { sml[0] = mo; sml[1] = lo2; }
    } else { const float inv = 1.0f / lo2;
#pragma unroll
        for (int dt = 0; dt < 4; ++dt) { const f32x4 v = oa[dt] * inv; *(unsigned long long*)(orow + 16 * dt) = (unsigned long long)pk2(v[0], v[1]) | ((unsigned long long)pk2(v[2], v[3]) << 32); } }
}
__device__ __forceinline__ void attn_item(const Params& P, const Ctx& C, const Wk& W, int b, int hd, int qt) {
    LAS unsigned char* Vw = C.lds + AT_VW + C.wave * (64 * AT_VP);
    const bf16* QKV = (const bf16*)(w_ar(P, W) + AR_QK); bf16* O = (bf16*)(P.ws + WS_H); const int bl = b - W_BT0(W);
    const int lane = C.lane, r = lane & 15, q4 = lane >> 4;
    const int t0 = qt * AT_QI; const size_t rowbase = (size_t)b * SEQ;
    const bf16* Qh = QKV + (size_t)((0 * 4 + bl) * 16 + hd) * QK_ROWS * 64; const bf16* Kb = QKV + (size_t)((1 * 4 + bl) * 16 + hd) * QK_ROWS * 64; const bf16* Vb = QKV + (size_t)((2 * 4 + bl) * 16 + hd) * QK_ROWS * 64;
#pragma unroll 1
    for (int g = 0; g < 3; ++g) {
        const int dsh = 4 - 2 * g, d = 1 << dsh;
#pragma unroll 1
        for (int uu = 0; uu < 2; ++uu) {
            const int u = C.wave + 8 * uu;
            const int c = u & (d - 1), j = u >> dsh;
            const int mq0 = (t0 >> dsh) + 32 * j;
            const int ql0 = c + d * (32 * j + r), ql1 = ql0 + 16 * d;
            const bf16* qp0 = Qh + (size_t)qk_row(t0 + ql0) * 64 + 8 * q4; const bf16* qp1 = Qh + (size_t)qk_row(t0 + ql1) * 64 + 8 * q4;
            const bf16x8 bq00 = *(const bf16x8*)qp0, bq01 = *(const bf16x8*)(qp0 + 32), bq10 = *(const bf16x8*)qp1, bq11 = *(const bf16x8*)(qp1 + 32);
            bf16x8 ka[10][2];
#pragma unroll
            for (int t = 0; t < 10; ++t) { int mk = mq0 - 128 + 16 * t + r; mk = mk < 0 ? 0 : mk;
                const unsigned ko = (unsigned)qk_row(c + (mk << dsh)) * 128u + 16u * q4; ka[t][0] = *(const bf16x8*)((const char*)Kb + ko); ka[t][1] = *(const bf16x8*)((const char*)Kb + ko + 64); }
            v4u vr[2][8];
#pragma unroll
            for (int it = 0; it < 8; ++it) { const int kap = 8 * it + (lane >> 3); int mk = mq0 - 128 + kap; mk = mk < 0 ? 0 : mk;
                vr[0][it] = *(const v4u*)((const char*)Vb + (unsigned)qk_row(c + (mk << dsh)) * 128u + (lane & 7) * 16u); }
            __builtin_amdgcn_sched_barrier(0);
            bf16x8 pf0[5], pf1[5]; float mx0, ls0, mx1, ls1;
            { f32x4 sa[9];
#pragma unroll
              for (int t = 0; t < 9; ++t) { sa[t] = (f32x4){0.f, 0.f, 0.f, 0.f}; sa[t] = __builtin_amdgcn_mfma_f32_16x16x32_bf16(ka[t][0], bq00, sa[t], 0, 0, 0); sa[t] = __builtin_amdgcn_mfma_f32_16x16x32_bf16(ka[t][1], bq01, sa[t], 0, 0, 0); }
              attn_softmax_block(sa, 0, r, mq0, q4, mx0, ls0, pf0); }
            { f32x4 sa[9];
#pragma unroll
              for (int t = 0; t < 9; ++t) { sa[t] = (f32x4){0.f, 0.f, 0.f, 0.f}; sa[t] = __builtin_amdgcn_mfma_f32_16x16x32_bf16(ka[t + 1][0], bq10, sa[t], 0, 0, 0); sa[t] = __builtin_amdgcn_mfma_f32_16x16x32_bf16(ka[t + 1][1], bq11, sa[t], 0, 0, 0); }
              __builtin_amdgcn_sched_barrier(0);
#pragma unroll
              for (int it = 0; it < 8; ++it) { const int kap = 64 + 8 * it + (lane >> 3); int mk = mq0 - 128 + kap; mk = mk < 0 ? 0 : mk;
                  vr[1][it] = *(const v4u*)((const char*)Vb + (unsigned)qk_row(c + (mk << dsh)) * 128u + (lane & 7) * 16u); }
              __builtin_amdgcn_sched_barrier(0);
              attn_softmax_block(sa, 1, 16 + r, mq0, q4, mx1, ls1, pf1); }
            v4u vr2[4];
#pragma unroll
            for (int it = 0; it < 4; ++it) { const int kap = 128 + 8 * it + (lane >> 3); const int mk = mq0 - 128 + kap;
                vr2[it] = *(const v4u*)((const char*)Vb + (unsigned)qk_row(c + (mk << dsh)) * 128u + (lane & 7) * 16u); }
            f32x4 oa0[4], oa1[4];
#pragma unroll
            for (int dt = 0; dt < 4; ++dt) { oa0[dt] = (f32x4){0.f, 0.f, 0.f, 0.f}; oa1[dt] = (f32x4){0.f, 0.f, 0.f, 0.f}; }
#pragma unroll
            for (int ch = 0; ch < 3; ++ch) {
#pragma unroll
                for (int it = 0; it < 8; ++it) { const int row = 8 * it + (lane >> 3);
                    if (ch < 2) *(LAS v4u*)(Vw + row * AT_VP + (lane & 7) * 16) = vr[ch < 2 ? ch : 0][it];
                    else if (it < 4) *(LAS v4u*)(Vw + row * AT_VP + (lane & 7) * 16) = vr2[it < 4 ? it : 0]; }
                asm volatile("s_waitcnt lgkmcnt(0)" ::: "memory");
#pragma unroll
                for (int s2 = 0; s2 < 2; ++s2) { const int sx = 2 * ch + s2; if (sx < 5) {
#pragma unroll
                    for (int dt = 0; dt < 4; ++dt) {
                        const LAS unsigned char* vp = Vw + (32 * s2 + 4 * q4 + (r >> 2)) * AT_VP + dt * 32 + (r & 3) * 8;
                        const v4i16_t x = __builtin_amdgcn_ds_read_tr16_b64_v4i16((LAS v4i16_t*)vp), y = __builtin_amdgcn_ds_read_tr16_b64_v4i16((LAS v4i16_t*)(vp + 16 * AT_VP));
                        const bf16x8 av = (bf16x8){x[0], x[1], x[2], x[3], y[0], y[1], y[2], y[3]};
                        oa0[dt] = __builtin_amdgcn_mfma_f32_16x16x32_bf16(av, pf0[sx], oa0[dt], 0, 0, 0);
                        oa1[dt] = __builtin_amdgcn_mfma_f32_16x16x32_bf16(av, pf1[sx], oa1[dt], 0, 0, 0); } } }
                asm volatile("s_waitcnt lgkmcnt(0)" ::: "memory");
            }
            attn_merge(g, C.lds, ql0, q4, oa0, mx0, ls0, O + (rowbase + t0 + ql0) * 1024 + hd * 64 + 4 * q4);
            attn_merge(g, C.lds, ql1, q4, oa1, mx1, ls1, O + (rowbase + t0 + ql1) * 1024 + hd * 64 + 4 * q4);
        }
        __syncthreads();
    }
}

__device__ __forceinline__ unsigned ordf(float s) { const unsigned u = __builtin_bit_cast(unsigned, s); return u ^ ((unsigned)((int)u >> 31) | 0x80000000u); }
__device__ __forceinline__ float unordf(unsigned v) { return __builtin_bit_cast(float, v ^ ((unsigned)((int)(~v) >> 31) | 0x80000000u)); }
__device__ __forceinline__ void ins16(unsigned (&top)[16], unsigned x) {
#pragma unroll
    for (int j = 0; j < 16; ++j) { const unsigned hi = top[j] > x ? top[j] : x; x = top[j] > x ? x : top[j]; top[j] = hi; }
}
#define CE_D(a, b) { const unsigned hi_ = (a) > (b) ? (a) : (b), lo_ = (a) > (b) ? (b) : (a); (a) = hi_; (b) = lo_; }
__device__ __forceinline__ void sort16_desc(unsigned (&v)[16]) {
#pragma unroll
    for (int k = 2; k <= 16; k <<= 1)
#pragma unroll
        for (int j = k >> 1; j > 0; j >>= 1)
#pragma unroll
            for (int i = 0; i < 16; ++i) { const int l = i ^ j; if (l > i) { if ((i & k) == 0) CE_D(v[i], v[l]) else CE_D(v[l], v[i]) } }
}
__device__ __forceinline__ void bitonic_merge16_desc(unsigned (&c)[16]) {
#pragma unroll
    for (int st = 8; st >= 1; st >>= 1)
#pragma unroll
        for (int j = 0; j < 16; ++j) if ((j & st) == 0) CE_D(c[j], c[j + st])
}
__device__ __forceinline__ void top16_of_two(unsigned (&a)[16], const unsigned (&b)[16]) {
#pragma unroll
    for (int j = 0; j < 16; ++j) a[j] = a[j] > b[15 - j] ? a[j] : b[15 - j];
    bitonic_merge16_desc(a);
}
__device__ __forceinline__ void merge16(unsigned (&top)[16], int mask) {
    unsigned o[16];
#pragma unroll
    for (int j = 0; j < 16; ++j) o[j] = (unsigned)__shfl_xor((int)top[j], mask);
    top16_of_two(top, o);
}
__device__ __forceinline__ void phase_peer_topk(const Params& P, const Ctx& C, const Wk& W, int layer) {
    LAS bf16* SK = (LAS bf16*)C.lds;
    const bf16* SKB = (const bf16*)(P.ws + WS_SKB) + (size_t)layer * 32768; const bf16* QP = w_tok16(P, W, AR_QP, 2048);
    int* IDX = (int*)(P.ws + WS_IDX); float* GATE = (float*)(P.ws + WS_GATE);
    for (int ch = C.tid; ch < 4096; ch += 512) { const int rr = ch >> 4, c8 = (ch & 15) * 8; *(LAS v4u*)(SK + rr * 136 + c8) = *(const v4u*)(SKB + (size_t)rr * 128 + c8); }
    __syncthreads();
    const int r = C.lane & 15, q4 = C.lane >> 4;
    const int gw = W.lv * NWAVES + C.wave, NGW = W.n * NWAVES;
    for (int grp = W_TK0(W) / 2 + gw; grp < W_TK0(W) / 2 + HT * 8 / 16; grp += NGW) {
        const size_t task = (size_t)grp * 16 + r;
        unsigned lst[2][16];
#pragma unroll
        for (int half = 0; half < 2; ++half) {
            bf16x8 bq[4];
#pragma unroll
            for (int ks = 0; ks < 4; ++ks) bq[ks] = *(const bf16x8*)(QP + task * 256 + half * 128 + ks * 32 + 8 * q4);
            unsigned ka[16], kb[16];
#pragma unroll
            for (int nt = 0; nt < 8; ++nt) { f32x4 acc = (f32x4){0.f, 0.f, 0.f, 0.f};
#pragma unroll
                for (int ks = 0; ks < 4; ++ks) { const bf16x8 a = *(const LAS bf16x8*)(SK + (half * 128 + 16 * nt + r) * 136 + ks * 32 + 8 * q4); acc = __builtin_amdgcn_mfma_f32_16x16x32_bf16(a, bq[ks], acc, 0, 0, 0); }
#pragma unroll
                for (int i = 0; i < 4; ++i) { const unsigned n = 16 * nt + 4 * q4 + i; const unsigned key = (ordf(acc[i]) & ~127u) | (127u - n); if (nt < 4) ka[4 * nt + i] = key; else kb[4 * (nt - 4) + i] = key; }
                if (nt == 3) sort16_desc(ka);
                __builtin_amdgcn_sched_barrier(0); }
            sort16_desc(kb); top16_of_two(ka, kb);
            merge16(ka, 16); merge16(ka, 32);
#pragma unroll
            for (int j = 0; j < 16; ++j) lst[half][j] = ka[j];
        }
        float v2[16]; unsigned e2[16];
#pragma unroll
        for (int j = 0; j < 16; ++j) { v2[j] = unordf(lst[1][j] & ~127u); e2[j] = 127u - (lst[1][j] & 127u); }
        float v1s[4]; unsigned e1s[4];
#pragma unroll
        for (int k = 0; k < 4; ++k) { const unsigned w = q4 == 0 ? lst[0][4 * k] : q4 == 1 ? lst[0][4 * k + 1] : q4 == 2 ? lst[0][4 * k + 2] : lst[0][4 * k + 3];
            v1s[k] = unordf(w & ~127u); e1s[k] = (127u - (w & 127u)) << 7; }
        unsigned top[16];
#pragma unroll
        for (int j = 0; j < 16; ++j) top[j] = (ordf(v1s[0] + v2[j]) & ~16383u) | e1s[0] | e2[j];
        sort16_desc(top);
#pragma unroll
        for (int j = 0; j < 3; ++j) ins16(top, (ordf(v1s[1] + v2[j]) & ~16383u) | e1s[1] | e2[j]);
        ins16(top, (ordf(v1s[2] + v2[0]) & ~16383u) | e1s[2] | e2[0]);
        ins16(top, (ordf(v1s[3] + v2[0]) & ~16383u) | e1s[3] | e2[0]);
        merge16(top, 16); merge16(top, 32);
        float ev[16]; float den = 0.f; const float mx = unordf(top[0] & ~16383u);
#pragma unroll
        for (int j = 0; j < 16; ++j) { ev[j] = __expf(unordf(top[j] & ~16383u) - mx); den += ev[j]; }
        const float inv = 1.0f / den;
        int* ip = IDX + task * 16; float* gp = GATE + task * 16;
        if (q4 == 0) { *(v4u*)(ip) = (v4u){top[0] & 16383u, top[1] & 16383u, top[2] & 16383u, top[3] & 16383u}; *(f32x4*)(gp) = (f32x4){ev[0] * inv, ev[1] * inv, ev[2] * inv, ev[3] * inv}; }
        else if (q4 == 1) { *(v4u*)(ip + 4) = (v4u){top[4] & 16383u, top[5] & 16383u, top[6] & 16383u, top[7] & 16383u}; *(f32x4*)(gp + 4) = (f32x4){ev[4] * inv, ev[5] * inv, ev[6] * inv, ev[7] * inv}; }
        else if (q4 == 2) { *(v4u*)(ip + 8) = (v4u){top[8] & 16383u, top[9] & 16383u, top[10] & 16383u, top[11] & 16383u}; *(f32x4*)(gp + 8) = (f32x4){ev[8] * inv, ev[9] * inv, ev[10] * inv, ev[11] * inv}; }
        else { *(v4u*)(ip + 12) = (v4u){top[12] & 16383u, top[13] & 16383u, top[14] & 16383u, top[15] & 16383u}; *(f32x4*)(gp + 12) = (f32x4){ev[12] * inv, ev[13] * inv, ev[14] * inv, ev[15] * inv}; }
    }
}
#ifndef EXP_LA
#define EXP_LA 7
#endif
struct ExpRow { v4u lo, hi; };
__device__ __forceinline__ void exp_issue(ExpRow& R, const unsigned char* T, int ex, int jl) {
    const unsigned oA = (unsigned)ex * (unsigned)TROW + 16u * (unsigned)jl;
    R.lo = *(const v4u*)(T + oA); R.hi = *(const v4u*)(T + oA + 256);
}
#define FP4PAIR(W, K) __builtin_amdgcn_cvt_scalef32_pk_f32_fp4((W), 1.0f, (K))
__device__ __forceinline__ float exp_down(const ExpRow& R, const f32x2 (&hq)[32]) {
    f32x2 a2 = (f32x2){0.f, 0.f}, b2 = (f32x2){0.f, 0.f};
#pragma unroll
    for (int j = 0; j < 4; ++j) { const unsigned w = R.lo[j];
        a2 = a2 + FP4PAIR(w, 0) * hq[4 * j]; b2 = b2 + FP4PAIR(w, 1) * hq[4 * j + 1]; a2 = a2 + FP4PAIR(w, 2) * hq[4 * j + 2]; b2 = b2 + FP4PAIR(w, 3) * hq[4 * j + 3]; }
#pragma unroll
    for (int j = 0; j < 4; ++j) { const unsigned w = R.hi[j];
        a2 = a2 + FP4PAIR(w, 0) * hq[16 + 4 * j]; b2 = b2 + FP4PAIR(w, 1) * hq[16 + 4 * j + 1]; a2 = a2 + FP4PAIR(w, 2) * hq[16 + 4 * j + 2]; b2 = b2 + FP4PAIR(w, 3) * hq[16 + 4 * j + 3]; }
    a2 = a2 + b2;
    float a = a2.x + a2.y; asm volatile("" : "+v"(a));
    return a;
}
__device__ __forceinline__ void exp_up(const ExpRow& R, float wk, f32x2 (&oacc)[32]) {
    const f32x2 wk2 = (f32x2){wk, wk};
#pragma unroll
    for (int j = 0; j < 4; ++j) { const unsigned w = R.lo[j];
        oacc[4 * j] = oacc[4 * j] + wk2 * FP4PAIR(w, 0); oacc[4 * j + 1] = oacc[4 * j + 1] + wk2 * FP4PAIR(w, 1); oacc[4 * j + 2] = oacc[4 * j + 2] + wk2 * FP4PAIR(w, 2); oacc[4 * j + 3] = oacc[4 * j + 3] + wk2 * FP4PAIR(w, 3); }
#pragma unroll
    for (int j = 0; j < 4; ++j) { const unsigned w = R.hi[j];
        oacc[16 + 4 * j] = oacc[16 + 4 * j] + wk2 * FP4PAIR(w, 0); oacc[16 + 4 * j + 1] = oacc[16 + 4 * j + 1] + wk2 * FP4PAIR(w, 1); oacc[16 + 4 * j + 2] = oacc[16 + 4 * j + 2] + wk2 * FP4PAIR(w, 2); oacc[16 + 4 * j + 3] = oacc[16 + 4 * j + 3] + wk2 * FP4PAIR(w, 3); }
    asm volatile("" : "+v"(oacc[0]), "+v"(oacc[1]), "+v"(oacc[2]), "+v"(oacc[3]), "+v"(oacc[4]), "+v"(oacc[5]), "+v"(oacc[6]), "+v"(oacc[7]),
                      "+v"(oacc[8]), "+v"(oacc[9]), "+v"(oacc[10]), "+v"(oacc[11]), "+v"(oacc[12]), "+v"(oacc[13]), "+v"(oacc[14]), "+v"(oacc[15]));
    asm volatile("" : "+v"(oacc[16]), "+v"(oacc[17]), "+v"(oacc[18]), "+v"(oacc[19]), "+v"(oacc[20]), "+v"(oacc[21]), "+v"(oacc[22]), "+v"(oacc[23]),
                      "+v"(oacc[24]), "+v"(oacc[25]), "+v"(oacc[26]), "+v"(oacc[27]), "+v"(oacc[28]), "+v"(oacc[29]), "+v"(oacc[30]), "+v"(oacc[31]));
}
__device__ __forceinline__ float exp_rs(float a, float b, int mask, bool hi) { const float keep = hi ? b : a, send = hi ? a : b; return keep + __shfl_xor(send, mask); }
__device__ __forceinline__ void phase_peer_experts(const Params& P, const Ctx& Cin, const Wk& W, int layer, bool last) {
    const Ctx C = fresh_ctx(Cin);
    const unsigned char* TD = P.ws + WS_TAB8 + (size_t)(2 * layer) * TAB8_BYTES; const unsigned char* TU = P.ws + WS_TAB8 + (size_t)(2 * layer + 1) * TAB8_BYTES; const float* SD = (const float*)(P.ws + WS_SC8) + (size_t)(2 * layer) * 16384; bf16* H = (bf16*)(P.ws + WS_H);
    const int* IDX = (const int*)(P.ws + WS_IDX); const float* GATE = (const float*)(P.ws + WS_GATE); const float* MOD = (const float*)(P.ws + WS_MOD);
    const int lane = C.lane, grp = lane >> 4, jl = lane & 15;
    unsigned* ticket = (unsigned*)(P.ws + WS_CTL) + 96 + 2 * layer + W.h;
    const bool dyn = W.n != C.G;
    const int gws = W.lv * NWAVES + C.wave, NGWS = W.n * NWAVES;
    int tnext = gws; if (dyn) { if (lane == 0) tnext = (int)atomicAdd(ticket, 1u); tnext = __builtin_amdgcn_readfirstlane(tnext); }
    if (tnext >= HT) return;
#define SB __builtin_amdgcn_sched_barrier(0);
#define EXP_SRC(GS) (((GS) & 16) ? i1 : i0)
#define EXP_ISSUE(R, GS) { const int gs_ = (GS); const int src_ = EXP_SRC(gs_); exp_issue(R, (gs_ & 32) ? TU : TD, __shfl(src_, (grp << 4) | (gs_ & 15)), jl); }
    int tok = W_TK0(W) + tnext;
    if (dyn) { int tn = 0; if (lane == 0) tn = (int)atomicAdd(ticket, 1u); tnext = tn; } else tnext += NGWS;
    int i0 = IDX[(size_t)tok * 128 + lane], i1 = IDX[(size_t)tok * 128 + 64 + lane];
    float g0 = GATE[(size_t)tok * 128 + lane], g1 = GATE[(size_t)tok * 128 + 64 + lane];
    v4u hn[8];
#pragma unroll
    for (int c = 0; c < 8; ++c) hn[c] = *(const v4u*)(H + (size_t)tok * 1024 + 64 * jl + 8 * c);
    ExpRow R0, R1, R2, R3, R4, R5, R6, R7;
    EXP_ISSUE(R0, 0) EXP_ISSUE(R1, 1) EXP_ISSUE(R2, 2) EXP_ISSUE(R3, 3) EXP_ISSUE(R4, 4) EXP_ISSUE(R5, 5) EXP_ISSUE(R6, 6) SB
    bool more = true;
    while (more) {
        const int b = tok >> 13;
        f32x2 hq[32];
#pragma unroll
        for (int c = 0; c < 8; ++c) {
#pragma unroll
            for (int e = 0; e < 4; ++e) hq[c * 4 + e] = (f32x2){bflo(hn[c][e]), bfhi(hn[c][e])}; }
        const float sd0 = SD[(unsigned)i0], sd1 = SD[(unsigned)i1], su0 = SD[16384u + (unsigned)i0], su1 = SD[16384u + (unsigned)i1];
        float U0 = 0.f, U1 = 0.f, tprev = 0.f;
        const bool j1 = (jl & 1) != 0, j2 = (jl & 2) != 0, j4 = (jl & 4) != 0, j8 = (jl & 8) != 0;
#define EXP_EX(GS) __shfl(EXP_SRC(GS), (grp << 4) | ((GS) & 15))
#define EXP_TAB(GS) (((GS) & 32) ? TU : TD)
#define STEP1(S, RC, RI, PV) { const int ex_ = EXP_EX(g8 + (S) + 7); SB PV = exp_down(RC, hq); SB exp_issue(RI, EXP_TAB(g8 + (S) + 7), ex_, jl); SB }
#pragma unroll 1
        for (int it = 0; it < 4; ++it) {
            const int g8 = 8 * it;
            float p0, p1, p2, p3, p4, p5, p6, p7;
            STEP1(0, R0, R7, p0) STEP1(1, R1, R0, p1)
            const float q0 = exp_rs(p0, p1, 1, j1);
            STEP1(2, R2, R1, p2) STEP1(3, R3, R2, p3)
            const float q1 = exp_rs(p2, p3, 1, j1); const float r0 = exp_rs(q0, q1, 2, j2);
            STEP1(4, R4, R3, p4) STEP1(5, R5, R4, p5)
            const float q2 = exp_rs(p4, p5, 1, j1);
            STEP1(6, R6, R5, p6) STEP1(7, R7, R6, p7)
            const float q3 = exp_rs(p6, p7, 1, j1); const float r1 = exp_rs(q2, q3, 2, j2); const float t = exp_rs(r0, r1, 4, j4);
            if (it & 1) { const float u = exp_rs(tprev, t, 8, j8); if (it == 1) U0 = u; else U1 = u; } else tprev = t;
        }
#undef STEP1
        const float wk0 = g0 * gelu_f(U0 * sd0) * su0, wk1 = g1 * gelu_f(U1 * sd1) * su1;
        if (dyn) tnext = __builtin_amdgcn_readfirstlane(tnext);
        more = tnext < HT;
        const int tokn = more ? W_TK0(W) + tnext : tok;
        if (dyn) { int tn = 0; if (more && lane == 0) tn = (int)atomicAdd(ticket, 1u); tnext = tn; } else tnext += NGWS;
        const int i0n = IDX[(size_t)tokn * 128 + lane], i1n = IDX[(size_t)tokn * 128 + 64 + lane];
        const float g0n = GATE[(size_t)tokn * 128 + lane], g1n = GATE[(size_t)tokn * 128 + 64 + lane];
        f32x2 oacc[32];
#pragma unroll
        for (int e = 0; e < 32; ++e) oacc[e] = (f32x2){0.f, 0.f};
#define EXP_WK(GS) __shfl(((GS) & 16) ? wk1 : wk0, (grp << 4) | ((GS) & 15))
#define EXP_EX2(GS) __shfl((GS) >= 64 ? i0n : EXP_SRC(GS), (grp << 4) | ((GS) & 15))
#define STEP2(S, RC, RI) { const int ex_ = EXP_EX2(g8 + (S) + 7); const float wn_ = EXP_WK(g8 + (S) + 1); SB exp_up(RC, wkc, oacc); SB exp_issue(RI, EXP_TAB(g8 + (S) + 7), ex_, jl); wkc = wn_; SB }
        float wkc = EXP_WK(32);
#pragma unroll 1
        for (int it = 4; it < 8; ++it) {
            const int g8 = 8 * it;
            STEP2(0, R0, R7) STEP2(1, R1, R0) STEP2(2, R2, R1) STEP2(3, R3, R2) STEP2(4, R4, R3) STEP2(5, R5, R4) STEP2(6, R6, R5) STEP2(7, R7, R6)
        }
#undef STEP2
#undef EXP_EX2
#undef EXP_WK
#undef EXP_EX
#undef EXP_TAB
#pragma unroll
        for (int c = 0; c < 8; ++c) hn[c] = *(const v4u*)(H + (size_t)tokn * 1024 + 64 * jl + 8 * c);
        f32x2 h1[16];
        { const bool up = (grp & 2) != 0;
#pragma unroll
          for (int e = 0; e < 16; ++e) { const f32x2 keep = up ? oacc[16 + e] : oacc[e], send = up ? oacc[e] : oacc[16 + e]; h1[e] = keep + (f32x2){__shfl_xor(send.x, 32), __shfl_xor(send.y, 32)}; } }
        f32x2 h2[8];
        { const bool up = (grp & 1) != 0;
#pragma unroll
          for (int e = 0; e < 8; ++e) { const f32x2 keep = up ? h1[8 + e] : h1[e], send = up ? h1[e] : h1[8 + e]; h2[e] = keep + (f32x2){__shfl_xor(send.x, 16), __shfl_xor(send.y, 16)}; } }
        const int d0 = 64 * jl + 16 * grp;
        const float* g2p = MOD + (size_t)(layer * 8 + b) * 6144 + 5120 + d0; const float psc = ((ABL_ON >= (layer == 0 ? 2 : 4)) ? 1.f : 0.f) * (1.0f / EXP_REP);
        float* xp = P.out + (size_t)tok * 1024 + d0;
        float xn[16]; float ss = 0.f;
#pragma unroll
        for (int q = 0; q < 4; ++q) { const f32x4 xa = *(const f32x4*)(xp + 4 * q), ga = *(const f32x4*)(g2p + 4 * q);
            xn[4 * q] = xa[0] + psc * ga[0] * h2[2 * q].x; xn[4 * q + 1] = xa[1] + psc * ga[1] * h2[2 * q].y; xn[4 * q + 2] = xa[2] + psc * ga[2] * h2[2 * q + 1].x; xn[4 * q + 3] = xa[3] + psc * ga[3] * h2[2 * q + 1].y; }
#pragma unroll
        for (int e = 0; e < 16; ++e) ss += xn[e] * xn[e];
        const float rstd = 1.0f / sqrtf(wave_sum(ss) * (1.0f / 1024.0f) + NORM_EPS);
        if (!last) {
            const float* ng = P.norm_mix_g + (layer + 1) * 1024 + d0; const float* mb = MOD + (size_t)((layer + 1) * 8 + b) * 6144 + d0;
            unsigned w[8];
#pragma unroll
            for (int q = 0; q < 4; ++q) { *(f32x4*)(xp + 4 * q) = (f32x4){xn[4 * q], xn[4 * q + 1], xn[4 * q + 2], xn[4 * q + 3]}; }
#pragma unroll
            for (int e = 0; e < 8; ++e) w[e] = pk2(xn[2 * e] * rstd * ng[2 * e] * (1.0f + mb[1024 + 2 * e]) + mb[2 * e], xn[2 * e + 1] * rstd * ng[2 * e + 1] * (1.0f + mb[1024 + 2 * e + 1]) + mb[2 * e + 1]);
            v4u* hp = (v4u*)(H + (size_t)tok * 1024 + d0); hp[0] = (v4u){w[0], w[1], w[2], w[3]}; hp[1] = (v4u){w[4], w[5], w[6], w[7]};
        } else {
            const float* fg = P.final_norm_g + d0;
#pragma unroll
            for (int q = 0; q < 4; ++q) *(f32x4*)(xp + 4 * q) = (f32x4){xn[4 * q] * rstd * fg[4 * q], xn[4 * q + 1] * rstd * fg[4 * q + 1], xn[4 * q + 2] * rstd * fg[4 * q + 2], xn[4 * q + 3] * rstd * fg[4 * q + 3]};
        }
        i0 = i0n; i1 = i1n; g0 = g0n; g1 = g1n; tok = tokn;
    }
#undef EXP_ISSUE
#undef EXP_SRC
#undef SB
}

#ifndef NC_PER_XCD
#define NC_PER_XCD 16
#endif
#ifdef PROBE_SEL
#define SUBSTAMP(i) do { if (W.c == 0 && C.tid == 0) __hip_atomic_store((unsigned*)(P.ws + WS_CTL) + 128 + 16 * W.h + (i), (unsigned)__builtin_amdgcn_s_memrealtime(), __ATOMIC_RELAXED, __HIP_MEMORY_SCOPE_AGENT); } while (0)
#else
#define SUBSTAMP(i) do {} while (0)
#endif
__device__ __forceinline__ void run_C0(const Params& P, const Ctx& Cin, const Wk& W, const XcdBarrier& tb) {
    const Ctx C = fresh_ctx(Cin);
    SUBSTAMP(0);
    unsigned char* ws = P.ws; float* MOD = (float*)(ws + WS_MOD); bf16* H = (bf16*)(ws + WS_H);
    const size_t tk = (size_t)W_TK0(W); unsigned char* const ar = w_ar(P, W);
    phase_norm(P, C, W, P.x, P.norm_mix_g, 0, 0); xcd_barrier(tb); SUBSTAMP(1);
    { pg8::Gemm g{H + tk * 1024, (const bf16*)(ws + WS_WIN), HT, 3072, 1024}; pg8::StaticOrder S; S.init(HT, 3072, W.n, W.c);
      EpiInProj E{(bf16*)(ar + AR_PU), (bf16*)(ar + AR_PV), (bf16*)(ar + AR_PQ), (bf16*)(ar + AR_PI), (bf16*)(ar + AR_PG), (float*)(ar + AR_G), (const float*)(ws + WS_LB)};
      pg8::gemm_phase<EpiInProj, pg8::StaticOrder, true, true>(C.lds, g, S, E); } xcd_barrier(tb); SUBSTAMP(2);
    for (int it = W.lv; it < 1024; it += W.n) gmlp_item(P, C, W, W_TK0(W) / 128 + (it >> 2), it & 3);
    for (int it = W.lv; it < 2048; it += W.n) hgrn_local_item(P, C, W, W_BT0(W) * 512 + it);
    xcd_barrier(tb); SUBSTAMP(3);
    phase_hgrn_scan(P, C, W); xcd_barrier(tb); SUBSTAMP(4);
    for (int it = W.lv; it < 2048; it += W.n) hgrn_out_item(P, C, W, W_BT0(W) * 512 + it);
    xcd_barrier(tb); SUBSTAMP(5);
    { pg8::Gemm g{H + tk * 1024, (const bf16*)(ws + WS_WOUT0), HT, 1024, 1024}; pg8::StaticOrder S; S.init(HT, 1024, W.n, W.c);
      EpiResid E{P.x + tk * 1024, P.out + tk * 1024, MOD + 2048 + (size_t)W_BT0(W) * 6144, 1.f};
      pg8::gemm_phase<EpiResid, pg8::StaticOrder, true, true>(C.lds, g, S, E); } xcd_barrier(tb); SUBSTAMP(6);
    phase_norm(P, C, W, P.out, P.norm_ffn_g, 0, 3072); xcd_barrier(tb); SUBSTAMP(7);
    { pg8::Gemm g{H + tk * 1024, (const bf16*)(ws + WS_WQ0), HT, 2048, 1024}; pg8::StaticOrder S; S.init(HT, 2048, W.n, W.c);
      EpiBf16P E{(bf16*)(ar + AR_QP), 2048};
      pg8::gemm_phase<EpiBf16P, pg8::StaticOrder, true, true>(C.lds, g, S, E); }
    SUBSTAMP(9);
}
__device__ __forceinline__ void run_C1(const Params& P, const Ctx& Cin, const Wk& W, const XcdBarrier& tb) {
    const Ctx C = fresh_ctx(Cin);
    SUBSTAMP(0);
    unsigned char* ws = P.ws; float* MOD = (float*)(ws + WS_MOD); bf16* H = (bf16*)(ws + WS_H);
    const size_t tk = (size_t)W_TK0(W); unsigned char* const ar = w_ar(P, W);
    { pg8::Gemm g{H + tk * 1024, (const bf16*)(ws + WS_WQKV), HT, 3072, 1024}; pg8::StaticOrder S; S.init(HT, 3072, W.n, W.c);
      EpiQKRot E{(bf16*)(ar + AR_QK), (const float*)(ws + WS_CS) + tk * 16};
      pg8::gemm_phase<EpiQKRot, pg8::StaticOrder, true, true>(C.lds, g, S, E); } xcd_barrier(tb); SUBSTAMP(1);
    for (int it = W.lv; it < (NB / 2) * 16 * 16; it += W.n) attn_item(P, C, W, W_BT0(W) + (it >> 8), (it >> 4) & 15, it & 15);
    xcd_barrier(tb); SUBSTAMP(2);
    { pg8::Gemm g{H + tk * 1024, (const bf16*)(ws + WS_WOUT1), HT, 1024, 1024}; pg8::StaticOrder S; S.init(HT, 1024, W.n, W.c);
      EpiResid E{P.out + tk * 1024, P.out + tk * 1024, MOD + (size_t)8 * 6144 + 2048 + (size_t)W_BT0(W) * 6144, 1.f};
      pg8::gemm_phase<EpiResid, pg8::StaticOrder, true, true>(C.lds, g, S, E); } xcd_barrier(tb); SUBSTAMP(3);
    phase_norm(P, C, W, P.out, P.norm_ffn_g + 1024, 1, 3072); xcd_barrier(tb); SUBSTAMP(4);
    { pg8::Gemm g{H + tk * 1024, (const bf16*)(ws + WS_WQ1), HT, 2048, 1024}; pg8::StaticOrder S; S.init(HT, 2048, W.n, W.c);
      EpiBf16P E{(bf16*)(ar + AR_QP), 2048};
      pg8::gemm_phase<EpiBf16P, pg8::StaticOrder, true, true>(C.lds, g, S, E); }
    SUBSTAMP(9);
}
__device__ __forceinline__ void run_E(const Params& P, const Ctx& Cin, const Wk& W, const XcdBarrier& tb, int layer) {
    { const Ctx C = fresh_ctx(Cin); phase_peer_topk(P, C, W, layer); }
    xcd_barrier(tb);
    if (W.c == 0 && Cin.tid == 0) __hip_atomic_store((unsigned*)(P.ws + WS_CTL) + 112 + 2 * layer + W.h, 1u, __ATOMIC_RELAXED, __HIP_MEMORY_SCOPE_AGENT);
    phase_peer_experts(P, Cin, W, layer, layer == 1);
}
__device__ __forceinline__ void help_E(const Params& P, const Ctx& Cin, int h, int layer) {
    volatile LAS unsigned* okw = (volatile LAS unsigned*)(Cin.lds + LDSCTL_OFF + 192);
    if (Cin.tid == 0) { unsigned* flag = (unsigned*)(P.ws + WS_CTL) + 112 + 2 * layer + h; unsigned ok = 0u;
        for (unsigned sp = 0; sp < (1u << 16); ++sp) { if (__hip_atomic_load(flag, __ATOMIC_RELAXED, __HIP_MEMORY_SCOPE_AGENT) != 0u) { ok = 1u; break; } __builtin_amdgcn_s_sleep(8); }
        __builtin_amdgcn_fence(__ATOMIC_ACQUIRE, "agent"); asm volatile("s_waitcnt vmcnt(0)" ::: "memory");
        *okw = ok; }
    __syncthreads();
    const bool ok = *okw != 0u;
    __syncthreads();
    if (ok) { Wk W; W.lv = 0; W.n = 1; W.c = 1; W.h = h; phase_peer_experts(P, Cin, W, layer, layer == 1); }
}
__global__ void __launch_bounds__(NWAVES * 64, 2) hybrid_fwd(Params P) {
    extern __shared__ __attribute__((aligned(16))) unsigned char lds_raw[];
    Ctx C;
    C.lds = (LAS unsigned char*)lds_raw;
    C.tid = threadIdx.x; C.lane = C.tid & 63; C.wave = __builtin_amdgcn_readfirstlane(C.tid >> 6);
    C.G = gridDim.x; const int bx = blockIdx.x; C.vcu = (bx % 8) * (C.G / 8) + bx / 8;
    volatile LAS unsigned* MISC = (volatile LAS unsigned*)(C.lds + MISC_OFF);
    for (int u = C.tid; u < (LDS_BYTES - LDSCTL_OFF) / 4; u += NWAVES * 64) ((LAS unsigned*)(C.lds + LDSCTL_OFF))[u] = 0u;
    __syncthreads();
    unsigned* ctl = (unsigned*)(P.ws + WS_CTL);
    const int xl = bx & 7, jx = bx >> 3, perx = C.G / 8;
    const bool inC = jx < NC_PER_XCD;
    const int nC = 8 * NC_PER_XCD, nE = C.G - nC;
    const XcdBarrier bar_all = xcd_barrier_post(ctl + CW_BAR, MISC + 8);
    XcdBarrier bar_c; bar_c.bar = ctl + CW_BAR + XCD_BAR_WORDS; bar_c.x = bar_all.x; bar_c.st = MISC + 10; bar_c.G = (unsigned)nC;
    if (inC && C.tid == 0) (void)xb_add(&bar_c.bar[XB_XCNT(bar_c.x)], 1u);
    XcdBarrier bar_e; bar_e.bar = ctl + CW_BAR + 2 * XCD_BAR_WORDS; bar_e.x = bar_all.x; bar_e.st = MISC + 12; bar_e.G = (unsigned)nE;
    if (!inC && C.tid == 0) (void)xb_add(&bar_e.bar[XB_XCNT(bar_e.x)], 1u);
    Wk Wall; Wall.lv = C.vcu; Wall.n = C.G; Wall.c = bx; Wall.h = 0;
    Wk Wc; Wc.lv = xl * NC_PER_XCD + jx; Wc.n = nC; Wc.c = jx * 8 + xl; Wc.h = 0;
    Wk We; { const int je = jx - NC_PER_XCD, ne = perx - NC_PER_XCD; We.lv = xl * ne + je; We.n = nE; We.c = je * 8 + xl; We.h = 0; }
    phase_prologue(P, C);
    xcd_barrier(bar_all);
#ifdef PROBE_SEL
    unsigned long long tp0 = __builtin_amdgcn_s_memrealtime(), tp1 = 0, tp2 = 0, tp3 = 0, tp4 = 0, tp5 = 0, tpe1 = 0, tpe2 = 0, tpe3 = 0;
#define STAMP(v) v = __builtin_amdgcn_s_memrealtime()
#else
#define STAMP(v)
#endif
    Wall.h = 0; run_C0(P, C, Wall, bar_all); xcd_barrier(bar_all); STAMP(tp1);
    if (inC) { Wc.h = 1; run_C0(P, C, Wc, bar_c); help_E(P, C, 0, 0); } else { We.h = 0; run_E(P, C, We, bar_e, 0); }
    STAMP(tpe1);
#ifdef PROBE_SEL
    if (C.tid == 0) atomicMax(ctl + 80 + (inC ? 0 : 1), (unsigned)(tpe1 - tp1));
#endif
    xcd_barrier(bar_all); STAMP(tp2);
    if (inC) { Wc.h = 0; run_C1(P, C, Wc, bar_c); help_E(P, C, 1, 0); } else { We.h = 1; run_E(P, C, We, bar_e, 0); }
    STAMP(tpe2);
#ifdef PROBE_SEL
    if (C.tid == 0) atomicMax(ctl + 82 + (inC ? 0 : 1), (unsigned)(tpe2 - tp2));
#endif
    xcd_barrier(bar_all); STAMP(tp3);
    if (inC) { Wc.h = 1; run_C1(P, C, Wc, bar_c); help_E(P, C, 0, 1); } else { We.h = 0; run_E(P, C, We, bar_e, 1); }
    STAMP(tpe3);
#ifdef PROBE_SEL
    if (C.tid == 0) atomicMax(ctl + 84 + (inC ? 0 : 1), (unsigned)(tpe3 - tp3));
#endif
    xcd_barrier(bar_all); STAMP(tp4);
    Wall.h = 1; run_E(P, C, Wall, bar_all, 1);
#ifdef PROBE_SEL
    STAMP(tp5);
    { unsigned long long d = 0; const int sel = PROBE_SEL;
      if (sel == 0) d = tp1 - tp0; if (sel == 1) d = tp2 - tp1; if (sel == 2) d = tp3 - tp2; if (sel == 3) d = tp4 - tp3; if (sel == 4) d = tp5 - tp4;
      if (sel == 5 || sel == 8) d = tpe1 - tp1; if (sel == 6 || sel == 9) d = tpe2 - tp2; if (sel == 7 || sel == 10) d = tpe3 - tp3;
      const int who = sel >= 8 ? 8 * NC_PER_XCD : 0;
      if (sel >= 20) { const unsigned* sp = (const unsigned*)(P.ws + WS_CTL) + 128 + 16 * PROBE_HALF; const int i = sel - 20; const int nxt = (i == PROBE_LAST) ? 9 : i + 1; d = (unsigned long long)(__hip_atomic_load(sp + nxt, __ATOMIC_RELAXED, __HIP_MEMORY_SCOPE_AGENT) - __hip_atomic_load(sp + i, __ATOMIC_RELAXED, __HIP_MEMORY_SCOPE_AGENT)); }
      if (sel >= 30) d = 0;
      if (bx == (sel >= 20 ? 0 : who) && C.tid == 0) __hip_atomic_store(ctl + 64, (unsigned)d, __ATOMIC_RELAXED, __HIP_MEMORY_SCOPE_AGENT);
      xcd_barrier(bar_all);
      if (bx == 0 && C.tid == 0) { const unsigned dd = sel >= 30 ? __hip_atomic_load(ctl + 80 + (sel - 30), __ATOMIC_RELAXED, __HIP_MEMORY_SCOPE_AGENT) : __hip_atomic_load(ctl + 64, __ATOMIC_RELAXED, __HIP_MEMORY_SCOPE_AGENT);
        const unsigned long long t0_ = __builtin_amdgcn_s_memrealtime(); while (__builtin_amdgcn_s_memrealtime() - t0_ < 4ull * dd) __builtin_amdgcn_s_sleep(32); } }
#endif
}

extern "C" void kernel_launch(void* const* d_in, const int* in_sizes, int n_in, void* d_out, int out_size, void* d_ws, size_t ws_size, hipStream_t stream) {
    static int grid = 0;
    if (grid == 0) {
        if (n_in != 22 || in_sizes[0] != T * DM || out_size != T * DM || ws_size < WS_END) {
            fprintf(stderr, "kernel_launch: unexpected shapes (n_in %d, in0 %d, out %d, ws %zu); nothing launched\n", n_in, n_in > 0 ? in_sizes[0] : -1, out_size, ws_size); grid = -1; return; }
        int dev = 0, cus = 0;
        if (hipGetDevice(&dev) != hipSuccess || hipDeviceGetAttribute(&cus, hipDeviceAttributeMultiprocessorCount, dev) != hipSuccess) { fprintf(stderr, "kernel_launch: device query failed\n"); grid = -1; return; }
        if (hipFuncSetAttribute((const void*)hybrid_fwd, hipFuncAttributeMaxDynamicSharedMemorySize, LDS_BYTES) != hipSuccess) { fprintf(stderr, "kernel_launch: hipFuncSetAttribute failed\n"); grid = -1; return; }
        (void)hipGetLastError();
        grid = cus;
        if (grid % 8 != 0 || grid / 8 <= NC_PER_XCD) { fprintf(stderr, "kernel_launch: built for a CU count that is a multiple of 8 and > %d; got %d; nothing launched\n", 8 * NC_PER_XCD, grid); grid = -1; return; }
    }
    if (grid < 0) return;
    if (hipMemsetAsync((char*)d_ws + WS_CTL, 0, CTL_ZERO_BYTES, stream) != hipSuccess) { fprintf(stderr, "kernel_launch: memset failed\n"); return; }
    Params p{};
    p.x = (const float*)d_in[0]; p.c = (const float*)d_in[1]; p.positions = (const int*)d_in[2]; p.ada_w = (const float*)d_in[3]; p.ada_b = (const float*)d_in[4];
    p.norm_mix_g = (const float*)d_in[5]; p.norm_ffn_g = (const float*)d_in[6]; p.final_norm_g = (const float*)d_in[7]; p.even_w_in = (const float*)d_in[8]; p.even_w_out = (const float*)d_in[9];
    p.gmlp_ln_g = (const float*)d_in[10]; p.gmlp_ln_b = (const float*)d_in[11]; p.gmlp_w_s = (const float*)d_in[12]; p.gmlp_b_s = (const float*)d_in[13]; p.hgrn_lb_logits = (const float*)d_in[14];
    p.hgrn_norm_g = (const float*)d_in[15]; p.odd_w_qkv = (const float*)d_in[16]; p.odd_w_out = (const float*)d_in[17]; p.peer_w_query = (const float*)d_in[18]; p.peer_sub_keys = (const float*)d_in[19];
    p.peer_down = (const float*)d_in[20]; p.peer_up = (const float*)d_in[21];
    p.out = (float*)d_out; p.ws = (unsigned char*)d_ws;
    p.ph_lo = 0; p.ph_hi = 0;
    hipLaunchKernelGGL(hybrid_fwd, dim3(grid), dim3(NWAVES * 64), LDS_BYTES, stream, p);
    const hipError_t le = hipPeekAtLastError();
    if (le != hipSuccess) fprintf(stderr, "kernel_launch: launch failed: %s\n", hipGetErrorName(le));
}
```

```cpp
#include <hip/hip_runtime.h>
#include <cstdio>
#include <cstdint>
#include <cmath>
namespace pg8 {
#define PG8_LAS __attribute__((address_space(3)))
typedef unsigned short bf16_t;
typedef short bf16x8 __attribute__((ext_vector_type(8)));
typedef float f32x4 __attribute__((ext_vector_type(4)));
typedef unsigned u32x4 __attribute__((ext_vector_type(4)));
constexpr int BM = 256, BK = 64, HALF = 128, HTB = HALF * BK * 2  , STAGE_BYTES = 8 * HTB, NXCD = 8, WGM = 8;

__host__ __device__ __forceinline__ int lds_byte(int r, int c) { const int st = (r >> 4) * 2 + (c >> 5), rr = r & 15, cc = c & 31, ob = rr * 64 + cc * 2; return st * 1024 + (ob ^ (((ob >> 9) & 1) << 5)); }
__host__ __device__ __forceinline__ void stage_rc(int b, int& R, int& C) { const int st = b / 1024, sb = b % 1024, swz = sb ^ (((sb >> 9) & 1) << 5); R = (st >> 1) * 16 + swz / 64; C = (st & 1) * 32 + (swz % 64) / 2; }
__host__ __device__ __forceinline__ int perm32(int rho) { const int n = rho >> 4, i = rho & 15; return 8 * (i >> 2) + 4 * n + (i & 3); }

struct Unit { int pm, pn; };
struct Gemm { const bf16_t* A; const bf16_t* Bt; int M, N, K; };

struct StaticOrder {
    int nM, nN, nwg, G, c;
    __host__ __device__ void init(int M, int N, int G_, int c_) { nM = M / BM; nN = N / BM; nwg = nM * nN; G = G_; c = c_; }
    __host__ __device__ bool next(int i, Unit& u) const {
        const long L = (long)i * G + c; if (L >= nwg) return false;
        int wgid = (int)L; { const int q = nwg / NXCD, r = nwg % NXCD, xcd = wgid % NXCD, off = wgid / NXCD; wgid = (xcd < r ? xcd * (q + 1) : r * (q + 1) + (xcd - r) * q) + off; }
        const int nig = WGM * nN, gid = wgid / nig, fm = gid * WGM, gsz = (nM - fm) < WGM ? (nM - fm) : WGM;
        u.pm = fm + ((wgid % nig) % gsz); u.pn = (wgid % nig) / gsz; return true;
    }
    __device__ __forceinline__ void a_ready(const Unit&) const {}
    __device__ __forceinline__ void done(const Unit&) const {}
};

__device__ __forceinline__ unsigned cvt_pk_bf16(float lo, float hi) { unsigned r; asm volatile("v_cvt_pk_bf16_f32 %0, %1, %2" : "=v"(r) : "v"(lo), "v"(hi)); return r; }
typedef float f32x2 __attribute__((ext_vector_type(2)));
__device__ __forceinline__ f32x2 gelu_pk(f32x2 v) {
    const f32x2 av = __builtin_elementwise_abs(v), d = av * 0.2316418882f + 1.0f;
    f32x2 t; t.x = __builtin_amdgcn_rcpf(d.x); t.y = __builtin_amdgcn_rcpf(d.y);
    f32x2 q = t * 0.5307027145f + (-0.7265760135f); q = q * t + 0.7107068705f; q = q * t + (-0.142248368f); q = q * t + 0.127414796f; q = q * t;
    const f32x2 s = (v * v) * (-0.72134752044f);
    f32x2 e; e.x = __builtin_amdgcn_exp2f(s.x); e.y = __builtin_amdgcn_exp2f(s.y);
    const f32x2 m = v * (q * e), r = v - m;
    f32x2 o; o.x = v.x < 0.f ? m.x : r.x; o.y = v.y < 0.f ? m.y : r.y; return o;
}

template <class Epi, class Sched, bool ALIGN_EPI = false, bool SP2 = false>
__device__ __forceinline__ void gemm_phase(PG8_LAS unsigned char* lds, const Gemm g, const Sched& S, const Epi& E) {
    int tid_ = threadIdx.x; asm volatile("" : "+v"(tid_));
    const int tid = tid_, wid = __builtin_amdgcn_readfirstlane(tid >> 6), lane = tid & 63, wr = wid >> 2, wc = wid & 3, fr = lane & 15, fq = lane >> 4;
    const int K = g.K, nt = K / BK;
    unsigned voffA[2], voffB[2];
#pragma unroll
    for (int i = 0; i < 2; ++i) { int R, C; stage_rc(tid * 16 + i * 8192, R, C); const int Rb = Epi::PERM ? ((R & ~31) + perm32(R & 31)) : R;
        voffA[i] = (unsigned)(R * K + C) * 2u; voffB[i] = (unsigned)(Rb * K + C) * 2u; }
    const size_t kstep = (size_t)(BK * 2);
    const size_t hstep = (size_t)HALF * K * 2;
    const size_t tstep = 2 * hstep;
    const unsigned ldsw = (unsigned)wid * 1024u;
    const int aoff = lds_byte(wr * 64 + fr, fq * 8), boff = lds_byte(wc * 32 + fr, fq * 8);
#define PG8_SA(b, h) (((b) * 2 + (h)) * HTB)
#define PG8_SB(b, h) ((4 + (b) * 2 + (h)) * HTB)
#define PG8_STAGE(bufoff, gbase, voff) do { _Pragma("unroll") for (int _i = 0; _i < 2; ++_i) \
        __builtin_amdgcn_global_load_lds((const unsigned*)((const char*)(gbase) + (voff)[_i]), (PG8_LAS unsigned*)(lds + (bufoff) + ldsw + _i * 8192), 16, 0, 0); } while (0)
#define PG8_LDA(dst, b, h) do { _Pragma("unroll") for (int m = 0; m < 4; ++m) _Pragma("unroll") for (int k = 0; k < 2; ++k) dst[m][k] = *(const PG8_LAS bf16x8*)(lds + PG8_SA(b, h) + aoff + m * 2048 + k * 1024); } while (0)
#define PG8_LDB(dst, b, h) do { _Pragma("unroll") for (int n = 0; n < 2; ++n) _Pragma("unroll") for (int k = 0; k < 2; ++k) dst[n][k] = *(const PG8_LAS bf16x8*)(lds + PG8_SB(b, h) + boff + n * 2048 + k * 1024); } while (0)
#define PG8_MMA(ai, bj, At, Bt) do { __builtin_amdgcn_s_setprio(1); _Pragma("unroll") for (int m = 0; m < 4; ++m) _Pragma("unroll") for (int n = 0; n < 2; ++n) _Pragma("unroll") for (int k = 0; k < 2; ++k) \
        acc[ai][bj][m][n] = __builtin_amdgcn_mfma_f32_16x16x32_bf16(Bt[n][k], At[m][k], acc[ai][bj][m][n], 0, 0, 0); __builtin_amdgcn_s_setprio(0); } while (0)
#define PG8_WAIT_V(n) asm volatile("s_waitcnt vmcnt(" #n ")" ::: "memory")
#define PG8_WAIT_L(n) asm volatile("s_waitcnt lgkmcnt(" #n ")" ::: "memory")
#define PG8_BAR __builtin_amdgcn_s_barrier()
#define PG8_SCHED __builtin_amdgcn_sched_barrier(0)
    Unit cur, nxt; int ui = 0;
    if (!S.next(0, cur)) return;
    f32x4 acc[2][2][4][2];
#pragma unroll
    for (int a = 0; a < 2; ++a)
#pragma unroll
        for (int b = 0; b < 2; ++b)
#pragma unroll
            for (int m = 0; m < 4; ++m)
#pragma unroll
                for (int n = 0; n < 2; ++n) acc[a][b][m][n] = (f32x4){0.f, 0.f, 0.f, 0.f};
    bf16x8 At[4][2], B0[2][2], B1[2][2];
    const char* cA = (const char*)g.A + (size_t)cur.pm * tstep; const char* cB = (const char*)g.Bt + (size_t)cur.pn * tstep;
    S.a_ready(cur);
    if constexpr (SP2) {
        PG8_STAGE(PG8_SB(0, 0), cB, voffB); PG8_STAGE(PG8_SB(0, 1), cB + hstep, voffB); PG8_STAGE(PG8_SA(0, 0), cA, voffA); PG8_STAGE(PG8_SA(0, 1), cA + hstep, voffA);
        if (wr == 1) PG8_BAR;
        PG8_WAIT_V(2); PG8_BAR;
        PG8_STAGE(PG8_SB(1, 0), cB + kstep, voffB); PG8_STAGE(PG8_SA(1, 0), cA + kstep, voffA); PG8_STAGE(PG8_SB(1, 1), cB + hstep + kstep, voffB);
        PG8_WAIT_V(6); PG8_BAR;
    } else {
        PG8_STAGE(PG8_SB(0, 0), cB, voffB); PG8_STAGE(PG8_SA(0, 0), cA, voffA); PG8_STAGE(PG8_SB(0, 1), cB + hstep, voffB); PG8_STAGE(PG8_SA(0, 1), cA + hstep, voffA);
        if (wr == 1) PG8_BAR;
        PG8_WAIT_V(4); PG8_BAR;
        PG8_STAGE(PG8_SB(1, 0), cB + kstep, voffB); PG8_STAGE(PG8_SA(1, 0), cA + kstep, voffA); PG8_STAGE(PG8_SB(1, 1), cB + hstep + kstep, voffB);
        PG8_WAIT_V(6); PG8_BAR;
    }
    for (;;) {
        const bool has_next = S.next(ui + 1, nxt);
        const char* nA = has_next ? (const char*)g.A + (size_t)nxt.pm * tstep : cA; const char* nB = has_next ? (const char*)g.Bt + (size_t)nxt.pn * tstep : cB;
        for (int t = 0; t < nt; t += 2) {
            const bool last = (t == nt - 2);
            const char* a1 = cA + (size_t)(t + 1) * kstep;
            const char* a2 = last ? nA : cA + (size_t)(t + 2) * kstep; const char* b2 = last ? nB : cB + (size_t)(t + 2) * kstep;
            const char* a3 = a2 + kstep; const char* b3 = b2 + kstep;
            if (last && has_next) S.a_ready(nxt);
            if constexpr (SP2) {
            PG8_LDB(B0, 0, 0); PG8_LDB(B1, 0, 1); PG8_SCHED; PG8_LDA(At, 0, 0); PG8_STAGE(PG8_SA(1, 1), a1 + hstep, voffA);
            PG8_WAIT_V(8); PG8_WAIT_L(0); PG8_BAR; PG8_MMA(0, 0, At, B0); PG8_MMA(0, 1, At, B1); PG8_BAR; PG8_SCHED;
            PG8_LDA(At, 0, 1); PG8_STAGE(PG8_SB(0, 0), b2, voffB); PG8_STAGE(PG8_SB(0, 1), b2 + hstep, voffB); PG8_STAGE(PG8_SA(0, 0), a2, voffA);
            PG8_WAIT_V(8); PG8_WAIT_L(0); PG8_BAR; PG8_MMA(1, 0, At, B0); PG8_MMA(1, 1, At, B1); PG8_BAR; PG8_SCHED;
            PG8_LDB(B0, 1, 0); PG8_LDB(B1, 1, 1); PG8_SCHED; PG8_LDA(At, 1, 0); PG8_STAGE(PG8_SA(0, 1), a2 + hstep, voffA);
            PG8_WAIT_V(8); PG8_WAIT_L(0); PG8_BAR; PG8_MMA(0, 0, At, B0); PG8_MMA(0, 1, At, B1); PG8_BAR; PG8_SCHED;
            PG8_LDA(At, 1, 1); PG8_STAGE(PG8_SB(1, 0), b3, voffB); PG8_STAGE(PG8_SB(1, 1), b3 + hstep, voffB); PG8_STAGE(PG8_SA(1, 0), a3, voffA);
            PG8_WAIT_V(8); PG8_WAIT_L(0); PG8_BAR; PG8_MMA(1, 0, At, B0); PG8_MMA(1, 1, At, B1); PG8_BAR; PG8_SCHED;
            } else {
            PG8_LDB(B0, 0, 0); PG8_SCHED; PG8_LDA(At, 0, 0); PG8_STAGE(PG8_SA(1, 1), a1 + hstep, voffA);
            PG8_WAIT_L(8); PG8_BAR; PG8_WAIT_L(0); PG8_MMA(0, 0, At, B0); PG8_BAR; PG8_SCHED;
            PG8_LDB(B1, 0, 1); PG8_STAGE(PG8_SB(0, 0), b2, voffB);
            PG8_BAR; PG8_WAIT_L(0); PG8_MMA(0, 1, At, B1); PG8_BAR;
            PG8_LDA(At, 0, 1); PG8_STAGE(PG8_SA(0, 0), a2, voffA);
            PG8_BAR; PG8_WAIT_L(0); PG8_MMA(1, 0, At, B0); PG8_BAR; PG8_SCHED;
            PG8_STAGE(PG8_SB(0, 1), b2 + hstep, voffB);
            PG8_WAIT_V(6); PG8_BAR; PG8_MMA(1, 1, At, B1); PG8_BAR;
            PG8_LDB(B0, 1, 0); PG8_SCHED; PG8_LDA(At, 1, 0); PG8_STAGE(PG8_SA(0, 1), a2 + hstep, voffA);
            PG8_WAIT_L(8); PG8_BAR; PG8_WAIT_L(0); PG8_MMA(0, 0, At, B0); PG8_BAR; PG8_SCHED;
            PG8_LDB(B1, 1, 1); PG8_STAGE(PG8_SB(1, 0), b3, voffB);
            PG8_BAR; PG8_WAIT_L(0); PG8_MMA(0, 1, At, B1); PG8_BAR;
            PG8_LDA(At, 1, 1); PG8_STAGE(PG8_SA(1, 0), a3, voffA);
            PG8_BAR; PG8_WAIT_L(0); PG8_MMA(1, 0, At, B0); PG8_BAR; PG8_SCHED;
            PG8_STAGE(PG8_SB(1, 1), b3 + hstep, voffB);
            PG8_WAIT_V(6); PG8_BAR; PG8_MMA(1, 1, At, B1); PG8_BAR;
            }
        }
        if constexpr (ALIGN_EPI) { if (wr == 0) PG8_BAR; }
        if constexpr (!Epi::AFTER_DRAIN) { E(acc, cur, wr, wc, fr, fq); S.done(cur); }
        if (!has_next) break;
#pragma unroll
        for (int a = 0; a < 2; ++a)
#pragma unroll
            for (int b = 0; b < 2; ++b)
#pragma unroll
                for (int m = 0; m < 4; ++m)
#pragma unroll
                    for (int n = 0; n < 2; ++n) acc[a][b][m][n] = (f32x4){0.f, 0.f, 0.f, 0.f};
        cur = nxt; cA = nA; cB = nB; ++ui;
        if constexpr (ALIGN_EPI) { if (wr == 1) PG8_BAR; }
    }
    PG8_WAIT_V(0);
    if constexpr (!ALIGN_EPI) { if (wr == 0) PG8_BAR; }
    PG8_BAR;
    if constexpr (Epi::AFTER_DRAIN) { E.fused(acc, cur, wr, wc, fr, fq, lds, wid, lane); S.done(cur); }
#undef PG8_SA
#undef PG8_SB
#undef PG8_STAGE
#undef PG8_LDA
#undef PG8_LDB
#undef PG8_MMA
#undef PG8_WAIT_V
#undef PG8_WAIT_L
#undef PG8_BAR
#undef PG8_SCHED
}
}
#define GAS __attribute__((address_space(1)))
#define LAS __attribute__((address_space(3)))
typedef unsigned short bf16;
typedef unsigned v4u __attribute__((ext_vector_type(4)));
typedef float f32x4 __attribute__((ext_vector_type(4)));
typedef short bf16x8 __attribute__((ext_vector_type(8)));
typedef __bf16 bf16x2_t __attribute__((ext_vector_type(2)));
#define LDS_WAIT() asm volatile("s_waitcnt lgkmcnt(0)" ::: "memory")
#define VM_WAIT() asm volatile("s_waitcnt vmcnt(0)" ::: "memory")
typedef float f32x2_cv __attribute__((ext_vector_type(2)));
__device__ __forceinline__ unsigned pk2(float lo, float hi) { const f32x2_cv v = {lo, hi}; return __builtin_bit_cast(unsigned, __builtin_convertvector(v, bf16x2_t)); }
__device__ __forceinline__ unsigned f2bf(float f) { return pk2(f, 0.f) & 0xffffu; }
__device__ __forceinline__ float bflo(unsigned u) { return __builtin_bit_cast(float, u << 16); }
__device__ __forceinline__ float bfhi(unsigned u) { return __builtin_bit_cast(float, u & 0xffff0000u); }
__device__ __forceinline__ float bf2f(bf16 u) { return __builtin_bit_cast(float, (unsigned)u << 16); }
#define XB_TMO      128
#define XB_XCNT(j)  (256  + 64 * (j))
#define XB_XSUB(j)  (1280 + 64 * (j))
#define XB_XGEN(j)  (2304 + 64 * (j))
#define XB_TOP      3328
#define XB_TOPGEN   3392
#define XCD_BAR_WORDS 3456
#define XB_SPIN_CAP (1u << 18)

__device__ __forceinline__ unsigned xb_ld(unsigned* p)              { return __hip_atomic_load(p, __ATOMIC_RELAXED, __HIP_MEMORY_SCOPE_AGENT); }
__device__ __forceinline__ unsigned xb_add(unsigned* p, unsigned v) { return __hip_atomic_fetch_add(p, v, __ATOMIC_RELAXED, __HIP_MEMORY_SCOPE_AGENT); }
__device__ __forceinline__ unsigned xb_xcc_id() { return (unsigned)__builtin_amdgcn_s_getreg((3 << 11) | 20) & 0xFu; }
#define XB_SPIN(cond, bar) do { unsigned _sp = 0; while (cond) { __builtin_amdgcn_s_sleep(1); \
    if ((++_sp & 255u) == 0u) { if (xb_ld(&(bar)[XB_TMO])) break; if (_sp > XB_SPIN_CAP) { atomicAdd(&(bar)[XB_TMO], 1u); break; } } } } while (0)

struct XcdBarrier {
    unsigned* bar; unsigned x; unsigned G;
    volatile LAS unsigned* st;
};

__device__ __forceinline__ XcdBarrier xcd_barrier_post(unsigned* bar, volatile LAS unsigned* st) {
    XcdBarrier b; b.bar = bar; b.x = xb_xcc_id(); b.st = st; b.G = gridDim.x;
    if (threadIdx.x == 0) (void)xb_add(&bar[XB_XCNT(b.x)], 1u);
    return b;
}
__device__ __forceinline__ void xcd_barrier_complete(unsigned* bar, unsigned x, unsigned& nloc, unsigned& nx, const unsigned G) {
    unsigned sum, cnt, mine, sp = 0u;
    for (;;) {
        sum = 0u; cnt = 0u; mine = 0u;
#pragma unroll
        for (unsigned j = 0; j < 16; ++j) { const unsigned c = xb_ld(&bar[XB_XCNT(j)]); sum += c; cnt += (c > 0u) ? 1u : 0u; mine = (j == x) ? c : mine; }
        if (sum == G) break;
        __builtin_amdgcn_s_sleep(1);
        if ((++sp & 255u) == 0u) { if (xb_ld(&bar[XB_TMO])) break; if (sp > XB_SPIN_CAP) { atomicAdd(&bar[XB_TMO], 1u); break; } }
    }
    nloc = mine > 0u ? mine : 1u; nx = cnt > 0u ? cnt : 1u;
}

__device__ __forceinline__ void xcd_barrier(const XcdBarrier& b) {
    asm volatile("s_waitcnt vmcnt(0)" ::: "memory");
    __syncthreads();
    if (threadIdx.x == 0) {
        unsigned* bar = b.bar;
        __builtin_amdgcn_s_waitcnt(0);
        unsigned nloc = b.st[0], nx = b.st[1];
        if (nloc == 0u) { xcd_barrier_complete(bar, b.x, nloc, nx, b.G); b.st[0] = nloc; b.st[1] = nx; }
        const unsigned old = xb_add(&bar[XB_XSUB(b.x)], 1u);
        const unsigned gen = old / nloc;
        if (old + 1u == (gen + 1u) * nloc) {
            __builtin_amdgcn_fence(__ATOMIC_RELEASE, "agent");
            asm volatile("s_waitcnt vmcnt(0)" ::: "memory");
            const unsigned og = xb_add(&bar[XB_TOP], 1u);
            const unsigned tg = og / nx;
            if (og + 1u == (tg + 1u) * nx) xb_add(&bar[XB_TOPGEN], 1u);
            else XB_SPIN(xb_ld(&bar[XB_TOPGEN]) == tg, bar);
            __builtin_amdgcn_fence(__ATOMIC_ACQUIRE, "agent");
            xb_add(&bar[XB_XGEN(b.x)], 1u);
            asm volatile("s_waitcnt vmcnt(0)" ::: "memory");
        } else {
            XB_SPIN(xb_ld(&bar[XB_XGEN(b.x)]) == gen, bar);
            __builtin_amdgcn_fence(__ATOMIC_ACQUIRE, "agent");
            asm volatile("s_waitcnt vmcnt(0)" ::: "memory");
        }
    }
    __syncthreads();
}

constexpr int NB = 8, SEQ = 8192, DM = 1024, T = NB * SEQ;
constexpr int NWAVES = 8;
constexpr float NORM_EPS = 1e-6f;
constexpr float C2 = 0.125f * 1.4426950408889634f;

constexpr size_t MiB = 1u << 20;
constexpr size_t WS_CTL = 0, CTL_ZERO_BYTES = 1 * MiB;
constexpr size_t WS_MOD = 1 * MiB;
constexpr size_t WS_SKB = 1 * MiB + 512 * 1024;
constexpr size_t WS_WSB = 1 * MiB + 768 * 1024;
constexpr size_t WS_LB  = 1 * MiB + 960 * 1024;
constexpr size_t WS_CS  = 2 * MiB;
constexpr size_t WS_HD  = 6 * MiB;
constexpr size_t WS_WIN = 16 * MiB, WS_WOUT0 = 22 * MiB, WS_WQKV = 24 * MiB, WS_WOUT1 = 30 * MiB, WS_WQ0 = 32 * MiB, WS_WQ1 = 36 * MiB;
constexpr size_t WS_TAB8 = 40 * MiB, TAB8_BYTES = 12 * MiB;
constexpr int TROW = 512;
constexpr size_t WS_SC8 = 8 * MiB;
constexpr size_t WS_H = 108 * MiB;
constexpr size_t WS_IDX = 236 * MiB, WS_GATE = 268 * MiB;
constexpr size_t WS_AR0 = 300 * MiB, AR_BYTES = 352 * MiB;
constexpr size_t AR_PU = 0, AR_PV = 32 * MiB, AR_PQ = 64 * MiB, AR_PI = 96 * MiB, AR_PG = 128 * MiB;
constexpr size_t AR_G = 160 * MiB;
constexpr size_t AR_KVT = 224 * MiB, AR_ST = 288 * MiB;
constexpr size_t AR_QP = 0;
constexpr size_t AR_QK = 0;
constexpr int QK_ROWS = SEQ + SEQ / 16;
__host__ __device__ __forceinline__ int qk_row(int t) { return t + (t >> 4); }
constexpr size_t WS_END = WS_AR0 + 2 * AR_BYTES;
constexpr int HT = T / 2;
constexpr int CW_BAR = 4096;

constexpr int LDS_BYTES = 147456;
constexpr int LDSCTL_OFF = LDS_BYTES - 512;
constexpr int MISC_OFF = LDSCTL_OFF;

struct Params {
    const float* x; const float* c; const int* positions; const float* ada_w; const float* ada_b; const float* norm_mix_g; const float* norm_ffn_g; const float* final_norm_g;
    const float* even_w_in; const float* even_w_out; const float* gmlp_ln_g; const float* gmlp_ln_b; const float* gmlp_w_s; const float* gmlp_b_s; const float* hgrn_lb_logits; const float* hgrn_norm_g;
    const float* odd_w_qkv; const float* odd_w_out; const float* peer_w_query; const float* peer_sub_keys; const float* peer_down; const float* peer_up;
    float* out; unsigned char* ws; int ph_lo, ph_hi;
};
struct Ctx { LAS unsigned char* lds; int tid, lane, wave, vcu, G; };
__device__ __forceinline__ Ctx fresh_ctx(const Ctx& C0) { Ctx C = C0; int t_ = threadIdx.x; asm volatile("" : "+v"(t_)); C.tid = t_; C.lane = t_ & 63; C.wave = __builtin_amdgcn_readfirstlane(t_ >> 6); return C; }
struct Wk { int lv, n, c, h; };
#define W_TK0(W) ((W).h * (T / 2))
#define W_BT0(W) ((W).h * (NB / 2))
__device__ __forceinline__ unsigned char* w_ar(const Params& P, const Wk& W) { return P.ws + WS_AR0 + (size_t)W.h * AR_BYTES; }
__device__ __forceinline__ bf16* w_tok16(const Params& P, const Wk& W, size_t off, int pitch) { return (bf16*)(w_ar(P, W) + off) - (size_t)W_TK0(W) * pitch; }
__device__ __forceinline__ float* w_tok32(const Params& P, const Wk& W, size_t off, int pitch) { return (float*)(w_ar(P, W) + off) - (size_t)W_TK0(W) * pitch; }
__device__ __forceinline__ bf16* w_item16(const Params& P, const Wk& W, size_t off) { return (bf16*)(w_ar(P, W) + off) - (size_t)W_BT0(W) * 512 * 16384; }

__device__ __forceinline__ float wave_sum(float v) {
#pragma unroll
    for (int o = 1; o < 64; o <<= 1) v += __shfl_xor(v, o);
    return v;
}
__device__ __forceinline__ float silu_f(float x) { return x * __builtin_amdgcn_rcpf(1.0f + __builtin_amdgcn_exp2f(-1.4426950408889634f * x)); }
__device__ __forceinline__ float sigmoid_f(float x) { return __builtin_amdgcn_rcpf(1.0f + __builtin_amdgcn_exp2f(-1.4426950408889634f * x)); }
__device__ __forceinline__ float gelu_f(float x) { return 0.5f * x * (1.0f + erff(x * 0.70710678118654752f)); }
__device__ __forceinline__ f32x4 mma16(f32x4 acc, const LAS bf16* A, int lda, const LAS bf16* Bt, int ldb, int K, int r, int q4) {
    const LAS bf16* ap = A + r * lda + 8 * q4; const LAS bf16* bp = Bt + r * ldb + 8 * q4;
    for (int k0 = 0; k0 < K; k0 += 32) {
        const bf16x8 a = *(const LAS bf16x8*)(ap + k0); const bf16x8 b = *(const LAS bf16x8*)(bp + k0);
        acc = __builtin_amdgcn_mfma_f32_16x16x32_bf16(a, b, acc, 0, 0, 0);
    }
    return acc;
}

struct EpiBf16P {
    static constexpr bool PERM = true, AFTER_DRAIN = false;
    bf16* O; size_t ldc;
    __device__ __forceinline__ void operator()(const f32x4 (&acc)[2][2][4][2], const pg8::Unit& u, int wr, int wc, int fr, int fq) const {
        const int row0 = u.pm * 256 + wr * 64 + fr, col0 = u.pn * 256 + wc * 32 + 8 * fq;
#pragma unroll
        for (int ai = 0; ai < 2; ++ai)
#pragma unroll
            for (int m = 0; m < 4; ++m) { bf16* rowp = O + (size_t)(row0 + ai * 128 + m * 16) * ldc + col0;
#pragma unroll
                for (int bj = 0; bj < 2; ++bj) { const f32x4 v0 = acc[ai][bj][m][0], v1 = acc[ai][bj][m][1];
                    v4u w; w.x = pg8::cvt_pk_bf16(v0[0], v0[1]); w.y = pg8::cvt_pk_bf16(v0[2], v0[3]); w.z = pg8::cvt_pk_bf16(v1[0], v1[1]); w.w = pg8::cvt_pk_bf16(v1[2], v1[3]);
                    *(v4u*)(rowp + bj * 128) = w; } }
    }
};
#ifndef REP_HG
#define REP_HG 1
#endif
#ifndef REP_TOPK
#define REP_TOPK 1
#endif
#ifndef REP_PRO
#define REP_PRO 1
#endif
#ifndef REP_NORM
#define REP_NORM 1
#endif
#ifndef REP_GEMM2
#define REP_GEMM2 1
#endif
#ifndef REP_GEMM
#define REP_GEMM 1
#endif
#ifndef EXP_REP
#define EXP_REP 1
#endif
#ifndef ATT_REP
#define ATT_REP 1
#endif
#ifndef ABL_ON
#define ABL_ON 4
#endif
struct EpiResid {
    static constexpr bool PERM = true, AFTER_DRAIN = false;
    const float* xin; float* xout; const float* gate; float gsc;
    __device__ __forceinline__ void operator()(const f32x4 (&acc)[2][2][4][2], const pg8::Unit& u, int wr, int wc, int fr, int fq) const {
        const int row0 = u.pm * 256 + wr * 64 + fr, col0 = u.pn * 256 + wc * 32 + 8 * fq;
        const float* gp = gate + (size_t)((u.pm * 256) >> 13) * 6144 + col0;
        f32x4 gv[2][2];
#pragma unroll
        for (int bj = 0; bj < 2; ++bj) { gv[bj][0] = *(const f32x4*)(gp + bj * 128); gv[bj][1] = *(const f32x4*)(gp + bj * 128 + 4); }
#pragma unroll
        for (int ai = 0; ai < 2; ++ai)
#pragma unroll
            for (int m = 0; m < 4; ++m) { const size_t off = (size_t)(row0 + ai * 128 + m * 16) * 1024 + col0;
#pragma unroll
                for (int bj = 0; bj < 2; ++bj) {
                    const f32x4 x0 = *(const f32x4*)(xin + off + bj * 128), x1 = *(const f32x4*)(xin + off + bj * 128 + 4);
                    *(f32x4*)(xout + off + bj * 128) = x0 + gv[bj][0] * acc[ai][bj][m][0] * gsc;
                    *(f32x4*)(xout + off + bj * 128 + 4) = x1 + gv[bj][1] * acc[ai][bj][m][1] * gsc; }
                asm volatile("" ::: "memory"); }
    }
};
struct EpiInProj {
    static constexpr bool PERM = true, AFTER_DRAIN = false;
    bf16* PU; bf16* PV; bf16* PQ; bf16* PI; bf16* PG; float* G; const float* LB;
    __device__ __forceinline__ void operator()(const f32x4 (&acc)[2][2][4][2], const pg8::Unit& u, int wr, int wc, int fr, int fq) const {
        const int type = u.pn >> 1;
        const int row0 = u.pm * 256 + wr * 64 + fr, lc0 = (u.pn & 1) * 256 + wc * 32 + 8 * fq;
        if (type == 3) {
            f32x4 lb[2][2];
#pragma unroll
            for (int bj = 0; bj < 2; ++bj) { lb[bj][0] = *(const f32x4*)(LB + lc0 + bj * 128); lb[bj][1] = *(const f32x4*)(LB + lc0 + bj * 128 + 4); }
#pragma unroll
            for (int ai = 0; ai < 2; ++ai)
#pragma unroll
                for (int m = 0; m < 4; ++m) { float* rowp = G + (size_t)(row0 + ai * 128 + m * 16) * 512 + lc0;
#pragma unroll
                    for (int bj = 0; bj < 2; ++bj)
#pragma unroll
                        for (int n = 0; n < 2; ++n) { const f32x4 v = acc[ai][bj][m][n]; f32x4 o;
#pragma unroll
                            for (int e = 0; e < 4; ++e) { const float l = lb[bj][n][e]; const float f = l + (1.0f - l) * sigmoid_f(v[e]); o[e] = __logf(f); }
                            *(f32x4*)(rowp + bj * 128 + 4 * n) = o; } }
            return;
        }
        bf16* base = type == 0 ? PU : type == 1 ? PV : type == 2 ? PQ : type == 4 ? PI : PG;
#pragma unroll
        for (int ai = 0; ai < 2; ++ai)
#pragma unroll
            for (int m = 0; m < 4; ++m) { bf16* rowp = base + (size_t)(row0 + ai * 128 + m * 16) * 512 + lc0;
#pragma unroll
                for (int bj = 0; bj < 2; ++bj) { f32x4 v0 = acc[ai][bj][m][0], v1 = acc[ai][bj][m][1];
                    if (type <= 1) { pg8::f32x2 a = pg8::gelu_pk((pg8::f32x2){v0[0], v0[1]}), b = pg8::gelu_pk((pg8::f32x2){v0[2], v0[3]}), c = pg8::gelu_pk((pg8::f32x2){v1[0], v1[1]}), d = pg8::gelu_pk((pg8::f32x2){v1[2], v1[3]});
                        v0 = (f32x4){a.x, a.y, b.x, b.y}; v1 = (f32x4){c.x, c.y, d.x, d.y}; }
                    else if (type == 2) {
#pragma unroll
                        for (int e = 0; e < 4; ++e) { v0[e] = silu_f(v0[e]) * 0.08838834764831845f; v1[e] = silu_f(v1[e]) * 0.08838834764831845f; } }
                    else if (type == 5) {
#pragma unroll
                        for (int e = 0; e < 4; ++e) { v0[e] = silu_f(v0[e]); v1[e] = silu_f(v1[e]); } }
                    v4u w; w.x = pg8::cvt_pk_bf16(v0[0], v0[1]); w.y = pg8::cvt_pk_bf16(v0[2], v0[3]); w.z = pg8::cvt_pk_bf16(v1[0], v1[1]); w.w = pg8::cvt_pk_bf16(v1[2], v1[3]);
                    *(v4u*)(rowp + bj * 128) = w; } }
    }
};
struct EpiQKRot {
    static constexpr bool PERM = true, AFTER_DRAIN = false;
    bf16* O; const float* CS;
    __device__ __forceinline__ void operator()(const f32x4 (&acc)[2][2][4][2], const pg8::Unit& u, int wr, int wc, int fr, int fq) const {
        const int row0 = u.pm * 256 + wr * 64 + fr, col0 = u.pn * 256 + wc * 32 + 8 * fq;
        const float sc = u.pn < 4 ? C2 : 1.0f;
        const bool rotw = (wc & 1) == 0 && u.pn < 8;
        const float sgn = fq == 0 ? -1.0f : 1.0f;
#pragma unroll
        for (int ai = 0; ai < 2; ++ai)
#pragma unroll
            for (int m = 0; m < 4; ++m) { const int row = row0 + ai * 128 + m * 16;
                bf16* rowp = O + ((size_t)(((u.pn >> 2) * 4 + (row >> 13)) * 16 + (u.pn & 3) * 4 + (wc >> 1)) * QK_ROWS + qk_row(row & 8191)) * 64 + (wc & 1) * 32 + 8 * fq;
                f32x4 c0 = (f32x4){1.f, 1.f, 1.f, 1.f}, c1 = c0, s0 = (f32x4){0.f, 0.f, 0.f, 0.f}, s1 = s0;
                if (rotw && fq < 2) { const float* cp = CS + (size_t)row * 16; c0 = *(const f32x4*)(cp); c1 = *(const f32x4*)(cp + 4); s0 = *(const f32x4*)(cp + 8) * sgn; s1 = *(const f32x4*)(cp + 12) * sgn; }
#pragma unroll
                for (int bj = 0; bj < 2; ++bj) { f32x4 v0 = acc[ai][bj][m][0], v1 = acc[ai][bj][m][1];
                    if (rotw) { f32x4 p0, p1;
#pragma unroll
                        for (int e = 0; e < 4; ++e) { p0[e] = __shfl_xor(v0[e], 16); p1[e] = __shfl_xor(v1[e], 16); }
                        v0 = v0 * c0 + p0 * s0; v1 = v1 * c1 + p1 * s1; }
                    v0 = v0 * sc; v1 = v1 * sc;
                    v4u w; w.x = pg8::cvt_pk_bf16(v0[0], v0[1]); w.y = pg8::cvt_pk_bf16(v0[2], v0[3]); w.z = pg8::cvt_pk_bf16(v1[0], v1[1]); w.w = pg8::cvt_pk_bf16(v1[2], v1[3]);
                    *(v4u*)(rowp + (size_t)bj * 2 * QK_ROWS * 64) = w; } }
    }
};

__device__ __forceinline__ void p0_transpose_item(const float* W, int K, int N, bf16* WT, LAS float* scr, int item, int lane) {
    const int nblk = N / 32, kb = item / nblk, nb = item % nblk, k0 = 64 * kb, n0 = 32 * nb;
#pragma unroll 8
    for (int i = 0; i < 32; ++i) { const int kk = 2 * i + (lane >> 5); scr[kk * 33 + (lane & 31)] = W[(size_t)(k0 + kk) * N + n0 + (lane & 31)]; }
    LDS_WAIT(); asm volatile("" ::: "memory");
    const int c = lane & 7;
#pragma unroll
    for (int j = 0; j < 4; ++j) { const int n = (lane >> 3) + 8 * j; const LAS float* s = scr + (8 * c) * 33 + n;
        v4u o; o.x = pk2(s[0 * 33], s[1 * 33]); o.y = pk2(s[2 * 33], s[3 * 33]); o.z = pk2(s[4 * 33], s[5 * 33]); o.w = pk2(s[6 * 33], s[7 * 33]);
        *(GAS v4u*)(WT + (size_t)(n0 + n) * K + k0 + 8 * c) = o; }
    LDS_WAIT(); asm volatile("" ::: "memory");
}
typedef float f32x2 __attribute__((ext_vector_type(2)));
typedef float f32x16v __attribute__((ext_vector_type(16)));
typedef float f32x32v __attribute__((ext_vector_type(32)));
typedef unsigned v6u __attribute__((ext_vector_type(6)));
__device__ __forceinline__ void convert_tables(const Params& P, const Ctx& C) {
    const int gw = C.vcu * NWAVES + C.wave, NGW = C.G * NWAVES, lane = C.lane, hl = lane & 31;
    LAS float* stg = (LAS float*)(C.lds + C.wave * 16384);
    for (int rp = gw; rp < 2 * 16384; rp += NGW) {
#pragma unroll
        for (int rr = 0; rr < 2; ++rr) { const int row_ = 2 * rp + rr, tb_ = row_ >> 14, e_ = row_ & 16383;
            const f32x4* src = (const f32x4*)(((tb_ & 1) ? P.peer_up : P.peer_down) + ((size_t)(tb_ >> 1) * 16384 + e_) * 1024);
#pragma unroll
            for (int j = 0; j < 4; ++j) *(LAS f32x4*)(stg + rr * 1024 + 4 * (64 * j + lane)) = src[64 * j + lane]; }
        LDS_WAIT(); asm volatile("" ::: "memory");
        const int row = 2 * rp + (lane >> 5), tb = row >> 14, e = row & 16383;
        const LAS f32x4* sp = (const LAS f32x4*)(stg + (lane >> 5) * 1024 + 32 * hl);
        unsigned char* dst = P.ws + WS_TAB8 + (size_t)tb * TAB8_BYTES + (size_t)e * TROW;
        f32x16v a, b2; float mx = 0.f;
#pragma unroll
        for (int j = 0; j < 4; ++j) { const f32x4 v = sp[j], w = sp[4 + j];
#pragma unroll
            for (int i = 0; i < 4; ++i) { mx = fmaxf(mx, fmaxf(fabsf(v[i]), fabsf(w[i]))); }
            a[2 * j] = v[0]; b2[2 * j] = v[1]; a[2 * j + 1] = v[2]; b2[2 * j + 1] = v[3]; a[8 + 2 * j] = w[0]; b2[8 + 2 * j] = w[1]; a[8 + 2 * j + 1] = w[2]; b2[8 + 2 * j + 1] = w[3]; }
        LDS_WAIT(); asm volatile("" ::: "memory");
#pragma unroll
        for (int o = 1; o < 32; o <<= 1) mx = fmaxf(mx, __shfl_xor(mx, o));
        const float sc = mx > 0.f ? 6.0f / mx : 0.f;
        a = a * sc; b2 = b2 * sc;
        unsigned p[4] = {0u, 0u, 0u, 0u};
#define PK4(D) p[D] = __builtin_amdgcn_cvt_scalef32_pk_fp4_f32(p[D], a[4 * (D)], b2[4 * (D)], 1.0f, 0); p[D] = __builtin_amdgcn_cvt_scalef32_pk_fp4_f32(p[D], a[4 * (D) + 1], b2[4 * (D) + 1], 1.0f, 1); \
               p[D] = __builtin_amdgcn_cvt_scalef32_pk_fp4_f32(p[D], a[4 * (D) + 2], b2[4 * (D) + 2], 1.0f, 2); p[D] = __builtin_amdgcn_cvt_scalef32_pk_fp4_f32(p[D], a[4 * (D) + 3], b2[4 * (D) + 3], 1.0f, 3);
        PK4(0) PK4(1) PK4(2) PK4(3)
#undef PK4
        *(v4u*)(dst + 256 * (hl & 1) + 16 * (hl >> 1)) = (v4u){p[0], p[1], p[2], p[3]};
        if (hl == 0) ((float*)(P.ws + WS_SC8))[row] = mx * (1.0f / 6.0f);
    }
}
__device__ __forceinline__ void phase_prologue(const Params& P, const Ctx& C) {
    float* MOD = (float*)(P.ws + WS_MOD);
    {
        LAS float* cond = (LAS float*)C.lds;
        LAS float* part = (LAS float*)(C.lds + 32768);
        for (int e = C.tid; e < 8192; e += 512) cond[e] = silu_f(P.c[e]);
        __syncthreads();
        for (int item = C.vcu; item < 192; item += C.G) {
            const int l = item / 96, cb = item % 96, col = cb * 64 + C.lane;
            float acc[8];
#pragma unroll
            for (int b = 0; b < 8; ++b) acc[b] = 0.f;
            const float* wp = P.ada_w + ((size_t)l * 1024 + C.wave * 128) * 6144 + col;
#pragma unroll 4
            for (int k = 0; k < 128; ++k) { const float wv = wp[(size_t)k * 6144];
#pragma unroll
                for (int b = 0; b < 8; ++b) acc[b] += cond[b * 1024 + C.wave * 128 + k] * wv; }
#pragma unroll
            for (int b = 0; b < 8; ++b) part[(C.wave * 8 + b) * 64 + C.lane] = acc[b];
            __syncthreads();
            { const int b = C.tid >> 6, ln = C.tid & 63; float s = P.ada_b[l * 6144 + cb * 64 + ln];
#pragma unroll
              for (int w = 0; w < 8; ++w) s += part[(w * 8 + b) * 64 + ln];
              MOD[(size_t)(l * 8 + b) * 6144 + cb * 64 + ln] = s; }
            __syncthreads();
        }
        __syncthreads();
    }
    {
        LAS float* scr = (LAS float*)(C.lds + C.wave * 16384);
        const int gw = C.vcu * NWAVES + C.wave, NGW = C.G * NWAVES;
        for (int it = gw; it < 6144; it += NGW) {
            int r = it;
            if (r < 1536) { p0_transpose_item(P.even_w_in, 1024, 3072, (bf16*)(P.ws + WS_WIN), scr, r, C.lane); continue; } r -= 1536;
            if (r < 512)  { p0_transpose_item(P.even_w_out, 1024, 1024, (bf16*)(P.ws + WS_WOUT0), scr, r, C.lane); continue; } r -= 512;
            if (r < 1536) { p0_transpose_item(P.odd_w_qkv, 1024, 3072, (bf16*)(P.ws + WS_WQKV), scr, r, C.lane); continue; } r -= 1536;
            if (r < 512)  { p0_transpose_item(P.odd_w_out, 1024, 1024, (bf16*)(P.ws + WS_WOUT1), scr, r, C.lane); continue; } r -= 512;
            if (r < 1024) { p0_transpose_item(P.peer_w_query, 1024, 2048, (bf16*)(P.ws + WS_WQ0), scr, r, C.lane); continue; } r -= 1024;
            p0_transpose_item(P.peer_w_query + (size_t)1024 * 2048, 1024, 2048, (bf16*)(P.ws + WS_WQ1), scr, r, C.lane);
        }
    }
    convert_tables(P, C);
    const int NT = C.G * 512, gt = C.vcu * 512 + C.tid;
    { bf16* skb = (bf16*)(P.ws + WS_SKB); for (int i = gt; i < 65536; i += NT) skb[i] = (bf16)f2bf(P.peer_sub_keys[i]); }
    { bf16* wsb = (bf16*)(P.ws + WS_WSB); for (int i = gt; i < 65536; i += NT) { const int t = (i >> 7) & 127, s = i & 127; wsb[i] = (bf16)(s <= t ? f2bf(P.gmlp_w_s[i]) : 0u); } }
    { float* lb = (float*)(P.ws + WS_LB); for (int i = gt; i < 512; i += NT) { const float l0 = P.hgrn_lb_logits[i], l1 = P.hgrn_lb_logits[512 + i]; lb[i] = 1.0f / (1.0f + expf(l1 - l0)); } }
    { float* cs = (float*)(P.ws + WS_CS); for (int i = gt; i < T * 8; i += NT) { const int tok = i >> 3, j = i & 7;
        const float inv = 1.0f / powf(500000.0f, (float)j * 0.125f); const float ang = (float)P.positions[tok] * inv; float sn, cn; sincosf(ang, &sn, &cn);
        cs[(size_t)tok * 16 + j] = cn; cs[(size_t)tok * 16 + 8 + j] = sn; } }
}
__device__ __forceinline__ void norm_row_bf16(const float* xrow, bf16* hrow, const float* g, const float* sh, const float* sc, int lane) {
    const f32x4* xr = (const f32x4*)xrow + lane; f32x4 v[4]; float s = 0.f;
#pragma unroll
    for (int j = 0; j < 4; ++j) { v[j] = xr[64 * j]; s += (v[j][0] * v[j][0] + v[j][1] * v[j][1]) + (v[j][2] * v[j][2] + v[j][3] * v[j][3]); }
    const float rstd = 1.0f / sqrtf(wave_sum(s) * (1.0f / 1024.0f) + NORM_EPS);
    unsigned long long* o8 = (unsigned long long*)hrow + lane;
#pragma unroll
    for (int j = 0; j < 4; ++j) { const f32x4 gg = ((const f32x4*)g)[64 * j + lane], hh = ((const f32x4*)sh)[64 * j + lane], cc = ((const f32x4*)sc)[64 * j + lane];
        const f32x4 y = (v[j] * rstd * gg) * (cc + 1.0f) + hh;
        o8[64 * j] = (unsigned long long)pk2(y[0], y[1]) | ((unsigned long long)pk2(y[2], y[3]) << 32); }
}
__device__ __forceinline__ void phase_norm(const Params& P, const Ctx& C, const Wk& W, const float* xsrc, const float* g, int l, int so) {
    const float* MOD = (const float*)(P.ws + WS_MOD); bf16* H = (bf16*)(P.ws + WS_H);
    const int gw = W.lv * NWAVES + C.wave, NGW = W.n * NWAVES;
    for (int m = W_TK0(W) + gw; m < W_TK0(W) + HT; m += NGW) { const float* mb = MOD + (size_t)(l * 8 + (m >> 13)) * 6144 + so;
        norm_row_bf16(xsrc + (size_t)m * 1024, H + (size_t)m * 1024, g, mb, mb + 1024, C.lane); }
}

__device__ __forceinline__ void gmlp_item(const Params& P, const Ctx& C, const Wk& W, int n, int g) {
    LAS bf16* Wt = (LAS bf16*)C.lds;
    LAS bf16* vT = (LAS bf16*)(C.lds + 34816);
    const bf16* WSB = (const bf16*)(P.ws + WS_WSB); const bf16* PU = w_tok16(P, W, AR_PU, 512); const bf16* PV = w_tok16(P, W, AR_PV, 512); bf16* MIX = (bf16*)(P.ws + WS_H);
    const int tid = C.tid, r = C.lane & 15, q4 = C.lane >> 4;
    for (int ch = tid; ch < 2048; ch += 512) { const int rr = ch >> 4, c8 = (ch & 15) * 8; *(LAS v4u*)(Wt + rr * 136 + c8) = *(const v4u*)(WSB + (size_t)(g * 128 + rr) * 128 + c8); }
    { const int t = tid >> 2, part = tid & 3; const bf16* src = PV + (size_t)(n * 128 + t) * 512 + g * 128 + part * 32;
      float x[32];
#pragma unroll
      for (int j = 0; j < 4; ++j) { const v4u w = *(const v4u*)(src + 8 * j);
#pragma unroll
          for (int e = 0; e < 4; ++e) { x[8 * j + 2 * e] = bflo(w[e]); x[8 * j + 2 * e + 1] = bfhi(w[e]); } }
      float s = 0.f;
#pragma unroll
      for (int j = 0; j < 32; ++j) s += x[j];
      s += __shfl_xor(s, 1); s += __shfl_xor(s, 2);
      const float mean = s * (1.0f / 128.0f); float q = 0.f;
#pragma unroll
      for (int j = 0; j < 32; ++j) { const float d = x[j] - mean; q += d * d; }
      q += __shfl_xor(q, 1); q += __shfl_xor(q, 2);
      const float rstd = 1.0f / sqrtf(q * (1.0f / 128.0f) + NORM_EPS);
      const float* lg = P.gmlp_ln_g + g * 128 + part * 32; const float* lbp = P.gmlp_ln_b + g * 128 + part * 32;
#pragma unroll
      for (int j = 0; j < 32; ++j) vT[(part * 32 + j) * 136 + t] = (bf16)f2bf((x[j] - mean) * rstd * lg[j] + lbp[j]);
    }
    __syncthreads();
    const int t0 = 16 * C.wave; const int Keff = ((t0 + 16 + 31) >> 5) << 5;
    f32x4 acc[8];
#pragma unroll
    for (int ct = 0; ct < 8; ++ct) { acc[ct] = (f32x4){0.f, 0.f, 0.f, 0.f}; acc[ct] = mma16(acc[ct], Wt + t0 * 136, 136, vT + (16 * ct) * 136, 136, Keff, r, q4); }
#pragma unroll
    for (int i = 0; i < 4; ++i) { const int t = t0 + 4 * q4 + i; const float bs = P.gmlp_b_s[g * 128 + t]; const size_t tok = (size_t)n * 128 + t;
#pragma unroll
        for (int ct = 0; ct < 8; ++ct) { const int c = 16 * ct + r; const float u = bf2f(PU[tok * 512 + g * 128 + c]); MIX[tok * 1024 + g * 128 + c] = (bf16)f2bf(u * (acc[ct][i] + bs)); } }
    __syncthreads();
}
__device__ __forceinline__ void hgrn_cumsum16(const float* G, size_t tok0, int hh, int k, int seg, LAS float* tot, float (&g)[16], float (&bb)[16], float& total) {
    const float* gp = G + (tok0 + seg * 16) * 512 + hh * 128 + k;
#pragma unroll
    for (int j = 0; j < 16; ++j) g[j] = gp[(size_t)j * 512];
    float run = 0.f;
#pragma unroll
    for (int j = 0; j < 16; ++j) { run += g[j]; bb[j] = run; }
    tot[seg * 128 + k] = run;
    __syncthreads();
    const float t0 = tot[k], t1 = tot[128 + k], t2 = tot[256 + k], t3 = tot[384 + k];
    const float pre = seg == 0 ? 0.f : seg == 1 ? t0 : seg == 2 ? t0 + t1 : t0 + t1 + t2;
    total = (t0 + t1) + (t2 + t3);
#pragma unroll
    for (int j = 0; j < 16; ++j) bb[j] += pre;
}
__device__ __forceinline__ void hgrn_stage_iT(const bf16* PI, size_t tok0, int hh, LAS bf16* iT, int tid) {
    const int s = tid >> 3, v0 = (tid & 7) * 16; const bf16* src = PI + (tok0 + s) * 512 + hh * 128 + v0;
#pragma unroll
    for (int h2 = 0; h2 < 2; ++h2) { const v4u w = *(const v4u*)(src + 8 * h2);
#pragma unroll
        for (int e = 0; e < 4; ++e) { iT[(v0 + 8 * h2 + 2 * e) * 72 + s] = (bf16)(w[e] & 0xffffu); iT[(v0 + 8 * h2 + 2 * e + 1) * 72 + s] = (bf16)(w[e] >> 16); } }
}
__device__ __forceinline__ void hgrn_local_item(const Params& P, const Ctx& C, const Wk& W, int item) {
    LAS bf16* khT = (LAS bf16*)C.lds;
    LAS bf16* iT = (LAS bf16*)(C.lds + 18432);
    LAS float* tot = (LAS float*)(C.lds + 36864);
    const float* G = w_tok32(P, W, AR_G, 512); const bf16* PI = w_tok16(P, W, AR_PI, 512); bf16* KVT = w_item16(P, W, AR_KVT); float* HD = (float*)(P.ws + WS_HD);
    const int bh = item >> 7, c = item & 127, b = bh >> 2, hh = bh & 3; const size_t tok0 = (size_t)b * SEQ + c * 64;
    const int tid = C.tid, k = tid & 127, seg = tid >> 7, r = C.lane & 15, q4 = C.lane >> 4;
    float g[16], bb[16], total;
    hgrn_cumsum16(G, tok0, hh, k, seg, tot, g, bb, total);
    { unsigned w[8];
#pragma unroll
      for (int j = 0; j < 8; ++j) { const float a0 = -expm1f(g[2 * j]) * __expf(total - bb[2 * j]), a1 = -expm1f(g[2 * j + 1]) * __expf(total - bb[2 * j + 1]); w[j] = pk2(a0, a1); }
      LAS v4u* dst = (LAS v4u*)(khT + k * 72 + seg * 16); dst[0] = (v4u){w[0], w[1], w[2], w[3]}; dst[1] = (v4u){w[4], w[5], w[6], w[7]}; }
    if (seg == 0) HD[(size_t)item * 128 + k] = __expf(total);
    hgrn_stage_iT(PI, tok0, hh, iT, tid);
    __syncthreads();
    const int v0 = 16 * C.wave;
#pragma unroll
    for (int ct = 0; ct < 8; ++ct) { f32x4 acc = (f32x4){0.f, 0.f, 0.f, 0.f}; acc = mma16(acc, iT + v0 * 72, 72, khT + (16 * ct) * 72, 72, 64, r, q4);
#pragma unroll
        for (int i = 0; i < 4; ++i) KVT[((size_t)item * 128 + v0 + 4 * q4 + i) * 128 + 16 * ct + r] = (bf16)f2bf(acc[i]); }
    __syncthreads();
}
__device__ __forceinline__ void phase_hgrn_scan(const Params& P, const Ctx& C, const Wk& W) {
    const bf16* KVT = w_item16(P, W, AR_KVT); bf16* ST = w_item16(P, W, AR_ST); const float* HD = (const float*)(P.ws + WS_HD);
    for (int task = W.lv * 256 + C.tid; C.tid < 256 && task < 32768; task += W.n * 256) {
        const int bh = W_BT0(W) * 4 + (task >> 11), v = (task >> 4) & 127, kb = task & 15;
        float st[8];
#pragma unroll
        for (int e = 0; e < 8; ++e) st[e] = 0.f;
#pragma unroll 4
        for (int c = 0; c < 128; ++c) { const size_t item = (size_t)bh * 128 + c, off = (item * 128 + v) * 128 + kb * 8;
            const v4u kv = *(const v4u*)(KVT + off); const f32x4 d0 = *(const f32x4*)(HD + item * 128 + kb * 8), d1 = *(const f32x4*)(HD + item * 128 + kb * 8 + 4);
            v4u o; o.x = pk2(st[0], st[1]); o.y = pk2(st[2], st[3]); o.z = pk2(st[4], st[5]); o.w = pk2(st[6], st[7]);
            *(v4u*)(ST + off) = o;
#pragma unroll
            for (int e = 0; e < 4; ++e) { st[2 * e] = (e < 2 ? d0[2 * e] : d1[2 * e - 4]) * st[2 * e] + bflo(kv[e]); st[2 * e + 1] = (e < 2 ? d0[2 * e + 1] : d1[2 * e - 3]) * st[2 * e + 1] + bfhi(kv[e]); }
        }
    }
}
__device__ __forceinline__ void hgrn_out_item(const Params& P, const Ctx& C, const Wk& W, int item) {
    LAS bf16* qt = (LAS bf16*)C.lds;
    LAS bf16* kt = (LAS bf16*)(C.lds + 17408);
    LAS bf16* iT = (LAS bf16*)(C.lds + 34816);
    LAS bf16* A1 = (LAS bf16*)(C.lds + 53248);
    LAS bf16* STl = (LAS bf16*)(C.lds + 62464);
    LAS float* ol = (LAS float*)(C.lds + 97280);
    LAS float* tot = (LAS float*)(C.lds + 131072);
    const float* G = w_tok32(P, W, AR_G, 512); const bf16* PQ = w_tok16(P, W, AR_PQ, 512); const bf16* PI = w_tok16(P, W, AR_PI, 512); const bf16* PG = w_tok16(P, W, AR_PG, 512);
    const bf16* ST = w_item16(P, W, AR_ST); bf16* MIX = (bf16*)(P.ws + WS_H);
    const int bh = item >> 7, c = item & 127, b = bh >> 2, hh = bh & 3; const size_t tok0 = (size_t)b * SEQ + c * 64;
    const int tid = C.tid, k = tid & 127, seg = tid >> 7, r = C.lane & 15, q4 = C.lane >> 4;
    float g[16], bb[16], total;
    hgrn_cumsum16(G, tok0, hh, k, seg, tot, g, bb, total);
#pragma unroll
    for (int j = 0; j < 16; ++j) { const int t = seg * 16 + j; const float qv = bf2f(PQ[(tok0 + t) * 512 + hh * 128 + k]);
        qt[t * 136 + k] = (bf16)f2bf(qv * __expf(bb[j])); kt[t * 136 + k] = (bf16)f2bf(-expm1f(g[j]) * __expf(-bb[j])); }
    hgrn_stage_iT(PI, tok0, hh, iT, tid);
    for (int ch = tid; ch < 2048; ch += 512) { const int rr = ch >> 4, c8 = (ch & 15) * 8; *(LAS v4u*)(STl + rr * 136 + c8) = *(const v4u*)(ST + ((size_t)item * 128 + rr) * 128 + c8); }
    __syncthreads();
    { const int rt = C.wave >> 1;
#pragma unroll
      for (int cc = 0; cc < 2; ++cc) { const int ct = (C.wave & 1) * 2 + cc; f32x4 acc = (f32x4){0.f, 0.f, 0.f, 0.f};
          acc = mma16(acc, qt + (16 * rt) * 136, 136, kt + (16 * ct) * 136, 136, 128, r, q4);
#pragma unroll
          for (int i = 0; i < 4; ++i) { const int t = 16 * rt + 4 * q4 + i, s = 16 * ct + r; A1[t * 72 + s] = (bf16)(s <= t ? f2bf(acc[i]) : 0u); } } }
    __syncthreads();
    { const int rt = C.wave >> 1;
#pragma unroll
      for (int cc = 0; cc < 4; ++cc) { const int ct = (C.wave & 1) * 4 + cc; f32x4 acc = (f32x4){0.f, 0.f, 0.f, 0.f};
          acc = mma16(acc, A1 + (16 * rt) * 72, 72, iT + (16 * ct) * 72, 72, 64, r, q4);
          acc = mma16(acc, qt + (16 * rt) * 136, 136, STl + (16 * ct) * 136, 136, 128, r, q4);
#pragma unroll
          for (int i = 0; i < 4; ++i) ol[(16 * rt + 4 * q4 + i) * 132 + 16 * ct + r] = acc[i]; } }
    __syncthreads();
    { const int t = tid >> 3, v0 = (tid & 7) * 16; float o[16]; float ss = 0.f;
#pragma unroll
      for (int e = 0; e < 16; ++e) { o[e] = ol[t * 132 + v0 + e]; ss += o[e] * o[e]; }
      ss += __shfl_xor(ss, 1); ss += __shfl_xor(ss, 2); ss += __shfl_xor(ss, 4);
      const float rstd = 1.0f / sqrtf(ss * (1.0f / 128.0f) + NORM_EPS);
      const float* ng = P.hgrn_norm_g + hh * 128 + v0; const bf16* gp = PG + (tok0 + t) * 512 + hh * 128 + v0;
      const v4u g0 = *(const v4u*)gp, g1 = *(const v4u*)(gp + 8); unsigned w[8];
#pragma unroll
      for (int e = 0; e < 4; ++e) { w[e] = pk2(o[2 * e] * rstd * ng[2 * e] * bflo(g0[e]), o[2 * e + 1] * rstd * ng[2 * e + 1] * bfhi(g0[e]));
                                    w[4 + e] = pk2(o[8 + 2 * e] * rstd * ng[8 + 2 * e] * bflo(g1[e]), o[9 + 2 * e] * rstd * ng[9 + 2 * e] * bfhi(g1[e])); }
      v4u* dst = (v4u*)(MIX + (tok0 + t) * 1024 + 512 + hh * 128 + v0); dst[0] = (v4u){w[0], w[1], w[2], w[3]}; dst[1] = (v4u){w[4], w[5], w[6], w[7]}; }
    __syncthreads();
}

typedef short v4i16_t __attribute__((ext_vector_type(4)));
constexpr int AT_VP = 144;
constexpr int AT_QI = 512;
constexpr int AT_STO = 0, AT_STML = AT_QI * 128, AT_VW = AT_STML + AT_QI * 8;
__device__ __forceinline__ void attn_softmax_block(f32x4 (&sa)[9], int tile0, int qq, int mq0, int q4, float& mx, float& ls, bf16x8 (&pf)[5]) {
    const int lo4 = (qq > 128 - mq0 ? qq : 128 - mq0) - 4 * q4, hi4 = qq + 128 - 4 * q4;
    mx = -1e30f;
#pragma unroll
    for (int t = 0; t < 9; ++t)
#pragma unroll
        for (int i = 0; i < 4; ++i) { const int K0 = 16 * (tile0 + t) + i; const bool ok = K0 >= lo4 && K0 <= hi4;
            sa[t][i] = ok ? sa[t][i] : -1e30f; mx = fmaxf(mx, sa[t][i]); }
    mx = fmaxf(mx, __shfl_xor(mx, 16)); mx = fmaxf(mx, __shfl_xor(mx, 32));
    ls = 0.f;
#pragma unroll
    for (int t = 0; t < 9; ++t)
#pragma unroll
        for (int i = 0; i < 4; ++i) { const float pv = __builtin_amdgcn_exp2f(sa[t][i] - mx); sa[t][i] = pv; ls += pv; }
    ls += __shfl_xor(ls, 16); ls += __shfl_xor(ls, 32);
#pragma unroll
    for (int s2 = 0; s2 < 5; ++s2) { const int tl = 2 * s2 - tile0, th = 2 * s2 + 1 - tile0;
        const f32x4 lo = (tl >= 0 && tl < 9) ? sa[(tl >= 0 && tl < 9) ? tl : 0] : (f32x4){0.f, 0.f, 0.f, 0.f}, hi = (th >= 0 && th < 9) ? sa[(th >= 0 && th < 9) ? th : 0] : (f32x4){0.f, 0.f, 0.f, 0.f};
        v4u w; w.x = pk2(lo[0], lo[1]); w.y = pk2(lo[2], lo[3]); w.z = pk2(hi[0], hi[1]); w.w = pk2(hi[2], hi[3]); pf[s2] = __builtin_bit_cast(bf16x8, w); }
}
__device__ __forceinline__ void attn_merge(int g, LAS unsigned char* lds, int qloc, int q4, f32x4 (&oa)[4], float mx, float ls, bf16* orow) {
    LAS unsigned char* so = lds + AT_STO + qloc * 128 + 8 * q4; LAS float* sml = (LAS float*)(lds + AT_STML) + 2 * qloc;
    float mo = mx, lo2 = ls;
    if (g > 0) { const float m_old = sml[0], l_old = sml[1]; const float M = fmaxf(m_old, mx); const float fo = __builtin_amdgcn_exp2f(m_old - M), fn = __builtin_amdgcn_exp2f(mx - M);
#pragma unroll
        for (int dt = 0; dt < 4; ++dt) { const unsigned long long w = *(const LAS unsigned long long*)(so + 32 * dt); const unsigned w0 = (unsigned)w, w1 = (unsigned)(w >> 32);
            oa[dt] = oa[dt] * fn + (f32x4){bflo(w0), bfhi(w0), bflo(w1), bfhi(w1)} * fo; }
        mo = M; lo2 = ls * fn + l_old * fo; }
    if (g < 2) {
#pragma unroll
        for (int dt = 0; dt < 4; ++dt) *(LAS unsigned long long*)(so + 32 * dt) = (unsigned long long)pk2(oa[dt][0], oa[dt][1]) | ((unsigned long long)pk2(oa[dt][2], oa[dt][3]) << 32);
        if (q4 == 0) { sml[0] = mo; sml[1] = lo2; }
    } else { const float inv = 1.0f / lo2;
#pragma unroll
        for (int dt = 0; dt < 4; ++dt) { const f32x4 v = oa[dt] * inv; *(unsigned long long*)(orow + 16 * dt) = (unsigned long long)pk2(v[0], v[1]) | ((unsigned long long)pk2(v[2], v[3]) << 32); } }
}
__device__ __forceinline__ void attn_item(const Params& P, const Ctx& C, const Wk& W, int b, int hd, int qt) {
    LAS unsigned char* Vw = C.lds + AT_VW + C.wave * (64 * AT_VP);
    const bf16* QKV = (const bf16*)(w_ar(P, W) + AR_QK); bf16* O = (bf16*)(P.ws + WS_H); const int bl = b - W_BT0(W);
    const int lane = C.lane, r = lane & 15, q4 = lane >> 4;
    const int t0 = qt * AT_QI; const size_t rowbase = (size_t)b * SEQ;
    const bf16* Qh = QKV + (size_t)((0 * 4 + bl) * 16 + hd) * QK_ROWS * 64; const bf16* Kb = QKV + (size_t)((1 * 4 + bl) * 16 + hd) * QK_ROWS * 64; const bf16* Vb = QKV + (size_t)((2 * 4 + bl) * 16 + hd) * QK_ROWS * 64;
#pragma unroll 1
    for (int g = 0; g < 3; ++g) {
        const int dsh = 4 - 2 * g, d = 1 << dsh;
#pragma unroll 1
        for (int uu = 0; uu < 2; ++uu) {
            const int u = C.wave + 8 * uu;
            const int c = u & (d - 1), j = u >> dsh;
            const int mq0 = (t0 >> dsh) + 32 * j;
            const int ql0 = c + d * (32 * j + r), ql1 = ql0 + 16 * d;
            const bf16* qp0 = Qh + (size_t)qk_row(t0 + ql0) * 64 + 8 * q4; const bf16* qp1 = Qh + (size_t)qk_row(t0 + ql1) * 64 + 8 * q4;
            const bf16x8 bq00 = *(const bf16x8*)qp0, bq01 = *(const bf16x8*)(qp0 + 32), bq10 = *(const bf16x8*)qp1, bq11 = *(const bf16x8*)(qp1 + 32);
            bf16x8 ka[10][2];
#pragma unroll
            for (int t = 0; t < 10; ++t) { int mk = mq0 - 128 + 16 * t + r; mk = mk < 0 ? 0 : mk;
                const unsigned ko = (unsigned)qk_row(c + (mk << dsh)) * 128u + 16u * q4; ka[t][0] = *(const bf16x8*)((const char*)Kb + ko); ka[t][1] = *(const bf16x8*)((const char*)Kb + ko + 64); }
            v4u vr[2][8];
#pragma unroll
            for (int it = 0; it < 8; ++it) { const int kap = 8 * it + (lane >> 3); int mk = mq0 - 128 + kap; mk = mk < 0 ? 0 : mk;
                vr[0][it] = *(const v4u*)((const char*)Vb + (unsigned)qk_row(c + (mk << dsh)) * 128u + (lane & 7) * 16u); }
            __builtin_amdgcn_sched_barrier(0);
            bf16x8 pf0[5], pf1[5]; float mx0, ls0, mx1, ls1;
            { f32x4 sa[9];
#pragma unroll
              for (int t = 0; t < 9; ++t) { sa[t] = (f32x4){0.f, 0.f, 0.f, 0.f}; sa[t] = __builtin_amdgcn_mfma_f32_16x16x32_bf16(ka[t][0], bq00, sa[t], 0, 0, 0); sa[t] = __builtin_amdgcn_mfma_f32_16x16x32_bf16(ka[t][1], bq01, sa[t], 0, 0, 0); }
              attn_softmax_block(sa, 0, r, mq0, q4, mx0, ls0, pf0); }
            { f32x4 sa[9];
#pragma unroll
              for (int t = 0; t < 9; ++t) { sa[t] = (f32x4){0.f, 0.f, 0.f, 0.f}; sa[t] = __builtin_amdgcn_mfma_f32_16x16x32_bf16(ka[t + 1][0], bq10, sa[t], 0, 0, 0); sa[t] = __builtin_amdgcn_mfma_f32_16x16x32_bf16(ka[t + 1][1], bq11, sa[t], 0, 0, 0); }
              __builtin_amdgcn_sched_barrier(0);
#pragma unroll
              for (int it = 0; it < 8; ++it) { const int kap = 64 + 8 * it + (lane >> 3); int mk = mq0 - 128 + kap; mk = mk < 0 ? 0 : mk;
                  vr[1][it] = *(const v4u*)((const char*)Vb + (unsigned)qk_row(c + (mk << dsh)) * 128u + (lane & 7) * 16u); }
              __builtin_amdgcn_sched_barrier(0);
              attn_softmax_block(sa, 1, 16 + r, mq0, q4, mx1, ls1, pf1); }
            v4u vr2[4];
#pragma unroll
            for (int it = 0; it < 4; ++it) { const int kap = 128 + 8 * it + (lane >> 3); const int mk = mq0 - 128 + kap;
                vr2[it] = *(const v4u*)((const char*)Vb + (unsigned)qk_row(c + (mk << dsh)) * 128u + (lane & 7) * 16u); }
            f32x4 oa0[4], oa1[4];
#pragma unroll
            for (int dt = 0; dt < 4; ++dt) { oa0[dt] = (f32x4){0.f, 0.f, 0.f, 0.f}; oa1[dt] = (f32x4){0.f, 0.f, 0.f, 0.f}; }
#pragma unroll
            for (int ch = 0; ch < 3; ++ch) {
#pragma unroll
                for (int it = 0; it < 8; ++it) { const int row = 8 * it + (lane >> 3);
                    if (ch < 2) *(LAS v4u*)(Vw + row * AT_VP + (lane & 7) * 16) = vr[ch < 2 ? ch : 0][it];
                    else if (it < 4) *(LAS v4u*)(Vw + row * AT_VP + (lane & 7) * 16) = vr2[it < 4 ? it : 0]; }
                asm volatile("s_waitcnt lgkmcnt(0)" ::: "memory");
#pragma unroll
                for (int s2 = 0; s2 < 2; ++s2) { const int sx = 2 * ch + s2; if (sx < 5) {
#pragma unroll
                    for (int dt = 0; dt < 4; ++dt) {
                        const LAS unsigned char* vp = Vw + (32 * s2 + 4 * q4 + (r >> 2)) * AT_VP + dt * 32 + (r & 3) * 8;
                        const v4i16_t x = __builtin_amdgcn_ds_read_tr16_b64_v4i16((LAS v4i16_t*)vp), y = __builtin_amdgcn_ds_read_tr16_b64_v4i16((LAS v4i16_t*)(vp + 16 * AT_VP));
                        const bf16x8 av = (bf16x8){x[0], x[1], x[2], x[3], y[0], y[1], y[2], y[3]};
                        oa0[dt] = __builtin_amdgcn_mfma_f32_16x16x32_bf16(av, pf0[sx], oa0[dt], 0, 0, 0);
                        oa1[dt] = __builtin_amdgcn_mfma_f32_16x16x32_bf16(av, pf1[sx], oa1[dt], 0, 0, 0); } } }
                asm volatile("s_waitcnt lgkmcnt(0)" ::: "memory");
            }
            attn_merge(g, C.lds, ql0, q4, oa0, mx0, ls0, O + (rowbase + t0 + ql0) * 1024 + hd * 64 + 4 * q4);
            attn_merge(g, C.lds, ql1, q4, oa1, mx1, ls1, O + (rowbase + t0 + ql1) * 1024 + hd * 64 + 4 * q4);
        }
        __syncthreads();
    }
}

__device__ __forceinline__ unsigned ordf(float s) { const unsigned u = __builtin_bit_cast(unsigned, s); return u ^ ((unsigned)((int)u >> 31) | 0x80000000u); }
__device__ __forceinline__ float unordf(unsigned v) { return __builtin_bit_cast(float, v ^ ((unsigned)((int)(~v) >> 31) | 0x80000000u)); }
__device__ __forceinline__ void ins16(unsigned (&top)[16], unsigned x) {
#pragma unroll
    for (int j = 0; j < 16; ++j) { const unsigned hi = top[j] > x ? top[j] : x; x = top[j] > x ? x : top[j]; top[j] = hi; }
}
#define CE_D(a, b) { const unsigned hi_ = (a) > (b) ? (a) : (b), lo_ = (a) > (b) ? (b) : (a); (a) = hi_; (b) = lo_; }
__device__ __forceinline__ void sort16_desc(unsigned (&v)[16]) {
#pragma unroll
    for (int k = 2; k <= 16; k <<= 1)
#pragma unroll
        for (int j = k >> 1; j > 0; j >>= 1)
#pragma unroll
            for (int i = 0; i < 16; ++i) { const int l = i ^ j; if (l > i) { if ((i & k) == 0) CE_D(v[i], v[l]) else CE_D(v[l], v[i]) } }
}
__device__ __forceinline__ void bitonic_merge16_desc(unsigned (&c)[16]) {
#pragma unroll
    for (int st = 8; st >= 1; st >>= 1)
#pragma unroll
        for (int j = 0; j < 16; ++j) if ((j & st) == 0) CE_D(c[j], c[j + st])
}
__device__ __forceinline__ void top16_of_two(unsigned (&a)[16], const unsigned (&b)[16]) {
#pragma unroll
    for (int j = 0; j < 16; ++j) a[j] = a[j] > b[15 - j] ? a[j] : b[15 - j];
    bitonic_merge16_desc(a);
}
__device__ __forceinline__ void merge16(unsigned (&top)[16], int mask) {
    unsigned o[16];
#pragma unroll
    for (int j = 0; j < 16; ++j) o[j] = (unsigned)__shfl_xor((int)top[j], mask);
    top16_of_two(top, o);
}
__device__ __forceinline__ void phase_peer_topk(const Params& P, const Ctx& C, const Wk& W, int layer) {
    LAS bf16* SK = (LAS bf16*)C.lds;
    const bf16* SKB = (const bf16*)(P.ws + WS_SKB) + (size_t)layer * 32768; const bf16* QP = w_tok16(P, W, AR_QP, 2048);
    int* IDX = (int*)(P.ws + WS_IDX); float* GATE = (float*)(P.ws + WS_GATE);
    for (int ch = C.tid; ch < 4096; ch += 512) { const int rr = ch >> 4, c8 = (ch & 15) * 8; *(LAS v4u*)(SK + rr * 136 + c8) = *(const v4u*)(SKB + (size_t)rr * 128 + c8); }
    __syncthreads();
    const int r = C.lane & 15, q4 = C.lane >> 4;
    const int gw = W.lv * NWAVES + C.wave, NGW = W.n * NWAVES;
    for (int grp = W_TK0(W) / 2 + gw; grp < W_TK0(W) / 2 + HT * 8 / 16; grp += NGW) {
        const size_t task = (size_t)grp * 16 + r;
        unsigned lst[2][16];
#pragma unroll
        for (int half = 0; half < 2; ++half) {
            bf16x8 bq[4];
#pragma unroll
            for (int ks = 0; ks < 4; ++ks) bq[ks] = *(const bf16x8*)(QP + task * 256 + half * 128 + ks * 32 + 8 * q4);
            unsigned ka[16], kb[16];
#pragma unroll
            for (int nt = 0; nt < 8; ++nt) { f32x4 acc = (f32x4){0.f, 0.f, 0.f, 0.f};
#pragma unroll
                for (int ks = 0; ks < 4; ++ks) { const bf16x8 a = *(const LAS bf16x8*)(SK + (half * 128 + 16 * nt + r) * 136 + ks * 32 + 8 * q4); acc = __builtin_amdgcn_mfma_f32_16x16x32_bf16(a, bq[ks], acc, 0, 0, 0); }
#pragma unroll
                for (int i = 0; i < 4; ++i) { const unsigned n = 16 * nt + 4 * q4 + i; const unsigned key = (ordf(acc[i]) & ~127u) | (127u - n); if (nt < 4) ka[4 * nt + i] = key; else kb[4 * (nt - 4) + i] = key; }
                if (nt == 3) sort16_desc(ka);
                __builtin_amdgcn_sched_barrier(0); }
            sort16_desc(kb); top16_of_two(ka, kb);
            merge16(ka, 16); merge16(ka, 32);
#pragma unroll
            for (int j = 0; j < 16; ++j) lst[half][j] = ka[j];
        }
        float v2[16]; unsigned e2[16];
#pragma unroll
        for (int j = 0; j < 16; ++j) { v2[j] = unordf(lst[1][j] & ~127u); e2[j] = 127u - (lst[1][j] & 127u); }
        float v1s[4]; unsigned e1s[4];
#pragma unroll
        for (int k = 0; k < 4; ++k) { const unsigned w = q4 == 0 ? lst[0][4 * k] : q4 == 1 ? lst[0][4 * k + 1] : q4 == 2 ? lst[0][4 * k + 2] : lst[0][4 * k + 3];
            v1s[k] = unordf(w & ~127u); e1s[k] = (127u - (w & 127u)) << 7; }
        unsigned top[16];
#pragma unroll
        for (int j = 0; j < 16; ++j) top[j] = (ordf(v1s[0] + v2[j]) & ~16383u) | e1s[0] | e2[j];
        sort16_desc(top);
#pragma unroll
        for (int j = 0; j < 3; ++j) ins16(top, (ordf(v1s[1] + v2[j]) & ~16383u) | e1s[1] | e2[j]);
        ins16(top, (ordf(v1s[2] + v2[0]) & ~16383u) | e1s[2] | e2[0]);
        ins16(top, (ordf(v1s[3] + v2[0]) & ~16383u) | e1s[3] | e2[0]);
        merge16(top, 16); merge16(top, 32);
        float ev[16]; float den = 0.f; const float mx = unordf(top[0] & ~16383u);
#pragma unroll
        for (int j = 0; j < 16; ++j) { ev[j] = __expf(unordf(top[j] & ~16383u) - mx); den += ev[j]; }
        const float inv = 1.0f / den;
        int* ip = IDX + task * 16; float* gp = GATE + task * 16;
        if (q4 == 0) { *(v4u*)(ip) = (v4u){top[0] & 16383u, top[1] & 16383u, top[2] & 16383u, top[3] & 16383u}; *(f32x4*)(gp) = (f32x4){ev[0] * inv, ev[1] * inv, ev[2] * inv, ev[3] * inv}; }
        else if (q4 == 1) { *(v4u*)(ip + 4) = (v4u){top[4] & 16383u, top[5] & 16383u, top[6] & 16383u, top[7] & 16383u}; *(f32x4*)(gp + 4) = (f32x4){ev[4] * inv, ev[5] * inv, ev[6] * inv, ev[7] * inv}; }
        else if (q4 == 2) { *(v4u*)(ip + 8) = (v4u){top[8] & 16383u, top[9] & 16383u, top[10] & 16383u, top[11] & 16383u}; *(f32x4*)(gp + 8) = (f32x4){ev[8] * inv, ev[9] * inv, ev[10] * inv, ev[11] * inv}; }
        else { *(v4u*)(ip + 12) = (v4u){top[12] & 16383u, top[13] & 16383u, top[14] & 16383u, top[15] & 16383u}; *(f32x4*)(gp + 12) = (f32x4){ev[12] * inv, ev[13] * inv, ev[14] * inv, ev[15] * inv}; }
    }
}
#ifndef EXP_LA
#define EXP_LA 7
#endif
struct ExpRow { v4u lo, hi; };
__device__ __forceinline__ void exp_issue(ExpRow& R, const unsigned char* T, int ex, int jl) {
    const unsigned oA = (unsigned)ex * (unsigned)TROW + 16u * (unsigned)jl;
    R.lo = *(const v4u*)(T + oA); R.hi = *(const v4u*)(T + oA + 256);
}
#define FP4PAIR(W, K) __builtin_amdgcn_cvt_scalef32_pk_f32_fp4((W), 1.0f, (K))
__device__ __forceinline__ float exp_down(const ExpRow& R, const f32x2 (&hq)[32]) {
    f32x2 a2 = (f32x2){0.f, 0.f}, b2 = (f32x2){0.f, 0.f};
#pragma unroll
    for (int j = 0; j < 4; ++j) { const unsigned w = R.lo[j];
        a2 = a2 + FP4PAIR(w, 0) * hq[4 * j]; b2 = b2 + FP4PAIR(w, 1) * hq[4 * j + 1]; a2 = a2 + FP4PAIR(w, 2) * hq[4 * j + 2]; b2 = b2 + FP4PAIR(w, 3) * hq[4 * j + 3]; }
#pragma unroll
    for (int j = 0; j < 4; ++j) { const unsigned w = R.hi[j];
        a2 = a2 + FP4PAIR(w, 0) * hq[16 + 4 * j]; b2 = b2 + FP4PAIR(w, 1) * hq[16 + 4 * j + 1]; a2 = a2 + FP4PAIR(w, 2) * hq[16 + 4 * j + 2]; b2 = b2 + FP4PAIR(w, 3) * hq[16 + 4 * j + 3]; }
    a2 = a2 + b2;
    float a = a2.x + a2.y; asm volatile("" : "+v"(a));
    return a;
}
__device__ __forceinline__ void exp_up(const ExpRow& R, float wk, f32x2 (&oacc)[32]) {
    const f32x2 wk2 = (f32x2){wk, wk};
#pragma unroll
    for (int j = 0; j < 4; ++j) { const unsigned w = R.lo[j];
        oacc[4 * j] = oacc[4 * j] + wk2 * FP4PAIR(w, 0); oacc[4 * j + 1] = oacc[4 * j + 1] + wk2 * FP4PAIR(w, 1); oacc[4 * j + 2] = oacc[4 * j + 2] + wk2 * FP4PAIR(w, 2); oacc[4 * j + 3] = oacc[4 * j + 3] + wk2 * FP4PAIR(w, 3); }
#pragma unroll
    for (int j = 0; j < 4; ++j) { const unsigned w = R.hi[j];
        oacc[16 + 4 * j] = oacc[16 + 4 * j] + wk2 * FP4PAIR(w, 0); oacc[16 + 4 * j + 1] = oacc[16 + 4 * j + 1] + wk2 * FP4PAIR(w, 1); oacc[16 + 4 * j + 2] = oacc[16 + 4 * j + 2] + wk2 * FP4PAIR(w, 2); oacc[16 + 4 * j + 3] = oacc[16 + 4 * j + 3] + wk2 * FP4PAIR(w, 3); }
    asm volatile("" : "+v"(oacc[0]), "+v"(oacc[1]), "+v"(oacc[2]), "+v"(oacc[3]), "+v"(oacc[4]), "+v"(oacc[5]), "+v"(oacc[6]), "+v"(oacc[7]),
                      "+v"(oacc[8]), "+v"(oacc[9]), "+v"(oacc[10]), "+v"(oacc[11]), "+v"(oacc[12]), "+v"(oacc[13]), "+v"(oacc[14]), "+v"(oacc[15]));
    asm volatile("" : "+v"(oacc[16]), "+v"(oacc[17]), "+v"(oacc[18]), "+v"(oacc[19]), "+v"(oacc[20]), "+v"(oacc[21]), "+v"(oacc[22]), "+v"(oacc[23]),
                      "+v"(oacc[24]), "+v"(oacc[25]), "+v"(oacc[26]), "+v"(oacc[27]), "+v"(oacc[28]), "+v"(oacc[29]), "+v"(oacc[30]), "+v"(oacc[31]));
}
__device__ __forceinline__ float exp_rs(float a, float b, int mask, bool hi) { const float keep = hi ? b : a, send = hi ? a : b; return keep + __shfl_xor(send, mask); }
__device__ __forceinline__ void phase_peer_experts(const Params& P, const Ctx& Cin, const Wk& W, int layer, bool last) {
    const Ctx C = fresh_ctx(Cin);
    const unsigned char* TD = P.ws + WS_TAB8 + (size_t)(2 * layer) * TAB8_BYTES; const unsigned char* TU = P.ws + WS_TAB8 + (size_t)(2 * layer + 1) * TAB8_BYTES; const float* SD = (const float*)(P.ws + WS_SC8) + (size_t)(2 * layer) * 16384; bf16* H = (bf16*)(P.ws + WS_H);
    const int* IDX = (const int*)(P.ws + WS_IDX); const float* GATE = (const float*)(P.ws + WS_GATE); const float* MOD = (const float*)(P.ws + WS_MOD);
    const int lane = C.lane, grp = lane >> 4, jl = lane & 15;
    unsigned* ticket = (unsigned*)(P.ws + WS_CTL) + 96 + 2 * layer + W.h;
    const bool dyn = W.n != C.G;
    const int gws = W.lv * NWAVES + C.wave, NGWS = W.n * NWAVES;
    int tnext = gws; if (dyn) { if (lane == 0) tnext = (int)atomicAdd(ticket, 1u); tnext = __builtin_amdgcn_readfirstlane(tnext); }
    if (tnext >= HT) return;
#define SB __builtin_amdgcn_sched_barrier(0);
#define EXP_SRC(GS) (((GS) & 16) ? i1 : i0)
#define EXP_ISSUE(R, GS) { const int gs_ = (GS); const int src_ = EXP_SRC(gs_); exp_issue(R, (gs_ & 32) ? TU : TD, __shfl(src_, (grp << 4) | (gs_ & 15)), jl); }
    int tok = W_TK0(W) + tnext;
    if (dyn) { int tn = 0; if (lane == 0) tn = (int)atomicAdd(ticket, 1u); tnext = tn; } else tnext += NGWS;
    int i0 = IDX[(size_t)tok * 128 + lane], i1 = IDX[(size_t)tok * 128 + 64 + lane];
    float g0 = GATE[(size_t)tok * 128 + lane], g1 = GATE[(size_t)tok * 128 + 64 + lane];
    v4u hn[8];
#pragma unroll
    for (int c = 0; c < 8; ++c) hn[c] = *(const v4u*)(H + (size_t)tok * 1024 + 64 * jl + 8 * c);
    ExpRow R0, R1, R2, R3, R4, R5, R6, R7;
    EXP_ISSUE(R0, 0) EXP_ISSUE(R1, 1) EXP_ISSUE(R2, 2) EXP_ISSUE(R3, 3) EXP_ISSUE(R4, 4) EXP_ISSUE(R5, 5) EXP_ISSUE(R6, 6) SB
    bool more = true;
    while (more) {
        const int b = tok >> 13;
        f32x2 hq[32];
#pragma unroll
        for (int c = 0; c < 8; ++c) {
#pragma unroll
            for (int e = 0; e < 4; ++e) hq[c * 4 + e] = (f32x2){bflo(hn[c][e]), bfhi(hn[c][e])}; }
        const float sd0 = SD[(unsigned)i0], sd1 = SD[(unsigned)i1], su0 = SD[16384u + (unsigned)i0], su1 = SD[16384u + (unsigned)i1];
        float U0 = 0.f, U1 = 0.f, tprev = 0.f;
        const bool j1 = (jl & 1) != 0, j2 = (jl & 2) != 0, j4 = (jl & 4) != 0, j8 = (jl & 8) != 0;
#define EXP_EX(GS) __shfl(EXP_SRC(GS), (grp << 4) | ((GS) & 15))
#define EXP_TAB(GS) (((GS) & 32) ? TU : TD)
#define STEP1(S, RC, RI, PV) { const int ex_ = EXP_EX(g8 + (S) + 7); SB PV = exp_down(RC, hq); SB exp_issue(RI, EXP_TAB(g8 + (S) + 7), ex_, jl); SB }
#pragma unroll 1
        for (int it = 0; it < 4; ++it) {
            const int g8 = 8 * it;
            float p0, p1, p2, p3, p4, p5, p6, p7;
            STEP1(0, R0, R7, p0) STEP1(1, R1, R0, p1)
            const float q0 = exp_rs(p0, p1, 1, j1);
            STEP1(2, R2, R1, p2) STEP1(3, R3, R2, p3)
            const float q1 = exp_rs(p2, p3, 1, j1); const float r0 = exp_rs(q0, q1, 2, j2);
            STEP1(4, R4, R3, p4) STEP1(5, R5, R4, p5)
            const float q2 = exp_rs(p4, p5, 1, j1);
            STEP1(6, R6, R5, p6) STEP1(7, R7, R6, p7)
            const float q3 = exp_rs(p6, p7, 1, j1); const float r1 = exp_rs(q2, q3, 2, j2); const float t = exp_rs(r0, r1, 4, j4);
            if (it & 1) { const float u = exp_rs(tprev, t, 8, j8); if (it == 1) U0 = u; else U1 = u; } else tprev = t;
        }
#undef STEP1
        const float wk0 = g0 * gelu_f(U0 * sd0) * su0, wk1 = g1 * gelu_f(U1 * sd1) * su1;
        if (dyn) tnext = __builtin_amdgcn_readfirstlane(tnext);
        more = tnext < HT;
        const int tokn = more ? W_TK0(W) + tnext : tok;
        if (dyn) { int tn = 0; if (more && lane == 0) tn = (int)atomicAdd(ticket, 1u); tnext = tn; } else tnext += NGWS;
        const int i0n = IDX[(size_t)tokn * 128 + lane], i1n = IDX[(size_t)tokn * 128 + 64 + lane];
        const float g0n = GATE[(size_t)tokn * 128 + lane], g1n = GATE[(size_t)tokn * 128 + 64 + lane];
        f32x2 oacc[32];
#pragma unroll
        for (int e = 0; e < 32; ++e) oacc[e] = (f32x2){0.f, 0.f};
#define EXP_WK(GS) __shfl(((GS) & 16) ? wk1 : wk0, (grp << 4) | ((GS) & 15))
#define EXP_EX2(GS) __shfl((GS) >= 64 ? i0n : EXP_SRC(GS), (grp << 4) | ((GS) & 15))
#define STEP2(S, RC, RI) { const int ex_ = EXP_EX2(g8 + (S) + 7); const float wn_ = EXP_WK(g8 + (S) + 1); SB exp_up(RC, wkc, oacc); SB exp_issue(RI, EXP_TAB(g8 + (S) + 7), ex_, jl); wkc = wn_; SB }
        float wkc = EXP_WK(32);
#pragma unroll 1
        for (int it = 4; it < 8; ++it) {
            const int g8 = 8 * it;
            STEP2(0, R0, R7) STEP2(1, R1, R0) STEP2(2, R2, R1) STEP2(3, R3, R2) STEP2(4, R4, R3) STEP2(5, R5, R4) STEP2(6, R6, R5) STEP2(7, R7, R6)
        }
#undef STEP2
#undef EXP_EX2
#undef EXP_WK
#undef EXP_EX
#undef EXP_TAB
#pragma unroll
        for (int c = 0; c < 8; ++c) hn[c] = *(const v4u*)(H + (size_t)tokn * 1024 + 64 * jl + 8 * c);
        f32x2 h1[16];
        { const bool up = (grp & 2) != 0;
#pragma unroll
          for (int e = 0; e < 16; ++e) { const f32x2 keep = up ? oacc[16 + e] : oacc[e], send = up ? oacc[e] : oacc[16 + e]; h1[e] = keep + (f32x2){__shfl_xor(send.x, 32), __shfl_xor(send.y, 32)}; } }
        f32x2 h2[8];
        { const bool up = (grp & 1) != 0;
#pragma unroll
          for (int e = 0; e < 8; ++e) { const f32x2 keep = up ? h1[8 + e] : h1[e], send = up ? h1[e] : h1[8 + e]; h2[e] = keep + (f32x2){__shfl_xor(send.x, 16), __shfl_xor(send.y, 16)}; } }
        const int d0 = 64 * jl + 16 * grp;
        const float* g2p = MOD + (size_t)(layer * 8 + b) * 6144 + 5120 + d0; const float psc = ((ABL_ON >= (layer == 0 ? 2 : 4)) ? 1.f : 0.f) * (1.0f / EXP_REP);
        float* xp = P.out + (size_t)tok * 1024 + d0;
        float xn[16]; float ss = 0.f;
#pragma unroll
        for (int q = 0; q < 4; ++q) { const f32x4 xa = *(const f32x4*)(xp + 4 * q), ga = *(const f32x4*)(g2p + 4 * q);
            xn[4 * q] = xa[0] + psc * ga[0] * h2[2 * q].x; xn[4 * q + 1] = xa[1] + psc * ga[1] * h2[2 * q].y; xn[4 * q + 2] = xa[2] + psc * ga[2] * h2[2 * q + 1].x; xn[4 * q + 3] = xa[3] + psc * ga[3] * h2[2 * q + 1].y; }
#pragma unroll
        for (int e = 0; e < 16; ++e) ss += xn[e] * xn[e];
        const float rstd = 1.0f / sqrtf(wave_sum(ss) * (1.0f / 1024.0f) + NORM_EPS);
        if (!last) {
            const float* ng = P.norm_mix_g + (layer + 1) * 1024 + d0; const float* mb = MOD + (size_t)((layer + 1) * 8 + b) * 6144 + d0;
            unsigned w[8];
#pragma unroll
            for (int q = 0; q < 4; ++q) { *(f32x4*)(xp + 4 * q) = (f32x4){xn[4 * q], xn[4 * q + 1], xn[4 * q + 2], xn[4 * q + 3]}; }
#pragma unroll
            for (int e = 0; e < 8; ++e) w[e] = pk2(xn[2 * e] * rstd * ng[2 * e] * (1.0f + mb[1024 + 2 * e]) + mb[2 * e], xn[2 * e + 1] * rstd * ng[2 * e + 1] * (1.0f + mb[1024 + 2 * e + 1]) + mb[2 * e + 1]);
            v4u* hp = (v4u*)(H + (size_t)tok * 1024 + d0); hp[0] = (v4u){w[0], w[1], w[2], w[3]}; hp[1] = (v4u){w[4], w[5], w[6], w[7]};
        } else {
            const float* fg = P.final_norm_g + d0;
#pragma unroll
            for (int q = 0; q < 4; ++q) *(f32x4*)(xp + 4 * q) = (f32x4){xn[4 * q] * rstd * fg[4 * q], xn[4 * q + 1] * rstd * fg[4 * q + 1], xn[4 * q + 2] * rstd * fg[4 * q + 2], xn[4 * q + 3] * rstd * fg[4 * q + 3]};
        }
        i0 = i0n; i1 = i1n; g0 = g0n; g1 = g1n; tok = tokn;
    }
#undef EXP_ISSUE
#undef EXP_SRC
#undef SB
}

#ifndef NC_PER_XCD
#define NC_PER_XCD 19
#endif
#ifdef PROBE_SEL
#define SUBSTAMP(i) do { if (W.c == 0 && C.tid == 0) __hip_atomic_store((unsigned*)(P.ws + WS_CTL) + 128 + 16 * W.h + (i), (unsigned)__builtin_amdgcn_s_memrealtime(), __ATOMIC_RELAXED, __HIP_MEMORY_SCOPE_AGENT); } while (0)
#else
#define SUBSTAMP(i) do {} while (0)
#endif
__device__ __forceinline__ void run_C0(const Params& P, const Ctx& Cin, const Wk& W, const XcdBarrier& tb) {
    const Ctx C = fresh_ctx(Cin);
    SUBSTAMP(0);
    unsigned char* ws = P.ws; float* MOD = (float*)(ws + WS_MOD); bf16* H = (bf16*)(ws + WS_H);
    const size_t tk = (size_t)W_TK0(W); unsigned char* const ar = w_ar(P, W);
    phase_norm(P, C, W, P.x, P.norm_mix_g, 0, 0); xcd_barrier(tb); SUBSTAMP(1);
    { pg8::Gemm g{H + tk * 1024, (const bf16*)(ws + WS_WIN), HT, 3072, 1024}; pg8::StaticOrder S; S.init(HT, 3072, W.n, W.c);
      EpiInProj E{(bf16*)(ar + AR_PU), (bf16*)(ar + AR_PV), (bf16*)(ar + AR_PQ), (bf16*)(ar + AR_PI), (bf16*)(ar + AR_PG), (float*)(ar + AR_G), (const float*)(ws + WS_LB)};
      pg8::gemm_phase<EpiInProj, pg8::StaticOrder, true, true>(C.lds, g, S, E); } xcd_barrier(tb); SUBSTAMP(2);
    for (int it = W.lv; it < 1024; it += W.n) gmlp_item(P, C, W, W_TK0(W) / 128 + (it >> 2), it & 3);
    for (int it = W.lv; it < 2048; it += W.n) hgrn_local_item(P, C, W, W_BT0(W) * 512 + it);
    xcd_barrier(tb); SUBSTAMP(3);
    phase_hgrn_scan(P, C, W); xcd_barrier(tb); SUBSTAMP(4);
    for (int it = W.lv; it < 2048; it += W.n) hgrn_out_item(P, C, W, W_BT0(W) * 512 + it);
    xcd_barrier(tb); SUBSTAMP(5);
    { pg8::Gemm g{H + tk * 1024, (const bf16*)(ws + WS_WOUT0), HT, 1024, 1024}; pg8::StaticOrder S; S.init(HT, 1024, W.n, W.c);
      EpiResid E{P.x + tk * 1024, P.out + tk * 1024, MOD + 2048 + (size_t)W_BT0(W) * 6144, 1.f};
      pg8::gemm_phase<EpiResid, pg8::StaticOrder, true, true>(C.lds, g, S, E); } xcd_barrier(tb); SUBSTAMP(6);
    phase_norm(P, C, W, P.out, P.norm_ffn_g, 0, 3072); xcd_barrier(tb); SUBSTAMP(7);
    { pg8::Gemm g{H + tk * 1024, (const bf16*)(ws + WS_WQ0), HT, 2048, 1024}; pg8::StaticOrder S; S.init(HT, 2048, W.n, W.c);
      EpiBf16P E{(bf16*)(ar + AR_QP), 2048};
      pg8::gemm_phase<EpiBf16P, pg8::StaticOrder, true, true>(C.lds, g, S, E); }
    SUBSTAMP(9);
}
__device__ __forceinline__ void run_C1(const Params& P, const Ctx& Cin, const Wk& W, const XcdBarrier& tb) {
    const Ctx C = fresh_ctx(Cin);
    SUBSTAMP(0);
    unsigned char* ws = P.ws; float* MOD = (float*)(ws + WS_MOD); bf16* H = (bf16*)(ws + WS_H);
    const size_t tk = (size_t)W_TK0(W); unsigned char* const ar = w_ar(P, W);
    { pg8::Gemm g{H + tk * 1024, (const bf16*)(ws + WS_WQKV), HT, 3072, 1024}; pg8::StaticOrder S; S.init(HT, 3072, W.n, W.c);
      EpiQKRot E{(bf16*)(ar + AR_QK), (const float*)(ws + WS_CS) + tk * 16};
      pg8::gemm_phase<EpiQKRot, pg8::StaticOrder, true, true>(C.lds, g, S, E); } xcd_barrier(tb); SUBSTAMP(1);
    for (int it = W.lv; it < (NB / 2) * 16 * 16; it += W.n) attn_item(P, C, W, W_BT0(W) + (it >> 8), (it >> 4) & 15, it & 15);
    xcd_barrier(tb); SUBSTAMP(2);
    { pg8::Gemm g{H + tk * 1024, (const bf16*)(ws + WS_WOUT1), HT, 1024, 1024}; pg8::StaticOrder S; S.init(HT, 1024, W.n, W.c);
      EpiResid E{P.out + tk * 1024, P.out + tk * 1024, MOD + (size_t)8 * 6144 + 2048 + (size_t)W_BT0(W) * 6144, 1.f};
      pg8::gemm_phase<EpiResid, pg8::StaticOrder, true, true>(C.lds, g, S, E); } xcd_barrier(tb); SUBSTAMP(3);
    phase_norm(P, C, W, P.out, P.norm_ffn_g + 1024, 1, 3072); xcd_barrier(tb); SUBSTAMP(4);
    { pg8::Gemm g{H + tk * 1024, (const bf16*)(ws + WS_WQ1), HT, 2048, 1024}; pg8::StaticOrder S; S.init(HT, 2048, W.n, W.c);
      EpiBf16P E{(bf16*)(ar + AR_QP), 2048};
      pg8::gemm_phase<EpiBf16P, pg8::StaticOrder, true, true>(C.lds, g, S, E); }
    SUBSTAMP(9);
}
__device__ __forceinline__ void run_E(const Params& P, const Ctx& Cin, const Wk& W, const XcdBarrier& tb, int layer) {
    { const Ctx C = fresh_ctx(Cin); phase_peer_topk(P, C, W, layer); }
    xcd_barrier(tb);
    if (W.c == 0 && Cin.tid == 0) __hip_atomic_store((unsigned*)(P.ws + WS_CTL) + 112 + 2 * layer + W.h, 1u, __ATOMIC_RELAXED, __HIP_MEMORY_SCOPE_AGENT);
    phase_peer_experts(P, Cin, W, layer, layer == 1);
}
__device__ __forceinline__ void help_E(const Params& P, const Ctx& Cin, int h, int layer) {
    volatile LAS unsigned* okw = (volatile LAS unsigned*)(Cin.lds + LDSCTL_OFF + 192);
    if (Cin.tid == 0) { unsigned* flag = (unsigned*)(P.ws + WS_CTL) + 112 + 2 * layer + h; unsigned ok = 0u;
        for (unsigned sp = 0; sp < (1u << 16); ++sp) { if (__hip_atomic_load(flag, __ATOMIC_RELAXED, __HIP_MEMORY_SCOPE_AGENT) != 0u) { ok = 1u; break; } __builtin_amdgcn_s_sleep(8); }
        __builtin_amdgcn_fence(__ATOMIC_ACQUIRE, "agent"); asm volatile("s_waitcnt vmcnt(0)" ::: "memory");
        *okw = ok; }
    __syncthreads();
    const bool ok = *okw != 0u;
    __syncthreads();
    if (ok) { Wk W; W.lv = 0; W.n = 1; W.c = 1; W.h = h; phase_peer_experts(P, Cin, W, layer, layer == 1); }
}
__global__ void __launch_bounds__(NWAVES * 64, 2) hybrid_fwd(Params P) {
    extern __shared__ __attribute__((aligned(16))) unsigned char lds_raw[];
    Ctx C;
    C.lds = (LAS unsigned char*)lds_raw;
    C.tid = threadIdx.x; C.lane = C.tid & 63; C.wave = __builtin_amdgcn_readfirstlane(C.tid >> 6);
    C.G = gridDim.x; const int bx = blockIdx.x; C.vcu = (bx % 8) * (C.G / 8) + bx / 8;
    volatile LAS unsigned* MISC = (volatile LAS unsigned*)(C.lds + MISC_OFF);
    for (int u = C.tid; u < (LDS_BYTES - LDSCTL_OFF) / 4; u += NWAVES * 64) ((LAS unsigned*)(C.lds + LDSCTL_OFF))[u] = 0u;
    __syncthreads();
    unsigned* ctl = (unsigned*)(P.ws + WS_CTL);
    const int xl = bx & 7, jx = bx >> 3, perx = C.G / 8;
    const bool inC = jx < NC_PER_XCD;
    const int nC = 8 * NC_PER_XCD, nE = C.G - nC;
    const XcdBarrier bar_all = xcd_barrier_post(ctl + CW_BAR, MISC + 8);
    XcdBarrier bar_c; bar_c.bar = ctl + CW_BAR + XCD_BAR_WORDS; bar_c.x = bar_all.x; bar_c.st = MISC + 10; bar_c.G = (unsigned)nC;
    if (inC && C.tid == 0) (void)xb_add(&bar_c.bar[XB_XCNT(bar_c.x)], 1u);
    XcdBarrier bar_e; bar_e.bar = ctl + CW_BAR + 2 * XCD_BAR_WORDS; bar_e.x = bar_all.x; bar_e.st = MISC + 12; bar_e.G = (unsigned)nE;
    if (!inC && C.tid == 0) (void)xb_add(&bar_e.bar[XB_XCNT(bar_e.x)], 1u);
    Wk Wall; Wall.lv = C.vcu; Wall.n = C.G; Wall.c = bx; Wall.h = 0;
    Wk Wc; Wc.lv = xl * NC_PER_XCD + jx; Wc.n = nC; Wc.c = jx * 8 + xl; Wc.h = 0;
    Wk We; { const int je = jx - NC_PER_XCD, ne = perx - NC_PER_XCD; We.lv = xl * ne + je; We.n = nE; We.c = je * 8 + xl; We.h = 0; }
    phase_prologue(P, C);
    xcd_barrier(bar_all);
#ifdef PROBE_SEL
    unsigned long long tp0 = __builtin_amdgcn_s_memrealtime(), tp1 = 0, tp2 = 0, tp3 = 0, tp4 = 0, tp5 = 0, tpe1 = 0, tpe2 = 0, tpe3 = 0;
#define STAMP(v) v = __builtin_amdgcn_s_memrealtime()
#else
#define STAMP(v)
#endif
    Wall.h = 0; run_C0(P, C, Wall, bar_all); xcd_barrier(bar_all); STAMP(tp1);
    if (inC) { Wc.h = 1; run_C0(P, C, Wc, bar_c); help_E(P, C, 0, 0); } else { We.h = 0; run_E(P, C, We, bar_e, 0); }
    STAMP(tpe1);
#ifdef PROBE_SEL
    if (C.tid == 0) atomicMax(ctl + 80 + (inC ? 0 : 1), (unsigned)(tpe1 - tp1));
#endif
    xcd_barrier(bar_all); STAMP(tp2);
    if (inC) { Wc.h = 0; run_C1(P, C, Wc, bar_c); help_E(P, C, 1, 0); } else { We.h = 1; run_E(P, C, We, bar_e, 0); }
    STAMP(tpe2);
#ifdef PROBE_SEL
    if (C.tid == 0) atomicMax(ctl + 82 + (inC ? 0 : 1), (unsigned)(tpe2 - tp2));
#endif
    xcd_barrier(bar_all); STAMP(tp3);
    if (inC) { Wc.h = 1; run_C1(P, C, Wc, bar_c); help_E(P, C, 0, 1); } else { We.h = 0; run_E(P, C, We, bar_e, 1); }
    STAMP(tpe3);
#ifdef PROBE_SEL
    if (C.tid == 0) atomicMax(ctl + 84 + (inC ? 0 : 1), (unsigned)(tpe3 - tp3));
#endif
    xcd_barrier(bar_all); STAMP(tp4);
    Wall.h = 1; run_E(P, C, Wall, bar_all, 1);
#ifdef PROBE_SEL
    STAMP(tp5);
    { unsigned long long d = 0; const int sel = PROBE_SEL;
      if (sel == 0) d = tp1 - tp0; if (sel == 1) d = tp2 - tp1; if (sel == 2) d = tp3 - tp2; if (sel == 3) d = tp4 - tp3; if (sel == 4) d = tp5 - tp4;
      if (sel == 5 || sel == 8) d = tpe1 - tp1; if (sel == 6 || sel == 9) d = tpe2 - tp2; if (sel == 7 || sel == 10) d = tpe3 - tp3;
      const int who = sel >= 8 ? 8 * NC_PER_XCD : 0;
      if (sel >= 20) { const unsigned* sp = (const unsigned*)(P.ws + WS_CTL) + 128 + 16 * PROBE_HALF; const int i = sel - 20; const int nxt = (i == PROBE_LAST) ? 9 : i + 1; d = (unsigned long long)(__hip_atomic_load(sp + nxt, __ATOMIC_RELAXED, __HIP_MEMORY_SCOPE_AGENT) - __hip_atomic_load(sp + i, __ATOMIC_RELAXED, __HIP_MEMORY_SCOPE_AGENT)); }
      if (sel >= 30) d = 0;
      if (bx == (sel >= 20 ? 0 : who) && C.tid == 0) __hip_atomic_store(ctl + 64, (unsigned)d, __ATOMIC_RELAXED, __HIP_MEMORY_SCOPE_AGENT);
      xcd_barrier(bar_all);
      if (bx == 0 && C.tid == 0) { const unsigned dd = sel >= 30 ? __hip_atomic_load(ctl + 80 + (sel - 30), __ATOMIC_RELAXED, __HIP_MEMORY_SCOPE_AGENT) : __hip_atomic_load(ctl + 64, __ATOMIC_RELAXED, __HIP_MEMORY_SCOPE_AGENT);
        const unsigned long long t0_ = __builtin_amdgcn_s_memrealtime(); while (__builtin_amdgcn_s_memrealtime() - t0_ < 4ull * dd) __builtin_amdgcn_s_sleep(32); } }
#endif
}

extern "C" void kernel_launch(void* const* d_in, const int* in_sizes, int n_in, void* d_out, int out_size, void* d_ws, size_t ws_size, hipStream_t stream) {
    static int grid = 0;
    if (grid == 0) {
        if (n_in != 22 || in_sizes[0] != T * DM || out_size != T * DM || ws_size < WS_END) {
            fprintf(stderr, "kernel_launch: unexpected shapes (n_in %d, in0 %d, out %d, ws %zu); nothing launched\n", n_in, n_in > 0 ? in_sizes[0] : -1, out_size, ws_size); grid = -1; return; }
        int dev = 0, cus = 0;
        if (hipGetDevice(&dev) != hipSuccess || hipDeviceGetAttribute(&cus, hipDeviceAttributeMultiprocessorCount, dev) != hipSuccess) { fprintf(stderr, "kernel_launch: device query failed\n"); grid = -1; return; }
        if (hipFuncSetAttribute((const void*)hybrid_fwd, hipFuncAttributeMaxDynamicSharedMemorySize, LDS_BYTES) != hipSuccess) { fprintf(stderr, "kernel_launch: hipFuncSetAttribute failed\n"); grid = -1; return; }
        (void)hipGetLastError();
        grid = cus;
        if (grid % 8 != 0 || grid / 8 <= NC_PER_XCD) { fprintf(stderr, "kernel_launch: built for a CU count that is a multiple of 8 and > %d; got %d; nothing launched\n", 8 * NC_PER_XCD, grid); grid = -1; return; }
    }
    if (grid < 0) return;
    if (hipMemsetAsync((char*)d_ws + WS_CTL, 0, CTL_ZERO_BYTES, stream) != hipSuccess) { fprintf(stderr, "kernel_launch: memset failed\n"); return; }
    Params p{};
    p.x = (const float*)d_in[0]; p.c = (const float*)d_in[1]; p.positions = (const int*)d_in[2]; p.ada_w = (const float*)d_in[3]; p.ada_b = (const float*)d_in[4];
    p.norm_mix_g = (const float*)d_in[5]; p.norm_ffn_g = (const float*)d_in[6]; p.final_norm_g = (const float*)d_in[7]; p.even_w_in = (const float*)d_in[8]; p.even_w_out = (const float*)d_in[9];
    p.gmlp_ln_g = (const float*)d_in[10]; p.gmlp_ln_b = (const float*)d_in[11]; p.gmlp_w_s = (const float*)d_in[12]; p.gmlp_b_s = (const float*)d_in[13]; p.hgrn_lb_logits = (const float*)d_in[14];
    p.hgrn_norm_g = (const float*)d_in[15]; p.odd_w_qkv = (const float*)d_in[16]; p.odd_w_out = (const float*)d_in[17]; p.peer_w_query = (const float*)d_in[18]; p.peer_sub_keys = (const float*)d_in[19];
    p.peer_down = (const float*)d_in[20]; p.peer_up = (const float*)d_in[21];
    p.out = (float*)d_out; p.ws = (unsigned char*)d_ws;
    p.ph_lo = 0; p.ph_hi = 0;
    hipLaunchKernelGGL(hybrid_fwd, dim3(grid), dim3(NWAVES * 64), LDS_BYTES, stream, p);
    const hipError_t le = hipPeekAtLastError();
    if (le != hipSuccess) fprintf(stderr, "kernel_launch: launch failed: %s\n", hipGetErrorName(le));
}
```
